# Optimizing an MI355X kernel written in HIP

```python
import jax
import jax.numpy as jnp
from jax import lax
import numpy as np

D_MODEL = 2048
BATCH = 8
SEQ = 2048
DEPTH = 2

GRID_W = 64
CTX_LEN = 256
N_HEADS = 16
N_KV_HEADS = 4
HEAD_DIM = D_MODEL // N_HEADS
KV_GROUP = N_HEADS // N_KV_HEADS
AXIS_ROT_DIM = HEAD_DIM // 2
ROPE_THETA = 10000.0
WINDOW = 128
BLOCK = 128
CONV_WIDTH = 3
N_EXPERTS = 16
EC_CAPACITY_FACTOR = 2
D_EXPERT = D_MODEL // 2
NORM_EPS = 1e-6
MASK_VALUE = -1e30
MIXER_ORDER = ('conv', 'attn')
N_MIXERS = 2
N_CONV_LAYERS = (DEPTH + 1) // 2
N_ATTN_LAYERS = DEPTH // 2

kernel_name = 'hybrid_shortconv_swa_ec_moe_dit'


def rms_norm(x, gain):
    xf = x.astype(jnp.float32)
    xf = xf * lax.rsqrt(jnp.mean(xf * xf, axis=-1, keepdims=True) + NORM_EPS)
    return (xf * gain.astype(jnp.float32)).astype(x.dtype)


def _row(v):
    return v[..., None, :]


def modulate(x, gain, shift, scale):
    return rms_norm(x, gain) * (1 + _row(scale)) + _row(shift)


def adaln(cond, w_ada, b_ada):
    return jnp.split(jax.nn.silu(cond) @ w_ada + b_ada, 6, axis=-1)


def axial_rope_angles(rows):
    row = jnp.repeat(jnp.arange(rows, dtype=jnp.float32), GRID_W)
    col = jnp.tile(jnp.arange(GRID_W, dtype=jnp.float32), rows)
    inv_freq = ROPE_THETA ** (-jnp.arange(AXIS_ROT_DIM // 2, dtype=jnp.float32) * 2.0 / AXIS_ROT_DIM)
    return row[:, None] * inv_freq, col[:, None] * inv_freq


def rope_rotate(x, ang):
    d2 = x.shape[-1] // 2
    cos = jnp.cos(ang)[:, None, :]
    sin = jnp.sin(ang)[:, None, :]
    x1, x2 = x[..., :d2], x[..., d2:]
    return jnp.concatenate([x1 * cos - x2 * sin, x2 * cos + x1 * sin], axis=-1)


def axial_rope(x, ang_row, ang_col):
    xf = x.astype(jnp.float32)
    out = jnp.concatenate([rope_rotate(xf[..., :AXIS_ROT_DIM], ang_row),
                           rope_rotate(xf[..., AXIS_ROT_DIM:], ang_col)], axis=-1)
    return out.astype(x.dtype)


def short_gated_conv(h, w_in, conv_w, w_out):
    s = h.shape[1]
    gate_b, gate_c, xv = jnp.split(h @ w_in, 3, axis=-1)
    u = gate_c * xv
    pad = CONV_WIDTH // 2
    up = jnp.pad(u, ((0, 0), (pad, pad), (0, 0)))
    y = conv_w[0] * up[:, 0:s]
    for j in range(1, CONV_WIDTH):
        y = y + conv_w[j] * up[:, j:j + s]
    return (gate_b * y) @ w_out


def windowed_gqa_sink(a_lat, a_ctx, w_qkv, q_gain, k_gain, sink, w_o, ang_row, ang_col, update_ctx):
    b, s, _ = a_lat.shape
    n_ctx = a_ctx.shape[1]
    n_blk = s // BLOCK
    dq = N_HEADS * HEAD_DIM
    dkv = N_KV_HEADS * HEAD_DIM
    scale = HEAD_DIM ** -0.5

    def heads(t, n_heads, gain):
        t = t.reshape(t.shape[0], t.shape[1], n_heads, HEAD_DIM)
        return t if gain is None else rms_norm(t, gain)

    qkv = a_lat @ w_qkv
    q = axial_rope(heads(qkv[..., :dq], N_HEADS, q_gain), ang_row, ang_col)
    k = axial_rope(heads(qkv[..., dq:dq + dkv], N_KV_HEADS, k_gain), ang_row, ang_col)
    v = heads(qkv[..., dq + dkv:], N_KV_HEADS, None)
    kv_ctx = a_ctx @ w_qkv[:, dq:]
    k_ctx = heads(kv_ctx[..., :dkv], N_KV_HEADS, k_gain)
    v_ctx = heads(kv_ctx[..., dkv:], N_KV_HEADS, None)
    sink_f = sink.astype(jnp.float32).reshape(N_KV_HEADS, KV_GROUP)

    qb = q.reshape(b, n_blk, BLOCK, N_KV_HEADS, KV_GROUP, HEAD_DIM)

    def band(t):
        tp = jnp.pad(t, ((0, 0), (BLOCK, BLOCK), (0, 0), (0, 0)))
        tb = tp.reshape(b, n_blk + 2, BLOCK, N_KV_HEADS, HEAD_DIM)
        return jnp.concatenate([tb[:, :-2], tb[:, 1:-1], tb[:, 2:]], axis=2)

    kb, vb = band(k), band(v)
    q_pos = jnp.arange(s).reshape(n_blk, BLOCK)
    k_pos = (jnp.arange(n_blk)[:, None] - 1) * BLOCK + jnp.arange(3 * BLOCK)[None, :]
    valid = ((k_pos[:, None, :] >= 0) & (k_pos[:, None, :] < s)
             & (jnp.abs(q_pos[:, :, None] - k_pos[:, None, :]) <= WINDOW))

    s_loc = jnp.einsum('bnqhgd,bnkhd->bhgnqk', qb, kb, preferred_element_type=jnp.float32) * scale
    s_loc = jnp.where(valid[None, None, None], s_loc, MASK_VALUE)
    s_ctx = jnp.einsum('bnqhgd,bchd->bhgnqc', qb, k_ctx, preferred_element_type=jnp.float32) * scale
    s_sink = jnp.broadcast_to(sink_f[None, :, :, None, None, None], s_loc.shape[:-1] + (1,))
    p = jax.nn.softmax(jnp.concatenate([s_loc, s_ctx, s_sink], axis=-1), axis=-1)
    p_loc = p[..., :3 * BLOCK].astype(v.dtype)
    p_ctx = p[..., 3 * BLOCK:3 * BLOCK + n_ctx].astype(v.dtype)
    o = (jnp.einsum('bhgnqk,bnkhd->bnqhgd', p_loc, vb)
         + jnp.einsum('bhgnqc,bchd->bnqhgd', p_ctx, v_ctx))
    y_lat = o.reshape(b, s, dq) @ w_o

    if not update_ctx:
        return y_lat, None
    q_ctx = heads(a_ctx @ w_qkv[:, :dq], N_HEADS, q_gain).reshape(b, n_ctx, N_KV_HEADS, KV_GROUP, HEAD_DIM)
    sc = jnp.einsum('bqhgd,bchd->bhgqc', q_ctx, k_ctx, preferred_element_type=jnp.float32) * scale
    sc_sink = jnp.broadcast_to(sink_f[None, :, :, None, None], sc.shape[:-1] + (1,))
    pc = jax.nn.softmax(jnp.concatenate([sc, sc_sink], axis=-1), axis=-1)[..., :n_ctx].astype(v_ctx.dtype)
    oc = jnp.einsum('bhgqc,bchd->bqhgd', pc, v_ctx).reshape(b, n_ctx, dq)
    return y_lat, oc @ w_o


def expert_choice_swiglu(h, w_router, w_gate, w_up, w_down):
    b, n, _ = h.shape
    cap = EC_CAPACITY_FACTOR * n // N_EXPERTS
    logits = jnp.einsum('bnd,de->bne', h, w_router, preferred_element_type=jnp.float32)
    affinity = jax.nn.softmax(logits, axis=-1)
    gates, idx = lax.top_k(jnp.swapaxes(affinity, 1, 2), cap)
    b_idx = jnp.arange(b)[:, None, None]
    xs = h[b_idx, idx]
    a = jnp.einsum('becd,edf->becf', xs, w_gate)
    u = jnp.einsum('becd,edf->becf', xs, w_up)
    y = jnp.einsum('becf,efd->becd', jax.nn.silu(a) * u, w_down)
    y = y * gates[..., None].astype(y.dtype)
    return jnp.zeros_like(h).at[b_idx, idx].add(y)


def setup_inputs(seed: int = 0) -> dict:
    key = jax.random.key(seed)
    ks = jax.random.split(key, 24)
    d, f = D_MODEL, D_EXPERT
    dqkv = (N_HEADS + 2 * N_KV_HEADS) * HEAD_DIM
    nrm = jax.random.normal
    return {
        'x': nrm(ks[0], (BATCH, SEQ, d), jnp.float32),
        'c': nrm(ks[1], (BATCH, d), jnp.float32),
        'ctx': nrm(ks[2], (BATCH, CTX_LEN, d), jnp.float32),
        'c_ctx': nrm(ks[3], (d,), jnp.float32),
        'ada_w': nrm(ks[4], (DEPTH, d, 6 * d), jnp.float32) * (0.5 * d ** -0.5),
        'ada_b': nrm(ks[5], (DEPTH, 6 * d), jnp.float32) * 0.02,
        'norm_mix_g': 1.0 + 0.02 * nrm(ks[6], (DEPTH, d), jnp.float32),
        'norm_ffn_g': 1.0 + 0.02 * nrm(ks[7], (DEPTH, d), jnp.float32),
        'conv_w_in': nrm(ks[8], (N_CONV_LAYERS, d, 3 * d), jnp.float32) * d ** -0.5,
        'conv_w': nrm(ks[9], (N_CONV_LAYERS, CONV_WIDTH, d), jnp.float32) * CONV_WIDTH ** -0.5,
        'conv_w_out': nrm(ks[10], (N_CONV_LAYERS, d, d), jnp.float32) * d ** -0.5,
        'attn_w_qkv': nrm(ks[11], (N_ATTN_LAYERS, d, dqkv), jnp.float32) * d ** -0.5,
        'attn_q_gain': 1.0 + 0.02 * nrm(ks[12], (N_ATTN_LAYERS, HEAD_DIM), jnp.float32),
        'attn_k_gain': 1.0 + 0.02 * nrm(ks[13], (N_ATTN_LAYERS, HEAD_DIM), jnp.float32),
        'attn_sink': nrm(ks[14], (N_ATTN_LAYERS, N_HEADS), jnp.float32),
        'attn_w_o': nrm(ks[15], (N_ATTN_LAYERS, N_HEADS * HEAD_DIM, d), jnp.float32) * d ** -0.5,
        'router_w': nrm(ks[16], (DEPTH, d, N_EXPERTS), jnp.float32) * d ** -0.5,
        'expert_w_gate': nrm(ks[17], (DEPTH, N_EXPERTS, d, f), jnp.float32) * d ** -0.5,
        'expert_w_up': nrm(ks[18], (DEPTH, N_EXPERTS, d, f), jnp.float32) * d ** -0.5,
        'expert_w_down': nrm(ks[19], (DEPTH, N_EXPERTS, f, d), jnp.float32) * f ** -0.5,
    }


def reference(x, c, ctx, c_ctx, ada_w, ada_b, norm_mix_g, norm_ffn_g, conv_w_in, conv_w, conv_w_out,
              attn_w_qkv, attn_q_gain, attn_k_gain, attn_sink, attn_w_o, router_w,
              expert_w_gate, expert_w_up, expert_w_down):
    s = x.shape[1]
    rows = s // GRID_W
    ang_row, ang_col = axial_rope_angles(rows)
    h_lat, h_ctx = x, ctx
    i_conv = 0
    i_attn = 0
    for i in range(DEPTH):
        kind = MIXER_ORDER[i % N_MIXERS]
        ctx_live = any(MIXER_ORDER[j % N_MIXERS] == 'attn' for j in range(i + 1, DEPTH))
        sh1, sc1, g1, sh2, sc2, g2 = adaln(c, ada_w[i], ada_b[i])
        csh1, csc1, cg1, csh2, csc2, cg2 = adaln(c_ctx, ada_w[i], ada_b[i])
        a_lat = modulate(h_lat, norm_mix_g[i], sh1, sc1)
        if kind == 'conv':
            y_lat = short_gated_conv(a_lat, conv_w_in[i_conv], conv_w[i_conv], conv_w_out[i_conv])
            y_ctx = None
            if ctx_live:
                a_ctx = modulate(h_ctx, norm_mix_g[i], csh1, csc1)
                y_ctx = short_gated_conv(a_ctx, conv_w_in[i_conv], conv_w[i_conv], conv_w_out[i_conv])
            i_conv += 1
        else:
            a_ctx = modulate(h_ctx, norm_mix_g[i], csh1, csc1)
            y_lat, y_ctx = windowed_gqa_sink(a_lat, a_ctx, attn_w_qkv[i_attn], attn_q_gain[i_attn],
                                             attn_k_gain[i_attn], attn_sink[i_attn], attn_w_o[i_attn],
                                             ang_row, ang_col, ctx_live)
            i_attn += 1
        h_lat = h_lat + _row(g1) * y_lat
        h_lat = h_lat + _row(g2) * expert_choice_swiglu(modulate(h_lat, norm_ffn_g[i], sh2, sc2), router_w[i],
                                                        expert_w_gate[i], expert_w_up[i], expert_w_down[i])
        if ctx_live:
            h_ctx = h_ctx + _row(cg1) * y_ctx
            h_ctx = h_ctx + _row(cg2) * expert_choice_swiglu(modulate(h_ctx, norm_ffn_g[i], csh2, csc2),
                                                             router_w[i], expert_w_gate[i], expert_w_up[i],
                                                             expert_w_down[i])
    return h_lat
```

```cpp
#include <hip/hip_runtime.h>
#include <cstdio>
#include <cstdint>
namespace pg8 {
#define PG8_LAS __attribute__((address_space(3)))
typedef unsigned short bf16_t;
typedef short bf16x8 __attribute__((ext_vector_type(8)));
typedef float f32x4 __attribute__((ext_vector_type(4)));
typedef unsigned u32x4 __attribute__((ext_vector_type(4)));
constexpr int BM = 256, BK = 64, HALF = 128, HTB = HALF * BK * 2  , STAGE_BYTES = 8 * HTB, NXCD = 8, WGM = 8;

__host__ __device__ __forceinline__ int lds_byte(int r, int c) { const int st = (r >> 4) * 2 + (c >> 5), rr = r & 15, cc = c & 31, ob = rr * 64 + cc * 2; return st * 1024 + (ob ^ (((ob >> 9) & 1) << 5)); }
__host__ __device__ __forceinline__ void stage_rc(int b, int& R, int& C) { const int st = b / 1024, sb = b % 1024, swz = sb ^ (((sb >> 9) & 1) << 5); R = (st >> 1) * 16 + swz / 64; C = (st & 1) * 32 + (swz % 64) / 2; }
__host__ __device__ __forceinline__ int perm32(int rho) { const int n = rho >> 4, i = rho & 15; return 8 * (i >> 2) + 4 * n + (i & 3); }

struct Unit { int pm, pn; };
struct Gemm { const bf16_t* A; const bf16_t* Bt; int M, N, K; };

struct StaticOrder {
    int nM, nN, nwg, G, c;
    __host__ __device__ void init(int M, int N, int G_, int c_) { nM = M / BM; nN = N / BM; nwg = nM * nN; G = G_; c = c_; }
    __host__ __device__ bool next(int i, Unit& u) const {
        const long L = (long)i * G + c; if (L >= nwg) return false;
        int wgid = (int)L; { const int q = nwg / NXCD, r = nwg % NXCD, xcd = wgid % NXCD, off = wgid / NXCD; wgid = (xcd < r ? xcd * (q + 1) : r * (q + 1) + (xcd - r) * q) + off; }
        const int nig = WGM * nN, gid = wgid / nig, fm = gid * WGM, gsz = (nM - fm) < WGM ? (nM - fm) : WGM;
        u.pm = fm + ((wgid % nig) % gsz); u.pn = (wgid % nig) / gsz; return true;
    }
    __device__ __forceinline__ void a_ready(const Unit&) const {}
    __device__ __forceinline__ void done(const Unit&) const {}
};
__device__ __forceinline__ unsigned cvt_pk_bf16(float lo, float hi) { unsigned r; asm volatile("v_cvt_pk_bf16_f32 %0, %1, %2" : "=v"(r) : "v"(lo), "v"(hi)); return r; }
typedef float f32x2 __attribute__((ext_vector_type(2)));
template <class Epi, class Sched, bool ALIGN_EPI = false, bool SP2 = false>
__device__ __forceinline__ void gemm_phase(PG8_LAS unsigned char* lds, const Gemm g, const Sched& S, const Epi& E) {
    const int tid = threadIdx.x, wid = __builtin_amdgcn_readfirstlane(tid >> 6), lane = tid & 63, wr = wid >> 2, wc = wid & 3, fr = lane & 15, fq = lane >> 4;
    const int K = g.K, nt = K / BK;
    unsigned voffA[2], voffB[2];
#pragma unroll
    for (int i = 0; i < 2; ++i) { int R, C; stage_rc(tid * 16 + i * 8192, R, C); const int Rb = Epi::PERM ? ((R & ~31) + perm32(R & 31)) : R;
        voffA[i] = (unsigned)(R * K + C) * 2u; voffB[i] = (unsigned)(Rb * K + C) * 2u; }
    const size_t kstep = (size_t)(BK * 2);
    const size_t hstep = (size_t)HALF * K * 2;
    const size_t tstep = 2 * hstep;
    const unsigned ldsw = (unsigned)wid * 1024u;
    const int aoff = lds_byte(wr * 64 + fr, fq * 8), boff = lds_byte(wc * 32 + fr, fq * 8);
#define PG8_SA(b, h) (((b) * 2 + (h)) * HTB)
#define PG8_SB(b, h) ((4 + (b) * 2 + (h)) * HTB)
#define PG8_STAGE(bufoff, gbase, voff) do { _Pragma("unroll") for (int _i = 0; _i < 2; ++_i) \
        __builtin_amdgcn_global_load_lds((const unsigned*)((const char*)(gbase) + (voff)[_i]), (PG8_LAS unsigned*)(lds + (bufoff) + ldsw + _i * 8192), 16, 0, 0); } while (0)
#define PG8_LDA(dst, b, h) do { _Pragma("unroll") for (int m = 0; m < 4; ++m) _Pragma("unroll") for (int k = 0; k < 2; ++k) dst[m][k] = *(const PG8_LAS bf16x8*)(lds + PG8_SA(b, h) + aoff + m * 2048 + k * 1024); } while (0)
#define PG8_LDB(dst, b, h) do { _Pragma("unroll") for (int n = 0; n < 2; ++n) _Pragma("unroll") for (int k = 0; k < 2; ++k) dst[n][k] = *(const PG8_LAS bf16x8*)(lds + PG8_SB(b, h) + boff + n * 2048 + k * 1024); } while (0)
#define PG8_MMA(ai, bj, At, Bt) do { __builtin_amdgcn_s_setprio(1); _Pragma("unroll") for (int m = 0; m < 4; ++m) _Pragma("unroll") for (int n = 0; n < 2; ++n) _Pragma("unroll") for (int k = 0; k < 2; ++k) \
        acc[ai][bj][m][n] = __builtin_amdgcn_mfma_f32_16x16x32_bf16(Bt[n][k], At[m][k], acc[ai][bj][m][n], 0, 0, 0); __builtin_amdgcn_s_setprio(0); } while (0)
#define PG8_WAIT_V(n) asm volatile("s_waitcnt vmcnt(" #n ")" ::: "memory")
#define PG8_WAIT_L(n) asm volatile("s_waitcnt lgkmcnt(" #n ")" ::: "memory")
#define PG8_BAR __builtin_amdgcn_s_barrier()
#define PG8_SCHED __builtin_amdgcn_sched_barrier(0)
    Unit cur, nxt; int ui = 0;
    if (!S.next(0, cur)) return;
    f32x4 acc[2][2][4][2];
#pragma unroll
    for (int a = 0; a < 2; ++a)
#pragma unroll
        for (int b = 0; b < 2; ++b)
#pragma unroll
            for (int m = 0; m < 4; ++m)
#pragma unroll
                for (int n = 0; n < 2; ++n) acc[a][b][m][n] = (f32x4){0.f, 0.f, 0.f, 0.f};
    bf16x8 At[4][2], B0[2][2], B1[2][2];
    const char* cA = (const char*)g.A + (size_t)cur.pm * tstep; const char* cB = (const char*)g.Bt + (size_t)cur.pn * tstep;
    S.a_ready(cur);
    if constexpr (SP2) {
        PG8_STAGE(PG8_SB(0, 0), cB, voffB); PG8_STAGE(PG8_SB(0, 1), cB + hstep, voffB); PG8_STAGE(PG8_SA(0, 0), cA, voffA); PG8_STAGE(PG8_SA(0, 1), cA + hstep, voffA);
        if (wr == 1) PG8_BAR;
        PG8_WAIT_V(2); PG8_BAR;
        PG8_STAGE(PG8_SB(1, 0), cB + kstep, voffB); PG8_STAGE(PG8_SA(1, 0), cA + kstep, voffA); PG8_STAGE(PG8_SB(1, 1), cB + hstep + kstep, voffB);
        PG8_WAIT_V(6); PG8_BAR;
    } else {
        PG8_STAGE(PG8_SB(0, 0), cB, voffB); PG8_STAGE(PG8_SA(0, 0), cA, voffA); PG8_STAGE(PG8_SB(0, 1), cB + hstep, voffB); PG8_STAGE(PG8_SA(0, 1), cA + hstep, voffA);
        if (wr == 1) PG8_BAR;
        PG8_WAIT_V(4); PG8_BAR;
        PG8_STAGE(PG8_SB(1, 0), cB + kstep, voffB); PG8_STAGE(PG8_SA(1, 0), cA + kstep, voffA); PG8_STAGE(PG8_SB(1, 1), cB + hstep + kstep, voffB);
        PG8_WAIT_V(6); PG8_BAR;
    }
    for (;;) {
        const bool has_next = S.next(ui + 1, nxt);
        const char* nA = has_next ? (const char*)g.A + (size_t)nxt.pm * tstep : cA; const char* nB = has_next ? (const char*)g.Bt + (size_t)nxt.pn * tstep : cB;
        for (int t = 0; t < nt; t += 2) {
            const bool last = (t == nt - 2);
            const char* a1 = cA + (size_t)(t + 1) * kstep;
            const char* a2 = last ? nA : cA + (size_t)(t + 2) * kstep; const char* b2 = last ? nB : cB + (size_t)(t + 2) * kstep;
            const char* a3 = a2 + kstep; const char* b3 = b2 + kstep;
            if (last && has_next) S.a_ready(nxt);
            if constexpr (SP2) {
            PG8_LDB(B0, 0, 0); PG8_LDB(B1, 0, 1); PG8_SCHED; PG8_LDA(At, 0, 0); PG8_STAGE(PG8_SA(1, 1), a1 + hstep, voffA);
            PG8_WAIT_V(8); PG8_WAIT_L(0); PG8_BAR; PG8_MMA(0, 0, At, B0); PG8_MMA(0, 1, At, B1); PG8_BAR; PG8_SCHED;
            PG8_LDA(At, 0, 1); PG8_STAGE(PG8_SB(0, 0), b2, voffB); PG8_STAGE(PG8_SB(0, 1), b2 + hstep, voffB); PG8_STAGE(PG8_SA(0, 0), a2, voffA);
            PG8_WAIT_V(8); PG8_WAIT_L(0); PG8_BAR; PG8_MMA(1, 0, At, B0); PG8_MMA(1, 1, At, B1); PG8_BAR; PG8_SCHED;
            PG8_LDB(B0, 1, 0); PG8_LDB(B1, 1, 1); PG8_SCHED; PG8_LDA(At, 1, 0); PG8_STAGE(PG8_SA(0, 1), a2 + hstep, voffA);
            PG8_WAIT_V(8); PG8_WAIT_L(0); PG8_BAR; PG8_MMA(0, 0, At, B0); PG8_MMA(0, 1, At, B1); PG8_BAR; PG8_SCHED;
            PG8_LDA(At, 1, 1); PG8_STAGE(PG8_SB(1, 0), b3, voffB); PG8_STAGE(PG8_SB(1, 1), b3 + hstep, voffB); PG8_STAGE(PG8_SA(1, 0), a3, voffA);
            PG8_WAIT_V(8); PG8_WAIT_L(0); PG8_BAR; PG8_MMA(1, 0, At, B0); PG8_MMA(1, 1, At, B1); PG8_BAR; PG8_SCHED;
            } else {
            PG8_LDB(B0, 0, 0); PG8_SCHED; PG8_LDA(At, 0, 0); PG8_STAGE(PG8_SA(1, 1), a1 + hstep, voffA);
            PG8_WAIT_L(8); PG8_BAR; PG8_WAIT_L(0); PG8_MMA(0, 0, At, B0); PG8_BAR; PG8_SCHED;
            PG8_LDB(B1, 0, 1); PG8_STAGE(PG8_SB(0, 0), b2, voffB);
            PG8_BAR; PG8_WAIT_L(0); PG8_MMA(0, 1, At, B1); PG8_BAR;
            PG8_LDA(At, 0, 1); PG8_STAGE(PG8_SA(0, 0), a2, voffA);
            PG8_BAR; PG8_WAIT_L(0); PG8_MMA(1, 0, At, B0); PG8_BAR; PG8_SCHED;
            PG8_STAGE(PG8_SB(0, 1), b2 + hstep, voffB);
            PG8_WAIT_V(6); PG8_BAR; PG8_MMA(1, 1, At, B1); PG8_BAR;
            PG8_LDB(B0, 1, 0); PG8_SCHED; PG8_LDA(At, 1, 0); PG8_STAGE(PG8_SA(0, 1), a2 + hstep, voffA);
            PG8_WAIT_L(8); PG8_BAR; PG8_WAIT_L(0); PG8_MMA(0, 0, At, B0); PG8_BAR; PG8_SCHED;
            PG8_LDB(B1, 1, 1); PG8_STAGE(PG8_SB(1, 0), b3, voffB);
            PG8_BAR; PG8_WAIT_L(0); PG8_MMA(0, 1, At, B1); PG8_BAR;
            PG8_LDA(At, 1, 1); PG8_STAGE(PG8_SA(1, 0), a3, voffA);
            PG8_BAR; PG8_WAIT_L(0); PG8_MMA(1, 0, At, B0); PG8_BAR; PG8_SCHED;
            PG8_STAGE(PG8_SB(1, 1), b3 + hstep, voffB);
            PG8_WAIT_V(6); PG8_BAR; PG8_MMA(1, 1, At, B1); PG8_BAR;
            }
        }
        if constexpr (ALIGN_EPI) { if (wr == 0) PG8_BAR; }
        if constexpr (!Epi::AFTER_DRAIN) { E(acc, cur, wr, wc, fr, fq); S.done(cur); }
        if (!has_next) break;
#pragma unroll
        for (int a = 0; a < 2; ++a)
#pragma unroll
            for (int b = 0; b < 2; ++b)
#pragma unroll
                for (int m = 0; m < 4; ++m)
#pragma unroll
                    for (int n = 0; n < 2; ++n) acc[a][b][m][n] = (f32x4){0.f, 0.f, 0.f, 0.f};
        cur = nxt; cA = nA; cB = nB; ++ui;
        if constexpr (ALIGN_EPI) { if (wr == 1) PG8_BAR; }
    }
    PG8_WAIT_V(0);
    if constexpr (!ALIGN_EPI) { if (wr == 0) PG8_BAR; }
    PG8_BAR;
    if constexpr (Epi::AFTER_DRAIN) { E.fused(acc, cur, wr, wc, fr, fq, lds, wid, lane); S.done(cur); }
#undef PG8_SA
#undef PG8_SB
#undef PG8_STAGE
#undef PG8_LDA
#undef PG8_LDB
#undef PG8_MMA
#undef PG8_WAIT_V
#undef PG8_WAIT_L
#undef PG8_BAR
#undef PG8_SCHED
}
}

constexpr int DM = 2048, NB = 8, SEQ = 2048, CTXL = 256, NH = 16, NKV = 4, HD = 128;
constexpr int ML = NB * SEQ;
constexpr int MC = NB * CTXL;
constexpr int MT = ML + MC;
constexpr int NE = 16, CAPL = 256, CAPC = 32, DFF = 1024;
constexpr int YR = NB * CAPL + NB * CAPC;
constexpr int YT = NE * YR;
constexpr int NMOD = 6 * DM;
constexpr float NORM_EPS = 1e-6f;
constexpr int KSPLIT = 16;

using pg8::Unit; using pg8::f32x4; using pg8::u32x4; using pg8::bf16_t; using pg8::bf16x8; using pg8::cvt_pk_bf16;
typedef float f32x2 __attribute__((ext_vector_type(2)));
typedef unsigned u32x2 __attribute__((ext_vector_type(2)));
typedef float f32x16 __attribute__((ext_vector_type(16)));
typedef short s16x4 __attribute__((ext_vector_type(4)));
#define DI __device__ __forceinline__

DI float bf_lo(unsigned w) { return __uint_as_float(w << 16); }
DI float bf_hi(unsigned w) { return __uint_as_float(w & 0xffff0000u); }
DI float silu_f(float a) { return a * __builtin_amdgcn_rcpf(1.0f + __expf(-a)); }

DI int xcd_remap(int wgid, int nwg) { const int q = nwg / 8, r = nwg % 8, xcd = wgid % 8, off = wgid / 8; return (xcd < r ? xcd * (q + 1) : r * (q + 1) + (xcd - r) * q) + off; }
struct QkvOrder {
    int G, c;
    DI bool next(int i, Unit& u) const {
        const int L = i * G + c; if (L >= 800) return false;
        if (L < 768) { const int w = xcd_remap(L, 768); const int nig = 8 * 12, gid = w / nig; u.pm = gid * 8 + ((w % nig) % 8); u.pn = (w % nig) / 8; }
        else { const int j = L - 768; u.pm = 64 + (j >> 2); u.pn = 8 + (j & 3); }
        return true;
    }
    DI void a_ready(const Unit&) const {}
    DI void done(const Unit&) const {}
};
struct MoeOrder {
    int G, c, NP;
    DI bool next(int i, Unit& u) const {
        const int nwg = NE * NP * 8; const int L = i * G + c; if (L >= nwg) return false;
        const int w = xcd_remap(L, nwg); const int per = NP * 8, e = w / per, rem = w % per;
        u.pm = e * 9 + (rem % NP); u.pn = e * 8 + (rem / NP); return true;
    }
    DI void a_ready(const Unit&) const {}
    DI void done(const Unit&) const {}
};

template <int ACT  > struct EpiPair {
    static constexpr bool PERM = true, AFTER_DRAIN = false;
    bf16_t* O; int ldc; int pn_mod;
    DI void operator()(const f32x4 (&acc)[2][2][4][2], const Unit& u, int wr, int wc, int fr, int fq) const {
        const int row0 = u.pm * 256 + wr * 64 + fr, col0 = (u.pn % pn_mod) * 128 + wc * 32 + 8 * fq;
#pragma unroll
        for (int ai = 0; ai < 2; ++ai)
#pragma unroll
            for (int m = 0; m < 4; ++m) {
                bf16_t* rowp = O + (size_t)(row0 + ai * 128 + m * 16) * ldc + col0;
                f32x4 a0 = acc[ai][0][m][0], a1 = acc[ai][0][m][1]; const f32x4 b0 = acc[ai][1][m][0], b1 = acc[ai][1][m][1];
                if (ACT == 1) {
#pragma unroll
                    for (int j = 0; j < 4; ++j) { a0[j] = silu_f(a0[j]); a1[j] = silu_f(a1[j]); } }
                const f32x4 v0 = a0 * b0, v1 = a1 * b1;
                u32x4 w; w.x = cvt_pk_bf16(v0[0], v0[1]); w.y = cvt_pk_bf16(v0[2], v0[3]); w.z = cvt_pk_bf16(v1[0], v1[1]); w.w = cvt_pk_bf16(v1[2], v1[3]);
                *(u32x4*)rowp = w;
            }
    }
};
struct EpiConvGate {
    static constexpr bool PERM = true, AFTER_DRAIN = false;
    const bf16_t* U; bf16_t* Z; const float* cw;
    DI void operator()(const f32x4 (&acc)[2][2][4][2], const Unit& u, int wr, int wc, int fr, int fq) const {
        const int row0 = u.pm * 256 + wr * 64 + fr, col0 = u.pn * 256 + wc * 32 + 8 * fq;
#pragma unroll
        for (int bj = 0; bj < 2; ++bj) {
            const int c = col0 + bj * 128;
            f32x4 w0a = *(const f32x4*)(cw + c), w0b = *(const f32x4*)(cw + c + 4), w1a = *(const f32x4*)(cw + 2048 + c), w1b = *(const f32x4*)(cw + 2048 + c + 4), w2a = *(const f32x4*)(cw + 4096 + c), w2b = *(const f32x4*)(cw + 4096 + c + 4);
#pragma unroll
            for (int ai = 0; ai < 2; ++ai)
#pragma unroll
                for (int m = 0; m < 4; ++m) {
                    const int row = row0 + ai * 128 + m * 16;
                    const int tpos = row < ML ? (row & (SEQ - 1)) : ((row - ML) & (CTXL - 1)); const int len = row < ML ? SEQ : CTXL;
                    const u32x4 z4 = (u32x4){0u, 0u, 0u, 0u};
                    const u32x4 uc = *(const u32x4*)(U + (size_t)row * DM + c);
                    const u32x4 up = tpos > 0 ? *(const u32x4*)(U + (size_t)(row - 1) * DM + c) : z4;
                    const u32x4 un = tpos < len - 1 ? *(const u32x4*)(U + (size_t)(row + 1) * DM + c) : z4;
                    f32x4 ya, yb;
                    ya[0] = w0a[0] * bf_lo(up.x) + w1a[0] * bf_lo(uc.x) + w2a[0] * bf_lo(un.x); ya[1] = w0a[1] * bf_hi(up.x) + w1a[1] * bf_hi(uc.x) + w2a[1] * bf_hi(un.x);
                    ya[2] = w0a[2] * bf_lo(up.y) + w1a[2] * bf_lo(uc.y) + w2a[2] * bf_lo(un.y); ya[3] = w0a[3] * bf_hi(up.y) + w1a[3] * bf_hi(uc.y) + w2a[3] * bf_hi(un.y);
                    yb[0] = w0b[0] * bf_lo(up.z) + w1b[0] * bf_lo(uc.z) + w2b[0] * bf_lo(un.z); yb[1] = w0b[1] * bf_hi(up.z) + w1b[1] * bf_hi(uc.z) + w2b[1] * bf_hi(un.z);
                    yb[2] = w0b[2] * bf_lo(up.w) + w1b[2] * bf_lo(uc.w) + w2b[2] * bf_lo(un.w); yb[3] = w0b[3] * bf_hi(up.w) + w1b[3] * bf_hi(uc.w) + w2b[3] * bf_hi(un.w);
                    const f32x4 v0 = acc[ai][bj][m][0] * ya, v1 = acc[ai][bj][m][1] * yb;
                    u32x4 w; w.x = cvt_pk_bf16(v0[0], v0[1]); w.y = cvt_pk_bf16(v0[2], v0[3]); w.z = cvt_pk_bf16(v1[0], v1[1]); w.w = cvt_pk_bf16(v1[2], v1[3]);
                    *(u32x4*)(Z + (size_t)row * DM + c) = w;
                }
        }
    }
};
struct EpiResid {
    static constexpr bool PERM = false, AFTER_DRAIN = false;
    const float* base_lat; const float* base_ctx; float* out; const float* gate;
    DI void operator()(const f32x4 (&acc)[2][2][4][2], const Unit& u, int wr, int wc, int fr, int fq) const {
        const int rowt = u.pm * 256; const int cr = rowt < ML ? (rowt >> 11) : 8;
        const float* base = rowt < ML ? base_lat : base_ctx - (size_t)ML * DM;
        const int row0 = rowt + wr * 64 + fr, col0 = u.pn * 256 + wc * 32 + 4 * fq;
        f32x4 gv[2][2];
#pragma unroll
        for (int bj = 0; bj < 2; ++bj)
#pragma unroll
            for (int n = 0; n < 2; ++n) gv[bj][n] = *(const f32x4*)(gate + (size_t)cr * NMOD + col0 + bj * 128 + n * 16);
#pragma unroll
        for (int ai = 0; ai < 2; ++ai)
#pragma unroll
            for (int m = 0; m < 4; ++m) { const size_t off = (size_t)(row0 + ai * 128 + m * 16) * DM + col0;
#pragma unroll
                for (int bj = 0; bj < 2; ++bj)
#pragma unroll
                    for (int n = 0; n < 2; ++n) { const f32x4 bs = *(const f32x4*)(base + off + bj * 128 + n * 16); *(f32x4*)(out + off + bj * 128 + n * 16) = bs + gv[bj][n] * acc[ai][bj][m][n]; }
                asm volatile("" ::: "memory"); }
    }
};
struct EpiDown {
    static constexpr bool PERM = true, AFTER_DRAIN = false;
    bf16_t* Y; const float* gatev;
    DI void operator()(const f32x4 (&acc)[2][2][4][2], const Unit& u, int wr, int wc, int fr, int fq) const {
        const int row0 = u.pm * 256 + wr * 64 + fr, col0 = (u.pn & 7) * 256 + wc * 32 + 8 * fq;
#pragma unroll
        for (int ai = 0; ai < 2; ++ai)
#pragma unroll
            for (int m = 0; m < 4; ++m) { const int row = row0 + ai * 128 + m * 16; const float gt = gatev[row];
#pragma unroll
                for (int bj = 0; bj < 2; ++bj) { const f32x4 v0 = acc[ai][bj][m][0] * gt, v1 = acc[ai][bj][m][1] * gt;
                    u32x4 w; w.x = cvt_pk_bf16(v0[0], v0[1]); w.y = cvt_pk_bf16(v0[2], v0[3]); w.z = cvt_pk_bf16(v1[0], v1[1]); w.w = cvt_pk_bf16(v1[2], v1[3]);
                    *(u32x4*)(Y + (size_t)row * DM + col0 + bj * 128) = w; } }
    }
};
struct EpiQkv {
    static constexpr bool PERM = true, AFTER_DRAIN = false;
    bf16_t* Q; bf16_t* K; bf16_t* V;
    DI void operator()(const f32x4 (&acc)[2][2][4][2], const Unit& u, int wr, int wc, int fr, int fq) const {
        const int row0 = u.pm * 256 + wr * 64 + fr; int colt = u.pn * 256; bf16_t* base; int ld;
        if (colt < 2048) { base = Q; ld = 2048; } else if (colt < 2560) { base = K; ld = 512; colt -= 2048; } else { base = V; ld = 512; colt -= 2560; }
        const int col0 = colt + wc * 32 + 8 * fq;
#pragma unroll
        for (int ai = 0; ai < 2; ++ai)
#pragma unroll
            for (int m = 0; m < 4; ++m) { bf16_t* rowp = base + (size_t)(row0 + ai * 128 + m * 16) * ld + col0;
#pragma unroll
                for (int bj = 0; bj < 2; ++bj) { const f32x4 v0 = acc[ai][bj][m][0], v1 = acc[ai][bj][m][1];
                    u32x4 w; w.x = cvt_pk_bf16(v0[0], v0[1]); w.y = cvt_pk_bf16(v0[2], v0[3]); w.z = cvt_pk_bf16(v1[0], v1[1]); w.w = cvt_pk_bf16(v1[2], v1[3]);
                    *(u32x4*)(rowp + bj * 128) = w; } }
    }
};

constexpr size_t MiB = 1u << 20;
constexpr size_t WS_CTL = 0, CTL_ZERO_BYTES = 1 * MiB;
constexpr size_t WS_MOD = 1 * MiB;
constexpr size_t WS_MODP = 2 * MiB;
constexpr size_t WS_AFFL = 16 * MiB;
constexpr size_t WS_AFFC = 17 * MiB;
constexpr size_t WS_ROWSRC = 17 * MiB + 512 * 1024;
constexpr size_t WS_GATEV = 18 * MiB;
constexpr size_t WS_INV = 18 * MiB + 512 * 1024;
constexpr size_t WS_W1A = 20 * MiB;
constexpr size_t WS_W1B = 36 * MiB;
constexpr size_t WS_W2 = 44 * MiB;
constexpr size_t WS_WQKV = 52 * MiB;
constexpr size_t WS_WO = 64 * MiB;
constexpr size_t WS_WGU = 72 * MiB;
constexpr size_t WS_WDN = 328 * MiB;
constexpr size_t WS_H = 456 * MiB;
constexpr size_t WS_A = 600 * MiB;
constexpr size_t WS_U = 672 * MiB;
constexpr size_t WS_Z = 744 * MiB;
constexpr size_t WS_Q = WS_U, WS_K = WS_Z, WS_V = WS_Z + 18 * MiB;
constexpr size_t WS_HM = 816 * MiB;
constexpr size_t WS_O = WS_HM;
constexpr size_t WS_Y = 888 * MiB;
constexpr size_t WS_XS = WS_Y;
constexpr size_t WS_END = 1032 * MiB;
constexpr int CW_BAR = 4096;

constexpr int RING_BYTES = 131072;
constexpr int MISC_OFF = RING_BYTES + 14336;
constexpr int LDS_BYTES = 147456;

#define GAS __attribute__((address_space(1)))
#define LAS __attribute__((address_space(3)))
#define LDS_WAIT() asm volatile("s_waitcnt lgkmcnt(0)" ::: "memory")
#define VM_WAIT() asm volatile("s_waitcnt vmcnt(0)" ::: "memory")
#define XB_TMO      128
#define XB_XCNT(j)  (256  + 64 * (j))
#define XB_XSUB(j)  (1280 + 64 * (j))
#define XB_XGEN(j)  (2304 + 64 * (j))
#define XB_TOP      3328
#define XB_TOPGEN   3392
#define XCD_BAR_WORDS 3456
#define XB_SPIN_CAP (1u << 18)

__device__ __forceinline__ unsigned xb_ld(unsigned* p)              { return __hip_atomic_load(p, __ATOMIC_RELAXED, __HIP_MEMORY_SCOPE_AGENT); }
__device__ __forceinline__ unsigned xb_add(unsigned* p, unsigned v) { return __hip_atomic_fetch_add(p, v, __ATOMIC_RELAXED, __HIP_MEMORY_SCOPE_AGENT); }
__device__ __forceinline__ unsigned xb_xcc_id() { return (unsigned)__builtin_amdgcn_s_getreg((3 << 11) | 20) & 0xFu; }
#define XB_SPIN(cond, bar) do { unsigned _sp = 0; while (cond) { __builtin_amdgcn_s_sleep(1); \
    if ((++_sp & 255u) == 0u) { if (xb_ld(&(bar)[XB_TMO])) break; if (_sp > XB_SPIN_CAP) { atomicAdd(&(bar)[XB_TMO], 1u); break; } } } } while (0)

struct XcdBarrier {
    unsigned* bar; unsigned x;
    volatile LAS unsigned* st;
};

__device__ __forceinline__ XcdBarrier xcd_barrier_post(unsigned* bar, volatile LAS unsigned* st) {
    XcdBarrier b; b.bar = bar; b.x = xb_xcc_id(); b.st = st;
    if (threadIdx.x == 0) (void)xb_add(&bar[XB_XCNT(b.x)], 1u);
    return b;
}
__device__ __forceinline__ void xcd_barrier_complete(unsigned* bar, unsigned x, unsigned& nloc, unsigned& nx) {
    const unsigned G = gridDim.x * gridDim.y * gridDim.z;
    unsigned sum, cnt, mine, sp = 0u;
    for (;;) {
        sum = 0u; cnt = 0u; mine = 0u;
#pragma unroll
        for (unsigned j = 0; j < 16; ++j) { const unsigned c = xb_ld(&bar[XB_XCNT(j)]); sum += c; cnt += (c > 0u) ? 1u : 0u; mine = (j == x) ? c : mine; }
        if (sum == G) break;
        __builtin_amdgcn_s_sleep(1);
        if ((++sp & 255u) == 0u) { if (xb_ld(&bar[XB_TMO])) break; if (sp > XB_SPIN_CAP) { atomicAdd(&bar[XB_TMO], 1u); break; } }
    }
    nloc = mine > 0u ? mine : 1u; nx = cnt > 0u ? cnt : 1u;
}

__device__ __forceinline__ void xcd_barrier(const XcdBarrier& b) {
    asm volatile("s_waitcnt vmcnt(0)" ::: "memory");
    __syncthreads();
    if (threadIdx.x == 0) {
        unsigned* bar = b.bar;
        __builtin_amdgcn_s_waitcnt(0);
        unsigned nloc = b.st[0], nx = b.st[1];
        if (nloc == 0u) { xcd_barrier_complete(bar, b.x, nloc, nx); b.st[0] = nloc; b.st[1] = nx; }
        const unsigned old = xb_add(&bar[XB_XSUB(b.x)], 1u);
        const unsigned gen = old / nloc;
        if (old + 1u == (gen + 1u) * nloc) {
            __builtin_amdgcn_fence(__ATOMIC_RELEASE, "agent");
            asm volatile("s_waitcnt vmcnt(0)" ::: "memory");
            const unsigned og = xb_add(&bar[XB_TOP], 1u);
            const unsigned tg = og / nx;
            if (og + 1u == (tg + 1u) * nx) xb_add(&bar[XB_TOPGEN], 1u);
            else XB_SPIN(xb_ld(&bar[XB_TOPGEN]) == tg, bar);
            __builtin_amdgcn_fence(__ATOMIC_ACQUIRE, "agent");
            xb_add(&bar[XB_XGEN(b.x)], 1u);
            asm volatile("s_waitcnt vmcnt(0)" ::: "memory");
        } else {
            XB_SPIN(xb_ld(&bar[XB_XGEN(b.x)]) == gen, bar);
            __builtin_amdgcn_fence(__ATOMIC_ACQUIRE, "agent");
            asm volatile("s_waitcnt vmcnt(0)" ::: "memory");
        }
    }
    __syncthreads();
}

DI float wave_sum(float v) {
#pragma unroll
    for (int o = 1; o < 64; o <<= 1) v += __shfl_xor(v, o);
    return v;
}
DI float rdlane(float v, int l) { return __uint_as_float((unsigned)__builtin_amdgcn_readlane((int)__float_as_uint(v), l)); }
DI unsigned pk2(float lo, float hi) { return cvt_pk_bf16(lo, hi); }

DI void ph_adaln(const float* cnd, const float* cctx, const float* ada_w, float* modp, int gw, int NGW, int lane) {
    for (int task = gw; task < 96 * KSPLIT; task += NGW) {
        const int ks = task & (KSPLIT - 1), cg = task / KSPLIT, l = cg / 48, cgl = cg % 48, col0 = cgl * 256 + lane * 4, k0 = ks * 128;
        float sv[9][2];
#pragma unroll
        for (int r = 0; r < 9; ++r)
#pragma unroll
            for (int hh = 0; hh < 2; ++hh) { const int k = k0 + hh * 64 + lane; const float v = r < 8 ? cnd[r * DM + k] : cctx[k]; sv[r][hh] = v / (1.0f + __expf(-v)); }
        f32x4 acc[9];
#pragma unroll
        for (int r = 0; r < 9; ++r) acc[r] = (f32x4){0.f, 0.f, 0.f, 0.f};
        const float* wp = ada_w + ((size_t)l * DM + k0) * NMOD + col0;
#pragma unroll
        for (int hh = 0; hh < 2; ++hh) {
#pragma unroll 8
            for (int kk = 0; kk < 64; ++kk) {
                const f32x4 w = *(const f32x4*)(wp + (size_t)(hh * 64 + kk) * NMOD);
#pragma unroll
                for (int r = 0; r < 9; ++r) { const float s = rdlane(sv[r][hh], kk); acc[r] += w * s; }
            }
        }
#pragma unroll
        for (int r = 0; r < 9; ++r) *(f32x4*)(modp + ((size_t)((ks * 2 + l) * 9 + r)) * NMOD + col0) = acc[r];
    }
}
DI void cvt_item(const float* W, int ldw, bf16_t* dst, int ldd, LAS float* scr, int lane) {
#pragma unroll 4
    for (int i = 0; i < 16; ++i) { const int row = 4 * i + (lane >> 4); const f32x4 v = *(const f32x4*)(W + (size_t)row * ldw + (lane & 15) * 4);
        LAS float* s = scr + row * 65 + (lane & 15) * 4; s[0] = v[0]; s[1] = v[1]; s[2] = v[2]; s[3] = v[3]; }
    LDS_WAIT(); asm volatile("" ::: "memory");
    const int c = lane & 7;
#pragma unroll
    for (int j = 0; j < 8; ++j) { const int n = (lane >> 3) + 8 * j; const LAS float* s = scr + (8 * c) * 65 + n;
        u32x4 o; o.x = pk2(s[0 * 65], s[1 * 65]); o.y = pk2(s[2 * 65], s[3 * 65]); o.z = pk2(s[4 * 65], s[5 * 65]); o.w = pk2(s[6 * 65], s[7 * 65]);
        *(u32x4*)(dst + (size_t)n * ldd + 8 * c) = o; }
    LDS_WAIT(); asm volatile("" ::: "memory");
}
struct CvtPtrs { const float *cin, *cout, *wqkv, *wo, *wg, *wu, *wd; bf16_t *W1A, *W1B, *W2, *WQKV, *WO, *WGU, *WDN; };
DI void ph_convert(const CvtPtrs& P, LAS float* scr, int gw, int NGW, int lane) {
    constexpr int I_CIN = 32 * 96, I_SQ = 32 * 32, I_QKV = 32 * 48, I_EXP = 32 * 512;
    constexpr int NITEMS = I_CIN + I_SQ + I_QKV + I_SQ + 3 * I_EXP;
    for (int it = gw; it < NITEMS; it += NGW) {
        int r = it;
        if (r < I_CIN) { const int kt = r / 96, nt = r % 96, n0 = nt * 64, part = n0 >> 11, j0 = n0 & 2047;
            bf16_t* d = part == 0 ? P.W1B + (size_t)j0 * DM : P.W1A + (size_t)((j0 >> 7) * 256 + (part == 2 ? 128 : 0) + (j0 & 127)) * DM;
            cvt_item(P.cin + (size_t)(kt * 64) * 6144 + n0, 6144, d + kt * 64, DM, scr, lane); continue; } r -= I_CIN;
        if (r < I_SQ) { const int kt = r / 32, nt = r % 32; cvt_item(P.cout + (size_t)(kt * 64) * DM + nt * 64, DM, P.W2 + (size_t)(nt * 64) * DM + kt * 64, DM, scr, lane); continue; } r -= I_SQ;
        if (r < I_QKV) { const int kt = r / 48, nt = r % 48; cvt_item(P.wqkv + (size_t)(kt * 64) * 3072 + nt * 64, 3072, P.WQKV + (size_t)(nt * 64) * DM + kt * 64, DM, scr, lane); continue; } r -= I_QKV;
        if (r < I_SQ) { const int kt = r / 32, nt = r % 32; cvt_item(P.wo + (size_t)(kt * 64) * DM + nt * 64, DM, P.WO + (size_t)(nt * 64) * DM + kt * 64, DM, scr, lane); continue; } r -= I_SQ;
        if (r < 2 * I_EXP) { const int up = r >= I_EXP ? 1 : 0; r -= up * I_EXP; const int le = r / 512, rem = r % 512, kt = rem / 16, nt = rem % 16, n0 = nt * 64;
            const float* src = (up ? P.wu : P.wg) + (size_t)le * DM * DFF + (size_t)(kt * 64) * DFF + n0;
            bf16_t* d = P.WGU + (size_t)(le * 2048 + (n0 >> 7) * 256 + up * 128 + (n0 & 127)) * DM + kt * 64;
            cvt_item(src, DFF, d, DM, scr, lane); continue; } r -= 2 * I_EXP;
        { const int le = r / 512, rem = r % 512, kt = rem / 32, nt = rem % 32;
            cvt_item(P.wd + (size_t)le * DFF * DM + (size_t)(kt * 64) * DM + nt * 64, DM, P.WDN + (size_t)(le * 2048 + nt * 64) * DFF + kt * 64, DFF, scr, lane); }
    }
}
DI void ph_modred(const float* modp, const float* ada_b, float* mod, int gtid, int GT) {
    for (int i = gtid; i < 2 * 9 * NMOD; i += GT) { const int l = i / (9 * NMOD), j = i % NMOD; float s = ada_b[l * NMOD + j];
#pragma unroll
        for (int ks = 0; ks < KSPLIT; ++ks) s += modp[(size_t)ks * (2 * 9 * NMOD) + i];
        mod[i] = s; }
}
DI void row_load(const float* p, f32x4 (&v)[8], int lane) {
#pragma unroll
    for (int j = 0; j < 8; ++j) v[j] = *(const f32x4*)(p + 4 * lane + 256 * j);
}
DI void row_modulate(const f32x4 (&v)[8], f32x4 (&y)[8], const float* gain, const float* shift, const float* scale, int lane) {
    float ss = 0.f;
#pragma unroll
    for (int j = 0; j < 8; ++j) ss += (v[j][0] * v[j][0] + v[j][1] * v[j][1]) + (v[j][2] * v[j][2] + v[j][3] * v[j][3]);
    ss = wave_sum(ss);
    const float rstd = 1.0f / sqrtf(ss * (1.0f / DM) + NORM_EPS);
#pragma unroll
    for (int j = 0; j < 8; ++j) { const int c = 4 * lane + 256 * j; const f32x4 g = *(const f32x4*)(gain + c), sh = *(const f32x4*)(shift + c), sc = *(const f32x4*)(scale + c);
        y[j] = ((v[j] * rstd) * g) * (sc + 1.0f) + sh; }
}
DI void row_store_bf16(bf16_t* p, const f32x4 (&y)[8], int lane) {
#pragma unroll
    for (int j = 0; j < 8; ++j) { u32x2 w; w.x = pk2(y[j][0], y[j][1]); w.y = pk2(y[j][2], y[j][3]); *(u32x2*)(p + 4 * lane + 256 * j) = w; }
}
DI void ph_mod0(const float* x, const float* ctx, const float* gain, const float* mod0, bf16_t* A, int gw, int NGW, int lane) {
    for (int row = gw; row < MT; row += NGW) {
        const int cr = row < ML ? (row >> 11) : 8; const float* src = row < ML ? x + (size_t)row * DM : ctx + (size_t)(row - ML) * DM;
        f32x4 v[8], y[8]; row_load(src, v, lane);
        row_modulate(v, y, gain, mod0 + (size_t)cr * NMOD + 0 * DM, mod0 + (size_t)cr * NMOD + 1 * DM, lane);
        row_store_bf16(A + (size_t)row * DM, y, lane);
    }
}
DI void router_row(const f32x4 (&y)[8], const LAS float* rwT, float* affL, float* affC, int row, int lane) {
    float lg[16];
#pragma unroll
    for (int e = 0; e < 16; ++e) { float s = 0.f;
#pragma unroll
        for (int j = 0; j < 8; ++j) { const f32x4 w = *(const LAS f32x4*)(rwT + e * DM + 4 * lane + 256 * j); s += (y[j][0] * w[0] + y[j][1] * w[1]) + (y[j][2] * w[2] + y[j][3] * w[3]); }
        lg[e] = wave_sum(s); }
    float mx = lg[0];
#pragma unroll
    for (int e = 1; e < 16; ++e) mx = fmaxf(mx, lg[e]);
    float den = 0.f;
#pragma unroll
    for (int e = 0; e < 16; ++e) { lg[e] = __expf(lg[e] - mx); den += lg[e]; }
    float mine = 0.f;
#pragma unroll
    for (int e = 0; e < 16; ++e) mine = (lane == e) ? lg[e] : mine;
    mine = mine / den;
    if (lane < 16) { if (row < ML) { const int b = row >> 11, n = row & 2047; affL[(size_t)(b * 16 + lane) * SEQ + n] = mine; }
                     else { const int rc = row - ML, b = rc >> 8, n = rc & 255; affC[(size_t)(b * 16 + lane) * CTXL + n] = mine; } }
}
DI void load_router(const float* rw, LAS float* rwT, int tid) {
    for (int i = tid; i < DM * 16; i += 512) rwT[(i & 15) * DM + (i >> 4)] = rw[i];
    __syncthreads();
}
DI void ph_modffn(const float* H, const float* gain, const float* modl, bf16_t* A, const LAS float* rwT, float* affL, float* affC, int nrows, int gw, int NGW, int lane) {
    for (int row = gw; row < nrows; row += NGW) {
        const int cr = row < ML ? (row >> 11) : 8;
        f32x4 v[8], y[8]; row_load(H + (size_t)row * DM, v, lane);
        row_modulate(v, y, gain, modl + (size_t)cr * NMOD + 3 * DM, modl + (size_t)cr * NMOD + 4 * DM, lane);
        row_store_bf16(A + (size_t)row * DM, y, lane);
        router_row(y, rwT, affL, affC, row, lane);
    }
}
DI void ph_topk(int nitems, const float* affL, const float* affC, int* rowsrc, float* gatev, int* inv, LAS unsigned* hist, int tid, int lane, int wave, int bid, int G) {
    LAS unsigned* sh = hist + 256;
    for (int it = bid; it < nitems; it += G) {
        const bool isc = it >= 128; const int be = it & 127, b = be >> 4, e = be & 15;
        const int N = isc ? CTXL : SEQ, C = isc ? CAPC : CAPL;
        const float* src = isc ? affC + (size_t)be * CTXL : affL + (size_t)be * SEQ;
        const int i0 = tid * 4; const bool valid = i0 < N;
        unsigned key[4];
        { f32x4 v = (f32x4){0.f, 0.f, 0.f, 0.f}; if (valid) v = *(const f32x4*)(src + i0);
#pragma unroll
          for (int q = 0; q < 4; ++q) key[q] = __float_as_uint(v[q]); }
        unsigned prefix = 0u, mask = 0u, krem = (unsigned)C;
        for (int pass = 3; pass >= 0; --pass) {
            const int shift = pass * 8;
            if (tid < 256) hist[tid] = 0u;
            __syncthreads();
            if (valid) {
#pragma unroll
                for (int q = 0; q < 4; ++q) if ((key[q] & mask) == prefix) __hip_atomic_fetch_add(&hist[(key[q] >> shift) & 255u], 1u, __ATOMIC_RELAXED, __HIP_MEMORY_SCOPE_WORKGROUP); }
            __syncthreads();
            if (wave == 0) {
                const unsigned h0 = hist[4 * lane], h1 = hist[4 * lane + 1], h2 = hist[4 * lane + 2], h3 = hist[4 * lane + 3];
                const unsigned tot = h0 + h1 + h2 + h3; unsigned incl = tot;
#pragma unroll
                for (int o = 1; o < 64; o <<= 1) { const unsigned t = __shfl_down(incl, o); if (lane + o < 64) incl += t; }
                const unsigned a3 = incl - tot, a2 = a3 + h3, a1 = a2 + h2, a0 = a1 + h1;
                if (a3 < krem && krem <= a3 + h3) { sh[0] = 4 * lane + 3; sh[1] = krem - a3; }
                if (a2 < krem && krem <= a2 + h2) { sh[0] = 4 * lane + 2; sh[1] = krem - a2; }
                if (a1 < krem && krem <= a1 + h1) { sh[0] = 4 * lane + 1; sh[1] = krem - a1; }
                if (a0 < krem && krem <= a0 + h0) { sh[0] = 4 * lane + 0; sh[1] = krem - a0; }
            }
            __syncthreads();
            const unsigned B = sh[0]; krem = sh[1]; prefix |= B << shift; mask |= 0xFFu << shift;
        }
        const unsigned T = prefix;
        unsigned cg = 0u, ce = 0u;
        if (valid) {
#pragma unroll
            for (int q = 0; q < 4; ++q) { cg += key[q] > T ? 1u : 0u; ce += key[q] == T ? 1u : 0u; } }
        const unsigned mine = cg | (ce << 16); unsigned incl = mine;
#pragma unroll
        for (int o = 1; o < 64; o <<= 1) { const unsigned t = __shfl_up(incl, o); if (lane >= o) incl += t; }
        if (lane == 63) sh[8 + wave] = incl;
        __syncthreads();
        unsigned woff = 0u;
#pragma unroll
        for (int w = 0; w < 8; ++w) woff += (w < wave) ? sh[8 + w] : 0u;
        const unsigned excl = woff + incl - mine; unsigned gtb = excl & 0xFFFFu, eqb = excl >> 16;
        if (valid) {
            const int ybase = e * YR + (isc ? NB * CAPL + b * CAPC : b * CAPL); const int rbase = isc ? ML + b * CTXL : b * SEQ;
#pragma unroll
            for (int q = 0; q < 4; ++q) {
                const bool isg = key[q] > T, ise = key[q] == T; const bool sel = isg || (ise && eqb < krem);
                const unsigned slot = gtb + (eqb < krem ? eqb : krem);
                const int trow = rbase + i0 + q; const int yrow = ybase + (int)slot;
                if (sel) { rowsrc[yrow] = trow; gatev[yrow] = __uint_as_float(key[q]); }
                inv[(size_t)trow * 16 + e] = sel ? yrow : -1;
                gtb += isg ? 1u : 0u; eqb += ise ? 1u : 0u;
            }
        }
        __syncthreads();
    }
}
DI void ph_gather(const bf16_t* A, const int* rowsrc, bf16_t* XS, bool with_ctx, int gw, int NGW, int lane) {
    for (int yr = gw; yr < YT; yr += NGW) {
        if (!with_ctx && (yr % YR) >= NB * CAPL) continue;
        const int src = rowsrc[yr];
        const u32x4* s = (const u32x4*)(A + (size_t)src * DM); u32x4* d = (u32x4*)(XS + (size_t)yr * DM);
#pragma unroll
        for (int j = 0; j < 4; ++j) d[lane + 64 * j] = s[lane + 64 * j];
    }
}
template <bool LAST> DI void ph_combine(float* H, const bf16_t* Y, const int* inv, const float* modl  , const float* gain1, const float* mod1, bf16_t* A, float* out, int nrows, int gw, int NGW, int lane) {
    for (int row = gw; row < nrows; row += NGW) {
        const int cr = row < ML ? (row >> 11) : 8;
        f32x4 v[8], acc[8]; row_load(H + (size_t)row * DM, v, lane);
#pragma unroll
        for (int j = 0; j < 8; ++j) acc[j] = (f32x4){0.f, 0.f, 0.f, 0.f};
        const int myinv = inv[(size_t)row * 16 + (lane & 15)];
        for (int e = 0; e < 16; ++e) {
            const int yr = __builtin_amdgcn_readlane(myinv, e);
            if (yr >= 0) { const bf16_t* yp = Y + (size_t)yr * DM + 4 * lane;
#pragma unroll
                for (int j = 0; j < 8; ++j) { const u32x2 p = *(const u32x2*)(yp + 256 * j); acc[j][0] += bf_lo(p.x); acc[j][1] += bf_hi(p.x); acc[j][2] += bf_lo(p.y); acc[j][3] += bf_hi(p.y); } }
        }
        const float* g2 = modl + (size_t)cr * NMOD + 5 * DM;
#pragma unroll
        for (int j = 0; j < 8; ++j) { const f32x4 g = *(const f32x4*)(g2 + 4 * lane + 256 * j); v[j] = v[j] + g * acc[j]; }
        if (LAST) {
#pragma unroll
            for (int j = 0; j < 8; ++j) *(f32x4*)(out + (size_t)row * DM + 4 * lane + 256 * j) = v[j];
        } else {
#pragma unroll
            for (int j = 0; j < 8; ++j) *(f32x4*)(H + (size_t)row * DM + 4 * lane + 256 * j) = v[j];
            f32x4 y[8]; row_modulate(v, y, gain1, mod1 + (size_t)cr * NMOD + 0 * DM, mod1 + (size_t)cr * NMOD + 1 * DM, lane);
            row_store_bf16(A + (size_t)row * DM, y, lane);
        }
    }
}
DI void ph_qknorm(bf16_t* Q, bf16_t* K, const float* qg, const float* kg, int gw, int NGW, int lane) {
    const int half = lane >> 5, i = lane & 31, d1 = half * 64 + i, d2 = d1 + 32;
    const float inv_freq = exp2f(-(float)i * (13.287712379549449f / 32.0f));
    const float qg1 = qg[d1], qg2 = qg[d2], kg1 = kg[d1], kg2 = kg[d2];
    for (int row = gw; row < MT; row += NGW) {
        const bool lat = row < ML; const int t = row & (SEQ - 1);
        const float pos = (float)(half == 0 ? (t >> 6) : (t & 63)); const float ang = pos * inv_freq;
        const float cs = lat ? __cosf(ang) : 1.0f, sn = lat ? __sinf(ang) : 0.0f;
        if (lat) {
            for (int hd = 0; hd < NH; ++hd) { bf16_t* p = Q + (size_t)row * DM + hd * HD;
                float x1 = __uint_as_float((unsigned)p[d1] << 16), x2 = __uint_as_float((unsigned)p[d2] << 16);
                const float ss = wave_sum(x1 * x1 + x2 * x2); const float rstd = 1.0f / sqrtf(ss * (1.0f / HD) + NORM_EPS);
                x1 = x1 * rstd * qg1; x2 = x2 * rstd * qg2;
                const float o1 = x1 * cs - x2 * sn, o2 = x2 * cs + x1 * sn;
                const unsigned w = pk2(o1, o2); p[d1] = (bf16_t)(w & 0xffffu); p[d2] = (bf16_t)(w >> 16); }
        }
        for (int kh = 0; kh < NKV; ++kh) { bf16_t* p = K + (size_t)row * 512 + kh * HD;
            float x1 = __uint_as_float((unsigned)p[d1] << 16), x2 = __uint_as_float((unsigned)p[d2] << 16);
            const float ss = wave_sum(x1 * x1 + x2 * x2); const float rstd = 1.0f / sqrtf(ss * (1.0f / HD) + NORM_EPS);
            x1 = x1 * rstd * kg1; x2 = x2 * rstd * kg2;
            const float o1 = x1 * cs - x2 * sn, o2 = x2 * cs + x1 * sn;
            const unsigned w = pk2(o1, o2); p[d1] = (bf16_t)(w & 0xffffu); p[d2] = (bf16_t)(w >> 16); }
    }
}
constexpr int KP = 272;
constexpr int ATT_VOFF = 64 * KP;
DI int crow(int reg, int h) { return (reg & 3) + 8 * (reg >> 2) + 4 * h; }
DI s16x4 vtr(const LAS unsigned char* p) { typedef short v4i16_t __attribute__((ext_vector_type(4))); return __builtin_bit_cast(s16x4, __builtin_amdgcn_ds_read_tr16_b64_v4i16((LAS v4i16_t*)p)); }
DI void ph_attn(const bf16_t* Q, const bf16_t* Kb, const bf16_t* Vb, bf16_t* O, const float* sink, LAS unsigned char* lds, int tid, int lane, int wave, int bid, int G) {
    constexpr float LOG2E = 1.4426950408889634f; constexpr float SC2 = 0.08838834764831845f * LOG2E;
    const int r = lane & 31, h = lane >> 5, g = wave >> 1, sub = wave & 1;
    const int ldrow = tid >> 3, ldc = tid & 7;
    for (int item = bid; item < 1024; item += G) {
        const int qhalf = item & 1, kvh = (item >> 1) & 3, n = (item >> 3) & 15, b = item >> 7;
        const int head = kvh * 4 + g, qq = qhalf * 64 + sub * 32 + r; const int qrow = b * SEQ + n * 128 + qq;
        bf16x8 qf[8];
#pragma unroll
        for (int s = 0; s < 8; ++s) qf[s] = *(const bf16x8*)(Q + (size_t)qrow * DM + head * HD + 16 * s + 8 * h);
        float m2 = sink[head] * LOG2E, lsum = 1.0f;
        f32x16 o[4];
#pragma unroll
        for (int d = 0; d < 4; ++d)
#pragma unroll
            for (int i = 0; i < 16; ++i) o[d][i] = 0.f;
        for (int ti = 0; ti < 10; ++ti) {
            int base, mtype = 0, tt = ti & 1;
            if (ti < 4) { base = ML + b * CTXL + 64 * ti; }
            else { const int blk = n - 1 + ((ti - 4) >> 1); if (blk < 0 || blk > 15) continue;
                   if (ti < 6) { mtype = 1; if (tt == 0 && qhalf == 1) continue; } else if (ti >= 8) { mtype = 2; if (tt == 1 && qhalf == 0) continue; }
                   base = b * SEQ + blk * 128 + 64 * tt; }
            __syncthreads();
#pragma unroll
            for (int c2 = 0; c2 < 2; ++c2) { const int c16 = ldc + 8 * c2;
                const u32x4 kv = *(const u32x4*)(Kb + (size_t)(base + ldrow) * 512 + kvh * HD + c16 * 8); const u32x4 vv = *(const u32x4*)(Vb + (size_t)(base + ldrow) * 512 + kvh * HD + c16 * 8);
                *(LAS u32x4*)(lds + ldrow * KP + c16 * 16) = kv; *(LAS u32x4*)(lds + ATT_VOFF + ldrow * KP + c16 * 16) = vv; }
            __syncthreads();
            f32x16 x0, x1;
#pragma unroll
            for (int i = 0; i < 16; ++i) { x0[i] = 0.f; x1[i] = 0.f; }
#pragma unroll
            for (int s = 0; s < 8; ++s) {
                const bf16x8 k0 = *(const LAS bf16x8*)(lds + r * KP + (16 * s + 8 * h) * 2), k1 = *(const LAS bf16x8*)(lds + (32 + r) * KP + (16 * s + 8 * h) * 2);
                x0 = __builtin_amdgcn_mfma_f32_32x32x16_bf16(k0, qf[s], x0, 0, 0, 0); x1 = __builtin_amdgcn_mfma_f32_32x32x16_bf16(k1, qf[s], x1, 0, 0, 0); }
            float tmax = -3.0e38f;
#pragma unroll
            for (int i = 0; i < 16; ++i) { const int kk0 = tt * 64 + crow(i, h), kk1 = kk0 + 32; float s0 = x0[i] * SC2, s1 = x1[i] * SC2;
                if (mtype == 1) { if (kk0 < qq) s0 = -1.0e30f; if (kk1 < qq) s1 = -1.0e30f; }
                if (mtype == 2) { if (kk0 > qq) s0 = -1.0e30f; if (kk1 > qq) s1 = -1.0e30f; }
                x0[i] = s0; x1[i] = s1; tmax = fmaxf(tmax, fmaxf(s0, s1)); }
            tmax = fmaxf(tmax, __shfl_xor(tmax, 32));
            const float mnew = fmaxf(m2, tmax), alpha = __builtin_amdgcn_exp2f(m2 - mnew); m2 = mnew;
            float ps = 0.f;
#pragma unroll
            for (int i = 0; i < 16; ++i) { x0[i] = __builtin_amdgcn_exp2f(x0[i] - mnew); x1[i] = __builtin_amdgcn_exp2f(x1[i] - mnew); ps += x0[i] + x1[i]; }
            ps += __shfl_xor(ps, 32); lsum = lsum * alpha + ps;
#pragma unroll
            for (int d = 0; d < 4; ++d)
#pragma unroll
                for (int i = 0; i < 16; ++i) o[d][i] *= alpha;
            bf16x8 pf[2][2];
#pragma unroll
            for (int s = 0; s < 2; ++s) {
                u32x4 a, c; a.x = pk2(x0[8 * s + 0], x0[8 * s + 1]); a.y = pk2(x0[8 * s + 2], x0[8 * s + 3]); a.z = pk2(x0[8 * s + 4], x0[8 * s + 5]); a.w = pk2(x0[8 * s + 6], x0[8 * s + 7]);
                c.x = pk2(x1[8 * s + 0], x1[8 * s + 1]); c.y = pk2(x1[8 * s + 2], x1[8 * s + 3]); c.z = pk2(x1[8 * s + 4], x1[8 * s + 5]); c.w = pk2(x1[8 * s + 6], x1[8 * s + 7]);
                pf[0][s] = __builtin_bit_cast(bf16x8, a); pf[1][s] = __builtin_bit_cast(bf16x8, c); }
            const LAS unsigned char* vb = lds + ATT_VOFF + (4 * h + ((lane & 15) >> 2)) * KP + (16 * ((lane >> 4) & 1) + 4 * (lane & 3)) * 2;
#pragma unroll
            for (int d = 0; d < 4; ++d)
#pragma unroll
                for (int t = 0; t < 2; ++t)
#pragma unroll
                    for (int s = 0; s < 2; ++s) {
                        const s16x4 lo = vtr(vb + (t * 32 + 16 * s) * KP + d * 64), hi = vtr(vb + (t * 32 + 16 * s + 8) * KP + d * 64);
                        const bf16x8 vf = (bf16x8){lo[0], lo[1], lo[2], lo[3], hi[0], hi[1], hi[2], hi[3]};
                        o[d] = __builtin_amdgcn_mfma_f32_32x32x16_bf16(vf, pf[t][s], o[d], 0, 0, 0); }
        }
        const float il = 1.0f / lsum;
        bf16_t* op = O + (size_t)qrow * DM + head * HD + 4 * h;
#pragma unroll
        for (int d = 0; d < 4; ++d)
#pragma unroll
            for (int g4 = 0; g4 < 4; ++g4) { u32x2 w; w.x = pk2(o[d][4 * g4 + 0] * il, o[d][4 * g4 + 1] * il); w.y = pk2(o[d][4 * g4 + 2] * il, o[d][4 * g4 + 3] * il);
                *(u32x2*)(op + d * 32 + 8 * g4) = w; }
    }
}

#ifndef MK_ONE_LAUNCH
#define MK_ONE_LAUNCH 0
#endif
constexpr int NPHASE = 22;
struct Args { const float* in[20]; float* out; unsigned char* ws; int ph_lo, ph_hi; };
__global__ void __launch_bounds__(512, 2) dit_fwd(Args args) {
    extern __shared__ __attribute__((aligned(16))) unsigned char lds_raw[];
    LAS unsigned char* lds = (LAS unsigned char*)lds_raw;
    const int tid = threadIdx.x, lane = tid & 63, wave = __builtin_amdgcn_readfirstlane(tid >> 6);
    const int G = gridDim.x, bid = blockIdx.x;
    const int gw = bid * 8 + wave, NGW = G * 8;
    unsigned char* ws = args.ws;
    const float* x = args.in[0]; const float* cnd = args.in[1]; const float* ctx = args.in[2]; const float* cctx = args.in[3];
    const float* ada_w = args.in[4]; const float* ada_b = args.in[5]; const float* nmix = args.in[6]; const float* nffn = args.in[7];
    const float* conv_w = args.in[9]; const float* qgain = args.in[12]; const float* kgain = args.in[13]; const float* sink = args.in[14]; const float* router_w = args.in[16];
    float* mod = (float*)(ws + WS_MOD); float* modp = (float*)(ws + WS_MODP);
    float* affL = (float*)(ws + WS_AFFL); float* affC = (float*)(ws + WS_AFFC);
    int* rowsrc = (int*)(ws + WS_ROWSRC); float* gatev = (float*)(ws + WS_GATEV); int* inv = (int*)(ws + WS_INV);
    bf16_t* W1A = (bf16_t*)(ws + WS_W1A); bf16_t* W1B = (bf16_t*)(ws + WS_W1B); bf16_t* W2 = (bf16_t*)(ws + WS_W2); bf16_t* WQKV = (bf16_t*)(ws + WS_WQKV); bf16_t* WOt = (bf16_t*)(ws + WS_WO);
    bf16_t* WGU = (bf16_t*)(ws + WS_WGU); bf16_t* WDN = (bf16_t*)(ws + WS_WDN);
    float* H = (float*)(ws + WS_H); bf16_t* A = (bf16_t*)(ws + WS_A); bf16_t* U = (bf16_t*)(ws + WS_U); bf16_t* Z = (bf16_t*)(ws + WS_Z);
    bf16_t* Qb = (bf16_t*)(ws + WS_Q); bf16_t* Kb = (bf16_t*)(ws + WS_K); bf16_t* Vb = (bf16_t*)(ws + WS_V); bf16_t* Ob = (bf16_t*)(ws + WS_O);
    bf16_t* HM = (bf16_t*)(ws + WS_HM); bf16_t* Y = (bf16_t*)(ws + WS_Y); bf16_t* XS = (bf16_t*)(ws + WS_XS);

    for (int u = tid; u < (LDS_BYTES - MISC_OFF) / 4; u += 512) ((LAS unsigned*)(lds + MISC_OFF))[u] = 0u;
    __syncthreads();
#if MK_ONE_LAUNCH
    XcdBarrier bar = xcd_barrier_post((unsigned*)(ws + WS_CTL) + CW_BAR, (volatile LAS unsigned*)(lds + MISC_OFF) + 8);
#define GRID_BAR() xcd_barrier(bar)
#else
#define GRID_BAR() do {} while (0)
#endif
    const int lo = args.ph_lo, hi = args.ph_hi;
#define IN(k) (lo <= (k) && (k) < hi)
#define SEAM(k) do { if (IN(k) && IN((k) + 1)) GRID_BAR(); } while (0)

    if (IN(0)) {
        ph_adaln(cnd, cctx, ada_w, modp, gw, NGW, lane);
        CvtPtrs P; P.cin = args.in[8]; P.cout = args.in[10]; P.wqkv = args.in[11]; P.wo = args.in[15]; P.wg = args.in[17]; P.wu = args.in[18]; P.wd = args.in[19];
        P.W1A = W1A; P.W1B = W1B; P.W2 = W2; P.WQKV = WQKV; P.WO = WOt; P.WGU = WGU; P.WDN = WDN;
        ph_convert(P, (LAS float*)(lds + wave * 16640), gw, NGW, lane);
    } SEAM(0);
    if (IN(1)) { ph_modred(modp, ada_b, mod, bid * 512 + tid, G * 512); } SEAM(1);
    if (IN(2)) { ph_mod0(x, ctx, nmix, mod, A, gw, NGW, lane); } SEAM(2);
    if (IN(3)) {
        pg8::Gemm g{A, W1A, MT, 4096, DM}; pg8::StaticOrder S; S.init(MT, 4096, G, bid);
        EpiPair<0> E{U, DM, 16};
        pg8::gemm_phase<EpiPair<0>, pg8::StaticOrder, true, true>(lds, g, S, E);
    } SEAM(3);
    if (IN(4)) {
        pg8::Gemm g{A, W1B, MT, DM, DM}; pg8::StaticOrder S; S.init(MT, DM, G, bid);
        EpiConvGate E{U, Z, conv_w};
        pg8::gemm_phase<EpiConvGate, pg8::StaticOrder, true, true>(lds, g, S, E);
    } SEAM(4);
    if (IN(5)) {
        pg8::Gemm g{Z, W2, MT, DM, DM}; pg8::StaticOrder S; S.init(MT, DM, G, bid);
        EpiResid E{x, ctx, H, mod + 2 * DM};
        pg8::gemm_phase<EpiResid, pg8::StaticOrder, true, true>(lds, g, S, E);
    } SEAM(5);
    if (IN(6)) { load_router(router_w, (LAS float*)lds, tid); ph_modffn(H, nffn, mod, A, (const LAS float*)lds, affL, affC, MT, gw, NGW, lane); } SEAM(6);
    if (IN(7)) { ph_topk(256, affL, affC, rowsrc, gatev, inv, (LAS unsigned*)lds, tid, lane, wave, bid, G); } SEAM(7);
    if (IN(8)) { ph_gather(A, rowsrc, XS, true, gw, NGW, lane); } SEAM(8);
    if (IN(9)) {
        pg8::Gemm g{XS, WGU, YT, NE * 2048, DM}; MoeOrder S{G, bid, 9};
        EpiPair<1> E{HM, DFF, 8};
        pg8::gemm_phase<EpiPair<1>, MoeOrder, true, true>(lds, g, S, E);
    } SEAM(9);
    if (IN(10)) {
        pg8::Gemm g{HM, WDN, YT, NE * 2048, DFF}; MoeOrder S{G, bid, 9};
        EpiDown E{Y, gatev};
        pg8::gemm_phase<EpiDown, MoeOrder, true, true>(lds, g, S, E);
    } SEAM(10);
    if (IN(11)) { ph_combine<false>(H, Y, inv, mod, nmix + DM, mod + 9 * NMOD, A, nullptr, MT, gw, NGW, lane); } SEAM(11);
    if (IN(12)) {
        pg8::Gemm g{A, WQKV, MT, 3072, DM}; QkvOrder S{G, bid};
        EpiQkv E{Qb, Kb, Vb};
        pg8::gemm_phase<EpiQkv, QkvOrder, true, true>(lds, g, S, E);
    } SEAM(12);
    if (IN(13)) { ph_qknorm(Qb, Kb, qgain, kgain, gw, NGW, lane); } SEAM(13);
    if (IN(14)) { ph_attn(Qb, Kb, Vb, Ob, sink, lds, tid, lane, wave, bid, G); } SEAM(14);
    if (IN(15)) {
        pg8::Gemm g{Ob, WOt, ML, DM, DM}; pg8::StaticOrder S; S.init(ML, DM, G, bid);
        EpiResid E{H, H + (size_t)ML * DM, H, mod + 9 * NMOD + 2 * DM};
        pg8::gemm_phase<EpiResid, pg8::StaticOrder, true, true>(lds, g, S, E);
    } SEAM(15);
    if (IN(16)) { load_router(router_w + DM * 16, (LAS float*)lds, tid); ph_modffn(H, nffn + DM, mod + 9 * NMOD, A, (const LAS float*)lds, affL, affC, ML, gw, NGW, lane); } SEAM(16);
    if (IN(17)) { ph_topk(128, affL, affC, rowsrc, gatev, inv, (LAS unsigned*)lds, tid, lane, wave, bid, G); } SEAM(17);
    if (IN(18)) { ph_gather(A, rowsrc, XS, false, gw, NGW, lane); } SEAM(18);
    if (IN(19)) {
        pg8::Gemm g{XS, WGU + (size_t)NE * 2048 * DM, YT, NE * 2048, DM}; MoeOrder S{G, bid, 8};
        EpiPair<1> E{HM, DFF, 8};
        pg8::gemm_phase<EpiPair<1>, MoeOrder, true, true>(lds, g, S, E);
    } SEAM(19);
    if (IN(20)) {
        pg8::Gemm g{HM, WDN + (size_t)NE * 2048 * DFF, YT, NE * 2048, DFF}; MoeOrder S{G, bid, 8};
        EpiDown E{Y, gatev};
        pg8::gemm_phase<EpiDown, MoeOrder, true, true>(lds, g, S, E);
    } SEAM(20);
    if (IN(21)) { ph_combine<true>(H, Y, inv, mod + 9 * NMOD, nullptr, nullptr, nullptr, args.out, ML, gw, NGW, lane); }
#undef IN
#undef SEAM
}

extern "C" void kernel_launch(void* const* d_in, const int* in_sizes, int n_in, void* d_out, int out_size, void* d_ws, size_t ws_size, hipStream_t stream) {
    static int grid = 0;
    if (grid == 0) {
        if (n_in != 20 || out_size != ML * DM || ws_size < WS_END) { fprintf(stderr, "kernel_launch: unexpected problem (n_in %d, out %d, ws %zu); nothing launched\n", n_in, out_size, ws_size); grid = -1; return; }
        int dev = 0, cus = 0, per_cu = 0;
        if (hipGetDevice(&dev) != hipSuccess || hipDeviceGetAttribute(&cus, hipDeviceAttributeMultiprocessorCount, dev) != hipSuccess) { grid = -1; return; }
        if (hipFuncSetAttribute((const void*)dit_fwd, hipFuncAttributeMaxDynamicSharedMemorySize, LDS_BYTES) != hipSuccess) { fprintf(stderr, "kernel_launch: hipFuncSetAttribute failed\n"); grid = -1; return; }
        if (hipOccupancyMaxActiveBlocksPerMultiprocessor(&per_cu, (const void*)dit_fwd, 512, LDS_BYTES) != hipSuccess || per_cu < 1) fprintf(stderr, "kernel_launch: occupancy query reports %d workgroups per CU\n", per_cu);
        (void)hipGetLastError();
        grid = cus;
    }
    if (grid < 0) return;
    (void)hipMemsetAsync((char*)d_ws + WS_CTL, 0, CTL_ZERO_BYTES, stream);
    Args a{};
    for (int i = 0; i < 20; ++i) a.in[i] = (const float*)d_in[i];
    a.out = (float*)d_out; a.ws = (unsigned char*)d_ws;
#if MK_ONE_LAUNCH
    a.ph_lo = 0; a.ph_hi = NPHASE;
    hipLaunchKernelGGL(dit_fwd, dim3(grid), dim3(512), LDS_BYTES, stream, a);
#else
    for (int p = 0; p < NPHASE; ++p) { a.ph_lo = p; a.ph_hi = p + 1; hipLaunchKernelGGL(dit_fwd, dim3(grid), dim3(512), LDS_BYTES, stream, a); }
#endif
}
```

```cpp
#include <hip/hip_runtime.h>
#include <cstdio>
#include <cstdint>
namespace pg8 {
#define PG8_LAS __attribute__((address_space(3)))
typedef unsigned short bf16_t;
typedef short bf16x8 __attribute__((ext_vector_type(8)));
typedef float f32x4 __attribute__((ext_vector_type(4)));
typedef unsigned u32x4 __attribute__((ext_vector_type(4)));
constexpr int BM = 256, BK = 64, HALF = 128, HTB = HALF * BK * 2  , STAGE_BYTES = 8 * HTB, NXCD = 8, WGM = 8;

__host__ __device__ __forceinline__ int lds_byte(int r, int c) { const int st = (r >> 4) * 2 + (c >> 5), rr = r & 15, cc = c & 31, ob = rr * 64 + cc * 2; return st * 1024 + (ob ^ (((ob >> 9) & 1) << 5)); }
__host__ __device__ __forceinline__ void stage_rc(int b, int& R, int& C) { const int st = b / 1024, sb = b % 1024, swz = sb ^ (((sb >> 9) & 1) << 5); R = (st >> 1) * 16 + swz / 64; C = (st & 1) * 32 + (swz % 64) / 2; }
__host__ __device__ __forceinline__ int perm32(int rho) { const int n = rho >> 4, i = rho & 15; return 8 * (i >> 2) + 4 * n + (i & 3); }

struct Unit { int pm, pn; };
struct Gemm { const bf16_t* A; const bf16_t* Bt; int M, N, K; };

struct StaticOrder {
    int nM, nN, nwg, G, c;
    __host__ __device__ void init(int M, int N, int G_, int c_) { nM = M / BM; nN = N / BM; nwg = nM * nN; G = G_; c = c_; }
    __host__ __device__ bool next(int i, Unit& u) const {
        const long L = (long)i * G + c; if (L >= nwg) return false;
        int wgid = (int)L; { const int q = nwg / NXCD, r = nwg % NXCD, xcd = wgid % NXCD, off = wgid / NXCD; wgid = (xcd < r ? xcd * (q + 1) : r * (q + 1) + (xcd - r) * q) + off; }
        const int nig = WGM * nN, gid = wgid / nig, fm = gid * WGM, gsz = (nM - fm) < WGM ? (nM - fm) : WGM;
        u.pm = fm + ((wgid % nig) % gsz); u.pn = (wgid % nig) / gsz; return true;
    }
    __device__ __forceinline__ void a_ready(const Unit&) const {}
    __device__ __forceinline__ void done(const Unit&) const {}
};
__device__ __forceinline__ unsigned cvt_pk_bf16(float lo, float hi) { unsigned r; asm volatile("v_cvt_pk_bf16_f32 %0, %1, %2" : "=v"(r) : "v"(lo), "v"(hi)); return r; }
typedef float f32x2 __attribute__((ext_vector_type(2)));
template <class Epi, class Sched, bool ALIGN_EPI = false, bool SP2 = false>
__device__ __forceinline__ void gemm_phase(PG8_LAS unsigned char* lds, const Gemm g, const Sched& S, const Epi& E) {
    const int tid = threadIdx.x, wid = __builtin_amdgcn_readfirstlane(tid >> 6), lane = tid & 63, wr = wid >> 2, wc = wid & 3, fr = lane & 15, fq = lane >> 4;
    const int K = g.K, nt = K / BK;
    unsigned voffA[2], voffB[2];
#pragma unroll
    for (int i = 0; i < 2; ++i) { int R, C; stage_rc(tid * 16 + i * 8192, R, C); const int Rb = Epi::PERM ? ((R & ~31) + perm32(R & 31)) : R;
        voffA[i] = (unsigned)(R * K + C) * 2u; voffB[i] = (unsigned)(Rb * K + C) * 2u; }
    const size_t kstep = (size_t)(BK * 2);
    const size_t hstep = (size_t)HALF * K * 2;
    const size_t tstep = 2 * hstep;
    const unsigned ldsw = (unsigned)wid * 1024u;
    const int aoff = lds_byte(wr * 64 + fr, fq * 8), boff = lds_byte(wc * 32 + fr, fq * 8);
#define PG8_SA(b, h) (((b) * 2 + (h)) * HTB)
#define PG8_SB(b, h) ((4 + (b) * 2 + (h)) * HTB)
#define PG8_STAGE(bufoff, gbase, voff) do { _Pragma("unroll") for (int _i = 0; _i < 2; ++_i) \
        __builtin_amdgcn_global_load_lds((const unsigned*)((const char*)(gbase) + (voff)[_i]), (PG8_LAS unsigned*)(lds + (bufoff) + ldsw + _i * 8192), 16, 0, 0); } while (0)
#define PG8_LDA(dst, b, h) do { _Pragma("unroll") for (int m = 0; m < 4; ++m) _Pragma("unroll") for (int k = 0; k < 2; ++k) dst[m][k] = *(const PG8_LAS bf16x8*)(lds + PG8_SA(b, h) + aoff + m * 2048 + k * 1024); } while (0)
#define PG8_LDB(dst, b, h) do { _Pragma("unroll") for (int n = 0; n < 2; ++n) _Pragma("unroll") for (int k = 0; k < 2; ++k) dst[n][k] = *(const PG8_LAS bf16x8*)(lds + PG8_SB(b, h) + boff + n * 2048 + k * 1024); } while (0)
#define PG8_MMA(ai, bj, At, Bt) do { __builtin_amdgcn_s_setprio(1); _Pragma("unroll") for (int m = 0; m < 4; ++m) _Pragma("unroll") for (int n = 0; n < 2; ++n) _Pragma("unroll") for (int k = 0; k < 2; ++k) \
        acc[ai][bj][m][n] = __builtin_amdgcn_mfma_f32_16x16x32_bf16(Bt[n][k], At[m][k], acc[ai][bj][m][n], 0, 0, 0); __builtin_amdgcn_s_setprio(0); } while (0)
#define PG8_WAIT_V(n) asm volatile("s_waitcnt vmcnt(" #n ")" ::: "memory")
#define PG8_WAIT_L(n) asm volatile("s_waitcnt lgkmcnt(" #n ")" ::: "memory")
#define PG8_BAR __builtin_amdgcn_s_barrier()
#define PG8_SCHED __builtin_amdgcn_sched_barrier(0)
    Unit cur, nxt; int ui = 0;
    if (!S.next(0, cur)) return;
    f32x4 acc[2][2][4][2];
#pragma unroll
    for (int a = 0; a < 2; ++a)
#pragma unroll
        for (int b = 0; b < 2; ++b)
#pragma unroll
            for (int m = 0; m < 4; ++m)
#pragma unroll
                for (int n = 0; n < 2; ++n) acc[a][b][m][n] = (f32x4){0.f, 0.f, 0.f, 0.f};
    bf16x8 At[4][2], B0[2][2], B1[2][2];
    const char* cA = (const char*)g.A + (size_t)cur.pm * tstep; const char* cB = (const char*)g.Bt + (size_t)cur.pn * tstep;
    S.a_ready(cur);
    if constexpr (SP2) {
        PG8_STAGE(PG8_SB(0, 0), cB, voffB); PG8_STAGE(PG8_SB(0, 1), cB + hstep, voffB); PG8_STAGE(PG8_SA(0, 0), cA, voffA); PG8_STAGE(PG8_SA(0, 1), cA + hstep, voffA);
        if (wr == 1) PG8_BAR;
        PG8_WAIT_V(2); PG8_BAR;
        PG8_STAGE(PG8_SB(1, 0), cB + kstep, voffB); PG8_STAGE(PG8_SA(1, 0), cA + kstep, voffA); PG8_STAGE(PG8_SB(1, 1), cB + hstep + kstep, voffB);
        PG8_WAIT_V(6); PG8_BAR;
    } else {
        PG8_STAGE(PG8_SB(0, 0), cB, voffB); PG8_STAGE(PG8_SA(0, 0), cA, voffA); PG8_STAGE(PG8_SB(0, 1), cB + hstep, voffB); PG8_STAGE(PG8_SA(0, 1), cA + hstep, voffA);
        if (wr == 1) PG8_BAR;
        PG8_WAIT_V(4); PG8_BAR;
        PG8_STAGE(PG8_SB(1, 0), cB + kstep, voffB); PG8_STAGE(PG8_SA(1, 0), cA + kstep, voffA); PG8_STAGE(PG8_SB(1, 1), cB + hstep + kstep, voffB);
        PG8_WAIT_V(6); PG8_BAR;
    }
    for (;;) {
        const bool has_next = S.next(ui + 1, nxt);
        const char* nA = has_next ? (const char*)g.A + (size_t)nxt.pm * tstep : cA; const char* nB = has_next ? (const char*)g.Bt + (size_t)nxt.pn * tstep : cB;
        for (int t = 0; t < nt; t += 2) {
            const bool last = (t == nt - 2);
            const char* a1 = cA + (size_t)(t + 1) * kstep;
            const char* a2 = last ? nA : cA + (size_t)(t + 2) * kstep; const char* b2 = last ? nB : cB + (size_t)(t + 2) * kstep;
            const char* a3 = a2 + kstep; const char* b3 = b2 + kstep;
            if (last && has_next) S.a_ready(nxt);
            if constexpr (SP2) {
            PG8_LDB(B0, 0, 0); PG8_LDB(B1, 0, 1); PG8_SCHED; PG8_LDA(At, 0, 0); PG8_STAGE(PG8_SA(1, 1), a1 + hstep, voffA);
            PG8_WAIT_V(8); PG8_WAIT_L(0); PG8_BAR; PG8_MMA(0, 0, At, B0); PG8_MMA(0, 1, At, B1); PG8_BAR; PG8_SCHED;
            PG8_LDA(At, 0, 1); PG8_STAGE(PG8_SB(0, 0), b2, voffB); PG8_STAGE(PG8_SB(0, 1), b2 + hstep, voffB); PG8_STAGE(PG8_SA(0, 0), a2, voffA);
            PG8_WAIT_V(8); PG8_WAIT_L(0); PG8_BAR; PG8_MMA(1, 0, At, B0); PG8_MMA(1, 1, At, B1); PG8_BAR; PG8_SCHED;
            PG8_LDB(B0, 1, 0); PG8_LDB(B1, 1, 1); PG8_SCHED; PG8_LDA(At, 1, 0); PG8_STAGE(PG8_SA(0, 1), a2 + hstep, voffA);
            PG8_WAIT_V(8); PG8_WAIT_L(0); PG8_BAR; PG8_MMA(0, 0, At, B0); PG8_MMA(0, 1, At, B1); PG8_BAR; PG8_SCHED;
            PG8_LDA(At, 1, 1); PG8_STAGE(PG8_SB(1, 0), b3, voffB); PG8_STAGE(PG8_SB(1, 1), b3 + hstep, voffB); PG8_STAGE(PG8_SA(1, 0), a3, voffA);
            PG8_WAIT_V(8); PG8_WAIT_L(0); PG8_BAR; PG8_MMA(1, 0, At, B0); PG8_MMA(1, 1, At, B1); PG8_BAR; PG8_SCHED;
            } else {
            PG8_LDB(B0, 0, 0); PG8_SCHED; PG8_LDA(At, 0, 0); PG8_STAGE(PG8_SA(1, 1), a1 + hstep, voffA);
            PG8_WAIT_L(8); PG8_BAR; PG8_WAIT_L(0); PG8_MMA(0, 0, At, B0); PG8_BAR; PG8_SCHED;
            PG8_LDB(B1, 0, 1); PG8_STAGE(PG8_SB(0, 0), b2, voffB);
            PG8_BAR; PG8_WAIT_L(0); PG8_MMA(0, 1, At, B1); PG8_BAR;
            PG8_LDA(At, 0, 1); PG8_STAGE(PG8_SA(0, 0), a2, voffA);
            PG8_BAR; PG8_WAIT_L(0); PG8_MMA(1, 0, At, B0); PG8_BAR; PG8_SCHED;
            PG8_STAGE(PG8_SB(0, 1), b2 + hstep, voffB);
            PG8_WAIT_V(6); PG8_BAR; PG8_MMA(1, 1, At, B1); PG8_BAR;
            PG8_LDB(B0, 1, 0); PG8_SCHED; PG8_LDA(At, 1, 0); PG8_STAGE(PG8_SA(0, 1), a2 + hstep, voffA);
            PG8_WAIT_L(8); PG8_BAR; PG8_WAIT_L(0); PG8_MMA(0, 0, At, B0); PG8_BAR; PG8_SCHED;
            PG8_LDB(B1, 1, 1); PG8_STAGE(PG8_SB(1, 0), b3, voffB);
            PG8_BAR; PG8_WAIT_L(0); PG8_MMA(0, 1, At, B1); PG8_BAR;
            PG8_LDA(At, 1, 1); PG8_STAGE(PG8_SA(1, 0), a3, voffA);
            PG8_BAR; PG8_WAIT_L(0); PG8_MMA(1, 0, At, B0); PG8_BAR; PG8_SCHED;
            PG8_STAGE(PG8_SB(1, 1), b3 + hstep, voffB);
            PG8_WAIT_V(6); PG8_BAR; PG8_MMA(1, 1, At, B1); PG8_BAR;
            }
        }
        if constexpr (ALIGN_EPI) { if (wr == 0) PG8_BAR; }
        if constexpr (!Epi::AFTER_DRAIN) { E(acc, cur, wr, wc, fr, fq); S.done(cur); }
        if (!has_next) break;
#pragma unroll
        for (int a = 0; a < 2; ++a)
#pragma unroll
            for (int b = 0; b < 2; ++b)
#pragma unroll
                for (int m = 0; m < 4; ++m)
#pragma unroll
                    for (int n = 0; n < 2; ++n) acc[a][b][m][n] = (f32x4){0.f, 0.f, 0.f, 0.f};
        cur = nxt; cA = nA; cB = nB; ++ui;
        if constexpr (ALIGN_EPI) { if (wr == 1) PG8_BAR; }
    }
    PG8_WAIT_V(0);
    if constexpr (!ALIGN_EPI) { if (wr == 0) PG8_BAR; }
    PG8_BAR;
    if constexpr (Epi::AFTER_DRAIN) { E.fused(acc, cur, wr, wc, fr, fq, lds, wid, lane); S.done(cur); }
#undef PG8_SA
#undef PG8_SB
#undef PG8_STAGE
#undef PG8_LDA
#undef PG8_LDB
#undef PG8_MMA
#undef PG8_WAIT_V
#undef PG8_WAIT_L
#undef PG8_BAR
#undef PG8_SCHED
}
}

constexpr int DM = 2048, NB = 8, SEQ = 2048, CTXL = 256, NH = 16, NKV = 4, HD = 128;
constexpr int ML = NB * SEQ;
constexpr int MC = NB * CTXL;
constexpr int MT = ML + MC;
constexpr int NE = 16, CAPL = 256, CAPC = 32, DFF = 1024;
constexpr int YR = NB * CAPL + NB * CAPC;
constexpr int YT = NE * YR;
constexpr int NMOD = 6 * DM;
constexpr float NORM_EPS = 1e-6f;
constexpr int KSPLIT = 16;

using pg8::Unit; using pg8::f32x4; using pg8::u32x4; using pg8::bf16_t; using pg8::bf16x8; using pg8::cvt_pk_bf16;
typedef float f32x2 __attribute__((ext_vector_type(2)));
typedef unsigned u32x2 __attribute__((ext_vector_type(2)));
typedef float f32x16 __attribute__((ext_vector_type(16)));
typedef short s16x4 __attribute__((ext_vector_type(4)));
#define DI __device__ __forceinline__

DI float bf_lo(unsigned w) { return __uint_as_float(w << 16); }
DI float bf_hi(unsigned w) { return __uint_as_float(w & 0xffff0000u); }
DI float silu_f(float a) { return a * __builtin_amdgcn_rcpf(1.0f + __expf(-a)); }

DI int xcd_remap(int wgid, int nwg) { const int q = nwg / 8, r = nwg % 8, xcd = wgid % 8, off = wgid / 8; return (xcd < r ? xcd * (q + 1) : r * (q + 1) + (xcd - r) * q) + off; }
struct QkvOrder {
    int G, c;
    DI bool next(int i, Unit& u) const {
        const int L = i * G + c; if (L >= 800) return false;
        if (L < 768) { const int w = xcd_remap(L, 768); const int nig = 8 * 12, gid = w / nig; u.pm = gid * 8 + ((w % nig) % 8); u.pn = (w % nig) / 8; }
        else { const int j = L - 768; u.pm = 64 + (j >> 2); u.pn = 8 + (j & 3); }
        return true;
    }
    DI void a_ready(const Unit&) const {}
    DI void done(const Unit&) const {}
};
struct MoeOrder {
    int G, c, NP;
    DI bool next(int i, Unit& u) const {
        const int nwg = NE * NP * 8; const int L = i * G + c; if (L >= nwg) return false;
        const int w = xcd_remap(L, nwg); const int per = NP * 8, e = w / per, rem = w % per;
        u.pm = e * 9 + (rem % NP); u.pn = e * 8 + (rem / NP); return true;
    }
    DI void a_ready(const Unit&) const {}
    DI void done(const Unit&) const {}
};

template <int ACT  > struct EpiPair {
    static constexpr bool PERM = true, AFTER_DRAIN = false;
    bf16_t* O; int ldc; int pn_mod;
    DI void operator()(const f32x4 (&acc)[2][2][4][2], const Unit& u, int wr, int wc, int fr, int fq) const {
        const int row0 = u.pm * 256 + wr * 64 + fr, col0 = (u.pn % pn_mod) * 128 + wc * 32 + 8 * fq;
#pragma unroll
        for (int ai = 0; ai < 2; ++ai)
#pragma unroll
            for (int m = 0; m < 4; ++m) {
                bf16_t* rowp = O + (size_t)(row0 + ai * 128 + m * 16) * ldc + col0;
                f32x4 a0 = acc[ai][0][m][0], a1 = acc[ai][0][m][1]; const f32x4 b0 = acc[ai][1][m][0], b1 = acc[ai][1][m][1];
                if (ACT == 1) {
#pragma unroll
                    for (int j = 0; j < 4; ++j) { a0[j] = silu_f(a0[j]); a1[j] = silu_f(a1[j]); } }
                const f32x4 v0 = a0 * b0, v1 = a1 * b1;
                u32x4 w; w.x = cvt_pk_bf16(v0[0], v0[1]); w.y = cvt_pk_bf16(v0[2], v0[3]); w.z = cvt_pk_bf16(v1[0], v1[1]); w.w = cvt_pk_bf16(v1[2], v1[3]);
                *(u32x4*)rowp = w;
            }
    }
};
struct EpiConvGate {
    static constexpr bool PERM = true, AFTER_DRAIN = false;
    const bf16_t* U; bf16_t* Z; const float* cw;
    DI void operator()(const f32x4 (&acc)[2][2][4][2], const Unit& u, int wr, int wc, int fr, int fq) const {
        const int row0 = u.pm * 256 + wr * 64 + fr, col0 = u.pn * 256 + wc * 32 + 8 * fq;
#pragma unroll
        for (int bj = 0; bj < 2; ++bj) {
            const int c = col0 + bj * 128;
            f32x4 w0a = *(const f32x4*)(cw + c), w0b = *(const f32x4*)(cw + c + 4), w1a = *(const f32x4*)(cw + 2048 + c), w1b = *(const f32x4*)(cw + 2048 + c + 4), w2a = *(const f32x4*)(cw + 4096 + c), w2b = *(const f32x4*)(cw + 4096 + c + 4);
#pragma unroll
            for (int ai = 0; ai < 2; ++ai)
#pragma unroll
                for (int m = 0; m < 4; ++m) {
                    const int row = row0 + ai * 128 + m * 16;
                    const int tpos = row < ML ? (row & (SEQ - 1)) : ((row - ML) & (CTXL - 1)); const int len = row < ML ? SEQ : CTXL;
                    const u32x4 z4 = (u32x4){0u, 0u, 0u, 0u};
                    const u32x4 uc = *(const u32x4*)(U + (size_t)row * DM + c);
                    const u32x4 up = tpos > 0 ? *(const u32x4*)(U + (size_t)(row - 1) * DM + c) : z4;
                    const u32x4 un = tpos < len - 1 ? *(const u32x4*)(U + (size_t)(row + 1) * DM + c) : z4;
                    f32x4 ya, yb;
                    ya[0] = w0a[0] * bf_lo(up.x) + w1a[0] * bf_lo(uc.x) + w2a[0] * bf_lo(un.x); ya[1] = w0a[1] * bf_hi(up.x) + w1a[1] * bf_hi(uc.x) + w2a[1] * bf_hi(un.x);
                    ya[2] = w0a[2] * bf_lo(up.y) + w1a[2] * bf_lo(uc.y) + w2a[2] * bf_lo(un.y); ya[3] = w0a[3] * bf_hi(up.y) + w1a[3] * bf_hi(uc.y) + w2a[3] * bf_hi(un.y);
                    yb[0] = w0b[0] * bf_lo(up.z) + w1b[0] * bf_lo(uc.z) + w2b[0] * bf_lo(un.z); yb[1] = w0b[1] * bf_hi(up.z) + w1b[1] * bf_hi(uc.z) + w2b[1] * bf_hi(un.z);
                    yb[2] = w0b[2] * bf_lo(up.w) + w1b[2] * bf_lo(uc.w) + w2b[2] * bf_lo(un.w); yb[3] = w0b[3] * bf_hi(up.w) + w1b[3] * bf_hi(uc.w) + w2b[3] * bf_hi(un.w);
                    const f32x4 v0 = acc[ai][bj][m][0] * ya, v1 = acc[ai][bj][m][1] * yb;
                    u32x4 w; w.x = cvt_pk_bf16(v0[0], v0[1]); w.y = cvt_pk_bf16(v0[2], v0[3]); w.z = cvt_pk_bf16(v1[0], v1[1]); w.w = cvt_pk_bf16(v1[2], v1[3]);
                    *(u32x4*)(Z + (size_t)row * DM + c) = w;
                }
        }
    }
};
struct EpiResid {
    static constexpr bool PERM = false, AFTER_DRAIN = false;
    const float* base_lat; const float* base_ctx; float* out; const float* gate;
    DI void operator()(const f32x4 (&acc)[2][2][4][2], const Unit& u, int wr, int wc, int fr, int fq) const {
        const int rowt = u.pm * 256; const int cr = rowt < ML ? (rowt >> 11) : 8;
        const float* base = rowt < ML ? base_lat : base_ctx - (size_t)ML * DM;
        const int row0 = rowt + wr * 64 + fr, col0 = u.pn * 256 + wc * 32 + 4 * fq;
        f32x4 gv[2][2];
#pragma unroll
        for (int bj = 0; bj < 2; ++bj)
#pragma unroll
            for (int n = 0; n < 2; ++n) gv[bj][n] = *(const f32x4*)(gate + (size_t)cr * NMOD + col0 + bj * 128 + n * 16);
#pragma unroll
        for (int ai = 0; ai < 2; ++ai)
#pragma unroll
            for (int m = 0; m < 4; ++m) { const size_t off = (size_t)(row0 + ai * 128 + m * 16) * DM + col0;
#pragma unroll
                for (int bj = 0; bj < 2; ++bj)
#pragma unroll
                    for (int n = 0; n < 2; ++n) { const f32x4 bs = *(const f32x4*)(base + off + bj * 128 + n * 16); *(f32x4*)(out + off + bj * 128 + n * 16) = bs + gv[bj][n] * acc[ai][bj][m][n]; }
                asm volatile("" ::: "memory"); }
    }
};
struct EpiDown {
    static constexpr bool PERM = true, AFTER_DRAIN = false;
    bf16_t* Y; const float* gatev;
    DI void operator()(const f32x4 (&acc)[2][2][4][2], const Unit& u, int wr, int wc, int fr, int fq) const {
        const int row0 = u.pm * 256 + wr * 64 + fr, col0 = (u.pn & 7) * 256 + wc * 32 + 8 * fq;
#pragma unroll
        for (int ai = 0; ai < 2; ++ai)
#pragma unroll
            for (int m = 0; m < 4; ++m) { const int row = row0 + ai * 128 + m * 16; const float gt = gatev[row];
#pragma unroll
                for (int bj = 0; bj < 2; ++bj) { const f32x4 v0 = acc[ai][bj][m][0] * gt, v1 = acc[ai][bj][m][1] * gt;
                    u32x4 w; w.x = cvt_pk_bf16(v0[0], v0[1]); w.y = cvt_pk_bf16(v0[2], v0[3]); w.z = cvt_pk_bf16(v1[0], v1[1]); w.w = cvt_pk_bf16(v1[2], v1[3]);
                    *(u32x4*)(Y + (size_t)row * DM + col0 + bj * 128) = w; } }
    }
};
struct EpiQkv {
    static constexpr bool PERM = true, AFTER_DRAIN = false;
    bf16_t* Q; bf16_t* K; bf16_t* V;
    DI void operator()(const f32x4 (&acc)[2][2][4][2], const Unit& u, int wr, int wc, int fr, int fq) const {
        const int row0 = u.pm * 256 + wr * 64 + fr; int colt = u.pn * 256; bf16_t* base; int ld;
        if (colt < 2048) { base = Q; ld = 2048; } else if (colt < 2560) { base = K; ld = 512; colt -= 2048; } else { base = V; ld = 512; colt -= 2560; }
        const int col0 = colt + wc * 32 + 8 * fq;
#pragma unroll
        for (int ai = 0; ai < 2; ++ai)
#pragma unroll
            for (int m = 0; m < 4; ++m) { bf16_t* rowp = base + (size_t)(row0 + ai * 128 + m * 16) * ld + col0;
#pragma unroll
                for (int bj = 0; bj < 2; ++bj) { const f32x4 v0 = acc[ai][bj][m][0], v1 = acc[ai][bj][m][1];
                    u32x4 w; w.x = cvt_pk_bf16(v0[0], v0[1]); w.y = cvt_pk_bf16(v0[2], v0[3]); w.z = cvt_pk_bf16(v1[0], v1[1]); w.w = cvt_pk_bf16(v1[2], v1[3]);
                    *(u32x4*)(rowp + bj * 128) = w; } }
    }
};

constexpr size_t MiB = 1u << 20;
constexpr size_t WS_CTL = 0, CTL_ZERO_BYTES = 1 * MiB;
constexpr size_t WS_MOD = 1 * MiB;
constexpr size_t WS_MODP = 2 * MiB;
constexpr size_t WS_AFFL = 16 * MiB;
constexpr size_t WS_AFFC = 17 * MiB;
constexpr size_t WS_ROWSRC = 17 * MiB + 512 * 1024;
constexpr size_t WS_GATEV = 18 * MiB;
constexpr size_t WS_INV = 18 * MiB + 512 * 1024;
constexpr size_t WS_W1A = 20 * MiB;
constexpr size_t WS_W1B = 36 * MiB;
constexpr size_t WS_W2 = 44 * MiB;
constexpr size_t WS_WQKV = 52 * MiB;
constexpr size_t WS_WO = 64 * MiB;
constexpr size_t WS_WGU = 72 * MiB;
constexpr size_t WS_WDN = 328 * MiB;
constexpr size_t WS_H = 456 * MiB;
constexpr size_t WS_A = 600 * MiB;
constexpr size_t WS_U = 672 * MiB;
constexpr size_t WS_Z = 744 * MiB;
constexpr size_t WS_Q = WS_U, WS_K = WS_Z, WS_V = WS_Z + 18 * MiB;
constexpr size_t WS_HM = 816 * MiB;
constexpr size_t WS_O = WS_HM;
constexpr size_t WS_Y = 888 * MiB;
constexpr size_t WS_XS = WS_Y;
constexpr size_t WS_END = 1032 * MiB;
constexpr int CW_BAR = 4096;

constexpr int RING_BYTES = 131072;
constexpr int MISC_OFF = RING_BYTES + 14336;
constexpr int LDS_BYTES = 147456;

#define GAS __attribute__((address_space(1)))
#define LAS __attribute__((address_space(3)))
#define LDS_WAIT() asm volatile("s_waitcnt lgkmcnt(0)" ::: "memory")
#define VM_WAIT() asm volatile("s_waitcnt vmcnt(0)" ::: "memory")
#define XB_TMO      128
#define XB_XCNT(j)  (256  + 64 * (j))
#define XB_XSUB(j)  (1280 + 64 * (j))
#define XB_XGEN(j)  (2304 + 64 * (j))
#define XB_TOP      3328
#define XB_TOPGEN   3392
#define XCD_BAR_WORDS 3456
#define XB_SPIN_CAP (1u << 18)

__device__ __forceinline__ unsigned xb_ld(unsigned* p)              { return __hip_atomic_load(p, __ATOMIC_RELAXED, __HIP_MEMORY_SCOPE_AGENT); }
__device__ __forceinline__ unsigned xb_add(unsigned* p, unsigned v) { return __hip_atomic_fetch_add(p, v, __ATOMIC_RELAXED, __HIP_MEMORY_SCOPE_AGENT); }
__device__ __forceinline__ unsigned xb_xcc_id() { return (unsigned)__builtin_amdgcn_s_getreg((3 << 11) | 20) & 0xFu; }
#define XB_SPIN(cond, bar) do { unsigned _sp = 0; while (cond) { __builtin_amdgcn_s_sleep(1); \
    if ((++_sp & 255u) == 0u) { if (xb_ld(&(bar)[XB_TMO])) break; if (_sp > XB_SPIN_CAP) { atomicAdd(&(bar)[XB_TMO], 1u); break; } } } } while (0)

struct XcdBarrier {
    unsigned* bar; unsigned x;
    volatile LAS unsigned* st;
};

__device__ __forceinline__ XcdBarrier xcd_barrier_post(unsigned* bar, volatile LAS unsigned* st) {
    XcdBarrier b; b.bar = bar; b.x = xb_xcc_id(); b.st = st;
    if (threadIdx.x == 0) (void)xb_add(&bar[XB_XCNT(b.x)], 1u);
    return b;
}
__device__ __forceinline__ void xcd_barrier_complete(unsigned* bar, unsigned x, unsigned& nloc, unsigned& nx) {
    const unsigned G = gridDim.x * gridDim.y * gridDim.z;
    unsigned sum, cnt, mine, sp = 0u;
    for (;;) {
        sum = 0u; cnt = 0u; mine = 0u;
#pragma unroll
        for (unsigned j = 0; j < 16; ++j) { const unsigned c = xb_ld(&bar[XB_XCNT(j)]); sum += c; cnt += (c > 0u) ? 1u : 0u; mine = (j == x) ? c : mine; }
        if (sum == G) break;
        __builtin_amdgcn_s_sleep(1);
        if ((++sp & 255u) == 0u) { if (xb_ld(&bar[XB_TMO])) break; if (sp > XB_SPIN_CAP) { atomicAdd(&bar[XB_TMO], 1u); break; } }
    }
    nloc = mine > 0u ? mine : 1u; nx = cnt > 0u ? cnt : 1u;
}

__device__ __forceinline__ void xcd_barrier(const XcdBarrier& b) {
    asm volatile("s_waitcnt vmcnt(0)" ::: "memory");
    __syncthreads();
    if (threadIdx.x == 0) {
        unsigned* bar = b.bar;
        __builtin_amdgcn_s_waitcnt(0);
        unsigned nloc = b.st[0], nx = b.st[1];
        if (nloc == 0u) { xcd_barrier_complete(bar, b.x, nloc, nx); b.st[0] = nloc; b.st[1] = nx; }
        const unsigned old = xb_add(&bar[XB_XSUB(b.x)], 1u);
        const unsigned gen = old / nloc;
        if (old + 1u == (gen + 1u) * nloc) {
            __builtin_amdgcn_fence(__ATOMIC_RELEASE, "agent");
            asm volatile("s_waitcnt vmcnt(0)" ::: "memory");
            const unsigned og = xb_add(&bar[XB_TOP], 1u);
            const unsigned tg = og / nx;
            if (og + 1u == (tg + 1u) * nx) xb_add(&bar[XB_TOPGEN], 1u);
            else XB_SPIN(xb_ld(&bar[XB_TOPGEN]) == tg, bar);
            __builtin_amdgcn_fence(__ATOMIC_ACQUIRE, "agent");
            xb_add(&bar[XB_XGEN(b.x)], 1u);
            asm volatile("s_waitcnt vmcnt(0)" ::: "memory");
        } else {
            XB_SPIN(xb_ld(&bar[XB_XGEN(b.x)]) == gen, bar);
            __builtin_amdgcn_fence(__ATOMIC_ACQUIRE, "agent");
            asm volatile("s_waitcnt vmcnt(0)" ::: "memory");
        }
    }
    __syncthreads();
}

DI float wave_sum(float v) {
#pragma unroll
    for (int o = 1; o < 64; o <<= 1) v += __shfl_xor(v, o);
    return v;
}
DI float rdlane(float v, int l) { return __uint_as_float((unsigned)__builtin_amdgcn_readlane((int)__float_as_uint(v), l)); }
DI unsigned pk2(float lo, float hi) { return cvt_pk_bf16(lo, hi); }

DI void ph_adaln(const float* cnd, const float* cctx, const float* ada_w, float* modp, int gw, int NGW, int lane) {
    for (int task = gw; task < 96 * KSPLIT; task += NGW) {
        const int ks = task & (KSPLIT - 1), cg = task / KSPLIT, l = cg / 48, cgl = cg % 48, col0 = cgl * 256 + lane * 4, k0 = ks * 128;
        float sv[9][2];
#pragma unroll
        for (int r = 0; r < 9; ++r)
#pragma unroll
            for (int hh = 0; hh < 2; ++hh) { const int k = k0 + hh * 64 + lane; const float v = r < 8 ? cnd[r * DM + k] : cctx[k]; sv[r][hh] = v / (1.0f + __expf(-v)); }
        f32x4 acc[9];
#pragma unroll
        for (int r = 0; r < 9; ++r) acc[r] = (f32x4){0.f, 0.f, 0.f, 0.f};
        const float* wp = ada_w + ((size_t)l * DM + k0) * NMOD + col0;
#pragma unroll
        for (int hh = 0; hh < 2; ++hh) {
#pragma unroll 8
            for (int kk = 0; kk < 64; ++kk) {
                const f32x4 w = *(const f32x4*)(wp + (size_t)(hh * 64 + kk) * NMOD);
#pragma unroll
                for (int r = 0; r < 9; ++r) { const float s = rdlane(sv[r][hh], kk); acc[r] += w * s; }
            }
        }
#pragma unroll
        for (int r = 0; r < 9; ++r) *(f32x4*)(modp + ((size_t)((ks * 2 + l) * 9 + r)) * NMOD + col0) = acc[r];
    }
}
DI void cvt_item(const float* W, int ldw, bf16_t* dst, int ldd, LAS float* scr, int lane) {
#pragma unroll 4
    for (int i = 0; i < 16; ++i) { const int row = 4 * i + (lane >> 4); const f32x4 v = *(const f32x4*)(W + (size_t)row * ldw + (lane & 15) * 4);
        LAS float* s = scr + row * 65 + (lane & 15) * 4; s[0] = v[0]; s[1] = v[1]; s[2] = v[2]; s[3] = v[3]; }
    LDS_WAIT(); asm volatile("" ::: "memory");
    const int c = lane & 7;
#pragma unroll
    for (int j = 0; j < 8; ++j) { const int n = (lane >> 3) + 8 * j; const LAS float* s = scr + (8 * c) * 65 + n;
        u32x4 o; o.x = pk2(s[0 * 65], s[1 * 65]); o.y = pk2(s[2 * 65], s[3 * 65]); o.z = pk2(s[4 * 65], s[5 * 65]); o.w = pk2(s[6 * 65], s[7 * 65]);
        *(u32x4*)(dst + (size_t)n * ldd + 8 * c) = o; }
    LDS_WAIT(); asm volatile("" ::: "memory");
}
struct CvtPtrs { const float *cin, *cout, *wqkv, *wo, *wg, *wu, *wd; bf16_t *W1A, *W1B, *W2, *WQKV, *WO, *WGU, *WDN; };
DI void ph_convert(const CvtPtrs& P, LAS float* scr, int gw, int NGW, int lane) {
    constexpr int I_CIN = 32 * 96, I_SQ = 32 * 32, I_QKV = 32 * 48, I_EXP = 32 * 512;
    constexpr int NITEMS = I_CIN + I_SQ + I_QKV + I_SQ + 3 * I_EXP;
    for (int it = gw; it < NITEMS; it += NGW) {
        int r = it;
        if (r < I_CIN) { const int kt = r / 96, nt = r % 96, n0 = nt * 64, part = n0 >> 11, j0 = n0 & 2047;
            bf16_t* d = part == 0 ? P.W1B + (size_t)j0 * DM : P.W1A + (size_t)((j0 >> 7) * 256 + (part == 2 ? 128 : 0) + (j0 & 127)) * DM;
            cvt_item(P.cin + (size_t)(kt * 64) * 6144 + n0, 6144, d + kt * 64, DM, scr, lane); continue; } r -= I_CIN;
        if (r < I_SQ) { const int kt = r / 32, nt = r % 32; cvt_item(P.cout + (size_t)(kt * 64) * DM + nt * 64, DM, P.W2 + (size_t)(nt * 64) * DM + kt * 64, DM, scr, lane); continue; } r -= I_SQ;
        if (r < I_QKV) { const int kt = r / 48, nt = r % 48; cvt_item(P.wqkv + (size_t)(kt * 64) * 3072 + nt * 64, 3072, P.WQKV + (size_t)(nt * 64) * DM + kt * 64, DM, scr, lane); continue; } r -= I_QKV;
        if (r < I_SQ) { const int kt = r / 32, nt = r % 32; cvt_item(P.wo + (size_t)(kt * 64) * DM + nt * 64, DM, P.WO + (size_t)(nt * 64) * DM + kt * 64, DM, scr, lane); continue; } r -= I_SQ;
        if (r < 2 * I_EXP) { const int up = r >= I_EXP ? 1 : 0; r -= up * I_EXP; const int le = r / 512, rem = r % 512, kt = rem / 16, nt = rem % 16, n0 = nt * 64;
            const float* src = (up ? P.wu : P.wg) + (size_t)le * DM * DFF + (size_t)(kt * 64) * DFF + n0;
            bf16_t* d = P.WGU + (size_t)(le * 2048 + (n0 >> 7) * 256 + up * 128 + (n0 & 127)) * DM + kt * 64;
            cvt_item(src, DFF, d, DM, scr, lane); continue; } r -= 2 * I_EXP;
        { const int le = r / 512, rem = r % 512, kt = rem / 32, nt = rem % 32;
            cvt_item(P.wd + (size_t)le * DFF * DM + (size_t)(kt * 64) * DM + nt * 64, DM, P.WDN + (size_t)(le * 2048 + nt * 64) * DFF + kt * 64, DFF, scr, lane); }
    }
}
DI void ph_modred(const float* modp, const float* ada_b, float* mod, int gtid, int GT) {
    for (int i = gtid; i < 2 * 9 * NMOD; i += GT) { const int l = i / (9 * NMOD), j = i % NMOD; float s = ada_b[l * NMOD + j];
#pragma unroll
        for (int ks = 0; ks < KSPLIT; ++ks) s += modp[(size_t)ks * (2 * 9 * NMOD) + i];
        mod[i] = s; }
}
DI void row_load(const float* p, f32x4 (&v)[8], int lane) {
#pragma unroll
    for (int j = 0; j < 8; ++j) v[j] = *(const f32x4*)(p + 4 * lane + 256 * j);
}
DI void row_modulate(const f32x4 (&v)[8], f32x4 (&y)[8], const float* gain, const float* shift, const float* scale, int lane) {
    float ss = 0.f;
#pragma unroll
    for (int j = 0; j < 8; ++j) ss += (v[j][0] * v[j][0] + v[j][1] * v[j][1]) + (v[j][2] * v[j][2] + v[j][3] * v[j][3]);
    ss = wave_sum(ss);
    const float rstd = 1.0f / sqrtf(ss * (1.0f / DM) + NORM_EPS);
#pragma unroll
    for (int j = 0; j < 8; ++j) { const int c = 4 * lane + 256 * j; const f32x4 g = *(const f32x4*)(gain + c), sh = *(const f32x4*)(shift + c), sc = *(const f32x4*)(scale + c);
        y[j] = ((v[j] * rstd) * g) * (sc + 1.0f) + sh; }
}
DI void row_store_bf16(bf16_t* p, const f32x4 (&y)[8], int lane) {
#pragma unroll
    for (int j = 0; j < 8; ++j) { u32x2 w; w.x = pk2(y[j][0], y[j][1]); w.y = pk2(y[j][2], y[j][3]); *(u32x2*)(p + 4 * lane + 256 * j) = w; }
}
DI void ph_mod0(const float* x, const float* ctx, const float* gain, const float* mod0, bf16_t* A, int gw, int NGW, int lane) {
    for (int row = gw; row < MT; row += NGW) {
        const int cr = row < ML ? (row >> 11) : 8; const float* src = row < ML ? x + (size_t)row * DM : ctx + (size_t)(row - ML) * DM;
        f32x4 v[8], y[8]; row_load(src, v, lane);
        row_modulate(v, y, gain, mod0 + (size_t)cr * NMOD + 0 * DM, mod0 + (size_t)cr * NMOD + 1 * DM, lane);
        row_store_bf16(A + (size_t)row * DM, y, lane);
    }
}
DI void router_row(const f32x4 (&y)[8], const LAS float* rwT, float* affL, float* affC, int row, int lane) {
    float lg[16];
#pragma unroll
    for (int e = 0; e < 16; ++e) { float s = 0.f;
#pragma unroll
        for (int j = 0; j < 8; ++j) { const f32x4 w = *(const LAS f32x4*)(rwT + e * DM + 4 * lane + 256 * j); s += (y[j][0] * w[0] + y[j][1] * w[1]) + (y[j][2] * w[2] + y[j][3] * w[3]); }
        lg[e] = wave_sum(s); }
    float mx = lg[0];
#pragma unroll
    for (int e = 1; e < 16; ++e) mx = fmaxf(mx, lg[e]);
    float den = 0.f;
#pragma unroll
    for (int e = 0; e < 16; ++e) { lg[e] = __expf(lg[e] - mx); den += lg[e]; }
    float mine = 0.f;
#pragma unroll
    for (int e = 0; e < 16; ++e) mine = (lane == e) ? lg[e] : mine;
    mine = mine / den;
    if (lane < 16) { if (row < ML) { const int b = row >> 11, n = row & 2047; affL[(size_t)(b * 16 + lane) * SEQ + n] = mine; }
                     else { const int rc = row - ML, b = rc >> 8, n = rc & 255; affC[(size_t)(b * 16 + lane) * CTXL + n] = mine; } }
}
DI void load_router(const float* rw, LAS float* rwT, int tid) {
    for (int i = tid; i < DM * 16; i += 512) rwT[(i & 15) * DM + (i >> 4)] = rw[i];
    __syncthreads();
}
DI void ph_modffn(const float* H, const float* gain, const float* modl, bf16_t* A, const LAS float* rwT, float* affL, float* affC, int nrows, int gw, int NGW, int lane) {
    for (int row = gw; row < nrows; row += NGW) {
        const int cr = row < ML ? (row >> 11) : 8;
        f32x4 v[8], y[8]; row_load(H + (size_t)row * DM, v, lane);
        row_modulate(v, y, gain, modl + (size_t)cr * NMOD + 3 * DM, modl + (size_t)cr * NMOD + 4 * DM, lane);
        row_store_bf16(A + (size_t)row * DM, y, lane);
        router_row(y, rwT, affL, affC, row, lane);
    }
}
DI void ph_topk(int nitems, const float* affL, const float* affC, int* rowsrc, float* gatev, int* inv, LAS unsigned* hist, int tid, int lane, int wave, int bid, int G) {
    LAS unsigned* sh = hist + 256;
    for (int it = bid; it < nitems; it += G) {
        const bool isc = it >= 128; const int be = it & 127, b = be >> 4, e = be & 15;
        const int N = isc ? CTXL : SEQ, C = isc ? CAPC : CAPL;
        const float* src = isc ? affC + (size_t)be * CTXL : affL + (size_t)be * SEQ;
        const int i0 = tid * 4; const bool valid = i0 < N;
        unsigned key[4];
        { f32x4 v = (f32x4){0.f, 0.f, 0.f, 0.f}; if (valid) v = *(const f32x4*)(src + i0);
#pragma unroll
          for (int q = 0; q < 4; ++q) key[q] = __float_as_uint(v[q]); }
        unsigned prefix = 0u, mask = 0u, krem = (unsigned)C;
        for (int pass = 3; pass >= 0; --pass) {
            const int shift = pass * 8;
            if (tid < 256) hist[tid] = 0u;
            __syncthreads();
            if (valid) {
#pragma unroll
                for (int q = 0; q < 4; ++q) if ((key[q] & mask) == prefix) __hip_atomic_fetch_add(&hist[(key[q] >> shift) & 255u], 1u, __ATOMIC_RELAXED, __HIP_MEMORY_SCOPE_WORKGROUP); }
            __syncthreads();
            if (wave == 0) {
                const unsigned h0 = hist[4 * lane], h1 = hist[4 * lane + 1], h2 = hist[4 * lane + 2], h3 = hist[4 * lane + 3];
                const unsigned tot = h0 + h1 + h2 + h3; unsigned incl = tot;
#pragma unroll
                for (int o = 1; o < 64; o <<= 1) { const unsigned t = __shfl_down(incl, o); if (lane + o < 64) incl += t; }
                const unsigned a3 = incl - tot, a2 = a3 + h3, a1 = a2 + h2, a0 = a1 + h1;
                if (a3 < krem && krem <= a3 + h3) { sh[0] = 4 * lane + 3; sh[1] = krem - a3; }
                if (a2 < krem && krem <= a2 + h2) { sh[0] = 4 * lane + 2; sh[1] = krem - a2; }
                if (a1 < krem && krem <= a1 + h1) { sh[0] = 4 * lane + 1; sh[1] = krem - a1; }
                if (a0 < krem && krem <= a0 + h0) { sh[0] = 4 * lane + 0; sh[1] = krem - a0; }
            }
            __syncthreads();
            const unsigned B = sh[0]; krem = sh[1]; prefix |= B << shift; mask |= 0xFFu << shift;
        }
        const unsigned T = prefix;
        unsigned cg = 0u, ce = 0u;
        if (valid) {
#pragma unroll
            for (int q = 0; q < 4; ++q) { cg += key[q] > T ? 1u : 0u; ce += key[q] == T ? 1u : 0u; } }
        const unsigned mine = cg | (ce << 16); unsigned incl = mine;
#pragma unroll
        for (int o = 1; o < 64; o <<= 1) { const unsigned t = __shfl_up(incl, o); if (lane >= o) incl += t; }
        if (lane == 63) sh[8 + wave] = incl;
        __syncthreads();
        unsigned woff = 0u;
#pragma unroll
        for (int w = 0; w < 8; ++w) woff += (w < wave) ? sh[8 + w] : 0u;
        const unsigned excl = woff + incl - mine; unsigned gtb = excl & 0xFFFFu, eqb = excl >> 16;
        if (valid) {
            const int ybase = e * YR + (isc ? NB * CAPL + b * CAPC : b * CAPL); const int rbase = isc ? ML + b * CTXL : b * SEQ;
#pragma unroll
            for (int q = 0; q < 4; ++q) {
                const bool isg = key[q] > T, ise = key[q] == T; const bool sel = isg || (ise && eqb < krem);
                const unsigned slot = gtb + (eqb < krem ? eqb : krem);
                const int trow = rbase + i0 + q; const int yrow = ybase + (int)slot;
                if (sel) { rowsrc[yrow] = trow; gatev[yrow] = __uint_as_float(key[q]); }
                inv[(size_t)trow * 16 + e] = sel ? yrow : -1;
                gtb += isg ? 1u : 0u; eqb += ise ? 1u : 0u;
            }
        }
        __syncthreads();
    }
}
DI void ph_gather(const bf16_t* A, const int* rowsrc, bf16_t* XS, bool with_ctx, int gw, int NGW, int lane) {
    for (int yr = gw; yr < YT; yr += NGW) {
        if (!with_ctx && (yr % YR) >= NB * CAPL) continue;
        const int src = rowsrc[yr];
        const u32x4* s = (const u32x4*)(A + (size_t)src * DM); u32x4* d = (u32x4*)(XS + (size_t)yr * DM);
#pragma unroll
        for (int j = 0; j < 4; ++j) d[lane + 64 * j] = s[lane + 64 * j];
    }
}
template <bool LAST> DI void ph_combine(float* H, const bf16_t* Y, const int* inv, const float* modl  , const float* gain1, const float* mod1, bf16_t* A, float* out, int nrows, int gw, int NGW, int lane) {
    for (int row = gw; row < nrows; row += NGW) {
        const int cr = row < ML ? (row >> 11) : 8;
        f32x4 v[8], acc[8]; row_load(H + (size_t)row * DM, v, lane);
#pragma unroll
        for (int j = 0; j < 8; ++j) acc[j] = (f32x4){0.f, 0.f, 0.f, 0.f};
        const int myinv = inv[(size_t)row * 16 + (lane & 15)];
        for (int e = 0; e < 16; ++e) {
            const int yr = __builtin_amdgcn_readlane(myinv, e);
            if (yr >= 0) { const bf16_t* yp = Y + (size_t)yr * DM + 4 * lane;
#pragma unroll
                for (int j = 0; j < 8; ++j) { const u32x2 p = *(const u32x2*)(yp + 256 * j); acc[j][0] += bf_lo(p.x); acc[j][1] += bf_hi(p.x); acc[j][2] += bf_lo(p.y); acc[j][3] += bf_hi(p.y); } }
        }
        const float* g2 = modl + (size_t)cr * NMOD + 5 * DM;
#pragma unroll
        for (int j = 0; j < 8; ++j) { const f32x4 g = *(const f32x4*)(g2 + 4 * lane + 256 * j); v[j] = v[j] + g * acc[j]; }
        if (LAST) {
#pragma unroll
            for (int j = 0; j < 8; ++j) *(f32x4*)(out + (size_t)row * DM + 4 * lane + 256 * j) = v[j];
        } else {
#pragma unroll
            for (int j = 0; j < 8; ++j) *(f32x4*)(H + (size_t)row * DM + 4 * lane + 256 * j) = v[j];
            f32x4 y[8]; row_modulate(v, y, gain1, mod1 + (size_t)cr * NMOD + 0 * DM, mod1 + (size_t)cr * NMOD + 1 * DM, lane);
            row_store_bf16(A + (size_t)row * DM, y, lane);
        }
    }
}
DI void ph_qknorm(bf16_t* Q, bf16_t* K, const float* qg, const float* kg, int gw, int NGW, int lane) {
    const int half = lane >> 5, i = lane & 31, d1 = half * 64 + i, d2 = d1 + 32;
    const float inv_freq = exp2f(-(float)i * (13.287712379549449f / 32.0f));
    const float qg1 = qg[d1], qg2 = qg[d2], kg1 = kg[d1], kg2 = kg[d2];
    for (int row = gw; row < MT; row += NGW) {
        const bool lat = row < ML; const int t = row & (SEQ - 1);
        const float pos = (float)(half == 0 ? (t >> 6) : (t & 63)); const float ang = pos * inv_freq;
        const float cs = lat ? __cosf(ang) : 1.0f, sn = lat ? __sinf(ang) : 0.0f;
        if (lat) {
            for (int hd = 0; hd < NH; ++hd) { bf16_t* p = Q + (size_t)row * DM + hd * HD;
                float x1 = __uint_as_float((unsigned)p[d1] << 16), x2 = __uint_as_float((unsigned)p[d2] << 16);
                const float ss = wave_sum(x1 * x1 + x2 * x2); const float rstd = 1.0f / sqrtf(ss * (1.0f / HD) + NORM_EPS);
                x1 = x1 * rstd * qg1; x2 = x2 * rstd * qg2;
                const float o1 = x1 * cs - x2 * sn, o2 = x2 * cs + x1 * sn;
                const unsigned w = pk2(o1, o2); p[d1] = (bf16_t)(w & 0xffffu); p[d2] = (bf16_t)(w >> 16); }
        }
        for (int kh = 0; kh < NKV; ++kh) { bf16_t* p = K + (size_t)row * 512 + kh * HD;
            float x1 = __uint_as_float((unsigned)p[d1] << 16), x2 = __uint_as_float((unsigned)p[d2] << 16);
            const float ss = wave_sum(x1 * x1 + x2 * x2); const float rstd = 1.0f / sqrtf(ss * (1.0f / HD) + NORM_EPS);
            x1 = x1 * rstd * kg1; x2 = x2 * rstd * kg2;
            const float o1 = x1 * cs - x2 * sn, o2 = x2 * cs + x1 * sn;
            const unsigned w = pk2(o1, o2); p[d1] = (bf16_t)(w & 0xffffu); p[d2] = (bf16_t)(w >> 16); }
    }
}
constexpr int KP = 272;
constexpr int ATT_VOFF = 64 * KP;
DI int crow(int reg, int h) { return (reg & 3) + 8 * (reg >> 2) + 4 * h; }
DI s16x4 vtr(const LAS unsigned char* p) { typedef short v4i16_t __attribute__((ext_vector_type(4))); return __builtin_bit_cast(s16x4, __builtin_amdgcn_ds_read_tr16_b64_v4i16((LAS v4i16_t*)p)); }
DI void ph_attn(const bf16_t* Q, const bf16_t* Kb, const bf16_t* Vb, bf16_t* O, const float* sink, LAS unsigned char* lds, int tid, int lane, int wave, int bid, int G) {
    constexpr float LOG2E = 1.4426950408889634f; constexpr float SC2 = 0.08838834764831845f * LOG2E;
    const int r = lane & 31, h = lane >> 5, g = wave >> 1, sub = wave & 1;
    const int ldrow = tid >> 3, ldc = tid & 7;
    for (int item = bid; item < 1024; item += G) {
        const int qhalf = item & 1, kvh = (item >> 1) & 3, n = (item >> 3) & 15, b = item >> 7;
        const int head = kvh * 4 + g, qq = qhalf * 64 + sub * 32 + r; const int qrow = b * SEQ + n * 128 + qq;
        bf16x8 qf[8];
#pragma unroll
        for (int s = 0; s < 8; ++s) qf[s] = *(const bf16x8*)(Q + (size_t)qrow * DM + head * HD + 16 * s + 8 * h);
        float m2 = sink[head] * LOG2E, lsum = 1.0f;
        f32x16 o[4];
#pragma unroll
        for (int d = 0; d < 4; ++d)
#pragma unroll
            for (int i = 0; i < 16; ++i) o[d][i] = 0.f;
        for (int ti = 0; ti < 10; ++ti) {
            int base, mtype = 0, tt = ti & 1;
            if (ti < 4) { base = ML + b * CTXL + 64 * ti; }
            else { const int blk = n - 1 + ((ti - 4) >> 1); if (blk < 0 || blk > 15) continue;
                   if (ti < 6) { mtype = 1; if (tt == 0 && qhalf == 1) continue; } else if (ti >= 8) { mtype = 2; if (tt == 1 && qhalf == 0) continue; }
                   base = b * SEQ + blk * 128 + 64 * tt; }
            __syncthreads();
#pragma unroll
            for (int c2 = 0; c2 < 2; ++c2) { const int c16 = ldc + 8 * c2;
                const u32x4 kv = *(const u32x4*)(Kb + (size_t)(base + ldrow) * 512 + kvh * HD + c16 * 8); const u32x4 vv = *(const u32x4*)(Vb + (size_t)(base + ldrow) * 512 + kvh * HD + c16 * 8);
                *(LAS u32x4*)(lds + ldrow * KP + c16 * 16) = kv; *(LAS u32x4*)(lds + ATT_VOFF + ldrow * KP + c16 * 16) = vv; }
            __syncthreads();
            f32x16 x0, x1;
#pragma unroll
            for (int i = 0; i < 16; ++i) { x0[i] = 0.f; x1[i] = 0.f; }
#pragma unroll
            for (int s = 0; s < 8; ++s) {
                const bf16x8 k0 = *(const LAS bf16x8*)(lds + r * KP + (16 * s + 8 * h) * 2), k1 = *(const LAS bf16x8*)(lds + (32 + r) * KP + (16 * s + 8 * h) * 2);
                x0 = __builtin_amdgcn_mfma_f32_32x32x16_bf16(k0, qf[s], x0, 0, 0, 0); x1 = __builtin_amdgcn_mfma_f32_32x32x16_bf16(k1, qf[s], x1, 0, 0, 0); }
            float tmax = -3.0e38f;
#pragma unroll
            for (int i = 0; i < 16; ++i) { const int kk0 = tt * 64 + crow(i, h), kk1 = kk0 + 32; float s0 = x0[i] * SC2, s1 = x1[i] * SC2;
                if (mtype == 1) { if (kk0 < qq) s0 = -1.0e30f; if (kk1 < qq) s1 = -1.0e30f; }
                if (mtype == 2) { if (kk0 > qq) s0 = -1.0e30f; if (kk1 > qq) s1 = -1.0e30f; }
                x0[i] = s0; x1[i] = s1; tmax = fmaxf(tmax, fmaxf(s0, s1)); }
            tmax = fmaxf(tmax, __shfl_xor(tmax, 32));
            const float mnew = fmaxf(m2, tmax), alpha = __builtin_amdgcn_exp2f(m2 - mnew); m2 = mnew;
            float ps = 0.f;
#pragma unroll
            for (int i = 0; i < 16; ++i) { x0[i] = __builtin_amdgcn_exp2f(x0[i] - mnew); x1[i] = __builtin_amdgcn_exp2f(x1[i] - mnew); ps += x0[i] + x1[i]; }
            ps += __shfl_xor(ps, 32); lsum = lsum * alpha + ps;
#pragma unroll
            for (int d = 0; d < 4; ++d)
#pragma unroll
                for (int i = 0; i < 16; ++i) o[d][i] *= alpha;
            bf16x8 pf[2][2];
#pragma unroll
            for (int s = 0; s < 2; ++s) {
                u32x4 a, c; a.x = pk2(x0[8 * s + 0], x0[8 * s + 1]); a.y = pk2(x0[8 * s + 2], x0[8 * s + 3]); a.z = pk2(x0[8 * s + 4], x0[8 * s + 5]); a.w = pk2(x0[8 * s + 6], x0[8 * s + 7]);
                c.x = pk2(x1[8 * s + 0], x1[8 * s + 1]); c.y = pk2(x1[8 * s + 2], x1[8 * s + 3]); c.z = pk2(x1[8 * s + 4], x1[8 * s + 5]); c.w = pk2(x1[8 * s + 6], x1[8 * s + 7]);
                pf[0][s] = __builtin_bit_cast(bf16x8, a); pf[1][s] = __builtin_bit_cast(bf16x8, c); }
            const LAS unsigned char* vb = lds + ATT_VOFF + (4 * h + ((lane & 15) >> 2)) * KP + (16 * ((lane >> 4) & 1) + 4 * (lane & 3)) * 2;
#pragma unroll
            for (int d = 0; d < 4; ++d)
#pragma unroll
                for (int t = 0; t < 2; ++t)
#pragma unroll
                    for (int s = 0; s < 2; ++s) {
                        const s16x4 lo = vtr(vb + (t * 32 + 16 * s) * KP + d * 64), hi = vtr(vb + (t * 32 + 16 * s + 8) * KP + d * 64);
                        const bf16x8 vf = (bf16x8){lo[0], lo[1], lo[2], lo[3], hi[0], hi[1], hi[2], hi[3]};
                        o[d] = __builtin_amdgcn_mfma_f32_32x32x16_bf16(vf, pf[t][s], o[d], 0, 0, 0); }
        }
        const float il = 1.0f / lsum;
        bf16_t* op = O + (size_t)qrow * DM + head * HD + 4 * h;
#pragma unroll
        for (int d = 0; d < 4; ++d)
#pragma unroll
            for (int g4 = 0; g4 < 4; ++g4) { u32x2 w; w.x = pk2(o[d][4 * g4 + 0] * il, o[d][4 * g4 + 1] * il); w.y = pk2(o[d][4 * g4 + 2] * il, o[d][4 * g4 + 3] * il);
                *(u32x2*)(op + d * 32 + 8 * g4) = w; }
    }
}

#ifndef MK_ONE_LAUNCH
#define MK_ONE_LAUNCH 1
#endif
constexpr int NPHASE = 22;
struct Args { const float* in[20]; float* out; unsigned char* ws; int ph_lo, ph_hi; };
__global__ void __launch_bounds__(512, 2) dit_fwd(Args args) {
    extern __shared__ __attribute__((aligned(16))) unsigned char lds_raw[];
    LAS unsigned char* lds = (LAS unsigned char*)lds_raw;
    const int tid = threadIdx.x, lane = tid & 63, wave = __builtin_amdgcn_readfirstlane(tid >> 6);
    const int G = gridDim.x, bid = blockIdx.x;
    const int gw = bid * 8 + wave, NGW = G * 8;
    unsigned char* ws = args.ws;
    const float* x = args.in[0]; const float* cnd = args.in[1]; const float* ctx = args.in[2]; const float* cctx = args.in[3];
    const float* ada_w = args.in[4]; const float* ada_b = args.in[5]; const float* nmix = args.in[6]; const float* nffn = args.in[7];
    const float* conv_w = args.in[9]; const float* qgain = args.in[12]; const float* kgain = args.in[13]; const float* sink = args.in[14]; const float* router_w = args.in[16];
    float* mod = (float*)(ws + WS_MOD); float* modp = (float*)(ws + WS_MODP);
    float* affL = (float*)(ws + WS_AFFL); float* affC = (float*)(ws + WS_AFFC);
    int* rowsrc = (int*)(ws + WS_ROWSRC); float* gatev = (float*)(ws + WS_GATEV); int* inv = (int*)(ws + WS_INV);
    bf16_t* W1A = (bf16_t*)(ws + WS_W1A); bf16_t* W1B = (bf16_t*)(ws + WS_W1B); bf16_t* W2 = (bf16_t*)(ws + WS_W2); bf16_t* WQKV = (bf16_t*)(ws + WS_WQKV); bf16_t* WOt = (bf16_t*)(ws + WS_WO);
    bf16_t* WGU = (bf16_t*)(ws + WS_WGU); bf16_t* WDN = (bf16_t*)(ws + WS_WDN);
    float* H = (float*)(ws + WS_H); bf16_t* A = (bf16_t*)(ws + WS_A); bf16_t* U = (bf16_t*)(ws + WS_U); bf16_t* Z = (bf16_t*)(ws + WS_Z);
    bf16_t* Qb = (bf16_t*)(ws + WS_Q); bf16_t* Kb = (bf16_t*)(ws + WS_K); bf16_t* Vb = (bf16_t*)(ws + WS_V); bf16_t* Ob = (bf16_t*)(ws + WS_O);
    bf16_t* HM = (bf16_t*)(ws + WS_HM); bf16_t* Y = (bf16_t*)(ws + WS_Y); bf16_t* XS = (bf16_t*)(ws + WS_XS);

    for (int u = tid; u < (LDS_BYTES - MISC_OFF) / 4; u += 512) ((LAS unsigned*)(lds + MISC_OFF))[u] = 0u;
    __syncthreads();
#if MK_ONE_LAUNCH
    XcdBarrier bar = xcd_barrier_post((unsigned*)(ws + WS_CTL) + CW_BAR, (volatile LAS unsigned*)(lds + MISC_OFF) + 8);
#define GRID_BAR() xcd_barrier(bar)
#else
#define GRID_BAR() do {} while (0)
#endif
    const int lo = args.ph_lo, hi = args.ph_hi;
#define IN(k) (lo <= (k) && (k) < hi)
#define SEAM(k) do { if (IN(k) && IN((k) + 1)) GRID_BAR(); } while (0)

    if (IN(0)) {
        ph_adaln(cnd, cctx, ada_w, modp, gw, NGW, lane);
        CvtPtrs P; P.cin = args.in[8]; P.cout = args.in[10]; P.wqkv = args.in[11]; P.wo = args.in[15]; P.wg = args.in[17]; P.wu = args.in[18]; P.wd = args.in[19];
        P.W1A = W1A; P.W1B = W1B; P.W2 = W2; P.WQKV = WQKV; P.WO = WOt; P.WGU = WGU; P.WDN = WDN;
        ph_convert(P, (LAS float*)(lds + wave * 16640), gw, NGW, lane);
    } SEAM(0);
    if (IN(1)) { ph_modred(modp, ada_b, mod, bid * 512 + tid, G * 512); } SEAM(1);
    if (IN(2)) { ph_mod0(x, ctx, nmix, mod, A, gw, NGW, lane); } SEAM(2);
    if (IN(3)) {
        pg8::Gemm g{A, W1A, MT, 4096, DM}; pg8::StaticOrder S; S.init(MT, 4096, G, bid);
        EpiPair<0> E{U, DM, 16};
        pg8::gemm_phase<EpiPair<0>, pg8::StaticOrder, true, true>(lds, g, S, E);
    } SEAM(3);
    if (IN(4)) {
        pg8::Gemm g{A, W1B, MT, DM, DM}; pg8::StaticOrder S; S.init(MT, DM, G, bid);
        EpiConvGate E{U, Z, conv_w};
        pg8::gemm_phase<EpiConvGate, pg8::StaticOrder, true, true>(lds, g, S, E);
    } SEAM(4);
    if (IN(5)) {
        pg8::Gemm g{Z, W2, MT, DM, DM}; pg8::StaticOrder S; S.init(MT, DM, G, bid);
        EpiResid E{x, ctx, H, mod + 2 * DM};
        pg8::gemm_phase<EpiResid, pg8::StaticOrder, true, true>(lds, g, S, E);
    } SEAM(5);
    if (IN(6)) { load_router(router_w, (LAS float*)lds, tid); ph_modffn(H, nffn, mod, A, (const LAS float*)lds, affL, affC, MT, gw, NGW, lane); } SEAM(6);
    if (IN(7)) { ph_topk(256, affL, affC, rowsrc, gatev, inv, (LAS unsigned*)lds, tid, lane, wave, bid, G); } SEAM(7);
    if (IN(8)) { ph_gather(A, rowsrc, XS, true, gw, NGW, lane); } SEAM(8);
    if (IN(9)) {
        pg8::Gemm g{XS, WGU, YT, NE * 2048, DM}; MoeOrder S{G, bid, 9};
        EpiPair<1> E{HM, DFF, 8};
        pg8::gemm_phase<EpiPair<1>, MoeOrder, true, true>(lds, g, S, E);
    } SEAM(9);
    if (IN(10)) {
        pg8::Gemm g{HM, WDN, YT, NE * 2048, DFF}; MoeOrder S{G, bid, 9};
        EpiDown E{Y, gatev};
        pg8::gemm_phase<EpiDown, MoeOrder, true, true>(lds, g, S, E);
    } SEAM(10);
    if (IN(11)) { ph_combine<false>(H, Y, inv, mod, nmix + DM, mod + 9 * NMOD, A, nullptr, MT, gw, NGW, lane); } SEAM(11);
    if (IN(12)) {
        pg8::Gemm g{A, WQKV, MT, 3072, DM}; QkvOrder S{G, bid};
        EpiQkv E{Qb, Kb, Vb};
        pg8::gemm_phase<EpiQkv, QkvOrder, true, true>(lds, g, S, E);
    } SEAM(12);
    if (IN(13)) { ph_qknorm(Qb, Kb, qgain, kgain, gw, NGW, lane); } SEAM(13);
    if (IN(14)) { ph_attn(Qb, Kb, Vb, Ob, sink, lds, tid, lane, wave, bid, G); } SEAM(14);
    if (IN(15)) {
        pg8::Gemm g{Ob, WOt, ML, DM, DM}; pg8::StaticOrder S; S.init(ML, DM, G, bid);
        EpiResid E{H, H + (size_t)ML * DM, H, mod + 9 * NMOD + 2 * DM};
        pg8::gemm_phase<EpiResid, pg8::StaticOrder, true, true>(lds, g, S, E);
    } SEAM(15);
    if (IN(16)) { load_router(router_w + DM * 16, (LAS float*)lds, tid); ph_modffn(H, nffn + DM, mod + 9 * NMOD, A, (const LAS float*)lds, affL, affC, ML, gw, NGW, lane); } SEAM(16);
    if (IN(17)) { ph_topk(128, affL, affC, rowsrc, gatev, inv, (LAS unsigned*)lds, tid, lane, wave, bid, G); } SEAM(17);
    if (IN(18)) { ph_gather(A, rowsrc, XS, false, gw, NGW, lane); } SEAM(18);
    if (IN(19)) {
        pg8::Gemm g{XS, WGU + (size_t)NE * 2048 * DM, YT, NE * 2048, DM}; MoeOrder S{G, bid, 8};
        EpiPair<1> E{HM, DFF, 8};
        pg8::gemm_phase<EpiPair<1>, MoeOrder, true, true>(lds, g, S, E);
    } SEAM(19);
    if (IN(20)) {
        pg8::Gemm g{HM, WDN + (size_t)NE * 2048 * DFF, YT, NE * 2048, DFF}; MoeOrder S{G, bid, 8};
        EpiDown E{Y, gatev};
        pg8::gemm_phase<EpiDown, MoeOrder, true, true>(lds, g, S, E);
    } SEAM(20);
    if (IN(21)) { ph_combine<true>(H, Y, inv, mod + 9 * NMOD, nullptr, nullptr, nullptr, args.out, ML, gw, NGW, lane); }
#undef IN
#undef SEAM
}

extern "C" void kernel_launch(void* const* d_in, const int* in_sizes, int n_in, void* d_out, int out_size, void* d_ws, size_t ws_size, hipStream_t stream) {
    static int grid = 0;
    if (grid == 0) {
        if (n_in != 20 || out_size != ML * DM || ws_size < WS_END) { fprintf(stderr, "kernel_launch: unexpected problem (n_in %d, out %d, ws %zu); nothing launched\n", n_in, out_size, ws_size); grid = -1; return; }
        int dev = 0, cus = 0, per_cu = 0;
        if (hipGetDevice(&dev) != hipSuccess || hipDeviceGetAttribute(&cus, hipDeviceAttributeMultiprocessorCount, dev) != hipSuccess) { grid = -1; return; }
        if (hipFuncSetAttribute((const void*)dit_fwd, hipFuncAttributeMaxDynamicSharedMemorySize, LDS_BYTES) != hipSuccess) { fprintf(stderr, "kernel_launch: hipFuncSetAttribute failed\n"); grid = -1; return; }
        if (hipOccupancyMaxActiveBlocksPerMultiprocessor(&per_cu, (const void*)dit_fwd, 512, LDS_BYTES) != hipSuccess || per_cu < 1) fprintf(stderr, "kernel_launch: occupancy query reports %d workgroups per CU\n", per_cu);
        (void)hipGetLastError();
        grid = cus;
    }
    if (grid < 0) return;
    (void)hipMemsetAsync((char*)d_ws + WS_CTL, 0, CTL_ZERO_BYTES, stream);
    Args a{};
    for (int i = 0; i < 20; ++i) a.in[i] = (const float*)d_in[i];
    a.out = (float*)d_out; a.ws = (unsigned char*)d_ws;
#if MK_ONE_LAUNCH
    a.ph_lo = 0; a.ph_hi = NPHASE;
    hipLaunchKernelGGL(dit_fwd, dim3(grid), dim3(512), LDS_BYTES, stream, a);
#else
    for (int p = 0; p < NPHASE; ++p) { a.ph_lo = p; a.ph_hi = p + 1; hipLaunchKernelGGL(dit_fwd, dim3(grid), dim3(512), LDS_BYTES, stream, a); }
#endif
}
```

```cpp
#include <hip/hip_runtime.h>
#include <cstdio>
#include <cstdint>
namespace pg8 {
#define PG8_LAS __attribute__((address_space(3)))
typedef unsigned short bf16_t;
typedef short bf16x8 __attribute__((ext_vector_type(8)));
typedef float f32x4 __attribute__((ext_vector_type(4)));
typedef unsigned u32x4 __attribute__((ext_vector_type(4)));
constexpr int BM = 256, BK = 64, HALF = 128, HTB = HALF * BK * 2  , STAGE_BYTES = 8 * HTB, NXCD = 8, WGM = 8;

__host__ __device__ __forceinline__ int lds_byte(int r, int c) { const int st = (r >> 4) * 2 + (c >> 5), rr = r & 15, cc = c & 31, ob = rr * 64 + cc * 2; return st * 1024 + (ob ^ (((ob >> 9) & 1) << 5)); }
__host__ __device__ __forceinline__ void stage_rc(int b, int& R, int& C) { const int st = b / 1024, sb = b % 1024, swz = sb ^ (((sb >> 9) & 1) << 5); R = (st >> 1) * 16 + swz / 64; C = (st & 1) * 32 + (swz % 64) / 2; }
__host__ __device__ __forceinline__ int perm32(int rho) { const int n = rho >> 4, i = rho & 15; return 8 * (i >> 2) + 4 * n + (i & 3); }

struct Unit { int pm, pn; };
struct Gemm { const bf16_t* A; const bf16_t* Bt; int M, N, K; const int* rows = nullptr; };

struct StaticOrder {
    int nM, nN, nwg, G, c;
    __host__ __device__ void init(int M, int N, int G_, int c_) { nM = M / BM; nN = N / BM; nwg = nM * nN; G = G_; c = c_; }
    __host__ __device__ bool next(int i, Unit& u) const {
        const long L = (long)i * G + c; if (L >= nwg) return false;
        int wgid = (int)L; { const int q = nwg / NXCD, r = nwg % NXCD, xcd = wgid % NXCD, off = wgid / NXCD; wgid = (xcd < r ? xcd * (q + 1) : r * (q + 1) + (xcd - r) * q) + off; }
        const int nig = WGM * nN, gid = wgid / nig, fm = gid * WGM, gsz = (nM - fm) < WGM ? (nM - fm) : WGM;
        u.pm = fm + ((wgid % nig) % gsz); u.pn = (wgid % nig) / gsz; return true;
    }
    __device__ __forceinline__ void a_ready(const Unit&) const {}
    __device__ __forceinline__ void done(const Unit&) const {}
};
__device__ __forceinline__ unsigned cvt_pk_bf16(float lo, float hi) { unsigned r; asm volatile("v_cvt_pk_bf16_f32 %0, %1, %2" : "=v"(r) : "v"(lo), "v"(hi)); return r; }
typedef float f32x2 __attribute__((ext_vector_type(2)));
template <class Epi, class Sched, bool ALIGN_EPI = false, bool SP2 = false, bool GATHER = false>
__device__ __forceinline__ void gemm_phase(PG8_LAS unsigned char* lds, const Gemm g, const Sched& S, const Epi& E) {
    const int tid = threadIdx.x, wid = __builtin_amdgcn_readfirstlane(tid >> 6), lane = tid & 63, wr = wid >> 2, wc = wid & 3, fr = lane & 15, fq = lane >> 4;
    const int K = g.K, nt = K / BK;
    unsigned voffA[2], voffB[2];
#pragma unroll
    for (int i = 0; i < 2; ++i) { int R, C; stage_rc(tid * 16 + i * 8192, R, C); const int Rb = Epi::PERM ? ((R & ~31) + perm32(R & 31)) : R;
        voffA[i] = (unsigned)(R * K + C) * 2u; voffB[i] = (unsigned)(Rb * K + C) * 2u; }
    const size_t kstep = (size_t)(BK * 2);
    const size_t hstep = (size_t)HALF * K * 2;
    const size_t tstep = 2 * hstep;
    const unsigned ldsw = (unsigned)wid * 1024u;
    const int aoff = lds_byte(wr * 64 + fr, fq * 8), boff = lds_byte(wc * 32 + fr, fq * 8);
#define PG8_SA(b, h) (((b) * 2 + (h)) * HTB)
#define PG8_SB(b, h) ((4 + (b) * 2 + (h)) * HTB)
#define PG8_STAGE(bufoff, gbase, voff) do { _Pragma("unroll") for (int _i = 0; _i < 2; ++_i) \
        __builtin_amdgcn_global_load_lds((const unsigned*)((const char*)(gbase) + (voff)[_i]), (PG8_LAS unsigned*)(lds + (bufoff) + ldsw + _i * 8192), 16, 0, 0); } while (0)
#define PG8_STAGE_A(bufoff, kptr, h) do { if constexpr (GATHER) { PG8_STAGE(bufoff, kptr, vA[h]); } else { PG8_STAGE(bufoff, (kptr) + (h) * hstep, voffA); } } while (0)
#define PG8_GATHER_SWITCH() do { if constexpr (GATHER) { if (last && has_next) { asm volatile("" : "+v"(nv[0]), "+v"(nv[1]), "+v"(nv[2]), "+v"(nv[3])); \
        vA[0][0] = nv[0] * (unsigned)(K * 2) + gcoff[0]; vA[0][1] = nv[1] * (unsigned)(K * 2) + gcoff[1]; vA[1][0] = nv[2] * (unsigned)(K * 2) + gcoff[0]; vA[1][1] = nv[3] * (unsigned)(K * 2) + gcoff[1]; } } } while (0)
#define PG8_LDA(dst, b, h) do { _Pragma("unroll") for (int m = 0; m < 4; ++m) _Pragma("unroll") for (int k = 0; k < 2; ++k) dst[m][k] = *(const PG8_LAS bf16x8*)(lds + PG8_SA(b, h) + aoff + m * 2048 + k * 1024); } while (0)
#define PG8_LDB(dst, b, h) do { _Pragma("unroll") for (int n = 0; n < 2; ++n) _Pragma("unroll") for (int k = 0; k < 2; ++k) dst[n][k] = *(const PG8_LAS bf16x8*)(lds + PG8_SB(b, h) + boff + n * 2048 + k * 1024); } while (0)
#define PG8_MMA(ai, bj, At, Bt) do { __builtin_amdgcn_s_setprio(1); _Pragma("unroll") for (int m = 0; m < 4; ++m) _Pragma("unroll") for (int n = 0; n < 2; ++n) _Pragma("unroll") for (int k = 0; k < 2; ++k) \
        acc[ai][bj][m][n] = __builtin_amdgcn_mfma_f32_16x16x32_bf16(Bt[n][k], At[m][k], acc[ai][bj][m][n], 0, 0, 0); __builtin_amdgcn_s_setprio(0); } while (0)
#define PG8_WAIT_V(n) asm volatile("s_waitcnt vmcnt(" #n ")" ::: "memory")
#define PG8_WAIT_L(n) asm volatile("s_waitcnt lgkmcnt(" #n ")" ::: "memory")
#define PG8_BAR __builtin_amdgcn_s_barrier()
#define PG8_SCHED __builtin_amdgcn_sched_barrier(0)
    Unit cur, nxt; int ui = 0;
    if (!S.next(0, cur)) return;
    f32x4 acc[2][2][4][2];
#pragma unroll
    for (int a = 0; a < 2; ++a)
#pragma unroll
        for (int b = 0; b < 2; ++b)
#pragma unroll
            for (int m = 0; m < 4; ++m)
#pragma unroll
                for (int n = 0; n < 2; ++n) acc[a][b][m][n] = (f32x4){0.f, 0.f, 0.f, 0.f};
    bf16x8 At[4][2], B0[2][2], B1[2][2];
    const char* cA = (const char*)g.A + (GATHER ? (size_t)0 : (size_t)cur.pm * tstep); const char* cB = (const char*)g.Bt + (size_t)cur.pn * tstep;
    unsigned vA[2][2], nv[4], gcoff[2]; int grow[2];
    if constexpr (GATHER) {
#pragma unroll
        for (int i = 0; i < 2; ++i) { int R, C; stage_rc(tid * 16 + i * 8192, R, C); grow[i] = R; gcoff[i] = (unsigned)(C * 2); }
#pragma unroll
        for (int h = 0; h < 2; ++h)
#pragma unroll
            for (int i = 0; i < 2; ++i) vA[h][i] = (unsigned)g.rows[cur.pm * BM + h * HALF + grow[i]] * (unsigned)(K * 2) + gcoff[i];
    }
    S.a_ready(cur);
    if constexpr (SP2) {
        PG8_STAGE(PG8_SB(0, 0), cB, voffB); PG8_STAGE(PG8_SB(0, 1), cB + hstep, voffB); PG8_STAGE_A(PG8_SA(0, 0), cA, 0); PG8_STAGE_A(PG8_SA(0, 1), cA, 1);
        if (wr == 1) PG8_BAR;
        PG8_WAIT_V(2); PG8_BAR;
        PG8_STAGE(PG8_SB(1, 0), cB + kstep, voffB); PG8_STAGE_A(PG8_SA(1, 0), cA + kstep, 0); PG8_STAGE(PG8_SB(1, 1), cB + hstep + kstep, voffB);
        PG8_WAIT_V(6); PG8_BAR;
    } else {
        PG8_STAGE(PG8_SB(0, 0), cB, voffB); PG8_STAGE_A(PG8_SA(0, 0), cA, 0); PG8_STAGE(PG8_SB(0, 1), cB + hstep, voffB); PG8_STAGE_A(PG8_SA(0, 1), cA, 1);
        if (wr == 1) PG8_BAR;
        PG8_WAIT_V(4); PG8_BAR;
        PG8_STAGE(PG8_SB(1, 0), cB + kstep, voffB); PG8_STAGE_A(PG8_SA(1, 0), cA + kstep, 0); PG8_STAGE(PG8_SB(1, 1), cB + hstep + kstep, voffB);
        PG8_WAIT_V(6); PG8_BAR;
    }
    for (;;) {
        const bool has_next = S.next(ui + 1, nxt);
        const char* nA = (has_next && !GATHER) ? (const char*)g.A + (size_t)nxt.pm * tstep : cA; const char* nB = has_next ? (const char*)g.Bt + (size_t)nxt.pn * tstep : cB;
        if constexpr (GATHER) { if (has_next) { const int* rp = g.rows + nxt.pm * BM;
            asm volatile("global_load_dword %0, %1, off" : "=&v"(nv[0]) : "v"(rp + grow[0]) : "memory"); asm volatile("global_load_dword %0, %1, off" : "=&v"(nv[1]) : "v"(rp + grow[1]) : "memory");
            asm volatile("global_load_dword %0, %1, off" : "=&v"(nv[2]) : "v"(rp + HALF + grow[0]) : "memory"); asm volatile("global_load_dword %0, %1, off" : "=&v"(nv[3]) : "v"(rp + HALF + grow[1]) : "memory"); } }
        for (int t = 0; t < nt; t += 2) {
            const bool last = (t == nt - 2);
            const char* a1 = cA + (size_t)(t + 1) * kstep;
            const char* a2 = last ? nA : cA + (size_t)(t + 2) * kstep; const char* b2 = last ? nB : cB + (size_t)(t + 2) * kstep;
            const char* a3 = a2 + kstep; const char* b3 = b2 + kstep;
            if (last && has_next) S.a_ready(nxt);
            if constexpr (SP2) {
            PG8_LDB(B0, 0, 0); PG8_LDB(B1, 0, 1); PG8_SCHED; PG8_LDA(At, 0, 0); PG8_STAGE_A(PG8_SA(1, 1), a1, 1); PG8_GATHER_SWITCH();
            PG8_WAIT_V(8); PG8_WAIT_L(0); PG8_BAR; PG8_MMA(0, 0, At, B0); PG8_MMA(0, 1, At, B1); PG8_BAR; PG8_SCHED;
            PG8_LDA(At, 0, 1); PG8_STAGE(PG8_SB(0, 0), b2, voffB); PG8_STAGE(PG8_SB(0, 1), b2 + hstep, voffB); PG8_STAGE_A(PG8_SA(0, 0), a2, 0);
            PG8_WAIT_V(8); PG8_WAIT_L(0); PG8_BAR; PG8_MMA(1, 0, At, B0); PG8_MMA(1, 1, At, B1); PG8_BAR; PG8_SCHED;
            PG8_LDB(B0, 1, 0); PG8_LDB(B1, 1, 1); PG8_SCHED; PG8_LDA(At, 1, 0); PG8_STAGE_A(PG8_SA(0, 1), a2, 1);
            PG8_WAIT_V(8); PG8_WAIT_L(0); PG8_BAR; PG8_MMA(0, 0, At, B0); PG8_MMA(0, 1, At, B1); PG8_BAR; PG8_SCHED;
            PG8_LDA(At, 1, 1); PG8_STAGE(PG8_SB(1, 0), b3, voffB); PG8_STAGE(PG8_SB(1, 1), b3 + hstep, voffB); PG8_STAGE_A(PG8_SA(1, 0), a3, 0);
            PG8_WAIT_V(8); PG8_WAIT_L(0); PG8_BAR; PG8_MMA(1, 0, At, B0); PG8_MMA(1, 1, At, B1); PG8_BAR; PG8_SCHED;
            } else {
            PG8_LDB(B0, 0, 0); PG8_SCHED; PG8_LDA(At, 0, 0); PG8_STAGE_A(PG8_SA(1, 1), a1, 1); PG8_GATHER_SWITCH();
            PG8_WAIT_L(8); PG8_BAR; PG8_WAIT_L(0); PG8_MMA(0, 0, At, B0); PG8_BAR; PG8_SCHED;
            PG8_LDB(B1, 0, 1); PG8_STAGE(PG8_SB(0, 0), b2, voffB);
            PG8_BAR; PG8_WAIT_L(0); PG8_MMA(0, 1, At, B1); PG8_BAR;
            PG8_LDA(At, 0, 1); PG8_STAGE_A(PG8_SA(0, 0), a2, 0);
            PG8_BAR; PG8_WAIT_L(0); PG8_MMA(1, 0, At, B0); PG8_BAR; PG8_SCHED;
            PG8_STAGE(PG8_SB(0, 1), b2 + hstep, voffB);
            PG8_WAIT_V(6); PG8_BAR; PG8_MMA(1, 1, At, B1); PG8_BAR;
            PG8_LDB(B0, 1, 0); PG8_SCHED; PG8_LDA(At, 1, 0); PG8_STAGE_A(PG8_SA(0, 1), a2, 1);
            PG8_WAIT_L(8); PG8_BAR; PG8_WAIT_L(0); PG8_MMA(0, 0, At, B0); PG8_BAR; PG8_SCHED;
            PG8_LDB(B1, 1, 1); PG8_STAGE(PG8_SB(1, 0), b3, voffB);
            PG8_BAR; PG8_WAIT_L(0); PG8_MMA(0, 1, At, B1); PG8_BAR;
            PG8_LDA(At, 1, 1); PG8_STAGE_A(PG8_SA(1, 0), a3, 0);
            PG8_BAR; PG8_WAIT_L(0); PG8_MMA(1, 0, At, B0); PG8_BAR; PG8_SCHED;
            PG8_STAGE(PG8_SB(1, 1), b3 + hstep, voffB);
            PG8_WAIT_V(6); PG8_BAR; PG8_MMA(1, 1, At, B1); PG8_BAR;
            }
        }
        if constexpr (ALIGN_EPI) { if (wr == 0) PG8_BAR; }
        if constexpr (!Epi::AFTER_DRAIN) { E(acc, cur, wr, wc, fr, fq); S.done(cur); }
        if (!has_next) break;
#pragma unroll
        for (int a = 0; a < 2; ++a)
#pragma unroll
            for (int b = 0; b < 2; ++b)
#pragma unroll
                for (int m = 0; m < 4; ++m)
#pragma unroll
                    for (int n = 0; n < 2; ++n) acc[a][b][m][n] = (f32x4){0.f, 0.f, 0.f, 0.f};
        cur = nxt; cA = nA; cB = nB; ++ui;
        if constexpr (ALIGN_EPI) { if (wr == 1) PG8_BAR; }
    }
    PG8_WAIT_V(0);
    if constexpr (!ALIGN_EPI) { if (wr == 0) PG8_BAR; }
    PG8_BAR;
    if constexpr (Epi::AFTER_DRAIN) { E.fused(acc, cur, wr, wc, fr, fq, lds, wid, lane); S.done(cur); }
#undef PG8_SA
#undef PG8_SB
#undef PG8_STAGE
#undef PG8_STAGE_A
#undef PG8_GATHER_SWITCH
#undef PG8_LDA
#undef PG8_LDB
#undef PG8_MMA
#undef PG8_WAIT_V
#undef PG8_WAIT_L
#undef PG8_BAR
#undef PG8_SCHED
}
}

constexpr int DM = 2048, NB = 8, SEQ = 2048, CTXL = 256, NH = 16, NKV = 4, HD = 128;
constexpr int ML = NB * SEQ;
constexpr int MC = NB * CTXL;
constexpr int MT = ML + MC;
constexpr int NE = 16, CAPL = 256, CAPC = 32, DFF = 1024;
constexpr int YR = NB * CAPL + NB * CAPC;
constexpr int YT = NE * YR;
constexpr int NMOD = 6 * DM;
constexpr float NORM_EPS = 1e-6f;
constexpr int KSPLIT = 16;

using pg8::Unit; using pg8::f32x4; using pg8::u32x4; using pg8::bf16_t; using pg8::bf16x8; using pg8::cvt_pk_bf16;
typedef float f32x2 __attribute__((ext_vector_type(2)));
typedef unsigned u32x2 __attribute__((ext_vector_type(2)));
typedef float f32x16 __attribute__((ext_vector_type(16)));
typedef short s16x4 __attribute__((ext_vector_type(4)));
#define DI __device__ __forceinline__

DI float bf_lo(unsigned w) { return __uint_as_float(w << 16); }
DI float bf_hi(unsigned w) { return __uint_as_float(w & 0xffff0000u); }
DI float silu_f(float a) { return a * __builtin_amdgcn_rcpf(1.0f + __expf(-a)); }

DI int xcd_remap(int wgid, int nwg) { const int q = nwg / 8, r = nwg % 8, xcd = wgid % 8, off = wgid / 8; return (xcd < r ? xcd * (q + 1) : r * (q + 1) + (xcd - r) * q) + off; }
struct QkvOrder {
    int G, c;
    DI bool next(int i, Unit& u) const {
        const int L = i * G + c; if (L >= 800) return false;
        if (L < 768) { const int w = xcd_remap(L, 768); const int nig = 8 * 12, gid = w / nig; u.pm = gid * 8 + ((w % nig) % 8); u.pn = (w % nig) / 8; }
        else { const int j = L - 768; u.pm = 64 + (j >> 2); u.pn = 8 + (j & 3); }
        return true;
    }
    DI void a_ready(const Unit&) const {}
    DI void done(const Unit&) const {}
};
struct MoeOrder {
    int G, c, NP;
    DI bool next(int i, Unit& u) const {
        const int nwg = NE * NP * 8; const int L = i * G + c; if (L >= nwg) return false;
        const int w = xcd_remap(L, nwg); const int per = NP * 8, e = w / per, rem = w % per;
        u.pm = e * 9 + (rem % NP); u.pn = e * 8 + (rem / NP); return true;
    }
    DI void a_ready(const Unit&) const {}
    DI void done(const Unit&) const {}
};

template <int ACT  > struct EpiPair {
    static constexpr bool PERM = true, AFTER_DRAIN = false;
    bf16_t* O; int ldc; int pn_mod;
    DI void operator()(const f32x4 (&acc)[2][2][4][2], const Unit& u, int wr, int wc, int fr, int fq) const {
        const int row0 = u.pm * 256 + wr * 64 + fr, col0 = (u.pn % pn_mod) * 128 + wc * 32 + 8 * fq;
#pragma unroll
        for (int ai = 0; ai < 2; ++ai)
#pragma unroll
            for (int m = 0; m < 4; ++m) {
                bf16_t* rowp = O + (size_t)(row0 + ai * 128 + m * 16) * ldc + col0;
                f32x4 a0 = acc[ai][0][m][0], a1 = acc[ai][0][m][1]; const f32x4 b0 = acc[ai][1][m][0], b1 = acc[ai][1][m][1];
                if (ACT == 1) {
#pragma unroll
                    for (int j = 0; j < 4; ++j) { a0[j] = silu_f(a0[j]); a1[j] = silu_f(a1[j]); } }
                const f32x4 v0 = a0 * b0, v1 = a1 * b1;
                u32x4 w; w.x = cvt_pk_bf16(v0[0], v0[1]); w.y = cvt_pk_bf16(v0[2], v0[3]); w.z = cvt_pk_bf16(v1[0], v1[1]); w.w = cvt_pk_bf16(v1[2], v1[3]);
                *(u32x4*)rowp = w;
            }
    }
};
struct EpiConvGate {
    static constexpr bool PERM = true, AFTER_DRAIN = false;
    const bf16_t* U; bf16_t* Z; const float* cw;
    DI void operator()(const f32x4 (&acc)[2][2][4][2], const Unit& u, int wr, int wc, int fr, int fq) const {
        const int row0 = u.pm * 256 + wr * 64 + fr, col0 = u.pn * 256 + wc * 32 + 8 * fq;
#pragma unroll
        for (int bj = 0; bj < 2; ++bj) {
            const int c = col0 + bj * 128;
            f32x4 w0a = *(const f32x4*)(cw + c), w0b = *(const f32x4*)(cw + c + 4), w1a = *(const f32x4*)(cw + 2048 + c), w1b = *(const f32x4*)(cw + 2048 + c + 4), w2a = *(const f32x4*)(cw + 4096 + c), w2b = *(const f32x4*)(cw + 4096 + c + 4);
#pragma unroll
            for (int ai = 0; ai < 2; ++ai)
#pragma unroll
                for (int m = 0; m < 4; ++m) {
                    const int row = row0 + ai * 128 + m * 16;
                    const int tpos = row < ML ? (row & (SEQ - 1)) : ((row - ML) & (CTXL - 1)); const int len = row < ML ? SEQ : CTXL;
                    const u32x4 z4 = (u32x4){0u, 0u, 0u, 0u};
                    const u32x4 uc = *(const u32x4*)(U + (size_t)row * DM + c);
                    const u32x4 up = tpos > 0 ? *(const u32x4*)(U + (size_t)(row - 1) * DM + c) : z4;
                    const u32x4 un = tpos < len - 1 ? *(const u32x4*)(U + (size_t)(row + 1) * DM + c) : z4;
                    f32x4 ya, yb;
                    ya[0] = w0a[0] * bf_lo(up.x) + w1a[0] * bf_lo(uc.x) + w2a[0] * bf_lo(un.x); ya[1] = w0a[1] * bf_hi(up.x) + w1a[1] * bf_hi(uc.x) + w2a[1] * bf_hi(un.x);
                    ya[2] = w0a[2] * bf_lo(up.y) + w1a[2] * bf_lo(uc.y) + w2a[2] * bf_lo(un.y); ya[3] = w0a[3] * bf_hi(up.y) + w1a[3] * bf_hi(uc.y) + w2a[3] * bf_hi(un.y);
                    yb[0] = w0b[0] * bf_lo(up.z) + w1b[0] * bf_lo(uc.z) + w2b[0] * bf_lo(un.z); yb[1] = w0b[1] * bf_hi(up.z) + w1b[1] * bf_hi(uc.z) + w2b[1] * bf_hi(un.z);
                    yb[2] = w0b[2] * bf_lo(up.w) + w1b[2] * bf_lo(uc.w) + w2b[2] * bf_lo(un.w); yb[3] = w0b[3] * bf_hi(up.w) + w1b[3] * bf_hi(uc.w) + w2b[3] * bf_hi(un.w);
                    const f32x4 v0 = acc[ai][bj][m][0] * ya, v1 = acc[ai][bj][m][1] * yb;
                    u32x4 w; w.x = cvt_pk_bf16(v0[0], v0[1]); w.y = cvt_pk_bf16(v0[2], v0[3]); w.z = cvt_pk_bf16(v1[0], v1[1]); w.w = cvt_pk_bf16(v1[2], v1[3]);
                    *(u32x4*)(Z + (size_t)row * DM + c) = w;
                }
        }
    }
};
struct EpiResid {
    static constexpr bool PERM = false, AFTER_DRAIN = false;
    const float* base_lat; const float* base_ctx; float* out; const float* gate;
    DI void operator()(const f32x4 (&acc)[2][2][4][2], const Unit& u, int wr, int wc, int fr, int fq) const {
        const int rowt = u.pm * 256; const int cr = rowt < ML ? (rowt >> 11) : 8;
        const float* base = rowt < ML ? base_lat : base_ctx - (size_t)ML * DM;
        const int row0 = rowt + wr * 64 + fr, col0 = u.pn * 256 + wc * 32 + 4 * fq;
        f32x4 gv[2][2];
#pragma unroll
        for (int bj = 0; bj < 2; ++bj)
#pragma unroll
            for (int n = 0; n < 2; ++n) gv[bj][n] = *(const f32x4*)(gate + (size_t)cr * NMOD + col0 + bj * 128 + n * 16);
#pragma unroll
        for (int ai = 0; ai < 2; ++ai)
#pragma unroll
            for (int m = 0; m < 4; ++m) { const size_t off = (size_t)(row0 + ai * 128 + m * 16) * DM + col0;
#pragma unroll
                for (int bj = 0; bj < 2; ++bj)
#pragma unroll
                    for (int n = 0; n < 2; ++n) { const f32x4 bs = *(const f32x4*)(base + off + bj * 128 + n * 16); *(f32x4*)(out + off + bj * 128 + n * 16) = bs + gv[bj][n] * acc[ai][bj][m][n]; }
                asm volatile("" ::: "memory"); }
    }
};
struct EpiDown {
    static constexpr bool PERM = true, AFTER_DRAIN = false;
    bf16_t* Y; const float* gatev;
    DI void operator()(const f32x4 (&acc)[2][2][4][2], const Unit& u, int wr, int wc, int fr, int fq) const {
        const int row0 = u.pm * 256 + wr * 64 + fr, col0 = (u.pn & 7) * 256 + wc * 32 + 8 * fq;
#pragma unroll
        for (int ai = 0; ai < 2; ++ai)
#pragma unroll
            for (int m = 0; m < 4; ++m) { const int row = row0 + ai * 128 + m * 16; const float gt = gatev[row];
#pragma unroll
                for (int bj = 0; bj < 2; ++bj) { const f32x4 v0 = acc[ai][bj][m][0] * gt, v1 = acc[ai][bj][m][1] * gt;
                    u32x4 w; w.x = cvt_pk_bf16(v0[0], v0[1]); w.y = cvt_pk_bf16(v0[2], v0[3]); w.z = cvt_pk_bf16(v1[0], v1[1]); w.w = cvt_pk_bf16(v1[2], v1[3]);
                    *(u32x4*)(Y + (size_t)row * DM + col0 + bj * 128) = w; } }
    }
};
struct EpiQkv {
    static constexpr bool PERM = true, AFTER_DRAIN = false;
    bf16_t* Q; bf16_t* K; bf16_t* V;
    DI void operator()(const f32x4 (&acc)[2][2][4][2], const Unit& u, int wr, int wc, int fr, int fq) const {
        const int row0 = u.pm * 256 + wr * 64 + fr; int colt = u.pn * 256; bf16_t* base; int ld;
        if (colt < 2048) { base = Q; ld = 2048; } else if (colt < 2560) { base = K; ld = 512; colt -= 2048; } else { base = V; ld = 512; colt -= 2560; }
        const int col0 = colt + wc * 32 + 8 * fq;
#pragma unroll
        for (int ai = 0; ai < 2; ++ai)
#pragma unroll
            for (int m = 0; m < 4; ++m) { bf16_t* rowp = base + (size_t)(row0 + ai * 128 + m * 16) * ld + col0;
#pragma unroll
                for (int bj = 0; bj < 2; ++bj) { const f32x4 v0 = acc[ai][bj][m][0], v1 = acc[ai][bj][m][1];
                    u32x4 w; w.x = cvt_pk_bf16(v0[0], v0[1]); w.y = cvt_pk_bf16(v0[2], v0[3]); w.z = cvt_pk_bf16(v1[0], v1[1]); w.w = cvt_pk_bf16(v1[2], v1[3]);
                    *(u32x4*)(rowp + bj * 128) = w; } }
    }
};

constexpr size_t MiB = 1u << 20;
constexpr size_t WS_CTL = 0, CTL_ZERO_BYTES = 1 * MiB;
constexpr size_t WS_MOD = 1 * MiB;
constexpr size_t WS_MODP = 2 * MiB;
constexpr size_t WS_AFFL = 16 * MiB;
constexpr size_t WS_AFFC = 17 * MiB;
constexpr size_t WS_ROWSRC = 17 * MiB + 512 * 1024;
constexpr size_t WS_GATEV = 18 * MiB;
constexpr size_t WS_INV = 18 * MiB + 512 * 1024;
constexpr size_t WS_W1A = 20 * MiB;
constexpr size_t WS_W1B = 36 * MiB;
constexpr size_t WS_W2 = 44 * MiB;
constexpr size_t WS_WQKV = 52 * MiB;
constexpr size_t WS_WO = 64 * MiB;
constexpr size_t WS_WGU = 72 * MiB;
constexpr size_t WS_WDN = 328 * MiB;
constexpr size_t WS_H = 456 * MiB;
constexpr size_t WS_A = 600 * MiB;
constexpr size_t WS_U = 672 * MiB;
constexpr size_t WS_Z = 744 * MiB;
constexpr size_t WS_Q = WS_U, WS_K = WS_Z, WS_V = WS_Z + 18 * MiB;
constexpr size_t WS_HM = 816 * MiB;
constexpr size_t WS_O = WS_HM;
constexpr size_t WS_Y = 888 * MiB;
constexpr size_t WS_XS = WS_Y;
constexpr size_t WS_END = 1032 * MiB;
constexpr int CW_BAR = 4096;

constexpr int RING_BYTES = 131072;
constexpr int MISC_OFF = RING_BYTES + 14336;
constexpr int LDS_BYTES = 147456;

#define GAS __attribute__((address_space(1)))
#define LAS __attribute__((address_space(3)))
#define LDS_WAIT() asm volatile("s_waitcnt lgkmcnt(0)" ::: "memory")
#define VM_WAIT() asm volatile("s_waitcnt vmcnt(0)" ::: "memory")
#define XB_TMO      128
#define XB_XCNT(j)  (256  + 64 * (j))
#define XB_XSUB(j)  (1280 + 64 * (j))
#define XB_XGEN(j)  (2304 + 64 * (j))
#define XB_TOP      3328
#define XB_TOPGEN   3392
#define XCD_BAR_WORDS 3456
#define XB_SPIN_CAP (1u << 18)

__device__ __forceinline__ unsigned xb_ld(unsigned* p)              { return __hip_atomic_load(p, __ATOMIC_RELAXED, __HIP_MEMORY_SCOPE_AGENT); }
__device__ __forceinline__ unsigned xb_add(unsigned* p, unsigned v) { return __hip_atomic_fetch_add(p, v, __ATOMIC_RELAXED, __HIP_MEMORY_SCOPE_AGENT); }
__device__ __forceinline__ unsigned xb_xcc_id() { return (unsigned)__builtin_amdgcn_s_getreg((3 << 11) | 20) & 0xFu; }
#define XB_SPIN(cond, bar) do { unsigned _sp = 0; while (cond) { __builtin_amdgcn_s_sleep(1); \
    if ((++_sp & 255u) == 0u) { if (xb_ld(&(bar)[XB_TMO])) break; if (_sp > XB_SPIN_CAP) { atomicAdd(&(bar)[XB_TMO], 1u); break; } } } } while (0)

struct XcdBarrier {
    unsigned* bar; unsigned x;
    volatile LAS unsigned* st;
};

__device__ __forceinline__ XcdBarrier xcd_barrier_post(unsigned* bar, volatile LAS unsigned* st) {
    XcdBarrier b; b.bar = bar; b.x = xb_xcc_id(); b.st = st;
    if (threadIdx.x == 0) (void)xb_add(&bar[XB_XCNT(b.x)], 1u);
    return b;
}
__device__ __forceinline__ void xcd_barrier_complete(unsigned* bar, unsigned x, unsigned& nloc, unsigned& nx) {
    const unsigned G = gridDim.x * gridDim.y * gridDim.z;
    unsigned sum, cnt, mine, sp = 0u;
    for (;;) {
        sum = 0u; cnt = 0u; mine = 0u;
#pragma unroll
        for (unsigned j = 0; j < 16; ++j) { const unsigned c = xb_ld(&bar[XB_XCNT(j)]); sum += c; cnt += (c > 0u) ? 1u : 0u; mine = (j == x) ? c : mine; }
        if (sum == G) break;
        __builtin_amdgcn_s_sleep(1);
        if ((++sp & 255u) == 0u) { if (xb_ld(&bar[XB_TMO])) break; if (sp > XB_SPIN_CAP) { atomicAdd(&bar[XB_TMO], 1u); break; } }
    }
    nloc = mine > 0u ? mine : 1u; nx = cnt > 0u ? cnt : 1u;
}

__device__ __forceinline__ void xcd_barrier(const XcdBarrier& b) {
    asm volatile("s_waitcnt vmcnt(0)" ::: "memory");
    __syncthreads();
    if (threadIdx.x == 0) {
        unsigned* bar = b.bar;
        __builtin_amdgcn_s_waitcnt(0);
        unsigned nloc = b.st[0], nx = b.st[1];
        if (nloc == 0u) { xcd_barrier_complete(bar, b.x, nloc, nx); b.st[0] = nloc; b.st[1] = nx; }
        const unsigned old = xb_add(&bar[XB_XSUB(b.x)], 1u);
        const unsigned gen = old / nloc;
        if (old + 1u == (gen + 1u) * nloc) {
            __builtin_amdgcn_fence(__ATOMIC_RELEASE, "agent");
            asm volatile("s_waitcnt vmcnt(0)" ::: "memory");
            const unsigned og = xb_add(&bar[XB_TOP], 1u);
            const unsigned tg = og / nx;
            if (og + 1u == (tg + 1u) * nx) xb_add(&bar[XB_TOPGEN], 1u);
            else XB_SPIN(xb_ld(&bar[XB_TOPGEN]) == tg, bar);
            __builtin_amdgcn_fence(__ATOMIC_ACQUIRE, "agent");
            xb_add(&bar[XB_XGEN(b.x)], 1u);
            asm volatile("s_waitcnt vmcnt(0)" ::: "memory");
        } else {
            XB_SPIN(xb_ld(&bar[XB_XGEN(b.x)]) == gen, bar);
            __builtin_amdgcn_fence(__ATOMIC_ACQUIRE, "agent");
            asm volatile("s_waitcnt vmcnt(0)" ::: "memory");
        }
    }
    __syncthreads();
}

DI float wave_sum(float v) {
#pragma unroll
    for (int o = 1; o < 64; o <<= 1) v += __shfl_xor(v, o);
    return v;
}
DI float rdlane(float v, int l) { return __uint_as_float((unsigned)__builtin_amdgcn_readlane((int)__float_as_uint(v), l)); }
DI unsigned pk2(float lo, float hi) { return cvt_pk_bf16(lo, hi); }

DI void ph_adaln(const float* cnd, const float* cctx, const float* ada_w, float* modp, int gw, int NGW, int lane) {
    for (int task = gw; task < 96 * KSPLIT; task += NGW) {
        const int ks = task & (KSPLIT - 1), cg = task / KSPLIT, l = cg / 48, cgl = cg % 48, col0 = cgl * 256 + lane * 4, k0 = ks * 128;
        float sv[9][2];
#pragma unroll
        for (int r = 0; r < 9; ++r)
#pragma unroll
            for (int hh = 0; hh < 2; ++hh) { const int k = k0 + hh * 64 + lane; const float v = r < 8 ? cnd[r * DM + k] : cctx[k]; sv[r][hh] = v / (1.0f + __expf(-v)); }
        f32x4 acc[9];
#pragma unroll
        for (int r = 0; r < 9; ++r) acc[r] = (f32x4){0.f, 0.f, 0.f, 0.f};
        const float* wp = ada_w + ((size_t)l * DM + k0) * NMOD + col0;
#pragma unroll
        for (int hh = 0; hh < 2; ++hh) {
#pragma unroll 8
            for (int kk = 0; kk < 64; ++kk) {
                const f32x4 w = *(const f32x4*)(wp + (size_t)(hh * 64 + kk) * NMOD);
#pragma unroll
                for (int r = 0; r < 9; ++r) { const float s = rdlane(sv[r][hh], kk); acc[r] += w * s; }
            }
        }
#pragma unroll
        for (int r = 0; r < 9; ++r) *(f32x4*)(modp + ((size_t)((ks * 2 + l) * 9 + r)) * NMOD + col0) = acc[r];
    }
}
struct CvtPtrs { const float *cin, *cout, *wqkv, *wo, *wg, *wu, *wd; bf16_t *W1A, *W1B, *W2, *WQKV, *WO, *WGU, *WDN; };
constexpr int CVT_E0 = 6656, CVT_L = 24576, CVT_TOTAL = CVT_E0 + 2 * CVT_L;
DI void cvt_resolve(const CvtPtrs& P, int it, const float*& src, int& ldw, bf16_t*& dst, int& ldd) {
    int r = it;
    if (r < 3072) { const int kt = r / 96, nt = r % 96, n0 = nt * 64, part = n0 >> 11, j0 = n0 & 2047;
        src = P.cin + (size_t)(kt * 64) * 6144 + n0; ldw = 6144; ldd = DM;
        dst = (part == 0 ? P.W1B + (size_t)j0 * DM : P.W1A + (size_t)((j0 >> 7) * 256 + (part == 2 ? 128 : 0) + (j0 & 127)) * DM) + kt * 64; return; } r -= 3072;
    if (r < 1024) { const int kt = r / 32, nt = r % 32; src = P.cout + (size_t)(kt * 64) * DM + nt * 64; ldw = DM; dst = P.W2 + (size_t)(nt * 64) * DM + kt * 64; ldd = DM; return; } r -= 1024;
    if (r < 1536) { const int kt = r / 48, nt = r % 48; src = P.wqkv + (size_t)(kt * 64) * 3072 + nt * 64; ldw = 3072; dst = P.WQKV + (size_t)(nt * 64) * DM + kt * 64; ldd = DM; return; } r -= 1536;
    if (r < 1024) { const int kt = r / 32, nt = r % 32; src = P.wo + (size_t)(kt * 64) * DM + nt * 64; ldw = DM; dst = P.WO + (size_t)(nt * 64) * DM + kt * 64; ldd = DM; return; } r -= 1024;
    const int l = r / CVT_L, rr = r % CVT_L, kind = rr / 8192, q = rr % 8192, le = l * 16 + q / 512, rem = q % 512;
    if (kind < 2) { const int kt = rem / 16, nt = rem % 16, n0 = nt * 64;
        src = (kind ? P.wu : P.wg) + (size_t)le * DM * DFF + (size_t)(kt * 64) * DFF + n0; ldw = DFF;
        dst = P.WGU + (size_t)(le * 2048 + (n0 >> 7) * 256 + kind * 128 + (n0 & 127)) * DM + kt * 64; ldd = DM; }
    else { const int kt = rem / 32, nt = rem % 32;
        src = P.wd + (size_t)le * DFF * DM + (size_t)(kt * 64) * DM + nt * 64; ldw = DM; dst = P.WDN + (size_t)(le * 2048 + nt * 64) * DFF + kt * 64; ldd = DFF; }
}
constexpr int CVT_P = 36;
DI void cvt_range(const CvtPtrs& P, int lo, int hi, int w, int NW, LAS unsigned* scr, int lane) {
    int it = lo + w; if (it >= hi) return;
    const int c = lane & 15, q = lane >> 4;
    const float* src; int ldw; bf16_t* dst; int ldd; cvt_resolve(P, it, src, ldw, dst, ldd);
    f32x4 v[16];
#pragma unroll
    for (int rr = 0; rr < 16; ++rr) v[rr] = __builtin_nontemporal_load((const f32x4*)(src + (size_t)(16 * q + rr) * ldw + 4 * c));
    for (;;) {
        u32x4 pa[4], pb[4];
#pragma unroll
        for (int i = 0; i < 4; ++i) { pa[i].x = pk2(v[0][i], v[1][i]); pa[i].y = pk2(v[2][i], v[3][i]); pa[i].z = pk2(v[4][i], v[5][i]); pa[i].w = pk2(v[6][i], v[7][i]);
                                      pb[i].x = pk2(v[8][i], v[9][i]); pb[i].y = pk2(v[10][i], v[11][i]); pb[i].z = pk2(v[12][i], v[13][i]); pb[i].w = pk2(v[14][i], v[15][i]); }
        const int nit = it + NW; bf16_t* cdst = dst; const int cldd = ldd;
        if (nit < hi) { cvt_resolve(P, nit, src, ldw, dst, ldd);
#pragma unroll
            for (int rr = 0; rr < 16; ++rr) v[rr] = __builtin_nontemporal_load((const f32x4*)(src + (size_t)(16 * q + rr) * ldw + 4 * c)); }
#pragma unroll
        for (int i = 0; i < 4; ++i) { *(LAS u32x4*)(scr + (4 * c + i) * CVT_P + 8 * q) = pa[i]; *(LAS u32x4*)(scr + (4 * c + i) * CVT_P + 8 * q + 4) = pb[i]; }
        LDS_WAIT(); asm volatile("" ::: "memory");
#pragma unroll
        for (int j = 0; j < 8; ++j) { const int n = (lane >> 3) + 8 * j; const u32x4 o = *(const LAS u32x4*)(scr + n * CVT_P + 4 * (lane & 7));
            *(u32x4*)(cdst + (size_t)n * cldd + 8 * (lane & 7)) = o; }
        LDS_WAIT(); asm volatile("" ::: "memory");
        if (nit >= hi) break;
        it = nit;
    }
}
DI void ph_modred(const float* modp, const float* ada_b, float* mod, int gtid, int GT) {
    for (int i = gtid; i < 2 * 9 * NMOD; i += GT) { const int l = i / (9 * NMOD), j = i % NMOD; float s = ada_b[l * NMOD + j];
#pragma unroll
        for (int ks = 0; ks < KSPLIT; ++ks) s += modp[(size_t)ks * (2 * 9 * NMOD) + i];
        mod[i] = s; }
}
DI void row_load(const float* p, f32x4 (&v)[8], int lane) {
#pragma unroll
    for (int j = 0; j < 8; ++j) v[j] = *(const f32x4*)(p + 4 * lane + 256 * j);
}
DI void row_modulate(const f32x4 (&v)[8], f32x4 (&y)[8], const float* gain, const float* shift, const float* scale, int lane) {
    float ss = 0.f;
#pragma unroll
    for (int j = 0; j < 8; ++j) ss += (v[j][0] * v[j][0] + v[j][1] * v[j][1]) + (v[j][2] * v[j][2] + v[j][3] * v[j][3]);
    ss = wave_sum(ss);
    const float rstd = 1.0f / sqrtf(ss * (1.0f / DM) + NORM_EPS);
#pragma unroll
    for (int j = 0; j < 8; ++j) { const int c = 4 * lane + 256 * j; const f32x4 g = *(const f32x4*)(gain + c), sh = *(const f32x4*)(shift + c), sc = *(const f32x4*)(scale + c);
        y[j] = ((v[j] * rstd) * g) * (sc + 1.0f) + sh; }
}
DI void row_store_bf16(bf16_t* p, const f32x4 (&y)[8], int lane) {
#pragma unroll
    for (int j = 0; j < 8; ++j) { u32x2 w; w.x = pk2(y[j][0], y[j][1]); w.y = pk2(y[j][2], y[j][3]); *(u32x2*)(p + 4 * lane + 256 * j) = w; }
}
DI void ph_mod0(const float* x, const float* ctx, const float* gain, const float* mod0, bf16_t* A, int gw, int NGW, int lane) {
    for (int row = gw; row < MT; row += NGW) {
        const int cr = row < ML ? (row >> 11) : 8; const float* src = row < ML ? x + (size_t)row * DM : ctx + (size_t)(row - ML) * DM;
        f32x4 v[8], y[8]; row_load(src, v, lane);
        row_modulate(v, y, gain, mod0 + (size_t)cr * NMOD + 0 * DM, mod0 + (size_t)cr * NMOD + 1 * DM, lane);
        row_store_bf16(A + (size_t)row * DM, y, lane);
    }
}
DI void router_row(const f32x4 (&y)[8], const LAS float* rwT, float* affL, float* affC, int row, int lane) {
    float lg[16];
#pragma unroll
    for (int e = 0; e < 16; ++e) { float s = 0.f;
#pragma unroll
        for (int j = 0; j < 8; ++j) { const f32x4 w = *(const LAS f32x4*)(rwT + e * DM + 4 * lane + 256 * j); s += (y[j][0] * w[0] + y[j][1] * w[1]) + (y[j][2] * w[2] + y[j][3] * w[3]); }
        lg[e] = wave_sum(s); }
    float mx = lg[0];
#pragma unroll
    for (int e = 1; e < 16; ++e) mx = fmaxf(mx, lg[e]);
    float den = 0.f;
#pragma unroll
    for (int e = 0; e < 16; ++e) { lg[e] = __expf(lg[e] - mx); den += lg[e]; }
    float mine = 0.f;
#pragma unroll
    for (int e = 0; e < 16; ++e) mine = (lane == e) ? lg[e] : mine;
    mine = mine / den;
    if (lane < 16) { if (row < ML) { const int b = row >> 11, n = row & 2047; affL[(size_t)(b * 16 + lane) * SEQ + n] = mine; }
                     else { const int rc = row - ML, b = rc >> 8, n = rc & 255; affC[(size_t)(b * 16 + lane) * CTXL + n] = mine; } }
}
DI void load_router(const float* rw, LAS float* rwT, int tid) {
    for (int i = tid; i < DM * 16; i += 512) rwT[(i & 15) * DM + (i >> 4)] = rw[i];
    __syncthreads();
}
DI void ph_modffn(const float* H, const float* gain, const float* modl, bf16_t* A, const LAS float* rwT, float* affL, float* affC, int nrows, int gw, int NGW, int lane) {
    for (int row = gw; row < nrows; row += NGW) {
        const int cr = row < ML ? (row >> 11) : 8;
        f32x4 v[8], y[8]; row_load(H + (size_t)row * DM, v, lane);
        row_modulate(v, y, gain, modl + (size_t)cr * NMOD + 3 * DM, modl + (size_t)cr * NMOD + 4 * DM, lane);
        row_store_bf16(A + (size_t)row * DM, y, lane);
        router_row(y, rwT, affL, affC, row, lane);
    }
}
DI void ph_topk(int nitems, const float* affL, const float* affC, int* rowsrc, float* gatev, int* inv, LAS unsigned* hist, int tid, int lane, int wave, int bid, int G) {
    LAS unsigned* sh = hist + 256;
    for (int it = bid; it < nitems; it += G) {
        const bool isc = it >= 128; const int be = it & 127, b = be >> 4, e = be & 15;
        const int N = isc ? CTXL : SEQ, C = isc ? CAPC : CAPL;
        const float* src = isc ? affC + (size_t)be * CTXL : affL + (size_t)be * SEQ;
        const int i0 = tid * 4; const bool valid = i0 < N;
        unsigned key[4];
        { f32x4 v = (f32x4){0.f, 0.f, 0.f, 0.f}; if (valid) v = *(const f32x4*)(src + i0);
#pragma unroll
          for (int q = 0; q < 4; ++q) key[q] = __float_as_uint(v[q]); }
        unsigned prefix = 0u, mask = 0u, krem = (unsigned)C;
        for (int pass = 3; pass >= 0; --pass) {
            const int shift = pass * 8;
            if (tid < 256) hist[tid] = 0u;
            __syncthreads();
            if (valid) {
#pragma unroll
                for (int q = 0; q < 4; ++q) if ((key[q] & mask) == prefix) __hip_atomic_fetch_add(&hist[(key[q] >> shift) & 255u], 1u, __ATOMIC_RELAXED, __HIP_MEMORY_SCOPE_WORKGROUP); }
            __syncthreads();
            if (wave == 0) {
                const unsigned h0 = hist[4 * lane], h1 = hist[4 * lane + 1], h2 = hist[4 * lane + 2], h3 = hist[4 * lane + 3];
                const unsigned tot = h0 + h1 + h2 + h3; unsigned incl = tot;
#pragma unroll
                for (int o = 1; o < 64; o <<= 1) { const unsigned t = __shfl_down(incl, o); if (lane + o < 64) incl += t; }
                const unsigned a3 = incl - tot, a2 = a3 + h3, a1 = a2 + h2, a0 = a1 + h1;
                if (a3 < krem && krem <= a3 + h3) { sh[0] = 4 * lane + 3; sh[1] = krem - a3; }
                if (a2 < krem && krem <= a2 + h2) { sh[0] = 4 * lane + 2; sh[1] = krem - a2; }
                if (a1 < krem && krem <= a1 + h1) { sh[0] = 4 * lane + 1; sh[1] = krem - a1; }
                if (a0 < krem && krem <= a0 + h0) { sh[0] = 4 * lane + 0; sh[1] = krem - a0; }
            }
            __syncthreads();
            const unsigned B = sh[0]; krem = sh[1]; prefix |= B << shift; mask |= 0xFFu << shift;
        }
        const unsigned T = prefix;
        unsigned cg = 0u, ce = 0u;
        if (valid) {
#pragma unroll
            for (int q = 0; q < 4; ++q) { cg += key[q] > T ? 1u : 0u; ce += key[q] == T ? 1u : 0u; } }
        const unsigned mine = cg | (ce << 16); unsigned incl = mine;
#pragma unroll
        for (int o = 1; o < 64; o <<= 1) { const unsigned t = __shfl_up(incl, o); if (lane >= o) incl += t; }
        if (lane == 63) sh[8 + wave] = incl;
        __syncthreads();
        unsigned woff = 0u;
#pragma unroll
        for (int w = 0; w < 8; ++w) woff += (w < wave) ? sh[8 + w] : 0u;
        const unsigned excl = woff + incl - mine; unsigned gtb = excl & 0xFFFFu, eqb = excl >> 16;
        if (valid) {
            const int ybase = e * YR + (isc ? NB * CAPL + b * CAPC : b * CAPL); const int rbase = isc ? ML + b * CTXL : b * SEQ;
#pragma unroll
            for (int q = 0; q < 4; ++q) {
                const bool isg = key[q] > T, ise = key[q] == T; const bool sel = isg || (ise && eqb < krem);
                const unsigned slot = gtb + (eqb < krem ? eqb : krem);
                const int trow = rbase + i0 + q; const int yrow = ybase + (int)slot;
                if (sel) { rowsrc[yrow] = trow; gatev[yrow] = __uint_as_float(key[q]); }
                inv[(size_t)trow * 16 + e] = sel ? yrow : -1;
                gtb += isg ? 1u : 0u; eqb += ise ? 1u : 0u;
            }
        }
        __syncthreads();
    }
}
DI void ph_gather(const bf16_t* A, const int* rowsrc, bf16_t* XS, bool with_ctx, int gw, int NGW, int lane) {
    for (int yr = gw; yr < YT; yr += NGW) {
        if (!with_ctx && (yr % YR) >= NB * CAPL) continue;
        const int src = rowsrc[yr];
        const u32x4* s = (const u32x4*)(A + (size_t)src * DM); u32x4* d = (u32x4*)(XS + (size_t)yr * DM);
#pragma unroll
        for (int j = 0; j < 4; ++j) d[lane + 64 * j] = s[lane + 64 * j];
    }
}
template <bool LAST> DI void ph_combine(float* H, const bf16_t* Y, const int* inv, const float* modl  , const float* gain1, const float* mod1, bf16_t* A, float* out, int nrows, int gw, int NGW, int lane) {
    for (int row = gw; row < nrows; row += NGW) {
        const int cr = row < ML ? (row >> 11) : 8;
        f32x4 v[8], acc[8]; row_load(H + (size_t)row * DM, v, lane);
#pragma unroll
        for (int j = 0; j < 8; ++j) acc[j] = (f32x4){0.f, 0.f, 0.f, 0.f};
        const int myinv = inv[(size_t)row * 16 + (lane & 15)];
        for (int e = 0; e < 16; ++e) {
            const int yr = __builtin_amdgcn_readlane(myinv, e);
            if (yr >= 0) { const bf16_t* yp = Y + (size_t)yr * DM + 4 * lane;
#pragma unroll
                for (int j = 0; j < 8; ++j) { const u32x2 p = *(const u32x2*)(yp + 256 * j); acc[j][0] += bf_lo(p.x); acc[j][1] += bf_hi(p.x); acc[j][2] += bf_lo(p.y); acc[j][3] += bf_hi(p.y); } }
        }
        const float* g2 = modl + (size_t)cr * NMOD + 5 * DM;
#pragma unroll
        for (int j = 0; j < 8; ++j) { const f32x4 g = *(const f32x4*)(g2 + 4 * lane + 256 * j); v[j] = v[j] + g * acc[j]; }
        if (LAST) {
#pragma unroll
            for (int j = 0; j < 8; ++j) *(f32x4*)(out + (size_t)row * DM + 4 * lane + 256 * j) = v[j];
        } else {
#pragma unroll
            for (int j = 0; j < 8; ++j) *(f32x4*)(H + (size_t)row * DM + 4 * lane + 256 * j) = v[j];
            f32x4 y[8]; row_modulate(v, y, gain1, mod1 + (size_t)cr * NMOD + 0 * DM, mod1 + (size_t)cr * NMOD + 1 * DM, lane);
            row_store_bf16(A + (size_t)row * DM, y, lane);
        }
    }
}
DI void ph_qknorm(bf16_t* Q, bf16_t* K, const float* qg, const float* kg, int gw, int NGW, int lane) {
    const int half = lane >> 5, i = lane & 31, d1 = half * 64 + i, d2 = d1 + 32;
    const float inv_freq = exp2f(-(float)i * (13.287712379549449f / 32.0f));
    constexpr float QSCALE = 0.08838834764831845f * 1.4426950408889634f;
    const float qg1 = qg[d1] * QSCALE, qg2 = qg[d2] * QSCALE, kg1 = kg[d1], kg2 = kg[d2];
    for (int row = gw; row < MT; row += NGW) {
        const bool lat = row < ML; const int t = row & (SEQ - 1);
        const float pos = (float)(half == 0 ? (t >> 6) : (t & 63)); const float ang = pos * inv_freq;
        const float cs = lat ? __cosf(ang) : 1.0f, sn = lat ? __sinf(ang) : 0.0f;
        if (lat) {
            for (int hd = 0; hd < NH; ++hd) { bf16_t* p = Q + (size_t)row * DM + hd * HD;
                float x1 = __uint_as_float((unsigned)p[d1] << 16), x2 = __uint_as_float((unsigned)p[d2] << 16);
                const float ss = wave_sum(x1 * x1 + x2 * x2); const float rstd = 1.0f / sqrtf(ss * (1.0f / HD) + NORM_EPS);
                x1 = x1 * rstd * qg1; x2 = x2 * rstd * qg2;
                const float o1 = x1 * cs - x2 * sn, o2 = x2 * cs + x1 * sn;
                const unsigned w = pk2(o1, o2); p[d1] = (bf16_t)(w & 0xffffu); p[d2] = (bf16_t)(w >> 16); }
        }
        for (int kh = 0; kh < NKV; ++kh) { bf16_t* p = K + (size_t)row * 512 + kh * HD;
            float x1 = __uint_as_float((unsigned)p[d1] << 16), x2 = __uint_as_float((unsigned)p[d2] << 16);
            const float ss = wave_sum(x1 * x1 + x2 * x2); const float rstd = 1.0f / sqrtf(ss * (1.0f / HD) + NORM_EPS);
            x1 = x1 * rstd * kg1; x2 = x2 * rstd * kg2;
            const float o1 = x1 * cs - x2 * sn, o2 = x2 * cs + x1 * sn;
            const unsigned w = pk2(o1, o2); p[d1] = (bf16_t)(w & 0xffffu); p[d2] = (bf16_t)(w >> 16); }
    }
}
constexpr int KP = 272;
constexpr int ATT_VOFF = 64 * KP;
constexpr int ATT_TILE = 2 * 64 * KP;
DI int crow(int reg, int h) { return (reg & 3) + 8 * (reg >> 2) + 4 * h; }
DI s16x4 vtr(const LAS unsigned char* p) { typedef short v4i16_t __attribute__((ext_vector_type(4))); return __builtin_bit_cast(s16x4, __builtin_amdgcn_ds_read_tr16_b64_v4i16((LAS v4i16_t*)p)); }
DI bool att_tile_info(int item, int ti, int& base, int& mtype) {
    const int qhalf = item & 1, n = (item >> 3) & 15, b = item >> 7, tt = ti & 1; mtype = 0;
    if (ti < 4) { base = ML + b * CTXL + 64 * ti; return true; }
    const int blk = n - 1 + ((ti - 4) >> 1); if (blk < 0 || blk > 15) return false;
    if (ti < 6) { mtype = 1; if (tt == 0 && qhalf == 1) return false; } else if (ti >= 8) { mtype = 2; if (tt == 1 && qhalf == 0) return false; }
    base = b * SEQ + blk * 128 + 64 * tt; return true;
}
DI void att_next(int& item, int& ti, int G) { for (;;) { ++ti; if (ti >= 10) { ti = 0; item += G; return; } int b_, m_; if (att_tile_info(item, ti, b_, m_)) return; } }
DI void ph_attn(const bf16_t* Q, const bf16_t* Kb, const bf16_t* Vb, bf16_t* O, const float* sink, LAS unsigned char* lds, int tid, int lane, int wave, int bid, int G) {
    constexpr float LOG2E = 1.4426950408889634f;
    const int r = lane & 31, h = lane >> 5, g = wave >> 1, sub = wave & 1;
    const int ldrow = tid >> 3, ldc = tid & 7;
    int item = bid, ti = 0; if (item >= 1024) return;
    u32x4 kr[2], vr[2];
#define ATT_ISSUE(it_, ti_) do { int base_, mt_; att_tile_info(it_, ti_, base_, mt_); const int kvh_ = ((it_) >> 1) & 3; \
        _Pragma("unroll") for (int c2 = 0; c2 < 2; ++c2) { const size_t off_ = (size_t)(base_ + ldrow) * 512 + kvh_ * HD + (ldc + 8 * c2) * 8; kr[c2] = *(const u32x4*)(Kb + off_); vr[c2] = *(const u32x4*)(Vb + off_); } } while (0)
    bf16x8 qf[8]; float m2 = 0.f, lsum = 1.f; f32x16 o[4];
#define ATT_QLOAD(it_) do { const int qrow_ = ((it_) >> 7) * SEQ + (((it_) >> 3) & 15) * 128 + ((it_) & 1) * 64 + sub * 32 + r; const int head_ = (((it_) >> 1) & 3) * 4 + g; \
        _Pragma("unroll") for (int s = 0; s < 8; ++s) qf[s] = *(const bf16x8*)(Q + (size_t)qrow_ * DM + head_ * HD + 16 * s + 8 * h); } while (0)
    ATT_QLOAD(item);
    ATT_ISSUE(item, ti);
    int buf = 0;
    while (item < 1024) {
        int nitem = item, nti = ti; att_next(nitem, nti, G);
        LAS unsigned char* tb = lds + buf * ATT_TILE;
#pragma unroll
        for (int c2 = 0; c2 < 2; ++c2) { *(LAS u32x4*)(tb + ldrow * KP + (ldc + 8 * c2) * 16) = kr[c2]; *(LAS u32x4*)(tb + ATT_VOFF + ldrow * KP + (ldc + 8 * c2) * 16) = vr[c2]; }
        if (nitem < 1024) ATT_ISSUE(nitem, nti);
        asm volatile("s_waitcnt lgkmcnt(0)" ::: "memory"); __builtin_amdgcn_s_barrier(); asm volatile("" ::: "memory");
        int base, mtype; att_tile_info(item, ti, base, mtype); const int tt = ti & 1;
        const int qhalf = item & 1, kvh = (item >> 1) & 3, n = (item >> 3) & 15, b = item >> 7;
        const int head = kvh * 4 + g, qq = qhalf * 64 + sub * 32 + r; const int qrow = b * SEQ + n * 128 + qq;
        if (ti == 0) {
            m2 = sink[head] * LOG2E; lsum = 1.0f;
#pragma unroll
            for (int d = 0; d < 4; ++d)
#pragma unroll
                for (int i = 0; i < 16; ++i) o[d][i] = 0.f;
        }
        f32x16 x0, x1;
#pragma unroll
        for (int i = 0; i < 16; ++i) { x0[i] = 0.f; x1[i] = 0.f; }
#pragma unroll
        for (int s = 0; s < 8; ++s) {
            const bf16x8 k0 = *(const LAS bf16x8*)(tb + r * KP + (16 * s + 8 * h) * 2), k1 = *(const LAS bf16x8*)(tb + (32 + r) * KP + (16 * s + 8 * h) * 2);
            x0 = __builtin_amdgcn_mfma_f32_32x32x16_bf16(k0, qf[s], x0, 0, 0, 0); x1 = __builtin_amdgcn_mfma_f32_32x32x16_bf16(k1, qf[s], x1, 0, 0, 0); }
        if (nitem != item && nitem < 1024) ATT_QLOAD(nitem);
        if (mtype == 1) {
#pragma unroll
            for (int i = 0; i < 16; ++i) { const int kk0 = tt * 64 + crow(i, h); if (kk0 < qq) x0[i] = -1.0e30f; if (kk0 + 32 < qq) x1[i] = -1.0e30f; } }
        if (mtype == 2) {
#pragma unroll
            for (int i = 0; i < 16; ++i) { const int kk0 = tt * 64 + crow(i, h); if (kk0 > qq) x0[i] = -1.0e30f; if (kk0 + 32 > qq) x1[i] = -1.0e30f; } }
        float tmax = fmaxf(x0[0], x1[0]);
#pragma unroll
        for (int i = 1; i < 16; ++i) tmax = fmaxf(tmax, fmaxf(x0[i], x1[i]));
        tmax = fmaxf(tmax, __shfl_xor(tmax, 32));
        const float mnew = fmaxf(m2, tmax), alpha = __builtin_amdgcn_exp2f(m2 - mnew); m2 = mnew;
        float ps = 0.f;
#pragma unroll
        for (int i = 0; i < 16; ++i) { x0[i] = __builtin_amdgcn_exp2f(x0[i] - mnew); x1[i] = __builtin_amdgcn_exp2f(x1[i] - mnew); ps += x0[i] + x1[i]; }
        ps += __shfl_xor(ps, 32); lsum = lsum * alpha + ps;
        if (__any(alpha != 1.0f)) {
#pragma unroll
            for (int d = 0; d < 4; ++d)
#pragma unroll
                for (int i = 0; i < 16; ++i) o[d][i] *= alpha; }
        bf16x8 pf[2][2];
#pragma unroll
        for (int s = 0; s < 2; ++s) {
            u32x4 a, c; a.x = pk2(x0[8 * s + 0], x0[8 * s + 1]); a.y = pk2(x0[8 * s + 2], x0[8 * s + 3]); a.z = pk2(x0[8 * s + 4], x0[8 * s + 5]); a.w = pk2(x0[8 * s + 6], x0[8 * s + 7]);
            c.x = pk2(x1[8 * s + 0], x1[8 * s + 1]); c.y = pk2(x1[8 * s + 2], x1[8 * s + 3]); c.z = pk2(x1[8 * s + 4], x1[8 * s + 5]); c.w = pk2(x1[8 * s + 6], x1[8 * s + 7]);
            pf[0][s] = __builtin_bit_cast(bf16x8, a); pf[1][s] = __builtin_bit_cast(bf16x8, c); }
        const LAS unsigned char* vb = tb + ATT_VOFF + (4 * h + ((lane & 15) >> 2)) * KP + (16 * ((lane >> 4) & 1) + 4 * (lane & 3)) * 2;
#pragma unroll
        for (int d = 0; d < 4; ++d)
#pragma unroll
            for (int t = 0; t < 2; ++t)
#pragma unroll
                for (int s = 0; s < 2; ++s) {
                    const s16x4 lo = vtr(vb + (t * 32 + 16 * s) * KP + d * 64), hi = vtr(vb + (t * 32 + 16 * s + 8) * KP + d * 64);
                    const bf16x8 vf = (bf16x8){lo[0], lo[1], lo[2], lo[3], hi[0], hi[1], hi[2], hi[3]};
                    o[d] = __builtin_amdgcn_mfma_f32_32x32x16_bf16(vf, pf[t][s], o[d], 0, 0, 0); }
        if (nitem != item) {
            const float il = 1.0f / lsum;
            bf16_t* op = O + (size_t)qrow * DM + head * HD + 4 * h;
#pragma unroll
            for (int d = 0; d < 4; ++d)
#pragma unroll
                for (int g4 = 0; g4 < 4; ++g4) { u32x2 w; w.x = pk2(o[d][4 * g4 + 0] * il, o[d][4 * g4 + 1] * il); w.y = pk2(o[d][4 * g4 + 2] * il, o[d][4 * g4 + 3] * il);
                    *(u32x2*)(op + d * 32 + 8 * g4) = w; }
        }
        item = nitem; ti = nti; buf ^= 1;
    }
#undef ATT_ISSUE
#undef ATT_QLOAD
}

#ifndef MK_ONE_LAUNCH
#define MK_ONE_LAUNCH 1
#endif
constexpr int NPHASE = 20;
#ifndef MK_CVT_Q
#define MK_CVT_Q 0
#endif
constexpr int CVT_Q = MK_CVT_Q;
constexpr int CVT_X0_END = CVT_E0 + CVT_L;
constexpr int CVT_R3_LO = CVT_X0_END - 3 * CVT_Q, CVT_R4_LO = CVT_X0_END - 2 * CVT_Q, CVT_R5_LO = CVT_X0_END - CVT_Q;
constexpr int CVT_R9_LO = CVT_TOTAL - 5 * CVT_Q / 2, CVT_R10_LO = CVT_TOTAL - 3 * CVT_Q / 2, CVT_R12_LO = CVT_TOTAL - CVT_Q;
static_assert(CVT_Q <= 8192 && CVT_Q % 2 == 0, "tail quota");
#define CVT_MKCP() CvtPtrs CP; CP.cin = args.in[8]; CP.cout = args.in[10]; CP.wqkv = args.in[11]; CP.wo = args.in[15]; CP.wg = args.in[17]; CP.wu = args.in[18]; CP.wd = args.in[19]; \
    CP.W1A = W1A; CP.W1B = W1B; CP.W2 = W2; CP.WQKV = WQKV; CP.WO = WOt; CP.WGU = WGU; CP.WDN = WDN
#define CVT_TAIL(NWG, LO, HI) do { if ((LO) < (HI)) { CVT_MKCP(); const int busy_ = (NWG) % G; if (busy_ == 0) cvt_range(CP, LO, HI, gw, NGW, cscr, lane); else if (bid >= busy_) cvt_range(CP, LO, HI, (bid - busy_) * 8 + wave, (G - busy_) * 8, cscr, lane); } } while (0)
#ifndef MK_DUP_MASK
#define MK_DUP_MASK 0u
#endif
constexpr unsigned DUP_MASK = MK_DUP_MASK;
struct Args { const float* in[20]; float* out; unsigned char* ws; int ph_lo, ph_hi; };
__global__ void __launch_bounds__(512, 2) dit_fwd(Args args) {
    extern __shared__ __attribute__((aligned(16))) unsigned char lds_raw[];
    LAS unsigned char* lds = (LAS unsigned char*)lds_raw;
    const int tid = threadIdx.x, lane = tid & 63, wave = __builtin_amdgcn_readfirstlane(tid >> 6);
    const int G = gridDim.x, bid = blockIdx.x;
    const int gw = bid * 8 + wave, NGW = G * 8;
    unsigned char* ws = args.ws;
    const float* x = args.in[0]; const float* cnd = args.in[1]; const float* ctx = args.in[2]; const float* cctx = args.in[3];
    const float* ada_w = args.in[4]; const float* ada_b = args.in[5]; const float* nmix = args.in[6]; const float* nffn = args.in[7];
    const float* conv_w = args.in[9]; const float* qgain = args.in[12]; const float* kgain = args.in[13]; const float* sink = args.in[14]; const float* router_w = args.in[16];
    float* mod = (float*)(ws + WS_MOD); float* modp = (float*)(ws + WS_MODP);
    float* affL = (float*)(ws + WS_AFFL); float* affC = (float*)(ws + WS_AFFC);
    int* rowsrc = (int*)(ws + WS_ROWSRC); float* gatev = (float*)(ws + WS_GATEV); int* inv = (int*)(ws + WS_INV);
    bf16_t* W1A = (bf16_t*)(ws + WS_W1A); bf16_t* W1B = (bf16_t*)(ws + WS_W1B); bf16_t* W2 = (bf16_t*)(ws + WS_W2); bf16_t* WQKV = (bf16_t*)(ws + WS_WQKV); bf16_t* WOt = (bf16_t*)(ws + WS_WO);
    bf16_t* WGU = (bf16_t*)(ws + WS_WGU); bf16_t* WDN = (bf16_t*)(ws + WS_WDN);
    float* H = (float*)(ws + WS_H); bf16_t* A = (bf16_t*)(ws + WS_A); bf16_t* U = (bf16_t*)(ws + WS_U); bf16_t* Z = (bf16_t*)(ws + WS_Z);
    bf16_t* Qb = (bf16_t*)(ws + WS_Q); bf16_t* Kb = (bf16_t*)(ws + WS_K); bf16_t* Vb = (bf16_t*)(ws + WS_V); bf16_t* Ob = (bf16_t*)(ws + WS_O);
    bf16_t* HM = (bf16_t*)(ws + WS_HM); bf16_t* Y = (bf16_t*)(ws + WS_Y); bf16_t* XS = (bf16_t*)(ws + WS_XS);
    LAS unsigned* cscr = (LAS unsigned*)(lds + wave * 9216);

    for (int u = tid; u < (LDS_BYTES - MISC_OFF) / 4; u += 512) ((LAS unsigned*)(lds + MISC_OFF))[u] = 0u;
    __syncthreads();
#if MK_ONE_LAUNCH
    XcdBarrier bar = xcd_barrier_post((unsigned*)(ws + WS_CTL) + CW_BAR, (volatile LAS unsigned*)(lds + MISC_OFF) + 8);
#define GRID_BAR() xcd_barrier(bar)
#else
#define GRID_BAR() do {} while (0)
#endif
    const int lo = args.ph_lo, hi = args.ph_hi;
#define IN(k) (lo <= (k) && (k) < hi)
#define SEAM(k) do { if (IN(k) && IN((k) + 1)) GRID_BAR(); } while (0)

    if (IN(0)) _Pragma("unroll") for (int rep_ = 0; rep_ < 1 + (int)((DUP_MASK >> 0) & 1u); ++rep_) { if (rep_) GRID_BAR();
        ph_adaln(cnd, cctx, ada_w, modp, gw, NGW, lane);
        CVT_MKCP();
        cvt_range(CP, 0, CVT_R3_LO, gw, NGW, cscr, lane); cvt_range(CP, CVT_X0_END, CVT_R9_LO, gw, NGW, cscr, lane);
    } SEAM(0);
    if (IN(1)) _Pragma("unroll") for (int rep_ = 0; rep_ < 1 + (int)((DUP_MASK >> 1) & 1u); ++rep_) { if (rep_) GRID_BAR();  ph_modred(modp, ada_b, mod, bid * 512 + tid, G * 512); } SEAM(1);
    if (IN(2)) _Pragma("unroll") for (int rep_ = 0; rep_ < 1 + (int)((DUP_MASK >> 2) & 1u); ++rep_) { if (rep_) GRID_BAR();  ph_mod0(x, ctx, nmix, mod, A, gw, NGW, lane); } SEAM(2);
    if (IN(3)) _Pragma("unroll") for (int rep_ = 0; rep_ < 1 + (int)((DUP_MASK >> 3) & 1u); ++rep_) { if (rep_) GRID_BAR();
        pg8::Gemm g{A, W1A, MT, 4096, DM}; pg8::StaticOrder S; S.init(MT, 4096, G, bid);
        EpiPair<0> E{U, DM, 16};
        pg8::gemm_phase<EpiPair<0>, pg8::StaticOrder, true, true>(lds, g, S, E);
        CVT_TAIL(1152, CVT_R3_LO, CVT_R4_LO);
    } SEAM(3);
    if (IN(4)) _Pragma("unroll") for (int rep_ = 0; rep_ < 1 + (int)((DUP_MASK >> 4) & 1u); ++rep_) { if (rep_) GRID_BAR();
        pg8::Gemm g{A, W1B, MT, DM, DM}; pg8::StaticOrder S; S.init(MT, DM, G, bid);
        EpiConvGate E{U, Z, conv_w};
        pg8::gemm_phase<EpiConvGate, pg8::StaticOrder, true, true>(lds, g, S, E);
        CVT_TAIL(576, CVT_R4_LO, CVT_R5_LO);
    } SEAM(4);
    if (IN(5)) _Pragma("unroll") for (int rep_ = 0; rep_ < 1 + (int)((DUP_MASK >> 5) & 1u); ++rep_) { if (rep_) GRID_BAR();
        pg8::Gemm g{Z, W2, MT, DM, DM}; pg8::StaticOrder S; S.init(MT, DM, G, bid);
        EpiResid E{x, ctx, H, mod + 2 * DM};
        pg8::gemm_phase<EpiResid, pg8::StaticOrder, true, true>(lds, g, S, E);
        CVT_TAIL(576, CVT_R5_LO, CVT_X0_END);
    } SEAM(5);
    if (IN(6)) _Pragma("unroll") for (int rep_ = 0; rep_ < 1 + (int)((DUP_MASK >> 6) & 1u); ++rep_) { if (rep_) GRID_BAR();  load_router(router_w, (LAS float*)lds, tid); ph_modffn(H, nffn, mod, A, (const LAS float*)lds, affL, affC, MT, gw, NGW, lane); } SEAM(6);
    if (IN(7)) _Pragma("unroll") for (int rep_ = 0; rep_ < 1 + (int)((DUP_MASK >> 7) & 1u); ++rep_) { if (rep_) GRID_BAR();  ph_topk(256, affL, affC, rowsrc, gatev, inv, (LAS unsigned*)lds, tid, lane, wave, bid, G); } SEAM(7);
    if (IN(8)) _Pragma("unroll") for (int rep_ = 0; rep_ < 1 + (int)((DUP_MASK >> 8) & 1u); ++rep_) { if (rep_) GRID_BAR();
        pg8::Gemm g{A, WGU, YT, NE * 2048, DM, rowsrc}; MoeOrder S{G, bid, 9};
        EpiPair<1> E{HM, DFF, 8};
        pg8::gemm_phase<EpiPair<1>, MoeOrder, true, true, true>(lds, g, S, E);
        CVT_TAIL(1152, CVT_R9_LO, CVT_R10_LO);
    } SEAM(8);
    if (IN(9)) _Pragma("unroll") for (int rep_ = 0; rep_ < 1 + (int)((DUP_MASK >> 9) & 1u); ++rep_) { if (rep_) GRID_BAR();
        pg8::Gemm g{HM, WDN, YT, NE * 2048, DFF}; MoeOrder S{G, bid, 9};
        EpiDown E{Y, gatev};
        pg8::gemm_phase<EpiDown, MoeOrder, true, true>(lds, g, S, E);
        CVT_TAIL(1152, CVT_R10_LO, CVT_R12_LO);
    } SEAM(9);
    if (IN(10)) _Pragma("unroll") for (int rep_ = 0; rep_ < 1 + (int)((DUP_MASK >> 10) & 1u); ++rep_) { if (rep_) GRID_BAR();  ph_combine<false>(H, Y, inv, mod, nmix + DM, mod + 9 * NMOD, A, nullptr, MT, gw, NGW, lane); } SEAM(10);
    if (IN(11)) _Pragma("unroll") for (int rep_ = 0; rep_ < 1 + (int)((DUP_MASK >> 11) & 1u); ++rep_) { if (rep_) GRID_BAR();
        pg8::Gemm g{A, WQKV, MT, 3072, DM}; QkvOrder S{G, bid};
        EpiQkv E{Qb, Kb, Vb};
        pg8::gemm_phase<EpiQkv, QkvOrder, true, true>(lds, g, S, E);
        CVT_TAIL(800, CVT_R12_LO, CVT_TOTAL);
    } SEAM(11);
    if (IN(12)) _Pragma("unroll") for (int rep_ = 0; rep_ < 1 + (int)((DUP_MASK >> 12) & 1u); ++rep_) { if (rep_) GRID_BAR();  ph_qknorm(Qb, Kb, qgain, kgain, gw, NGW, lane); } SEAM(12);
    if (IN(13)) _Pragma("unroll") for (int rep_ = 0; rep_ < 1 + (int)((DUP_MASK >> 13) & 1u); ++rep_) { if (rep_) GRID_BAR();  ph_attn(Qb, Kb, Vb, Ob, sink, lds, tid, lane, wave, bid, G); } SEAM(13);
    if (IN(14)) _Pragma("unroll") for (int rep_ = 0; rep_ < 1 + (int)((DUP_MASK >> 14) & 1u); ++rep_) { if (rep_) GRID_BAR();
        pg8::Gemm g{Ob, WOt, ML, DM, DM}; pg8::StaticOrder S; S.init(ML, DM, G, bid);
        EpiResid E{H, H + (size_t)ML * DM, H, mod + 9 * NMOD + 2 * DM};
        pg8::gemm_phase<EpiResid, pg8::StaticOrder, true, true>(lds, g, S, E);
    } SEAM(14);
    if (IN(15)) _Pragma("unroll") for (int rep_ = 0; rep_ < 1 + (int)((DUP_MASK >> 15) & 1u); ++rep_) { if (rep_) GRID_BAR();  load_router(router_w + DM * 16, (LAS float*)lds, tid); ph_modffn(H, nffn + DM, mod + 9 * NMOD, A, (const LAS float*)lds, affL, affC, ML, gw, NGW, lane); } SEAM(15);
    if (IN(16)) _Pragma("unroll") for (int rep_ = 0; rep_ < 1 + (int)((DUP_MASK >> 16) & 1u); ++rep_) { if (rep_) GRID_BAR();  ph_topk(128, affL, affC, rowsrc, gatev, inv, (LAS unsigned*)lds, tid, lane, wave, bid, G); } SEAM(16);
    if (IN(17)) _Pragma("unroll") for (int rep_ = 0; rep_ < 1 + (int)((DUP_MASK >> 17) & 1u); ++rep_) { if (rep_) GRID_BAR();
        pg8::Gemm g{A, WGU + (size_t)NE * 2048 * DM, YT, NE * 2048, DM, rowsrc}; MoeOrder S{G, bid, 8};
        EpiPair<1> E{HM, DFF, 8};
        pg8::gemm_phase<EpiPair<1>, MoeOrder, true, true, true>(lds, g, S, E);
    } SEAM(17);
    if (IN(18)) _Pragma("unroll") for (int rep_ = 0; rep_ < 1 + (int)((DUP_MASK >> 18) & 1u); ++rep_) { if (rep_) GRID_BAR();
        pg8::Gemm g{HM, WDN + (size_t)NE * 2048 * DFF, YT, NE * 2048, DFF}; MoeOrder S{G, bid, 8};
        EpiDown E{Y, gatev};
        pg8::gemm_phase<EpiDown, MoeOrder, true, true>(lds, g, S, E);
    } SEAM(18);
    if (IN(19)) _Pragma("unroll") for (int rep_ = 0; rep_ < 1 + (int)((DUP_MASK >> 19) & 1u); ++rep_) { if (rep_) GRID_BAR();  ph_combine<true>(H, Y, inv, mod + 9 * NMOD, nullptr, nullptr, nullptr, args.out, ML, gw, NGW, lane); }
#undef IN
#undef SEAM
}

extern "C" void kernel_launch(void* const* d_in, const int* in_sizes, int n_in, void* d_out, int out_size, void* d_ws, size_t ws_size, hipStream_t stream) {
    static int grid = 0;
    if (grid == 0) {
        if (n_in != 20 || out_size != ML * DM || ws_size < WS_END) { fprintf(stderr, "kernel_launch: unexpected problem (n_in %d, out %d, ws %zu); nothing launched\n", n_in, out_size, ws_size); grid = -1; return; }
        int dev = 0, cus = 0, per_cu = 0;
        if (hipGetDevice(&dev) != hipSuccess || hipDeviceGetAttribute(&cus, hipDeviceAttributeMultiprocessorCount, dev) != hipSuccess) { grid = -1; return; }
        if (hipFuncSetAttribute((const void*)dit_fwd, hipFuncAttributeMaxDynamicSharedMemorySize, LDS_BYTES) != hipSuccess) { fprintf(stderr, "kernel_launch: hipFuncSetAttribute failed\n"); grid = -1; return; }
        if (hipOccupancyMaxActiveBlocksPerMultiprocessor(&per_cu, (const void*)dit_fwd, 512, LDS_BYTES) != hipSuccess || per_cu < 1) fprintf(stderr, "kernel_launch: occupancy query reports %d workgroups per CU\n", per_cu);
        (void)hipGetLastError();
        grid = cus;
    }
    if (grid < 0) return;
    (void)hipMemsetAsync((char*)d_ws + WS_CTL, 0, CTL_ZERO_BYTES, stream);
    Args a{};
    for (int i = 0; i < 20; ++i) a.in[i] = (const float*)d_in[i];
    a.out = (float*)d_out; a.ws = (unsigned char*)d_ws;
#if MK_ONE_LAUNCH
    a.ph_lo = 0; a.ph_hi = NPHASE;
    hipLaunchKernelGGL(dit_fwd, dim3(grid), dim3(512), LDS_BYTES, stream, a);
#else
    for (int p = 0; p < NPHASE; ++p) { a.ph_lo = p; a.ph_hi = p + 1; hipLaunchKernelGGL(dit_fwd, dim3(grid), dim3(512), LDS_BYTES, stream, a); }
#endif
}
```

```cpp
#include <hip/hip_runtime.h>
#include <cstdio>
#include <cstdint>
namespace pg8 {
#define PG8_LAS __attribute__((address_space(3)))
typedef unsigned short bf16_t;
typedef short bf16x8 __attribute__((ext_vector_type(8)));
typedef float f32x4 __attribute__((ext_vector_type(4)));
typedef unsigned u32x4 __attribute__((ext_vector_type(4)));
constexpr int BM = 256, BK = 64, HALF = 128, HTB = HALF * BK * 2  , STAGE_BYTES = 8 * HTB, NXCD = 8, WGM = 8;

__host__ __device__ __forceinline__ int lds_byte(int r, int c) { const int st = (r >> 4) * 2 + (c >> 5), rr = r & 15, cc = c & 31, ob = rr * 64 + cc * 2; return st * 1024 + (ob ^ (((ob >> 9) & 1) << 5)); }
__host__ __device__ __forceinline__ void stage_rc(int b, int& R, int& C) { const int st = b / 1024, sb = b % 1024, swz = sb ^ (((sb >> 9) & 1) << 5); R = (st >> 1) * 16 + swz / 64; C = (st & 1) * 32 + (swz % 64) / 2; }
__host__ __device__ __forceinline__ int perm32(int rho) { const int n = rho >> 4, i = rho & 15; return 8 * (i >> 2) + 4 * n + (i & 3); }

struct Unit { int pm, pn; };
struct Gemm { const bf16_t* A; const bf16_t* Bt; int M, N, K; const int* rows = nullptr; };

struct StaticOrder {
    int nM, nN, nwg, G, c;
    __host__ __device__ void init(int M, int N, int G_, int c_) { nM = M / BM; nN = N / BM; nwg = nM * nN; G = G_; c = c_; }
    __host__ __device__ bool next(int i, Unit& u) const {
        const long L = (long)i * G + c; if (L >= nwg) return false;
        int wgid = (int)L; { const int q = nwg / NXCD, r = nwg % NXCD, xcd = wgid % NXCD, off = wgid / NXCD; wgid = (xcd < r ? xcd * (q + 1) : r * (q + 1) + (xcd - r) * q) + off; }
        const int nig = WGM * nN, gid = wgid / nig, fm = gid * WGM, gsz = (nM - fm) < WGM ? (nM - fm) : WGM;
        u.pm = fm + ((wgid % nig) % gsz); u.pn = (wgid % nig) / gsz; return true;
    }
    __device__ __forceinline__ void a_ready(const Unit&) const {}
    __device__ __forceinline__ void done(const Unit&) const {}
};
__device__ __forceinline__ unsigned cvt_pk_bf16(float lo, float hi) { unsigned r; asm volatile("v_cvt_pk_bf16_f32 %0, %1, %2" : "=v"(r) : "v"(lo), "v"(hi)); return r; }
typedef float f32x2 __attribute__((ext_vector_type(2)));
template <class Epi, class Sched, bool ALIGN_EPI = false, bool SP2 = false, bool GATHER = false>
__device__ __forceinline__ void gemm_phase(PG8_LAS unsigned char* lds, const Gemm g, const Sched& S, const Epi& E) {
    const int tid = threadIdx.x, wid = __builtin_amdgcn_readfirstlane(tid >> 6), lane = tid & 63, wr = wid >> 2, wc = wid & 3, fr = lane & 15, fq = lane >> 4;
    const int K = g.K, nt = K / BK;
    unsigned voffA[2], voffB[2];
#pragma unroll
    for (int i = 0; i < 2; ++i) { int R, C; stage_rc(tid * 16 + i * 8192, R, C); const int Rb = Epi::PERM ? ((R & ~31) + perm32(R & 31)) : R;
        voffA[i] = (unsigned)(R * K + C) * 2u; voffB[i] = (unsigned)(Rb * K + C) * 2u; }
    const size_t kstep = (size_t)(BK * 2);
    const size_t hstep = (size_t)HALF * K * 2;
    const size_t tstep = 2 * hstep;
    const unsigned ldsw = (unsigned)wid * 1024u;
    const int aoff = lds_byte(wr * 64 + fr, fq * 8), boff = lds_byte(wc * 32 + fr, fq * 8);
#define PG8_SA(b, h) (((b) * 2 + (h)) * HTB)
#define PG8_SB(b, h) ((4 + (b) * 2 + (h)) * HTB)
#define PG8_STAGE(bufoff, gbase, voff) do { _Pragma("unroll") for (int _i = 0; _i < 2; ++_i) \
        __builtin_amdgcn_global_load_lds((const unsigned*)((const char*)(gbase) + (voff)[_i]), (PG8_LAS unsigned*)(lds + (bufoff) + ldsw + _i * 8192), 16, 0, 0); } while (0)
#define PG8_STAGE_A(bufoff, kptr, h) do { if constexpr (GATHER) { PG8_STAGE(bufoff, kptr, vA[h]); } else { PG8_STAGE(bufoff, (kptr) + (h) * hstep, voffA); } } while (0)
#define PG8_GATHER_SWITCH() do { if constexpr (GATHER) { if (last && has_next) { asm volatile("" : "+v"(nv[0]), "+v"(nv[1]), "+v"(nv[2]), "+v"(nv[3])); \
        vA[0][0] = nv[0] * (unsigned)(K * 2) + gcoff[0]; vA[0][1] = nv[1] * (unsigned)(K * 2) + gcoff[1]; vA[1][0] = nv[2] * (unsigned)(K * 2) + gcoff[0]; vA[1][1] = nv[3] * (unsigned)(K * 2) + gcoff[1]; } } } while (0)
#define PG8_LDA(dst, b, h) do { _Pragma("unroll") for (int m = 0; m < 4; ++m) _Pragma("unroll") for (int k = 0; k < 2; ++k) dst[m][k] = *(const PG8_LAS bf16x8*)(lds + PG8_SA(b, h) + aoff + m * 2048 + k * 1024); } while (0)
#define PG8_LDB(dst, b, h) do { _Pragma("unroll") for (int n = 0; n < 2; ++n) _Pragma("unroll") for (int k = 0; k < 2; ++k) dst[n][k] = *(const PG8_LAS bf16x8*)(lds + PG8_SB(b, h) + boff + n * 2048 + k * 1024); } while (0)
#define PG8_MMA(ai, bj, At, Bt) do { __builtin_amdgcn_s_setprio(1); _Pragma("unroll") for (int m = 0; m < 4; ++m) _Pragma("unroll") for (int n = 0; n < 2; ++n) _Pragma("unroll") for (int k = 0; k < 2; ++k) \
        acc[ai][bj][m][n] = __builtin_amdgcn_mfma_f32_16x16x32_bf16(Bt[n][k], At[m][k], acc[ai][bj][m][n], 0, 0, 0); __builtin_amdgcn_s_setprio(0); } while (0)
#define PG8_WAIT_V(n) asm volatile("s_waitcnt vmcnt(" #n ")" ::: "memory")
#define PG8_WAIT_L(n) asm volatile("s_waitcnt lgkmcnt(" #n ")" ::: "memory")
#define PG8_BAR __builtin_amdgcn_s_barrier()
#define PG8_SCHED __builtin_amdgcn_sched_barrier(0)
    Unit cur, nxt; int ui = 0;
    if (!S.next(0, cur)) return;
    f32x4 acc[2][2][4][2];
#pragma unroll
    for (int a = 0; a < 2; ++a)
#pragma unroll
        for (int b = 0; b < 2; ++b)
#pragma unroll
            for (int m = 0; m < 4; ++m)
#pragma unroll
                for (int n = 0; n < 2; ++n) acc[a][b][m][n] = (f32x4){0.f, 0.f, 0.f, 0.f};
    bf16x8 At[4][2], B0[2][2], B1[2][2];
    const char* cA = (const char*)g.A + (GATHER ? (size_t)0 : (size_t)cur.pm * tstep); const char* cB = (const char*)g.Bt + (size_t)cur.pn * tstep;
    unsigned vA[2][2], nv[4], gcoff[2]; int grow[2];
    if constexpr (GATHER) {
#pragma unroll
        for (int i = 0; i < 2; ++i) { int R, C; stage_rc(tid * 16 + i * 8192, R, C); grow[i] = R; gcoff[i] = (unsigned)(C * 2); }
#pragma unroll
        for (int h = 0; h < 2; ++h)
#pragma unroll
            for (int i = 0; i < 2; ++i) vA[h][i] = (unsigned)g.rows[cur.pm * BM + h * HALF + grow[i]] * (unsigned)(K * 2) + gcoff[i];
    }
    S.a_ready(cur);
    if constexpr (SP2) {
        PG8_STAGE(PG8_SB(0, 0), cB, voffB); PG8_STAGE(PG8_SB(0, 1), cB + hstep, voffB); PG8_STAGE_A(PG8_SA(0, 0), cA, 0); PG8_STAGE_A(PG8_SA(0, 1), cA, 1);
        if (wr == 1) PG8_BAR;
        PG8_WAIT_V(2); PG8_BAR;
        PG8_STAGE(PG8_SB(1, 0), cB + kstep, voffB); PG8_STAGE_A(PG8_SA(1, 0), cA + kstep, 0); PG8_STAGE(PG8_SB(1, 1), cB + hstep + kstep, voffB);
        PG8_WAIT_V(6); PG8_BAR;
    } else {
        PG8_STAGE(PG8_SB(0, 0), cB, voffB); PG8_STAGE_A(PG8_SA(0, 0), cA, 0); PG8_STAGE(PG8_SB(0, 1), cB + hstep, voffB); PG8_STAGE_A(PG8_SA(0, 1), cA, 1);
        if (wr == 1) PG8_BAR;
        PG8_WAIT_V(4); PG8_BAR;
        PG8_STAGE(PG8_SB(1, 0), cB + kstep, voffB); PG8_STAGE_A(PG8_SA(1, 0), cA + kstep, 0); PG8_STAGE(PG8_SB(1, 1), cB + hstep + kstep, voffB);
        PG8_WAIT_V(6); PG8_BAR;
    }
    for (;;) {
        const bool has_next = S.next(ui + 1, nxt);
        const char* nA = (has_next && !GATHER) ? (const char*)g.A + (size_t)nxt.pm * tstep : cA; const char* nB = has_next ? (const char*)g.Bt + (size_t)nxt.pn * tstep : cB;
        if constexpr (GATHER) { if (has_next) { const int* rp = g.rows + nxt.pm * BM;
            asm volatile("global_load_dword %0, %1, off" : "=&v"(nv[0]) : "v"(rp + grow[0]) : "memory"); asm volatile("global_load_dword %0, %1, off" : "=&v"(nv[1]) : "v"(rp + grow[1]) : "memory");
            asm volatile("global_load_dword %0, %1, off" : "=&v"(nv[2]) : "v"(rp + HALF + grow[0]) : "memory"); asm volatile("global_load_dword %0, %1, off" : "=&v"(nv[3]) : "v"(rp + HALF + grow[1]) : "memory"); } }
        for (int t = 0; t < nt; t += 2) {
            const bool last = (t == nt - 2);
            const char* a1 = cA + (size_t)(t + 1) * kstep;
            const char* a2 = last ? nA : cA + (size_t)(t + 2) * kstep; const char* b2 = last ? nB : cB + (size_t)(t + 2) * kstep;
            const char* a3 = a2 + kstep; const char* b3 = b2 + kstep;
            if (last && has_next) S.a_ready(nxt);
            if constexpr (SP2) {
            PG8_LDB(B0, 0, 0); PG8_LDB(B1, 0, 1); PG8_SCHED; PG8_LDA(At, 0, 0); PG8_STAGE_A(PG8_SA(1, 1), a1, 1); PG8_GATHER_SWITCH();
            PG8_WAIT_V(8); PG8_WAIT_L(0); PG8_BAR; PG8_MMA(0, 0, At, B0); PG8_MMA(0, 1, At, B1); PG8_BAR; PG8_SCHED;
            PG8_LDA(At, 0, 1); PG8_STAGE(PG8_SB(0, 0), b2, voffB); PG8_STAGE(PG8_SB(0, 1), b2 + hstep, voffB); PG8_STAGE_A(PG8_SA(0, 0), a2, 0);
            PG8_WAIT_V(8); PG8_WAIT_L(0); PG8_BAR; PG8_MMA(1, 0, At, B0); PG8_MMA(1, 1, At, B1); PG8_BAR; PG8_SCHED;
            PG8_LDB(B0, 1, 0); PG8_LDB(B1, 1, 1); PG8_SCHED; PG8_LDA(At, 1, 0); PG8_STAGE_A(PG8_SA(0, 1), a2, 1);
            PG8_WAIT_V(8); PG8_WAIT_L(0); PG8_BAR; PG8_MMA(0, 0, At, B0); PG8_MMA(0, 1, At, B1); PG8_BAR; PG8_SCHED;
            PG8_LDA(At, 1, 1); PG8_STAGE(PG8_SB(1, 0), b3, voffB); PG8_STAGE(PG8_SB(1, 1), b3 + hstep, voffB); PG8_STAGE_A(PG8_SA(1, 0), a3, 0);
            PG8_WAIT_V(8); PG8_WAIT_L(0); PG8_BAR; PG8_MMA(1, 0, At, B0); PG8_MMA(1, 1, At, B1); PG8_BAR; PG8_SCHED;
            } else {
            PG8_LDB(B0, 0, 0); PG8_SCHED; PG8_LDA(At, 0, 0); PG8_STAGE_A(PG8_SA(1, 1), a1, 1); PG8_GATHER_SWITCH();
            PG8_WAIT_L(8); PG8_BAR; PG8_WAIT_L(0); PG8_MMA(0, 0, At, B0); PG8_BAR; PG8_SCHED;
            PG8_LDB(B1, 0, 1); PG8_STAGE(PG8_SB(0, 0), b2, voffB);
            PG8_BAR; PG8_WAIT_L(0); PG8_MMA(0, 1, At, B1); PG8_BAR;
            PG8_LDA(At, 0, 1); PG8_STAGE_A(PG8_SA(0, 0), a2, 0);
            PG8_BAR; PG8_WAIT_L(0); PG8_MMA(1, 0, At, B0); PG8_BAR; PG8_SCHED;
            PG8_STAGE(PG8_SB(0, 1), b2 + hstep, voffB);
            PG8_WAIT_V(6); PG8_BAR; PG8_MMA(1, 1, At, B1); PG8_BAR;
            PG8_LDB(B0, 1, 0); PG8_SCHED; PG8_LDA(At, 1, 0); PG8_STAGE_A(PG8_SA(0, 1), a2, 1);
            PG8_WAIT_L(8); PG8_BAR; PG8_WAIT_L(0); PG8_MMA(0, 0, At, B0); PG8_BAR; PG8_SCHED;
            PG8_LDB(B1, 1, 1); PG8_STAGE(PG8_SB(1, 0), b3, voffB);
            PG8_BAR; PG8_WAIT_L(0); PG8_MMA(0, 1, At, B1); PG8_BAR;
            PG8_LDA(At, 1, 1); PG8_STAGE_A(PG8_SA(1, 0), a3, 0);
            PG8_BAR; PG8_WAIT_L(0); PG8_MMA(1, 0, At, B0); PG8_BAR; PG8_SCHED;
            PG8_STAGE(PG8_SB(1, 1), b3 + hstep, voffB);
            PG8_WAIT_V(6); PG8_BAR; PG8_MMA(1, 1, At, B1); PG8_BAR;
            }
        }
        if constexpr (ALIGN_EPI) { if (wr == 0) PG8_BAR; }
        if constexpr (!Epi::AFTER_DRAIN) { E(acc, cur, wr, wc, fr, fq); S.done(cur); }
        if (!has_next) break;
#pragma unroll
        for (int a = 0; a < 2; ++a)
#pragma unroll
            for (int b = 0; b < 2; ++b)
#pragma unroll
                for (int m = 0; m < 4; ++m)
#pragma unroll
                    for (int n = 0; n < 2; ++n) acc[a][b][m][n] = (f32x4){0.f, 0.f, 0.f, 0.f};
        cur = nxt; cA = nA; cB = nB; ++ui;
        if constexpr (ALIGN_EPI) { if (wr == 1) PG8_BAR; }
    }
    PG8_WAIT_V(0);
    if constexpr (!ALIGN_EPI) { if (wr == 0) PG8_BAR; }
    PG8_BAR;
    if constexpr (Epi::AFTER_DRAIN) { E.fused(acc, cur, wr, wc, fr, fq, lds, wid, lane); S.done(cur); }
#undef PG8_SA
#undef PG8_SB
#undef PG8_STAGE
#undef PG8_STAGE_A
#undef PG8_GATHER_SWITCH
#undef PG8_LDA
#undef PG8_LDB
#undef PG8_MMA
#undef PG8_WAIT_V
#undef PG8_WAIT_L
#undef PG8_BAR
#undef PG8_SCHED
}
}

constexpr int DM = 2048, NB = 8, SEQ = 2048, CTXL = 256, NH = 16, NKV = 4, HD = 128;
constexpr int ML = NB * SEQ;
constexpr int MC = NB * CTXL;
constexpr int MT = ML + MC;
constexpr int NE = 16, CAPL = 256, CAPC = 32, DFF = 1024;
constexpr int YR = NB * CAPL + NB * CAPC;
constexpr int YT = NE * YR;
constexpr int NMOD = 6 * DM;
constexpr float NORM_EPS = 1e-6f;
constexpr int KSPLIT = 16;

using pg8::Unit; using pg8::f32x4; using pg8::u32x4; using pg8::bf16_t; using pg8::bf16x8; using pg8::cvt_pk_bf16;
typedef float f32x2 __attribute__((ext_vector_type(2)));
typedef unsigned u32x2 __attribute__((ext_vector_type(2)));
typedef float f32x16 __attribute__((ext_vector_type(16)));
typedef short s16x4 __attribute__((ext_vector_type(4)));
#define DI __device__ __forceinline__

DI float bf_lo(unsigned w) { return __uint_as_float(w << 16); }
DI float bf_hi(unsigned w) { return __uint_as_float(w & 0xffff0000u); }
DI float silu_f(float a) { return a * __builtin_amdgcn_rcpf(1.0f + __expf(-a)); }

DI int xcd_remap(int wgid, int nwg) { const int q = nwg / 8, r = nwg % 8, xcd = wgid % 8, off = wgid / 8; return (xcd < r ? xcd * (q + 1) : r * (q + 1) + (xcd - r) * q) + off; }
struct QkvOrder {
    int G, c;
    DI bool next(int i, Unit& u) const {
        const int L = i * G + c; if (L >= 800) return false;
        if (L < 768) { const int w = xcd_remap(L, 768); const int nig = 8 * 12, gid = w / nig; u.pm = gid * 8 + ((w % nig) % 8); u.pn = (w % nig) / 8; }
        else { const int j = L - 768; u.pm = 64 + (j >> 2); u.pn = 8 + (j & 3); }
        return true;
    }
    DI void a_ready(const Unit&) const {}
    DI void done(const Unit&) const {}
};
struct MoeOrder {
    int G, c, NP;
    DI bool next(int i, Unit& u) const {
        const int nwg = NE * NP * 8; const int L = i * G + c; if (L >= nwg) return false;
        const int w = xcd_remap(L, nwg); const int per = NP * 8, e = w / per, rem = w % per;
        u.pm = e * 9 + (rem % NP); u.pn = e * 8 + (rem / NP); return true;
    }
    DI void a_ready(const Unit&) const {}
    DI void done(const Unit&) const {}
};

template <int ACT  > struct EpiPair {
    static constexpr bool PERM = true, AFTER_DRAIN = false;
    bf16_t* O; int ldc; int pn_mod;
    DI void operator()(const f32x4 (&acc)[2][2][4][2], const Unit& u, int wr, int wc, int fr, int fq) const {
        const int row0 = u.pm * 256 + wr * 64 + fr, col0 = (u.pn % pn_mod) * 128 + wc * 32 + 8 * fq;
#pragma unroll
        for (int ai = 0; ai < 2; ++ai)
#pragma unroll
            for (int m = 0; m < 4; ++m) {
                bf16_t* rowp = O + (size_t)(row0 + ai * 128 + m * 16) * ldc + col0;
                f32x4 a0 = acc[ai][0][m][0], a1 = acc[ai][0][m][1]; const f32x4 b0 = acc[ai][1][m][0], b1 = acc[ai][1][m][1];
                if (ACT == 1) {
#pragma unroll
                    for (int j = 0; j < 4; ++j) { a0[j] = silu_f(a0[j]); a1[j] = silu_f(a1[j]); } }
                const f32x4 v0 = a0 * b0, v1 = a1 * b1;
                u32x4 w; w.x = cvt_pk_bf16(v0[0], v0[1]); w.y = cvt_pk_bf16(v0[2], v0[3]); w.z = cvt_pk_bf16(v1[0], v1[1]); w.w = cvt_pk_bf16(v1[2], v1[3]);
                *(u32x4*)rowp = w;
            }
    }
};
struct EpiConvGate {
    static constexpr bool PERM = true, AFTER_DRAIN = false;
    const bf16_t* U; bf16_t* Z; const float* cw;
    DI void operator()(const f32x4 (&acc)[2][2][4][2], const Unit& u, int wr, int wc, int fr, int fq) const {
        const int row0 = u.pm * 256 + wr * 64 + fr, col0 = u.pn * 256 + wc * 32 + 8 * fq;
#pragma unroll
        for (int bj = 0; bj < 2; ++bj) {
            const int c = col0 + bj * 128;
            f32x4 w0a = *(const f32x4*)(cw + c), w0b = *(const f32x4*)(cw + c + 4), w1a = *(const f32x4*)(cw + 2048 + c), w1b = *(const f32x4*)(cw + 2048 + c + 4), w2a = *(const f32x4*)(cw + 4096 + c), w2b = *(const f32x4*)(cw + 4096 + c + 4);
#pragma unroll
            for (int ai = 0; ai < 2; ++ai)
#pragma unroll
                for (int m = 0; m < 4; ++m) {
                    const int row = row0 + ai * 128 + m * 16;
                    const int tpos = row < ML ? (row & (SEQ - 1)) : ((row - ML) & (CTXL - 1)); const int len = row < ML ? SEQ : CTXL;
                    const u32x4 z4 = (u32x4){0u, 0u, 0u, 0u};
                    const u32x4 uc = *(const u32x4*)(U + (size_t)row * DM + c);
                    const u32x4 up = tpos > 0 ? *(const u32x4*)(U + (size_t)(row - 1) * DM + c) : z4;
                    const u32x4 un = tpos < len - 1 ? *(const u32x4*)(U + (size_t)(row + 1) * DM + c) : z4;
                    f32x4 ya, yb;
                    ya[0] = w0a[0] * bf_lo(up.x) + w1a[0] * bf_lo(uc.x) + w2a[0] * bf_lo(un.x); ya[1] = w0a[1] * bf_hi(up.x) + w1a[1] * bf_hi(uc.x) + w2a[1] * bf_hi(un.x);
                    ya[2] = w0a[2] * bf_lo(up.y) + w1a[2] * bf_lo(uc.y) + w2a[2] * bf_lo(un.y); ya[3] = w0a[3] * bf_hi(up.y) + w1a[3] * bf_hi(uc.y) + w2a[3] * bf_hi(un.y);
                    yb[0] = w0b[0] * bf_lo(up.z) + w1b[0] * bf_lo(uc.z) + w2b[0] * bf_lo(un.z); yb[1] = w0b[1] * bf_hi(up.z) + w1b[1] * bf_hi(uc.z) + w2b[1] * bf_hi(un.z);
                    yb[2] = w0b[2] * bf_lo(up.w) + w1b[2] * bf_lo(uc.w) + w2b[2] * bf_lo(un.w); yb[3] = w0b[3] * bf_hi(up.w) + w1b[3] * bf_hi(uc.w) + w2b[3] * bf_hi(un.w);
                    const f32x4 v0 = acc[ai][bj][m][0] * ya, v1 = acc[ai][bj][m][1] * yb;
                    u32x4 w; w.x = cvt_pk_bf16(v0[0], v0[1]); w.y = cvt_pk_bf16(v0[2], v0[3]); w.z = cvt_pk_bf16(v1[0], v1[1]); w.w = cvt_pk_bf16(v1[2], v1[3]);
                    *(u32x4*)(Z + (size_t)row * DM + c) = w;
                }
        }
    }
};
struct EpiResid {
    static constexpr bool PERM = false, AFTER_DRAIN = false;
    const float* base_lat; const float* base_ctx; float* out; const float* gate;
    DI void operator()(const f32x4 (&acc)[2][2][4][2], const Unit& u, int wr, int wc, int fr, int fq) const {
        const int rowt = u.pm * 256; const int cr = rowt < ML ? (rowt >> 11) : 8;
        const float* base = rowt < ML ? base_lat : base_ctx - (size_t)ML * DM;
        const int row0 = rowt + wr * 64 + fr, col0 = u.pn * 256 + wc * 32 + 4 * fq;
        f32x4 gv[2][2];
#pragma unroll
        for (int bj = 0; bj < 2; ++bj)
#pragma unroll
            for (int n = 0; n < 2; ++n) gv[bj][n] = *(const f32x4*)(gate + (size_t)cr * NMOD + col0 + bj * 128 + n * 16);
#pragma unroll
        for (int ai = 0; ai < 2; ++ai)
#pragma unroll
            for (int m = 0; m < 4; ++m) { const size_t off = (size_t)(row0 + ai * 128 + m * 16) * DM + col0;
#pragma unroll
                for (int bj = 0; bj < 2; ++bj)
#pragma unroll
                    for (int n = 0; n < 2; ++n) { const f32x4 bs = *(const f32x4*)(base + off + bj * 128 + n * 16); *(f32x4*)(out + off + bj * 128 + n * 16) = bs + gv[bj][n] * acc[ai][bj][m][n]; }
                asm volatile("" ::: "memory"); }
    }
};
struct EpiDown {
    static constexpr bool PERM = true, AFTER_DRAIN = false;
    bf16_t* Y; const float* gatev;
    DI void operator()(const f32x4 (&acc)[2][2][4][2], const Unit& u, int wr, int wc, int fr, int fq) const {
        const int row0 = u.pm * 256 + wr * 64 + fr, col0 = (u.pn & 7) * 256 + wc * 32 + 8 * fq;
#pragma unroll
        for (int ai = 0; ai < 2; ++ai)
#pragma unroll
            for (int m = 0; m < 4; ++m) { const int row = row0 + ai * 128 + m * 16; const float gt = gatev[row];
#pragma unroll
                for (int bj = 0; bj < 2; ++bj) { const f32x4 v0 = acc[ai][bj][m][0] * gt, v1 = acc[ai][bj][m][1] * gt;
                    u32x4 w; w.x = cvt_pk_bf16(v0[0], v0[1]); w.y = cvt_pk_bf16(v0[2], v0[3]); w.z = cvt_pk_bf16(v1[0], v1[1]); w.w = cvt_pk_bf16(v1[2], v1[3]);
                    *(u32x4*)(Y + (size_t)row * DM + col0 + bj * 128) = w; } }
    }
};
struct EpiQkv {
    static constexpr bool PERM = true, AFTER_DRAIN = false;
    bf16_t* Q; bf16_t* K; bf16_t* V;
    DI void operator()(const f32x4 (&acc)[2][2][4][2], const Unit& u, int wr, int wc, int fr, int fq) const {
        const int row0 = u.pm * 256 + wr * 64 + fr; int colt = u.pn * 256; bf16_t* base; int ld;
        if (colt < 2048) { base = Q; ld = 2048; } else if (colt < 2560) { base = K; ld = 512; colt -= 2048; } else { base = V; ld = 512; colt -= 2560; }
        const int col0 = colt + wc * 32 + 8 * fq;
#pragma unroll
        for (int ai = 0; ai < 2; ++ai)
#pragma unroll
            for (int m = 0; m < 4; ++m) { bf16_t* rowp = base + (size_t)(row0 + ai * 128 + m * 16) * ld + col0;
#pragma unroll
                for (int bj = 0; bj < 2; ++bj) { const f32x4 v0 = acc[ai][bj][m][0], v1 = acc[ai][bj][m][1];
                    u32x4 w; w.x = cvt_pk_bf16(v0[0], v0[1]); w.y = cvt_pk_bf16(v0[2], v0[3]); w.z = cvt_pk_bf16(v1[0], v1[1]); w.w = cvt_pk_bf16(v1[2], v1[3]);
                    *(u32x4*)(rowp + bj * 128) = w; } }
    }
};

#define LAS3 __attribute__((address_space(3)))
struct EpiQkvNorm {
    static constexpr bool PERM = true, AFTER_DRAIN = false;
    bf16_t* Q; bf16_t* K; bf16_t* V; const float* qg; const float* kg; LAS3 float* P;
    DI void operator()(const f32x4 (&acc)[2][2][4][2], const Unit& u, int wr, int wc, int fr, int fq) const {
        const int row0 = u.pm * 256 + wr * 64 + fr; int colt = u.pn * 256;
        if (colt >= 2560) {
            const int col0 = colt - 2560 + wc * 32 + 8 * fq;
#pragma unroll
            for (int ai = 0; ai < 2; ++ai)
#pragma unroll
                for (int m = 0; m < 4; ++m) { bf16_t* rowp = V + (size_t)(row0 + ai * 128 + m * 16) * 512 + col0;
#pragma unroll
                    for (int bj = 0; bj < 2; ++bj) { const f32x4 v0 = acc[ai][bj][m][0], v1 = acc[ai][bj][m][1];
                        u32x4 w; w.x = cvt_pk_bf16(v0[0], v0[1]); w.y = cvt_pk_bf16(v0[2], v0[3]); w.z = cvt_pk_bf16(v1[0], v1[1]); w.w = cvt_pk_bf16(v1[2], v1[3]);
                        *(u32x4*)(rowp + bj * 128) = w; } }
            return;
        }
        const bool isq = colt < 2048; bf16_t* base = isq ? Q : K; const int ld = isq ? 2048 : 512; if (!isq) colt -= 2048;
        const int rl0 = wr * 64 + fr;
#pragma unroll
        for (int ai = 0; ai < 2; ++ai)
#pragma unroll
            for (int m = 0; m < 4; ++m)
#pragma unroll
                for (int bj = 0; bj < 2; ++bj) { const f32x4 a = acc[ai][bj][m][0], b = acc[ai][bj][m][1];
                    float s = (a[0] * a[0] + a[1] * a[1]) + (a[2] * a[2] + a[3] * a[3]) + (b[0] * b[0] + b[1] * b[1]) + (b[2] * b[2] + b[3] * b[3]);
                    s += __shfl_xor(s, 16); s += __shfl_xor(s, 32);
                    if (fq == 0) P[((ai * 128 + m * 16 + rl0) * 2 + bj) * 4 + wc] = s; }
        asm volatile("s_waitcnt lgkmcnt(0)" ::: "memory"); __builtin_amdgcn_s_barrier(); asm volatile("" ::: "memory");
        constexpr float QSCALE = 0.08838834764831845f * 1.4426950408889634f;
        const int i0 = 16 * (wc & 1) + 4 * fq, d0 = 64 * (wc >> 1) + i0;
        const float* gp = isq ? qg : kg; f32x4 g0 = *(const f32x4*)(gp + d0), g1 = *(const f32x4*)(gp + d0 + 32);
        if (isq) { g0 = g0 * QSCALE; g1 = g1 * QSCALE; }
        f32x4 ifr;
#pragma unroll
        for (int j = 0; j < 4; ++j) ifr[j] = exp2f(-(float)(i0 + j) * (13.287712379549449f / 32.0f));
        const bool lat = u.pm < 64;
#pragma unroll
        for (int ai = 0; ai < 2; ++ai)
#pragma unroll
            for (int m = 0; m < 4; ++m) { const int row = row0 + ai * 128 + m * 16; const int t = row & (SEQ - 1);
                const float pos = (float)((wc >> 1) == 0 ? (t >> 6) : (t & 63));
                f32x4 cs, sn;
#pragma unroll
                for (int j = 0; j < 4; ++j) { const float ang = pos * ifr[j]; cs[j] = lat ? __cosf(ang) : 1.0f; sn[j] = lat ? __sinf(ang) : 0.0f; }
#pragma unroll
                for (int bj = 0; bj < 2; ++bj) { const f32x4 pp = *(const LAS3 f32x4*)(P + ((ai * 128 + m * 16 + rl0) * 2 + bj) * 4);
                    const float rstd = 1.0f / sqrtf(((pp[0] + pp[1]) + (pp[2] + pp[3])) * (1.0f / HD) + NORM_EPS);
                    const f32x4 a = acc[ai][bj][m][0] * rstd * g0, b = acc[ai][bj][m][1] * rstd * g1;
                    const f32x4 o1 = a * cs - b * sn, o2 = b * cs + a * sn;
                    u32x4 w; w.x = cvt_pk_bf16(o1[0], o1[1]); w.y = cvt_pk_bf16(o1[2], o1[3]); w.z = cvt_pk_bf16(o2[0], o2[1]); w.w = cvt_pk_bf16(o2[2], o2[3]);
                    *(u32x4*)(base + (size_t)row * ld + colt + bj * 128 + wc * 32 + 8 * fq) = w; } }
    }
};

constexpr size_t MiB = 1u << 20;
constexpr size_t WS_CTL = 0, CTL_ZERO_BYTES = 1 * MiB;
constexpr size_t WS_MOD = 1 * MiB;
constexpr size_t WS_MODP = 2 * MiB;
constexpr size_t WS_AFFL = 16 * MiB;
constexpr size_t WS_AFFC = 17 * MiB;
constexpr size_t WS_ROWSRC = 17 * MiB + 512 * 1024;
constexpr size_t WS_GATEV = 18 * MiB;
constexpr size_t WS_INV = 18 * MiB + 512 * 1024;
constexpr size_t WS_W1A = 20 * MiB;
constexpr size_t WS_W1B = 36 * MiB;
constexpr size_t WS_W2 = 44 * MiB;
constexpr size_t WS_WQKV = 52 * MiB;
constexpr size_t WS_WO = 64 * MiB;
constexpr size_t WS_WGU = 72 * MiB;
constexpr size_t WS_WDN = 328 * MiB;
constexpr size_t WS_H = 456 * MiB;
constexpr size_t WS_A = 600 * MiB;
constexpr size_t WS_U = 672 * MiB;
constexpr size_t WS_Z = 744 * MiB;
constexpr size_t WS_Q = WS_U, WS_K = WS_Z, WS_V = WS_Z + 18 * MiB;
constexpr size_t WS_HM = 816 * MiB;
constexpr size_t WS_O = WS_HM;
constexpr size_t WS_Y = 888 * MiB;
constexpr size_t WS_XS = WS_Y;
constexpr size_t WS_END = 1032 * MiB;
constexpr int CW_BAR = 4096;

constexpr int RING_BYTES = 131072;
constexpr int MISC_OFF = RING_BYTES + 14336;
constexpr int LDS_BYTES = 147456;

#define GAS __attribute__((address_space(1)))
#define LAS __attribute__((address_space(3)))
#define LDS_WAIT() asm volatile("s_waitcnt lgkmcnt(0)" ::: "memory")
#define VM_WAIT() asm volatile("s_waitcnt vmcnt(0)" ::: "memory")
#define XB_TMO      128
#define XB_XCNT(j)  (256  + 64 * (j))
#define XB_XSUB(j)  (1280 + 64 * (j))
#define XB_XGEN(j)  (2304 + 64 * (j))
#define XB_TOP      3328
#define XB_TOPGEN   3392
#define XCD_BAR_WORDS 3456
#define XB_SPIN_CAP (1u << 18)

__device__ __forceinline__ unsigned xb_ld(unsigned* p)              { return __hip_atomic_load(p, __ATOMIC_RELAXED, __HIP_MEMORY_SCOPE_AGENT); }
__device__ __forceinline__ unsigned xb_add(unsigned* p, unsigned v) { return __hip_atomic_fetch_add(p, v, __ATOMIC_RELAXED, __HIP_MEMORY_SCOPE_AGENT); }
__device__ __forceinline__ unsigned xb_xcc_id() { return (unsigned)__builtin_amdgcn_s_getreg((3 << 11) | 20) & 0xFu; }
#define XB_SPIN(cond, bar) do { unsigned _sp = 0; while (cond) { __builtin_amdgcn_s_sleep(1); \
    if ((++_sp & 255u) == 0u) { if (xb_ld(&(bar)[XB_TMO])) break; if (_sp > XB_SPIN_CAP) { atomicAdd(&(bar)[XB_TMO], 1u); break; } } } } while (0)

struct XcdBarrier {
    unsigned* bar; unsigned x;
    volatile LAS unsigned* st;
};

__device__ __forceinline__ XcdBarrier xcd_barrier_post(unsigned* bar, volatile LAS unsigned* st) {
    XcdBarrier b; b.bar = bar; b.x = xb_xcc_id(); b.st = st;
    if (threadIdx.x == 0) (void)xb_add(&bar[XB_XCNT(b.x)], 1u);
    return b;
}
__device__ __forceinline__ void xcd_barrier_complete(unsigned* bar, unsigned x, unsigned& nloc, unsigned& nx) {
    const unsigned G = gridDim.x * gridDim.y * gridDim.z;
    unsigned sum, cnt, mine, sp = 0u;
    for (;;) {
        sum = 0u; cnt = 0u; mine = 0u;
#pragma unroll
        for (unsigned j = 0; j < 16; ++j) { const unsigned c = xb_ld(&bar[XB_XCNT(j)]); sum += c; cnt += (c > 0u) ? 1u : 0u; mine = (j == x) ? c : mine; }
        if (sum == G) break;
        __builtin_amdgcn_s_sleep(1);
        if ((++sp & 255u) == 0u) { if (xb_ld(&bar[XB_TMO])) break; if (sp > XB_SPIN_CAP) { atomicAdd(&bar[XB_TMO], 1u); break; } }
    }
    nloc = mine > 0u ? mine : 1u; nx = cnt > 0u ? cnt : 1u;
}

__device__ __forceinline__ void xcd_barrier(const XcdBarrier& b) {
    asm volatile("s_waitcnt vmcnt(0)" ::: "memory");
    __syncthreads();
    if (threadIdx.x == 0) {
        unsigned* bar = b.bar;
        __builtin_amdgcn_s_waitcnt(0);
        unsigned nloc = b.st[0], nx = b.st[1];
        if (nloc == 0u) { xcd_barrier_complete(bar, b.x, nloc, nx); b.st[0] = nloc; b.st[1] = nx; }
        const unsigned old = xb_add(&bar[XB_XSUB(b.x)], 1u);
        const unsigned gen = old / nloc;
        if (old + 1u == (gen + 1u) * nloc) {
            __builtin_amdgcn_fence(__ATOMIC_RELEASE, "agent");
            asm volatile("s_waitcnt vmcnt(0)" ::: "memory");
            const unsigned og = xb_add(&bar[XB_TOP], 1u);
            const unsigned tg = og / nx;
            if (og + 1u == (tg + 1u) * nx) xb_add(&bar[XB_TOPGEN], 1u);
            else XB_SPIN(xb_ld(&bar[XB_TOPGEN]) == tg, bar);
            __builtin_amdgcn_fence(__ATOMIC_ACQUIRE, "agent");
            xb_add(&bar[XB_XGEN(b.x)], 1u);
            asm volatile("s_waitcnt vmcnt(0)" ::: "memory");
        } else {
            XB_SPIN(xb_ld(&bar[XB_XGEN(b.x)]) == gen, bar);
            __builtin_amdgcn_fence(__ATOMIC_ACQUIRE, "agent");
            asm volatile("s_waitcnt vmcnt(0)" ::: "memory");
        }
    }
    __syncthreads();
}

DI float wave_sum(float v) {
#pragma unroll
    for (int o = 1; o < 64; o <<= 1) v += __shfl_xor(v, o);
    return v;
}
DI float rdlane(float v, int l) { return __uint_as_float((unsigned)__builtin_amdgcn_readlane((int)__float_as_uint(v), l)); }
DI unsigned pk2(float lo, float hi) { return cvt_pk_bf16(lo, hi); }

DI void ph_adaln(const float* cnd, const float* cctx, const float* ada_w, float* modp, int gw, int NGW, int lane) {
    for (int task = gw; task < 96 * KSPLIT; task += NGW) {
        const int ks = task & (KSPLIT - 1), cg = task / KSPLIT, l = cg / 48, cgl = cg % 48, col0 = cgl * 256 + lane * 4, k0 = ks * 128;
        float sv[9][2];
#pragma unroll
        for (int r = 0; r < 9; ++r)
#pragma unroll
            for (int hh = 0; hh < 2; ++hh) { const int k = k0 + hh * 64 + lane; const float v = r < 8 ? cnd[r * DM + k] : cctx[k]; sv[r][hh] = v / (1.0f + __expf(-v)); }
        f32x4 acc[9];
#pragma unroll
        for (int r = 0; r < 9; ++r) acc[r] = (f32x4){0.f, 0.f, 0.f, 0.f};
        const float* wp = ada_w + ((size_t)l * DM + k0) * NMOD + col0;
#pragma unroll
        for (int hh = 0; hh < 2; ++hh) {
#pragma unroll 8
            for (int kk = 0; kk < 64; ++kk) {
                const f32x4 w = *(const f32x4*)(wp + (size_t)(hh * 64 + kk) * NMOD);
#pragma unroll
                for (int r = 0; r < 9; ++r) { const float s = rdlane(sv[r][hh], kk); acc[r] += w * s; }
            }
        }
#pragma unroll
        for (int r = 0; r < 9; ++r) *(f32x4*)(modp + ((size_t)((ks * 2 + l) * 9 + r)) * NMOD + col0) = acc[r];
    }
}
struct CvtPtrs { const float *cin, *cout, *wqkv, *wo, *wg, *wu, *wd; bf16_t *W1A, *W1B, *W2, *WQKV, *WO, *WGU, *WDN; };
constexpr int CVT_E0 = 6656, CVT_L = 24576, CVT_TOTAL = CVT_E0 + 2 * CVT_L;
DI void cvt_resolve(const CvtPtrs& P, int it, const float*& src, int& ldw, bf16_t*& dst, int& ldd, bool& qperm) {
    int r = it; qperm = false;
    if (r < 3072) { const int kt = r / 96, nt = r % 96, n0 = nt * 64, part = n0 >> 11, j0 = n0 & 2047;
        src = P.cin + (size_t)(kt * 64) * 6144 + n0; ldw = 6144; ldd = DM;
        dst = (part == 0 ? P.W1B + (size_t)j0 * DM : P.W1A + (size_t)((j0 >> 7) * 256 + (part == 2 ? 128 : 0) + (j0 & 127)) * DM) + kt * 64; return; } r -= 3072;
    if (r < 1024) { const int kt = r / 32, nt = r % 32; src = P.cout + (size_t)(kt * 64) * DM + nt * 64; ldw = DM; dst = P.W2 + (size_t)(nt * 64) * DM + kt * 64; ldd = DM; return; } r -= 1024;
    if (r < 1536) { const int kt = r / 48, nt = r % 48; src = P.wqkv + (size_t)(kt * 64) * 3072 + nt * 64; ldw = 3072; qperm = nt < 40;     dst = P.WQKV + (size_t)(nt * 64) * DM + kt * 64; ldd = DM; return; } r -= 1536;
    if (r < 1024) { const int kt = r / 32, nt = r % 32; src = P.wo + (size_t)(kt * 64) * DM + nt * 64; ldw = DM; dst = P.WO + (size_t)(nt * 64) * DM + kt * 64; ldd = DM; return; } r -= 1024;
    const int l = r / CVT_L, rr = r % CVT_L, kind = rr / 8192, q = rr % 8192, le = l * 16 + q / 512, rem = q % 512;
    if (kind < 2) { const int kt = rem / 16, nt = rem % 16, n0 = nt * 64;
        src = (kind ? P.wu : P.wg) + (size_t)le * DM * DFF + (size_t)(kt * 64) * DFF + n0; ldw = DFF;
        dst = P.WGU + (size_t)(le * 2048 + (n0 >> 7) * 256 + kind * 128 + (n0 & 127)) * DM + kt * 64; ldd = DM; }
    else { const int kt = rem / 32, nt = rem % 32;
        src = P.wd + (size_t)le * DFF * DM + (size_t)(kt * 64) * DM + nt * 64; ldw = DM; dst = P.WDN + (size_t)(le * 2048 + nt * 64) * DFF + kt * 64; ldd = DFF; }
}
constexpr int CVT_P = 36;
DI void cvt_range(const CvtPtrs& P, int lo, int hi, int w, int NW, LAS unsigned* scr, int lane) {
    int it = lo + w; if (it >= hi) return;
    const int c = lane & 15, q = lane >> 4;
    const float* src; int ldw; bf16_t* dst; int ldd; bool qperm; cvt_resolve(P, it, src, ldw, dst, ldd, qperm);
    f32x4 v[16];
#pragma unroll
    for (int rr = 0; rr < 16; ++rr) v[rr] = __builtin_nontemporal_load((const f32x4*)(src + (size_t)(16 * q + rr) * ldw + 4 * c));
    for (;;) {
        u32x4 pa[4], pb[4];
#pragma unroll
        for (int i = 0; i < 4; ++i) { pa[i].x = pk2(v[0][i], v[1][i]); pa[i].y = pk2(v[2][i], v[3][i]); pa[i].z = pk2(v[4][i], v[5][i]); pa[i].w = pk2(v[6][i], v[7][i]);
                                      pb[i].x = pk2(v[8][i], v[9][i]); pb[i].y = pk2(v[10][i], v[11][i]); pb[i].z = pk2(v[12][i], v[13][i]); pb[i].w = pk2(v[14][i], v[15][i]); }
        const int nit = it + NW; bf16_t* cdst = dst; const int cldd = ldd; const int wrow = qperm ? 32 * ((c >> 2) & 1) + 8 * (c & 3) + 4 * (c >> 3) : 4 * c;
        if (nit < hi) { cvt_resolve(P, nit, src, ldw, dst, ldd, qperm);
#pragma unroll
            for (int rr = 0; rr < 16; ++rr) v[rr] = __builtin_nontemporal_load((const f32x4*)(src + (size_t)(16 * q + rr) * ldw + 4 * c)); }
#pragma unroll
        for (int i = 0; i < 4; ++i) { *(LAS u32x4*)(scr + (wrow + i) * CVT_P + 8 * q) = pa[i]; *(LAS u32x4*)(scr + (wrow + i) * CVT_P + 8 * q + 4) = pb[i]; }
        LDS_WAIT(); asm volatile("" ::: "memory");
#pragma unroll
        for (int j = 0; j < 8; ++j) { const int n = (lane >> 3) + 8 * j; const u32x4 o = *(const LAS u32x4*)(scr + n * CVT_P + 4 * (lane & 7));
            *(u32x4*)(cdst + (size_t)n * cldd + 8 * (lane & 7)) = o; }
        LDS_WAIT(); asm volatile("" ::: "memory");
        if (nit >= hi) break;
        it = nit;
    }
}
DI void ph_modred(const float* modp, const float* ada_b, float* mod, int gtid, int GT) {
    for (int i = gtid; i < 2 * 9 * NMOD; i += GT) { const int l = i / (9 * NMOD), j = i % NMOD; float s = ada_b[l * NMOD + j];
#pragma unroll
        for (int ks = 0; ks < KSPLIT; ++ks) s += modp[(size_t)ks * (2 * 9 * NMOD) + i];
        mod[i] = s; }
}
DI void row_load(const float* p, f32x4 (&v)[8], int lane) {
#pragma unroll
    for (int j = 0; j < 8; ++j) v[j] = *(const f32x4*)(p + 4 * lane + 256 * j);
}
DI void row_modulate(const f32x4 (&v)[8], f32x4 (&y)[8], const float* gain, const float* shift, const float* scale, int lane) {
    float ss = 0.f;
#pragma unroll
    for (int j = 0; j < 8; ++j) ss += (v[j][0] * v[j][0] + v[j][1] * v[j][1]) + (v[j][2] * v[j][2] + v[j][3] * v[j][3]);
    ss = wave_sum(ss);
    const float rstd = 1.0f / sqrtf(ss * (1.0f / DM) + NORM_EPS);
#pragma unroll
    for (int j = 0; j < 8; ++j) { const int c = 4 * lane + 256 * j; const f32x4 g = *(const f32x4*)(gain + c), sh = *(const f32x4*)(shift + c), sc = *(const f32x4*)(scale + c);
        y[j] = ((v[j] * rstd) * g) * (sc + 1.0f) + sh; }
}
DI void row_store_bf16(bf16_t* p, const f32x4 (&y)[8], int lane) {
#pragma unroll
    for (int j = 0; j < 8; ++j) { u32x2 w; w.x = pk2(y[j][0], y[j][1]); w.y = pk2(y[j][2], y[j][3]); *(u32x2*)(p + 4 * lane + 256 * j) = w; }
}
DI void ph_mod0(const float* x, const float* ctx, const float* gain, const float* mod0, bf16_t* A, int gw, int NGW, int lane) {
    for (int row = gw; row < MT; row += NGW) {
        const int cr = row < ML ? (row >> 11) : 8; const float* src = row < ML ? x + (size_t)row * DM : ctx + (size_t)(row - ML) * DM;
        f32x4 v[8], y[8]; row_load(src, v, lane);
        row_modulate(v, y, gain, mod0 + (size_t)cr * NMOD + 0 * DM, mod0 + (size_t)cr * NMOD + 1 * DM, lane);
        row_store_bf16(A + (size_t)row * DM, y, lane);
    }
}
DI void router_row(const f32x4 (&y)[8], const LAS float* rwT, float* affL, float* affC, int row, int lane) {
    float lg[16];
#pragma unroll
    for (int e = 0; e < 16; ++e) { float s = 0.f;
#pragma unroll
        for (int j = 0; j < 8; ++j) { const f32x4 w = *(const LAS f32x4*)(rwT + e * DM + 4 * lane + 256 * j); s += (y[j][0] * w[0] + y[j][1] * w[1]) + (y[j][2] * w[2] + y[j][3] * w[3]); }
        lg[e] = wave_sum(s); }
    float mx = lg[0];
#pragma unroll
    for (int e = 1; e < 16; ++e) mx = fmaxf(mx, lg[e]);
    float den = 0.f;
#pragma unroll
    for (int e = 0; e < 16; ++e) { lg[e] = __expf(lg[e] - mx); den += lg[e]; }
    float mine = 0.f;
#pragma unroll
    for (int e = 0; e < 16; ++e) mine = (lane == e) ? lg[e] : mine;
    mine = mine / den;
    if (lane < 16) { if (row < ML) { const int b = row >> 11, n = row & 2047; affL[(size_t)(b * 16 + lane) * SEQ + n] = mine; }
                     else { const int rc = row - ML, b = rc >> 8, n = rc & 255; affC[(size_t)(b * 16 + lane) * CTXL + n] = mine; } }
}
DI void load_router(const float* rw, LAS float* rwT, int tid) {
    for (int i = tid; i < DM * 16; i += 512) rwT[(i & 15) * DM + (i >> 4)] = rw[i];
    __syncthreads();
}
DI void ph_modffn(const float* H, const float* gain, const float* modl, bf16_t* A, const LAS float* rwT, float* affL, float* affC, int nrows, int gw, int NGW, int lane) {
    for (int row = gw; row < nrows; row += NGW) {
        const int cr = row < ML ? (row >> 11) : 8;
        f32x4 v[8], y[8]; row_load(H + (size_t)row * DM, v, lane);
        row_modulate(v, y, gain, modl + (size_t)cr * NMOD + 3 * DM, modl + (size_t)cr * NMOD + 4 * DM, lane);
        row_store_bf16(A + (size_t)row * DM, y, lane);
        router_row(y, rwT, affL, affC, row, lane);
    }
}
DI void ph_topk(int nitems, const float* affL, const float* affC, int* rowsrc, float* gatev, int* inv, LAS unsigned* hist, int tid, int lane, int wave, int bid, int G) {
    LAS unsigned* sh = hist + 256;
    for (int it = bid; it < nitems; it += G) {
        const bool isc = it >= 128; const int be = it & 127, b = be >> 4, e = be & 15;
        const int N = isc ? CTXL : SEQ, C = isc ? CAPC : CAPL;
        const float* src = isc ? affC + (size_t)be * CTXL : affL + (size_t)be * SEQ;
        const int i0 = tid * 4; const bool valid = i0 < N;
        unsigned key[4];
        { f32x4 v = (f32x4){0.f, 0.f, 0.f, 0.f}; if (valid) v = *(const f32x4*)(src + i0);
#pragma unroll
          for (int q = 0; q < 4; ++q) key[q] = __float_as_uint(v[q]); }
        unsigned prefix = 0u, mask = 0u, krem = (unsigned)C;
        for (int pass = 3; pass >= 0; --pass) {
            const int shift = pass * 8;
            if (tid < 256) hist[tid] = 0u;
            __syncthreads();
            if (valid) {
#pragma unroll
                for (int q = 0; q < 4; ++q) if ((key[q] & mask) == prefix) __hip_atomic_fetch_add(&hist[(key[q] >> shift) & 255u], 1u, __ATOMIC_RELAXED, __HIP_MEMORY_SCOPE_WORKGROUP); }
            __syncthreads();
            if (wave == 0) {
                const unsigned h0 = hist[4 * lane], h1 = hist[4 * lane + 1], h2 = hist[4 * lane + 2], h3 = hist[4 * lane + 3];
                const unsigned tot = h0 + h1 + h2 + h3; unsigned incl = tot;
#pragma unroll
                for (int o = 1; o < 64; o <<= 1) { const unsigned t = __shfl_down(incl, o); if (lane + o < 64) incl += t; }
                const unsigned a3 = incl - tot, a2 = a3 + h3, a1 = a2 + h2, a0 = a1 + h1;
                if (a3 < krem && krem <= a3 + h3) { sh[0] = 4 * lane + 3; sh[1] = krem - a3; }
                if (a2 < krem && krem <= a2 + h2) { sh[0] = 4 * lane + 2; sh[1] = krem - a2; }
                if (a1 < krem && krem <= a1 + h1) { sh[0] = 4 * lane + 1; sh[1] = krem - a1; }
                if (a0 < krem && krem <= a0 + h0) { sh[0] = 4 * lane + 0; sh[1] = krem - a0; }
            }
            __syncthreads();
            const unsigned B = sh[0]; krem = sh[1]; prefix |= B << shift; mask |= 0xFFu << shift;
        }
        const unsigned T = prefix;
        unsigned cg = 0u, ce = 0u;
        if (valid) {
#pragma unroll
            for (int q = 0; q < 4; ++q) { cg += key[q] > T ? 1u : 0u; ce += key[q] == T ? 1u : 0u; } }
        const unsigned mine = cg | (ce << 16); unsigned incl = mine;
#pragma unroll
        for (int o = 1; o < 64; o <<= 1) { const unsigned t = __shfl_up(incl, o); if (lane >= o) incl += t; }
        if (lane == 63) sh[8 + wave] = incl;
        __syncthreads();
        unsigned woff = 0u;
#pragma unroll
        for (int w = 0; w < 8; ++w) woff += (w < wave) ? sh[8 + w] : 0u;
        const unsigned excl = woff + incl - mine; unsigned gtb = excl & 0xFFFFu, eqb = excl >> 16;
        if (valid) {
            const int ybase = e * YR + (isc ? NB * CAPL + b * CAPC : b * CAPL); const int rbase = isc ? ML + b * CTXL : b * SEQ;
#pragma unroll
            for (int q = 0; q < 4; ++q) {
                const bool isg = key[q] > T, ise = key[q] == T; const bool sel = isg || (ise && eqb < krem);
                const unsigned slot = gtb + (eqb < krem ? eqb : krem);
                const int trow = rbase + i0 + q; const int yrow = ybase + (int)slot;
                if (sel) { rowsrc[yrow] = trow; gatev[yrow] = __uint_as_float(key[q]); }
                inv[(size_t)trow * 16 + e] = sel ? yrow : -1;
                gtb += isg ? 1u : 0u; eqb += ise ? 1u : 0u;
            }
        }
        __syncthreads();
    }
}
DI void ph_gather(const bf16_t* A, const int* rowsrc, bf16_t* XS, bool with_ctx, int gw, int NGW, int lane) {
    for (int yr = gw; yr < YT; yr += NGW) {
        if (!with_ctx && (yr % YR) >= NB * CAPL) continue;
        const int src = rowsrc[yr];
        const u32x4* s = (const u32x4*)(A + (size_t)src * DM); u32x4* d = (u32x4*)(XS + (size_t)yr * DM);
#pragma unroll
        for (int j = 0; j < 4; ++j) d[lane + 64 * j] = s[lane + 64 * j];
    }
}
template <bool LAST> DI void ph_combine(float* H, const bf16_t* Y, const int* inv, const float* modl  , const float* gain1, const float* mod1, bf16_t* A, float* out, int nrows, int gw, int NGW, int lane) {
    for (int row = gw; row < nrows; row += NGW) {
        const int cr = row < ML ? (row >> 11) : 8;
        f32x4 v[8], acc[8]; row_load(H + (size_t)row * DM, v, lane);
#pragma unroll
        for (int j = 0; j < 8; ++j) acc[j] = (f32x4){0.f, 0.f, 0.f, 0.f};
        const int myinv = inv[(size_t)row * 16 + (lane & 15)];
        for (int e = 0; e < 16; ++e) {
            const int yr = __builtin_amdgcn_readlane(myinv, e);
            if (yr >= 0) { const bf16_t* yp = Y + (size_t)yr * DM + 4 * lane;
#pragma unroll
                for (int j = 0; j < 8; ++j) { const u32x2 p = *(const u32x2*)(yp + 256 * j); acc[j][0] += bf_lo(p.x); acc[j][1] += bf_hi(p.x); acc[j][2] += bf_lo(p.y); acc[j][3] += bf_hi(p.y); } }
        }
        const float* g2 = modl + (size_t)cr * NMOD + 5 * DM;
#pragma unroll
        for (int j = 0; j < 8; ++j) { const f32x4 g = *(const f32x4*)(g2 + 4 * lane + 256 * j); v[j] = v[j] + g * acc[j]; }
        if (LAST) {
#pragma unroll
            for (int j = 0; j < 8; ++j) *(f32x4*)(out + (size_t)row * DM + 4 * lane + 256 * j) = v[j];
        } else {
#pragma unroll
            for (int j = 0; j < 8; ++j) *(f32x4*)(H + (size_t)row * DM + 4 * lane + 256 * j) = v[j];
            f32x4 y[8]; row_modulate(v, y, gain1, mod1 + (size_t)cr * NMOD + 0 * DM, mod1 + (size_t)cr * NMOD + 1 * DM, lane);
            row_store_bf16(A + (size_t)row * DM, y, lane);
        }
    }
}
DI void ph_qknorm(bf16_t* Q, bf16_t* K, const float* qg, const float* kg, int gw, int NGW, int lane) {
    const int half = lane >> 5, i = lane & 31, d1 = half * 64 + i, d2 = d1 + 32;
    const float inv_freq = exp2f(-(float)i * (13.287712379549449f / 32.0f));
    constexpr float QSCALE = 0.08838834764831845f * 1.4426950408889634f;
    const float qg1 = qg[d1] * QSCALE, qg2 = qg[d2] * QSCALE, kg1 = kg[d1], kg2 = kg[d2];
    for (int row = gw; row < MT; row += NGW) {
        const bool lat = row < ML; const int t = row & (SEQ - 1);
        const float pos = (float)(half == 0 ? (t >> 6) : (t & 63)); const float ang = pos * inv_freq;
        const float cs = lat ? __cosf(ang) : 1.0f, sn = lat ? __sinf(ang) : 0.0f;
        if (lat) {
            for (int hd = 0; hd < NH; ++hd) { bf16_t* p = Q + (size_t)row * DM + hd * HD;
                float x1 = __uint_as_float((unsigned)p[d1] << 16), x2 = __uint_as_float((unsigned)p[d2] << 16);
                const float ss = wave_sum(x1 * x1 + x2 * x2); const float rstd = 1.0f / sqrtf(ss * (1.0f / HD) + NORM_EPS);
                x1 = x1 * rstd * qg1; x2 = x2 * rstd * qg2;
                const float o1 = x1 * cs - x2 * sn, o2 = x2 * cs + x1 * sn;
                const unsigned w = pk2(o1, o2); p[d1] = (bf16_t)(w & 0xffffu); p[d2] = (bf16_t)(w >> 16); }
        }
        for (int kh = 0; kh < NKV; ++kh) { bf16_t* p = K + (size_t)row * 512 + kh * HD;
            float x1 = __uint_as_float((unsigned)p[d1] << 16), x2 = __uint_as_float((unsigned)p[d2] << 16);
            const float ss = wave_sum(x1 * x1 + x2 * x2); const float rstd = 1.0f / sqrtf(ss * (1.0f / HD) + NORM_EPS);
            x1 = x1 * rstd * kg1; x2 = x2 * rstd * kg2;
            const float o1 = x1 * cs - x2 * sn, o2 = x2 * cs + x1 * sn;
            const unsigned w = pk2(o1, o2); p[d1] = (bf16_t)(w & 0xffffu); p[d2] = (bf16_t)(w >> 16); }
    }
}
constexpr int KP = 272;
constexpr int ATT_VOFF = 64 * KP;
constexpr int ATT_TILE = 2 * 64 * KP;
DI int crow(int reg, int h) { return (reg & 3) + 8 * (reg >> 2) + 4 * h; }
DI s16x4 vtr(const LAS unsigned char* p) { typedef short v4i16_t __attribute__((ext_vector_type(4))); return __builtin_bit_cast(s16x4, __builtin_amdgcn_ds_read_tr16_b64_v4i16((LAS v4i16_t*)p)); }
DI bool att_tile_info(int item, int ti, int& base, int& mtype) {
    const int qhalf = item & 1, n = (item >> 3) & 15, b = item >> 7, tt = ti & 1; mtype = 0;
    if (ti < 4) { base = ML + b * CTXL + 64 * ti; return true; }
    const int blk = n - 1 + ((ti - 4) >> 1); if (blk < 0 || blk > 15) return false;
    if (ti < 6) { mtype = 1; if (tt == 0 && qhalf == 1) return false; } else if (ti >= 8) { mtype = 2; if (tt == 1 && qhalf == 0) return false; }
    base = b * SEQ + blk * 128 + 64 * tt; return true;
}
DI void att_next(int& item, int& ti, int G) { for (;;) { ++ti; if (ti >= 10) { ti = 0; item += G; return; } int b_, m_; if (att_tile_info(item, ti, b_, m_)) return; } }
DI void ph_attn(const bf16_t* Q, const bf16_t* Kb, const bf16_t* Vb, bf16_t* O, const float* sink, LAS unsigned char* lds, int tid, int lane, int wave, int bid, int G) {
    constexpr float LOG2E = 1.4426950408889634f;
    const int r = lane & 31, h = lane >> 5, g = wave >> 1, sub = wave & 1;
    const int ldrow = tid >> 3, ldc = tid & 7;
    int item = bid, ti = 0; if (item >= 1024) return;
    u32x4 kr[2], vr[2];
#define ATT_ISSUE(it_, ti_) do { int base_, mt_; att_tile_info(it_, ti_, base_, mt_); const int kvh_ = ((it_) >> 1) & 3; \
        _Pragma("unroll") for (int c2 = 0; c2 < 2; ++c2) { const size_t off_ = (size_t)(base_ + ldrow) * 512 + kvh_ * HD + (ldc + 8 * c2) * 8; kr[c2] = *(const u32x4*)(Kb + off_); vr[c2] = *(const u32x4*)(Vb + off_); } } while (0)
    bf16x8 qf[8]; float m2 = 0.f, lsum = 1.f; f32x16 o[4];
#define ATT_QLOAD(it_) do { const int qrow_ = ((it_) >> 7) * SEQ + (((it_) >> 3) & 15) * 128 + ((it_) & 1) * 64 + sub * 32 + r; const int head_ = (((it_) >> 1) & 3) * 4 + g; \
        _Pragma("unroll") for (int s = 0; s < 8; ++s) qf[s] = *(const bf16x8*)(Q + (size_t)qrow_ * DM + head_ * HD + 16 * s + 8 * h); } while (0)
    ATT_QLOAD(item);
    ATT_ISSUE(item, ti);
    int buf = 0;
    while (item < 1024) {
        int nitem = item, nti = ti; att_next(nitem, nti, G);
        LAS unsigned char* tb = lds + buf * ATT_TILE;
#pragma unroll
        for (int c2 = 0; c2 < 2; ++c2) { *(LAS u32x4*)(tb + ldrow * KP + (ldc + 8 * c2) * 16) = kr[c2]; *(LAS u32x4*)(tb + ATT_VOFF + ldrow * KP + (ldc + 8 * c2) * 16) = vr[c2]; }
        if (nitem < 1024) ATT_ISSUE(nitem, nti);
        asm volatile("s_waitcnt lgkmcnt(0)" ::: "memory"); __builtin_amdgcn_s_barrier(); asm volatile("" ::: "memory");
        int base, mtype; att_tile_info(item, ti, base, mtype); const int tt = ti & 1;
        const int qhalf = item & 1, kvh = (item >> 1) & 3, n = (item >> 3) & 15, b = item >> 7;
        const int head = kvh * 4 + g, qq = qhalf * 64 + sub * 32 + r; const int qrow = b * SEQ + n * 128 + qq;
        if (ti == 0) {
            m2 = sink[head] * LOG2E; lsum = 1.0f;
#pragma unroll
            for (int d = 0; d < 4; ++d)
#pragma unroll
                for (int i = 0; i < 16; ++i) o[d][i] = 0.f;
        }
        f32x16 x0, x1;
#pragma unroll
        for (int i = 0; i < 16; ++i) { x0[i] = 0.f; x1[i] = 0.f; }
#pragma unroll
        for (int s = 0; s < 8; ++s) {
            const bf16x8 k0 = *(const LAS bf16x8*)(tb + r * KP + (16 * s + 8 * h) * 2), k1 = *(const LAS bf16x8*)(tb + (32 + r) * KP + (16 * s + 8 * h) * 2);
            x0 = __builtin_amdgcn_mfma_f32_32x32x16_bf16(k0, qf[s], x0, 0, 0, 0); x1 = __builtin_amdgcn_mfma_f32_32x32x16_bf16(k1, qf[s], x1, 0, 0, 0); }
        if (nitem != item && nitem < 1024) ATT_QLOAD(nitem);
        if (mtype == 1) {
#pragma unroll
            for (int i = 0; i < 16; ++i) { const int kk0 = tt * 64 + crow(i, h); if (kk0 < qq) x0[i] = -1.0e30f; if (kk0 + 32 < qq) x1[i] = -1.0e30f; } }
        if (mtype == 2) {
#pragma unroll
            for (int i = 0; i < 16; ++i) { const int kk0 = tt * 64 + crow(i, h); if (kk0 > qq) x0[i] = -1.0e30f; if (kk0 + 32 > qq) x1[i] = -1.0e30f; } }
        float tmax = fmaxf(x0[0], x1[0]);
#pragma unroll
        for (int i = 1; i < 16; ++i) tmax = fmaxf(tmax, fmaxf(x0[i], x1[i]));
        tmax = fmaxf(tmax, __shfl_xor(tmax, 32));
        const float mnew = fmaxf(m2, tmax), alpha = __builtin_amdgcn_exp2f(m2 - mnew); m2 = mnew;
        float ps = 0.f;
#pragma unroll
        for (int i = 0; i < 16; ++i) { x0[i] = __builtin_amdgcn_exp2f(x0[i] - mnew); x1[i] = __builtin_amdgcn_exp2f(x1[i] - mnew); ps += x0[i] + x1[i]; }
        ps += __shfl_xor(ps, 32); lsum = lsum * alpha + ps;
        if (__any(alpha != 1.0f)) {
#pragma unroll
            for (int d = 0; d < 4; ++d)
#pragma unroll
                for (int i = 0; i < 16; ++i) o[d][i] *= alpha; }
        bf16x8 pf[2][2];
#pragma unroll
        for (int s = 0; s < 2; ++s) {
            u32x4 a, c; a.x = pk2(x0[8 * s + 0], x0[8 * s + 1]); a.y = pk2(x0[8 * s + 2], x0[8 * s + 3]); a.z = pk2(x0[8 * s + 4], x0[8 * s + 5]); a.w = pk2(x0[8 * s + 6], x0[8 * s + 7]);
            c.x = pk2(x1[8 * s + 0], x1[8 * s + 1]); c.y = pk2(x1[8 * s + 2], x1[8 * s + 3]); c.z = pk2(x1[8 * s + 4], x1[8 * s + 5]); c.w = pk2(x1[8 * s + 6], x1[8 * s + 7]);
            pf[0][s] = __builtin_bit_cast(bf16x8, a); pf[1][s] = __builtin_bit_cast(bf16x8, c); }
        const LAS unsigned char* vb = tb + ATT_VOFF + (4 * h + ((lane & 15) >> 2)) * KP + (16 * ((lane >> 4) & 1) + 4 * (lane & 3)) * 2;
#pragma unroll
        for (int d = 0; d < 4; ++d)
#pragma unroll
            for (int t = 0; t < 2; ++t)
#pragma unroll
                for (int s = 0; s < 2; ++s) {
                    const s16x4 lo = vtr(vb + (t * 32 + 16 * s) * KP + d * 64), hi = vtr(vb + (t * 32 + 16 * s + 8) * KP + d * 64);
                    const bf16x8 vf = (bf16x8){lo[0], lo[1], lo[2], lo[3], hi[0], hi[1], hi[2], hi[3]};
                    o[d] = __builtin_amdgcn_mfma_f32_32x32x16_bf16(vf, pf[t][s], o[d], 0, 0, 0); }
        if (nitem != item) {
            const float il = 1.0f / lsum;
            bf16_t* op = O + (size_t)qrow * DM + head * HD + 4 * h;
#pragma unroll
            for (int d = 0; d < 4; ++d)
#pragma unroll
                for (int g4 = 0; g4 < 4; ++g4) { u32x2 w; w.x = pk2(o[d][4 * g4 + 0] * il, o[d][4 * g4 + 1] * il); w.y = pk2(o[d][4 * g4 + 2] * il, o[d][4 * g4 + 3] * il);
                    *(u32x2*)(op + d * 32 + 8 * g4) = w; }
        }
        item = nitem; ti = nti; buf ^= 1;
    }
#undef ATT_ISSUE
#undef ATT_QLOAD
}

#ifndef MK_ONE_LAUNCH
#define MK_ONE_LAUNCH 1
#endif
constexpr int NPHASE = 19;
#ifndef MK_CVT_Q
#define MK_CVT_Q 0
#endif
constexpr int CVT_Q = MK_CVT_Q;
constexpr int CVT_X0_END = CVT_E0 + CVT_L;
constexpr int CVT_R3_LO = CVT_X0_END - 3 * CVT_Q, CVT_R4_LO = CVT_X0_END - 2 * CVT_Q, CVT_R5_LO = CVT_X0_END - CVT_Q;
constexpr int CVT_R9_LO = CVT_TOTAL - 5 * CVT_Q / 2, CVT_R10_LO = CVT_TOTAL - 3 * CVT_Q / 2, CVT_R12_LO = CVT_TOTAL - CVT_Q;
static_assert(CVT_Q <= 8192 && CVT_Q % 2 == 0, "tail quota");
#define CVT_MKCP() CvtPtrs CP; CP.cin = args.in[8]; CP.cout = args.in[10]; CP.wqkv = args.in[11]; CP.wo = args.in[15]; CP.wg = args.in[17]; CP.wu = args.in[18]; CP.wd = args.in[19]; \
    CP.W1A = W1A; CP.W1B = W1B; CP.W2 = W2; CP.WQKV = WQKV; CP.WO = WOt; CP.WGU = WGU; CP.WDN = WDN
#define CVT_TAIL(NWG, LO, HI) do { if ((LO) < (HI)) { CVT_MKCP(); const int busy_ = (NWG) % G; if (busy_ == 0) cvt_range(CP, LO, HI, gw, NGW, cscr, lane); else if (bid >= busy_) cvt_range(CP, LO, HI, (bid - busy_) * 8 + wave, (G - busy_) * 8, cscr, lane); } } while (0)
#ifndef MK_DUP_MASK
#define MK_DUP_MASK 0u
#endif
constexpr unsigned DUP_MASK = MK_DUP_MASK;
struct Args { const float* in[20]; float* out; unsigned char* ws; int ph_lo, ph_hi; };
__global__ void __launch_bounds__(512, 2) dit_fwd(Args args) {
    extern __shared__ __attribute__((aligned(16))) unsigned char lds_raw[];
    LAS unsigned char* lds = (LAS unsigned char*)lds_raw;
    const int tid = threadIdx.x, lane = tid & 63, wave = __builtin_amdgcn_readfirstlane(tid >> 6);
    const int G = gridDim.x, bid = blockIdx.x;
    const int gw = bid * 8 + wave, NGW = G * 8;
    unsigned char* ws = args.ws;
    const float* x = args.in[0]; const float* cnd = args.in[1]; const float* ctx = args.in[2]; const float* cctx = args.in[3];
    const float* ada_w = args.in[4]; const float* ada_b = args.in[5]; const float* nmix = args.in[6]; const float* nffn = args.in[7];
    const float* conv_w = args.in[9]; const float* qgain = args.in[12]; const float* kgain = args.in[13]; const float* sink = args.in[14]; const float* router_w = args.in[16];
    float* mod = (float*)(ws + WS_MOD); float* modp = (float*)(ws + WS_MODP);
    float* affL = (float*)(ws + WS_AFFL); float* affC = (float*)(ws + WS_AFFC);
    int* rowsrc = (int*)(ws + WS_ROWSRC); float* gatev = (float*)(ws + WS_GATEV); int* inv = (int*)(ws + WS_INV);
    bf16_t* W1A = (bf16_t*)(ws + WS_W1A); bf16_t* W1B = (bf16_t*)(ws + WS_W1B); bf16_t* W2 = (bf16_t*)(ws + WS_W2); bf16_t* WQKV = (bf16_t*)(ws + WS_WQKV); bf16_t* WOt = (bf16_t*)(ws + WS_WO);
    bf16_t* WGU = (bf16_t*)(ws + WS_WGU); bf16_t* WDN = (bf16_t*)(ws + WS_WDN);
    float* H = (float*)(ws + WS_H); bf16_t* A = (bf16_t*)(ws + WS_A); bf16_t* U = (bf16_t*)(ws + WS_U); bf16_t* Z = (bf16_t*)(ws + WS_Z);
    bf16_t* Qb = (bf16_t*)(ws + WS_Q); bf16_t* Kb = (bf16_t*)(ws + WS_K); bf16_t* Vb = (bf16_t*)(ws + WS_V); bf16_t* Ob = (bf16_t*)(ws + WS_O);
    bf16_t* HM = (bf16_t*)(ws + WS_HM); bf16_t* Y = (bf16_t*)(ws + WS_Y); bf16_t* XS = (bf16_t*)(ws + WS_XS);
    LAS unsigned* cscr = (LAS unsigned*)(lds + wave * 9216);

    for (int u = tid; u < (LDS_BYTES - MISC_OFF) / 4; u += 512) ((LAS unsigned*)(lds + MISC_OFF))[u] = 0u;
    __syncthreads();
#if MK_ONE_LAUNCH
    XcdBarrier bar = xcd_barrier_post((unsigned*)(ws + WS_CTL) + CW_BAR, (volatile LAS unsigned*)(lds + MISC_OFF) + 8);
#define GRID_BAR() xcd_barrier(bar)
#else
#define GRID_BAR() do {} while (0)
#endif
    const int lo = args.ph_lo, hi = args.ph_hi;
#define IN(k) (lo <= (k) && (k) < hi)
#define SEAM(k) do { if (IN(k) && IN((k) + 1)) GRID_BAR(); } while (0)

    if (IN(0)) _Pragma("unroll") for (int rep_ = 0; rep_ < 1 + (int)((DUP_MASK >> 0) & 1u); ++rep_) { if (rep_) GRID_BAR();
        ph_adaln(cnd, cctx, ada_w, modp, gw, NGW, lane);
        CVT_MKCP();
        cvt_range(CP, 0, CVT_R3_LO, gw, NGW, cscr, lane); cvt_range(CP, CVT_X0_END, CVT_R9_LO, gw, NGW, cscr, lane);
    } SEAM(0);
    if (IN(1)) _Pragma("unroll") for (int rep_ = 0; rep_ < 1 + (int)((DUP_MASK >> 1) & 1u); ++rep_) { if (rep_) GRID_BAR();  ph_modred(modp, ada_b, mod, bid * 512 + tid, G * 512); } SEAM(1);
    if (IN(2)) _Pragma("unroll") for (int rep_ = 0; rep_ < 1 + (int)((DUP_MASK >> 2) & 1u); ++rep_) { if (rep_) GRID_BAR();  ph_mod0(x, ctx, nmix, mod, A, gw, NGW, lane); } SEAM(2);
    if (IN(3)) _Pragma("unroll") for (int rep_ = 0; rep_ < 1 + (int)((DUP_MASK >> 3) & 1u); ++rep_) { if (rep_) GRID_BAR();
        pg8::Gemm g{A, W1A, MT, 4096, DM}; pg8::StaticOrder S; S.init(MT, 4096, G, bid);
        EpiPair<0> E{U, DM, 16};
        pg8::gemm_phase<EpiPair<0>, pg8::StaticOrder, true, true>(lds, g, S, E);
        CVT_TAIL(1152, CVT_R3_LO, CVT_R4_LO);
    } SEAM(3);
    if (IN(4)) _Pragma("unroll") for (int rep_ = 0; rep_ < 1 + (int)((DUP_MASK >> 4) & 1u); ++rep_) { if (rep_) GRID_BAR();
        pg8::Gemm g{A, W1B, MT, DM, DM}; pg8::StaticOrder S; S.init(MT, DM, G, bid);
        EpiConvGate E{U, Z, conv_w};
        pg8::gemm_phase<EpiConvGate, pg8::StaticOrder, true, true>(lds, g, S, E);
        CVT_TAIL(576, CVT_R4_LO, CVT_R5_LO);
    } SEAM(4);
    if (IN(5)) _Pragma("unroll") for (int rep_ = 0; rep_ < 1 + (int)((DUP_MASK >> 5) & 1u); ++rep_) { if (rep_) GRID_BAR();
        pg8::Gemm g{Z, W2, MT, DM, DM}; pg8::StaticOrder S; S.init(MT, DM, G, bid);
        EpiResid E{x, ctx, H, mod + 2 * DM};
        pg8::gemm_phase<EpiResid, pg8::StaticOrder, true, true>(lds, g, S, E);
        CVT_TAIL(576, CVT_R5_LO, CVT_X0_END);
    } SEAM(5);
    if (IN(6)) _Pragma("unroll") for (int rep_ = 0; rep_ < 1 + (int)((DUP_MASK >> 6) & 1u); ++rep_) { if (rep_) GRID_BAR();  load_router(router_w, (LAS float*)lds, tid); ph_modffn(H, nffn, mod, A, (const LAS float*)lds, affL, affC, MT, gw, NGW, lane); } SEAM(6);
    if (IN(7)) _Pragma("unroll") for (int rep_ = 0; rep_ < 1 + (int)((DUP_MASK >> 7) & 1u); ++rep_) { if (rep_) GRID_BAR();  ph_topk(256, affL, affC, rowsrc, gatev, inv, (LAS unsigned*)lds, tid, lane, wave, bid, G); } SEAM(7);
    if (IN(8)) _Pragma("unroll") for (int rep_ = 0; rep_ < 1 + (int)((DUP_MASK >> 8) & 1u); ++rep_) { if (rep_) GRID_BAR();
        pg8::Gemm g{A, WGU, YT, NE * 2048, DM, rowsrc}; MoeOrder S{G, bid, 9};
        EpiPair<1> E{HM, DFF, 8};
        pg8::gemm_phase<EpiPair<1>, MoeOrder, true, true, true>(lds, g, S, E);
        CVT_TAIL(1152, CVT_R9_LO, CVT_R10_LO);
    } SEAM(8);
    if (IN(9)) _Pragma("unroll") for (int rep_ = 0; rep_ < 1 + (int)((DUP_MASK >> 9) & 1u); ++rep_) { if (rep_) GRID_BAR();
        pg8::Gemm g{HM, WDN, YT, NE * 2048, DFF}; MoeOrder S{G, bid, 9};
        EpiDown E{Y, gatev};
        pg8::gemm_phase<EpiDown, MoeOrder, true, true>(lds, g, S, E);
        CVT_TAIL(1152, CVT_R10_LO, CVT_R12_LO);
    } SEAM(9);
    if (IN(10)) _Pragma("unroll") for (int rep_ = 0; rep_ < 1 + (int)((DUP_MASK >> 10) & 1u); ++rep_) { if (rep_) GRID_BAR();  ph_combine<false>(H, Y, inv, mod, nmix + DM, mod + 9 * NMOD, A, nullptr, MT, gw, NGW, lane); } SEAM(10);
    if (IN(11)) _Pragma("unroll") for (int rep_ = 0; rep_ < 1 + (int)((DUP_MASK >> 11) & 1u); ++rep_) { if (rep_) GRID_BAR();
        pg8::Gemm g{A, WQKV, MT, 3072, DM}; QkvOrder S{G, bid};
        EpiQkvNorm E{Qb, Kb, Vb, qgain, kgain, (LAS float*)(lds + RING_BYTES)};
        pg8::gemm_phase<EpiQkvNorm, QkvOrder, true, true>(lds, g, S, E);
        CVT_TAIL(800, CVT_R12_LO, CVT_TOTAL);
    } SEAM(11);
    if (IN(12)) _Pragma("unroll") for (int rep_ = 0; rep_ < 1 + (int)((DUP_MASK >> 12) & 1u); ++rep_) { if (rep_) GRID_BAR();  ph_attn(Qb, Kb, Vb, Ob, sink, lds, tid, lane, wave, bid, G); } SEAM(12);
    if (IN(13)) _Pragma("unroll") for (int rep_ = 0; rep_ < 1 + (int)((DUP_MASK >> 13) & 1u); ++rep_) { if (rep_) GRID_BAR();
        pg8::Gemm g{Ob, WOt, ML, DM, DM}; pg8::StaticOrder S; S.init(ML, DM, G, bid);
        EpiResid E{H, H + (size_t)ML * DM, H, mod + 9 * NMOD + 2 * DM};
        pg8::gemm_phase<EpiResid, pg8::StaticOrder, true, true>(lds, g, S, E);
    } SEAM(13);
    if (IN(14)) _Pragma("unroll") for (int rep_ = 0; rep_ < 1 + (int)((DUP_MASK >> 14) & 1u); ++rep_) { if (rep_) GRID_BAR();  load_router(router_w + DM * 16, (LAS float*)lds, tid); ph_modffn(H, nffn + DM, mod + 9 * NMOD, A, (const LAS float*)lds, affL, affC, ML, gw, NGW, lane); } SEAM(14);
    if (IN(15)) _Pragma("unroll") for (int rep_ = 0; rep_ < 1 + (int)((DUP_MASK >> 15) & 1u); ++rep_) { if (rep_) GRID_BAR();  ph_topk(128, affL, affC, rowsrc, gatev, inv, (LAS unsigned*)lds, tid, lane, wave, bid, G); } SEAM(15);
    if (IN(16)) _Pragma("unroll") for (int rep_ = 0; rep_ < 1 + (int)((DUP_MASK >> 16) & 1u); ++rep_) { if (rep_) GRID_BAR();
        pg8::Gemm g{A, WGU + (size_t)NE * 2048 * DM, YT, NE * 2048, DM, rowsrc}; MoeOrder S{G, bid, 8};
        EpiPair<1> E{HM, DFF, 8};
        pg8::gemm_phase<EpiPair<1>, MoeOrder, true, true, true>(lds, g, S, E);
    } SEAM(16);
    if (IN(17)) _Pragma("unroll") for (int rep_ = 0; rep_ < 1 + (int)((DUP_MASK >> 17) & 1u); ++rep_) { if (rep_) GRID_BAR();
        pg8::Gemm g{HM, WDN + (size_t)NE * 2048 * DFF, YT, NE * 2048, DFF}; MoeOrder S{G, bid, 8};
        EpiDown E{Y, gatev};
        pg8::gemm_phase<EpiDown, MoeOrder, true, true>(lds, g, S, E);
    } SEAM(17);
    if (IN(18)) _Pragma("unroll") for (int rep_ = 0; rep_ < 1 + (int)((DUP_MASK >> 18) & 1u); ++rep_) { if (rep_) GRID_BAR();  ph_combine<true>(H, Y, inv, mod + 9 * NMOD, nullptr, nullptr, nullptr, args.out, ML, gw, NGW, lane); }
#undef IN
#undef SEAM
}

extern "C" void kernel_launch(void* const* d_in, const int* in_sizes, int n_in, void* d_out, int out_size, void* d_ws, size_t ws_size, hipStream_t stream) {
    static int grid = 0;
    if (grid == 0) {
        if (n_in != 20 || out_size != ML * DM || ws_size < WS_END) { fprintf(stderr, "kernel_launch: unexpected problem (n_in %d, out %d, ws %zu); nothing launched\n", n_in, out_size, ws_size); grid = -1; return; }
        int dev = 0, cus = 0, per_cu = 0;
        if (hipGetDevice(&dev) != hipSuccess || hipDeviceGetAttribute(&cus, hipDeviceAttributeMultiprocessorCount, dev) != hipSuccess) { grid = -1; return; }
        if (hipFuncSetAttribute((const void*)dit_fwd, hipFuncAttributeMaxDynamicSharedMemorySize, LDS_BYTES) != hipSuccess) { fprintf(stderr, "kernel_launch: hipFuncSetAttribute failed\n"); grid = -1; return; }
        if (hipOccupancyMaxActiveBlocksPerMultiprocessor(&per_cu, (const void*)dit_fwd, 512, LDS_BYTES) != hipSuccess || per_cu < 1) fprintf(stderr, "kernel_launch: occupancy query reports %d workgroups per CU\n", per_cu);
        (void)hipGetLastError();
        grid = cus;
    }
    if (grid < 0) return;
    (void)hipMemsetAsync((char*)d_ws + WS_CTL, 0, CTL_ZERO_BYTES, stream);
    Args a{};
    for (int i = 0; i < 20; ++i) a.in[i] = (const float*)d_in[i];
    a.out = (float*)d_out; a.ws = (unsigned char*)d_ws;
#if MK_ONE_LAUNCH
    a.ph_lo = 0; a.ph_hi = NPHASE;
    hipLaunchKernelGGL(dit_fwd, dim3(grid), dim3(512), LDS_BYTES, stream, a);
#else
    for (int p = 0; p < NPHASE; ++p) { a.ph_lo = p; a.ph_hi = p + 1; hipLaunchKernelGGL(dit_fwd, dim3(grid), dim3(512), LDS_BYTES, stream, a); }
#endif
}
```

```cpp
#include <hip/hip_runtime.h>
#include <cstdio>
#include <cstdint>
namespace pg8 {
#define PG8_LAS __attribute__((address_space(3)))
typedef unsigned short bf16_t;
typedef short bf16x8 __attribute__((ext_vector_type(8)));
typedef float f32x4 __attribute__((ext_vector_type(4)));
typedef unsigned u32x4 __attribute__((ext_vector_type(4)));
constexpr int BM = 256, BK = 64, HALF = 128, HTB = HALF * BK * 2  , STAGE_BYTES = 8 * HTB, NXCD = 8, WGM = 8;

__host__ __device__ __forceinline__ int lds_byte(int r, int c) { const int st = (r >> 4) * 2 + (c >> 5), rr = r & 15, cc = c & 31, ob = rr * 64 + cc * 2; return st * 1024 + (ob ^ (((ob >> 9) & 1) << 5)); }
__host__ __device__ __forceinline__ void stage_rc(int b, int& R, int& C) { const int st = b / 1024, sb = b % 1024, swz = sb ^ (((sb >> 9) & 1) << 5); R = (st >> 1) * 16 + swz / 64; C = (st & 1) * 32 + (swz % 64) / 2; }
__host__ __device__ __forceinline__ int perm32(int rho) { const int n = rho >> 4, i = rho & 15; return 8 * (i >> 2) + 4 * n + (i & 3); }

struct Unit { int pm, pn; };
struct Gemm { const bf16_t* A; const bf16_t* Bt; int M, N, K; const int* rows = nullptr; };

struct StaticOrder {
    int nM, nN, nwg, G, c;
    __host__ __device__ void init(int M, int N, int G_, int c_) { nM = M / BM; nN = N / BM; nwg = nM * nN; G = G_; c = c_; }
    __host__ __device__ bool next(int i, Unit& u) const {
        const long L = (long)i * G + c; if (L >= nwg) return false;
        int wgid = (int)L; { const int q = nwg / NXCD, r = nwg % NXCD, xcd = wgid % NXCD, off = wgid / NXCD; wgid = (xcd < r ? xcd * (q + 1) : r * (q + 1) + (xcd - r) * q) + off; }
        const int nig = WGM * nN, gid = wgid / nig, fm = gid * WGM, gsz = (nM - fm) < WGM ? (nM - fm) : WGM;
        u.pm = fm + ((wgid % nig) % gsz); u.pn = (wgid % nig) / gsz; return true;
    }
    __device__ __forceinline__ void a_ready(const Unit&) const {}
    __device__ __forceinline__ void done(const Unit&) const {}
};
__device__ __forceinline__ unsigned cvt_pk_bf16(float lo, float hi) { unsigned r; asm volatile("v_cvt_pk_bf16_f32 %0, %1, %2" : "=v"(r) : "v"(lo), "v"(hi)); return r; }
typedef float f32x2 __attribute__((ext_vector_type(2)));
template <class Epi, class Sched, bool ALIGN_EPI = false, bool SP2 = false, bool GATHER = false>
__device__ __forceinline__ void gemm_phase(PG8_LAS unsigned char* lds, const Gemm g, const Sched& S, const Epi& E) {
    const int tid = threadIdx.x, wid = __builtin_amdgcn_readfirstlane(tid >> 6), lane = tid & 63, wr = wid >> 2, wc = wid & 3, fr = lane & 15, fq = lane >> 4;
    const int K = g.K, nt = K / BK;
    unsigned voffA[2], voffB[2];
#pragma unroll
    for (int i = 0; i < 2; ++i) { int R, C; stage_rc(tid * 16 + i * 8192, R, C); const int Rb = Epi::PERM ? ((R & ~31) + perm32(R & 31)) : R;
        voffA[i] = (unsigned)(R * K + C) * 2u; voffB[i] = (unsigned)(Rb * K + C) * 2u; }
    const size_t kstep = (size_t)(BK * 2);
    const size_t hstep = (size_t)HALF * K * 2;
    const size_t tstep = 2 * hstep;
    const unsigned ldsw = (unsigned)wid * 1024u;
    const int aoff = lds_byte(wr * 64 + fr, fq * 8), boff = lds_byte(wc * 32 + fr, fq * 8);
#define PG8_SA(b, h) (((b) * 2 + (h)) * HTB)
#define PG8_SB(b, h) ((4 + (b) * 2 + (h)) * HTB)
#define PG8_STAGE(bufoff, gbase, voff) do { _Pragma("unroll") for (int _i = 0; _i < 2; ++_i) \
        __builtin_amdgcn_global_load_lds((const unsigned*)((const char*)(gbase) + (voff)[_i]), (PG8_LAS unsigned*)(lds + (bufoff) + ldsw + _i * 8192), 16, 0, 0); } while (0)
#define PG8_STAGE_A(bufoff, kptr, h) do { if constexpr (GATHER) { PG8_STAGE(bufoff, kptr, vA[h]); } else { PG8_STAGE(bufoff, (kptr) + (h) * hstep, voffA); } } while (0)
#define PG8_GATHER_SWITCH() do { if constexpr (GATHER) { if (last && has_next) { asm volatile("" : "+v"(nv[0]), "+v"(nv[1]), "+v"(nv[2]), "+v"(nv[3])); \
        vA[0][0] = nv[0] * (unsigned)(K * 2) + gcoff[0]; vA[0][1] = nv[1] * (unsigned)(K * 2) + gcoff[1]; vA[1][0] = nv[2] * (unsigned)(K * 2) + gcoff[0]; vA[1][1] = nv[3] * (unsigned)(K * 2) + gcoff[1]; } } } while (0)
#define PG8_LDA(dst, b, h) do { _Pragma("unroll") for (int m = 0; m < 4; ++m) _Pragma("unroll") for (int k = 0; k < 2; ++k) dst[m][k] = *(const PG8_LAS bf16x8*)(lds + PG8_SA(b, h) + aoff + m * 2048 + k * 1024); } while (0)
#define PG8_LDB(dst, b, h) do { _Pragma("unroll") for (int n = 0; n < 2; ++n) _Pragma("unroll") for (int k = 0; k < 2; ++k) dst[n][k] = *(const PG8_LAS bf16x8*)(lds + PG8_SB(b, h) + boff + n * 2048 + k * 1024); } while (0)
#define PG8_MMA(ai, bj, At, Bt) do { __builtin_amdgcn_s_setprio(1); _Pragma("unroll") for (int m = 0; m < 4; ++m) _Pragma("unroll") for (int n = 0; n < 2; ++n) _Pragma("unroll") for (int k = 0; k < 2; ++k) \
        acc[ai][bj][m][n] = __builtin_amdgcn_mfma_f32_16x16x32_bf16(Bt[n][k], At[m][k], acc[ai][bj][m][n], 0, 0, 0); __builtin_amdgcn_s_setprio(0); } while (0)
#define PG8_WAIT_V(n) asm volatile("s_waitcnt vmcnt(" #n ")" ::: "memory")
#define PG8_WAIT_L(n) asm volatile("s_waitcnt lgkmcnt(" #n ")" ::: "memory")
#define PG8_BAR __builtin_amdgcn_s_barrier()
#define PG8_SCHED __builtin_amdgcn_sched_barrier(0)
    Unit cur, nxt; int ui = 0;
    if (!S.next(0, cur)) return;
    f32x4 acc[2][2][4][2];
#pragma unroll
    for (int a = 0; a < 2; ++a)
#pragma unroll
        for (int b = 0; b < 2; ++b)
#pragma unroll
            for (int m = 0; m < 4; ++m)
#pragma unroll
                for (int n = 0; n < 2; ++n) acc[a][b][m][n] = (f32x4){0.f, 0.f, 0.f, 0.f};
    bf16x8 At[4][2], B0[2][2], B1[2][2];
    const char* cA = (const char*)g.A + (GATHER ? (size_t)0 : (size_t)cur.pm * tstep); const char* cB = (const char*)g.Bt + (size_t)cur.pn * tstep;
    unsigned vA[2][2], nv[4], gcoff[2]; int grow[2];
    if constexpr (GATHER) {
#pragma unroll
        for (int i = 0; i < 2; ++i) { int R, C; stage_rc(tid * 16 + i * 8192, R, C); grow[i] = R; gcoff[i] = (unsigned)(C * 2); }
#pragma unroll
        for (int h = 0; h < 2; ++h)
#pragma unroll
            for (int i = 0; i < 2; ++i) vA[h][i] = (unsigned)g.rows[cur.pm * BM + h * HALF + grow[i]] * (unsigned)(K * 2) + gcoff[i];
    }
    S.a_ready(cur);
    if constexpr (SP2) {
        PG8_STAGE(PG8_SB(0, 0), cB, voffB); PG8_STAGE(PG8_SB(0, 1), cB + hstep, voffB); PG8_STAGE_A(PG8_SA(0, 0), cA, 0); PG8_STAGE_A(PG8_SA(0, 1), cA, 1);
        if (wr == 1) PG8_BAR;
        PG8_WAIT_V(2); PG8_BAR;
        PG8_STAGE(PG8_SB(1, 0), cB + kstep, voffB); PG8_STAGE_A(PG8_SA(1, 0), cA + kstep, 0); PG8_STAGE(PG8_SB(1, 1), cB + hstep + kstep, voffB);
        PG8_WAIT_V(6); PG8_BAR;
    } else {
        PG8_STAGE(PG8_SB(0, 0), cB, voffB); PG8_STAGE_A(PG8_SA(0, 0), cA, 0); PG8_STAGE(PG8_SB(0, 1), cB + hstep, voffB); PG8_STAGE_A(PG8_SA(0, 1), cA, 1);
        if (wr == 1) PG8_BAR;
        PG8_WAIT_V(4); PG8_BAR;
        PG8_STAGE(PG8_SB(1, 0), cB + kstep, voffB); PG8_STAGE_A(PG8_SA(1, 0), cA + kstep, 0); PG8_STAGE(PG8_SB(1, 1), cB + hstep + kstep, voffB);
        PG8_WAIT_V(6); PG8_BAR;
    }
    for (;;) {
        const bool has_next = S.next(ui + 1, nxt);
        const char* nA = (has_next && !GATHER) ? (const char*)g.A + (size_t)nxt.pm * tstep : cA; const char* nB = has_next ? (const char*)g.Bt + (size_t)nxt.pn * tstep : cB;
        if constexpr (GATHER) { if (has_next) { const int* rp = g.rows + nxt.pm * BM;
            asm volatile("global_load_dword %0, %1, off" : "=&v"(nv[0]) : "v"(rp + grow[0]) : "memory"); asm volatile("global_load_dword %0, %1, off" : "=&v"(nv[1]) : "v"(rp + grow[1]) : "memory");
            asm volatile("global_load_dword %0, %1, off" : "=&v"(nv[2]) : "v"(rp + HALF + grow[0]) : "memory"); asm volatile("global_load_dword %0, %1, off" : "=&v"(nv[3]) : "v"(rp + HALF + grow[1]) : "memory"); } }
        for (int t = 0; t < nt; t += 2) {
            const bool last = (t == nt - 2);
            const char* a1 = cA + (size_t)(t + 1) * kstep;
            const char* a2 = last ? nA : cA + (size_t)(t + 2) * kstep; const char* b2 = last ? nB : cB + (size_t)(t + 2) * kstep;
            const char* a3 = a2 + kstep; const char* b3 = b2 + kstep;
            if (last && has_next) S.a_ready(nxt);
            if constexpr (SP2) {
            PG8_LDB(B0, 0, 0); PG8_LDB(B1, 0, 1); PG8_SCHED; PG8_LDA(At, 0, 0); PG8_STAGE_A(PG8_SA(1, 1), a1, 1); PG8_GATHER_SWITCH();
            PG8_WAIT_V(8); PG8_WAIT_L(0); PG8_BAR; PG8_MMA(0, 0, At, B0); PG8_MMA(0, 1, At, B1); PG8_BAR; PG8_SCHED;
            PG8_LDA(At, 0, 1); PG8_STAGE(PG8_SB(0, 0), b2, voffB); PG8_STAGE(PG8_SB(0, 1), b2 + hstep, voffB); PG8_STAGE_A(PG8_SA(0, 0), a2, 0);
            PG8_WAIT_V(8); PG8_WAIT_L(0); PG8_BAR; PG8_MMA(1, 0, At, B0); PG8_MMA(1, 1, At, B1); PG8_BAR; PG8_SCHED;
            PG8_LDB(B0, 1, 0); PG8_LDB(B1, 1, 1); PG8_SCHED; PG8_LDA(At, 1, 0); PG8_STAGE_A(PG8_SA(0, 1), a2, 1);
            PG8_WAIT_V(8); PG8_WAIT_L(0); PG8_BAR; PG8_MMA(0, 0, At, B0); PG8_MMA(0, 1, At, B1); PG8_BAR; PG8_SCHED;
            PG8_LDA(At, 1, 1); PG8_STAGE(PG8_SB(1, 0), b3, voffB); PG8_STAGE(PG8_SB(1, 1), b3 + hstep, voffB); PG8_STAGE_A(PG8_SA(1, 0), a3, 0);
            PG8_WAIT_V(8); PG8_WAIT_L(0); PG8_BAR; PG8_MMA(1, 0, At, B0); PG8_MMA(1, 1, At, B1); PG8_BAR; PG8_SCHED;
            } else {
            PG8_LDB(B0, 0, 0); PG8_SCHED; PG8_LDA(At, 0, 0); PG8_STAGE_A(PG8_SA(1, 1), a1, 1); PG8_GATHER_SWITCH();
            PG8_WAIT_L(8); PG8_BAR; PG8_WAIT_L(0); PG8_MMA(0, 0, At, B0); PG8_BAR; PG8_SCHED;
            PG8_LDB(B1, 0, 1); PG8_STAGE(PG8_SB(0, 0), b2, voffB);
            PG8_BAR; PG8_WAIT_L(0); PG8_MMA(0, 1, At, B1); PG8_BAR;
            PG8_LDA(At, 0, 1); PG8_STAGE_A(PG8_SA(0, 0), a2, 0);
            PG8_BAR; PG8_WAIT_L(0); PG8_MMA(1, 0, At, B0); PG8_BAR; PG8_SCHED;
            PG8_STAGE(PG8_SB(0, 1), b2 + hstep, voffB);
            PG8_WAIT_V(6); PG8_BAR; PG8_MMA(1, 1, At, B1); PG8_BAR;
            PG8_LDB(B0, 1, 0); PG8_SCHED; PG8_LDA(At, 1, 0); PG8_STAGE_A(PG8_SA(0, 1), a2, 1);
            PG8_WAIT_L(8); PG8_BAR; PG8_WAIT_L(0); PG8_MMA(0, 0, At, B0); PG8_BAR; PG8_SCHED;
            PG8_LDB(B1, 1, 1); PG8_STAGE(PG8_SB(1, 0), b3, voffB);
            PG8_BAR; PG8_WAIT_L(0); PG8_MMA(0, 1, At, B1); PG8_BAR;
            PG8_LDA(At, 1, 1); PG8_STAGE_A(PG8_SA(1, 0), a3, 0);
            PG8_BAR; PG8_WAIT_L(0); PG8_MMA(1, 0, At, B0); PG8_BAR; PG8_SCHED;
            PG8_STAGE(PG8_SB(1, 1), b3 + hstep, voffB);
            PG8_WAIT_V(6); PG8_BAR; PG8_MMA(1, 1, At, B1); PG8_BAR;
            }
        }
        if constexpr (ALIGN_EPI) { if (wr == 0) PG8_BAR; }
        if constexpr (!Epi::AFTER_DRAIN) { E(acc, cur, wr, wc, fr, fq); S.done(cur); }
        if (!has_next) break;
#pragma unroll
        for (int a = 0; a < 2; ++a)
#pragma unroll
            for (int b = 0; b < 2; ++b)
#pragma unroll
                for (int m = 0; m < 4; ++m)
#pragma unroll
                    for (int n = 0; n < 2; ++n) acc[a][b][m][n] = (f32x4){0.f, 0.f, 0.f, 0.f};
        cur = nxt; cA = nA; cB = nB; ++ui;
        if constexpr (ALIGN_EPI) { if (wr == 1) PG8_BAR; }
    }
    PG8_WAIT_V(0);
    if constexpr (!ALIGN_EPI) { if (wr == 0) PG8_BAR; }
    PG8_BAR;
    if constexpr (Epi::AFTER_DRAIN) { E.fused(acc, cur, wr, wc, fr, fq, lds, wid, lane); S.done(cur); }
#undef PG8_SA
#undef PG8_SB
#undef PG8_STAGE
#undef PG8_STAGE_A
#undef PG8_GATHER_SWITCH
#undef PG8_LDA
#undef PG8_LDB
#undef PG8_MMA
#undef PG8_WAIT_V
#undef PG8_WAIT_L
#undef PG8_BAR
#undef PG8_SCHED
}
}

constexpr int DM = 2048, NB = 8, SEQ = 2048, CTXL = 256, NH = 16, NKV = 4, HD = 128;
constexpr int ML = NB * SEQ;
constexpr int MC = NB * CTXL;
constexpr int MT = ML + MC;
constexpr int NE = 16, CAPL = 256, CAPC = 32, DFF = 1024;
constexpr int YR = NB * CAPL + NB * CAPC;
constexpr int YT = NE * YR;
constexpr int NMOD = 6 * DM;
constexpr float NORM_EPS = 1e-6f;
constexpr int KSPLIT = 16;

using pg8::Unit; using pg8::f32x4; using pg8::u32x4; using pg8::bf16_t; using pg8::bf16x8; using pg8::cvt_pk_bf16;
typedef float f32x2 __attribute__((ext_vector_type(2)));
typedef unsigned u32x2 __attribute__((ext_vector_type(2)));
typedef float f32x16 __attribute__((ext_vector_type(16)));
typedef short s16x4 __attribute__((ext_vector_type(4)));
#define DI __device__ __forceinline__

DI float bf_lo(unsigned w) { return __uint_as_float(w << 16); }
DI float bf_hi(unsigned w) { return __uint_as_float(w & 0xffff0000u); }
DI float silu_f(float a) { return a * __builtin_amdgcn_rcpf(1.0f + __expf(-a)); }

DI int xcd_remap(int wgid, int nwg) { const int q = nwg / 8, r = nwg % 8, xcd = wgid % 8, off = wgid / 8; return (xcd < r ? xcd * (q + 1) : r * (q + 1) + (xcd - r) * q) + off; }
struct QkvOrder {
    int G, c;
    DI bool next(int i, Unit& u) const {
        const int L = i * G + c; if (L >= 800) return false;
        if (L < 768) { const int w = xcd_remap(L, 768); const int nig = 8 * 12, gid = w / nig; u.pm = gid * 8 + ((w % nig) % 8); u.pn = (w % nig) / 8; }
        else { const int j = L - 768; u.pm = 64 + (j >> 2); u.pn = 8 + (j & 3); }
        return true;
    }
    DI void a_ready(const Unit&) const {}
    DI void done(const Unit&) const {}
};
struct MoeOrder {
    int G, c, NP;
    DI bool next(int i, Unit& u) const {
        const int nwg = NE * NP * 8; const int L = i * G + c; if (L >= nwg) return false;
        const int w = xcd_remap(L, nwg); const int per = NP * 8, e = w / per, rem = w % per;
        u.pm = e * 9 + (rem % NP); u.pn = e * 8 + (rem / NP); return true;
    }
    DI void a_ready(const Unit&) const {}
    DI void done(const Unit&) const {}
};

template <int ACT  > struct EpiPair {
    static constexpr bool PERM = true, AFTER_DRAIN = false;
    bf16_t* O; int ldc; int pn_mod;
    DI void operator()(const f32x4 (&acc)[2][2][4][2], const Unit& u, int wr, int wc, int fr, int fq) const {
        const int row0 = u.pm * 256 + wr * 64 + fr, col0 = (u.pn % pn_mod) * 128 + wc * 32 + 8 * fq;
#pragma unroll
        for (int ai = 0; ai < 2; ++ai)
#pragma unroll
            for (int m = 0; m < 4; ++m) {
                bf16_t* rowp = O + (size_t)(row0 + ai * 128 + m * 16) * ldc + col0;
                f32x4 a0 = acc[ai][0][m][0], a1 = acc[ai][0][m][1]; const f32x4 b0 = acc[ai][1][m][0], b1 = acc[ai][1][m][1];
                if (ACT == 1) {
#pragma unroll
                    for (int j = 0; j < 4; ++j) { a0[j] = silu_f(a0[j]); a1[j] = silu_f(a1[j]); } }
                const f32x4 v0 = a0 * b0, v1 = a1 * b1;
                u32x4 w; w.x = cvt_pk_bf16(v0[0], v0[1]); w.y = cvt_pk_bf16(v0[2], v0[3]); w.z = cvt_pk_bf16(v1[0], v1[1]); w.w = cvt_pk_bf16(v1[2], v1[3]);
                *(u32x4*)rowp = w;
            }
    }
};
struct EpiConvGate {
    static constexpr bool PERM = true, AFTER_DRAIN = false;
    const bf16_t* U; bf16_t* Z; const float* cw;
    DI void operator()(const f32x4 (&acc)[2][2][4][2], const Unit& u, int wr, int wc, int fr, int fq) const {
        const int row0 = u.pm * 256 + wr * 64 + fr, col0 = u.pn * 256 + wc * 32 + 8 * fq;
#pragma unroll
        for (int bj = 0; bj < 2; ++bj) {
            const int c = col0 + bj * 128;
            f32x4 w0a = *(const f32x4*)(cw + c), w0b = *(const f32x4*)(cw + c + 4), w1a = *(const f32x4*)(cw + 2048 + c), w1b = *(const f32x4*)(cw + 2048 + c + 4), w2a = *(const f32x4*)(cw + 4096 + c), w2b = *(const f32x4*)(cw + 4096 + c + 4);
#pragma unroll
            for (int ai = 0; ai < 2; ++ai)
#pragma unroll
                for (int m = 0; m < 4; ++m) {
                    const int row = row0 + ai * 128 + m * 16;
                    const int tpos = row < ML ? (row & (SEQ - 1)) : ((row - ML) & (CTXL - 1)); const int len = row < ML ? SEQ : CTXL;
                    const u32x4 z4 = (u32x4){0u, 0u, 0u, 0u};
                    const u32x4 uc = *(const u32x4*)(U + (size_t)row * DM + c);
                    const u32x4 up = tpos > 0 ? *(const u32x4*)(U + (size_t)(row - 1) * DM + c) : z4;
                    const u32x4 un = tpos < len - 1 ? *(const u32x4*)(U + (size_t)(row + 1) * DM + c) : z4;
                    f32x4 ya, yb;
                    ya[0] = w0a[0] * bf_lo(up.x) + w1a[0] * bf_lo(uc.x) + w2a[0] * bf_lo(un.x); ya[1] = w0a[1] * bf_hi(up.x) + w1a[1] * bf_hi(uc.x) + w2a[1] * bf_hi(un.x);
                    ya[2] = w0a[2] * bf_lo(up.y) + w1a[2] * bf_lo(uc.y) + w2a[2] * bf_lo(un.y); ya[3] = w0a[3] * bf_hi(up.y) + w1a[3] * bf_hi(uc.y) + w2a[3] * bf_hi(un.y);
                    yb[0] = w0b[0] * bf_lo(up.z) + w1b[0] * bf_lo(uc.z) + w2b[0] * bf_lo(un.z); yb[1] = w0b[1] * bf_hi(up.z) + w1b[1] * bf_hi(uc.z) + w2b[1] * bf_hi(un.z);
                    yb[2] = w0b[2] * bf_lo(up.w) + w1b[2] * bf_lo(uc.w) + w2b[2] * bf_lo(un.w); yb[3] = w0b[3] * bf_hi(up.w) + w1b[3] * bf_hi(uc.w) + w2b[3] * bf_hi(un.w);
                    const f32x4 v0 = acc[ai][bj][m][0] * ya, v1 = acc[ai][bj][m][1] * yb;
                    u32x4 w; w.x = cvt_pk_bf16(v0[0], v0[1]); w.y = cvt_pk_bf16(v0[2], v0[3]); w.z = cvt_pk_bf16(v1[0], v1[1]); w.w = cvt_pk_bf16(v1[2], v1[3]);
                    *(u32x4*)(Z + (size_t)row * DM + c) = w;
                }
        }
    }
};
template <bool BASE_F32> struct EpiResid {
    static constexpr bool PERM = true, AFTER_DRAIN = false;
    const float* base_lat; const float* base_ctx; bf16_t* out; const float* gate;
    DI void operator()(const f32x4 (&acc)[2][2][4][2], const Unit& u, int wr, int wc, int fr, int fq) const {
        const int rowt = u.pm * 256; const int cr = rowt < ML ? (rowt >> 11) : 8;
        const float* base = rowt < ML ? base_lat : base_ctx - (size_t)ML * DM;
        const int row0 = rowt + wr * 64 + fr, col0 = u.pn * 256 + wc * 32 + 8 * fq;
        f32x4 gv[2][2];
#pragma unroll
        for (int bj = 0; bj < 2; ++bj)
#pragma unroll
            for (int n = 0; n < 2; ++n) gv[bj][n] = *(const f32x4*)(gate + (size_t)cr * NMOD + col0 + bj * 128 + n * 4);
#pragma unroll
        for (int ai = 0; ai < 2; ++ai)
#pragma unroll
            for (int m = 0; m < 4; ++m) { const size_t off = (size_t)(row0 + ai * 128 + m * 16) * DM + col0;
#pragma unroll
                for (int bj = 0; bj < 2; ++bj) { f32x4 b0, b1;
                    if (BASE_F32) { b0 = *(const f32x4*)(base + off + bj * 128); b1 = *(const f32x4*)(base + off + bj * 128 + 4); }
                    else { const u32x4 hb = *(const u32x4*)(out + off + bj * 128); b0 = (f32x4){bf_lo(hb.x), bf_hi(hb.x), bf_lo(hb.y), bf_hi(hb.y)}; b1 = (f32x4){bf_lo(hb.z), bf_hi(hb.z), bf_lo(hb.w), bf_hi(hb.w)}; }
                    const f32x4 v0 = b0 + gv[bj][0] * acc[ai][bj][m][0], v1 = b1 + gv[bj][1] * acc[ai][bj][m][1];
                    u32x4 w; w.x = cvt_pk_bf16(v0[0], v0[1]); w.y = cvt_pk_bf16(v0[2], v0[3]); w.z = cvt_pk_bf16(v1[0], v1[1]); w.w = cvt_pk_bf16(v1[2], v1[3]);
                    *(u32x4*)(out + off + bj * 128) = w; }
                asm volatile("" ::: "memory"); }
    }
};
struct EpiDown {
    static constexpr bool PERM = true, AFTER_DRAIN = false;
    bf16_t* Y; const float* gatev;
    DI void operator()(const f32x4 (&acc)[2][2][4][2], const Unit& u, int wr, int wc, int fr, int fq) const {
        const int row0 = u.pm * 256 + wr * 64 + fr, col0 = (u.pn & 7) * 256 + wc * 32 + 8 * fq;
#pragma unroll
        for (int ai = 0; ai < 2; ++ai)
#pragma unroll
            for (int m = 0; m < 4; ++m) { const int row = row0 + ai * 128 + m * 16; const float gt = gatev[row];
#pragma unroll
                for (int bj = 0; bj < 2; ++bj) { const f32x4 v0 = acc[ai][bj][m][0] * gt, v1 = acc[ai][bj][m][1] * gt;
                    u32x4 w; w.x = cvt_pk_bf16(v0[0], v0[1]); w.y = cvt_pk_bf16(v0[2], v0[3]); w.z = cvt_pk_bf16(v1[0], v1[1]); w.w = cvt_pk_bf16(v1[2], v1[3]);
                    *(u32x4*)(Y + (size_t)row * DM + col0 + bj * 128) = w; } }
    }
};
struct EpiQkv {
    static constexpr bool PERM = true, AFTER_DRAIN = false;
    bf16_t* Q; bf16_t* K; bf16_t* V;
    DI void operator()(const f32x4 (&acc)[2][2][4][2], const Unit& u, int wr, int wc, int fr, int fq) const {
        const int row0 = u.pm * 256 + wr * 64 + fr; int colt = u.pn * 256; bf16_t* base; int ld;
        if (colt < 2048) { base = Q; ld = 2048; } else if (colt < 2560) { base = K; ld = 512; colt -= 2048; } else { base = V; ld = 512; colt -= 2560; }
        const int col0 = colt + wc * 32 + 8 * fq;
#pragma unroll
        for (int ai = 0; ai < 2; ++ai)
#pragma unroll
            for (int m = 0; m < 4; ++m) { bf16_t* rowp = base + (size_t)(row0 + ai * 128 + m * 16) * ld + col0;
#pragma unroll
                for (int bj = 0; bj < 2; ++bj) { const f32x4 v0 = acc[ai][bj][m][0], v1 = acc[ai][bj][m][1];
                    u32x4 w; w.x = cvt_pk_bf16(v0[0], v0[1]); w.y = cvt_pk_bf16(v0[2], v0[3]); w.z = cvt_pk_bf16(v1[0], v1[1]); w.w = cvt_pk_bf16(v1[2], v1[3]);
                    *(u32x4*)(rowp + bj * 128) = w; } }
    }
};

#define LAS3 __attribute__((address_space(3)))
struct EpiQkvNorm {
    static constexpr bool PERM = true, AFTER_DRAIN = false;
    bf16_t* Q; bf16_t* K; bf16_t* V; const float* qg; const float* kg; LAS3 float* P;
    DI void operator()(const f32x4 (&acc)[2][2][4][2], const Unit& u, int wr, int wc, int fr, int fq) const {
        const int row0 = u.pm * 256 + wr * 64 + fr; int colt = u.pn * 256;
        if (colt >= 2560) {
            const int col0 = colt - 2560 + wc * 32 + 8 * fq;
#pragma unroll
            for (int ai = 0; ai < 2; ++ai)
#pragma unroll
                for (int m = 0; m < 4; ++m) { bf16_t* rowp = V + (size_t)(row0 + ai * 128 + m * 16) * 512 + col0;
#pragma unroll
                    for (int bj = 0; bj < 2; ++bj) { const f32x4 v0 = acc[ai][bj][m][0], v1 = acc[ai][bj][m][1];
                        u32x4 w; w.x = cvt_pk_bf16(v0[0], v0[1]); w.y = cvt_pk_bf16(v0[2], v0[3]); w.z = cvt_pk_bf16(v1[0], v1[1]); w.w = cvt_pk_bf16(v1[2], v1[3]);
                        *(u32x4*)(rowp + bj * 128) = w; } }
            return;
        }
        const bool isq = colt < 2048; bf16_t* base = isq ? Q : K; const int ld = isq ? 2048 : 512; if (!isq) colt -= 2048;
        const int rl0 = wr * 64 + fr;
#pragma unroll
        for (int ai = 0; ai < 2; ++ai)
#pragma unroll
            for (int m = 0; m < 4; ++m)
#pragma unroll
                for (int bj = 0; bj < 2; ++bj) { const f32x4 a = acc[ai][bj][m][0], b = acc[ai][bj][m][1];
                    float s = (a[0] * a[0] + a[1] * a[1]) + (a[2] * a[2] + a[3] * a[3]) + (b[0] * b[0] + b[1] * b[1]) + (b[2] * b[2] + b[3] * b[3]);
                    s += __shfl_xor(s, 16); s += __shfl_xor(s, 32);
                    if (fq == 0) P[((ai * 128 + m * 16 + rl0) * 2 + bj) * 4 + wc] = s; }
        asm volatile("s_waitcnt lgkmcnt(0)" ::: "memory"); __builtin_amdgcn_s_barrier(); asm volatile("" ::: "memory");
        constexpr float QSCALE = 0.08838834764831845f * 1.4426950408889634f;
        const int i0 = 16 * (wc & 1) + 4 * fq, d0 = 64 * (wc >> 1) + i0;
        const float* gp = isq ? qg : kg; f32x4 g0 = *(const f32x4*)(gp + d0), g1 = *(const f32x4*)(gp + d0 + 32);
        if (isq) { g0 = g0 * QSCALE; g1 = g1 * QSCALE; }
        f32x4 ifr;
#pragma unroll
        for (int j = 0; j < 4; ++j) ifr[j] = exp2f(-(float)(i0 + j) * (13.287712379549449f / 32.0f));
        const bool lat = u.pm < 64;
#pragma unroll
        for (int ai = 0; ai < 2; ++ai)
#pragma unroll
            for (int m = 0; m < 4; ++m) { const int row = row0 + ai * 128 + m * 16; const int t = row & (SEQ - 1);
                const float pos = (float)((wc >> 1) == 0 ? (t >> 6) : (t & 63));
                f32x4 cs, sn;
#pragma unroll
                for (int j = 0; j < 4; ++j) { const float ang = pos * ifr[j]; cs[j] = lat ? __cosf(ang) : 1.0f; sn[j] = lat ? __sinf(ang) : 0.0f; }
#pragma unroll
                for (int bj = 0; bj < 2; ++bj) { const f32x4 pp = *(const LAS3 f32x4*)(P + ((ai * 128 + m * 16 + rl0) * 2 + bj) * 4);
                    const float rstd = 1.0f / sqrtf(((pp[0] + pp[1]) + (pp[2] + pp[3])) * (1.0f / HD) + NORM_EPS);
                    const f32x4 a = acc[ai][bj][m][0] * rstd * g0, b = acc[ai][bj][m][1] * rstd * g1;
                    const f32x4 o1 = a * cs - b * sn, o2 = b * cs + a * sn;
                    u32x4 w; w.x = cvt_pk_bf16(o1[0], o1[1]); w.y = cvt_pk_bf16(o1[2], o1[3]); w.z = cvt_pk_bf16(o2[0], o2[1]); w.w = cvt_pk_bf16(o2[2], o2[3]);
                    *(u32x4*)(base + (size_t)row * ld + colt + bj * 128 + wc * 32 + 8 * fq) = w; } }
    }
};

constexpr size_t MiB = 1u << 20;
constexpr size_t WS_CTL = 0, CTL_ZERO_BYTES = 1 * MiB;
constexpr size_t WS_MOD = 1 * MiB;
constexpr size_t WS_MODP = 2 * MiB;
constexpr size_t WS_AFFL = 16 * MiB;
constexpr size_t WS_AFFC = 17 * MiB;
constexpr size_t WS_ROWSRC = 17 * MiB + 512 * 1024;
constexpr size_t WS_GATEV = 18 * MiB;
constexpr size_t WS_INV = 18 * MiB + 512 * 1024;
constexpr size_t WS_W1A = 20 * MiB;
constexpr size_t WS_W1B = 36 * MiB;
constexpr size_t WS_W2 = 44 * MiB;
constexpr size_t WS_WQKV = 52 * MiB;
constexpr size_t WS_WO = 64 * MiB;
constexpr size_t WS_WGU = 72 * MiB;
constexpr size_t WS_WDN = 328 * MiB;
constexpr size_t WS_H = 456 * MiB;
constexpr size_t WS_A = 600 * MiB;
constexpr size_t WS_U = 672 * MiB;
constexpr size_t WS_Z = 744 * MiB;
constexpr size_t WS_Q = WS_U, WS_K = WS_Z, WS_V = WS_Z + 18 * MiB;
constexpr size_t WS_HM = 816 * MiB;
constexpr size_t WS_O = WS_HM;
constexpr size_t WS_Y = 888 * MiB;
constexpr size_t WS_XS = WS_Y;
constexpr size_t WS_END = 1032 * MiB;
constexpr int CW_BAR = 4096;

constexpr int RING_BYTES = 131072;
constexpr int MISC_OFF = RING_BYTES + 14336;
constexpr int LDS_BYTES = 147456;

#define GAS __attribute__((address_space(1)))
#define LAS __attribute__((address_space(3)))
#define LDS_WAIT() asm volatile("s_waitcnt lgkmcnt(0)" ::: "memory")
#define VM_WAIT() asm volatile("s_waitcnt vmcnt(0)" ::: "memory")
#define XB_TMO      128
#define XB_XCNT(j)  (256  + 64 * (j))
#define XB_XSUB(j)  (1280 + 64 * (j))
#define XB_XGEN(j)  (2304 + 64 * (j))
#define XB_TOP      3328
#define XB_TOPGEN   3392
#define XCD_BAR_WORDS 3456
#define XB_SPIN_CAP (1u << 18)

__device__ __forceinline__ unsigned xb_ld(unsigned* p)              { return __hip_atomic_load(p, __ATOMIC_RELAXED, __HIP_MEMORY_SCOPE_AGENT); }
__device__ __forceinline__ unsigned xb_add(unsigned* p, unsigned v) { return __hip_atomic_fetch_add(p, v, __ATOMIC_RELAXED, __HIP_MEMORY_SCOPE_AGENT); }
__device__ __forceinline__ unsigned xb_xcc_id() { return (unsigned)__builtin_amdgcn_s_getreg((3 << 11) | 20) & 0xFu; }
#define XB_SPIN(cond, bar) do { unsigned _sp = 0; while (cond) { __builtin_amdgcn_s_sleep(1); \
    if ((++_sp & 255u) == 0u) { if (xb_ld(&(bar)[XB_TMO])) break; if (_sp > XB_SPIN_CAP) { atomicAdd(&(bar)[XB_TMO], 1u); break; } } } } while (0)

struct XcdBarrier {
    unsigned* bar; unsigned x;
    volatile LAS unsigned* st;
};

__device__ __forceinline__ XcdBarrier xcd_barrier_post(unsigned* bar, volatile LAS unsigned* st) {
    XcdBarrier b; b.bar = bar; b.x = xb_xcc_id(); b.st = st;
    if (threadIdx.x == 0) (void)xb_add(&bar[XB_XCNT(b.x)], 1u);
    return b;
}
__device__ __forceinline__ void xcd_barrier_complete(unsigned* bar, unsigned x, unsigned& nloc, unsigned& nx) {
    const unsigned G = gridDim.x * gridDim.y * gridDim.z;
    unsigned sum, cnt, mine, sp = 0u;
    for (;;) {
        sum = 0u; cnt = 0u; mine = 0u;
#pragma unroll
        for (unsigned j = 0; j < 16; ++j) { const unsigned c = xb_ld(&bar[XB_XCNT(j)]); sum += c; cnt += (c > 0u) ? 1u : 0u; mine = (j == x) ? c : mine; }
        if (sum == G) break;
        __builtin_amdgcn_s_sleep(1);
        if ((++sp & 255u) == 0u) { if (xb_ld(&bar[XB_TMO])) break; if (sp > XB_SPIN_CAP) { atomicAdd(&bar[XB_TMO], 1u); break; } }
    }
    nloc = mine > 0u ? mine : 1u; nx = cnt > 0u ? cnt : 1u;
}

__device__ __forceinline__ void xcd_barrier(const XcdBarrier& b) {
    asm volatile("s_waitcnt vmcnt(0)" ::: "memory");
    __syncthreads();
    if (threadIdx.x == 0) {
        unsigned* bar = b.bar;
        __builtin_amdgcn_s_waitcnt(0);
        unsigned nloc = b.st[0], nx = b.st[1];
        if (nloc == 0u) { xcd_barrier_complete(bar, b.x, nloc, nx); b.st[0] = nloc; b.st[1] = nx; }
        const unsigned old = xb_add(&bar[XB_XSUB(b.x)], 1u);
        const unsigned gen = old / nloc;
        if (old + 1u == (gen + 1u) * nloc) {
            __builtin_amdgcn_fence(__ATOMIC_RELEASE, "agent");
            asm volatile("s_waitcnt vmcnt(0)" ::: "memory");
            const unsigned og = xb_add(&bar[XB_TOP], 1u);
            const unsigned tg = og / nx;
            if (og + 1u == (tg + 1u) * nx) xb_add(&bar[XB_TOPGEN], 1u);
            else XB_SPIN(xb_ld(&bar[XB_TOPGEN]) == tg, bar);
            __builtin_amdgcn_fence(__ATOMIC_ACQUIRE, "agent");
            xb_add(&bar[XB_XGEN(b.x)], 1u);
            asm volatile("s_waitcnt vmcnt(0)" ::: "memory");
        } else {
            XB_SPIN(xb_ld(&bar[XB_XGEN(b.x)]) == gen, bar);
            __builtin_amdgcn_fence(__ATOMIC_ACQUIRE, "agent");
            asm volatile("s_waitcnt vmcnt(0)" ::: "memory");
        }
    }
    __syncthreads();
}

DI float wave_sum(float v) {
#pragma unroll
    for (int o = 1; o < 64; o <<= 1) v += __shfl_xor(v, o);
    return v;
}
DI float rdlane(float v, int l) { return __uint_as_float((unsigned)__builtin_amdgcn_readlane((int)__float_as_uint(v), l)); }
DI unsigned pk2(float lo, float hi) { return cvt_pk_bf16(lo, hi); }

DI void ph_adaln(const float* cnd, const float* cctx, const float* ada_w, float* modp, int gw, int NGW, int lane) {
    for (int task = gw; task < 96 * KSPLIT; task += NGW) {
        const int ks = task & (KSPLIT - 1), cg = task / KSPLIT, l = cg / 48, cgl = cg % 48, col0 = cgl * 256 + lane * 4, k0 = ks * 128;
        float sv[9][2];
#pragma unroll
        for (int r = 0; r < 9; ++r)
#pragma unroll
            for (int hh = 0; hh < 2; ++hh) { const int k = k0 + hh * 64 + lane; const float v = r < 8 ? cnd[r * DM + k] : cctx[k]; sv[r][hh] = v / (1.0f + __expf(-v)); }
        f32x4 acc[9];
#pragma unroll
        for (int r = 0; r < 9; ++r) acc[r] = (f32x4){0.f, 0.f, 0.f, 0.f};
        const float* wp = ada_w + ((size_t)l * DM + k0) * NMOD + col0;
#pragma unroll
        for (int hh = 0; hh < 2; ++hh) {
#pragma unroll 8
            for (int kk = 0; kk < 64; ++kk) {
                const f32x4 w = *(const f32x4*)(wp + (size_t)(hh * 64 + kk) * NMOD);
#pragma unroll
                for (int r = 0; r < 9; ++r) { const float s = rdlane(sv[r][hh], kk); acc[r] += w * s; }
            }
        }
#pragma unroll
        for (int r = 0; r < 9; ++r) *(f32x4*)(modp + ((size_t)((ks * 2 + l) * 9 + r)) * NMOD + col0) = acc[r];
    }
}
struct CvtPtrs { const float *cin, *cout, *wqkv, *wo, *wg, *wu, *wd; bf16_t *W1A, *W1B, *W2, *WQKV, *WO, *WGU, *WDN; };
constexpr int CVT_E0 = 6656, CVT_L = 24576, CVT_TOTAL = CVT_E0 + 2 * CVT_L;
DI void cvt_resolve(const CvtPtrs& P, int it, const float*& src, int& ldw, bf16_t*& dst, int& ldd, bool& qperm) {
    int r = it; qperm = false;
    if (r < 3072) { const int kt = r / 96, nt = r % 96, n0 = nt * 64, part = n0 >> 11, j0 = n0 & 2047;
        src = P.cin + (size_t)(kt * 64) * 6144 + n0; ldw = 6144; ldd = DM;
        dst = (part == 0 ? P.W1B + (size_t)j0 * DM : P.W1A + (size_t)((j0 >> 7) * 256 + (part == 2 ? 128 : 0) + (j0 & 127)) * DM) + kt * 64; return; } r -= 3072;
    if (r < 1024) { const int kt = r / 32, nt = r % 32; src = P.cout + (size_t)(kt * 64) * DM + nt * 64; ldw = DM; dst = P.W2 + (size_t)(nt * 64) * DM + kt * 64; ldd = DM; return; } r -= 1024;
    if (r < 1536) { const int kt = r / 48, nt = r % 48; src = P.wqkv + (size_t)(kt * 64) * 3072 + nt * 64; ldw = 3072; qperm = nt < 40;     dst = P.WQKV + (size_t)(nt * 64) * DM + kt * 64; ldd = DM; return; } r -= 1536;
    if (r < 1024) { const int kt = r / 32, nt = r % 32; src = P.wo + (size_t)(kt * 64) * DM + nt * 64; ldw = DM; dst = P.WO + (size_t)(nt * 64) * DM + kt * 64; ldd = DM; return; } r -= 1024;
    const int l = r / CVT_L, rr = r % CVT_L, kind = rr / 8192, q = rr % 8192, le = l * 16 + q / 512, rem = q % 512;
    if (kind < 2) { const int kt = rem / 16, nt = rem % 16, n0 = nt * 64;
        src = (kind ? P.wu : P.wg) + (size_t)le * DM * DFF + (size_t)(kt * 64) * DFF + n0; ldw = DFF;
        dst = P.WGU + (size_t)(le * 2048 + (n0 >> 7) * 256 + kind * 128 + (n0 & 127)) * DM + kt * 64; ldd = DM; }
    else { const int kt = rem / 32, nt = rem % 32;
        src = P.wd + (size_t)le * DFF * DM + (size_t)(kt * 64) * DM + nt * 64; ldw = DM; dst = P.WDN + (size_t)(le * 2048 + nt * 64) * DFF + kt * 64; ldd = DFF; }
}
constexpr int CVT_P = 36;
DI void cvt_range(const CvtPtrs& P, int lo, int hi, int w, int NW, LAS unsigned* scr, int lane) {
    int it = lo + w; if (it >= hi) return;
    const int c = lane & 15, q = lane >> 4;
    const float* src; int ldw; bf16_t* dst; int ldd; bool qperm; cvt_resolve(P, it, src, ldw, dst, ldd, qperm);
    f32x4 v[16];
#pragma unroll
    for (int rr = 0; rr < 16; ++rr) v[rr] = __builtin_nontemporal_load((const f32x4*)(src + (size_t)(16 * q + rr) * ldw + 4 * c));
    for (;;) {
        u32x4 pa[4], pb[4];
#pragma unroll
        for (int i = 0; i < 4; ++i) { pa[i].x = pk2(v[0][i], v[1][i]); pa[i].y = pk2(v[2][i], v[3][i]); pa[i].z = pk2(v[4][i], v[5][i]); pa[i].w = pk2(v[6][i], v[7][i]);
                                      pb[i].x = pk2(v[8][i], v[9][i]); pb[i].y = pk2(v[10][i], v[11][i]); pb[i].z = pk2(v[12][i], v[13][i]); pb[i].w = pk2(v[14][i], v[15][i]); }
        const int nit = it + NW; bf16_t* cdst = dst; const int cldd = ldd; const int wrow = qperm ? 32 * ((c >> 2) & 1) + 8 * (c & 3) + 4 * (c >> 3) : 4 * c;
        if (nit < hi) { cvt_resolve(P, nit, src, ldw, dst, ldd, qperm);
#pragma unroll
            for (int rr = 0; rr < 16; ++rr) v[rr] = __builtin_nontemporal_load((const f32x4*)(src + (size_t)(16 * q + rr) * ldw + 4 * c)); }
#pragma unroll
        for (int i = 0; i < 4; ++i) { *(LAS u32x4*)(scr + (wrow + i) * CVT_P + 8 * q) = pa[i]; *(LAS u32x4*)(scr + (wrow + i) * CVT_P + 8 * q + 4) = pb[i]; }
        LDS_WAIT(); asm volatile("" ::: "memory");
#pragma unroll
        for (int j = 0; j < 8; ++j) { const int n = (lane >> 3) + 8 * j; const u32x4 o = *(const LAS u32x4*)(scr + n * CVT_P + 4 * (lane & 7));
            *(u32x4*)(cdst + (size_t)n * cldd + 8 * (lane & 7)) = o; }
        LDS_WAIT(); asm volatile("" ::: "memory");
        if (nit >= hi) break;
        it = nit;
    }
}
DI void ph_modred(const float* modp, const float* ada_b, float* mod, int gtid, int GT) {
    for (int i = gtid; i < 2 * 9 * NMOD; i += GT) { const int l = i / (9 * NMOD), j = i % NMOD; float s = ada_b[l * NMOD + j];
#pragma unroll
        for (int ks = 0; ks < KSPLIT; ++ks) s += modp[(size_t)ks * (2 * 9 * NMOD) + i];
        mod[i] = s; }
}
DI void row_load(const float* p, f32x4 (&v)[8], int lane) {
#pragma unroll
    for (int j = 0; j < 8; ++j) v[j] = *(const f32x4*)(p + 4 * lane + 256 * j);
}
DI void row_load_bf(const bf16_t* p, f32x4 (&v)[8], int lane) {
#pragma unroll
    for (int j = 0; j < 8; ++j) { const u32x2 w = *(const u32x2*)(p + 4 * lane + 256 * j); v[j] = (f32x4){bf_lo(w.x), bf_hi(w.x), bf_lo(w.y), bf_hi(w.y)}; }
}
DI void row_modulate(const f32x4 (&v)[8], f32x4 (&y)[8], const float* gain, const float* shift, const float* scale, int lane) {
    float ss = 0.f;
#pragma unroll
    for (int j = 0; j < 8; ++j) ss += (v[j][0] * v[j][0] + v[j][1] * v[j][1]) + (v[j][2] * v[j][2] + v[j][3] * v[j][3]);
    ss = wave_sum(ss);
    const float rstd = 1.0f / sqrtf(ss * (1.0f / DM) + NORM_EPS);
#pragma unroll
    for (int j = 0; j < 8; ++j) { const int c = 4 * lane + 256 * j; const f32x4 g = *(const f32x4*)(gain + c), sh = *(const f32x4*)(shift + c), sc = *(const f32x4*)(scale + c);
        y[j] = ((v[j] * rstd) * g) * (sc + 1.0f) + sh; }
}
DI void row_store_bf16(bf16_t* p, const f32x4 (&y)[8], int lane) {
#pragma unroll
    for (int j = 0; j < 8; ++j) { u32x2 w; w.x = pk2(y[j][0], y[j][1]); w.y = pk2(y[j][2], y[j][3]); *(u32x2*)(p + 4 * lane + 256 * j) = w; }
}
DI void ph_mod0(const float* x, const float* ctx, const float* gain, const float* mod0, bf16_t* A, int gw, int NGW, int lane) {
    for (int row = gw; row < MT; row += NGW) {
        const int cr = row < ML ? (row >> 11) : 8; const float* src = row < ML ? x + (size_t)row * DM : ctx + (size_t)(row - ML) * DM;
        f32x4 v[8], y[8]; row_load(src, v, lane);
        row_modulate(v, y, gain, mod0 + (size_t)cr * NMOD + 0 * DM, mod0 + (size_t)cr * NMOD + 1 * DM, lane);
        row_store_bf16(A + (size_t)row * DM, y, lane);
    }
}
DI void router_row(const f32x4 (&y)[8], const LAS float* rwT, float* affL, float* affC, int row, int lane) {
    float lg[16];
#pragma unroll
    for (int e = 0; e < 16; ++e) { float s = 0.f;
#pragma unroll
        for (int j = 0; j < 8; ++j) { const f32x4 w = *(const LAS f32x4*)(rwT + e * DM + 4 * lane + 256 * j); s += (y[j][0] * w[0] + y[j][1] * w[1]) + (y[j][2] * w[2] + y[j][3] * w[3]); }
        lg[e] = wave_sum(s); }
    float mx = lg[0];
#pragma unroll
    for (int e = 1; e < 16; ++e) mx = fmaxf(mx, lg[e]);
    float den = 0.f;
#pragma unroll
    for (int e = 0; e < 16; ++e) { lg[e] = __expf(lg[e] - mx); den += lg[e]; }
    float mine = 0.f;
#pragma unroll
    for (int e = 0; e < 16; ++e) mine = (lane == e) ? lg[e] : mine;
    mine = mine / den;
    if (lane < 16) { if (row < ML) { const int b = row >> 11, n = row & 2047; affL[(size_t)(b * 16 + lane) * SEQ + n] = mine; }
                     else { const int rc = row - ML, b = rc >> 8, n = rc & 255; affC[(size_t)(b * 16 + lane) * CTXL + n] = mine; } }
}
DI void load_router(const float* rw, LAS float* rwT, int tid) {
    for (int i = tid; i < DM * 16; i += 512) rwT[(i & 15) * DM + (i >> 4)] = rw[i];
    __syncthreads();
}
DI void ph_modffn(const bf16_t* H, const float* gain, const float* modl, bf16_t* A, const LAS float* rwT, float* affL, float* affC, int nrows, int gw, int NGW, int lane) {
    for (int row = gw; row < nrows; row += NGW) {
        const int cr = row < ML ? (row >> 11) : 8;
        f32x4 v[8], y[8]; row_load_bf(H + (size_t)row * DM, v, lane);
        row_modulate(v, y, gain, modl + (size_t)cr * NMOD + 3 * DM, modl + (size_t)cr * NMOD + 4 * DM, lane);
        row_store_bf16(A + (size_t)row * DM, y, lane);
        router_row(y, rwT, affL, affC, row, lane);
    }
}
DI void ph_topk(int nitems, const float* affL, const float* affC, int* rowsrc, float* gatev, int* inv, LAS unsigned* hist, int tid, int lane, int wave, int bid, int G) {
    LAS unsigned* sh = hist + 256;
    for (int it = bid; it < nitems; it += G) {
        const bool isc = it >= 128; const int be = it & 127, b = be >> 4, e = be & 15;
        const int N = isc ? CTXL : SEQ, C = isc ? CAPC : CAPL;
        const float* src = isc ? affC + (size_t)be * CTXL : affL + (size_t)be * SEQ;
        const int i0 = tid * 4; const bool valid = i0 < N;
        unsigned key[4];
        { f32x4 v = (f32x4){0.f, 0.f, 0.f, 0.f}; if (valid) v = *(const f32x4*)(src + i0);
#pragma unroll
          for (int q = 0; q < 4; ++q) key[q] = __float_as_uint(v[q]); }
        unsigned prefix = 0u, mask = 0u, krem = (unsigned)C;
        for (int pass = 3; pass >= 0; --pass) {
            const int shift = pass * 8;
            if (tid < 256) hist[tid] = 0u;
            __syncthreads();
            if (valid) {
#pragma unroll
                for (int q = 0; q < 4; ++q) if ((key[q] & mask) == prefix) __hip_atomic_fetch_add(&hist[(key[q] >> shift) & 255u], 1u, __ATOMIC_RELAXED, __HIP_MEMORY_SCOPE_WORKGROUP); }
            __syncthreads();
            if (wave == 0) {
                const unsigned h0 = hist[4 * lane], h1 = hist[4 * lane + 1], h2 = hist[4 * lane + 2], h3 = hist[4 * lane + 3];
                const unsigned tot = h0 + h1 + h2 + h3; unsigned incl = tot;
#pragma unroll
                for (int o = 1; o < 64; o <<= 1) { const unsigned t = __shfl_down(incl, o); if (lane + o < 64) incl += t; }
                const unsigned a3 = incl - tot, a2 = a3 + h3, a1 = a2 + h2, a0 = a1 + h1;
                if (a3 < krem && krem <= a3 + h3) { sh[0] = 4 * lane + 3; sh[1] = krem - a3; }
                if (a2 < krem && krem <= a2 + h2) { sh[0] = 4 * lane + 2; sh[1] = krem - a2; }
                if (a1 < krem && krem <= a1 + h1) { sh[0] = 4 * lane + 1; sh[1] = krem - a1; }
                if (a0 < krem && krem <= a0 + h0) { sh[0] = 4 * lane + 0; sh[1] = krem - a0; }
            }
            __syncthreads();
            const unsigned B = sh[0]; krem = sh[1]; prefix |= B << shift; mask |= 0xFFu << shift;
        }
        const unsigned T = prefix;
        unsigned cg = 0u, ce = 0u;
        if (valid) {
#pragma unroll
            for (int q = 0; q < 4; ++q) { cg += key[q] > T ? 1u : 0u; ce += key[q] == T ? 1u : 0u; } }
        const unsigned mine = cg | (ce << 16); unsigned incl = mine;
#pragma unroll
        for (int o = 1; o < 64; o <<= 1) { const unsigned t = __shfl_up(incl, o); if (lane >= o) incl += t; }
        if (lane == 63) sh[8 + wave] = incl;
        __syncthreads();
        unsigned woff = 0u;
#pragma unroll
        for (int w = 0; w < 8; ++w) woff += (w < wave) ? sh[8 + w] : 0u;
        const unsigned excl = woff + incl - mine; unsigned gtb = excl & 0xFFFFu, eqb = excl >> 16;
        if (valid) {
            const int ybase = e * YR + (isc ? NB * CAPL + b * CAPC : b * CAPL); const int rbase = isc ? ML + b * CTXL : b * SEQ;
#pragma unroll
            for (int q = 0; q < 4; ++q) {
                const bool isg = key[q] > T, ise = key[q] == T; const bool sel = isg || (ise && eqb < krem);
                const unsigned slot = gtb + (eqb < krem ? eqb : krem);
                const int trow = rbase + i0 + q; const int yrow = ybase + (int)slot;
                if (sel) { rowsrc[yrow] = trow; gatev[yrow] = __uint_as_float(key[q]); }
                inv[(size_t)trow * 16 + e] = sel ? yrow : -1;
                gtb += isg ? 1u : 0u; eqb += ise ? 1u : 0u;
            }
        }
        __syncthreads();
    }
}
DI void ph_gather(const bf16_t* A, const int* rowsrc, bf16_t* XS, bool with_ctx, int gw, int NGW, int lane) {
    for (int yr = gw; yr < YT; yr += NGW) {
        if (!with_ctx && (yr % YR) >= NB * CAPL) continue;
        const int src = rowsrc[yr];
        const u32x4* s = (const u32x4*)(A + (size_t)src * DM); u32x4* d = (u32x4*)(XS + (size_t)yr * DM);
#pragma unroll
        for (int j = 0; j < 4; ++j) d[lane + 64 * j] = s[lane + 64 * j];
    }
}
template <bool LAST> DI void ph_combine(bf16_t* H, const bf16_t* Y, const int* inv, const float* modl  , const float* gain1, const float* mod1, bf16_t* A, float* out, int nrows, int gw, int NGW, int lane) {
    for (int row = gw; row < nrows; row += NGW) {
        const int cr = row < ML ? (row >> 11) : 8;
        f32x4 v[8], acc[8]; row_load_bf(H + (size_t)row * DM, v, lane);
#pragma unroll
        for (int j = 0; j < 8; ++j) acc[j] = (f32x4){0.f, 0.f, 0.f, 0.f};
        const int myinv = inv[(size_t)row * 16 + (lane & 15)];
        for (int e = 0; e < 16; ++e) {
            const int yr = __builtin_amdgcn_readlane(myinv, e);
            if (yr >= 0) { const bf16_t* yp = Y + (size_t)yr * DM + 4 * lane;
#pragma unroll
                for (int j = 0; j < 8; ++j) { const u32x2 p = *(const u32x2*)(yp + 256 * j); acc[j][0] += bf_lo(p.x); acc[j][1] += bf_hi(p.x); acc[j][2] += bf_lo(p.y); acc[j][3] += bf_hi(p.y); } }
        }
        const float* g2 = modl + (size_t)cr * NMOD + 5 * DM;
#pragma unroll
        for (int j = 0; j < 8; ++j) { const f32x4 g = *(const f32x4*)(g2 + 4 * lane + 256 * j); v[j] = v[j] + g * acc[j]; }
        if (LAST) {
#pragma unroll
            for (int j = 0; j < 8; ++j) *(f32x4*)(out + (size_t)row * DM + 4 * lane + 256 * j) = v[j];
        } else {
            row_store_bf16(H + (size_t)row * DM, v, lane);
            f32x4 y[8]; row_modulate(v, y, gain1, mod1 + (size_t)cr * NMOD + 0 * DM, mod1 + (size_t)cr * NMOD + 1 * DM, lane);
            row_store_bf16(A + (size_t)row * DM, y, lane);
        }
    }
}
DI void ph_qknorm(bf16_t* Q, bf16_t* K, const float* qg, const float* kg, int gw, int NGW, int lane) {
    const int half = lane >> 5, i = lane & 31, d1 = half * 64 + i, d2 = d1 + 32;
    const float inv_freq = exp2f(-(float)i * (13.287712379549449f / 32.0f));
    constexpr float QSCALE = 0.08838834764831845f * 1.4426950408889634f;
    const float qg1 = qg[d1] * QSCALE, qg2 = qg[d2] * QSCALE, kg1 = kg[d1], kg2 = kg[d2];
    for (int row = gw; row < MT; row += NGW) {
        const bool lat = row < ML; const int t = row & (SEQ - 1);
        const float pos = (float)(half == 0 ? (t >> 6) : (t & 63)); const float ang = pos * inv_freq;
        const float cs = lat ? __cosf(ang) : 1.0f, sn = lat ? __sinf(ang) : 0.0f;
        if (lat) {
            for (int hd = 0; hd < NH; ++hd) { bf16_t* p = Q + (size_t)row * DM + hd * HD;
                float x1 = __uint_as_float((unsigned)p[d1] << 16), x2 = __uint_as_float((unsigned)p[d2] << 16);
                const float ss = wave_sum(x1 * x1 + x2 * x2); const float rstd = 1.0f / sqrtf(ss * (1.0f / HD) + NORM_EPS);
                x1 = x1 * rstd * qg1; x2 = x2 * rstd * qg2;
                const float o1 = x1 * cs - x2 * sn, o2 = x2 * cs + x1 * sn;
                const unsigned w = pk2(o1, o2); p[d1] = (bf16_t)(w & 0xffffu); p[d2] = (bf16_t)(w >> 16); }
        }
        for (int kh = 0; kh < NKV; ++kh) { bf16_t* p = K + (size_t)row * 512 + kh * HD;
            float x1 = __uint_as_float((unsigned)p[d1] << 16), x2 = __uint_as_float((unsigned)p[d2] << 16);
            const float ss = wave_sum(x1 * x1 + x2 * x2); const float rstd = 1.0f / sqrtf(ss * (1.0f / HD) + NORM_EPS);
            x1 = x1 * rstd * kg1; x2 = x2 * rstd * kg2;
            const float o1 = x1 * cs - x2 * sn, o2 = x2 * cs + x1 * sn;
            const unsigned w = pk2(o1, o2); p[d1] = (bf16_t)(w & 0xffffu); p[d2] = (bf16_t)(w >> 16); }
    }
}
constexpr int KP = 272;
constexpr int ATT_VOFF = 64 * KP;
constexpr int ATT_TILE = 2 * 64 * KP;
DI int crow(int reg, int h) { return (reg & 3) + 8 * (reg >> 2) + 4 * h; }
DI s16x4 vtr(const LAS unsigned char* p) { typedef short v4i16_t __attribute__((ext_vector_type(4))); return __builtin_bit_cast(s16x4, __builtin_amdgcn_ds_read_tr16_b64_v4i16((LAS v4i16_t*)p)); }
DI bool att_tile_info(int item, int ti, int& base, int& mtype) {
    const int qhalf = item & 1, n = (item >> 3) & 15, b = item >> 7, tt = ti & 1; mtype = 0;
    if (ti < 4) { base = ML + b * CTXL + 64 * ti; return true; }
    const int blk = n - 1 + ((ti - 4) >> 1); if (blk < 0 || blk > 15) return false;
    if (ti < 6) { mtype = 1; if (tt == 0 && qhalf == 1) return false; } else if (ti >= 8) { mtype = 2; if (tt == 1 && qhalf == 0) return false; }
    base = b * SEQ + blk * 128 + 64 * tt; return true;
}
DI void att_next(int& item, int& ti, int G) { for (;;) { ++ti; if (ti >= 10) { ti = 0; item += G; return; } int b_, m_; if (att_tile_info(item, ti, b_, m_)) return; } }
DI void ph_attn(const bf16_t* Q, const bf16_t* Kb, const bf16_t* Vb, bf16_t* O, const float* sink, LAS unsigned char* lds, int tid, int lane, int wave, int bid, int G) {
    constexpr float LOG2E = 1.4426950408889634f;
    const int r = lane & 31, h = lane >> 5, g = wave >> 1, sub = wave & 1;
    const int ldrow = tid >> 3, ldc = tid & 7;
    int item = bid, ti = 0; if (item >= 1024) return;
    u32x4 kr[2], vr[2];
#define ATT_ISSUE(it_, ti_) do { int base_, mt_; att_tile_info(it_, ti_, base_, mt_); const int kvh_ = ((it_) >> 1) & 3; \
        _Pragma("unroll") for (int c2 = 0; c2 < 2; ++c2) { const size_t off_ = (size_t)(base_ + ldrow) * 512 + kvh_ * HD + (ldc + 8 * c2) * 8; kr[c2] = *(const u32x4*)(Kb + off_); vr[c2] = *(const u32x4*)(Vb + off_); } } while (0)
    bf16x8 qf[8]; float m2 = 0.f, lsum = 1.f; f32x16 o[4];
#define ATT_QLOAD(it_) do { const int qrow_ = ((it_) >> 7) * SEQ + (((it_) >> 3) & 15) * 128 + ((it_) & 1) * 64 + sub * 32 + r; const int head_ = (((it_) >> 1) & 3) * 4 + g; \
        _Pragma("unroll") for (int s = 0; s < 8; ++s) qf[s] = *(const bf16x8*)(Q + (size_t)qrow_ * DM + head_ * HD + 16 * s + 8 * h); } while (0)
    ATT_QLOAD(item);
    ATT_ISSUE(item, ti);
    int buf = 0;
    while (item < 1024) {
        int nitem = item, nti = ti; att_next(nitem, nti, G);
        LAS unsigned char* tb = lds + buf * ATT_TILE;
#pragma unroll
        for (int c2 = 0; c2 < 2; ++c2) { *(LAS u32x4*)(tb + ldrow * KP + (ldc + 8 * c2) * 16) = kr[c2]; *(LAS u32x4*)(tb + ATT_VOFF + ldrow * KP + (ldc + 8 * c2) * 16) = vr[c2]; }
        if (nitem < 1024) ATT_ISSUE(nitem, nti);
        asm volatile("s_waitcnt lgkmcnt(0)" ::: "memory"); __builtin_amdgcn_s_barrier(); asm volatile("" ::: "memory");
        int base, mtype; att_tile_info(item, ti, base, mtype); const int tt = ti & 1;
        const int qhalf = item & 1, kvh = (item >> 1) & 3, n = (item >> 3) & 15, b = item >> 7;
        const int head = kvh * 4 + g, qq = qhalf * 64 + sub * 32 + r; const int qrow = b * SEQ + n * 128 + qq;
        if (ti == 0) {
            m2 = sink[head] * LOG2E; lsum = 1.0f;
#pragma unroll
            for (int d = 0; d < 4; ++d)
#pragma unroll
                for (int i = 0; i < 16; ++i) o[d][i] = 0.f;
        }
        f32x16 x0, x1;
#pragma unroll
        for (int i = 0; i < 16; ++i) { x0[i] = 0.f; x1[i] = 0.f; }
#pragma unroll
        for (int s = 0; s < 8; ++s) {
            const bf16x8 k0 = *(const LAS bf16x8*)(tb + r * KP + (16 * s + 8 * h) * 2), k1 = *(const LAS bf16x8*)(tb + (32 + r) * KP + (16 * s + 8 * h) * 2);
            x0 = __builtin_amdgcn_mfma_f32_32x32x16_bf16(k0, qf[s], x0, 0, 0, 0); x1 = __builtin_amdgcn_mfma_f32_32x32x16_bf16(k1, qf[s], x1, 0, 0, 0); }
        if (nitem != item && nitem < 1024) ATT_QLOAD(nitem);
        if (mtype == 1) {
#pragma unroll
            for (int i = 0; i < 16; ++i) { const int kk0 = tt * 64 + crow(i, h); if (kk0 < qq) x0[i] = -1.0e30f; if (kk0 + 32 < qq) x1[i] = -1.0e30f; } }
        if (mtype == 2) {
#pragma unroll
            for (int i = 0; i < 16; ++i) { const int kk0 = tt * 64 + crow(i, h); if (kk0 > qq) x0[i] = -1.0e30f; if (kk0 + 32 > qq) x1[i] = -1.0e30f; } }
        float tmax = fmaxf(x0[0], x1[0]);
#pragma unroll
        for (int i = 1; i < 16; ++i) tmax = fmaxf(tmax, fmaxf(x0[i], x1[i]));
        tmax = fmaxf(tmax, __shfl_xor(tmax, 32));
        const float mnew = fmaxf(m2, tmax), alpha = __builtin_amdgcn_exp2f(m2 - mnew); m2 = mnew;
        float ps = 0.f;
#pragma unroll
        for (int i = 0; i < 16; ++i) { x0[i] = __builtin_amdgcn_exp2f(x0[i] - mnew); x1[i] = __builtin_amdgcn_exp2f(x1[i] - mnew); ps += x0[i] + x1[i]; }
        ps += __shfl_xor(ps, 32); lsum = lsum * alpha + ps;
        if (__any(alpha != 1.0f)) {
#pragma unroll
            for (int d = 0; d < 4; ++d)
#pragma unroll
                for (int i = 0; i < 16; ++i) o[d][i] *= alpha; }
        bf16x8 pf[2][2];
#pragma unroll
        for (int s = 0; s < 2; ++s) {
            u32x4 a, c; a.x = pk2(x0[8 * s + 0], x0[8 * s + 1]); a.y = pk2(x0[8 * s + 2], x0[8 * s + 3]); a.z = pk2(x0[8 * s + 4], x0[8 * s + 5]); a.w = pk2(x0[8 * s + 6], x0[8 * s + 7]);
            c.x = pk2(x1[8 * s + 0], x1[8 * s + 1]); c.y = pk2(x1[8 * s + 2], x1[8 * s + 3]); c.z = pk2(x1[8 * s + 4], x1[8 * s + 5]); c.w = pk2(x1[8 * s + 6], x1[8 * s + 7]);
            pf[0][s] = __builtin_bit_cast(bf16x8, a); pf[1][s] = __builtin_bit_cast(bf16x8, c); }
        const LAS unsigned char* vb = tb + ATT_VOFF + (4 * h + ((lane & 15) >> 2)) * KP + (16 * ((lane >> 4) & 1) + 4 * (lane & 3)) * 2;
#pragma unroll
        for (int d = 0; d < 4; ++d)
#pragma unroll
            for (int t = 0; t < 2; ++t)
#pragma unroll
                for (int s = 0; s < 2; ++s) {
                    const s16x4 lo = vtr(vb + (t * 32 + 16 * s) * KP + d * 64), hi = vtr(vb + (t * 32 + 16 * s + 8) * KP + d * 64);
                    const bf16x8 vf = (bf16x8){lo[0], lo[1], lo[2], lo[3], hi[0], hi[1], hi[2], hi[3]};
                    o[d] = __builtin_amdgcn_mfma_f32_32x32x16_bf16(vf, pf[t][s], o[d], 0, 0, 0); }
        if (nitem != item) {
            const float il = 1.0f / lsum;
            bf16_t* op = O + (size_t)qrow * DM + head * HD + 4 * h;
#pragma unroll
            for (int d = 0; d < 4; ++d)
#pragma unroll
                for (int g4 = 0; g4 < 4; ++g4) { u32x2 w; w.x = pk2(o[d][4 * g4 + 0] * il, o[d][4 * g4 + 1] * il); w.y = pk2(o[d][4 * g4 + 2] * il, o[d][4 * g4 + 3] * il);
                    *(u32x2*)(op + d * 32 + 8 * g4) = w; }
        }
        item = nitem; ti = nti; buf ^= 1;
    }
#undef ATT_ISSUE
#undef ATT_QLOAD
}

#ifndef MK_ONE_LAUNCH
#define MK_ONE_LAUNCH 1
#endif
constexpr int NPHASE = 19;
#ifndef MK_CVT_Q
#define MK_CVT_Q 0
#endif
constexpr int CVT_Q = MK_CVT_Q;
constexpr int CVT_X0_END = CVT_E0 + CVT_L;
constexpr int CVT_R3_LO = CVT_X0_END - 3 * CVT_Q, CVT_R4_LO = CVT_X0_END - 2 * CVT_Q, CVT_R5_LO = CVT_X0_END - CVT_Q;
constexpr int CVT_R9_LO = CVT_TOTAL - 5 * CVT_Q / 2, CVT_R10_LO = CVT_TOTAL - 3 * CVT_Q / 2, CVT_R12_LO = CVT_TOTAL - CVT_Q;
static_assert(CVT_Q <= 8192 && CVT_Q % 2 == 0, "tail quota");
#define CVT_MKCP() CvtPtrs CP; CP.cin = args.in[8]; CP.cout = args.in[10]; CP.wqkv = args.in[11]; CP.wo = args.in[15]; CP.wg = args.in[17]; CP.wu = args.in[18]; CP.wd = args.in[19]; \
    CP.W1A = W1A; CP.W1B = W1B; CP.W2 = W2; CP.WQKV = WQKV; CP.WO = WOt; CP.WGU = WGU; CP.WDN = WDN
#define CVT_TAIL(NWG, LO, HI) do { if ((LO) < (HI)) { CVT_MKCP(); const int busy_ = (NWG) % G; if (busy_ == 0) cvt_range(CP, LO, HI, gw, NGW, cscr, lane); else if (bid >= busy_) cvt_range(CP, LO, HI, (bid - busy_) * 8 + wave, (G - busy_) * 8, cscr, lane); } } while (0)
#ifndef MK_DUP_MASK
#define MK_DUP_MASK 0u
#endif
constexpr unsigned DUP_MASK = MK_DUP_MASK;
struct Args { const float* in[20]; float* out; unsigned char* ws; int ph_lo, ph_hi; };
__global__ void __launch_bounds__(512, 2) dit_fwd(Args args) {
    extern __shared__ __attribute__((aligned(16))) unsigned char lds_raw[];
    LAS unsigned char* lds = (LAS unsigned char*)lds_raw;
    const int tid = threadIdx.x, lane = tid & 63, wave = __builtin_amdgcn_readfirstlane(tid >> 6);
    const int G = gridDim.x, bid = blockIdx.x;
    const int gw = bid * 8 + wave, NGW = G * 8;
    unsigned char* ws = args.ws;
    const float* x = args.in[0]; const float* cnd = args.in[1]; const float* ctx = args.in[2]; const float* cctx = args.in[3];
    const float* ada_w = args.in[4]; const float* ada_b = args.in[5]; const float* nmix = args.in[6]; const float* nffn = args.in[7];
    const float* conv_w = args.in[9]; const float* qgain = args.in[12]; const float* kgain = args.in[13]; const float* sink = args.in[14]; const float* router_w = args.in[16];
    float* mod = (float*)(ws + WS_MOD); float* modp = (float*)(ws + WS_MODP);
    float* affL = (float*)(ws + WS_AFFL); float* affC = (float*)(ws + WS_AFFC);
    int* rowsrc = (int*)(ws + WS_ROWSRC); float* gatev = (float*)(ws + WS_GATEV); int* inv = (int*)(ws + WS_INV);
    bf16_t* W1A = (bf16_t*)(ws + WS_W1A); bf16_t* W1B = (bf16_t*)(ws + WS_W1B); bf16_t* W2 = (bf16_t*)(ws + WS_W2); bf16_t* WQKV = (bf16_t*)(ws + WS_WQKV); bf16_t* WOt = (bf16_t*)(ws + WS_WO);
    bf16_t* WGU = (bf16_t*)(ws + WS_WGU); bf16_t* WDN = (bf16_t*)(ws + WS_WDN);
    bf16_t* H = (bf16_t*)(ws + WS_H); bf16_t* A = (bf16_t*)(ws + WS_A); bf16_t* U = (bf16_t*)(ws + WS_U); bf16_t* Z = (bf16_t*)(ws + WS_Z);
    bf16_t* Qb = (bf16_t*)(ws + WS_Q); bf16_t* Kb = (bf16_t*)(ws + WS_K); bf16_t* Vb = (bf16_t*)(ws + WS_V); bf16_t* Ob = (bf16_t*)(ws + WS_O);
    bf16_t* HM = (bf16_t*)(ws + WS_HM); bf16_t* Y = (bf16_t*)(ws + WS_Y); bf16_t* XS = (bf16_t*)(ws + WS_XS);
    LAS unsigned* cscr = (LAS unsigned*)(lds + wave * 9216);

    for (int u = tid; u < (LDS_BYTES - MISC_OFF) / 4; u += 512) ((LAS unsigned*)(lds + MISC_OFF))[u] = 0u;
    __syncthreads();
#if MK_ONE_LAUNCH
    XcdBarrier bar = xcd_barrier_post((unsigned*)(ws + WS_CTL) + CW_BAR, (volatile LAS unsigned*)(lds + MISC_OFF) + 8);
#define GRID_BAR() xcd_barrier(bar)
#else
#define GRID_BAR() do {} while (0)
#endif
    const int lo = args.ph_lo, hi = args.ph_hi;
#define IN(k) (lo <= (k) && (k) < hi)
#define SEAM(k) do { if (IN(k) && IN((k) + 1)) GRID_BAR(); } while (0)

    if (IN(0)) _Pragma("unroll") for (int rep_ = 0; rep_ < 1 + (int)((DUP_MASK >> 0) & 1u); ++rep_) { if (rep_) GRID_BAR();
        ph_adaln(cnd, cctx, ada_w, modp, gw, NGW, lane);
        CVT_MKCP();
        cvt_range(CP, 0, CVT_R3_LO, gw, NGW, cscr, lane); cvt_range(CP, CVT_X0_END, CVT_R9_LO, gw, NGW, cscr, lane);
    } SEAM(0);
    if (IN(1)) _Pragma("unroll") for (int rep_ = 0; rep_ < 1 + (int)((DUP_MASK >> 1) & 1u); ++rep_) { if (rep_) GRID_BAR();  ph_modred(modp, ada_b, mod, bid * 512 + tid, G * 512); } SEAM(1);
    if (IN(2)) _Pragma("unroll") for (int rep_ = 0; rep_ < 1 + (int)((DUP_MASK >> 2) & 1u); ++rep_) { if (rep_) GRID_BAR();  ph_mod0(x, ctx, nmix, mod, A, gw, NGW, lane); } SEAM(2);
    if (IN(3)) _Pragma("unroll") for (int rep_ = 0; rep_ < 1 + (int)((DUP_MASK >> 3) & 1u); ++rep_) { if (rep_) GRID_BAR();
        pg8::Gemm g{A, W1A, MT, 4096, DM}; pg8::StaticOrder S; S.init(MT, 4096, G, bid);
        EpiPair<0> E{U, DM, 16};
        pg8::gemm_phase<EpiPair<0>, pg8::StaticOrder, true, true>(lds, g, S, E);
        CVT_TAIL(1152, CVT_R3_LO, CVT_R4_LO);
    } SEAM(3);
    if (IN(4)) _Pragma("unroll") for (int rep_ = 0; rep_ < 1 + (int)((DUP_MASK >> 4) & 1u); ++rep_) { if (rep_) GRID_BAR();
        pg8::Gemm g{A, W1B, MT, DM, DM}; pg8::StaticOrder S; S.init(MT, DM, G, bid);
        EpiConvGate E{U, Z, conv_w};
        pg8::gemm_phase<EpiConvGate, pg8::StaticOrder, true, true>(lds, g, S, E);
        CVT_TAIL(576, CVT_R4_LO, CVT_R5_LO);
    } SEAM(4);
    if (IN(5)) _Pragma("unroll") for (int rep_ = 0; rep_ < 1 + (int)((DUP_MASK >> 5) & 1u); ++rep_) { if (rep_) GRID_BAR();
        pg8::Gemm g{Z, W2, MT, DM, DM}; pg8::StaticOrder S; S.init(MT, DM, G, bid);
        EpiResid<true> E{x, ctx, H, mod + 2 * DM};
        pg8::gemm_phase<EpiResid<true>, pg8::StaticOrder, true, true>(lds, g, S, E);
        CVT_TAIL(576, CVT_R5_LO, CVT_X0_END);
    } SEAM(5);
    if (IN(6)) _Pragma("unroll") for (int rep_ = 0; rep_ < 1 + (int)((DUP_MASK >> 6) & 1u); ++rep_) { if (rep_) GRID_BAR();  load_router(router_w, (LAS float*)lds, tid); ph_modffn(H, nffn, mod, A, (const LAS float*)lds, affL, affC, MT, gw, NGW, lane); } SEAM(6);
    if (IN(7)) _Pragma("unroll") for (int rep_ = 0; rep_ < 1 + (int)((DUP_MASK >> 7) & 1u); ++rep_) { if (rep_) GRID_BAR();  ph_topk(256, affL, affC, rowsrc, gatev, inv, (LAS unsigned*)lds, tid, lane, wave, bid, G); } SEAM(7);
    if (IN(8)) _Pragma("unroll") for (int rep_ = 0; rep_ < 1 + (int)((DUP_MASK >> 8) & 1u); ++rep_) { if (rep_) GRID_BAR();
        pg8::Gemm g{A, WGU, YT, NE * 2048, DM, rowsrc}; MoeOrder S{G, bid, 9};
        EpiPair<1> E{HM, DFF, 8};
        pg8::gemm_phase<EpiPair<1>, MoeOrder, true, true, true>(lds, g, S, E);
        CVT_TAIL(1152, CVT_R9_LO, CVT_R10_LO);
    } SEAM(8);
    if (IN(9)) _Pragma("unroll") for (int rep_ = 0; rep_ < 1 + (int)((DUP_MASK >> 9) & 1u); ++rep_) { if (rep_) GRID_BAR();
        pg8::Gemm g{HM, WDN, YT, NE * 2048, DFF}; MoeOrder S{G, bid, 9};
        EpiDown E{Y, gatev};
        pg8::gemm_phase<EpiDown, MoeOrder, true, true>(lds, g, S, E);
        CVT_TAIL(1152, CVT_R10_LO, CVT_R12_LO);
    } SEAM(9);
    if (IN(10)) _Pragma("unroll") for (int rep_ = 0; rep_ < 1 + (int)((DUP_MASK >> 10) & 1u); ++rep_) { if (rep_) GRID_BAR();  ph_combine<false>(H, Y, inv, mod, nmix + DM, mod + 9 * NMOD, A, nullptr, MT, gw, NGW, lane); } SEAM(10);
    if (IN(11)) _Pragma("unroll") for (int rep_ = 0; rep_ < 1 + (int)((DUP_MASK >> 11) & 1u); ++rep_) { if (rep_) GRID_BAR();
        pg8::Gemm g{A, WQKV, MT, 3072, DM}; QkvOrder S{G, bid};
        EpiQkvNorm E{Qb, Kb, Vb, qgain, kgain, (LAS float*)(lds + RING_BYTES)};
        pg8::gemm_phase<EpiQkvNorm, QkvOrder, true, true>(lds, g, S, E);
        CVT_TAIL(800, CVT_R12_LO, CVT_TOTAL);
    } SEAM(11);
    if (IN(12)) _Pragma("unroll") for (int rep_ = 0; rep_ < 1 + (int)((DUP_MASK >> 12) & 1u); ++rep_) { if (rep_) GRID_BAR();  ph_attn(Qb, Kb, Vb, Ob, sink, lds, tid, lane, wave, bid, G); } SEAM(12);
    if (IN(13)) _Pragma("unroll") for (int rep_ = 0; rep_ < 1 + (int)((DUP_MASK >> 13) & 1u); ++rep_) { if (rep_) GRID_BAR();
        pg8::Gemm g{Ob, WOt, ML, DM, DM}; pg8::StaticOrder S; S.init(ML, DM, G, bid);
        EpiResid<false> E{nullptr, nullptr, H, mod + 9 * NMOD + 2 * DM};
        pg8::gemm_phase<EpiResid<false>, pg8::StaticOrder, true, true>(lds, g, S, E);
    } SEAM(13);
    if (IN(14)) _Pragma("unroll") for (int rep_ = 0; rep_ < 1 + (int)((DUP_MASK >> 14) & 1u); ++rep_) { if (rep_) GRID_BAR();  load_router(router_w + DM * 16, (LAS float*)lds, tid); ph_modffn(H, nffn + DM, mod + 9 * NMOD, A, (const LAS float*)lds, affL, affC, ML, gw, NGW, lane); } SEAM(14);
    if (IN(15)) _Pragma("unroll") for (int rep_ = 0; rep_ < 1 + (int)((DUP_MASK >> 15) & 1u); ++rep_) { if (rep_) GRID_BAR();  ph_topk(128, affL, affC, rowsrc, gatev, inv, (LAS unsigned*)lds, tid, lane, wave, bid, G); } SEAM(15);
    if (IN(16)) _Pragma("unroll") for (int rep_ = 0; rep_ < 1 + (int)((DUP_MASK >> 16) & 1u); ++rep_) { if (rep_) GRID_BAR();
        pg8::Gemm g{A, WGU + (size_t)NE * 2048 * DM, YT, NE * 2048, DM, rowsrc}; MoeOrder S{G, bid, 8};
        EpiPair<1> E{HM, DFF, 8};
        pg8::gemm_phase<EpiPair<1>, MoeOrder, true, true, true>(lds, g, S, E);
    } SEAM(16);
    if (IN(17)) _Pragma("unroll") for (int rep_ = 0; rep_ < 1 + (int)((DUP_MASK >> 17) & 1u); ++rep_) { if (rep_) GRID_BAR();
        pg8::Gemm g{HM, WDN + (size_t)NE * 2048 * DFF, YT, NE * 2048, DFF}; MoeOrder S{G, bid, 8};
        EpiDown E{Y, gatev};
        pg8::gemm_phase<EpiDown, MoeOrder, true, true>(lds, g, S, E);
    } SEAM(17);
    if (IN(18)) _Pragma("unroll") for (int rep_ = 0; rep_ < 1 + (int)((DUP_MASK >> 18) & 1u); ++rep_) { if (rep_) GRID_BAR();  ph_combine<true>(H, Y, inv, mod + 9 * NMOD, nullptr, nullptr, nullptr, args.out, ML, gw, NGW, lane); }
#undef IN
#undef SEAM
}

extern "C" void kernel_launch(void* const* d_in, const int* in_sizes, int n_in, void* d_out, int out_size, void* d_ws, size_t ws_size, hipStream_t stream) {
    static int grid = 0;
    if (grid == 0) {
        if (n_in != 20 || out_size != ML * DM || ws_size < WS_END) { fprintf(stderr, "kernel_launch: unexpected problem (n_in %d, out %d, ws %zu); nothing launched\n", n_in, out_size, ws_size); grid = -1; return; }
        int dev = 0, cus = 0, per_cu = 0;
        if (hipGetDevice(&dev) != hipSuccess || hipDeviceGetAttribute(&cus, hipDeviceAttributeMultiprocessorCount, dev) != hipSuccess) { grid = -1; return; }
        if (hipFuncSetAttribute((const void*)dit_fwd, hipFuncAttributeMaxDynamicSharedMemorySize, LDS_BYTES) != hipSuccess) { fprintf(stderr, "kernel_launch: hipFuncSetAttribute failed\n"); grid = -1; return; }
        if (hipOccupancyMaxActiveBlocksPerMultiprocessor(&per_cu, (const void*)dit_fwd, 512, LDS_BYTES) != hipSuccess || per_cu < 1) fprintf(stderr, "kernel_launch: occupancy query reports %d workgroups per CU\n", per_cu);
        (void)hipGetLastError();
        grid = cus;
    }
    if (grid < 0) return;
    (void)hipMemsetAsync((char*)d_ws + WS_CTL, 0, CTL_ZERO_BYTES, stream);
    Args a{};
    for (int i = 0; i < 20; ++i) a.in[i] = (const float*)d_in[i];
    a.out = (float*)d_out; a.ws = (unsigned char*)d_ws;
#if MK_ONE_LAUNCH
    a.ph_lo = 0; a.ph_hi = NPHASE;
    hipLaunchKernelGGL(dit_fwd, dim3(grid), dim3(512), LDS_BYTES, stream, a);
#else
    for (int p = 0; p < NPHASE; ++p) { a.ph_lo = p; a.ph_hi = p + 1; hipLaunchKernelGGL(dit_fwd, dim3(grid), dim3(512), LDS_BYTES, stream, a); }
#endif
}
```

```cpp
#include <hip/hip_runtime.h>
#include <cstdio>
#include <cstdint>
namespace pg8 {
#define PG8_LAS __attribute__((address_space(3)))
typedef unsigned short bf16_t;
typedef short bf16x8 __attribute__((ext_vector_type(8)));
typedef float f32x4 __attribute__((ext_vector_type(4)));
typedef unsigned u32x4 __attribute__((ext_vector_type(4)));
constexpr int BM = 256, BK = 64, HALF = 128, HTB = HALF * BK * 2  , STAGE_BYTES = 8 * HTB, NXCD = 8, WGM = 8;

__host__ __device__ __forceinline__ int lds_byte(int r, int c) { const int st = (r >> 4) * 2 + (c >> 5), rr = r & 15, cc = c & 31, ob = rr * 64 + cc * 2; return st * 1024 + (ob ^ (((ob >> 9) & 1) << 5)); }
__host__ __device__ __forceinline__ void stage_rc(int b, int& R, int& C) { const int st = b / 1024, sb = b % 1024, swz = sb ^ (((sb >> 9) & 1) << 5); R = (st >> 1) * 16 + swz / 64; C = (st & 1) * 32 + (swz % 64) / 2; }
__host__ __device__ __forceinline__ int perm32(int rho) { const int n = rho >> 4, i = rho & 15; return 8 * (i >> 2) + 4 * n + (i & 3); }

struct Unit { int pm, pn; };
struct Gemm { const bf16_t* A; const bf16_t* Bt; int M, N, K; const int* rows = nullptr; };

struct StaticOrder {
    int nM, nN, nwg, G, c;
    __host__ __device__ void init(int M, int N, int G_, int c_) { nM = M / BM; nN = N / BM; nwg = nM * nN; G = G_; c = c_; }
    __host__ __device__ bool next(int i, Unit& u) const {
        const long L = (long)i * G + c; if (L >= nwg) return false;
        int wgid = (int)L; { const int q = nwg / NXCD, r = nwg % NXCD, xcd = wgid % NXCD, off = wgid / NXCD; wgid = (xcd < r ? xcd * (q + 1) : r * (q + 1) + (xcd - r) * q) + off; }
        const int nig = WGM * nN, gid = wgid / nig, fm = gid * WGM, gsz = (nM - fm) < WGM ? (nM - fm) : WGM;
        u.pm = fm + ((wgid % nig) % gsz); u.pn = (wgid % nig) / gsz; return true;
    }
    __device__ __forceinline__ void a_ready(const Unit&) const {}
    __device__ __forceinline__ void done(const Unit&) const {}
};
__device__ __forceinline__ unsigned cvt_pk_bf16(float lo, float hi) { unsigned r; asm volatile("v_cvt_pk_bf16_f32 %0, %1, %2" : "=v"(r) : "v"(lo), "v"(hi)); return r; }
typedef float f32x2 __attribute__((ext_vector_type(2)));
template <class Epi, class Sched, bool ALIGN_EPI = false, bool SP2 = false, bool GATHER = false>
__device__ __forceinline__ void gemm_phase(PG8_LAS unsigned char* lds, const Gemm g, const Sched& S, const Epi& E) {
    const int tid = threadIdx.x, wid = __builtin_amdgcn_readfirstlane(tid >> 6), lane = tid & 63, wr = wid >> 2, wc = wid & 3, fr = lane & 15, fq = lane >> 4;
    const int K = g.K, nt = K / BK;
    unsigned voffA[2], voffB[2];
#pragma unroll
    for (int i = 0; i < 2; ++i) { int R, C; stage_rc(tid * 16 + i * 8192, R, C); const int Rb = Epi::PERM ? ((R & ~31) + perm32(R & 31)) : R;
        voffA[i] = (unsigned)(R * K + C) * 2u; voffB[i] = (unsigned)(Rb * K + C) * 2u; }
    const size_t kstep = (size_t)(BK * 2);
    const size_t hstep = (size_t)HALF * K * 2;
    const size_t tstep = 2 * hstep;
    const unsigned ldsw = (unsigned)wid * 1024u;
    const int aoff = lds_byte(wr * 64 + fr, fq * 8), boff = lds_byte(wc * 32 + fr, fq * 8);
#define PG8_SA(b, h) (((b) * 2 + (h)) * HTB)
#define PG8_SB(b, h) ((4 + (b) * 2 + (h)) * HTB)
#define PG8_STAGE(bufoff, gbase, voff) do { _Pragma("unroll") for (int _i = 0; _i < 2; ++_i) \
        __builtin_amdgcn_global_load_lds((const unsigned*)((const char*)(gbase) + (voff)[_i]), (PG8_LAS unsigned*)(lds + (bufoff) + ldsw + _i * 8192), 16, 0, 0); } while (0)
#define PG8_STAGE_A(bufoff, kptr, h) do { if constexpr (GATHER) { PG8_STAGE(bufoff, kptr, vA[h]); } else { PG8_STAGE(bufoff, (kptr) + (h) * hstep, voffA); } } while (0)
#define PG8_GATHER_SWITCH() do { if constexpr (GATHER) { if (last && has_next) { asm volatile("" : "+v"(nv[0]), "+v"(nv[1]), "+v"(nv[2]), "+v"(nv[3])); \
        vA[0][0] = nv[0] * (unsigned)(K * 2) + gcoff[0]; vA[0][1] = nv[1] * (unsigned)(K * 2) + gcoff[1]; vA[1][0] = nv[2] * (unsigned)(K * 2) + gcoff[0]; vA[1][1] = nv[3] * (unsigned)(K * 2) + gcoff[1]; } } } while (0)
#define PG8_LDA(dst, b, h) do { _Pragma("unroll") for (int m = 0; m < 4; ++m) _Pragma("unroll") for (int k = 0; k < 2; ++k) dst[m][k] = *(const PG8_LAS bf16x8*)(lds + PG8_SA(b, h) + aoff + m * 2048 + k * 1024); } while (0)
#define PG8_LDB(dst, b, h) do { _Pragma("unroll") for (int n = 0; n < 2; ++n) _Pragma("unroll") for (int k = 0; k < 2; ++k) dst[n][k] = *(const PG8_LAS bf16x8*)(lds + PG8_SB(b, h) + boff + n * 2048 + k * 1024); } while (0)
#define PG8_MMA(ai, bj, At, Bt) do { __builtin_amdgcn_s_setprio(1); _Pragma("unroll") for (int m = 0; m < 4; ++m) _Pragma("unroll") for (int n = 0; n < 2; ++n) _Pragma("unroll") for (int k = 0; k < 2; ++k) \
        acc[ai][bj][m][n] = __builtin_amdgcn_mfma_f32_16x16x32_bf16(Bt[n][k], At[m][k], acc[ai][bj][m][n], 0, 0, 0); __builtin_amdgcn_s_setprio(0); } while (0)
#define PG8_WAIT_V(n) asm volatile("s_waitcnt vmcnt(" #n ")" ::: "memory")
#define PG8_WAIT_L(n) asm volatile("s_waitcnt lgkmcnt(" #n ")" ::: "memory")
#define PG8_BAR __builtin_amdgcn_s_barrier()
#define PG8_SCHED __builtin_amdgcn_sched_barrier(0)
    Unit cur, nxt; int ui = 0;
    if (!S.next(0, cur)) return;
    f32x4 acc[2][2][4][2];
#pragma unroll
    for (int a = 0; a < 2; ++a)
#pragma unroll
        for (int b = 0; b < 2; ++b)
#pragma unroll
            for (int m = 0; m < 4; ++m)
#pragma unroll
                for (int n = 0; n < 2; ++n) acc[a][b][m][n] = (f32x4){0.f, 0.f, 0.f, 0.f};
    bf16x8 At[4][2], B0[2][2], B1[2][2];
    const char* cA = (const char*)g.A + (GATHER ? (size_t)0 : (size_t)cur.pm * tstep); const char* cB = (const char*)g.Bt + (size_t)cur.pn * tstep;
    unsigned vA[2][2], nv[4], gcoff[2]; int grow[2];
    if constexpr (GATHER) {
#pragma unroll
        for (int i = 0; i < 2; ++i) { int R, C; stage_rc(tid * 16 + i * 8192, R, C); grow[i] = R; gcoff[i] = (unsigned)(C * 2); }
#pragma unroll
        for (int h = 0; h < 2; ++h)
#pragma unroll
            for (int i = 0; i < 2; ++i) vA[h][i] = (unsigned)g.rows[cur.pm * BM + h * HALF + grow[i]] * (unsigned)(K * 2) + gcoff[i];
    }
    S.a_ready(cur);
    if constexpr (SP2) {
        PG8_STAGE(PG8_SB(0, 0), cB, voffB); PG8_STAGE(PG8_SB(0, 1), cB + hstep, voffB); PG8_STAGE_A(PG8_SA(0, 0), cA, 0); PG8_STAGE_A(PG8_SA(0, 1), cA, 1);
        if (wr == 1) PG8_BAR;
        PG8_WAIT_V(2); PG8_BAR;
        PG8_STAGE(PG8_SB(1, 0), cB + kstep, voffB); PG8_STAGE_A(PG8_SA(1, 0), cA + kstep, 0); PG8_STAGE(PG8_SB(1, 1), cB + hstep + kstep, voffB);
        PG8_WAIT_V(6); PG8_BAR;
    } else {
        PG8_STAGE(PG8_SB(0, 0), cB, voffB); PG8_STAGE_A(PG8_SA(0, 0), cA, 0); PG8_STAGE(PG8_SB(0, 1), cB + hstep, voffB); PG8_STAGE_A(PG8_SA(0, 1), cA, 1);
        if (wr == 1) PG8_BAR;
        PG8_WAIT_V(4); PG8_BAR;
        PG8_STAGE(PG8_SB(1, 0), cB + kstep, voffB); PG8_STAGE_A(PG8_SA(1, 0), cA + kstep, 0); PG8_STAGE(PG8_SB(1, 1), cB + hstep + kstep, voffB);
        PG8_WAIT_V(6); PG8_BAR;
    }
    for (;;) {
        const bool has_next = S.next(ui + 1, nxt);
        const char* nA = (has_next && !GATHER) ? (const char*)g.A + (size_t)nxt.pm * tstep : cA; const char* nB = has_next ? (const char*)g.Bt + (size_t)nxt.pn * tstep : cB;
        if constexpr (GATHER) { if (has_next) { const int* rp = g.rows + nxt.pm * BM;
            asm volatile("global_load_dword %0, %1, off" : "=&v"(nv[0]) : "v"(rp + grow[0]) : "memory"); asm volatile("global_load_dword %0, %1, off" : "=&v"(nv[1]) : "v"(rp + grow[1]) : "memory");
            asm volatile("global_load_dword %0, %1, off" : "=&v"(nv[2]) : "v"(rp + HALF + grow[0]) : "memory"); asm volatile("global_load_dword %0, %1, off" : "=&v"(nv[3]) : "v"(rp + HALF + grow[1]) : "memory"); } }
        for (int t = 0; t < nt; t += 2) {
            const bool last = (t == nt - 2);
            const char* a1 = cA + (size_t)(t + 1) * kstep;
            const char* a2 = last ? nA : cA + (size_t)(t + 2) * kstep; const char* b2 = last ? nB : cB + (size_t)(t + 2) * kstep;
            const char* a3 = a2 + kstep; const char* b3 = b2 + kstep;
            if (last && has_next) S.a_ready(nxt);
            if constexpr (SP2) {
            PG8_LDB(B0, 0, 0); PG8_LDB(B1, 0, 1); PG8_SCHED; PG8_LDA(At, 0, 0); PG8_STAGE_A(PG8_SA(1, 1), a1, 1); PG8_GATHER_SWITCH();
            PG8_WAIT_V(8); PG8_WAIT_L(0); PG8_BAR; PG8_MMA(0, 0, At, B0); PG8_MMA(0, 1, At, B1); PG8_BAR; PG8_SCHED;
            PG8_LDA(At, 0, 1); PG8_STAGE(PG8_SB(0, 0), b2, voffB); PG8_STAGE(PG8_SB(0, 1), b2 + hstep, voffB); PG8_STAGE_A(PG8_SA(0, 0), a2, 0);
            PG8_WAIT_V(8); PG8_WAIT_L(0); PG8_BAR; PG8_MMA(1, 0, At, B0); PG8_MMA(1, 1, At, B1); PG8_BAR; PG8_SCHED;
            PG8_LDB(B0, 1, 0); PG8_LDB(B1, 1, 1); PG8_SCHED; PG8_LDA(At, 1, 0); PG8_STAGE_A(PG8_SA(0, 1), a2, 1);
            PG8_WAIT_V(8); PG8_WAIT_L(0); PG8_BAR; PG8_MMA(0, 0, At, B0); PG8_MMA(0, 1, At, B1); PG8_BAR; PG8_SCHED;
            PG8_LDA(At, 1, 1); PG8_STAGE(PG8_SB(1, 0), b3, voffB); PG8_STAGE(PG8_SB(1, 1), b3 + hstep, voffB); PG8_STAGE_A(PG8_SA(1, 0), a3, 0);
            PG8_WAIT_V(8); PG8_WAIT_L(0); PG8_BAR; PG8_MMA(1, 0, At, B0); PG8_MMA(1, 1, At, B1); PG8_BAR; PG8_SCHED;
            } else {
            PG8_LDB(B0, 0, 0); PG8_SCHED; PG8_LDA(At, 0, 0); PG8_STAGE_A(PG8_SA(1, 1), a1, 1); PG8_GATHER_SWITCH();
            PG8_WAIT_L(8); PG8_BAR; PG8_WAIT_L(0); PG8_MMA(0, 0, At, B0); PG8_BAR; PG8_SCHED;
            PG8_LDB(B1, 0, 1); PG8_STAGE(PG8_SB(0, 0), b2, voffB);
            PG8_BAR; PG8_WAIT_L(0); PG8_MMA(0, 1, At, B1); PG8_BAR;
            PG8_LDA(At, 0, 1); PG8_STAGE_A(PG8_SA(0, 0), a2, 0);
            PG8_BAR; PG8_WAIT_L(0); PG8_MMA(1, 0, At, B0); PG8_BAR; PG8_SCHED;
            PG8_STAGE(PG8_SB(0, 1), b2 + hstep, voffB);
            PG8_WAIT_V(6); PG8_BAR; PG8_MMA(1, 1, At, B1); PG8_BAR;
            PG8_LDB(B0, 1, 0); PG8_SCHED; PG8_LDA(At, 1, 0); PG8_STAGE_A(PG8_SA(0, 1), a2, 1);
            PG8_WAIT_L(8); PG8_BAR; PG8_WAIT_L(0); PG8_MMA(0, 0, At, B0); PG8_BAR; PG8_SCHED;
            PG8_LDB(B1, 1, 1); PG8_STAGE(PG8_SB(1, 0), b3, voffB);
            PG8_BAR; PG8_WAIT_L(0); PG8_MMA(0, 1, At, B1); PG8_BAR;
            PG8_LDA(At, 1, 1); PG8_STAGE_A(PG8_SA(1, 0), a3, 0);
            PG8_BAR; PG8_WAIT_L(0); PG8_MMA(1, 0, At, B0); PG8_BAR; PG8_SCHED;
            PG8_STAGE(PG8_SB(1, 1), b3 + hstep, voffB);
            PG8_WAIT_V(6); PG8_BAR; PG8_MMA(1, 1, At, B1); PG8_BAR;
            }
        }
        if constexpr (ALIGN_EPI) { if (wr == 0) PG8_BAR; }
        if constexpr (!Epi::AFTER_DRAIN) { E(acc, cur, wr, wc, fr, fq); S.done(cur); }
        if (!has_next) break;
#pragma unroll
        for (int a = 0; a < 2; ++a)
#pragma unroll
            for (int b = 0; b < 2; ++b)
#pragma unroll
                for (int m = 0; m < 4; ++m)
#pragma unroll
                    for (int n = 0; n < 2; ++n) acc[a][b][m][n] = (f32x4){0.f, 0.f, 0.f, 0.f};
        cur = nxt; cA = nA; cB = nB; ++ui;
        if constexpr (ALIGN_EPI) { if (wr == 1) PG8_BAR; }
    }
    PG8_WAIT_V(0);
    if constexpr (!ALIGN_EPI) { if (wr == 0) PG8_BAR; }
    PG8_BAR;
    if constexpr (Epi::AFTER_DRAIN) { E.fused(acc, cur, wr, wc, fr, fq, lds, wid, lane); S.done(cur); }
#undef PG8_SA
#undef PG8_SB
#undef PG8_STAGE
#undef PG8_STAGE_A
#undef PG8_GATHER_SWITCH
#undef PG8_LDA
#undef PG8_LDB
#undef PG8_MMA
#undef PG8_WAIT_V
#undef PG8_WAIT_L
#undef PG8_BAR
#undef PG8_SCHED
}
}

constexpr int DM = 2048, NB = 8, SEQ = 2048, CTXL = 256, NH = 16, NKV = 4, HD = 128;
constexpr int ML = NB * SEQ;
constexpr int MC = NB * CTXL;
constexpr int MT = ML + MC;
constexpr int NE = 16, CAPL = 256, CAPC = 32, DFF = 1024;
constexpr int YR = NB * CAPL + NB * CAPC;
constexpr int YT = NE * YR;
constexpr int NMOD = 6 * DM;
constexpr float NORM_EPS = 1e-6f;
constexpr int KSPLIT = 16;

using pg8::Unit; using pg8::f32x4; using pg8::u32x4; using pg8::bf16_t; using pg8::bf16x8; using pg8::cvt_pk_bf16;
typedef float f32x2 __attribute__((ext_vector_type(2)));
typedef unsigned u32x2 __attribute__((ext_vector_type(2)));
typedef float f32x16 __attribute__((ext_vector_type(16)));
typedef short s16x4 __attribute__((ext_vector_type(4)));
#define DI __device__ __forceinline__

DI float bf_lo(unsigned w) { return __uint_as_float(w << 16); }
DI float bf_hi(unsigned w) { return __uint_as_float(w & 0xffff0000u); }
DI float silu_f(float a) { return a * __builtin_amdgcn_rcpf(1.0f + __expf(-a)); }

DI int xcd_remap(int wgid, int nwg) { const int q = nwg / 8, r = nwg % 8, xcd = wgid % 8, off = wgid / 8; return (xcd < r ? xcd * (q + 1) : r * (q + 1) + (xcd - r) * q) + off; }
struct QkvOrder {
    int G, c;
    DI bool next(int i, Unit& u) const {
        const int L = i * G + c; if (L >= 800) return false;
        if (L < 768) { const int w = xcd_remap(L, 768); const int nig = 8 * 12, gid = w / nig; u.pm = gid * 8 + ((w % nig) % 8); u.pn = (w % nig) / 8; }
        else { const int j = L - 768; u.pm = 64 + (j >> 2); u.pn = 8 + (j & 3); }
        return true;
    }
    DI void a_ready(const Unit&) const {}
    DI void done(const Unit&) const {}
};
struct MoeOrder {
    int G, c, NP;
    DI bool next(int i, Unit& u) const {
        const int nwg = NE * NP * 8; const int L = i * G + c; if (L >= nwg) return false;
        const int w = xcd_remap(L, nwg); const int per = NP * 8, e = w / per, rem = w % per;
        u.pm = e * 9 + (rem % NP); u.pn = e * 8 + (rem / NP); return true;
    }
    DI void a_ready(const Unit&) const {}
    DI void done(const Unit&) const {}
};

template <int ACT  > struct EpiPair {
    static constexpr bool PERM = true, AFTER_DRAIN = false;
    bf16_t* O; int ldc; int pn_mod;
    DI void operator()(const f32x4 (&acc)[2][2][4][2], const Unit& u, int wr, int wc, int fr, int fq) const {
        const int row0 = u.pm * 256 + wr * 64 + fr, col0 = (u.pn % pn_mod) * 128 + wc * 32 + 8 * fq;
#pragma unroll
        for (int ai = 0; ai < 2; ++ai)
#pragma unroll
            for (int m = 0; m < 4; ++m) {
                bf16_t* rowp = O + (size_t)(row0 + ai * 128 + m * 16) * ldc + col0;
                f32x4 a0 = acc[ai][0][m][0], a1 = acc[ai][0][m][1]; const f32x4 b0 = acc[ai][1][m][0], b1 = acc[ai][1][m][1];
                if (ACT == 1) {
#pragma unroll
                    for (int j = 0; j < 4; ++j) { a0[j] = silu_f(a0[j]); a1[j] = silu_f(a1[j]); } }
                const f32x4 v0 = a0 * b0, v1 = a1 * b1;
                u32x4 w; w.x = cvt_pk_bf16(v0[0], v0[1]); w.y = cvt_pk_bf16(v0[2], v0[3]); w.z = cvt_pk_bf16(v1[0], v1[1]); w.w = cvt_pk_bf16(v1[2], v1[3]);
                *(u32x4*)rowp = w;
            }
    }
};
struct EpiConvGate {
    static constexpr bool PERM = true, AFTER_DRAIN = false;
    const bf16_t* U; bf16_t* Z; const float* cw;
    DI void operator()(const f32x4 (&acc)[2][2][4][2], const Unit& u, int wr, int wc, int fr, int fq) const {
        const int row0 = u.pm * 256 + wr * 64 + fr, col0 = u.pn * 256 + wc * 32 + 8 * fq;
#pragma unroll
        for (int bj = 0; bj < 2; ++bj) {
            const int c = col0 + bj * 128;
            f32x4 w0a = *(const f32x4*)(cw + c), w0b = *(const f32x4*)(cw + c + 4), w1a = *(const f32x4*)(cw + 2048 + c), w1b = *(const f32x4*)(cw + 2048 + c + 4), w2a = *(const f32x4*)(cw + 4096 + c), w2b = *(const f32x4*)(cw + 4096 + c + 4);
#pragma unroll
            for (int ai = 0; ai < 2; ++ai)
#pragma unroll
                for (int m = 0; m < 4; ++m) {
                    const int row = row0 + ai * 128 + m * 16;
                    const int tpos = row < ML ? (row & (SEQ - 1)) : ((row - ML) & (CTXL - 1)); const int len = row < ML ? SEQ : CTXL;
                    const u32x4 z4 = (u32x4){0u, 0u, 0u, 0u};
                    const u32x4 uc = *(const u32x4*)(U + (size_t)row * DM + c);
                    const u32x4 up = tpos > 0 ? *(const u32x4*)(U + (size_t)(row - 1) * DM + c) : z4;
                    const u32x4 un = tpos < len - 1 ? *(const u32x4*)(U + (size_t)(row + 1) * DM + c) : z4;
                    f32x4 ya, yb;
                    ya[0] = w0a[0] * bf_lo(up.x) + w1a[0] * bf_lo(uc.x) + w2a[0] * bf_lo(un.x); ya[1] = w0a[1] * bf_hi(up.x) + w1a[1] * bf_hi(uc.x) + w2a[1] * bf_hi(un.x);
                    ya[2] = w0a[2] * bf_lo(up.y) + w1a[2] * bf_lo(uc.y) + w2a[2] * bf_lo(un.y); ya[3] = w0a[3] * bf_hi(up.y) + w1a[3] * bf_hi(uc.y) + w2a[3] * bf_hi(un.y);
                    yb[0] = w0b[0] * bf_lo(up.z) + w1b[0] * bf_lo(uc.z) + w2b[0] * bf_lo(un.z); yb[1] = w0b[1] * bf_hi(up.z) + w1b[1] * bf_hi(uc.z) + w2b[1] * bf_hi(un.z);
                    yb[2] = w0b[2] * bf_lo(up.w) + w1b[2] * bf_lo(uc.w) + w2b[2] * bf_lo(un.w); yb[3] = w0b[3] * bf_hi(up.w) + w1b[3] * bf_hi(uc.w) + w2b[3] * bf_hi(un.w);
                    const f32x4 v0 = acc[ai][bj][m][0] * ya, v1 = acc[ai][bj][m][1] * yb;
                    u32x4 w; w.x = cvt_pk_bf16(v0[0], v0[1]); w.y = cvt_pk_bf16(v0[2], v0[3]); w.z = cvt_pk_bf16(v1[0], v1[1]); w.w = cvt_pk_bf16(v1[2], v1[3]);
                    *(u32x4*)(Z + (size_t)row * DM + c) = w;
                }
        }
    }
};
template <bool BASE_F32> struct EpiResid {
    static constexpr bool PERM = true, AFTER_DRAIN = false;
    const float* base_lat; const float* base_ctx; bf16_t* out; const float* gate;
    DI void operator()(const f32x4 (&acc)[2][2][4][2], const Unit& u, int wr, int wc, int fr, int fq) const {
        const int rowt = u.pm * 256; const int cr = rowt < ML ? (rowt >> 11) : 8;
        const float* base = rowt < ML ? base_lat : base_ctx - (size_t)ML * DM;
        const int row0 = rowt + wr * 64 + fr, col0 = u.pn * 256 + wc * 32 + 8 * fq;
        f32x4 gv[2][2];
#pragma unroll
        for (int bj = 0; bj < 2; ++bj)
#pragma unroll
            for (int n = 0; n < 2; ++n) gv[bj][n] = *(const f32x4*)(gate + (size_t)cr * NMOD + col0 + bj * 128 + n * 4);
#pragma unroll
        for (int ai = 0; ai < 2; ++ai)
#pragma unroll
            for (int m = 0; m < 4; ++m) { const size_t off = (size_t)(row0 + ai * 128 + m * 16) * DM + col0;
#pragma unroll
                for (int bj = 0; bj < 2; ++bj) { f32x4 b0, b1;
                    if (BASE_F32) { b0 = *(const f32x4*)(base + off + bj * 128); b1 = *(const f32x4*)(base + off + bj * 128 + 4); }
                    else { const u32x4 hb = *(const u32x4*)(out + off + bj * 128); b0 = (f32x4){bf_lo(hb.x), bf_hi(hb.x), bf_lo(hb.y), bf_hi(hb.y)}; b1 = (f32x4){bf_lo(hb.z), bf_hi(hb.z), bf_lo(hb.w), bf_hi(hb.w)}; }
                    const f32x4 v0 = b0 + gv[bj][0] * acc[ai][bj][m][0], v1 = b1 + gv[bj][1] * acc[ai][bj][m][1];
                    u32x4 w; w.x = cvt_pk_bf16(v0[0], v0[1]); w.y = cvt_pk_bf16(v0[2], v0[3]); w.z = cvt_pk_bf16(v1[0], v1[1]); w.w = cvt_pk_bf16(v1[2], v1[3]);
                    *(u32x4*)(out + off + bj * 128) = w; }
                asm volatile("" ::: "memory"); }
    }
};
struct EpiDown {
    static constexpr bool PERM = true, AFTER_DRAIN = false;
    bf16_t* Y; const float* gatev;
    DI void operator()(const f32x4 (&acc)[2][2][4][2], const Unit& u, int wr, int wc, int fr, int fq) const {
        const int row0 = u.pm * 256 + wr * 64 + fr, col0 = (u.pn & 7) * 256 + wc * 32 + 8 * fq;
#pragma unroll
        for (int ai = 0; ai < 2; ++ai)
#pragma unroll
            for (int m = 0; m < 4; ++m) { const int row = row0 + ai * 128 + m * 16; const float gt = gatev[row];
#pragma unroll
                for (int bj = 0; bj < 2; ++bj) { const f32x4 v0 = acc[ai][bj][m][0] * gt, v1 = acc[ai][bj][m][1] * gt;
                    u32x4 w; w.x = cvt_pk_bf16(v0[0], v0[1]); w.y = cvt_pk_bf16(v0[2], v0[3]); w.z = cvt_pk_bf16(v1[0], v1[1]); w.w = cvt_pk_bf16(v1[2], v1[3]);
                    *(u32x4*)(Y + (size_t)row * DM + col0 + bj * 128) = w; } }
    }
};
struct EpiQkv {
    static constexpr bool PERM = true, AFTER_DRAIN = false;
    bf16_t* Q; bf16_t* K; bf16_t* V;
    DI void operator()(const f32x4 (&acc)[2][2][4][2], const Unit& u, int wr, int wc, int fr, int fq) const {
        const int row0 = u.pm * 256 + wr * 64 + fr; int colt = u.pn * 256; bf16_t* base; int ld;
        if (colt < 2048) { base = Q; ld = 2048; } else if (colt < 2560) { base = K; ld = 512; colt -= 2048; } else { base = V; ld = 512; colt -= 2560; }
        const int col0 = colt + wc * 32 + 8 * fq;
#pragma unroll
        for (int ai = 0; ai < 2; ++ai)
#pragma unroll
            for (int m = 0; m < 4; ++m) { bf16_t* rowp = base + (size_t)(row0 + ai * 128 + m * 16) * ld + col0;
#pragma unroll
                for (int bj = 0; bj < 2; ++bj) { const f32x4 v0 = acc[ai][bj][m][0], v1 = acc[ai][bj][m][1];
                    u32x4 w; w.x = cvt_pk_bf16(v0[0], v0[1]); w.y = cvt_pk_bf16(v0[2], v0[3]); w.z = cvt_pk_bf16(v1[0], v1[1]); w.w = cvt_pk_bf16(v1[2], v1[3]);
                    *(u32x4*)(rowp + bj * 128) = w; } }
    }
};

#define LAS3 __attribute__((address_space(3)))
struct EpiQkvNorm {
    static constexpr bool PERM = true, AFTER_DRAIN = false;
    bf16_t* Q; bf16_t* K; bf16_t* V; const float* qg; const float* kg; LAS3 float* P;
    DI void operator()(const f32x4 (&acc)[2][2][4][2], const Unit& u, int wr, int wc, int fr, int fq) const {
        const int row0 = u.pm * 256 + wr * 64 + fr; int colt = u.pn * 256;
        if (colt >= 2560) {
            const int col0 = colt - 2560 + wc * 32 + 8 * fq;
#pragma unroll
            for (int ai = 0; ai < 2; ++ai)
#pragma unroll
                for (int m = 0; m < 4; ++m) { bf16_t* rowp = V + (size_t)(row0 + ai * 128 + m * 16) * 512 + col0;
#pragma unroll
                    for (int bj = 0; bj < 2; ++bj) { const f32x4 v0 = acc[ai][bj][m][0], v1 = acc[ai][bj][m][1];
                        u32x4 w; w.x = cvt_pk_bf16(v0[0], v0[1]); w.y = cvt_pk_bf16(v0[2], v0[3]); w.z = cvt_pk_bf16(v1[0], v1[1]); w.w = cvt_pk_bf16(v1[2], v1[3]);
                        *(u32x4*)(rowp + bj * 128) = w; } }
            return;
        }
        const bool isq = colt < 2048; bf16_t* base = isq ? Q : K; const int ld = isq ? 2048 : 512; if (!isq) colt -= 2048;
        const int rl0 = wr * 64 + fr;
#pragma unroll
        for (int ai = 0; ai < 2; ++ai)
#pragma unroll
            for (int m = 0; m < 4; ++m)
#pragma unroll
                for (int bj = 0; bj < 2; ++bj) { const f32x4 a = acc[ai][bj][m][0], b = acc[ai][bj][m][1];
                    float s = (a[0] * a[0] + a[1] * a[1]) + (a[2] * a[2] + a[3] * a[3]) + (b[0] * b[0] + b[1] * b[1]) + (b[2] * b[2] + b[3] * b[3]);
                    s += __shfl_xor(s, 16); s += __shfl_xor(s, 32);
                    if (fq == 0) P[((ai * 128 + m * 16 + rl0) * 2 + bj) * 4 + wc] = s; }
        asm volatile("s_waitcnt lgkmcnt(0)" ::: "memory"); __builtin_amdgcn_s_barrier(); asm volatile("" ::: "memory");
        constexpr float QSCALE = 0.08838834764831845f * 1.4426950408889634f;
        const int i0 = 16 * (wc & 1) + 4 * fq, d0 = 64 * (wc >> 1) + i0;
        const float* gp = isq ? qg : kg; f32x4 g0 = *(const f32x4*)(gp + d0), g1 = *(const f32x4*)(gp + d0 + 32);
        if (isq) { g0 = g0 * QSCALE; g1 = g1 * QSCALE; }
        f32x4 ifr;
#pragma unroll
        for (int j = 0; j < 4; ++j) ifr[j] = exp2f(-(float)(i0 + j) * (13.287712379549449f / 32.0f));
        const bool lat = u.pm < 64;
#pragma unroll
        for (int ai = 0; ai < 2; ++ai)
#pragma unroll
            for (int m = 0; m < 4; ++m) { const int row = row0 + ai * 128 + m * 16; const int t = row & (SEQ - 1);
                const float pos = (float)((wc >> 1) == 0 ? (t >> 6) : (t & 63));
                f32x4 cs, sn;
#pragma unroll
                for (int j = 0; j < 4; ++j) { const float ang = pos * ifr[j]; cs[j] = lat ? __cosf(ang) : 1.0f; sn[j] = lat ? __sinf(ang) : 0.0f; }
#pragma unroll
                for (int bj = 0; bj < 2; ++bj) { const f32x4 pp = *(const LAS3 f32x4*)(P + ((ai * 128 + m * 16 + rl0) * 2 + bj) * 4);
                    const float rstd = 1.0f / sqrtf(((pp[0] + pp[1]) + (pp[2] + pp[3])) * (1.0f / HD) + NORM_EPS);
                    const f32x4 a = acc[ai][bj][m][0] * rstd * g0, b = acc[ai][bj][m][1] * rstd * g1;
                    const f32x4 o1 = a * cs - b * sn, o2 = b * cs + a * sn;
                    u32x4 w; w.x = cvt_pk_bf16(o1[0], o1[1]); w.y = cvt_pk_bf16(o1[2], o1[3]); w.z = cvt_pk_bf16(o2[0], o2[1]); w.w = cvt_pk_bf16(o2[2], o2[3]);
                    *(u32x4*)(base + (size_t)row * ld + colt + bj * 128 + wc * 32 + 8 * fq) = w; } }
    }
};

constexpr size_t MiB = 1u << 20;
constexpr size_t WS_CTL = 0, CTL_ZERO_BYTES = 1 * MiB;
constexpr size_t WS_MOD = 1 * MiB;
constexpr size_t WS_MODP = 2 * MiB;
constexpr size_t WS_AFFL = 16 * MiB;
constexpr size_t WS_AFFC = 17 * MiB;
constexpr size_t WS_ROWSRC = 17 * MiB + 512 * 1024;
constexpr size_t WS_GATEV = 18 * MiB;
constexpr size_t WS_INV = 18 * MiB + 512 * 1024;
constexpr size_t WS_W1A = 20 * MiB;
constexpr size_t WS_W1B = 36 * MiB;
constexpr size_t WS_W2 = 44 * MiB;
constexpr size_t WS_WQKV = 52 * MiB;
constexpr size_t WS_WO = 64 * MiB;
constexpr size_t WS_WGU = 72 * MiB;
constexpr size_t WS_WDN = 328 * MiB;
constexpr size_t WS_H = 456 * MiB;
constexpr size_t WS_A = 600 * MiB;
constexpr size_t WS_U = 672 * MiB;
constexpr size_t WS_Z = 744 * MiB;
constexpr size_t WS_Q = WS_U, WS_K = WS_Z, WS_V = WS_Z + 18 * MiB;
constexpr size_t WS_HM = 816 * MiB;
constexpr size_t WS_O = WS_HM;
constexpr size_t WS_Y = 888 * MiB;
constexpr size_t WS_XS = WS_Y;
constexpr size_t WS_END = 1032 * MiB;
constexpr int CW_BAR = 4096;

constexpr int RING_BYTES = 131072;
constexpr int MISC_OFF = RING_BYTES + 14336;
constexpr int LDS_BYTES = 147456;

#define GAS __attribute__((address_space(1)))
#define LAS __attribute__((address_space(3)))
#define LDS_WAIT() asm volatile("s_waitcnt lgkmcnt(0)" ::: "memory")
#define VM_WAIT() asm volatile("s_waitcnt vmcnt(0)" ::: "memory")
#define XB_TMO      128
#define XB_XCNT(j)  (256  + 64 * (j))
#define XB_XSUB(j)  (1280 + 64 * (j))
#define XB_XGEN(j)  (2304 + 64 * (j))
#define XB_TOP      3328
#define XB_TOPGEN   3392
#define XCD_BAR_WORDS 3456
#define XB_SPIN_CAP (1u << 18)

__device__ __forceinline__ unsigned xb_ld(unsigned* p)              { return __hip_atomic_load(p, __ATOMIC_RELAXED, __HIP_MEMORY_SCOPE_AGENT); }
__device__ __forceinline__ unsigned xb_add(unsigned* p, unsigned v) { return __hip_atomic_fetch_add(p, v, __ATOMIC_RELAXED, __HIP_MEMORY_SCOPE_AGENT); }
__device__ __forceinline__ unsigned xb_xcc_id() { return (unsigned)__builtin_amdgcn_s_getreg((3 << 11) | 20) & 0xFu; }
#define XB_SPIN(cond, bar) do { unsigned _sp = 0; while (cond) { __builtin_amdgcn_s_sleep(1); \
    if ((++_sp & 255u) == 0u) { if (xb_ld(&(bar)[XB_TMO])) break; if (_sp > XB_SPIN_CAP) { atomicAdd(&(bar)[XB_TMO], 1u); break; } } } } while (0)

struct XcdBarrier {
    unsigned* bar; unsigned x;
    volatile LAS unsigned* st;
};

__device__ __forceinline__ XcdBarrier xcd_barrier_post(unsigned* bar, volatile LAS unsigned* st) {
    XcdBarrier b; b.bar = bar; b.x = xb_xcc_id(); b.st = st;
    if (threadIdx.x == 0) (void)xb_add(&bar[XB_XCNT(b.x)], 1u);
    return b;
}
__device__ __forceinline__ void xcd_barrier_complete(unsigned* bar, unsigned x, unsigned& nloc, unsigned& nx) {
    const unsigned G = gridDim.x * gridDim.y * gridDim.z;
    unsigned sum, cnt, mine, sp = 0u;
    for (;;) {
        sum = 0u; cnt = 0u; mine = 0u;
#pragma unroll
        for (unsigned j = 0; j < 16; ++j) { const unsigned c = xb_ld(&bar[XB_XCNT(j)]); sum += c; cnt += (c > 0u) ? 1u : 0u; mine = (j == x) ? c : mine; }
        if (sum == G) break;
        __builtin_amdgcn_s_sleep(1);
        if ((++sp & 255u) == 0u) { if (xb_ld(&bar[XB_TMO])) break; if (sp > XB_SPIN_CAP) { atomicAdd(&bar[XB_TMO], 1u); break; } }
    }
    nloc = mine > 0u ? mine : 1u; nx = cnt > 0u ? cnt : 1u;
}

__device__ __forceinline__ void xcd_barrier(const XcdBarrier& b) {
    asm volatile("s_waitcnt vmcnt(0)" ::: "memory");
    __syncthreads();
    if (threadIdx.x == 0) {
        unsigned* bar = b.bar;
        __builtin_amdgcn_s_waitcnt(0);
        unsigned nloc = b.st[0], nx = b.st[1];
        if (nloc == 0u) { xcd_barrier_complete(bar, b.x, nloc, nx); b.st[0] = nloc; b.st[1] = nx; }
        const unsigned old = xb_add(&bar[XB_XSUB(b.x)], 1u);
        const unsigned gen = old / nloc;
        if (old + 1u == (gen + 1u) * nloc) {
            __builtin_amdgcn_fence(__ATOMIC_RELEASE, "agent");
            asm volatile("s_waitcnt vmcnt(0)" ::: "memory");
            const unsigned og = xb_add(&bar[XB_TOP], 1u);
            const unsigned tg = og / nx;
            if (og + 1u == (tg + 1u) * nx) xb_add(&bar[XB_TOPGEN], 1u);
            else XB_SPIN(xb_ld(&bar[XB_TOPGEN]) == tg, bar);
            __builtin_amdgcn_fence(__ATOMIC_ACQUIRE, "agent");
            xb_add(&bar[XB_XGEN(b.x)], 1u);
            asm volatile("s_waitcnt vmcnt(0)" ::: "memory");
        } else {
            XB_SPIN(xb_ld(&bar[XB_XGEN(b.x)]) == gen, bar);
            __builtin_amdgcn_fence(__ATOMIC_ACQUIRE, "agent");
            asm volatile("s_waitcnt vmcnt(0)" ::: "memory");
        }
    }
    __syncthreads();
}

DI float wave_sum(float v) {
#pragma unroll
    for (int o = 1; o < 64; o <<= 1) v += __shfl_xor(v, o);
    return v;
}
DI float rdlane(float v, int l) { return __uint_as_float((unsigned)__builtin_amdgcn_readlane((int)__float_as_uint(v), l)); }
DI unsigned pk2(float lo, float hi) { return cvt_pk_bf16(lo, hi); }

DI void ph_adaln(const float* cnd, const float* cctx, const float* ada_w, float* modp, int gw, int NGW, int lane) {
    for (int task = gw; task < 96 * KSPLIT; task += NGW) {
        const int ks = task & (KSPLIT - 1), cg = task / KSPLIT, l = cg / 48, cgl = cg % 48, col0 = cgl * 256 + lane * 4, k0 = ks * 128;
        float sv[9][2];
#pragma unroll
        for (int r = 0; r < 9; ++r)
#pragma unroll
            for (int hh = 0; hh < 2; ++hh) { const int k = k0 + hh * 64 + lane; const float v = r < 8 ? cnd[r * DM + k] : cctx[k]; sv[r][hh] = v / (1.0f + __expf(-v)); }
        f32x4 acc[9];
#pragma unroll
        for (int r = 0; r < 9; ++r) acc[r] = (f32x4){0.f, 0.f, 0.f, 0.f};
        const float* wp = ada_w + ((size_t)l * DM + k0) * NMOD + col0;
#pragma unroll
        for (int hh = 0; hh < 2; ++hh) {
#pragma unroll 8
            for (int kk = 0; kk < 64; ++kk) {
                const f32x4 w = *(const f32x4*)(wp + (size_t)(hh * 64 + kk) * NMOD);
#pragma unroll
                for (int r = 0; r < 9; ++r) { const float s = rdlane(sv[r][hh], kk); acc[r] += w * s; }
            }
        }
#pragma unroll
        for (int r = 0; r < 9; ++r) *(f32x4*)(modp + ((size_t)((ks * 2 + l) * 9 + r)) * NMOD + col0) = acc[r];
    }
}
struct CvtPtrs { const float *cin, *cout, *wqkv, *wo, *wg, *wu, *wd; bf16_t *W1A, *W1B, *W2, *WQKV, *WO, *WGU, *WDN; };
constexpr int CVT_E0 = 6656, CVT_L = 24576, CVT_TOTAL = CVT_E0 + 2 * CVT_L;
DI void cvt_resolve(const CvtPtrs& P, int it, const float*& src, int& ldw, bf16_t*& dst, int& ldd, bool& qperm) {
    int r = it; qperm = false;
    if (r < 3072) { const int kt = ((r >> 3) / 96) * 8 + (r & 7), nt = (r >> 3) % 96, n0 = nt * 64, part = n0 >> 11, j0 = n0 & 2047;
        src = P.cin + (size_t)(kt * 64) * 6144 + n0; ldw = 6144; ldd = DM;
        dst = (part == 0 ? P.W1B + (size_t)j0 * DM : P.W1A + (size_t)((j0 >> 7) * 256 + (part == 2 ? 128 : 0) + (j0 & 127)) * DM) + kt * 64; return; } r -= 3072;
    if (r < 1024) { const int kt = ((r >> 3) / 32) * 8 + (r & 7), nt = (r >> 3) % 32; src = P.cout + (size_t)(kt * 64) * DM + nt * 64; ldw = DM; dst = P.W2 + (size_t)(nt * 64) * DM + kt * 64; ldd = DM; return; } r -= 1024;
    if (r < 1536) { const int kt = ((r >> 3) / 48) * 8 + (r & 7), nt = (r >> 3) % 48; src = P.wqkv + (size_t)(kt * 64) * 3072 + nt * 64; ldw = 3072; qperm = nt < 40;     dst = P.WQKV + (size_t)(nt * 64) * DM + kt * 64; ldd = DM; return; } r -= 1536;
    if (r < 1024) { const int kt = ((r >> 3) / 32) * 8 + (r & 7), nt = (r >> 3) % 32; src = P.wo + (size_t)(kt * 64) * DM + nt * 64; ldw = DM; dst = P.WO + (size_t)(nt * 64) * DM + kt * 64; ldd = DM; return; } r -= 1024;
    const int l = r / CVT_L, rr = r % CVT_L, kind = rr / 8192, q = rr % 8192, le = l * 16 + q / 512, rem = q % 512;
    if (kind < 2) { const int kt = ((rem >> 3) / 16) * 8 + (rem & 7), nt = (rem >> 3) % 16, n0 = nt * 64;
        src = (kind ? P.wu : P.wg) + (size_t)le * DM * DFF + (size_t)(kt * 64) * DFF + n0; ldw = DFF;
        dst = P.WGU + (size_t)(le * 2048 + (n0 >> 7) * 256 + kind * 128 + (n0 & 127)) * DM + kt * 64; ldd = DM; }
    else { const int kt = ((rem >> 3) / 32) * 8 + (rem & 7), nt = (rem >> 3) % 32;
        src = P.wd + (size_t)le * DFF * DM + (size_t)(kt * 64) * DM + nt * 64; ldw = DM; dst = P.WDN + (size_t)(le * 2048 + nt * 64) * DFF + kt * 64; ldd = DFF; }
}
constexpr int CVT_P = 36;
DI void cvt_range(const CvtPtrs& P, int lo, int hi, int w, int NW, LAS unsigned* scr, int lane) {
    int it = lo + w; if (it >= hi) return;
    const int c = lane & 15, q = lane >> 4;
    const float* src; int ldw; bf16_t* dst; int ldd; bool qperm; cvt_resolve(P, it, src, ldw, dst, ldd, qperm);
    f32x4 v[16];
#pragma unroll
    for (int rr = 0; rr < 16; ++rr) v[rr] = __builtin_nontemporal_load((const f32x4*)(src + (size_t)(16 * q + rr) * ldw + 4 * c));
    for (;;) {
        u32x4 pa[4], pb[4];
#pragma unroll
        for (int i = 0; i < 4; ++i) { pa[i].x = pk2(v[0][i], v[1][i]); pa[i].y = pk2(v[2][i], v[3][i]); pa[i].z = pk2(v[4][i], v[5][i]); pa[i].w = pk2(v[6][i], v[7][i]);
                                      pb[i].x = pk2(v[8][i], v[9][i]); pb[i].y = pk2(v[10][i], v[11][i]); pb[i].z = pk2(v[12][i], v[13][i]); pb[i].w = pk2(v[14][i], v[15][i]); }
        const int nit = it + NW; bf16_t* cdst = dst; const int cldd = ldd; const int wrow = qperm ? 32 * ((c >> 2) & 1) + 8 * (c & 3) + 4 * (c >> 3) : 4 * c;
        if (nit < hi) { cvt_resolve(P, nit, src, ldw, dst, ldd, qperm);
#pragma unroll
            for (int rr = 0; rr < 16; ++rr) v[rr] = __builtin_nontemporal_load((const f32x4*)(src + (size_t)(16 * q + rr) * ldw + 4 * c)); }
#pragma unroll
        for (int i = 0; i < 4; ++i) { *(LAS u32x4*)(scr + (wrow + i) * CVT_P + 8 * q) = pa[i]; *(LAS u32x4*)(scr + (wrow + i) * CVT_P + 8 * q + 4) = pb[i]; }
        LDS_WAIT(); asm volatile("" ::: "memory");
#pragma unroll
        for (int j = 0; j < 8; ++j) { const int n = (lane >> 3) + 8 * j; const u32x4 o = *(const LAS u32x4*)(scr + n * CVT_P + 4 * (lane & 7));
            *(u32x4*)(cdst + (size_t)n * cldd + 8 * (lane & 7)) = o; }
        LDS_WAIT(); asm volatile("" ::: "memory");
        if (nit >= hi) break;
        it = nit;
    }
}
DI void ph_modred(const float* modp, const float* ada_b, float* mod, int gtid, int GT) {
    for (int i = gtid; i < 2 * 9 * NMOD; i += GT) { const int l = i / (9 * NMOD), j = i % NMOD; float s = ada_b[l * NMOD + j];
#pragma unroll
        for (int ks = 0; ks < KSPLIT; ++ks) s += modp[(size_t)ks * (2 * 9 * NMOD) + i];
        mod[i] = s; }
}
DI void row_load(const float* p, f32x4 (&v)[8], int lane) {
#pragma unroll
    for (int j = 0; j < 8; ++j) v[j] = *(const f32x4*)(p + 4 * lane + 256 * j);
}
DI void row_load_bf(const bf16_t* p, f32x4 (&v)[8], int lane) {
#pragma unroll
    for (int j = 0; j < 8; ++j) { const u32x2 w = *(const u32x2*)(p + 4 * lane + 256 * j); v[j] = (f32x4){bf_lo(w.x), bf_hi(w.x), bf_lo(w.y), bf_hi(w.y)}; }
}
DI void row_modulate(const f32x4 (&v)[8], f32x4 (&y)[8], const float* gain, const float* shift, const float* scale, int lane) {
    float ss = 0.f;
#pragma unroll
    for (int j = 0; j < 8; ++j) ss += (v[j][0] * v[j][0] + v[j][1] * v[j][1]) + (v[j][2] * v[j][2] + v[j][3] * v[j][3]);
    ss = wave_sum(ss);
    const float rstd = 1.0f / sqrtf(ss * (1.0f / DM) + NORM_EPS);
#pragma unroll
    for (int j = 0; j < 8; ++j) { const int c = 4 * lane + 256 * j; const f32x4 g = *(const f32x4*)(gain + c), sh = *(const f32x4*)(shift + c), sc = *(const f32x4*)(scale + c);
        y[j] = ((v[j] * rstd) * g) * (sc + 1.0f) + sh; }
}
DI void row_modulate2(const f32x4 (&v0)[8], const f32x4 (&v1)[8], f32x4 (&y0)[8], f32x4 (&y1)[8], const float* gain, const float* shift, const float* scale, int lane) {
    float s0 = 0.f, s1 = 0.f;
#pragma unroll
    for (int j = 0; j < 8; ++j) { s0 += (v0[j][0] * v0[j][0] + v0[j][1] * v0[j][1]) + (v0[j][2] * v0[j][2] + v0[j][3] * v0[j][3]); s1 += (v1[j][0] * v1[j][0] + v1[j][1] * v1[j][1]) + (v1[j][2] * v1[j][2] + v1[j][3] * v1[j][3]); }
    s0 = wave_sum(s0); s1 = wave_sum(s1);
    const float r0 = 1.0f / sqrtf(s0 * (1.0f / DM) + NORM_EPS), r1 = 1.0f / sqrtf(s1 * (1.0f / DM) + NORM_EPS);
#pragma unroll
    for (int j = 0; j < 8; ++j) { const int c = 4 * lane + 256 * j; const f32x4 g = *(const f32x4*)(gain + c), sh = *(const f32x4*)(shift + c), sc = *(const f32x4*)(scale + c);
        y0[j] = ((v0[j] * r0) * g) * (sc + 1.0f) + sh; y1[j] = ((v1[j] * r1) * g) * (sc + 1.0f) + sh; }
}
DI void row_store_bf16(bf16_t* p, const f32x4 (&y)[8], int lane) {
#pragma unroll
    for (int j = 0; j < 8; ++j) { u32x2 w; w.x = pk2(y[j][0], y[j][1]); w.y = pk2(y[j][2], y[j][3]); *(u32x2*)(p + 4 * lane + 256 * j) = w; }
}
DI void ph_mod0(const float* x, const float* ctx, const float* gain, const float* mod0, bf16_t* A, int gw, int NGW, int lane) {
    for (int row = gw; row < MT; row += NGW) {
        const int cr = row < ML ? (row >> 11) : 8; const float* src = row < ML ? x + (size_t)row * DM : ctx + (size_t)(row - ML) * DM;
        f32x4 v[8], y[8]; row_load(src, v, lane);
        row_modulate(v, y, gain, mod0 + (size_t)cr * NMOD + 0 * DM, mod0 + (size_t)cr * NMOD + 1 * DM, lane);
        row_store_bf16(A + (size_t)row * DM, y, lane);
    }
}
DI float reduce8(const float (&v)[8], int lane) {
    const bool u0 = lane & 1, u1 = lane & 2, u2 = lane & 4;
    float a[4], b2[2];
#pragma unroll
    for (int k = 0; k < 4; ++k) { const float lo = v[2 * k], hi = v[2 * k + 1]; a[k] = (u0 ? hi : lo) + __shfl_xor(u0 ? lo : hi, 1); }
#pragma unroll
    for (int k = 0; k < 2; ++k) { const float lo = a[2 * k], hi = a[2 * k + 1]; b2[k] = (u1 ? hi : lo) + __shfl_xor(u1 ? lo : hi, 2); }
    return (u2 ? b2[1] : b2[0]) + __shfl_xor(u2 ? b2[0] : b2[1], 4);
}
DI float reduce_halves(float lo8, float hi8, int lane) {
    const bool u3 = lane & 8;
    float t = (u3 ? hi8 : lo8) + __shfl_xor(u3 ? lo8 : hi8, 8);
    t += __shfl_xor(t, 16); t += __shfl_xor(t, 32); return t;
}
DI float softmax16(float lg) {
    float mx = lg;
#pragma unroll
    for (int o = 1; o < 16; o <<= 1) mx = fmaxf(mx, __shfl_xor(mx, o));
    const float ex = __expf(lg - mx); float den = ex;
#pragma unroll
    for (int o = 1; o < 16; o <<= 1) den += __shfl_xor(den, o);
    return ex / den;
}
DI void aff_store(float v, float* affL, float* affC, int row, int lane) {
    if (lane < 16) { if (row < ML) { const int b = row >> 11, n = row & 2047; affL[(size_t)(b * 16 + lane) * SEQ + n] = v; }
                     else { const int rc = row - ML, b = rc >> 8, n = rc & 255; affC[(size_t)(b * 16 + lane) * CTXL + n] = v; } }
}
DI void router_rows2(const f32x4 (&y0)[8], const f32x4 (&y1)[8], const LAS float* rwT, float* affL, float* affC, int row0, int lane) {
    float r0[2], r1[2];
#pragma unroll
    for (int hf = 0; hf < 2; ++hf) {
        float l0[8], l1[8];
#pragma unroll
        for (int e = 0; e < 8; ++e) { float s0 = 0.f, s1 = 0.f;
#pragma unroll
            for (int j = 0; j < 8; ++j) { const f32x4 w = *(const LAS f32x4*)(rwT + (8 * hf + e) * DM + 4 * lane + 256 * j);
                s0 += (y0[j][0] * w[0] + y0[j][1] * w[1]) + (y0[j][2] * w[2] + y0[j][3] * w[3]); s1 += (y1[j][0] * w[0] + y1[j][1] * w[1]) + (y1[j][2] * w[2] + y1[j][3] * w[3]); }
            l0[e] = s0; l1[e] = s1; __builtin_amdgcn_sched_barrier(0); }
        r0[hf] = reduce8(l0, lane); r1[hf] = reduce8(l1, lane);
    }
    const float a0 = softmax16(reduce_halves(r0[0], r0[1], lane)), a1 = softmax16(reduce_halves(r1[0], r1[1], lane));
    aff_store(a0, affL, affC, row0, lane); aff_store(a1, affL, affC, row0 + 1, lane);
}
DI void load_router(const float* rw, LAS float* rwT, int tid) {
    for (int i = tid; i < DM * 16; i += 512) rwT[(i & 15) * DM + (i >> 4)] = rw[i];
    __syncthreads();
}
DI void ph_modffn(const bf16_t* H, const float* gain, const float* modl, bf16_t* A, const LAS float* rwT, float* affL, float* affC, int nrows, int gw, int NGW, int lane) {
    for (int rp = gw; rp < nrows / 2; rp += NGW) {
        const int row = 2 * rp; const int cr = row < ML ? (row >> 11) : 8;
        u32x2 p0[8], p1[8];
#pragma unroll
        for (int j = 0; j < 8; ++j) { p0[j] = *(const u32x2*)(H + (size_t)row * DM + 4 * lane + 256 * j); p1[j] = *(const u32x2*)(H + (size_t)(row + 1) * DM + 4 * lane + 256 * j); }
        float s0 = 0.f, s1 = 0.f;
#pragma unroll
        for (int j = 0; j < 8; ++j) { const float a0 = bf_lo(p0[j].x), a1 = bf_hi(p0[j].x), a2 = bf_lo(p0[j].y), a3 = bf_hi(p0[j].y); s0 += (a0 * a0 + a1 * a1) + (a2 * a2 + a3 * a3);
                                      const float b0 = bf_lo(p1[j].x), b1 = bf_hi(p1[j].x), b2 = bf_lo(p1[j].y), b3 = bf_hi(p1[j].y); s1 += (b0 * b0 + b1 * b1) + (b2 * b2 + b3 * b3); }
        s0 = wave_sum(s0); s1 = wave_sum(s1);
        const float r0 = 1.0f / sqrtf(s0 * (1.0f / DM) + NORM_EPS), r1 = 1.0f / sqrtf(s1 * (1.0f / DM) + NORM_EPS);
        const float* shift = modl + (size_t)cr * NMOD + 3 * DM; const float* scale = modl + (size_t)cr * NMOD + 4 * DM;
        f32x4 y0[8], y1[8];
#pragma unroll
        for (int j = 0; j < 8; ++j) { const int c = 4 * lane + 256 * j; const f32x4 g = *(const f32x4*)(gain + c), sh = *(const f32x4*)(shift + c), sc = *(const f32x4*)(scale + c);
            const f32x4 v0 = (f32x4){bf_lo(p0[j].x), bf_hi(p0[j].x), bf_lo(p0[j].y), bf_hi(p0[j].y)}, v1 = (f32x4){bf_lo(p1[j].x), bf_hi(p1[j].x), bf_lo(p1[j].y), bf_hi(p1[j].y)};
            y0[j] = ((v0 * r0) * g) * (sc + 1.0f) + sh; y1[j] = ((v1 * r1) * g) * (sc + 1.0f) + sh;
            u32x2 w0, w1; w0.x = pk2(y0[j][0], y0[j][1]); w0.y = pk2(y0[j][2], y0[j][3]); w1.x = pk2(y1[j][0], y1[j][1]); w1.y = pk2(y1[j][2], y1[j][3]);
            *(u32x2*)(A + (size_t)row * DM + c) = w0; *(u32x2*)(A + (size_t)(row + 1) * DM + c) = w1; }
        asm volatile("" ::: "memory");
        router_rows2(y0, y1, rwT, affL, affC, row, lane);
    }
}
DI void ph_topk(int nitems, const float* affL, const float* affC, int* rowsrc, float* gatev, int* inv, LAS unsigned* hist, int tid, int lane, int wave, int bid, int G) {
    LAS unsigned* sh = hist + 256;
    for (int it = bid; it < nitems; it += G) {
        const bool isc = it >= 128; const int be = it & 127, b = be >> 4, e = be & 15;
        const int N = isc ? CTXL : SEQ, C = isc ? CAPC : CAPL;
        const float* src = isc ? affC + (size_t)be * CTXL : affL + (size_t)be * SEQ;
        const int i0 = tid * 4; const bool valid = i0 < N;
        unsigned key[4];
        { f32x4 v = (f32x4){0.f, 0.f, 0.f, 0.f}; if (valid) v = *(const f32x4*)(src + i0);
#pragma unroll
          for (int q = 0; q < 4; ++q) key[q] = __float_as_uint(v[q]); }
        unsigned prefix = 0u, mask = 0u, krem = (unsigned)C;
        for (int pass = 3; pass >= 0; --pass) {
            const int shift = pass * 8;
            if (tid < 256) hist[tid] = 0u;
            __syncthreads();
            if (valid) {
#pragma unroll
                for (int q = 0; q < 4; ++q) if ((key[q] & mask) == prefix) __hip_atomic_fetch_add(&hist[(key[q] >> shift) & 255u], 1u, __ATOMIC_RELAXED, __HIP_MEMORY_SCOPE_WORKGROUP); }
            __syncthreads();
            if (wave == 0) {
                const unsigned h0 = hist[4 * lane], h1 = hist[4 * lane + 1], h2 = hist[4 * lane + 2], h3 = hist[4 * lane + 3];
                const unsigned tot = h0 + h1 + h2 + h3; unsigned incl = tot;
#pragma unroll
                for (int o = 1; o < 64; o <<= 1) { const unsigned t = __shfl_down(incl, o); if (lane + o < 64) incl += t; }
                const unsigned a3 = incl - tot, a2 = a3 + h3, a1 = a2 + h2, a0 = a1 + h1;
                if (a3 < krem && krem <= a3 + h3) { sh[0] = 4 * lane + 3; sh[1] = krem - a3; }
                if (a2 < krem && krem <= a2 + h2) { sh[0] = 4 * lane + 2; sh[1] = krem - a2; }
                if (a1 < krem && krem <= a1 + h1) { sh[0] = 4 * lane + 1; sh[1] = krem - a1; }
                if (a0 < krem && krem <= a0 + h0) { sh[0] = 4 * lane + 0; sh[1] = krem - a0; }
            }
            __syncthreads();
            const unsigned B = sh[0]; krem = sh[1]; prefix |= B << shift; mask |= 0xFFu << shift;
        }
        const unsigned T = prefix;
        unsigned cg = 0u, ce = 0u;
        if (valid) {
#pragma unroll
            for (int q = 0; q < 4; ++q) { cg += key[q] > T ? 1u : 0u; ce += key[q] == T ? 1u : 0u; } }
        const unsigned mine = cg | (ce << 16); unsigned incl = mine;
#pragma unroll
        for (int o = 1; o < 64; o <<= 1) { const unsigned t = __shfl_up(incl, o); if (lane >= o) incl += t; }
        if (lane == 63) sh[8 + wave] = incl;
        __syncthreads();
        unsigned woff = 0u;
#pragma unroll
        for (int w = 0; w < 8; ++w) woff += (w < wave) ? sh[8 + w] : 0u;
        const unsigned excl = woff + incl - mine; unsigned gtb = excl & 0xFFFFu, eqb = excl >> 16;
        if (valid) {
            const int ybase = e * YR + (isc ? NB * CAPL + b * CAPC : b * CAPL); const int rbase = isc ? ML + b * CTXL : b * SEQ;
#pragma unroll
            for (int q = 0; q < 4; ++q) {
                const bool isg = key[q] > T, ise = key[q] == T; const bool sel = isg || (ise && eqb < krem);
                const unsigned slot = gtb + (eqb < krem ? eqb : krem);
                const int trow = rbase + i0 + q; const int yrow = ybase + (int)slot;
                if (sel) { rowsrc[yrow] = trow; gatev[yrow] = __uint_as_float(key[q]); }
                inv[(size_t)trow * 16 + e] = sel ? yrow : -1;
                gtb += isg ? 1u : 0u; eqb += ise ? 1u : 0u;
            }
        }
        __syncthreads();
    }
}
DI void ph_gather(const bf16_t* A, const int* rowsrc, bf16_t* XS, bool with_ctx, int gw, int NGW, int lane) {
    for (int yr = gw; yr < YT; yr += NGW) {
        if (!with_ctx && (yr % YR) >= NB * CAPL) continue;
        const int src = rowsrc[yr];
        const u32x4* s = (const u32x4*)(A + (size_t)src * DM); u32x4* d = (u32x4*)(XS + (size_t)yr * DM);
#pragma unroll
        for (int j = 0; j < 4; ++j) d[lane + 64 * j] = s[lane + 64 * j];
    }
}
template <bool LAST> DI void ph_combine(bf16_t* H, const bf16_t* Y, const int* inv, const float* modl  , const float* gain1, const float* mod1, bf16_t* A, float* out, int nrows, int gw, int NGW, int lane) {
    for (int row = gw; row < nrows; row += NGW) {
        const int cr = row < ML ? (row >> 11) : 8;
        f32x4 v[8], acc[8]; row_load_bf(H + (size_t)row * DM, v, lane);
#pragma unroll
        for (int j = 0; j < 8; ++j) acc[j] = (f32x4){0.f, 0.f, 0.f, 0.f};
        const int myinv = inv[(size_t)row * 16 + (lane & 15)];
        for (int e = 0; e < 16; ++e) {
            const int yr = __builtin_amdgcn_readlane(myinv, e);
            if (yr >= 0) { const bf16_t* yp = Y + (size_t)yr * DM + 4 * lane;
#pragma unroll
                for (int j = 0; j < 8; ++j) { const u32x2 p = *(const u32x2*)(yp + 256 * j); acc[j][0] += bf_lo(p.x); acc[j][1] += bf_hi(p.x); acc[j][2] += bf_lo(p.y); acc[j][3] += bf_hi(p.y); } }
        }
        const float* g2 = modl + (size_t)cr * NMOD + 5 * DM;
#pragma unroll
        for (int j = 0; j < 8; ++j) { const f32x4 g = *(const f32x4*)(g2 + 4 * lane + 256 * j); v[j] = v[j] + g * acc[j]; }
        if (LAST) {
#pragma unroll
            for (int j = 0; j < 8; ++j) *(f32x4*)(out + (size_t)row * DM + 4 * lane + 256 * j) = v[j];
        } else {
            row_store_bf16(H + (size_t)row * DM, v, lane);
            f32x4 y[8]; row_modulate(v, y, gain1, mod1 + (size_t)cr * NMOD + 0 * DM, mod1 + (size_t)cr * NMOD + 1 * DM, lane);
            row_store_bf16(A + (size_t)row * DM, y, lane);
        }
    }
}
DI void ph_qknorm(bf16_t* Q, bf16_t* K, const float* qg, const float* kg, int gw, int NGW, int lane) {
    const int half = lane >> 5, i = lane & 31, d1 = half * 64 + i, d2 = d1 + 32;
    const float inv_freq = exp2f(-(float)i * (13.287712379549449f / 32.0f));
    constexpr float QSCALE = 0.08838834764831845f * 1.4426950408889634f;
    const float qg1 = qg[d1] * QSCALE, qg2 = qg[d2] * QSCALE, kg1 = kg[d1], kg2 = kg[d2];
    for (int row = gw; row < MT; row += NGW) {
        const bool lat = row < ML; const int t = row & (SEQ - 1);
        const float pos = (float)(half == 0 ? (t >> 6) : (t & 63)); const float ang = pos * inv_freq;
        const float cs = lat ? __cosf(ang) : 1.0f, sn = lat ? __sinf(ang) : 0.0f;
        if (lat) {
            for (int hd = 0; hd < NH; ++hd) { bf16_t* p = Q + (size_t)row * DM + hd * HD;
                float x1 = __uint_as_float((unsigned)p[d1] << 16), x2 = __uint_as_float((unsigned)p[d2] << 16);
                const float ss = wave_sum(x1 * x1 + x2 * x2); const float rstd = 1.0f / sqrtf(ss * (1.0f / HD) + NORM_EPS);
                x1 = x1 * rstd * qg1; x2 = x2 * rstd * qg2;
                const float o1 = x1 * cs - x2 * sn, o2 = x2 * cs + x1 * sn;
                const unsigned w = pk2(o1, o2); p[d1] = (bf16_t)(w & 0xffffu); p[d2] = (bf16_t)(w >> 16); }
        }
        for (int kh = 0; kh < NKV; ++kh) { bf16_t* p = K + (size_t)row * 512 + kh * HD;
            float x1 = __uint_as_float((unsigned)p[d1] << 16), x2 = __uint_as_float((unsigned)p[d2] << 16);
            const float ss = wave_sum(x1 * x1 + x2 * x2); const float rstd = 1.0f / sqrtf(ss * (1.0f / HD) + NORM_EPS);
            x1 = x1 * rstd * kg1; x2 = x2 * rstd * kg2;
            const float o1 = x1 * cs - x2 * sn, o2 = x2 * cs + x1 * sn;
            const unsigned w = pk2(o1, o2); p[d1] = (bf16_t)(w & 0xffffu); p[d2] = (bf16_t)(w >> 16); }
    }
}
constexpr int KP = 272;
constexpr int ATT_VOFF = 64 * KP;
constexpr int ATT_TILE = 2 * 64 * KP;
DI int crow(int reg, int h) { return (reg & 3) + 8 * (reg >> 2) + 4 * h; }
DI long long vtr64(const LAS unsigned char* p) { typedef short v4i16_t __attribute__((ext_vector_type(4))); return __builtin_bit_cast(long long, __builtin_amdgcn_ds_read_tr16_b64_v4i16((LAS v4i16_t*)p)); }
DI s16x4 vtr(const LAS unsigned char* p) { typedef short v4i16_t __attribute__((ext_vector_type(4))); return __builtin_bit_cast(s16x4, __builtin_amdgcn_ds_read_tr16_b64_v4i16((LAS v4i16_t*)p)); }
DI bool att_tile_info(int item, int ti, int& base, int& mtype) {
    const int qhalf = item & 1, n = (item >> 3) & 15, b = item >> 7, tt = ti & 1; mtype = 0;
    if (ti < 4) { base = ML + b * CTXL + 64 * ti; return true; }
    const int blk = n - 1 + ((ti - 4) >> 1); if (blk < 0 || blk > 15) return false;
    if (ti < 6) { mtype = 1; if (tt == 0 && qhalf == 1) return false; } else if (ti >= 8) { mtype = 2; if (tt == 1 && qhalf == 0) return false; }
    base = b * SEQ + blk * 128 + 64 * tt; return true;
}
DI void att_next(int& item, int& ti, int G) { for (;;) { ++ti; if (ti >= 10) { ti = 0; item += G; return; } int b_, m_; if (att_tile_info(item, ti, b_, m_)) return; } }
DI void ph_attn(const bf16_t* Q, const bf16_t* Kb, const bf16_t* Vb, bf16_t* O, const float* sink, LAS unsigned char* lds, int tid, int lane, int wave, int bid, int G) {
    constexpr float LOG2E = 1.4426950408889634f;
    const int r = lane & 31, h = lane >> 5, g = wave >> 1, sub = wave & 1;
    const int ldrow = tid >> 3, ldc = tid & 7;
    int item = bid, ti = 0; if (item >= 1024) return;
    u32x4 kr[2], vr[2];
#define ATT_ISSUE(it_, ti_) do { int base_, mt_; att_tile_info(it_, ti_, base_, mt_); const int kvh_ = ((it_) >> 1) & 3; \
        _Pragma("unroll") for (int c2 = 0; c2 < 2; ++c2) { const size_t off_ = (size_t)(base_ + ldrow) * 512 + kvh_ * HD + (ldc + 8 * c2) * 8; kr[c2] = *(const u32x4*)(Kb + off_); vr[c2] = *(const u32x4*)(Vb + off_); } } while (0)
    bf16x8 qf[8]; float m2 = 0.f, lsum = 1.f; f32x16 o[4]; f32x16 negm;
#define ATT_QLOAD(it_) do { const int qrow_ = ((it_) >> 7) * SEQ + (((it_) >> 3) & 15) * 128 + ((it_) & 1) * 64 + sub * 32 + r; const int head_ = (((it_) >> 1) & 3) * 4 + g; \
        _Pragma("unroll") for (int s = 0; s < 8; ++s) qf[s] = *(const bf16x8*)(Q + (size_t)qrow_ * DM + head_ * HD + 16 * s + 8 * h); } while (0)
    ATT_QLOAD(item);
    ATT_ISSUE(item, ti);
    int buf = 0;
    while (item < 1024) {
        int nitem = item, nti = ti; att_next(nitem, nti, G);
        LAS unsigned char* tb = lds + buf * ATT_TILE;
#pragma unroll
        for (int c2 = 0; c2 < 2; ++c2) { *(LAS u32x4*)(tb + ldrow * KP + (ldc + 8 * c2) * 16) = kr[c2]; *(LAS u32x4*)(tb + ATT_VOFF + ldrow * KP + (ldc + 8 * c2) * 16) = vr[c2]; }
        if (nitem < 1024) ATT_ISSUE(nitem, nti);
        asm volatile("s_waitcnt lgkmcnt(0)" ::: "memory"); __builtin_amdgcn_s_barrier(); asm volatile("" ::: "memory");
        int base, mtype; att_tile_info(item, ti, base, mtype); const int tt = ti & 1;
        const int qhalf = item & 1, kvh = (item >> 1) & 3, n = (item >> 3) & 15, b = item >> 7;
        const int head = kvh * 4 + g, qq = qhalf * 64 + sub * 32 + r; const int qrow = b * SEQ + n * 128 + qq;
        if (ti == 0) {
            m2 = sink[head] * LOG2E; lsum = 1.0f;
#pragma unroll
            for (int i = 0; i < 16; ++i) negm[i] = -m2;
#pragma unroll
            for (int d = 0; d < 4; ++d)
#pragma unroll
                for (int i = 0; i < 16; ++i) o[d][i] = 0.f;
        }
        f32x16 x0, x1;
#pragma unroll
        for (int s = 0; s < 8; ++s) {
            const bf16x8 k0 = *(const LAS bf16x8*)(tb + r * KP + (16 * s + 8 * h) * 2), k1 = *(const LAS bf16x8*)(tb + (32 + r) * KP + (16 * s + 8 * h) * 2);
            if (s == 0) { x0 = __builtin_amdgcn_mfma_f32_32x32x16_bf16(k0, qf[s], negm, 0, 0, 0); x1 = __builtin_amdgcn_mfma_f32_32x32x16_bf16(k1, qf[s], negm, 0, 0, 0); }
            else { x0 = __builtin_amdgcn_mfma_f32_32x32x16_bf16(k0, qf[s], x0, 0, 0, 0); x1 = __builtin_amdgcn_mfma_f32_32x32x16_bf16(k1, qf[s], x1, 0, 0, 0); } }
        if (nitem != item && nitem < 1024) ATT_QLOAD(nitem);
        if (mtype == 1) {
#pragma unroll
            for (int i = 0; i < 16; ++i) { const int kk0 = tt * 64 + crow(i, h); if (kk0 < qq) x0[i] = -1.0e30f; if (kk0 + 32 < qq) x1[i] = -1.0e30f; } }
        if (mtype == 2) {
#pragma unroll
            for (int i = 0; i < 16; ++i) { const int kk0 = tt * 64 + crow(i, h); if (kk0 > qq) x0[i] = -1.0e30f; if (kk0 + 32 > qq) x1[i] = -1.0e30f; } }
        float tmax = fmaxf(x0[0], x1[0]);
#pragma unroll
        for (int i = 1; i < 16; ++i) tmax = fmaxf(fmaxf(tmax, x0[i]), x1[i]);
        tmax = fmaxf(tmax, __shfl_xor(tmax, 32));
        if (__any(tmax > 0.0f)) {
            const float dl = fmaxf(tmax, 0.0f), alpha = __builtin_amdgcn_exp2f(-dl); m2 += dl; lsum *= alpha;
#pragma unroll
            for (int i = 0; i < 16; ++i) { x0[i] -= dl; x1[i] -= dl; negm[i] = -m2; }
#pragma unroll
            for (int d = 0; d < 4; ++d)
#pragma unroll
                for (int i = 0; i < 16; ++i) o[d][i] *= alpha;
        }
        float ps = 0.f;
#pragma unroll
        for (int i = 0; i < 16; ++i) { x0[i] = __builtin_amdgcn_exp2f(x0[i]); x1[i] = __builtin_amdgcn_exp2f(x1[i]); ps += x0[i] + x1[i]; }
        ps += __shfl_xor(ps, 32); lsum += ps;
        bf16x8 pf[2][2];
#pragma unroll
        for (int s = 0; s < 2; ++s) {
            u32x4 a, c; a.x = pk2(x0[8 * s + 0], x0[8 * s + 1]); a.y = pk2(x0[8 * s + 2], x0[8 * s + 3]); a.z = pk2(x0[8 * s + 4], x0[8 * s + 5]); a.w = pk2(x0[8 * s + 6], x0[8 * s + 7]);
            c.x = pk2(x1[8 * s + 0], x1[8 * s + 1]); c.y = pk2(x1[8 * s + 2], x1[8 * s + 3]); c.z = pk2(x1[8 * s + 4], x1[8 * s + 5]); c.w = pk2(x1[8 * s + 6], x1[8 * s + 7]);
            pf[0][s] = __builtin_bit_cast(bf16x8, a); pf[1][s] = __builtin_bit_cast(bf16x8, c); }
        const LAS unsigned char* vb = tb + ATT_VOFF + (4 * h + ((lane & 15) >> 2)) * KP + (16 * ((lane >> 4) & 1) + 4 * (lane & 3)) * 2;
#pragma unroll
        for (int d = 0; d < 4; ++d)
#pragma unroll
            for (int t = 0; t < 2; ++t)
#pragma unroll
                for (int s = 0; s < 2; ++s) {
                    typedef long long i64x2_t __attribute__((ext_vector_type(2)));
                    i64x2_t vv; vv.x = vtr64(vb + (t * 32 + 16 * s) * KP + d * 64); vv.y = vtr64(vb + (t * 32 + 16 * s + 8) * KP + d * 64);
                    const bf16x8 vf = __builtin_bit_cast(bf16x8, vv);
                    o[d] = __builtin_amdgcn_mfma_f32_32x32x16_bf16(vf, pf[t][s], o[d], 0, 0, 0); }
        if (nitem != item) {
            const float il = 1.0f / lsum;
            bf16_t* op = O + (size_t)qrow * DM + head * HD + 4 * h;
#pragma unroll
            for (int d = 0; d < 4; ++d)
#pragma unroll
                for (int g4 = 0; g4 < 4; ++g4) { u32x2 w; w.x = pk2(o[d][4 * g4 + 0] * il, o[d][4 * g4 + 1] * il); w.y = pk2(o[d][4 * g4 + 2] * il, o[d][4 * g4 + 3] * il);
                    *(u32x2*)(op + d * 32 + 8 * g4) = w; }
        }
        item = nitem; ti = nti; buf ^= 1;
    }
#undef ATT_ISSUE
#undef ATT_QLOAD
}

#ifndef MK_ONE_LAUNCH
#define MK_ONE_LAUNCH 1
#endif
constexpr int NPHASE = 19;
#ifndef MK_CVT_Q
#define MK_CVT_Q 0
#endif
constexpr int CVT_Q = MK_CVT_Q;
constexpr int CVT_X0_END = CVT_E0 + CVT_L;
constexpr int CVT_R3_LO = CVT_X0_END - 3 * CVT_Q, CVT_R4_LO = CVT_X0_END - 2 * CVT_Q, CVT_R5_LO = CVT_X0_END - CVT_Q;
constexpr int CVT_R9_LO = CVT_TOTAL - 5 * CVT_Q / 2, CVT_R10_LO = CVT_TOTAL - 3 * CVT_Q / 2, CVT_R12_LO = CVT_TOTAL - CVT_Q;
static_assert(CVT_Q <= 8192 && CVT_Q % 2 == 0, "tail quota");
#define CVT_MKCP() CvtPtrs CP; CP.cin = args.in[8]; CP.cout = args.in[10]; CP.wqkv = args.in[11]; CP.wo = args.in[15]; CP.wg = args.in[17]; CP.wu = args.in[18]; CP.wd = args.in[19]; \
    CP.W1A = W1A; CP.W1B = W1B; CP.W2 = W2; CP.WQKV = WQKV; CP.WO = WOt; CP.WGU = WGU; CP.WDN = WDN
#define CVT_TAIL(NWG, LO, HI) do { if ((LO) < (HI)) { CVT_MKCP(); const int busy_ = (NWG) % G; if (busy_ == 0) cvt_range(CP, LO, HI, gw, NGW, cscr, lane); else if (bid >= busy_) cvt_range(CP, LO, HI, (bid - busy_) * 8 + wave, (G - busy_) * 8, cscr, lane); } } while (0)
#ifndef MK_DUP_MASK
#define MK_DUP_MASK 0u
#endif
constexpr unsigned DUP_MASK = MK_DUP_MASK;
struct Args { const float* in[20]; float* out; unsigned char* ws; int ph_lo, ph_hi; };
__global__ void __launch_bounds__(512, 2) dit_fwd(Args args) {
    extern __shared__ __attribute__((aligned(16))) unsigned char lds_raw[];
    LAS unsigned char* lds = (LAS unsigned char*)lds_raw;
    const int tid = threadIdx.x, lane = tid & 63, wave = __builtin_amdgcn_readfirstlane(tid >> 6);
    const int G = gridDim.x, bid = blockIdx.x;
    const int gw = bid * 8 + wave, NGW = G * 8;
    unsigned char* ws = args.ws;
    const float* x = args.in[0]; const float* cnd = args.in[1]; const float* ctx = args.in[2]; const float* cctx = args.in[3];
    const float* ada_w = args.in[4]; const float* ada_b = args.in[5]; const float* nmix = args.in[6]; const float* nffn = args.in[7];
    const float* conv_w = args.in[9]; const float* qgain = args.in[12]; const float* kgain = args.in[13]; const float* sink = args.in[14]; const float* router_w = args.in[16];
    float* mod = (float*)(ws + WS_MOD); float* modp = (float*)(ws + WS_MODP);
    float* affL = (float*)(ws + WS_AFFL); float* affC = (float*)(ws + WS_AFFC);
    int* rowsrc = (int*)(ws + WS_ROWSRC); float* gatev = (float*)(ws + WS_GATEV); int* inv = (int*)(ws + WS_INV);
    bf16_t* W1A = (bf16_t*)(ws + WS_W1A); bf16_t* W1B = (bf16_t*)(ws + WS_W1B); bf16_t* W2 = (bf16_t*)(ws + WS_W2); bf16_t* WQKV = (bf16_t*)(ws + WS_WQKV); bf16_t* WOt = (bf16_t*)(ws + WS_WO);
    bf16_t* WGU = (bf16_t*)(ws + WS_WGU); bf16_t* WDN = (bf16_t*)(ws + WS_WDN);
    bf16_t* H = (bf16_t*)(ws + WS_H); bf16_t* A = (bf16_t*)(ws + WS_A); bf16_t* U = (bf16_t*)(ws + WS_U); bf16_t* Z = (bf16_t*)(ws + WS_Z);
    bf16_t* Qb = (bf16_t*)(ws + WS_Q); bf16_t* Kb = (bf16_t*)(ws + WS_K); bf16_t* Vb = (bf16_t*)(ws + WS_V); bf16_t* Ob = (bf16_t*)(ws + WS_O);
    bf16_t* HM = (bf16_t*)(ws + WS_HM); bf16_t* Y = (bf16_t*)(ws + WS_Y); bf16_t* XS = (bf16_t*)(ws + WS_XS);
    LAS unsigned* cscr = (LAS unsigned*)(lds + wave * 9216);

    for (int u = tid; u < (LDS_BYTES - MISC_OFF) / 4; u += 512) ((LAS unsigned*)(lds + MISC_OFF))[u] = 0u;
    __syncthreads();
#if MK_ONE_LAUNCH
    XcdBarrier bar = xcd_barrier_post((unsigned*)(ws + WS_CTL) + CW_BAR, (volatile LAS unsigned*)(lds + MISC_OFF) + 8);
#define GRID_BAR() xcd_barrier(bar)
#else
#define GRID_BAR() do {} while (0)
#endif
    const int lo = args.ph_lo, hi = args.ph_hi;
#define IN(k) (lo <= (k) && (k) < hi)
#define SEAM(k) do { if (IN(k) && IN((k) + 1)) GRID_BAR(); } while (0)

    if (IN(0)) _Pragma("unroll") for (int rep_ = 0; rep_ < 1 + (int)((DUP_MASK >> 0) & 1u); ++rep_) { if (rep_) GRID_BAR();
        ph_adaln(cnd, cctx, ada_w, modp, gw, NGW, lane);
        CVT_MKCP();
        cvt_range(CP, 0, CVT_R3_LO, gw, NGW, cscr, lane); cvt_range(CP, CVT_X0_END, CVT_R9_LO, gw, NGW, cscr, lane);
    } SEAM(0);
    if (IN(1)) _Pragma("unroll") for (int rep_ = 0; rep_ < 1 + (int)((DUP_MASK >> 1) & 1u); ++rep_) { if (rep_) GRID_BAR();  ph_modred(modp, ada_b, mod, bid * 512 + tid, G * 512); } SEAM(1);
    if (IN(2)) _Pragma("unroll") for (int rep_ = 0; rep_ < 1 + (int)((DUP_MASK >> 2) & 1u); ++rep_) { if (rep_) GRID_BAR();  ph_mod0(x, ctx, nmix, mod, A, gw, NGW, lane); } SEAM(2);
    if (IN(3)) _Pragma("unroll") for (int rep_ = 0; rep_ < 1 + (int)((DUP_MASK >> 3) & 1u); ++rep_) { if (rep_) GRID_BAR();
        pg8::Gemm g{A, W1A, MT, 4096, DM}; pg8::StaticOrder S; S.init(MT, 4096, G, bid);
        EpiPair<0> E{U, DM, 16};
        pg8::gemm_phase<EpiPair<0>, pg8::StaticOrder, true, true>(lds, g, S, E);
        CVT_TAIL(1152, CVT_R3_LO, CVT_R4_LO);
    } SEAM(3);
    if (IN(4)) _Pragma("unroll") for (int rep_ = 0; rep_ < 1 + (int)((DUP_MASK >> 4) & 1u); ++rep_) { if (rep_) GRID_BAR();
        pg8::Gemm g{A, W1B, MT, DM, DM}; pg8::StaticOrder S; S.init(MT, DM, G, bid);
        EpiConvGate E{U, Z, conv_w};
        pg8::gemm_phase<EpiConvGate, pg8::StaticOrder, true, true>(lds, g, S, E);
        CVT_TAIL(576, CVT_R4_LO, CVT_R5_LO);
    } SEAM(4);
    if (IN(5)) _Pragma("unroll") for (int rep_ = 0; rep_ < 1 + (int)((DUP_MASK >> 5) & 1u); ++rep_) { if (rep_) GRID_BAR();
        pg8::Gemm g{Z, W2, MT, DM, DM}; pg8::StaticOrder S; S.init(MT, DM, G, bid);
        EpiResid<true> E{x, ctx, H, mod + 2 * DM};
        pg8::gemm_phase<EpiResid<true>, pg8::StaticOrder, true, true>(lds, g, S, E);
        CVT_TAIL(576, CVT_R5_LO, CVT_X0_END);
    } SEAM(5);
    if (IN(6)) _Pragma("unroll") for (int rep_ = 0; rep_ < 1 + (int)((DUP_MASK >> 6) & 1u); ++rep_) { if (rep_) GRID_BAR();  load_router(router_w, (LAS float*)lds, tid); ph_modffn(H, nffn, mod, A, (const LAS float*)lds, affL, affC, MT, gw, NGW, lane); } SEAM(6);
    if (IN(7)) _Pragma("unroll") for (int rep_ = 0; rep_ < 1 + (int)((DUP_MASK >> 7) & 1u); ++rep_) { if (rep_) GRID_BAR();  ph_topk(256, affL, affC, rowsrc, gatev, inv, (LAS unsigned*)lds, tid, lane, wave, bid, G); } SEAM(7);
    if (IN(8)) _Pragma("unroll") for (int rep_ = 0; rep_ < 1 + (int)((DUP_MASK >> 8) & 1u); ++rep_) { if (rep_) GRID_BAR();
        pg8::Gemm g{A, WGU, YT, NE * 2048, DM, rowsrc}; MoeOrder S{G, bid, 9};
        EpiPair<1> E{HM, DFF, 8};
        pg8::gemm_phase<EpiPair<1>, MoeOrder, true, true, true>(lds, g, S, E);
        CVT_TAIL(1152, CVT_R9_LO, CVT_R10_LO);
    } SEAM(8);
    if (IN(9)) _Pragma("unroll") for (int rep_ = 0; rep_ < 1 + (int)((DUP_MASK >> 9) & 1u); ++rep_) { if (rep_) GRID_BAR();
        pg8::Gemm g{HM, WDN, YT, NE * 2048, DFF}; MoeOrder S{G, bid, 9};
        EpiDown E{Y, gatev};
        pg8::gemm_phase<EpiDown, MoeOrder, true, true>(lds, g, S, E);
        CVT_TAIL(1152, CVT_R10_LO, CVT_R12_LO);
    } SEAM(9);
    if (IN(10)) _Pragma("unroll") for (int rep_ = 0; rep_ < 1 + (int)((DUP_MASK >> 10) & 1u); ++rep_) { if (rep_) GRID_BAR();  ph_combine<false>(H, Y, inv, mod, nmix + DM, mod + 9 * NMOD, A, nullptr, MT, gw, NGW, lane); } SEAM(10);
    if (IN(11)) _Pragma("unroll") for (int rep_ = 0; rep_ < 1 + (int)((DUP_MASK >> 11) & 1u); ++rep_) { if (rep_) GRID_BAR();
        pg8::Gemm g{A, WQKV, MT, 3072, DM}; QkvOrder S{G, bid};
        EpiQkvNorm E{Qb, Kb, Vb, qgain, kgain, (LAS float*)(lds + RING_BYTES)};
        pg8::gemm_phase<EpiQkvNorm, QkvOrder, true, true>(lds, g, S, E);
        CVT_TAIL(800, CVT_R12_LO, CVT_TOTAL);
    } SEAM(11);
    if (IN(12)) _Pragma("unroll") for (int rep_ = 0; rep_ < 1 + (int)((DUP_MASK >> 12) & 1u); ++rep_) { if (rep_) GRID_BAR();  ph_attn(Qb, Kb, Vb, Ob, sink, lds, tid, lane, wave, bid, G); } SEAM(12);
    if (IN(13)) _Pragma("unroll") for (int rep_ = 0; rep_ < 1 + (int)((DUP_MASK >> 13) & 1u); ++rep_) { if (rep_) GRID_BAR();
        pg8::Gemm g{Ob, WOt, ML, DM, DM}; pg8::StaticOrder S; S.init(ML, DM, G, bid);
        EpiResid<false> E{nullptr, nullptr, H, mod + 9 * NMOD + 2 * DM};
        pg8::gemm_phase<EpiResid<false>, pg8::StaticOrder, true, true>(lds, g, S, E);
    } SEAM(13);
    if (IN(14)) _Pragma("unroll") for (int rep_ = 0; rep_ < 1 + (int)((DUP_MASK >> 14) & 1u); ++rep_) { if (rep_) GRID_BAR();  load_router(router_w + DM * 16, (LAS float*)lds, tid); ph_modffn(H, nffn + DM, mod + 9 * NMOD, A, (const LAS float*)lds, affL, affC, ML, gw, NGW, lane); } SEAM(14);
    if (IN(15)) _Pragma("unroll") for (int rep_ = 0; rep_ < 1 + (int)((DUP_MASK >> 15) & 1u); ++rep_) { if (rep_) GRID_BAR();  ph_topk(128, affL, affC, rowsrc, gatev, inv, (LAS unsigned*)lds, tid, lane, wave, bid, G); } SEAM(15);
    if (IN(16)) _Pragma("unroll") for (int rep_ = 0; rep_ < 1 + (int)((DUP_MASK >> 16) & 1u); ++rep_) { if (rep_) GRID_BAR();
        pg8::Gemm g{A, WGU + (size_t)NE * 2048 * DM, YT, NE * 2048, DM, rowsrc}; MoeOrder S{G, bid, 8};
        EpiPair<1> E{HM, DFF, 8};
        pg8::gemm_phase<EpiPair<1>, MoeOrder, true, true, true>(lds, g, S, E);
    } SEAM(16);
    if (IN(17)) _Pragma("unroll") for (int rep_ = 0; rep_ < 1 + (int)((DUP_MASK >> 17) & 1u); ++rep_) { if (rep_) GRID_BAR();
        pg8::Gemm g{HM, WDN + (size_t)NE * 2048 * DFF, YT, NE * 2048, DFF}; MoeOrder S{G, bid, 8};
        EpiDown E{Y, gatev};
        pg8::gemm_phase<EpiDown, MoeOrder, true, true>(lds, g, S, E);
    } SEAM(17);
    if (IN(18)) _Pragma("unroll") for (int rep_ = 0; rep_ < 1 + (int)((DUP_MASK >> 18) & 1u); ++rep_) { if (rep_) GRID_BAR();  ph_combine<true>(H, Y, inv, mod + 9 * NMOD, nullptr, nullptr, nullptr, args.out, ML, gw, NGW, lane); }
#undef IN
#undef SEAM
}

extern "C" void kernel_launch(void* const* d_in, const int* in_sizes, int n_in, void* d_out, int out_size, void* d_ws, size_t ws_size, hipStream_t stream) {
    static int grid = 0;
    if (grid == 0) {
        if (n_in != 20 || out_size != ML * DM || ws_size < WS_END) { fprintf(stderr, "kernel_launch: unexpected problem (n_in %d, out %d, ws %zu); nothing launched\n", n_in, out_size, ws_size); grid = -1; return; }
        int dev = 0, cus = 0, per_cu = 0;
        if (hipGetDevice(&dev) != hipSuccess || hipDeviceGetAttribute(&cus, hipDeviceAttributeMultiprocessorCount, dev) != hipSuccess) { grid = -1; return; }
        if (hipFuncSetAttribute((const void*)dit_fwd, hipFuncAttributeMaxDynamicSharedMemorySize, LDS_BYTES) != hipSuccess) { fprintf(stderr, "kernel_launch: hipFuncSetAttribute failed\n"); grid = -1; return; }
        if (hipOccupancyMaxActiveBlocksPerMultiprocessor(&per_cu, (const void*)dit_fwd, 512, LDS_BYTES) != hipSuccess || per_cu < 1) fprintf(stderr, "kernel_launch: occupancy query reports %d workgroups per CU\n", per_cu);
        (void)hipGetLastError();
        grid = cus;
    }
    if (grid < 0) return;
    (void)hipMemsetAsync((char*)d_ws + WS_CTL, 0, CTL_ZERO_BYTES, stream);
    Args a{};
    for (int i = 0; i < 20; ++i) a.in[i] = (const float*)d_in[i];
    a.out = (float*)d_out; a.ws = (unsigned char*)d_ws;
#if MK_ONE_LAUNCH
    a.ph_lo = 0; a.ph_hi = NPHASE;
    hipLaunchKernelGGL(dit_fwd, dim3(grid), dim3(512), LDS_BYTES, stream, a);
#else
    for (int p = 0; p < NPHASE; ++p) { a.ph_lo = p; a.ph_hi = p + 1; hipLaunchKernelGGL(dit_fwd, dim3(grid), dim3(512), LDS_BYTES, stream, a); }
#endif
}
```

```cpp
#include <hip/hip_runtime.h>
#include <cstdio>
#include <cstdint>
namespace pg8 {
#define PG8_LAS __attribute__((address_space(3)))
typedef unsigned short bf16_t;
typedef short bf16x8 __attribute__((ext_vector_type(8)));
typedef float f32x4 __attribute__((ext_vector_type(4)));
typedef unsigned u32x4 __attribute__((ext_vector_type(4)));
constexpr int BM = 256, BK = 64, HALF = 128, HTB = HALF * BK * 2  , STAGE_BYTES = 8 * HTB, NXCD = 8, WGM = 8;

__host__ __device__ __forceinline__ int lds_byte(int r, int c) { const int st = (r >> 4) * 2 + (c >> 5), rr = r & 15, cc = c & 31, ob = rr * 64 + cc * 2; return st * 1024 + (ob ^ (((ob >> 9) & 1) << 5)); }
__host__ __device__ __forceinline__ void stage_rc(int b, int& R, int& C) { const int st = b / 1024, sb = b % 1024, swz = sb ^ (((sb >> 9) & 1) << 5); R = (st >> 1) * 16 + swz / 64; C = (st & 1) * 32 + (swz % 64) / 2; }
__host__ __device__ __forceinline__ int perm32(int rho) { const int n = rho >> 4, i = rho & 15; return 8 * (i >> 2) + 4 * n + (i & 3); }

struct Unit { int pm, pn; };
struct Gemm { const bf16_t* A; const bf16_t* Bt; int M, N, K; const int* rows = nullptr; };

struct StaticOrder {
    int nM, nN, nwg, G, c;
    __host__ __device__ void init(int M, int N, int G_, int c_) { nM = M / BM; nN = N / BM; nwg = nM * nN; G = G_; c = c_; }
    __host__ __device__ bool next(int i, Unit& u) const {
        const long L = (long)i * G + c; if (L >= nwg) return false;
        int wgid = (int)L; { const int q = nwg / NXCD, r = nwg % NXCD, xcd = wgid % NXCD, off = wgid / NXCD; wgid = (xcd < r ? xcd * (q + 1) : r * (q + 1) + (xcd - r) * q) + off; }
        const int nig = WGM * nN, gid = wgid / nig, fm = gid * WGM, gsz = (nM - fm) < WGM ? (nM - fm) : WGM;
        u.pm = fm + ((wgid % nig) % gsz); u.pn = (wgid % nig) / gsz; return true;
    }
    __device__ __forceinline__ void a_ready(const Unit&) const {}
    __device__ __forceinline__ void done(const Unit&) const {}
};
__device__ __forceinline__ unsigned cvt_pk_bf16(float lo, float hi) { unsigned r; asm volatile("v_cvt_pk_bf16_f32 %0, %1, %2" : "=v"(r) : "v"(lo), "v"(hi)); return r; }
typedef float f32x2 __attribute__((ext_vector_type(2)));
template <class Epi, class Sched, bool ALIGN_EPI = false, bool SP2 = false, bool GATHER = false>
__device__ __forceinline__ void gemm_phase(PG8_LAS unsigned char* lds, const Gemm g, const Sched& S, const Epi& E) {
    const int tid = threadIdx.x, wid = __builtin_amdgcn_readfirstlane(tid >> 6), lane = tid & 63, wr = wid >> 2, wc = wid & 3, fr = lane & 15, fq = lane >> 4;
    const int K = g.K, nt = K / BK;
    unsigned voffA[2], voffB[2];
#pragma unroll
    for (int i = 0; i < 2; ++i) { int R, C; stage_rc(tid * 16 + i * 8192, R, C); const int Rb = Epi::PERM ? ((R & ~31) + perm32(R & 31)) : R;
        voffA[i] = (unsigned)(R * K + C) * 2u; voffB[i] = (unsigned)(Rb * K + C) * 2u; }
    const size_t kstep = (size_t)(BK * 2);
    const size_t hstep = (size_t)HALF * K * 2;
    const size_t tstep = 2 * hstep;
    const unsigned ldsw = (unsigned)wid * 1024u;
    const int aoff = lds_byte(wr * 64 + fr, fq * 8), boff = lds_byte(wc * 32 + fr, fq * 8);
#define PG8_SA(b, h) (((b) * 2 + (h)) * HTB)
#define PG8_SB(b, h) ((4 + (b) * 2 + (h)) * HTB)
#define PG8_STAGE(bufoff, gbase, voff) do { _Pragma("unroll") for (int _i = 0; _i < 2; ++_i) \
        __builtin_amdgcn_global_load_lds((const unsigned*)((const char*)(gbase) + (voff)[_i]), (PG8_LAS unsigned*)(lds + (bufoff) + ldsw + _i * 8192), 16, 0, 0); } while (0)
#define PG8_STAGE_A(bufoff, kptr, h) do { if constexpr (GATHER) { PG8_STAGE(bufoff, kptr, vA[h]); } else { PG8_STAGE(bufoff, (kptr) + (h) * hstep, voffA); } } while (0)
#define PG8_GATHER_SWITCH() do { if constexpr (GATHER) { if (last && has_next) { asm volatile("" : "+v"(nv[0]), "+v"(nv[1]), "+v"(nv[2]), "+v"(nv[3])); \
        vA[0][0] = nv[0] * (unsigned)(K * 2) + gcoff[0]; vA[0][1] = nv[1] * (unsigned)(K * 2) + gcoff[1]; vA[1][0] = nv[2] * (unsigned)(K * 2) + gcoff[0]; vA[1][1] = nv[3] * (unsigned)(K * 2) + gcoff[1]; } } } while (0)
#define PG8_LDA(dst, b, h) do { _Pragma("unroll") for (int m = 0; m < 4; ++m) _Pragma("unroll") for (int k = 0; k < 2; ++k) dst[m][k] = *(const PG8_LAS bf16x8*)(lds + PG8_SA(b, h) + aoff + m * 2048 + k * 1024); } while (0)
#define PG8_LDB(dst, b, h) do { _Pragma("unroll") for (int n = 0; n < 2; ++n) _Pragma("unroll") for (int k = 0; k < 2; ++k) dst[n][k] = *(const PG8_LAS bf16x8*)(lds + PG8_SB(b, h) + boff + n * 2048 + k * 1024); } while (0)
#define PG8_MMA(ai, bj, At, Bt) do { __builtin_amdgcn_s_setprio(1); _Pragma("unroll") for (int m = 0; m < 4; ++m) _Pragma("unroll") for (int n = 0; n < 2; ++n) _Pragma("unroll") for (int k = 0; k < 2; ++k) \
        acc[ai][bj][m][n] = __builtin_amdgcn_mfma_f32_16x16x32_bf16(Bt[n][k], At[m][k], acc[ai][bj][m][n], 0, 0, 0); __builtin_amdgcn_s_setprio(0); } while (0)
#define PG8_WAIT_V(n) asm volatile("s_waitcnt vmcnt(" #n ")" ::: "memory")
#define PG8_WAIT_L(n) asm volatile("s_waitcnt lgkmcnt(" #n ")" ::: "memory")
#define PG8_BAR __builtin_amdgcn_s_barrier()
#define PG8_SCHED __builtin_amdgcn_sched_barrier(0)
    Unit cur, nxt; int ui = 0;
    if (!S.next(0, cur)) return;
    f32x4 acc[2][2][4][2];
#pragma unroll
    for (int a = 0; a < 2; ++a)
#pragma unroll
        for (int b = 0; b < 2; ++b)
#pragma unroll
            for (int m = 0; m < 4; ++m)
#pragma unroll
                for (int n = 0; n < 2; ++n) acc[a][b][m][n] = (f32x4){0.f, 0.f, 0.f, 0.f};
    bf16x8 At[4][2], B0[2][2], B1[2][2];
    const char* cA = (const char*)g.A + (GATHER ? (size_t)0 : (size_t)cur.pm * tstep); const char* cB = (const char*)g.Bt + (size_t)cur.pn * tstep;
    unsigned vA[2][2], nv[4], gcoff[2]; int grow[2];
    if constexpr (GATHER) {
#pragma unroll
        for (int i = 0; i < 2; ++i) { int R, C; stage_rc(tid * 16 + i * 8192, R, C); grow[i] = R; gcoff[i] = (unsigned)(C * 2); }
#pragma unroll
        for (int h = 0; h < 2; ++h)
#pragma unroll
            for (int i = 0; i < 2; ++i) vA[h][i] = (unsigned)g.rows[cur.pm * BM + h * HALF + grow[i]] * (unsigned)(K * 2) + gcoff[i];
    }
    S.a_ready(cur);
    if constexpr (SP2) {
        PG8_STAGE(PG8_SB(0, 0), cB, voffB); PG8_STAGE(PG8_SB(0, 1), cB + hstep, voffB); PG8_STAGE_A(PG8_SA(0, 0), cA, 0); PG8_STAGE_A(PG8_SA(0, 1), cA, 1);
        if (wr == 1) PG8_BAR;
        PG8_WAIT_V(2); PG8_BAR;
        PG8_STAGE(PG8_SB(1, 0), cB + kstep, voffB); PG8_STAGE_A(PG8_SA(1, 0), cA + kstep, 0); PG8_STAGE(PG8_SB(1, 1), cB + hstep + kstep, voffB);
        PG8_WAIT_V(6); PG8_BAR;
    } else {
        PG8_STAGE(PG8_SB(0, 0), cB, voffB); PG8_STAGE_A(PG8_SA(0, 0), cA, 0); PG8_STAGE(PG8_SB(0, 1), cB + hstep, voffB); PG8_STAGE_A(PG8_SA(0, 1), cA, 1);
        if (wr == 1) PG8_BAR;
        PG8_WAIT_V(4); PG8_BAR;
        PG8_STAGE(PG8_SB(1, 0), cB + kstep, voffB); PG8_STAGE_A(PG8_SA(1, 0), cA + kstep, 0); PG8_STAGE(PG8_SB(1, 1), cB + hstep + kstep, voffB);
        PG8_WAIT_V(6); PG8_BAR;
    }
    for (;;) {
        const bool has_next = S.next(ui + 1, nxt);
        const char* nA = (has_next && !GATHER) ? (const char*)g.A + (size_t)nxt.pm * tstep : cA; const char* nB = has_next ? (const char*)g.Bt + (size_t)nxt.pn * tstep : cB;
        if constexpr (GATHER) { if (has_next) { const int* rp = g.rows + nxt.pm * BM;
            asm volatile("global_load_dword %0, %1, off" : "=&v"(nv[0]) : "v"(rp + grow[0]) : "memory"); asm volatile("global_load_dword %0, %1, off" : "=&v"(nv[1]) : "v"(rp + grow[1]) : "memory");
            asm volatile("global_load_dword %0, %1, off" : "=&v"(nv[2]) : "v"(rp + HALF + grow[0]) : "memory"); asm volatile("global_load_dword %0, %1, off" : "=&v"(nv[3]) : "v"(rp + HALF + grow[1]) : "memory"); } }
        for (int t = 0; t < nt; t += 2) {
            const bool last = (t == nt - 2);
            const char* a1 = cA + (size_t)(t + 1) * kstep;
            const char* a2 = last ? nA : cA + (size_t)(t + 2) * kstep; const char* b2 = last ? nB : cB + (size_t)(t + 2) * kstep;
            const char* a3 = a2 + kstep; const char* b3 = b2 + kstep;
            if (last && has_next) S.a_ready(nxt);
            if constexpr (SP2) {
            PG8_LDB(B0, 0, 0); PG8_LDB(B1, 0, 1); PG8_SCHED; PG8_LDA(At, 0, 0); PG8_STAGE_A(PG8_SA(1, 1), a1, 1); PG8_GATHER_SWITCH();
            PG8_WAIT_V(8); PG8_WAIT_L(0); PG8_BAR; PG8_MMA(0, 0, At, B0); PG8_MMA(0, 1, At, B1); PG8_BAR; PG8_SCHED;
            PG8_LDA(At, 0, 1); PG8_STAGE(PG8_SB(0, 0), b2, voffB); PG8_STAGE(PG8_SB(0, 1), b2 + hstep, voffB); PG8_STAGE_A(PG8_SA(0, 0), a2, 0);
            PG8_WAIT_V(8); PG8_WAIT_L(0); PG8_BAR; PG8_MMA(1, 0, At, B0); PG8_MMA(1, 1, At, B1); PG8_BAR; PG8_SCHED;
            PG8_LDB(B0, 1, 0); PG8_LDB(B1, 1, 1); PG8_SCHED; PG8_LDA(At, 1, 0); PG8_STAGE_A(PG8_SA(0, 1), a2, 1);
            PG8_WAIT_V(8); PG8_WAIT_L(0); PG8_BAR; PG8_MMA(0, 0, At, B0); PG8_MMA(0, 1, At, B1); PG8_BAR; PG8_SCHED;
            PG8_LDA(At, 1, 1); PG8_STAGE(PG8_SB(1, 0), b3, voffB); PG8_STAGE(PG8_SB(1, 1), b3 + hstep, voffB); PG8_STAGE_A(PG8_SA(1, 0), a3, 0);
            PG8_WAIT_V(8); PG8_WAIT_L(0); PG8_BAR; PG8_MMA(1, 0, At, B0); PG8_MMA(1, 1, At, B1); PG8_BAR; PG8_SCHED;
            } else {
            PG8_LDB(B0, 0, 0); PG8_SCHED; PG8_LDA(At, 0, 0); PG8_STAGE_A(PG8_SA(1, 1), a1, 1); PG8_GATHER_SWITCH();
            PG8_WAIT_L(8); PG8_BAR; PG8_WAIT_L(0); PG8_MMA(0, 0, At, B0); PG8_BAR; PG8_SCHED;
            PG8_LDB(B1, 0, 1); PG8_STAGE(PG8_SB(0, 0), b2, voffB);
            PG8_BAR; PG8_WAIT_L(0); PG8_MMA(0, 1, At, B1); PG8_BAR;
            PG8_LDA(At, 0, 1); PG8_STAGE_A(PG8_SA(0, 0), a2, 0);
            PG8_BAR; PG8_WAIT_L(0); PG8_MMA(1, 0, At, B0); PG8_BAR; PG8_SCHED;
            PG8_STAGE(PG8_SB(0, 1), b2 + hstep, voffB);
            PG8_WAIT_V(6); PG8_BAR; PG8_MMA(1, 1, At, B1); PG8_BAR;
            PG8_LDB(B0, 1, 0); PG8_SCHED; PG8_LDA(At, 1, 0); PG8_STAGE_A(PG8_SA(0, 1), a2, 1);
            PG8_WAIT_L(8); PG8_BAR; PG8_WAIT_L(0); PG8_MMA(0, 0, At, B0); PG8_BAR; PG8_SCHED;
            PG8_LDB(B1, 1, 1); PG8_STAGE(PG8_SB(1, 0), b3, voffB);
            PG8_BAR; PG8_WAIT_L(0); PG8_MMA(0, 1, At, B1); PG8_BAR;
            PG8_LDA(At, 1, 1); PG8_STAGE_A(PG8_SA(1, 0), a3, 0);
            PG8_BAR; PG8_WAIT_L(0); PG8_MMA(1, 0, At, B0); PG8_BAR; PG8_SCHED;
            PG8_STAGE(PG8_SB(1, 1), b3 + hstep, voffB);
            PG8_WAIT_V(6); PG8_BAR; PG8_MMA(1, 1, At, B1); PG8_BAR;
            }
        }
        if constexpr (ALIGN_EPI) { if (wr == 0) PG8_BAR; }
        if constexpr (!Epi::AFTER_DRAIN) { E(acc, cur, wr, wc, fr, fq); S.done(cur); }
        if (!has_next) break;
#pragma unroll
        for (int a = 0; a < 2; ++a)
#pragma unroll
            for (int b = 0; b < 2; ++b)
#pragma unroll
                for (int m = 0; m < 4; ++m)
#pragma unroll
                    for (int n = 0; n < 2; ++n) acc[a][b][m][n] = (f32x4){0.f, 0.f, 0.f, 0.f};
        cur = nxt; cA = nA; cB = nB; ++ui;
        if constexpr (ALIGN_EPI) { if (wr == 1) PG8_BAR; }
    }
    PG8_WAIT_V(0);
    if constexpr (!ALIGN_EPI) { if (wr == 0) PG8_BAR; }
    PG8_BAR;
    if constexpr (Epi::AFTER_DRAIN) { E.fused(acc, cur, wr, wc, fr, fq, lds, wid, lane); S.done(cur); }
#undef PG8_SA
#undef PG8_SB
#undef PG8_STAGE
#undef PG8_STAGE_A
#undef PG8_GATHER_SWITCH
#undef PG8_LDA
#undef PG8_LDB
#undef PG8_MMA
#undef PG8_WAIT_V
#undef PG8_WAIT_L
#undef PG8_BAR
#undef PG8_SCHED
}
}

constexpr int DM = 2048, NB = 8, SEQ = 2048, CTXL = 256, NH = 16, NKV = 4, HD = 128;
constexpr int ML = NB * SEQ;
constexpr int MC = NB * CTXL;
constexpr int MT = ML + MC;
constexpr int NE = 16, CAPL = 256, CAPC = 32, DFF = 1024;
constexpr int YR = NB * CAPL + NB * CAPC;
constexpr int YT = NE * YR;
constexpr int NMOD = 6 * DM;
constexpr float NORM_EPS = 1e-6f;
constexpr int KSPLIT = 16;

using pg8::Unit; using pg8::f32x4; using pg8::u32x4; using pg8::bf16_t; using pg8::bf16x8; using pg8::cvt_pk_bf16;
typedef float f32x2 __attribute__((ext_vector_type(2)));
typedef unsigned u32x2 __attribute__((ext_vector_type(2)));
typedef float f32x16 __attribute__((ext_vector_type(16)));
typedef short s16x4 __attribute__((ext_vector_type(4)));
#define DI __device__ __forceinline__

DI float bf_lo(unsigned w) { return __uint_as_float(w << 16); }
DI float bf_hi(unsigned w) { return __uint_as_float(w & 0xffff0000u); }
DI float silu_f(float a) { return a * __builtin_amdgcn_rcpf(1.0f + __expf(-a)); }

DI int xcd_remap(int wgid, int nwg) { const int q = nwg / 8, r = nwg % 8, xcd = wgid % 8, off = wgid / 8; return (xcd < r ? xcd * (q + 1) : r * (q + 1) + (xcd - r) * q) + off; }
struct QkvOrder {
    int G, c;
    DI bool next(int i, Unit& u) const {
        const int L = i * G + c; if (L >= 800) return false;
        if (L < 768) { const int w = xcd_remap(L, 768); const int nig = 8 * 12, gid = w / nig; u.pm = gid * 8 + ((w % nig) % 8); u.pn = (w % nig) / 8; }
        else { const int j = L - 768; u.pm = 64 + (j >> 2); u.pn = 8 + (j & 3); }
        return true;
    }
    DI void a_ready(const Unit&) const {}
    DI void done(const Unit&) const {}
};
struct MoeOrder {
    int G, c, NP;
    DI bool next(int i, Unit& u) const {
        const int nwg = NE * NP * 8; const int L = i * G + c; if (L >= nwg) return false;
        const int w = xcd_remap(L, nwg); const int per = NP * 8, e = w / per, rem = w % per;
        u.pm = e * 9 + (rem % NP); u.pn = e * 8 + (rem / NP); return true;
    }
    DI void a_ready(const Unit&) const {}
    DI void done(const Unit&) const {}
};

template <int ACT  > struct EpiPair {
    static constexpr bool PERM = true, AFTER_DRAIN = false;
    bf16_t* O; int ldc; int pn_mod;
    DI void operator()(const f32x4 (&acc)[2][2][4][2], const Unit& u, int wr, int wc, int fr, int fq) const {
        const int row0 = u.pm * 256 + wr * 64 + fr, col0 = (u.pn % pn_mod) * 128 + wc * 32 + 8 * fq;
#pragma unroll
        for (int ai = 0; ai < 2; ++ai)
#pragma unroll
            for (int m = 0; m < 4; ++m) {
                bf16_t* rowp = O + (size_t)(row0 + ai * 128 + m * 16) * ldc + col0;
                f32x4 a0 = acc[ai][0][m][0], a1 = acc[ai][0][m][1]; const f32x4 b0 = acc[ai][1][m][0], b1 = acc[ai][1][m][1];
                if (ACT == 1) {
#pragma unroll
                    for (int j = 0; j < 4; ++j) { a0[j] = silu_f(a0[j]); a1[j] = silu_f(a1[j]); } }
                const f32x4 v0 = a0 * b0, v1 = a1 * b1;
                u32x4 w; w.x = cvt_pk_bf16(v0[0], v0[1]); w.y = cvt_pk_bf16(v0[2], v0[3]); w.z = cvt_pk_bf16(v1[0], v1[1]); w.w = cvt_pk_bf16(v1[2], v1[3]);
                *(u32x4*)rowp = w;
            }
    }
};
struct EpiConvGate {
    static constexpr bool PERM = true, AFTER_DRAIN = false;
    const bf16_t* U; bf16_t* Z; const float* cw;
    DI void operator()(const f32x4 (&acc)[2][2][4][2], const Unit& u, int wr, int wc, int fr, int fq) const {
        const int row0 = u.pm * 256 + wr * 64 + fr, col0 = u.pn * 256 + wc * 32 + 8 * fq;
#pragma unroll
        for (int bj = 0; bj < 2; ++bj) {
            const int c = col0 + bj * 128;
            f32x4 w0a = *(const f32x4*)(cw + c), w0b = *(const f32x4*)(cw + c + 4), w1a = *(const f32x4*)(cw + 2048 + c), w1b = *(const f32x4*)(cw + 2048 + c + 4), w2a = *(const f32x4*)(cw + 4096 + c), w2b = *(const f32x4*)(cw + 4096 + c + 4);
#pragma unroll
            for (int ai = 0; ai < 2; ++ai)
#pragma unroll
                for (int m = 0; m < 4; ++m) {
                    const int row = row0 + ai * 128 + m * 16;
                    const int tpos = row < ML ? (row & (SEQ - 1)) : ((row - ML) & (CTXL - 1)); const int len = row < ML ? SEQ : CTXL;
                    const u32x4 z4 = (u32x4){0u, 0u, 0u, 0u};
                    const u32x4 uc = *(const u32x4*)(U + (size_t)row * DM + c);
                    const u32x4 up = tpos > 0 ? *(const u32x4*)(U + (size_t)(row - 1) * DM + c) : z4;
                    const u32x4 un = tpos < len - 1 ? *(const u32x4*)(U + (size_t)(row + 1) * DM + c) : z4;
                    f32x4 ya, yb;
                    ya[0] = w0a[0] * bf_lo(up.x) + w1a[0] * bf_lo(uc.x) + w2a[0] * bf_lo(un.x); ya[1] = w0a[1] * bf_hi(up.x) + w1a[1] * bf_hi(uc.x) + w2a[1] * bf_hi(un.x);
                    ya[2] = w0a[2] * bf_lo(up.y) + w1a[2] * bf_lo(uc.y) + w2a[2] * bf_lo(un.y); ya[3] = w0a[3] * bf_hi(up.y) + w1a[3] * bf_hi(uc.y) + w2a[3] * bf_hi(un.y);
                    yb[0] = w0b[0] * bf_lo(up.z) + w1b[0] * bf_lo(uc.z) + w2b[0] * bf_lo(un.z); yb[1] = w0b[1] * bf_hi(up.z) + w1b[1] * bf_hi(uc.z) + w2b[1] * bf_hi(un.z);
                    yb[2] = w0b[2] * bf_lo(up.w) + w1b[2] * bf_lo(uc.w) + w2b[2] * bf_lo(un.w); yb[3] = w0b[3] * bf_hi(up.w) + w1b[3] * bf_hi(uc.w) + w2b[3] * bf_hi(un.w);
                    const f32x4 v0 = acc[ai][bj][m][0] * ya, v1 = acc[ai][bj][m][1] * yb;
                    u32x4 w; w.x = cvt_pk_bf16(v0[0], v0[1]); w.y = cvt_pk_bf16(v0[2], v0[3]); w.z = cvt_pk_bf16(v1[0], v1[1]); w.w = cvt_pk_bf16(v1[2], v1[3]);
                    *(u32x4*)(Z + (size_t)row * DM + c) = w;
                }
        }
    }
};
template <bool BASE_F32> struct EpiResid {
    static constexpr bool PERM = true, AFTER_DRAIN = false;
    const float* base_lat; const float* base_ctx; bf16_t* out; const float* gate;
    DI void operator()(const f32x4 (&acc)[2][2][4][2], const Unit& u, int wr, int wc, int fr, int fq) const {
        const int rowt = u.pm * 256; const int cr = rowt < ML ? (rowt >> 11) : 8;
        const float* base = rowt < ML ? base_lat : base_ctx - (size_t)ML * DM;
        const int row0 = rowt + wr * 64 + fr, col0 = u.pn * 256 + wc * 32 + 8 * fq;
        f32x4 gv[2][2];
#pragma unroll
        for (int bj = 0; bj < 2; ++bj)
#pragma unroll
            for (int n = 0; n < 2; ++n) gv[bj][n] = *(const f32x4*)(gate + (size_t)cr * NMOD + col0 + bj * 128 + n * 4);
#pragma unroll
        for (int ai = 0; ai < 2; ++ai)
#pragma unroll
            for (int m = 0; m < 4; ++m) { const size_t off = (size_t)(row0 + ai * 128 + m * 16) * DM + col0;
#pragma unroll
                for (int bj = 0; bj < 2; ++bj) { f32x4 b0, b1;
                    if (BASE_F32) { b0 = *(const f32x4*)(base + off + bj * 128); b1 = *(const f32x4*)(base + off + bj * 128 + 4); }
                    else { const u32x4 hb = *(const u32x4*)(out + off + bj * 128); b0 = (f32x4){bf_lo(hb.x), bf_hi(hb.x), bf_lo(hb.y), bf_hi(hb.y)}; b1 = (f32x4){bf_lo(hb.z), bf_hi(hb.z), bf_lo(hb.w), bf_hi(hb.w)}; }
                    const f32x4 v0 = b0 + gv[bj][0] * acc[ai][bj][m][0], v1 = b1 + gv[bj][1] * acc[ai][bj][m][1];
                    u32x4 w; w.x = cvt_pk_bf16(v0[0], v0[1]); w.y = cvt_pk_bf16(v0[2], v0[3]); w.z = cvt_pk_bf16(v1[0], v1[1]); w.w = cvt_pk_bf16(v1[2], v1[3]);
                    *(u32x4*)(out + off + bj * 128) = w; }
                asm volatile("" ::: "memory"); }
    }
};
struct EpiDown {
    static constexpr bool PERM = true, AFTER_DRAIN = false;
    bf16_t* Y; const float* gatev;
    DI void operator()(const f32x4 (&acc)[2][2][4][2], const Unit& u, int wr, int wc, int fr, int fq) const {
        const int row0 = u.pm * 256 + wr * 64 + fr, col0 = (u.pn & 7) * 256 + wc * 32 + 8 * fq;
#pragma unroll
        for (int ai = 0; ai < 2; ++ai)
#pragma unroll
            for (int m = 0; m < 4; ++m) { const int row = row0 + ai * 128 + m * 16; const float gt = gatev[row];
#pragma unroll
                for (int bj = 0; bj < 2; ++bj) { const f32x4 v0 = acc[ai][bj][m][0] * gt, v1 = acc[ai][bj][m][1] * gt;
                    u32x4 w; w.x = cvt_pk_bf16(v0[0], v0[1]); w.y = cvt_pk_bf16(v0[2], v0[3]); w.z = cvt_pk_bf16(v1[0], v1[1]); w.w = cvt_pk_bf16(v1[2], v1[3]);
                    *(u32x4*)(Y + (size_t)row * DM + col0 + bj * 128) = w; } }
    }
};
struct EpiQkv {
    static constexpr bool PERM = true, AFTER_DRAIN = false;
    bf16_t* Q; bf16_t* K; bf16_t* V;
    DI void operator()(const f32x4 (&acc)[2][2][4][2], const Unit& u, int wr, int wc, int fr, int fq) const {
        const int row0 = u.pm * 256 + wr * 64 + fr; int colt = u.pn * 256; bf16_t* base; int ld;
        if (colt < 2048) { base = Q; ld = 2048; } else if (colt < 2560) { base = K; ld = 512; colt -= 2048; } else { base = V; ld = 512; colt -= 2560; }
        const int col0 = colt + wc * 32 + 8 * fq;
#pragma unroll
        for (int ai = 0; ai < 2; ++ai)
#pragma unroll
            for (int m = 0; m < 4; ++m) { bf16_t* rowp = base + (size_t)(row0 + ai * 128 + m * 16) * ld + col0;
#pragma unroll
                for (int bj = 0; bj < 2; ++bj) { const f32x4 v0 = acc[ai][bj][m][0], v1 = acc[ai][bj][m][1];
                    u32x4 w; w.x = cvt_pk_bf16(v0[0], v0[1]); w.y = cvt_pk_bf16(v0[2], v0[3]); w.z = cvt_pk_bf16(v1[0], v1[1]); w.w = cvt_pk_bf16(v1[2], v1[3]);
                    *(u32x4*)(rowp + bj * 128) = w; } }
    }
};

#define LAS3 __attribute__((address_space(3)))
struct EpiQkvNorm {
    static constexpr bool PERM = true, AFTER_DRAIN = false;
    bf16_t* Q; bf16_t* K; bf16_t* V; const float* qg; const float* kg; LAS3 float* P;
    DI void operator()(const f32x4 (&acc)[2][2][4][2], const Unit& u, int wr, int wc, int fr, int fq) const {
        const int row0 = u.pm * 256 + wr * 64 + fr; int colt = u.pn * 256;
        if (colt >= 2560) {
            const int col0 = colt - 2560 + wc * 32 + 8 * fq;
#pragma unroll
            for (int ai = 0; ai < 2; ++ai)
#pragma unroll
                for (int m = 0; m < 4; ++m) { bf16_t* rowp = V + (size_t)(row0 + ai * 128 + m * 16) * 512 + col0;
#pragma unroll
                    for (int bj = 0; bj < 2; ++bj) { const f32x4 v0 = acc[ai][bj][m][0], v1 = acc[ai][bj][m][1];
                        u32x4 w; w.x = cvt_pk_bf16(v0[0], v0[1]); w.y = cvt_pk_bf16(v0[2], v0[3]); w.z = cvt_pk_bf16(v1[0], v1[1]); w.w = cvt_pk_bf16(v1[2], v1[3]);
                        *(u32x4*)(rowp + bj * 128) = w; } }
            return;
        }
        const bool isq = colt < 2048; bf16_t* base = isq ? Q : K; const int ld = isq ? 2048 : 512; if (!isq) colt -= 2048;
        const int rl0 = wr * 64 + fr;
#pragma unroll
        for (int ai = 0; ai < 2; ++ai)
#pragma unroll
            for (int m = 0; m < 4; ++m)
#pragma unroll
                for (int bj = 0; bj < 2; ++bj) { const f32x4 a = acc[ai][bj][m][0], b = acc[ai][bj][m][1];
                    float s = (a[0] * a[0] + a[1] * a[1]) + (a[2] * a[2] + a[3] * a[3]) + (b[0] * b[0] + b[1] * b[1]) + (b[2] * b[2] + b[3] * b[3]);
                    s += __shfl_xor(s, 16); s += __shfl_xor(s, 32);
                    if (fq == 0) P[((ai * 128 + m * 16 + rl0) * 2 + bj) * 4 + wc] = s; }
        asm volatile("s_waitcnt lgkmcnt(0)" ::: "memory"); __builtin_amdgcn_s_barrier(); asm volatile("" ::: "memory");
        constexpr float QSCALE = 0.08838834764831845f * 1.4426950408889634f;
        const int i0 = 16 * (wc & 1) + 4 * fq, d0 = 64 * (wc >> 1) + i0;
        const float* gp = isq ? qg : kg; f32x4 g0 = *(const f32x4*)(gp + d0), g1 = *(const f32x4*)(gp + d0 + 32);
        if (isq) { g0 = g0 * QSCALE; g1 = g1 * QSCALE; }
        f32x4 ifr;
#pragma unroll
        for (int j = 0; j < 4; ++j) ifr[j] = exp2f(-(float)(i0 + j) * (13.287712379549449f / 32.0f));
        const bool lat = u.pm < 64;
#pragma unroll
        for (int ai = 0; ai < 2; ++ai)
#pragma unroll
            for (int m = 0; m < 4; ++m) { const int row = row0 + ai * 128 + m * 16; const int t = row & (SEQ - 1);
                const float pos = (float)((wc >> 1) == 0 ? (t >> 6) : (t & 63));
                f32x4 cs, sn;
#pragma unroll
                for (int j = 0; j < 4; ++j) { const float ang = pos * ifr[j]; cs[j] = lat ? __cosf(ang) : 1.0f; sn[j] = lat ? __sinf(ang) : 0.0f; }
#pragma unroll
                for (int bj = 0; bj < 2; ++bj) { const f32x4 pp = *(const LAS3 f32x4*)(P + ((ai * 128 + m * 16 + rl0) * 2 + bj) * 4);
                    const float rstd = 1.0f / sqrtf(((pp[0] + pp[1]) + (pp[2] + pp[3])) * (1.0f / HD) + NORM_EPS);
                    const f32x4 a = acc[ai][bj][m][0] * rstd * g0, b = acc[ai][bj][m][1] * rstd * g1;
                    const f32x4 o1 = a * cs - b * sn, o2 = b * cs + a * sn;
                    u32x4 w; w.x = cvt_pk_bf16(o1[0], o1[1]); w.y = cvt_pk_bf16(o1[2], o1[3]); w.z = cvt_pk_bf16(o2[0], o2[1]); w.w = cvt_pk_bf16(o2[2], o2[3]);
                    *(u32x4*)(base + (size_t)row * ld + colt + bj * 128 + wc * 32 + 8 * fq) = w; } }
    }
};

constexpr size_t MiB = 1u << 20;
constexpr size_t WS_CTL = 0, CTL_ZERO_BYTES = 1 * MiB;
constexpr size_t WS_MOD = 1 * MiB;
constexpr size_t WS_MODP = 2 * MiB;
constexpr size_t WS_AFFL = 16 * MiB;
constexpr size_t WS_AFFC = 17 * MiB;
constexpr size_t WS_ROWSRC = 17 * MiB + 512 * 1024;
constexpr size_t WS_GATEV = 18 * MiB;
constexpr size_t WS_INV = 18 * MiB + 512 * 1024;
constexpr size_t WS_W1A = 20 * MiB;
constexpr size_t WS_W1B = 36 * MiB;
constexpr size_t WS_W2 = 44 * MiB;
constexpr size_t WS_WQKV = 52 * MiB;
constexpr size_t WS_WO = 64 * MiB;
constexpr size_t WS_WGU = 72 * MiB;
constexpr size_t WS_WDN = 328 * MiB;
constexpr size_t WS_H = 456 * MiB;
constexpr size_t WS_A = 600 * MiB;
constexpr size_t WS_U = 672 * MiB;
constexpr size_t WS_Z = 744 * MiB;
constexpr size_t WS_Q = WS_U, WS_K = WS_Z, WS_V = WS_Z + 18 * MiB;
constexpr size_t WS_HM = 816 * MiB;
constexpr size_t WS_O = WS_HM;
constexpr size_t WS_Y = 888 * MiB;
constexpr size_t WS_XS = WS_Y;
constexpr size_t WS_END = 1032 * MiB;
constexpr int CW_BAR = 4096;

constexpr int RING_BYTES = 131072;
constexpr int MISC_OFF = RING_BYTES + 14336;
constexpr int LDS_BYTES = 147456;

#define GAS __attribute__((address_space(1)))
#define LAS __attribute__((address_space(3)))
#define LDS_WAIT() asm volatile("s_waitcnt lgkmcnt(0)" ::: "memory")
#define VM_WAIT() asm volatile("s_waitcnt vmcnt(0)" ::: "memory")
#define XB_TMO      128
#define XB_XCNT(j)  (256  + 64 * (j))
#define XB_XSUB(j)  (1280 + 64 * (j))
#define XB_XGEN(j)  (2304 + 64 * (j))
#define XB_TOP      3328
#define XB_TOPGEN   3392
#define XCD_BAR_WORDS 3456
#define XB_SPIN_CAP (1u << 18)

__device__ __forceinline__ unsigned xb_ld(unsigned* p)              { return __hip_atomic_load(p, __ATOMIC_RELAXED, __HIP_MEMORY_SCOPE_AGENT); }
__device__ __forceinline__ unsigned xb_add(unsigned* p, unsigned v) { return __hip_atomic_fetch_add(p, v, __ATOMIC_RELAXED, __HIP_MEMORY_SCOPE_AGENT); }
__device__ __forceinline__ unsigned xb_xcc_id() { return (unsigned)__builtin_amdgcn_s_getreg((3 << 11) | 20) & 0xFu; }
#define XB_SPIN(cond, bar) do { unsigned _sp = 0; while (cond) { __builtin_amdgcn_s_sleep(1); \
    if ((++_sp & 255u) == 0u) { if (xb_ld(&(bar)[XB_TMO])) break; if (_sp > XB_SPIN_CAP) { atomicAdd(&(bar)[XB_TMO], 1u); break; } } } } while (0)

struct XcdBarrier {
    unsigned* bar; unsigned x;
    volatile LAS unsigned* st;
};

__device__ __forceinline__ XcdBarrier xcd_barrier_post(unsigned* bar, volatile LAS unsigned* st) {
    XcdBarrier b; b.bar = bar; b.x = xb_xcc_id(); b.st = st;
    if (threadIdx.x == 0) (void)xb_add(&bar[XB_XCNT(b.x)], 1u);
    return b;
}
__device__ __forceinline__ void xcd_barrier_complete(unsigned* bar, unsigned x, unsigned& nloc, unsigned& nx) {
    const unsigned G = gridDim.x * gridDim.y * gridDim.z;
    unsigned sum, cnt, mine, sp = 0u;
    for (;;) {
        sum = 0u; cnt = 0u; mine = 0u;
#pragma unroll
        for (unsigned j = 0; j < 16; ++j) { const unsigned c = xb_ld(&bar[XB_XCNT(j)]); sum += c; cnt += (c > 0u) ? 1u : 0u; mine = (j == x) ? c : mine; }
        if (sum == G) break;
        __builtin_amdgcn_s_sleep(1);
        if ((++sp & 255u) == 0u) { if (xb_ld(&bar[XB_TMO])) break; if (sp > XB_SPIN_CAP) { atomicAdd(&bar[XB_TMO], 1u); break; } }
    }
    nloc = mine > 0u ? mine : 1u; nx = cnt > 0u ? cnt : 1u;
}

__device__ __forceinline__ void xcd_barrier(const XcdBarrier& b) {
    asm volatile("s_waitcnt vmcnt(0)" ::: "memory");
    __syncthreads();
    if (threadIdx.x == 0) {
        unsigned* bar = b.bar;
        __builtin_amdgcn_s_waitcnt(0);
        unsigned nloc = b.st[0], nx = b.st[1];
        if (nloc == 0u) { xcd_barrier_complete(bar, b.x, nloc, nx); b.st[0] = nloc; b.st[1] = nx; }
        const unsigned old = xb_add(&bar[XB_XSUB(b.x)], 1u);
        const unsigned gen = old / nloc;
        if (old + 1u == (gen + 1u) * nloc) {
            __builtin_amdgcn_fence(__ATOMIC_RELEASE, "agent");
            asm volatile("s_waitcnt vmcnt(0)" ::: "memory");
            const unsigned og = xb_add(&bar[XB_TOP], 1u);
            const unsigned tg = og / nx;
            if (og + 1u == (tg + 1u) * nx) xb_add(&bar[XB_TOPGEN], 1u);
            else XB_SPIN(xb_ld(&bar[XB_TOPGEN]) == tg, bar);
            __builtin_amdgcn_fence(__ATOMIC_ACQUIRE, "agent");
            xb_add(&bar[XB_XGEN(b.x)], 1u);
            asm volatile("s_waitcnt vmcnt(0)" ::: "memory");
        } else {
            XB_SPIN(xb_ld(&bar[XB_XGEN(b.x)]) == gen, bar);
            __builtin_amdgcn_fence(__ATOMIC_ACQUIRE, "agent");
            asm volatile("s_waitcnt vmcnt(0)" ::: "memory");
        }
    }
    __syncthreads();
}

DI float wave_sum(float v) {
#pragma unroll
    for (int o = 1; o < 64; o <<= 1) v += __shfl_xor(v, o);
    return v;
}
DI float rdlane(float v, int l) { return __uint_as_float((unsigned)__builtin_amdgcn_readlane((int)__float_as_uint(v), l)); }
DI unsigned pk2(float lo, float hi) { return cvt_pk_bf16(lo, hi); }

DI void ph_adaln(const float* cnd, const float* cctx, const float* ada_w, float* modp, int gw, int NGW, int lane) {
    for (int task = gw; task < 96 * KSPLIT; task += NGW) {
        const int ks = task & (KSPLIT - 1), cg = task / KSPLIT, l = cg / 48, cgl = cg % 48, col0 = cgl * 256 + lane * 4, k0 = ks * 128;
        float sv[9][2];
#pragma unroll
        for (int r = 0; r < 9; ++r)
#pragma unroll
            for (int hh = 0; hh < 2; ++hh) { const int k = k0 + hh * 64 + lane; const float v = r < 8 ? cnd[r * DM + k] : cctx[k]; sv[r][hh] = v / (1.0f + __expf(-v)); }
        f32x4 acc[9];
#pragma unroll
        for (int r = 0; r < 9; ++r) acc[r] = (f32x4){0.f, 0.f, 0.f, 0.f};
        const float* wp = ada_w + ((size_t)l * DM + k0) * NMOD + col0;
#pragma unroll
        for (int hh = 0; hh < 2; ++hh) {
#pragma unroll 8
            for (int kk = 0; kk < 64; ++kk) {
                const f32x4 w = *(const f32x4*)(wp + (size_t)(hh * 64 + kk) * NMOD);
#pragma unroll
                for (int r = 0; r < 9; ++r) { const float s = rdlane(sv[r][hh], kk); acc[r] += w * s; }
            }
        }
#pragma unroll
        for (int r = 0; r < 9; ++r) *(f32x4*)(modp + ((size_t)((ks * 2 + l) * 9 + r)) * NMOD + col0) = acc[r];
    }
}
struct CvtPtrs { const float *cin, *cout, *wqkv, *wo, *wg, *wu, *wd; bf16_t *W1A, *W1B, *W2, *WQKV, *WO, *WGU, *WDN; };
constexpr int CVT_E0 = 6656, CVT_L = 24576, CVT_TOTAL = CVT_E0 + 2 * CVT_L;
DI void cvt_resolve(const CvtPtrs& P, int it, const float*& src, int& ldw, bf16_t*& dst, int& ldd, bool& qperm) {
    int r = it; qperm = false;
    if (r < 3072) { const int kt = ((r >> 3) / 96) * 8 + (r & 7), nt = (r >> 3) % 96, n0 = nt * 64, part = n0 >> 11, j0 = n0 & 2047;
        src = P.cin + (size_t)(kt * 64) * 6144 + n0; ldw = 6144; ldd = DM;
        dst = (part == 0 ? P.W1B + (size_t)j0 * DM : P.W1A + (size_t)((j0 >> 7) * 256 + (part == 2 ? 128 : 0) + (j0 & 127)) * DM) + kt * 64; return; } r -= 3072;
    if (r < 1024) { const int kt = ((r >> 3) / 32) * 8 + (r & 7), nt = (r >> 3) % 32; src = P.cout + (size_t)(kt * 64) * DM + nt * 64; ldw = DM; dst = P.W2 + (size_t)(nt * 64) * DM + kt * 64; ldd = DM; return; } r -= 1024;
    if (r < 1536) { const int kt = ((r >> 3) / 48) * 8 + (r & 7), nt = (r >> 3) % 48; src = P.wqkv + (size_t)(kt * 64) * 3072 + nt * 64; ldw = 3072; qperm = nt < 40;     dst = P.WQKV + (size_t)(nt * 64) * DM + kt * 64; ldd = DM; return; } r -= 1536;
    if (r < 1024) { const int kt = ((r >> 3) / 32) * 8 + (r & 7), nt = (r >> 3) % 32; src = P.wo + (size_t)(kt * 64) * DM + nt * 64; ldw = DM; dst = P.WO + (size_t)(nt * 64) * DM + kt * 64; ldd = DM; return; } r -= 1024;
    const int l = r / CVT_L, rr = r % CVT_L, kind = rr / 8192, q = rr % 8192, le = l * 16 + q / 512, rem = q % 512;
    if (kind < 2) { const int kt = ((rem >> 3) / 16) * 8 + (rem & 7), nt = (rem >> 3) % 16, n0 = nt * 64;
        src = (kind ? P.wu : P.wg) + (size_t)le * DM * DFF + (size_t)(kt * 64) * DFF + n0; ldw = DFF;
        dst = P.WGU + (size_t)(le * 2048 + (n0 >> 7) * 256 + kind * 128 + (n0 & 127)) * DM + kt * 64; ldd = DM; }
    else { const int kt = ((rem >> 3) / 32) * 8 + (rem & 7), nt = (rem >> 3) % 32;
        src = P.wd + (size_t)le * DFF * DM + (size_t)(kt * 64) * DM + nt * 64; ldw = DM; dst = P.WDN + (size_t)(le * 2048 + nt * 64) * DFF + kt * 64; ldd = DFF; }
}
constexpr int CVT_P = 36;
DI void cvt_range(const CvtPtrs& P, int lo, int hi, int w, int NW, LAS unsigned* scr, int lane) {
    int it = lo + w; if (it >= hi) return;
    const int c = lane & 15, q = lane >> 4;
    const float* src; int ldw; bf16_t* dst; int ldd; bool qperm; cvt_resolve(P, it, src, ldw, dst, ldd, qperm);
    f32x4 v[16];
#pragma unroll
    for (int rr = 0; rr < 16; ++rr) v[rr] = __builtin_nontemporal_load((const f32x4*)(src + (size_t)(16 * q + rr) * ldw + 4 * c));
    for (;;) {
        u32x4 pa[4], pb[4];
#pragma unroll
        for (int i = 0; i < 4; ++i) { pa[i].x = pk2(v[0][i], v[1][i]); pa[i].y = pk2(v[2][i], v[3][i]); pa[i].z = pk2(v[4][i], v[5][i]); pa[i].w = pk2(v[6][i], v[7][i]);
                                      pb[i].x = pk2(v[8][i], v[9][i]); pb[i].y = pk2(v[10][i], v[11][i]); pb[i].z = pk2(v[12][i], v[13][i]); pb[i].w = pk2(v[14][i], v[15][i]); }
        const int nit = it + NW; bf16_t* cdst = dst; const int cldd = ldd; const int wrow = qperm ? 32 * ((c >> 2) & 1) + 8 * (c & 3) + 4 * (c >> 3) : 4 * c;
        if (nit < hi) { cvt_resolve(P, nit, src, ldw, dst, ldd, qperm);
#pragma unroll
            for (int rr = 0; rr < 16; ++rr) v[rr] = __builtin_nontemporal_load((const f32x4*)(src + (size_t)(16 * q + rr) * ldw + 4 * c)); }
#pragma unroll
        for (int i = 0; i < 4; ++i) { *(LAS u32x4*)(scr + (wrow + i) * CVT_P + 8 * q) = pa[i]; *(LAS u32x4*)(scr + (wrow + i) * CVT_P + 8 * q + 4) = pb[i]; }
        LDS_WAIT(); asm volatile("" ::: "memory");
#pragma unroll
        for (int j = 0; j < 8; ++j) { const int n = (lane >> 3) + 8 * j; const u32x4 o = *(const LAS u32x4*)(scr + n * CVT_P + 4 * (lane & 7));
            *(u32x4*)(cdst + (size_t)n * cldd + 8 * (lane & 7)) = o; }
        LDS_WAIT(); asm volatile("" ::: "memory");
        if (nit >= hi) break;
        it = nit;
    }
}
DI void ph_modred(const float* modp, const float* ada_b, float* mod, int gtid, int GT) {
    for (int i = gtid; i < 2 * 9 * NMOD; i += GT) { const int l = i / (9 * NMOD), j = i % NMOD; float s = ada_b[l * NMOD + j];
#pragma unroll
        for (int ks = 0; ks < KSPLIT; ++ks) s += modp[(size_t)ks * (2 * 9 * NMOD) + i];
        mod[i] = s; }
}
DI void row_load(const float* p, f32x4 (&v)[8], int lane) {
#pragma unroll
    for (int j = 0; j < 8; ++j) v[j] = *(const f32x4*)(p + 4 * lane + 256 * j);
}
DI void row_load_bf(const bf16_t* p, f32x4 (&v)[8], int lane) {
#pragma unroll
    for (int j = 0; j < 8; ++j) { const u32x2 w = *(const u32x2*)(p + 4 * lane + 256 * j); v[j] = (f32x4){bf_lo(w.x), bf_hi(w.x), bf_lo(w.y), bf_hi(w.y)}; }
}
DI void row_modulate(const f32x4 (&v)[8], f32x4 (&y)[8], const float* gain, const float* shift, const float* scale, int lane) {
    float ss = 0.f;
#pragma unroll
    for (int j = 0; j < 8; ++j) ss += (v[j][0] * v[j][0] + v[j][1] * v[j][1]) + (v[j][2] * v[j][2] + v[j][3] * v[j][3]);
    ss = wave_sum(ss);
    const float rstd = 1.0f / sqrtf(ss * (1.0f / DM) + NORM_EPS);
#pragma unroll
    for (int j = 0; j < 8; ++j) { const int c = 4 * lane + 256 * j; const f32x4 g = *(const f32x4*)(gain + c), sh = *(const f32x4*)(shift + c), sc = *(const f32x4*)(scale + c);
        y[j] = ((v[j] * rstd) * g) * (sc + 1.0f) + sh; }
}
DI void row_modulate2(const f32x4 (&v0)[8], const f32x4 (&v1)[8], f32x4 (&y0)[8], f32x4 (&y1)[8], const float* gain, const float* shift, const float* scale, int lane) {
    float s0 = 0.f, s1 = 0.f;
#pragma unroll
    for (int j = 0; j < 8; ++j) { s0 += (v0[j][0] * v0[j][0] + v0[j][1] * v0[j][1]) + (v0[j][2] * v0[j][2] + v0[j][3] * v0[j][3]); s1 += (v1[j][0] * v1[j][0] + v1[j][1] * v1[j][1]) + (v1[j][2] * v1[j][2] + v1[j][3] * v1[j][3]); }
    s0 = wave_sum(s0); s1 = wave_sum(s1);
    const float r0 = 1.0f / sqrtf(s0 * (1.0f / DM) + NORM_EPS), r1 = 1.0f / sqrtf(s1 * (1.0f / DM) + NORM_EPS);
#pragma unroll
    for (int j = 0; j < 8; ++j) { const int c = 4 * lane + 256 * j; const f32x4 g = *(const f32x4*)(gain + c), sh = *(const f32x4*)(shift + c), sc = *(const f32x4*)(scale + c);
        y0[j] = ((v0[j] * r0) * g) * (sc + 1.0f) + sh; y1[j] = ((v1[j] * r1) * g) * (sc + 1.0f) + sh; }
}
DI void row_store_bf16(bf16_t* p, const f32x4 (&y)[8], int lane) {
#pragma unroll
    for (int j = 0; j < 8; ++j) { u32x2 w; w.x = pk2(y[j][0], y[j][1]); w.y = pk2(y[j][2], y[j][3]); *(u32x2*)(p + 4 * lane + 256 * j) = w; }
}
DI void ph_mod0(const float* x, const float* ctx, const float* gain, const float* mod0, bf16_t* A, int gw, int NGW, int lane) {
    for (int row = gw; row < MT; row += NGW) {
        const int cr = row < ML ? (row >> 11) : 8; const float* src = row < ML ? x + (size_t)row * DM : ctx + (size_t)(row - ML) * DM;
        f32x4 v[8], y[8]; row_load(src, v, lane);
        row_modulate(v, y, gain, mod0 + (size_t)cr * NMOD + 0 * DM, mod0 + (size_t)cr * NMOD + 1 * DM, lane);
        row_store_bf16(A + (size_t)row * DM, y, lane);
    }
}
DI float reduce8(const float (&v)[8], int lane) {
    const bool u0 = lane & 1, u1 = lane & 2, u2 = lane & 4;
    float a[4], b2[2];
#pragma unroll
    for (int k = 0; k < 4; ++k) { const float lo = v[2 * k], hi = v[2 * k + 1]; a[k] = (u0 ? hi : lo) + __shfl_xor(u0 ? lo : hi, 1); }
#pragma unroll
    for (int k = 0; k < 2; ++k) { const float lo = a[2 * k], hi = a[2 * k + 1]; b2[k] = (u1 ? hi : lo) + __shfl_xor(u1 ? lo : hi, 2); }
    return (u2 ? b2[1] : b2[0]) + __shfl_xor(u2 ? b2[0] : b2[1], 4);
}
DI float reduce_halves(float lo8, float hi8, int lane) {
    const bool u3 = lane & 8;
    float t = (u3 ? hi8 : lo8) + __shfl_xor(u3 ? lo8 : hi8, 8);
    t += __shfl_xor(t, 16); t += __shfl_xor(t, 32); return t;
}
DI float softmax16(float lg) {
    float mx = lg;
#pragma unroll
    for (int o = 1; o < 16; o <<= 1) mx = fmaxf(mx, __shfl_xor(mx, o));
    const float ex = __expf(lg - mx); float den = ex;
#pragma unroll
    for (int o = 1; o < 16; o <<= 1) den += __shfl_xor(den, o);
    return ex / den;
}
DI void aff_store(float v, float* affL, float* affC, int row, int lane) {
    if (lane < 16) { if (row < ML) { const int b = row >> 11, n = row & 2047; affL[(size_t)(b * 16 + lane) * SEQ + n] = v; }
                     else { const int rc = row - ML, b = rc >> 8, n = rc & 255; affC[(size_t)(b * 16 + lane) * CTXL + n] = v; } }
}
DI void router_rows2(const f32x4 (&y0)[8], const f32x4 (&y1)[8], const LAS float* rwT, float* affL, float* affC, int row0, int lane) {
    float r0[2], r1[2];
#pragma unroll
    for (int hf = 0; hf < 2; ++hf) {
        float l0[8], l1[8];
#pragma unroll
        for (int e = 0; e < 8; ++e) { float s0 = 0.f, s1 = 0.f;
#pragma unroll
            for (int j = 0; j < 8; ++j) { const f32x4 w = *(const LAS f32x4*)(rwT + (8 * hf + e) * DM + 4 * lane + 256 * j);
                s0 += (y0[j][0] * w[0] + y0[j][1] * w[1]) + (y0[j][2] * w[2] + y0[j][3] * w[3]); s1 += (y1[j][0] * w[0] + y1[j][1] * w[1]) + (y1[j][2] * w[2] + y1[j][3] * w[3]); }
            l0[e] = s0; l1[e] = s1; __builtin_amdgcn_sched_barrier(0); }
        r0[hf] = reduce8(l0, lane); r1[hf] = reduce8(l1, lane);
    }
    const float a0 = softmax16(reduce_halves(r0[0], r0[1], lane)), a1 = softmax16(reduce_halves(r1[0], r1[1], lane));
    aff_store(a0, affL, affC, row0, lane); aff_store(a1, affL, affC, row0 + 1, lane);
}
DI void load_router(const float* rw, LAS float* rwT, int tid) {
    for (int i = tid; i < DM * 16; i += 512) rwT[(i & 15) * DM + (i >> 4)] = rw[i];
    __syncthreads();
}
DI void ph_modffn(const bf16_t* H, const float* gain, const float* modl, bf16_t* A, const LAS float* rwT, float* affL, float* affC, int nrows, int gw, int NGW, int lane) {
    for (int rp = gw; rp < nrows / 2; rp += NGW) {
        const int row = 2 * rp; const int cr = row < ML ? (row >> 11) : 8;
        u32x2 p0[8], p1[8];
#pragma unroll
        for (int j = 0; j < 8; ++j) { p0[j] = *(const u32x2*)(H + (size_t)row * DM + 4 * lane + 256 * j); p1[j] = *(const u32x2*)(H + (size_t)(row + 1) * DM + 4 * lane + 256 * j); }
        float s0 = 0.f, s1 = 0.f;
#pragma unroll
        for (int j = 0; j < 8; ++j) { const float a0 = bf_lo(p0[j].x), a1 = bf_hi(p0[j].x), a2 = bf_lo(p0[j].y), a3 = bf_hi(p0[j].y); s0 += (a0 * a0 + a1 * a1) + (a2 * a2 + a3 * a3);
                                      const float b0 = bf_lo(p1[j].x), b1 = bf_hi(p1[j].x), b2 = bf_lo(p1[j].y), b3 = bf_hi(p1[j].y); s1 += (b0 * b0 + b1 * b1) + (b2 * b2 + b3 * b3); }
        s0 = wave_sum(s0); s1 = wave_sum(s1);
        const float r0 = 1.0f / sqrtf(s0 * (1.0f / DM) + NORM_EPS), r1 = 1.0f / sqrtf(s1 * (1.0f / DM) + NORM_EPS);
        const float* shift = modl + (size_t)cr * NMOD + 3 * DM; const float* scale = modl + (size_t)cr * NMOD + 4 * DM;
        f32x4 y0[8], y1[8];
#pragma unroll
        for (int j = 0; j < 8; ++j) { const int c = 4 * lane + 256 * j; const f32x4 g = *(const f32x4*)(gain + c), sh = *(const f32x4*)(shift + c), sc = *(const f32x4*)(scale + c);
            const f32x4 v0 = (f32x4){bf_lo(p0[j].x), bf_hi(p0[j].x), bf_lo(p0[j].y), bf_hi(p0[j].y)}, v1 = (f32x4){bf_lo(p1[j].x), bf_hi(p1[j].x), bf_lo(p1[j].y), bf_hi(p1[j].y)};
            y0[j] = ((v0 * r0) * g) * (sc + 1.0f) + sh; y1[j] = ((v1 * r1) * g) * (sc + 1.0f) + sh;
            u32x2 w0, w1; w0.x = pk2(y0[j][0], y0[j][1]); w0.y = pk2(y0[j][2], y0[j][3]); w1.x = pk2(y1[j][0], y1[j][1]); w1.y = pk2(y1[j][2], y1[j][3]);
            *(u32x2*)(A + (size_t)row * DM + c) = w0; *(u32x2*)(A + (size_t)(row + 1) * DM + c) = w1; }
        asm volatile("" ::: "memory");
        router_rows2(y0, y1, rwT, affL, affC, row, lane);
    }
}
DI void ph_topk(int nitems, const float* affL, const float* affC, int* rowsrc, float* gatev, int* inv, LAS unsigned* hist, int tid, int lane, int wave, int bid, int G) {
    LAS unsigned* sh = hist + 256;
    for (int it = bid; it < nitems; it += G) {
        const bool isc = it >= 128; const int be = it & 127, b = be >> 4, e = be & 15;
        const int N = isc ? CTXL : SEQ, C = isc ? CAPC : CAPL;
        const float* src = isc ? affC + (size_t)be * CTXL : affL + (size_t)be * SEQ;
        const int i0 = tid * 4; const bool valid = i0 < N;
        unsigned key[4];
        { f32x4 v = (f32x4){0.f, 0.f, 0.f, 0.f}; if (valid) v = *(const f32x4*)(src + i0);
#pragma unroll
          for (int q = 0; q < 4; ++q) key[q] = __float_as_uint(v[q]); }
        unsigned prefix = 0u, mask = 0u, krem = (unsigned)C;
        for (int pass = 3; pass >= 0; --pass) {
            const int shift = pass * 8;
            if (tid < 256) hist[tid] = 0u;
            __syncthreads();
            if (valid) {
#pragma unroll
                for (int q = 0; q < 4; ++q) if ((key[q] & mask) == prefix) __hip_atomic_fetch_add(&hist[(key[q] >> shift) & 255u], 1u, __ATOMIC_RELAXED, __HIP_MEMORY_SCOPE_WORKGROUP); }
            __syncthreads();
            if (wave == 0) {
                const unsigned h0 = hist[4 * lane], h1 = hist[4 * lane + 1], h2 = hist[4 * lane + 2], h3 = hist[4 * lane + 3];
                const unsigned tot = h0 + h1 + h2 + h3; unsigned incl = tot;
#pragma unroll
                for (int o = 1; o < 64; o <<= 1) { const unsigned t = __shfl_down(incl, o); if (lane + o < 64) incl += t; }
                const unsigned a3 = incl - tot, a2 = a3 + h3, a1 = a2 + h2, a0 = a1 + h1;
                if (a3 < krem && krem <= a3 + h3) { sh[0] = 4 * lane + 3; sh[1] = krem - a3; }
                if (a2 < krem && krem <= a2 + h2) { sh[0] = 4 * lane + 2; sh[1] = krem - a2; }
                if (a1 < krem && krem <= a1 + h1) { sh[0] = 4 * lane + 1; sh[1] = krem - a1; }
                if (a0 < krem && krem <= a0 + h0) { sh[0] = 4 * lane + 0; sh[1] = krem - a0; }
            }
            __syncthreads();
            const unsigned B = sh[0]; krem = sh[1]; prefix |= B << shift; mask |= 0xFFu << shift;
        }
        const unsigned T = prefix;
        unsigned cg = 0u, ce = 0u;
        if (valid) {
#pragma unroll
            for (int q = 0; q < 4; ++q) { cg += key[q] > T ? 1u : 0u; ce += key[q] == T ? 1u : 0u; } }
        const unsigned mine = cg | (ce << 16); unsigned incl = mine;
#pragma unroll
        for (int o = 1; o < 64; o <<= 1) { const unsigned t = __shfl_up(incl, o); if (lane >= o) incl += t; }
        if (lane == 63) sh[8 + wave] = incl;
        __syncthreads();
        unsigned woff = 0u;
#pragma unroll
        for (int w = 0; w < 8; ++w) woff += (w < wave) ? sh[8 + w] : 0u;
        const unsigned excl = woff + incl - mine; unsigned gtb = excl & 0xFFFFu, eqb = excl >> 16;
        if (valid) {
            const int ybase = e * YR + (isc ? NB * CAPL + b * CAPC : b * CAPL); const int rbase = isc ? ML + b * CTXL : b * SEQ;
#pragma unroll
            for (int q = 0; q < 4; ++q) {
                const bool isg = key[q] > T, ise = key[q] == T; const bool sel = isg || (ise && eqb < krem);
                const unsigned slot = gtb + (eqb < krem ? eqb : krem);
                const int trow = rbase + i0 + q; const int yrow = ybase + (int)slot;
                if (sel) { rowsrc[yrow] = trow; gatev[yrow] = __uint_as_float(key[q]); }
                inv[(size_t)trow * 16 + e] = sel ? yrow : -1;
                gtb += isg ? 1u : 0u; eqb += ise ? 1u : 0u;
            }
        }
        __syncthreads();
    }
}
DI void ph_gather(const bf16_t* A, const int* rowsrc, bf16_t* XS, bool with_ctx, int gw, int NGW, int lane) {
    for (int yr = gw; yr < YT; yr += NGW) {
        if (!with_ctx && (yr % YR) >= NB * CAPL) continue;
        const int src = rowsrc[yr];
        const u32x4* s = (const u32x4*)(A + (size_t)src * DM); u32x4* d = (u32x4*)(XS + (size_t)yr * DM);
#pragma unroll
        for (int j = 0; j < 4; ++j) d[lane + 64 * j] = s[lane + 64 * j];
    }
}
template <bool LAST> DI void ph_combine(bf16_t* H, const bf16_t* Y, const int* inv, const float* modl  , const float* gain1, const float* mod1, bf16_t* A, float* out, int nrows, int gw, int NGW, int lane) {
    for (int row = gw; row < nrows; row += NGW) {
        const int cr = row < ML ? (row >> 11) : 8;
        f32x4 v[8], acc[8]; row_load_bf(H + (size_t)row * DM, v, lane);
#pragma unroll
        for (int j = 0; j < 8; ++j) acc[j] = (f32x4){0.f, 0.f, 0.f, 0.f};
        const int myinv = inv[(size_t)row * 16 + (lane & 15)];
        for (int e = 0; e < 16; ++e) {
            const int yr = __builtin_amdgcn_readlane(myinv, e);
            if (yr >= 0) { const bf16_t* yp = Y + (size_t)yr * DM + 4 * lane;
#pragma unroll
                for (int j = 0; j < 8; ++j) { const u32x2 p = *(const u32x2*)(yp + 256 * j); acc[j][0] += bf_lo(p.x); acc[j][1] += bf_hi(p.x); acc[j][2] += bf_lo(p.y); acc[j][3] += bf_hi(p.y); } }
        }
        const float* g2 = modl + (size_t)cr * NMOD + 5 * DM;
#pragma unroll
        for (int j = 0; j < 8; ++j) { const f32x4 g = *(const f32x4*)(g2 + 4 * lane + 256 * j); v[j] = v[j] + g * acc[j]; }
        if (LAST) {
#pragma unroll
            for (int j = 0; j < 8; ++j) *(f32x4*)(out + (size_t)row * DM + 4 * lane + 256 * j) = v[j];
        } else {
            row_store_bf16(H + (size_t)row * DM, v, lane);
            f32x4 y[8]; row_modulate(v, y, gain1, mod1 + (size_t)cr * NMOD + 0 * DM, mod1 + (size_t)cr * NMOD + 1 * DM, lane);
            row_store_bf16(A + (size_t)row * DM, y, lane);
        }
    }
}
DI void ph_qknorm(bf16_t* Q, bf16_t* K, const float* qg, const float* kg, int gw, int NGW, int lane) {
    const int half = lane >> 5, i = lane & 31, d1 = half * 64 + i, d2 = d1 + 32;
    const float inv_freq = exp2f(-(float)i * (13.287712379549449f / 32.0f));
    constexpr float QSCALE = 0.08838834764831845f * 1.4426950408889634f;
    const float qg1 = qg[d1] * QSCALE, qg2 = qg[d2] * QSCALE, kg1 = kg[d1], kg2 = kg[d2];
    for (int row = gw; row < MT; row += NGW) {
        const bool lat = row < ML; const int t = row & (SEQ - 1);
        const float pos = (float)(half == 0 ? (t >> 6) : (t & 63)); const float ang = pos * inv_freq;
        const float cs = lat ? __cosf(ang) : 1.0f, sn = lat ? __sinf(ang) : 0.0f;
        if (lat) {
            for (int hd = 0; hd < NH; ++hd) { bf16_t* p = Q + (size_t)row * DM + hd * HD;
                float x1 = __uint_as_float((unsigned)p[d1] << 16), x2 = __uint_as_float((unsigned)p[d2] << 16);
                const float ss = wave_sum(x1 * x1 + x2 * x2); const float rstd = 1.0f / sqrtf(ss * (1.0f / HD) + NORM_EPS);
                x1 = x1 * rstd * qg1; x2 = x2 * rstd * qg2;
                const float o1 = x1 * cs - x2 * sn, o2 = x2 * cs + x1 * sn;
                const unsigned w = pk2(o1, o2); p[d1] = (bf16_t)(w & 0xffffu); p[d2] = (bf16_t)(w >> 16); }
        }
        for (int kh = 0; kh < NKV; ++kh) { bf16_t* p = K + (size_t)row * 512 + kh * HD;
            float x1 = __uint_as_float((unsigned)p[d1] << 16), x2 = __uint_as_float((unsigned)p[d2] << 16);
            const float ss = wave_sum(x1 * x1 + x2 * x2); const float rstd = 1.0f / sqrtf(ss * (1.0f / HD) + NORM_EPS);
            x1 = x1 * rstd * kg1; x2 = x2 * rstd * kg2;
            const float o1 = x1 * cs - x2 * sn, o2 = x2 * cs + x1 * sn;
            const unsigned w = pk2(o1, o2); p[d1] = (bf16_t)(w & 0xffffu); p[d2] = (bf16_t)(w >> 16); }
    }
}
constexpr int KP = 272;
constexpr int ATT_VOFF = 64 * KP;
constexpr int ATT_TILE = 2 * 64 * KP;
DI int crow(int reg, int h) { return (reg & 3) + 8 * (reg >> 2) + 4 * h; }
DI long long vtr64(const LAS unsigned char* p) { typedef short v4i16_t __attribute__((ext_vector_type(4))); return __builtin_bit_cast(long long, __builtin_amdgcn_ds_read_tr16_b64_v4i16((LAS v4i16_t*)p)); }
DI s16x4 vtr(const LAS unsigned char* p) { typedef short v4i16_t __attribute__((ext_vector_type(4))); return __builtin_bit_cast(s16x4, __builtin_amdgcn_ds_read_tr16_b64_v4i16((LAS v4i16_t*)p)); }
DI bool att_tile_info(int item, int ti, int& base, int& mtype) {
    const int qhalf = item & 1, n = (item >> 3) & 15, b = item >> 7, tt = ti & 1; mtype = 0;
    if (ti < 4) { base = ML + b * CTXL + 64 * ti; return true; }
    const int blk = n - 1 + ((ti - 4) >> 1); if (blk < 0 || blk > 15) return false;
    if (ti < 6) { mtype = 1; if (tt == 0 && qhalf == 1) return false; } else if (ti >= 8) { mtype = 2; if (tt == 1 && qhalf == 0) return false; }
    base = b * SEQ + blk * 128 + 64 * tt; return true;
}
DI void att_next(int& item, int& ti, int G) { for (;;) { ++ti; if (ti >= 10) { ti = 0; item += G; return; } int b_, m_; if (att_tile_info(item, ti, b_, m_)) return; } }
DI void ph_attn(const bf16_t* Q, const bf16_t* Kb, const bf16_t* Vb, bf16_t* O, const float* sink, LAS unsigned char* lds, int tid, int lane, int wave, int bid, int G) {
    constexpr float LOG2E = 1.4426950408889634f;
    const int r = lane & 31, h = lane >> 5, g = wave >> 1, sub = wave & 1;
    const int ldrow = tid >> 3, ldc = tid & 7;
    int item = bid, ti = 0; if (item >= 1024) return;
    u32x4 kr[2], vr[2];
#define ATT_ISSUE(it_, ti_) do { int base_, mt_; att_tile_info(it_, ti_, base_, mt_); const int kvh_ = ((it_) >> 1) & 3; \
        _Pragma("unroll") for (int c2 = 0; c2 < 2; ++c2) { const size_t off_ = (size_t)(base_ + ldrow) * 512 + kvh_ * HD + (ldc + 8 * c2) * 8; kr[c2] = *(const u32x4*)(Kb + off_); vr[c2] = *(const u32x4*)(Vb + off_); } } while (0)
    bf16x8 qf[8]; float m2 = 0.f, lsum = 1.f; f32x16 o[4]; f32x16 negm;
#define ATT_QLOAD(it_) do { const int qrow_ = ((it_) >> 7) * SEQ + (((it_) >> 3) & 15) * 128 + ((it_) & 1) * 64 + sub * 32 + r; const int head_ = (((it_) >> 1) & 3) * 4 + g; \
        _Pragma("unroll") for (int s = 0; s < 8; ++s) qf[s] = *(const bf16x8*)(Q + (size_t)qrow_ * DM + head_ * HD + 16 * s + 8 * h); } while (0)
    ATT_QLOAD(item);
    ATT_ISSUE(item, ti);
    int buf = 0;
    while (item < 1024) {
        int nitem = item, nti = ti; att_next(nitem, nti, G);
        LAS unsigned char* tb = lds + buf * ATT_TILE;
#pragma unroll
        for (int c2 = 0; c2 < 2; ++c2) { *(LAS u32x4*)(tb + ldrow * KP + (ldc + 8 * c2) * 16) = kr[c2]; *(LAS u32x4*)(tb + ATT_VOFF + ldrow * KP + (ldc + 8 * c2) * 16) = vr[c2]; }
        if (nitem < 1024) ATT_ISSUE(nitem, nti);
        asm volatile("s_waitcnt lgkmcnt(0)" ::: "memory"); __builtin_amdgcn_s_barrier(); asm volatile("" ::: "memory");
        int base, mtype; att_tile_info(item, ti, base, mtype); const int tt = ti & 1;
        const int qhalf = item & 1, kvh = (item >> 1) & 3, n = (item >> 3) & 15, b = item >> 7;
        const int head = kvh * 4 + g, qq = qhalf * 64 + sub * 32 + r; const int qrow = b * SEQ + n * 128 + qq;
        if (ti == 0) {
            m2 = sink[head] * LOG2E; lsum = 1.0f;
#pragma unroll
            for (int i = 0; i < 16; ++i) negm[i] = -m2;
#pragma unroll
            for (int d = 0; d < 4; ++d)
#pragma unroll
                for (int i = 0; i < 16; ++i) o[d][i] = 0.f;
        }
        f32x16 x0, x1;
#pragma unroll
        for (int s = 0; s < 8; ++s) {
            const bf16x8 k0 = *(const LAS bf16x8*)(tb + r * KP + (16 * s + 8 * h) * 2), k1 = *(const LAS bf16x8*)(tb + (32 + r) * KP + (16 * s + 8 * h) * 2);
            if (s == 0) { x0 = __builtin_amdgcn_mfma_f32_32x32x16_bf16(k0, qf[s], negm, 0, 0, 0); x1 = __builtin_amdgcn_mfma_f32_32x32x16_bf16(k1, qf[s], negm, 0, 0, 0); }
            else { x0 = __builtin_amdgcn_mfma_f32_32x32x16_bf16(k0, qf[s], x0, 0, 0, 0); x1 = __builtin_amdgcn_mfma_f32_32x32x16_bf16(k1, qf[s], x1, 0, 0, 0); } }
        if (nitem != item && nitem < 1024) ATT_QLOAD(nitem);
        if (mtype == 1) {
#pragma unroll
            for (int i = 0; i < 16; ++i) { const int kk0 = tt * 64 + crow(i, h); if (kk0 < qq) x0[i] = -1.0e30f; if (kk0 + 32 < qq) x1[i] = -1.0e30f; } }
        if (mtype == 2) {
#pragma unroll
            for (int i = 0; i < 16; ++i) { const int kk0 = tt * 64 + crow(i, h); if (kk0 > qq) x0[i] = -1.0e30f; if (kk0 + 32 > qq) x1[i] = -1.0e30f; } }
        float tmax = fmaxf(x0[0], x1[0]);
#pragma unroll
        for (int i = 1; i < 16; ++i) tmax = fmaxf(fmaxf(tmax, x0[i]), x1[i]);
        tmax = fmaxf(tmax, __shfl_xor(tmax, 32));
        if (__any(tmax > 0.0f)) {
            const float dl = fmaxf(tmax, 0.0f), alpha = __builtin_amdgcn_exp2f(-dl); m2 += dl; lsum *= alpha;
#pragma unroll
            for (int i = 0; i < 16; ++i) { x0[i] -= dl; x1[i] -= dl; negm[i] = -m2; }
#pragma unroll
            for (int d = 0; d < 4; ++d)
#pragma unroll
                for (int i = 0; i < 16; ++i) o[d][i] *= alpha;
        }
        float ps = 0.f;
#pragma unroll
        for (int i = 0; i < 16; ++i) { x0[i] = __builtin_amdgcn_exp2f(x0[i]); x1[i] = __builtin_amdgcn_exp2f(x1[i]); ps += x0[i] + x1[i]; }
        ps += __shfl_xor(ps, 32); lsum += ps;
        bf16x8 pf[2][2];
#pragma unroll
        for (int s = 0; s < 2; ++s) {
            u32x4 a, c; a.x = pk2(x0[8 * s + 0], x0[8 * s + 1]); a.y = pk2(x0[8 * s + 2], x0[8 * s + 3]); a.z = pk2(x0[8 * s + 4], x0[8 * s + 5]); a.w = pk2(x0[8 * s + 6], x0[8 * s + 7]);
            c.x = pk2(x1[8 * s + 0], x1[8 * s + 1]); c.y = pk2(x1[8 * s + 2], x1[8 * s + 3]); c.z = pk2(x1[8 * s + 4], x1[8 * s + 5]); c.w = pk2(x1[8 * s + 6], x1[8 * s + 7]);
            pf[0][s] = __builtin_bit_cast(bf16x8, a); pf[1][s] = __builtin_bit_cast(bf16x8, c); }
        const LAS unsigned char* vb = tb + ATT_VOFF + (4 * h + ((lane & 15) >> 2)) * KP + (16 * ((lane >> 4) & 1) + 4 * (lane & 3)) * 2;
#pragma unroll
        for (int d = 0; d < 4; ++d)
#pragma unroll
            for (int t = 0; t < 2; ++t)
#pragma unroll
                for (int s = 0; s < 2; ++s) {
                    typedef long long i64x2_t __attribute__((ext_vector_type(2)));
                    i64x2_t vv; vv.x = vtr64(vb + (t * 32 + 16 * s) * KP + d * 64); vv.y = vtr64(vb + (t * 32 + 16 * s + 8) * KP + d * 64);
                    const bf16x8 vf = __builtin_bit_cast(bf16x8, vv);
                    o[d] = __builtin_amdgcn_mfma_f32_32x32x16_bf16(vf, pf[t][s], o[d], 0, 0, 0); }
        if (nitem != item) {
            const float il = 1.0f / lsum;
            bf16_t* op = O + (size_t)qrow * DM + head * HD + 4 * h;
#pragma unroll
            for (int d = 0; d < 4; ++d)
#pragma unroll
                for (int g4 = 0; g4 < 4; ++g4) { u32x2 w; w.x = pk2(o[d][4 * g4 + 0] * il, o[d][4 * g4 + 1] * il); w.y = pk2(o[d][4 * g4 + 2] * il, o[d][4 * g4 + 3] * il);
                    *(u32x2*)(op + d * 32 + 8 * g4) = w; }
        }
        item = nitem; ti = nti; buf ^= 1;
    }
#undef ATT_ISSUE
#undef ATT_QLOAD
}

#ifndef MK_ONE_LAUNCH
#define MK_ONE_LAUNCH 1
#endif
constexpr int NPHASE = 19;
#ifndef MK_CVT_JIT
#define MK_CVT_JIT 1
#endif
#ifndef MK_CVT_Q
#define MK_CVT_Q 0
#endif
constexpr int CVT_Q = MK_CVT_Q;
constexpr int CVT_X0_END = CVT_E0 + CVT_L;
constexpr int CVT_R3_LO = CVT_X0_END - 3 * CVT_Q, CVT_R4_LO = CVT_X0_END - 2 * CVT_Q, CVT_R5_LO = CVT_X0_END - CVT_Q;
constexpr int CVT_R9_LO = CVT_TOTAL - 5 * CVT_Q / 2, CVT_R10_LO = CVT_TOTAL - 3 * CVT_Q / 2, CVT_R12_LO = CVT_TOTAL - CVT_Q;
static_assert(CVT_Q <= 8192 && CVT_Q % 2 == 0, "tail quota");
#define CVT_MKCP() CvtPtrs CP; CP.cin = args.in[8]; CP.cout = args.in[10]; CP.wqkv = args.in[11]; CP.wo = args.in[15]; CP.wg = args.in[17]; CP.wu = args.in[18]; CP.wd = args.in[19]; \
    CP.W1A = W1A; CP.W1B = W1B; CP.W2 = W2; CP.WQKV = WQKV; CP.WO = WOt; CP.WGU = WGU; CP.WDN = WDN
#define CVT_TAIL(NWG, LO, HI) do { if ((LO) < (HI)) { CVT_MKCP(); const int busy_ = (NWG) % G; if (busy_ == 0) cvt_range(CP, LO, HI, gw, NGW, cscr, lane); else if (bid >= busy_) cvt_range(CP, LO, HI, (bid - busy_) * 8 + wave, (G - busy_) * 8, cscr, lane); } } while (0)
#ifndef MK_DUP_MASK
#define MK_DUP_MASK 0u
#endif
constexpr unsigned DUP_MASK = MK_DUP_MASK;
struct Args { const float* in[20]; float* out; unsigned char* ws; int ph_lo, ph_hi; };
__global__ void __launch_bounds__(512, 2) dit_fwd(Args args) {
    extern __shared__ __attribute__((aligned(16))) unsigned char lds_raw[];
    LAS unsigned char* lds = (LAS unsigned char*)lds_raw;
    const int tid = threadIdx.x, lane = tid & 63, wave = __builtin_amdgcn_readfirstlane(tid >> 6);
    const int G = gridDim.x, bid = blockIdx.x;
    const int gw = bid * 8 + wave, NGW = G * 8;
    unsigned char* ws = args.ws;
    const float* x = args.in[0]; const float* cnd = args.in[1]; const float* ctx = args.in[2]; const float* cctx = args.in[3];
    const float* ada_w = args.in[4]; const float* ada_b = args.in[5]; const float* nmix = args.in[6]; const float* nffn = args.in[7];
    const float* conv_w = args.in[9]; const float* qgain = args.in[12]; const float* kgain = args.in[13]; const float* sink = args.in[14]; const float* router_w = args.in[16];
    float* mod = (float*)(ws + WS_MOD); float* modp = (float*)(ws + WS_MODP);
    float* affL = (float*)(ws + WS_AFFL); float* affC = (float*)(ws + WS_AFFC);
    int* rowsrc = (int*)(ws + WS_ROWSRC); float* gatev = (float*)(ws + WS_GATEV); int* inv = (int*)(ws + WS_INV);
    bf16_t* W1A = (bf16_t*)(ws + WS_W1A); bf16_t* W1B = (bf16_t*)(ws + WS_W1B); bf16_t* W2 = (bf16_t*)(ws + WS_W2); bf16_t* WQKV = (bf16_t*)(ws + WS_WQKV); bf16_t* WOt = (bf16_t*)(ws + WS_WO);
    bf16_t* WGU = (bf16_t*)(ws + WS_WGU); bf16_t* WDN = (bf16_t*)(ws + WS_WDN);
    bf16_t* H = (bf16_t*)(ws + WS_H); bf16_t* A = (bf16_t*)(ws + WS_A); bf16_t* U = (bf16_t*)(ws + WS_U); bf16_t* Z = (bf16_t*)(ws + WS_Z);
    bf16_t* Qb = (bf16_t*)(ws + WS_Q); bf16_t* Kb = (bf16_t*)(ws + WS_K); bf16_t* Vb = (bf16_t*)(ws + WS_V); bf16_t* Ob = (bf16_t*)(ws + WS_O);
    bf16_t* HM = (bf16_t*)(ws + WS_HM); bf16_t* Y = (bf16_t*)(ws + WS_Y); bf16_t* XS = (bf16_t*)(ws + WS_XS);
    LAS unsigned* cscr = (LAS unsigned*)(lds + wave * 9216);

    for (int u = tid; u < (LDS_BYTES - MISC_OFF) / 4; u += 512) ((LAS unsigned*)(lds + MISC_OFF))[u] = 0u;
    __syncthreads();
#if MK_ONE_LAUNCH
    XcdBarrier bar = xcd_barrier_post((unsigned*)(ws + WS_CTL) + CW_BAR, (volatile LAS unsigned*)(lds + MISC_OFF) + 8);
#define GRID_BAR() xcd_barrier(bar)
#else
#define GRID_BAR() do {} while (0)
#endif
    const int lo = args.ph_lo, hi = args.ph_hi;
#define IN(k) (lo <= (k) && (k) < hi)
#define SEAM(k) do { if (IN(k) && IN((k) + 1)) GRID_BAR(); } while (0)

    if (IN(0)) _Pragma("unroll") for (int rep_ = 0; rep_ < 1 + (int)((DUP_MASK >> 0) & 1u); ++rep_) { if (rep_) GRID_BAR();
        ph_adaln(cnd, cctx, ada_w, modp, gw, NGW, lane);
        CVT_MKCP();
#if MK_CVT_JIT
        cvt_range(CP, 0, CVT_E0, gw, NGW, cscr, lane);
#else
        cvt_range(CP, 0, CVT_R3_LO, gw, NGW, cscr, lane); cvt_range(CP, CVT_X0_END, CVT_R9_LO, gw, NGW, cscr, lane);
#endif
    } SEAM(0);
    if (IN(1)) _Pragma("unroll") for (int rep_ = 0; rep_ < 1 + (int)((DUP_MASK >> 1) & 1u); ++rep_) { if (rep_) GRID_BAR();  ph_modred(modp, ada_b, mod, bid * 512 + tid, G * 512); } SEAM(1);
    if (IN(2)) _Pragma("unroll") for (int rep_ = 0; rep_ < 1 + (int)((DUP_MASK >> 2) & 1u); ++rep_) { if (rep_) GRID_BAR();  ph_mod0(x, ctx, nmix, mod, A, gw, NGW, lane); } SEAM(2);
    if (IN(3)) _Pragma("unroll") for (int rep_ = 0; rep_ < 1 + (int)((DUP_MASK >> 3) & 1u); ++rep_) { if (rep_) GRID_BAR();
        pg8::Gemm g{A, W1A, MT, 4096, DM}; pg8::StaticOrder S; S.init(MT, 4096, G, bid);
        EpiPair<0> E{U, DM, 16};
        pg8::gemm_phase<EpiPair<0>, pg8::StaticOrder, true, true>(lds, g, S, E);
        CVT_TAIL(1152, CVT_R3_LO, CVT_R4_LO);
    } SEAM(3);
    if (IN(4)) _Pragma("unroll") for (int rep_ = 0; rep_ < 1 + (int)((DUP_MASK >> 4) & 1u); ++rep_) { if (rep_) GRID_BAR();
        pg8::Gemm g{A, W1B, MT, DM, DM}; pg8::StaticOrder S; S.init(MT, DM, G, bid);
        EpiConvGate E{U, Z, conv_w};
        pg8::gemm_phase<EpiConvGate, pg8::StaticOrder, true, true>(lds, g, S, E);
        CVT_TAIL(576, CVT_R4_LO, CVT_R5_LO);
    } SEAM(4);
    if (IN(5)) _Pragma("unroll") for (int rep_ = 0; rep_ < 1 + (int)((DUP_MASK >> 5) & 1u); ++rep_) { if (rep_) GRID_BAR();
        pg8::Gemm g{Z, W2, MT, DM, DM}; pg8::StaticOrder S; S.init(MT, DM, G, bid);
        EpiResid<true> E{x, ctx, H, mod + 2 * DM};
        pg8::gemm_phase<EpiResid<true>, pg8::StaticOrder, true, true>(lds, g, S, E);
        CVT_TAIL(576, CVT_R5_LO, CVT_X0_END);
    } SEAM(5);
    if (IN(6)) _Pragma("unroll") for (int rep_ = 0; rep_ < 1 + (int)((DUP_MASK >> 6) & 1u); ++rep_) { if (rep_) GRID_BAR();  load_router(router_w, (LAS float*)lds, tid); ph_modffn(H, nffn, mod, A, (const LAS float*)lds, affL, affC, MT, gw, NGW, lane); } SEAM(6);
    if (IN(7)) _Pragma("unroll") for (int rep_ = 0; rep_ < 1 + (int)((DUP_MASK >> 7) & 1u); ++rep_) { if (rep_) GRID_BAR();  ph_topk(256, affL, affC, rowsrc, gatev, inv, (LAS unsigned*)lds, tid, lane, wave, bid, G);
#if MK_CVT_JIT
        { CVT_MKCP(); cvt_range(CP, CVT_E0, CVT_X0_END, gw, NGW, cscr, lane); }
#endif
    } SEAM(7);
    if (IN(8)) _Pragma("unroll") for (int rep_ = 0; rep_ < 1 + (int)((DUP_MASK >> 8) & 1u); ++rep_) { if (rep_) GRID_BAR();
        pg8::Gemm g{A, WGU, YT, NE * 2048, DM, rowsrc}; MoeOrder S{G, bid, 9};
        EpiPair<1> E{HM, DFF, 8};
        pg8::gemm_phase<EpiPair<1>, MoeOrder, true, true, true>(lds, g, S, E);
        CVT_TAIL(1152, CVT_R9_LO, CVT_R10_LO);
    } SEAM(8);
    if (IN(9)) _Pragma("unroll") for (int rep_ = 0; rep_ < 1 + (int)((DUP_MASK >> 9) & 1u); ++rep_) { if (rep_) GRID_BAR();
        pg8::Gemm g{HM, WDN, YT, NE * 2048, DFF}; MoeOrder S{G, bid, 9};
        EpiDown E{Y, gatev};
        pg8::gemm_phase<EpiDown, MoeOrder, true, true>(lds, g, S, E);
        CVT_TAIL(1152, CVT_R10_LO, CVT_R12_LO);
    } SEAM(9);
    if (IN(10)) _Pragma("unroll") for (int rep_ = 0; rep_ < 1 + (int)((DUP_MASK >> 10) & 1u); ++rep_) { if (rep_) GRID_BAR();  ph_combine<false>(H, Y, inv, mod, nmix + DM, mod + 9 * NMOD, A, nullptr, MT, gw, NGW, lane); } SEAM(10);
    if (IN(11)) _Pragma("unroll") for (int rep_ = 0; rep_ < 1 + (int)((DUP_MASK >> 11) & 1u); ++rep_) { if (rep_) GRID_BAR();
        pg8::Gemm g{A, WQKV, MT, 3072, DM}; QkvOrder S{G, bid};
        EpiQkvNorm E{Qb, Kb, Vb, qgain, kgain, (LAS float*)(lds + RING_BYTES)};
        pg8::gemm_phase<EpiQkvNorm, QkvOrder, true, true>(lds, g, S, E);
        CVT_TAIL(800, CVT_R12_LO, CVT_TOTAL);
    } SEAM(11);
    if (IN(12)) _Pragma("unroll") for (int rep_ = 0; rep_ < 1 + (int)((DUP_MASK >> 12) & 1u); ++rep_) { if (rep_) GRID_BAR();  ph_attn(Qb, Kb, Vb, Ob, sink, lds, tid, lane, wave, bid, G); } SEAM(12);
    if (IN(13)) _Pragma("unroll") for (int rep_ = 0; rep_ < 1 + (int)((DUP_MASK >> 13) & 1u); ++rep_) { if (rep_) GRID_BAR();
        pg8::Gemm g{Ob, WOt, ML, DM, DM}; pg8::StaticOrder S; S.init(ML, DM, G, bid);
        EpiResid<false> E{nullptr, nullptr, H, mod + 9 * NMOD + 2 * DM};
        pg8::gemm_phase<EpiResid<false>, pg8::StaticOrder, true, true>(lds, g, S, E);
    } SEAM(13);
    if (IN(14)) _Pragma("unroll") for (int rep_ = 0; rep_ < 1 + (int)((DUP_MASK >> 14) & 1u); ++rep_) { if (rep_) GRID_BAR();  load_router(router_w + DM * 16, (LAS float*)lds, tid); ph_modffn(H, nffn + DM, mod + 9 * NMOD, A, (const LAS float*)lds, affL, affC, ML, gw, NGW, lane); } SEAM(14);
    if (IN(15)) _Pragma("unroll") for (int rep_ = 0; rep_ < 1 + (int)((DUP_MASK >> 15) & 1u); ++rep_) { if (rep_) GRID_BAR();  ph_topk(128, affL, affC, rowsrc, gatev, inv, (LAS unsigned*)lds, tid, lane, wave, bid, G);
#if MK_CVT_JIT
        { CVT_MKCP(); cvt_range(CP, CVT_X0_END, CVT_TOTAL, gw, NGW, cscr, lane); }
#endif
    } SEAM(15);
    if (IN(16)) _Pragma("unroll") for (int rep_ = 0; rep_ < 1 + (int)((DUP_MASK >> 16) & 1u); ++rep_) { if (rep_) GRID_BAR();
        pg8::Gemm g{A, WGU + (size_t)NE * 2048 * DM, YT, NE * 2048, DM, rowsrc}; MoeOrder S{G, bid, 8};
        EpiPair<1> E{HM, DFF, 8};
        pg8::gemm_phase<EpiPair<1>, MoeOrder, true, true, true>(lds, g, S, E);
    } SEAM(16);
    if (IN(17)) _Pragma("unroll") for (int rep_ = 0; rep_ < 1 + (int)((DUP_MASK >> 17) & 1u); ++rep_) { if (rep_) GRID_BAR();
        pg8::Gemm g{HM, WDN + (size_t)NE * 2048 * DFF, YT, NE * 2048, DFF}; MoeOrder S{G, bid, 8};
        EpiDown E{Y, gatev};
        pg8::gemm_phase<EpiDown, MoeOrder, true, true>(lds, g, S, E);
    } SEAM(17);
    if (IN(18)) _Pragma("unroll") for (int rep_ = 0; rep_ < 1 + (int)((DUP_MASK >> 18) & 1u); ++rep_) { if (rep_) GRID_BAR();  ph_combine<true>(H, Y, inv, mod + 9 * NMOD, nullptr, nullptr, nullptr, args.out, ML, gw, NGW, lane); }
#undef IN
#undef SEAM
}

extern "C" void kernel_launch(void* const* d_in, const int* in_sizes, int n_in, void* d_out, int out_size, void* d_ws, size_t ws_size, hipStream_t stream) {
    static int grid = 0;
    if (grid == 0) {
        if (n_in != 20 || out_size != ML * DM || ws_size < WS_END) { fprintf(stderr, "kernel_launch: unexpected problem (n_in %d, out %d, ws %zu); nothing launched\n", n_in, out_size, ws_size); grid = -1; return; }
        int dev = 0, cus = 0, per_cu = 0;
        if (hipGetDevice(&dev) != hipSuccess || hipDeviceGetAttribute(&cus, hipDeviceAttributeMultiprocessorCount, dev) != hipSuccess) { grid = -1; return; }
        if (hipFuncSetAttribute((const void*)dit_fwd, hipFuncAttributeMaxDynamicSharedMemorySize, LDS_BYTES) != hipSuccess) { fprintf(stderr, "kernel_launch: hipFuncSetAttribute failed\n"); grid = -1; return; }
        if (hipOccupancyMaxActiveBlocksPerMultiprocessor(&per_cu, (const void*)dit_fwd, 512, LDS_BYTES) != hipSuccess || per_cu < 1) fprintf(stderr, "kernel_launch: occupancy query reports %d workgroups per CU\n", per_cu);
        (void)hipGetLastError();
        grid = cus;
    }
    if (grid < 0) return;
    (void)hipMemsetAsync((char*)d_ws + WS_CTL, 0, CTL_ZERO_BYTES, stream);
    Args a{};
    for (int i = 0; i < 20; ++i) a.in[i] = (const float*)d_in[i];
    a.out = (float*)d_out; a.ws = (unsigned char*)d_ws;
#if MK_ONE_LAUNCH
    a.ph_lo = 0; a.ph_hi = NPHASE;
    hipLaunchKernelGGL(dit_fwd, dim3(grid), dim3(512), LDS_BYTES, stream, a);
#else
    for (int p = 0; p < NPHASE; ++p) { a.ph_lo = p; a.ph_hi = p + 1; hipLaunchKernelGGL(dit_fwd, dim3(grid), dim3(512), LDS_BYTES, stream, a); }
#endif
}
```

```cpp
#include <hip/hip_runtime.h>
#include <cstdio>
#include <cstdint>
namespace pg8 {
#define PG8_LAS __attribute__((address_space(3)))
typedef unsigned short bf16_t;
typedef short bf16x8 __attribute__((ext_vector_type(8)));
typedef float f32x4 __attribute__((ext_vector_type(4)));
typedef unsigned u32x4 __attribute__((ext_vector_type(4)));
constexpr int BM = 256, BK = 64, HALF = 128, HTB = HALF * BK * 2  , STAGE_BYTES = 8 * HTB, NXCD = 8, WGM = 8;

__host__ __device__ __forceinline__ int lds_byte(int r, int c) { const int st = (r >> 4) * 2 + (c >> 5), rr = r & 15, cc = c & 31, ob = rr * 64 + cc * 2; return st * 1024 + (ob ^ (((ob >> 9) & 1) << 5)); }
__host__ __device__ __forceinline__ void stage_rc(int b, int& R, int& C) { const int st = b / 1024, sb = b % 1024, swz = sb ^ (((sb >> 9) & 1) << 5); R = (st >> 1) * 16 + swz / 64; C = (st & 1) * 32 + (swz % 64) / 2; }
__host__ __device__ __forceinline__ int perm32(int rho) { const int n = rho >> 4, i = rho & 15; return 8 * (i >> 2) + 4 * n + (i & 3); }

struct Unit { int pm, pn; };
struct Gemm { const bf16_t* A; const bf16_t* Bt; int M, N, K; const int* rows = nullptr; };

struct StaticOrder {
    int nM, nN, nwg, G, c;
    __host__ __device__ void init(int M, int N, int G_, int c_) { nM = M / BM; nN = N / BM; nwg = nM * nN; G = G_; c = c_; }
    __host__ __device__ bool next(int i, Unit& u) const {
        const long L = (long)i * G + c; if (L >= nwg) return false;
        int wgid = (int)L; { const int q = nwg / NXCD, r = nwg % NXCD, xcd = wgid % NXCD, off = wgid / NXCD; wgid = (xcd < r ? xcd * (q + 1) : r * (q + 1) + (xcd - r) * q) + off; }
        const int nig = WGM * nN, gid = wgid / nig, fm = gid * WGM, gsz = (nM - fm) < WGM ? (nM - fm) : WGM;
        u.pm = fm + ((wgid % nig) % gsz); u.pn = (wgid % nig) / gsz; return true;
    }
    __device__ __forceinline__ void a_ready(const Unit&) const {}
    __device__ __forceinline__ void done(const Unit&) const {}
};
__device__ __forceinline__ unsigned cvt_pk_bf16(float lo, float hi) { unsigned r; asm volatile("v_cvt_pk_bf16_f32 %0, %1, %2" : "=v"(r) : "v"(lo), "v"(hi)); return r; }
typedef float f32x2 __attribute__((ext_vector_type(2)));
template <class Epi, class Sched, bool ALIGN_EPI = false, bool SP2 = false, bool GATHER = false>
__device__ __forceinline__ void gemm_phase(PG8_LAS unsigned char* lds, const Gemm g, const Sched& S, const Epi& E) {
    const int tid = threadIdx.x, wid = __builtin_amdgcn_readfirstlane(tid >> 6), lane = tid & 63, wr = wid >> 2, wc = wid & 3, fr = lane & 15, fq = lane >> 4;
    const int K = g.K, nt = K / BK;
    unsigned voffA[2], voffB[2];
#pragma unroll
    for (int i = 0; i < 2; ++i) { int R, C; stage_rc(tid * 16 + i * 8192, R, C); const int Rb = Epi::PERM ? ((R & ~31) + perm32(R & 31)) : R;
        voffA[i] = (unsigned)(R * K + C) * 2u; voffB[i] = (unsigned)(Rb * K + C) * 2u; }
    const size_t kstep = (size_t)(BK * 2);
    const size_t hstep = (size_t)HALF * K * 2;
    const size_t tstep = 2 * hstep;
    const unsigned ldsw = (unsigned)wid * 1024u;
    const int aoff = lds_byte(wr * 64 + fr, fq * 8), boff = lds_byte(wc * 32 + fr, fq * 8);
#define PG8_SA(b, h) (((b) * 2 + (h)) * HTB)
#define PG8_SB(b, h) ((4 + (b) * 2 + (h)) * HTB)
#define PG8_STAGE(bufoff, gbase, voff) do { _Pragma("unroll") for (int _i = 0; _i < 2; ++_i) \
        __builtin_amdgcn_global_load_lds((const unsigned*)((const char*)(gbase) + (voff)[_i]), (PG8_LAS unsigned*)(lds + (bufoff) + ldsw + _i * 8192), 16, 0, 0); } while (0)
#define PG8_STAGE_A(bufoff, kptr, h) do { if constexpr (GATHER) { PG8_STAGE(bufoff, kptr, vA[h]); } else { PG8_STAGE(bufoff, (kptr) + (h) * hstep, voffA); } } while (0)
#define PG8_GATHER_SWITCH() do { if constexpr (GATHER) { if (last && has_next) { asm volatile("" : "+v"(nv[0]), "+v"(nv[1]), "+v"(nv[2]), "+v"(nv[3])); \
        vA[0][0] = nv[0] * (unsigned)(K * 2) + gcoff[0]; vA[0][1] = nv[1] * (unsigned)(K * 2) + gcoff[1]; vA[1][0] = nv[2] * (unsigned)(K * 2) + gcoff[0]; vA[1][1] = nv[3] * (unsigned)(K * 2) + gcoff[1]; } } } while (0)
#define PG8_LDA(dst, b, h) do { _Pragma("unroll") for (int m = 0; m < 4; ++m) _Pragma("unroll") for (int k = 0; k < 2; ++k) dst[m][k] = *(const PG8_LAS bf16x8*)(lds + PG8_SA(b, h) + aoff + m * 2048 + k * 1024); } while (0)
#define PG8_LDB(dst, b, h) do { _Pragma("unroll") for (int n = 0; n < 2; ++n) _Pragma("unroll") for (int k = 0; k < 2; ++k) dst[n][k] = *(const PG8_LAS bf16x8*)(lds + PG8_SB(b, h) + boff + n * 2048 + k * 1024); } while (0)
#define PG8_MMA(ai, bj, At, Bt) do { __builtin_amdgcn_s_setprio(1); _Pragma("unroll") for (int m = 0; m < 4; ++m) _Pragma("unroll") for (int n = 0; n < 2; ++n) _Pragma("unroll") for (int k = 0; k < 2; ++k) \
        acc[ai][bj][m][n] = __builtin_amdgcn_mfma_f32_16x16x32_bf16(Bt[n][k], At[m][k], acc[ai][bj][m][n], 0, 0, 0); __builtin_amdgcn_s_setprio(0); } while (0)
#define PG8_WAIT_V(n) asm volatile("s_waitcnt vmcnt(" #n ")" ::: "memory")
#define PG8_WAIT_L(n) asm volatile("s_waitcnt lgkmcnt(" #n ")" ::: "memory")
#define PG8_BAR __builtin_amdgcn_s_barrier()
#define PG8_SCHED __builtin_amdgcn_sched_barrier(0)
    Unit cur, nxt; int ui = 0;
    if (!S.next(0, cur)) return;
    f32x4 acc[2][2][4][2];
#pragma unroll
    for (int a = 0; a < 2; ++a)
#pragma unroll
        for (int b = 0; b < 2; ++b)
#pragma unroll
            for (int m = 0; m < 4; ++m)
#pragma unroll
                for (int n = 0; n < 2; ++n) acc[a][b][m][n] = (f32x4){0.f, 0.f, 0.f, 0.f};
    bf16x8 At[4][2], B0[2][2], B1[2][2];
    const char* cA = (const char*)g.A + (GATHER ? (size_t)0 : (size_t)cur.pm * tstep); const char* cB = (const char*)g.Bt + (size_t)cur.pn * tstep;
    unsigned vA[2][2], nv[4], gcoff[2]; int grow[2];
    if constexpr (GATHER) {
#pragma unroll
        for (int i = 0; i < 2; ++i) { int R, C; stage_rc(tid * 16 + i * 8192, R, C); grow[i] = R; gcoff[i] = (unsigned)(C * 2); }
#pragma unroll
        for (int h = 0; h < 2; ++h)
#pragma unroll
            for (int i = 0; i < 2; ++i) vA[h][i] = (unsigned)g.rows[cur.pm * BM + h * HALF + grow[i]] * (unsigned)(K * 2) + gcoff[i];
    }
    S.a_ready(cur);
    if constexpr (SP2) {
        PG8_STAGE(PG8_SB(0, 0), cB, voffB); PG8_STAGE(PG8_SB(0, 1), cB + hstep, voffB); PG8_STAGE_A(PG8_SA(0, 0), cA, 0); PG8_STAGE_A(PG8_SA(0, 1), cA, 1);
        if (wr == 1) PG8_BAR;
        PG8_WAIT_V(2); PG8_BAR;
        PG8_STAGE(PG8_SB(1, 0), cB + kstep, voffB); PG8_STAGE_A(PG8_SA(1, 0), cA + kstep, 0); PG8_STAGE(PG8_SB(1, 1), cB + hstep + kstep, voffB);
        PG8_WAIT_V(6); PG8_BAR;
    } else {
        PG8_STAGE(PG8_SB(0, 0), cB, voffB); PG8_STAGE_A(PG8_SA(0, 0), cA, 0); PG8_STAGE(PG8_SB(0, 1), cB + hstep, voffB); PG8_STAGE_A(PG8_SA(0, 1), cA, 1);
        if (wr == 1) PG8_BAR;
        PG8_WAIT_V(4); PG8_BAR;
        PG8_STAGE(PG8_SB(1, 0), cB + kstep, voffB); PG8_STAGE_A(PG8_SA(1, 0), cA + kstep, 0); PG8_STAGE(PG8_SB(1, 1), cB + hstep + kstep, voffB);
        PG8_WAIT_V(6); PG8_BAR;
    }
    for (;;) {
        const bool has_next = S.next(ui + 1, nxt);
        const char* nA = (has_next && !GATHER) ? (const char*)g.A + (size_t)nxt.pm * tstep : cA; const char* nB = has_next ? (const char*)g.Bt + (size_t)nxt.pn * tstep : cB;
        if constexpr (GATHER) { if (has_next) { const int* rp = g.rows + nxt.pm * BM;
            asm volatile("global_load_dword %0, %1, off" : "=&v"(nv[0]) : "v"(rp + grow[0]) : "memory"); asm volatile("global_load_dword %0, %1, off" : "=&v"(nv[1]) : "v"(rp + grow[1]) : "memory");
            asm volatile("global_load_dword %0, %1, off" : "=&v"(nv[2]) : "v"(rp + HALF + grow[0]) : "memory"); asm volatile("global_load_dword %0, %1, off" : "=&v"(nv[3]) : "v"(rp + HALF + grow[1]) : "memory"); } }
        for (int t = 0; t < nt; t += 2) {
            const bool last = (t == nt - 2);
            const char* a1 = cA + (size_t)(t + 1) * kstep;
            const char* a2 = last ? nA : cA + (size_t)(t + 2) * kstep; const char* b2 = last ? nB : cB + (size_t)(t + 2) * kstep;
            const char* a3 = a2 + kstep; const char* b3 = b2 + kstep;
            if (last && has_next) S.a_ready(nxt);
            if constexpr (SP2) {
            PG8_LDB(B0, 0, 0); PG8_LDB(B1, 0, 1); PG8_SCHED; PG8_LDA(At, 0, 0); PG8_STAGE_A(PG8_SA(1, 1), a1, 1); PG8_GATHER_SWITCH();
            PG8_WAIT_V(8); PG8_WAIT_L(0); PG8_BAR; PG8_MMA(0, 0, At, B0); PG8_MMA(0, 1, At, B1); PG8_BAR; PG8_SCHED;
            PG8_LDA(At, 0, 1); PG8_STAGE(PG8_SB(0, 0), b2, voffB); PG8_STAGE(PG8_SB(0, 1), b2 + hstep, voffB); PG8_STAGE_A(PG8_SA(0, 0), a2, 0);
            PG8_WAIT_V(8); PG8_WAIT_L(0); PG8_BAR; PG8_MMA(1, 0, At, B0); PG8_MMA(1, 1, At, B1); PG8_BAR; PG8_SCHED;
            PG8_LDB(B0, 1, 0); PG8_LDB(B1, 1, 1); PG8_SCHED; PG8_LDA(At, 1, 0); PG8_STAGE_A(PG8_SA(0, 1), a2, 1);
            PG8_WAIT_V(8); PG8_WAIT_L(0); PG8_BAR; PG8_MMA(0, 0, At, B0); PG8_MMA(0, 1, At, B1); PG8_BAR; PG8_SCHED;
            PG8_LDA(At, 1, 1); PG8_STAGE(PG8_SB(1, 0), b3, voffB); PG8_STAGE(PG8_SB(1, 1), b3 + hstep, voffB); PG8_STAGE_A(PG8_SA(1, 0), a3, 0);
            PG8_WAIT_V(8); PG8_WAIT_L(0); PG8_BAR; PG8_MMA(1, 0, At, B0); PG8_MMA(1, 1, At, B1); PG8_BAR; PG8_SCHED;
            } else {
            PG8_LDB(B0, 0, 0); PG8_SCHED; PG8_LDA(At, 0, 0); PG8_STAGE_A(PG8_SA(1, 1), a1, 1); PG8_GATHER_SWITCH();
            PG8_WAIT_L(8); PG8_BAR; PG8_WAIT_L(0); PG8_MMA(0, 0, At, B0); PG8_BAR; PG8_SCHED;
            PG8_LDB(B1, 0, 1); PG8_STAGE(PG8_SB(0, 0), b2, voffB);
            PG8_BAR; PG8_WAIT_L(0); PG8_MMA(0, 1, At, B1); PG8_BAR;
            PG8_LDA(At, 0, 1); PG8_STAGE_A(PG8_SA(0, 0), a2, 0);
            PG8_BAR; PG8_WAIT_L(0); PG8_MMA(1, 0, At, B0); PG8_BAR; PG8_SCHED;
            PG8_STAGE(PG8_SB(0, 1), b2 + hstep, voffB);
            PG8_WAIT_V(6); PG8_BAR; PG8_MMA(1, 1, At, B1); PG8_BAR;
            PG8_LDB(B0, 1, 0); PG8_SCHED; PG8_LDA(At, 1, 0); PG8_STAGE_A(PG8_SA(0, 1), a2, 1);
            PG8_WAIT_L(8); PG8_BAR; PG8_WAIT_L(0); PG8_MMA(0, 0, At, B0); PG8_BAR; PG8_SCHED;
            PG8_LDB(B1, 1, 1); PG8_STAGE(PG8_SB(1, 0), b3, voffB);
            PG8_BAR; PG8_WAIT_L(0); PG8_MMA(0, 1, At, B1); PG8_BAR;
            PG8_LDA(At, 1, 1); PG8_STAGE_A(PG8_SA(1, 0), a3, 0);
            PG8_BAR; PG8_WAIT_L(0); PG8_MMA(1, 0, At, B0); PG8_BAR; PG8_SCHED;
            PG8_STAGE(PG8_SB(1, 1), b3 + hstep, voffB);
            PG8_WAIT_V(6); PG8_BAR; PG8_MMA(1, 1, At, B1); PG8_BAR;
            }
        }
        if constexpr (ALIGN_EPI) { if (wr == 0) PG8_BAR; }
        if constexpr (!Epi::AFTER_DRAIN) { E(acc, cur, wr, wc, fr, fq); S.done(cur); }
        if (!has_next) break;
#pragma unroll
        for (int a = 0; a < 2; ++a)
#pragma unroll
            for (int b = 0; b < 2; ++b)
#pragma unroll
                for (int m = 0; m < 4; ++m)
#pragma unroll
                    for (int n = 0; n < 2; ++n) acc[a][b][m][n] = (f32x4){0.f, 0.f, 0.f, 0.f};
        cur = nxt; cA = nA; cB = nB; ++ui;
        if constexpr (ALIGN_EPI) { if (wr == 1) PG8_BAR; }
    }
    PG8_WAIT_V(0);
    if constexpr (!ALIGN_EPI) { if (wr == 0) PG8_BAR; }
    PG8_BAR;
    if constexpr (Epi::AFTER_DRAIN) { E.fused(acc, cur, wr, wc, fr, fq, lds, wid, lane); S.done(cur); }
#undef PG8_SA
#undef PG8_SB
#undef PG8_STAGE
#undef PG8_STAGE_A
#undef PG8_GATHER_SWITCH
#undef PG8_LDA
#undef PG8_LDB
#undef PG8_MMA
#undef PG8_WAIT_V
#undef PG8_WAIT_L
#undef PG8_BAR
#undef PG8_SCHED
}
}

constexpr int DM = 2048, NB = 8, SEQ = 2048, CTXL = 256, NH = 16, NKV = 4, HD = 128;
constexpr int ML = NB * SEQ;
constexpr int MC = NB * CTXL;
constexpr int MT = ML + MC;
constexpr int NE = 16, CAPL = 256, CAPC = 32, DFF = 1024;
constexpr int YR = NB * CAPL + NB * CAPC;
constexpr int YT = NE * YR;
constexpr int NMOD = 6 * DM;
constexpr float NORM_EPS = 1e-6f;
constexpr int KSPLIT = 16;

using pg8::Unit; using pg8::f32x4; using pg8::u32x4; using pg8::bf16_t; using pg8::bf16x8; using pg8::cvt_pk_bf16;
typedef float f32x2 __attribute__((ext_vector_type(2)));
typedef unsigned u32x2 __attribute__((ext_vector_type(2)));
typedef float f32x16 __attribute__((ext_vector_type(16)));
typedef short s16x4 __attribute__((ext_vector_type(4)));
#define DI __device__ __forceinline__

DI float bf_lo(unsigned w) { return __uint_as_float(w << 16); }
DI float bf_hi(unsigned w) { return __uint_as_float(w & 0xffff0000u); }
DI float silu_f(float a) { return a * __builtin_amdgcn_rcpf(1.0f + __expf(-a)); }

DI int xcd_remap(int wgid, int nwg) { const int q = nwg / 8, r = nwg % 8, xcd = wgid % 8, off = wgid / 8; return (xcd < r ? xcd * (q + 1) : r * (q + 1) + (xcd - r) * q) + off; }
struct QkvOrder {
    int G, c;
    DI bool next(int i, Unit& u) const {
        const int L = i * G + c; if (L >= 800) return false;
        if (L < 768) { const int w = xcd_remap(L, 768); const int nig = 8 * 12, gid = w / nig; u.pm = gid * 8 + ((w % nig) % 8); u.pn = (w % nig) / 8; }
        else { const int j = L - 768; u.pm = 64 + (j >> 2); u.pn = 8 + (j & 3); }
        return true;
    }
    DI void a_ready(const Unit&) const {}
    DI void done(const Unit&) const {}
};
struct MoeOrder {
    int G, c, NP;
    DI bool next(int i, Unit& u) const {
        const int nwg = NE * NP * 8; const int L = i * G + c; if (L >= nwg) return false;
        const int w = xcd_remap(L, nwg); const int per = NP * 8, e = w / per, rem = w % per;
        u.pm = e * 9 + (rem % NP); u.pn = e * 8 + (rem / NP); return true;
    }
    DI void a_ready(const Unit&) const {}
    DI void done(const Unit&) const {}
};

template <int ACT  > struct EpiPair {
    static constexpr bool PERM = true, AFTER_DRAIN = false;
    bf16_t* O; int ldc; int pn_mod;
    DI void operator()(const f32x4 (&acc)[2][2][4][2], const Unit& u, int wr, int wc, int fr, int fq) const {
        const int row0 = u.pm * 256 + wr * 64 + fr, col0 = (u.pn % pn_mod) * 128 + wc * 32 + 8 * fq;
#pragma unroll
        for (int ai = 0; ai < 2; ++ai)
#pragma unroll
            for (int m = 0; m < 4; ++m) {
                bf16_t* rowp = O + (size_t)(row0 + ai * 128 + m * 16) * ldc + col0;
                f32x4 a0 = acc[ai][0][m][0], a1 = acc[ai][0][m][1]; const f32x4 b0 = acc[ai][1][m][0], b1 = acc[ai][1][m][1];
                if (ACT == 1) {
#pragma unroll
                    for (int j = 0; j < 4; ++j) { a0[j] = silu_f(a0[j]); a1[j] = silu_f(a1[j]); } }
                const f32x4 v0 = a0 * b0, v1 = a1 * b1;
                u32x4 w; w.x = cvt_pk_bf16(v0[0], v0[1]); w.y = cvt_pk_bf16(v0[2], v0[3]); w.z = cvt_pk_bf16(v1[0], v1[1]); w.w = cvt_pk_bf16(v1[2], v1[3]);
                *(u32x4*)rowp = w;
            }
    }
};
struct EpiConvGate {
    static constexpr bool PERM = true, AFTER_DRAIN = false;
    const bf16_t* U; bf16_t* Z; const float* cw;
    DI void operator()(const f32x4 (&acc)[2][2][4][2], const Unit& u, int wr, int wc, int fr, int fq) const {
        const int row0 = u.pm * 256 + wr * 64 + fr, col0 = u.pn * 256 + wc * 32 + 8 * fq;
#pragma unroll
        for (int bj = 0; bj < 2; ++bj) {
            const int c = col0 + bj * 128;
            f32x4 w0a = *(const f32x4*)(cw + c), w0b = *(const f32x4*)(cw + c + 4), w1a = *(const f32x4*)(cw + 2048 + c), w1b = *(const f32x4*)(cw + 2048 + c + 4), w2a = *(const f32x4*)(cw + 4096 + c), w2b = *(const f32x4*)(cw + 4096 + c + 4);
#pragma unroll
            for (int ai = 0; ai < 2; ++ai)
#pragma unroll
                for (int m = 0; m < 4; ++m) {
                    const int row = row0 + ai * 128 + m * 16;
                    const int tpos = row < ML ? (row & (SEQ - 1)) : ((row - ML) & (CTXL - 1)); const int len = row < ML ? SEQ : CTXL;
                    const u32x4 z4 = (u32x4){0u, 0u, 0u, 0u};
                    const u32x4 uc = *(const u32x4*)(U + (size_t)row * DM + c);
                    const u32x4 up = tpos > 0 ? *(const u32x4*)(U + (size_t)(row - 1) * DM + c) : z4;
                    const u32x4 un = tpos < len - 1 ? *(const u32x4*)(U + (size_t)(row + 1) * DM + c) : z4;
                    f32x4 ya, yb;
                    ya[0] = w0a[0] * bf_lo(up.x) + w1a[0] * bf_lo(uc.x) + w2a[0] * bf_lo(un.x); ya[1] = w0a[1] * bf_hi(up.x) + w1a[1] * bf_hi(uc.x) + w2a[1] * bf_hi(un.x);
                    ya[2] = w0a[2] * bf_lo(up.y) + w1a[2] * bf_lo(uc.y) + w2a[2] * bf_lo(un.y); ya[3] = w0a[3] * bf_hi(up.y) + w1a[3] * bf_hi(uc.y) + w2a[3] * bf_hi(un.y);
                    yb[0] = w0b[0] * bf_lo(up.z) + w1b[0] * bf_lo(uc.z) + w2b[0] * bf_lo(un.z); yb[1] = w0b[1] * bf_hi(up.z) + w1b[1] * bf_hi(uc.z) + w2b[1] * bf_hi(un.z);
                    yb[2] = w0b[2] * bf_lo(up.w) + w1b[2] * bf_lo(uc.w) + w2b[2] * bf_lo(un.w); yb[3] = w0b[3] * bf_hi(up.w) + w1b[3] * bf_hi(uc.w) + w2b[3] * bf_hi(un.w);
                    const f32x4 v0 = acc[ai][bj][m][0] * ya, v1 = acc[ai][bj][m][1] * yb;
                    u32x4 w; w.x = cvt_pk_bf16(v0[0], v0[1]); w.y = cvt_pk_bf16(v0[2], v0[3]); w.z = cvt_pk_bf16(v1[0], v1[1]); w.w = cvt_pk_bf16(v1[2], v1[3]);
                    *(u32x4*)(Z + (size_t)row * DM + c) = w;
                }
        }
    }
};
template <bool BASE_F32> struct EpiResid {
    static constexpr bool PERM = true, AFTER_DRAIN = false;
    const float* base_lat; const float* base_ctx; bf16_t* out; const float* gate;
    DI void operator()(const f32x4 (&acc)[2][2][4][2], const Unit& u, int wr, int wc, int fr, int fq) const {
        const int rowt = u.pm * 256; const int cr = rowt < ML ? (rowt >> 11) : 8;
        const float* base = rowt < ML ? base_lat : base_ctx - (size_t)ML * DM;
        const int row0 = rowt + wr * 64 + fr, col0 = u.pn * 256 + wc * 32 + 8 * fq;
        f32x4 gv[2][2];
#pragma unroll
        for (int bj = 0; bj < 2; ++bj)
#pragma unroll
            for (int n = 0; n < 2; ++n) gv[bj][n] = *(const f32x4*)(gate + (size_t)cr * NMOD + col0 + bj * 128 + n * 4);
#pragma unroll
        for (int ai = 0; ai < 2; ++ai)
#pragma unroll
            for (int m = 0; m < 4; ++m) { const size_t off = (size_t)(row0 + ai * 128 + m * 16) * DM + col0;
#pragma unroll
                for (int bj = 0; bj < 2; ++bj) { f32x4 b0, b1;
                    if (BASE_F32) { b0 = *(const f32x4*)(base + off + bj * 128); b1 = *(const f32x4*)(base + off + bj * 128 + 4); }
                    else { const u32x4 hb = *(const u32x4*)(out + off + bj * 128); b0 = (f32x4){bf_lo(hb.x), bf_hi(hb.x), bf_lo(hb.y), bf_hi(hb.y)}; b1 = (f32x4){bf_lo(hb.z), bf_hi(hb.z), bf_lo(hb.w), bf_hi(hb.w)}; }
                    const f32x4 v0 = b0 + gv[bj][0] * acc[ai][bj][m][0], v1 = b1 + gv[bj][1] * acc[ai][bj][m][1];
                    u32x4 w; w.x = cvt_pk_bf16(v0[0], v0[1]); w.y = cvt_pk_bf16(v0[2], v0[3]); w.z = cvt_pk_bf16(v1[0], v1[1]); w.w = cvt_pk_bf16(v1[2], v1[3]);
                    *(u32x4*)(out + off + bj * 128) = w; }
                asm volatile("" ::: "memory"); }
    }
};
struct EpiDown {
    static constexpr bool PERM = true, AFTER_DRAIN = false;
    bf16_t* Y; const float* gatev;
    DI void operator()(const f32x4 (&acc)[2][2][4][2], const Unit& u, int wr, int wc, int fr, int fq) const {
        const int row0 = u.pm * 256 + wr * 64 + fr, col0 = (u.pn & 7) * 256 + wc * 32 + 8 * fq;
#pragma unroll
        for (int ai = 0; ai < 2; ++ai)
#pragma unroll
            for (int m = 0; m < 4; ++m) { const int row = row0 + ai * 128 + m * 16; const float gt = gatev[row];
#pragma unroll
                for (int bj = 0; bj < 2; ++bj) { const f32x4 v0 = acc[ai][bj][m][0] * gt, v1 = acc[ai][bj][m][1] * gt;
                    u32x4 w; w.x = cvt_pk_bf16(v0[0], v0[1]); w.y = cvt_pk_bf16(v0[2], v0[3]); w.z = cvt_pk_bf16(v1[0], v1[1]); w.w = cvt_pk_bf16(v1[2], v1[3]);
                    *(u32x4*)(Y + (size_t)row * DM + col0 + bj * 128) = w; } }
    }
};
struct EpiQkv {
    static constexpr bool PERM = true, AFTER_DRAIN = false;
    bf16_t* Q; bf16_t* K; bf16_t* V;
    DI void operator()(const f32x4 (&acc)[2][2][4][2], const Unit& u, int wr, int wc, int fr, int fq) const {
        const int row0 = u.pm * 256 + wr * 64 + fr; int colt = u.pn * 256; bf16_t* base; int ld;
        if (colt < 2048) { base = Q; ld = 2048; } else if (colt < 2560) { base = K; ld = 512; colt -= 2048; } else { base = V; ld = 512; colt -= 2560; }
        const int col0 = colt + wc * 32 + 8 * fq;
#pragma unroll
        for (int ai = 0; ai < 2; ++ai)
#pragma unroll
            for (int m = 0; m < 4; ++m) { bf16_t* rowp = base + (size_t)(row0 + ai * 128 + m * 16) * ld + col0;
#pragma unroll
                for (int bj = 0; bj < 2; ++bj) { const f32x4 v0 = acc[ai][bj][m][0], v1 = acc[ai][bj][m][1];
                    u32x4 w; w.x = cvt_pk_bf16(v0[0], v0[1]); w.y = cvt_pk_bf16(v0[2], v0[3]); w.z = cvt_pk_bf16(v1[0], v1[1]); w.w = cvt_pk_bf16(v1[2], v1[3]);
                    *(u32x4*)(rowp + bj * 128) = w; } }
    }
};

#define LAS3 __attribute__((address_space(3)))
struct EpiQkvNorm {
    static constexpr bool PERM = true, AFTER_DRAIN = false;
    bf16_t* Q; bf16_t* K; bf16_t* V; const float* qg; const float* kg; LAS3 float* P;
    DI void operator()(const f32x4 (&acc)[2][2][4][2], const Unit& u, int wr, int wc, int fr, int fq) const {
        const int row0 = u.pm * 256 + wr * 64 + fr; int colt = u.pn * 256;
        if (colt >= 2560) {
            const int col0 = colt - 2560 + wc * 32 + 8 * fq;
#pragma unroll
            for (int ai = 0; ai < 2; ++ai)
#pragma unroll
                for (int m = 0; m < 4; ++m) { bf16_t* rowp = V + (size_t)(row0 + ai * 128 + m * 16) * 512 + col0;
#pragma unroll
                    for (int bj = 0; bj < 2; ++bj) { const f32x4 v0 = acc[ai][bj][m][0], v1 = acc[ai][bj][m][1];
                        u32x4 w; w.x = cvt_pk_bf16(v0[0], v0[1]); w.y = cvt_pk_bf16(v0[2], v0[3]); w.z = cvt_pk_bf16(v1[0], v1[1]); w.w = cvt_pk_bf16(v1[2], v1[3]);
                        *(u32x4*)(rowp + bj * 128) = w; } }
            return;
        }
        const bool isq = colt < 2048; bf16_t* base = isq ? Q : K; const int ld = isq ? 2048 : 512; if (!isq) colt -= 2048;
        const int rl0 = wr * 64 + fr;
#pragma unroll
        for (int ai = 0; ai < 2; ++ai)
#pragma unroll
            for (int m = 0; m < 4; ++m)
#pragma unroll
                for (int bj = 0; bj < 2; ++bj) { const f32x4 a = acc[ai][bj][m][0], b = acc[ai][bj][m][1];
                    float s = (a[0] * a[0] + a[1] * a[1]) + (a[2] * a[2] + a[3] * a[3]) + (b[0] * b[0] + b[1] * b[1]) + (b[2] * b[2] + b[3] * b[3]);
                    s += __shfl_xor(s, 16); s += __shfl_xor(s, 32);
                    if (fq == 0) P[((ai * 128 + m * 16 + rl0) * 2 + bj) * 4 + wc] = s; }
        asm volatile("s_waitcnt lgkmcnt(0)" ::: "memory"); __builtin_amdgcn_s_barrier(); asm volatile("" ::: "memory");
        constexpr float QSCALE = 0.08838834764831845f * 1.4426950408889634f;
        const int i0 = 16 * (wc & 1) + 4 * fq, d0 = 64 * (wc >> 1) + i0;
        const float* gp = isq ? qg : kg; f32x4 g0 = *(const f32x4*)(gp + d0), g1 = *(const f32x4*)(gp + d0 + 32);
        if (isq) { g0 = g0 * QSCALE; g1 = g1 * QSCALE; }
        f32x4 ifr;
#pragma unroll
        for (int j = 0; j < 4; ++j) ifr[j] = exp2f(-(float)(i0 + j) * (13.287712379549449f / 32.0f));
        const bool lat = u.pm < 64;
#pragma unroll
        for (int ai = 0; ai < 2; ++ai)
#pragma unroll
            for (int m = 0; m < 4; ++m) { const int row = row0 + ai * 128 + m * 16; const int t = row & (SEQ - 1);
                const float pos = (float)((wc >> 1) == 0 ? (t >> 6) : (t & 63));
                f32x4 cs, sn;
#pragma unroll
                for (int j = 0; j < 4; ++j) { const float ang = pos * ifr[j]; cs[j] = lat ? __cosf(ang) : 1.0f; sn[j] = lat ? __sinf(ang) : 0.0f; }
#pragma unroll
                for (int bj = 0; bj < 2; ++bj) { const f32x4 pp = *(const LAS3 f32x4*)(P + ((ai * 128 + m * 16 + rl0) * 2 + bj) * 4);
                    const float rstd = 1.0f / sqrtf(((pp[0] + pp[1]) + (pp[2] + pp[3])) * (1.0f / HD) + NORM_EPS);
                    const f32x4 a = acc[ai][bj][m][0] * rstd * g0, b = acc[ai][bj][m][1] * rstd * g1;
                    const f32x4 o1 = a * cs - b * sn, o2 = b * cs + a * sn;
                    u32x4 w; w.x = cvt_pk_bf16(o1[0], o1[1]); w.y = cvt_pk_bf16(o1[2], o1[3]); w.z = cvt_pk_bf16(o2[0], o2[1]); w.w = cvt_pk_bf16(o2[2], o2[3]);
                    *(u32x4*)(base + (size_t)row * ld + colt + bj * 128 + wc * 32 + 8 * fq) = w; } }
    }
};

constexpr size_t MiB = 1u << 20;
constexpr size_t WS_CTL = 0, CTL_ZERO_BYTES = 1 * MiB;
constexpr size_t WS_MOD = 1 * MiB;
constexpr size_t WS_MODP = 2 * MiB;
constexpr size_t WS_AFFL = 16 * MiB;
constexpr size_t WS_AFFC = 17 * MiB;
constexpr size_t WS_ROWSRC = 17 * MiB + 512 * 1024;
constexpr size_t WS_GATEV = 18 * MiB;
constexpr size_t WS_INV = 18 * MiB + 512 * 1024;
constexpr size_t WS_W1A = 20 * MiB;
constexpr size_t WS_W1B = 36 * MiB;
constexpr size_t WS_W2 = 44 * MiB;
constexpr size_t WS_WQKV = 52 * MiB;
constexpr size_t WS_WO = 64 * MiB;
constexpr size_t WS_WGU = 72 * MiB;
constexpr size_t WS_WDN = 328 * MiB;
constexpr size_t WS_H = 456 * MiB;
constexpr size_t WS_A = 600 * MiB;
constexpr size_t WS_U = 672 * MiB;
constexpr size_t WS_Z = 744 * MiB;
constexpr size_t WS_Q = WS_U, WS_K = WS_Z, WS_V = WS_Z + 18 * MiB;
constexpr size_t WS_HM = 816 * MiB;
constexpr size_t WS_O = WS_HM;
constexpr size_t WS_Y = 888 * MiB;
constexpr size_t WS_XS = WS_Y;
constexpr size_t WS_END = 1032 * MiB;
constexpr int CW_BAR = 4096;

constexpr int RING_BYTES = 131072;
constexpr int MISC_OFF = RING_BYTES + 14336;
constexpr int LDS_BYTES = 147456;

#define GAS __attribute__((address_space(1)))
#define LAS __attribute__((address_space(3)))
#define LDS_WAIT() asm volatile("s_waitcnt lgkmcnt(0)" ::: "memory")
#define VM_WAIT() asm volatile("s_waitcnt vmcnt(0)" ::: "memory")
#define XB_TMO      128
#define XB_XCNT(j)  (256  + 64 * (j))
#define XB_XSUB(j)  (1280 + 64 * (j))
#define XB_XGEN(j)  (2304 + 64 * (j))
#define XB_TOP      3328
#define XB_TOPGEN   3392
#define XCD_BAR_WORDS 3456
#define XB_SPIN_CAP (1u << 18)

__device__ __forceinline__ unsigned xb_ld(unsigned* p)              { return __hip_atomic_load(p, __ATOMIC_RELAXED, __HIP_MEMORY_SCOPE_AGENT); }
__device__ __forceinline__ unsigned xb_add(unsigned* p, unsigned v) { return __hip_atomic_fetch_add(p, v, __ATOMIC_RELAXED, __HIP_MEMORY_SCOPE_AGENT); }
__device__ __forceinline__ unsigned xb_xcc_id() { return (unsigned)__builtin_amdgcn_s_getreg((3 << 11) | 20) & 0xFu; }
#define XB_SPIN(cond, bar) do { unsigned _sp = 0; while (cond) { __builtin_amdgcn_s_sleep(1); \
    if ((++_sp & 255u) == 0u) { if (xb_ld(&(bar)[XB_TMO])) break; if (_sp > XB_SPIN_CAP) { atomicAdd(&(bar)[XB_TMO], 1u); break; } } } } while (0)

struct XcdBarrier {
    unsigned* bar; unsigned x;
    volatile LAS unsigned* st;
};

__device__ __forceinline__ XcdBarrier xcd_barrier_post(unsigned* bar, volatile LAS unsigned* st) {
    XcdBarrier b; b.bar = bar; b.x = xb_xcc_id(); b.st = st;
    if (threadIdx.x == 0) (void)xb_add(&bar[XB_XCNT(b.x)], 1u);
    return b;
}
__device__ __forceinline__ void xcd_barrier_complete(unsigned* bar, unsigned x, unsigned& nloc, unsigned& nx) {
    const unsigned G = gridDim.x * gridDim.y * gridDim.z;
    unsigned sum, cnt, mine, sp = 0u;
    for (;;) {
        sum = 0u; cnt = 0u; mine = 0u;
#pragma unroll
        for (unsigned j = 0; j < 16; ++j) { const unsigned c = xb_ld(&bar[XB_XCNT(j)]); sum += c; cnt += (c > 0u) ? 1u : 0u; mine = (j == x) ? c : mine; }
        if (sum == G) break;
        __builtin_amdgcn_s_sleep(1);
        if ((++sp & 255u) == 0u) { if (xb_ld(&bar[XB_TMO])) break; if (sp > XB_SPIN_CAP) { atomicAdd(&bar[XB_TMO], 1u); break; } }
    }
    nloc = mine > 0u ? mine : 1u; nx = cnt > 0u ? cnt : 1u;
}

__device__ __forceinline__ void xcd_barrier(const XcdBarrier& b) {
    asm volatile("s_waitcnt vmcnt(0)" ::: "memory");
    __syncthreads();
    if (threadIdx.x == 0) {
        unsigned* bar = b.bar;
        __builtin_amdgcn_s_waitcnt(0);
        unsigned nloc = b.st[0], nx = b.st[1];
        if (nloc == 0u) { xcd_barrier_complete(bar, b.x, nloc, nx); b.st[0] = nloc; b.st[1] = nx; }
        const unsigned old = xb_add(&bar[XB_XSUB(b.x)], 1u);
        const unsigned gen = old / nloc;
        if (old + 1u == (gen + 1u) * nloc) {
            __builtin_amdgcn_fence(__ATOMIC_RELEASE, "agent");
            asm volatile("s_waitcnt vmcnt(0)" ::: "memory");
            const unsigned og = xb_add(&bar[XB_TOP], 1u);
            const unsigned tg = og / nx;
            if (og + 1u == (tg + 1u) * nx) xb_add(&bar[XB_TOPGEN], 1u);
            else XB_SPIN(xb_ld(&bar[XB_TOPGEN]) == tg, bar);
            __builtin_amdgcn_fence(__ATOMIC_ACQUIRE, "agent");
            xb_add(&bar[XB_XGEN(b.x)], 1u);
            asm volatile("s_waitcnt vmcnt(0)" ::: "memory");
        } else {
            XB_SPIN(xb_ld(&bar[XB_XGEN(b.x)]) == gen, bar);
            __builtin_amdgcn_fence(__ATOMIC_ACQUIRE, "agent");
            asm volatile("s_waitcnt vmcnt(0)" ::: "memory");
        }
    }
    __syncthreads();
}

DI float wave_sum(float v) {
#pragma unroll
    for (int o = 1; o < 64; o <<= 1) v += __shfl_xor(v, o);
    return v;
}
DI float rdlane(float v, int l) { return __uint_as_float((unsigned)__builtin_amdgcn_readlane((int)__float_as_uint(v), l)); }
DI unsigned pk2(float lo, float hi) { return cvt_pk_bf16(lo, hi); }

DI void ph_adaln(const float* cnd, const float* cctx, const float* ada_w, float* modp, int gw, int NGW, int lane) {
    for (int task = gw; task < 96 * KSPLIT; task += NGW) {
        const int ks = task & (KSPLIT - 1), cg = task / KSPLIT, l = cg / 48, cgl = cg % 48, col0 = cgl * 256 + lane * 4, k0 = ks * 128;
        float sv[9][2];
#pragma unroll
        for (int r = 0; r < 9; ++r)
#pragma unroll
            for (int hh = 0; hh < 2; ++hh) { const int k = k0 + hh * 64 + lane; const float v = r < 8 ? cnd[r * DM + k] : cctx[k]; sv[r][hh] = v / (1.0f + __expf(-v)); }
        f32x4 acc[9];
#pragma unroll
        for (int r = 0; r < 9; ++r) acc[r] = (f32x4){0.f, 0.f, 0.f, 0.f};
        const float* wp = ada_w + ((size_t)l * DM + k0) * NMOD + col0;
#pragma unroll
        for (int hh = 0; hh < 2; ++hh) {
#pragma unroll 8
            for (int kk = 0; kk < 64; ++kk) {
                const f32x4 w = *(const f32x4*)(wp + (size_t)(hh * 64 + kk) * NMOD);
#pragma unroll
                for (int r = 0; r < 9; ++r) { const float s = rdlane(sv[r][hh], kk); acc[r] += w * s; }
            }
        }
#pragma unroll
        for (int r = 0; r < 9; ++r) *(f32x4*)(modp + ((size_t)((ks * 2 + l) * 9 + r)) * NMOD + col0) = acc[r];
    }
}
struct CvtPtrs { const float *cin, *cout, *wqkv, *wo, *wg, *wu, *wd; bf16_t *W1A, *W1B, *W2, *WQKV, *WO, *WGU, *WDN; };
constexpr int CVT_E0 = 6656, CVT_L = 24576, CVT_TOTAL = CVT_E0 + 2 * CVT_L;
DI void cvt_resolve(const CvtPtrs& P, int it, const float*& src, int& ldw, bf16_t*& dst, int& ldd, bool& qperm) {
    int r = it; qperm = false;
    if (r < 3072) { const int kt = ((r >> 3) / 96) * 8 + (r & 7), nt = (r >> 3) % 96, n0 = nt * 64, part = n0 >> 11, j0 = n0 & 2047;
        src = P.cin + (size_t)(kt * 64) * 6144 + n0; ldw = 6144; ldd = DM;
        dst = (part == 0 ? P.W1B + (size_t)j0 * DM : P.W1A + (size_t)((j0 >> 7) * 256 + (part == 2 ? 128 : 0) + (j0 & 127)) * DM) + kt * 64; return; } r -= 3072;
    if (r < 1024) { const int kt = ((r >> 3) / 32) * 8 + (r & 7), nt = (r >> 3) % 32; src = P.cout + (size_t)(kt * 64) * DM + nt * 64; ldw = DM; dst = P.W2 + (size_t)(nt * 64) * DM + kt * 64; ldd = DM; return; } r -= 1024;
    if (r < 1536) { const int kt = ((r >> 3) / 48) * 8 + (r & 7), nt = (r >> 3) % 48; src = P.wqkv + (size_t)(kt * 64) * 3072 + nt * 64; ldw = 3072; qperm = nt < 40;     dst = P.WQKV + (size_t)(nt * 64) * DM + kt * 64; ldd = DM; return; } r -= 1536;
    if (r < 1024) { const int kt = ((r >> 3) / 32) * 8 + (r & 7), nt = (r >> 3) % 32; src = P.wo + (size_t)(kt * 64) * DM + nt * 64; ldw = DM; dst = P.WO + (size_t)(nt * 64) * DM + kt * 64; ldd = DM; return; } r -= 1024;
    const int l = r / CVT_L, rr = r % CVT_L, kind = rr / 8192, q = rr % 8192, le = l * 16 + q / 512, rem = q % 512;
    if (kind < 2) { const int kt = ((rem >> 3) / 16) * 8 + (rem & 7), nt = (rem >> 3) % 16, n0 = nt * 64;
        src = (kind ? P.wu : P.wg) + (size_t)le * DM * DFF + (size_t)(kt * 64) * DFF + n0; ldw = DFF;
        dst = P.WGU + (size_t)(le * 2048 + (n0 >> 7) * 256 + kind * 128 + (n0 & 127)) * DM + kt * 64; ldd = DM; }
    else { const int kt = ((rem >> 3) / 32) * 8 + (rem & 7), nt = (rem >> 3) % 32;
        src = P.wd + (size_t)le * DFF * DM + (size_t)(kt * 64) * DM + nt * 64; ldw = DM; dst = P.WDN + (size_t)(le * 2048 + nt * 64) * DFF + kt * 64; ldd = DFF; }
}
constexpr int CVT_P = 36;
DI void cvt_range(const CvtPtrs& P, int lo, int hi, int w, int NW, LAS unsigned* scr, int lane) {
    int it = lo + w; if (it >= hi) return;
    const int c = lane & 15, q = lane >> 4;
    const float* src; int ldw; bf16_t* dst; int ldd; bool qperm; cvt_resolve(P, it, src, ldw, dst, ldd, qperm);
    f32x4 v[16];
#pragma unroll
    for (int rr = 0; rr < 16; ++rr) v[rr] = __builtin_nontemporal_load((const f32x4*)(src + (size_t)(16 * q + rr) * ldw + 4 * c));
    for (;;) {
        u32x4 pa[4], pb[4];
#pragma unroll
        for (int i = 0; i < 4; ++i) { pa[i].x = pk2(v[0][i], v[1][i]); pa[i].y = pk2(v[2][i], v[3][i]); pa[i].z = pk2(v[4][i], v[5][i]); pa[i].w = pk2(v[6][i], v[7][i]);
                                      pb[i].x = pk2(v[8][i], v[9][i]); pb[i].y = pk2(v[10][i], v[11][i]); pb[i].z = pk2(v[12][i], v[13][i]); pb[i].w = pk2(v[14][i], v[15][i]); }
        const int nit = it + NW; bf16_t* cdst = dst; const int cldd = ldd; const int wrow = qperm ? 32 * ((c >> 2) & 1) + 8 * (c & 3) + 4 * (c >> 3) : 4 * c;
        if (nit < hi) { cvt_resolve(P, nit, src, ldw, dst, ldd, qperm);
#pragma unroll
            for (int rr = 0; rr < 16; ++rr) v[rr] = __builtin_nontemporal_load((const f32x4*)(src + (size_t)(16 * q + rr) * ldw + 4 * c)); }
#pragma unroll
        for (int i = 0; i < 4; ++i) { *(LAS u32x4*)(scr + (wrow + i) * CVT_P + 8 * q) = pa[i]; *(LAS u32x4*)(scr + (wrow + i) * CVT_P + 8 * q + 4) = pb[i]; }
        LDS_WAIT(); asm volatile("" ::: "memory");
#pragma unroll
        for (int j = 0; j < 8; ++j) { const int n = (lane >> 3) + 8 * j; const u32x4 o = *(const LAS u32x4*)(scr + n * CVT_P + 4 * (lane & 7));
            *(u32x4*)(cdst + (size_t)n * cldd + 8 * (lane & 7)) = o; }
        LDS_WAIT(); asm volatile("" ::: "memory");
        if (nit >= hi) break;
        it = nit;
    }
}
DI void ph_modred(const float* modp, const float* ada_b, float* mod, int gtid, int GT) {
    for (int i = gtid; i < 2 * 9 * NMOD; i += GT) { const int l = i / (9 * NMOD), j = i % NMOD; float s = ada_b[l * NMOD + j];
#pragma unroll
        for (int ks = 0; ks < KSPLIT; ++ks) s += modp[(size_t)ks * (2 * 9 * NMOD) + i];
        mod[i] = s; }
}
DI void row_load(const float* p, f32x4 (&v)[8], int lane) {
#pragma unroll
    for (int j = 0; j < 8; ++j) v[j] = *(const f32x4*)(p + 4 * lane + 256 * j);
}
DI void row_load_bf(const bf16_t* p, f32x4 (&v)[8], int lane) {
#pragma unroll
    for (int j = 0; j < 8; ++j) { const u32x2 w = *(const u32x2*)(p + 4 * lane + 256 * j); v[j] = (f32x4){bf_lo(w.x), bf_hi(w.x), bf_lo(w.y), bf_hi(w.y)}; }
}
DI void row_modulate(const f32x4 (&v)[8], f32x4 (&y)[8], const float* gain, const float* shift, const float* scale, int lane) {
    float ss = 0.f;
#pragma unroll
    for (int j = 0; j < 8; ++j) ss += (v[j][0] * v[j][0] + v[j][1] * v[j][1]) + (v[j][2] * v[j][2] + v[j][3] * v[j][3]);
    ss = wave_sum(ss);
    const float rstd = 1.0f / sqrtf(ss * (1.0f / DM) + NORM_EPS);
#pragma unroll
    for (int j = 0; j < 8; ++j) { const int c = 4 * lane + 256 * j; const f32x4 g = *(const f32x4*)(gain + c), sh = *(const f32x4*)(shift + c), sc = *(const f32x4*)(scale + c);
        y[j] = ((v[j] * rstd) * g) * (sc + 1.0f) + sh; }
}
DI void row_modulate2(const f32x4 (&v0)[8], const f32x4 (&v1)[8], f32x4 (&y0)[8], f32x4 (&y1)[8], const float* gain, const float* shift, const float* scale, int lane) {
    float s0 = 0.f, s1 = 0.f;
#pragma unroll
    for (int j = 0; j < 8; ++j) { s0 += (v0[j][0] * v0[j][0] + v0[j][1] * v0[j][1]) + (v0[j][2] * v0[j][2] + v0[j][3] * v0[j][3]); s1 += (v1[j][0] * v1[j][0] + v1[j][1] * v1[j][1]) + (v1[j][2] * v1[j][2] + v1[j][3] * v1[j][3]); }
    s0 = wave_sum(s0); s1 = wave_sum(s1);
    const float r0 = 1.0f / sqrtf(s0 * (1.0f / DM) + NORM_EPS), r1 = 1.0f / sqrtf(s1 * (1.0f / DM) + NORM_EPS);
#pragma unroll
    for (int j = 0; j < 8; ++j) { const int c = 4 * lane + 256 * j; const f32x4 g = *(const f32x4*)(gain + c), sh = *(const f32x4*)(shift + c), sc = *(const f32x4*)(scale + c);
        y0[j] = ((v0[j] * r0) * g) * (sc + 1.0f) + sh; y1[j] = ((v1[j] * r1) * g) * (sc + 1.0f) + sh; }
}
DI void row_store_bf16(bf16_t* p, const f32x4 (&y)[8], int lane) {
#pragma unroll
    for (int j = 0; j < 8; ++j) { u32x2 w; w.x = pk2(y[j][0], y[j][1]); w.y = pk2(y[j][2], y[j][3]); *(u32x2*)(p + 4 * lane + 256 * j) = w; }
}
DI void ph_mod0(const float* x, const float* ctx, const float* gain, const float* mod0, bf16_t* A, int gw, int NGW, int lane) {
    for (int row = gw; row < MT; row += NGW) {
        const int cr = row < ML ? (row >> 11) : 8; const float* src = row < ML ? x + (size_t)row * DM : ctx + (size_t)(row - ML) * DM;
        f32x4 v[8], y[8]; row_load(src, v, lane);
        row_modulate(v, y, gain, mod0 + (size_t)cr * NMOD + 0 * DM, mod0 + (size_t)cr * NMOD + 1 * DM, lane);
        row_store_bf16(A + (size_t)row * DM, y, lane);
    }
}
DI float reduce8(const float (&v)[8], int lane) {
    const bool u0 = lane & 1, u1 = lane & 2, u2 = lane & 4;
    float a[4], b2[2];
#pragma unroll
    for (int k = 0; k < 4; ++k) { const float lo = v[2 * k], hi = v[2 * k + 1]; a[k] = (u0 ? hi : lo) + __shfl_xor(u0 ? lo : hi, 1); }
#pragma unroll
    for (int k = 0; k < 2; ++k) { const float lo = a[2 * k], hi = a[2 * k + 1]; b2[k] = (u1 ? hi : lo) + __shfl_xor(u1 ? lo : hi, 2); }
    return (u2 ? b2[1] : b2[0]) + __shfl_xor(u2 ? b2[0] : b2[1], 4);
}
DI float reduce_halves(float lo8, float hi8, int lane) {
    const bool u3 = lane & 8;
    float t = (u3 ? hi8 : lo8) + __shfl_xor(u3 ? lo8 : hi8, 8);
    t += __shfl_xor(t, 16); t += __shfl_xor(t, 32); return t;
}
DI float softmax16(float lg) {
    float mx = lg;
#pragma unroll
    for (int o = 1; o < 16; o <<= 1) mx = fmaxf(mx, __shfl_xor(mx, o));
    const float ex = __expf(lg - mx); float den = ex;
#pragma unroll
    for (int o = 1; o < 16; o <<= 1) den += __shfl_xor(den, o);
    return ex / den;
}
DI void aff_store(float v, float* affL, float* affC, int row, int lane) {
    if (lane < 16) { if (row < ML) { const int b = row >> 11, n = row & 2047; affL[(size_t)(b * 16 + lane) * SEQ + n] = v; }
                     else { const int rc = row - ML, b = rc >> 8, n = rc & 255; affC[(size_t)(b * 16 + lane) * CTXL + n] = v; } }
}
DI void router_rows2(const f32x4 (&y0)[8], const f32x4 (&y1)[8], const LAS float* rwT, float* affL, float* affC, int row0, int lane) {
    float r0[2], r1[2];
#pragma unroll
    for (int hf = 0; hf < 2; ++hf) {
        float l0[8], l1[8];
#pragma unroll
        for (int e = 0; e < 8; ++e) { float s0 = 0.f, s1 = 0.f;
#pragma unroll
            for (int j = 0; j < 8; ++j) { const f32x4 w = *(const LAS f32x4*)(rwT + (8 * hf + e) * DM + 4 * lane + 256 * j);
                s0 += (y0[j][0] * w[0] + y0[j][1] * w[1]) + (y0[j][2] * w[2] + y0[j][3] * w[3]); s1 += (y1[j][0] * w[0] + y1[j][1] * w[1]) + (y1[j][2] * w[2] + y1[j][3] * w[3]); }
            l0[e] = s0; l1[e] = s1; __builtin_amdgcn_sched_barrier(0); }
        r0[hf] = reduce8(l0, lane); r1[hf] = reduce8(l1, lane);
    }
    const float a0 = softmax16(reduce_halves(r0[0], r0[1], lane)), a1 = softmax16(reduce_halves(r1[0], r1[1], lane));
    aff_store(a0, affL, affC, row0, lane); aff_store(a1, affL, affC, row0 + 1, lane);
}
DI void load_router(const float* rw, LAS float* rwT, int tid) {
    for (int i = tid; i < DM * 16; i += 512) rwT[(i & 15) * DM + (i >> 4)] = rw[i];
    __syncthreads();
}
DI void ph_modffn(const bf16_t* H, const float* gain, const float* modl, bf16_t* A, const LAS float* rwT, float* affL, float* affC, int nrows, int gw, int NGW, int lane) {
    for (int rp = gw; rp < nrows / 2; rp += NGW) {
        const int row = 2 * rp; const int cr = row < ML ? (row >> 11) : 8;
        u32x2 p0[8], p1[8];
#pragma unroll
        for (int j = 0; j < 8; ++j) { p0[j] = *(const u32x2*)(H + (size_t)row * DM + 4 * lane + 256 * j); p1[j] = *(const u32x2*)(H + (size_t)(row + 1) * DM + 4 * lane + 256 * j); }
        float s0 = 0.f, s1 = 0.f;
#pragma unroll
        for (int j = 0; j < 8; ++j) { const float a0 = bf_lo(p0[j].x), a1 = bf_hi(p0[j].x), a2 = bf_lo(p0[j].y), a3 = bf_hi(p0[j].y); s0 += (a0 * a0 + a1 * a1) + (a2 * a2 + a3 * a3);
                                      const float b0 = bf_lo(p1[j].x), b1 = bf_hi(p1[j].x), b2 = bf_lo(p1[j].y), b3 = bf_hi(p1[j].y); s1 += (b0 * b0 + b1 * b1) + (b2 * b2 + b3 * b3); }
        s0 = wave_sum(s0); s1 = wave_sum(s1);
        const float r0 = 1.0f / sqrtf(s0 * (1.0f / DM) + NORM_EPS), r1 = 1.0f / sqrtf(s1 * (1.0f / DM) + NORM_EPS);
        const float* shift = modl + (size_t)cr * NMOD + 3 * DM; const float* scale = modl + (size_t)cr * NMOD + 4 * DM;
        f32x4 y0[8], y1[8];
#pragma unroll
        for (int j = 0; j < 8; ++j) { const int c = 4 * lane + 256 * j; const f32x4 g = *(const f32x4*)(gain + c), sh = *(const f32x4*)(shift + c), sc = *(const f32x4*)(scale + c);
            const f32x4 v0 = (f32x4){bf_lo(p0[j].x), bf_hi(p0[j].x), bf_lo(p0[j].y), bf_hi(p0[j].y)}, v1 = (f32x4){bf_lo(p1[j].x), bf_hi(p1[j].x), bf_lo(p1[j].y), bf_hi(p1[j].y)};
            y0[j] = ((v0 * r0) * g) * (sc + 1.0f) + sh; y1[j] = ((v1 * r1) * g) * (sc + 1.0f) + sh;
            u32x2 w0, w1; w0.x = pk2(y0[j][0], y0[j][1]); w0.y = pk2(y0[j][2], y0[j][3]); w1.x = pk2(y1[j][0], y1[j][1]); w1.y = pk2(y1[j][2], y1[j][3]);
            *(u32x2*)(A + (size_t)row * DM + c) = w0; *(u32x2*)(A + (size_t)(row + 1) * DM + c) = w1; }
        asm volatile("" ::: "memory");
        router_rows2(y0, y1, rwT, affL, affC, row, lane);
    }
}
DI void ph_topk(int nitems, const float* affL, const float* affC, int* rowsrc, float* gatev, int* inv, LAS unsigned* hist, int tid, int lane, int wave, int bid, int G) {
    LAS unsigned* sh = hist + 256;
    for (int it = bid; it < nitems; it += G) {
        const bool isc = it >= 128; const int be = it & 127, b = be >> 4, e = be & 15;
        const int N = isc ? CTXL : SEQ, C = isc ? CAPC : CAPL;
        const float* src = isc ? affC + (size_t)be * CTXL : affL + (size_t)be * SEQ;
        const int i0 = tid * 4; const bool valid = i0 < N;
        unsigned key[4];
        { f32x4 v = (f32x4){0.f, 0.f, 0.f, 0.f}; if (valid) v = *(const f32x4*)(src + i0);
#pragma unroll
          for (int q = 0; q < 4; ++q) key[q] = __float_as_uint(v[q]); }
        unsigned prefix = 0u, mask = 0u, krem = (unsigned)C;
        for (int pass = 3; pass >= 0; --pass) {
            const int shift = pass * 8;
            if (tid < 256) hist[tid] = 0u;
            __syncthreads();
            if (valid) {
#pragma unroll
                for (int q = 0; q < 4; ++q) if ((key[q] & mask) == prefix) __hip_atomic_fetch_add(&hist[(key[q] >> shift) & 255u], 1u, __ATOMIC_RELAXED, __HIP_MEMORY_SCOPE_WORKGROUP); }
            __syncthreads();
            if (wave == 0) {
                const unsigned h0 = hist[4 * lane], h1 = hist[4 * lane + 1], h2 = hist[4 * lane + 2], h3 = hist[4 * lane + 3];
                const unsigned tot = h0 + h1 + h2 + h3; unsigned incl = tot;
#pragma unroll
                for (int o = 1; o < 64; o <<= 1) { const unsigned t = __shfl_down(incl, o); if (lane + o < 64) incl += t; }
                const unsigned a3 = incl - tot, a2 = a3 + h3, a1 = a2 + h2, a0 = a1 + h1;
                if (a3 < krem && krem <= a3 + h3) { sh[0] = 4 * lane + 3; sh[1] = krem - a3; }
                if (a2 < krem && krem <= a2 + h2) { sh[0] = 4 * lane + 2; sh[1] = krem - a2; }
                if (a1 < krem && krem <= a1 + h1) { sh[0] = 4 * lane + 1; sh[1] = krem - a1; }
                if (a0 < krem && krem <= a0 + h0) { sh[0] = 4 * lane + 0; sh[1] = krem - a0; }
            }
            __syncthreads();
            const unsigned B = sh[0]; krem = sh[1]; prefix |= B << shift; mask |= 0xFFu << shift;
        }
        const unsigned T = prefix;
        unsigned cg = 0u, ce = 0u;
        if (valid) {
#pragma unroll
            for (int q = 0; q < 4; ++q) { cg += key[q] > T ? 1u : 0u; ce += key[q] == T ? 1u : 0u; } }
        const unsigned mine = cg | (ce << 16); unsigned incl = mine;
#pragma unroll
        for (int o = 1; o < 64; o <<= 1) { const unsigned t = __shfl_up(incl, o); if (lane >= o) incl += t; }
        if (lane == 63) sh[8 + wave] = incl;
        __syncthreads();
        unsigned woff = 0u;
#pragma unroll
        for (int w = 0; w < 8; ++w) woff += (w < wave) ? sh[8 + w] : 0u;
        const unsigned excl = woff + incl - mine; unsigned gtb = excl & 0xFFFFu, eqb = excl >> 16;
        if (valid) {
            const int ybase = e * YR + (isc ? NB * CAPL + b * CAPC : b * CAPL); const int rbase = isc ? ML + b * CTXL : b * SEQ;
#pragma unroll
            for (int q = 0; q < 4; ++q) {
                const bool isg = key[q] > T, ise = key[q] == T; const bool sel = isg || (ise && eqb < krem);
                const unsigned slot = gtb + (eqb < krem ? eqb : krem);
                const int trow = rbase + i0 + q; const int yrow = ybase + (int)slot;
                if (sel) { rowsrc[yrow] = trow; gatev[yrow] = __uint_as_float(key[q]); }
                inv[(size_t)trow * 16 + e] = sel ? yrow : -1;
                gtb += isg ? 1u : 0u; eqb += ise ? 1u : 0u;
            }
        }
        __syncthreads();
    }
}
DI void ph_gather(const bf16_t* A, const int* rowsrc, bf16_t* XS, bool with_ctx, int gw, int NGW, int lane) {
    for (int yr = gw; yr < YT; yr += NGW) {
        if (!with_ctx && (yr % YR) >= NB * CAPL) continue;
        const int src = rowsrc[yr];
        const u32x4* s = (const u32x4*)(A + (size_t)src * DM); u32x4* d = (u32x4*)(XS + (size_t)yr * DM);
#pragma unroll
        for (int j = 0; j < 4; ++j) d[lane + 64 * j] = s[lane + 64 * j];
    }
}
template <bool LAST> DI void ph_combine(bf16_t* H, const bf16_t* Y, const int* inv, const float* modl  , const float* gain1, const float* mod1, bf16_t* A, float* out, int nrows, int gw, int NGW, int lane) {
    for (int row = gw; row < nrows; row += NGW) {
        const int cr = row < ML ? (row >> 11) : 8;
        f32x4 v[8], acc[8]; row_load_bf(H + (size_t)row * DM, v, lane);
#pragma unroll
        for (int j = 0; j < 8; ++j) acc[j] = (f32x4){0.f, 0.f, 0.f, 0.f};
        const int myinv = inv[(size_t)row * 16 + (lane & 15)];
        for (int e = 0; e < 16; ++e) {
            const int yr = __builtin_amdgcn_readlane(myinv, e);
            if (yr >= 0) { const bf16_t* yp = Y + (size_t)yr * DM + 4 * lane;
#pragma unroll
                for (int j = 0; j < 8; ++j) { const u32x2 p = *(const u32x2*)(yp + 256 * j); acc[j][0] += bf_lo(p.x); acc[j][1] += bf_hi(p.x); acc[j][2] += bf_lo(p.y); acc[j][3] += bf_hi(p.y); } }
        }
        const float* g2 = modl + (size_t)cr * NMOD + 5 * DM;
#pragma unroll
        for (int j = 0; j < 8; ++j) { const f32x4 g = *(const f32x4*)(g2 + 4 * lane + 256 * j); v[j] = v[j] + g * acc[j]; }
        if (LAST) {
#pragma unroll
            for (int j = 0; j < 8; ++j) *(f32x4*)(out + (size_t)row * DM + 4 * lane + 256 * j) = v[j];
        } else {
            row_store_bf16(H + (size_t)row * DM, v, lane);
            f32x4 y[8]; row_modulate(v, y, gain1, mod1 + (size_t)cr * NMOD + 0 * DM, mod1 + (size_t)cr * NMOD + 1 * DM, lane);
            row_store_bf16(A + (size_t)row * DM, y, lane);
        }
    }
}
DI void ph_qknorm(bf16_t* Q, bf16_t* K, const float* qg, const float* kg, int gw, int NGW, int lane) {
    const int half = lane >> 5, i = lane & 31, d1 = half * 64 + i, d2 = d1 + 32;
    const float inv_freq = exp2f(-(float)i * (13.287712379549449f / 32.0f));
    constexpr float QSCALE = 0.08838834764831845f * 1.4426950408889634f;
    const float qg1 = qg[d1] * QSCALE, qg2 = qg[d2] * QSCALE, kg1 = kg[d1], kg2 = kg[d2];
    for (int row = gw; row < MT; row += NGW) {
        const bool lat = row < ML; const int t = row & (SEQ - 1);
        const float pos = (float)(half == 0 ? (t >> 6) : (t & 63)); const float ang = pos * inv_freq;
        const float cs = lat ? __cosf(ang) : 1.0f, sn = lat ? __sinf(ang) : 0.0f;
        if (lat) {
            for (int hd = 0; hd < NH; ++hd) { bf16_t* p = Q + (size_t)row * DM + hd * HD;
                float x1 = __uint_as_float((unsigned)p[d1] << 16), x2 = __uint_as_float((unsigned)p[d2] << 16);
                const float ss = wave_sum(x1 * x1 + x2 * x2); const float rstd = 1.0f / sqrtf(ss * (1.0f / HD) + NORM_EPS);
                x1 = x1 * rstd * qg1; x2 = x2 * rstd * qg2;
                const float o1 = x1 * cs - x2 * sn, o2 = x2 * cs + x1 * sn;
                const unsigned w = pk2(o1, o2); p[d1] = (bf16_t)(w & 0xffffu); p[d2] = (bf16_t)(w >> 16); }
        }
        for (int kh = 0; kh < NKV; ++kh) { bf16_t* p = K + (size_t)row * 512 + kh * HD;
            float x1 = __uint_as_float((unsigned)p[d1] << 16), x2 = __uint_as_float((unsigned)p[d2] << 16);
            const float ss = wave_sum(x1 * x1 + x2 * x2); const float rstd = 1.0f / sqrtf(ss * (1.0f / HD) + NORM_EPS);
            x1 = x1 * rstd * kg1; x2 = x2 * rstd * kg2;
            const float o1 = x1 * cs - x2 * sn, o2 = x2 * cs + x1 * sn;
            const unsigned w = pk2(o1, o2); p[d1] = (bf16_t)(w & 0xffffu); p[d2] = (bf16_t)(w >> 16); }
    }
}
constexpr int KP = 272;
constexpr int ATT_VOFF = 64 * KP;
constexpr int ATT_TILE = 2 * 64 * KP;
DI int crow(int reg, int h) { return (reg & 3) + 8 * (reg >> 2) + 4 * h; }
DI long long vtr64(const LAS unsigned char* p) { typedef short v4i16_t __attribute__((ext_vector_type(4))); return __builtin_bit_cast(long long, __builtin_amdgcn_ds_read_tr16_b64_v4i16((LAS v4i16_t*)p)); }
DI s16x4 vtr(const LAS unsigned char* p) { typedef short v4i16_t __attribute__((ext_vector_type(4))); return __builtin_bit_cast(s16x4, __builtin_amdgcn_ds_read_tr16_b64_v4i16((LAS v4i16_t*)p)); }
DI bool att_tile_info(int item, int ti, int& base, int& mtype) {
    const int qhalf = item & 1, n = (item >> 3) & 15, b = item >> 7, tt = ti & 1; mtype = 0;
    if (ti < 4) { base = ML + b * CTXL + 64 * ti; return true; }
    const int blk = n - 1 + ((ti - 4) >> 1); if (blk < 0 || blk > 15) return false;
    if (ti < 6) { mtype = 1; if (tt == 0 && qhalf == 1) return false; } else if (ti >= 8) { mtype = 2; if (tt == 1 && qhalf == 0) return false; }
    base = b * SEQ + blk * 128 + 64 * tt; return true;
}
DI void att_next(int& item, int& ti, int G) { for (;;) { ++ti; if (ti >= 10) { ti = 0; item += G; return; } int b_, m_; if (att_tile_info(item, ti, b_, m_)) return; } }
DI void ph_attn(const bf16_t* Q, const bf16_t* Kb, const bf16_t* Vb, bf16_t* O, const float* sink, LAS unsigned char* lds, int tid, int lane, int wave, int bid, int G) {
    constexpr float LOG2E = 1.4426950408889634f;
    const int r = lane & 31, h = lane >> 5, g = wave >> 1, sub = wave & 1;
    const int ldrow = tid >> 3, ldc = tid & 7;
    int item = bid, ti = 0; if (item >= 1024) return;
    u32x4 kr[2], vr[2];
#define ATT_ISSUE(it_, ti_) do { int base_, mt_; att_tile_info(it_, ti_, base_, mt_); const int kvh_ = ((it_) >> 1) & 3; \
        _Pragma("unroll") for (int c2 = 0; c2 < 2; ++c2) { const size_t off_ = (size_t)(base_ + ldrow) * 512 + kvh_ * HD + (ldc + 8 * c2) * 8; kr[c2] = *(const u32x4*)(Kb + off_); vr[c2] = *(const u32x4*)(Vb + off_); } } while (0)
    bf16x8 qf[8]; float m2 = 0.f, lsum = 1.f; f32x16 o[4]; f32x16 negm;
#define ATT_QLOAD(it_) do { const int qrow_ = ((it_) >> 7) * SEQ + (((it_) >> 3) & 15) * 128 + ((it_) & 1) * 64 + sub * 32 + r; const int head_ = (((it_) >> 1) & 3) * 4 + g; \
        _Pragma("unroll") for (int s = 0; s < 8; ++s) qf[s] = *(const bf16x8*)(Q + (size_t)qrow_ * DM + head_ * HD + 16 * s + 8 * h); } while (0)
    ATT_QLOAD(item);
    ATT_ISSUE(item, ti);
    int buf = 0;
    while (item < 1024) {
        int nitem = item, nti = ti; att_next(nitem, nti, G);
        LAS unsigned char* tb = lds + buf * ATT_TILE;
#pragma unroll
        for (int c2 = 0; c2 < 2; ++c2) { *(LAS u32x4*)(tb + ldrow * KP + (ldc + 8 * c2) * 16) = kr[c2]; *(LAS u32x4*)(tb + ATT_VOFF + ldrow * KP + (ldc + 8 * c2) * 16) = vr[c2]; }
        if (nitem < 1024) ATT_ISSUE(nitem, nti);
        asm volatile("s_waitcnt lgkmcnt(0)" ::: "memory"); __builtin_amdgcn_s_barrier(); asm volatile("" ::: "memory");
        int base, mtype; att_tile_info(item, ti, base, mtype); const int tt = ti & 1;
        const int qhalf = item & 1, kvh = (item >> 1) & 3, n = (item >> 3) & 15, b = item >> 7;
        const int head = kvh * 4 + g, qq = qhalf * 64 + sub * 32 + r; const int qrow = b * SEQ + n * 128 + qq;
        if (ti == 0) {
            m2 = sink[head] * LOG2E; lsum = 1.0f;
#pragma unroll
            for (int i = 0; i < 16; ++i) negm[i] = -m2;
#pragma unroll
            for (int d = 0; d < 4; ++d)
#pragma unroll
                for (int i = 0; i < 16; ++i) o[d][i] = 0.f;
        }
        f32x16 x0, x1;
#pragma unroll
        for (int s = 0; s < 8; ++s) {
            const bf16x8 k0 = *(const LAS bf16x8*)(tb + r * KP + (16 * s + 8 * h) * 2), k1 = *(const LAS bf16x8*)(tb + (32 + r) * KP + (16 * s + 8 * h) * 2);
            if (s == 0) { x0 = __builtin_amdgcn_mfma_f32_32x32x16_bf16(k0, qf[s], negm, 0, 0, 0); x1 = __builtin_amdgcn_mfma_f32_32x32x16_bf16(k1, qf[s], negm, 0, 0, 0); }
            else { x0 = __builtin_amdgcn_mfma_f32_32x32x16_bf16(k0, qf[s], x0, 0, 0, 0); x1 = __builtin_amdgcn_mfma_f32_32x32x16_bf16(k1, qf[s], x1, 0, 0, 0); } }
        if (nitem != item && nitem < 1024) ATT_QLOAD(nitem);
        if (mtype == 1) {
#pragma unroll
            for (int i = 0; i < 16; ++i) { const int kk0 = tt * 64 + crow(i, h); if (kk0 < qq) x0[i] = -1.0e30f; if (kk0 + 32 < qq) x1[i] = -1.0e30f; } }
        if (mtype == 2) {
#pragma unroll
            for (int i = 0; i < 16; ++i) { const int kk0 = tt * 64 + crow(i, h); if (kk0 > qq) x0[i] = -1.0e30f; if (kk0 + 32 > qq) x1[i] = -1.0e30f; } }
        float tmax = fmaxf(x0[0], x1[0]);
#pragma unroll
        for (int i = 1; i < 16; ++i) tmax = fmaxf(fmaxf(tmax, x0[i]), x1[i]);
        tmax = fmaxf(tmax, __shfl_xor(tmax, 32));
        if (__any(tmax > 0.0f)) {
            const float dl = fmaxf(tmax, 0.0f), alpha = __builtin_amdgcn_exp2f(-dl); m2 += dl; lsum *= alpha;
#pragma unroll
            for (int i = 0; i < 16; ++i) { x0[i] -= dl; x1[i] -= dl; negm[i] = -m2; }
#pragma unroll
            for (int d = 0; d < 4; ++d)
#pragma unroll
                for (int i = 0; i < 16; ++i) o[d][i] *= alpha;
        }
        float ps = 0.f;
#pragma unroll
        for (int i = 0; i < 16; ++i) { x0[i] = __builtin_amdgcn_exp2f(x0[i]); x1[i] = __builtin_amdgcn_exp2f(x1[i]); ps += x0[i] + x1[i]; }
        ps += __shfl_xor(ps, 32); lsum += ps;
        bf16x8 pf[2][2];
#pragma unroll
        for (int s = 0; s < 2; ++s) {
            u32x4 a, c; a.x = pk2(x0[8 * s + 0], x0[8 * s + 1]); a.y = pk2(x0[8 * s + 2], x0[8 * s + 3]); a.z = pk2(x0[8 * s + 4], x0[8 * s + 5]); a.w = pk2(x0[8 * s + 6], x0[8 * s + 7]);
            c.x = pk2(x1[8 * s + 0], x1[8 * s + 1]); c.y = pk2(x1[8 * s + 2], x1[8 * s + 3]); c.z = pk2(x1[8 * s + 4], x1[8 * s + 5]); c.w = pk2(x1[8 * s + 6], x1[8 * s + 7]);
            pf[0][s] = __builtin_bit_cast(bf16x8, a); pf[1][s] = __builtin_bit_cast(bf16x8, c); }
        const LAS unsigned char* vb = tb + ATT_VOFF + (4 * h + ((lane & 15) >> 2)) * KP + (16 * ((lane >> 4) & 1) + 4 * (lane & 3)) * 2;
#pragma unroll
        for (int d = 0; d < 4; ++d)
#pragma unroll
            for (int t = 0; t < 2; ++t)
#pragma unroll
                for (int s = 0; s < 2; ++s) {
                    typedef long long i64x2_t __attribute__((ext_vector_type(2)));
                    i64x2_t vv; vv.x = vtr64(vb + (t * 32 + 16 * s) * KP + d * 64); vv.y = vtr64(vb + (t * 32 + 16 * s + 8) * KP + d * 64);
                    const bf16x8 vf = __builtin_bit_cast(bf16x8, vv);
                    o[d] = __builtin_amdgcn_mfma_f32_32x32x16_bf16(vf, pf[t][s], o[d], 0, 0, 0); }
        if (nitem != item) {
            const float il = 1.0f / lsum;
            bf16_t* op = O + (size_t)qrow * DM + head * HD + 4 * h;
#pragma unroll
            for (int d = 0; d < 4; ++d)
#pragma unroll
                for (int g4 = 0; g4 < 4; ++g4) { u32x2 w; w.x = pk2(o[d][4 * g4 + 0] * il, o[d][4 * g4 + 1] * il); w.y = pk2(o[d][4 * g4 + 2] * il, o[d][4 * g4 + 3] * il);
                    *(u32x2*)(op + d * 32 + 8 * g4) = w; }
        }
        item = nitem; ti = nti; buf ^= 1;
    }
#undef ATT_ISSUE
#undef ATT_QLOAD
}

#ifndef MK_ONE_LAUNCH
#define MK_ONE_LAUNCH 1
#endif
constexpr int NPHASE = 19;
#ifndef MK_CVT_JIT
#define MK_CVT_JIT 1
#endif
#ifndef MK_CVT_Q
#define MK_CVT_Q 0
#endif
constexpr int CVT_Q = MK_CVT_Q;
constexpr int CVT_X0_END = CVT_E0 + CVT_L;
constexpr int CVT_R3_LO = CVT_X0_END - 3 * CVT_Q, CVT_R4_LO = CVT_X0_END - 2 * CVT_Q, CVT_R5_LO = CVT_X0_END - CVT_Q;
constexpr int CVT_R9_LO = CVT_TOTAL - 5 * CVT_Q / 2, CVT_R10_LO = CVT_TOTAL - 3 * CVT_Q / 2, CVT_R12_LO = CVT_TOTAL - CVT_Q;
static_assert(CVT_Q <= 8192 && CVT_Q % 2 == 0, "tail quota");
#define CVT_MKCP() CvtPtrs CP; CP.cin = args.in[8]; CP.cout = args.in[10]; CP.wqkv = args.in[11]; CP.wo = args.in[15]; CP.wg = args.in[17]; CP.wu = args.in[18]; CP.wd = args.in[19]; \
    CP.W1A = W1A; CP.W1B = W1B; CP.W2 = W2; CP.WQKV = WQKV; CP.WO = WOt; CP.WGU = WGU; CP.WDN = WDN
#define CVT_TAIL(NWG, LO, HI) do { if ((LO) < (HI)) { CVT_MKCP(); const int busy_ = (NWG) % G; if (busy_ == 0) cvt_range(CP, LO, HI, gw, NGW, cscr, lane); else if (bid >= busy_) cvt_range(CP, LO, HI, (bid - busy_) * 8 + wave, (G - busy_) * 8, cscr, lane); } } while (0)
#ifndef MK_DUP_MASK
#define MK_DUP_MASK 0u
#endif
constexpr unsigned DUP_MASK = MK_DUP_MASK;
struct Args { const float* in[20]; float* out; unsigned char* ws; int ph_lo, ph_hi; };
__global__ void __launch_bounds__(512, 2) dit_fwd(Args args) {
    extern __shared__ __attribute__((aligned(16))) unsigned char lds_raw[];
    LAS unsigned char* lds = (LAS unsigned char*)lds_raw;
    const int tid = threadIdx.x, lane = tid & 63, wave = __builtin_amdgcn_readfirstlane(tid >> 6);
    const int G = gridDim.x, bid = blockIdx.x;
    const int gw = bid * 8 + wave, NGW = G * 8;
    unsigned char* ws = args.ws;
    const float* x = args.in[0]; const float* cnd = args.in[1]; const float* ctx = args.in[2]; const float* cctx = args.in[3];
    const float* ada_w = args.in[4]; const float* ada_b = args.in[5]; const float* nmix = args.in[6]; const float* nffn = args.in[7];
    const float* conv_w = args.in[9]; const float* qgain = args.in[12]; const float* kgain = args.in[13]; const float* sink = args.in[14]; const float* router_w = args.in[16];
    float* mod = (float*)(ws + WS_MOD); float* modp = (float*)(ws + WS_MODP);
    float* affL = (float*)(ws + WS_AFFL); float* affC = (float*)(ws + WS_AFFC);
    int* rowsrc = (int*)(ws + WS_ROWSRC); float* gatev = (float*)(ws + WS_GATEV); int* inv = (int*)(ws + WS_INV);
    bf16_t* W1A = (bf16_t*)(ws + WS_W1A); bf16_t* W1B = (bf16_t*)(ws + WS_W1B); bf16_t* W2 = (bf16_t*)(ws + WS_W2); bf16_t* WQKV = (bf16_t*)(ws + WS_WQKV); bf16_t* WOt = (bf16_t*)(ws + WS_WO);
    bf16_t* WGU = (bf16_t*)(ws + WS_WGU); bf16_t* WDN = (bf16_t*)(ws + WS_WDN);
    bf16_t* H = (bf16_t*)(ws + WS_H); bf16_t* A = (bf16_t*)(ws + WS_A); bf16_t* U = (bf16_t*)(ws + WS_U); bf16_t* Z = (bf16_t*)(ws + WS_Z);
    bf16_t* Qb = (bf16_t*)(ws + WS_Q); bf16_t* Kb = (bf16_t*)(ws + WS_K); bf16_t* Vb = (bf16_t*)(ws + WS_V); bf16_t* Ob = (bf16_t*)(ws + WS_O);
    bf16_t* HM = (bf16_t*)(ws + WS_HM); bf16_t* Y = (bf16_t*)(ws + WS_Y); bf16_t* XS = (bf16_t*)(ws + WS_XS);
    LAS unsigned* cscr = (LAS unsigned*)(lds + wave * 9216);

    for (int u = tid; u < (LDS_BYTES - MISC_OFF) / 4; u += 512) ((LAS unsigned*)(lds + MISC_OFF))[u] = 0u;
    __syncthreads();
#if MK_ONE_LAUNCH
    XcdBarrier bar = xcd_barrier_post((unsigned*)(ws + WS_CTL) + CW_BAR, (volatile LAS unsigned*)(lds + MISC_OFF) + 8);
#define GRID_BAR() xcd_barrier(bar)
#else
#define GRID_BAR() do {} while (0)
#endif
    const int lo = args.ph_lo, hi = args.ph_hi;
#define IN(k) (lo <= (k) && (k) < hi)
#define SEAM(k) do { if (IN(k) && IN((k) + 1)) GRID_BAR(); } while (0)

    if (IN(0)) _Pragma("unroll") for (int rep_ = 0; rep_ < 1 + (int)((DUP_MASK >> 0) & 1u); ++rep_) { if (rep_) GRID_BAR();
        ph_adaln(cnd, cctx, ada_w, modp, gw, NGW, lane);
        CVT_MKCP();
#if MK_CVT_JIT
#else
        cvt_range(CP, 0, CVT_R3_LO, gw, NGW, cscr, lane); cvt_range(CP, CVT_X0_END, CVT_R9_LO, gw, NGW, cscr, lane);
#endif
    } SEAM(0);
    if (IN(1)) _Pragma("unroll") for (int rep_ = 0; rep_ < 1 + (int)((DUP_MASK >> 1) & 1u); ++rep_) { if (rep_) GRID_BAR();  ph_modred(modp, ada_b, mod, bid * 512 + tid, G * 512); } SEAM(1);
    if (IN(2)) _Pragma("unroll") for (int rep_ = 0; rep_ < 1 + (int)((DUP_MASK >> 2) & 1u); ++rep_) { if (rep_) GRID_BAR();  ph_mod0(x, ctx, nmix, mod, A, gw, NGW, lane);
#if MK_CVT_JIT
        { CVT_MKCP(); cvt_range(CP, 0, 4096, gw, NGW, cscr, lane); }
#endif
    } SEAM(2);
    if (IN(3)) _Pragma("unroll") for (int rep_ = 0; rep_ < 1 + (int)((DUP_MASK >> 3) & 1u); ++rep_) { if (rep_) GRID_BAR();
        pg8::Gemm g{A, W1A, MT, 4096, DM}; pg8::StaticOrder S; S.init(MT, 4096, G, bid);
        EpiPair<0> E{U, DM, 16};
        pg8::gemm_phase<EpiPair<0>, pg8::StaticOrder, true, true>(lds, g, S, E);
        CVT_TAIL(1152, CVT_R3_LO, CVT_R4_LO);
    } SEAM(3);
    if (IN(4)) _Pragma("unroll") for (int rep_ = 0; rep_ < 1 + (int)((DUP_MASK >> 4) & 1u); ++rep_) { if (rep_) GRID_BAR();
        pg8::Gemm g{A, W1B, MT, DM, DM}; pg8::StaticOrder S; S.init(MT, DM, G, bid);
        EpiConvGate E{U, Z, conv_w};
        pg8::gemm_phase<EpiConvGate, pg8::StaticOrder, true, true>(lds, g, S, E);
        CVT_TAIL(576, CVT_R4_LO, CVT_R5_LO);
    } SEAM(4);
    if (IN(5)) _Pragma("unroll") for (int rep_ = 0; rep_ < 1 + (int)((DUP_MASK >> 5) & 1u); ++rep_) { if (rep_) GRID_BAR();
        pg8::Gemm g{Z, W2, MT, DM, DM}; pg8::StaticOrder S; S.init(MT, DM, G, bid);
        EpiResid<true> E{x, ctx, H, mod + 2 * DM};
        pg8::gemm_phase<EpiResid<true>, pg8::StaticOrder, true, true>(lds, g, S, E);
        CVT_TAIL(576, CVT_R5_LO, CVT_X0_END);
    } SEAM(5);
    if (IN(6)) _Pragma("unroll") for (int rep_ = 0; rep_ < 1 + (int)((DUP_MASK >> 6) & 1u); ++rep_) { if (rep_) GRID_BAR();  load_router(router_w, (LAS float*)lds, tid); ph_modffn(H, nffn, mod, A, (const LAS float*)lds, affL, affC, MT, gw, NGW, lane); } SEAM(6);
    if (IN(7)) _Pragma("unroll") for (int rep_ = 0; rep_ < 1 + (int)((DUP_MASK >> 7) & 1u); ++rep_) { if (rep_) GRID_BAR();  ph_topk(256, affL, affC, rowsrc, gatev, inv, (LAS unsigned*)lds, tid, lane, wave, bid, G);
#if MK_CVT_JIT
        { CVT_MKCP(); cvt_range(CP, CVT_E0, CVT_E0 + 16384, gw, NGW, cscr, lane); }
#endif
    } SEAM(7);
    if (IN(8)) _Pragma("unroll") for (int rep_ = 0; rep_ < 1 + (int)((DUP_MASK >> 8) & 1u); ++rep_) { if (rep_) GRID_BAR();
        pg8::Gemm g{A, WGU, YT, NE * 2048, DM, rowsrc}; MoeOrder S{G, bid, 9};
        EpiPair<1> E{HM, DFF, 8};
        pg8::gemm_phase<EpiPair<1>, MoeOrder, true, true, true>(lds, g, S, E);
#if MK_CVT_JIT
        { CVT_MKCP(); cvt_range(CP, CVT_E0 + 16384, CVT_X0_END, gw, NGW, cscr, lane); }
#endif
    } SEAM(8);
    if (IN(9)) _Pragma("unroll") for (int rep_ = 0; rep_ < 1 + (int)((DUP_MASK >> 9) & 1u); ++rep_) { if (rep_) GRID_BAR();
        pg8::Gemm g{HM, WDN, YT, NE * 2048, DFF}; MoeOrder S{G, bid, 9};
        EpiDown E{Y, gatev};
        pg8::gemm_phase<EpiDown, MoeOrder, true, true>(lds, g, S, E);
        CVT_TAIL(1152, CVT_R10_LO, CVT_R12_LO);
    } SEAM(9);
    if (IN(10)) _Pragma("unroll") for (int rep_ = 0; rep_ < 1 + (int)((DUP_MASK >> 10) & 1u); ++rep_) { if (rep_) GRID_BAR();  ph_combine<false>(H, Y, inv, mod, nmix + DM, mod + 9 * NMOD, A, nullptr, MT, gw, NGW, lane);
#if MK_CVT_JIT
        { CVT_MKCP(); cvt_range(CP, 4096, 4096 + 1536, gw, NGW, cscr, lane); }
#endif
    } SEAM(10);
    if (IN(11)) _Pragma("unroll") for (int rep_ = 0; rep_ < 1 + (int)((DUP_MASK >> 11) & 1u); ++rep_) { if (rep_) GRID_BAR();
        pg8::Gemm g{A, WQKV, MT, 3072, DM}; QkvOrder S{G, bid};
        EpiQkvNorm E{Qb, Kb, Vb, qgain, kgain, (LAS float*)(lds + RING_BYTES)};
        pg8::gemm_phase<EpiQkvNorm, QkvOrder, true, true>(lds, g, S, E);
        CVT_TAIL(800, CVT_R12_LO, CVT_TOTAL);
    } SEAM(11);
    if (IN(12)) _Pragma("unroll") for (int rep_ = 0; rep_ < 1 + (int)((DUP_MASK >> 12) & 1u); ++rep_) { if (rep_) GRID_BAR();  ph_attn(Qb, Kb, Vb, Ob, sink, lds, tid, lane, wave, bid, G);
#if MK_CVT_JIT
        __syncthreads(); { CVT_MKCP(); cvt_range(CP, 4096 + 1536, CVT_E0, gw, NGW, cscr, lane); }
#endif
    } SEAM(12);
    if (IN(13)) _Pragma("unroll") for (int rep_ = 0; rep_ < 1 + (int)((DUP_MASK >> 13) & 1u); ++rep_) { if (rep_) GRID_BAR();
        pg8::Gemm g{Ob, WOt, ML, DM, DM}; pg8::StaticOrder S; S.init(ML, DM, G, bid);
        EpiResid<false> E{nullptr, nullptr, H, mod + 9 * NMOD + 2 * DM};
        pg8::gemm_phase<EpiResid<false>, pg8::StaticOrder, true, true>(lds, g, S, E);
    } SEAM(13);
    if (IN(14)) _Pragma("unroll") for (int rep_ = 0; rep_ < 1 + (int)((DUP_MASK >> 14) & 1u); ++rep_) { if (rep_) GRID_BAR();  load_router(router_w + DM * 16, (LAS float*)lds, tid); ph_modffn(H, nffn + DM, mod + 9 * NMOD, A, (const LAS float*)lds, affL, affC, ML, gw, NGW, lane); } SEAM(14);
    if (IN(15)) _Pragma("unroll") for (int rep_ = 0; rep_ < 1 + (int)((DUP_MASK >> 15) & 1u); ++rep_) { if (rep_) GRID_BAR();  ph_topk(128, affL, affC, rowsrc, gatev, inv, (LAS unsigned*)lds, tid, lane, wave, bid, G);
#if MK_CVT_JIT
        { CVT_MKCP(); cvt_range(CP, CVT_X0_END, CVT_X0_END + 16384, gw, NGW, cscr, lane); }
#endif
    } SEAM(15);
    if (IN(16)) _Pragma("unroll") for (int rep_ = 0; rep_ < 1 + (int)((DUP_MASK >> 16) & 1u); ++rep_) { if (rep_) GRID_BAR();
        pg8::Gemm g{A, WGU + (size_t)NE * 2048 * DM, YT, NE * 2048, DM, rowsrc}; MoeOrder S{G, bid, 8};
        EpiPair<1> E{HM, DFF, 8};
        pg8::gemm_phase<EpiPair<1>, MoeOrder, true, true, true>(lds, g, S, E);
#if MK_CVT_JIT
        { CVT_MKCP(); cvt_range(CP, CVT_X0_END + 16384, CVT_TOTAL, gw, NGW, cscr, lane); }
#endif
    } SEAM(16);
    if (IN(17)) _Pragma("unroll") for (int rep_ = 0; rep_ < 1 + (int)((DUP_MASK >> 17) & 1u); ++rep_) { if (rep_) GRID_BAR();
        pg8::Gemm g{HM, WDN + (size_t)NE * 2048 * DFF, YT, NE * 2048, DFF}; MoeOrder S{G, bid, 8};
        EpiDown E{Y, gatev};
        pg8::gemm_phase<EpiDown, MoeOrder, true, true>(lds, g, S, E);
    } SEAM(17);
    if (IN(18)) _Pragma("unroll") for (int rep_ = 0; rep_ < 1 + (int)((DUP_MASK >> 18) & 1u); ++rep_) { if (rep_) GRID_BAR();  ph_combine<true>(H, Y, inv, mod + 9 * NMOD, nullptr, nullptr, nullptr, args.out, ML, gw, NGW, lane); }
#undef IN
#undef SEAM
}

extern "C" void kernel_launch(void* const* d_in, const int* in_sizes, int n_in, void* d_out, int out_size, void* d_ws, size_t ws_size, hipStream_t stream) {
    static int grid = 0;
    if (grid == 0) {
        if (n_in != 20 || out_size != ML * DM || ws_size < WS_END) { fprintf(stderr, "kernel_launch: unexpected problem (n_in %d, out %d, ws %zu); nothing launched\n", n_in, out_size, ws_size); grid = -1; return; }
        int dev = 0, cus = 0, per_cu = 0;
        if (hipGetDevice(&dev) != hipSuccess || hipDeviceGetAttribute(&cus, hipDeviceAttributeMultiprocessorCount, dev) != hipSuccess) { grid = -1; return; }
        if (hipFuncSetAttribute((const void*)dit_fwd, hipFuncAttributeMaxDynamicSharedMemorySize, LDS_BYTES) != hipSuccess) { fprintf(stderr, "kernel_launch: hipFuncSetAttribute failed\n"); grid = -1; return; }
        if (hipOccupancyMaxActiveBlocksPerMultiprocessor(&per_cu, (const void*)dit_fwd, 512, LDS_BYTES) != hipSuccess || per_cu < 1) fprintf(stderr, "kernel_launch: occupancy query reports %d workgroups per CU\n", per_cu);
        (void)hipGetLastError();
        grid = cus;
    }
    if (grid < 0) return;
    (void)hipMemsetAsync((char*)d_ws + WS_CTL, 0, CTL_ZERO_BYTES, stream);
    Args a{};
    for (int i = 0; i < 20; ++i) a.in[i] = (const float*)d_in[i];
    a.out = (float*)d_out; a.ws = (unsigned char*)d_ws;
#if MK_ONE_LAUNCH
    a.ph_lo = 0; a.ph_hi = NPHASE;
    hipLaunchKernelGGL(dit_fwd, dim3(grid), dim3(512), LDS_BYTES, stream, a);
#else
    for (int p = 0; p < NPHASE; ++p) { a.ph_lo = p; a.ph_hi = p + 1; hipLaunchKernelGGL(dit_fwd, dim3(grid), dim3(512), LDS_BYTES, stream, a); }
#endif
}
```

```cpp
#include <hip/hip_runtime.h>
#include <cstdio>
#include <cstdint>
namespace pg8 {
#define PG8_LAS __attribute__((address_space(3)))
typedef unsigned short bf16_t;
typedef short bf16x8 __attribute__((ext_vector_type(8)));
typedef float f32x4 __attribute__((ext_vector_type(4)));
typedef unsigned u32x4 __attribute__((ext_vector_type(4)));
constexpr int BM = 256, BK = 64, HALF = 128, HTB = HALF * BK * 2  , STAGE_BYTES = 8 * HTB, NXCD = 8, WGM = 8;

__host__ __device__ __forceinline__ int lds_byte(int r, int c) { const int st = (r >> 4) * 2 + (c >> 5), rr = r & 15, cc = c & 31, ob = rr * 64 + cc * 2; return st * 1024 + (ob ^ (((ob >> 9) & 1) << 5)); }
__host__ __device__ __forceinline__ void stage_rc(int b, int& R, int& C) { const int st = b / 1024, sb = b % 1024, swz = sb ^ (((sb >> 9) & 1) << 5); R = (st >> 1) * 16 + swz / 64; C = (st & 1) * 32 + (swz % 64) / 2; }
__host__ __device__ __forceinline__ int perm32(int rho) { const int n = rho >> 4, i = rho & 15; return 8 * (i >> 2) + 4 * n + (i & 3); }

struct Unit { int pm, pn; };
struct Gemm { const bf16_t* A; const bf16_t* Bt; int M, N, K; const int* rows = nullptr; };

struct StaticOrder {
    int nM, nN, nwg, G, c;
    __host__ __device__ void init(int M, int N, int G_, int c_) { nM = M / BM; nN = N / BM; nwg = nM * nN; G = G_; c = c_; }
    __host__ __device__ bool next(int i, Unit& u) const {
        const long L = (long)i * G + c; if (L >= nwg) return false;
        int wgid = (int)L; { const int q = nwg / NXCD, r = nwg % NXCD, xcd = wgid % NXCD, off = wgid / NXCD; wgid = (xcd < r ? xcd * (q + 1) : r * (q + 1) + (xcd - r) * q) + off; }
        const int nig = WGM * nN, gid = wgid / nig, fm = gid * WGM, gsz = (nM - fm) < WGM ? (nM - fm) : WGM;
        u.pm = fm + ((wgid % nig) % gsz); u.pn = (wgid % nig) / gsz; return true;
    }
    __device__ __forceinline__ void a_ready(const Unit&) const {}
    __device__ __forceinline__ void done(const Unit&) const {}
};
__device__ __forceinline__ unsigned cvt_pk_bf16(float lo, float hi) { unsigned r; asm volatile("v_cvt_pk_bf16_f32 %0, %1, %2" : "=v"(r) : "v"(lo), "v"(hi)); return r; }
typedef float f32x2 __attribute__((ext_vector_type(2)));
template <class Epi, class Sched, bool ALIGN_EPI = false, bool SP2 = false, bool GATHER = false>
__device__ __forceinline__ void gemm_phase(PG8_LAS unsigned char* lds, const Gemm g, const Sched& S, const Epi& E) {
    const int tid = threadIdx.x, wid = __builtin_amdgcn_readfirstlane(tid >> 6), lane = tid & 63, wr = wid >> 2, wc = wid & 3, fr = lane & 15, fq = lane >> 4;
    const int K = g.K, nt = K / BK;
    unsigned voffA[2], voffB[2];
#pragma unroll
    for (int i = 0; i < 2; ++i) { int R, C; stage_rc(tid * 16 + i * 8192, R, C); const int Rb = Epi::PERM ? ((R & ~31) + perm32(R & 31)) : R;
        voffA[i] = (unsigned)(R * K + C) * 2u; voffB[i] = (unsigned)(Rb * K + C) * 2u; }
    const size_t kstep = (size_t)(BK * 2);
    const size_t hstep = (size_t)HALF * K * 2;
    const size_t tstep = 2 * hstep;
    const unsigned ldsw = (unsigned)wid * 1024u;
    const int aoff = lds_byte(wr * 64 + fr, fq * 8), boff = lds_byte(wc * 32 + fr, fq * 8);
#define PG8_SA(b, h) (((b) * 2 + (h)) * HTB)
#define PG8_SB(b, h) ((4 + (b) * 2 + (h)) * HTB)
#define PG8_STAGE(bufoff, gbase, voff) do { _Pragma("unroll") for (int _i = 0; _i < 2; ++_i) \
        __builtin_amdgcn_global_load_lds((const unsigned*)((const char*)(gbase) + (voff)[_i]), (PG8_LAS unsigned*)(lds + (bufoff) + ldsw + _i * 8192), 16, 0, 0); } while (0)
#define PG8_STAGE_A(bufoff, kptr, h) do { if constexpr (GATHER) { PG8_STAGE(bufoff, kptr, vA[h]); } else { PG8_STAGE(bufoff, (kptr) + (h) * hstep, voffA); } } while (0)
#define PG8_GATHER_SWITCH() do { if constexpr (GATHER) { if (last && has_next) { asm volatile("" : "+v"(nv[0]), "+v"(nv[1]), "+v"(nv[2]), "+v"(nv[3])); \
        vA[0][0] = nv[0] * (unsigned)(K * 2) + gcoff[0]; vA[0][1] = nv[1] * (unsigned)(K * 2) + gcoff[1]; vA[1][0] = nv[2] * (unsigned)(K * 2) + gcoff[0]; vA[1][1] = nv[3] * (unsigned)(K * 2) + gcoff[1]; } } } while (0)
#define PG8_LDA(dst, b, h) do { _Pragma("unroll") for (int m = 0; m < 4; ++m) _Pragma("unroll") for (int k = 0; k < 2; ++k) dst[m][k] = *(const PG8_LAS bf16x8*)(lds + PG8_SA(b, h) + aoff + m * 2048 + k * 1024); } while (0)
#define PG8_LDB(dst, b, h) do { _Pragma("unroll") for (int n = 0; n < 2; ++n) _Pragma("unroll") for (int k = 0; k < 2; ++k) dst[n][k] = *(const PG8_LAS bf16x8*)(lds + PG8_SB(b, h) + boff + n * 2048 + k * 1024); } while (0)
#define PG8_MMA(ai, bj, At, Bt) do { __builtin_amdgcn_s_setprio(1); _Pragma("unroll") for (int m = 0; m < 4; ++m) _Pragma("unroll") for (int n = 0; n < 2; ++n) _Pragma("unroll") for (int k = 0; k < 2; ++k) \
        acc[ai][bj][m][n] = __builtin_amdgcn_mfma_f32_16x16x32_bf16(Bt[n][k], At[m][k], acc[ai][bj][m][n], 0, 0, 0); __builtin_amdgcn_s_setprio(0); } while (0)
#define PG8_WAIT_V(n) asm volatile("s_waitcnt vmcnt(" #n ")" ::: "memory")
#define PG8_WAIT_L(n) asm volatile("s_waitcnt lgkmcnt(" #n ")" ::: "memory")
#define PG8_BAR __builtin_amdgcn_s_barrier()
#define PG8_SCHED __builtin_amdgcn_sched_barrier(0)
    Unit cur, nxt; int ui = 0;
    if (!S.next(0, cur)) return;
    f32x4 acc[2][2][4][2];
#pragma unroll
    for (int a = 0; a < 2; ++a)
#pragma unroll
        for (int b = 0; b < 2; ++b)
#pragma unroll
            for (int m = 0; m < 4; ++m)
#pragma unroll
                for (int n = 0; n < 2; ++n) acc[a][b][m][n] = (f32x4){0.f, 0.f, 0.f, 0.f};
    bf16x8 At[4][2], B0[2][2], B1[2][2];
    const char* cA = (const char*)g.A + (GATHER ? (size_t)0 : (size_t)cur.pm * tstep); const char* cB = (const char*)g.Bt + (size_t)cur.pn * tstep;
    unsigned vA[2][2], nv[4], gcoff[2]; int grow[2];
    if constexpr (GATHER) {
#pragma unroll
        for (int i = 0; i < 2; ++i) { int R, C; stage_rc(tid * 16 + i * 8192, R, C); grow[i] = R; gcoff[i] = (unsigned)(C * 2); }
#pragma unroll
        for (int h = 0; h < 2; ++h)
#pragma unroll
            for (int i = 0; i < 2; ++i) vA[h][i] = (unsigned)g.rows[cur.pm * BM + h * HALF + grow[i]] * (unsigned)(K * 2) + gcoff[i];
    }
    S.a_ready(cur);
    if constexpr (SP2) {
        PG8_STAGE(PG8_SB(0, 0), cB, voffB); PG8_STAGE(PG8_SB(0, 1), cB + hstep, voffB); PG8_STAGE_A(PG8_SA(0, 0), cA, 0); PG8_STAGE_A(PG8_SA(0, 1), cA, 1);
        if (wr == 1) PG8_BAR;
        PG8_WAIT_V(2); PG8_BAR;
        PG8_STAGE(PG8_SB(1, 0), cB + kstep, voffB); PG8_STAGE_A(PG8_SA(1, 0), cA + kstep, 0); PG8_STAGE(PG8_SB(1, 1), cB + hstep + kstep, voffB);
        PG8_WAIT_V(6); PG8_BAR;
    } else {
        PG8_STAGE(PG8_SB(0, 0), cB, voffB); PG8_STAGE_A(PG8_SA(0, 0), cA, 0); PG8_STAGE(PG8_SB(0, 1), cB + hstep, voffB); PG8_STAGE_A(PG8_SA(0, 1), cA, 1);
        if (wr == 1) PG8_BAR;
        PG8_WAIT_V(4); PG8_BAR;
        PG8_STAGE(PG8_SB(1, 0), cB + kstep, voffB); PG8_STAGE_A(PG8_SA(1, 0), cA + kstep, 0); PG8_STAGE(PG8_SB(1, 1), cB + hstep + kstep, voffB);
        PG8_WAIT_V(6); PG8_BAR;
    }
    for (;;) {
        const bool has_next = S.next(ui + 1, nxt);
        const char* nA = (has_next && !GATHER) ? (const char*)g.A + (size_t)nxt.pm * tstep : cA; const char* nB = has_next ? (const char*)g.Bt + (size_t)nxt.pn * tstep : cB;
        if constexpr (GATHER) { if (has_next) { const int* rp = g.rows + nxt.pm * BM;
            asm volatile("global_load_dword %0, %1, off" : "=&v"(nv[0]) : "v"(rp + grow[0]) : "memory"); asm volatile("global_load_dword %0, %1, off" : "=&v"(nv[1]) : "v"(rp + grow[1]) : "memory");
            asm volatile("global_load_dword %0, %1, off" : "=&v"(nv[2]) : "v"(rp + HALF + grow[0]) : "memory"); asm volatile("global_load_dword %0, %1, off" : "=&v"(nv[3]) : "v"(rp + HALF + grow[1]) : "memory"); } }
        for (int t = 0; t < nt; t += 2) {
            const bool last = (t == nt - 2);
            const char* a1 = cA + (size_t)(t + 1) * kstep;
            const char* a2 = last ? nA : cA + (size_t)(t + 2) * kstep; const char* b2 = last ? nB : cB + (size_t)(t + 2) * kstep;
            const char* a3 = a2 + kstep; const char* b3 = b2 + kstep;
            if (last && has_next) S.a_ready(nxt);
            if constexpr (SP2) {
            PG8_LDB(B0, 0, 0); PG8_LDB(B1, 0, 1); PG8_SCHED; PG8_LDA(At, 0, 0); PG8_STAGE_A(PG8_SA(1, 1), a1, 1); PG8_GATHER_SWITCH();
            PG8_WAIT_V(8); PG8_WAIT_L(0); PG8_BAR; PG8_MMA(0, 0, At, B0); PG8_MMA(0, 1, At, B1); PG8_BAR; PG8_SCHED;
            PG8_LDA(At, 0, 1); PG8_STAGE(PG8_SB(0, 0), b2, voffB); PG8_STAGE(PG8_SB(0, 1), b2 + hstep, voffB); PG8_STAGE_A(PG8_SA(0, 0), a2, 0);
            PG8_WAIT_V(8); PG8_WAIT_L(0); PG8_BAR; PG8_MMA(1, 0, At, B0); PG8_MMA(1, 1, At, B1); PG8_BAR; PG8_SCHED;
            PG8_LDB(B0, 1, 0); PG8_LDB(B1, 1, 1); PG8_SCHED; PG8_LDA(At, 1, 0); PG8_STAGE_A(PG8_SA(0, 1), a2, 1);
            PG8_WAIT_V(8); PG8_WAIT_L(0); PG8_BAR; PG8_MMA(0, 0, At, B0); PG8_MMA(0, 1, At, B1); PG8_BAR; PG8_SCHED;
            PG8_LDA(At, 1, 1); PG8_STAGE(PG8_SB(1, 0), b3, voffB); PG8_STAGE(PG8_SB(1, 1), b3 + hstep, voffB); PG8_STAGE_A(PG8_SA(1, 0), a3, 0);
            PG8_WAIT_V(8); PG8_WAIT_L(0); PG8_BAR; PG8_MMA(1, 0, At, B0); PG8_MMA(1, 1, At, B1); PG8_BAR; PG8_SCHED;
            } else {
            PG8_LDB(B0, 0, 0); PG8_SCHED; PG8_LDA(At, 0, 0); PG8_STAGE_A(PG8_SA(1, 1), a1, 1); PG8_GATHER_SWITCH();
            PG8_WAIT_L(8); PG8_BAR; PG8_WAIT_L(0); PG8_MMA(0, 0, At, B0); PG8_BAR; PG8_SCHED;
            PG8_LDB(B1, 0, 1); PG8_STAGE(PG8_SB(0, 0), b2, voffB);
            PG8_BAR; PG8_WAIT_L(0); PG8_MMA(0, 1, At, B1); PG8_BAR;
            PG8_LDA(At, 0, 1); PG8_STAGE_A(PG8_SA(0, 0), a2, 0);
            PG8_BAR; PG8_WAIT_L(0); PG8_MMA(1, 0, At, B0); PG8_BAR; PG8_SCHED;
            PG8_STAGE(PG8_SB(0, 1), b2 + hstep, voffB);
            PG8_WAIT_V(6); PG8_BAR; PG8_MMA(1, 1, At, B1); PG8_BAR;
            PG8_LDB(B0, 1, 0); PG8_SCHED; PG8_LDA(At, 1, 0); PG8_STAGE_A(PG8_SA(0, 1), a2, 1);
            PG8_WAIT_L(8); PG8_BAR; PG8_WAIT_L(0); PG8_MMA(0, 0, At, B0); PG8_BAR; PG8_SCHED;
            PG8_LDB(B1, 1, 1); PG8_STAGE(PG8_SB(1, 0), b3, voffB);
            PG8_BAR; PG8_WAIT_L(0); PG8_MMA(0, 1, At, B1); PG8_BAR;
            PG8_LDA(At, 1, 1); PG8_STAGE_A(PG8_SA(1, 0), a3, 0);
            PG8_BAR; PG8_WAIT_L(0); PG8_MMA(1, 0, At, B0); PG8_BAR; PG8_SCHED;
            PG8_STAGE(PG8_SB(1, 1), b3 + hstep, voffB);
            PG8_WAIT_V(6); PG8_BAR; PG8_MMA(1, 1, At, B1); PG8_BAR;
            }
        }
        if constexpr (ALIGN_EPI) { if (wr == 0) PG8_BAR; }
        if constexpr (!Epi::AFTER_DRAIN) { E(acc, cur, wr, wc, fr, fq); S.done(cur); }
        if (!has_next) break;
#pragma unroll
        for (int a = 0; a < 2; ++a)
#pragma unroll
            for (int b = 0; b < 2; ++b)
#pragma unroll
                for (int m = 0; m < 4; ++m)
#pragma unroll
                    for (int n = 0; n < 2; ++n) acc[a][b][m][n] = (f32x4){0.f, 0.f, 0.f, 0.f};
        cur = nxt; cA = nA; cB = nB; ++ui;
        if constexpr (ALIGN_EPI) { if (wr == 1) PG8_BAR; }
    }
    PG8_WAIT_V(0);
    if constexpr (!ALIGN_EPI) { if (wr == 0) PG8_BAR; }
    PG8_BAR;
    if constexpr (Epi::AFTER_DRAIN) { E.fused(acc, cur, wr, wc, fr, fq, lds, wid, lane); S.done(cur); }
#undef PG8_SA
#undef PG8_SB
#undef PG8_STAGE
#undef PG8_STAGE_A
#undef PG8_GATHER_SWITCH
#undef PG8_LDA
#undef PG8_LDB
#undef PG8_MMA
#undef PG8_WAIT_V
#undef PG8_WAIT_L
#undef PG8_BAR
#undef PG8_SCHED
}
}

constexpr int DM = 2048, NB = 8, SEQ = 2048, CTXL = 256, NH = 16, NKV = 4, HD = 128;
constexpr int ML = NB * SEQ;
constexpr int MC = NB * CTXL;
constexpr int MT = ML + MC;
constexpr int NE = 16, CAPL = 256, CAPC = 32, DFF = 1024;
constexpr int YR = NB * CAPL + NB * CAPC;
constexpr int YT = NE * YR;
constexpr int NMOD = 6 * DM;
constexpr float NORM_EPS = 1e-6f;
constexpr int KSPLIT = 16;

using pg8::Unit; using pg8::f32x4; using pg8::u32x4; using pg8::bf16_t; using pg8::bf16x8; using pg8::cvt_pk_bf16;
typedef float f32x2 __attribute__((ext_vector_type(2)));
typedef unsigned u32x2 __attribute__((ext_vector_type(2)));
typedef float f32x16 __attribute__((ext_vector_type(16)));
typedef short s16x4 __attribute__((ext_vector_type(4)));
#define DI __device__ __forceinline__

DI float bf_lo(unsigned w) { return __uint_as_float(w << 16); }
DI float bf_hi(unsigned w) { return __uint_as_float(w & 0xffff0000u); }
DI float silu_f(float a) { return a * __builtin_amdgcn_rcpf(1.0f + __expf(-a)); }

DI int xcd_remap(int wgid, int nwg) { const int q = nwg / 8, r = nwg % 8, xcd = wgid % 8, off = wgid / 8; return (xcd < r ? xcd * (q + 1) : r * (q + 1) + (xcd - r) * q) + off; }
struct QkvOrder {
    int G, c;
    DI bool next(int i, Unit& u) const {
        const int L = i * G + c; if (L >= 800) return false;
        if (L < 768) { const int w = xcd_remap(L, 768); const int nig = 8 * 12, gid = w / nig; u.pm = gid * 8 + ((w % nig) % 8); u.pn = (w % nig) / 8; }
        else { const int j = L - 768; u.pm = 64 + (j >> 2); u.pn = 8 + (j & 3); }
        return true;
    }
    DI void a_ready(const Unit&) const {}
    DI void done(const Unit&) const {}
};
struct MoeOrder {
    int G, c, NP;
    DI bool next(int i, Unit& u) const {
        const int nwg = NE * NP * 8; const int L = i * G + c; if (L >= nwg) return false;
        const int w = xcd_remap(L, nwg); const int per = NP * 8, e = w / per, rem = w % per;
        u.pm = e * 9 + (rem % NP); u.pn = e * 8 + (rem / NP); return true;
    }
    DI void a_ready(const Unit&) const {}
    DI void done(const Unit&) const {}
};

template <int ACT  > struct EpiPair {
    static constexpr bool PERM = true, AFTER_DRAIN = false;
    bf16_t* O; int ldc; int pn_mod;
    DI void operator()(const f32x4 (&acc)[2][2][4][2], const Unit& u, int wr, int wc, int fr, int fq) const {
        const int row0 = u.pm * 256 + wr * 64 + fr, col0 = (u.pn % pn_mod) * 128 + wc * 32 + 8 * fq;
#pragma unroll
        for (int ai = 0; ai < 2; ++ai)
#pragma unroll
            for (int m = 0; m < 4; ++m) {
                bf16_t* rowp = O + (size_t)(row0 + ai * 128 + m * 16) * ldc + col0;
                f32x4 a0 = acc[ai][0][m][0], a1 = acc[ai][0][m][1]; const f32x4 b0 = acc[ai][1][m][0], b1 = acc[ai][1][m][1];
                if (ACT == 1) {
#pragma unroll
                    for (int j = 0; j < 4; ++j) { a0[j] = silu_f(a0[j]); a1[j] = silu_f(a1[j]); } }
                const f32x4 v0 = a0 * b0, v1 = a1 * b1;
                u32x4 w; w.x = cvt_pk_bf16(v0[0], v0[1]); w.y = cvt_pk_bf16(v0[2], v0[3]); w.z = cvt_pk_bf16(v1[0], v1[1]); w.w = cvt_pk_bf16(v1[2], v1[3]);
                *(u32x4*)rowp = w;
            }
    }
};
struct EpiConvGate {
    static constexpr bool PERM = true, AFTER_DRAIN = false;
    const bf16_t* U; bf16_t* Z; const float* cw;
    DI void operator()(const f32x4 (&acc)[2][2][4][2], const Unit& u, int wr, int wc, int fr, int fq) const {
        const int row0 = u.pm * 256 + wr * 64 + fr, col0 = u.pn * 256 + wc * 32 + 8 * fq;
#pragma unroll
        for (int bj = 0; bj < 2; ++bj) {
            const int c = col0 + bj * 128;
            f32x4 w0a = *(const f32x4*)(cw + c), w0b = *(const f32x4*)(cw + c + 4), w1a = *(const f32x4*)(cw + 2048 + c), w1b = *(const f32x4*)(cw + 2048 + c + 4), w2a = *(const f32x4*)(cw + 4096 + c), w2b = *(const f32x4*)(cw + 4096 + c + 4);
#pragma unroll
            for (int ai = 0; ai < 2; ++ai)
#pragma unroll
                for (int m = 0; m < 4; ++m) {
                    const int row = row0 + ai * 128 + m * 16;
                    const int tpos = row < ML ? (row & (SEQ - 1)) : ((row - ML) & (CTXL - 1)); const int len = row < ML ? SEQ : CTXL;
                    const u32x4 z4 = (u32x4){0u, 0u, 0u, 0u};
                    const u32x4 uc = *(const u32x4*)(U + (size_t)row * DM + c);
                    const u32x4 up = tpos > 0 ? *(const u32x4*)(U + (size_t)(row - 1) * DM + c) : z4;
                    const u32x4 un = tpos < len - 1 ? *(const u32x4*)(U + (size_t)(row + 1) * DM + c) : z4;
                    f32x4 ya, yb;
                    ya[0] = w0a[0] * bf_lo(up.x) + w1a[0] * bf_lo(uc.x) + w2a[0] * bf_lo(un.x); ya[1] = w0a[1] * bf_hi(up.x) + w1a[1] * bf_hi(uc.x) + w2a[1] * bf_hi(un.x);
                    ya[2] = w0a[2] * bf_lo(up.y) + w1a[2] * bf_lo(uc.y) + w2a[2] * bf_lo(un.y); ya[3] = w0a[3] * bf_hi(up.y) + w1a[3] * bf_hi(uc.y) + w2a[3] * bf_hi(un.y);
                    yb[0] = w0b[0] * bf_lo(up.z) + w1b[0] * bf_lo(uc.z) + w2b[0] * bf_lo(un.z); yb[1] = w0b[1] * bf_hi(up.z) + w1b[1] * bf_hi(uc.z) + w2b[1] * bf_hi(un.z);
                    yb[2] = w0b[2] * bf_lo(up.w) + w1b[2] * bf_lo(uc.w) + w2b[2] * bf_lo(un.w); yb[3] = w0b[3] * bf_hi(up.w) + w1b[3] * bf_hi(uc.w) + w2b[3] * bf_hi(un.w);
                    const f32x4 v0 = acc[ai][bj][m][0] * ya, v1 = acc[ai][bj][m][1] * yb;
                    u32x4 w; w.x = cvt_pk_bf16(v0[0], v0[1]); w.y = cvt_pk_bf16(v0[2], v0[3]); w.z = cvt_pk_bf16(v1[0], v1[1]); w.w = cvt_pk_bf16(v1[2], v1[3]);
                    *(u32x4*)(Z + (size_t)row * DM + c) = w;
                }
        }
    }
};
template <bool BASE_F32> struct EpiResid {
    static constexpr bool PERM = true, AFTER_DRAIN = false;
    const float* base_lat; const float* base_ctx; bf16_t* out; const float* gate;
    DI void operator()(const f32x4 (&acc)[2][2][4][2], const Unit& u, int wr, int wc, int fr, int fq) const {
        const int rowt = u.pm * 256; const int cr = rowt < ML ? (rowt >> 11) : 8;
        const float* base = rowt < ML ? base_lat : base_ctx - (size_t)ML * DM;
        const int row0 = rowt + wr * 64 + fr, col0 = u.pn * 256 + wc * 32 + 8 * fq;
        f32x4 gv[2][2];
#pragma unroll
        for (int bj = 0; bj < 2; ++bj)
#pragma unroll
            for (int n = 0; n < 2; ++n) gv[bj][n] = *(const f32x4*)(gate + (size_t)cr * NMOD + col0 + bj * 128 + n * 4);
#pragma unroll
        for (int ai = 0; ai < 2; ++ai)
#pragma unroll
            for (int m = 0; m < 4; ++m) { const size_t off = (size_t)(row0 + ai * 128 + m * 16) * DM + col0;
#pragma unroll
                for (int bj = 0; bj < 2; ++bj) { f32x4 b0, b1;
                    if (BASE_F32) { b0 = *(const f32x4*)(base + off + bj * 128); b1 = *(const f32x4*)(base + off + bj * 128 + 4); }
                    else { const u32x4 hb = *(const u32x4*)(out + off + bj * 128); b0 = (f32x4){bf_lo(hb.x), bf_hi(hb.x), bf_lo(hb.y), bf_hi(hb.y)}; b1 = (f32x4){bf_lo(hb.z), bf_hi(hb.z), bf_lo(hb.w), bf_hi(hb.w)}; }
                    const f32x4 v0 = b0 + gv[bj][0] * acc[ai][bj][m][0], v1 = b1 + gv[bj][1] * acc[ai][bj][m][1];
                    u32x4 w; w.x = cvt_pk_bf16(v0[0], v0[1]); w.y = cvt_pk_bf16(v0[2], v0[3]); w.z = cvt_pk_bf16(v1[0], v1[1]); w.w = cvt_pk_bf16(v1[2], v1[3]);
                    *(u32x4*)(out + off + bj * 128) = w; }
                asm volatile("" ::: "memory"); }
    }
};
struct EpiDown {
    static constexpr bool PERM = true, AFTER_DRAIN = false;
    bf16_t* Y; const float* gatev;
    DI void operator()(const f32x4 (&acc)[2][2][4][2], const Unit& u, int wr, int wc, int fr, int fq) const {
        const int row0 = u.pm * 256 + wr * 64 + fr, col0 = (u.pn & 7) * 256 + wc * 32 + 8 * fq;
#pragma unroll
        for (int ai = 0; ai < 2; ++ai)
#pragma unroll
            for (int m = 0; m < 4; ++m) { const int row = row0 + ai * 128 + m * 16; const float gt = gatev[row];
#pragma unroll
                for (int bj = 0; bj < 2; ++bj) { const f32x4 v0 = acc[ai][bj][m][0] * gt, v1 = acc[ai][bj][m][1] * gt;
                    u32x4 w; w.x = cvt_pk_bf16(v0[0], v0[1]); w.y = cvt_pk_bf16(v0[2], v0[3]); w.z = cvt_pk_bf16(v1[0], v1[1]); w.w = cvt_pk_bf16(v1[2], v1[3]);
                    *(u32x4*)(Y + (size_t)row * DM + col0 + bj * 128) = w; } }
    }
};
#define LAS3 __attribute__((address_space(3)))
struct EpiQkvNorm {
    static constexpr bool PERM = true, AFTER_DRAIN = false;
    bf16_t* Q; bf16_t* K; bf16_t* V; const float* qg; const float* kg; LAS3 float* P;
    DI void operator()(const f32x4 (&acc)[2][2][4][2], const Unit& u, int wr, int wc, int fr, int fq) const {
        const int row0 = u.pm * 256 + wr * 64 + fr; int colt = u.pn * 256;
        if (colt >= 2560) {
            const int col0 = colt - 2560 + wc * 32 + 8 * fq;
#pragma unroll
            for (int ai = 0; ai < 2; ++ai)
#pragma unroll
                for (int m = 0; m < 4; ++m) { bf16_t* rowp = V + (size_t)(row0 + ai * 128 + m * 16) * 512 + col0;
#pragma unroll
                    for (int bj = 0; bj < 2; ++bj) { const f32x4 v0 = acc[ai][bj][m][0], v1 = acc[ai][bj][m][1];
                        u32x4 w; w.x = cvt_pk_bf16(v0[0], v0[1]); w.y = cvt_pk_bf16(v0[2], v0[3]); w.z = cvt_pk_bf16(v1[0], v1[1]); w.w = cvt_pk_bf16(v1[2], v1[3]);
                        *(u32x4*)(rowp + bj * 128) = w; } }
            return;
        }
        const bool isq = colt < 2048; bf16_t* base = isq ? Q : K; const int ld = isq ? 2048 : 512; if (!isq) colt -= 2048;
        const int rl0 = wr * 64 + fr;
#pragma unroll
        for (int ai = 0; ai < 2; ++ai)
#pragma unroll
            for (int m = 0; m < 4; ++m)
#pragma unroll
                for (int bj = 0; bj < 2; ++bj) { const f32x4 a = acc[ai][bj][m][0], b = acc[ai][bj][m][1];
                    float s = (a[0] * a[0] + a[1] * a[1]) + (a[2] * a[2] + a[3] * a[3]) + (b[0] * b[0] + b[1] * b[1]) + (b[2] * b[2] + b[3] * b[3]);
                    s += __shfl_xor(s, 16); s += __shfl_xor(s, 32);
                    if (fq == 0) P[((ai * 128 + m * 16 + rl0) * 2 + bj) * 4 + wc] = s; }
        asm volatile("s_waitcnt lgkmcnt(0)" ::: "memory"); __builtin_amdgcn_s_barrier(); asm volatile("" ::: "memory");
        constexpr float QSCALE = 0.08838834764831845f * 1.4426950408889634f;
        const int i0 = 16 * (wc & 1) + 4 * fq, d0 = 64 * (wc >> 1) + i0;
        const float* gp = isq ? qg : kg; f32x4 g0 = *(const f32x4*)(gp + d0), g1 = *(const f32x4*)(gp + d0 + 32);
        if (isq) { g0 = g0 * QSCALE; g1 = g1 * QSCALE; }
        f32x4 ifr;
#pragma unroll
        for (int j = 0; j < 4; ++j) ifr[j] = exp2f(-(float)(i0 + j) * (13.287712379549449f / 32.0f));
        const bool lat = u.pm < 64;
#pragma unroll
        for (int ai = 0; ai < 2; ++ai)
#pragma unroll
            for (int m = 0; m < 4; ++m) { const int row = row0 + ai * 128 + m * 16; const int t = row & (SEQ - 1);
                const float pos = (float)((wc >> 1) == 0 ? (t >> 6) : (t & 63));
                f32x4 cs, sn;
#pragma unroll
                for (int j = 0; j < 4; ++j) { const float ang = pos * ifr[j]; cs[j] = lat ? __cosf(ang) : 1.0f; sn[j] = lat ? __sinf(ang) : 0.0f; }
#pragma unroll
                for (int bj = 0; bj < 2; ++bj) { const f32x4 pp = *(const LAS3 f32x4*)(P + ((ai * 128 + m * 16 + rl0) * 2 + bj) * 4);
                    const float rstd = 1.0f / sqrtf(((pp[0] + pp[1]) + (pp[2] + pp[3])) * (1.0f / HD) + NORM_EPS);
                    const f32x4 a = acc[ai][bj][m][0] * rstd * g0, b = acc[ai][bj][m][1] * rstd * g1;
                    const f32x4 o1 = a * cs - b * sn, o2 = b * cs + a * sn;
                    u32x4 w; w.x = cvt_pk_bf16(o1[0], o1[1]); w.y = cvt_pk_bf16(o1[2], o1[3]); w.z = cvt_pk_bf16(o2[0], o2[1]); w.w = cvt_pk_bf16(o2[2], o2[3]);
                    *(u32x4*)(base + (size_t)row * ld + colt + bj * 128 + wc * 32 + 8 * fq) = w; } }
    }
};

constexpr size_t MiB = 1u << 20;
constexpr size_t WS_CTL = 0, CTL_ZERO_BYTES = 1 * MiB;
constexpr size_t WS_MOD = 1 * MiB;
constexpr size_t WS_MODP = 2 * MiB;
constexpr size_t WS_AFFL = 16 * MiB;
constexpr size_t WS_AFFC = 17 * MiB;
constexpr size_t WS_ROWSRC = 17 * MiB + 512 * 1024;
constexpr size_t WS_GATEV = 18 * MiB;
constexpr size_t WS_INV = 18 * MiB + 512 * 1024;
constexpr size_t WS_W1A = 20 * MiB;
constexpr size_t WS_W1B = 36 * MiB;
constexpr size_t WS_W2 = 44 * MiB;
constexpr size_t WS_WQKV = 52 * MiB;
constexpr size_t WS_WO = 64 * MiB;
constexpr size_t WS_WGU = 72 * MiB;
constexpr size_t WS_WDN = 328 * MiB;
constexpr size_t WS_H = 456 * MiB;
constexpr size_t WS_A = 600 * MiB;
constexpr size_t WS_U = 672 * MiB;
constexpr size_t WS_Z = 744 * MiB;
constexpr size_t WS_Q = WS_U, WS_K = WS_Z, WS_V = WS_Z + 18 * MiB;
constexpr size_t WS_HM = 816 * MiB;
constexpr size_t WS_O = WS_HM;
constexpr size_t WS_Y = 888 * MiB;
constexpr size_t WS_END = 1032 * MiB;
constexpr int CW_BAR = 4096;

constexpr int RING_BYTES = 131072;
constexpr int MISC_OFF = RING_BYTES + 14336;
constexpr int LDS_BYTES = 147456;

#define GAS __attribute__((address_space(1)))
#define LAS __attribute__((address_space(3)))
#define LDS_WAIT() asm volatile("s_waitcnt lgkmcnt(0)" ::: "memory")
#define VM_WAIT() asm volatile("s_waitcnt vmcnt(0)" ::: "memory")
#define XB_TMO      128
#define XB_XCNT(j)  (256  + 64 * (j))
#define XB_XSUB(j)  (1280 + 64 * (j))
#define XB_XGEN(j)  (2304 + 64 * (j))
#define XB_TOP      3328
#define XB_TOPGEN   3392
#define XCD_BAR_WORDS 3456
#define XB_SPIN_CAP (1u << 18)

__device__ __forceinline__ unsigned xb_ld(unsigned* p)              { return __hip_atomic_load(p, __ATOMIC_RELAXED, __HIP_MEMORY_SCOPE_AGENT); }
__device__ __forceinline__ unsigned xb_add(unsigned* p, unsigned v) { return __hip_atomic_fetch_add(p, v, __ATOMIC_RELAXED, __HIP_MEMORY_SCOPE_AGENT); }
__device__ __forceinline__ unsigned xb_xcc_id() { return (unsigned)__builtin_amdgcn_s_getreg((3 << 11) | 20) & 0xFu; }
#define XB_SPIN(cond, bar) do { unsigned _sp = 0; while (cond) { __builtin_amdgcn_s_sleep(1); \
    if ((++_sp & 255u) == 0u) { if (xb_ld(&(bar)[XB_TMO])) break; if (_sp > XB_SPIN_CAP) { atomicAdd(&(bar)[XB_TMO], 1u); break; } } } } while (0)

struct XcdBarrier {
    unsigned* bar; unsigned x;
    volatile LAS unsigned* st;
};

__device__ __forceinline__ XcdBarrier xcd_barrier_post(unsigned* bar, volatile LAS unsigned* st) {
    XcdBarrier b; b.bar = bar; b.x = xb_xcc_id(); b.st = st;
    if (threadIdx.x == 0) (void)xb_add(&bar[XB_XCNT(b.x)], 1u);
    return b;
}
__device__ __forceinline__ void xcd_barrier_complete(unsigned* bar, unsigned x, unsigned& nloc, unsigned& nx) {
    const unsigned G = gridDim.x * gridDim.y * gridDim.z;
    unsigned sum, cnt, mine, sp = 0u;
    for (;;) {
        sum = 0u; cnt = 0u; mine = 0u;
#pragma unroll
        for (unsigned j = 0; j < 16; ++j) { const unsigned c = xb_ld(&bar[XB_XCNT(j)]); sum += c; cnt += (c > 0u) ? 1u : 0u; mine = (j == x) ? c : mine; }
        if (sum == G) break;
        __builtin_amdgcn_s_sleep(1);
        if ((++sp & 255u) == 0u) { if (xb_ld(&bar[XB_TMO])) break; if (sp > XB_SPIN_CAP) { atomicAdd(&bar[XB_TMO], 1u); break; } }
    }
    nloc = mine > 0u ? mine : 1u; nx = cnt > 0u ? cnt : 1u;
}

__device__ __forceinline__ void xcd_barrier(const XcdBarrier& b) {
    asm volatile("s_waitcnt vmcnt(0)" ::: "memory");
    __syncthreads();
    if (threadIdx.x == 0) {
        unsigned* bar = b.bar;
        __builtin_amdgcn_s_waitcnt(0);
        unsigned nloc = b.st[0], nx = b.st[1];
        if (nloc == 0u) { xcd_barrier_complete(bar, b.x, nloc, nx); b.st[0] = nloc; b.st[1] = nx; }
        const unsigned old = xb_add(&bar[XB_XSUB(b.x)], 1u);
        const unsigned gen = old / nloc;
        if (old + 1u == (gen + 1u) * nloc) {
            __builtin_amdgcn_fence(__ATOMIC_RELEASE, "agent");
            asm volatile("s_waitcnt vmcnt(0)" ::: "memory");
            const unsigned og = xb_add(&bar[XB_TOP], 1u);
            const unsigned tg = og / nx;
            if (og + 1u == (tg + 1u) * nx) xb_add(&bar[XB_TOPGEN], 1u);
            else XB_SPIN(xb_ld(&bar[XB_TOPGEN]) == tg, bar);
            __builtin_amdgcn_fence(__ATOMIC_ACQUIRE, "agent");
            xb_add(&bar[XB_XGEN(b.x)], 1u);
            asm volatile("s_waitcnt vmcnt(0)" ::: "memory");
        } else {
            XB_SPIN(xb_ld(&bar[XB_XGEN(b.x)]) == gen, bar);
            __builtin_amdgcn_fence(__ATOMIC_ACQUIRE, "agent");
            asm volatile("s_waitcnt vmcnt(0)" ::: "memory");
        }
    }
    __syncthreads();
}

DI float wave_sum(float v) {
#pragma unroll
    for (int o = 1; o < 64; o <<= 1) v += __shfl_xor(v, o);
    return v;
}
DI float rdlane(float v, int l) { return __uint_as_float((unsigned)__builtin_amdgcn_readlane((int)__float_as_uint(v), l)); }
DI unsigned pk2(float lo, float hi) { return cvt_pk_bf16(lo, hi); }

DI void ph_adaln(const float* cnd, const float* cctx, const float* ada_w, float* modp, int gw, int NGW, int lane) {
    for (int task = gw; task < 96 * KSPLIT; task += NGW) {
        const int ks = task & (KSPLIT - 1), cg = task / KSPLIT, l = cg / 48, cgl = cg % 48, col0 = cgl * 256 + lane * 4, k0 = ks * 128;
        float sv[9][2];
#pragma unroll
        for (int r = 0; r < 9; ++r)
#pragma unroll
            for (int hh = 0; hh < 2; ++hh) { const int k = k0 + hh * 64 + lane; const float v = r < 8 ? cnd[r * DM + k] : cctx[k]; sv[r][hh] = v / (1.0f + __expf(-v)); }
        f32x4 acc[9];
#pragma unroll
        for (int r = 0; r < 9; ++r) acc[r] = (f32x4){0.f, 0.f, 0.f, 0.f};
        const float* wp = ada_w + ((size_t)l * DM + k0) * NMOD + col0;
#pragma unroll
        for (int hh = 0; hh < 2; ++hh) {
#pragma unroll 8
            for (int kk = 0; kk < 64; ++kk) {
                const f32x4 w = *(const f32x4*)(wp + (size_t)(hh * 64 + kk) * NMOD);
#pragma unroll
                for (int r = 0; r < 9; ++r) { const float s = rdlane(sv[r][hh], kk); acc[r] += w * s; }
            }
        }
#pragma unroll
        for (int r = 0; r < 9; ++r) *(f32x4*)(modp + ((size_t)((ks * 2 + l) * 9 + r)) * NMOD + col0) = acc[r];
    }
}
struct CvtPtrs { const float *cin, *cout, *wqkv, *wo, *wg, *wu, *wd; bf16_t *W1A, *W1B, *W2, *WQKV, *WO, *WGU, *WDN; };
constexpr int CVT_E0 = 6656, CVT_L = 24576, CVT_TOTAL = CVT_E0 + 2 * CVT_L;
DI void cvt_resolve(const CvtPtrs& P, int it, const float*& src, int& ldw, bf16_t*& dst, int& ldd, bool& qperm) {
    int r = it; qperm = false;
    if (r < 3072) { const int kt = ((r >> 3) / 96) * 8 + (r & 7), nt = (r >> 3) % 96, n0 = nt * 64, part = n0 >> 11, j0 = n0 & 2047;
        src = P.cin + (size_t)(kt * 64) * 6144 + n0; ldw = 6144; ldd = DM;
        dst = (part == 0 ? P.W1B + (size_t)j0 * DM : P.W1A + (size_t)((j0 >> 7) * 256 + (part == 2 ? 128 : 0) + (j0 & 127)) * DM) + kt * 64; return; } r -= 3072;
    if (r < 1024) { const int kt = ((r >> 3) / 32) * 8 + (r & 7), nt = (r >> 3) % 32; src = P.cout + (size_t)(kt * 64) * DM + nt * 64; ldw = DM; dst = P.W2 + (size_t)(nt * 64) * DM + kt * 64; ldd = DM; return; } r -= 1024;
    if (r < 1536) { const int kt = ((r >> 3) / 48) * 8 + (r & 7), nt = (r >> 3) % 48; src = P.wqkv + (size_t)(kt * 64) * 3072 + nt * 64; ldw = 3072; qperm = nt < 40;     dst = P.WQKV + (size_t)(nt * 64) * DM + kt * 64; ldd = DM; return; } r -= 1536;
    if (r < 1024) { const int kt = ((r >> 3) / 32) * 8 + (r & 7), nt = (r >> 3) % 32; src = P.wo + (size_t)(kt * 64) * DM + nt * 64; ldw = DM; dst = P.WO + (size_t)(nt * 64) * DM + kt * 64; ldd = DM; return; } r -= 1024;
    const int l = r / CVT_L, rr = r % CVT_L, kind = rr / 8192, q = rr % 8192, le = l * 16 + q / 512, rem = q % 512;
    if (kind < 2) { const int kt = ((rem >> 3) / 16) * 8 + (rem & 7), nt = (rem >> 3) % 16, n0 = nt * 64;
        src = (kind ? P.wu : P.wg) + (size_t)le * DM * DFF + (size_t)(kt * 64) * DFF + n0; ldw = DFF;
        dst = P.WGU + (size_t)(le * 2048 + (n0 >> 7) * 256 + kind * 128 + (n0 & 127)) * DM + kt * 64; ldd = DM; }
    else { const int kt = ((rem >> 3) / 32) * 8 + (rem & 7), nt = (rem >> 3) % 32;
        src = P.wd + (size_t)le * DFF * DM + (size_t)(kt * 64) * DM + nt * 64; ldw = DM; dst = P.WDN + (size_t)(le * 2048 + nt * 64) * DFF + kt * 64; ldd = DFF; }
}
constexpr int CVT_P = 36;
DI void cvt_range(const CvtPtrs& P, int lo, int hi, int w, int NW, LAS unsigned* scr, int lane) {
    int it = lo + w; if (it >= hi) return;
    const int c = lane & 15, q = lane >> 4;
    const float* src; int ldw; bf16_t* dst; int ldd; bool qperm; cvt_resolve(P, it, src, ldw, dst, ldd, qperm);
    f32x4 v[16];
#pragma unroll
    for (int rr = 0; rr < 16; ++rr) v[rr] = __builtin_nontemporal_load((const f32x4*)(src + (size_t)(16 * q + rr) * ldw + 4 * c));
    for (;;) {
        u32x4 pa[4], pb[4];
#pragma unroll
        for (int i = 0; i < 4; ++i) { pa[i].x = pk2(v[0][i], v[1][i]); pa[i].y = pk2(v[2][i], v[3][i]); pa[i].z = pk2(v[4][i], v[5][i]); pa[i].w = pk2(v[6][i], v[7][i]);
                                      pb[i].x = pk2(v[8][i], v[9][i]); pb[i].y = pk2(v[10][i], v[11][i]); pb[i].z = pk2(v[12][i], v[13][i]); pb[i].w = pk2(v[14][i], v[15][i]); }
        const int nit = it + NW; bf16_t* cdst = dst; const int cldd = ldd; const int wrow = qperm ? 32 * ((c >> 2) & 1) + 8 * (c & 3) + 4 * (c >> 3) : 4 * c;
        if (nit < hi) { cvt_resolve(P, nit, src, ldw, dst, ldd, qperm);
#pragma unroll
            for (int rr = 0; rr < 16; ++rr) v[rr] = __builtin_nontemporal_load((const f32x4*)(src + (size_t)(16 * q + rr) * ldw + 4 * c)); }
#pragma unroll
        for (int i = 0; i < 4; ++i) { *(LAS u32x4*)(scr + (wrow + i) * CVT_P + 8 * q) = pa[i]; *(LAS u32x4*)(scr + (wrow + i) * CVT_P + 8 * q + 4) = pb[i]; }
        LDS_WAIT(); asm volatile("" ::: "memory");
#pragma unroll
        for (int j = 0; j < 8; ++j) { const int n = (lane >> 3) + 8 * j; const u32x4 o = *(const LAS u32x4*)(scr + n * CVT_P + 4 * (lane & 7));
            *(u32x4*)(cdst + (size_t)n * cldd + 8 * (lane & 7)) = o; }
        LDS_WAIT(); asm volatile("" ::: "memory");
        if (nit >= hi) break;
        it = nit;
    }
}
DI void ph_modred(const float* modp, const float* ada_b, float* mod, int gtid, int GT) {
    for (int i = gtid; i < 2 * 9 * NMOD; i += GT) { const int l = i / (9 * NMOD), j = i % NMOD; float s = ada_b[l * NMOD + j];
#pragma unroll
        for (int ks = 0; ks < KSPLIT; ++ks) s += modp[(size_t)ks * (2 * 9 * NMOD) + i];
        mod[i] = s; }
}
DI void row_load(const float* p, f32x4 (&v)[8], int lane) {
#pragma unroll
    for (int j = 0; j < 8; ++j) v[j] = *(const f32x4*)(p + 4 * lane + 256 * j);
}
DI void row_load_bf(const bf16_t* p, f32x4 (&v)[8], int lane) {
#pragma unroll
    for (int j = 0; j < 8; ++j) { const u32x2 w = *(const u32x2*)(p + 4 * lane + 256 * j); v[j] = (f32x4){bf_lo(w.x), bf_hi(w.x), bf_lo(w.y), bf_hi(w.y)}; }
}
DI void row_modulate(const f32x4 (&v)[8], f32x4 (&y)[8], const float* gain, const float* shift, const float* scale, int lane) {
    float ss = 0.f;
#pragma unroll
    for (int j = 0; j < 8; ++j) ss += (v[j][0] * v[j][0] + v[j][1] * v[j][1]) + (v[j][2] * v[j][2] + v[j][3] * v[j][3]);
    ss = wave_sum(ss);
    const float rstd = 1.0f / sqrtf(ss * (1.0f / DM) + NORM_EPS);
#pragma unroll
    for (int j = 0; j < 8; ++j) { const int c = 4 * lane + 256 * j; const f32x4 g = *(const f32x4*)(gain + c), sh = *(const f32x4*)(shift + c), sc = *(const f32x4*)(scale + c);
        y[j] = ((v[j] * rstd) * g) * (sc + 1.0f) + sh; }
}
DI void row_modulate2(const f32x4 (&v0)[8], const f32x4 (&v1)[8], f32x4 (&y0)[8], f32x4 (&y1)[8], const float* gain, const float* shift, const float* scale, int lane) {
    float s0 = 0.f, s1 = 0.f;
#pragma unroll
    for (int j = 0; j < 8; ++j) { s0 += (v0[j][0] * v0[j][0] + v0[j][1] * v0[j][1]) + (v0[j][2] * v0[j][2] + v0[j][3] * v0[j][3]); s1 += (v1[j][0] * v1[j][0] + v1[j][1] * v1[j][1]) + (v1[j][2] * v1[j][2] + v1[j][3] * v1[j][3]); }
    s0 = wave_sum(s0); s1 = wave_sum(s1);
    const float r0 = 1.0f / sqrtf(s0 * (1.0f / DM) + NORM_EPS), r1 = 1.0f / sqrtf(s1 * (1.0f / DM) + NORM_EPS);
#pragma unroll
    for (int j = 0; j < 8; ++j) { const int c = 4 * lane + 256 * j; const f32x4 g = *(const f32x4*)(gain + c), sh = *(const f32x4*)(shift + c), sc = *(const f32x4*)(scale + c);
        y0[j] = ((v0[j] * r0) * g) * (sc + 1.0f) + sh; y1[j] = ((v1[j] * r1) * g) * (sc + 1.0f) + sh; }
}
DI void row_store_bf16(bf16_t* p, const f32x4 (&y)[8], int lane) {
#pragma unroll
    for (int j = 0; j < 8; ++j) { u32x2 w; w.x = pk2(y[j][0], y[j][1]); w.y = pk2(y[j][2], y[j][3]); *(u32x2*)(p + 4 * lane + 256 * j) = w; }
}
DI void ph_mod0(const float* x, const float* ctx, const float* gain, const float* mod0, bf16_t* A, int gw, int NGW, int lane) {
    for (int row = gw; row < MT; row += NGW) {
        const int cr = row < ML ? (row >> 11) : 8; const float* src = row < ML ? x + (size_t)row * DM : ctx + (size_t)(row - ML) * DM;
        f32x4 v[8], y[8]; row_load(src, v, lane);
        row_modulate(v, y, gain, mod0 + (size_t)cr * NMOD + 0 * DM, mod0 + (size_t)cr * NMOD + 1 * DM, lane);
        row_store_bf16(A + (size_t)row * DM, y, lane);
    }
}
DI float reduce8(const float (&v)[8], int lane) {
    const bool u0 = lane & 1, u1 = lane & 2, u2 = lane & 4;
    float a[4], b2[2];
#pragma unroll
    for (int k = 0; k < 4; ++k) { const float lo = v[2 * k], hi = v[2 * k + 1]; a[k] = (u0 ? hi : lo) + __shfl_xor(u0 ? lo : hi, 1); }
#pragma unroll
    for (int k = 0; k < 2; ++k) { const float lo = a[2 * k], hi = a[2 * k + 1]; b2[k] = (u1 ? hi : lo) + __shfl_xor(u1 ? lo : hi, 2); }
    return (u2 ? b2[1] : b2[0]) + __shfl_xor(u2 ? b2[0] : b2[1], 4);
}
DI float reduce_halves(float lo8, float hi8, int lane) {
    const bool u3 = lane & 8;
    float t = (u3 ? hi8 : lo8) + __shfl_xor(u3 ? lo8 : hi8, 8);
    t += __shfl_xor(t, 16); t += __shfl_xor(t, 32); return t;
}
DI float softmax16(float lg) {
    float mx = lg;
#pragma unroll
    for (int o = 1; o < 16; o <<= 1) mx = fmaxf(mx, __shfl_xor(mx, o));
    const float ex = __expf(lg - mx); float den = ex;
#pragma unroll
    for (int o = 1; o < 16; o <<= 1) den += __shfl_xor(den, o);
    return ex / den;
}
DI void aff_store(float v, float* affL, float* affC, int row, int lane) {
    if (lane < 16) { if (row < ML) { const int b = row >> 11, n = row & 2047; affL[(size_t)(b * 16 + lane) * SEQ + n] = v; }
                     else { const int rc = row - ML, b = rc >> 8, n = rc & 255; affC[(size_t)(b * 16 + lane) * CTXL + n] = v; } }
}
DI void router_rows2(const f32x4 (&y0)[8], const f32x4 (&y1)[8], const LAS float* rwT, float* affL, float* affC, int row0, int lane) {
    float r0[2], r1[2];
#pragma unroll
    for (int hf = 0; hf < 2; ++hf) {
        float l0[8], l1[8];
#pragma unroll
        for (int e = 0; e < 8; ++e) { float s0 = 0.f, s1 = 0.f;
#pragma unroll
            for (int j = 0; j < 8; ++j) { const f32x4 w = *(const LAS f32x4*)(rwT + (8 * hf + e) * DM + 4 * lane + 256 * j);
                s0 += (y0[j][0] * w[0] + y0[j][1] * w[1]) + (y0[j][2] * w[2] + y0[j][3] * w[3]); s1 += (y1[j][0] * w[0] + y1[j][1] * w[1]) + (y1[j][2] * w[2] + y1[j][3] * w[3]); }
            l0[e] = s0; l1[e] = s1; __builtin_amdgcn_sched_barrier(0); }
        r0[hf] = reduce8(l0, lane); r1[hf] = reduce8(l1, lane);
    }
    const float a0 = softmax16(reduce_halves(r0[0], r0[1], lane)), a1 = softmax16(reduce_halves(r1[0], r1[1], lane));
    aff_store(a0, affL, affC, row0, lane); aff_store(a1, affL, affC, row0 + 1, lane);
}
DI void load_router(const float* rw, LAS float* rwT, int tid) {
    for (int i = tid; i < DM * 16; i += 512) rwT[(i & 15) * DM + (i >> 4)] = rw[i];
    __syncthreads();
}
DI void ph_modffn(const bf16_t* H, const float* gain, const float* modl, bf16_t* A, const LAS float* rwT, float* affL, float* affC, int nrows, int gw, int NGW, int lane) {
    for (int rp = gw; rp < nrows / 2; rp += NGW) {
        const int row = 2 * rp; const int cr = row < ML ? (row >> 11) : 8;
        u32x2 p0[8], p1[8];
#pragma unroll
        for (int j = 0; j < 8; ++j) { p0[j] = *(const u32x2*)(H + (size_t)row * DM + 4 * lane + 256 * j); p1[j] = *(const u32x2*)(H + (size_t)(row + 1) * DM + 4 * lane + 256 * j); }
        float s0 = 0.f, s1 = 0.f;
#pragma unroll
        for (int j = 0; j < 8; ++j) { const float a0 = bf_lo(p0[j].x), a1 = bf_hi(p0[j].x), a2 = bf_lo(p0[j].y), a3 = bf_hi(p0[j].y); s0 += (a0 * a0 + a1 * a1) + (a2 * a2 + a3 * a3);
                                      const float b0 = bf_lo(p1[j].x), b1 = bf_hi(p1[j].x), b2 = bf_lo(p1[j].y), b3 = bf_hi(p1[j].y); s1 += (b0 * b0 + b1 * b1) + (b2 * b2 + b3 * b3); }
        s0 = wave_sum(s0); s1 = wave_sum(s1);
        const float r0 = 1.0f / sqrtf(s0 * (1.0f / DM) + NORM_EPS), r1 = 1.0f / sqrtf(s1 * (1.0f / DM) + NORM_EPS);
        const float* shift = modl + (size_t)cr * NMOD + 3 * DM; const float* scale = modl + (size_t)cr * NMOD + 4 * DM;
        f32x4 y0[8], y1[8];
#pragma unroll
        for (int j = 0; j < 8; ++j) { const int c = 4 * lane + 256 * j; const f32x4 g = *(const f32x4*)(gain + c), sh = *(const f32x4*)(shift + c), sc = *(const f32x4*)(scale + c);
            const f32x4 v0 = (f32x4){bf_lo(p0[j].x), bf_hi(p0[j].x), bf_lo(p0[j].y), bf_hi(p0[j].y)}, v1 = (f32x4){bf_lo(p1[j].x), bf_hi(p1[j].x), bf_lo(p1[j].y), bf_hi(p1[j].y)};
            y0[j] = ((v0 * r0) * g) * (sc + 1.0f) + sh; y1[j] = ((v1 * r1) * g) * (sc + 1.0f) + sh;
            u32x2 w0, w1; w0.x = pk2(y0[j][0], y0[j][1]); w0.y = pk2(y0[j][2], y0[j][3]); w1.x = pk2(y1[j][0], y1[j][1]); w1.y = pk2(y1[j][2], y1[j][3]);
            *(u32x2*)(A + (size_t)row * DM + c) = w0; *(u32x2*)(A + (size_t)(row + 1) * DM + c) = w1; }
        asm volatile("" ::: "memory");
        router_rows2(y0, y1, rwT, affL, affC, row, lane);
    }
}
DI void ph_topk(int nitems, const float* affL, const float* affC, int* rowsrc, float* gatev, int* inv, LAS unsigned* hist, int tid, int lane, int wave, int bid, int G) {
    LAS unsigned* sh = hist + 256;
    for (int it = bid; it < nitems; it += G) {
        const bool isc = it >= 128; const int be = it & 127, b = be >> 4, e = be & 15;
        const int N = isc ? CTXL : SEQ, C = isc ? CAPC : CAPL;
        const float* src = isc ? affC + (size_t)be * CTXL : affL + (size_t)be * SEQ;
        const int i0 = tid * 4; const bool valid = i0 < N;
        unsigned key[4];
        { f32x4 v = (f32x4){0.f, 0.f, 0.f, 0.f}; if (valid) v = *(const f32x4*)(src + i0);
#pragma unroll
          for (int q = 0; q < 4; ++q) key[q] = __float_as_uint(v[q]); }
        unsigned prefix = 0u, mask = 0u, krem = (unsigned)C;
        for (int pass = 3; pass >= 0; --pass) {
            const int shift = pass * 8;
            if (tid < 256) hist[tid] = 0u;
            __syncthreads();
            if (valid) {
#pragma unroll
                for (int q = 0; q < 4; ++q) if ((key[q] & mask) == prefix) __hip_atomic_fetch_add(&hist[(key[q] >> shift) & 255u], 1u, __ATOMIC_RELAXED, __HIP_MEMORY_SCOPE_WORKGROUP); }
            __syncthreads();
            if (wave == 0) {
                const unsigned h0 = hist[4 * lane], h1 = hist[4 * lane + 1], h2 = hist[4 * lane + 2], h3 = hist[4 * lane + 3];
                const unsigned tot = h0 + h1 + h2 + h3; unsigned incl = tot;
#pragma unroll
                for (int o = 1; o < 64; o <<= 1) { const unsigned t = __shfl_down(incl, o); if (lane + o < 64) incl += t; }
                const unsigned a3 = incl - tot, a2 = a3 + h3, a1 = a2 + h2, a0 = a1 + h1;
                if (a3 < krem && krem <= a3 + h3) { sh[0] = 4 * lane + 3; sh[1] = krem - a3; }
                if (a2 < krem && krem <= a2 + h2) { sh[0] = 4 * lane + 2; sh[1] = krem - a2; }
                if (a1 < krem && krem <= a1 + h1) { sh[0] = 4 * lane + 1; sh[1] = krem - a1; }
                if (a0 < krem && krem <= a0 + h0) { sh[0] = 4 * lane + 0; sh[1] = krem - a0; }
            }
            __syncthreads();
            const unsigned B = sh[0]; krem = sh[1]; prefix |= B << shift; mask |= 0xFFu << shift;
        }
        const unsigned T = prefix;
        unsigned cg = 0u, ce = 0u;
        if (valid) {
#pragma unroll
            for (int q = 0; q < 4; ++q) { cg += key[q] > T ? 1u : 0u; ce += key[q] == T ? 1u : 0u; } }
        const unsigned mine = cg | (ce << 16); unsigned incl = mine;
#pragma unroll
        for (int o = 1; o < 64; o <<= 1) { const unsigned t = __shfl_up(incl, o); if (lane >= o) incl += t; }
        if (lane == 63) sh[8 + wave] = incl;
        __syncthreads();
        unsigned woff = 0u;
#pragma unroll
        for (int w = 0; w < 8; ++w) woff += (w < wave) ? sh[8 + w] : 0u;
        const unsigned excl = woff + incl - mine; unsigned gtb = excl & 0xFFFFu, eqb = excl >> 16;
        if (valid) {
            const int ybase = e * YR + (isc ? NB * CAPL + b * CAPC : b * CAPL); const int rbase = isc ? ML + b * CTXL : b * SEQ;
#pragma unroll
            for (int q = 0; q < 4; ++q) {
                const bool isg = key[q] > T, ise = key[q] == T; const bool sel = isg || (ise && eqb < krem);
                const unsigned slot = gtb + (eqb < krem ? eqb : krem);
                const int trow = rbase + i0 + q; const int yrow = ybase + (int)slot;
                if (sel) { rowsrc[yrow] = trow; gatev[yrow] = __uint_as_float(key[q]); }
                inv[(size_t)trow * 16 + e] = sel ? yrow : -1;
                gtb += isg ? 1u : 0u; eqb += ise ? 1u : 0u;
            }
        }
        __syncthreads();
    }
}
template <bool LAST> DI void ph_combine(bf16_t* H, const bf16_t* Y, const int* inv, const float* modl  , const float* gain1, const float* mod1, bf16_t* A, float* out, int nrows, int gw, int NGW, int lane) {
    for (int row = gw; row < nrows; row += NGW) {
        const int cr = row < ML ? (row >> 11) : 8;
        f32x4 v[8], acc[8]; row_load_bf(H + (size_t)row * DM, v, lane);
#pragma unroll
        for (int j = 0; j < 8; ++j) acc[j] = (f32x4){0.f, 0.f, 0.f, 0.f};
        const int myinv = inv[(size_t)row * 16 + (lane & 15)];
        for (int e = 0; e < 16; ++e) {
            const int yr = __builtin_amdgcn_readlane(myinv, e);
            if (yr >= 0) { const bf16_t* yp = Y + (size_t)yr * DM + 4 * lane;
#pragma unroll
                for (int j = 0; j < 8; ++j) { const u32x2 p = *(const u32x2*)(yp + 256 * j); acc[j][0] += bf_lo(p.x); acc[j][1] += bf_hi(p.x); acc[j][2] += bf_lo(p.y); acc[j][3] += bf_hi(p.y); } }
        }
        const float* g2 = modl + (size_t)cr * NMOD + 5 * DM;
#pragma unroll
        for (int j = 0; j < 8; ++j) { const f32x4 g = *(const f32x4*)(g2 + 4 * lane + 256 * j); v[j] = v[j] + g * acc[j]; }
        if (LAST) {
#pragma unroll
            for (int j = 0; j < 8; ++j) *(f32x4*)(out + (size_t)row * DM + 4 * lane + 256 * j) = v[j];
        } else {
            row_store_bf16(H + (size_t)row * DM, v, lane);
            f32x4 y[8]; row_modulate(v, y, gain1, mod1 + (size_t)cr * NMOD + 0 * DM, mod1 + (size_t)cr * NMOD + 1 * DM, lane);
            row_store_bf16(A + (size_t)row * DM, y, lane);
        }
    }
}
DI void ph_qknorm(bf16_t* Q, bf16_t* K, const float* qg, const float* kg, int gw, int NGW, int lane) {
    const int half = lane >> 5, i = lane & 31, d1 = half * 64 + i, d2 = d1 + 32;
    const float inv_freq = exp2f(-(float)i * (13.287712379549449f / 32.0f));
    constexpr float QSCALE = 0.08838834764831845f * 1.4426950408889634f;
    const float qg1 = qg[d1] * QSCALE, qg2 = qg[d2] * QSCALE, kg1 = kg[d1], kg2 = kg[d2];
    for (int row = gw; row < MT; row += NGW) {
        const bool lat = row < ML; const int t = row & (SEQ - 1);
        const float pos = (float)(half == 0 ? (t >> 6) : (t & 63)); const float ang = pos * inv_freq;
        const float cs = lat ? __cosf(ang) : 1.0f, sn = lat ? __sinf(ang) : 0.0f;
        if (lat) {
            for (int hd = 0; hd < NH; ++hd) { bf16_t* p = Q + (size_t)row * DM + hd * HD;
                float x1 = __uint_as_float((unsigned)p[d1] << 16), x2 = __uint_as_float((unsigned)p[d2] << 16);
                const float ss = wave_sum(x1 * x1 + x2 * x2); const float rstd = 1.0f / sqrtf(ss * (1.0f / HD) + NORM_EPS);
                x1 = x1 * rstd * qg1; x2 = x2 * rstd * qg2;
                const float o1 = x1 * cs - x2 * sn, o2 = x2 * cs + x1 * sn;
                const unsigned w = pk2(o1, o2); p[d1] = (bf16_t)(w & 0xffffu); p[d2] = (bf16_t)(w >> 16); }
        }
        for (int kh = 0; kh < NKV; ++kh) { bf16_t* p = K + (size_t)row * 512 + kh * HD;
            float x1 = __uint_as_float((unsigned)p[d1] << 16), x2 = __uint_as_float((unsigned)p[d2] << 16);
            const float ss = wave_sum(x1 * x1 + x2 * x2); const float rstd = 1.0f / sqrtf(ss * (1.0f / HD) + NORM_EPS);
            x1 = x1 * rstd * kg1; x2 = x2 * rstd * kg2;
            const float o1 = x1 * cs - x2 * sn, o2 = x2 * cs + x1 * sn;
            const unsigned w = pk2(o1, o2); p[d1] = (bf16_t)(w & 0xffffu); p[d2] = (bf16_t)(w >> 16); }
    }
}
constexpr int KP = 272;
constexpr int VP = 288;
constexpr int ATT_VOFF = 64 * KP;
constexpr int ATT_TILE = 64 * KP + 64 * VP;
DI int crow(int reg, int h) { return (reg & 3) + 8 * (reg >> 2) + 4 * h; }
DI long long vtr64(const LAS unsigned char* p) { typedef short v4i16_t __attribute__((ext_vector_type(4))); return __builtin_bit_cast(long long, __builtin_amdgcn_ds_read_tr16_b64_v4i16((LAS v4i16_t*)p)); }
DI s16x4 vtr(const LAS unsigned char* p) { typedef short v4i16_t __attribute__((ext_vector_type(4))); return __builtin_bit_cast(s16x4, __builtin_amdgcn_ds_read_tr16_b64_v4i16((LAS v4i16_t*)p)); }
DI bool att_tile_info(int item, int ti, int& base, int& mtype) {
    const int qhalf = item & 1, n = (item >> 3) & 15, b = item >> 7, tt = ti & 1; mtype = 0;
    if (ti < 4) { base = ML + b * CTXL + 64 * ti; return true; }
    const int blk = n - 1 + ((ti - 4) >> 1); if (blk < 0 || blk > 15) return false;
    if (ti < 6) { mtype = 1; if (tt == 0 && qhalf == 1) return false; } else if (ti >= 8) { mtype = 2; if (tt == 1 && qhalf == 0) return false; }
    base = b * SEQ + blk * 128 + 64 * tt; return true;
}
DI void att_next(int& item, int& ti, int G) { for (;;) { ++ti; if (ti >= 10) { ti = 0; item += G; return; } int b_, m_; if (att_tile_info(item, ti, b_, m_)) return; } }
DI void ph_attn(const bf16_t* Q, const bf16_t* Kb, const bf16_t* Vb, bf16_t* O, const float* sink, LAS unsigned char* lds, int tid, int lane, int wave, int bid, int G) {
    constexpr float LOG2E = 1.4426950408889634f;
    const int r = lane & 31, h = lane >> 5, g = wave >> 1, sub = wave & 1;
    const int ldrow = tid >> 3, ldc = tid & 7;
    int item = bid, ti = 0; if (item >= 1024) return;
    u32x4 kr[2], vr[2];
#define ATT_ISSUE(it_, ti_) do { int base_, mt_; att_tile_info(it_, ti_, base_, mt_); const int kvh_ = ((it_) >> 1) & 3; \
        _Pragma("unroll") for (int c2 = 0; c2 < 2; ++c2) { const size_t off_ = (size_t)(base_ + ldrow) * 512 + kvh_ * HD + (ldc + 8 * c2) * 8; kr[c2] = *(const u32x4*)(Kb + off_); vr[c2] = *(const u32x4*)(Vb + off_); } } while (0)
    bf16x8 qf[8]; float m2 = 0.f, lsum = 1.f; f32x16 o[4]; f32x16 negm;
#define ATT_QLOAD(it_) do { const int qrow_ = ((it_) >> 7) * SEQ + (((it_) >> 3) & 15) * 128 + ((it_) & 1) * 64 + sub * 32 + r; const int head_ = (((it_) >> 1) & 3) * 4 + g; \
        _Pragma("unroll") for (int s = 0; s < 8; ++s) qf[s] = *(const bf16x8*)(Q + (size_t)qrow_ * DM + head_ * HD + 16 * s + 8 * h); } while (0)
    ATT_QLOAD(item);
    ATT_ISSUE(item, ti);
    int buf = 0;
    while (item < 1024) {
        int nitem = item, nti = ti; att_next(nitem, nti, G);
        LAS unsigned char* tb = lds + buf * ATT_TILE;
#pragma unroll
        for (int c2 = 0; c2 < 2; ++c2) { *(LAS u32x4*)(tb + ldrow * KP + (ldc + 8 * c2) * 16) = kr[c2]; *(LAS u32x4*)(tb + ATT_VOFF + ldrow * VP + (ldc + 8 * c2) * 16) = vr[c2]; }
        if (nitem < 1024) ATT_ISSUE(nitem, nti);
        asm volatile("s_waitcnt lgkmcnt(0)" ::: "memory"); __builtin_amdgcn_s_barrier(); asm volatile("" ::: "memory");
        int base, mtype; att_tile_info(item, ti, base, mtype); const int tt = ti & 1;
        const int qhalf = item & 1, kvh = (item >> 1) & 3, n = (item >> 3) & 15, b = item >> 7;
        const int head = kvh * 4 + g, qq = qhalf * 64 + sub * 32 + r; const int qrow = b * SEQ + n * 128 + qq;
        if (ti == 0) {
            m2 = sink[head] * LOG2E; lsum = 1.0f;
#pragma unroll
            for (int i = 0; i < 16; ++i) negm[i] = -m2;
#pragma unroll
            for (int d = 0; d < 4; ++d)
#pragma unroll
                for (int i = 0; i < 16; ++i) o[d][i] = 0.f;
        }
        f32x16 x0, x1;
#pragma unroll
        for (int s = 0; s < 8; ++s) {
            const bf16x8 k0 = *(const LAS bf16x8*)(tb + r * KP + (16 * s + 8 * h) * 2), k1 = *(const LAS bf16x8*)(tb + (32 + r) * KP + (16 * s + 8 * h) * 2);
            if (s == 0) { x0 = __builtin_amdgcn_mfma_f32_32x32x16_bf16(k0, qf[s], negm, 0, 0, 0); x1 = __builtin_amdgcn_mfma_f32_32x32x16_bf16(k1, qf[s], negm, 0, 0, 0); }
            else { x0 = __builtin_amdgcn_mfma_f32_32x32x16_bf16(k0, qf[s], x0, 0, 0, 0); x1 = __builtin_amdgcn_mfma_f32_32x32x16_bf16(k1, qf[s], x1, 0, 0, 0); } }
        if (nitem != item && nitem < 1024) ATT_QLOAD(nitem);
        if (mtype == 1) {
#pragma unroll
            for (int i = 0; i < 16; ++i) { const int kk0 = tt * 64 + crow(i, h); if (kk0 < qq) x0[i] = -1.0e30f; if (kk0 + 32 < qq) x1[i] = -1.0e30f; } }
        if (mtype == 2) {
#pragma unroll
            for (int i = 0; i < 16; ++i) { const int kk0 = tt * 64 + crow(i, h); if (kk0 > qq) x0[i] = -1.0e30f; if (kk0 + 32 > qq) x1[i] = -1.0e30f; } }
        float tmax = fmaxf(x0[0], x1[0]);
#pragma unroll
        for (int i = 1; i < 16; ++i) tmax = fmaxf(fmaxf(tmax, x0[i]), x1[i]);
        tmax = fmaxf(tmax, __shfl_xor(tmax, 32));
        if (__any(tmax > 0.0f)) {
            const float dl = fmaxf(tmax, 0.0f), alpha = __builtin_amdgcn_exp2f(-dl); m2 += dl; lsum *= alpha;
#pragma unroll
            for (int i = 0; i < 16; ++i) { x0[i] -= dl; x1[i] -= dl; negm[i] = -m2; }
#pragma unroll
            for (int d = 0; d < 4; ++d)
#pragma unroll
                for (int i = 0; i < 16; ++i) o[d][i] *= alpha;
        }
        float ps = 0.f;
#pragma unroll
        for (int i = 0; i < 16; ++i) { x0[i] = __builtin_amdgcn_exp2f(x0[i]); x1[i] = __builtin_amdgcn_exp2f(x1[i]); ps += x0[i] + x1[i]; }
        ps += __shfl_xor(ps, 32); lsum += ps;
        bf16x8 pf[2][2];
#pragma unroll
        for (int s = 0; s < 2; ++s) {
            u32x4 a, c; a.x = pk2(x0[8 * s + 0], x0[8 * s + 1]); a.y = pk2(x0[8 * s + 2], x0[8 * s + 3]); a.z = pk2(x0[8 * s + 4], x0[8 * s + 5]); a.w = pk2(x0[8 * s + 6], x0[8 * s + 7]);
            c.x = pk2(x1[8 * s + 0], x1[8 * s + 1]); c.y = pk2(x1[8 * s + 2], x1[8 * s + 3]); c.z = pk2(x1[8 * s + 4], x1[8 * s + 5]); c.w = pk2(x1[8 * s + 6], x1[8 * s + 7]);
            pf[0][s] = __builtin_bit_cast(bf16x8, a); pf[1][s] = __builtin_bit_cast(bf16x8, c); }
        const LAS unsigned char* vb = tb + ATT_VOFF + (4 * h + ((lane & 15) >> 2)) * VP + (16 * ((lane >> 4) & 1) + 4 * (lane & 3)) * 2;
#pragma unroll
        for (int d = 0; d < 4; ++d)
#pragma unroll
            for (int t = 0; t < 2; ++t)
#pragma unroll
                for (int s = 0; s < 2; ++s) {
                    typedef long long i64x2_t __attribute__((ext_vector_type(2)));
                    i64x2_t vv; vv.x = vtr64(vb + (t * 32 + 16 * s) * VP + d * 64); vv.y = vtr64(vb + (t * 32 + 16 * s + 8) * VP + d * 64);
                    const bf16x8 vf = __builtin_bit_cast(bf16x8, vv);
                    o[d] = __builtin_amdgcn_mfma_f32_32x32x16_bf16(vf, pf[t][s], o[d], 0, 0, 0); }
        if (nitem != item) {
            const float il = 1.0f / lsum;
            bf16_t* op = O + (size_t)qrow * DM + head * HD + 4 * h;
#pragma unroll
            for (int d = 0; d < 4; ++d)
#pragma unroll
                for (int g4 = 0; g4 < 4; ++g4) { u32x2 w; w.x = pk2(o[d][4 * g4 + 0] * il, o[d][4 * g4 + 1] * il); w.y = pk2(o[d][4 * g4 + 2] * il, o[d][4 * g4 + 3] * il);
                    *(u32x2*)(op + d * 32 + 8 * g4) = w; }
        }
        item = nitem; ti = nti; buf ^= 1;
    }
#undef ATT_ISSUE
#undef ATT_QLOAD
}
#ifndef MK_ONE_LAUNCH
#define MK_ONE_LAUNCH 1
#endif
constexpr int NPHASE = 19;
constexpr int CVT_X0_END = CVT_E0 + CVT_L;
#define CVT_MKCP() CvtPtrs CP; CP.cin = args.in[8]; CP.cout = args.in[10]; CP.wqkv = args.in[11]; CP.wo = args.in[15]; CP.wg = args.in[17]; CP.wu = args.in[18]; CP.wd = args.in[19]; \
    CP.W1A = W1A; CP.W1B = W1B; CP.W2 = W2; CP.WQKV = WQKV; CP.WO = WOt; CP.WGU = WGU; CP.WDN = WDN
#define CVT(LO, HI) do { CVT_MKCP(); cvt_range(CP, LO, HI, gw, NGW, cscr, lane); } while (0)
#ifndef MK_DUP_MASK
#define MK_DUP_MASK 0u
#endif
constexpr unsigned DUP_MASK = MK_DUP_MASK;
struct Args { const float* in[20]; float* out; unsigned char* ws; int ph_lo, ph_hi; };
__global__ void __launch_bounds__(512, 2) dit_fwd(Args args) {
    extern __shared__ __attribute__((aligned(16))) unsigned char lds_raw[];
    LAS unsigned char* lds = (LAS unsigned char*)lds_raw;
    const int tid = threadIdx.x, lane = tid & 63, wave = __builtin_amdgcn_readfirstlane(tid >> 6);
    const int G = gridDim.x, bid = blockIdx.x;
    const int gw = bid * 8 + wave, NGW = G * 8;
    unsigned char* ws = args.ws;
    const float* x = args.in[0]; const float* cnd = args.in[1]; const float* ctx = args.in[2]; const float* cctx = args.in[3];
    const float* ada_w = args.in[4]; const float* ada_b = args.in[5]; const float* nmix = args.in[6]; const float* nffn = args.in[7];
    const float* conv_w = args.in[9]; const float* qgain = args.in[12]; const float* kgain = args.in[13]; const float* sink = args.in[14]; const float* router_w = args.in[16];
    float* mod = (float*)(ws + WS_MOD); float* modp = (float*)(ws + WS_MODP);
    float* affL = (float*)(ws + WS_AFFL); float* affC = (float*)(ws + WS_AFFC);
    int* rowsrc = (int*)(ws + WS_ROWSRC); float* gatev = (float*)(ws + WS_GATEV); int* inv = (int*)(ws + WS_INV);
    bf16_t* W1A = (bf16_t*)(ws + WS_W1A); bf16_t* W1B = (bf16_t*)(ws + WS_W1B); bf16_t* W2 = (bf16_t*)(ws + WS_W2); bf16_t* WQKV = (bf16_t*)(ws + WS_WQKV); bf16_t* WOt = (bf16_t*)(ws + WS_WO);
    bf16_t* WGU = (bf16_t*)(ws + WS_WGU); bf16_t* WDN = (bf16_t*)(ws + WS_WDN);
    bf16_t* H = (bf16_t*)(ws + WS_H); bf16_t* A = (bf16_t*)(ws + WS_A); bf16_t* U = (bf16_t*)(ws + WS_U); bf16_t* Z = (bf16_t*)(ws + WS_Z);
    bf16_t* Qb = (bf16_t*)(ws + WS_Q); bf16_t* Kb = (bf16_t*)(ws + WS_K); bf16_t* Vb = (bf16_t*)(ws + WS_V); bf16_t* Ob = (bf16_t*)(ws + WS_O);
    bf16_t* HM = (bf16_t*)(ws + WS_HM); bf16_t* Y = (bf16_t*)(ws + WS_Y);
    LAS unsigned* cscr = (LAS unsigned*)(lds + wave * 9216);

    for (int u = tid; u < (LDS_BYTES - MISC_OFF) / 4; u += 512) ((LAS unsigned*)(lds + MISC_OFF))[u] = 0u;
    __syncthreads();
#if MK_ONE_LAUNCH
    XcdBarrier bar = xcd_barrier_post((unsigned*)(ws + WS_CTL) + CW_BAR, (volatile LAS unsigned*)(lds + MISC_OFF) + 8);
#define GRID_BAR() xcd_barrier(bar)
#else
#define GRID_BAR() do {} while (0)
#endif
    const int lo = args.ph_lo, hi = args.ph_hi;
#define IN(k) (lo <= (k) && (k) < hi)
#define SEAM(k) do { if (IN(k) && IN((k) + 1)) GRID_BAR(); } while (0)
#define PHASE(k) if (IN(k)) _Pragma("unroll") for (int rep_ = 0; rep_ < 1 + (int)((DUP_MASK >> (k)) & 1u); ++rep_)
#define REP_BAR() do { if (rep_) GRID_BAR(); } while (0)

    PHASE(0) { REP_BAR(); ph_adaln(cnd, cctx, ada_w, modp, gw, NGW, lane); } SEAM(0);
    PHASE(1) { REP_BAR(); ph_modred(modp, ada_b, mod, bid * 512 + tid, G * 512); } SEAM(1);
    PHASE(2) { REP_BAR(); ph_mod0(x, ctx, nmix, mod, A, gw, NGW, lane); CVT(0, 4096); } SEAM(2);
    PHASE(3) { REP_BAR();
        pg8::Gemm g{A, W1A, MT, 4096, DM}; pg8::StaticOrder S; S.init(MT, 4096, G, bid);
        EpiPair<0> E{U, DM, 16};
        pg8::gemm_phase<EpiPair<0>, pg8::StaticOrder, true, true>(lds, g, S, E);
    } SEAM(3);
    PHASE(4) { REP_BAR();
        pg8::Gemm g{A, W1B, MT, DM, DM}; pg8::StaticOrder S; S.init(MT, DM, G, bid);
        EpiConvGate E{U, Z, conv_w};
        pg8::gemm_phase<EpiConvGate, pg8::StaticOrder, true, true>(lds, g, S, E);
    } SEAM(4);
    PHASE(5) { REP_BAR();
        pg8::Gemm g{Z, W2, MT, DM, DM}; pg8::StaticOrder S; S.init(MT, DM, G, bid);
        EpiResid<true> E{x, ctx, H, mod + 2 * DM};
        pg8::gemm_phase<EpiResid<true>, pg8::StaticOrder, true, true>(lds, g, S, E);
    } SEAM(5);
    PHASE(6) { REP_BAR(); load_router(router_w, (LAS float*)lds, tid); ph_modffn(H, nffn, mod, A, (const LAS float*)lds, affL, affC, MT, gw, NGW, lane); } SEAM(6);
    PHASE(7) { REP_BAR(); ph_topk(256, affL, affC, rowsrc, gatev, inv, (LAS unsigned*)lds, tid, lane, wave, bid, G); CVT(CVT_E0, CVT_E0 + 16384); } SEAM(7);
    PHASE(8) { REP_BAR();
        pg8::Gemm g{A, WGU, YT, NE * 2048, DM, rowsrc}; MoeOrder S{G, bid, 9};
        EpiPair<1> E{HM, DFF, 8};
        pg8::gemm_phase<EpiPair<1>, MoeOrder, true, true, true>(lds, g, S, E);
        CVT(CVT_E0 + 16384, CVT_X0_END);
    } SEAM(8);
    PHASE(9) { REP_BAR();
        pg8::Gemm g{HM, WDN, YT, NE * 2048, DFF}; MoeOrder S{G, bid, 9};
        EpiDown E{Y, gatev};
        pg8::gemm_phase<EpiDown, MoeOrder, true, true>(lds, g, S, E);
    } SEAM(9);
    PHASE(10) { REP_BAR(); ph_combine<false>(H, Y, inv, mod, nmix + DM, mod + 9 * NMOD, A, nullptr, MT, gw, NGW, lane); CVT(4096, 4096 + 1536); } SEAM(10);
    PHASE(11) { REP_BAR();
        pg8::Gemm g{A, WQKV, MT, 3072, DM}; QkvOrder S{G, bid};
        EpiQkvNorm E{Qb, Kb, Vb, qgain, kgain, (LAS float*)(lds + RING_BYTES)};
        pg8::gemm_phase<EpiQkvNorm, QkvOrder, true, true>(lds, g, S, E);
    } SEAM(11);
    PHASE(12) { REP_BAR(); ph_attn(Qb, Kb, Vb, Ob, sink, lds, tid, lane, wave, bid, G); __syncthreads(); CVT(4096 + 1536, CVT_E0); } SEAM(12);
    PHASE(13) { REP_BAR();
        pg8::Gemm g{Ob, WOt, ML, DM, DM}; pg8::StaticOrder S; S.init(ML, DM, G, bid);
        EpiResid<false> E{nullptr, nullptr, H, mod + 9 * NMOD + 2 * DM};
        pg8::gemm_phase<EpiResid<false>, pg8::StaticOrder, true, true>(lds, g, S, E);
    } SEAM(13);
    PHASE(14) { REP_BAR(); load_router(router_w + DM * 16, (LAS float*)lds, tid); ph_modffn(H, nffn + DM, mod + 9 * NMOD, A, (const LAS float*)lds, affL, affC, ML, gw, NGW, lane); } SEAM(14);
    PHASE(15) { REP_BAR(); ph_topk(128, affL, affC, rowsrc, gatev, inv, (LAS unsigned*)lds, tid, lane, wave, bid, G); CVT(CVT_X0_END, CVT_X0_END + 16384); } SEAM(15);
    PHASE(16) { REP_BAR();
        pg8::Gemm g{A, WGU + (size_t)NE * 2048 * DM, YT, NE * 2048, DM, rowsrc}; MoeOrder S{G, bid, 8};
        EpiPair<1> E{HM, DFF, 8};
        pg8::gemm_phase<EpiPair<1>, MoeOrder, true, true, true>(lds, g, S, E);
        CVT(CVT_X0_END + 16384, CVT_TOTAL);
    } SEAM(16);
    PHASE(17) { REP_BAR();
        pg8::Gemm g{HM, WDN + (size_t)NE * 2048 * DFF, YT, NE * 2048, DFF}; MoeOrder S{G, bid, 8};
        EpiDown E{Y, gatev};
        pg8::gemm_phase<EpiDown, MoeOrder, true, true>(lds, g, S, E);
    } SEAM(17);
    PHASE(18) { REP_BAR(); ph_combine<true>(H, Y, inv, mod + 9 * NMOD, nullptr, nullptr, nullptr, args.out, ML, gw, NGW, lane); }
#undef IN
#undef SEAM
#undef PHASE
#undef REP_BAR
}

extern "C" void kernel_launch(void* const* d_in, const int* in_sizes, int n_in, void* d_out, int out_size, void* d_ws, size_t ws_size, hipStream_t stream) {
    static int grid = 0;
    if (grid == 0) {
        if (n_in != 20 || out_size != ML * DM || ws_size < WS_END) { fprintf(stderr, "kernel_launch: unexpected problem (n_in %d, out %d, ws %zu); nothing launched\n", n_in, out_size, ws_size); grid = -1; return; }
        int dev = 0, cus = 0, per_cu = 0;
        if (hipGetDevice(&dev) != hipSuccess || hipDeviceGetAttribute(&cus, hipDeviceAttributeMultiprocessorCount, dev) != hipSuccess) { grid = -1; return; }
        if (hipFuncSetAttribute((const void*)dit_fwd, hipFuncAttributeMaxDynamicSharedMemorySize, LDS_BYTES) != hipSuccess) { fprintf(stderr, "kernel_launch: hipFuncSetAttribute failed\n"); grid = -1; return; }
        if (hipOccupancyMaxActiveBlocksPerMultiprocessor(&per_cu, (const void*)dit_fwd, 512, LDS_BYTES) != hipSuccess || per_cu < 1) fprintf(stderr, "kernel_launch: occupancy query reports %d workgroups per CU\n", per_cu);
        (void)hipGetLastError();
        grid = cus;
    }
    if (grid < 0) return;
    (void)hipMemsetAsync((char*)d_ws + WS_CTL, 0, CTL_ZERO_BYTES, stream);
    Args a{};
    for (int i = 0; i < 20; ++i) a.in[i] = (const float*)d_in[i];
    a.out = (float*)d_out; a.ws = (unsigned char*)d_ws;
#if MK_ONE_LAUNCH
    a.ph_lo = 0; a.ph_hi = NPHASE;
    hipLaunchKernelGGL(dit_fwd, dim3(grid), dim3(512), LDS_BYTES, stream, a);
#else
    for (int p = 0; p < NPHASE; ++p) { a.ph_lo = p; a.ph_hi = p + 1; hipLaunchKernelGGL(dit_fwd, dim3(grid), dim3(512), LDS_BYTES, stream, a); }
#endif
}
```

```cpp
#include <hip/hip_runtime.h>
#include <cstdio>
#include <cstdint>
namespace pg8 {
#define PG8_LAS __attribute__((address_space(3)))
typedef unsigned short bf16_t;
typedef short bf16x8 __attribute__((ext_vector_type(8)));
typedef float f32x4 __attribute__((ext_vector_type(4)));
typedef unsigned u32x4 __attribute__((ext_vector_type(4)));
constexpr int BM = 256, BK = 64, HALF = 128, HTB = HALF * BK * 2  , STAGE_BYTES = 8 * HTB, NXCD = 8, WGM = 8;

__host__ __device__ __forceinline__ int lds_byte(int r, int c) { const int st = (r >> 4) * 2 + (c >> 5), rr = r & 15, cc = c & 31, ob = rr * 64 + cc * 2; return st * 1024 + (ob ^ (((ob >> 9) & 1) << 5)); }
__host__ __device__ __forceinline__ void stage_rc(int b, int& R, int& C) { const int st = b / 1024, sb = b % 1024, swz = sb ^ (((sb >> 9) & 1) << 5); R = (st >> 1) * 16 + swz / 64; C = (st & 1) * 32 + (swz % 64) / 2; }
__host__ __device__ __forceinline__ int perm32(int rho) { const int n = rho >> 4, i = rho & 15; return 8 * (i >> 2) + 4 * n + (i & 3); }

struct Unit { int pm, pn; };
struct Gemm { const bf16_t* A; const bf16_t* Bt; int M, N, K; const int* rows = nullptr; };

struct StaticOrder {
    int nM, nN, nwg, G, c;
    __host__ __device__ void init(int M, int N, int G_, int c_) { nM = M / BM; nN = N / BM; nwg = nM * nN; G = G_; c = c_; }
    __host__ __device__ bool next(int i, Unit& u) const {
        const long L = (long)i * G + c; if (L >= nwg) return false;
        int wgid = (int)L; { const int q = nwg / NXCD, r = nwg % NXCD, xcd = wgid % NXCD, off = wgid / NXCD; wgid = (xcd < r ? xcd * (q + 1) : r * (q + 1) + (xcd - r) * q) + off; }
        const int nig = WGM * nN, gid = wgid / nig, fm = gid * WGM, gsz = (nM - fm) < WGM ? (nM - fm) : WGM;
        u.pm = fm + ((wgid % nig) % gsz); u.pn = (wgid % nig) / gsz; return true;
    }
    __device__ __forceinline__ void a_ready(const Unit&) const {}
    __device__ __forceinline__ void done(const Unit&) const {}
};
__device__ __forceinline__ unsigned cvt_pk_bf16(float lo, float hi) { unsigned r; asm volatile("v_cvt_pk_bf16_f32 %0, %1, %2" : "=v"(r) : "v"(lo), "v"(hi)); return r; }
typedef float f32x2 __attribute__((ext_vector_type(2)));
template <class Epi, class Sched, bool ALIGN_EPI = false, bool SP2 = false, bool GATHER = false>
__device__ __forceinline__ void gemm_phase(PG8_LAS unsigned char* lds, const Gemm g, const Sched& S, const Epi& E) {
    const int tid = threadIdx.x, wid = __builtin_amdgcn_readfirstlane(tid >> 6), lane = tid & 63, wr = wid >> 2, wc = wid & 3, fr = lane & 15, fq = lane >> 4;
    const int K = g.K, nt = K / BK;
    unsigned voffA[2], voffB[2];
#pragma unroll
    for (int i = 0; i < 2; ++i) { int R, C; stage_rc(tid * 16 + i * 8192, R, C); const int Rb = Epi::PERM ? ((R & ~31) + perm32(R & 31)) : R;
        voffA[i] = (unsigned)(R * K + C) * 2u; voffB[i] = (unsigned)(Rb * K + C) * 2u; }
    const size_t kstep = (size_t)(BK * 2);
    const size_t hstep = (size_t)HALF * K * 2;
    const size_t tstep = 2 * hstep;
    const unsigned ldsw = (unsigned)wid * 1024u;
    const int aoff = lds_byte(wr * 64 + fr, fq * 8), boff = lds_byte(wc * 32 + fr, fq * 8);
#define PG8_SA(b, h) (((b) * 2 + (h)) * HTB)
#define PG8_SB(b, h) ((4 + (b) * 2 + (h)) * HTB)
#define PG8_STAGE(bufoff, gbase, voff) do { _Pragma("unroll") for (int _i = 0; _i < 2; ++_i) \
        __builtin_amdgcn_global_load_lds((const unsigned*)((const char*)(gbase) + (voff)[_i]), (PG8_LAS unsigned*)(lds + (bufoff) + ldsw + _i * 8192), 16, 0, 0); } while (0)
#define PG8_STAGE_A(bufoff, kptr, h) do { if constexpr (GATHER) { PG8_STAGE(bufoff, kptr, vA[h]); } else { PG8_STAGE(bufoff, (kptr) + (h) * hstep, voffA); } } while (0)
#define PG8_GATHER_SWITCH() do { if constexpr (GATHER) { if (last && has_next) { asm volatile("" : "+v"(nv[0]), "+v"(nv[1]), "+v"(nv[2]), "+v"(nv[3])); \
        vA[0][0] = nv[0] * (unsigned)(K * 2) + gcoff[0]; vA[0][1] = nv[1] * (unsigned)(K * 2) + gcoff[1]; vA[1][0] = nv[2] * (unsigned)(K * 2) + gcoff[0]; vA[1][1] = nv[3] * (unsigned)(K * 2) + gcoff[1]; } } } while (0)
#define PG8_LDA(dst, b, h) do { _Pragma("unroll") for (int m = 0; m < 4; ++m) _Pragma("unroll") for (int k = 0; k < 2; ++k) dst[m][k] = *(const PG8_LAS bf16x8*)(lds + PG8_SA(b, h) + aoff + m * 2048 + k * 1024); } while (0)
#define PG8_LDB(dst, b, h) do { _Pragma("unroll") for (int n = 0; n < 2; ++n) _Pragma("unroll") for (int k = 0; k < 2; ++k) dst[n][k] = *(const PG8_LAS bf16x8*)(lds + PG8_SB(b, h) + boff + n * 2048 + k * 1024); } while (0)
#define PG8_MMA(ai, bj, At, Bt) do { __builtin_amdgcn_s_setprio(1); _Pragma("unroll") for (int m = 0; m < 4; ++m) _Pragma("unroll") for (int n = 0; n < 2; ++n) _Pragma("unroll") for (int k = 0; k < 2; ++k) \
        acc[ai][bj][m][n] = __builtin_amdgcn_mfma_f32_16x16x32_bf16(Bt[n][k], At[m][k], acc[ai][bj][m][n], 0, 0, 0); __builtin_amdgcn_s_setprio(0); } while (0)
#define PG8_WAIT_V(n) asm volatile("s_waitcnt vmcnt(" #n ")" ::: "memory")
#define PG8_WAIT_L(n) asm volatile("s_waitcnt lgkmcnt(" #n ")" ::: "memory")
#define PG8_BAR __builtin_amdgcn_s_barrier()
#define PG8_SCHED __builtin_amdgcn_sched_barrier(0)
    Unit cur, nxt; int ui = 0;
    if (!S.next(0, cur)) return;
    f32x4 acc[2][2][4][2];
#pragma unroll
    for (int a = 0; a < 2; ++a)
#pragma unroll
        for (int b = 0; b < 2; ++b)
#pragma unroll
            for (int m = 0; m < 4; ++m)
#pragma unroll
                for (int n = 0; n < 2; ++n) acc[a][b][m][n] = (f32x4){0.f, 0.f, 0.f, 0.f};
    bf16x8 At[4][2], B0[2][2], B1[2][2];
    const char* cA = (const char*)g.A + (GATHER ? (size_t)0 : (size_t)cur.pm * tstep); const char* cB = (const char*)g.Bt + (size_t)cur.pn * tstep;
    unsigned vA[2][2], nv[4], gcoff[2]; int grow[2];
    if constexpr (GATHER) {
#pragma unroll
        for (int i = 0; i < 2; ++i) { int R, C; stage_rc(tid * 16 + i * 8192, R, C); grow[i] = R; gcoff[i] = (unsigned)(C * 2); }
#pragma unroll
        for (int h = 0; h < 2; ++h)
#pragma unroll
            for (int i = 0; i < 2; ++i) vA[h][i] = (unsigned)g.rows[cur.pm * BM + h * HALF + grow[i]] * (unsigned)(K * 2) + gcoff[i];
    }
    S.a_ready(cur);
    if constexpr (SP2) {
        PG8_STAGE(PG8_SB(0, 0), cB, voffB); PG8_STAGE(PG8_SB(0, 1), cB + hstep, voffB); PG8_STAGE_A(PG8_SA(0, 0), cA, 0); PG8_STAGE_A(PG8_SA(0, 1), cA, 1);
        if (wr == 1) PG8_BAR;
        PG8_WAIT_V(2); PG8_BAR;
        PG8_STAGE(PG8_SB(1, 0), cB + kstep, voffB); PG8_STAGE_A(PG8_SA(1, 0), cA + kstep, 0); PG8_STAGE(PG8_SB(1, 1), cB + hstep + kstep, voffB);
        PG8_WAIT_V(6); PG8_BAR;
    } else {
        PG8_STAGE(PG8_SB(0, 0), cB, voffB); PG8_STAGE_A(PG8_SA(0, 0), cA, 0); PG8_STAGE(PG8_SB(0, 1), cB + hstep, voffB); PG8_STAGE_A(PG8_SA(0, 1), cA, 1);
        if (wr == 1) PG8_BAR;
        PG8_WAIT_V(4); PG8_BAR;
        PG8_STAGE(PG8_SB(1, 0), cB + kstep, voffB); PG8_STAGE_A(PG8_SA(1, 0), cA + kstep, 0); PG8_STAGE(PG8_SB(1, 1), cB + hstep + kstep, voffB);
        PG8_WAIT_V(6); PG8_BAR;
    }
    for (;;) {
        const bool has_next = S.next(ui + 1, nxt);
        const char* nA = (has_next && !GATHER) ? (const char*)g.A + (size_t)nxt.pm * tstep : cA; const char* nB = has_next ? (const char*)g.Bt + (size_t)nxt.pn * tstep : cB;
        if constexpr (GATHER) { if (has_next) { const int* rp = g.rows + nxt.pm * BM;
            asm volatile("global_load_dword %0, %1, off" : "=&v"(nv[0]) : "v"(rp + grow[0]) : "memory"); asm volatile("global_load_dword %0, %1, off" : "=&v"(nv[1]) : "v"(rp + grow[1]) : "memory");
            asm volatile("global_load_dword %0, %1, off" : "=&v"(nv[2]) : "v"(rp + HALF + grow[0]) : "memory"); asm volatile("global_load_dword %0, %1, off" : "=&v"(nv[3]) : "v"(rp + HALF + grow[1]) : "memory"); } }
        for (int t = 0; t < nt; t += 2) {
            const bool last = (t == nt - 2);
            const char* a1 = cA + (size_t)(t + 1) * kstep;
            const char* a2 = last ? nA : cA + (size_t)(t + 2) * kstep; const char* b2 = last ? nB : cB + (size_t)(t + 2) * kstep;
            const char* a3 = a2 + kstep; const char* b3 = b2 + kstep;
            if (last && has_next) S.a_ready(nxt);
            if constexpr (SP2) {
            PG8_LDB(B0, 0, 0); PG8_LDB(B1, 0, 1); PG8_SCHED; PG8_LDA(At, 0, 0); PG8_STAGE_A(PG8_SA(1, 1), a1, 1); PG8_GATHER_SWITCH();
            PG8_WAIT_V(8); PG8_WAIT_L(0); PG8_BAR; PG8_MMA(0, 0, At, B0); PG8_MMA(0, 1, At, B1); PG8_BAR; PG8_SCHED;
            PG8_LDA(At, 0, 1); PG8_STAGE(PG8_SB(0, 0), b2, voffB); PG8_STAGE(PG8_SB(0, 1), b2 + hstep, voffB); PG8_STAGE_A(PG8_SA(0, 0), a2, 0);
            PG8_WAIT_V(8); PG8_WAIT_L(0); PG8_BAR; PG8_MMA(1, 0, At, B0); PG8_MMA(1, 1, At, B1); PG8_BAR; PG8_SCHED;
            PG8_LDB(B0, 1, 0); PG8_LDB(B1, 1, 1); PG8_SCHED; PG8_LDA(At, 1, 0); PG8_STAGE_A(PG8_SA(0, 1), a2, 1);
            PG8_WAIT_V(8); PG8_WAIT_L(0); PG8_BAR; PG8_MMA(0, 0, At, B0); PG8_MMA(0, 1, At, B1); PG8_BAR; PG8_SCHED;
            PG8_LDA(At, 1, 1); PG8_STAGE(PG8_SB(1, 0), b3, voffB); PG8_STAGE(PG8_SB(1, 1), b3 + hstep, voffB); PG8_STAGE_A(PG8_SA(1, 0), a3, 0);
            PG8_WAIT_V(8); PG8_WAIT_L(0); PG8_BAR; PG8_MMA(1, 0, At, B0); PG8_MMA(1, 1, At, B1); PG8_BAR; PG8_SCHED;
            } else {
            PG8_LDB(B0, 0, 0); PG8_SCHED; PG8_LDA(At, 0, 0); PG8_STAGE_A(PG8_SA(1, 1), a1, 1); PG8_GATHER_SWITCH();
            PG8_WAIT_L(8); PG8_BAR; PG8_WAIT_L(0); PG8_MMA(0, 0, At, B0); PG8_BAR; PG8_SCHED;
            PG8_LDB(B1, 0, 1); PG8_STAGE(PG8_SB(0, 0), b2, voffB);
            PG8_BAR; PG8_WAIT_L(0); PG8_MMA(0, 1, At, B1); PG8_BAR;
            PG8_LDA(At, 0, 1); PG8_STAGE_A(PG8_SA(0, 0), a2, 0);
            PG8_BAR; PG8_WAIT_L(0); PG8_MMA(1, 0, At, B0); PG8_BAR; PG8_SCHED;
            PG8_STAGE(PG8_SB(0, 1), b2 + hstep, voffB);
            PG8_WAIT_V(6); PG8_BAR; PG8_MMA(1, 1, At, B1); PG8_BAR;
            PG8_LDB(B0, 1, 0); PG8_SCHED; PG8_LDA(At, 1, 0); PG8_STAGE_A(PG8_SA(0, 1), a2, 1);
            PG8_WAIT_L(8); PG8_BAR; PG8_WAIT_L(0); PG8_MMA(0, 0, At, B0); PG8_BAR; PG8_SCHED;
            PG8_LDB(B1, 1, 1); PG8_STAGE(PG8_SB(1, 0), b3, voffB);
            PG8_BAR; PG8_WAIT_L(0); PG8_MMA(0, 1, At, B1); PG8_BAR;
            PG8_LDA(At, 1, 1); PG8_STAGE_A(PG8_SA(1, 0), a3, 0);
            PG8_BAR; PG8_WAIT_L(0); PG8_MMA(1, 0, At, B0); PG8_BAR; PG8_SCHED;
            PG8_STAGE(PG8_SB(1, 1), b3 + hstep, voffB);
            PG8_WAIT_V(6); PG8_BAR; PG8_MMA(1, 1, At, B1); PG8_BAR;
            }
        }
        if constexpr (ALIGN_EPI) { if (wr == 0) PG8_BAR; }
        if constexpr (!Epi::AFTER_DRAIN) { E(acc, cur, wr, wc, fr, fq); S.done(cur); }
        if (!has_next) break;
#pragma unroll
        for (int a = 0; a < 2; ++a)
#pragma unroll
            for (int b = 0; b < 2; ++b)
#pragma unroll
                for (int m = 0; m < 4; ++m)
#pragma unroll
                    for (int n = 0; n < 2; ++n) acc[a][b][m][n] = (f32x4){0.f, 0.f, 0.f, 0.f};
        cur = nxt; cA = nA; cB = nB; ++ui;
        if constexpr (ALIGN_EPI) { if (wr == 1) PG8_BAR; }
    }
    PG8_WAIT_V(0);
    if constexpr (!ALIGN_EPI) { if (wr == 0) PG8_BAR; }
    PG8_BAR;
    if constexpr (Epi::AFTER_DRAIN) { E.fused(acc, cur, wr, wc, fr, fq, lds, wid, lane); S.done(cur); }
#undef PG8_SA
#undef PG8_SB
#undef PG8_STAGE
#undef PG8_STAGE_A
#undef PG8_GATHER_SWITCH
#undef PG8_LDA
#undef PG8_LDB
#undef PG8_MMA
#undef PG8_WAIT_V
#undef PG8_WAIT_L
#undef PG8_BAR
#undef PG8_SCHED
}
}

constexpr int DM = 2048, NB = 8, SEQ = 2048, CTXL = 256, NH = 16, NKV = 4, HD = 128;
constexpr int ML = NB * SEQ;
constexpr int MC = NB * CTXL;
constexpr int MT = ML + MC;
constexpr int NE = 16, CAPL = 256, CAPC = 32, DFF = 1024;
constexpr int YR = NB * CAPL + NB * CAPC;
constexpr int YT = NE * YR;
constexpr int NMOD = 6 * DM;
constexpr float NORM_EPS = 1e-6f;
constexpr int KSPLIT = 16;

using pg8::Unit; using pg8::f32x4; using pg8::u32x4; using pg8::bf16_t; using pg8::bf16x8; using pg8::cvt_pk_bf16;
typedef float f32x2 __attribute__((ext_vector_type(2)));
typedef unsigned u32x2 __attribute__((ext_vector_type(2)));
typedef float f32x16 __attribute__((ext_vector_type(16)));
typedef short s16x4 __attribute__((ext_vector_type(4)));
#define DI __device__ __forceinline__

DI float bf_lo(unsigned w) { return __uint_as_float(w << 16); }
DI float bf_hi(unsigned w) { return __uint_as_float(w & 0xffff0000u); }
DI float silu_f(float a) { return a * __builtin_amdgcn_rcpf(1.0f + __expf(-a)); }

DI int xcd_remap(int wgid, int nwg) { const int q = nwg / 8, r = nwg % 8, xcd = wgid % 8, off = wgid / 8; return (xcd < r ? xcd * (q + 1) : r * (q + 1) + (xcd - r) * q) + off; }
struct QkvOrder {
    int G, c;
    DI bool next(int i, Unit& u) const {
        const int L = i * G + c; if (L >= 800) return false;
        if (L < 768) { const int w = xcd_remap(L, 768); const int nig = 8 * 12, gid = w / nig; u.pm = gid * 8 + ((w % nig) % 8); u.pn = (w % nig) / 8; }
        else { const int j = L - 768; u.pm = 64 + (j >> 2); u.pn = 8 + (j & 3); }
        return true;
    }
    DI void a_ready(const Unit&) const {}
    DI void done(const Unit&) const {}
};
struct MoeOrder {
    int G, c, NP;
    DI bool next(int i, Unit& u) const {
        const int nwg = NE * NP * 8; const int L = i * G + c; if (L >= nwg) return false;
        const int w = xcd_remap(L, nwg); const int per = NP * 8, e = w / per, rem = w % per;
        u.pm = e * 9 + (rem % NP); u.pn = e * 8 + (rem / NP); return true;
    }
    DI void a_ready(const Unit&) const {}
    DI void done(const Unit&) const {}
};

template <int ACT  > struct EpiPair {
    static constexpr bool PERM = true, AFTER_DRAIN = false;
    bf16_t* O; int ldc; int pn_mod;
    DI void operator()(const f32x4 (&acc)[2][2][4][2], const Unit& u, int wr, int wc, int fr, int fq) const {
        const int row0 = u.pm * 256 + wr * 64 + fr, col0 = (u.pn % pn_mod) * 128 + wc * 32 + 8 * fq;
#pragma unroll
        for (int ai = 0; ai < 2; ++ai)
#pragma unroll
            for (int m = 0; m < 4; ++m) {
                bf16_t* rowp = O + (size_t)(row0 + ai * 128 + m * 16) * ldc + col0;
                f32x4 a0 = acc[ai][0][m][0], a1 = acc[ai][0][m][1]; const f32x4 b0 = acc[ai][1][m][0], b1 = acc[ai][1][m][1];
                if (ACT == 1) {
#pragma unroll
                    for (int j = 0; j < 4; ++j) { a0[j] = silu_f(a0[j]); a1[j] = silu_f(a1[j]); } }
                const f32x4 v0 = a0 * b0, v1 = a1 * b1;
                u32x4 w; w.x = cvt_pk_bf16(v0[0], v0[1]); w.y = cvt_pk_bf16(v0[2], v0[3]); w.z = cvt_pk_bf16(v1[0], v1[1]); w.w = cvt_pk_bf16(v1[2], v1[3]);
                *(u32x4*)rowp = w;
            }
    }
};
struct EpiConvGate {
    static constexpr bool PERM = true, AFTER_DRAIN = false;
    const bf16_t* U; bf16_t* Z; const float* cw;
    DI void operator()(const f32x4 (&acc)[2][2][4][2], const Unit& u, int wr, int wc, int fr, int fq) const {
        const int row0 = u.pm * 256 + wr * 64 + fr, col0 = u.pn * 256 + wc * 32 + 8 * fq;
#pragma unroll
        for (int bj = 0; bj < 2; ++bj) {
            const int c = col0 + bj * 128;
            f32x4 w0a = *(const f32x4*)(cw + c), w0b = *(const f32x4*)(cw + c + 4), w1a = *(const f32x4*)(cw + 2048 + c), w1b = *(const f32x4*)(cw + 2048 + c + 4), w2a = *(const f32x4*)(cw + 4096 + c), w2b = *(const f32x4*)(cw + 4096 + c + 4);
#pragma unroll
            for (int ai = 0; ai < 2; ++ai)
#pragma unroll
                for (int m = 0; m < 4; ++m) {
                    const int row = row0 + ai * 128 + m * 16;
                    const int tpos = row < ML ? (row & (SEQ - 1)) : ((row - ML) & (CTXL - 1)); const int len = row < ML ? SEQ : CTXL;
                    const u32x4 z4 = (u32x4){0u, 0u, 0u, 0u};
                    const u32x4 uc = *(const u32x4*)(U + (size_t)row * DM + c);
                    const u32x4 up = tpos > 0 ? *(const u32x4*)(U + (size_t)(row - 1) * DM + c) : z4;
                    const u32x4 un = tpos < len - 1 ? *(const u32x4*)(U + (size_t)(row + 1) * DM + c) : z4;
                    f32x4 ya, yb;
                    ya[0] = w0a[0] * bf_lo(up.x) + w1a[0] * bf_lo(uc.x) + w2a[0] * bf_lo(un.x); ya[1] = w0a[1] * bf_hi(up.x) + w1a[1] * bf_hi(uc.x) + w2a[1] * bf_hi(un.x);
                    ya[2] = w0a[2] * bf_lo(up.y) + w1a[2] * bf_lo(uc.y) + w2a[2] * bf_lo(un.y); ya[3] = w0a[3] * bf_hi(up.y) + w1a[3] * bf_hi(uc.y) + w2a[3] * bf_hi(un.y);
                    yb[0] = w0b[0] * bf_lo(up.z) + w1b[0] * bf_lo(uc.z) + w2b[0] * bf_lo(un.z); yb[1] = w0b[1] * bf_hi(up.z) + w1b[1] * bf_hi(uc.z) + w2b[1] * bf_hi(un.z);
                    yb[2] = w0b[2] * bf_lo(up.w) + w1b[2] * bf_lo(uc.w) + w2b[2] * bf_lo(un.w); yb[3] = w0b[3] * bf_hi(up.w) + w1b[3] * bf_hi(uc.w) + w2b[3] * bf_hi(un.w);
                    const f32x4 v0 = acc[ai][bj][m][0] * ya, v1 = acc[ai][bj][m][1] * yb;
                    u32x4 w; w.x = cvt_pk_bf16(v0[0], v0[1]); w.y = cvt_pk_bf16(v0[2], v0[3]); w.z = cvt_pk_bf16(v1[0], v1[1]); w.w = cvt_pk_bf16(v1[2], v1[3]);
                    *(u32x4*)(Z + (size_t)row * DM + c) = w;
                }
        }
    }
};
template <bool BASE_F32> struct EpiResid {
    static constexpr bool PERM = true, AFTER_DRAIN = false;
    const float* base_lat; const float* base_ctx; bf16_t* out; const float* gate;
    DI void operator()(const f32x4 (&acc)[2][2][4][2], const Unit& u, int wr, int wc, int fr, int fq) const {
        const int rowt = u.pm * 256; const int cr = rowt < ML ? (rowt >> 11) : 8;
        const float* base = rowt < ML ? base_lat : base_ctx - (size_t)ML * DM;
        const int row0 = rowt + wr * 64 + fr, col0 = u.pn * 256 + wc * 32 + 8 * fq;
        f32x4 gv[2][2];
#pragma unroll
        for (int bj = 0; bj < 2; ++bj)
#pragma unroll
            for (int n = 0; n < 2; ++n) gv[bj][n] = *(const f32x4*)(gate + (size_t)cr * NMOD + col0 + bj * 128 + n * 4);
#pragma unroll
        for (int ai = 0; ai < 2; ++ai)
#pragma unroll
            for (int m = 0; m < 4; ++m) { const size_t off = (size_t)(row0 + ai * 128 + m * 16) * DM + col0;
#pragma unroll
                for (int bj = 0; bj < 2; ++bj) { f32x4 b0, b1;
                    if (BASE_F32) { b0 = *(const f32x4*)(base + off + bj * 128); b1 = *(const f32x4*)(base + off + bj * 128 + 4); }
                    else { const u32x4 hb = *(const u32x4*)(out + off + bj * 128); b0 = (f32x4){bf_lo(hb.x), bf_hi(hb.x), bf_lo(hb.y), bf_hi(hb.y)}; b1 = (f32x4){bf_lo(hb.z), bf_hi(hb.z), bf_lo(hb.w), bf_hi(hb.w)}; }
                    const f32x4 v0 = b0 + gv[bj][0] * acc[ai][bj][m][0], v1 = b1 + gv[bj][1] * acc[ai][bj][m][1];
                    u32x4 w; w.x = cvt_pk_bf16(v0[0], v0[1]); w.y = cvt_pk_bf16(v0[2], v0[3]); w.z = cvt_pk_bf16(v1[0], v1[1]); w.w = cvt_pk_bf16(v1[2], v1[3]);
                    *(u32x4*)(out + off + bj * 128) = w; }
                asm volatile("" ::: "memory"); }
    }
};
struct EpiDown {
    static constexpr bool PERM = true, AFTER_DRAIN = false;
    bf16_t* Y; const float* gatev;
    DI void operator()(const f32x4 (&acc)[2][2][4][2], const Unit& u, int wr, int wc, int fr, int fq) const {
        const int row0 = u.pm * 256 + wr * 64 + fr, col0 = (u.pn & 7) * 256 + wc * 32 + 8 * fq;
#pragma unroll
        for (int ai = 0; ai < 2; ++ai)
#pragma unroll
            for (int m = 0; m < 4; ++m) { const int row = row0 + ai * 128 + m * 16; const float gt = gatev[row];
#pragma unroll
                for (int bj = 0; bj < 2; ++bj) { const f32x4 v0 = acc[ai][bj][m][0] * gt, v1 = acc[ai][bj][m][1] * gt;
                    u32x4 w; w.x = cvt_pk_bf16(v0[0], v0[1]); w.y = cvt_pk_bf16(v0[2], v0[3]); w.z = cvt_pk_bf16(v1[0], v1[1]); w.w = cvt_pk_bf16(v1[2], v1[3]);
                    *(u32x4*)(Y + (size_t)row * DM + col0 + bj * 128) = w; } }
    }
};
#define LAS3 __attribute__((address_space(3)))
struct EpiQkvNorm {
    static constexpr bool PERM = true, AFTER_DRAIN = false;
    bf16_t* Q; bf16_t* K; bf16_t* V; const float* qg; const float* kg; LAS3 float* P;
    DI void operator()(const f32x4 (&acc)[2][2][4][2], const Unit& u, int wr, int wc, int fr, int fq) const {
        const int row0 = u.pm * 256 + wr * 64 + fr; int colt = u.pn * 256;
        if (colt >= 2560) {
            const int col0 = colt - 2560 + wc * 32 + 8 * fq;
#pragma unroll
            for (int ai = 0; ai < 2; ++ai)
#pragma unroll
                for (int m = 0; m < 4; ++m) { bf16_t* rowp = V + (size_t)(row0 + ai * 128 + m * 16) * 512 + col0;
#pragma unroll
                    for (int bj = 0; bj < 2; ++bj) { const f32x4 v0 = acc[ai][bj][m][0], v1 = acc[ai][bj][m][1];
                        u32x4 w; w.x = cvt_pk_bf16(v0[0], v0[1]); w.y = cvt_pk_bf16(v0[2], v0[3]); w.z = cvt_pk_bf16(v1[0], v1[1]); w.w = cvt_pk_bf16(v1[2], v1[3]);
                        *(u32x4*)(rowp + bj * 128) = w; } }
            return;
        }
        const bool isq = colt < 2048; bf16_t* base = isq ? Q : K; const int ld = isq ? 2048 : 512; if (!isq) colt -= 2048;
        const int rl0 = wr * 64 + fr;
#pragma unroll
        for (int ai = 0; ai < 2; ++ai)
#pragma unroll
            for (int m = 0; m < 4; ++m)
#pragma unroll
                for (int bj = 0; bj < 2; ++bj) { const f32x4 a = acc[ai][bj][m][0], b = acc[ai][bj][m][1];
                    float s = (a[0] * a[0] + a[1] * a[1]) + (a[2] * a[2] + a[3] * a[3]) + (b[0] * b[0] + b[1] * b[1]) + (b[2] * b[2] + b[3] * b[3]);
                    s += __shfl_xor(s, 16); s += __shfl_xor(s, 32);
                    if (fq == 0) P[((ai * 128 + m * 16 + rl0) * 2 + bj) * 4 + wc] = s; }
        asm volatile("s_waitcnt lgkmcnt(0)" ::: "memory"); __builtin_amdgcn_s_barrier(); asm volatile("" ::: "memory");
        constexpr float QSCALE = 0.08838834764831845f * 1.4426950408889634f;
        const int i0 = 16 * (wc & 1) + 4 * fq, d0 = 64 * (wc >> 1) + i0;
        const float* gp = isq ? qg : kg; f32x4 g0 = *(const f32x4*)(gp + d0), g1 = *(const f32x4*)(gp + d0 + 32);
        if (isq) { g0 = g0 * QSCALE; g1 = g1 * QSCALE; }
        f32x4 ifr;
#pragma unroll
        for (int j = 0; j < 4; ++j) ifr[j] = exp2f(-(float)(i0 + j) * (13.287712379549449f / 32.0f));
        const bool lat = u.pm < 64;
#pragma unroll
        for (int ai = 0; ai < 2; ++ai)
#pragma unroll
            for (int m = 0; m < 4; ++m) { const int row = row0 + ai * 128 + m * 16; const int t = row & (SEQ - 1);
                const float pos = (float)((wc >> 1) == 0 ? (t >> 6) : (t & 63));
                f32x4 cs, sn;
#pragma unroll
                for (int j = 0; j < 4; ++j) { const float ang = pos * ifr[j]; cs[j] = lat ? __cosf(ang) : 1.0f; sn[j] = lat ? __sinf(ang) : 0.0f; }
#pragma unroll
                for (int bj = 0; bj < 2; ++bj) { const f32x4 pp = *(const LAS3 f32x4*)(P + ((ai * 128 + m * 16 + rl0) * 2 + bj) * 4);
                    const float rstd = 1.0f / sqrtf(((pp[0] + pp[1]) + (pp[2] + pp[3])) * (1.0f / HD) + NORM_EPS);
                    const f32x4 a = acc[ai][bj][m][0] * rstd * g0, b = acc[ai][bj][m][1] * rstd * g1;
                    const f32x4 o1 = a * cs - b * sn, o2 = b * cs + a * sn;
                    u32x4 w; w.x = cvt_pk_bf16(o1[0], o1[1]); w.y = cvt_pk_bf16(o1[2], o1[3]); w.z = cvt_pk_bf16(o2[0], o2[1]); w.w = cvt_pk_bf16(o2[2], o2[3]);
                    *(u32x4*)(base + (size_t)row * ld + colt + bj * 128 + wc * 32 + 8 * fq) = w; } }
    }
};

constexpr size_t MiB = 1u << 20;
constexpr size_t WS_CTL = 0, CTL_ZERO_BYTES = 1 * MiB;
constexpr size_t WS_MOD = 1 * MiB;
constexpr size_t WS_MODP = 2 * MiB;
constexpr size_t WS_AFFL = 16 * MiB;
constexpr size_t WS_AFFC = 17 * MiB;
constexpr size_t WS_RWT = 17 * MiB + 128 * 1024;
constexpr size_t WS_ROWSRC = 17 * MiB + 512 * 1024;
constexpr size_t WS_GATEV = 18 * MiB;
constexpr size_t WS_INV = 18 * MiB + 512 * 1024;
constexpr size_t WS_W1A = 20 * MiB;
constexpr size_t WS_W1B = 36 * MiB;
constexpr size_t WS_W2 = 44 * MiB;
constexpr size_t WS_WQKV = 52 * MiB;
constexpr size_t WS_WO = 64 * MiB;
constexpr size_t WS_WGU = 72 * MiB;
constexpr size_t WS_WDN = 328 * MiB;
constexpr size_t WS_H = 456 * MiB;
constexpr size_t WS_A = 600 * MiB;
constexpr size_t WS_U = 672 * MiB;
constexpr size_t WS_Z = 744 * MiB;
constexpr size_t WS_Q = WS_U, WS_K = WS_Z, WS_V = WS_Z + 18 * MiB;
constexpr size_t WS_HM = 816 * MiB;
constexpr size_t WS_O = WS_HM;
constexpr size_t WS_Y = 888 * MiB;
constexpr size_t WS_END = 1032 * MiB;
constexpr int CW_BAR = 4096;

constexpr int RING_BYTES = 131072;
constexpr int MISC_OFF = RING_BYTES + 14336;
constexpr int LDS_BYTES = 147456;

#define GAS __attribute__((address_space(1)))
#define LAS __attribute__((address_space(3)))
#define LDS_WAIT() asm volatile("s_waitcnt lgkmcnt(0)" ::: "memory")
#define VM_WAIT() asm volatile("s_waitcnt vmcnt(0)" ::: "memory")
#define XB_TMO      128
#define XB_XCNT(j)  (256  + 64 * (j))
#define XB_XSUB(j)  (1280 + 64 * (j))
#define XB_XGEN(j)  (2304 + 64 * (j))
#define XB_TOP      3328
#define XB_TOPGEN   3392
#define XCD_BAR_WORDS 3456
#define XB_SPIN_CAP (1u << 18)

__device__ __forceinline__ unsigned xb_ld(unsigned* p)              { return __hip_atomic_load(p, __ATOMIC_RELAXED, __HIP_MEMORY_SCOPE_AGENT); }
__device__ __forceinline__ unsigned xb_add(unsigned* p, unsigned v) { return __hip_atomic_fetch_add(p, v, __ATOMIC_RELAXED, __HIP_MEMORY_SCOPE_AGENT); }
__device__ __forceinline__ unsigned xb_xcc_id() { return (unsigned)__builtin_amdgcn_s_getreg((3 << 11) | 20) & 0xFu; }
#define XB_SPIN(cond, bar) do { unsigned _sp = 0; while (cond) { __builtin_amdgcn_s_sleep(1); \
    if ((++_sp & 255u) == 0u) { if (xb_ld(&(bar)[XB_TMO])) break; if (_sp > XB_SPIN_CAP) { atomicAdd(&(bar)[XB_TMO], 1u); break; } } } } while (0)

struct XcdBarrier {
    unsigned* bar; unsigned x;
    volatile LAS unsigned* st;
};

__device__ __forceinline__ XcdBarrier xcd_barrier_post(unsigned* bar, volatile LAS unsigned* st) {
    XcdBarrier b; b.bar = bar; b.x = xb_xcc_id(); b.st = st;
    if (threadIdx.x == 0) (void)xb_add(&bar[XB_XCNT(b.x)], 1u);
    return b;
}
__device__ __forceinline__ void xcd_barrier_complete(unsigned* bar, unsigned x, unsigned& nloc, unsigned& nx) {
    const unsigned G = gridDim.x * gridDim.y * gridDim.z;
    unsigned sum, cnt, mine, sp = 0u;
    for (;;) {
        sum = 0u; cnt = 0u; mine = 0u;
#pragma unroll
        for (unsigned j = 0; j < 16; ++j) { const unsigned c = xb_ld(&bar[XB_XCNT(j)]); sum += c; cnt += (c > 0u) ? 1u : 0u; mine = (j == x) ? c : mine; }
        if (sum == G) break;
        __builtin_amdgcn_s_sleep(1);
        if ((++sp & 255u) == 0u) { if (xb_ld(&bar[XB_TMO])) break; if (sp > XB_SPIN_CAP) { atomicAdd(&bar[XB_TMO], 1u); break; } }
    }
    nloc = mine > 0u ? mine : 1u; nx = cnt > 0u ? cnt : 1u;
}

__device__ __forceinline__ void xcd_barrier(const XcdBarrier& b) {
    asm volatile("s_waitcnt vmcnt(0)" ::: "memory");
    __syncthreads();
    if (threadIdx.x == 0) {
        unsigned* bar = b.bar;
        __builtin_amdgcn_s_waitcnt(0);
        unsigned nloc = b.st[0], nx = b.st[1];
        if (nloc == 0u) { xcd_barrier_complete(bar, b.x, nloc, nx); b.st[0] = nloc; b.st[1] = nx; }
        const unsigned old = xb_add(&bar[XB_XSUB(b.x)], 1u);
        const unsigned gen = old / nloc;
        if (old + 1u == (gen + 1u) * nloc) {
            __builtin_amdgcn_fence(__ATOMIC_RELEASE, "agent");
            asm volatile("s_waitcnt vmcnt(0)" ::: "memory");
            const unsigned og = xb_add(&bar[XB_TOP], 1u);
            const unsigned tg = og / nx;
            if (og + 1u == (tg + 1u) * nx) xb_add(&bar[XB_TOPGEN], 1u);
            else XB_SPIN(xb_ld(&bar[XB_TOPGEN]) == tg, bar);
            __builtin_amdgcn_fence(__ATOMIC_ACQUIRE, "agent");
            xb_add(&bar[XB_XGEN(b.x)], 1u);
            asm volatile("s_waitcnt vmcnt(0)" ::: "memory");
        } else {
            XB_SPIN(xb_ld(&bar[XB_XGEN(b.x)]) == gen, bar);
            __builtin_amdgcn_fence(__ATOMIC_ACQUIRE, "agent");
            asm volatile("s_waitcnt vmcnt(0)" ::: "memory");
        }
    }
    __syncthreads();
}

DI float wave_sum(float v) {
#pragma unroll
    for (int o = 1; o < 64; o <<= 1) v += __shfl_xor(v, o);
    return v;
}
DI float rdlane(float v, int l) { return __uint_as_float((unsigned)__builtin_amdgcn_readlane((int)__float_as_uint(v), l)); }
DI unsigned pk2(float lo, float hi) { return cvt_pk_bf16(lo, hi); }

DI void ph_adaln(const float* cnd, const float* cctx, const float* ada_w, float* modp, int gw, int NGW, int lane) {
    for (int task = gw; task < 96 * KSPLIT; task += NGW) {
        const int ks = task & (KSPLIT - 1), cg = task / KSPLIT, l = cg / 48, cgl = cg % 48, col0 = cgl * 256 + lane * 4, k0 = ks * 128;
        float sv[9][2];
#pragma unroll
        for (int r = 0; r < 9; ++r)
#pragma unroll
            for (int hh = 0; hh < 2; ++hh) { const int k = k0 + hh * 64 + lane; const float v = r < 8 ? cnd[r * DM + k] : cctx[k]; sv[r][hh] = v / (1.0f + __expf(-v)); }
        f32x4 acc[9];
#pragma unroll
        for (int r = 0; r < 9; ++r) acc[r] = (f32x4){0.f, 0.f, 0.f, 0.f};
        const float* wp = ada_w + ((size_t)l * DM + k0) * NMOD + col0;
#pragma unroll
        for (int hh = 0; hh < 2; ++hh) {
#pragma unroll 8
            for (int kk = 0; kk < 64; ++kk) {
                const f32x4 w = *(const f32x4*)(wp + (size_t)(hh * 64 + kk) * NMOD);
#pragma unroll
                for (int r = 0; r < 9; ++r) { const float s = rdlane(sv[r][hh], kk); acc[r] += w * s; }
            }
        }
#pragma unroll
        for (int r = 0; r < 9; ++r) *(f32x4*)(modp + ((size_t)((ks * 2 + l) * 9 + r)) * NMOD + col0) = acc[r];
    }
}
struct CvtPtrs { const float *cin, *cout, *wqkv, *wo, *wg, *wu, *wd; bf16_t *W1A, *W1B, *W2, *WQKV, *WO, *WGU, *WDN; };
constexpr int CVT_E0 = 6656, CVT_L = 24576, CVT_TOTAL = CVT_E0 + 2 * CVT_L;
DI void cvt_resolve(const CvtPtrs& P, int it, const float*& src, int& ldw, bf16_t*& dst, int& ldd, bool& qperm) {
    int r = it; qperm = false;
    if (r < 3072) { const int kt = ((r >> 3) / 96) * 8 + (r & 7), nt = (r >> 3) % 96, n0 = nt * 64, part = n0 >> 11, j0 = n0 & 2047;
        src = P.cin + (size_t)(kt * 64) * 6144 + n0; ldw = 6144; ldd = DM;
        dst = (part == 0 ? P.W1B + (size_t)j0 * DM : P.W1A + (size_t)((j0 >> 7) * 256 + (part == 2 ? 128 : 0) + (j0 & 127)) * DM) + kt * 64; return; } r -= 3072;
    if (r < 1024) { const int kt = ((r >> 3) / 32) * 8 + (r & 7), nt = (r >> 3) % 32; src = P.cout + (size_t)(kt * 64) * DM + nt * 64; ldw = DM; dst = P.W2 + (size_t)(nt * 64) * DM + kt * 64; ldd = DM; return; } r -= 1024;
    if (r < 1536) { const int kt = ((r >> 3) / 48) * 8 + (r & 7), nt = (r >> 3) % 48; src = P.wqkv + (size_t)(kt * 64) * 3072 + nt * 64; ldw = 3072; qperm = nt < 40;     dst = P.WQKV + (size_t)(nt * 64) * DM + kt * 64; ldd = DM; return; } r -= 1536;
    if (r < 1024) { const int kt = ((r >> 3) / 32) * 8 + (r & 7), nt = (r >> 3) % 32; src = P.wo + (size_t)(kt * 64) * DM + nt * 64; ldw = DM; dst = P.WO + (size_t)(nt * 64) * DM + kt * 64; ldd = DM; return; } r -= 1024;
    const int l = r / CVT_L, rr = r % CVT_L, kind = rr / 8192, q = rr % 8192, le = l * 16 + q / 512, rem = q % 512;
    if (kind < 2) { const int kt = ((rem >> 3) / 16) * 8 + (rem & 7), nt = (rem >> 3) % 16, n0 = nt * 64;
        src = (kind ? P.wu : P.wg) + (size_t)le * DM * DFF + (size_t)(kt * 64) * DFF + n0; ldw = DFF;
        dst = P.WGU + (size_t)(le * 2048 + (n0 >> 7) * 256 + kind * 128 + (n0 & 127)) * DM + kt * 64; ldd = DM; }
    else { const int kt = ((rem >> 3) / 32) * 8 + (rem & 7), nt = (rem >> 3) % 32;
        src = P.wd + (size_t)le * DFF * DM + (size_t)(kt * 64) * DM + nt * 64; ldw = DM; dst = P.WDN + (size_t)(le * 2048 + nt * 64) * DFF + kt * 64; ldd = DFF; }
}
constexpr int CVT_P = 36;
DI void cvt_range(const CvtPtrs& P, int lo, int hi, int w, int NW, LAS unsigned* scr, int lane) {
    int it = lo + w; if (it >= hi) return;
    const int c = lane & 15, q = lane >> 4;
    const float* src; int ldw; bf16_t* dst; int ldd; bool qperm; cvt_resolve(P, it, src, ldw, dst, ldd, qperm);
    f32x4 v[16];
#pragma unroll
    for (int rr = 0; rr < 16; ++rr) v[rr] = __builtin_nontemporal_load((const f32x4*)(src + (size_t)(16 * q + rr) * ldw + 4 * c));
    for (;;) {
        u32x4 pa[4], pb[4];
#pragma unroll
        for (int i = 0; i < 4; ++i) { pa[i].x = pk2(v[0][i], v[1][i]); pa[i].y = pk2(v[2][i], v[3][i]); pa[i].z = pk2(v[4][i], v[5][i]); pa[i].w = pk2(v[6][i], v[7][i]);
                                      pb[i].x = pk2(v[8][i], v[9][i]); pb[i].y = pk2(v[10][i], v[11][i]); pb[i].z = pk2(v[12][i], v[13][i]); pb[i].w = pk2(v[14][i], v[15][i]); }
        const int nit = it + NW; bf16_t* cdst = dst; const int cldd = ldd; const int wrow = qperm ? 32 * ((c >> 2) & 1) + 8 * (c & 3) + 4 * (c >> 3) : 4 * c;
        if (nit < hi) { cvt_resolve(P, nit, src, ldw, dst, ldd, qperm);
#pragma unroll
            for (int rr = 0; rr < 16; ++rr) v[rr] = __builtin_nontemporal_load((const f32x4*)(src + (size_t)(16 * q + rr) * ldw + 4 * c)); }
#pragma unroll
        for (int i = 0; i < 4; ++i) { *(LAS u32x4*)(scr + (wrow + i) * CVT_P + 8 * q) = pa[i]; *(LAS u32x4*)(scr + (wrow + i) * CVT_P + 8 * q + 4) = pb[i]; }
        LDS_WAIT(); asm volatile("" ::: "memory");
#pragma unroll
        for (int j = 0; j < 8; ++j) { const int n = (lane >> 3) + 8 * j; const u32x4 o = *(const LAS u32x4*)(scr + n * CVT_P + 4 * (lane & 7));
            *(u32x4*)(cdst + (size_t)n * cldd + 8 * (lane & 7)) = o; }
        LDS_WAIT(); asm volatile("" ::: "memory");
        if (nit >= hi) break;
        it = nit;
    }
}
DI void ph_modred(const float* modp, const float* ada_b, float* mod, int gtid, int GT) {
    for (int i = gtid; i < 2 * 9 * NMOD; i += GT) { const int l = i / (9 * NMOD), j = i % NMOD; float s = ada_b[l * NMOD + j];
#pragma unroll
        for (int ks = 0; ks < KSPLIT; ++ks) s += modp[(size_t)ks * (2 * 9 * NMOD) + i];
        mod[i] = s; }
}
DI void row_load(const float* p, f32x4 (&v)[8], int lane) {
#pragma unroll
    for (int j = 0; j < 8; ++j) v[j] = *(const f32x4*)(p + 4 * lane + 256 * j);
}
DI void row_load_bf(const bf16_t* p, f32x4 (&v)[8], int lane) {
#pragma unroll
    for (int j = 0; j < 8; ++j) { const u32x2 w = *(const u32x2*)(p + 4 * lane + 256 * j); v[j] = (f32x4){bf_lo(w.x), bf_hi(w.x), bf_lo(w.y), bf_hi(w.y)}; }
}
DI void row_modulate(const f32x4 (&v)[8], f32x4 (&y)[8], const float* gain, const float* shift, const float* scale, int lane) {
    float ss = 0.f;
#pragma unroll
    for (int j = 0; j < 8; ++j) ss += (v[j][0] * v[j][0] + v[j][1] * v[j][1]) + (v[j][2] * v[j][2] + v[j][3] * v[j][3]);
    ss = wave_sum(ss);
    const float rstd = 1.0f / sqrtf(ss * (1.0f / DM) + NORM_EPS);
#pragma unroll
    for (int j = 0; j < 8; ++j) { const int c = 4 * lane + 256 * j; const f32x4 g = *(const f32x4*)(gain + c), sh = *(const f32x4*)(shift + c), sc = *(const f32x4*)(scale + c);
        y[j] = ((v[j] * rstd) * g) * (sc + 1.0f) + sh; }
}
DI void row_modulate2(const f32x4 (&v0)[8], const f32x4 (&v1)[8], f32x4 (&y0)[8], f32x4 (&y1)[8], const float* gain, const float* shift, const float* scale, int lane) {
    float s0 = 0.f, s1 = 0.f;
#pragma unroll
    for (int j = 0; j < 8; ++j) { s0 += (v0[j][0] * v0[j][0] + v0[j][1] * v0[j][1]) + (v0[j][2] * v0[j][2] + v0[j][3] * v0[j][3]); s1 += (v1[j][0] * v1[j][0] + v1[j][1] * v1[j][1]) + (v1[j][2] * v1[j][2] + v1[j][3] * v1[j][3]); }
    s0 = wave_sum(s0); s1 = wave_sum(s1);
    const float r0 = 1.0f / sqrtf(s0 * (1.0f / DM) + NORM_EPS), r1 = 1.0f / sqrtf(s1 * (1.0f / DM) + NORM_EPS);
#pragma unroll
    for (int j = 0; j < 8; ++j) { const int c = 4 * lane + 256 * j; const f32x4 g = *(const f32x4*)(gain + c), sh = *(const f32x4*)(shift + c), sc = *(const f32x4*)(scale + c);
        y0[j] = ((v0[j] * r0) * g) * (sc + 1.0f) + sh; y1[j] = ((v1[j] * r1) * g) * (sc + 1.0f) + sh; }
}
DI void row_store_bf16(bf16_t* p, const f32x4 (&y)[8], int lane) {
#pragma unroll
    for (int j = 0; j < 8; ++j) { u32x2 w; w.x = pk2(y[j][0], y[j][1]); w.y = pk2(y[j][2], y[j][3]); *(u32x2*)(p + 4 * lane + 256 * j) = w; }
}
DI void ph_mod0(const float* x, const float* ctx, const float* gain, const float* mod0, bf16_t* A, int gw, int NGW, int lane) {
    int row = gw; if (row >= MT) return;
    f32x4 v[8], vn[8];
    row_load(row < ML ? x + (size_t)row * DM : ctx + (size_t)(row - ML) * DM, v, lane);
    for (;;) {
        const int nrow = row + NGW; const bool more = nrow < MT;
        if (more) row_load(nrow < ML ? x + (size_t)nrow * DM : ctx + (size_t)(nrow - ML) * DM, vn, lane);
        const int cr = row < ML ? (row >> 11) : 8;
        f32x4 y[8]; row_modulate(v, y, gain, mod0 + (size_t)cr * NMOD + 0 * DM, mod0 + (size_t)cr * NMOD + 1 * DM, lane);
        row_store_bf16(A + (size_t)row * DM, y, lane);
        if (!more) break;
#pragma unroll
        for (int j = 0; j < 8; ++j) v[j] = vn[j];
        row = nrow;
    }
}
DI float reduce8(const float (&v)[8], int lane) {
    const bool u0 = lane & 1, u1 = lane & 2, u2 = lane & 4;
    float a[4], b2[2];
#pragma unroll
    for (int k = 0; k < 4; ++k) { const float lo = v[2 * k], hi = v[2 * k + 1]; a[k] = (u0 ? hi : lo) + __shfl_xor(u0 ? lo : hi, 1); }
#pragma unroll
    for (int k = 0; k < 2; ++k) { const float lo = a[2 * k], hi = a[2 * k + 1]; b2[k] = (u1 ? hi : lo) + __shfl_xor(u1 ? lo : hi, 2); }
    return (u2 ? b2[1] : b2[0]) + __shfl_xor(u2 ? b2[0] : b2[1], 4);
}
DI float reduce_halves(float lo8, float hi8, int lane) {
    const bool u3 = lane & 8;
    float t = (u3 ? hi8 : lo8) + __shfl_xor(u3 ? lo8 : hi8, 8);
    t += __shfl_xor(t, 16); t += __shfl_xor(t, 32); return t;
}
DI float softmax16(float lg) {
    float mx = lg;
#pragma unroll
    for (int o = 1; o < 16; o <<= 1) mx = fmaxf(mx, __shfl_xor(mx, o));
    const float ex = __expf(lg - mx); float den = ex;
#pragma unroll
    for (int o = 1; o < 16; o <<= 1) den += __shfl_xor(den, o);
    return ex / den;
}
DI void aff_store(float v, float* affL, float* affC, int row, int lane) {
    if (lane < 16) { if (row < ML) { const int b = row >> 11, n = row & 2047; affL[(size_t)(b * 16 + lane) * SEQ + n] = v; }
                     else { const int rc = row - ML, b = rc >> 8, n = rc & 255; affC[(size_t)(b * 16 + lane) * CTXL + n] = v; } }
}
DI void router_rows2(const f32x4 (&y0)[8], const f32x4 (&y1)[8], const LAS float* rwT, float* affL, float* affC, int row0, int lane) {
    f32x2 yp[8][4];
#pragma unroll
    for (int j = 0; j < 8; ++j)
#pragma unroll
        for (int q = 0; q < 4; ++q) yp[j][q] = (f32x2){y0[j][q], y1[j][q]};
    float r0[2], r1[2];
#pragma unroll
    for (int hf = 0; hf < 2; ++hf) {
        float l0[8], l1[8];
#pragma unroll
        for (int e = 0; e < 8; ++e) { f32x2 acc = (f32x2){0.f, 0.f};
#pragma unroll
            for (int j = 0; j < 8; ++j) { const f32x4 w = *(const LAS f32x4*)(rwT + (8 * hf + e) * DM + 4 * lane + 256 * j);
#pragma unroll
                for (int q = 0; q < 4; ++q) acc = __builtin_elementwise_fma(yp[j][q], (f32x2){w[q], w[q]}, acc); }
            l0[e] = acc.x; l1[e] = acc.y; __builtin_amdgcn_sched_barrier(0); }
        r0[hf] = reduce8(l0, lane); r1[hf] = reduce8(l1, lane);
    }
    const float a0 = softmax16(reduce_halves(r0[0], r0[1], lane)), a1 = softmax16(reduce_halves(r1[0], r1[1], lane));
    aff_store(a0, affL, affC, row0, lane); aff_store(a1, affL, affC, row0 + 1, lane);
}
DI void ph_rwt(const float* rw, float* rwT, int gtid, int GT) {
    for (int i = gtid; i < 2 * 16 * DM; i += GT) { const int l = i >> 15, e = (i >> 11) & 15, d = i & (DM - 1); rwT[i] = rw[(size_t)l * DM * 16 + d * 16 + e]; }
}
DI void load_router(const float* rwT_g, LAS float* rwT, int tid) {
    for (int i = tid; i < DM * 16 / 4; i += 512) ((LAS f32x4*)rwT)[i] = ((const f32x4*)rwT_g)[i];
    __syncthreads();
}
DI void ph_modffn(const bf16_t* H, const float* gain, const float* modl, bf16_t* A, const LAS float* rwT, float* affL, float* affC, int nrows, int gw, int NGW, int lane) {
    int rp = gw; if (rp >= nrows / 2) return;
    u32x2 p0[8], p1[8];
#define MODFFN_LOAD(rp_) do { const int row_ = 2 * (rp_); _Pragma("unroll") for (int j = 0; j < 8; ++j) { p0[j] = *(const u32x2*)(H + (size_t)row_ * DM + 4 * lane + 256 * j); p1[j] = *(const u32x2*)(H + (size_t)(row_ + 1) * DM + 4 * lane + 256 * j); } } while (0)
    MODFFN_LOAD(rp);
    for (;;) {
        const int row = 2 * rp; const int cr = row < ML ? (row >> 11) : 8;
        float s0 = 0.f, s1 = 0.f;
#pragma unroll
        for (int j = 0; j < 8; ++j) { const float a0 = bf_lo(p0[j].x), a1 = bf_hi(p0[j].x), a2 = bf_lo(p0[j].y), a3 = bf_hi(p0[j].y); s0 += (a0 * a0 + a1 * a1) + (a2 * a2 + a3 * a3);
                                      const float b0 = bf_lo(p1[j].x), b1 = bf_hi(p1[j].x), b2 = bf_lo(p1[j].y), b3 = bf_hi(p1[j].y); s1 += (b0 * b0 + b1 * b1) + (b2 * b2 + b3 * b3); }
        s0 = wave_sum(s0); s1 = wave_sum(s1);
        const float r0 = 1.0f / sqrtf(s0 * (1.0f / DM) + NORM_EPS), r1 = 1.0f / sqrtf(s1 * (1.0f / DM) + NORM_EPS);
        const float* shift = modl + (size_t)cr * NMOD + 3 * DM; const float* scale = modl + (size_t)cr * NMOD + 4 * DM;
        f32x4 y0[8], y1[8];
#pragma unroll
        for (int j = 0; j < 8; ++j) { const int c = 4 * lane + 256 * j; const f32x4 g = *(const f32x4*)(gain + c), sh = *(const f32x4*)(shift + c), sc = *(const f32x4*)(scale + c);
            const f32x4 v0 = (f32x4){bf_lo(p0[j].x), bf_hi(p0[j].x), bf_lo(p0[j].y), bf_hi(p0[j].y)}, v1 = (f32x4){bf_lo(p1[j].x), bf_hi(p1[j].x), bf_lo(p1[j].y), bf_hi(p1[j].y)};
            y0[j] = ((v0 * r0) * g) * (sc + 1.0f) + sh; y1[j] = ((v1 * r1) * g) * (sc + 1.0f) + sh;
            u32x2 w0, w1; w0.x = pk2(y0[j][0], y0[j][1]); w0.y = pk2(y0[j][2], y0[j][3]); w1.x = pk2(y1[j][0], y1[j][1]); w1.y = pk2(y1[j][2], y1[j][3]);
            *(u32x2*)(A + (size_t)row * DM + c) = w0; *(u32x2*)(A + (size_t)(row + 1) * DM + c) = w1; }
        const int nrp = rp + NGW; const bool more = nrp < nrows / 2;
        if (more) MODFFN_LOAD(nrp);
        asm volatile("" ::: "memory");
        router_rows2(y0, y1, rwT, affL, affC, row, lane);
        if (!more) break;
        rp = nrp;
    }
#undef MODFFN_LOAD
}
DI void ph_topk(int nitems, const float* affL, const float* affC, int* rowsrc, float* gatev, int* inv, LAS unsigned* hist, int tid, int lane, int wave, int bid, int G) {
    LAS unsigned* sh = hist + 256;
    for (int it = bid; it < nitems; it += G) {
        const bool isc = it >= 128; const int be = it & 127, b = be >> 4, e = be & 15;
        const int N = isc ? CTXL : SEQ, C = isc ? CAPC : CAPL;
        const float* src = isc ? affC + (size_t)be * CTXL : affL + (size_t)be * SEQ;
        const int i0 = tid * 4; const bool valid = i0 < N;
        unsigned key[4];
        { f32x4 v = (f32x4){0.f, 0.f, 0.f, 0.f}; if (valid) v = *(const f32x4*)(src + i0);
#pragma unroll
          for (int q = 0; q < 4; ++q) key[q] = __float_as_uint(v[q]); }
        unsigned prefix = 0u, mask = 0u, krem = (unsigned)C;
        for (int pass = 3; pass >= 0; --pass) {
            const int shift = pass * 8;
            if (tid < 256) hist[tid] = 0u;
            __syncthreads();
            if (valid) {
#pragma unroll
                for (int q = 0; q < 4; ++q) if ((key[q] & mask) == prefix) __hip_atomic_fetch_add(&hist[(key[q] >> shift) & 255u], 1u, __ATOMIC_RELAXED, __HIP_MEMORY_SCOPE_WORKGROUP); }
            __syncthreads();
            if (wave == 0) {
                const unsigned h0 = hist[4 * lane], h1 = hist[4 * lane + 1], h2 = hist[4 * lane + 2], h3 = hist[4 * lane + 3];
                const unsigned tot = h0 + h1 + h2 + h3; unsigned incl = tot;
#pragma unroll
                for (int o = 1; o < 64; o <<= 1) { const unsigned t = __shfl_down(incl, o); if (lane + o < 64) incl += t; }
                const unsigned a3 = incl - tot, a2 = a3 + h3, a1 = a2 + h2, a0 = a1 + h1;
                if (a3 < krem && krem <= a3 + h3) { sh[0] = 4 * lane + 3; sh[1] = krem - a3; }
                if (a2 < krem && krem <= a2 + h2) { sh[0] = 4 * lane + 2; sh[1] = krem - a2; }
                if (a1 < krem && krem <= a1 + h1) { sh[0] = 4 * lane + 1; sh[1] = krem - a1; }
                if (a0 < krem && krem <= a0 + h0) { sh[0] = 4 * lane + 0; sh[1] = krem - a0; }
            }
            __syncthreads();
            const unsigned B = sh[0]; krem = sh[1]; prefix |= B << shift; mask |= 0xFFu << shift;
        }
        const unsigned T = prefix;
        unsigned cg = 0u, ce = 0u;
        if (valid) {
#pragma unroll
            for (int q = 0; q < 4; ++q) { cg += key[q] > T ? 1u : 0u; ce += key[q] == T ? 1u : 0u; } }
        const unsigned mine = cg | (ce << 16); unsigned incl = mine;
#pragma unroll
        for (int o = 1; o < 64; o <<= 1) { const unsigned t = __shfl_up(incl, o); if (lane >= o) incl += t; }
        if (lane == 63) sh[8 + wave] = incl;
        __syncthreads();
        unsigned woff = 0u;
#pragma unroll
        for (int w = 0; w < 8; ++w) woff += (w < wave) ? sh[8 + w] : 0u;
        const unsigned excl = woff + incl - mine; unsigned gtb = excl & 0xFFFFu, eqb = excl >> 16;
        if (valid) {
            const int ybase = e * YR + (isc ? NB * CAPL + b * CAPC : b * CAPL); const int rbase = isc ? ML + b * CTXL : b * SEQ;
#pragma unroll
            for (int q = 0; q < 4; ++q) {
                const bool isg = key[q] > T, ise = key[q] == T; const bool sel = isg || (ise && eqb < krem);
                const unsigned slot = gtb + (eqb < krem ? eqb : krem);
                const int trow = rbase + i0 + q; const int yrow = ybase + (int)slot;
                if (sel) { rowsrc[yrow] = trow; gatev[yrow] = __uint_as_float(key[q]); }
                inv[(size_t)trow * 16 + e] = sel ? yrow : -1;
                gtb += isg ? 1u : 0u; eqb += ise ? 1u : 0u;
            }
        }
        __syncthreads();
    }
}
template <bool LAST> DI void ph_combine(bf16_t* H, const bf16_t* Y, const int* inv, const float* modl  , const float* gain1, const float* mod1, bf16_t* A, float* out, int nrows, int gw, int NGW, int lane) {
    int row = gw; if (row >= nrows) return;
    u32x2 hp[8], hn[8]; int myinv, ninv = -1;
#define CMB_LOAD(HP, IV, row_) do { _Pragma("unroll") for (int j = 0; j < 8; ++j) HP[j] = *(const u32x2*)(H + (size_t)(row_) * DM + 4 * lane + 256 * j); IV = inv[(size_t)(row_) * 16 + (lane & 15)]; } while (0)
    CMB_LOAD(hp, myinv, row);
    for (;;) {
        const int nrow = row + NGW; const bool more = nrow < nrows;
        if (more) CMB_LOAD(hn, ninv, nrow);
        const int cr = row < ML ? (row >> 11) : 8;
        f32x4 acc[8];
#pragma unroll
        for (int j = 0; j < 8; ++j) acc[j] = (f32x4){0.f, 0.f, 0.f, 0.f};
        unsigned m = (unsigned)(__ballot(myinv >= 0) & 0xFFFFull);
        while (m) {
            const int e1 = __builtin_ctz(m); m &= m - 1; const bool two = m != 0u; const int e2 = two ? __builtin_ctz(m) : e1; if (two) m &= m - 1;
            const bf16_t* y1 = Y + (size_t)__builtin_amdgcn_readlane(myinv, e1) * DM + 4 * lane; const bf16_t* y2 = Y + (size_t)__builtin_amdgcn_readlane(myinv, e2) * DM + 4 * lane;
            u32x2 q1[8], q2[8];
#pragma unroll
            for (int j = 0; j < 8; ++j) { q1[j] = *(const u32x2*)(y1 + 256 * j); q2[j] = *(const u32x2*)(y2 + 256 * j); }
            const float f2 = two ? 1.0f : 0.0f;
#pragma unroll
            for (int j = 0; j < 8; ++j) { acc[j][0] += bf_lo(q1[j].x) + f2 * bf_lo(q2[j].x); acc[j][1] += bf_hi(q1[j].x) + f2 * bf_hi(q2[j].x); acc[j][2] += bf_lo(q1[j].y) + f2 * bf_lo(q2[j].y); acc[j][3] += bf_hi(q1[j].y) + f2 * bf_hi(q2[j].y); }
        }
        const float* g2 = modl + (size_t)cr * NMOD + 5 * DM;
        f32x4 v[8];
#pragma unroll
        for (int j = 0; j < 8; ++j) { const f32x4 g = *(const f32x4*)(g2 + 4 * lane + 256 * j); const f32x4 h = (f32x4){bf_lo(hp[j].x), bf_hi(hp[j].x), bf_lo(hp[j].y), bf_hi(hp[j].y)}; v[j] = h + g * acc[j]; }
        if (LAST) {
#pragma unroll
            for (int j = 0; j < 8; ++j) *(f32x4*)(out + (size_t)row * DM + 4 * lane + 256 * j) = v[j];
        } else {
            row_store_bf16(H + (size_t)row * DM, v, lane);
            f32x4 y[8]; row_modulate(v, y, gain1, mod1 + (size_t)cr * NMOD + 0 * DM, mod1 + (size_t)cr * NMOD + 1 * DM, lane);
            row_store_bf16(A + (size_t)row * DM, y, lane);
        }
        if (!more) break;
#pragma unroll
        for (int j = 0; j < 8; ++j) hp[j] = hn[j];
        myinv = ninv; row = nrow;
    }
#undef CMB_LOAD
}
constexpr int KP = 272;
constexpr int VP = 288;
constexpr int ATT_VOFF = 64 * KP;
constexpr int ATT_TILE = 64 * KP + 64 * VP;
constexpr int ATT_OST = 2 * ATT_TILE;
DI float xhalf_max(float v) { auto rr = __builtin_amdgcn_permlane32_swap(__float_as_uint(v), __float_as_uint(v), false, false); return fmaxf(__uint_as_float(rr[0]), __uint_as_float(rr[1])); }
DI float xhalf_sum(float v) { auto rr = __builtin_amdgcn_permlane32_swap(__float_as_uint(v), __float_as_uint(v), false, false); return __uint_as_float(rr[0]) + __uint_as_float(rr[1]); }
DI int crow(int reg, int h) { return (reg & 3) + 8 * (reg >> 2) + 4 * h; }
DI long long vtr64(const LAS unsigned char* p) { typedef short v4i16_t __attribute__((ext_vector_type(4))); return __builtin_bit_cast(long long, __builtin_amdgcn_ds_read_tr16_b64_v4i16((LAS v4i16_t*)p)); }
DI s16x4 vtr(const LAS unsigned char* p) { typedef short v4i16_t __attribute__((ext_vector_type(4))); return __builtin_bit_cast(s16x4, __builtin_amdgcn_ds_read_tr16_b64_v4i16((LAS v4i16_t*)p)); }
DI bool att_tile_info(int item, int ti, int& base, int& mtype) {
    const int qhalf = item & 1, n = (item >> 3) & 15, b = item >> 7, tt = ti & 1; mtype = 0;
    if (ti < 4) { base = ML + b * CTXL + 64 * ti; return true; }
    const int blk = n - 1 + ((ti - 4) >> 1); if (blk < 0 || blk > 15) return false;
    if (ti < 6) { mtype = 1; if (tt == 0 && qhalf == 1) return false; } else if (ti >= 8) { mtype = 2; if (tt == 1 && qhalf == 0) return false; }
    base = b * SEQ + blk * 128 + 64 * tt; return true;
}
DI void att_next(int& item, int& ti, int G) { for (;;) { ++ti; if (ti >= 10) { ti = 0; item += G; return; } int b_, m_; if (att_tile_info(item, ti, b_, m_)) return; } }
DI void ph_attn(const bf16_t* Q, const bf16_t* Kb, const bf16_t* Vb, bf16_t* O, const float* sink, LAS unsigned char* lds, int tid, int lane, int wave, int bid, int G) {
    constexpr float LOG2E = 1.4426950408889634f;
    const int r = lane & 31, h = lane >> 5, g = wave >> 1, sub = wave & 1;
    const int ldrow = tid >> 3, ldc = tid & 7;
    int item = bid, ti = 0; if (item >= 1024) return;
    u32x4 kr[2], vr[2];
#define ATT_ISSUE(it_, ti_) do { int base_, mt_; att_tile_info(it_, ti_, base_, mt_); const int kvh_ = ((it_) >> 1) & 3; \
        _Pragma("unroll") for (int c2 = 0; c2 < 2; ++c2) { const size_t off_ = (size_t)(base_ + ldrow) * 512 + kvh_ * HD + (ldc + 8 * c2) * 8; kr[c2] = *(const u32x4*)(Kb + off_); vr[c2] = *(const u32x4*)(Vb + off_); } } while (0)
    bf16x8 qf[8]; float m2 = 0.f, lsum = 1.f; f32x16 o[4]; f32x16 negm;
#define ATT_QLOAD(it_) do { const int qrow_ = ((it_) >> 7) * SEQ + (((it_) >> 3) & 15) * 128 + ((it_) & 1) * 64 + sub * 32 + r; const int head_ = (((it_) >> 1) & 3) * 4 + g; \
        _Pragma("unroll") for (int s = 0; s < 8; ++s) qf[s] = *(const bf16x8*)(Q + (size_t)qrow_ * DM + head_ * HD + 16 * s + 8 * h); } while (0)
    ATT_QLOAD(item);
    ATT_ISSUE(item, ti);
    int buf = 0;
    while (item < 1024) {
        int nitem = item, nti = ti; att_next(nitem, nti, G);
        LAS unsigned char* tb = lds + buf * ATT_TILE;
#pragma unroll
        for (int c2 = 0; c2 < 2; ++c2) { *(LAS u32x4*)(tb + ldrow * KP + (ldc + 8 * c2) * 16) = kr[c2]; *(LAS u32x4*)(tb + ATT_VOFF + ldrow * VP + (ldc + 8 * c2) * 16) = vr[c2]; }
        if (nitem < 1024) ATT_ISSUE(nitem, nti);
        asm volatile("s_waitcnt lgkmcnt(0)" ::: "memory"); __builtin_amdgcn_s_barrier(); asm volatile("" ::: "memory");
        int base, mtype; att_tile_info(item, ti, base, mtype); const int tt = ti & 1;
        const int qhalf = item & 1, kvh = (item >> 1) & 3, n = (item >> 3) & 15, b = item >> 7;
        const int head = kvh * 4 + g, qq = qhalf * 64 + sub * 32 + r; const int qrow = b * SEQ + n * 128 + qq;
        if (ti == 0) {
            m2 = sink[head] * LOG2E; lsum = 1.0f;
#pragma unroll
            for (int i = 0; i < 16; ++i) negm[i] = -m2;
#pragma unroll
            for (int d = 0; d < 4; ++d)
#pragma unroll
                for (int i = 0; i < 16; ++i) o[d][i] = 0.f;
        }
        f32x16 x0, x1;
#pragma unroll
        for (int s = 0; s < 8; ++s) {
            const bf16x8 k0 = *(const LAS bf16x8*)(tb + r * KP + (16 * s + 8 * h) * 2), k1 = *(const LAS bf16x8*)(tb + (32 + r) * KP + (16 * s + 8 * h) * 2);
            if (s == 0) { x0 = __builtin_amdgcn_mfma_f32_32x32x16_bf16(k0, qf[s], negm, 0, 0, 0); x1 = __builtin_amdgcn_mfma_f32_32x32x16_bf16(k1, qf[s], negm, 0, 0, 0); }
            else { x0 = __builtin_amdgcn_mfma_f32_32x32x16_bf16(k0, qf[s], x0, 0, 0, 0); x1 = __builtin_amdgcn_mfma_f32_32x32x16_bf16(k1, qf[s], x1, 0, 0, 0); } }
        if (nitem != item && nitem < 1024) ATT_QLOAD(nitem);
        if (mtype == 1) {
#pragma unroll
            for (int i = 0; i < 16; ++i) { const int kk0 = tt * 64 + crow(i, h); if (kk0 < qq) x0[i] = -1.0e30f; if (kk0 + 32 < qq) x1[i] = -1.0e30f; } }
        if (mtype == 2) {
#pragma unroll
            for (int i = 0; i < 16; ++i) { const int kk0 = tt * 64 + crow(i, h); if (kk0 > qq) x0[i] = -1.0e30f; if (kk0 + 32 > qq) x1[i] = -1.0e30f; } }
        float tmax = fmaxf(x0[0], x1[0]);
#pragma unroll
        for (int i = 1; i < 16; ++i) tmax = fmaxf(fmaxf(tmax, x0[i]), x1[i]);
        tmax = xhalf_max(tmax);
        if (__any(tmax > 0.0f)) {
            const float dl = fmaxf(tmax, 0.0f), alpha = __builtin_amdgcn_exp2f(-dl); m2 += dl; lsum *= alpha;
#pragma unroll
            for (int i = 0; i < 16; ++i) { x0[i] -= dl; x1[i] -= dl; negm[i] = -m2; }
#pragma unroll
            for (int d = 0; d < 4; ++d)
#pragma unroll
                for (int i = 0; i < 16; ++i) o[d][i] *= alpha;
        }
        float ps = 0.f;
#pragma unroll
        for (int i = 0; i < 16; ++i) { x0[i] = __builtin_amdgcn_exp2f(x0[i]); x1[i] = __builtin_amdgcn_exp2f(x1[i]); ps += x0[i] + x1[i]; }
        lsum += xhalf_sum(ps);
        bf16x8 pf[2][2];
#pragma unroll
        for (int s = 0; s < 2; ++s) {
            u32x4 a, c; a.x = pk2(x0[8 * s + 0], x0[8 * s + 1]); a.y = pk2(x0[8 * s + 2], x0[8 * s + 3]); a.z = pk2(x0[8 * s + 4], x0[8 * s + 5]); a.w = pk2(x0[8 * s + 6], x0[8 * s + 7]);
            c.x = pk2(x1[8 * s + 0], x1[8 * s + 1]); c.y = pk2(x1[8 * s + 2], x1[8 * s + 3]); c.z = pk2(x1[8 * s + 4], x1[8 * s + 5]); c.w = pk2(x1[8 * s + 6], x1[8 * s + 7]);
            pf[0][s] = __builtin_bit_cast(bf16x8, a); pf[1][s] = __builtin_bit_cast(bf16x8, c); }
        const LAS unsigned char* vb = tb + ATT_VOFF + (4 * h + ((lane & 15) >> 2)) * VP + (16 * ((lane >> 4) & 1) + 4 * (lane & 3)) * 2;
#pragma unroll
        for (int d = 0; d < 4; ++d)
#pragma unroll
            for (int t = 0; t < 2; ++t)
#pragma unroll
                for (int s = 0; s < 2; ++s) {
                    typedef long long i64x2_t __attribute__((ext_vector_type(2)));
                    i64x2_t vv; vv.x = vtr64(vb + (t * 32 + 16 * s) * VP + d * 64); vv.y = vtr64(vb + (t * 32 + 16 * s + 8) * VP + d * 64);
                    const bf16x8 vf = __builtin_bit_cast(bf16x8, vv);
                    o[d] = __builtin_amdgcn_mfma_f32_32x32x16_bf16(vf, pf[t][s], o[d], 0, 0, 0); }
        if (nitem != item) {
            const float il = 1.0f / lsum;
            LAS unsigned char* st = lds + ATT_OST + wave * (32 * KP);
#pragma unroll
            for (int d = 0; d < 4; ++d)
#pragma unroll
                for (int g4 = 0; g4 < 4; ++g4) { u32x2 w; w.x = pk2(o[d][4 * g4 + 0] * il, o[d][4 * g4 + 1] * il); w.y = pk2(o[d][4 * g4 + 2] * il, o[d][4 * g4 + 3] * il);
                    *(LAS u32x2*)(st + r * KP + (d * 32 + 8 * g4 + 4 * h) * 2) = w; }
            asm volatile("s_waitcnt lgkmcnt(0)" ::: "memory");
            bf16_t* ob = O + (size_t)(qrow - r) * DM + head * HD;
#pragma unroll
            for (int j = 0; j < 8; ++j) { const int c = lane + 64 * j, row = c >> 4, c16 = c & 15;
                const u32x4 v = *(const LAS u32x4*)(st + row * KP + c16 * 16); *(u32x4*)(ob + (size_t)row * DM + c16 * 8) = v; }
        }
        item = nitem; ti = nti; buf ^= 1;
    }
#undef ATT_ISSUE
#undef ATT_QLOAD
}
#ifndef MK_ONE_LAUNCH
#define MK_ONE_LAUNCH 1
#endif
constexpr int NPHASE = 19;
constexpr int CVT_X0_END = CVT_E0 + CVT_L;
#define CVT_MKCP() CvtPtrs CP; CP.cin = args.in[8]; CP.cout = args.in[10]; CP.wqkv = args.in[11]; CP.wo = args.in[15]; CP.wg = args.in[17]; CP.wu = args.in[18]; CP.wd = args.in[19]; \
    CP.W1A = W1A; CP.W1B = W1B; CP.W2 = W2; CP.WQKV = WQKV; CP.WO = WOt; CP.WGU = WGU; CP.WDN = WDN
#define CVT(LO, HI) do { CVT_MKCP(); cvt_range(CP, LO, HI, gw, NGW, cscr, lane); } while (0)
#ifndef MK_DUP_MASK
#define MK_DUP_MASK 0u
#endif
constexpr unsigned DUP_MASK = MK_DUP_MASK;
struct Args { const float* in[20]; float* out; unsigned char* ws; int ph_lo, ph_hi; };
__global__ void __launch_bounds__(512, 2) dit_fwd(Args args) {
    extern __shared__ __attribute__((aligned(16))) unsigned char lds_raw[];
    LAS unsigned char* lds = (LAS unsigned char*)lds_raw;
    const int tid = threadIdx.x, lane = tid & 63, wave = __builtin_amdgcn_readfirstlane(tid >> 6);
    const int G = gridDim.x, bid = blockIdx.x;
    const int gw = bid * 8 + wave, NGW = G * 8;
    unsigned char* ws = args.ws;
    const float* x = args.in[0]; const float* cnd = args.in[1]; const float* ctx = args.in[2]; const float* cctx = args.in[3];
    const float* ada_w = args.in[4]; const float* ada_b = args.in[5]; const float* nmix = args.in[6]; const float* nffn = args.in[7];
    const float* conv_w = args.in[9]; const float* qgain = args.in[12]; const float* kgain = args.in[13]; const float* sink = args.in[14]; const float* router_w = args.in[16];
    float* mod = (float*)(ws + WS_MOD); float* modp = (float*)(ws + WS_MODP);
    float* affL = (float*)(ws + WS_AFFL); float* affC = (float*)(ws + WS_AFFC);
    float* rwt = (float*)(ws + WS_RWT);
    int* rowsrc = (int*)(ws + WS_ROWSRC); float* gatev = (float*)(ws + WS_GATEV); int* inv = (int*)(ws + WS_INV);
    bf16_t* W1A = (bf16_t*)(ws + WS_W1A); bf16_t* W1B = (bf16_t*)(ws + WS_W1B); bf16_t* W2 = (bf16_t*)(ws + WS_W2); bf16_t* WQKV = (bf16_t*)(ws + WS_WQKV); bf16_t* WOt = (bf16_t*)(ws + WS_WO);
    bf16_t* WGU = (bf16_t*)(ws + WS_WGU); bf16_t* WDN = (bf16_t*)(ws + WS_WDN);
    bf16_t* H = (bf16_t*)(ws + WS_H); bf16_t* A = (bf16_t*)(ws + WS_A); bf16_t* U = (bf16_t*)(ws + WS_U); bf16_t* Z = (bf16_t*)(ws + WS_Z);
    bf16_t* Qb = (bf16_t*)(ws + WS_Q); bf16_t* Kb = (bf16_t*)(ws + WS_K); bf16_t* Vb = (bf16_t*)(ws + WS_V); bf16_t* Ob = (bf16_t*)(ws + WS_O);
    bf16_t* HM = (bf16_t*)(ws + WS_HM); bf16_t* Y = (bf16_t*)(ws + WS_Y);
    LAS unsigned* cscr = (LAS unsigned*)(lds + wave * 9216);

    for (int u = tid; u < (LDS_BYTES - MISC_OFF) / 4; u += 512) ((LAS unsigned*)(lds + MISC_OFF))[u] = 0u;
    __syncthreads();
#if MK_ONE_LAUNCH
    XcdBarrier bar = xcd_barrier_post((unsigned*)(ws + WS_CTL) + CW_BAR, (volatile LAS unsigned*)(lds + MISC_OFF) + 8);
#define GRID_BAR() xcd_barrier(bar)
#else
#define GRID_BAR() do {} while (0)
#endif
    const int lo = args.ph_lo, hi = args.ph_hi;
#define IN(k) (lo <= (k) && (k) < hi)
#define SEAM(k) do { if (IN(k) && IN((k) + 1)) GRID_BAR(); } while (0)
#define PHASE(k) if (IN(k)) _Pragma("unroll") for (int rep_ = 0; rep_ < 1 + (int)((DUP_MASK >> (k)) & 1u); ++rep_)
#define REP_BAR() do { if (rep_) GRID_BAR(); } while (0)

    PHASE(0) { REP_BAR(); ph_adaln(cnd, cctx, ada_w, modp, gw, NGW, lane); } SEAM(0);
    PHASE(1) { REP_BAR(); ph_modred(modp, ada_b, mod, bid * 512 + tid, G * 512); ph_rwt(router_w, rwt, bid * 512 + tid, G * 512); } SEAM(1);
    PHASE(2) { REP_BAR(); ph_mod0(x, ctx, nmix, mod, A, gw, NGW, lane); CVT(0, 4096); } SEAM(2);
    PHASE(3) { REP_BAR();
        pg8::Gemm g{A, W1A, MT, 4096, DM}; pg8::StaticOrder S; S.init(MT, 4096, G, bid);
        EpiPair<0> E{U, DM, 16};
        pg8::gemm_phase<EpiPair<0>, pg8::StaticOrder, true, true>(lds, g, S, E);
    } SEAM(3);
    PHASE(4) { REP_BAR();
        pg8::Gemm g{A, W1B, MT, DM, DM}; pg8::StaticOrder S; S.init(MT, DM, G, bid);
        EpiConvGate E{U, Z, conv_w};
        pg8::gemm_phase<EpiConvGate, pg8::StaticOrder, true, true>(lds, g, S, E);
    } SEAM(4);
    PHASE(5) { REP_BAR();
        pg8::Gemm g{Z, W2, MT, DM, DM}; pg8::StaticOrder S; S.init(MT, DM, G, bid);
        EpiResid<true> E{x, ctx, H, mod + 2 * DM};
        pg8::gemm_phase<EpiResid<true>, pg8::StaticOrder, true, true>(lds, g, S, E);
    } SEAM(5);
    PHASE(6) { REP_BAR(); load_router(rwt, (LAS float*)lds, tid); ph_modffn(H, nffn, mod, A, (const LAS float*)lds, affL, affC, MT, gw, NGW, lane); } SEAM(6);
    PHASE(7) { REP_BAR(); ph_topk(256, affL, affC, rowsrc, gatev, inv, (LAS unsigned*)lds, tid, lane, wave, bid, G); CVT(CVT_E0, CVT_E0 + 16384); } SEAM(7);
    PHASE(8) { REP_BAR();
        pg8::Gemm g{A, WGU, YT, NE * 2048, DM, rowsrc}; MoeOrder S{G, bid, 9};
        EpiPair<1> E{HM, DFF, 8};
        pg8::gemm_phase<EpiPair<1>, MoeOrder, true, true, true>(lds, g, S, E);
        CVT(CVT_E0 + 16384, CVT_X0_END);
    } SEAM(8);
    PHASE(9) { REP_BAR();
        pg8::Gemm g{HM, WDN, YT, NE * 2048, DFF}; MoeOrder S{G, bid, 9};
        EpiDown E{Y, gatev};
        pg8::gemm_phase<EpiDown, MoeOrder, true, true>(lds, g, S, E);
    } SEAM(9);
    PHASE(10) { REP_BAR(); ph_combine<false>(H, Y, inv, mod, nmix + DM, mod + 9 * NMOD, A, nullptr, MT, gw, NGW, lane); CVT(4096, 4096 + 1536); } SEAM(10);
    PHASE(11) { REP_BAR();
        pg8::Gemm g{A, WQKV, MT, 3072, DM}; QkvOrder S{G, bid};
        EpiQkvNorm E{Qb, Kb, Vb, qgain, kgain, (LAS float*)(lds + RING_BYTES)};
        pg8::gemm_phase<EpiQkvNorm, QkvOrder, true, true>(lds, g, S, E);
    } SEAM(11);
    PHASE(12) { REP_BAR(); ph_attn(Qb, Kb, Vb, Ob, sink, lds, tid, lane, wave, bid, G); __syncthreads(); CVT(4096 + 1536, CVT_E0); } SEAM(12);
    PHASE(13) { REP_BAR();
        pg8::Gemm g{Ob, WOt, ML, DM, DM}; pg8::StaticOrder S; S.init(ML, DM, G, bid);
        EpiResid<false> E{nullptr, nullptr, H, mod + 9 * NMOD + 2 * DM};
        pg8::gemm_phase<EpiResid<false>, pg8::StaticOrder, true, true>(lds, g, S, E);
    } SEAM(13);
    PHASE(14) { REP_BAR(); load_router(rwt + DM * 16, (LAS float*)lds, tid); ph_modffn(H, nffn + DM, mod + 9 * NMOD, A, (const LAS float*)lds, affL, affC, ML, gw, NGW, lane); } SEAM(14);
    PHASE(15) { REP_BAR(); ph_topk(128, affL, affC, rowsrc, gatev, inv, (LAS unsigned*)lds, tid, lane, wave, bid, G); CVT(CVT_X0_END, CVT_X0_END + 16384); } SEAM(15);
    PHASE(16) { REP_BAR();
        pg8::Gemm g{A, WGU + (size_t)NE * 2048 * DM, YT, NE * 2048, DM, rowsrc}; MoeOrder S{G, bid, 8};
        EpiPair<1> E{HM, DFF, 8};
        pg8::gemm_phase<EpiPair<1>, MoeOrder, true, true, true>(lds, g, S, E);
        CVT(CVT_X0_END + 16384, CVT_TOTAL);
    } SEAM(16);
    PHASE(17) { REP_BAR();
        pg8::Gemm g{HM, WDN + (size_t)NE * 2048 * DFF, YT, NE * 2048, DFF}; MoeOrder S{G, bid, 8};
        EpiDown E{Y, gatev};
        pg8::gemm_phase<EpiDown, MoeOrder, true, true>(lds, g, S, E);
    } SEAM(17);
    PHASE(18) { REP_BAR(); ph_combine<true>(H, Y, inv, mod + 9 * NMOD, nullptr, nullptr, nullptr, args.out, ML, gw, NGW, lane); }
#undef IN
#undef SEAM
#undef PHASE
#undef REP_BAR
}

extern "C" void kernel_launch(void* const* d_in, const int* in_sizes, int n_in, void* d_out, int out_size, void* d_ws, size_t ws_size, hipStream_t stream) {
    static int grid = 0;
    if (grid == 0) {
        if (n_in != 20 || out_size != ML * DM || ws_size < WS_END) { fprintf(stderr, "kernel_launch: unexpected problem (n_in %d, out %d, ws %zu); nothing launched\n", n_in, out_size, ws_size); grid = -1; return; }
        int dev = 0, cus = 0, per_cu = 0;
        if (hipGetDevice(&dev) != hipSuccess || hipDeviceGetAttribute(&cus, hipDeviceAttributeMultiprocessorCount, dev) != hipSuccess) { grid = -1; return; }
        if (hipFuncSetAttribute((const void*)dit_fwd, hipFuncAttributeMaxDynamicSharedMemorySize, LDS_BYTES) != hipSuccess) { fprintf(stderr, "kernel_launch: hipFuncSetAttribute failed\n"); grid = -1; return; }
        if (hipOccupancyMaxActiveBlocksPerMultiprocessor(&per_cu, (const void*)dit_fwd, 512, LDS_BYTES) != hipSuccess || per_cu < 1) fprintf(stderr, "kernel_launch: occupancy query reports %d workgroups per CU\n", per_cu);
        (void)hipGetLastError();
        grid = cus;
    }
    if (grid < 0) return;
    (void)hipMemsetAsync((char*)d_ws + WS_CTL, 0, CTL_ZERO_BYTES, stream);
    Args a{};
    for (int i = 0; i < 20; ++i) a.in[i] = (const float*)d_in[i];
    a.out = (float*)d_out; a.ws = (unsigned char*)d_ws;
#if MK_ONE_LAUNCH
    a.ph_lo = 0; a.ph_hi = NPHASE;
    hipLaunchKernelGGL(dit_fwd, dim3(grid), dim3(512), LDS_BYTES, stream, a);
#else
    for (int p = 0; p < NPHASE; ++p) { a.ph_lo = p; a.ph_hi = p + 1; hipLaunchKernelGGL(dit_fwd, dim3(grid), dim3(512), LDS_BYTES, stream, a); }
#endif
}
```

```cpp
#include <hip/hip_runtime.h>
#include <cstdio>
#include <cstdint>
namespace pg8 {
#define PG8_LAS __attribute__((address_space(3)))
typedef unsigned short bf16_t;
typedef short bf16x8 __attribute__((ext_vector_type(8)));
typedef float f32x4 __attribute__((ext_vector_type(4)));
typedef unsigned u32x4 __attribute__((ext_vector_type(4)));
constexpr int BM = 256, BK = 64, HALF = 128, HTB = HALF * BK * 2  , STAGE_BYTES = 8 * HTB, NXCD = 8, WGM = 8;

__host__ __device__ __forceinline__ int lds_byte(int r, int c) { const int st = (r >> 4) * 2 + (c >> 5), rr = r & 15, cc = c & 31, ob = rr * 64 + cc * 2; return st * 1024 + (ob ^ (((ob >> 9) & 1) << 5)); }
__host__ __device__ __forceinline__ void stage_rc(int b, int& R, int& C) { const int st = b / 1024, sb = b % 1024, swz = sb ^ (((sb >> 9) & 1) << 5); R = (st >> 1) * 16 + swz / 64; C = (st & 1) * 32 + (swz % 64) / 2; }
__host__ __device__ __forceinline__ int perm32(int rho) { const int n = rho >> 4, i = rho & 15; return 8 * (i >> 2) + 4 * n + (i & 3); }

struct Unit { int pm, pn; };
struct Gemm { const bf16_t* A; const bf16_t* Bt; int M, N, K; const int* rows = nullptr; };

struct StaticOrder {
    int nM, nN, nwg, G, c;
    __host__ __device__ void init(int M, int N, int G_, int c_) { nM = M / BM; nN = N / BM; nwg = nM * nN; G = G_; c = c_; }
    __host__ __device__ bool next(int i, Unit& u) const {
        const long L = (long)i * G + c; if (L >= nwg) return false;
        int wgid = (int)L; { const int q = nwg / NXCD, r = nwg % NXCD, xcd = wgid % NXCD, off = wgid / NXCD; wgid = (xcd < r ? xcd * (q + 1) : r * (q + 1) + (xcd - r) * q) + off; }
        const int nig = WGM * nN, gid = wgid / nig, fm = gid * WGM, gsz = (nM - fm) < WGM ? (nM - fm) : WGM;
        u.pm = fm + ((wgid % nig) % gsz); u.pn = (wgid % nig) / gsz; return true;
    }
    __device__ __forceinline__ void a_ready(const Unit&) const {}
    __device__ __forceinline__ void done(const Unit&) const {}
};
__device__ __forceinline__ unsigned cvt_pk_bf16(float lo, float hi) { unsigned r; asm volatile("v_cvt_pk_bf16_f32 %0, %1, %2" : "=v"(r) : "v"(lo), "v"(hi)); return r; }
typedef float f32x2 __attribute__((ext_vector_type(2)));
template <class Epi, class Sched, bool ALIGN_EPI = false, bool SP2 = false, bool GATHER = false, bool F8 = false>
__device__ __forceinline__ void gemm_phase(PG8_LAS unsigned char* lds, const Gemm g, const Sched& S, const Epi& E) {
    typedef int i32x4_t __attribute__((ext_vector_type(4)));
    const int tid = threadIdx.x, wid = __builtin_amdgcn_readfirstlane(tid >> 6), lane = tid & 63, wr = wid >> 2, wc = wid & 3, fr = lane & 15, fq = lane >> 4;
    const int K = g.K, nt = K / BK;
    unsigned voffA[2], voffB[2];
#pragma unroll
    for (int i = 0; i < 2; ++i) { int R, C; stage_rc(tid * 16 + i * 8192, R, C); const int Rb = Epi::PERM ? ((R & ~31) + perm32(R & 31)) : R;
        voffA[i] = (unsigned)(R * K + C) * 2u; voffB[i] = (unsigned)(Rb * K + C) * 2u; }
    const size_t kstep = (size_t)(BK * 2);
    const size_t hstep = (size_t)HALF * K * 2;
    const size_t tstep = 2 * hstep;
    const unsigned ldsw = (unsigned)wid * 1024u;
    const int aoff = lds_byte(wr * 64 + fr, fq * 8), boff = lds_byte(wc * 32 + fr, fq * 8);
#define PG8_SA(b, h) (((b) * 2 + (h)) * HTB)
#define PG8_SB(b, h) ((4 + (b) * 2 + (h)) * HTB)
#define PG8_UNI(p) ((const char*)(((unsigned long long)(unsigned)__builtin_amdgcn_readfirstlane((int)((unsigned long long)(p) >> 32)) << 32) | (unsigned long long)(unsigned)__builtin_amdgcn_readfirstlane((int)(unsigned long long)(p))))
#define PG8_STAGE(bufoff, gbase, voff) do { const char* gb_ = PG8_UNI(gbase);     \
        _Pragma("unroll") for (int _i = 0; _i < 2; ++_i) \
        __builtin_amdgcn_global_load_lds((const unsigned*)(gb_ + (voff)[_i]), (PG8_LAS unsigned*)(lds + (bufoff) + ldsw + _i * 8192), 16, 0, 0); } while (0)
#define PG8_STAGE_A(bufoff, kptr, h) do { if constexpr (GATHER) { PG8_STAGE(bufoff, kptr, vA[h]); } else { PG8_STAGE(bufoff, (kptr) + (h) * hstep, voffA); } } while (0)
#define PG8_GATHER_SWITCH() do { if constexpr (GATHER) { if (last && has_next) { asm volatile("" : "+v"(nv[0]), "+v"(nv[1]), "+v"(nv[2]), "+v"(nv[3])); \
        vA[0][0] = nv[0] * (unsigned)(K * 2) + gcoff[0]; vA[0][1] = nv[1] * (unsigned)(K * 2) + gcoff[1]; vA[1][0] = nv[2] * (unsigned)(K * 2) + gcoff[0]; vA[1][1] = nv[3] * (unsigned)(K * 2) + gcoff[1]; } } } while (0)
#define PG8_LDA(dst, b, h) do { _Pragma("unroll") for (int m = 0; m < 4; ++m) { if constexpr (F8) { dst##8[m] = PG8_CAT8(*(const PG8_LAS i32x4_t*)(lds + PG8_SA(b, h) + aoff + m * 2048), *(const PG8_LAS i32x4_t*)(lds + PG8_SA(b, h) + aoff + m * 2048 + 1024)); } \
        else { _Pragma("unroll") for (int k = 0; k < 2; ++k) dst[m][k] = *(const PG8_LAS bf16x8*)(lds + PG8_SA(b, h) + aoff + m * 2048 + k * 1024); } } } while (0)
#define PG8_LDB(dst, b, h) do { _Pragma("unroll") for (int n = 0; n < 2; ++n) { if constexpr (F8) { dst##8[n] = PG8_CAT8(*(const PG8_LAS i32x4_t*)(lds + PG8_SB(b, h) + boff + n * 2048), *(const PG8_LAS i32x4_t*)(lds + PG8_SB(b, h) + boff + n * 2048 + 1024)); } \
        else { _Pragma("unroll") for (int k = 0; k < 2; ++k) dst[n][k] = *(const PG8_LAS bf16x8*)(lds + PG8_SB(b, h) + boff + n * 2048 + k * 1024); } } } while (0)
#define PG8_CAT8(lo_, hi_) __builtin_shufflevector(lo_, hi_, 0, 1, 2, 3, 4, 5, 6, 7)
#define PG8_MMA(ai, bj, At, Bt) do { __builtin_amdgcn_s_setprio(1); _Pragma("unroll") for (int m = 0; m < 4; ++m) _Pragma("unroll") for (int n = 0; n < 2; ++n) { \
        if constexpr (F8) { acc[ai][bj][m][n] = __builtin_amdgcn_mfma_scale_f32_16x16x128_f8f6f4(Bt##8[n], At##8[m], acc[ai][bj][m][n], 0, 0, 0, 0x7f7f7f7f, 0, 0x7f7f7f7f); } \
        else { _Pragma("unroll") for (int k = 0; k < 2; ++k) acc[ai][bj][m][n] = __builtin_amdgcn_mfma_f32_16x16x32_bf16(Bt[n][k], At[m][k], acc[ai][bj][m][n], 0, 0, 0); } } \
        __builtin_amdgcn_s_setprio(0); } while (0)
#define PG8_WAIT_V(n) asm volatile("s_waitcnt vmcnt(" #n ")" ::: "memory")
#define PG8_WAIT_L(n) asm volatile("s_waitcnt lgkmcnt(" #n ")" ::: "memory")
#define PG8_BAR __builtin_amdgcn_s_barrier()
#define PG8_SCHED __builtin_amdgcn_sched_barrier(0)
    Unit cur, nxt; int ui = 0;
    if (!S.next(0, cur)) return;
    f32x4 acc[2][2][4][2];
#pragma unroll
    for (int a = 0; a < 2; ++a)
#pragma unroll
        for (int b = 0; b < 2; ++b)
#pragma unroll
            for (int m = 0; m < 4; ++m)
#pragma unroll
                for (int n = 0; n < 2; ++n) acc[a][b][m][n] = (f32x4){0.f, 0.f, 0.f, 0.f};
    bf16x8 At[4][2], B0[2][2], B1[2][2]; typedef int i32x8_t __attribute__((ext_vector_type(8))); i32x8_t At8[4], B08[2], B18[2];
    const char* cA = (const char*)g.A + (GATHER ? (size_t)0 : (size_t)cur.pm * tstep); const char* cB = (const char*)g.Bt + (size_t)cur.pn * tstep;
    unsigned vA[2][2], nv[4], gcoff[2]; int grow[2];
    if constexpr (GATHER) {
#pragma unroll
        for (int i = 0; i < 2; ++i) { int R, C; stage_rc(tid * 16 + i * 8192, R, C); grow[i] = R; gcoff[i] = (unsigned)(C * 2); }
#pragma unroll
        for (int h = 0; h < 2; ++h)
#pragma unroll
            for (int i = 0; i < 2; ++i) vA[h][i] = (unsigned)g.rows[cur.pm * BM + h * HALF + grow[i]] * (unsigned)(K * 2) + gcoff[i];
    }
    S.a_ready(cur);
    if constexpr (SP2) {
        PG8_STAGE(PG8_SB(0, 0), cB, voffB); PG8_STAGE(PG8_SB(0, 1), cB + hstep, voffB); PG8_STAGE_A(PG8_SA(0, 0), cA, 0); PG8_STAGE_A(PG8_SA(0, 1), cA, 1);
        if (wr == 1) PG8_BAR;
        PG8_WAIT_V(2); PG8_BAR;
        PG8_STAGE(PG8_SB(1, 0), cB + kstep, voffB); PG8_STAGE_A(PG8_SA(1, 0), cA + kstep, 0); PG8_STAGE(PG8_SB(1, 1), cB + hstep + kstep, voffB);
        PG8_WAIT_V(6); PG8_BAR;
    } else {
        PG8_STAGE(PG8_SB(0, 0), cB, voffB); PG8_STAGE_A(PG8_SA(0, 0), cA, 0); PG8_STAGE(PG8_SB(0, 1), cB + hstep, voffB); PG8_STAGE_A(PG8_SA(0, 1), cA, 1);
        if (wr == 1) PG8_BAR;
        PG8_WAIT_V(4); PG8_BAR;
        PG8_STAGE(PG8_SB(1, 0), cB + kstep, voffB); PG8_STAGE_A(PG8_SA(1, 0), cA + kstep, 0); PG8_STAGE(PG8_SB(1, 1), cB + hstep + kstep, voffB);
        PG8_WAIT_V(6); PG8_BAR;
    }
    for (;;) {
        const bool has_next = S.next(ui + 1, nxt);
        const char* nA = (has_next && !GATHER) ? (const char*)g.A + (size_t)nxt.pm * tstep : cA; const char* nB = has_next ? (const char*)g.Bt + (size_t)nxt.pn * tstep : cB;
        if constexpr (GATHER) { if (has_next) { const int* rp = g.rows + nxt.pm * BM;
            asm volatile("global_load_dword %0, %1, off" : "=&v"(nv[0]) : "v"(rp + grow[0]) : "memory"); asm volatile("global_load_dword %0, %1, off" : "=&v"(nv[1]) : "v"(rp + grow[1]) : "memory");
            asm volatile("global_load_dword %0, %1, off" : "=&v"(nv[2]) : "v"(rp + HALF + grow[0]) : "memory"); asm volatile("global_load_dword %0, %1, off" : "=&v"(nv[3]) : "v"(rp + HALF + grow[1]) : "memory"); } }
#pragma unroll 1
        for (int t = 0; t < nt; t += 2) {
            const bool last = (t == nt - 2);
            const char* a1 = cA + (size_t)(t + 1) * kstep;
            const char* a2 = last ? nA : cA + (size_t)(t + 2) * kstep; const char* b2 = last ? nB : cB + (size_t)(t + 2) * kstep;
            const char* a3 = a2 + kstep; const char* b3 = b2 + kstep;
            if (last && has_next) S.a_ready(nxt);
            if constexpr (SP2) {
            PG8_LDB(B0, 0, 0); PG8_LDB(B1, 0, 1); PG8_SCHED; PG8_LDA(At, 0, 0); PG8_STAGE_A(PG8_SA(1, 1), a1, 1); PG8_GATHER_SWITCH();
            PG8_WAIT_V(8); PG8_WAIT_L(0); PG8_BAR; PG8_MMA(0, 0, At, B0); PG8_MMA(0, 1, At, B1); PG8_BAR; PG8_SCHED;
            PG8_LDA(At, 0, 1); PG8_STAGE(PG8_SB(0, 0), b2, voffB); PG8_STAGE(PG8_SB(0, 1), b2 + hstep, voffB); PG8_STAGE_A(PG8_SA(0, 0), a2, 0);
            PG8_WAIT_V(8); PG8_WAIT_L(0); PG8_BAR; PG8_MMA(1, 0, At, B0); PG8_MMA(1, 1, At, B1); PG8_BAR; PG8_SCHED;
            PG8_LDB(B0, 1, 0); PG8_LDB(B1, 1, 1); PG8_SCHED; PG8_LDA(At, 1, 0); PG8_STAGE_A(PG8_SA(0, 1), a2, 1);
            PG8_WAIT_V(8); PG8_WAIT_L(0); PG8_BAR; PG8_MMA(0, 0, At, B0); PG8_MMA(0, 1, At, B1); PG8_BAR; PG8_SCHED;
            PG8_LDA(At, 1, 1); PG8_STAGE(PG8_SB(1, 0), b3, voffB); PG8_STAGE(PG8_SB(1, 1), b3 + hstep, voffB); PG8_STAGE_A(PG8_SA(1, 0), a3, 0);
            PG8_WAIT_V(8); PG8_WAIT_L(0); PG8_BAR; PG8_MMA(1, 0, At, B0); PG8_MMA(1, 1, At, B1); PG8_BAR; PG8_SCHED;
            } else {
            PG8_LDB(B0, 0, 0); PG8_SCHED; PG8_LDA(At, 0, 0); PG8_STAGE_A(PG8_SA(1, 1), a1, 1); PG8_GATHER_SWITCH();
            PG8_WAIT_L(8); PG8_BAR; PG8_WAIT_L(0); PG8_MMA(0, 0, At, B0); PG8_BAR; PG8_SCHED;
            PG8_LDB(B1, 0, 1); PG8_STAGE(PG8_SB(0, 0), b2, voffB);
            PG8_BAR; PG8_WAIT_L(0); PG8_MMA(0, 1, At, B1); PG8_BAR;
            PG8_LDA(At, 0, 1); PG8_STAGE_A(PG8_SA(0, 0), a2, 0);
            PG8_BAR; PG8_WAIT_L(0); PG8_MMA(1, 0, At, B0); PG8_BAR; PG8_SCHED;
            PG8_STAGE(PG8_SB(0, 1), b2 + hstep, voffB);
            PG8_WAIT_V(6); PG8_BAR; PG8_MMA(1, 1, At, B1); PG8_BAR;
            PG8_LDB(B0, 1, 0); PG8_SCHED; PG8_LDA(At, 1, 0); PG8_STAGE_A(PG8_SA(0, 1), a2, 1);
            PG8_WAIT_L(8); PG8_BAR; PG8_WAIT_L(0); PG8_MMA(0, 0, At, B0); PG8_BAR; PG8_SCHED;
            PG8_LDB(B1, 1, 1); PG8_STAGE(PG8_SB(1, 0), b3, voffB);
            PG8_BAR; PG8_WAIT_L(0); PG8_MMA(0, 1, At, B1); PG8_BAR;
            PG8_LDA(At, 1, 1); PG8_STAGE_A(PG8_SA(1, 0), a3, 0);
            PG8_BAR; PG8_WAIT_L(0); PG8_MMA(1, 0, At, B0); PG8_BAR; PG8_SCHED;
            PG8_STAGE(PG8_SB(1, 1), b3 + hstep, voffB);
            PG8_WAIT_V(6); PG8_BAR; PG8_MMA(1, 1, At, B1); PG8_BAR;
            }
        }
        if constexpr (ALIGN_EPI) { if (wr == 0) PG8_BAR; }
        if constexpr (!Epi::AFTER_DRAIN) { E(acc, cur, wr, wc, fr, fq); S.done(cur); }
        if (!has_next) break;
#pragma unroll
        for (int a = 0; a < 2; ++a)
#pragma unroll
            for (int b = 0; b < 2; ++b)
#pragma unroll
                for (int m = 0; m < 4; ++m)
#pragma unroll
                    for (int n = 0; n < 2; ++n) acc[a][b][m][n] = (f32x4){0.f, 0.f, 0.f, 0.f};
        cur = nxt; cA = nA; cB = nB; ++ui;
        if constexpr (ALIGN_EPI) { if (wr == 1) PG8_BAR; }
    }
    PG8_WAIT_V(0);
    if constexpr (!ALIGN_EPI) { if (wr == 0) PG8_BAR; }
    PG8_BAR;
    if constexpr (Epi::AFTER_DRAIN) { E.fused(acc, cur, wr, wc, fr, fq, lds, wid, lane); S.done(cur); }
#undef PG8_SA
#undef PG8_SB
#undef PG8_STAGE
#undef PG8_UNI
#undef PG8_STAGE_A
#undef PG8_GATHER_SWITCH
#undef PG8_LDA
#undef PG8_LDB
#undef PG8_MMA
#undef PG8_CAT8
#undef PG8_WAIT_V
#undef PG8_WAIT_L
#undef PG8_BAR
#undef PG8_SCHED
}
}

constexpr int DM = 2048, NB = 8, SEQ = 2048, CTXL = 256, NH = 16, NKV = 4, HD = 128;
constexpr int ML = NB * SEQ;
constexpr int MC = NB * CTXL;
constexpr int MT = ML + MC;
constexpr int NE = 16, CAPL = 256, CAPC = 32, DFF = 1024;
constexpr int YR = NB * CAPL + NB * CAPC;
constexpr int YT = NE * YR;
constexpr int NMOD = 6 * DM;
constexpr float NORM_EPS = 1e-6f;
constexpr int KSPLIT = 16;

using pg8::Unit; using pg8::f32x4; using pg8::u32x4; using pg8::bf16_t; using pg8::bf16x8; using pg8::cvt_pk_bf16;
typedef float f32x2 __attribute__((ext_vector_type(2)));
typedef unsigned u32x2 __attribute__((ext_vector_type(2)));
typedef float f32x16 __attribute__((ext_vector_type(16)));
typedef short s16x4 __attribute__((ext_vector_type(4)));
#define DI __device__ __forceinline__

DI float bf_lo(unsigned w) { return __uint_as_float(w << 16); }
DI float bf_hi(unsigned w) { return __uint_as_float(w & 0xffff0000u); }
DI unsigned pk4_fp8(float a, float b, float c, float d) {
    a = __builtin_amdgcn_fmed3f(a, -448.0f, 448.0f); b = __builtin_amdgcn_fmed3f(b, -448.0f, 448.0f); c = __builtin_amdgcn_fmed3f(c, -448.0f, 448.0f); d = __builtin_amdgcn_fmed3f(d, -448.0f, 448.0f);
    int w = __builtin_amdgcn_cvt_pk_fp8_f32(a, b, 0, false); w = __builtin_amdgcn_cvt_pk_fp8_f32(c, d, w, true); return (unsigned)w;
}
constexpr float W8_SCALE = 32.0f, W8_INV = 1.0f / 32.0f;
DI float silu_f(float a) { return a * __builtin_amdgcn_rcpf(1.0f + __expf(-a)); }

DI int xcd_remap(int wgid, int nwg) { const int q = nwg / 8, r = nwg % 8, xcd = wgid % 8, off = wgid / 8; return (xcd < r ? xcd * (q + 1) : r * (q + 1) + (xcd - r) * q) + off; }
struct QkvOrder {
    int G, c;
    DI bool next(int i, Unit& u) const {
        const int L = i * G + c; if (L >= 800) return false;
        if (L < 768) { const int w = xcd_remap(L, 768); const int nig = 8 * 12, gid = w / nig; u.pm = gid * 8 + ((w % nig) % 8); u.pn = (w % nig) / 8; }
        else { const int j = L - 768; u.pm = 64 + (j >> 2); u.pn = 8 + (j & 3); }
        return true;
    }
    DI void a_ready(const Unit&) const {}
    DI void done(const Unit&) const {}
};
struct MoeOrder {
    int G, c, NP;
    DI bool next(int i, Unit& u) const {
        const int nwg = NE * NP * 8; const int L = i * G + c; if (L >= nwg) return false;
        const int w = xcd_remap(L, nwg); const int per = NP * 8, e = w / per, rem = w % per;
        u.pm = e * 9 + (rem % NP); u.pn = e * 8 + (rem / NP); return true;
    }
    DI void a_ready(const Unit&) const {}
    DI void done(const Unit&) const {}
};

template <int ACT  > struct EpiPair {
    static constexpr bool PERM = true, AFTER_DRAIN = false;
    bf16_t* O; int ldc; int pn_mod;
    DI void operator()(const f32x4 (&acc)[2][2][4][2], const Unit& u, int wr, int wc, int fr, int fq) const {
        const int row0 = u.pm * 256 + wr * 64 + fr, col0 = (u.pn % pn_mod) * 128 + wc * 32 + 8 * fq;
#pragma unroll
        for (int ai = 0; ai < 2; ++ai)
#pragma unroll
            for (int m = 0; m < 4; ++m) {
                bf16_t* rowp = O + (size_t)(row0 + ai * 128 + m * 16) * ldc + col0;
                f32x4 a0 = acc[ai][0][m][0], a1 = acc[ai][0][m][1]; const f32x4 b0 = acc[ai][1][m][0], b1 = acc[ai][1][m][1];
                if (ACT == 1) {
#pragma unroll
                    for (int j = 0; j < 4; ++j) { a0[j] = silu_f(a0[j]); a1[j] = silu_f(a1[j]); } }
                const f32x4 v0 = a0 * b0, v1 = a1 * b1;
                u32x4 w; w.x = cvt_pk_bf16(v0[0], v0[1]); w.y = cvt_pk_bf16(v0[2], v0[3]); w.z = cvt_pk_bf16(v1[0], v1[1]); w.w = cvt_pk_bf16(v1[2], v1[3]);
                *(u32x4*)rowp = w;
            }
    }
};
struct EpiPairF8 {
    static constexpr bool PERM = true, AFTER_DRAIN = false;
    unsigned char* O; int ldc; int pn_mod;
    DI void operator()(const f32x4 (&acc)[2][2][4][2], const Unit& u, int wr, int wc, int fr, int fq) const {
        const int row0 = u.pm * 256 + wr * 64 + fr, col0 = (u.pn % pn_mod) * 128 + wc * 32 + 8 * fq;
#pragma unroll
        for (int ai = 0; ai < 2; ++ai)
#pragma unroll
            for (int m = 0; m < 4; ++m) {
                unsigned char* rowp = O + (size_t)(row0 + ai * 128 + m * 16) * ldc + col0;
                f32x4 a0 = acc[ai][0][m][0] * W8_INV, a1 = acc[ai][0][m][1] * W8_INV; const f32x4 b0 = acc[ai][1][m][0] * W8_INV, b1 = acc[ai][1][m][1] * W8_INV;
#pragma unroll
                for (int j = 0; j < 4; ++j) { a0[j] = silu_f(a0[j]); a1[j] = silu_f(a1[j]); }
                const f32x4 v0 = a0 * b0, v1 = a1 * b1;
                u32x2 w; w.x = pk4_fp8(v0[0], v0[1], v0[2], v0[3]); w.y = pk4_fp8(v1[0], v1[1], v1[2], v1[3]);
                *(u32x2*)rowp = w;
            }
    }
};
struct EpiConvGate {
    static constexpr bool PERM = true, AFTER_DRAIN = false;
    const bf16_t* U; bf16_t* Z; const float* cw;
    DI void operator()(const f32x4 (&acc)[2][2][4][2], const Unit& u, int wr, int wc, int fr, int fq) const {
        const int row0 = u.pm * 256 + wr * 64 + fr, col0 = u.pn * 256 + wc * 32 + 8 * fq;
#pragma unroll
        for (int bj = 0; bj < 2; ++bj) {
            const int c = col0 + bj * 128;
            f32x4 w0a = *(const f32x4*)(cw + c), w0b = *(const f32x4*)(cw + c + 4), w1a = *(const f32x4*)(cw + 2048 + c), w1b = *(const f32x4*)(cw + 2048 + c + 4), w2a = *(const f32x4*)(cw + 4096 + c), w2b = *(const f32x4*)(cw + 4096 + c + 4);
#pragma unroll
            for (int ai = 0; ai < 2; ++ai)
#pragma unroll
                for (int m = 0; m < 4; ++m) {
                    const int row = row0 + ai * 128 + m * 16;
                    const int tpos = row < ML ? (row & (SEQ - 1)) : ((row - ML) & (CTXL - 1)); const int len = row < ML ? SEQ : CTXL;
                    const u32x4 z4 = (u32x4){0u, 0u, 0u, 0u};
                    const u32x4 uc = *(const u32x4*)(U + (size_t)row * DM + c);
                    const u32x4 up = tpos > 0 ? *(const u32x4*)(U + (size_t)(row - 1) * DM + c) : z4;
                    const u32x4 un = tpos < len - 1 ? *(const u32x4*)(U + (size_t)(row + 1) * DM + c) : z4;
                    f32x4 ya, yb;
                    ya[0] = w0a[0] * bf_lo(up.x) + w1a[0] * bf_lo(uc.x) + w2a[0] * bf_lo(un.x); ya[1] = w0a[1] * bf_hi(up.x) + w1a[1] * bf_hi(uc.x) + w2a[1] * bf_hi(un.x);
                    ya[2] = w0a[2] * bf_lo(up.y) + w1a[2] * bf_lo(uc.y) + w2a[2] * bf_lo(un.y); ya[3] = w0a[3] * bf_hi(up.y) + w1a[3] * bf_hi(uc.y) + w2a[3] * bf_hi(un.y);
                    yb[0] = w0b[0] * bf_lo(up.z) + w1b[0] * bf_lo(uc.z) + w2b[0] * bf_lo(un.z); yb[1] = w0b[1] * bf_hi(up.z) + w1b[1] * bf_hi(uc.z) + w2b[1] * bf_hi(un.z);
                    yb[2] = w0b[2] * bf_lo(up.w) + w1b[2] * bf_lo(uc.w) + w2b[2] * bf_lo(un.w); yb[3] = w0b[3] * bf_hi(up.w) + w1b[3] * bf_hi(uc.w) + w2b[3] * bf_hi(un.w);
                    const f32x4 v0 = acc[ai][bj][m][0] * ya, v1 = acc[ai][bj][m][1] * yb;
                    u32x4 w; w.x = cvt_pk_bf16(v0[0], v0[1]); w.y = cvt_pk_bf16(v0[2], v0[3]); w.z = cvt_pk_bf16(v1[0], v1[1]); w.w = cvt_pk_bf16(v1[2], v1[3]);
                    *(u32x4*)(Z + (size_t)row * DM + c) = w;
                }
        }
    }
};
template <bool BASE_F32> struct EpiResid {
    static constexpr bool PERM = true, AFTER_DRAIN = false;
    const float* base_lat; const float* base_ctx; bf16_t* out; const float* gate;
    DI void operator()(const f32x4 (&acc)[2][2][4][2], const Unit& u, int wr, int wc, int fr, int fq) const {
        const int rowt = u.pm * 256; const int cr = rowt < ML ? (rowt >> 11) : 8;
        const float* base = rowt < ML ? base_lat : base_ctx - (size_t)ML * DM;
        const int row0 = rowt + wr * 64 + fr, col0 = u.pn * 256 + wc * 32 + 8 * fq;
        f32x4 gv[2][2];
#pragma unroll
        for (int bj = 0; bj < 2; ++bj)
#pragma unroll
            for (int n = 0; n < 2; ++n) gv[bj][n] = *(const f32x4*)(gate + (size_t)cr * NMOD + col0 + bj * 128 + n * 4);
#pragma unroll
        for (int ai = 0; ai < 2; ++ai)
#pragma unroll
            for (int m = 0; m < 4; ++m) { const size_t off = (size_t)(row0 + ai * 128 + m * 16) * DM + col0;
#pragma unroll
                for (int bj = 0; bj < 2; ++bj) { f32x4 b0, b1;
                    if (BASE_F32) { b0 = *(const f32x4*)(base + off + bj * 128); b1 = *(const f32x4*)(base + off + bj * 128 + 4); }
                    else { const u32x4 hb = *(const u32x4*)(out + off + bj * 128); b0 = (f32x4){bf_lo(hb.x), bf_hi(hb.x), bf_lo(hb.y), bf_hi(hb.y)}; b1 = (f32x4){bf_lo(hb.z), bf_hi(hb.z), bf_lo(hb.w), bf_hi(hb.w)}; }
                    const f32x4 v0 = b0 + gv[bj][0] * acc[ai][bj][m][0], v1 = b1 + gv[bj][1] * acc[ai][bj][m][1];
                    u32x4 w; w.x = cvt_pk_bf16(v0[0], v0[1]); w.y = cvt_pk_bf16(v0[2], v0[3]); w.z = cvt_pk_bf16(v1[0], v1[1]); w.w = cvt_pk_bf16(v1[2], v1[3]);
                    *(u32x4*)(out + off + bj * 128) = w; }
                asm volatile("" ::: "memory"); }
    }
};
struct EpiDown {
    static constexpr bool PERM = true, AFTER_DRAIN = false;
    bf16_t* Y; const float* gatev; float ws;
    DI void operator()(const f32x4 (&acc)[2][2][4][2], const Unit& u, int wr, int wc, int fr, int fq) const {
        const int row0 = u.pm * 256 + wr * 64 + fr, col0 = (u.pn & 7) * 256 + wc * 32 + 8 * fq;
#pragma unroll
        for (int ai = 0; ai < 2; ++ai)
#pragma unroll
            for (int m = 0; m < 4; ++m) { const int row = row0 + ai * 128 + m * 16; const float gt = gatev[row] * ws;
#pragma unroll
                for (int bj = 0; bj < 2; ++bj) { const f32x4 v0 = acc[ai][bj][m][0] * gt, v1 = acc[ai][bj][m][1] * gt;
                    u32x4 w; w.x = cvt_pk_bf16(v0[0], v0[1]); w.y = cvt_pk_bf16(v0[2], v0[3]); w.z = cvt_pk_bf16(v1[0], v1[1]); w.w = cvt_pk_bf16(v1[2], v1[3]);
                    *(u32x4*)(Y + (size_t)row * DM + col0 + bj * 128) = w; } }
    }
};
#define LAS3 __attribute__((address_space(3)))
struct EpiQkvNorm {
    static constexpr bool PERM = true, AFTER_DRAIN = false;
    bf16_t* Q; bf16_t* K; bf16_t* V; const float* qg; const float* kg; LAS3 float* P;
    DI void operator()(const f32x4 (&acc)[2][2][4][2], const Unit& u, int wr, int wc, int fr, int fq) const {
        const int row0 = u.pm * 256 + wr * 64 + fr; int colt = u.pn * 256;
        if (colt >= 2560) {
            const int col0 = colt - 2560 + wc * 32 + 8 * fq;
#pragma unroll
            for (int ai = 0; ai < 2; ++ai)
#pragma unroll
                for (int m = 0; m < 4; ++m) { bf16_t* rowp = V + (size_t)(row0 + ai * 128 + m * 16) * 512 + col0;
#pragma unroll
                    for (int bj = 0; bj < 2; ++bj) { const f32x4 v0 = acc[ai][bj][m][0], v1 = acc[ai][bj][m][1];
                        u32x4 w; w.x = cvt_pk_bf16(v0[0], v0[1]); w.y = cvt_pk_bf16(v0[2], v0[3]); w.z = cvt_pk_bf16(v1[0], v1[1]); w.w = cvt_pk_bf16(v1[2], v1[3]);
                        *(u32x4*)(rowp + bj * 128) = w; } }
            return;
        }
        const bool isq = colt < 2048; bf16_t* base = isq ? Q : K; const int ld = isq ? 2048 : 512; if (!isq) colt -= 2048;
        const int rl0 = wr * 64 + fr;
#pragma unroll
        for (int ai = 0; ai < 2; ++ai)
#pragma unroll
            for (int m = 0; m < 4; ++m)
#pragma unroll
                for (int bj = 0; bj < 2; ++bj) { const f32x4 a = acc[ai][bj][m][0], b = acc[ai][bj][m][1];
                    float s = (a[0] * a[0] + a[1] * a[1]) + (a[2] * a[2] + a[3] * a[3]) + (b[0] * b[0] + b[1] * b[1]) + (b[2] * b[2] + b[3] * b[3]);
                    s += __shfl_xor(s, 16); s += __shfl_xor(s, 32);
                    if (fq == 0) P[((ai * 128 + m * 16 + rl0) * 2 + bj) * 4 + wc] = s; }
        asm volatile("s_waitcnt lgkmcnt(0)" ::: "memory"); __builtin_amdgcn_s_barrier(); asm volatile("" ::: "memory");
        constexpr float QSCALE = 0.08838834764831845f * 1.4426950408889634f;
        const int i0 = 16 * (wc & 1) + 4 * fq, d0 = 64 * (wc >> 1) + i0;
        const float* gp = isq ? qg : kg; f32x4 g0 = *(const f32x4*)(gp + d0), g1 = *(const f32x4*)(gp + d0 + 32);
        if (isq) { g0 = g0 * QSCALE; g1 = g1 * QSCALE; }
        f32x4 ifr;
#pragma unroll
        for (int j = 0; j < 4; ++j) ifr[j] = exp2f(-(float)(i0 + j) * (13.287712379549449f / 32.0f));
        const bool lat = u.pm < 64;
#pragma unroll
        for (int ai = 0; ai < 2; ++ai)
#pragma unroll
            for (int m = 0; m < 4; ++m) { const int row = row0 + ai * 128 + m * 16; const int t = row & (SEQ - 1);
                const float pos = (float)((wc >> 1) == 0 ? (t >> 6) : (t & 63));
                f32x4 cs, sn;
#pragma unroll
                for (int j = 0; j < 4; ++j) { const float ang = pos * ifr[j]; cs[j] = lat ? __cosf(ang) : 1.0f; sn[j] = lat ? __sinf(ang) : 0.0f; }
#pragma unroll
                for (int bj = 0; bj < 2; ++bj) { const f32x4 pp = *(const LAS3 f32x4*)(P + ((ai * 128 + m * 16 + rl0) * 2 + bj) * 4);
                    const float rstd = 1.0f / sqrtf(((pp[0] + pp[1]) + (pp[2] + pp[3])) * (1.0f / HD) + NORM_EPS);
                    const f32x4 a = acc[ai][bj][m][0] * rstd * g0, b = acc[ai][bj][m][1] * rstd * g1;
                    const f32x4 o1 = a * cs - b * sn, o2 = b * cs + a * sn;
                    u32x4 w; w.x = cvt_pk_bf16(o1[0], o1[1]); w.y = cvt_pk_bf16(o1[2], o1[3]); w.z = cvt_pk_bf16(o2[0], o2[1]); w.w = cvt_pk_bf16(o2[2], o2[3]);
                    *(u32x4*)(base + (size_t)row * ld + colt + bj * 128 + wc * 32 + 8 * fq) = w; } }
    }
};

constexpr size_t MiB = 1u << 20;
constexpr size_t WS_CTL = 0, CTL_ZERO_BYTES = 1 * MiB;
constexpr size_t WS_MOD = 1 * MiB;
constexpr size_t WS_MODP = 2 * MiB;
constexpr size_t WS_AFFL = 16 * MiB;
constexpr size_t WS_AFFC = 17 * MiB;
constexpr size_t WS_RWT = 17 * MiB + 128 * 1024;
constexpr size_t WS_IDMAP = 19 * MiB + 768 * 1024;
constexpr size_t WS_ROWSRC = 17 * MiB + 512 * 1024;
constexpr size_t WS_GATEV = 18 * MiB;
constexpr size_t WS_INV = 18 * MiB + 512 * 1024;
constexpr size_t WS_W1A = 20 * MiB;
constexpr size_t WS_W1B = 36 * MiB;
constexpr size_t WS_W2 = 44 * MiB;
constexpr size_t WS_WQKV = 52 * MiB;
constexpr size_t WS_WO = 64 * MiB;
constexpr size_t WS_WGU = 72 * MiB;
constexpr size_t WS_WDN = 328 * MiB;
constexpr size_t WS_H = 456 * MiB;
constexpr size_t WS_A = 600 * MiB;
constexpr size_t WS_U = 672 * MiB;
constexpr size_t WS_Z = 744 * MiB;
constexpr size_t WS_Q = WS_U, WS_K = WS_Z, WS_V = WS_Z + 18 * MiB;
constexpr size_t WS_HM = 816 * MiB;
constexpr size_t WS_O = WS_HM;
constexpr size_t WS_Y = 888 * MiB;
constexpr size_t WS_END = 1032 * MiB;
constexpr int CW_BAR = 4096;

constexpr int RING_BYTES = 131072;
constexpr int MISC_OFF = RING_BYTES + 14336;
constexpr int LDS_BYTES = 147456;

#define GAS __attribute__((address_space(1)))
#define LAS __attribute__((address_space(3)))
#define LDS_WAIT() asm volatile("s_waitcnt lgkmcnt(0)" ::: "memory")
#define VM_WAIT() asm volatile("s_waitcnt vmcnt(0)" ::: "memory")
#define XB_TMO      128
#define XB_XCNT(j)  (256  + 64 * (j))
#define XB_XSUB(j)  (1280 + 64 * (j))
#define XB_XGEN(j)  (2304 + 64 * (j))
#define XB_TOP      3328
#define XB_TOPGEN   3392
#define XCD_BAR_WORDS 3456
#define XB_SPIN_CAP (1u << 18)

__device__ __forceinline__ unsigned xb_ld(unsigned* p)              { return __hip_atomic_load(p, __ATOMIC_RELAXED, __HIP_MEMORY_SCOPE_AGENT); }
__device__ __forceinline__ unsigned xb_add(unsigned* p, unsigned v) { return __hip_atomic_fetch_add(p, v, __ATOMIC_RELAXED, __HIP_MEMORY_SCOPE_AGENT); }
__device__ __forceinline__ unsigned xb_xcc_id() { return (unsigned)__builtin_amdgcn_s_getreg((3 << 11) | 20) & 0xFu; }
#define XB_SPIN(cond, bar) do { unsigned _sp = 0; while (cond) { __builtin_amdgcn_s_sleep(1); \
    if ((++_sp & 255u) == 0u) { if (xb_ld(&(bar)[XB_TMO])) break; if (_sp > XB_SPIN_CAP) { atomicAdd(&(bar)[XB_TMO], 1u); break; } } } } while (0)

struct XcdBarrier {
    unsigned* bar; unsigned x;
    volatile LAS unsigned* st;
};

__device__ __forceinline__ XcdBarrier xcd_barrier_post(unsigned* bar, volatile LAS unsigned* st) {
    XcdBarrier b; b.bar = bar; b.x = xb_xcc_id(); b.st = st;
    if (threadIdx.x == 0) (void)xb_add(&bar[XB_XCNT(b.x)], 1u);
    return b;
}
__device__ __forceinline__ void xcd_barrier_complete(unsigned* bar, unsigned x, unsigned& nloc, unsigned& nx) {
    const unsigned G = gridDim.x * gridDim.y * gridDim.z;
    unsigned sum, cnt, mine, sp = 0u;
    for (;;) {
        sum = 0u; cnt = 0u; mine = 0u;
#pragma unroll
        for (unsigned j = 0; j < 16; ++j) { const unsigned c = xb_ld(&bar[XB_XCNT(j)]); sum += c; cnt += (c > 0u) ? 1u : 0u; mine = (j == x) ? c : mine; }
        if (sum == G) break;
        __builtin_amdgcn_s_sleep(1);
        if ((++sp & 255u) == 0u) { if (xb_ld(&bar[XB_TMO])) break; if (sp > XB_SPIN_CAP) { atomicAdd(&bar[XB_TMO], 1u); break; } }
    }
    nloc = mine > 0u ? mine : 1u; nx = cnt > 0u ? cnt : 1u;
}

__device__ __forceinline__ void xcd_barrier(const XcdBarrier& b) {
    asm volatile("s_waitcnt vmcnt(0)" ::: "memory");
    __syncthreads();
    if (threadIdx.x == 0) {
        unsigned* bar = b.bar;
        __builtin_amdgcn_s_waitcnt(0);
        unsigned nloc = b.st[0], nx = b.st[1];
        if (nloc == 0u) { xcd_barrier_complete(bar, b.x, nloc, nx); b.st[0] = nloc; b.st[1] = nx; }
        const unsigned old = xb_add(&bar[XB_XSUB(b.x)], 1u);
        const unsigned gen = old / nloc;
        if (old + 1u == (gen + 1u) * nloc) {
            __builtin_amdgcn_fence(__ATOMIC_RELEASE, "agent");
            asm volatile("s_waitcnt vmcnt(0)" ::: "memory");
            const unsigned og = xb_add(&bar[XB_TOP], 1u);
            const unsigned tg = og / nx;
            if (og + 1u == (tg + 1u) * nx) xb_add(&bar[XB_TOPGEN], 1u);
            else XB_SPIN(xb_ld(&bar[XB_TOPGEN]) == tg, bar);
            __builtin_amdgcn_fence(__ATOMIC_ACQUIRE, "agent");
            xb_add(&bar[XB_XGEN(b.x)], 1u);
            asm volatile("s_waitcnt vmcnt(0)" ::: "memory");
        } else {
            XB_SPIN(xb_ld(&bar[XB_XGEN(b.x)]) == gen, bar);
            __builtin_amdgcn_fence(__ATOMIC_ACQUIRE, "agent");
            asm volatile("s_waitcnt vmcnt(0)" ::: "memory");
        }
    }
    __syncthreads();
}

DI float wave_sum(float v) {
#pragma unroll
    for (int o = 1; o < 64; o <<= 1) v += __shfl_xor(v, o);
    return v;
}
DI float rdlane(float v, int l) { return __uint_as_float((unsigned)__builtin_amdgcn_readlane((int)__float_as_uint(v), l)); }
DI unsigned pk2(float lo, float hi) { return cvt_pk_bf16(lo, hi); }

DI void ph_adaln(const float* cnd, const float* cctx, const float* ada_w, float* modp, int gw, int NGW, int lane) {
    for (int task = gw; task < 96 * KSPLIT; task += NGW) {
        const int ks = task & (KSPLIT - 1), cg = task / KSPLIT, l = cg / 48, cgl = cg % 48, col0 = cgl * 256 + lane * 4, k0 = ks * 128;
        float sv[9][2];
#pragma unroll
        for (int r = 0; r < 9; ++r)
#pragma unroll
            for (int hh = 0; hh < 2; ++hh) { const int k = k0 + hh * 64 + lane; const float v = r < 8 ? cnd[r * DM + k] : cctx[k]; sv[r][hh] = v / (1.0f + __expf(-v)); }
        f32x4 acc[9];
#pragma unroll
        for (int r = 0; r < 9; ++r) acc[r] = (f32x4){0.f, 0.f, 0.f, 0.f};
        const float* wp = ada_w + ((size_t)l * DM + k0) * NMOD + col0;
#pragma unroll
        for (int hh = 0; hh < 2; ++hh) {
#pragma unroll 8
            for (int kk = 0; kk < 64; ++kk) {
                const f32x4 w = *(const f32x4*)(wp + (size_t)(hh * 64 + kk) * NMOD);
#pragma unroll
                for (int r = 0; r < 9; ++r) { const float s = rdlane(sv[r][hh], kk); acc[r] += w * s; }
            }
        }
#pragma unroll
        for (int r = 0; r < 9; ++r) *(f32x4*)(modp + ((size_t)((ks * 2 + l) * 9 + r)) * NMOD + col0) = acc[r];
    }
}
struct CvtPtrs { const float *cin, *cout, *wqkv, *wo, *wg, *wu, *wd; bf16_t *W1A, *W1B, *W2, *WQKV, *WO, *WGU, *WDN; };
constexpr int CVT_E0 = 6656, CVT_L = 24576, CVT_TOTAL = CVT_E0 + 2 * CVT_L;
DI void cvt_resolve(const CvtPtrs& P, int it, const float*& src, int& ldw, bf16_t*& dst, int& ldd, bool& qperm, bool& f8) {
    int r = it; qperm = false; f8 = false;
    if (r < 3072) { const int kt = ((r >> 3) / 96) * 8 + (r & 7), nt = (r >> 3) % 96, n0 = nt * 64, part = n0 >> 11, j0 = n0 & 2047;
        src = P.cin + (size_t)(kt * 64) * 6144 + n0; ldw = 6144; ldd = DM;
        dst = (part == 0 ? P.W1B + (size_t)j0 * DM : P.W1A + (size_t)((j0 >> 7) * 256 + (part == 2 ? 128 : 0) + (j0 & 127)) * DM) + kt * 64; return; } r -= 3072;
    if (r < 1024) { const int kt = ((r >> 3) / 32) * 8 + (r & 7), nt = (r >> 3) % 32; src = P.cout + (size_t)(kt * 64) * DM + nt * 64; ldw = DM; dst = P.W2 + (size_t)(nt * 64) * DM + kt * 64; ldd = DM; return; } r -= 1024;
    if (r < 1536) { const int kt = ((r >> 3) / 48) * 8 + (r & 7), nt = (r >> 3) % 48; src = P.wqkv + (size_t)(kt * 64) * 3072 + nt * 64; ldw = 3072; qperm = nt < 40;     dst = P.WQKV + (size_t)(nt * 64) * DM + kt * 64; ldd = DM; return; } r -= 1536;
    if (r < 1024) { const int kt = ((r >> 3) / 32) * 8 + (r & 7), nt = (r >> 3) % 32; src = P.wo + (size_t)(kt * 64) * DM + nt * 64; ldw = DM; dst = P.WO + (size_t)(nt * 64) * DM + kt * 64; ldd = DM; return; } r -= 1024;
    const int l = r / CVT_L, rr = r % CVT_L, kind = rr / 8192, q = rr % 8192, le = l * 16 + q / 512, rem = q % 512;
    f8 = true;
    if (kind < 2) { const int kt = ((rem >> 3) / 16) * 8 + (rem & 7), nt = (rem >> 3) % 16, n0 = nt * 64;
        src = (kind ? P.wu : P.wg) + (size_t)le * DM * DFF + (size_t)(kt * 64) * DFF + n0; ldw = DFF;
        dst = (bf16_t*)((unsigned char*)P.WGU + (size_t)(le * 2048 + (n0 >> 7) * 256 + kind * 128 + (n0 & 127)) * DM + kt * 64); ldd = DM; }
    else { const int kt = ((rem >> 3) / 32) * 8 + (rem & 7), nt = (rem >> 3) % 32;
        src = P.wd + (size_t)le * DFF * DM + (size_t)(kt * 64) * DM + nt * 64; ldw = DM; dst = (bf16_t*)((unsigned char*)P.WDN + (size_t)(le * 2048 + nt * 64) * DFF + kt * 64); ldd = DFF; }
}
constexpr int CVT_P = 36;
DI void cvt_range(const CvtPtrs& P, int lo, int hi, int w, int NW, LAS unsigned* scr, int lane) {
    int it = lo + w; if (it >= hi) return;
    const int c = lane & 15, q = lane >> 4;
    const float* src; int ldw; bf16_t* dst; int ldd; bool qperm, f8; cvt_resolve(P, it, src, ldw, dst, ldd, qperm, f8);
    f32x4 v[16];
#pragma unroll
    for (int rr = 0; rr < 16; ++rr) v[rr] = __builtin_nontemporal_load((const f32x4*)(src + (size_t)(16 * q + rr) * ldw + 4 * c));
    for (;;) {
        const bool cf8 = f8; const int wrow = qperm ? 32 * ((c >> 2) & 1) + 8 * (c & 3) + 4 * (c >> 3) : 4 * c;
        u32x4 pa[4], pb[4];
        if (cf8) {
#pragma unroll
            for (int i = 0; i < 4; ++i) { pa[i].x = pk4_fp8(v[0][i] * W8_SCALE, v[1][i] * W8_SCALE, v[2][i] * W8_SCALE, v[3][i] * W8_SCALE); pa[i].y = pk4_fp8(v[4][i] * W8_SCALE, v[5][i] * W8_SCALE, v[6][i] * W8_SCALE, v[7][i] * W8_SCALE);
                                          pa[i].z = pk4_fp8(v[8][i] * W8_SCALE, v[9][i] * W8_SCALE, v[10][i] * W8_SCALE, v[11][i] * W8_SCALE); pa[i].w = pk4_fp8(v[12][i] * W8_SCALE, v[13][i] * W8_SCALE, v[14][i] * W8_SCALE, v[15][i] * W8_SCALE); pb[i] = pa[i]; }
        } else {
#pragma unroll
            for (int i = 0; i < 4; ++i) { pa[i].x = pk2(v[0][i], v[1][i]); pa[i].y = pk2(v[2][i], v[3][i]); pa[i].z = pk2(v[4][i], v[5][i]); pa[i].w = pk2(v[6][i], v[7][i]);
                                          pb[i].x = pk2(v[8][i], v[9][i]); pb[i].y = pk2(v[10][i], v[11][i]); pb[i].z = pk2(v[12][i], v[13][i]); pb[i].w = pk2(v[14][i], v[15][i]); }
        }
        const int nit = it + NW; bf16_t* cdst = dst; const int cldd = ldd;
        if (nit < hi) { cvt_resolve(P, nit, src, ldw, dst, ldd, qperm, f8);
#pragma unroll
            for (int rr = 0; rr < 16; ++rr) v[rr] = __builtin_nontemporal_load((const f32x4*)(src + (size_t)(16 * q + rr) * ldw + 4 * c)); }
        if (cf8) {
#pragma unroll
            for (int i = 0; i < 4; ++i) *(LAS u32x4*)(scr + (wrow + i) * 20 + 4 * q) = pa[i];
            LDS_WAIT(); asm volatile("" ::: "memory");
#pragma unroll
            for (int j = 0; j < 4; ++j) { const int ch = lane + 64 * j, n = ch >> 2, part = ch & 3; const u32x4 o = *(const LAS u32x4*)(scr + n * 20 + 4 * part);
                *(u32x4*)((unsigned char*)cdst + (size_t)n * cldd + 16 * part) = o; }
        } else {
#pragma unroll
            for (int i = 0; i < 4; ++i) { *(LAS u32x4*)(scr + (wrow + i) * CVT_P + 8 * q) = pa[i]; *(LAS u32x4*)(scr + (wrow + i) * CVT_P + 8 * q + 4) = pb[i]; }
            LDS_WAIT(); asm volatile("" ::: "memory");
#pragma unroll
            for (int j = 0; j < 8; ++j) { const int n = (lane >> 3) + 8 * j; const u32x4 o = *(const LAS u32x4*)(scr + n * CVT_P + 4 * (lane & 7));
                *(u32x4*)(cdst + (size_t)n * cldd + 8 * (lane & 7)) = o; }
        }
        LDS_WAIT(); asm volatile("" ::: "memory");
        if (nit >= hi) break;
        it = nit;
    }
}
DI void ph_modred(const float* modp, const float* ada_b, float* mod, int gtid, int GT) {
    for (int i = gtid; i < 2 * 9 * NMOD; i += GT) { const int l = i / (9 * NMOD), j = i % NMOD; float s = ada_b[l * NMOD + j];
#pragma unroll
        for (int ks = 0; ks < KSPLIT; ++ks) s += modp[(size_t)ks * (2 * 9 * NMOD) + i];
        mod[i] = s; }
}
DI void row_load(const float* p, f32x4 (&v)[8], int lane) {
#pragma unroll
    for (int j = 0; j < 8; ++j) v[j] = *(const f32x4*)(p + 4 * lane + 256 * j);
}
DI void row_load_bf(const bf16_t* p, f32x4 (&v)[8], int lane) {
#pragma unroll
    for (int j = 0; j < 8; ++j) { const u32x2 w = *(const u32x2*)(p + 4 * lane + 256 * j); v[j] = (f32x4){bf_lo(w.x), bf_hi(w.x), bf_lo(w.y), bf_hi(w.y)}; }
}
DI void row_modulate(const f32x4 (&v)[8], f32x4 (&y)[8], const float* gain, const float* shift, const float* scale, int lane) {
    float ss = 0.f;
#pragma unroll
    for (int j = 0; j < 8; ++j) ss += (v[j][0] * v[j][0] + v[j][1] * v[j][1]) + (v[j][2] * v[j][2] + v[j][3] * v[j][3]);
    ss = wave_sum(ss);
    const float rstd = 1.0f / sqrtf(ss * (1.0f / DM) + NORM_EPS);
#pragma unroll
    for (int j = 0; j < 8; ++j) { const int c = 4 * lane + 256 * j; const f32x4 g = *(const f32x4*)(gain + c), sh = *(const f32x4*)(shift + c), sc = *(const f32x4*)(scale + c);
        y[j] = ((v[j] * rstd) * g) * (sc + 1.0f) + sh; }
}
DI void row_modulate2(const f32x4 (&v0)[8], const f32x4 (&v1)[8], f32x4 (&y0)[8], f32x4 (&y1)[8], const float* gain, const float* shift, const float* scale, int lane) {
    float s0 = 0.f, s1 = 0.f;
#pragma unroll
    for (int j = 0; j < 8; ++j) { s0 += (v0[j][0] * v0[j][0] + v0[j][1] * v0[j][1]) + (v0[j][2] * v0[j][2] + v0[j][3] * v0[j][3]); s1 += (v1[j][0] * v1[j][0] + v1[j][1] * v1[j][1]) + (v1[j][2] * v1[j][2] + v1[j][3] * v1[j][3]); }
    s0 = wave_sum(s0); s1 = wave_sum(s1);
    const float r0 = 1.0f / sqrtf(s0 * (1.0f / DM) + NORM_EPS), r1 = 1.0f / sqrtf(s1 * (1.0f / DM) + NORM_EPS);
#pragma unroll
    for (int j = 0; j < 8; ++j) { const int c = 4 * lane + 256 * j; const f32x4 g = *(const f32x4*)(gain + c), sh = *(const f32x4*)(shift + c), sc = *(const f32x4*)(scale + c);
        y0[j] = ((v0[j] * r0) * g) * (sc + 1.0f) + sh; y1[j] = ((v1[j] * r1) * g) * (sc + 1.0f) + sh; }
}
DI void row_store_bf16(bf16_t* p, const f32x4 (&y)[8], int lane) {
#pragma unroll
    for (int j = 0; j < 8; ++j) { u32x2 w; w.x = pk2(y[j][0], y[j][1]); w.y = pk2(y[j][2], y[j][3]); *(u32x2*)(p + 4 * lane + 256 * j) = w; }
}
DI void ph_mod0(const float* x, const float* ctx, const float* gain, const float* mod0, bf16_t* A, int gw, int NGW, int lane) {
    int row = gw; if (row >= MT) return;
    f32x4 v[8], vn[8];
    row_load(row < ML ? x + (size_t)row * DM : ctx + (size_t)(row - ML) * DM, v, lane);
    for (;;) {
        const int nrow = row + NGW; const bool more = nrow < MT;
        if (more) row_load(nrow < ML ? x + (size_t)nrow * DM : ctx + (size_t)(nrow - ML) * DM, vn, lane);
        const int cr = row < ML ? (row >> 11) : 8;
        f32x4 y[8]; row_modulate(v, y, gain, mod0 + (size_t)cr * NMOD + 0 * DM, mod0 + (size_t)cr * NMOD + 1 * DM, lane);
        row_store_bf16(A + (size_t)row * DM, y, lane);
        if (!more) break;
#pragma unroll
        for (int j = 0; j < 8; ++j) v[j] = vn[j];
        row = nrow;
    }
}
DI float reduce8(const float (&v)[8], int lane) {
    const bool u0 = lane & 1, u1 = lane & 2, u2 = lane & 4;
    float a[4], b2[2];
#pragma unroll
    for (int k = 0; k < 4; ++k) { const float lo = v[2 * k], hi = v[2 * k + 1]; a[k] = (u0 ? hi : lo) + __shfl_xor(u0 ? lo : hi, 1); }
#pragma unroll
    for (int k = 0; k < 2; ++k) { const float lo = a[2 * k], hi = a[2 * k + 1]; b2[k] = (u1 ? hi : lo) + __shfl_xor(u1 ? lo : hi, 2); }
    return (u2 ? b2[1] : b2[0]) + __shfl_xor(u2 ? b2[0] : b2[1], 4);
}
DI float reduce_halves(float lo8, float hi8, int lane) {
    const bool u3 = lane & 8;
    float t = (u3 ? hi8 : lo8) + __shfl_xor(u3 ? lo8 : hi8, 8);
    t += __shfl_xor(t, 16); t += __shfl_xor(t, 32); return t;
}
DI float softmax16(float lg) {
    float mx = lg;
#pragma unroll
    for (int o = 1; o < 16; o <<= 1) mx = fmaxf(mx, __shfl_xor(mx, o));
    const float ex = __expf(lg - mx); float den = ex;
#pragma unroll
    for (int o = 1; o < 16; o <<= 1) den += __shfl_xor(den, o);
    return ex / den;
}
DI void aff_store(float v, float* affL, float* affC, int row, int lane) {
    if (lane < 16) { if (row < ML) { const int b = row >> 11, n = row & 2047; affL[(size_t)(b * 16 + lane) * SEQ + n] = v; }
                     else { const int rc = row - ML, b = rc >> 8, n = rc & 255; affC[(size_t)(b * 16 + lane) * CTXL + n] = v; } }
}
DI void router_rows2(const f32x4 (&y0)[8], const f32x4 (&y1)[8], const LAS float* rwT, float* affL, float* affC, int row0, int lane) {
    f32x2 yp[8][4];
#pragma unroll
    for (int j = 0; j < 8; ++j)
#pragma unroll
        for (int q = 0; q < 4; ++q) yp[j][q] = (f32x2){y0[j][q], y1[j][q]};
    float r0[2], r1[2];
#pragma unroll
    for (int hf = 0; hf < 2; ++hf) {
        float l0[8], l1[8];
#pragma unroll
        for (int e = 0; e < 8; ++e) { f32x2 acc = (f32x2){0.f, 0.f};
#pragma unroll
            for (int j = 0; j < 8; ++j) { const f32x4 w = *(const LAS f32x4*)(rwT + (8 * hf + e) * DM + 4 * lane + 256 * j);
#pragma unroll
                for (int q = 0; q < 4; ++q) acc = __builtin_elementwise_fma(yp[j][q], (f32x2){w[q], w[q]}, acc); }
            l0[e] = acc.x; l1[e] = acc.y; __builtin_amdgcn_sched_barrier(0); }
        r0[hf] = reduce8(l0, lane); r1[hf] = reduce8(l1, lane);
    }
    const float a0 = softmax16(reduce_halves(r0[0], r0[1], lane)), a1 = softmax16(reduce_halves(r1[0], r1[1], lane));
    aff_store(a0, affL, affC, row0, lane); aff_store(a1, affL, affC, row0 + 1, lane);
}
DI void ph_rwt(const float* rw, float* rwT, int gtid, int GT) {
    for (int i = gtid; i < 2 * 16 * DM; i += GT) { const int l = i >> 15, e = (i >> 11) & 15, d = i & (DM - 1); rwT[i] = rw[(size_t)l * DM * 16 + d * 16 + e]; }
}
DI void load_router(const float* rwT_g, LAS float* rwT, int tid) {
    for (int i = tid; i < DM * 16 / 4; i += 512) ((LAS f32x4*)rwT)[i] = ((const f32x4*)rwT_g)[i];
    __syncthreads();
}
DI void ph_modffn(const bf16_t* H, const float* gain, const float* modl, bf16_t* A, const LAS float* rwT, float* affL, float* affC, int nrows, int gw, int NGW, int lane) {
    int rp = gw; if (rp >= nrows / 2) return;
    u32x2 p0[8], p1[8];
#define MODFFN_LOAD(rp_) do { const int row_ = 2 * (rp_); _Pragma("unroll") for (int j = 0; j < 8; ++j) { p0[j] = *(const u32x2*)(H + (size_t)row_ * DM + 4 * lane + 256 * j); p1[j] = *(const u32x2*)(H + (size_t)(row_ + 1) * DM + 4 * lane + 256 * j); } } while (0)
    MODFFN_LOAD(rp);
    for (;;) {
        const int row = 2 * rp; const int cr = row < ML ? (row >> 11) : 8;
        float s0 = 0.f, s1 = 0.f;
#pragma unroll
        for (int j = 0; j < 8; ++j) { const float a0 = bf_lo(p0[j].x), a1 = bf_hi(p0[j].x), a2 = bf_lo(p0[j].y), a3 = bf_hi(p0[j].y); s0 += (a0 * a0 + a1 * a1) + (a2 * a2 + a3 * a3);
                                      const float b0 = bf_lo(p1[j].x), b1 = bf_hi(p1[j].x), b2 = bf_lo(p1[j].y), b3 = bf_hi(p1[j].y); s1 += (b0 * b0 + b1 * b1) + (b2 * b2 + b3 * b3); }
        s0 = wave_sum(s0); s1 = wave_sum(s1);
        const float r0 = 1.0f / sqrtf(s0 * (1.0f / DM) + NORM_EPS), r1 = 1.0f / sqrtf(s1 * (1.0f / DM) + NORM_EPS);
        const float* shift = modl + (size_t)cr * NMOD + 3 * DM; const float* scale = modl + (size_t)cr * NMOD + 4 * DM;
        f32x4 y0[8], y1[8];
#pragma unroll
        for (int j = 0; j < 8; ++j) { const int c = 4 * lane + 256 * j; const f32x4 g = *(const f32x4*)(gain + c), sh = *(const f32x4*)(shift + c), sc = *(const f32x4*)(scale + c);
            const f32x4 v0 = (f32x4){bf_lo(p0[j].x), bf_hi(p0[j].x), bf_lo(p0[j].y), bf_hi(p0[j].y)}, v1 = (f32x4){bf_lo(p1[j].x), bf_hi(p1[j].x), bf_lo(p1[j].y), bf_hi(p1[j].y)};
            y0[j] = ((v0 * r0) * g) * (sc + 1.0f) + sh; y1[j] = ((v1 * r1) * g) * (sc + 1.0f) + sh;
            *(unsigned*)((unsigned char*)A + (size_t)row * DM + c) = pk4_fp8(y0[j][0], y0[j][1], y0[j][2], y0[j][3]);
            *(unsigned*)((unsigned char*)A + (size_t)(row + 1) * DM + c) = pk4_fp8(y1[j][0], y1[j][1], y1[j][2], y1[j][3]); }
        const int nrp = rp + NGW; const bool more = nrp < nrows / 2;
        if (more) MODFFN_LOAD(nrp);
        asm volatile("" ::: "memory");
        router_rows2(y0, y1, rwT, affL, affC, row, lane);
        if (!more) break;
        rp = nrp;
    }
#undef MODFFN_LOAD
}
DI void ph_topk(int nitems, const float* affL, const float* affC, int* rowsrc, float* gatev, int* inv, LAS unsigned* hist, int tid, int lane, int wave, int bid, int G) {
    LAS unsigned* sh = hist + 256;
    for (int it = bid; it < nitems; it += G) {
        const bool isc = it >= 128; const int be = it & 127, b = be >> 4, e = be & 15;
        const int N = isc ? CTXL : SEQ, C = isc ? CAPC : CAPL;
        const float* src = isc ? affC + (size_t)be * CTXL : affL + (size_t)be * SEQ;
        const int i0 = tid * 4; const bool valid = i0 < N;
        unsigned key[4];
        { f32x4 v = (f32x4){0.f, 0.f, 0.f, 0.f}; if (valid) v = *(const f32x4*)(src + i0);
#pragma unroll
          for (int q = 0; q < 4; ++q) key[q] = __float_as_uint(v[q]); }
        unsigned prefix = 0u, mask = 0u, krem = (unsigned)C;
        for (int pass = 3; pass >= 0; --pass) {
            const int shift = pass * 8;
            if (tid < 256) hist[tid] = 0u;
            __syncthreads();
            if (valid) {
#pragma unroll
                for (int q = 0; q < 4; ++q) if ((key[q] & mask) == prefix) __hip_atomic_fetch_add(&hist[(key[q] >> shift) & 255u], 1u, __ATOMIC_RELAXED, __HIP_MEMORY_SCOPE_WORKGROUP); }
            __syncthreads();
            if (wave == 0) {
                const unsigned h0 = hist[4 * lane], h1 = hist[4 * lane + 1], h2 = hist[4 * lane + 2], h3 = hist[4 * lane + 3];
                const unsigned tot = h0 + h1 + h2 + h3; unsigned incl = tot;
#pragma unroll
                for (int o = 1; o < 64; o <<= 1) { const unsigned t = __shfl_down(incl, o); if (lane + o < 64) incl += t; }
                const unsigned a3 = incl - tot, a2 = a3 + h3, a1 = a2 + h2, a0 = a1 + h1;
                if (a3 < krem && krem <= a3 + h3) { sh[0] = 4 * lane + 3; sh[1] = krem - a3; }
                if (a2 < krem && krem <= a2 + h2) { sh[0] = 4 * lane + 2; sh[1] = krem - a2; }
                if (a1 < krem && krem <= a1 + h1) { sh[0] = 4 * lane + 1; sh[1] = krem - a1; }
                if (a0 < krem && krem <= a0 + h0) { sh[0] = 4 * lane + 0; sh[1] = krem - a0; }
            }
            __syncthreads();
            const unsigned B = sh[0]; krem = sh[1]; prefix |= B << shift; mask |= 0xFFu << shift;
        }
        const unsigned T = prefix;
        unsigned cg = 0u, ce = 0u;
        if (valid) {
#pragma unroll
            for (int q = 0; q < 4; ++q) { cg += key[q] > T ? 1u : 0u; ce += key[q] == T ? 1u : 0u; } }
        const unsigned mine = cg | (ce << 16); unsigned incl = mine;
#pragma unroll
        for (int o = 1; o < 64; o <<= 1) { const unsigned t = __shfl_up(incl, o); if (lane >= o) incl += t; }
        if (lane == 63) sh[8 + wave] = incl;
        __syncthreads();
        unsigned woff = 0u;
#pragma unroll
        for (int w = 0; w < 8; ++w) woff += (w < wave) ? sh[8 + w] : 0u;
        const unsigned excl = woff + incl - mine; unsigned gtb = excl & 0xFFFFu, eqb = excl >> 16;
        if (valid) {
            const int ybase = e * YR + (isc ? NB * CAPL + b * CAPC : b * CAPL); const int rbase = isc ? ML + b * CTXL : b * SEQ;
#pragma unroll
            for (int q = 0; q < 4; ++q) {
                const bool isg = key[q] > T, ise = key[q] == T; const bool sel = isg || (ise && eqb < krem);
                const unsigned slot = gtb + (eqb < krem ? eqb : krem);
                const int trow = rbase + i0 + q; const int yrow = ybase + (int)slot;
                if (sel) { rowsrc[yrow] = trow; gatev[yrow] = __uint_as_float(key[q]); }
                inv[(size_t)trow * 16 + e] = sel ? yrow : -1;
                gtb += isg ? 1u : 0u; eqb += ise ? 1u : 0u;
            }
        }
        __syncthreads();
    }
}
template <bool LAST> DI void ph_combine(bf16_t* H, const bf16_t* Y, const int* inv, const float* modl  , const float* gain1, const float* mod1, bf16_t* A, float* out, int nrows, int gw, int NGW, int lane) {
    int row = gw; if (row >= nrows) return;
    u32x2 hp[8], hn[8]; int myinv, ninv = -1;
#define CMB_LOAD(HP, IV, row_) do { _Pragma("unroll") for (int j = 0; j < 8; ++j) HP[j] = *(const u32x2*)(H + (size_t)(row_) * DM + 4 * lane + 256 * j); IV = inv[(size_t)(row_) * 16 + (lane & 15)]; } while (0)
    CMB_LOAD(hp, myinv, row);
    for (;;) {
        const int nrow = row + NGW; const bool more = nrow < nrows;
        if (more) CMB_LOAD(hn, ninv, nrow);
        const int cr = row < ML ? (row >> 11) : 8;
        f32x4 acc[8];
#pragma unroll
        for (int j = 0; j < 8; ++j) acc[j] = (f32x4){0.f, 0.f, 0.f, 0.f};
        unsigned m = (unsigned)(__ballot(myinv >= 0) & 0xFFFFull);
        while (m) {
            const int e1 = __builtin_ctz(m); m &= m - 1; const bool two = m != 0u; const int e2 = two ? __builtin_ctz(m) : e1; if (two) m &= m - 1;
            const bf16_t* y1 = Y + (size_t)__builtin_amdgcn_readlane(myinv, e1) * DM + 4 * lane; const bf16_t* y2 = Y + (size_t)__builtin_amdgcn_readlane(myinv, e2) * DM + 4 * lane;
            u32x2 q1[8], q2[8];
#pragma unroll
            for (int j = 0; j < 8; ++j) { q1[j] = *(const u32x2*)(y1 + 256 * j); q2[j] = *(const u32x2*)(y2 + 256 * j); }
            const float f2 = two ? 1.0f : 0.0f;
#pragma unroll
            for (int j = 0; j < 8; ++j) { acc[j][0] += bf_lo(q1[j].x) + f2 * bf_lo(q2[j].x); acc[j][1] += bf_hi(q1[j].x) + f2 * bf_hi(q2[j].x); acc[j][2] += bf_lo(q1[j].y) + f2 * bf_lo(q2[j].y); acc[j][3] += bf_hi(q1[j].y) + f2 * bf_hi(q2[j].y); }
        }
        const float* g2 = modl + (size_t)cr * NMOD + 5 * DM;
        f32x4 v[8];
#pragma unroll
        for (int j = 0; j < 8; ++j) { const f32x4 g = *(const f32x4*)(g2 + 4 * lane + 256 * j); const f32x4 h = (f32x4){bf_lo(hp[j].x), bf_hi(hp[j].x), bf_lo(hp[j].y), bf_hi(hp[j].y)}; v[j] = h + g * acc[j]; }
        if (LAST) {
#pragma unroll
            for (int j = 0; j < 8; ++j) *(f32x4*)(out + (size_t)row * DM + 4 * lane + 256 * j) = v[j];
        } else {
            row_store_bf16(H + (size_t)row * DM, v, lane);
            f32x4 y[8]; row_modulate(v, y, gain1, mod1 + (size_t)cr * NMOD + 0 * DM, mod1 + (size_t)cr * NMOD + 1 * DM, lane);
            row_store_bf16(A + (size_t)row * DM, y, lane);
        }
        if (!more) break;
#pragma unroll
        for (int j = 0; j < 8; ++j) hp[j] = hn[j];
        myinv = ninv; row = nrow;
    }
#undef CMB_LOAD
}
constexpr int KP = 272;
constexpr int VP = 288;
constexpr int ATT_VOFF = 64 * KP;
constexpr int ATT_TILE = 64 * KP + 64 * VP;
constexpr int ATT_OST = 2 * ATT_TILE;
DI float xhalf_max(float v) { auto rr = __builtin_amdgcn_permlane32_swap(__float_as_uint(v), __float_as_uint(v), false, false); return fmaxf(__uint_as_float(rr[0]), __uint_as_float(rr[1])); }
DI float xhalf_sum(float v) { auto rr = __builtin_amdgcn_permlane32_swap(__float_as_uint(v), __float_as_uint(v), false, false); return __uint_as_float(rr[0]) + __uint_as_float(rr[1]); }
DI int crow(int reg, int h) { return (reg & 3) + 8 * (reg >> 2) + 4 * h; }
DI long long vtr64(const LAS unsigned char* p) { typedef short v4i16_t __attribute__((ext_vector_type(4))); return __builtin_bit_cast(long long, __builtin_amdgcn_ds_read_tr16_b64_v4i16((LAS v4i16_t*)p)); }
DI s16x4 vtr(const LAS unsigned char* p) { typedef short v4i16_t __attribute__((ext_vector_type(4))); return __builtin_bit_cast(s16x4, __builtin_amdgcn_ds_read_tr16_b64_v4i16((LAS v4i16_t*)p)); }
DI bool att_tile_info(int item, int ti, int& base, int& mtype) {
    const int qhalf = item & 1, n = (item >> 3) & 15, b = item >> 7, tt = ti & 1; mtype = 0;
    if (ti < 4) { base = ML + b * CTXL + 64 * ti; return true; }
    const int blk = n - 1 + ((ti - 4) >> 1); if (blk < 0 || blk > 15) return false;
    if (ti < 6) { mtype = 1; if (tt == 0 && qhalf == 1) return false; } else if (ti >= 8) { mtype = 2; if (tt == 1 && qhalf == 0) return false; }
    base = b * SEQ + blk * 128 + 64 * tt; return true;
}
DI void att_next(int& item, int& ti, int G) { for (;;) { ++ti; if (ti >= 10) { ti = 0; item += G; return; } int b_, m_; if (att_tile_info(item, ti, b_, m_)) return; } }
DI void ph_attn(const bf16_t* Q, const bf16_t* Kb, const bf16_t* Vb, bf16_t* O, const float* sink, LAS unsigned char* lds, int tid, int lane, int wave, int bid, int G) {
    constexpr float LOG2E = 1.4426950408889634f;
    const int r = lane & 31, h = lane >> 5, g = wave >> 1, sub = wave & 1;
    const int ldrow = tid >> 3, ldc = tid & 7;
    int item = bid, ti = 0; if (item >= 1024) return;
    u32x4 kr[2], vr[2];
#define ATT_ISSUE(it_, ti_) do { int base_, mt_; att_tile_info(it_, ti_, base_, mt_); const int kvh_ = ((it_) >> 1) & 3; \
        _Pragma("unroll") for (int c2 = 0; c2 < 2; ++c2) { const size_t off_ = (size_t)(base_ + ldrow) * 512 + kvh_ * HD + (ldc + 8 * c2) * 8; kr[c2] = *(const u32x4*)(Kb + off_); vr[c2] = *(const u32x4*)(Vb + off_); } } while (0)
    bf16x8 qf[8]; float m2 = 0.f, lsum = 1.f; f32x16 o[4]; f32x16 negm;
#define ATT_QLOAD(it_) do { const int qrow_ = ((it_) >> 7) * SEQ + (((it_) >> 3) & 15) * 128 + ((it_) & 1) * 64 + sub * 32 + r; const int head_ = (((it_) >> 1) & 3) * 4 + g; \
        _Pragma("unroll") for (int s = 0; s < 8; ++s) qf[s] = *(const bf16x8*)(Q + (size_t)qrow_ * DM + head_ * HD + 16 * s + 8 * h); } while (0)
    ATT_QLOAD(item);
    ATT_ISSUE(item, ti);
    int buf = 0;
    while (item < 1024) {
        int nitem = item, nti = ti; att_next(nitem, nti, G);
        LAS unsigned char* tb = lds + buf * ATT_TILE;
#pragma unroll
        for (int c2 = 0; c2 < 2; ++c2) { *(LAS u32x4*)(tb + ldrow * KP + (ldc + 8 * c2) * 16) = kr[c2]; *(LAS u32x4*)(tb + ATT_VOFF + ldrow * VP + (ldc + 8 * c2) * 16) = vr[c2]; }
        if (nitem < 1024) ATT_ISSUE(nitem, nti);
        asm volatile("s_waitcnt lgkmcnt(0)" ::: "memory"); __builtin_amdgcn_s_barrier(); asm volatile("" ::: "memory");
        int base, mtype; att_tile_info(item, ti, base, mtype); const int tt = ti & 1;
        const int qhalf = item & 1, kvh = (item >> 1) & 3, n = (item >> 3) & 15, b = item >> 7;
        const int head = kvh * 4 + g, qq = qhalf * 64 + sub * 32 + r; const int qrow = b * SEQ + n * 128 + qq;
        if (ti == 0) {
            m2 = sink[head] * LOG2E; lsum = 1.0f;
#pragma unroll
            for (int i = 0; i < 16; ++i) negm[i] = -m2;
#pragma unroll
            for (int d = 0; d < 4; ++d)
#pragma unroll
                for (int i = 0; i < 16; ++i) o[d][i] = 0.f;
        }
        f32x16 x0, x1;
#pragma unroll
        for (int s = 0; s < 8; ++s) {
            const bf16x8 k0 = *(const LAS bf16x8*)(tb + r * KP + (16 * s + 8 * h) * 2), k1 = *(const LAS bf16x8*)(tb + (32 + r) * KP + (16 * s + 8 * h) * 2);
            if (s == 0) { x0 = __builtin_amdgcn_mfma_f32_32x32x16_bf16(k0, qf[s], negm, 0, 0, 0); x1 = __builtin_amdgcn_mfma_f32_32x32x16_bf16(k1, qf[s], negm, 0, 0, 0); }
            else { x0 = __builtin_amdgcn_mfma_f32_32x32x16_bf16(k0, qf[s], x0, 0, 0, 0); x1 = __builtin_amdgcn_mfma_f32_32x32x16_bf16(k1, qf[s], x1, 0, 0, 0); } }
        if (nitem != item && nitem < 1024) ATT_QLOAD(nitem);
        if (mtype == 1) {
#pragma unroll
            for (int i = 0; i < 16; ++i) { const int kk0 = tt * 64 + crow(i, h); if (kk0 < qq) x0[i] = -1.0e30f; if (kk0 + 32 < qq) x1[i] = -1.0e30f; } }
        if (mtype == 2) {
#pragma unroll
            for (int i = 0; i < 16; ++i) { const int kk0 = tt * 64 + crow(i, h); if (kk0 > qq) x0[i] = -1.0e30f; if (kk0 + 32 > qq) x1[i] = -1.0e30f; } }
        float tmax = fmaxf(x0[0], x1[0]);
#pragma unroll
        for (int i = 1; i < 16; ++i) tmax = fmaxf(fmaxf(tmax, x0[i]), x1[i]);
        tmax = xhalf_max(tmax);
        if (__any(tmax > 0.0f)) {
            const float dl = fmaxf(tmax, 0.0f), alpha = __builtin_amdgcn_exp2f(-dl); m2 += dl; lsum *= alpha;
#pragma unroll
            for (int i = 0; i < 16; ++i) { x0[i] -= dl; x1[i] -= dl; negm[i] = -m2; }
#pragma unroll
            for (int d = 0; d < 4; ++d)
#pragma unroll
                for (int i = 0; i < 16; ++i) o[d][i] *= alpha;
        }
        float ps = 0.f;
#pragma unroll
        for (int i = 0; i < 16; ++i) { x0[i] = __builtin_amdgcn_exp2f(x0[i]); x1[i] = __builtin_amdgcn_exp2f(x1[i]); ps += x0[i] + x1[i]; }
        lsum += xhalf_sum(ps);
        bf16x8 pf[2][2];
#pragma unroll
        for (int s = 0; s < 2; ++s) {
            u32x4 a, c; a.x = pk2(x0[8 * s + 0], x0[8 * s + 1]); a.y = pk2(x0[8 * s + 2], x0[8 * s + 3]); a.z = pk2(x0[8 * s + 4], x0[8 * s + 5]); a.w = pk2(x0[8 * s + 6], x0[8 * s + 7]);
            c.x = pk2(x1[8 * s + 0], x1[8 * s + 1]); c.y = pk2(x1[8 * s + 2], x1[8 * s + 3]); c.z = pk2(x1[8 * s + 4], x1[8 * s + 5]); c.w = pk2(x1[8 * s + 6], x1[8 * s + 7]);
            pf[0][s] = __builtin_bit_cast(bf16x8, a); pf[1][s] = __builtin_bit_cast(bf16x8, c); }
        const LAS unsigned char* vb = tb + ATT_VOFF + (4 * h + ((lane & 15) >> 2)) * VP + (16 * ((lane >> 4) & 1) + 4 * (lane & 3)) * 2;
#pragma unroll
        for (int d = 0; d < 4; ++d)
#pragma unroll
            for (int t = 0; t < 2; ++t)
#pragma unroll
                for (int s = 0; s < 2; ++s) {
                    typedef long long i64x2_t __attribute__((ext_vector_type(2)));
                    i64x2_t vv; vv.x = vtr64(vb + (t * 32 + 16 * s) * VP + d * 64); vv.y = vtr64(vb + (t * 32 + 16 * s + 8) * VP + d * 64);
                    const bf16x8 vf = __builtin_bit_cast(bf16x8, vv);
                    o[d] = __builtin_amdgcn_mfma_f32_32x32x16_bf16(vf, pf[t][s], o[d], 0, 0, 0); }
        if (nitem != item) {
            const float il = 1.0f / lsum;
            LAS unsigned char* st = lds + ATT_OST + wave * (32 * KP);
#pragma unroll
            for (int d = 0; d < 4; ++d)
#pragma unroll
                for (int g4 = 0; g4 < 4; ++g4) { u32x2 w; w.x = pk2(o[d][4 * g4 + 0] * il, o[d][4 * g4 + 1] * il); w.y = pk2(o[d][4 * g4 + 2] * il, o[d][4 * g4 + 3] * il);
                    *(LAS u32x2*)(st + r * KP + (d * 32 + 8 * g4 + 4 * h) * 2) = w; }
            asm volatile("s_waitcnt lgkmcnt(0)" ::: "memory");
            bf16_t* ob = O + (size_t)(qrow - r) * DM + head * HD;
#pragma unroll
            for (int j = 0; j < 8; ++j) { const int c = lane + 64 * j, row = c >> 4, c16 = c & 15;
                const u32x4 v = *(const LAS u32x4*)(st + row * KP + c16 * 16); *(u32x4*)(ob + (size_t)row * DM + c16 * 8) = v; }
        }
        item = nitem; ti = nti; buf ^= 1;
    }
#undef ATT_ISSUE
#undef ATT_QLOAD
}
#ifndef MK_ONE_LAUNCH
#define MK_ONE_LAUNCH 1
#endif
constexpr int NPHASE = 19;
constexpr int CVT_X0_END = CVT_E0 + CVT_L;
#define CVT_MKCP() CvtPtrs CP; CP.cin = args.in[8]; CP.cout = args.in[10]; CP.wqkv = args.in[11]; CP.wo = args.in[15]; CP.wg = args.in[17]; CP.wu = args.in[18]; CP.wd = args.in[19]; \
    CP.W1A = W1A; CP.W1B = W1B; CP.W2 = W2; CP.WQKV = WQKV; CP.WO = WOt; CP.WGU = WGU; CP.WDN = WDN
#define CVT(LO, HI) do { CVT_MKCP(); cvt_range(CP, LO, HI, gw, NGW, cscr, lane); } while (0)
#ifndef MK_DUP_MASK
#define MK_DUP_MASK 0u
#endif
constexpr unsigned DUP_MASK = MK_DUP_MASK;
struct Args { const float* in[20]; float* out; unsigned char* ws; int ph_lo, ph_hi; };
__global__ void __launch_bounds__(512, 2) dit_fwd(Args args) {
    extern __shared__ __attribute__((aligned(16))) unsigned char lds_raw[];
    LAS unsigned char* lds = (LAS unsigned char*)lds_raw;
    const int tid = threadIdx.x, lane = tid & 63, wave = __builtin_amdgcn_readfirstlane(tid >> 6);
    const int G = gridDim.x, bid = blockIdx.x;
    const int gw = bid * 8 + wave, NGW = G * 8;
    unsigned char* ws = args.ws;
    const float* x = args.in[0]; const float* cnd = args.in[1]; const float* ctx = args.in[2]; const float* cctx = args.in[3];
    const float* ada_w = args.in[4]; const float* ada_b = args.in[5]; const float* nmix = args.in[6]; const float* nffn = args.in[7];
    const float* conv_w = args.in[9]; const float* qgain = args.in[12]; const float* kgain = args.in[13]; const float* sink = args.in[14]; const float* router_w = args.in[16];
    float* mod = (float*)(ws + WS_MOD); float* modp = (float*)(ws + WS_MODP);
    float* affL = (float*)(ws + WS_AFFL); float* affC = (float*)(ws + WS_AFFC);
    float* rwt = (float*)(ws + WS_RWT);
    int* idmap = (int*)(ws + WS_IDMAP);
    int* rowsrc = (int*)(ws + WS_ROWSRC); float* gatev = (float*)(ws + WS_GATEV); int* inv = (int*)(ws + WS_INV);
    bf16_t* W1A = (bf16_t*)(ws + WS_W1A); bf16_t* W1B = (bf16_t*)(ws + WS_W1B); bf16_t* W2 = (bf16_t*)(ws + WS_W2); bf16_t* WQKV = (bf16_t*)(ws + WS_WQKV); bf16_t* WOt = (bf16_t*)(ws + WS_WO);
    bf16_t* WGU = (bf16_t*)(ws + WS_WGU); bf16_t* WDN = (bf16_t*)(ws + WS_WDN);
    bf16_t* H = (bf16_t*)(ws + WS_H); bf16_t* A = (bf16_t*)(ws + WS_A); bf16_t* U = (bf16_t*)(ws + WS_U); bf16_t* Z = (bf16_t*)(ws + WS_Z);
    bf16_t* Qb = (bf16_t*)(ws + WS_Q); bf16_t* Kb = (bf16_t*)(ws + WS_K); bf16_t* Vb = (bf16_t*)(ws + WS_V); bf16_t* Ob = (bf16_t*)(ws + WS_O);
    bf16_t* HM = (bf16_t*)(ws + WS_HM); bf16_t* Y = (bf16_t*)(ws + WS_Y);
    LAS unsigned* cscr = (LAS unsigned*)(lds + wave * 9216);

    for (int u = tid; u < (LDS_BYTES - MISC_OFF) / 4; u += 512) ((LAS unsigned*)(lds + MISC_OFF))[u] = 0u;
    __syncthreads();
#if MK_ONE_LAUNCH
    XcdBarrier bar = xcd_barrier_post((unsigned*)(ws + WS_CTL) + CW_BAR, (volatile LAS unsigned*)(lds + MISC_OFF) + 8);
#define GRID_BAR() xcd_barrier(bar)
#else
#define GRID_BAR() do {} while (0)
#endif
    const int lo = args.ph_lo, hi = args.ph_hi;
#define IN(k) (lo <= (k) && (k) < hi)
#define SEAM(k) do { if (IN(k) && IN((k) + 1)) GRID_BAR(); } while (0)
#define PHASE(k) if (IN(k)) _Pragma("unroll") for (int rep_ = 0; rep_ < 1 + (int)((DUP_MASK >> (k)) & 1u); ++rep_)
#define REP_BAR() do { if (rep_) GRID_BAR(); } while (0)

    PHASE(0) { REP_BAR(); ph_adaln(cnd, cctx, ada_w, modp, gw, NGW, lane); } SEAM(0);
    PHASE(1) { REP_BAR(); ph_modred(modp, ada_b, mod, bid * 512 + tid, G * 512); ph_rwt(router_w, rwt, bid * 512 + tid, G * 512); for (int i = bid * 512 + tid; i < YT; i += G * 512) idmap[i] = i; } SEAM(1);
    PHASE(2) { REP_BAR(); ph_mod0(x, ctx, nmix, mod, A, gw, NGW, lane); CVT(0, 4096); } SEAM(2);
    PHASE(3) { REP_BAR();
        pg8::Gemm g{A, W1A, MT, 4096, DM}; pg8::StaticOrder S; S.init(MT, 4096, G, bid);
        EpiPair<0> E{U, DM, 16};
        pg8::gemm_phase<EpiPair<0>, pg8::StaticOrder, true, true>(lds, g, S, E);
    } SEAM(3);
    PHASE(4) { REP_BAR();
        pg8::Gemm g{A, W1B, MT, DM, DM}; pg8::StaticOrder S; S.init(MT, DM, G, bid);
        EpiConvGate E{U, Z, conv_w};
        pg8::gemm_phase<EpiConvGate, pg8::StaticOrder, true, true>(lds, g, S, E);
    } SEAM(4);
    PHASE(5) { REP_BAR();
        pg8::Gemm g{Z, W2, MT, DM, DM}; pg8::StaticOrder S; S.init(MT, DM, G, bid);
        EpiResid<true> E{x, ctx, H, mod + 2 * DM};
        pg8::gemm_phase<EpiResid<true>, pg8::StaticOrder, true, true>(lds, g, S, E);
    } SEAM(5);
    PHASE(6) { REP_BAR(); load_router(rwt, (LAS float*)lds, tid); ph_modffn(H, nffn, mod, A, (const LAS float*)lds, affL, affC, MT, gw, NGW, lane); } SEAM(6);
    PHASE(7) { REP_BAR(); ph_topk(256, affL, affC, rowsrc, gatev, inv, (LAS unsigned*)lds, tid, lane, wave, bid, G); CVT(CVT_E0, CVT_E0 + 16384); } SEAM(7);
    PHASE(8) { REP_BAR();
        pg8::Gemm g{A, WGU, YT, NE * 2048, DM / 2, rowsrc}; MoeOrder S{G, bid, 9};
        EpiPairF8 E{(unsigned char*)HM, DFF, 8};
        pg8::gemm_phase<EpiPairF8, MoeOrder, true, true, true, true>(lds, g, S, E);
        CVT(CVT_E0 + 16384, CVT_X0_END);
    } SEAM(8);
    PHASE(9) { REP_BAR();
        pg8::Gemm g{HM, WDN, YT, NE * 2048, DFF / 2, idmap}; MoeOrder S{G, bid, 9};
        EpiDown E{Y, gatev, W8_INV};
        pg8::gemm_phase<EpiDown, MoeOrder, true, true, true, true>(lds, g, S, E);
    } SEAM(9);
    PHASE(10) { REP_BAR(); ph_combine<false>(H, Y, inv, mod, nmix + DM, mod + 9 * NMOD, A, nullptr, MT, gw, NGW, lane); CVT(4096, 4096 + 1536); } SEAM(10);
    PHASE(11) { REP_BAR();
        pg8::Gemm g{A, WQKV, MT, 3072, DM}; QkvOrder S{G, bid};
        EpiQkvNorm E{Qb, Kb, Vb, qgain, kgain, (LAS float*)(lds + RING_BYTES)};
        pg8::gemm_phase<EpiQkvNorm, QkvOrder, true, true>(lds, g, S, E);
    } SEAM(11);
    PHASE(12) { REP_BAR(); ph_attn(Qb, Kb, Vb, Ob, sink, lds, tid, lane, wave, bid, G); __syncthreads(); CVT(4096 + 1536, CVT_E0); } SEAM(12);
    PHASE(13) { REP_BAR();
        pg8::Gemm g{Ob, WOt, ML, DM, DM}; pg8::StaticOrder S; S.init(ML, DM, G, bid);
        EpiResid<false> E{nullptr, nullptr, H, mod + 9 * NMOD + 2 * DM};
        pg8::gemm_phase<EpiResid<false>, pg8::StaticOrder, true, true>(lds, g, S, E);
    } SEAM(13);
    PHASE(14) { REP_BAR(); load_router(rwt + DM * 16, (LAS float*)lds, tid); ph_modffn(H, nffn + DM, mod + 9 * NMOD, A, (const LAS float*)lds, affL, affC, ML, gw, NGW, lane); } SEAM(14);
    PHASE(15) { REP_BAR(); ph_topk(128, affL, affC, rowsrc, gatev, inv, (LAS unsigned*)lds, tid, lane, wave, bid, G); CVT(CVT_X0_END, CVT_X0_END + 16384); } SEAM(15);
    PHASE(16) { REP_BAR();
        pg8::Gemm g{A, (const bf16_t*)((const unsigned char*)WGU + (size_t)NE * 2048 * DM), YT, NE * 2048, DM / 2, rowsrc}; MoeOrder S{G, bid, 8};
        EpiPairF8 E{(unsigned char*)HM, DFF, 8};
        pg8::gemm_phase<EpiPairF8, MoeOrder, true, true, true, true>(lds, g, S, E);
        CVT(CVT_X0_END + 16384, CVT_TOTAL);
    } SEAM(16);
    PHASE(17) { REP_BAR();
        pg8::Gemm g{HM, (const bf16_t*)((const unsigned char*)WDN + (size_t)NE * 2048 * DFF), YT, NE * 2048, DFF / 2, idmap}; MoeOrder S{G, bid, 8};
        EpiDown E{Y, gatev, W8_INV};
        pg8::gemm_phase<EpiDown, MoeOrder, true, true, true, true>(lds, g, S, E);
    } SEAM(17);
    PHASE(18) { REP_BAR(); ph_combine<true>(H, Y, inv, mod + 9 * NMOD, nullptr, nullptr, nullptr, args.out, ML, gw, NGW, lane); }
#undef IN
#undef SEAM
#undef PHASE
#undef REP_BAR
}

extern "C" void kernel_launch(void* const* d_in, const int* in_sizes, int n_in, void* d_out, int out_size, void* d_ws, size_t ws_size, hipStream_t stream) {
    static int grid = 0;
    if (grid == 0) {
        if (n_in != 20 || out_size != ML * DM || ws_size < WS_END) { fprintf(stderr, "kernel_launch: unexpected problem (n_in %d, out %d, ws %zu); nothing launched\n", n_in, out_size, ws_size); grid = -1; return; }
        int dev = 0, cus = 0, per_cu = 0;
        if (hipGetDevice(&dev) != hipSuccess || hipDeviceGetAttribute(&cus, hipDeviceAttributeMultiprocessorCount, dev) != hipSuccess) { grid = -1; return; }
        if (hipFuncSetAttribute((const void*)dit_fwd, hipFuncAttributeMaxDynamicSharedMemorySize, LDS_BYTES) != hipSuccess) { fprintf(stderr, "kernel_launch: hipFuncSetAttribute failed\n"); grid = -1; return; }
        if (hipOccupancyMaxActiveBlocksPerMultiprocessor(&per_cu, (const void*)dit_fwd, 512, LDS_BYTES) != hipSuccess || per_cu < 1) fprintf(stderr, "kernel_launch: occupancy query reports %d workgroups per CU\n", per_cu);
        (void)hipGetLastError();
        grid = cus;
    }
    if (grid < 0) return;
    (void)hipMemsetAsync((char*)d_ws + WS_CTL, 0, CTL_ZERO_BYTES, stream);
    Args a{};
    for (int i = 0; i < 20; ++i) a.in[i] = (const float*)d_in[i];
    a.out = (float*)d_out; a.ws = (unsigned char*)d_ws;
#if MK_ONE_LAUNCH
    a.ph_lo = 0; a.ph_hi = NPHASE;
    hipLaunchKernelGGL(dit_fwd, dim3(grid), dim3(512), LDS_BYTES, stream, a);
#else
    for (int p = 0; p < NPHASE; ++p) { a.ph_lo = p; a.ph_hi = p + 1; hipLaunchKernelGGL(dit_fwd, dim3(grid), dim3(512), LDS_BYTES, stream, a); }
#endif
}
```

```cpp
#include <hip/hip_runtime.h>
#include <cstdio>
#include <cstdint>
namespace pg8 {
#define PG8_LAS __attribute__((address_space(3)))
typedef unsigned short bf16_t;
typedef short bf16x8 __attribute__((ext_vector_type(8)));
typedef float f32x4 __attribute__((ext_vector_type(4)));
typedef unsigned u32x4 __attribute__((ext_vector_type(4)));
constexpr int BM = 256, BK = 64, HALF = 128, HTB = HALF * BK * 2  , STAGE_BYTES = 8 * HTB, NXCD = 8, WGM = 8;

__host__ __device__ __forceinline__ int lds_byte(int r, int c) { const int st = (r >> 4) * 2 + (c >> 5), rr = r & 15, cc = c & 31, ob = rr * 64 + cc * 2; return st * 1024 + (ob ^ (((ob >> 9) & 1) << 5)); }
__host__ __device__ __forceinline__ void stage_rc(int b, int& R, int& C) { const int st = b / 1024, sb = b % 1024, swz = sb ^ (((sb >> 9) & 1) << 5); R = (st >> 1) * 16 + swz / 64; C = (st & 1) * 32 + (swz % 64) / 2; }
__host__ __device__ __forceinline__ int perm32(int rho) { const int n = rho >> 4, i = rho & 15; return 8 * (i >> 2) + 4 * n + (i & 3); }

struct Unit { int pm, pn; };
struct Gemm { const bf16_t* A; const bf16_t* Bt; int M, N, K; const int* rows = nullptr; };

struct StaticOrder {
    int nM, nN, nwg, G, c;
    __host__ __device__ void init(int M, int N, int G_, int c_) { nM = M / BM; nN = N / BM; nwg = nM * nN; G = G_; c = c_; }
    __host__ __device__ bool next(int i, Unit& u) const {
        const long L = (long)i * G + c; if (L >= nwg) return false;
        int wgid = (int)L; { const int q = nwg / NXCD, r = nwg % NXCD, xcd = wgid % NXCD, off = wgid / NXCD; wgid = (xcd < r ? xcd * (q + 1) : r * (q + 1) + (xcd - r) * q) + off; }
        const int nig = WGM * nN, gid = wgid / nig, fm = gid * WGM, gsz = (nM - fm) < WGM ? (nM - fm) : WGM;
        u.pm = fm + ((wgid % nig) % gsz); u.pn = (wgid % nig) / gsz; return true;
    }
    __device__ __forceinline__ void a_ready(const Unit&) const {}
    __device__ __forceinline__ void done(const Unit&) const {}
};
__device__ __forceinline__ unsigned cvt_pk_bf16(float lo, float hi) { unsigned r; asm volatile("v_cvt_pk_bf16_f32 %0, %1, %2" : "=v"(r) : "v"(lo), "v"(hi)); return r; }
typedef float f32x2 __attribute__((ext_vector_type(2)));
template <class Epi, class Sched, bool ALIGN_EPI = false, bool SP2 = false, bool GATHER = false, bool F8 = false>
__device__ __forceinline__ void gemm_phase(PG8_LAS unsigned char* lds, const Gemm g, const Sched& S, const Epi& E) {
    typedef int i32x4_t __attribute__((ext_vector_type(4)));
    const int tid = threadIdx.x, wid = __builtin_amdgcn_readfirstlane(tid >> 6), lane = tid & 63, wr = wid >> 2, wc = wid & 3, fr = lane & 15, fq = lane >> 4;
    const int K = g.K, nt = K / BK;
    unsigned voffA[2], voffB[2];
#pragma unroll
    for (int i = 0; i < 2; ++i) { int R, C; stage_rc(tid * 16 + i * 8192, R, C); const int Rb = Epi::PERM ? ((R & ~31) + perm32(R & 31)) : R;
        voffA[i] = (unsigned)(R * K + C) * 2u; voffB[i] = (unsigned)(Rb * K + C) * 2u; }
    const size_t kstep = (size_t)(BK * 2);
    const size_t hstep = (size_t)HALF * K * 2;
    const size_t tstep = 2 * hstep;
    const unsigned ldsw = (unsigned)wid * 1024u;
    const int aoff = lds_byte(wr * 64 + fr, fq * 8), boff = lds_byte(wc * 32 + fr, fq * 8);
#define PG8_SA(b, h) (((b) * 2 + (h)) * HTB)
#define PG8_SB(b, h) ((4 + (b) * 2 + (h)) * HTB)
#define PG8_UNI(p) ((const char*)(((unsigned long long)(unsigned)__builtin_amdgcn_readfirstlane((int)((unsigned long long)(p) >> 32)) << 32) | (unsigned long long)(unsigned)__builtin_amdgcn_readfirstlane((int)(unsigned long long)(p))))
#define PG8_STAGE(bufoff, gbase, voff) do { const char* gb_ = PG8_UNI(gbase);     \
        _Pragma("unroll") for (int _i = 0; _i < 2; ++_i) \
        __builtin_amdgcn_global_load_lds((const unsigned*)(gb_ + (voff)[_i]), (PG8_LAS unsigned*)(lds + (bufoff) + ldsw + _i * 8192), 16, 0, 0); } while (0)
#define PG8_STAGE_A(bufoff, kptr, h) do { if constexpr (GATHER) { PG8_STAGE(bufoff, kptr, vA[h]); } else { PG8_STAGE(bufoff, (kptr) + (h) * hstep, voffA); } } while (0)
#define PG8_GATHER_SWITCH() do { if constexpr (GATHER) { if (last && has_next) { asm volatile("" : "+v"(nv[0]), "+v"(nv[1]), "+v"(nv[2]), "+v"(nv[3])); \
        vA[0][0] = nv[0] * (unsigned)(K * 2) + gcoff[0]; vA[0][1] = nv[1] * (unsigned)(K * 2) + gcoff[1]; vA[1][0] = nv[2] * (unsigned)(K * 2) + gcoff[0]; vA[1][1] = nv[3] * (unsigned)(K * 2) + gcoff[1]; } } } while (0)
#define PG8_LDA(dst, b, h) do { _Pragma("unroll") for (int m = 0; m < 4; ++m) { if constexpr (F8) { dst##8[m] = PG8_CAT8(*(const PG8_LAS i32x4_t*)(lds + PG8_SA(b, h) + aoff + m * 2048), *(const PG8_LAS i32x4_t*)(lds + PG8_SA(b, h) + aoff + m * 2048 + 1024)); } \
        else { _Pragma("unroll") for (int k = 0; k < 2; ++k) dst[m][k] = *(const PG8_LAS bf16x8*)(lds + PG8_SA(b, h) + aoff + m * 2048 + k * 1024); } } } while (0)
#define PG8_LDB(dst, b, h) do { _Pragma("unroll") for (int n = 0; n < 2; ++n) { if constexpr (F8) { dst##8[n] = PG8_CAT8(*(const PG8_LAS i32x4_t*)(lds + PG8_SB(b, h) + boff + n * 2048), *(const PG8_LAS i32x4_t*)(lds + PG8_SB(b, h) + boff + n * 2048 + 1024)); } \
        else { _Pragma("unroll") for (int k = 0; k < 2; ++k) dst[n][k] = *(const PG8_LAS bf16x8*)(lds + PG8_SB(b, h) + boff + n * 2048 + k * 1024); } } } while (0)
#define PG8_CAT8(lo_, hi_) __builtin_shufflevector(lo_, hi_, 0, 1, 2, 3, 4, 5, 6, 7)
#define PG8_MMA(ai, bj, At, Bt) do { __builtin_amdgcn_s_setprio(1); _Pragma("unroll") for (int m = 0; m < 4; ++m) _Pragma("unroll") for (int n = 0; n < 2; ++n) { \
        if constexpr (F8) { acc[ai][bj][m][n] = __builtin_amdgcn_mfma_scale_f32_16x16x128_f8f6f4(Bt##8[n], At##8[m], acc[ai][bj][m][n], 0, 0, 0, 0x7f7f7f7f, 0, 0x7f7f7f7f); } \
        else { _Pragma("unroll") for (int k = 0; k < 2; ++k) acc[ai][bj][m][n] = __builtin_amdgcn_mfma_f32_16x16x32_bf16(Bt[n][k], At[m][k], acc[ai][bj][m][n], 0, 0, 0); } } \
        __builtin_amdgcn_s_setprio(0); } while (0)
#define PG8_WAIT_V(n) asm volatile("s_waitcnt vmcnt(" #n ")" ::: "memory")
#define PG8_WAIT_L(n) asm volatile("s_waitcnt lgkmcnt(" #n ")" ::: "memory")
#define PG8_BAR __builtin_amdgcn_s_barrier()
#define PG8_SCHED __builtin_amdgcn_sched_barrier(0)
    Unit cur, nxt; int ui = 0;
    if (!S.next(0, cur)) return;
    f32x4 acc[2][2][4][2];
#pragma unroll
    for (int a = 0; a < 2; ++a)
#pragma unroll
        for (int b = 0; b < 2; ++b)
#pragma unroll
            for (int m = 0; m < 4; ++m)
#pragma unroll
                for (int n = 0; n < 2; ++n) acc[a][b][m][n] = (f32x4){0.f, 0.f, 0.f, 0.f};
    bf16x8 At[4][2], B0[2][2], B1[2][2]; typedef int i32x8_t __attribute__((ext_vector_type(8))); i32x8_t At8[4], B08[2], B18[2];
    const char* cA = (const char*)g.A + (GATHER ? (size_t)0 : (size_t)cur.pm * tstep); const char* cB = (const char*)g.Bt + (size_t)cur.pn * tstep;
    unsigned vA[2][2], nv[4], gcoff[2]; int grow[2];
    if constexpr (GATHER) {
#pragma unroll
        for (int i = 0; i < 2; ++i) { int R, C; stage_rc(tid * 16 + i * 8192, R, C); grow[i] = R; gcoff[i] = (unsigned)(C * 2); }
#pragma unroll
        for (int h = 0; h < 2; ++h)
#pragma unroll
            for (int i = 0; i < 2; ++i) vA[h][i] = (unsigned)g.rows[cur.pm * BM + h * HALF + grow[i]] * (unsigned)(K * 2) + gcoff[i];
    }
    S.a_ready(cur);
    if constexpr (SP2) {
        PG8_STAGE(PG8_SB(0, 0), cB, voffB); PG8_STAGE(PG8_SB(0, 1), cB + hstep, voffB); PG8_STAGE_A(PG8_SA(0, 0), cA, 0); PG8_STAGE_A(PG8_SA(0, 1), cA, 1);
        if (wr == 1) PG8_BAR;
        PG8_WAIT_V(2); PG8_BAR;
        PG8_STAGE(PG8_SB(1, 0), cB + kstep, voffB); PG8_STAGE_A(PG8_SA(1, 0), cA + kstep, 0); PG8_STAGE(PG8_SB(1, 1), cB + hstep + kstep, voffB);
        PG8_WAIT_V(6); PG8_BAR;
    } else {
        PG8_STAGE(PG8_SB(0, 0), cB, voffB); PG8_STAGE_A(PG8_SA(0, 0), cA, 0); PG8_STAGE(PG8_SB(0, 1), cB + hstep, voffB); PG8_STAGE_A(PG8_SA(0, 1), cA, 1);
        if (wr == 1) PG8_BAR;
        PG8_WAIT_V(4); PG8_BAR;
        PG8_STAGE(PG8_SB(1, 0), cB + kstep, voffB); PG8_STAGE_A(PG8_SA(1, 0), cA + kstep, 0); PG8_STAGE(PG8_SB(1, 1), cB + hstep + kstep, voffB);
        PG8_WAIT_V(6); PG8_BAR;
    }
    for (;;) {
        const bool has_next = S.next(ui + 1, nxt);
        const char* nA = (has_next && !GATHER) ? (const char*)g.A + (size_t)nxt.pm * tstep : cA; const char* nB = has_next ? (const char*)g.Bt + (size_t)nxt.pn * tstep : cB;
        if constexpr (GATHER) { if (has_next) { const int* rp = g.rows + nxt.pm * BM;
            asm volatile("global_load_dword %0, %1, off" : "=&v"(nv[0]) : "v"(rp + grow[0]) : "memory"); asm volatile("global_load_dword %0, %1, off" : "=&v"(nv[1]) : "v"(rp + grow[1]) : "memory");
            asm volatile("global_load_dword %0, %1, off" : "=&v"(nv[2]) : "v"(rp + HALF + grow[0]) : "memory"); asm volatile("global_load_dword %0, %1, off" : "=&v"(nv[3]) : "v"(rp + HALF + grow[1]) : "memory"); } }
#pragma unroll 1
        for (int t = 0; t < nt; t += 2) {
            const bool last = (t == nt - 2);
            const char* a1 = cA + (size_t)(t + 1) * kstep;
            const char* a2 = last ? nA : cA + (size_t)(t + 2) * kstep; const char* b2 = last ? nB : cB + (size_t)(t + 2) * kstep;
            const char* a3 = a2 + kstep; const char* b3 = b2 + kstep;
            if (last && has_next) S.a_ready(nxt);
            if constexpr (SP2) {
            PG8_LDB(B0, 0, 0); PG8_LDB(B1, 0, 1); PG8_SCHED; PG8_LDA(At, 0, 0); PG8_STAGE_A(PG8_SA(1, 1), a1, 1); PG8_GATHER_SWITCH();
            PG8_WAIT_V(8); PG8_WAIT_L(0); PG8_BAR; PG8_MMA(0, 0, At, B0); PG8_MMA(0, 1, At, B1); PG8_BAR; PG8_SCHED;
            PG8_LDA(At, 0, 1); PG8_STAGE(PG8_SB(0, 0), b2, voffB); PG8_STAGE(PG8_SB(0, 1), b2 + hstep, voffB); PG8_STAGE_A(PG8_SA(0, 0), a2, 0);
            PG8_WAIT_V(8); PG8_WAIT_L(0); PG8_BAR; PG8_MMA(1, 0, At, B0); PG8_MMA(1, 1, At, B1); PG8_BAR; PG8_SCHED;
            PG8_LDB(B0, 1, 0); PG8_LDB(B1, 1, 1); PG8_SCHED; PG8_LDA(At, 1, 0); PG8_STAGE_A(PG8_SA(0, 1), a2, 1);
            PG8_WAIT_V(8); PG8_WAIT_L(0); PG8_BAR; PG8_MMA(0, 0, At, B0); PG8_MMA(0, 1, At, B1); PG8_BAR; PG8_SCHED;
            PG8_LDA(At, 1, 1); PG8_STAGE(PG8_SB(1, 0), b3, voffB); PG8_STAGE(PG8_SB(1, 1), b3 + hstep, voffB); PG8_STAGE_A(PG8_SA(1, 0), a3, 0);
            PG8_WAIT_V(8); PG8_WAIT_L(0); PG8_BAR; PG8_MMA(1, 0, At, B0); PG8_MMA(1, 1, At, B1); PG8_BAR; PG8_SCHED;
            } else {
            PG8_LDB(B0, 0, 0); PG8_SCHED; PG8_LDA(At, 0, 0); PG8_STAGE_A(PG8_SA(1, 1), a1, 1); PG8_GATHER_SWITCH();
            PG8_WAIT_L(8); PG8_BAR; PG8_WAIT_L(0); PG8_MMA(0, 0, At, B0); PG8_BAR; PG8_SCHED;
            PG8_LDB(B1, 0, 1); PG8_STAGE(PG8_SB(0, 0), b2, voffB);
            PG8_BAR; PG8_WAIT_L(0); PG8_MMA(0, 1, At, B1); PG8_BAR;
            PG8_LDA(At, 0, 1); PG8_STAGE_A(PG8_SA(0, 0), a2, 0);
            PG8_BAR; PG8_WAIT_L(0); PG8_MMA(1, 0, At, B0); PG8_BAR; PG8_SCHED;
            PG8_STAGE(PG8_SB(0, 1), b2 + hstep, voffB);
            PG8_WAIT_V(6); PG8_BAR; PG8_MMA(1, 1, At, B1); PG8_BAR;
            PG8_LDB(B0, 1, 0); PG8_SCHED; PG8_LDA(At, 1, 0); PG8_STAGE_A(PG8_SA(0, 1), a2, 1);
            PG8_WAIT_L(8); PG8_BAR; PG8_WAIT_L(0); PG8_MMA(0, 0, At, B0); PG8_BAR; PG8_SCHED;
            PG8_LDB(B1, 1, 1); PG8_STAGE(PG8_SB(1, 0), b3, voffB);
            PG8_BAR; PG8_WAIT_L(0); PG8_MMA(0, 1, At, B1); PG8_BAR;
            PG8_LDA(At, 1, 1); PG8_STAGE_A(PG8_SA(1, 0), a3, 0);
            PG8_BAR; PG8_WAIT_L(0); PG8_MMA(1, 0, At, B0); PG8_BAR; PG8_SCHED;
            PG8_STAGE(PG8_SB(1, 1), b3 + hstep, voffB);
            PG8_WAIT_V(6); PG8_BAR; PG8_MMA(1, 1, At, B1); PG8_BAR;
            }
        }
        if constexpr (ALIGN_EPI) { if (wr == 0) PG8_BAR; }
        if constexpr (!Epi::AFTER_DRAIN) { E(acc, cur, wr, wc, fr, fq); S.done(cur); }
        if (!has_next) break;
#pragma unroll
        for (int a = 0; a < 2; ++a)
#pragma unroll
            for (int b = 0; b < 2; ++b)
#pragma unroll
                for (int m = 0; m < 4; ++m)
#pragma unroll
                    for (int n = 0; n < 2; ++n) acc[a][b][m][n] = (f32x4){0.f, 0.f, 0.f, 0.f};
        cur = nxt; cA = nA; cB = nB; ++ui;
        if constexpr (ALIGN_EPI) { if (wr == 1) PG8_BAR; }
    }
    PG8_WAIT_V(0);
    if constexpr (!ALIGN_EPI) { if (wr == 0) PG8_BAR; }
    PG8_BAR;
    if constexpr (Epi::AFTER_DRAIN) { E.fused(acc, cur, wr, wc, fr, fq, lds, wid, lane); S.done(cur); }
#undef PG8_SA
#undef PG8_SB
#undef PG8_STAGE
#undef PG8_UNI
#undef PG8_STAGE_A
#undef PG8_GATHER_SWITCH
#undef PG8_LDA
#undef PG8_LDB
#undef PG8_MMA
#undef PG8_CAT8
#undef PG8_WAIT_V
#undef PG8_WAIT_L
#undef PG8_BAR
#undef PG8_SCHED
}
}

constexpr int DM = 2048, NB = 8, SEQ = 2048, CTXL = 256, NH = 16, NKV = 4, HD = 128;
constexpr int ML = NB * SEQ;
constexpr int MC = NB * CTXL;
constexpr int MT = ML + MC;
constexpr int NE = 16, CAPL = 256, CAPC = 32, DFF = 1024;
constexpr int YR = NB * CAPL + NB * CAPC;
constexpr int YT = NE * YR;
constexpr int NMOD = 6 * DM;
constexpr float NORM_EPS = 1e-6f;
constexpr int KSPLIT = 16;

using pg8::Unit; using pg8::f32x4; using pg8::u32x4; using pg8::bf16_t; using pg8::bf16x8; using pg8::cvt_pk_bf16;
typedef float f32x2 __attribute__((ext_vector_type(2)));
typedef unsigned u32x2 __attribute__((ext_vector_type(2)));
typedef float f32x16 __attribute__((ext_vector_type(16)));
typedef short s16x4 __attribute__((ext_vector_type(4)));
#define DI __device__ __forceinline__

DI float bf_lo(unsigned w) { return __uint_as_float(w << 16); }
DI float bf_hi(unsigned w) { return __uint_as_float(w & 0xffff0000u); }
DI unsigned pk4_fp8(float a, float b, float c, float d) {
    a = __builtin_amdgcn_fmed3f(a, -448.0f, 448.0f); b = __builtin_amdgcn_fmed3f(b, -448.0f, 448.0f); c = __builtin_amdgcn_fmed3f(c, -448.0f, 448.0f); d = __builtin_amdgcn_fmed3f(d, -448.0f, 448.0f);
    int w = __builtin_amdgcn_cvt_pk_fp8_f32(a, b, 0, false); w = __builtin_amdgcn_cvt_pk_fp8_f32(c, d, w, true); return (unsigned)w;
}
constexpr float Y8_SCALE = 64.0f, Y8_INV = 1.0f / 64.0f;
constexpr float W8_SCALE = 32.0f, W8_INV = 1.0f / 32.0f;
DI f32x4 unpk4_fp8(unsigned w) { const f32x2 lo = __builtin_amdgcn_cvt_pk_f32_fp8((int)w, false), hi = __builtin_amdgcn_cvt_pk_f32_fp8((int)w, true); return (f32x4){lo.x, lo.y, hi.x, hi.y}; }
DI float silu_f(float a) { return a * __builtin_amdgcn_rcpf(1.0f + __expf(-a)); }

DI int xcd_remap(int wgid, int nwg) { const int q = nwg / 8, r = nwg % 8, xcd = wgid % 8, off = wgid / 8; return (xcd < r ? xcd * (q + 1) : r * (q + 1) + (xcd - r) * q) + off; }
struct QkvOrder {
    int G, c;
    DI bool next(int i, Unit& u) const {
        const int L = i * G + c; if (L >= 800) return false;
        if (L < 768) { const int w = xcd_remap(L, 768); const int nig = 8 * 12, gid = w / nig; u.pm = gid * 8 + ((w % nig) % 8); u.pn = (w % nig) / 8; }
        else { const int j = L - 768; u.pm = 64 + (j >> 2); u.pn = 8 + (j & 3); }
        return true;
    }
    DI void a_ready(const Unit&) const {}
    DI void done(const Unit&) const {}
};
struct MoeOrder {
    int G, c, NP;
    DI bool next(int i, Unit& u) const {
        const int nwg = NE * NP * 8; const int L = i * G + c; if (L >= nwg) return false;
        const int w = xcd_remap(L, nwg); const int per = NP * 8, e = w / per, rem = w % per;
        u.pm = e * 9 + (rem % NP); u.pn = e * 8 + (rem / NP); return true;
    }
    DI void a_ready(const Unit&) const {}
    DI void done(const Unit&) const {}
};

template <int ACT  > struct EpiPair {
    static constexpr bool PERM = true, AFTER_DRAIN = false;
    bf16_t* O; int ldc; int pn_mod;
    DI void operator()(const f32x4 (&acc)[2][2][4][2], const Unit& u, int wr, int wc, int fr, int fq) const {
        const int row0 = u.pm * 256 + wr * 64 + fr, col0 = (u.pn % pn_mod) * 128 + wc * 32 + 8 * fq;
#pragma unroll
        for (int ai = 0; ai < 2; ++ai)
#pragma unroll
            for (int m = 0; m < 4; ++m) {
                bf16_t* rowp = O + (size_t)(row0 + ai * 128 + m * 16) * ldc + col0;
                f32x4 a0 = acc[ai][0][m][0], a1 = acc[ai][0][m][1]; const f32x4 b0 = acc[ai][1][m][0], b1 = acc[ai][1][m][1];
                if (ACT == 1) {
#pragma unroll
                    for (int j = 0; j < 4; ++j) { a0[j] = silu_f(a0[j]); a1[j] = silu_f(a1[j]); } }
                const f32x4 v0 = a0 * b0, v1 = a1 * b1;
                u32x4 w; w.x = cvt_pk_bf16(v0[0], v0[1]); w.y = cvt_pk_bf16(v0[2], v0[3]); w.z = cvt_pk_bf16(v1[0], v1[1]); w.w = cvt_pk_bf16(v1[2], v1[3]);
                *(u32x4*)rowp = w;
            }
    }
};
struct EpiPairF8 {
    static constexpr bool PERM = true, AFTER_DRAIN = false;
    unsigned char* O; int ldc; int pn_mod;
    DI void operator()(const f32x4 (&acc)[2][2][4][2], const Unit& u, int wr, int wc, int fr, int fq) const {
        const int row0 = u.pm * 256 + wr * 64 + fr, col0 = (u.pn % pn_mod) * 128 + wc * 32 + 8 * fq;
#pragma unroll
        for (int ai = 0; ai < 2; ++ai)
#pragma unroll
            for (int m = 0; m < 4; ++m) {
                unsigned char* rowp = O + (size_t)(row0 + ai * 128 + m * 16) * ldc + col0;
                f32x4 a0 = acc[ai][0][m][0] * W8_INV, a1 = acc[ai][0][m][1] * W8_INV; const f32x4 b0 = acc[ai][1][m][0] * W8_INV, b1 = acc[ai][1][m][1] * W8_INV;
#pragma unroll
                for (int j = 0; j < 4; ++j) { a0[j] = silu_f(a0[j]); a1[j] = silu_f(a1[j]); }
                const f32x4 v0 = a0 * b0, v1 = a1 * b1;
                u32x2 w; w.x = pk4_fp8(v0[0], v0[1], v0[2], v0[3]); w.y = pk4_fp8(v1[0], v1[1], v1[2], v1[3]);
                *(u32x2*)rowp = w;
            }
    }
};
struct EpiConvGate {
    static constexpr bool PERM = true, AFTER_DRAIN = false;
    const bf16_t* U; bf16_t* Z; const float* cw;
    DI void operator()(const f32x4 (&acc)[2][2][4][2], const Unit& u, int wr, int wc, int fr, int fq) const {
        const int row0 = u.pm * 256 + wr * 64 + fr, col0 = u.pn * 256 + wc * 32 + 8 * fq;
#pragma unroll
        for (int bj = 0; bj < 2; ++bj) {
            const int c = col0 + bj * 128;
            f32x4 w0a = *(const f32x4*)(cw + c), w0b = *(const f32x4*)(cw + c + 4), w1a = *(const f32x4*)(cw + 2048 + c), w1b = *(const f32x4*)(cw + 2048 + c + 4), w2a = *(const f32x4*)(cw + 4096 + c), w2b = *(const f32x4*)(cw + 4096 + c + 4);
#pragma unroll
            for (int ai = 0; ai < 2; ++ai)
#pragma unroll
                for (int m = 0; m < 4; ++m) {
                    const int row = row0 + ai * 128 + m * 16;
                    const int tpos = row < ML ? (row & (SEQ - 1)) : ((row - ML) & (CTXL - 1)); const int len = row < ML ? SEQ : CTXL;
                    const u32x4 z4 = (u32x4){0u, 0u, 0u, 0u};
                    const u32x4 uc = *(const u32x4*)(U + (size_t)row * DM + c);
                    const u32x4 up = tpos > 0 ? *(const u32x4*)(U + (size_t)(row - 1) * DM + c) : z4;
                    const u32x4 un = tpos < len - 1 ? *(const u32x4*)(U + (size_t)(row + 1) * DM + c) : z4;
                    f32x4 ya, yb;
                    ya[0] = w0a[0] * bf_lo(up.x) + w1a[0] * bf_lo(uc.x) + w2a[0] * bf_lo(un.x); ya[1] = w0a[1] * bf_hi(up.x) + w1a[1] * bf_hi(uc.x) + w2a[1] * bf_hi(un.x);
                    ya[2] = w0a[2] * bf_lo(up.y) + w1a[2] * bf_lo(uc.y) + w2a[2] * bf_lo(un.y); ya[3] = w0a[3] * bf_hi(up.y) + w1a[3] * bf_hi(uc.y) + w2a[3] * bf_hi(un.y);
                    yb[0] = w0b[0] * bf_lo(up.z) + w1b[0] * bf_lo(uc.z) + w2b[0] * bf_lo(un.z); yb[1] = w0b[1] * bf_hi(up.z) + w1b[1] * bf_hi(uc.z) + w2b[1] * bf_hi(un.z);
                    yb[2] = w0b[2] * bf_lo(up.w) + w1b[2] * bf_lo(uc.w) + w2b[2] * bf_lo(un.w); yb[3] = w0b[3] * bf_hi(up.w) + w1b[3] * bf_hi(uc.w) + w2b[3] * bf_hi(un.w);
                    const f32x4 v0 = acc[ai][bj][m][0] * ya, v1 = acc[ai][bj][m][1] * yb;
                    u32x4 w; w.x = cvt_pk_bf16(v0[0], v0[1]); w.y = cvt_pk_bf16(v0[2], v0[3]); w.z = cvt_pk_bf16(v1[0], v1[1]); w.w = cvt_pk_bf16(v1[2], v1[3]);
                    *(u32x4*)(Z + (size_t)row * DM + c) = w;
                }
        }
    }
};
template <bool BASE_F32> struct EpiResid {
    static constexpr bool PERM = true, AFTER_DRAIN = false;
    const float* base_lat; const float* base_ctx; bf16_t* out; const float* gate;
    DI void operator()(const f32x4 (&acc)[2][2][4][2], const Unit& u, int wr, int wc, int fr, int fq) const {
        const int rowt = u.pm * 256; const int cr = rowt < ML ? (rowt >> 11) : 8;
        const float* base = rowt < ML ? base_lat : base_ctx - (size_t)ML * DM;
        const int row0 = rowt + wr * 64 + fr, col0 = u.pn * 256 + wc * 32 + 8 * fq;
        f32x4 gv[2][2];
#pragma unroll
        for (int bj = 0; bj < 2; ++bj)
#pragma unroll
            for (int n = 0; n < 2; ++n) gv[bj][n] = *(const f32x4*)(gate + (size_t)cr * NMOD + col0 + bj * 128 + n * 4);
#pragma unroll
        for (int ai = 0; ai < 2; ++ai)
#pragma unroll
            for (int m = 0; m < 4; ++m) { const size_t off = (size_t)(row0 + ai * 128 + m * 16) * DM + col0;
#pragma unroll
                for (int bj = 0; bj < 2; ++bj) { f32x4 b0, b1;
                    if (BASE_F32) { b0 = *(const f32x4*)(base + off + bj * 128); b1 = *(const f32x4*)(base + off + bj * 128 + 4); }
                    else { const u32x4 hb = *(const u32x4*)(out + off + bj * 128); b0 = (f32x4){bf_lo(hb.x), bf_hi(hb.x), bf_lo(hb.y), bf_hi(hb.y)}; b1 = (f32x4){bf_lo(hb.z), bf_hi(hb.z), bf_lo(hb.w), bf_hi(hb.w)}; }
                    const f32x4 v0 = b0 + gv[bj][0] * acc[ai][bj][m][0], v1 = b1 + gv[bj][1] * acc[ai][bj][m][1];
                    u32x4 w; w.x = cvt_pk_bf16(v0[0], v0[1]); w.y = cvt_pk_bf16(v0[2], v0[3]); w.z = cvt_pk_bf16(v1[0], v1[1]); w.w = cvt_pk_bf16(v1[2], v1[3]);
                    *(u32x4*)(out + off + bj * 128) = w; }
                asm volatile("" ::: "memory"); }
    }
};
struct EpiDown {
    static constexpr bool PERM = true, AFTER_DRAIN = false;
    bf16_t* Y; const float* gatev; float ws;
    DI void operator()(const f32x4 (&acc)[2][2][4][2], const Unit& u, int wr, int wc, int fr, int fq) const {
        const int row0 = u.pm * 256 + wr * 64 + fr, col0 = (u.pn & 7) * 256 + wc * 32 + 8 * fq;
#pragma unroll
        for (int ai = 0; ai < 2; ++ai)
#pragma unroll
            for (int m = 0; m < 4; ++m) { const int row = row0 + ai * 128 + m * 16; const float gt = gatev[row] * ws;
#pragma unroll
                for (int bj = 0; bj < 2; ++bj) { const f32x4 v0 = acc[ai][bj][m][0] * gt, v1 = acc[ai][bj][m][1] * gt;
                    u32x2 w; w.x = pk4_fp8(v0[0], v0[1], v0[2], v0[3]); w.y = pk4_fp8(v1[0], v1[1], v1[2], v1[3]);
                    *(u32x2*)((unsigned char*)Y + (size_t)row * DM + col0 + bj * 128) = w; } }
    }
};
#define LAS3 __attribute__((address_space(3)))
struct EpiQkvNorm {
    static constexpr bool PERM = true, AFTER_DRAIN = false;
    bf16_t* Q; bf16_t* K; bf16_t* V; const float* qg; const float* kg; LAS3 float* P;
    DI void operator()(const f32x4 (&acc)[2][2][4][2], const Unit& u, int wr, int wc, int fr, int fq) const {
        const int row0 = u.pm * 256 + wr * 64 + fr; int colt = u.pn * 256;
        if (colt >= 2560) {
            const int col0 = colt - 2560 + wc * 32 + 8 * fq;
#pragma unroll
            for (int ai = 0; ai < 2; ++ai)
#pragma unroll
                for (int m = 0; m < 4; ++m) { bf16_t* rowp = V + (size_t)(row0 + ai * 128 + m * 16) * 512 + col0;
#pragma unroll
                    for (int bj = 0; bj < 2; ++bj) { const f32x4 v0 = acc[ai][bj][m][0], v1 = acc[ai][bj][m][1];
                        u32x4 w; w.x = cvt_pk_bf16(v0[0], v0[1]); w.y = cvt_pk_bf16(v0[2], v0[3]); w.z = cvt_pk_bf16(v1[0], v1[1]); w.w = cvt_pk_bf16(v1[2], v1[3]);
                        *(u32x4*)(rowp + bj * 128) = w; } }
            return;
        }
        const bool isq = colt < 2048; bf16_t* base = isq ? Q : K; const int ld = isq ? 2048 : 512; if (!isq) colt -= 2048;
        const int rl0 = wr * 64 + fr;
#pragma unroll
        for (int ai = 0; ai < 2; ++ai)
#pragma unroll
            for (int m = 0; m < 4; ++m)
#pragma unroll
                for (int bj = 0; bj < 2; ++bj) { const f32x4 a = acc[ai][bj][m][0], b = acc[ai][bj][m][1];
                    float s = (a[0] * a[0] + a[1] * a[1]) + (a[2] * a[2] + a[3] * a[3]) + (b[0] * b[0] + b[1] * b[1]) + (b[2] * b[2] + b[3] * b[3]);
                    s += __shfl_xor(s, 16); s += __shfl_xor(s, 32);
                    if (fq == 0) P[((ai * 128 + m * 16 + rl0) * 2 + bj) * 4 + wc] = s; }
        asm volatile("s_waitcnt lgkmcnt(0)" ::: "memory"); __builtin_amdgcn_s_barrier(); asm volatile("" ::: "memory");
        constexpr float QSCALE = 0.08838834764831845f * 1.4426950408889634f;
        const int i0 = 16 * (wc & 1) + 4 * fq, d0 = 64 * (wc >> 1) + i0;
        const float* gp = isq ? qg : kg; f32x4 g0 = *(const f32x4*)(gp + d0), g1 = *(const f32x4*)(gp + d0 + 32);
        if (isq) { g0 = g0 * QSCALE; g1 = g1 * QSCALE; }
        f32x4 ifr;
#pragma unroll
        for (int j = 0; j < 4; ++j) ifr[j] = exp2f(-(float)(i0 + j) * (13.287712379549449f / 32.0f));
        const bool lat = u.pm < 64;
#pragma unroll
        for (int ai = 0; ai < 2; ++ai)
#pragma unroll
            for (int m = 0; m < 4; ++m) { const int row = row0 + ai * 128 + m * 16; const int t = row & (SEQ - 1);
                const float pos = (float)((wc >> 1) == 0 ? (t >> 6) : (t & 63));
                f32x4 cs, sn;
#pragma unroll
                for (int j = 0; j < 4; ++j) { const float ang = pos * ifr[j]; cs[j] = lat ? __cosf(ang) : 1.0f; sn[j] = lat ? __sinf(ang) : 0.0f; }
#pragma unroll
                for (int bj = 0; bj < 2; ++bj) { const f32x4 pp = *(const LAS3 f32x4*)(P + ((ai * 128 + m * 16 + rl0) * 2 + bj) * 4);
                    const float rstd = 1.0f / sqrtf(((pp[0] + pp[1]) + (pp[2] + pp[3])) * (1.0f / HD) + NORM_EPS);
                    const f32x4 a = acc[ai][bj][m][0] * rstd * g0, b = acc[ai][bj][m][1] * rstd * g1;
                    const f32x4 o1 = a * cs - b * sn, o2 = b * cs + a * sn;
                    u32x4 w; w.x = cvt_pk_bf16(o1[0], o1[1]); w.y = cvt_pk_bf16(o1[2], o1[3]); w.z = cvt_pk_bf16(o2[0], o2[1]); w.w = cvt_pk_bf16(o2[2], o2[3]);
                    *(u32x4*)(base + (size_t)row * ld + colt + bj * 128 + wc * 32 + 8 * fq) = w; } }
    }
};

constexpr size_t MiB = 1u << 20;
constexpr size_t WS_CTL = 0, CTL_ZERO_BYTES = 1 * MiB;
constexpr size_t WS_MOD = 1 * MiB;
constexpr size_t WS_MODP = 2 * MiB;
constexpr size_t WS_AFFL = 16 * MiB;
constexpr size_t WS_AFFC = 17 * MiB;
constexpr size_t WS_RWT = 17 * MiB + 128 * 1024;
constexpr size_t WS_IDMAP = 19 * MiB + 768 * 1024;
constexpr size_t WS_ROWSRC = 17 * MiB + 512 * 1024;
constexpr size_t WS_GATEV = 18 * MiB;
constexpr size_t WS_INV = 18 * MiB + 512 * 1024;
constexpr size_t WS_W1A = 20 * MiB;
constexpr size_t WS_W1B = 36 * MiB;
constexpr size_t WS_W2 = 44 * MiB;
constexpr size_t WS_WQKV = 52 * MiB;
constexpr size_t WS_WO = 64 * MiB;
constexpr size_t WS_WGU = 72 * MiB;
constexpr size_t WS_WDN = 328 * MiB;
constexpr size_t WS_H = 456 * MiB;
constexpr size_t WS_A = 600 * MiB;
constexpr size_t WS_U = 672 * MiB;
constexpr size_t WS_Z = 744 * MiB;
constexpr size_t WS_Q = WS_U, WS_K = WS_Z, WS_V = WS_Z + 18 * MiB;
constexpr size_t WS_HM = 816 * MiB;
constexpr size_t WS_O = WS_HM;
constexpr size_t WS_Y = 888 * MiB;
constexpr size_t WS_END = 1032 * MiB;
constexpr int CW_BAR = 4096;

constexpr int RING_BYTES = 131072;
constexpr int MISC_OFF = RING_BYTES + 14336;
constexpr int LDS_BYTES = 147456;

#define GAS __attribute__((address_space(1)))
#define LAS __attribute__((address_space(3)))
#define LDS_WAIT() asm volatile("s_waitcnt lgkmcnt(0)" ::: "memory")
#define VM_WAIT() asm volatile("s_waitcnt vmcnt(0)" ::: "memory")
#define XB_TMO      128
#define XB_XCNT(j)  (256  + 64 * (j))
#define XB_XSUB(j)  (1280 + 64 * (j))
#define XB_XGEN(j)  (2304 + 64 * (j))
#define XB_TOP      3328
#define XB_TOPGEN   3392
#define XCD_BAR_WORDS 3456
#define XB_SPIN_CAP (1u << 18)

__device__ __forceinline__ unsigned xb_ld(unsigned* p)              { return __hip_atomic_load(p, __ATOMIC_RELAXED, __HIP_MEMORY_SCOPE_AGENT); }
__device__ __forceinline__ unsigned xb_add(unsigned* p, unsigned v) { return __hip_atomic_fetch_add(p, v, __ATOMIC_RELAXED, __HIP_MEMORY_SCOPE_AGENT); }
__device__ __forceinline__ unsigned xb_xcc_id() { return (unsigned)__builtin_amdgcn_s_getreg((3 << 11) | 20) & 0xFu; }
#define XB_SPIN(cond, bar) do { unsigned _sp = 0; while (cond) { __builtin_amdgcn_s_sleep(1); \
    if ((++_sp & 255u) == 0u) { if (xb_ld(&(bar)[XB_TMO])) break; if (_sp > XB_SPIN_CAP) { atomicAdd(&(bar)[XB_TMO], 1u); break; } } } } while (0)

struct XcdBarrier {
    unsigned* bar; unsigned x;
    volatile LAS unsigned* st;
};

__device__ __forceinline__ XcdBarrier xcd_barrier_post(unsigned* bar, volatile LAS unsigned* st) {
    XcdBarrier b; b.bar = bar; b.x = xb_xcc_id(); b.st = st;
    if (threadIdx.x == 0) (void)xb_add(&bar[XB_XCNT(b.x)], 1u);
    return b;
}
__device__ __forceinline__ void xcd_barrier_complete(unsigned* bar, unsigned x, unsigned& nloc, unsigned& nx) {
    const unsigned G = gridDim.x * gridDim.y * gridDim.z;
    unsigned sum, cnt, mine, sp = 0u;
    for (;;) {
        sum = 0u; cnt = 0u; mine = 0u;
#pragma unroll
        for (unsigned j = 0; j < 16; ++j) { const unsigned c = xb_ld(&bar[XB_XCNT(j)]); sum += c; cnt += (c > 0u) ? 1u : 0u; mine = (j == x) ? c : mine; }
        if (sum == G) break;
        __builtin_amdgcn_s_sleep(1);
        if ((++sp & 255u) == 0u) { if (xb_ld(&bar[XB_TMO])) break; if (sp > XB_SPIN_CAP) { atomicAdd(&bar[XB_TMO], 1u); break; } }
    }
    nloc = mine > 0u ? mine : 1u; nx = cnt > 0u ? cnt : 1u;
}

__device__ __forceinline__ void xcd_barrier(const XcdBarrier& b) {
    asm volatile("s_waitcnt vmcnt(0)" ::: "memory");
    __syncthreads();
    if (threadIdx.x == 0) {
        unsigned* bar = b.bar;
        __builtin_amdgcn_s_waitcnt(0);
        unsigned nloc = b.st[0], nx = b.st[1];
        if (nloc == 0u) { xcd_barrier_complete(bar, b.x, nloc, nx); b.st[0] = nloc; b.st[1] = nx; }
        const unsigned old = xb_add(&bar[XB_XSUB(b.x)], 1u);
        const unsigned gen = old / nloc;
        if (old + 1u == (gen + 1u) * nloc) {
            __builtin_amdgcn_fence(__ATOMIC_RELEASE, "agent");
            asm volatile("s_waitcnt vmcnt(0)" ::: "memory");
            const unsigned og = xb_add(&bar[XB_TOP], 1u);
            const unsigned tg = og / nx;
            if (og + 1u == (tg + 1u) * nx) xb_add(&bar[XB_TOPGEN], 1u);
            else XB_SPIN(xb_ld(&bar[XB_TOPGEN]) == tg, bar);
            __builtin_amdgcn_fence(__ATOMIC_ACQUIRE, "agent");
            xb_add(&bar[XB_XGEN(b.x)], 1u);
            asm volatile("s_waitcnt vmcnt(0)" ::: "memory");
        } else {
            XB_SPIN(xb_ld(&bar[XB_XGEN(b.x)]) == gen, bar);
            __builtin_amdgcn_fence(__ATOMIC_ACQUIRE, "agent");
            asm volatile("s_waitcnt vmcnt(0)" ::: "memory");
        }
    }
    __syncthreads();
}

DI float wave_sum(float v) {
#pragma unroll
    for (int o = 1; o < 64; o <<= 1) v += __shfl_xor(v, o);
    return v;
}
DI float rdlane(float v, int l) { return __uint_as_float((unsigned)__builtin_amdgcn_readlane((int)__float_as_uint(v), l)); }
DI unsigned pk2(float lo, float hi) { return cvt_pk_bf16(lo, hi); }

DI void ph_adaln(const float* cnd, const float* cctx, const float* ada_w, float* modp, int gw, int NGW, int lane) {
    for (int task = gw; task < 96 * KSPLIT; task += NGW) {
        const int ks = task & (KSPLIT - 1), cg = task / KSPLIT, l = cg / 48, cgl = cg % 48, col0 = cgl * 256 + lane * 4, k0 = ks * 128;
        float sv[9][2];
#pragma unroll
        for (int r = 0; r < 9; ++r)
#pragma unroll
            for (int hh = 0; hh < 2; ++hh) { const int k = k0 + hh * 64 + lane; const float v = r < 8 ? cnd[r * DM + k] : cctx[k]; sv[r][hh] = v / (1.0f + __expf(-v)); }
        f32x4 acc[9];
#pragma unroll
        for (int r = 0; r < 9; ++r) acc[r] = (f32x4){0.f, 0.f, 0.f, 0.f};
        const float* wp = ada_w + ((size_t)l * DM + k0) * NMOD + col0;
#pragma unroll
        for (int hh = 0; hh < 2; ++hh) {
#pragma unroll 8
            for (int kk = 0; kk < 64; ++kk) {
                const f32x4 w = *(const f32x4*)(wp + (size_t)(hh * 64 + kk) * NMOD);
#pragma unroll
                for (int r = 0; r < 9; ++r) { const float s = rdlane(sv[r][hh], kk); acc[r] += w * s; }
            }
        }
#pragma unroll
        for (int r = 0; r < 9; ++r) *(f32x4*)(modp + ((size_t)((ks * 2 + l) * 9 + r)) * NMOD + col0) = acc[r];
    }
}
struct CvtPtrs { const float *cin, *cout, *wqkv, *wo, *wg, *wu, *wd; bf16_t *W1A, *W1B, *W2, *WQKV, *WO, *WGU, *WDN; };
constexpr int CVT_E0 = 6656, CVT_L = 24576, CVT_TOTAL = CVT_E0 + 2 * CVT_L;
DI void cvt_resolve(const CvtPtrs& P, int it, const float*& src, int& ldw, bf16_t*& dst, int& ldd, bool& qperm, bool& f8) {
    int r = it; qperm = false; f8 = false;
    if (r < 3072) { const int kt = ((r >> 3) / 96) * 8 + (r & 7), nt = (r >> 3) % 96, n0 = nt * 64, part = n0 >> 11, j0 = n0 & 2047;
        src = P.cin + (size_t)(kt * 64) * 6144 + n0; ldw = 6144; ldd = DM;
        dst = (part == 0 ? P.W1B + (size_t)j0 * DM : P.W1A + (size_t)((j0 >> 7) * 256 + (part == 2 ? 128 : 0) + (j0 & 127)) * DM) + kt * 64; return; } r -= 3072;
    if (r < 1024) { const int kt = ((r >> 3) / 32) * 8 + (r & 7), nt = (r >> 3) % 32; src = P.cout + (size_t)(kt * 64) * DM + nt * 64; ldw = DM; dst = P.W2 + (size_t)(nt * 64) * DM + kt * 64; ldd = DM; return; } r -= 1024;
    if (r < 1536) { const int kt = ((r >> 3) / 48) * 8 + (r & 7), nt = (r >> 3) % 48; src = P.wqkv + (size_t)(kt * 64) * 3072 + nt * 64; ldw = 3072; qperm = nt < 40;     dst = P.WQKV + (size_t)(nt * 64) * DM + kt * 64; ldd = DM; return; } r -= 1536;
    if (r < 1024) { const int kt = ((r >> 3) / 32) * 8 + (r & 7), nt = (r >> 3) % 32; src = P.wo + (size_t)(kt * 64) * DM + nt * 64; ldw = DM; dst = P.WO + (size_t)(nt * 64) * DM + kt * 64; ldd = DM; return; } r -= 1024;
    const int l = r / CVT_L, rr = r % CVT_L, kind = rr / 8192, q = rr % 8192, le = l * 16 + q / 512, rem = q % 512;
    f8 = true;
    if (kind < 2) { const int kt = ((rem >> 3) / 16) * 8 + (rem & 7), nt = (rem >> 3) % 16, n0 = nt * 64;
        src = (kind ? P.wu : P.wg) + (size_t)le * DM * DFF + (size_t)(kt * 64) * DFF + n0; ldw = DFF;
        dst = (bf16_t*)((unsigned char*)P.WGU + (size_t)(le * 2048 + (n0 >> 7) * 256 + kind * 128 + (n0 & 127)) * DM + kt * 64); ldd = DM; }
    else { const int kt = ((rem >> 3) / 32) * 8 + (rem & 7), nt = (rem >> 3) % 32;
        src = P.wd + (size_t)le * DFF * DM + (size_t)(kt * 64) * DM + nt * 64; ldw = DM; dst = (bf16_t*)((unsigned char*)P.WDN + (size_t)(le * 2048 + nt * 64) * DFF + kt * 64); ldd = DFF; }
}
constexpr int CVT_P = 36;
DI void cvt_range(const CvtPtrs& P, int lo, int hi, int w, int NW, LAS unsigned* scr, int lane) {
    int it = lo + w; if (it >= hi) return;
    const int c = lane & 15, q = lane >> 4;
    const float* src; int ldw; bf16_t* dst; int ldd; bool qperm, f8; cvt_resolve(P, it, src, ldw, dst, ldd, qperm, f8);
    f32x4 v[16];
#pragma unroll
    for (int rr = 0; rr < 16; ++rr) v[rr] = __builtin_nontemporal_load((const f32x4*)(src + (size_t)(16 * q + rr) * ldw + 4 * c));
    for (;;) {
        const bool cf8 = f8; const int wrow = qperm ? 32 * ((c >> 2) & 1) + 8 * (c & 3) + 4 * (c >> 3) : 4 * c;
        u32x4 pa[4], pb[4];
        if (cf8) {
#pragma unroll
            for (int i = 0; i < 4; ++i) { pa[i].x = pk4_fp8(v[0][i] * W8_SCALE, v[1][i] * W8_SCALE, v[2][i] * W8_SCALE, v[3][i] * W8_SCALE); pa[i].y = pk4_fp8(v[4][i] * W8_SCALE, v[5][i] * W8_SCALE, v[6][i] * W8_SCALE, v[7][i] * W8_SCALE);
                                          pa[i].z = pk4_fp8(v[8][i] * W8_SCALE, v[9][i] * W8_SCALE, v[10][i] * W8_SCALE, v[11][i] * W8_SCALE); pa[i].w = pk4_fp8(v[12][i] * W8_SCALE, v[13][i] * W8_SCALE, v[14][i] * W8_SCALE, v[15][i] * W8_SCALE); pb[i] = pa[i]; }
        } else {
#pragma unroll
            for (int i = 0; i < 4; ++i) { pa[i].x = pk2(v[0][i], v[1][i]); pa[i].y = pk2(v[2][i], v[3][i]); pa[i].z = pk2(v[4][i], v[5][i]); pa[i].w = pk2(v[6][i], v[7][i]);
                                          pb[i].x = pk2(v[8][i], v[9][i]); pb[i].y = pk2(v[10][i], v[11][i]); pb[i].z = pk2(v[12][i], v[13][i]); pb[i].w = pk2(v[14][i], v[15][i]); }
        }
        const int nit = it + NW; bf16_t* cdst = dst; const int cldd = ldd;
        if (nit < hi) { cvt_resolve(P, nit, src, ldw, dst, ldd, qperm, f8);
#pragma unroll
            for (int rr = 0; rr < 16; ++rr) v[rr] = __builtin_nontemporal_load((const f32x4*)(src + (size_t)(16 * q + rr) * ldw + 4 * c)); }
        if (cf8) {
#pragma unroll
            for (int i = 0; i < 4; ++i) *(LAS u32x4*)(scr + (wrow + i) * 20 + 4 * q) = pa[i];
            LDS_WAIT(); asm volatile("" ::: "memory");
#pragma unroll
            for (int j = 0; j < 4; ++j) { const int ch = lane + 64 * j, n = ch >> 2, part = ch & 3; const u32x4 o = *(const LAS u32x4*)(scr + n * 20 + 4 * part);
                *(u32x4*)((unsigned char*)cdst + (size_t)n * cldd + 16 * part) = o; }
        } else {
#pragma unroll
            for (int i = 0; i < 4; ++i) { *(LAS u32x4*)(scr + (wrow + i) * CVT_P + 8 * q) = pa[i]; *(LAS u32x4*)(scr + (wrow + i) * CVT_P + 8 * q + 4) = pb[i]; }
            LDS_WAIT(); asm volatile("" ::: "memory");
#pragma unroll
            for (int j = 0; j < 8; ++j) { const int n = (lane >> 3) + 8 * j; const u32x4 o = *(const LAS u32x4*)(scr + n * CVT_P + 4 * (lane & 7));
                *(u32x4*)(cdst + (size_t)n * cldd + 8 * (lane & 7)) = o; }
        }
        LDS_WAIT(); asm volatile("" ::: "memory");
        if (nit >= hi) break;
        it = nit;
    }
}
DI void ph_modred(const float* modp, const float* ada_b, float* mod, int gtid, int GT) {
    for (int i = gtid; i < 2 * 9 * NMOD; i += GT) { const int l = i / (9 * NMOD), j = i % NMOD; float s = ada_b[l * NMOD + j];
#pragma unroll
        for (int ks = 0; ks < KSPLIT; ++ks) s += modp[(size_t)ks * (2 * 9 * NMOD) + i];
        mod[i] = s; }
}
DI void row_load(const float* p, f32x4 (&v)[8], int lane) {
#pragma unroll
    for (int j = 0; j < 8; ++j) v[j] = *(const f32x4*)(p + 4 * lane + 256 * j);
}
DI void row_load_bf(const bf16_t* p, f32x4 (&v)[8], int lane) {
#pragma unroll
    for (int j = 0; j < 8; ++j) { const u32x2 w = *(const u32x2*)(p + 4 * lane + 256 * j); v[j] = (f32x4){bf_lo(w.x), bf_hi(w.x), bf_lo(w.y), bf_hi(w.y)}; }
}
DI void row_modulate(const f32x4 (&v)[8], f32x4 (&y)[8], const float* gain, const float* shift, const float* scale, int lane) {
    float ss = 0.f;
#pragma unroll
    for (int j = 0; j < 8; ++j) ss += (v[j][0] * v[j][0] + v[j][1] * v[j][1]) + (v[j][2] * v[j][2] + v[j][3] * v[j][3]);
    ss = wave_sum(ss);
    const float rstd = 1.0f / sqrtf(ss * (1.0f / DM) + NORM_EPS);
#pragma unroll
    for (int j = 0; j < 8; ++j) { const int c = 4 * lane + 256 * j; const f32x4 g = *(const f32x4*)(gain + c), sh = *(const f32x4*)(shift + c), sc = *(const f32x4*)(scale + c);
        y[j] = ((v[j] * rstd) * g) * (sc + 1.0f) + sh; }
}
DI void row_modulate2(const f32x4 (&v0)[8], const f32x4 (&v1)[8], f32x4 (&y0)[8], f32x4 (&y1)[8], const float* gain, const float* shift, const float* scale, int lane) {
    float s0 = 0.f, s1 = 0.f;
#pragma unroll
    for (int j = 0; j < 8; ++j) { s0 += (v0[j][0] * v0[j][0] + v0[j][1] * v0[j][1]) + (v0[j][2] * v0[j][2] + v0[j][3] * v0[j][3]); s1 += (v1[j][0] * v1[j][0] + v1[j][1] * v1[j][1]) + (v1[j][2] * v1[j][2] + v1[j][3] * v1[j][3]); }
    s0 = wave_sum(s0); s1 = wave_sum(s1);
    const float r0 = 1.0f / sqrtf(s0 * (1.0f / DM) + NORM_EPS), r1 = 1.0f / sqrtf(s1 * (1.0f / DM) + NORM_EPS);
#pragma unroll
    for (int j = 0; j < 8; ++j) { const int c = 4 * lane + 256 * j; const f32x4 g = *(const f32x4*)(gain + c), sh = *(const f32x4*)(shift + c), sc = *(const f32x4*)(scale + c);
        y0[j] = ((v0[j] * r0) * g) * (sc + 1.0f) + sh; y1[j] = ((v1[j] * r1) * g) * (sc + 1.0f) + sh; }
}
DI void row_store_bf16(bf16_t* p, const f32x4 (&y)[8], int lane) {
#pragma unroll
    for (int j = 0; j < 8; ++j) { u32x2 w; w.x = pk2(y[j][0], y[j][1]); w.y = pk2(y[j][2], y[j][3]); *(u32x2*)(p + 4 * lane + 256 * j) = w; }
}
DI void ph_mod0(const float* x, const float* ctx, const float* gain, const float* mod0, bf16_t* A, int gw, int NGW, int lane) {
    int row = gw; if (row >= MT) return;
    f32x4 v[8], vn[8];
    row_load(row < ML ? x + (size_t)row * DM : ctx + (size_t)(row - ML) * DM, v, lane);
    for (;;) {
        const int nrow = row + NGW; const bool more = nrow < MT;
        if (more) row_load(nrow < ML ? x + (size_t)nrow * DM : ctx + (size_t)(nrow - ML) * DM, vn, lane);
        const int cr = row < ML ? (row >> 11) : 8;
        f32x4 y[8]; row_modulate(v, y, gain, mod0 + (size_t)cr * NMOD + 0 * DM, mod0 + (size_t)cr * NMOD + 1 * DM, lane);
        row_store_bf16(A + (size_t)row * DM, y, lane);
        if (!more) break;
#pragma unroll
        for (int j = 0; j < 8; ++j) v[j] = vn[j];
        row = nrow;
    }
}
DI float reduce8(const float (&v)[8], int lane) {
    const bool u0 = lane & 1, u1 = lane & 2, u2 = lane & 4;
    float a[4], b2[2];
#pragma unroll
    for (int k = 0; k < 4; ++k) { const float lo = v[2 * k], hi = v[2 * k + 1]; a[k] = (u0 ? hi : lo) + __shfl_xor(u0 ? lo : hi, 1); }
#pragma unroll
    for (int k = 0; k < 2; ++k) { const float lo = a[2 * k], hi = a[2 * k + 1]; b2[k] = (u1 ? hi : lo) + __shfl_xor(u1 ? lo : hi, 2); }
    return (u2 ? b2[1] : b2[0]) + __shfl_xor(u2 ? b2[0] : b2[1], 4);
}
DI float reduce_halves(float lo8, float hi8, int lane) {
    const bool u3 = lane & 8;
    float t = (u3 ? hi8 : lo8) + __shfl_xor(u3 ? lo8 : hi8, 8);
    t += __shfl_xor(t, 16); t += __shfl_xor(t, 32); return t;
}
DI float softmax16(float lg) {
    float mx = lg;
#pragma unroll
    for (int o = 1; o < 16; o <<= 1) mx = fmaxf(mx, __shfl_xor(mx, o));
    const float ex = __expf(lg - mx); float den = ex;
#pragma unroll
    for (int o = 1; o < 16; o <<= 1) den += __shfl_xor(den, o);
    return ex / den;
}
DI void aff_store(float v, float* affL, float* affC, int row, int lane) {
    if (lane < 16) { if (row < ML) { const int b = row >> 11, n = row & 2047; affL[(size_t)(b * 16 + lane) * SEQ + n] = v; }
                     else { const int rc = row - ML, b = rc >> 8, n = rc & 255; affC[(size_t)(b * 16 + lane) * CTXL + n] = v; } }
}
DI void router_rows2(const f32x4 (&y0)[8], const f32x4 (&y1)[8], const LAS float* rwT, float* affL, float* affC, int row0, int lane) {
    f32x2 yp[8][4];
#pragma unroll
    for (int j = 0; j < 8; ++j)
#pragma unroll
        for (int q = 0; q < 4; ++q) yp[j][q] = (f32x2){y0[j][q], y1[j][q]};
    float r0[2], r1[2];
#pragma unroll
    for (int hf = 0; hf < 2; ++hf) {
        float l0[8], l1[8];
#pragma unroll
        for (int e = 0; e < 8; ++e) { f32x2 acc = (f32x2){0.f, 0.f};
#pragma unroll
            for (int j = 0; j < 8; ++j) { const f32x4 w = *(const LAS f32x4*)(rwT + (8 * hf + e) * DM + 4 * lane + 256 * j);
#pragma unroll
                for (int q = 0; q < 4; ++q) acc = __builtin_elementwise_fma(yp[j][q], (f32x2){w[q], w[q]}, acc); }
            l0[e] = acc.x; l1[e] = acc.y; __builtin_amdgcn_sched_barrier(0); }
        r0[hf] = reduce8(l0, lane); r1[hf] = reduce8(l1, lane);
    }
    const float a0 = softmax16(reduce_halves(r0[0], r0[1], lane)), a1 = softmax16(reduce_halves(r1[0], r1[1], lane));
    aff_store(a0, affL, affC, row0, lane); aff_store(a1, affL, affC, row0 + 1, lane);
}
DI void ph_rwt(const float* rw, float* rwT, int gtid, int GT) {
    for (int i = gtid; i < 2 * 16 * DM; i += GT) { const int l = i >> 15, e = (i >> 11) & 15, d = i & (DM - 1); rwT[i] = rw[(size_t)l * DM * 16 + d * 16 + e]; }
}
DI void load_router(const float* rwT_g, LAS float* rwT, int tid) {
    for (int i = tid; i < DM * 16 / 4; i += 512) ((LAS f32x4*)rwT)[i] = ((const f32x4*)rwT_g)[i];
    __syncthreads();
}
DI void ph_modffn(const bf16_t* H, const float* gain, const float* modl, bf16_t* A, const LAS float* rwT, float* affL, float* affC, int nrows, int gw, int NGW, int lane) {
    int rp = gw; if (rp >= nrows / 2) return;
    u32x2 p0[8], p1[8];
#define MODFFN_LOAD(rp_) do { const int row_ = 2 * (rp_); _Pragma("unroll") for (int j = 0; j < 8; ++j) { p0[j] = *(const u32x2*)(H + (size_t)row_ * DM + 4 * lane + 256 * j); p1[j] = *(const u32x2*)(H + (size_t)(row_ + 1) * DM + 4 * lane + 256 * j); } } while (0)
    MODFFN_LOAD(rp);
    for (;;) {
        const int row = 2 * rp; const int cr = row < ML ? (row >> 11) : 8;
        float s0 = 0.f, s1 = 0.f;
#pragma unroll
        for (int j = 0; j < 8; ++j) { const float a0 = bf_lo(p0[j].x), a1 = bf_hi(p0[j].x), a2 = bf_lo(p0[j].y), a3 = bf_hi(p0[j].y); s0 += (a0 * a0 + a1 * a1) + (a2 * a2 + a3 * a3);
                                      const float b0 = bf_lo(p1[j].x), b1 = bf_hi(p1[j].x), b2 = bf_lo(p1[j].y), b3 = bf_hi(p1[j].y); s1 += (b0 * b0 + b1 * b1) + (b2 * b2 + b3 * b3); }
        s0 = wave_sum(s0); s1 = wave_sum(s1);
        const float r0 = 1.0f / sqrtf(s0 * (1.0f / DM) + NORM_EPS), r1 = 1.0f / sqrtf(s1 * (1.0f / DM) + NORM_EPS);
        const float* shift = modl + (size_t)cr * NMOD + 3 * DM; const float* scale = modl + (size_t)cr * NMOD + 4 * DM;
        f32x4 y0[8], y1[8];
#pragma unroll
        for (int j = 0; j < 8; ++j) { const int c = 4 * lane + 256 * j; const f32x4 g = *(const f32x4*)(gain + c), sh = *(const f32x4*)(shift + c), sc = *(const f32x4*)(scale + c);
            const f32x4 v0 = (f32x4){bf_lo(p0[j].x), bf_hi(p0[j].x), bf_lo(p0[j].y), bf_hi(p0[j].y)}, v1 = (f32x4){bf_lo(p1[j].x), bf_hi(p1[j].x), bf_lo(p1[j].y), bf_hi(p1[j].y)};
            y0[j] = ((v0 * r0) * g) * (sc + 1.0f) + sh; y1[j] = ((v1 * r1) * g) * (sc + 1.0f) + sh;
            *(unsigned*)((unsigned char*)A + (size_t)row * DM + c) = pk4_fp8(y0[j][0], y0[j][1], y0[j][2], y0[j][3]);
            *(unsigned*)((unsigned char*)A + (size_t)(row + 1) * DM + c) = pk4_fp8(y1[j][0], y1[j][1], y1[j][2], y1[j][3]); }
        const int nrp = rp + NGW; const bool more = nrp < nrows / 2;
        if (more) MODFFN_LOAD(nrp);
        asm volatile("" ::: "memory");
        router_rows2(y0, y1, rwT, affL, affC, row, lane);
        if (!more) break;
        rp = nrp;
    }
#undef MODFFN_LOAD
}
DI void ph_topk(int nitems, const float* affL, const float* affC, int* rowsrc, float* gatev, int* inv, LAS unsigned* hist, int tid, int lane, int wave, int bid, int G) {
    LAS unsigned* sh = hist + 256;
    for (int it = bid; it < nitems; it += G) {
        const bool isc = it >= 128; const int be = it & 127, b = be >> 4, e = be & 15;
        const int N = isc ? CTXL : SEQ, C = isc ? CAPC : CAPL;
        const float* src = isc ? affC + (size_t)be * CTXL : affL + (size_t)be * SEQ;
        const int i0 = tid * 4; const bool valid = i0 < N;
        unsigned key[4];
        { f32x4 v = (f32x4){0.f, 0.f, 0.f, 0.f}; if (valid) v = *(const f32x4*)(src + i0);
#pragma unroll
          for (int q = 0; q < 4; ++q) key[q] = __float_as_uint(v[q]); }
        unsigned prefix = 0u, mask = 0u, krem = (unsigned)C;
        for (int pass = 3; pass >= 0; --pass) {
            const int shift = pass * 8;
            if (tid < 256) hist[tid] = 0u;
            __syncthreads();
            if (valid) {
#pragma unroll
                for (int q = 0; q < 4; ++q) if ((key[q] & mask) == prefix) __hip_atomic_fetch_add(&hist[(key[q] >> shift) & 255u], 1u, __ATOMIC_RELAXED, __HIP_MEMORY_SCOPE_WORKGROUP); }
            __syncthreads();
            if (wave == 0) {
                const unsigned h0 = hist[4 * lane], h1 = hist[4 * lane + 1], h2 = hist[4 * lane + 2], h3 = hist[4 * lane + 3];
                const unsigned tot = h0 + h1 + h2 + h3; unsigned incl = tot;
#pragma unroll
                for (int o = 1; o < 64; o <<= 1) { const unsigned t = __shfl_down(incl, o); if (lane + o < 64) incl += t; }
                const unsigned a3 = incl - tot, a2 = a3 + h3, a1 = a2 + h2, a0 = a1 + h1;
                if (a3 < krem && krem <= a3 + h3) { sh[0] = 4 * lane + 3; sh[1] = krem - a3; }
                if (a2 < krem && krem <= a2 + h2) { sh[0] = 4 * lane + 2; sh[1] = krem - a2; }
                if (a1 < krem && krem <= a1 + h1) { sh[0] = 4 * lane + 1; sh[1] = krem - a1; }
                if (a0 < krem && krem <= a0 + h0) { sh[0] = 4 * lane + 0; sh[1] = krem - a0; }
            }
            __syncthreads();
            const unsigned B = sh[0]; krem = sh[1]; prefix |= B << shift; mask |= 0xFFu << shift;
        }
        const unsigned T = prefix;
        unsigned cg = 0u, ce = 0u;
        if (valid) {
#pragma unroll
            for (int q = 0; q < 4; ++q) { cg += key[q] > T ? 1u : 0u; ce += key[q] == T ? 1u : 0u; } }
        const unsigned mine = cg | (ce << 16); unsigned incl = mine;
#pragma unroll
        for (int o = 1; o < 64; o <<= 1) { const unsigned t = __shfl_up(incl, o); if (lane >= o) incl += t; }
        if (lane == 63) sh[8 + wave] = incl;
        __syncthreads();
        unsigned woff = 0u;
#pragma unroll
        for (int w = 0; w < 8; ++w) woff += (w < wave) ? sh[8 + w] : 0u;
        const unsigned excl = woff + incl - mine; unsigned gtb = excl & 0xFFFFu, eqb = excl >> 16;
        if (valid) {
            const int ybase = e * YR + (isc ? NB * CAPL + b * CAPC : b * CAPL); const int rbase = isc ? ML + b * CTXL : b * SEQ;
#pragma unroll
            for (int q = 0; q < 4; ++q) {
                const bool isg = key[q] > T, ise = key[q] == T; const bool sel = isg || (ise && eqb < krem);
                const unsigned slot = gtb + (eqb < krem ? eqb : krem);
                const int trow = rbase + i0 + q; const int yrow = ybase + (int)slot;
                if (sel) { rowsrc[yrow] = trow; gatev[yrow] = __uint_as_float(key[q]); }
                inv[(size_t)trow * 16 + e] = sel ? yrow : -1;
                gtb += isg ? 1u : 0u; eqb += ise ? 1u : 0u;
            }
        }
        __syncthreads();
    }
}
template <bool LAST> DI void ph_combine(bf16_t* H, const bf16_t* Y, const int* inv, const float* modl  , const float* gain1, const float* mod1, bf16_t* A, float* out, int nrows, int gw, int NGW, int lane) {
    int row = gw; if (row >= nrows) return;
    u32x2 hp[8], hn[8]; int myinv, ninv = -1;
#define CMB_LOAD(HP, IV, row_) do { _Pragma("unroll") for (int j = 0; j < 8; ++j) HP[j] = *(const u32x2*)(H + (size_t)(row_) * DM + 4 * lane + 256 * j); IV = inv[(size_t)(row_) * 16 + (lane & 15)]; } while (0)
    CMB_LOAD(hp, myinv, row);
    for (;;) {
        const int nrow = row + NGW; const bool more = nrow < nrows;
        if (more) CMB_LOAD(hn, ninv, nrow);
        const int cr = row < ML ? (row >> 11) : 8;
        f32x4 acc[8];
#pragma unroll
        for (int j = 0; j < 8; ++j) acc[j] = (f32x4){0.f, 0.f, 0.f, 0.f};
        unsigned m = (unsigned)(__ballot(myinv >= 0) & 0xFFFFull);
        while (m) {
            const int e1 = __builtin_ctz(m); m &= m - 1; const bool two = m != 0u; const int e2 = two ? __builtin_ctz(m) : e1; if (two) m &= m - 1;
            const unsigned char* y1 = (const unsigned char*)Y + (size_t)__builtin_amdgcn_readlane(myinv, e1) * DM + 4 * lane; const unsigned char* y2 = (const unsigned char*)Y + (size_t)__builtin_amdgcn_readlane(myinv, e2) * DM + 4 * lane;
            unsigned q1[8], q2[8];
#pragma unroll
            for (int j = 0; j < 8; ++j) { q1[j] = *(const unsigned*)(y1 + 256 * j); q2[j] = *(const unsigned*)(y2 + 256 * j); }
            const float f2 = two ? 1.0f : 0.0f;
#pragma unroll
            for (int j = 0; j < 8; ++j) acc[j] += unpk4_fp8(q1[j]) + unpk4_fp8(q2[j]) * f2;
        }
        const float* g2 = modl + (size_t)cr * NMOD + 5 * DM;
        f32x4 v[8];
#pragma unroll
        for (int j = 0; j < 8; ++j) { const f32x4 g = *(const f32x4*)(g2 + 4 * lane + 256 * j); const f32x4 h = (f32x4){bf_lo(hp[j].x), bf_hi(hp[j].x), bf_lo(hp[j].y), bf_hi(hp[j].y)}; v[j] = h + g * (acc[j] * Y8_INV); }
        if (LAST) {
#pragma unroll
            for (int j = 0; j < 8; ++j) *(f32x4*)(out + (size_t)row * DM + 4 * lane + 256 * j) = v[j];
        } else {
            row_store_bf16(H + (size_t)row * DM, v, lane);
            f32x4 y[8]; row_modulate(v, y, gain1, mod1 + (size_t)cr * NMOD + 0 * DM, mod1 + (size_t)cr * NMOD + 1 * DM, lane);
            row_store_bf16(A + (size_t)row * DM, y, lane);
        }
        if (!more) break;
#pragma unroll
        for (int j = 0; j < 8; ++j) hp[j] = hn[j];
        myinv = ninv; row = nrow;
    }
#undef CMB_LOAD
}
constexpr int KP = 272;
constexpr int VP = 288;
constexpr int ATT_VOFF = 64 * KP;
constexpr int ATT_TILE = 64 * KP + 64 * VP;
constexpr int ATT_OST = 2 * ATT_TILE;
DI float xhalf_max(float v) { auto rr = __builtin_amdgcn_permlane32_swap(__float_as_uint(v), __float_as_uint(v), false, false); return fmaxf(__uint_as_float(rr[0]), __uint_as_float(rr[1])); }
DI float xhalf_sum(float v) { auto rr = __builtin_amdgcn_permlane32_swap(__float_as_uint(v), __float_as_uint(v), false, false); return __uint_as_float(rr[0]) + __uint_as_float(rr[1]); }
DI int crow(int reg, int h) { return (reg & 3) + 8 * (reg >> 2) + 4 * h; }
DI long long vtr64(const LAS unsigned char* p) { typedef short v4i16_t __attribute__((ext_vector_type(4))); return __builtin_bit_cast(long long, __builtin_amdgcn_ds_read_tr16_b64_v4i16((LAS v4i16_t*)p)); }
DI s16x4 vtr(const LAS unsigned char* p) { typedef short v4i16_t __attribute__((ext_vector_type(4))); return __builtin_bit_cast(s16x4, __builtin_amdgcn_ds_read_tr16_b64_v4i16((LAS v4i16_t*)p)); }
DI bool att_tile_info(int item, int ti, int& base, int& mtype) {
    const int qhalf = item & 1, n = (item >> 3) & 15, b = item >> 7, tt = ti & 1; mtype = 0;
    if (ti < 4) { base = ML + b * CTXL + 64 * ti; return true; }
    const int blk = n - 1 + ((ti - 4) >> 1); if (blk < 0 || blk > 15) return false;
    if (ti < 6) { mtype = 1; if (tt == 0 && qhalf == 1) return false; } else if (ti >= 8) { mtype = 2; if (tt == 1 && qhalf == 0) return false; }
    base = b * SEQ + blk * 128 + 64 * tt; return true;
}
DI void att_next(int& item, int& ti, int G) { for (;;) { ++ti; if (ti >= 10) { ti = 0; item += G; return; } int b_, m_; if (att_tile_info(item, ti, b_, m_)) return; } }
DI void ph_attn(const bf16_t* Q, const bf16_t* Kb, const bf16_t* Vb, bf16_t* O, const float* sink, LAS unsigned char* lds, int tid, int lane, int wave, int bid, int G) {
    constexpr float LOG2E = 1.4426950408889634f;
    const int r = lane & 31, h = lane >> 5, g = wave >> 1, sub = wave & 1;
    const int ldrow = tid >> 3, ldc = tid & 7;
    int item = bid, ti = 0; if (item >= 1024) return;
    u32x4 kr[2], vr[2];
#define ATT_ISSUE(it_, ti_) do { int base_, mt_; att_tile_info(it_, ti_, base_, mt_); const int kvh_ = ((it_) >> 1) & 3; \
        _Pragma("unroll") for (int c2 = 0; c2 < 2; ++c2) { const size_t off_ = (size_t)(base_ + ldrow) * 512 + kvh_ * HD + (ldc + 8 * c2) * 8; kr[c2] = *(const u32x4*)(Kb + off_); vr[c2] = *(const u32x4*)(Vb + off_); } } while (0)
    bf16x8 qf[8]; float m2 = 0.f, lsum = 1.f; f32x16 o[4]; f32x16 negm;
#define ATT_QLOAD(it_) do { const int qrow_ = ((it_) >> 7) * SEQ + (((it_) >> 3) & 15) * 128 + ((it_) & 1) * 64 + sub * 32 + r; const int head_ = (((it_) >> 1) & 3) * 4 + g; \
        _Pragma("unroll") for (int s = 0; s < 8; ++s) qf[s] = *(const bf16x8*)(Q + (size_t)qrow_ * DM + head_ * HD + 16 * s + 8 * h); } while (0)
    ATT_QLOAD(item);
    ATT_ISSUE(item, ti);
    int buf = 0;
    while (item < 1024) {
        int nitem = item, nti = ti; att_next(nitem, nti, G);
        LAS unsigned char* tb = lds + buf * ATT_TILE;
#pragma unroll
        for (int c2 = 0; c2 < 2; ++c2) { *(LAS u32x4*)(tb + ldrow * KP + (ldc + 8 * c2) * 16) = kr[c2]; *(LAS u32x4*)(tb + ATT_VOFF + ldrow * VP + (ldc + 8 * c2) * 16) = vr[c2]; }
        if (nitem < 1024) ATT_ISSUE(nitem, nti);
        asm volatile("s_waitcnt lgkmcnt(0)" ::: "memory"); __builtin_amdgcn_s_barrier(); asm volatile("" ::: "memory");
        int base, mtype; att_tile_info(item, ti, base, mtype); const int tt = ti & 1;
        const int qhalf = item & 1, kvh = (item >> 1) & 3, n = (item >> 3) & 15, b = item >> 7;
        const int head = kvh * 4 + g, qq = qhalf * 64 + sub * 32 + r; const int qrow = b * SEQ + n * 128 + qq;
        if (ti == 0) {
            m2 = sink[head] * LOG2E; lsum = 1.0f;
#pragma unroll
            for (int i = 0; i < 16; ++i) negm[i] = -m2;
#pragma unroll
            for (int d = 0; d < 4; ++d)
#pragma unroll
                for (int i = 0; i < 16; ++i) o[d][i] = 0.f;
        }
        f32x16 x0, x1;
#pragma unroll
        for (int s = 0; s < 8; ++s) {
            const bf16x8 k0 = *(const LAS bf16x8*)(tb + r * KP + (16 * s + 8 * h) * 2), k1 = *(const LAS bf16x8*)(tb + (32 + r) * KP + (16 * s + 8 * h) * 2);
            if (s == 0) { x0 = __builtin_amdgcn_mfma_f32_32x32x16_bf16(k0, qf[s], negm, 0, 0, 0); x1 = __builtin_amdgcn_mfma_f32_32x32x16_bf16(k1, qf[s], negm, 0, 0, 0); }
            else { x0 = __builtin_amdgcn_mfma_f32_32x32x16_bf16(k0, qf[s], x0, 0, 0, 0); x1 = __builtin_amdgcn_mfma_f32_32x32x16_bf16(k1, qf[s], x1, 0, 0, 0); } }
        if (nitem != item && nitem < 1024) ATT_QLOAD(nitem);
        if (mtype == 1) {
#pragma unroll
            for (int i = 0; i < 16; ++i) { const int kk0 = tt * 64 + crow(i, h); if (kk0 < qq) x0[i] = -1.0e30f; if (kk0 + 32 < qq) x1[i] = -1.0e30f; } }
        if (mtype == 2) {
#pragma unroll
            for (int i = 0; i < 16; ++i) { const int kk0 = tt * 64 + crow(i, h); if (kk0 > qq) x0[i] = -1.0e30f; if (kk0 + 32 > qq) x1[i] = -1.0e30f; } }
        float tmax = fmaxf(x0[0], x1[0]);
#pragma unroll
        for (int i = 1; i < 16; ++i) tmax = fmaxf(fmaxf(tmax, x0[i]), x1[i]);
        tmax = xhalf_max(tmax);
        if (__any(tmax > 0.0f)) {
            const float dl = fmaxf(tmax, 0.0f), alpha = __builtin_amdgcn_exp2f(-dl); m2 += dl; lsum *= alpha;
#pragma unroll
            for (int i = 0; i < 16; ++i) { x0[i] -= dl; x1[i] -= dl; negm[i] = -m2; }
#pragma unroll
            for (int d = 0; d < 4; ++d)
#pragma unroll
                for (int i = 0; i < 16; ++i) o[d][i] *= alpha;
        }
        float ps = 0.f;
#pragma unroll
        for (int i = 0; i < 16; ++i) { x0[i] = __builtin_amdgcn_exp2f(x0[i]); x1[i] = __builtin_amdgcn_exp2f(x1[i]); ps += x0[i] + x1[i]; }
        lsum += xhalf_sum(ps);
        bf16x8 pf[2][2];
#pragma unroll
        for (int s = 0; s < 2; ++s) {
            u32x4 a, c; a.x = pk2(x0[8 * s + 0], x0[8 * s + 1]); a.y = pk2(x0[8 * s + 2], x0[8 * s + 3]); a.z = pk2(x0[8 * s + 4], x0[8 * s + 5]); a.w = pk2(x0[8 * s + 6], x0[8 * s + 7]);
            c.x = pk2(x1[8 * s + 0], x1[8 * s + 1]); c.y = pk2(x1[8 * s + 2], x1[8 * s + 3]); c.z = pk2(x1[8 * s + 4], x1[8 * s + 5]); c.w = pk2(x1[8 * s + 6], x1[8 * s + 7]);
            pf[0][s] = __builtin_bit_cast(bf16x8, a); pf[1][s] = __builtin_bit_cast(bf16x8, c); }
        const LAS unsigned char* vb = tb + ATT_VOFF + (4 * h + ((lane & 15) >> 2)) * VP + (16 * ((lane >> 4) & 1) + 4 * (lane & 3)) * 2;
#pragma unroll
        for (int d = 0; d < 4; ++d)
#pragma unroll
            for (int t = 0; t < 2; ++t)
#pragma unroll
                for (int s = 0; s < 2; ++s) {
                    typedef long long i64x2_t __attribute__((ext_vector_type(2)));
                    i64x2_t vv; vv.x = vtr64(vb + (t * 32 + 16 * s) * VP + d * 64); vv.y = vtr64(vb + (t * 32 + 16 * s + 8) * VP + d * 64);
                    const bf16x8 vf = __builtin_bit_cast(bf16x8, vv);
                    o[d] = __builtin_amdgcn_mfma_f32_32x32x16_bf16(vf, pf[t][s], o[d], 0, 0, 0); }
        if (nitem != item) {
            const float il = 1.0f / lsum;
            LAS unsigned char* st = lds + ATT_OST + wave * (32 * KP);
#pragma unroll
            for (int d = 0; d < 4; ++d)
#pragma unroll
                for (int g4 = 0; g4 < 4; ++g4) { u32x2 w; w.x = pk2(o[d][4 * g4 + 0] * il, o[d][4 * g4 + 1] * il); w.y = pk2(o[d][4 * g4 + 2] * il, o[d][4 * g4 + 3] * il);
                    *(LAS u32x2*)(st + r * KP + (d * 32 + 8 * g4 + 4 * h) * 2) = w; }
            asm volatile("s_waitcnt lgkmcnt(0)" ::: "memory");
            bf16_t* ob = O + (size_t)(qrow - r) * DM + head * HD;
#pragma unroll
            for (int j = 0; j < 8; ++j) { const int c = lane + 64 * j, row = c >> 4, c16 = c & 15;
                const u32x4 v = *(const LAS u32x4*)(st + row * KP + c16 * 16); *(u32x4*)(ob + (size_t)row * DM + c16 * 8) = v; }
        }
        item = nitem; ti = nti; buf ^= 1;
    }
#undef ATT_ISSUE
#undef ATT_QLOAD
}
#ifndef MK_ONE_LAUNCH
#define MK_ONE_LAUNCH 1
#endif
constexpr int NPHASE = 19;
constexpr int CVT_X0_END = CVT_E0 + CVT_L;
#define CVT_MKCP() CvtPtrs CP; CP.cin = args.in[8]; CP.cout = args.in[10]; CP.wqkv = args.in[11]; CP.wo = args.in[15]; CP.wg = args.in[17]; CP.wu = args.in[18]; CP.wd = args.in[19]; \
    CP.W1A = W1A; CP.W1B = W1B; CP.W2 = W2; CP.WQKV = WQKV; CP.WO = WOt; CP.WGU = WGU; CP.WDN = WDN
#define CVT(LO, HI) do { CVT_MKCP(); cvt_range(CP, LO, HI, gw, NGW, cscr, lane); } while (0)
#ifndef MK_DUP_MASK
#define MK_DUP_MASK 0u
#endif
constexpr unsigned DUP_MASK = MK_DUP_MASK;
struct Args { const float* in[20]; float* out; unsigned char* ws; int ph_lo, ph_hi; };
__global__ void __launch_bounds__(512, 2) dit_fwd(Args args) {
    extern __shared__ __attribute__((aligned(16))) unsigned char lds_raw[];
    LAS unsigned char* lds = (LAS unsigned char*)lds_raw;
    const int tid = threadIdx.x, lane = tid & 63, wave = __builtin_amdgcn_readfirstlane(tid >> 6);
    const int G = gridDim.x, bid = blockIdx.x;
    const int gw = bid * 8 + wave, NGW = G * 8;
    unsigned char* ws = args.ws;
    const float* x = args.in[0]; const float* cnd = args.in[1]; const float* ctx = args.in[2]; const float* cctx = args.in[3];
    const float* ada_w = args.in[4]; const float* ada_b = args.in[5]; const float* nmix = args.in[6]; const float* nffn = args.in[7];
    const float* conv_w = args.in[9]; const float* qgain = args.in[12]; const float* kgain = args.in[13]; const float* sink = args.in[14]; const float* router_w = args.in[16];
    float* mod = (float*)(ws + WS_MOD); float* modp = (float*)(ws + WS_MODP);
    float* affL = (float*)(ws + WS_AFFL); float* affC = (float*)(ws + WS_AFFC);
    float* rwt = (float*)(ws + WS_RWT);
    int* idmap = (int*)(ws + WS_IDMAP);
    int* rowsrc = (int*)(ws + WS_ROWSRC); float* gatev = (float*)(ws + WS_GATEV); int* inv = (int*)(ws + WS_INV);
    bf16_t* W1A = (bf16_t*)(ws + WS_W1A); bf16_t* W1B = (bf16_t*)(ws + WS_W1B); bf16_t* W2 = (bf16_t*)(ws + WS_W2); bf16_t* WQKV = (bf16_t*)(ws + WS_WQKV); bf16_t* WOt = (bf16_t*)(ws + WS_WO);
    bf16_t* WGU = (bf16_t*)(ws + WS_WGU); bf16_t* WDN = (bf16_t*)(ws + WS_WDN);
    bf16_t* H = (bf16_t*)(ws + WS_H); bf16_t* A = (bf16_t*)(ws + WS_A); bf16_t* U = (bf16_t*)(ws + WS_U); bf16_t* Z = (bf16_t*)(ws + WS_Z);
    bf16_t* Qb = (bf16_t*)(ws + WS_Q); bf16_t* Kb = (bf16_t*)(ws + WS_K); bf16_t* Vb = (bf16_t*)(ws + WS_V); bf16_t* Ob = (bf16_t*)(ws + WS_O);
    bf16_t* HM = (bf16_t*)(ws + WS_HM); bf16_t* Y = (bf16_t*)(ws + WS_Y);
    LAS unsigned* cscr = (LAS unsigned*)(lds + wave * 9216);

    for (int u = tid; u < (LDS_BYTES - MISC_OFF) / 4; u += 512) ((LAS unsigned*)(lds + MISC_OFF))[u] = 0u;
    __syncthreads();
#if MK_ONE_LAUNCH
    XcdBarrier bar = xcd_barrier_post((unsigned*)(ws + WS_CTL) + CW_BAR, (volatile LAS unsigned*)(lds + MISC_OFF) + 8);
#define GRID_BAR() xcd_barrier(bar)
#else
#define GRID_BAR() do {} while (0)
#endif
    const int lo = args.ph_lo, hi = args.ph_hi;
#define IN(k) (lo <= (k) && (k) < hi)
#define SEAM(k) do { if (IN(k) && IN((k) + 1)) GRID_BAR(); } while (0)
#define PHASE(k) if (IN(k)) _Pragma("unroll") for (int rep_ = 0; rep_ < 1 + (int)((DUP_MASK >> (k)) & 1u); ++rep_)
#define REP_BAR() do { if (rep_) GRID_BAR(); } while (0)

    PHASE(0) { REP_BAR(); ph_adaln(cnd, cctx, ada_w, modp, gw, NGW, lane); } SEAM(0);
    PHASE(1) { REP_BAR(); ph_modred(modp, ada_b, mod, bid * 512 + tid, G * 512); ph_rwt(router_w, rwt, bid * 512 + tid, G * 512); for (int i = bid * 512 + tid; i < YT; i += G * 512) idmap[i] = i; } SEAM(1);
    PHASE(2) { REP_BAR(); ph_mod0(x, ctx, nmix, mod, A, gw, NGW, lane); CVT(0, 4096); } SEAM(2);
    PHASE(3) { REP_BAR();
        pg8::Gemm g{A, W1A, MT, 4096, DM}; pg8::StaticOrder S; S.init(MT, 4096, G, bid);
        EpiPair<0> E{U, DM, 16};
        pg8::gemm_phase<EpiPair<0>, pg8::StaticOrder, true, true>(lds, g, S, E);
    } SEAM(3);
    PHASE(4) { REP_BAR();
        pg8::Gemm g{A, W1B, MT, DM, DM}; pg8::StaticOrder S; S.init(MT, DM, G, bid);
        EpiConvGate E{U, Z, conv_w};
        pg8::gemm_phase<EpiConvGate, pg8::StaticOrder, true, true>(lds, g, S, E);
    } SEAM(4);
    PHASE(5) { REP_BAR();
        pg8::Gemm g{Z, W2, MT, DM, DM}; pg8::StaticOrder S; S.init(MT, DM, G, bid);
        EpiResid<true> E{x, ctx, H, mod + 2 * DM};
        pg8::gemm_phase<EpiResid<true>, pg8::StaticOrder, true, true>(lds, g, S, E);
    } SEAM(5);
    PHASE(6) { REP_BAR(); load_router(rwt, (LAS float*)lds, tid); ph_modffn(H, nffn, mod, A, (const LAS float*)lds, affL, affC, MT, gw, NGW, lane); } SEAM(6);
    PHASE(7) { REP_BAR(); ph_topk(256, affL, affC, rowsrc, gatev, inv, (LAS unsigned*)lds, tid, lane, wave, bid, G); CVT(CVT_E0, CVT_E0 + 16384); } SEAM(7);
    PHASE(8) { REP_BAR();
        pg8::Gemm g{A, WGU, YT, NE * 2048, DM / 2, rowsrc}; MoeOrder S{G, bid, 9};
        EpiPairF8 E{(unsigned char*)HM, DFF, 8};
        pg8::gemm_phase<EpiPairF8, MoeOrder, true, true, true, true>(lds, g, S, E);
        CVT(CVT_E0 + 16384, CVT_X0_END);
    } SEAM(8);
    PHASE(9) { REP_BAR();
        pg8::Gemm g{HM, WDN, YT, NE * 2048, DFF / 2, idmap}; MoeOrder S{G, bid, 9};
        EpiDown E{Y, gatev, W8_INV * Y8_SCALE};
        pg8::gemm_phase<EpiDown, MoeOrder, true, true, true, true>(lds, g, S, E);
    } SEAM(9);
    PHASE(10) { REP_BAR(); ph_combine<false>(H, Y, inv, mod, nmix + DM, mod + 9 * NMOD, A, nullptr, MT, gw, NGW, lane); CVT(4096, 4096 + 1536); } SEAM(10);
    PHASE(11) { REP_BAR();
        pg8::Gemm g{A, WQKV, MT, 3072, DM}; QkvOrder S{G, bid};
        EpiQkvNorm E{Qb, Kb, Vb, qgain, kgain, (LAS float*)(lds + RING_BYTES)};
        pg8::gemm_phase<EpiQkvNorm, QkvOrder, true, true>(lds, g, S, E);
    } SEAM(11);
    PHASE(12) { REP_BAR(); ph_attn(Qb, Kb, Vb, Ob, sink, lds, tid, lane, wave, bid, G); __syncthreads(); CVT(4096 + 1536, CVT_E0); } SEAM(12);
    PHASE(13) { REP_BAR();
        pg8::Gemm g{Ob, WOt, ML, DM, DM}; pg8::StaticOrder S; S.init(ML, DM, G, bid);
        EpiResid<false> E{nullptr, nullptr, H, mod + 9 * NMOD + 2 * DM};
        pg8::gemm_phase<EpiResid<false>, pg8::StaticOrder, true, true>(lds, g, S, E);
    } SEAM(13);
    PHASE(14) { REP_BAR(); load_router(rwt + DM * 16, (LAS float*)lds, tid); ph_modffn(H, nffn + DM, mod + 9 * NMOD, A, (const LAS float*)lds, affL, affC, ML, gw, NGW, lane); } SEAM(14);
    PHASE(15) { REP_BAR(); ph_topk(128, affL, affC, rowsrc, gatev, inv, (LAS unsigned*)lds, tid, lane, wave, bid, G); CVT(CVT_X0_END, CVT_X0_END + 16384); } SEAM(15);
    PHASE(16) { REP_BAR();
        pg8::Gemm g{A, (const bf16_t*)((const unsigned char*)WGU + (size_t)NE * 2048 * DM), YT, NE * 2048, DM / 2, rowsrc}; MoeOrder S{G, bid, 8};
        EpiPairF8 E{(unsigned char*)HM, DFF, 8};
        pg8::gemm_phase<EpiPairF8, MoeOrder, true, true, true, true>(lds, g, S, E);
        CVT(CVT_X0_END + 16384, CVT_TOTAL);
    } SEAM(16);
    PHASE(17) { REP_BAR();
        pg8::Gemm g{HM, (const bf16_t*)((const unsigned char*)WDN + (size_t)NE * 2048 * DFF), YT, NE * 2048, DFF / 2, idmap}; MoeOrder S{G, bid, 8};
        EpiDown E{Y, gatev, W8_INV * Y8_SCALE};
        pg8::gemm_phase<EpiDown, MoeOrder, true, true, true, true>(lds, g, S, E);
    } SEAM(17);
    PHASE(18) { REP_BAR(); ph_combine<true>(H, Y, inv, mod + 9 * NMOD, nullptr, nullptr, nullptr, args.out, ML, gw, NGW, lane); }
#undef IN
#undef SEAM
#undef PHASE
#undef REP_BAR
}

extern "C" void kernel_launch(void* const* d_in, const int* in_sizes, int n_in, void* d_out, int out_size, void* d_ws, size_t ws_size, hipStream_t stream) {
    static int grid = 0;
    if (grid == 0) {
        if (n_in != 20 || out_size != ML * DM || ws_size < WS_END) { fprintf(stderr, "kernel_launch: unexpected problem (n_in %d, out %d, ws %zu); nothing launched\n", n_in, out_size, ws_size); grid = -1; return; }
        int dev = 0, cus = 0, per_cu = 0;
        if (hipGetDevice(&dev) != hipSuccess || hipDeviceGetAttribute(&cus, hipDeviceAttributeMultiprocessorCount, dev) != hipSuccess) { grid = -1; return; }
        if (hipFuncSetAttribute((const void*)dit_fwd, hipFuncAttributeMaxDynamicSharedMemorySize, LDS_BYTES) != hipSuccess) { fprintf(stderr, "kernel_launch: hipFuncSetAttribute failed\n"); grid = -1; return; }
        if (hipOccupancyMaxActiveBlocksPerMultiprocessor(&per_cu, (const void*)dit_fwd, 512, LDS_BYTES) != hipSuccess || per_cu < 1) fprintf(stderr, "kernel_launch: occupancy query reports %d workgroups per CU\n", per_cu);
        (void)hipGetLastError();
        grid = cus;
    }
    if (grid < 0) return;
    (void)hipMemsetAsync((char*)d_ws + WS_CTL, 0, CTL_ZERO_BYTES, stream);
    Args a{};
    for (int i = 0; i < 20; ++i) a.in[i] = (const float*)d_in[i];
    a.out = (float*)d_out; a.ws = (unsigned char*)d_ws;
#if MK_ONE_LAUNCH
    a.ph_lo = 0; a.ph_hi = NPHASE;
    hipLaunchKernelGGL(dit_fwd, dim3(grid), dim3(512), LDS_BYTES, stream, a);
#else
    for (int p = 0; p < NPHASE; ++p) { a.ph_lo = p; a.ph_hi = p + 1; hipLaunchKernelGGL(dit_fwd, dim3(grid), dim3(512), LDS_BYTES, stream, a); }
#endif
}
```

```cpp
#include <hip/hip_runtime.h>
#include <cstdio>
#include <cstdint>
namespace pg8 {
#define PG8_LAS __attribute__((address_space(3)))
typedef unsigned short bf16_t;
typedef short bf16x8 __attribute__((ext_vector_type(8)));
typedef float f32x4 __attribute__((ext_vector_type(4)));
typedef unsigned u32x4 __attribute__((ext_vector_type(4)));
constexpr int BM = 256, BK = 64, HALF = 128, HTB = HALF * BK * 2  , STAGE_BYTES = 8 * HTB, NXCD = 8, WGM = 8;

__host__ __device__ __forceinline__ int lds_byte(int r, int c) { const int st = (r >> 4) * 2 + (c >> 5), rr = r & 15, cc = c & 31, ob = rr * 64 + cc * 2; return st * 1024 + (ob ^ (((ob >> 9) & 1) << 5)); }
__host__ __device__ __forceinline__ void stage_rc(int b, int& R, int& C) { const int st = b / 1024, sb = b % 1024, swz = sb ^ (((sb >> 9) & 1) << 5); R = (st >> 1) * 16 + swz / 64; C = (st & 1) * 32 + (swz % 64) / 2; }
__host__ __device__ __forceinline__ int perm32(int rho) { const int n = rho >> 4, i = rho & 15; return 8 * (i >> 2) + 4 * n + (i & 3); }

struct Unit { int pm, pn; };
struct Gemm { const bf16_t* A; const bf16_t* Bt; int M, N, K; const int* rows = nullptr; };

struct StaticOrder {
    int nM, nN, nwg, G, c;
    __host__ __device__ void init(int M, int N, int G_, int c_) { nM = M / BM; nN = N / BM; nwg = nM * nN; G = G_; c = c_; }
    __host__ __device__ bool next(int i, Unit& u) const {
        const long L = (long)i * G + c; if (L >= nwg) return false;
        int wgid = (int)L; { const int q = nwg / NXCD, r = nwg % NXCD, xcd = wgid % NXCD, off = wgid / NXCD; wgid = (xcd < r ? xcd * (q + 1) : r * (q + 1) + (xcd - r) * q) + off; }
        const int nig = WGM * nN, gid = wgid / nig, fm = gid * WGM, gsz = (nM - fm) < WGM ? (nM - fm) : WGM;
        u.pm = fm + ((wgid % nig) % gsz); u.pn = (wgid % nig) / gsz; return true;
    }
    __device__ __forceinline__ void a_ready(const Unit&) const {}
    __device__ __forceinline__ void done(const Unit&) const {}
};
__device__ __forceinline__ unsigned cvt_pk_bf16(float lo, float hi) { unsigned r; asm volatile("v_cvt_pk_bf16_f32 %0, %1, %2" : "=v"(r) : "v"(lo), "v"(hi)); return r; }
typedef float f32x2 __attribute__((ext_vector_type(2)));
template <class Epi, class Sched, bool ALIGN_EPI = false, bool SP2 = false, bool GATHER = false, bool F8 = false>
__device__ __forceinline__ void gemm_phase(PG8_LAS unsigned char* lds, const Gemm g, const Sched& S, const Epi& E) {
    typedef int i32x4_t __attribute__((ext_vector_type(4)));
    const int tid = threadIdx.x, wid = __builtin_amdgcn_readfirstlane(tid >> 6), lane = tid & 63, wr = wid >> 2, wc = wid & 3, fr = lane & 15, fq = lane >> 4;
    const int K = g.K, nt = K / BK;
    unsigned voffA[2], voffB[2];
#pragma unroll
    for (int i = 0; i < 2; ++i) { int R, C; stage_rc(tid * 16 + i * 8192, R, C); const int Rb = Epi::PERM ? ((R & ~31) + perm32(R & 31)) : R;
        voffA[i] = (unsigned)(R * K + C) * 2u; voffB[i] = (unsigned)(Rb * K + C) * 2u; }
    const size_t kstep = (size_t)(BK * 2);
    const size_t hstep = (size_t)HALF * K * 2;
    const size_t tstep = 2 * hstep;
    const unsigned ldsw = (unsigned)wid * 1024u;
    const int aoff = lds_byte(wr * 64 + fr, fq * 8), boff = lds_byte(wc * 32 + fr, fq * 8);
#define PG8_SA(b, h) (((b) * 2 + (h)) * HTB)
#define PG8_SB(b, h) ((4 + (b) * 2 + (h)) * HTB)
#define PG8_UNI(p) ((const char*)(((unsigned long long)(unsigned)__builtin_amdgcn_readfirstlane((int)((unsigned long long)(p) >> 32)) << 32) | (unsigned long long)(unsigned)__builtin_amdgcn_readfirstlane((int)(unsigned long long)(p))))
#define PG8_STAGE(bufoff, gbase, voff) do { const char* gb_ = PG8_UNI(gbase);     \
        _Pragma("unroll") for (int _i = 0; _i < 2; ++_i) \
        __builtin_amdgcn_global_load_lds((const unsigned*)(gb_ + (voff)[_i]), (PG8_LAS unsigned*)(lds + (bufoff) + ldsw + _i * 8192), 16, 0, 0); } while (0)
#define PG8_STAGE_A(bufoff, kptr, h) do { if constexpr (GATHER) { PG8_STAGE(bufoff, kptr, vA[h]); } else { PG8_STAGE(bufoff, (kptr) + (h) * hstep, voffA); } } while (0)
#define PG8_GATHER_SWITCH() do { if constexpr (GATHER) { if (last && has_next) { asm volatile("" : "+v"(nv[0]), "+v"(nv[1]), "+v"(nv[2]), "+v"(nv[3])); \
        vA[0][0] = nv[0] * (unsigned)(K * 2) + gcoff[0]; vA[0][1] = nv[1] * (unsigned)(K * 2) + gcoff[1]; vA[1][0] = nv[2] * (unsigned)(K * 2) + gcoff[0]; vA[1][1] = nv[3] * (unsigned)(K * 2) + gcoff[1]; } } } while (0)
#define PG8_LDA(dst, b, h) do { _Pragma("unroll") for (int m = 0; m < 4; ++m) { if constexpr (F8) { dst##8[m] = PG8_CAT8(*(const PG8_LAS i32x4_t*)(lds + PG8_SA(b, h) + aoff + m * 2048), *(const PG8_LAS i32x4_t*)(lds + PG8_SA(b, h) + aoff + m * 2048 + 1024)); } \
        else { _Pragma("unroll") for (int k = 0; k < 2; ++k) dst[m][k] = *(const PG8_LAS bf16x8*)(lds + PG8_SA(b, h) + aoff + m * 2048 + k * 1024); } } } while (0)
#define PG8_LDB(dst, b, h) do { _Pragma("unroll") for (int n = 0; n < 2; ++n) { if constexpr (F8) { dst##8[n] = PG8_CAT8(*(const PG8_LAS i32x4_t*)(lds + PG8_SB(b, h) + boff + n * 2048), *(const PG8_LAS i32x4_t*)(lds + PG8_SB(b, h) + boff + n * 2048 + 1024)); } \
        else { _Pragma("unroll") for (int k = 0; k < 2; ++k) dst[n][k] = *(const PG8_LAS bf16x8*)(lds + PG8_SB(b, h) + boff + n * 2048 + k * 1024); } } } while (0)
#define PG8_CAT8(lo_, hi_) __builtin_shufflevector(lo_, hi_, 0, 1, 2, 3, 4, 5, 6, 7)
#define PG8_MMA(ai, bj, At, Bt) do { __builtin_amdgcn_s_setprio(1); _Pragma("unroll") for (int m = 0; m < 4; ++m) _Pragma("unroll") for (int n = 0; n < 2; ++n) { \
        if constexpr (F8) { acc[ai][bj][m][n] = __builtin_amdgcn_mfma_scale_f32_16x16x128_f8f6f4(Bt##8[n], At##8[m], acc[ai][bj][m][n], 0, 0, 0, 0x7f7f7f7f, 0, 0x7f7f7f7f); } \
        else { _Pragma("unroll") for (int k = 0; k < 2; ++k) acc[ai][bj][m][n] = __builtin_amdgcn_mfma_f32_16x16x32_bf16(Bt[n][k], At[m][k], acc[ai][bj][m][n], 0, 0, 0); } } \
        __builtin_amdgcn_s_setprio(0); } while (0)
#define PG8_WAIT_V(n) asm volatile("s_waitcnt vmcnt(" #n ")" ::: "memory")
#define PG8_WAIT_L(n) asm volatile("s_waitcnt lgkmcnt(" #n ")" ::: "memory")
#define PG8_BAR __builtin_amdgcn_s_barrier()
#define PG8_SCHED __builtin_amdgcn_sched_barrier(0)
    Unit cur, nxt; int ui = 0;
    if (!S.next(0, cur)) return;
    f32x4 acc[2][2][4][2];
#pragma unroll
    for (int a = 0; a < 2; ++a)
#pragma unroll
        for (int b = 0; b < 2; ++b)
#pragma unroll
            for (int m = 0; m < 4; ++m)
#pragma unroll
                for (int n = 0; n < 2; ++n) acc[a][b][m][n] = (f32x4){0.f, 0.f, 0.f, 0.f};
    bf16x8 At[4][2], B0[2][2], B1[2][2]; typedef int i32x8_t __attribute__((ext_vector_type(8))); i32x8_t At8[4], B08[2], B18[2];
    const char* cA = (const char*)g.A + (GATHER ? (size_t)0 : (size_t)cur.pm * tstep); const char* cB = (const char*)g.Bt + (size_t)cur.pn * tstep;
    unsigned vA[2][2], nv[4], gcoff[2]; int grow[2];
    if constexpr (GATHER) {
#pragma unroll
        for (int i = 0; i < 2; ++i) { int R, C; stage_rc(tid * 16 + i * 8192, R, C); grow[i] = R; gcoff[i] = (unsigned)(C * 2); }
#pragma unroll
        for (int h = 0; h < 2; ++h)
#pragma unroll
            for (int i = 0; i < 2; ++i) vA[h][i] = (unsigned)g.rows[cur.pm * BM + h * HALF + grow[i]] * (unsigned)(K * 2) + gcoff[i];
    }
    S.a_ready(cur);
    if constexpr (SP2) {
        PG8_STAGE(PG8_SB(0, 0), cB, voffB); PG8_STAGE(PG8_SB(0, 1), cB + hstep, voffB); PG8_STAGE_A(PG8_SA(0, 0), cA, 0); PG8_STAGE_A(PG8_SA(0, 1), cA, 1);
        if (wr == 1) PG8_BAR;
        PG8_WAIT_V(2); PG8_BAR;
        PG8_STAGE(PG8_SB(1, 0), cB + kstep, voffB); PG8_STAGE_A(PG8_SA(1, 0), cA + kstep, 0); PG8_STAGE(PG8_SB(1, 1), cB + hstep + kstep, voffB);
        PG8_WAIT_V(6); PG8_BAR;
    } else {
        PG8_STAGE(PG8_SB(0, 0), cB, voffB); PG8_STAGE_A(PG8_SA(0, 0), cA, 0); PG8_STAGE(PG8_SB(0, 1), cB + hstep, voffB); PG8_STAGE_A(PG8_SA(0, 1), cA, 1);
        if (wr == 1) PG8_BAR;
        PG8_WAIT_V(4); PG8_BAR;
        PG8_STAGE(PG8_SB(1, 0), cB + kstep, voffB); PG8_STAGE_A(PG8_SA(1, 0), cA + kstep, 0); PG8_STAGE(PG8_SB(1, 1), cB + hstep + kstep, voffB);
        PG8_WAIT_V(6); PG8_BAR;
    }
    for (;;) {
        const bool has_next = S.next(ui + 1, nxt);
        const char* nA = (has_next && !GATHER) ? (const char*)g.A + (size_t)nxt.pm * tstep : cA; const char* nB = has_next ? (const char*)g.Bt + (size_t)nxt.pn * tstep : cB;
        if constexpr (GATHER) { if (has_next) { const int* rp = g.rows + nxt.pm * BM;
            asm volatile("global_load_dword %0, %1, off" : "=&v"(nv[0]) : "v"(rp + grow[0]) : "memory"); asm volatile("global_load_dword %0, %1, off" : "=&v"(nv[1]) : "v"(rp + grow[1]) : "memory");
            asm volatile("global_load_dword %0, %1, off" : "=&v"(nv[2]) : "v"(rp + HALF + grow[0]) : "memory"); asm volatile("global_load_dword %0, %1, off" : "=&v"(nv[3]) : "v"(rp + HALF + grow[1]) : "memory"); } }
#pragma unroll 1
        for (int t = 0; t < nt; t += 2) {
            const bool last = (t == nt - 2);
            const char* a1 = cA + (size_t)(t + 1) * kstep;
            const char* a2 = last ? nA : cA + (size_t)(t + 2) * kstep; const char* b2 = last ? nB : cB + (size_t)(t + 2) * kstep;
            const char* a3 = a2 + kstep; const char* b3 = b2 + kstep;
            if (last && has_next) S.a_ready(nxt);
            if constexpr (SP2) {
            PG8_LDB(B0, 0, 0); PG8_LDB(B1, 0, 1); PG8_SCHED; PG8_LDA(At, 0, 0); PG8_STAGE_A(PG8_SA(1, 1), a1, 1); PG8_GATHER_SWITCH();
            PG8_WAIT_V(8); PG8_WAIT_L(0); PG8_BAR; PG8_MMA(0, 0, At, B0); PG8_MMA(0, 1, At, B1); PG8_BAR; PG8_SCHED;
            PG8_LDA(At, 0, 1); PG8_STAGE(PG8_SB(0, 0), b2, voffB); PG8_STAGE(PG8_SB(0, 1), b2 + hstep, voffB); PG8_STAGE_A(PG8_SA(0, 0), a2, 0);
            PG8_WAIT_V(8); PG8_WAIT_L(0); PG8_BAR; PG8_MMA(1, 0, At, B0); PG8_MMA(1, 1, At, B1); PG8_BAR; PG8_SCHED;
            PG8_LDB(B0, 1, 0); PG8_LDB(B1, 1, 1); PG8_SCHED; PG8_LDA(At, 1, 0); PG8_STAGE_A(PG8_SA(0, 1), a2, 1);
            PG8_WAIT_V(8); PG8_WAIT_L(0); PG8_BAR; PG8_MMA(0, 0, At, B0); PG8_MMA(0, 1, At, B1); PG8_BAR; PG8_SCHED;
            PG8_LDA(At, 1, 1); PG8_STAGE(PG8_SB(1, 0), b3, voffB); PG8_STAGE(PG8_SB(1, 1), b3 + hstep, voffB); PG8_STAGE_A(PG8_SA(1, 0), a3, 0);
            PG8_WAIT_V(8); PG8_WAIT_L(0); PG8_BAR; PG8_MMA(1, 0, At, B0); PG8_MMA(1, 1, At, B1); PG8_BAR; PG8_SCHED;
            } else {
            PG8_LDB(B0, 0, 0); PG8_SCHED; PG8_LDA(At, 0, 0); PG8_STAGE_A(PG8_SA(1, 1), a1, 1); PG8_GATHER_SWITCH();
            PG8_WAIT_L(8); PG8_BAR; PG8_WAIT_L(0); PG8_MMA(0, 0, At, B0); PG8_BAR; PG8_SCHED;
            PG8_LDB(B1, 0, 1); PG8_STAGE(PG8_SB(0, 0), b2, voffB);
            PG8_BAR; PG8_WAIT_L(0); PG8_MMA(0, 1, At, B1); PG8_BAR;
            PG8_LDA(At, 0, 1); PG8_STAGE_A(PG8_SA(0, 0), a2, 0);
            PG8_BAR; PG8_WAIT_L(0); PG8_MMA(1, 0, At, B0); PG8_BAR; PG8_SCHED;
            PG8_STAGE(PG8_SB(0, 1), b2 + hstep, voffB);
            PG8_WAIT_V(6); PG8_BAR; PG8_MMA(1, 1, At, B1); PG8_BAR;
            PG8_LDB(B0, 1, 0); PG8_SCHED; PG8_LDA(At, 1, 0); PG8_STAGE_A(PG8_SA(0, 1), a2, 1);
            PG8_WAIT_L(8); PG8_BAR; PG8_WAIT_L(0); PG8_MMA(0, 0, At, B0); PG8_BAR; PG8_SCHED;
            PG8_LDB(B1, 1, 1); PG8_STAGE(PG8_SB(1, 0), b3, voffB);
            PG8_BAR; PG8_WAIT_L(0); PG8_MMA(0, 1, At, B1); PG8_BAR;
            PG8_LDA(At, 1, 1); PG8_STAGE_A(PG8_SA(1, 0), a3, 0);
            PG8_BAR; PG8_WAIT_L(0); PG8_MMA(1, 0, At, B0); PG8_BAR; PG8_SCHED;
            PG8_STAGE(PG8_SB(1, 1), b3 + hstep, voffB);
            PG8_WAIT_V(6); PG8_BAR; PG8_MMA(1, 1, At, B1); PG8_BAR;
            }
        }
        if constexpr (ALIGN_EPI) { if (wr == 0) PG8_BAR; }
        if constexpr (!Epi::AFTER_DRAIN) { E(acc, cur, wr, wc, fr, fq); S.done(cur); }
        if (!has_next) break;
#pragma unroll
        for (int a = 0; a < 2; ++a)
#pragma unroll
            for (int b = 0; b < 2; ++b)
#pragma unroll
                for (int m = 0; m < 4; ++m)
#pragma unroll
                    for (int n = 0; n < 2; ++n) acc[a][b][m][n] = (f32x4){0.f, 0.f, 0.f, 0.f};
        cur = nxt; cA = nA; cB = nB; ++ui;
        if constexpr (ALIGN_EPI) { if (wr == 1) PG8_BAR; }
    }
    PG8_WAIT_V(0);
    if constexpr (!ALIGN_EPI) { if (wr == 0) PG8_BAR; }
    PG8_BAR;
    if constexpr (Epi::AFTER_DRAIN) { E.fused(acc, cur, wr, wc, fr, fq, lds, wid, lane); S.done(cur); }
#undef PG8_SA
#undef PG8_SB
#undef PG8_STAGE
#undef PG8_UNI
#undef PG8_STAGE_A
#undef PG8_GATHER_SWITCH
#undef PG8_LDA
#undef PG8_LDB
#undef PG8_MMA
#undef PG8_CAT8
#undef PG8_WAIT_V
#undef PG8_WAIT_L
#undef PG8_BAR
#undef PG8_SCHED
}
}

constexpr int DM = 2048, NB = 8, SEQ = 2048, CTXL = 256, NH = 16, NKV = 4, HD = 128;
constexpr int ML = NB * SEQ;
constexpr int MC = NB * CTXL;
constexpr int MT = ML + MC;
constexpr int NE = 16, CAPL = 256, CAPC = 32, DFF = 1024;
constexpr int YR = NB * CAPL + NB * CAPC;
constexpr int YT = NE * YR;
constexpr int NMOD = 6 * DM;
constexpr float NORM_EPS = 1e-6f;
constexpr int KSPLIT = 16;

using pg8::Unit; using pg8::f32x4; using pg8::u32x4; using pg8::bf16_t; using pg8::bf16x8; using pg8::cvt_pk_bf16;
typedef float f32x2 __attribute__((ext_vector_type(2)));
typedef unsigned u32x2 __attribute__((ext_vector_type(2)));
typedef float f32x16 __attribute__((ext_vector_type(16)));
typedef short s16x4 __attribute__((ext_vector_type(4)));
#define DI __device__ __forceinline__

DI float bf_lo(unsigned w) { return __uint_as_float(w << 16); }
DI float bf_hi(unsigned w) { return __uint_as_float(w & 0xffff0000u); }
DI unsigned pk4_fp8(float a, float b, float c, float d) {
    a = __builtin_amdgcn_fmed3f(a, -448.0f, 448.0f); b = __builtin_amdgcn_fmed3f(b, -448.0f, 448.0f); c = __builtin_amdgcn_fmed3f(c, -448.0f, 448.0f); d = __builtin_amdgcn_fmed3f(d, -448.0f, 448.0f);
    int w = __builtin_amdgcn_cvt_pk_fp8_f32(a, b, 0, false); w = __builtin_amdgcn_cvt_pk_fp8_f32(c, d, w, true); return (unsigned)w;
}
constexpr float Y8_SCALE = 64.0f, Y8_INV = 1.0f / 64.0f;
constexpr float W8_SCALE = 32.0f, W8_INV = 1.0f / 32.0f;
DI f32x4 unpk4_fp8(unsigned w) { const f32x2 lo = __builtin_amdgcn_cvt_pk_f32_fp8((int)w, false), hi = __builtin_amdgcn_cvt_pk_f32_fp8((int)w, true); return (f32x4){lo.x, lo.y, hi.x, hi.y}; }
DI float silu_f(float a) { return a * __builtin_amdgcn_rcpf(1.0f + __expf(-a)); }

DI int xcd_remap(int wgid, int nwg) { const int q = nwg / 8, r = nwg % 8, xcd = wgid % 8, off = wgid / 8; return (xcd < r ? xcd * (q + 1) : r * (q + 1) + (xcd - r) * q) + off; }
struct QkvOrder {
    int G, c;
    DI bool next(int i, Unit& u) const {
        const int L = i * G + c; if (L >= 800) return false;
        if (L < 768) { const int w = xcd_remap(L, 768); const int nig = 8 * 12, gid = w / nig; u.pm = gid * 8 + ((w % nig) % 8); u.pn = (w % nig) / 8; }
        else { const int j = L - 768; u.pm = 64 + (j >> 2); u.pn = 8 + (j & 3); }
        return true;
    }
    DI void a_ready(const Unit&) const {}
    DI void done(const Unit&) const {}
};
struct MoeOrder {
    int G, c, NP;
    DI bool next(int i, Unit& u) const {
        const int nwg = NE * NP * 8; const int L = i * G + c; if (L >= nwg) return false;
        const int w = xcd_remap(L, nwg); const int per = NP * 8, e = w / per, rem = w % per;
        u.pm = e * 9 + (rem % NP); u.pn = e * 8 + (rem / NP); return true;
    }
    DI void a_ready(const Unit&) const {}
    DI void done(const Unit&) const {}
};

template <int ACT  > struct EpiPair {
    static constexpr bool PERM = true, AFTER_DRAIN = false;
    bf16_t* O; int ldc; int pn_mod;
    DI void operator()(const f32x4 (&acc)[2][2][4][2], const Unit& u, int wr, int wc, int fr, int fq) const {
        const int row0 = u.pm * 256 + wr * 64 + fr, col0 = (u.pn % pn_mod) * 128 + wc * 32 + 8 * fq;
#pragma unroll
        for (int ai = 0; ai < 2; ++ai)
#pragma unroll
            for (int m = 0; m < 4; ++m) {
                bf16_t* rowp = O + (size_t)(row0 + ai * 128 + m * 16) * ldc + col0;
                f32x4 a0 = acc[ai][0][m][0], a1 = acc[ai][0][m][1]; const f32x4 b0 = acc[ai][1][m][0], b1 = acc[ai][1][m][1];
                if (ACT == 1) {
#pragma unroll
                    for (int j = 0; j < 4; ++j) { a0[j] = silu_f(a0[j]); a1[j] = silu_f(a1[j]); } }
                const f32x4 v0 = a0 * b0, v1 = a1 * b1;
                u32x4 w; w.x = cvt_pk_bf16(v0[0], v0[1]); w.y = cvt_pk_bf16(v0[2], v0[3]); w.z = cvt_pk_bf16(v1[0], v1[1]); w.w = cvt_pk_bf16(v1[2], v1[3]);
                *(u32x4*)rowp = w;
            }
    }
};
struct EpiPairF8 {
    static constexpr bool PERM = true, AFTER_DRAIN = false;
    unsigned char* O; int ldc; int pn_mod;
    DI void operator()(const f32x4 (&acc)[2][2][4][2], const Unit& u, int wr, int wc, int fr, int fq) const {
        const int row0 = u.pm * 256 + wr * 64 + fr, col0 = (u.pn % pn_mod) * 128 + wc * 32 + 8 * fq;
#pragma unroll
        for (int ai = 0; ai < 2; ++ai)
#pragma unroll
            for (int m = 0; m < 4; ++m) {
                unsigned char* rowp = O + (size_t)(row0 + ai * 128 + m * 16) * ldc + col0;
                f32x4 a0 = acc[ai][0][m][0] * W8_INV, a1 = acc[ai][0][m][1] * W8_INV; const f32x4 b0 = acc[ai][1][m][0] * W8_INV, b1 = acc[ai][1][m][1] * W8_INV;
#pragma unroll
                for (int j = 0; j < 4; ++j) { a0[j] = silu_f(a0[j]); a1[j] = silu_f(a1[j]); }
                const f32x4 v0 = a0 * b0, v1 = a1 * b1;
                u32x2 w; w.x = pk4_fp8(v0[0], v0[1], v0[2], v0[3]); w.y = pk4_fp8(v1[0], v1[1], v1[2], v1[3]);
                *(u32x2*)rowp = w;
            }
    }
};
struct EpiConvGate {
    static constexpr bool PERM = true, AFTER_DRAIN = false;
    const bf16_t* U; bf16_t* Z; const float* cw;
    DI void operator()(const f32x4 (&acc)[2][2][4][2], const Unit& u, int wr, int wc, int fr, int fq) const {
        const int row0 = u.pm * 256 + wr * 64 + fr, col0 = u.pn * 256 + wc * 32 + 8 * fq;
#pragma unroll
        for (int bj = 0; bj < 2; ++bj) {
            const int c = col0 + bj * 128;
            f32x4 w0a = *(const f32x4*)(cw + c), w0b = *(const f32x4*)(cw + c + 4), w1a = *(const f32x4*)(cw + 2048 + c), w1b = *(const f32x4*)(cw + 2048 + c + 4), w2a = *(const f32x4*)(cw + 4096 + c), w2b = *(const f32x4*)(cw + 4096 + c + 4);
#pragma unroll
            for (int ai = 0; ai < 2; ++ai)
#pragma unroll
                for (int m = 0; m < 4; ++m) {
                    const int row = row0 + ai * 128 + m * 16;
                    const int tpos = row < ML ? (row & (SEQ - 1)) : ((row - ML) & (CTXL - 1)); const int len = row < ML ? SEQ : CTXL;
                    const u32x4 z4 = (u32x4){0u, 0u, 0u, 0u};
                    const u32x4 uc = *(const u32x4*)(U + (size_t)row * DM + c);
                    const u32x4 up = tpos > 0 ? *(const u32x4*)(U + (size_t)(row - 1) * DM + c) : z4;
                    const u32x4 un = tpos < len - 1 ? *(const u32x4*)(U + (size_t)(row + 1) * DM + c) : z4;
                    f32x4 ya, yb;
                    ya[0] = w0a[0] * bf_lo(up.x) + w1a[0] * bf_lo(uc.x) + w2a[0] * bf_lo(un.x); ya[1] = w0a[1] * bf_hi(up.x) + w1a[1] * bf_hi(uc.x) + w2a[1] * bf_hi(un.x);
                    ya[2] = w0a[2] * bf_lo(up.y) + w1a[2] * bf_lo(uc.y) + w2a[2] * bf_lo(un.y); ya[3] = w0a[3] * bf_hi(up.y) + w1a[3] * bf_hi(uc.y) + w2a[3] * bf_hi(un.y);
                    yb[0] = w0b[0] * bf_lo(up.z) + w1b[0] * bf_lo(uc.z) + w2b[0] * bf_lo(un.z); yb[1] = w0b[1] * bf_hi(up.z) + w1b[1] * bf_hi(uc.z) + w2b[1] * bf_hi(un.z);
                    yb[2] = w0b[2] * bf_lo(up.w) + w1b[2] * bf_lo(uc.w) + w2b[2] * bf_lo(un.w); yb[3] = w0b[3] * bf_hi(up.w) + w1b[3] * bf_hi(uc.w) + w2b[3] * bf_hi(un.w);
                    const f32x4 v0 = acc[ai][bj][m][0] * ya, v1 = acc[ai][bj][m][1] * yb;
                    u32x4 w; w.x = cvt_pk_bf16(v0[0], v0[1]); w.y = cvt_pk_bf16(v0[2], v0[3]); w.z = cvt_pk_bf16(v1[0], v1[1]); w.w = cvt_pk_bf16(v1[2], v1[3]);
                    *(u32x4*)(Z + (size_t)row * DM + c) = w;
                }
        }
    }
};
template <bool BASE_F32> struct EpiResid {
    static constexpr bool PERM = true, AFTER_DRAIN = false;
    const float* base_lat; const float* base_ctx; bf16_t* out; const float* gate; float ws;
    DI void operator()(const f32x4 (&acc)[2][2][4][2], const Unit& u, int wr, int wc, int fr, int fq) const {
        const int rowt = u.pm * 256; const int cr = rowt < ML ? (rowt >> 11) : 8;
        const float* base = rowt < ML ? base_lat : base_ctx - (size_t)ML * DM;
        const int row0 = rowt + wr * 64 + fr, col0 = u.pn * 256 + wc * 32 + 8 * fq;
        f32x4 gv[2][2];
#pragma unroll
        for (int bj = 0; bj < 2; ++bj)
#pragma unroll
            for (int n = 0; n < 2; ++n) gv[bj][n] = *(const f32x4*)(gate + (size_t)cr * NMOD + col0 + bj * 128 + n * 4) * ws;
#pragma unroll
        for (int ai = 0; ai < 2; ++ai)
#pragma unroll
            for (int m = 0; m < 4; ++m) { const size_t off = (size_t)(row0 + ai * 128 + m * 16) * DM + col0;
#pragma unroll
                for (int bj = 0; bj < 2; ++bj) { f32x4 b0, b1;
                    if (BASE_F32) { b0 = *(const f32x4*)(base + off + bj * 128); b1 = *(const f32x4*)(base + off + bj * 128 + 4); }
                    else { const u32x4 hb = *(const u32x4*)(out + off + bj * 128); b0 = (f32x4){bf_lo(hb.x), bf_hi(hb.x), bf_lo(hb.y), bf_hi(hb.y)}; b1 = (f32x4){bf_lo(hb.z), bf_hi(hb.z), bf_lo(hb.w), bf_hi(hb.w)}; }
                    const f32x4 v0 = b0 + gv[bj][0] * acc[ai][bj][m][0], v1 = b1 + gv[bj][1] * acc[ai][bj][m][1];
                    u32x4 w; w.x = cvt_pk_bf16(v0[0], v0[1]); w.y = cvt_pk_bf16(v0[2], v0[3]); w.z = cvt_pk_bf16(v1[0], v1[1]); w.w = cvt_pk_bf16(v1[2], v1[3]);
                    *(u32x4*)(out + off + bj * 128) = w; }
                asm volatile("" ::: "memory"); }
    }
};
struct EpiDown {
    static constexpr bool PERM = true, AFTER_DRAIN = false;
    bf16_t* Y; const float* gatev; float ws;
    DI void operator()(const f32x4 (&acc)[2][2][4][2], const Unit& u, int wr, int wc, int fr, int fq) const {
        const int row0 = u.pm * 256 + wr * 64 + fr, col0 = (u.pn & 7) * 256 + wc * 32 + 8 * fq;
#pragma unroll
        for (int ai = 0; ai < 2; ++ai)
#pragma unroll
            for (int m = 0; m < 4; ++m) { const int row = row0 + ai * 128 + m * 16; const float gt = gatev[row] * ws;
#pragma unroll
                for (int bj = 0; bj < 2; ++bj) { const f32x4 v0 = acc[ai][bj][m][0] * gt, v1 = acc[ai][bj][m][1] * gt;
                    u32x2 w; w.x = pk4_fp8(v0[0], v0[1], v0[2], v0[3]); w.y = pk4_fp8(v1[0], v1[1], v1[2], v1[3]);
                    *(u32x2*)((unsigned char*)Y + (size_t)row * DM + col0 + bj * 128) = w; } }
    }
};
#define LAS3 __attribute__((address_space(3)))
struct EpiQkvNorm {
    static constexpr bool PERM = true, AFTER_DRAIN = false;
    bf16_t* Q; bf16_t* K; bf16_t* V; const float* qg; const float* kg; LAS3 float* P;
    DI void operator()(const f32x4 (&acc)[2][2][4][2], const Unit& u, int wr, int wc, int fr, int fq) const {
        const int row0 = u.pm * 256 + wr * 64 + fr; int colt = u.pn * 256;
        if (colt >= 2560) {
            const int col0 = colt - 2560 + wc * 32 + 8 * fq;
#pragma unroll
            for (int ai = 0; ai < 2; ++ai)
#pragma unroll
                for (int m = 0; m < 4; ++m) { bf16_t* rowp = V + (size_t)(row0 + ai * 128 + m * 16) * 512 + col0;
#pragma unroll
                    for (int bj = 0; bj < 2; ++bj) { const f32x4 v0 = acc[ai][bj][m][0], v1 = acc[ai][bj][m][1];
                        u32x4 w; w.x = cvt_pk_bf16(v0[0], v0[1]); w.y = cvt_pk_bf16(v0[2], v0[3]); w.z = cvt_pk_bf16(v1[0], v1[1]); w.w = cvt_pk_bf16(v1[2], v1[3]);
                        *(u32x4*)(rowp + bj * 128) = w; } }
            return;
        }
        const bool isq = colt < 2048; bf16_t* base = isq ? Q : K; const int ld = isq ? 2048 : 512; if (!isq) colt -= 2048;
        const int rl0 = wr * 64 + fr;
#pragma unroll
        for (int ai = 0; ai < 2; ++ai)
#pragma unroll
            for (int m = 0; m < 4; ++m)
#pragma unroll
                for (int bj = 0; bj < 2; ++bj) { const f32x4 a = acc[ai][bj][m][0], b = acc[ai][bj][m][1];
                    float s = (a[0] * a[0] + a[1] * a[1]) + (a[2] * a[2] + a[3] * a[3]) + (b[0] * b[0] + b[1] * b[1]) + (b[2] * b[2] + b[3] * b[3]);
                    s += __shfl_xor(s, 16); s += __shfl_xor(s, 32);
                    if (fq == 0) P[((ai * 128 + m * 16 + rl0) * 2 + bj) * 4 + wc] = s; }
        asm volatile("s_waitcnt lgkmcnt(0)" ::: "memory"); __builtin_amdgcn_s_barrier(); asm volatile("" ::: "memory");
        constexpr float QSCALE = 0.08838834764831845f * 1.4426950408889634f;
        const int i0 = 16 * (wc & 1) + 4 * fq, d0 = 64 * (wc >> 1) + i0;
        const float* gp = isq ? qg : kg; f32x4 g0 = *(const f32x4*)(gp + d0), g1 = *(const f32x4*)(gp + d0 + 32);
        if (isq) { g0 = g0 * QSCALE; g1 = g1 * QSCALE; }
        f32x4 ifr;
#pragma unroll
        for (int j = 0; j < 4; ++j) ifr[j] = exp2f(-(float)(i0 + j) * (13.287712379549449f / 32.0f));
        const bool lat = u.pm < 64;
#pragma unroll
        for (int ai = 0; ai < 2; ++ai)
#pragma unroll
            for (int m = 0; m < 4; ++m) { const int row = row0 + ai * 128 + m * 16; const int t = row & (SEQ - 1);
                const float pos = (float)((wc >> 1) == 0 ? (t >> 6) : (t & 63));
                f32x4 cs, sn;
#pragma unroll
                for (int j = 0; j < 4; ++j) { const float ang = pos * ifr[j]; cs[j] = lat ? __cosf(ang) : 1.0f; sn[j] = lat ? __sinf(ang) : 0.0f; }
#pragma unroll
                for (int bj = 0; bj < 2; ++bj) { const f32x4 pp = *(const LAS3 f32x4*)(P + ((ai * 128 + m * 16 + rl0) * 2 + bj) * 4);
                    const float rstd = 1.0f / sqrtf(((pp[0] + pp[1]) + (pp[2] + pp[3])) * (1.0f / HD) + NORM_EPS);
                    const f32x4 a = acc[ai][bj][m][0] * rstd * g0, b = acc[ai][bj][m][1] * rstd * g1;
                    const f32x4 o1 = a * cs - b * sn, o2 = b * cs + a * sn;
                    u32x4 w; w.x = cvt_pk_bf16(o1[0], o1[1]); w.y = cvt_pk_bf16(o1[2], o1[3]); w.z = cvt_pk_bf16(o2[0], o2[1]); w.w = cvt_pk_bf16(o2[2], o2[3]);
                    *(u32x4*)(base + (size_t)row * ld + colt + bj * 128 + wc * 32 + 8 * fq) = w; } }
    }
};

constexpr size_t MiB = 1u << 20;
constexpr size_t WS_CTL = 0, CTL_ZERO_BYTES = 1 * MiB;
constexpr size_t WS_MOD = 1 * MiB;
constexpr size_t WS_MODP = 2 * MiB;
constexpr size_t WS_AFFL = 16 * MiB;
constexpr size_t WS_AFFC = 17 * MiB;
constexpr size_t WS_RWT = 17 * MiB + 128 * 1024;
constexpr size_t WS_IDMAP = 19 * MiB + 768 * 1024;
constexpr size_t WS_ROWSRC = 17 * MiB + 512 * 1024;
constexpr size_t WS_GATEV = 18 * MiB;
constexpr size_t WS_INV = 18 * MiB + 512 * 1024;
constexpr size_t WS_W1A = 20 * MiB;
constexpr size_t WS_W1B = 36 * MiB;
constexpr size_t WS_W2 = 44 * MiB;
constexpr size_t WS_WQKV = 52 * MiB;
constexpr size_t WS_WO = 64 * MiB;
constexpr size_t WS_WGU = 72 * MiB;
constexpr size_t WS_WDN = 328 * MiB;
constexpr size_t WS_H = 456 * MiB;
constexpr size_t WS_A = 600 * MiB;
constexpr size_t WS_U = 672 * MiB;
constexpr size_t WS_Z = 744 * MiB;
constexpr size_t WS_Q = WS_U, WS_K = WS_Z, WS_V = WS_Z + 18 * MiB;
constexpr size_t WS_HM = 816 * MiB;
constexpr size_t WS_O = WS_HM;
constexpr size_t WS_Y = 888 * MiB;
constexpr size_t WS_END = 1032 * MiB;
constexpr int CW_BAR = 4096;

constexpr int RING_BYTES = 131072;
constexpr int MISC_OFF = RING_BYTES + 14336;
constexpr int LDS_BYTES = 147456;

#define GAS __attribute__((address_space(1)))
#define LAS __attribute__((address_space(3)))
#define LDS_WAIT() asm volatile("s_waitcnt lgkmcnt(0)" ::: "memory")
#define VM_WAIT() asm volatile("s_waitcnt vmcnt(0)" ::: "memory")
#define XB_TMO      128
#define XB_XCNT(j)  (256  + 64 * (j))
#define XB_XSUB(j)  (1280 + 64 * (j))
#define XB_XGEN(j)  (2304 + 64 * (j))
#define XB_TOP      3328
#define XB_TOPGEN   3392
#define XCD_BAR_WORDS 3456
#define XB_SPIN_CAP (1u << 18)

__device__ __forceinline__ unsigned xb_ld(unsigned* p)              { return __hip_atomic_load(p, __ATOMIC_RELAXED, __HIP_MEMORY_SCOPE_AGENT); }
__device__ __forceinline__ unsigned xb_add(unsigned* p, unsigned v) { return __hip_atomic_fetch_add(p, v, __ATOMIC_RELAXED, __HIP_MEMORY_SCOPE_AGENT); }
__device__ __forceinline__ unsigned xb_xcc_id() { return (unsigned)__builtin_amdgcn_s_getreg((3 << 11) | 20) & 0xFu; }
#define XB_SPIN(cond, bar) do { unsigned _sp = 0; while (cond) { __builtin_amdgcn_s_sleep(1); \
    if ((++_sp & 255u) == 0u) { if (xb_ld(&(bar)[XB_TMO])) break; if (_sp > XB_SPIN_CAP) { atomicAdd(&(bar)[XB_TMO], 1u); break; } } } } while (0)

struct XcdBarrier {
    unsigned* bar; unsigned x;
    volatile LAS unsigned* st;
};

__device__ __forceinline__ XcdBarrier xcd_barrier_post(unsigned* bar, volatile LAS unsigned* st) {
    XcdBarrier b; b.bar = bar; b.x = xb_xcc_id(); b.st = st;
    if (threadIdx.x == 0) (void)xb_add(&bar[XB_XCNT(b.x)], 1u);
    return b;
}
__device__ __forceinline__ void xcd_barrier_complete(unsigned* bar, unsigned x, unsigned& nloc, unsigned& nx) {
    const unsigned G = gridDim.x * gridDim.y * gridDim.z;
    unsigned sum, cnt, mine, sp = 0u;
    for (;;) {
        sum = 0u; cnt = 0u; mine = 0u;
#pragma unroll
        for (unsigned j = 0; j < 16; ++j) { const unsigned c = xb_ld(&bar[XB_XCNT(j)]); sum += c; cnt += (c > 0u) ? 1u : 0u; mine = (j == x) ? c : mine; }
        if (sum == G) break;
        __builtin_amdgcn_s_sleep(1);
        if ((++sp & 255u) == 0u) { if (xb_ld(&bar[XB_TMO])) break; if (sp > XB_SPIN_CAP) { atomicAdd(&bar[XB_TMO], 1u); break; } }
    }
    nloc = mine > 0u ? mine : 1u; nx = cnt > 0u ? cnt : 1u;
}

__device__ __forceinline__ void xcd_barrier(const XcdBarrier& b) {
    asm volatile("s_waitcnt vmcnt(0)" ::: "memory");
    __syncthreads();
    if (threadIdx.x == 0) {
        unsigned* bar = b.bar;
        __builtin_amdgcn_s_waitcnt(0);
        unsigned nloc = b.st[0], nx = b.st[1];
        if (nloc == 0u) { xcd_barrier_complete(bar, b.x, nloc, nx); b.st[0] = nloc; b.st[1] = nx; }
        const unsigned old = xb_add(&bar[XB_XSUB(b.x)], 1u);
        const unsigned gen = old / nloc;
        if (old + 1u == (gen + 1u) * nloc) {
            __builtin_amdgcn_fence(__ATOMIC_RELEASE, "agent");
            asm volatile("s_waitcnt vmcnt(0)" ::: "memory");
            const unsigned og = xb_add(&bar[XB_TOP], 1u);
            const unsigned tg = og / nx;
            if (og + 1u == (tg + 1u) * nx) xb_add(&bar[XB_TOPGEN], 1u);
            else XB_SPIN(xb_ld(&bar[XB_TOPGEN]) == tg, bar);
            __builtin_amdgcn_fence(__ATOMIC_ACQUIRE, "agent");
            xb_add(&bar[XB_XGEN(b.x)], 1u);
            asm volatile("s_waitcnt vmcnt(0)" ::: "memory");
        } else {
            XB_SPIN(xb_ld(&bar[XB_XGEN(b.x)]) == gen, bar);
            __builtin_amdgcn_fence(__ATOMIC_ACQUIRE, "agent");
            asm volatile("s_waitcnt vmcnt(0)" ::: "memory");
        }
    }
    __syncthreads();
}

DI float wave_sum(float v) {
#pragma unroll
    for (int o = 1; o < 64; o <<= 1) v += __shfl_xor(v, o);
    return v;
}
DI float rdlane(float v, int l) { return __uint_as_float((unsigned)__builtin_amdgcn_readlane((int)__float_as_uint(v), l)); }
DI unsigned pk2(float lo, float hi) { return cvt_pk_bf16(lo, hi); }

DI void ph_adaln(const float* cnd, const float* cctx, const float* ada_w, float* modp, int gw, int NGW, int lane) {
    for (int task = gw; task < 96 * KSPLIT; task += NGW) {
        const int ks = task & (KSPLIT - 1), cg = task / KSPLIT, l = cg / 48, cgl = cg % 48, col0 = cgl * 256 + lane * 4, k0 = ks * 128;
        float sv[9][2];
#pragma unroll
        for (int r = 0; r < 9; ++r)
#pragma unroll
            for (int hh = 0; hh < 2; ++hh) { const int k = k0 + hh * 64 + lane; const float v = r < 8 ? cnd[r * DM + k] : cctx[k]; sv[r][hh] = v / (1.0f + __expf(-v)); }
        f32x4 acc[9];
#pragma unroll
        for (int r = 0; r < 9; ++r) acc[r] = (f32x4){0.f, 0.f, 0.f, 0.f};
        const float* wp = ada_w + ((size_t)l * DM + k0) * NMOD + col0;
#pragma unroll
        for (int hh = 0; hh < 2; ++hh) {
#pragma unroll 8
            for (int kk = 0; kk < 64; ++kk) {
                const f32x4 w = *(const f32x4*)(wp + (size_t)(hh * 64 + kk) * NMOD);
#pragma unroll
                for (int r = 0; r < 9; ++r) { const float s = rdlane(sv[r][hh], kk); acc[r] += w * s; }
            }
        }
#pragma unroll
        for (int r = 0; r < 9; ++r) *(f32x4*)(modp + ((size_t)((ks * 2 + l) * 9 + r)) * NMOD + col0) = acc[r];
    }
}
struct CvtPtrs { const float *cin, *cout, *wqkv, *wo, *wg, *wu, *wd; bf16_t *W1A, *W1B, *W2, *WQKV, *WO, *WGU, *WDN; };
constexpr int CVT_E0 = 6656, CVT_L = 24576, CVT_TOTAL = CVT_E0 + 2 * CVT_L;
DI void cvt_resolve(const CvtPtrs& P, int it, const float*& src, int& ldw, bf16_t*& dst, int& ldd, bool& qperm, bool& f8) {
    int r = it; qperm = false; f8 = false;
    if (r < 3072) { const int kt = ((r >> 3) / 96) * 8 + (r & 7), nt = (r >> 3) % 96, n0 = nt * 64, part = n0 >> 11, j0 = n0 & 2047;
        src = P.cin + (size_t)(kt * 64) * 6144 + n0; ldw = 6144; ldd = DM;
        dst = (part == 0 ? P.W1B + (size_t)j0 * DM : P.W1A + (size_t)((j0 >> 7) * 256 + (part == 2 ? 128 : 0) + (j0 & 127)) * DM) + kt * 64; return; } r -= 3072;
    if (r < 1024) { const int kt = ((r >> 3) / 32) * 8 + (r & 7), nt = (r >> 3) % 32; src = P.cout + (size_t)(kt * 64) * DM + nt * 64; ldw = DM; dst = P.W2 + (size_t)(nt * 64) * DM + kt * 64; ldd = DM; return; } r -= 1024;
    if (r < 1536) { const int kt = ((r >> 3) / 48) * 8 + (r & 7), nt = (r >> 3) % 48; src = P.wqkv + (size_t)(kt * 64) * 3072 + nt * 64; ldw = 3072; qperm = nt < 40;     dst = P.WQKV + (size_t)(nt * 64) * DM + kt * 64; ldd = DM; return; } r -= 1536;
    if (r < 1024) { const int kt = ((r >> 3) / 32) * 8 + (r & 7), nt = (r >> 3) % 32; src = P.wo + (size_t)(kt * 64) * DM + nt * 64; ldw = DM; f8 = true;
        dst = (bf16_t*)((unsigned char*)P.WO + (size_t)(nt * 64) * DM + kt * 64); ldd = DM; return; } r -= 1024;
    const int l = r / CVT_L, rr = r % CVT_L, kind = rr / 8192, q = rr % 8192, le = l * 16 + q / 512, rem = q % 512;
    f8 = true;
    if (kind < 2) { const int kt = ((rem >> 3) / 16) * 8 + (rem & 7), nt = (rem >> 3) % 16, n0 = nt * 64;
        src = (kind ? P.wu : P.wg) + (size_t)le * DM * DFF + (size_t)(kt * 64) * DFF + n0; ldw = DFF;
        dst = (bf16_t*)((unsigned char*)P.WGU + (size_t)(le * 2048 + (n0 >> 7) * 256 + kind * 128 + (n0 & 127)) * DM + kt * 64); ldd = DM; }
    else { const int kt = ((rem >> 3) / 32) * 8 + (rem & 7), nt = (rem >> 3) % 32;
        src = P.wd + (size_t)le * DFF * DM + (size_t)(kt * 64) * DM + nt * 64; ldw = DM; dst = (bf16_t*)((unsigned char*)P.WDN + (size_t)(le * 2048 + nt * 64) * DFF + kt * 64); ldd = DFF; }
}
constexpr int CVT_P = 36;
DI void cvt_range(const CvtPtrs& P, int lo, int hi, int w, int NW, LAS unsigned* scr, int lane) {
    int it = lo + w; if (it >= hi) return;
    const int c = lane & 15, q = lane >> 4;
    const float* src; int ldw; bf16_t* dst; int ldd; bool qperm, f8; cvt_resolve(P, it, src, ldw, dst, ldd, qperm, f8);
    f32x4 v[16];
#pragma unroll
    for (int rr = 0; rr < 16; ++rr) v[rr] = __builtin_nontemporal_load((const f32x4*)(src + (size_t)(16 * q + rr) * ldw + 4 * c));
    for (;;) {
        const bool cf8 = f8; const int wrow = qperm ? 32 * ((c >> 2) & 1) + 8 * (c & 3) + 4 * (c >> 3) : 4 * c;
        u32x4 pa[4], pb[4];
        if (cf8) {
#pragma unroll
            for (int i = 0; i < 4; ++i) { pa[i].x = pk4_fp8(v[0][i] * W8_SCALE, v[1][i] * W8_SCALE, v[2][i] * W8_SCALE, v[3][i] * W8_SCALE); pa[i].y = pk4_fp8(v[4][i] * W8_SCALE, v[5][i] * W8_SCALE, v[6][i] * W8_SCALE, v[7][i] * W8_SCALE);
                                          pa[i].z = pk4_fp8(v[8][i] * W8_SCALE, v[9][i] * W8_SCALE, v[10][i] * W8_SCALE, v[11][i] * W8_SCALE); pa[i].w = pk4_fp8(v[12][i] * W8_SCALE, v[13][i] * W8_SCALE, v[14][i] * W8_SCALE, v[15][i] * W8_SCALE); pb[i] = pa[i]; }
        } else {
#pragma unroll
            for (int i = 0; i < 4; ++i) { pa[i].x = pk2(v[0][i], v[1][i]); pa[i].y = pk2(v[2][i], v[3][i]); pa[i].z = pk2(v[4][i], v[5][i]); pa[i].w = pk2(v[6][i], v[7][i]);
                                          pb[i].x = pk2(v[8][i], v[9][i]); pb[i].y = pk2(v[10][i], v[11][i]); pb[i].z = pk2(v[12][i], v[13][i]); pb[i].w = pk2(v[14][i], v[15][i]); }
        }
        const int nit = it + NW; bf16_t* cdst = dst; const int cldd = ldd;
        if (nit < hi) { cvt_resolve(P, nit, src, ldw, dst, ldd, qperm, f8);
#pragma unroll
            for (int rr = 0; rr < 16; ++rr) v[rr] = __builtin_nontemporal_load((const f32x4*)(src + (size_t)(16 * q + rr) * ldw + 4 * c)); }
        if (cf8) {
#pragma unroll
            for (int i = 0; i < 4; ++i) *(LAS u32x4*)(scr + (wrow + i) * 20 + 4 * q) = pa[i];
            LDS_WAIT(); asm volatile("" ::: "memory");
#pragma unroll
            for (int j = 0; j < 4; ++j) { const int ch = lane + 64 * j, n = ch >> 2, part = ch & 3; const u32x4 o = *(const LAS u32x4*)(scr + n * 20 + 4 * part);
                *(u32x4*)((unsigned char*)cdst + (size_t)n * cldd + 16 * part) = o; }
        } else {
#pragma unroll
            for (int i = 0; i < 4; ++i) { *(LAS u32x4*)(scr + (wrow + i) * CVT_P + 8 * q) = pa[i]; *(LAS u32x4*)(scr + (wrow + i) * CVT_P + 8 * q + 4) = pb[i]; }
            LDS_WAIT(); asm volatile("" ::: "memory");
#pragma unroll
            for (int j = 0; j < 8; ++j) { const int n = (lane >> 3) + 8 * j; const u32x4 o = *(const LAS u32x4*)(scr + n * CVT_P + 4 * (lane & 7));
                *(u32x4*)(cdst + (size_t)n * cldd + 8 * (lane & 7)) = o; }
        }
        LDS_WAIT(); asm volatile("" ::: "memory");
        if (nit >= hi) break;
        it = nit;
    }
}
DI void ph_modred(const float* modp, const float* ada_b, float* mod, int gtid, int GT) {
    for (int i = gtid; i < 2 * 9 * NMOD; i += GT) { const int l = i / (9 * NMOD), j = i % NMOD; float s = ada_b[l * NMOD + j];
#pragma unroll
        for (int ks = 0; ks < KSPLIT; ++ks) s += modp[(size_t)ks * (2 * 9 * NMOD) + i];
        mod[i] = s; }
}
DI void row_load(const float* p, f32x4 (&v)[8], int lane) {
#pragma unroll
    for (int j = 0; j < 8; ++j) v[j] = *(const f32x4*)(p + 4 * lane + 256 * j);
}
DI void row_load_bf(const bf16_t* p, f32x4 (&v)[8], int lane) {
#pragma unroll
    for (int j = 0; j < 8; ++j) { const u32x2 w = *(const u32x2*)(p + 4 * lane + 256 * j); v[j] = (f32x4){bf_lo(w.x), bf_hi(w.x), bf_lo(w.y), bf_hi(w.y)}; }
}
DI void row_modulate(const f32x4 (&v)[8], f32x4 (&y)[8], const float* gain, const float* shift, const float* scale, int lane) {
    float ss = 0.f;
#pragma unroll
    for (int j = 0; j < 8; ++j) ss += (v[j][0] * v[j][0] + v[j][1] * v[j][1]) + (v[j][2] * v[j][2] + v[j][3] * v[j][3]);
    ss = wave_sum(ss);
    const float rstd = 1.0f / sqrtf(ss * (1.0f / DM) + NORM_EPS);
#pragma unroll
    for (int j = 0; j < 8; ++j) { const int c = 4 * lane + 256 * j; const f32x4 g = *(const f32x4*)(gain + c), sh = *(const f32x4*)(shift + c), sc = *(const f32x4*)(scale + c);
        y[j] = ((v[j] * rstd) * g) * (sc + 1.0f) + sh; }
}
DI void row_modulate2(const f32x4 (&v0)[8], const f32x4 (&v1)[8], f32x4 (&y0)[8], f32x4 (&y1)[8], const float* gain, const float* shift, const float* scale, int lane) {
    float s0 = 0.f, s1 = 0.f;
#pragma unroll
    for (int j = 0; j < 8; ++j) { s0 += (v0[j][0] * v0[j][0] + v0[j][1] * v0[j][1]) + (v0[j][2] * v0[j][2] + v0[j][3] * v0[j][3]); s1 += (v1[j][0] * v1[j][0] + v1[j][1] * v1[j][1]) + (v1[j][2] * v1[j][2] + v1[j][3] * v1[j][3]); }
    s0 = wave_sum(s0); s1 = wave_sum(s1);
    const float r0 = 1.0f / sqrtf(s0 * (1.0f / DM) + NORM_EPS), r1 = 1.0f / sqrtf(s1 * (1.0f / DM) + NORM_EPS);
#pragma unroll
    for (int j = 0; j < 8; ++j) { const int c = 4 * lane + 256 * j; const f32x4 g = *(const f32x4*)(gain + c), sh = *(const f32x4*)(shift + c), sc = *(const f32x4*)(scale + c);
        y0[j] = ((v0[j] * r0) * g) * (sc + 1.0f) + sh; y1[j] = ((v1[j] * r1) * g) * (sc + 1.0f) + sh; }
}
DI void row_store_bf16(bf16_t* p, const f32x4 (&y)[8], int lane) {
#pragma unroll
    for (int j = 0; j < 8; ++j) { u32x2 w; w.x = pk2(y[j][0], y[j][1]); w.y = pk2(y[j][2], y[j][3]); *(u32x2*)(p + 4 * lane + 256 * j) = w; }
}
DI void ph_mod0(const float* x, const float* ctx, const float* gain, const float* mod0, bf16_t* A, int gw, int NGW, int lane) {
    int row = gw; if (row >= MT) return;
    f32x4 v[8], vn[8];
    row_load(row < ML ? x + (size_t)row * DM : ctx + (size_t)(row - ML) * DM, v, lane);
    for (;;) {
        const int nrow = row + NGW; const bool more = nrow < MT;
        if (more) row_load(nrow < ML ? x + (size_t)nrow * DM : ctx + (size_t)(nrow - ML) * DM, vn, lane);
        const int cr = row < ML ? (row >> 11) : 8;
        f32x4 y[8]; row_modulate(v, y, gain, mod0 + (size_t)cr * NMOD + 0 * DM, mod0 + (size_t)cr * NMOD + 1 * DM, lane);
        row_store_bf16(A + (size_t)row * DM, y, lane);
        if (!more) break;
#pragma unroll
        for (int j = 0; j < 8; ++j) v[j] = vn[j];
        row = nrow;
    }
}
DI float reduce8(const float (&v)[8], int lane) {
    const bool u0 = lane & 1, u1 = lane & 2, u2 = lane & 4;
    float a[4], b2[2];
#pragma unroll
    for (int k = 0; k < 4; ++k) { const float lo = v[2 * k], hi = v[2 * k + 1]; a[k] = (u0 ? hi : lo) + __shfl_xor(u0 ? lo : hi, 1); }
#pragma unroll
    for (int k = 0; k < 2; ++k) { const float lo = a[2 * k], hi = a[2 * k + 1]; b2[k] = (u1 ? hi : lo) + __shfl_xor(u1 ? lo : hi, 2); }
    return (u2 ? b2[1] : b2[0]) + __shfl_xor(u2 ? b2[0] : b2[1], 4);
}
DI float reduce_halves(float lo8, float hi8, int lane) {
    const bool u3 = lane & 8;
    float t = (u3 ? hi8 : lo8) + __shfl_xor(u3 ? lo8 : hi8, 8);
    t += __shfl_xor(t, 16); t += __shfl_xor(t, 32); return t;
}
DI float softmax16(float lg) {
    float mx = lg;
#pragma unroll
    for (int o = 1; o < 16; o <<= 1) mx = fmaxf(mx, __shfl_xor(mx, o));
    const float ex = __expf(lg - mx); float den = ex;
#pragma unroll
    for (int o = 1; o < 16; o <<= 1) den += __shfl_xor(den, o);
    return ex / den;
}
DI void aff_store(float v, float* affL, float* affC, int row, int lane) {
    if (lane < 16) { if (row < ML) { const int b = row >> 11, n = row & 2047; affL[(size_t)(b * 16 + lane) * SEQ + n] = v; }
                     else { const int rc = row - ML, b = rc >> 8, n = rc & 255; affC[(size_t)(b * 16 + lane) * CTXL + n] = v; } }
}
DI void router_rows2(const f32x4 (&y0)[8], const f32x4 (&y1)[8], const LAS float* rwT, float* affL, float* affC, int row0, int lane) {
    f32x2 yp[8][4];
#pragma unroll
    for (int j = 0; j < 8; ++j)
#pragma unroll
        for (int q = 0; q < 4; ++q) yp[j][q] = (f32x2){y0[j][q], y1[j][q]};
    float r0[2], r1[2];
#pragma unroll
    for (int hf = 0; hf < 2; ++hf) {
        float l0[8], l1[8];
#pragma unroll
        for (int e = 0; e < 8; ++e) { f32x2 acc = (f32x2){0.f, 0.f};
#pragma unroll
            for (int j = 0; j < 8; ++j) { const f32x4 w = *(const LAS f32x4*)(rwT + (8 * hf + e) * DM + 4 * lane + 256 * j);
#pragma unroll
                for (int q = 0; q < 4; ++q) acc = __builtin_elementwise_fma(yp[j][q], (f32x2){w[q], w[q]}, acc); }
            l0[e] = acc.x; l1[e] = acc.y; __builtin_amdgcn_sched_barrier(0); }
        r0[hf] = reduce8(l0, lane); r1[hf] = reduce8(l1, lane);
    }
    const float a0 = softmax16(reduce_halves(r0[0], r0[1], lane)), a1 = softmax16(reduce_halves(r1[0], r1[1], lane));
    aff_store(a0, affL, affC, row0, lane); aff_store(a1, affL, affC, row0 + 1, lane);
}
DI void ph_rwt(const float* rw, float* rwT, int gtid, int GT) {
    for (int i = gtid; i < 2 * 16 * DM; i += GT) { const int l = i >> 15, e = (i >> 11) & 15, d = i & (DM - 1); rwT[i] = rw[(size_t)l * DM * 16 + d * 16 + e]; }
}
DI void load_router(const float* rwT_g, LAS float* rwT, int tid) {
    for (int i = tid; i < DM * 16 / 4; i += 512) ((LAS f32x4*)rwT)[i] = ((const f32x4*)rwT_g)[i];
    __syncthreads();
}
DI void ph_modffn(const bf16_t* H, const float* gain, const float* modl, bf16_t* A, const LAS float* rwT, float* affL, float* affC, int nrows, int gw, int NGW, int lane) {
    int rp = gw; if (rp >= nrows / 2) return;
    u32x2 p0[8], p1[8];
#define MODFFN_LOAD(rp_) do { const int row_ = 2 * (rp_); _Pragma("unroll") for (int j = 0; j < 8; ++j) { p0[j] = *(const u32x2*)(H + (size_t)row_ * DM + 4 * lane + 256 * j); p1[j] = *(const u32x2*)(H + (size_t)(row_ + 1) * DM + 4 * lane + 256 * j); } } while (0)
    MODFFN_LOAD(rp);
    for (;;) {
        const int row = 2 * rp; const int cr = row < ML ? (row >> 11) : 8;
        float s0 = 0.f, s1 = 0.f;
#pragma unroll
        for (int j = 0; j < 8; ++j) { const float a0 = bf_lo(p0[j].x), a1 = bf_hi(p0[j].x), a2 = bf_lo(p0[j].y), a3 = bf_hi(p0[j].y); s0 += (a0 * a0 + a1 * a1) + (a2 * a2 + a3 * a3);
                                      const float b0 = bf_lo(p1[j].x), b1 = bf_hi(p1[j].x), b2 = bf_lo(p1[j].y), b3 = bf_hi(p1[j].y); s1 += (b0 * b0 + b1 * b1) + (b2 * b2 + b3 * b3); }
        s0 = wave_sum(s0); s1 = wave_sum(s1);
        const float r0 = 1.0f / sqrtf(s0 * (1.0f / DM) + NORM_EPS), r1 = 1.0f / sqrtf(s1 * (1.0f / DM) + NORM_EPS);
        const float* shift = modl + (size_t)cr * NMOD + 3 * DM; const float* scale = modl + (size_t)cr * NMOD + 4 * DM;
        f32x4 y0[8], y1[8];
#pragma unroll
        for (int j = 0; j < 8; ++j) { const int c = 4 * lane + 256 * j; const f32x4 g = *(const f32x4*)(gain + c), sh = *(const f32x4*)(shift + c), sc = *(const f32x4*)(scale + c);
            const f32x4 v0 = (f32x4){bf_lo(p0[j].x), bf_hi(p0[j].x), bf_lo(p0[j].y), bf_hi(p0[j].y)}, v1 = (f32x4){bf_lo(p1[j].x), bf_hi(p1[j].x), bf_lo(p1[j].y), bf_hi(p1[j].y)};
            y0[j] = ((v0 * r0) * g) * (sc + 1.0f) + sh; y1[j] = ((v1 * r1) * g) * (sc + 1.0f) + sh;
            *(unsigned*)((unsigned char*)A + (size_t)row * DM + c) = pk4_fp8(y0[j][0], y0[j][1], y0[j][2], y0[j][3]);
            *(unsigned*)((unsigned char*)A + (size_t)(row + 1) * DM + c) = pk4_fp8(y1[j][0], y1[j][1], y1[j][2], y1[j][3]); }
        const int nrp = rp + NGW; const bool more = nrp < nrows / 2;
        if (more) MODFFN_LOAD(nrp);
        asm volatile("" ::: "memory");
        router_rows2(y0, y1, rwT, affL, affC, row, lane);
        if (!more) break;
        rp = nrp;
    }
#undef MODFFN_LOAD
}
DI void ph_topk(int nitems, const float* affL, const float* affC, int* rowsrc, float* gatev, int* inv, LAS unsigned* hist, int tid, int lane, int wave, int bid, int G) {
    LAS unsigned* sh = hist + 256;
    for (int it = bid; it < nitems; it += G) {
        const bool isc = it >= 128; const int be = it & 127, b = be >> 4, e = be & 15;
        const int N = isc ? CTXL : SEQ, C = isc ? CAPC : CAPL;
        const float* src = isc ? affC + (size_t)be * CTXL : affL + (size_t)be * SEQ;
        const int i0 = tid * 4; const bool valid = i0 < N;
        unsigned key[4];
        { f32x4 v = (f32x4){0.f, 0.f, 0.f, 0.f}; if (valid) v = *(const f32x4*)(src + i0);
#pragma unroll
          for (int q = 0; q < 4; ++q) key[q] = __float_as_uint(v[q]); }
        unsigned prefix = 0u, mask = 0u, krem = (unsigned)C;
        for (int pass = 3; pass >= 0; --pass) {
            const int shift = pass * 8;
            if (tid < 256) hist[tid] = 0u;
            __syncthreads();
            if (valid) {
#pragma unroll
                for (int q = 0; q < 4; ++q) if ((key[q] & mask) == prefix) __hip_atomic_fetch_add(&hist[(key[q] >> shift) & 255u], 1u, __ATOMIC_RELAXED, __HIP_MEMORY_SCOPE_WORKGROUP); }
            __syncthreads();
            if (wave == 0) {
                const unsigned h0 = hist[4 * lane], h1 = hist[4 * lane + 1], h2 = hist[4 * lane + 2], h3 = hist[4 * lane + 3];
                const unsigned tot = h0 + h1 + h2 + h3; unsigned incl = tot;
#pragma unroll
                for (int o = 1; o < 64; o <<= 1) { const unsigned t = __shfl_down(incl, o); if (lane + o < 64) incl += t; }
                const unsigned a3 = incl - tot, a2 = a3 + h3, a1 = a2 + h2, a0 = a1 + h1;
                if (a3 < krem && krem <= a3 + h3) { sh[0] = 4 * lane + 3; sh[1] = krem - a3; }
                if (a2 < krem && krem <= a2 + h2) { sh[0] = 4 * lane + 2; sh[1] = krem - a2; }
                if (a1 < krem && krem <= a1 + h1) { sh[0] = 4 * lane + 1; sh[1] = krem - a1; }
                if (a0 < krem && krem <= a0 + h0) { sh[0] = 4 * lane + 0; sh[1] = krem - a0; }
            }
            __syncthreads();
            const unsigned B = sh[0]; krem = sh[1]; prefix |= B << shift; mask |= 0xFFu << shift;
        }
        const unsigned T = prefix;
        unsigned cg = 0u, ce = 0u;
        if (valid) {
#pragma unroll
            for (int q = 0; q < 4; ++q) { cg += key[q] > T ? 1u : 0u; ce += key[q] == T ? 1u : 0u; } }
        const unsigned mine = cg | (ce << 16); unsigned incl = mine;
#pragma unroll
        for (int o = 1; o < 64; o <<= 1) { const unsigned t = __shfl_up(incl, o); if (lane >= o) incl += t; }
        if (lane == 63) sh[8 + wave] = incl;
        __syncthreads();
        unsigned woff = 0u;
#pragma unroll
        for (int w = 0; w < 8; ++w) woff += (w < wave) ? sh[8 + w] : 0u;
        const unsigned excl = woff + incl - mine; unsigned gtb = excl & 0xFFFFu, eqb = excl >> 16;
        if (valid) {
            const int ybase = e * YR + (isc ? NB * CAPL + b * CAPC : b * CAPL); const int rbase = isc ? ML + b * CTXL : b * SEQ;
#pragma unroll
            for (int q = 0; q < 4; ++q) {
                const bool isg = key[q] > T, ise = key[q] == T; const bool sel = isg || (ise && eqb < krem);
                const unsigned slot = gtb + (eqb < krem ? eqb : krem);
                const int trow = rbase + i0 + q; const int yrow = ybase + (int)slot;
                if (sel) { rowsrc[yrow] = trow; gatev[yrow] = __uint_as_float(key[q]); }
                inv[(size_t)trow * 16 + e] = sel ? yrow : -1;
                gtb += isg ? 1u : 0u; eqb += ise ? 1u : 0u;
            }
        }
        __syncthreads();
    }
}
template <bool LAST> DI void ph_combine(bf16_t* H, const bf16_t* Y, const int* inv, const float* modl  , const float* gain1, const float* mod1, bf16_t* A, float* out, int nrows, int gw, int NGW, int lane) {
    int row = gw; if (row >= nrows) return;
    u32x2 hp[8], hn[8]; int myinv, ninv = -1;
#define CMB_LOAD(HP, IV, row_) do { _Pragma("unroll") for (int j = 0; j < 8; ++j) HP[j] = *(const u32x2*)(H + (size_t)(row_) * DM + 4 * lane + 256 * j); IV = inv[(size_t)(row_) * 16 + (lane & 15)]; } while (0)
    CMB_LOAD(hp, myinv, row);
    for (;;) {
        const int nrow = row + NGW; const bool more = nrow < nrows;
        if (more) CMB_LOAD(hn, ninv, nrow);
        const int cr = row < ML ? (row >> 11) : 8;
        f32x4 acc[8];
#pragma unroll
        for (int j = 0; j < 8; ++j) acc[j] = (f32x4){0.f, 0.f, 0.f, 0.f};
        unsigned m = (unsigned)(__ballot(myinv >= 0) & 0xFFFFull);
        while (m) {
            const int e1 = __builtin_ctz(m); m &= m - 1; const bool two = m != 0u; const int e2 = two ? __builtin_ctz(m) : e1; if (two) m &= m - 1;
            const unsigned char* y1 = (const unsigned char*)Y + (size_t)__builtin_amdgcn_readlane(myinv, e1) * DM + 4 * lane; const unsigned char* y2 = (const unsigned char*)Y + (size_t)__builtin_amdgcn_readlane(myinv, e2) * DM + 4 * lane;
            unsigned q1[8], q2[8];
#pragma unroll
            for (int j = 0; j < 8; ++j) { q1[j] = *(const unsigned*)(y1 + 256 * j); q2[j] = *(const unsigned*)(y2 + 256 * j); }
            const float f2 = two ? 1.0f : 0.0f;
#pragma unroll
            for (int j = 0; j < 8; ++j) acc[j] += unpk4_fp8(q1[j]) + unpk4_fp8(q2[j]) * f2;
        }
        const float* g2 = modl + (size_t)cr * NMOD + 5 * DM;
        f32x4 v[8];
#pragma unroll
        for (int j = 0; j < 8; ++j) { const f32x4 g = *(const f32x4*)(g2 + 4 * lane + 256 * j); const f32x4 h = (f32x4){bf_lo(hp[j].x), bf_hi(hp[j].x), bf_lo(hp[j].y), bf_hi(hp[j].y)}; v[j] = h + g * (acc[j] * Y8_INV); }
        if (LAST) {
#pragma unroll
            for (int j = 0; j < 8; ++j) *(f32x4*)(out + (size_t)row * DM + 4 * lane + 256 * j) = v[j];
        } else {
            row_store_bf16(H + (size_t)row * DM, v, lane);
            f32x4 y[8]; row_modulate(v, y, gain1, mod1 + (size_t)cr * NMOD + 0 * DM, mod1 + (size_t)cr * NMOD + 1 * DM, lane);
            row_store_bf16(A + (size_t)row * DM, y, lane);
        }
        if (!more) break;
#pragma unroll
        for (int j = 0; j < 8; ++j) hp[j] = hn[j];
        myinv = ninv; row = nrow;
    }
#undef CMB_LOAD
}
constexpr int KP = 272;
constexpr int VP = 288;
constexpr int ATT_VOFF = 64 * KP;
constexpr int ATT_TILE = 64 * KP + 64 * VP;
constexpr int ATT_OST = 2 * ATT_TILE;
DI float xhalf_max(float v) { auto rr = __builtin_amdgcn_permlane32_swap(__float_as_uint(v), __float_as_uint(v), false, false); return fmaxf(__uint_as_float(rr[0]), __uint_as_float(rr[1])); }
DI float xhalf_sum(float v) { auto rr = __builtin_amdgcn_permlane32_swap(__float_as_uint(v), __float_as_uint(v), false, false); return __uint_as_float(rr[0]) + __uint_as_float(rr[1]); }
DI int crow(int reg, int h) { return (reg & 3) + 8 * (reg >> 2) + 4 * h; }
DI long long vtr64(const LAS unsigned char* p) { typedef short v4i16_t __attribute__((ext_vector_type(4))); return __builtin_bit_cast(long long, __builtin_amdgcn_ds_read_tr16_b64_v4i16((LAS v4i16_t*)p)); }
DI s16x4 vtr(const LAS unsigned char* p) { typedef short v4i16_t __attribute__((ext_vector_type(4))); return __builtin_bit_cast(s16x4, __builtin_amdgcn_ds_read_tr16_b64_v4i16((LAS v4i16_t*)p)); }
DI bool att_tile_info(int item, int ti, int& base, int& mtype) {
    const int qhalf = item & 1, n = (item >> 3) & 15, b = item >> 7, tt = ti & 1; mtype = 0;
    if (ti < 4) { base = ML + b * CTXL + 64 * ti; return true; }
    const int blk = n - 1 + ((ti - 4) >> 1); if (blk < 0 || blk > 15) return false;
    if (ti < 6) { mtype = 1; if (tt == 0 && qhalf == 1) return false; } else if (ti >= 8) { mtype = 2; if (tt == 1 && qhalf == 0) return false; }
    base = b * SEQ + blk * 128 + 64 * tt; return true;
}
DI void att_next(int& item, int& ti, int G) { for (;;) { ++ti; if (ti >= 10) { ti = 0; item += G; return; } int b_, m_; if (att_tile_info(item, ti, b_, m_)) return; } }
DI void ph_attn(const bf16_t* Q, const bf16_t* Kb, const bf16_t* Vb, bf16_t* O, const float* sink, LAS unsigned char* lds, int tid, int lane, int wave, int bid, int G) {
    constexpr float LOG2E = 1.4426950408889634f;
    const int r = lane & 31, h = lane >> 5, g = wave >> 1, sub = wave & 1;
    const int ldrow = tid >> 3, ldc = tid & 7;
    int item = bid, ti = 0; if (item >= 1024) return;
    u32x4 kr[2], vr[2];
#define ATT_ISSUE(it_, ti_) do { int base_, mt_; att_tile_info(it_, ti_, base_, mt_); const int kvh_ = ((it_) >> 1) & 3; \
        _Pragma("unroll") for (int c2 = 0; c2 < 2; ++c2) { const size_t off_ = (size_t)(base_ + ldrow) * 512 + kvh_ * HD + (ldc + 8 * c2) * 8; kr[c2] = *(const u32x4*)(Kb + off_); vr[c2] = *(const u32x4*)(Vb + off_); } } while (0)
    bf16x8 qf[8]; float m2 = 0.f, lsum = 1.f; f32x16 o[4]; f32x16 negm;
#define ATT_QLOAD(it_) do { const int qrow_ = ((it_) >> 7) * SEQ + (((it_) >> 3) & 15) * 128 + ((it_) & 1) * 64 + sub * 32 + r; const int head_ = (((it_) >> 1) & 3) * 4 + g; \
        _Pragma("unroll") for (int s = 0; s < 8; ++s) qf[s] = *(const bf16x8*)(Q + (size_t)qrow_ * DM + head_ * HD + 16 * s + 8 * h); } while (0)
    ATT_QLOAD(item);
    ATT_ISSUE(item, ti);
    int buf = 0;
    while (item < 1024) {
        int nitem = item, nti = ti; att_next(nitem, nti, G);
        LAS unsigned char* tb = lds + buf * ATT_TILE;
#pragma unroll
        for (int c2 = 0; c2 < 2; ++c2) { *(LAS u32x4*)(tb + ldrow * KP + (ldc + 8 * c2) * 16) = kr[c2]; *(LAS u32x4*)(tb + ATT_VOFF + ldrow * VP + (ldc + 8 * c2) * 16) = vr[c2]; }
        if (nitem < 1024) ATT_ISSUE(nitem, nti);
        asm volatile("s_waitcnt lgkmcnt(0)" ::: "memory"); __builtin_amdgcn_s_barrier(); asm volatile("" ::: "memory");
        int base, mtype; att_tile_info(item, ti, base, mtype); const int tt = ti & 1;
        const int qhalf = item & 1, kvh = (item >> 1) & 3, n = (item >> 3) & 15, b = item >> 7;
        const int head = kvh * 4 + g, qq = qhalf * 64 + sub * 32 + r; const int qrow = b * SEQ + n * 128 + qq;
        if (ti == 0) {
            m2 = sink[head] * LOG2E; lsum = 1.0f;
#pragma unroll
            for (int i = 0; i < 16; ++i) negm[i] = -m2;
#pragma unroll
            for (int d = 0; d < 4; ++d)
#pragma unroll
                for (int i = 0; i < 16; ++i) o[d][i] = 0.f;
        }
        f32x16 x0, x1;
#pragma unroll
        for (int s = 0; s < 8; ++s) {
            const bf16x8 k0 = *(const LAS bf16x8*)(tb + r * KP + (16 * s + 8 * h) * 2), k1 = *(const LAS bf16x8*)(tb + (32 + r) * KP + (16 * s + 8 * h) * 2);
            if (s == 0) { x0 = __builtin_amdgcn_mfma_f32_32x32x16_bf16(k0, qf[s], negm, 0, 0, 0); x1 = __builtin_amdgcn_mfma_f32_32x32x16_bf16(k1, qf[s], negm, 0, 0, 0); }
            else { x0 = __builtin_amdgcn_mfma_f32_32x32x16_bf16(k0, qf[s], x0, 0, 0, 0); x1 = __builtin_amdgcn_mfma_f32_32x32x16_bf16(k1, qf[s], x1, 0, 0, 0); } }
        if (nitem != item && nitem < 1024) ATT_QLOAD(nitem);
        if (mtype == 1) {
#pragma unroll
            for (int i = 0; i < 16; ++i) { const int kk0 = tt * 64 + crow(i, h); if (kk0 < qq) x0[i] = -1.0e30f; if (kk0 + 32 < qq) x1[i] = -1.0e30f; } }
        if (mtype == 2) {
#pragma unroll
            for (int i = 0; i < 16; ++i) { const int kk0 = tt * 64 + crow(i, h); if (kk0 > qq) x0[i] = -1.0e30f; if (kk0 + 32 > qq) x1[i] = -1.0e30f; } }
        float tmax = fmaxf(x0[0], x1[0]);
#pragma unroll
        for (int i = 1; i < 16; ++i) tmax = fmaxf(fmaxf(tmax, x0[i]), x1[i]);
        tmax = xhalf_max(tmax);
        if (__any(tmax > 0.0f)) {
            const float dl = fmaxf(tmax, 0.0f), alpha = __builtin_amdgcn_exp2f(-dl); m2 += dl; lsum *= alpha;
#pragma unroll
            for (int i = 0; i < 16; ++i) { x0[i] -= dl; x1[i] -= dl; negm[i] = -m2; }
#pragma unroll
            for (int d = 0; d < 4; ++d)
#pragma unroll
                for (int i = 0; i < 16; ++i) o[d][i] *= alpha;
        }
        float ps = 0.f;
#pragma unroll
        for (int i = 0; i < 16; ++i) { x0[i] = __builtin_amdgcn_exp2f(x0[i]); x1[i] = __builtin_amdgcn_exp2f(x1[i]); ps += x0[i] + x1[i]; }
        lsum += xhalf_sum(ps);
        bf16x8 pf[2][2];
#pragma unroll
        for (int s = 0; s < 2; ++s) {
            u32x4 a, c; a.x = pk2(x0[8 * s + 0], x0[8 * s + 1]); a.y = pk2(x0[8 * s + 2], x0[8 * s + 3]); a.z = pk2(x0[8 * s + 4], x0[8 * s + 5]); a.w = pk2(x0[8 * s + 6], x0[8 * s + 7]);
            c.x = pk2(x1[8 * s + 0], x1[8 * s + 1]); c.y = pk2(x1[8 * s + 2], x1[8 * s + 3]); c.z = pk2(x1[8 * s + 4], x1[8 * s + 5]); c.w = pk2(x1[8 * s + 6], x1[8 * s + 7]);
            pf[0][s] = __builtin_bit_cast(bf16x8, a); pf[1][s] = __builtin_bit_cast(bf16x8, c); }
        const LAS unsigned char* vb = tb + ATT_VOFF + (4 * h + ((lane & 15) >> 2)) * VP + (16 * ((lane >> 4) & 1) + 4 * (lane & 3)) * 2;
#pragma unroll
        for (int d = 0; d < 4; ++d)
#pragma unroll
            for (int t = 0; t < 2; ++t)
#pragma unroll
                for (int s = 0; s < 2; ++s) {
                    typedef long long i64x2_t __attribute__((ext_vector_type(2)));
                    i64x2_t vv; vv.x = vtr64(vb + (t * 32 + 16 * s) * VP + d * 64); vv.y = vtr64(vb + (t * 32 + 16 * s + 8) * VP + d * 64);
                    const bf16x8 vf = __builtin_bit_cast(bf16x8, vv);
                    o[d] = __builtin_amdgcn_mfma_f32_32x32x16_bf16(vf, pf[t][s], o[d], 0, 0, 0); }
        if (nitem != item) {
            const float il = 1.0f / lsum;
            LAS unsigned char* st = lds + ATT_OST + wave * (32 * KP);
#pragma unroll
            for (int d = 0; d < 4; ++d)
#pragma unroll
                for (int g4 = 0; g4 < 4; ++g4) *(LAS unsigned*)(st + r * 144 + d * 32 + 8 * g4 + 4 * h) = pk4_fp8(o[d][4 * g4 + 0] * il, o[d][4 * g4 + 1] * il, o[d][4 * g4 + 2] * il, o[d][4 * g4 + 3] * il);
            asm volatile("s_waitcnt lgkmcnt(0)" ::: "memory");
            unsigned char* ob = (unsigned char*)O + (size_t)(qrow - r) * DM + head * HD;
#pragma unroll
            for (int j = 0; j < 4; ++j) { const int c = lane + 64 * j, row = c >> 3, c16 = c & 7;
                const u32x4 v = *(const LAS u32x4*)(st + row * 144 + c16 * 16); *(u32x4*)(ob + (size_t)row * DM + c16 * 16) = v; }
        }
        item = nitem; ti = nti; buf ^= 1;
    }
#undef ATT_ISSUE
#undef ATT_QLOAD
}
#ifndef MK_ONE_LAUNCH
#define MK_ONE_LAUNCH 1
#endif
constexpr int NPHASE = 19;
constexpr int CVT_X0_END = CVT_E0 + CVT_L;
#define CVT_MKCP() CvtPtrs CP; CP.cin = args.in[8]; CP.cout = args.in[10]; CP.wqkv = args.in[11]; CP.wo = args.in[15]; CP.wg = args.in[17]; CP.wu = args.in[18]; CP.wd = args.in[19]; \
    CP.W1A = W1A; CP.W1B = W1B; CP.W2 = W2; CP.WQKV = WQKV; CP.WO = WOt; CP.WGU = WGU; CP.WDN = WDN
#define CVT(LO, HI) do { CVT_MKCP(); cvt_range(CP, LO, HI, gw, NGW, cscr, lane); } while (0)
#ifndef MK_DUP_MASK
#define MK_DUP_MASK 0u
#endif
constexpr unsigned DUP_MASK = MK_DUP_MASK;
struct Args { const float* in[20]; float* out; unsigned char* ws; int ph_lo, ph_hi; };
__global__ void __launch_bounds__(512, 2) dit_fwd(Args args) {
    extern __shared__ __attribute__((aligned(16))) unsigned char lds_raw[];
    LAS unsigned char* lds = (LAS unsigned char*)lds_raw;
    const int tid = threadIdx.x, lane = tid & 63, wave = __builtin_amdgcn_readfirstlane(tid >> 6);
    const int G = gridDim.x, bid = blockIdx.x;
    const int gw = bid * 8 + wave, NGW = G * 8;
    unsigned char* ws = args.ws;
    const float* x = args.in[0]; const float* cnd = args.in[1]; const float* ctx = args.in[2]; const float* cctx = args.in[3];
    const float* ada_w = args.in[4]; const float* ada_b = args.in[5]; const float* nmix = args.in[6]; const float* nffn = args.in[7];
    const float* conv_w = args.in[9]; const float* qgain = args.in[12]; const float* kgain = args.in[13]; const float* sink = args.in[14]; const float* router_w = args.in[16];
    float* mod = (float*)(ws + WS_MOD); float* modp = (float*)(ws + WS_MODP);
    float* affL = (float*)(ws + WS_AFFL); float* affC = (float*)(ws + WS_AFFC);
    float* rwt = (float*)(ws + WS_RWT);
    int* idmap = (int*)(ws + WS_IDMAP);
    int* rowsrc = (int*)(ws + WS_ROWSRC); float* gatev = (float*)(ws + WS_GATEV); int* inv = (int*)(ws + WS_INV);
    bf16_t* W1A = (bf16_t*)(ws + WS_W1A); bf16_t* W1B = (bf16_t*)(ws + WS_W1B); bf16_t* W2 = (bf16_t*)(ws + WS_W2); bf16_t* WQKV = (bf16_t*)(ws + WS_WQKV); bf16_t* WOt = (bf16_t*)(ws + WS_WO);
    bf16_t* WGU = (bf16_t*)(ws + WS_WGU); bf16_t* WDN = (bf16_t*)(ws + WS_WDN);
    bf16_t* H = (bf16_t*)(ws + WS_H); bf16_t* A = (bf16_t*)(ws + WS_A); bf16_t* U = (bf16_t*)(ws + WS_U); bf16_t* Z = (bf16_t*)(ws + WS_Z);
    bf16_t* Qb = (bf16_t*)(ws + WS_Q); bf16_t* Kb = (bf16_t*)(ws + WS_K); bf16_t* Vb = (bf16_t*)(ws + WS_V); bf16_t* Ob = (bf16_t*)(ws + WS_O);
    bf16_t* HM = (bf16_t*)(ws + WS_HM); bf16_t* Y = (bf16_t*)(ws + WS_Y);
    LAS unsigned* cscr = (LAS unsigned*)(lds + wave * 9216);

    for (int u = tid; u < (LDS_BYTES - MISC_OFF) / 4; u += 512) ((LAS unsigned*)(lds + MISC_OFF))[u] = 0u;
    __syncthreads();
#if MK_ONE_LAUNCH
    XcdBarrier bar = xcd_barrier_post((unsigned*)(ws + WS_CTL) + CW_BAR, (volatile LAS unsigned*)(lds + MISC_OFF) + 8);
#define GRID_BAR() xcd_barrier(bar)
#else
#define GRID_BAR() do {} while (0)
#endif
    const int lo = args.ph_lo, hi = args.ph_hi;
#define IN(k) (lo <= (k) && (k) < hi)
#define SEAM(k) do { if (IN(k) && IN((k) + 1)) GRID_BAR(); } while (0)
#define PHASE(k) if (IN(k)) _Pragma("unroll") for (int rep_ = 0; rep_ < 1 + (int)((DUP_MASK >> (k)) & 1u); ++rep_)
#define REP_BAR() do { if (rep_) GRID_BAR(); } while (0)

    PHASE(0) { REP_BAR(); ph_adaln(cnd, cctx, ada_w, modp, gw, NGW, lane); } SEAM(0);
    PHASE(1) { REP_BAR(); ph_modred(modp, ada_b, mod, bid * 512 + tid, G * 512); ph_rwt(router_w, rwt, bid * 512 + tid, G * 512); for (int i = bid * 512 + tid; i < YT; i += G * 512) idmap[i] = i; } SEAM(1);
    PHASE(2) { REP_BAR(); ph_mod0(x, ctx, nmix, mod, A, gw, NGW, lane); CVT(0, 4096); } SEAM(2);
    PHASE(3) { REP_BAR();
        pg8::Gemm g{A, W1A, MT, 4096, DM}; pg8::StaticOrder S; S.init(MT, 4096, G, bid);
        EpiPair<0> E{U, DM, 16};
        pg8::gemm_phase<EpiPair<0>, pg8::StaticOrder, true, true>(lds, g, S, E);
    } SEAM(3);
    PHASE(4) { REP_BAR();
        pg8::Gemm g{A, W1B, MT, DM, DM}; pg8::StaticOrder S; S.init(MT, DM, G, bid);
        EpiConvGate E{U, Z, conv_w};
        pg8::gemm_phase<EpiConvGate, pg8::StaticOrder, true, true>(lds, g, S, E);
    } SEAM(4);
    PHASE(5) { REP_BAR();
        pg8::Gemm g{Z, W2, MT, DM, DM}; pg8::StaticOrder S; S.init(MT, DM, G, bid);
        EpiResid<true> E{x, ctx, H, mod + 2 * DM, 1.0f};
        pg8::gemm_phase<EpiResid<true>, pg8::StaticOrder, true, true>(lds, g, S, E);
    } SEAM(5);
    PHASE(6) { REP_BAR(); load_router(rwt, (LAS float*)lds, tid); ph_modffn(H, nffn, mod, A, (const LAS float*)lds, affL, affC, MT, gw, NGW, lane); } SEAM(6);
    PHASE(7) { REP_BAR(); ph_topk(256, affL, affC, rowsrc, gatev, inv, (LAS unsigned*)lds, tid, lane, wave, bid, G); CVT(CVT_E0, CVT_E0 + 16384); } SEAM(7);
    PHASE(8) { REP_BAR();
        pg8::Gemm g{A, WGU, YT, NE * 2048, DM / 2, rowsrc}; MoeOrder S{G, bid, 9};
        EpiPairF8 E{(unsigned char*)HM, DFF, 8};
        pg8::gemm_phase<EpiPairF8, MoeOrder, true, true, true, true>(lds, g, S, E);
        CVT(CVT_E0 + 16384, CVT_X0_END);
    } SEAM(8);
    PHASE(9) { REP_BAR();
        pg8::Gemm g{HM, WDN, YT, NE * 2048, DFF / 2, idmap}; MoeOrder S{G, bid, 9};
        EpiDown E{Y, gatev, W8_INV * Y8_SCALE};
        pg8::gemm_phase<EpiDown, MoeOrder, true, true, true, true>(lds, g, S, E);
    } SEAM(9);
    PHASE(10) { REP_BAR(); ph_combine<false>(H, Y, inv, mod, nmix + DM, mod + 9 * NMOD, A, nullptr, MT, gw, NGW, lane); CVT(4096, 4096 + 1536); } SEAM(10);
    PHASE(11) { REP_BAR();
        pg8::Gemm g{A, WQKV, MT, 3072, DM}; QkvOrder S{G, bid};
        EpiQkvNorm E{Qb, Kb, Vb, qgain, kgain, (LAS float*)(lds + RING_BYTES)};
        pg8::gemm_phase<EpiQkvNorm, QkvOrder, true, true>(lds, g, S, E);
    } SEAM(11);
    PHASE(12) { REP_BAR(); ph_attn(Qb, Kb, Vb, Ob, sink, lds, tid, lane, wave, bid, G); __syncthreads(); CVT(4096 + 1536, CVT_E0); } SEAM(12);
    PHASE(13) { REP_BAR();
        pg8::Gemm g{Ob, WOt, ML, DM, DM / 2, idmap}; pg8::StaticOrder S; S.init(ML, DM, G, bid);
        EpiResid<false> E{nullptr, nullptr, H, mod + 9 * NMOD + 2 * DM, W8_INV};
        pg8::gemm_phase<EpiResid<false>, pg8::StaticOrder, true, true, true, true>(lds, g, S, E);
    } SEAM(13);
    PHASE(14) { REP_BAR(); load_router(rwt + DM * 16, (LAS float*)lds, tid); ph_modffn(H, nffn + DM, mod + 9 * NMOD, A, (const LAS float*)lds, affL, affC, ML, gw, NGW, lane); } SEAM(14);
    PHASE(15) { REP_BAR(); ph_topk(128, affL, affC, rowsrc, gatev, inv, (LAS unsigned*)lds, tid, lane, wave, bid, G); CVT(CVT_X0_END, CVT_X0_END + 16384); } SEAM(15);
    PHASE(16) { REP_BAR();
        pg8::Gemm g{A, (const bf16_t*)((const unsigned char*)WGU + (size_t)NE * 2048 * DM), YT, NE * 2048, DM / 2, rowsrc}; MoeOrder S{G, bid, 8};
        EpiPairF8 E{(unsigned char*)HM, DFF, 8};
        pg8::gemm_phase<EpiPairF8, MoeOrder, true, true, true, true>(lds, g, S, E);
        CVT(CVT_X0_END + 16384, CVT_TOTAL);
    } SEAM(16);
    PHASE(17) { REP_BAR();
        pg8::Gemm g{HM, (const bf16_t*)((const unsigned char*)WDN + (size_t)NE * 2048 * DFF), YT, NE * 2048, DFF / 2, idmap}; MoeOrder S{G, bid, 8};
        EpiDown E{Y, gatev, W8_INV * Y8_SCALE};
        pg8::gemm_phase<EpiDown, MoeOrder, true, true, true, true>(lds, g, S, E);
    } SEAM(17);
    PHASE(18) { REP_BAR(); ph_combine<true>(H, Y, inv, mod + 9 * NMOD, nullptr, nullptr, nullptr, args.out, ML, gw, NGW, lane); }
#undef IN
#undef SEAM
#undef PHASE
#undef REP_BAR
}

extern "C" void kernel_launch(void* const* d_in, const int* in_sizes, int n_in, void* d_out, int out_size, void* d_ws, size_t ws_size, hipStream_t stream) {
    static int grid = 0;
    if (grid == 0) {
        if (n_in != 20 || out_size != ML * DM || ws_size < WS_END) { fprintf(stderr, "kernel_launch: unexpected problem (n_in %d, out %d, ws %zu); nothing launched\n", n_in, out_size, ws_size); grid = -1; return; }
        int dev = 0, cus = 0, per_cu = 0;
        if (hipGetDevice(&dev) != hipSuccess || hipDeviceGetAttribute(&cus, hipDeviceAttributeMultiprocessorCount, dev) != hipSuccess) { grid = -1; return; }
        if (hipFuncSetAttribute((const void*)dit_fwd, hipFuncAttributeMaxDynamicSharedMemorySize, LDS_BYTES) != hipSuccess) { fprintf(stderr, "kernel_launch: hipFuncSetAttribute failed\n"); grid = -1; return; }
        if (hipOccupancyMaxActiveBlocksPerMultiprocessor(&per_cu, (const void*)dit_fwd, 512, LDS_BYTES) != hipSuccess || per_cu < 1) fprintf(stderr, "kernel_launch: occupancy query reports %d workgroups per CU\n", per_cu);
        (void)hipGetLastError();
        grid = cus;
    }
    if (grid < 0) return;
    (void)hipMemsetAsync((char*)d_ws + WS_CTL, 0, CTL_ZERO_BYTES, stream);
    Args a{};
    for (int i = 0; i < 20; ++i) a.in[i] = (const float*)d_in[i];
    a.out = (float*)d_out; a.ws = (unsigned char*)d_ws;
#if MK_ONE_LAUNCH
    a.ph_lo = 0; a.ph_hi = NPHASE;
    hipLaunchKernelGGL(dit_fwd, dim3(grid), dim3(512), LDS_BYTES, stream, a);
#else
    for (int p = 0; p < NPHASE; ++p) { a.ph_lo = p; a.ph_hi = p + 1; hipLaunchKernelGGL(dit_fwd, dim3(grid), dim3(512), LDS_BYTES, stream, a); }
#endif
}
```

```cpp
#include <hip/hip_runtime.h>
#include <cstdio>
#include <cstdint>
namespace pg8 {
#define PG8_LAS __attribute__((address_space(3)))
typedef unsigned short bf16_t;
typedef short bf16x8 __attribute__((ext_vector_type(8)));
typedef float f32x4 __attribute__((ext_vector_type(4)));
typedef unsigned u32x4 __attribute__((ext_vector_type(4)));
constexpr int BM = 256, BK = 64, HALF = 128, HTB = HALF * BK * 2  , STAGE_BYTES = 8 * HTB, NXCD = 8, WGM = 8;

__host__ __device__ __forceinline__ int lds_byte(int r, int c) { const int st = (r >> 4) * 2 + (c >> 5), rr = r & 15, cc = c & 31, ob = rr * 64 + cc * 2; return st * 1024 + (ob ^ (((ob >> 9) & 1) << 5)); }
__host__ __device__ __forceinline__ void stage_rc(int b, int& R, int& C) { const int st = b / 1024, sb = b % 1024, swz = sb ^ (((sb >> 9) & 1) << 5); R = (st >> 1) * 16 + swz / 64; C = (st & 1) * 32 + (swz % 64) / 2; }
__host__ __device__ __forceinline__ int perm32(int rho) { const int n = rho >> 4, i = rho & 15; return 8 * (i >> 2) + 4 * n + (i & 3); }

struct Unit { int pm, pn; };
struct Gemm { const bf16_t* A; const bf16_t* Bt; int M, N, K; const int* rows = nullptr; };

struct StaticOrder {
    int nM, nN, nwg, G, c;
    __host__ __device__ void init(int M, int N, int G_, int c_) { nM = M / BM; nN = N / BM; nwg = nM * nN; G = G_; c = c_; }
    __host__ __device__ bool next(int i, Unit& u) const {
        const long L = (long)i * G + c; if (L >= nwg) return false;
        int wgid = (int)L; { const int q = nwg / NXCD, r = nwg % NXCD, xcd = wgid % NXCD, off = wgid / NXCD; wgid = (xcd < r ? xcd * (q + 1) : r * (q + 1) + (xcd - r) * q) + off; }
        const int nig = WGM * nN, gid = wgid / nig, fm = gid * WGM, gsz = (nM - fm) < WGM ? (nM - fm) : WGM;
        u.pm = fm + ((wgid % nig) % gsz); u.pn = (wgid % nig) / gsz; return true;
    }
    __device__ __forceinline__ void a_ready(const Unit&) const {}
    __device__ __forceinline__ void done(const Unit&) const {}
};
__device__ __forceinline__ unsigned cvt_pk_bf16(float lo, float hi) { unsigned r; asm volatile("v_cvt_pk_bf16_f32 %0, %1, %2" : "=v"(r) : "v"(lo), "v"(hi)); return r; }
typedef float f32x2 __attribute__((ext_vector_type(2)));
template <class Epi, class Sched, bool ALIGN_EPI = false, bool SP2 = false, bool GATHER = false, bool F8 = false>
__device__ __forceinline__ void gemm_phase(PG8_LAS unsigned char* lds, const Gemm g, const Sched& S, const Epi& E) {
    typedef int i32x4_t __attribute__((ext_vector_type(4)));
    const int tid = threadIdx.x, wid = __builtin_amdgcn_readfirstlane(tid >> 6), lane = tid & 63, wr = wid >> 2, wc = wid & 3, fr = lane & 15, fq = lane >> 4;
    const int K = g.K, nt = K / BK;
    unsigned voffA[2], voffB[2];
#pragma unroll
    for (int i = 0; i < 2; ++i) { int R, C; stage_rc(tid * 16 + i * 8192, R, C); const int Rb = Epi::PERM ? ((R & ~31) + perm32(R & 31)) : R;
        voffA[i] = (unsigned)(R * K + C) * 2u; voffB[i] = (unsigned)(Rb * K + C) * 2u; }
    const size_t kstep = (size_t)(BK * 2);
    const size_t hstep = (size_t)HALF * K * 2;
    const size_t tstep = 2 * hstep;
    const unsigned ldsw = (unsigned)wid * 1024u;
    const int aoff = lds_byte(wr * 64 + fr, fq * 8), boff = lds_byte(wc * 32 + fr, fq * 8);
#define PG8_SA(b, h) (((b) * 2 + (h)) * HTB)
#define PG8_SB(b, h) ((4 + (b) * 2 + (h)) * HTB)
#define PG8_UNI(p) ((const char*)(((unsigned long long)(unsigned)__builtin_amdgcn_readfirstlane((int)((unsigned long long)(p) >> 32)) << 32) | (unsigned long long)(unsigned)__builtin_amdgcn_readfirstlane((int)(unsigned long long)(p))))
#define PG8_STAGE(bufoff, gbase, voff) do { const char* gb_ = PG8_UNI(gbase);     \
        _Pragma("unroll") for (int _i = 0; _i < 2; ++_i) \
        __builtin_amdgcn_global_load_lds((const unsigned*)(gb_ + (voff)[_i]), (PG8_LAS unsigned*)(lds + (bufoff) + ldsw + _i * 8192), 16, 0, 0); } while (0)
#define PG8_STAGE_A(bufoff, kptr, h) do { if constexpr (GATHER) { PG8_STAGE(bufoff, kptr, vA[h]); } else { PG8_STAGE(bufoff, (kptr) + (h) * hstep, voffA); } } while (0)
#define PG8_GATHER_SWITCH() do { if constexpr (GATHER) { if (last && has_next) { asm volatile("" : "+v"(nv[0]), "+v"(nv[1]), "+v"(nv[2]), "+v"(nv[3])); \
        vA[0][0] = nv[0] * (unsigned)(K * 2) + gcoff[0]; vA[0][1] = nv[1] * (unsigned)(K * 2) + gcoff[1]; vA[1][0] = nv[2] * (unsigned)(K * 2) + gcoff[0]; vA[1][1] = nv[3] * (unsigned)(K * 2) + gcoff[1]; } } } while (0)
#define PG8_LDA(dst, b, h) do { _Pragma("unroll") for (int m = 0; m < 4; ++m) { if constexpr (F8) { dst##8[m] = PG8_CAT8(*(const PG8_LAS i32x4_t*)(lds + PG8_SA(b, h) + aoff + m * 2048), *(const PG8_LAS i32x4_t*)(lds + PG8_SA(b, h) + aoff + m * 2048 + 1024)); } \
        else { _Pragma("unroll") for (int k = 0; k < 2; ++k) dst[m][k] = *(const PG8_LAS bf16x8*)(lds + PG8_SA(b, h) + aoff + m * 2048 + k * 1024); } } } while (0)
#define PG8_LDB(dst, b, h) do { _Pragma("unroll") for (int n = 0; n < 2; ++n) { if constexpr (F8) { dst##8[n] = PG8_CAT8(*(const PG8_LAS i32x4_t*)(lds + PG8_SB(b, h) + boff + n * 2048), *(const PG8_LAS i32x4_t*)(lds + PG8_SB(b, h) + boff + n * 2048 + 1024)); } \
        else { _Pragma("unroll") for (int k = 0; k < 2; ++k) dst[n][k] = *(const PG8_LAS bf16x8*)(lds + PG8_SB(b, h) + boff + n * 2048 + k * 1024); } } } while (0)
#define PG8_CAT8(lo_, hi_) __builtin_shufflevector(lo_, hi_, 0, 1, 2, 3, 4, 5, 6, 7)
#define PG8_MMA(ai, bj, At, Bt) do { __builtin_amdgcn_s_setprio(1); _Pragma("unroll") for (int m = 0; m < 4; ++m) _Pragma("unroll") for (int n = 0; n < 2; ++n) { \
        if constexpr (F8) { acc[ai][bj][m][n] = __builtin_amdgcn_mfma_scale_f32_16x16x128_f8f6f4(Bt##8[n], At##8[m], acc[ai][bj][m][n], 0, 0, 0, 0x7f7f7f7f, 0, 0x7f7f7f7f); } \
        else { _Pragma("unroll") for (int k = 0; k < 2; ++k) acc[ai][bj][m][n] = __builtin_amdgcn_mfma_f32_16x16x32_bf16(Bt[n][k], At[m][k], acc[ai][bj][m][n], 0, 0, 0); } } \
        __builtin_amdgcn_s_setprio(0); } while (0)
#define PG8_WAIT_V(n) asm volatile("s_waitcnt vmcnt(" #n ")" ::: "memory")
#define PG8_WAIT_L(n) asm volatile("s_waitcnt lgkmcnt(" #n ")" ::: "memory")
#define PG8_BAR __builtin_amdgcn_s_barrier()
#define PG8_SCHED __builtin_amdgcn_sched_barrier(0)
    Unit cur, nxt; int ui = 0;
    if (!S.next(0, cur)) return;
    f32x4 acc[2][2][4][2];
#pragma unroll
    for (int a = 0; a < 2; ++a)
#pragma unroll
        for (int b = 0; b < 2; ++b)
#pragma unroll
            for (int m = 0; m < 4; ++m)
#pragma unroll
                for (int n = 0; n < 2; ++n) acc[a][b][m][n] = (f32x4){0.f, 0.f, 0.f, 0.f};
    bf16x8 At[4][2], B0[2][2], B1[2][2]; typedef int i32x8_t __attribute__((ext_vector_type(8))); i32x8_t At8[4], B08[2], B18[2];
    const char* cA = (const char*)g.A + (GATHER ? (size_t)0 : (size_t)cur.pm * tstep); const char* cB = (const char*)g.Bt + (size_t)cur.pn * tstep;
    unsigned vA[2][2], nv[4], gcoff[2]; int grow[2];
    if constexpr (GATHER) {
#pragma unroll
        for (int i = 0; i < 2; ++i) { int R, C; stage_rc(tid * 16 + i * 8192, R, C); grow[i] = R; gcoff[i] = (unsigned)(C * 2); }
#pragma unroll
        for (int h = 0; h < 2; ++h)
#pragma unroll
            for (int i = 0; i < 2; ++i) vA[h][i] = (unsigned)g.rows[cur.pm * BM + h * HALF + grow[i]] * (unsigned)(K * 2) + gcoff[i];
    }
    S.a_ready(cur);
    if constexpr (SP2) {
        PG8_STAGE(PG8_SB(0, 0), cB, voffB); PG8_STAGE(PG8_SB(0, 1), cB + hstep, voffB); PG8_STAGE_A(PG8_SA(0, 0), cA, 0); PG8_STAGE_A(PG8_SA(0, 1), cA, 1);
        if (wr == 1) PG8_BAR;
        PG8_WAIT_V(2); PG8_BAR;
        PG8_STAGE(PG8_SB(1, 0), cB + kstep, voffB); PG8_STAGE_A(PG8_SA(1, 0), cA + kstep, 0); PG8_STAGE(PG8_SB(1, 1), cB + hstep + kstep, voffB);
        PG8_WAIT_V(6); PG8_BAR;
    } else {
        PG8_STAGE(PG8_SB(0, 0), cB, voffB); PG8_STAGE_A(PG8_SA(0, 0), cA, 0); PG8_STAGE(PG8_SB(0, 1), cB + hstep, voffB); PG8_STAGE_A(PG8_SA(0, 1), cA, 1);
        if (wr == 1) PG8_BAR;
        PG8_WAIT_V(4); PG8_BAR;
        PG8_STAGE(PG8_SB(1, 0), cB + kstep, voffB); PG8_STAGE_A(PG8_SA(1, 0), cA + kstep, 0); PG8_STAGE(PG8_SB(1, 1), cB + hstep + kstep, voffB);
        PG8_WAIT_V(6); PG8_BAR;
    }
    for (;;) {
        const bool has_next = S.next(ui + 1, nxt);
        const char* nA = (has_next && !GATHER) ? (const char*)g.A + (size_t)nxt.pm * tstep : cA; const char* nB = has_next ? (const char*)g.Bt + (size_t)nxt.pn * tstep : cB;
        if constexpr (GATHER) { if (has_next) { const int* rp = g.rows + nxt.pm * BM;
            asm volatile("global_load_dword %0, %1, off" : "=&v"(nv[0]) : "v"(rp + grow[0]) : "memory"); asm volatile("global_load_dword %0, %1, off" : "=&v"(nv[1]) : "v"(rp + grow[1]) : "memory");
            asm volatile("global_load_dword %0, %1, off" : "=&v"(nv[2]) : "v"(rp + HALF + grow[0]) : "memory"); asm volatile("global_load_dword %0, %1, off" : "=&v"(nv[3]) : "v"(rp + HALF + grow[1]) : "memory"); } }
#pragma unroll 1
        for (int t = 0; t < nt; t += 2) {
            const bool last = (t == nt - 2);
            const char* a1 = cA + (size_t)(t + 1) * kstep;
            const char* a2 = last ? nA : cA + (size_t)(t + 2) * kstep; const char* b2 = last ? nB : cB + (size_t)(t + 2) * kstep;
            const char* a3 = a2 + kstep; const char* b3 = b2 + kstep;
            if (last && has_next) S.a_ready(nxt);
            if constexpr (SP2) {
            PG8_LDB(B0, 0, 0); PG8_LDB(B1, 0, 1); PG8_SCHED; PG8_LDA(At, 0, 0); PG8_STAGE_A(PG8_SA(1, 1), a1, 1); PG8_GATHER_SWITCH();
            PG8_WAIT_V(8); PG8_WAIT_L(0); PG8_BAR; PG8_MMA(0, 0, At, B0); PG8_MMA(0, 1, At, B1); PG8_BAR; PG8_SCHED;
            PG8_LDA(At, 0, 1); PG8_STAGE(PG8_SB(0, 0), b2, voffB); PG8_STAGE(PG8_SB(0, 1), b2 + hstep, voffB); PG8_STAGE_A(PG8_SA(0, 0), a2, 0);
            PG8_WAIT_V(8); PG8_WAIT_L(0); PG8_BAR; PG8_MMA(1, 0, At, B0); PG8_MMA(1, 1, At, B1); PG8_BAR; PG8_SCHED;
            PG8_LDB(B0, 1, 0); PG8_LDB(B1, 1, 1); PG8_SCHED; PG8_LDA(At, 1, 0); PG8_STAGE_A(PG8_SA(0, 1), a2, 1);
            PG8_WAIT_V(8); PG8_WAIT_L(0); PG8_BAR; PG8_MMA(0, 0, At, B0); PG8_MMA(0, 1, At, B1); PG8_BAR; PG8_SCHED;
            PG8_LDA(At, 1, 1); PG8_STAGE(PG8_SB(1, 0), b3, voffB); PG8_STAGE(PG8_SB(1, 1), b3 + hstep, voffB); PG8_STAGE_A(PG8_SA(1, 0), a3, 0);
            PG8_WAIT_V(8); PG8_WAIT_L(0); PG8_BAR; PG8_MMA(1, 0, At, B0); PG8_MMA(1, 1, At, B1); PG8_BAR; PG8_SCHED;
            } else {
            PG8_LDB(B0, 0, 0); PG8_SCHED; PG8_LDA(At, 0, 0); PG8_STAGE_A(PG8_SA(1, 1), a1, 1); PG8_GATHER_SWITCH();
            PG8_WAIT_L(8); PG8_BAR; PG8_WAIT_L(0); PG8_MMA(0, 0, At, B0); PG8_BAR; PG8_SCHED;
            PG8_LDB(B1, 0, 1); PG8_STAGE(PG8_SB(0, 0), b2, voffB);
            PG8_BAR; PG8_WAIT_L(0); PG8_MMA(0, 1, At, B1); PG8_BAR;
            PG8_LDA(At, 0, 1); PG8_STAGE_A(PG8_SA(0, 0), a2, 0);
            PG8_BAR; PG8_WAIT_L(0); PG8_MMA(1, 0, At, B0); PG8_BAR; PG8_SCHED;
            PG8_STAGE(PG8_SB(0, 1), b2 + hstep, voffB);
            PG8_WAIT_V(6); PG8_BAR; PG8_MMA(1, 1, At, B1); PG8_BAR;
            PG8_LDB(B0, 1, 0); PG8_SCHED; PG8_LDA(At, 1, 0); PG8_STAGE_A(PG8_SA(0, 1), a2, 1);
            PG8_WAIT_L(8); PG8_BAR; PG8_WAIT_L(0); PG8_MMA(0, 0, At, B0); PG8_BAR; PG8_SCHED;
            PG8_LDB(B1, 1, 1); PG8_STAGE(PG8_SB(1, 0), b3, voffB);
            PG8_BAR; PG8_WAIT_L(0); PG8_MMA(0, 1, At, B1); PG8_BAR;
            PG8_LDA(At, 1, 1); PG8_STAGE_A(PG8_SA(1, 0), a3, 0);
            PG8_BAR; PG8_WAIT_L(0); PG8_MMA(1, 0, At, B0); PG8_BAR; PG8_SCHED;
            PG8_STAGE(PG8_SB(1, 1), b3 + hstep, voffB);
            PG8_WAIT_V(6); PG8_BAR; PG8_MMA(1, 1, At, B1); PG8_BAR;
            }
        }
        if constexpr (ALIGN_EPI) { if (wr == 0) PG8_BAR; }
        if constexpr (!Epi::AFTER_DRAIN) { E(acc, cur, wr, wc, fr, fq); S.done(cur); }
        if (!has_next) break;
#pragma unroll
        for (int a = 0; a < 2; ++a)
#pragma unroll
            for (int b = 0; b < 2; ++b)
#pragma unroll
                for (int m = 0; m < 4; ++m)
#pragma unroll
                    for (int n = 0; n < 2; ++n) acc[a][b][m][n] = (f32x4){0.f, 0.f, 0.f, 0.f};
        cur = nxt; cA = nA; cB = nB; ++ui;
        if constexpr (ALIGN_EPI) { if (wr == 1) PG8_BAR; }
    }
    PG8_WAIT_V(0);
    if constexpr (!ALIGN_EPI) { if (wr == 0) PG8_BAR; }
    PG8_BAR;
    if constexpr (Epi::AFTER_DRAIN) { E.fused(acc, cur, wr, wc, fr, fq, lds, wid, lane); S.done(cur); }
#undef PG8_SA
#undef PG8_SB
#undef PG8_STAGE
#undef PG8_UNI
#undef PG8_STAGE_A
#undef PG8_GATHER_SWITCH
#undef PG8_LDA
#undef PG8_LDB
#undef PG8_MMA
#undef PG8_CAT8
#undef PG8_WAIT_V
#undef PG8_WAIT_L
#undef PG8_BAR
#undef PG8_SCHED
}
}

constexpr int DM = 2048, NB = 8, SEQ = 2048, CTXL = 256, NH = 16, NKV = 4, HD = 128;
constexpr int ML = NB * SEQ;
constexpr int MC = NB * CTXL;
constexpr int MT = ML + MC;
constexpr int NE = 16, CAPL = 256, CAPC = 32, DFF = 1024;
constexpr int YR = NB * CAPL + NB * CAPC;
constexpr int YT = NE * YR;
constexpr int NMOD = 6 * DM;
constexpr float NORM_EPS = 1e-6f;
constexpr int KSPLIT = 16;

using pg8::Unit; using pg8::f32x4; using pg8::u32x4; using pg8::bf16_t; using pg8::bf16x8; using pg8::cvt_pk_bf16;
typedef float f32x2 __attribute__((ext_vector_type(2)));
typedef unsigned u32x2 __attribute__((ext_vector_type(2)));
typedef float f32x16 __attribute__((ext_vector_type(16)));
typedef short s16x4 __attribute__((ext_vector_type(4)));
#define DI __device__ __forceinline__

DI float bf_lo(unsigned w) { return __uint_as_float(w << 16); }
DI float bf_hi(unsigned w) { return __uint_as_float(w & 0xffff0000u); }
DI unsigned pk4_fp8(float a, float b, float c, float d) {
    a = __builtin_amdgcn_fmed3f(a, -448.0f, 448.0f); b = __builtin_amdgcn_fmed3f(b, -448.0f, 448.0f); c = __builtin_amdgcn_fmed3f(c, -448.0f, 448.0f); d = __builtin_amdgcn_fmed3f(d, -448.0f, 448.0f);
    int w = __builtin_amdgcn_cvt_pk_fp8_f32(a, b, 0, false); w = __builtin_amdgcn_cvt_pk_fp8_f32(c, d, w, true); return (unsigned)w;
}
constexpr float Y8_SCALE = 64.0f, Y8_INV = 1.0f / 64.0f;
constexpr float W8_SCALE = 32.0f, W8_INV = 1.0f / 32.0f;
DI f32x4 unpk4_fp8(unsigned w) { const f32x2 lo = __builtin_amdgcn_cvt_pk_f32_fp8((int)w, false), hi = __builtin_amdgcn_cvt_pk_f32_fp8((int)w, true); return (f32x4){lo.x, lo.y, hi.x, hi.y}; }
DI float silu_f(float a) { return a * __builtin_amdgcn_rcpf(1.0f + __expf(-a)); }

DI int xcd_remap(int wgid, int nwg) { const int q = nwg / 8, r = nwg % 8, xcd = wgid % 8, off = wgid / 8; return (xcd < r ? xcd * (q + 1) : r * (q + 1) + (xcd - r) * q) + off; }
struct QkvOrder {
    int G, c;
    DI bool next(int i, Unit& u) const {
        const int L = i * G + c; if (L >= 800) return false;
        if (L < 768) { const int w = xcd_remap(L, 768); const int nig = 8 * 12, gid = w / nig; u.pm = gid * 8 + ((w % nig) % 8); u.pn = (w % nig) / 8; }
        else { const int j = L - 768; u.pm = 64 + (j >> 2); u.pn = 8 + (j & 3); }
        return true;
    }
    DI void a_ready(const Unit&) const {}
    DI void done(const Unit&) const {}
};
struct MoeOrder {
    int G, c, NP;
    DI bool next(int i, Unit& u) const {
        const int nwg = NE * NP * 8; const int L = i * G + c; if (L >= nwg) return false;
        const int w = xcd_remap(L, nwg); const int per = NP * 8, e = w / per, rem = w % per;
        u.pm = e * 9 + (rem % NP); u.pn = e * 8 + (rem / NP); return true;
    }
    DI void a_ready(const Unit&) const {}
    DI void done(const Unit&) const {}
};

template <int ACT  > struct EpiPair {
    static constexpr bool PERM = true, AFTER_DRAIN = false;
    bf16_t* O; int ldc; int pn_mod;
    DI void operator()(const f32x4 (&acc)[2][2][4][2], const Unit& u, int wr, int wc, int fr, int fq) const {
        const int row0 = u.pm * 256 + wr * 64 + fr, col0 = (u.pn % pn_mod) * 128 + wc * 32 + 8 * fq;
#pragma unroll
        for (int ai = 0; ai < 2; ++ai)
#pragma unroll
            for (int m = 0; m < 4; ++m) {
                bf16_t* rowp = O + (size_t)(row0 + ai * 128 + m * 16) * ldc + col0;
                f32x4 a0 = acc[ai][0][m][0], a1 = acc[ai][0][m][1]; const f32x4 b0 = acc[ai][1][m][0], b1 = acc[ai][1][m][1];
                if (ACT == 1) {
#pragma unroll
                    for (int j = 0; j < 4; ++j) { a0[j] = silu_f(a0[j]); a1[j] = silu_f(a1[j]); } }
                const f32x4 v0 = a0 * b0, v1 = a1 * b1;
                u32x4 w; w.x = cvt_pk_bf16(v0[0], v0[1]); w.y = cvt_pk_bf16(v0[2], v0[3]); w.z = cvt_pk_bf16(v1[0], v1[1]); w.w = cvt_pk_bf16(v1[2], v1[3]);
                *(u32x4*)rowp = w;
            }
    }
};
struct EpiPairF8 {
    static constexpr bool PERM = true, AFTER_DRAIN = false;
    unsigned char* O; int ldc; int pn_mod;
    DI void operator()(const f32x4 (&acc)[2][2][4][2], const Unit& u, int wr, int wc, int fr, int fq) const {
        const int row0 = u.pm * 256 + wr * 64 + fr, col0 = (u.pn % pn_mod) * 128 + wc * 32 + 8 * fq;
#pragma unroll
        for (int ai = 0; ai < 2; ++ai)
#pragma unroll
            for (int m = 0; m < 4; ++m) {
                unsigned char* rowp = O + (size_t)(row0 + ai * 128 + m * 16) * ldc + col0;
                f32x4 a0 = acc[ai][0][m][0] * W8_INV, a1 = acc[ai][0][m][1] * W8_INV; const f32x4 b0 = acc[ai][1][m][0] * W8_INV, b1 = acc[ai][1][m][1] * W8_INV;
#pragma unroll
                for (int j = 0; j < 4; ++j) { a0[j] = silu_f(a0[j]); a1[j] = silu_f(a1[j]); }
                const f32x4 v0 = a0 * b0, v1 = a1 * b1;
                u32x2 w; w.x = pk4_fp8(v0[0], v0[1], v0[2], v0[3]); w.y = pk4_fp8(v1[0], v1[1], v1[2], v1[3]);
                *(u32x2*)rowp = w;
            }
    }
};
struct EpiConvGate {
    static constexpr bool PERM = true, AFTER_DRAIN = false;
    const bf16_t* U; bf16_t* Z; const float* cw;
    DI void operator()(const f32x4 (&acc)[2][2][4][2], const Unit& u, int wr, int wc, int fr, int fq) const {
        const int row0 = u.pm * 256 + wr * 64 + fr, col0 = u.pn * 256 + wc * 32 + 8 * fq;
#pragma unroll
        for (int bj = 0; bj < 2; ++bj) {
            const int c = col0 + bj * 128;
            f32x4 w0a = *(const f32x4*)(cw + c), w0b = *(const f32x4*)(cw + c + 4), w1a = *(const f32x4*)(cw + 2048 + c), w1b = *(const f32x4*)(cw + 2048 + c + 4), w2a = *(const f32x4*)(cw + 4096 + c), w2b = *(const f32x4*)(cw + 4096 + c + 4);
#pragma unroll
            for (int ai = 0; ai < 2; ++ai)
#pragma unroll
                for (int m = 0; m < 4; ++m) {
                    const int row = row0 + ai * 128 + m * 16;
                    const int tpos = row < ML ? (row & (SEQ - 1)) : ((row - ML) & (CTXL - 1)); const int len = row < ML ? SEQ : CTXL;
                    const u32x4 z4 = (u32x4){0u, 0u, 0u, 0u};
                    const u32x4 uc = *(const u32x4*)(U + (size_t)row * DM + c);
                    const u32x4 up = tpos > 0 ? *(const u32x4*)(U + (size_t)(row - 1) * DM + c) : z4;
                    const u32x4 un = tpos < len - 1 ? *(const u32x4*)(U + (size_t)(row + 1) * DM + c) : z4;
                    f32x4 ya, yb;
                    ya[0] = w0a[0] * bf_lo(up.x) + w1a[0] * bf_lo(uc.x) + w2a[0] * bf_lo(un.x); ya[1] = w0a[1] * bf_hi(up.x) + w1a[1] * bf_hi(uc.x) + w2a[1] * bf_hi(un.x);
                    ya[2] = w0a[2] * bf_lo(up.y) + w1a[2] * bf_lo(uc.y) + w2a[2] * bf_lo(un.y); ya[3] = w0a[3] * bf_hi(up.y) + w1a[3] * bf_hi(uc.y) + w2a[3] * bf_hi(un.y);
                    yb[0] = w0b[0] * bf_lo(up.z) + w1b[0] * bf_lo(uc.z) + w2b[0] * bf_lo(un.z); yb[1] = w0b[1] * bf_hi(up.z) + w1b[1] * bf_hi(uc.z) + w2b[1] * bf_hi(un.z);
                    yb[2] = w0b[2] * bf_lo(up.w) + w1b[2] * bf_lo(uc.w) + w2b[2] * bf_lo(un.w); yb[3] = w0b[3] * bf_hi(up.w) + w1b[3] * bf_hi(uc.w) + w2b[3] * bf_hi(un.w);
                    const f32x4 v0 = acc[ai][bj][m][0] * ya, v1 = acc[ai][bj][m][1] * yb;
                    u32x4 w; w.x = cvt_pk_bf16(v0[0], v0[1]); w.y = cvt_pk_bf16(v0[2], v0[3]); w.z = cvt_pk_bf16(v1[0], v1[1]); w.w = cvt_pk_bf16(v1[2], v1[3]);
                    *(u32x4*)(Z + (size_t)row * DM + c) = w;
                }
        }
    }
};
template <bool BASE_F32> struct EpiResid {
    static constexpr bool PERM = true, AFTER_DRAIN = false;
    const float* base_lat; const float* base_ctx; bf16_t* out; const float* gate; float ws;
    DI void operator()(const f32x4 (&acc)[2][2][4][2], const Unit& u, int wr, int wc, int fr, int fq) const {
        const int rowt = u.pm * 256; const int cr = rowt < ML ? (rowt >> 11) : 8;
        const float* base = rowt < ML ? base_lat : base_ctx - (size_t)ML * DM;
        const int row0 = rowt + wr * 64 + fr, col0 = u.pn * 256 + wc * 32 + 8 * fq;
        f32x4 gv[2][2];
#pragma unroll
        for (int bj = 0; bj < 2; ++bj)
#pragma unroll
            for (int n = 0; n < 2; ++n) gv[bj][n] = *(const f32x4*)(gate + (size_t)cr * NMOD + col0 + bj * 128 + n * 4) * ws;
#pragma unroll
        for (int ai = 0; ai < 2; ++ai)
#pragma unroll
            for (int m = 0; m < 4; ++m) { const size_t off = (size_t)(row0 + ai * 128 + m * 16) * DM + col0;
#pragma unroll
                for (int bj = 0; bj < 2; ++bj) { f32x4 b0, b1;
                    if (BASE_F32) { b0 = *(const f32x4*)(base + off + bj * 128); b1 = *(const f32x4*)(base + off + bj * 128 + 4); }
                    else { const u32x4 hb = *(const u32x4*)(out + off + bj * 128); b0 = (f32x4){bf_lo(hb.x), bf_hi(hb.x), bf_lo(hb.y), bf_hi(hb.y)}; b1 = (f32x4){bf_lo(hb.z), bf_hi(hb.z), bf_lo(hb.w), bf_hi(hb.w)}; }
                    const f32x4 v0 = b0 + gv[bj][0] * acc[ai][bj][m][0], v1 = b1 + gv[bj][1] * acc[ai][bj][m][1];
                    u32x4 w; w.x = cvt_pk_bf16(v0[0], v0[1]); w.y = cvt_pk_bf16(v0[2], v0[3]); w.z = cvt_pk_bf16(v1[0], v1[1]); w.w = cvt_pk_bf16(v1[2], v1[3]);
                    *(u32x4*)(out + off + bj * 128) = w; }
                asm volatile("" ::: "memory"); }
    }
};
struct EpiDown {
    static constexpr bool PERM = true, AFTER_DRAIN = false;
    bf16_t* Y; const float* gatev; float ws;
    DI void operator()(const f32x4 (&acc)[2][2][4][2], const Unit& u, int wr, int wc, int fr, int fq) const {
        const int row0 = u.pm * 256 + wr * 64 + fr, col0 = (u.pn & 7) * 256 + wc * 32 + 8 * fq;
#pragma unroll
        for (int ai = 0; ai < 2; ++ai)
#pragma unroll
            for (int m = 0; m < 4; ++m) { const int row = row0 + ai * 128 + m * 16; const float gt = gatev[row] * ws;
#pragma unroll
                for (int bj = 0; bj < 2; ++bj) { const f32x4 v0 = acc[ai][bj][m][0] * gt, v1 = acc[ai][bj][m][1] * gt;
                    u32x2 w; w.x = pk4_fp8(v0[0], v0[1], v0[2], v0[3]); w.y = pk4_fp8(v1[0], v1[1], v1[2], v1[3]);
                    *(u32x2*)((unsigned char*)Y + (size_t)row * DM + col0 + bj * 128) = w; } }
    }
};
#define LAS3 __attribute__((address_space(3)))
struct EpiQkvNorm {
    static constexpr bool PERM = true, AFTER_DRAIN = false;
    bf16_t* Q; bf16_t* K; bf16_t* V; const float* qg; const float* kg; LAS3 float* P; float ws;
    DI void operator()(const f32x4 (&acc)[2][2][4][2], const Unit& u, int wr, int wc, int fr, int fq) const {
        const int row0 = u.pm * 256 + wr * 64 + fr; int colt = u.pn * 256;
        if (colt >= 2560) {
            const int col0 = colt - 2560 + wc * 32 + 8 * fq;
#pragma unroll
            for (int ai = 0; ai < 2; ++ai)
#pragma unroll
                for (int m = 0; m < 4; ++m) { bf16_t* rowp = V + (size_t)(row0 + ai * 128 + m * 16) * 512 + col0;
#pragma unroll
                    for (int bj = 0; bj < 2; ++bj) { const f32x4 v0 = acc[ai][bj][m][0] * ws, v1 = acc[ai][bj][m][1] * ws;
                        u32x4 w; w.x = cvt_pk_bf16(v0[0], v0[1]); w.y = cvt_pk_bf16(v0[2], v0[3]); w.z = cvt_pk_bf16(v1[0], v1[1]); w.w = cvt_pk_bf16(v1[2], v1[3]);
                        *(u32x4*)(rowp + bj * 128) = w; } }
            return;
        }
        const bool isq = colt < 2048; bf16_t* base = isq ? Q : K; const int ld = isq ? 2048 : 512; if (!isq) colt -= 2048;
        const int rl0 = wr * 64 + fr;
#pragma unroll
        for (int ai = 0; ai < 2; ++ai)
#pragma unroll
            for (int m = 0; m < 4; ++m)
#pragma unroll
                for (int bj = 0; bj < 2; ++bj) { const f32x4 a = acc[ai][bj][m][0], b = acc[ai][bj][m][1];
                    float s = (a[0] * a[0] + a[1] * a[1]) + (a[2] * a[2] + a[3] * a[3]) + (b[0] * b[0] + b[1] * b[1]) + (b[2] * b[2] + b[3] * b[3]);
                    s += __shfl_xor(s, 16); s += __shfl_xor(s, 32);
                    if (fq == 0) P[((ai * 128 + m * 16 + rl0) * 2 + bj) * 4 + wc] = s; }
        asm volatile("s_waitcnt lgkmcnt(0)" ::: "memory"); __builtin_amdgcn_s_barrier(); asm volatile("" ::: "memory");
        constexpr float QSCALE = 0.08838834764831845f * 1.4426950408889634f;
        const int i0 = 16 * (wc & 1) + 4 * fq, d0 = 64 * (wc >> 1) + i0;
        const float* gp = isq ? qg : kg; f32x4 g0 = *(const f32x4*)(gp + d0), g1 = *(const f32x4*)(gp + d0 + 32);
        if (isq) { g0 = g0 * QSCALE; g1 = g1 * QSCALE; }
        f32x4 ifr;
#pragma unroll
        for (int j = 0; j < 4; ++j) ifr[j] = exp2f(-(float)(i0 + j) * (13.287712379549449f / 32.0f));
        const bool lat = u.pm < 64;
#pragma unroll
        for (int ai = 0; ai < 2; ++ai)
#pragma unroll
            for (int m = 0; m < 4; ++m) { const int row = row0 + ai * 128 + m * 16; const int t = row & (SEQ - 1);
                const float pos = (float)((wc >> 1) == 0 ? (t >> 6) : (t & 63));
                f32x4 cs, sn;
#pragma unroll
                for (int j = 0; j < 4; ++j) { const float ang = pos * ifr[j]; cs[j] = lat ? __cosf(ang) : 1.0f; sn[j] = lat ? __sinf(ang) : 0.0f; }
#pragma unroll
                for (int bj = 0; bj < 2; ++bj) { const f32x4 pp = *(const LAS3 f32x4*)(P + ((ai * 128 + m * 16 + rl0) * 2 + bj) * 4);
                    const float rstd = ws / sqrtf(((pp[0] + pp[1]) + (pp[2] + pp[3])) * (ws * ws) * (1.0f / HD) + NORM_EPS);
                    const f32x4 a = acc[ai][bj][m][0] * rstd * g0, b = acc[ai][bj][m][1] * rstd * g1;
                    const f32x4 o1 = a * cs - b * sn, o2 = b * cs + a * sn;
                    u32x4 w; w.x = cvt_pk_bf16(o1[0], o1[1]); w.y = cvt_pk_bf16(o1[2], o1[3]); w.z = cvt_pk_bf16(o2[0], o2[1]); w.w = cvt_pk_bf16(o2[2], o2[3]);
                    *(u32x4*)(base + (size_t)row * ld + colt + bj * 128 + wc * 32 + 8 * fq) = w; } }
    }
};

constexpr size_t MiB = 1u << 20;
constexpr size_t WS_CTL = 0, CTL_ZERO_BYTES = 1 * MiB;
constexpr size_t WS_MOD = 1 * MiB;
constexpr size_t WS_MODP = 2 * MiB;
constexpr size_t WS_AFFL = 16 * MiB;
constexpr size_t WS_AFFC = 17 * MiB;
constexpr size_t WS_RWT = 17 * MiB + 128 * 1024;
constexpr size_t WS_IDMAP = 19 * MiB + 768 * 1024;
constexpr size_t WS_ROWSRC = 17 * MiB + 512 * 1024;
constexpr size_t WS_GATEV = 18 * MiB;
constexpr size_t WS_INV = 18 * MiB + 512 * 1024;
constexpr size_t WS_W1A = 20 * MiB;
constexpr size_t WS_W1B = 36 * MiB;
constexpr size_t WS_W2 = 44 * MiB;
constexpr size_t WS_WQKV = 52 * MiB;
constexpr size_t WS_WO = 64 * MiB;
constexpr size_t WS_WGU = 72 * MiB;
constexpr size_t WS_WDN = 328 * MiB;
constexpr size_t WS_H = 456 * MiB;
constexpr size_t WS_A = 600 * MiB;
constexpr size_t WS_U = 672 * MiB;
constexpr size_t WS_Z = 744 * MiB;
constexpr size_t WS_Q = WS_U, WS_K = WS_Z, WS_V = WS_Z + 18 * MiB;
constexpr size_t WS_HM = 816 * MiB;
constexpr size_t WS_O = WS_HM;
constexpr size_t WS_Y = 888 * MiB;
constexpr size_t WS_END = 1032 * MiB;
constexpr int CW_BAR = 4096;

constexpr int RING_BYTES = 131072;
constexpr int MISC_OFF = RING_BYTES + 14336;
constexpr int LDS_BYTES = 147456;

#define GAS __attribute__((address_space(1)))
#define LAS __attribute__((address_space(3)))
#define LDS_WAIT() asm volatile("s_waitcnt lgkmcnt(0)" ::: "memory")
#define VM_WAIT() asm volatile("s_waitcnt vmcnt(0)" ::: "memory")
#define XB_TMO      128
#define XB_XCNT(j)  (256  + 64 * (j))
#define XB_XSUB(j)  (1280 + 64 * (j))
#define XB_XGEN(j)  (2304 + 64 * (j))
#define XB_TOP      3328
#define XB_TOPGEN   3392
#define XCD_BAR_WORDS 3456
#define XB_SPIN_CAP (1u << 18)

__device__ __forceinline__ unsigned xb_ld(unsigned* p)              { return __hip_atomic_load(p, __ATOMIC_RELAXED, __HIP_MEMORY_SCOPE_AGENT); }
__device__ __forceinline__ unsigned xb_add(unsigned* p, unsigned v) { return __hip_atomic_fetch_add(p, v, __ATOMIC_RELAXED, __HIP_MEMORY_SCOPE_AGENT); }
__device__ __forceinline__ unsigned xb_xcc_id() { return (unsigned)__builtin_amdgcn_s_getreg((3 << 11) | 20) & 0xFu; }
#define XB_SPIN(cond, bar) do { unsigned _sp = 0; while (cond) { __builtin_amdgcn_s_sleep(1); \
    if ((++_sp & 255u) == 0u) { if (xb_ld(&(bar)[XB_TMO])) break; if (_sp > XB_SPIN_CAP) { atomicAdd(&(bar)[XB_TMO], 1u); break; } } } } while (0)

struct XcdBarrier {
    unsigned* bar; unsigned x;
    volatile LAS unsigned* st;
};

__device__ __forceinline__ XcdBarrier xcd_barrier_post(unsigned* bar, volatile LAS unsigned* st) {
    XcdBarrier b; b.bar = bar; b.x = xb_xcc_id(); b.st = st;
    if (threadIdx.x == 0) (void)xb_add(&bar[XB_XCNT(b.x)], 1u);
    return b;
}
__device__ __forceinline__ void xcd_barrier_complete(unsigned* bar, unsigned x, unsigned& nloc, unsigned& nx) {
    const unsigned G = gridDim.x * gridDim.y * gridDim.z;
    unsigned sum, cnt, mine, sp = 0u;
    for (;;) {
        sum = 0u; cnt = 0u; mine = 0u;
#pragma unroll
        for (unsigned j = 0; j < 16; ++j) { const unsigned c = xb_ld(&bar[XB_XCNT(j)]); sum += c; cnt += (c > 0u) ? 1u : 0u; mine = (j == x) ? c : mine; }
        if (sum == G) break;
        __builtin_amdgcn_s_sleep(1);
        if ((++sp & 255u) == 0u) { if (xb_ld(&bar[XB_TMO])) break; if (sp > XB_SPIN_CAP) { atomicAdd(&bar[XB_TMO], 1u); break; } }
    }
    nloc = mine > 0u ? mine : 1u; nx = cnt > 0u ? cnt : 1u;
}

__device__ __forceinline__ void xcd_barrier(const XcdBarrier& b) {
    asm volatile("s_waitcnt vmcnt(0)" ::: "memory");
    __syncthreads();
    if (threadIdx.x == 0) {
        unsigned* bar = b.bar;
        __builtin_amdgcn_s_waitcnt(0);
        unsigned nloc = b.st[0], nx = b.st[1];
        if (nloc == 0u) { xcd_barrier_complete(bar, b.x, nloc, nx); b.st[0] = nloc; b.st[1] = nx; }
        const unsigned old = xb_add(&bar[XB_XSUB(b.x)], 1u);
        const unsigned gen = old / nloc;
        if (old + 1u == (gen + 1u) * nloc) {
            __builtin_amdgcn_fence(__ATOMIC_RELEASE, "agent");
            asm volatile("s_waitcnt vmcnt(0)" ::: "memory");
            const unsigned og = xb_add(&bar[XB_TOP], 1u);
            const unsigned tg = og / nx;
            if (og + 1u == (tg + 1u) * nx) xb_add(&bar[XB_TOPGEN], 1u);
            else XB_SPIN(xb_ld(&bar[XB_TOPGEN]) == tg, bar);
            __builtin_amdgcn_fence(__ATOMIC_ACQUIRE, "agent");
            xb_add(&bar[XB_XGEN(b.x)], 1u);
            asm volatile("s_waitcnt vmcnt(0)" ::: "memory");
        } else {
            XB_SPIN(xb_ld(&bar[XB_XGEN(b.x)]) == gen, bar);
            __builtin_amdgcn_fence(__ATOMIC_ACQUIRE, "agent");
            asm volatile("s_waitcnt vmcnt(0)" ::: "memory");
        }
    }
    __syncthreads();
}

DI float wave_sum(float v) {
#pragma unroll
    for (int o = 1; o < 64; o <<= 1) v += __shfl_xor(v, o);
    return v;
}
DI float rdlane(float v, int l) { return __uint_as_float((unsigned)__builtin_amdgcn_readlane((int)__float_as_uint(v), l)); }
DI unsigned pk2(float lo, float hi) { return cvt_pk_bf16(lo, hi); }

DI void ph_adaln(const float* cnd, const float* cctx, const float* ada_w, float* modp, int gw, int NGW, int lane) {
    for (int task = gw; task < 96 * KSPLIT; task += NGW) {
        const int ks = task & (KSPLIT - 1), cg = task / KSPLIT, l = cg / 48, cgl = cg % 48, col0 = cgl * 256 + lane * 4, k0 = ks * 128;
        float sv[9][2];
#pragma unroll
        for (int r = 0; r < 9; ++r)
#pragma unroll
            for (int hh = 0; hh < 2; ++hh) { const int k = k0 + hh * 64 + lane; const float v = r < 8 ? cnd[r * DM + k] : cctx[k]; sv[r][hh] = v / (1.0f + __expf(-v)); }
        f32x4 acc[9];
#pragma unroll
        for (int r = 0; r < 9; ++r) acc[r] = (f32x4){0.f, 0.f, 0.f, 0.f};
        const float* wp = ada_w + ((size_t)l * DM + k0) * NMOD + col0;
#pragma unroll
        for (int hh = 0; hh < 2; ++hh) {
#pragma unroll 8
            for (int kk = 0; kk < 64; ++kk) {
                const f32x4 w = *(const f32x4*)(wp + (size_t)(hh * 64 + kk) * NMOD);
#pragma unroll
                for (int r = 0; r < 9; ++r) { const float s = rdlane(sv[r][hh], kk); acc[r] += w * s; }
            }
        }
#pragma unroll
        for (int r = 0; r < 9; ++r) *(f32x4*)(modp + ((size_t)((ks * 2 + l) * 9 + r)) * NMOD + col0) = acc[r];
    }
}
struct CvtPtrs { const float *cin, *cout, *wqkv, *wo, *wg, *wu, *wd; bf16_t *W1A, *W1B, *W2, *WQKV, *WO, *WGU, *WDN; };
constexpr int CVT_E0 = 6656, CVT_L = 24576, CVT_TOTAL = CVT_E0 + 2 * CVT_L;
DI void cvt_resolve(const CvtPtrs& P, int it, const float*& src, int& ldw, bf16_t*& dst, int& ldd, bool& qperm, bool& f8) {
    int r = it; qperm = false; f8 = false;
    if (r < 3072) { const int kt = ((r >> 3) / 96) * 8 + (r & 7), nt = (r >> 3) % 96, n0 = nt * 64, part = n0 >> 11, j0 = n0 & 2047;
        src = P.cin + (size_t)(kt * 64) * 6144 + n0; ldw = 6144; ldd = DM;
        dst = (part == 0 ? P.W1B + (size_t)j0 * DM : P.W1A + (size_t)((j0 >> 7) * 256 + (part == 2 ? 128 : 0) + (j0 & 127)) * DM) + kt * 64; return; } r -= 3072;
    if (r < 1024) { const int kt = ((r >> 3) / 32) * 8 + (r & 7), nt = (r >> 3) % 32; src = P.cout + (size_t)(kt * 64) * DM + nt * 64; ldw = DM; dst = P.W2 + (size_t)(nt * 64) * DM + kt * 64; ldd = DM; return; } r -= 1024;
    if (r < 1536) { const int kt = ((r >> 3) / 48) * 8 + (r & 7), nt = (r >> 3) % 48; src = P.wqkv + (size_t)(kt * 64) * 3072 + nt * 64; ldw = 3072; qperm = nt < 40;     f8 = true; dst = (bf16_t*)((unsigned char*)P.WQKV + (size_t)(nt * 64) * DM + kt * 64); ldd = DM;     return; } r -= 1536;
    if (r < 1024) { const int kt = ((r >> 3) / 32) * 8 + (r & 7), nt = (r >> 3) % 32; src = P.wo + (size_t)(kt * 64) * DM + nt * 64; ldw = DM; f8 = true;
        dst = (bf16_t*)((unsigned char*)P.WO + (size_t)(nt * 64) * DM + kt * 64); ldd = DM; return; } r -= 1024;
    const int l = r / CVT_L, rr = r % CVT_L, kind = rr / 8192, q = rr % 8192, le = l * 16 + q / 512, rem = q % 512;
    f8 = true;
    if (kind < 2) { const int kt = ((rem >> 3) / 16) * 8 + (rem & 7), nt = (rem >> 3) % 16, n0 = nt * 64;
        src = (kind ? P.wu : P.wg) + (size_t)le * DM * DFF + (size_t)(kt * 64) * DFF + n0; ldw = DFF;
        dst = (bf16_t*)((unsigned char*)P.WGU + (size_t)(le * 2048 + (n0 >> 7) * 256 + kind * 128 + (n0 & 127)) * DM + kt * 64); ldd = DM; }
    else { const int kt = ((rem >> 3) / 32) * 8 + (rem & 7), nt = (rem >> 3) % 32;
        src = P.wd + (size_t)le * DFF * DM + (size_t)(kt * 64) * DM + nt * 64; ldw = DM; dst = (bf16_t*)((unsigned char*)P.WDN + (size_t)(le * 2048 + nt * 64) * DFF + kt * 64); ldd = DFF; }
}
constexpr int CVT_P = 36;
DI void cvt_range(const CvtPtrs& P, int lo, int hi, int w, int NW, LAS unsigned* scr, int lane) {
    int it = lo + w; if (it >= hi) return;
    const int c = lane & 15, q = lane >> 4;
    const float* src; int ldw; bf16_t* dst; int ldd; bool qperm, f8; cvt_resolve(P, it, src, ldw, dst, ldd, qperm, f8);
    f32x4 v[16];
#pragma unroll
    for (int rr = 0; rr < 16; ++rr) v[rr] = __builtin_nontemporal_load((const f32x4*)(src + (size_t)(16 * q + rr) * ldw + 4 * c));
    for (;;) {
        const bool cf8 = f8; const int wrow = qperm ? 32 * ((c >> 2) & 1) + 8 * (c & 3) + 4 * (c >> 3) : 4 * c;
        u32x4 pa[4], pb[4];
        if (cf8) {
#pragma unroll
            for (int i = 0; i < 4; ++i) { pa[i].x = pk4_fp8(v[0][i] * W8_SCALE, v[1][i] * W8_SCALE, v[2][i] * W8_SCALE, v[3][i] * W8_SCALE); pa[i].y = pk4_fp8(v[4][i] * W8_SCALE, v[5][i] * W8_SCALE, v[6][i] * W8_SCALE, v[7][i] * W8_SCALE);
                                          pa[i].z = pk4_fp8(v[8][i] * W8_SCALE, v[9][i] * W8_SCALE, v[10][i] * W8_SCALE, v[11][i] * W8_SCALE); pa[i].w = pk4_fp8(v[12][i] * W8_SCALE, v[13][i] * W8_SCALE, v[14][i] * W8_SCALE, v[15][i] * W8_SCALE); pb[i] = pa[i]; }
        } else {
#pragma unroll
            for (int i = 0; i < 4; ++i) { pa[i].x = pk2(v[0][i], v[1][i]); pa[i].y = pk2(v[2][i], v[3][i]); pa[i].z = pk2(v[4][i], v[5][i]); pa[i].w = pk2(v[6][i], v[7][i]);
                                          pb[i].x = pk2(v[8][i], v[9][i]); pb[i].y = pk2(v[10][i], v[11][i]); pb[i].z = pk2(v[12][i], v[13][i]); pb[i].w = pk2(v[14][i], v[15][i]); }
        }
        const int nit = it + NW; bf16_t* cdst = dst; const int cldd = ldd;
        if (nit < hi) { cvt_resolve(P, nit, src, ldw, dst, ldd, qperm, f8);
#pragma unroll
            for (int rr = 0; rr < 16; ++rr) v[rr] = __builtin_nontemporal_load((const f32x4*)(src + (size_t)(16 * q + rr) * ldw + 4 * c)); }
        if (cf8) {
#pragma unroll
            for (int i = 0; i < 4; ++i) *(LAS u32x4*)(scr + (wrow + i) * 20 + 4 * q) = pa[i];
            LDS_WAIT(); asm volatile("" ::: "memory");
#pragma unroll
            for (int j = 0; j < 4; ++j) { const int ch = lane + 64 * j, n = ch >> 2, part = ch & 3; const u32x4 o = *(const LAS u32x4*)(scr + n * 20 + 4 * part);
                *(u32x4*)((unsigned char*)cdst + (size_t)n * cldd + 16 * part) = o; }
        } else {
#pragma unroll
            for (int i = 0; i < 4; ++i) { *(LAS u32x4*)(scr + (wrow + i) * CVT_P + 8 * q) = pa[i]; *(LAS u32x4*)(scr + (wrow + i) * CVT_P + 8 * q + 4) = pb[i]; }
            LDS_WAIT(); asm volatile("" ::: "memory");
#pragma unroll
            for (int j = 0; j < 8; ++j) { const int n = (lane >> 3) + 8 * j; const u32x4 o = *(const LAS u32x4*)(scr + n * CVT_P + 4 * (lane & 7));
                *(u32x4*)(cdst + (size_t)n * cldd + 8 * (lane & 7)) = o; }
        }
        LDS_WAIT(); asm volatile("" ::: "memory");
        if (nit >= hi) break;
        it = nit;
    }
}
DI void ph_modred(const float* modp, const float* ada_b, float* mod, int gtid, int GT) {
    for (int i = gtid; i < 2 * 9 * NMOD; i += GT) { const int l = i / (9 * NMOD), j = i % NMOD; float s = ada_b[l * NMOD + j];
#pragma unroll
        for (int ks = 0; ks < KSPLIT; ++ks) s += modp[(size_t)ks * (2 * 9 * NMOD) + i];
        mod[i] = s; }
}
DI void row_load(const float* p, f32x4 (&v)[8], int lane) {
#pragma unroll
    for (int j = 0; j < 8; ++j) v[j] = *(const f32x4*)(p + 4 * lane + 256 * j);
}
DI void row_load_bf(const bf16_t* p, f32x4 (&v)[8], int lane) {
#pragma unroll
    for (int j = 0; j < 8; ++j) { const u32x2 w = *(const u32x2*)(p + 4 * lane + 256 * j); v[j] = (f32x4){bf_lo(w.x), bf_hi(w.x), bf_lo(w.y), bf_hi(w.y)}; }
}
DI void row_modulate(const f32x4 (&v)[8], f32x4 (&y)[8], const float* gain, const float* shift, const float* scale, int lane) {
    float ss = 0.f;
#pragma unroll
    for (int j = 0; j < 8; ++j) ss += (v[j][0] * v[j][0] + v[j][1] * v[j][1]) + (v[j][2] * v[j][2] + v[j][3] * v[j][3]);
    ss = wave_sum(ss);
    const float rstd = 1.0f / sqrtf(ss * (1.0f / DM) + NORM_EPS);
#pragma unroll
    for (int j = 0; j < 8; ++j) { const int c = 4 * lane + 256 * j; const f32x4 g = *(const f32x4*)(gain + c), sh = *(const f32x4*)(shift + c), sc = *(const f32x4*)(scale + c);
        y[j] = ((v[j] * rstd) * g) * (sc + 1.0f) + sh; }
}
DI void row_modulate2(const f32x4 (&v0)[8], const f32x4 (&v1)[8], f32x4 (&y0)[8], f32x4 (&y1)[8], const float* gain, const float* shift, const float* scale, int lane) {
    float s0 = 0.f, s1 = 0.f;
#pragma unroll
    for (int j = 0; j < 8; ++j) { s0 += (v0[j][0] * v0[j][0] + v0[j][1] * v0[j][1]) + (v0[j][2] * v0[j][2] + v0[j][3] * v0[j][3]); s1 += (v1[j][0] * v1[j][0] + v1[j][1] * v1[j][1]) + (v1[j][2] * v1[j][2] + v1[j][3] * v1[j][3]); }
    s0 = wave_sum(s0); s1 = wave_sum(s1);
    const float r0 = 1.0f / sqrtf(s0 * (1.0f / DM) + NORM_EPS), r1 = 1.0f / sqrtf(s1 * (1.0f / DM) + NORM_EPS);
#pragma unroll
    for (int j = 0; j < 8; ++j) { const int c = 4 * lane + 256 * j; const f32x4 g = *(const f32x4*)(gain + c), sh = *(const f32x4*)(shift + c), sc = *(const f32x4*)(scale + c);
        y0[j] = ((v0[j] * r0) * g) * (sc + 1.0f) + sh; y1[j] = ((v1[j] * r1) * g) * (sc + 1.0f) + sh; }
}
DI void row_store_bf16(bf16_t* p, const f32x4 (&y)[8], int lane) {
#pragma unroll
    for (int j = 0; j < 8; ++j) { u32x2 w; w.x = pk2(y[j][0], y[j][1]); w.y = pk2(y[j][2], y[j][3]); *(u32x2*)(p + 4 * lane + 256 * j) = w; }
}
DI void ph_mod0(const float* x, const float* ctx, const float* gain, const float* mod0, bf16_t* A, int gw, int NGW, int lane) {
    int row = gw; if (row >= MT) return;
    f32x4 v[8], vn[8];
    row_load(row < ML ? x + (size_t)row * DM : ctx + (size_t)(row - ML) * DM, v, lane);
    for (;;) {
        const int nrow = row + NGW; const bool more = nrow < MT;
        if (more) row_load(nrow < ML ? x + (size_t)nrow * DM : ctx + (size_t)(nrow - ML) * DM, vn, lane);
        const int cr = row < ML ? (row >> 11) : 8;
        f32x4 y[8]; row_modulate(v, y, gain, mod0 + (size_t)cr * NMOD + 0 * DM, mod0 + (size_t)cr * NMOD + 1 * DM, lane);
        row_store_bf16(A + (size_t)row * DM, y, lane);
        if (!more) break;
#pragma unroll
        for (int j = 0; j < 8; ++j) v[j] = vn[j];
        row = nrow;
    }
}
DI float reduce8(const float (&v)[8], int lane) {
    const bool u0 = lane & 1, u1 = lane & 2, u2 = lane & 4;
    float a[4], b2[2];
#pragma unroll
    for (int k = 0; k < 4; ++k) { const float lo = v[2 * k], hi = v[2 * k + 1]; a[k] = (u0 ? hi : lo) + __shfl_xor(u0 ? lo : hi, 1); }
#pragma unroll
    for (int k = 0; k < 2; ++k) { const float lo = a[2 * k], hi = a[2 * k + 1]; b2[k] = (u1 ? hi : lo) + __shfl_xor(u1 ? lo : hi, 2); }
    return (u2 ? b2[1] : b2[0]) + __shfl_xor(u2 ? b2[0] : b2[1], 4);
}
DI float reduce_halves(float lo8, float hi8, int lane) {
    const bool u3 = lane & 8;
    float t = (u3 ? hi8 : lo8) + __shfl_xor(u3 ? lo8 : hi8, 8);
    t += __shfl_xor(t, 16); t += __shfl_xor(t, 32); return t;
}
DI float softmax16(float lg) {
    float mx = lg;
#pragma unroll
    for (int o = 1; o < 16; o <<= 1) mx = fmaxf(mx, __shfl_xor(mx, o));
    const float ex = __expf(lg - mx); float den = ex;
#pragma unroll
    for (int o = 1; o < 16; o <<= 1) den += __shfl_xor(den, o);
    return ex / den;
}
DI void aff_store(float v, float* affL, float* affC, int row, int lane) {
    if (lane < 16) { if (row < ML) { const int b = row >> 11, n = row & 2047; affL[(size_t)(b * 16 + lane) * SEQ + n] = v; }
                     else { const int rc = row - ML, b = rc >> 8, n = rc & 255; affC[(size_t)(b * 16 + lane) * CTXL + n] = v; } }
}
DI void router_rows2(const f32x4 (&y0)[8], const f32x4 (&y1)[8], const LAS float* rwT, float* affL, float* affC, int row0, int lane) {
    f32x2 yp[8][4];
#pragma unroll
    for (int j = 0; j < 8; ++j)
#pragma unroll
        for (int q = 0; q < 4; ++q) yp[j][q] = (f32x2){y0[j][q], y1[j][q]};
    float r0[2], r1[2];
#pragma unroll
    for (int hf = 0; hf < 2; ++hf) {
        float l0[8], l1[8];
#pragma unroll
        for (int e = 0; e < 8; ++e) { f32x2 acc = (f32x2){0.f, 0.f};
#pragma unroll
            for (int j = 0; j < 8; ++j) { const f32x4 w = *(const LAS f32x4*)(rwT + (8 * hf + e) * DM + 4 * lane + 256 * j);
#pragma unroll
                for (int q = 0; q < 4; ++q) acc = __builtin_elementwise_fma(yp[j][q], (f32x2){w[q], w[q]}, acc); }
            l0[e] = acc.x; l1[e] = acc.y; __builtin_amdgcn_sched_barrier(0); }
        r0[hf] = reduce8(l0, lane); r1[hf] = reduce8(l1, lane);
    }
    const float a0 = softmax16(reduce_halves(r0[0], r0[1], lane)), a1 = softmax16(reduce_halves(r1[0], r1[1], lane));
    aff_store(a0, affL, affC, row0, lane); aff_store(a1, affL, affC, row0 + 1, lane);
}
DI void ph_rwt(const float* rw, float* rwT, int gtid, int GT) {
    for (int i = gtid; i < 2 * 16 * DM; i += GT) { const int l = i >> 15, e = (i >> 11) & 15, d = i & (DM - 1); rwT[i] = rw[(size_t)l * DM * 16 + d * 16 + e]; }
}
DI void load_router(const float* rwT_g, LAS float* rwT, int tid) {
    for (int i = tid; i < DM * 16 / 4; i += 512) ((LAS f32x4*)rwT)[i] = ((const f32x4*)rwT_g)[i];
    __syncthreads();
}
DI void ph_modffn(const bf16_t* H, const float* gain, const float* modl, bf16_t* A, const LAS float* rwT, float* affL, float* affC, int nrows, int gw, int NGW, int lane) {
    int rp = gw; if (rp >= nrows / 2) return;
    u32x2 p0[8], p1[8];
#define MODFFN_LOAD(rp_) do { const int row_ = 2 * (rp_); _Pragma("unroll") for (int j = 0; j < 8; ++j) { p0[j] = *(const u32x2*)(H + (size_t)row_ * DM + 4 * lane + 256 * j); p1[j] = *(const u32x2*)(H + (size_t)(row_ + 1) * DM + 4 * lane + 256 * j); } } while (0)
    MODFFN_LOAD(rp);
    for (;;) {
        const int row = 2 * rp; const int cr = row < ML ? (row >> 11) : 8;
        float s0 = 0.f, s1 = 0.f;
#pragma unroll
        for (int j = 0; j < 8; ++j) { const float a0 = bf_lo(p0[j].x), a1 = bf_hi(p0[j].x), a2 = bf_lo(p0[j].y), a3 = bf_hi(p0[j].y); s0 += (a0 * a0 + a1 * a1) + (a2 * a2 + a3 * a3);
                                      const float b0 = bf_lo(p1[j].x), b1 = bf_hi(p1[j].x), b2 = bf_lo(p1[j].y), b3 = bf_hi(p1[j].y); s1 += (b0 * b0 + b1 * b1) + (b2 * b2 + b3 * b3); }
        s0 = wave_sum(s0); s1 = wave_sum(s1);
        const float r0 = 1.0f / sqrtf(s0 * (1.0f / DM) + NORM_EPS), r1 = 1.0f / sqrtf(s1 * (1.0f / DM) + NORM_EPS);
        const float* shift = modl + (size_t)cr * NMOD + 3 * DM; const float* scale = modl + (size_t)cr * NMOD + 4 * DM;
        f32x4 y0[8], y1[8];
#pragma unroll
        for (int j = 0; j < 8; ++j) { const int c = 4 * lane + 256 * j; const f32x4 g = *(const f32x4*)(gain + c), sh = *(const f32x4*)(shift + c), sc = *(const f32x4*)(scale + c);
            const f32x4 v0 = (f32x4){bf_lo(p0[j].x), bf_hi(p0[j].x), bf_lo(p0[j].y), bf_hi(p0[j].y)}, v1 = (f32x4){bf_lo(p1[j].x), bf_hi(p1[j].x), bf_lo(p1[j].y), bf_hi(p1[j].y)};
            y0[j] = ((v0 * r0) * g) * (sc + 1.0f) + sh; y1[j] = ((v1 * r1) * g) * (sc + 1.0f) + sh;
            *(unsigned*)((unsigned char*)A + (size_t)row * DM + c) = pk4_fp8(y0[j][0], y0[j][1], y0[j][2], y0[j][3]);
            *(unsigned*)((unsigned char*)A + (size_t)(row + 1) * DM + c) = pk4_fp8(y1[j][0], y1[j][1], y1[j][2], y1[j][3]); }
        const int nrp = rp + NGW; const bool more = nrp < nrows / 2;
        if (more) MODFFN_LOAD(nrp);
        asm volatile("" ::: "memory");
        router_rows2(y0, y1, rwT, affL, affC, row, lane);
        if (!more) break;
        rp = nrp;
    }
#undef MODFFN_LOAD
}
DI void ph_topk(int nitems, const float* affL, const float* affC, int* rowsrc, float* gatev, int* inv, LAS unsigned* hist, int tid, int lane, int wave, int bid, int G) {
    LAS unsigned* sh = hist + 256;
    for (int it = bid; it < nitems; it += G) {
        const bool isc = it >= 128; const int be = it & 127, b = be >> 4, e = be & 15;
        const int N = isc ? CTXL : SEQ, C = isc ? CAPC : CAPL;
        const float* src = isc ? affC + (size_t)be * CTXL : affL + (size_t)be * SEQ;
        const int i0 = tid * 4; const bool valid = i0 < N;
        unsigned key[4];
        { f32x4 v = (f32x4){0.f, 0.f, 0.f, 0.f}; if (valid) v = *(const f32x4*)(src + i0);
#pragma unroll
          for (int q = 0; q < 4; ++q) key[q] = __float_as_uint(v[q]); }
        unsigned prefix = 0u, mask = 0u, krem = (unsigned)C;
        for (int pass = 3; pass >= 0; --pass) {
            const int shift = pass * 8;
            if (tid < 256) hist[tid] = 0u;
            __syncthreads();
            if (valid) {
#pragma unroll
                for (int q = 0; q < 4; ++q) if ((key[q] & mask) == prefix) __hip_atomic_fetch_add(&hist[(key[q] >> shift) & 255u], 1u, __ATOMIC_RELAXED, __HIP_MEMORY_SCOPE_WORKGROUP); }
            __syncthreads();
            if (wave == 0) {
                const unsigned h0 = hist[4 * lane], h1 = hist[4 * lane + 1], h2 = hist[4 * lane + 2], h3 = hist[4 * lane + 3];
                const unsigned tot = h0 + h1 + h2 + h3; unsigned incl = tot;
#pragma unroll
                for (int o = 1; o < 64; o <<= 1) { const unsigned t = __shfl_down(incl, o); if (lane + o < 64) incl += t; }
                const unsigned a3 = incl - tot, a2 = a3 + h3, a1 = a2 + h2, a0 = a1 + h1;
                if (a3 < krem && krem <= a3 + h3) { sh[0] = 4 * lane + 3; sh[1] = krem - a3; }
                if (a2 < krem && krem <= a2 + h2) { sh[0] = 4 * lane + 2; sh[1] = krem - a2; }
                if (a1 < krem && krem <= a1 + h1) { sh[0] = 4 * lane + 1; sh[1] = krem - a1; }
                if (a0 < krem && krem <= a0 + h0) { sh[0] = 4 * lane + 0; sh[1] = krem - a0; }
            }
            __syncthreads();
            const unsigned B = sh[0]; krem = sh[1]; prefix |= B << shift; mask |= 0xFFu << shift;
        }
        const unsigned T = prefix;
        unsigned cg = 0u, ce = 0u;
        if (valid) {
#pragma unroll
            for (int q = 0; q < 4; ++q) { cg += key[q] > T ? 1u : 0u; ce += key[q] == T ? 1u : 0u; } }
        const unsigned mine = cg | (ce << 16); unsigned incl = mine;
#pragma unroll
        for (int o = 1; o < 64; o <<= 1) { const unsigned t = __shfl_up(incl, o); if (lane >= o) incl += t; }
        if (lane == 63) sh[8 + wave] = incl;
        __syncthreads();
        unsigned woff = 0u;
#pragma unroll
        for (int w = 0; w < 8; ++w) woff += (w < wave) ? sh[8 + w] : 0u;
        const unsigned excl = woff + incl - mine; unsigned gtb = excl & 0xFFFFu, eqb = excl >> 16;
        if (valid) {
            const int ybase = e * YR + (isc ? NB * CAPL + b * CAPC : b * CAPL); const int rbase = isc ? ML + b * CTXL : b * SEQ;
#pragma unroll
            for (int q = 0; q < 4; ++q) {
                const bool isg = key[q] > T, ise = key[q] == T; const bool sel = isg || (ise && eqb < krem);
                const unsigned slot = gtb + (eqb < krem ? eqb : krem);
                const int trow = rbase + i0 + q; const int yrow = ybase + (int)slot;
                if (sel) { rowsrc[yrow] = trow; gatev[yrow] = __uint_as_float(key[q]); }
                inv[(size_t)trow * 16 + e] = sel ? yrow : -1;
                gtb += isg ? 1u : 0u; eqb += ise ? 1u : 0u;
            }
        }
        __syncthreads();
    }
}
template <bool LAST> DI void ph_combine(bf16_t* H, const bf16_t* Y, const int* inv, const float* modl  , const float* gain1, const float* mod1, bf16_t* A, float* out, int nrows, int gw, int NGW, int lane) {
    int row = gw; if (row >= nrows) return;
    u32x2 hp[8], hn[8]; int myinv, ninv = -1;
#define CMB_LOAD(HP, IV, row_) do { _Pragma("unroll") for (int j = 0; j < 8; ++j) HP[j] = *(const u32x2*)(H + (size_t)(row_) * DM + 4 * lane + 256 * j); IV = inv[(size_t)(row_) * 16 + (lane & 15)]; } while (0)
    CMB_LOAD(hp, myinv, row);
    for (;;) {
        const int nrow = row + NGW; const bool more = nrow < nrows;
        if (more) CMB_LOAD(hn, ninv, nrow);
        const int cr = row < ML ? (row >> 11) : 8;
        f32x4 acc[8];
#pragma unroll
        for (int j = 0; j < 8; ++j) acc[j] = (f32x4){0.f, 0.f, 0.f, 0.f};
        unsigned m = (unsigned)(__ballot(myinv >= 0) & 0xFFFFull);
        while (m) {
            const int e1 = __builtin_ctz(m); m &= m - 1; const bool two = m != 0u; const int e2 = two ? __builtin_ctz(m) : e1; if (two) m &= m - 1;
            const unsigned char* y1 = (const unsigned char*)Y + (size_t)__builtin_amdgcn_readlane(myinv, e1) * DM + 4 * lane; const unsigned char* y2 = (const unsigned char*)Y + (size_t)__builtin_amdgcn_readlane(myinv, e2) * DM + 4 * lane;
            unsigned q1[8], q2[8];
#pragma unroll
            for (int j = 0; j < 8; ++j) { q1[j] = *(const unsigned*)(y1 + 256 * j); q2[j] = *(const unsigned*)(y2 + 256 * j); }
            const float f2 = two ? 1.0f : 0.0f;
#pragma unroll
            for (int j = 0; j < 8; ++j) acc[j] += unpk4_fp8(q1[j]) + unpk4_fp8(q2[j]) * f2;
        }
        const float* g2 = modl + (size_t)cr * NMOD + 5 * DM;
        f32x4 v[8];
#pragma unroll
        for (int j = 0; j < 8; ++j) { const f32x4 g = *(const f32x4*)(g2 + 4 * lane + 256 * j); const f32x4 h = (f32x4){bf_lo(hp[j].x), bf_hi(hp[j].x), bf_lo(hp[j].y), bf_hi(hp[j].y)}; v[j] = h + g * (acc[j] * Y8_INV); }
        if (LAST) {
#pragma unroll
            for (int j = 0; j < 8; ++j) *(f32x4*)(out + (size_t)row * DM + 4 * lane + 256 * j) = v[j];
        } else {
            row_store_bf16(H + (size_t)row * DM, v, lane);
            f32x4 y[8]; row_modulate(v, y, gain1, mod1 + (size_t)cr * NMOD + 0 * DM, mod1 + (size_t)cr * NMOD + 1 * DM, lane);
#pragma unroll
            for (int j = 0; j < 8; ++j) *(unsigned*)((unsigned char*)A + (size_t)row * DM + 4 * lane + 256 * j) = pk4_fp8(y[j][0], y[j][1], y[j][2], y[j][3]);
        }
        if (!more) break;
#pragma unroll
        for (int j = 0; j < 8; ++j) hp[j] = hn[j];
        myinv = ninv; row = nrow;
    }
#undef CMB_LOAD
}
constexpr int KP = 272;
constexpr int VP = 288;
constexpr int ATT_VOFF = 64 * KP;
constexpr int ATT_TILE = 64 * KP + 64 * VP;
constexpr int ATT_OST = 2 * ATT_TILE;
DI float xhalf_max(float v) { auto rr = __builtin_amdgcn_permlane32_swap(__float_as_uint(v), __float_as_uint(v), false, false); return fmaxf(__uint_as_float(rr[0]), __uint_as_float(rr[1])); }
DI float xhalf_sum(float v) { auto rr = __builtin_amdgcn_permlane32_swap(__float_as_uint(v), __float_as_uint(v), false, false); return __uint_as_float(rr[0]) + __uint_as_float(rr[1]); }
DI int crow(int reg, int h) { return (reg & 3) + 8 * (reg >> 2) + 4 * h; }
DI long long vtr64(const LAS unsigned char* p) { typedef short v4i16_t __attribute__((ext_vector_type(4))); return __builtin_bit_cast(long long, __builtin_amdgcn_ds_read_tr16_b64_v4i16((LAS v4i16_t*)p)); }
DI s16x4 vtr(const LAS unsigned char* p) { typedef short v4i16_t __attribute__((ext_vector_type(4))); return __builtin_bit_cast(s16x4, __builtin_amdgcn_ds_read_tr16_b64_v4i16((LAS v4i16_t*)p)); }
DI bool att_tile_info(int item, int ti, int& base, int& mtype) {
    const int qhalf = item & 1, n = (item >> 3) & 15, b = item >> 7, tt = ti & 1; mtype = 0;
    if (ti < 4) { base = ML + b * CTXL + 64 * ti; return true; }
    const int blk = n - 1 + ((ti - 4) >> 1); if (blk < 0 || blk > 15) return false;
    if (ti < 6) { mtype = 1; if (tt == 0 && qhalf == 1) return false; } else if (ti >= 8) { mtype = 2; if (tt == 1 && qhalf == 0) return false; }
    base = b * SEQ + blk * 128 + 64 * tt; return true;
}
DI void att_next(int& item, int& ti, int G) { for (;;) { ++ti; if (ti >= 10) { ti = 0; item += G; return; } int b_, m_; if (att_tile_info(item, ti, b_, m_)) return; } }
DI void ph_attn(const bf16_t* Q, const bf16_t* Kb, const bf16_t* Vb, bf16_t* O, const float* sink, LAS unsigned char* lds, int tid, int lane, int wave, int bid, int G) {
    constexpr float LOG2E = 1.4426950408889634f;
    const int r = lane & 31, h = lane >> 5, g = wave >> 1, sub = wave & 1;
    const int ldrow = tid >> 3, ldc = tid & 7;
    int item = bid, ti = 0; if (item >= 1024) return;
    u32x4 kr[2], vr[2];
#define ATT_ISSUE(it_, ti_) do { int base_, mt_; att_tile_info(it_, ti_, base_, mt_); const int kvh_ = ((it_) >> 1) & 3; \
        _Pragma("unroll") for (int c2 = 0; c2 < 2; ++c2) { const size_t off_ = (size_t)(base_ + ldrow) * 512 + kvh_ * HD + (ldc + 8 * c2) * 8; kr[c2] = *(const u32x4*)(Kb + off_); vr[c2] = *(const u32x4*)(Vb + off_); } } while (0)
    bf16x8 qf[8]; float m2 = 0.f, lsum = 1.f; f32x16 o[4]; f32x16 negm;
#define ATT_QLOAD(it_) do { const int qrow_ = ((it_) >> 7) * SEQ + (((it_) >> 3) & 15) * 128 + ((it_) & 1) * 64 + sub * 32 + r; const int head_ = (((it_) >> 1) & 3) * 4 + g; \
        _Pragma("unroll") for (int s = 0; s < 8; ++s) qf[s] = *(const bf16x8*)(Q + (size_t)qrow_ * DM + head_ * HD + 16 * s + 8 * h); } while (0)
    ATT_QLOAD(item);
    ATT_ISSUE(item, ti);
    int buf = 0;
    while (item < 1024) {
        int nitem = item, nti = ti; att_next(nitem, nti, G);
        LAS unsigned char* tb = lds + buf * ATT_TILE;
#pragma unroll
        for (int c2 = 0; c2 < 2; ++c2) { *(LAS u32x4*)(tb + ldrow * KP + (ldc + 8 * c2) * 16) = kr[c2]; *(LAS u32x4*)(tb + ATT_VOFF + ldrow * VP + (ldc + 8 * c2) * 16) = vr[c2]; }
        if (nitem < 1024) ATT_ISSUE(nitem, nti);
        asm volatile("s_waitcnt lgkmcnt(0)" ::: "memory"); __builtin_amdgcn_s_barrier(); asm volatile("" ::: "memory");
        int base, mtype; att_tile_info(item, ti, base, mtype); const int tt = ti & 1;
        const int qhalf = item & 1, kvh = (item >> 1) & 3, n = (item >> 3) & 15, b = item >> 7;
        const int head = kvh * 4 + g, qq = qhalf * 64 + sub * 32 + r; const int qrow = b * SEQ + n * 128 + qq;
        if (ti == 0) {
            m2 = sink[head] * LOG2E; lsum = 1.0f;
#pragma unroll
            for (int i = 0; i < 16; ++i) negm[i] = -m2;
#pragma unroll
            for (int d = 0; d < 4; ++d)
#pragma unroll
                for (int i = 0; i < 16; ++i) o[d][i] = 0.f;
        }
        f32x16 x0, x1;
#pragma unroll
        for (int s = 0; s < 8; ++s) {
            const bf16x8 k0 = *(const LAS bf16x8*)(tb + r * KP + (16 * s + 8 * h) * 2), k1 = *(const LAS bf16x8*)(tb + (32 + r) * KP + (16 * s + 8 * h) * 2);
            if (s == 0) { x0 = __builtin_amdgcn_mfma_f32_32x32x16_bf16(k0, qf[s], negm, 0, 0, 0); x1 = __builtin_amdgcn_mfma_f32_32x32x16_bf16(k1, qf[s], negm, 0, 0, 0); }
            else { x0 = __builtin_amdgcn_mfma_f32_32x32x16_bf16(k0, qf[s], x0, 0, 0, 0); x1 = __builtin_amdgcn_mfma_f32_32x32x16_bf16(k1, qf[s], x1, 0, 0, 0); } }
        if (nitem != item && nitem < 1024) ATT_QLOAD(nitem);
        if (mtype == 1) {
#pragma unroll
            for (int i = 0; i < 16; ++i) { const int kk0 = tt * 64 + crow(i, h); if (kk0 < qq) x0[i] = -1.0e30f; if (kk0 + 32 < qq) x1[i] = -1.0e30f; } }
        if (mtype == 2) {
#pragma unroll
            for (int i = 0; i < 16; ++i) { const int kk0 = tt * 64 + crow(i, h); if (kk0 > qq) x0[i] = -1.0e30f; if (kk0 + 32 > qq) x1[i] = -1.0e30f; } }
        float tmax = fmaxf(x0[0], x1[0]);
#pragma unroll
        for (int i = 1; i < 16; ++i) tmax = fmaxf(fmaxf(tmax, x0[i]), x1[i]);
        tmax = xhalf_max(tmax);
        if (__any(tmax > 0.0f)) {
            const float dl = fmaxf(tmax, 0.0f), alpha = __builtin_amdgcn_exp2f(-dl); m2 += dl; lsum *= alpha;
#pragma unroll
            for (int i = 0; i < 16; ++i) { x0[i] -= dl; x1[i] -= dl; negm[i] = -m2; }
#pragma unroll
            for (int d = 0; d < 4; ++d)
#pragma unroll
                for (int i = 0; i < 16; ++i) o[d][i] *= alpha;
        }
        float ps = 0.f;
#pragma unroll
        for (int i = 0; i < 16; ++i) { x0[i] = __builtin_amdgcn_exp2f(x0[i]); x1[i] = __builtin_amdgcn_exp2f(x1[i]); ps += x0[i] + x1[i]; }
        lsum += xhalf_sum(ps);
        bf16x8 pf[2][2];
#pragma unroll
        for (int s = 0; s < 2; ++s) {
            u32x4 a, c; a.x = pk2(x0[8 * s + 0], x0[8 * s + 1]); a.y = pk2(x0[8 * s + 2], x0[8 * s + 3]); a.z = pk2(x0[8 * s + 4], x0[8 * s + 5]); a.w = pk2(x0[8 * s + 6], x0[8 * s + 7]);
            c.x = pk2(x1[8 * s + 0], x1[8 * s + 1]); c.y = pk2(x1[8 * s + 2], x1[8 * s + 3]); c.z = pk2(x1[8 * s + 4], x1[8 * s + 5]); c.w = pk2(x1[8 * s + 6], x1[8 * s + 7]);
            pf[0][s] = __builtin_bit_cast(bf16x8, a); pf[1][s] = __builtin_bit_cast(bf16x8, c); }
        const LAS unsigned char* vb = tb + ATT_VOFF + (4 * h + ((lane & 15) >> 2)) * VP + (16 * ((lane >> 4) & 1) + 4 * (lane & 3)) * 2;
#pragma unroll
        for (int d = 0; d < 4; ++d)
#pragma unroll
            for (int t = 0; t < 2; ++t)
#pragma unroll
                for (int s = 0; s < 2; ++s) {
                    typedef long long i64x2_t __attribute__((ext_vector_type(2)));
                    i64x2_t vv; vv.x = vtr64(vb + (t * 32 + 16 * s) * VP + d * 64); vv.y = vtr64(vb + (t * 32 + 16 * s + 8) * VP + d * 64);
                    const bf16x8 vf = __builtin_bit_cast(bf16x8, vv);
                    o[d] = __builtin_amdgcn_mfma_f32_32x32x16_bf16(vf, pf[t][s], o[d], 0, 0, 0); }
        if (nitem != item) {
            const float il = 1.0f / lsum;
            LAS unsigned char* st = lds + ATT_OST + wave * (32 * KP);
#pragma unroll
            for (int d = 0; d < 4; ++d)
#pragma unroll
                for (int g4 = 0; g4 < 4; ++g4) *(LAS unsigned*)(st + r * 144 + d * 32 + 8 * g4 + 4 * h) = pk4_fp8(o[d][4 * g4 + 0] * il, o[d][4 * g4 + 1] * il, o[d][4 * g4 + 2] * il, o[d][4 * g4 + 3] * il);
            asm volatile("s_waitcnt lgkmcnt(0)" ::: "memory");
            unsigned char* ob = (unsigned char*)O + (size_t)(qrow - r) * DM + head * HD;
#pragma unroll
            for (int j = 0; j < 4; ++j) { const int c = lane + 64 * j, row = c >> 3, c16 = c & 7;
                const u32x4 v = *(const LAS u32x4*)(st + row * 144 + c16 * 16); *(u32x4*)(ob + (size_t)row * DM + c16 * 16) = v; }
        }
        item = nitem; ti = nti; buf ^= 1;
    }
#undef ATT_ISSUE
#undef ATT_QLOAD
}
#ifndef MK_ONE_LAUNCH
#define MK_ONE_LAUNCH 1
#endif
constexpr int NPHASE = 19;
constexpr int CVT_X0_END = CVT_E0 + CVT_L;
#define CVT_MKCP() CvtPtrs CP; CP.cin = args.in[8]; CP.cout = args.in[10]; CP.wqkv = args.in[11]; CP.wo = args.in[15]; CP.wg = args.in[17]; CP.wu = args.in[18]; CP.wd = args.in[19]; \
    CP.W1A = W1A; CP.W1B = W1B; CP.W2 = W2; CP.WQKV = WQKV; CP.WO = WOt; CP.WGU = WGU; CP.WDN = WDN
#define CVT(LO, HI) do { CVT_MKCP(); cvt_range(CP, LO, HI, gw, NGW, cscr, lane); } while (0)
#ifndef MK_DUP_MASK
#define MK_DUP_MASK 0u
#endif
constexpr unsigned DUP_MASK = MK_DUP_MASK;
struct Args { const float* in[20]; float* out; unsigned char* ws; int ph_lo, ph_hi; };
__global__ void __launch_bounds__(512, 2) dit_fwd(Args args) {
    extern __shared__ __attribute__((aligned(16))) unsigned char lds_raw[];
    LAS unsigned char* lds = (LAS unsigned char*)lds_raw;
    const int tid = threadIdx.x, lane = tid & 63, wave = __builtin_amdgcn_readfirstlane(tid >> 6);
    const int G = gridDim.x, bid = blockIdx.x;
    const int gw = bid * 8 + wave, NGW = G * 8;
    unsigned char* ws = args.ws;
    const float* x = args.in[0]; const float* cnd = args.in[1]; const float* ctx = args.in[2]; const float* cctx = args.in[3];
    const float* ada_w = args.in[4]; const float* ada_b = args.in[5]; const float* nmix = args.in[6]; const float* nffn = args.in[7];
    const float* conv_w = args.in[9]; const float* qgain = args.in[12]; const float* kgain = args.in[13]; const float* sink = args.in[14]; const float* router_w = args.in[16];
    float* mod = (float*)(ws + WS_MOD); float* modp = (float*)(ws + WS_MODP);
    float* affL = (float*)(ws + WS_AFFL); float* affC = (float*)(ws + WS_AFFC);
    float* rwt = (float*)(ws + WS_RWT);
    int* idmap = (int*)(ws + WS_IDMAP);
    int* rowsrc = (int*)(ws + WS_ROWSRC); float* gatev = (float*)(ws + WS_GATEV); int* inv = (int*)(ws + WS_INV);
    bf16_t* W1A = (bf16_t*)(ws + WS_W1A); bf16_t* W1B = (bf16_t*)(ws + WS_W1B); bf16_t* W2 = (bf16_t*)(ws + WS_W2); bf16_t* WQKV = (bf16_t*)(ws + WS_WQKV); bf16_t* WOt = (bf16_t*)(ws + WS_WO);
    bf16_t* WGU = (bf16_t*)(ws + WS_WGU); bf16_t* WDN = (bf16_t*)(ws + WS_WDN);
    bf16_t* H = (bf16_t*)(ws + WS_H); bf16_t* A = (bf16_t*)(ws + WS_A); bf16_t* U = (bf16_t*)(ws + WS_U); bf16_t* Z = (bf16_t*)(ws + WS_Z);
    bf16_t* Qb = (bf16_t*)(ws + WS_Q); bf16_t* Kb = (bf16_t*)(ws + WS_K); bf16_t* Vb = (bf16_t*)(ws + WS_V); bf16_t* Ob = (bf16_t*)(ws + WS_O);
    bf16_t* HM = (bf16_t*)(ws + WS_HM); bf16_t* Y = (bf16_t*)(ws + WS_Y);
    LAS unsigned* cscr = (LAS unsigned*)(lds + wave * 9216);

    for (int u = tid; u < (LDS_BYTES - MISC_OFF) / 4; u += 512) ((LAS unsigned*)(lds + MISC_OFF))[u] = 0u;
    __syncthreads();
#if MK_ONE_LAUNCH
    XcdBarrier bar = xcd_barrier_post((unsigned*)(ws + WS_CTL) + CW_BAR, (volatile LAS unsigned*)(lds + MISC_OFF) + 8);
#define GRID_BAR() xcd_barrier(bar)
#else
#define GRID_BAR() do {} while (0)
#endif
    const int lo = args.ph_lo, hi = args.ph_hi;
#define IN(k) (lo <= (k) && (k) < hi)
#define SEAM(k) do { if (IN(k) && IN((k) + 1)) GRID_BAR(); } while (0)
#define PHASE(k) if (IN(k)) _Pragma("unroll") for (int rep_ = 0; rep_ < 1 + (int)((DUP_MASK >> (k)) & 1u); ++rep_)
#define REP_BAR() do { if (rep_) GRID_BAR(); } while (0)

    PHASE(0) { REP_BAR(); ph_adaln(cnd, cctx, ada_w, modp, gw, NGW, lane); } SEAM(0);
    PHASE(1) { REP_BAR(); ph_modred(modp, ada_b, mod, bid * 512 + tid, G * 512); ph_rwt(router_w, rwt, bid * 512 + tid, G * 512); for (int i = bid * 512 + tid; i < YT; i += G * 512) idmap[i] = i; } SEAM(1);
    PHASE(2) { REP_BAR(); ph_mod0(x, ctx, nmix, mod, A, gw, NGW, lane); CVT(0, 4096); } SEAM(2);
    PHASE(3) { REP_BAR();
        pg8::Gemm g{A, W1A, MT, 4096, DM}; pg8::StaticOrder S; S.init(MT, 4096, G, bid);
        EpiPair<0> E{U, DM, 16};
        pg8::gemm_phase<EpiPair<0>, pg8::StaticOrder, true, true>(lds, g, S, E);
    } SEAM(3);
    PHASE(4) { REP_BAR();
        pg8::Gemm g{A, W1B, MT, DM, DM}; pg8::StaticOrder S; S.init(MT, DM, G, bid);
        EpiConvGate E{U, Z, conv_w};
        pg8::gemm_phase<EpiConvGate, pg8::StaticOrder, true, true>(lds, g, S, E);
    } SEAM(4);
    PHASE(5) { REP_BAR();
        pg8::Gemm g{Z, W2, MT, DM, DM}; pg8::StaticOrder S; S.init(MT, DM, G, bid);
        EpiResid<true> E{x, ctx, H, mod + 2 * DM, 1.0f};
        pg8::gemm_phase<EpiResid<true>, pg8::StaticOrder, true, true>(lds, g, S, E);
    } SEAM(5);
    PHASE(6) { REP_BAR(); load_router(rwt, (LAS float*)lds, tid); ph_modffn(H, nffn, mod, A, (const LAS float*)lds, affL, affC, MT, gw, NGW, lane); } SEAM(6);
    PHASE(7) { REP_BAR(); ph_topk(256, affL, affC, rowsrc, gatev, inv, (LAS unsigned*)lds, tid, lane, wave, bid, G); CVT(CVT_E0, CVT_E0 + 16384); } SEAM(7);
    PHASE(8) { REP_BAR();
        pg8::Gemm g{A, WGU, YT, NE * 2048, DM / 2, rowsrc}; MoeOrder S{G, bid, 9};
        EpiPairF8 E{(unsigned char*)HM, DFF, 8};
        pg8::gemm_phase<EpiPairF8, MoeOrder, true, true, true, true>(lds, g, S, E);
        CVT(CVT_E0 + 16384, CVT_X0_END);
    } SEAM(8);
    PHASE(9) { REP_BAR();
        pg8::Gemm g{HM, WDN, YT, NE * 2048, DFF / 2, idmap}; MoeOrder S{G, bid, 9};
        EpiDown E{Y, gatev, W8_INV * Y8_SCALE};
        pg8::gemm_phase<EpiDown, MoeOrder, true, true, true, true>(lds, g, S, E);
    } SEAM(9);
    PHASE(10) { REP_BAR(); ph_combine<false>(H, Y, inv, mod, nmix + DM, mod + 9 * NMOD, A, nullptr, MT, gw, NGW, lane); CVT(4096, 4096 + 1536); } SEAM(10);
    PHASE(11) { REP_BAR();
        pg8::Gemm g{A, WQKV, MT, 3072, DM / 2, idmap}; QkvOrder S{G, bid};
        EpiQkvNorm E{Qb, Kb, Vb, qgain, kgain, (LAS float*)(lds + RING_BYTES), W8_INV};
        pg8::gemm_phase<EpiQkvNorm, QkvOrder, true, true, true, true>(lds, g, S, E);
    } SEAM(11);
    PHASE(12) { REP_BAR(); ph_attn(Qb, Kb, Vb, Ob, sink, lds, tid, lane, wave, bid, G); __syncthreads(); CVT(4096 + 1536, CVT_E0); } SEAM(12);
    PHASE(13) { REP_BAR();
        pg8::Gemm g{Ob, WOt, ML, DM, DM / 2, idmap}; pg8::StaticOrder S; S.init(ML, DM, G, bid);
        EpiResid<false> E{nullptr, nullptr, H, mod + 9 * NMOD + 2 * DM, W8_INV};
        pg8::gemm_phase<EpiResid<false>, pg8::StaticOrder, true, true, true, true>(lds, g, S, E);
    } SEAM(13);
    PHASE(14) { REP_BAR(); load_router(rwt + DM * 16, (LAS float*)lds, tid); ph_modffn(H, nffn + DM, mod + 9 * NMOD, A, (const LAS float*)lds, affL, affC, ML, gw, NGW, lane); } SEAM(14);
    PHASE(15) { REP_BAR(); ph_topk(128, affL, affC, rowsrc, gatev, inv, (LAS unsigned*)lds, tid, lane, wave, bid, G); CVT(CVT_X0_END, CVT_X0_END + 16384); } SEAM(15);
    PHASE(16) { REP_BAR();
        pg8::Gemm g{A, (const bf16_t*)((const unsigned char*)WGU + (size_t)NE * 2048 * DM), YT, NE * 2048, DM / 2, rowsrc}; MoeOrder S{G, bid, 8};
        EpiPairF8 E{(unsigned char*)HM, DFF, 8};
        pg8::gemm_phase<EpiPairF8, MoeOrder, true, true, true, true>(lds, g, S, E);
        CVT(CVT_X0_END + 16384, CVT_TOTAL);
    } SEAM(16);
    PHASE(17) { REP_BAR();
        pg8::Gemm g{HM, (const bf16_t*)((const unsigned char*)WDN + (size_t)NE * 2048 * DFF), YT, NE * 2048, DFF / 2, idmap}; MoeOrder S{G, bid, 8};
        EpiDown E{Y, gatev, W8_INV * Y8_SCALE};
        pg8::gemm_phase<EpiDown, MoeOrder, true, true, true, true>(lds, g, S, E);
    } SEAM(17);
    PHASE(18) { REP_BAR(); ph_combine<true>(H, Y, inv, mod + 9 * NMOD, nullptr, nullptr, nullptr, args.out, ML, gw, NGW, lane); }
#undef IN
#undef SEAM
#undef PHASE
#undef REP_BAR
}

extern "C" void kernel_launch(void* const* d_in, const int* in_sizes, int n_in, void* d_out, int out_size, void* d_ws, size_t ws_size, hipStream_t stream) {
    static int grid = 0;
    if (grid == 0) {
        if (n_in != 20 || out_size != ML * DM || ws_size < WS_END) { fprintf(stderr, "kernel_launch: unexpected problem (n_in %d, out %d, ws %zu); nothing launched\n", n_in, out_size, ws_size); grid = -1; return; }
        int dev = 0, cus = 0, per_cu = 0;
        if (hipGetDevice(&dev) != hipSuccess || hipDeviceGetAttribute(&cus, hipDeviceAttributeMultiprocessorCount, dev) != hipSuccess) { grid = -1; return; }
        if (hipFuncSetAttribute((const void*)dit_fwd, hipFuncAttributeMaxDynamicSharedMemorySize, LDS_BYTES) != hipSuccess) { fprintf(stderr, "kernel_launch: hipFuncSetAttribute failed\n"); grid = -1; return; }
        if (hipOccupancyMaxActiveBlocksPerMultiprocessor(&per_cu, (const void*)dit_fwd, 512, LDS_BYTES) != hipSuccess || per_cu < 1) fprintf(stderr, "kernel_launch: occupancy query reports %d workgroups per CU\n", per_cu);
        (void)hipGetLastError();
        grid = cus;
    }
    if (grid < 0) return;
    (void)hipMemsetAsync((char*)d_ws + WS_CTL, 0, CTL_ZERO_BYTES, stream);
    Args a{};
    for (int i = 0; i < 20; ++i) a.in[i] = (const float*)d_in[i];
    a.out = (float*)d_out; a.ws = (unsigned char*)d_ws;
#if MK_ONE_LAUNCH
    a.ph_lo = 0; a.ph_hi = NPHASE;
    hipLaunchKernelGGL(dit_fwd, dim3(grid), dim3(512), LDS_BYTES, stream, a);
#else
    for (int p = 0; p < NPHASE; ++p) { a.ph_lo = p; a.ph_hi = p + 1; hipLaunchKernelGGL(dit_fwd, dim3(grid), dim3(512), LDS_BYTES, stream, a); }
#endif
}
```

```cpp
#include <hip/hip_runtime.h>
#include <cstdio>
#include <cstdint>
namespace pg8 {
#define PG8_LAS __attribute__((address_space(3)))
typedef unsigned short bf16_t;
typedef short bf16x8 __attribute__((ext_vector_type(8)));
typedef float f32x4 __attribute__((ext_vector_type(4)));
typedef unsigned u32x4 __attribute__((ext_vector_type(4)));
constexpr int BM = 256, BK = 64, HALF = 128, HTB = HALF * BK * 2  , STAGE_BYTES = 8 * HTB, NXCD = 8, WGM = 8;

__host__ __device__ __forceinline__ int lds_byte(int r, int c) { const int st = (r >> 4) * 2 + (c >> 5), rr = r & 15, cc = c & 31, ob = rr * 64 + cc * 2; return st * 1024 + (ob ^ (((ob >> 9) & 1) << 5)); }
__host__ __device__ __forceinline__ void stage_rc(int b, int& R, int& C) { const int st = b / 1024, sb = b % 1024, swz = sb ^ (((sb >> 9) & 1) << 5); R = (st >> 1) * 16 + swz / 64; C = (st & 1) * 32 + (swz % 64) / 2; }
__host__ __device__ __forceinline__ int perm32(int rho) { const int n = rho >> 4, i = rho & 15; return 8 * (i >> 2) + 4 * n + (i & 3); }

struct Unit { int pm, pn; };
struct Gemm { const bf16_t* A; const bf16_t* Bt; int M, N, K; const int* rows = nullptr; };

struct StaticOrder {
    int nM, nN, nwg, G, c;
    __host__ __device__ void init(int M, int N, int G_, int c_) { nM = M / BM; nN = N / BM; nwg = nM * nN; G = G_; c = c_; }
    __host__ __device__ bool next(int i, Unit& u) const {
        const long L = (long)i * G + c; if (L >= nwg) return false;
        int wgid = (int)L; { const int q = nwg / NXCD, r = nwg % NXCD, xcd = wgid % NXCD, off = wgid / NXCD; wgid = (xcd < r ? xcd * (q + 1) : r * (q + 1) + (xcd - r) * q) + off; }
        const int nig = WGM * nN, gid = wgid / nig, fm = gid * WGM, gsz = (nM - fm) < WGM ? (nM - fm) : WGM;
        u.pm = fm + ((wgid % nig) % gsz); u.pn = (wgid % nig) / gsz; return true;
    }
    __device__ __forceinline__ void a_ready(const Unit&) const {}
    __device__ __forceinline__ void done(const Unit&) const {}
};
__device__ __forceinline__ unsigned cvt_pk_bf16(float lo, float hi) { unsigned r; asm volatile("v_cvt_pk_bf16_f32 %0, %1, %2" : "=v"(r) : "v"(lo), "v"(hi)); return r; }
typedef float f32x2 __attribute__((ext_vector_type(2)));
template <class Epi, class Sched, bool ALIGN_EPI = false, bool SP2 = false, bool GATHER = false, bool F8 = false>
__device__ __forceinline__ void gemm_phase(PG8_LAS unsigned char* lds, const Gemm g, const Sched& S, const Epi& E) {
    typedef int i32x4_t __attribute__((ext_vector_type(4)));
    const int tid = threadIdx.x, wid = __builtin_amdgcn_readfirstlane(tid >> 6), lane = tid & 63, wr = wid >> 2, wc = wid & 3, fr = lane & 15, fq = lane >> 4;
    const int K = g.K, nt = K / BK;
    unsigned voffA[2], voffB[2];
#pragma unroll
    for (int i = 0; i < 2; ++i) { int R, C; stage_rc(tid * 16 + i * 8192, R, C); const int Rb = Epi::PERM ? ((R & ~31) + perm32(R & 31)) : R;
        voffA[i] = (unsigned)(R * K + C) * 2u; voffB[i] = (unsigned)(Rb * K + C) * 2u; }
    const size_t kstep = (size_t)(BK * 2);
    const size_t hstep = (size_t)HALF * K * 2;
    const size_t tstep = 2 * hstep;
    const unsigned ldsw = (unsigned)wid * 1024u;
    const int aoff = lds_byte(wr * 64 + fr, fq * 8), boff = lds_byte(wc * 32 + fr, fq * 8);
#define PG8_SA(b, h) (((b) * 2 + (h)) * HTB)
#define PG8_SB(b, h) ((4 + (b) * 2 + (h)) * HTB)
#define PG8_UNI(p) ((const char*)(((unsigned long long)(unsigned)__builtin_amdgcn_readfirstlane((int)((unsigned long long)(p) >> 32)) << 32) | (unsigned long long)(unsigned)__builtin_amdgcn_readfirstlane((int)(unsigned long long)(p))))
#define PG8_STAGE(bufoff, gbase, voff) do { const char* gb_ = PG8_UNI(gbase);     \
        _Pragma("unroll") for (int _i = 0; _i < 2; ++_i) \
        __builtin_amdgcn_global_load_lds((const unsigned*)(gb_ + (voff)[_i]), (PG8_LAS unsigned*)(lds + (bufoff) + ldsw + _i * 8192), 16, 0, 0); } while (0)
#define PG8_STAGE_A(bufoff, kptr, h) do { if constexpr (GATHER) { PG8_STAGE(bufoff, kptr, vA[h]); } else { PG8_STAGE(bufoff, (kptr) + (h) * hstep, voffA); } } while (0)
#define PG8_GATHER_SWITCH() do { if constexpr (GATHER) { if (last && has_next) { asm volatile("" : "+v"(nv[0]), "+v"(nv[1]), "+v"(nv[2]), "+v"(nv[3])); \
        vA[0][0] = nv[0] * (unsigned)(K * 2) + gcoff[0]; vA[0][1] = nv[1] * (unsigned)(K * 2) + gcoff[1]; vA[1][0] = nv[2] * (unsigned)(K * 2) + gcoff[0]; vA[1][1] = nv[3] * (unsigned)(K * 2) + gcoff[1]; } } } while (0)
#define PG8_LDA(dst, b, h) do { _Pragma("unroll") for (int m = 0; m < 4; ++m) { if constexpr (F8) { dst##8[m] = PG8_CAT8(*(const PG8_LAS i32x4_t*)(lds + PG8_SA(b, h) + aoff + m * 2048), *(const PG8_LAS i32x4_t*)(lds + PG8_SA(b, h) + aoff + m * 2048 + 1024)); } \
        else { _Pragma("unroll") for (int k = 0; k < 2; ++k) dst[m][k] = *(const PG8_LAS bf16x8*)(lds + PG8_SA(b, h) + aoff + m * 2048 + k * 1024); } } } while (0)
#define PG8_LDB(dst, b, h) do { _Pragma("unroll") for (int n = 0; n < 2; ++n) { if constexpr (F8) { dst##8[n] = PG8_CAT8(*(const PG8_LAS i32x4_t*)(lds + PG8_SB(b, h) + boff + n * 2048), *(const PG8_LAS i32x4_t*)(lds + PG8_SB(b, h) + boff + n * 2048 + 1024)); } \
        else { _Pragma("unroll") for (int k = 0; k < 2; ++k) dst[n][k] = *(const PG8_LAS bf16x8*)(lds + PG8_SB(b, h) + boff + n * 2048 + k * 1024); } } } while (0)
#define PG8_CAT8(lo_, hi_) __builtin_shufflevector(lo_, hi_, 0, 1, 2, 3, 4, 5, 6, 7)
#define PG8_MMA(ai, bj, At, Bt) do { __builtin_amdgcn_s_setprio(1); _Pragma("unroll") for (int m = 0; m < 4; ++m) _Pragma("unroll") for (int n = 0; n < 2; ++n) { \
        if constexpr (F8) { acc[ai][bj][m][n] = __builtin_amdgcn_mfma_scale_f32_16x16x128_f8f6f4(Bt##8[n], At##8[m], acc[ai][bj][m][n], 0, 0, 0, 0x7f7f7f7f, 0, 0x7f7f7f7f); } \
        else { _Pragma("unroll") for (int k = 0; k < 2; ++k) acc[ai][bj][m][n] = __builtin_amdgcn_mfma_f32_16x16x32_bf16(Bt[n][k], At[m][k], acc[ai][bj][m][n], 0, 0, 0); } } \
        __builtin_amdgcn_s_setprio(0); } while (0)
#define PG8_WAIT_V(n) asm volatile("s_waitcnt vmcnt(" #n ")" ::: "memory")
#define PG8_WAIT_L(n) asm volatile("s_waitcnt lgkmcnt(" #n ")" ::: "memory")
#define PG8_BAR __builtin_amdgcn_s_barrier()
#define PG8_SCHED __builtin_amdgcn_sched_barrier(0)
    Unit cur, nxt; int ui = 0;
    if (!S.next(0, cur)) return;
    f32x4 acc[2][2][4][2];
#pragma unroll
    for (int a = 0; a < 2; ++a)
#pragma unroll
        for (int b = 0; b < 2; ++b)
#pragma unroll
            for (int m = 0; m < 4; ++m)
#pragma unroll
                for (int n = 0; n < 2; ++n) acc[a][b][m][n] = (f32x4){0.f, 0.f, 0.f, 0.f};
    bf16x8 At[4][2], B0[2][2], B1[2][2]; typedef int i32x8_t __attribute__((ext_vector_type(8))); i32x8_t At8[4], B08[2], B18[2];
    const char* cA = (const char*)g.A + (GATHER ? (size_t)0 : (size_t)cur.pm * tstep); const char* cB = (const char*)g.Bt + (size_t)cur.pn * tstep;
    unsigned vA[2][2], nv[4], gcoff[2]; int grow[2];
    if constexpr (GATHER) {
#pragma unroll
        for (int i = 0; i < 2; ++i) { int R, C; stage_rc(tid * 16 + i * 8192, R, C); grow[i] = R; gcoff[i] = (unsigned)(C * 2); }
#pragma unroll
        for (int h = 0; h < 2; ++h)
#pragma unroll
            for (int i = 0; i < 2; ++i) vA[h][i] = (unsigned)g.rows[cur.pm * BM + h * HALF + grow[i]] * (unsigned)(K * 2) + gcoff[i];
    }
    S.a_ready(cur);
    if constexpr (SP2) {
        PG8_STAGE(PG8_SB(0, 0), cB, voffB); PG8_STAGE(PG8_SB(0, 1), cB + hstep, voffB); PG8_STAGE_A(PG8_SA(0, 0), cA, 0); PG8_STAGE_A(PG8_SA(0, 1), cA, 1);
        if (wr == 1) PG8_BAR;
        PG8_WAIT_V(2); PG8_BAR;
        PG8_STAGE(PG8_SB(1, 0), cB + kstep, voffB); PG8_STAGE_A(PG8_SA(1, 0), cA + kstep, 0); PG8_STAGE(PG8_SB(1, 1), cB + hstep + kstep, voffB);
        PG8_WAIT_V(6); PG8_BAR;
    } else {
        PG8_STAGE(PG8_SB(0, 0), cB, voffB); PG8_STAGE_A(PG8_SA(0, 0), cA, 0); PG8_STAGE(PG8_SB(0, 1), cB + hstep, voffB); PG8_STAGE_A(PG8_SA(0, 1), cA, 1);
        if (wr == 1) PG8_BAR;
        PG8_WAIT_V(4); PG8_BAR;
        PG8_STAGE(PG8_SB(1, 0), cB + kstep, voffB); PG8_STAGE_A(PG8_SA(1, 0), cA + kstep, 0); PG8_STAGE(PG8_SB(1, 1), cB + hstep + kstep, voffB);
        PG8_WAIT_V(6); PG8_BAR;
    }
    for (;;) {
        const bool has_next = S.next(ui + 1, nxt);
        const char* nA = (has_next && !GATHER) ? (const char*)g.A + (size_t)nxt.pm * tstep : cA; const char* nB = has_next ? (const char*)g.Bt + (size_t)nxt.pn * tstep : cB;
        if constexpr (GATHER) { if (has_next) { const int* rp = g.rows + nxt.pm * BM;
            asm volatile("global_load_dword %0, %1, off" : "=&v"(nv[0]) : "v"(rp + grow[0]) : "memory"); asm volatile("global_load_dword %0, %1, off" : "=&v"(nv[1]) : "v"(rp + grow[1]) : "memory");
            asm volatile("global_load_dword %0, %1, off" : "=&v"(nv[2]) : "v"(rp + HALF + grow[0]) : "memory"); asm volatile("global_load_dword %0, %1, off" : "=&v"(nv[3]) : "v"(rp + HALF + grow[1]) : "memory"); } }
#pragma unroll 1
        for (int t = 0; t < nt; t += 2) {
            const bool last = (t == nt - 2);
            const char* a1 = cA + (size_t)(t + 1) * kstep;
            const char* a2 = last ? nA : cA + (size_t)(t + 2) * kstep; const char* b2 = last ? nB : cB + (size_t)(t + 2) * kstep;
            const char* a3 = a2 + kstep; const char* b3 = b2 + kstep;
            if (last && has_next) S.a_ready(nxt);
            if constexpr (SP2) {
            PG8_LDB(B0, 0, 0); PG8_LDB(B1, 0, 1); PG8_SCHED; PG8_LDA(At, 0, 0); PG8_STAGE_A(PG8_SA(1, 1), a1, 1); PG8_GATHER_SWITCH();
            PG8_WAIT_V(8); PG8_WAIT_L(0); PG8_BAR; PG8_MMA(0, 0, At, B0); PG8_MMA(0, 1, At, B1); PG8_BAR; PG8_SCHED;
            PG8_LDA(At, 0, 1); PG8_STAGE(PG8_SB(0, 0), b2, voffB); PG8_STAGE(PG8_SB(0, 1), b2 + hstep, voffB); PG8_STAGE_A(PG8_SA(0, 0), a2, 0);
            PG8_WAIT_V(8); PG8_WAIT_L(0); PG8_BAR; PG8_MMA(1, 0, At, B0); PG8_MMA(1, 1, At, B1); PG8_BAR; PG8_SCHED;
            PG8_LDB(B0, 1, 0); PG8_LDB(B1, 1, 1); PG8_SCHED; PG8_LDA(At, 1, 0); PG8_STAGE_A(PG8_SA(0, 1), a2, 1);
            PG8_WAIT_V(8); PG8_WAIT_L(0); PG8_BAR; PG8_MMA(0, 0, At, B0); PG8_MMA(0, 1, At, B1); PG8_BAR; PG8_SCHED;
            PG8_LDA(At, 1, 1); PG8_STAGE(PG8_SB(1, 0), b3, voffB); PG8_STAGE(PG8_SB(1, 1), b3 + hstep, voffB); PG8_STAGE_A(PG8_SA(1, 0), a3, 0);
            PG8_WAIT_V(8); PG8_WAIT_L(0); PG8_BAR; PG8_MMA(1, 0, At, B0); PG8_MMA(1, 1, At, B1); PG8_BAR; PG8_SCHED;
            } else {
            PG8_LDB(B0, 0, 0); PG8_SCHED; PG8_LDA(At, 0, 0); PG8_STAGE_A(PG8_SA(1, 1), a1, 1); PG8_GATHER_SWITCH();
            PG8_WAIT_L(8); PG8_BAR; PG8_WAIT_L(0); PG8_MMA(0, 0, At, B0); PG8_BAR; PG8_SCHED;
            PG8_LDB(B1, 0, 1); PG8_STAGE(PG8_SB(0, 0), b2, voffB);
            PG8_BAR; PG8_WAIT_L(0); PG8_MMA(0, 1, At, B1); PG8_BAR;
            PG8_LDA(At, 0, 1); PG8_STAGE_A(PG8_SA(0, 0), a2, 0);
            PG8_BAR; PG8_WAIT_L(0); PG8_MMA(1, 0, At, B0); PG8_BAR; PG8_SCHED;
            PG8_STAGE(PG8_SB(0, 1), b2 + hstep, voffB);
            PG8_WAIT_V(6); PG8_BAR; PG8_MMA(1, 1, At, B1); PG8_BAR;
            PG8_LDB(B0, 1, 0); PG8_SCHED; PG8_LDA(At, 1, 0); PG8_STAGE_A(PG8_SA(0, 1), a2, 1);
            PG8_WAIT_L(8); PG8_BAR; PG8_WAIT_L(0); PG8_MMA(0, 0, At, B0); PG8_BAR; PG8_SCHED;
            PG8_LDB(B1, 1, 1); PG8_STAGE(PG8_SB(1, 0), b3, voffB);
            PG8_BAR; PG8_WAIT_L(0); PG8_MMA(0, 1, At, B1); PG8_BAR;
            PG8_LDA(At, 1, 1); PG8_STAGE_A(PG8_SA(1, 0), a3, 0);
            PG8_BAR; PG8_WAIT_L(0); PG8_MMA(1, 0, At, B0); PG8_BAR; PG8_SCHED;
            PG8_STAGE(PG8_SB(1, 1), b3 + hstep, voffB);
            PG8_WAIT_V(6); PG8_BAR; PG8_MMA(1, 1, At, B1); PG8_BAR;
            }
        }
        if constexpr (ALIGN_EPI) { if (wr == 0) PG8_BAR; }
        if constexpr (!Epi::AFTER_DRAIN) { E(acc, cur, wr, wc, fr, fq); S.done(cur); }
        if (!has_next) break;
#pragma unroll
        for (int a = 0; a < 2; ++a)
#pragma unroll
            for (int b = 0; b < 2; ++b)
#pragma unroll
                for (int m = 0; m < 4; ++m)
#pragma unroll
                    for (int n = 0; n < 2; ++n) acc[a][b][m][n] = (f32x4){0.f, 0.f, 0.f, 0.f};
        cur = nxt; cA = nA; cB = nB; ++ui;
        if constexpr (ALIGN_EPI) { if (wr == 1) PG8_BAR; }
    }
    PG8_WAIT_V(0);
    if constexpr (!ALIGN_EPI) { if (wr == 0) PG8_BAR; }
    PG8_BAR;
    if constexpr (Epi::AFTER_DRAIN) { E.fused(acc, cur, wr, wc, fr, fq, lds, wid, lane); S.done(cur); }
#undef PG8_SA
#undef PG8_SB
#undef PG8_STAGE
#undef PG8_UNI
#undef PG8_STAGE_A
#undef PG8_GATHER_SWITCH
#undef PG8_LDA
#undef PG8_LDB
#undef PG8_MMA
#undef PG8_CAT8
#undef PG8_WAIT_V
#undef PG8_WAIT_L
#undef PG8_BAR
#undef PG8_SCHED
}
}

constexpr int DM = 2048, NB = 8, SEQ = 2048, CTXL = 256, NH = 16, NKV = 4, HD = 128;
constexpr int ML = NB * SEQ;
constexpr int MC = NB * CTXL;
constexpr int MT = ML + MC;
constexpr int NE = 16, CAPL = 256, CAPC = 32, DFF = 1024;
constexpr int YR = NB * CAPL + NB * CAPC;
constexpr int YT = NE * YR;
constexpr int NMOD = 6 * DM;
constexpr float NORM_EPS = 1e-6f;
constexpr int KSPLIT = 16;

using pg8::Unit; using pg8::f32x4; using pg8::u32x4; using pg8::bf16_t; using pg8::bf16x8; using pg8::cvt_pk_bf16;
typedef float f32x2 __attribute__((ext_vector_type(2)));
typedef unsigned u32x2 __attribute__((ext_vector_type(2)));
typedef float f32x16 __attribute__((ext_vector_type(16)));
typedef short s16x4 __attribute__((ext_vector_type(4)));
#define DI __device__ __forceinline__

DI float bf_lo(unsigned w) { return __uint_as_float(w << 16); }
DI float bf_hi(unsigned w) { return __uint_as_float(w & 0xffff0000u); }
DI unsigned pk4_fp8(float a, float b, float c, float d) {
    a = __builtin_amdgcn_fmed3f(a, -448.0f, 448.0f); b = __builtin_amdgcn_fmed3f(b, -448.0f, 448.0f); c = __builtin_amdgcn_fmed3f(c, -448.0f, 448.0f); d = __builtin_amdgcn_fmed3f(d, -448.0f, 448.0f);
    int w = __builtin_amdgcn_cvt_pk_fp8_f32(a, b, 0, false); w = __builtin_amdgcn_cvt_pk_fp8_f32(c, d, w, true); return (unsigned)w;
}
constexpr float Y8_SCALE = 64.0f, Y8_INV = 1.0f / 64.0f;
constexpr float W8_SCALE = 32.0f, W8_INV = 1.0f / 32.0f;
DI f32x4 unpk4_fp8(unsigned w) { const f32x2 lo = __builtin_amdgcn_cvt_pk_f32_fp8((int)w, false), hi = __builtin_amdgcn_cvt_pk_f32_fp8((int)w, true); return (f32x4){lo.x, lo.y, hi.x, hi.y}; }
DI float silu_f(float a) { return a * __builtin_amdgcn_rcpf(1.0f + __expf(-a)); }

DI int xcd_remap(int wgid, int nwg) { const int q = nwg / 8, r = nwg % 8, xcd = wgid % 8, off = wgid / 8; return (xcd < r ? xcd * (q + 1) : r * (q + 1) + (xcd - r) * q) + off; }
struct QkvOrder {
    int G, c;
    DI bool next(int i, Unit& u) const {
        const int L = i * G + c; if (L >= 800) return false;
        if (L < 768) { const int w = xcd_remap(L, 768); const int nig = 8 * 12, gid = w / nig; u.pm = gid * 8 + ((w % nig) % 8); u.pn = (w % nig) / 8; }
        else { const int j = L - 768; u.pm = 64 + (j >> 2); u.pn = 8 + (j & 3); }
        return true;
    }
    DI void a_ready(const Unit&) const {}
    DI void done(const Unit&) const {}
};
struct MoeOrder {
    int G, c, NP;
    DI bool next(int i, Unit& u) const {
        const int nwg = NE * NP * 8; const int L = i * G + c; if (L >= nwg) return false;
        const int w = xcd_remap(L, nwg); const int per = NP * 8, e = w / per, rem = w % per;
        u.pm = e * 9 + (rem % NP); u.pn = e * 8 + (rem / NP); return true;
    }
    DI void a_ready(const Unit&) const {}
    DI void done(const Unit&) const {}
};

template <int ACT  > struct EpiPair {
    static constexpr bool PERM = true, AFTER_DRAIN = false;
    bf16_t* O; int ldc; int pn_mod;
    DI void operator()(const f32x4 (&acc)[2][2][4][2], const Unit& u, int wr, int wc, int fr, int fq) const {
        const int row0 = u.pm * 256 + wr * 64 + fr, col0 = (u.pn % pn_mod) * 128 + wc * 32 + 8 * fq;
#pragma unroll
        for (int ai = 0; ai < 2; ++ai)
#pragma unroll
            for (int m = 0; m < 4; ++m) {
                bf16_t* rowp = O + (size_t)(row0 + ai * 128 + m * 16) * ldc + col0;
                f32x4 a0 = acc[ai][0][m][0], a1 = acc[ai][0][m][1]; const f32x4 b0 = acc[ai][1][m][0], b1 = acc[ai][1][m][1];
                if (ACT == 1) {
#pragma unroll
                    for (int j = 0; j < 4; ++j) { a0[j] = silu_f(a0[j]); a1[j] = silu_f(a1[j]); } }
                const f32x4 v0 = a0 * b0, v1 = a1 * b1;
                u32x4 w; w.x = cvt_pk_bf16(v0[0], v0[1]); w.y = cvt_pk_bf16(v0[2], v0[3]); w.z = cvt_pk_bf16(v1[0], v1[1]); w.w = cvt_pk_bf16(v1[2], v1[3]);
                *(u32x4*)rowp = w;
            }
    }
};
struct EpiPairF8 {
    static constexpr bool PERM = true, AFTER_DRAIN = false;
    unsigned char* O; int ldc; int pn_mod;
    DI void operator()(const f32x4 (&acc)[2][2][4][2], const Unit& u, int wr, int wc, int fr, int fq) const {
        const int row0 = u.pm * 256 + wr * 64 + fr, col0 = (u.pn % pn_mod) * 128 + wc * 32 + 8 * fq;
#pragma unroll
        for (int ai = 0; ai < 2; ++ai)
#pragma unroll
            for (int m = 0; m < 4; ++m) {
                unsigned char* rowp = O + (size_t)(row0 + ai * 128 + m * 16) * ldc + col0;
                f32x4 a0 = acc[ai][0][m][0] * W8_INV, a1 = acc[ai][0][m][1] * W8_INV; const f32x4 b0 = acc[ai][1][m][0] * W8_INV, b1 = acc[ai][1][m][1] * W8_INV;
#pragma unroll
                for (int j = 0; j < 4; ++j) { a0[j] = silu_f(a0[j]); a1[j] = silu_f(a1[j]); }
                const f32x4 v0 = a0 * b0, v1 = a1 * b1;
                u32x2 w; w.x = pk4_fp8(v0[0], v0[1], v0[2], v0[3]); w.y = pk4_fp8(v1[0], v1[1], v1[2], v1[3]);
                *(u32x2*)rowp = w;
            }
    }
};
struct EpiConvGate {
    static constexpr bool PERM = true, AFTER_DRAIN = false;
    const bf16_t* U; bf16_t* Z; const float* cw;
    DI void operator()(const f32x4 (&acc)[2][2][4][2], const Unit& u, int wr, int wc, int fr, int fq) const {
        const int row0 = u.pm * 256 + wr * 64 + fr, col0 = u.pn * 256 + wc * 32 + 8 * fq;
#pragma unroll
        for (int bj = 0; bj < 2; ++bj) {
            const int c = col0 + bj * 128;
            f32x4 w0a = *(const f32x4*)(cw + c), w0b = *(const f32x4*)(cw + c + 4), w1a = *(const f32x4*)(cw + 2048 + c), w1b = *(const f32x4*)(cw + 2048 + c + 4), w2a = *(const f32x4*)(cw + 4096 + c), w2b = *(const f32x4*)(cw + 4096 + c + 4);
#pragma unroll
            for (int ai = 0; ai < 2; ++ai)
#pragma unroll
                for (int m = 0; m < 4; ++m) {
                    const int row = row0 + ai * 128 + m * 16;
                    const int tpos = row < ML ? (row & (SEQ - 1)) : ((row - ML) & (CTXL - 1)); const int len = row < ML ? SEQ : CTXL;
                    const u32x4 z4 = (u32x4){0u, 0u, 0u, 0u};
                    const u32x4 uc = *(const u32x4*)(U + (size_t)row * DM + c);
                    const u32x4 up = tpos > 0 ? *(const u32x4*)(U + (size_t)(row - 1) * DM + c) : z4;
                    const u32x4 un = tpos < len - 1 ? *(const u32x4*)(U + (size_t)(row + 1) * DM + c) : z4;
                    f32x4 ya, yb;
                    ya[0] = w0a[0] * bf_lo(up.x) + w1a[0] * bf_lo(uc.x) + w2a[0] * bf_lo(un.x); ya[1] = w0a[1] * bf_hi(up.x) + w1a[1] * bf_hi(uc.x) + w2a[1] * bf_hi(un.x);
                    ya[2] = w0a[2] * bf_lo(up.y) + w1a[2] * bf_lo(uc.y) + w2a[2] * bf_lo(un.y); ya[3] = w0a[3] * bf_hi(up.y) + w1a[3] * bf_hi(uc.y) + w2a[3] * bf_hi(un.y);
                    yb[0] = w0b[0] * bf_lo(up.z) + w1b[0] * bf_lo(uc.z) + w2b[0] * bf_lo(un.z); yb[1] = w0b[1] * bf_hi(up.z) + w1b[1] * bf_hi(uc.z) + w2b[1] * bf_hi(un.z);
                    yb[2] = w0b[2] * bf_lo(up.w) + w1b[2] * bf_lo(uc.w) + w2b[2] * bf_lo(un.w); yb[3] = w0b[3] * bf_hi(up.w) + w1b[3] * bf_hi(uc.w) + w2b[3] * bf_hi(un.w);
                    const f32x4 v0 = acc[ai][bj][m][0] * ya, v1 = acc[ai][bj][m][1] * yb;
                    u32x4 w; w.x = cvt_pk_bf16(v0[0], v0[1]); w.y = cvt_pk_bf16(v0[2], v0[3]); w.z = cvt_pk_bf16(v1[0], v1[1]); w.w = cvt_pk_bf16(v1[2], v1[3]);
                    *(u32x4*)(Z + (size_t)row * DM + c) = w;
                }
        }
    }
};
template <bool BASE_F32> struct EpiResid {
    static constexpr bool PERM = true, AFTER_DRAIN = false;
    const float* base_lat; const float* base_ctx; bf16_t* out; const float* gate; float ws;
    DI void operator()(const f32x4 (&acc)[2][2][4][2], const Unit& u, int wr, int wc, int fr, int fq) const {
        const int rowt = u.pm * 256; const int cr = rowt < ML ? (rowt >> 11) : 8;
        const float* base = rowt < ML ? base_lat : base_ctx - (size_t)ML * DM;
        const int row0 = rowt + wr * 64 + fr, col0 = u.pn * 256 + wc * 32 + 8 * fq;
        f32x4 gv[2][2];
#pragma unroll
        for (int bj = 0; bj < 2; ++bj)
#pragma unroll
            for (int n = 0; n < 2; ++n) gv[bj][n] = *(const f32x4*)(gate + (size_t)cr * NMOD + col0 + bj * 128 + n * 4) * ws;
#pragma unroll
        for (int ai = 0; ai < 2; ++ai)
#pragma unroll
            for (int m = 0; m < 4; ++m) { const size_t off = (size_t)(row0 + ai * 128 + m * 16) * DM + col0;
#pragma unroll
                for (int bj = 0; bj < 2; ++bj) { f32x4 b0, b1;
                    if (BASE_F32) { b0 = *(const f32x4*)(base + off + bj * 128); b1 = *(const f32x4*)(base + off + bj * 128 + 4); }
                    else { const u32x4 hb = *(const u32x4*)(out + off + bj * 128); b0 = (f32x4){bf_lo(hb.x), bf_hi(hb.x), bf_lo(hb.y), bf_hi(hb.y)}; b1 = (f32x4){bf_lo(hb.z), bf_hi(hb.z), bf_lo(hb.w), bf_hi(hb.w)}; }
                    const f32x4 v0 = b0 + gv[bj][0] * acc[ai][bj][m][0], v1 = b1 + gv[bj][1] * acc[ai][bj][m][1];
                    u32x4 w; w.x = cvt_pk_bf16(v0[0], v0[1]); w.y = cvt_pk_bf16(v0[2], v0[3]); w.z = cvt_pk_bf16(v1[0], v1[1]); w.w = cvt_pk_bf16(v1[2], v1[3]);
                    *(u32x4*)(out + off + bj * 128) = w; }
                asm volatile("" ::: "memory"); }
    }
};
struct EpiDown {
    static constexpr bool PERM = true, AFTER_DRAIN = false;
    bf16_t* Y; const float* gatev; float ws;
    DI void operator()(const f32x4 (&acc)[2][2][4][2], const Unit& u, int wr, int wc, int fr, int fq) const {
        const int row0 = u.pm * 256 + wr * 64 + fr, col0 = (u.pn & 7) * 256 + wc * 32 + 8 * fq;
#pragma unroll
        for (int ai = 0; ai < 2; ++ai)
#pragma unroll
            for (int m = 0; m < 4; ++m) { const int row = row0 + ai * 128 + m * 16; const float gt = gatev[row] * ws;
#pragma unroll
                for (int bj = 0; bj < 2; ++bj) { const f32x4 v0 = acc[ai][bj][m][0] * gt, v1 = acc[ai][bj][m][1] * gt;
                    u32x2 w; w.x = pk4_fp8(v0[0], v0[1], v0[2], v0[3]); w.y = pk4_fp8(v1[0], v1[1], v1[2], v1[3]);
                    *(u32x2*)((unsigned char*)Y + (size_t)row * DM + col0 + bj * 128) = w; } }
    }
};
#define LAS3 __attribute__((address_space(3)))
struct EpiQkvNorm {
    static constexpr bool PERM = true, AFTER_DRAIN = false;
    bf16_t* Q; bf16_t* K; bf16_t* V; const float* qg; const float* kg; LAS3 float* P; float ws;
    DI void operator()(const f32x4 (&acc)[2][2][4][2], const Unit& u, int wr, int wc, int fr, int fq) const {
        const int row0 = u.pm * 256 + wr * 64 + fr; int colt = u.pn * 256;
        if (colt >= 2560) {
            const int col0 = colt - 2560 + wc * 32 + 8 * fq;
#pragma unroll
            for (int ai = 0; ai < 2; ++ai)
#pragma unroll
                for (int m = 0; m < 4; ++m) { bf16_t* rowp = V + (size_t)(row0 + ai * 128 + m * 16) * 512 + col0;
#pragma unroll
                    for (int bj = 0; bj < 2; ++bj) { const f32x4 v0 = acc[ai][bj][m][0] * ws, v1 = acc[ai][bj][m][1] * ws;
                        u32x4 w; w.x = cvt_pk_bf16(v0[0], v0[1]); w.y = cvt_pk_bf16(v0[2], v0[3]); w.z = cvt_pk_bf16(v1[0], v1[1]); w.w = cvt_pk_bf16(v1[2], v1[3]);
                        *(u32x4*)(rowp + bj * 128) = w; } }
            return;
        }
        const bool isq = colt < 2048; bf16_t* base = isq ? Q : K; const int ld = isq ? 2048 : 512; if (!isq) colt -= 2048;
        const int rl0 = wr * 64 + fr;
#pragma unroll
        for (int ai = 0; ai < 2; ++ai)
#pragma unroll
            for (int m = 0; m < 4; ++m)
#pragma unroll
                for (int bj = 0; bj < 2; ++bj) { const f32x4 a = acc[ai][bj][m][0], b = acc[ai][bj][m][1];
                    float s = (a[0] * a[0] + a[1] * a[1]) + (a[2] * a[2] + a[3] * a[3]) + (b[0] * b[0] + b[1] * b[1]) + (b[2] * b[2] + b[3] * b[3]);
                    s += __shfl_xor(s, 16); s += __shfl_xor(s, 32);
                    if (fq == 0) P[((ai * 128 + m * 16 + rl0) * 2 + bj) * 4 + wc] = s; }
        asm volatile("s_waitcnt lgkmcnt(0)" ::: "memory"); __builtin_amdgcn_s_barrier(); asm volatile("" ::: "memory");
        constexpr float QSCALE = 0.08838834764831845f * 1.4426950408889634f;
        const int i0 = 16 * (wc & 1) + 4 * fq, d0 = 64 * (wc >> 1) + i0;
        const float* gp = isq ? qg : kg; f32x4 g0 = *(const f32x4*)(gp + d0), g1 = *(const f32x4*)(gp + d0 + 32);
        if (isq) { g0 = g0 * QSCALE; g1 = g1 * QSCALE; }
        f32x4 ifr;
#pragma unroll
        for (int j = 0; j < 4; ++j) ifr[j] = exp2f(-(float)(i0 + j) * (13.287712379549449f / 32.0f));
        const bool lat = u.pm < 64;
#pragma unroll
        for (int ai = 0; ai < 2; ++ai)
#pragma unroll
            for (int m = 0; m < 4; ++m) { const int row = row0 + ai * 128 + m * 16; const int t = row & (SEQ - 1);
                const float pos = (float)((wc >> 1) == 0 ? (t >> 6) : (t & 63));
                f32x4 cs, sn;
#pragma unroll
                for (int j = 0; j < 4; ++j) { const float ang = pos * ifr[j]; cs[j] = lat ? __cosf(ang) : 1.0f; sn[j] = lat ? __sinf(ang) : 0.0f; }
#pragma unroll
                for (int bj = 0; bj < 2; ++bj) { const f32x4 pp = *(const LAS3 f32x4*)(P + ((ai * 128 + m * 16 + rl0) * 2 + bj) * 4);
                    const float rstd = ws / sqrtf(((pp[0] + pp[1]) + (pp[2] + pp[3])) * (ws * ws) * (1.0f / HD) + NORM_EPS);
                    const f32x4 a = acc[ai][bj][m][0] * rstd * g0, b = acc[ai][bj][m][1] * rstd * g1;
                    const f32x4 o1 = a * cs - b * sn, o2 = b * cs + a * sn;
                    u32x4 w; w.x = cvt_pk_bf16(o1[0], o1[1]); w.y = cvt_pk_bf16(o1[2], o1[3]); w.z = cvt_pk_bf16(o2[0], o2[1]); w.w = cvt_pk_bf16(o2[2], o2[3]);
                    *(u32x4*)(base + (size_t)row * ld + colt + bj * 128 + wc * 32 + 8 * fq) = w; } }
    }
};

constexpr size_t MiB = 1u << 20;
constexpr size_t WS_CTL = 0, CTL_ZERO_BYTES = 1 * MiB;
constexpr size_t WS_MOD = 1 * MiB;
constexpr size_t WS_MODP = 2 * MiB;
constexpr size_t WS_AFFL = 16 * MiB;
constexpr size_t WS_AFFC = 17 * MiB;
constexpr size_t WS_RWT = 17 * MiB + 128 * 1024;
constexpr size_t WS_IDMAP = 19 * MiB + 768 * 1024;
constexpr size_t WS_ROWSRC = 17 * MiB + 512 * 1024;
constexpr size_t WS_GATEV = 18 * MiB;
constexpr size_t WS_INV = 18 * MiB + 512 * 1024;
constexpr size_t WS_W1A = 20 * MiB;
constexpr size_t WS_W1B = 36 * MiB;
constexpr size_t WS_W2 = 44 * MiB;
constexpr size_t WS_WQKV = 52 * MiB;
constexpr size_t WS_WO = 64 * MiB;
constexpr size_t WS_WGU = 72 * MiB;
constexpr size_t WS_WDN = 328 * MiB;
constexpr size_t WS_H = 456 * MiB;
constexpr size_t WS_A = 600 * MiB;
constexpr size_t WS_U = 672 * MiB;
constexpr size_t WS_Z = 744 * MiB;
constexpr size_t WS_Q = WS_U, WS_K = WS_Z, WS_V = WS_Z + 18 * MiB;
constexpr size_t WS_HM = 816 * MiB;
constexpr size_t WS_O = WS_HM;
constexpr size_t WS_Y = 888 * MiB;
constexpr size_t WS_END = 1032 * MiB;
constexpr int CW_BAR = 4096;

constexpr int RING_BYTES = 131072;
constexpr int MISC_OFF = RING_BYTES + 14336;
constexpr int LDS_BYTES = 147456;

#define GAS __attribute__((address_space(1)))
#define LAS __attribute__((address_space(3)))
#define LDS_WAIT() asm volatile("s_waitcnt lgkmcnt(0)" ::: "memory")
#define VM_WAIT() asm volatile("s_waitcnt vmcnt(0)" ::: "memory")
#define XB_TMO      128
#define XB_XCNT(j)  (256  + 64 * (j))
#define XB_XSUB(j)  (1280 + 64 * (j))
#define XB_XGEN(j)  (2304 + 64 * (j))
#define XB_TOP      3328
#define XB_TOPGEN   3392
#define XCD_BAR_WORDS 3456
#define XB_SPIN_CAP (1u << 18)

__device__ __forceinline__ unsigned xb_ld(unsigned* p)              { return __hip_atomic_load(p, __ATOMIC_RELAXED, __HIP_MEMORY_SCOPE_AGENT); }
__device__ __forceinline__ unsigned xb_add(unsigned* p, unsigned v) { return __hip_atomic_fetch_add(p, v, __ATOMIC_RELAXED, __HIP_MEMORY_SCOPE_AGENT); }
__device__ __forceinline__ unsigned xb_xcc_id() { return (unsigned)__builtin_amdgcn_s_getreg((3 << 11) | 20) & 0xFu; }
#define XB_SPIN(cond, bar) do { unsigned _sp = 0; while (cond) { __builtin_amdgcn_s_sleep(1); \
    if ((++_sp & 255u) == 0u) { if (xb_ld(&(bar)[XB_TMO])) break; if (_sp > XB_SPIN_CAP) { atomicAdd(&(bar)[XB_TMO], 1u); break; } } } } while (0)

struct XcdBarrier {
    unsigned* bar; unsigned x;
    volatile LAS unsigned* st;
};

__device__ __forceinline__ XcdBarrier xcd_barrier_post(unsigned* bar, volatile LAS unsigned* st) {
    XcdBarrier b; b.bar = bar; b.x = xb_xcc_id(); b.st = st;
    if (threadIdx.x == 0) (void)xb_add(&bar[XB_XCNT(b.x)], 1u);
    return b;
}
__device__ __forceinline__ void xcd_barrier_complete(unsigned* bar, unsigned x, unsigned& nloc, unsigned& nx) {
    const unsigned G = gridDim.x * gridDim.y * gridDim.z;
    unsigned sum, cnt, mine, sp = 0u;
    for (;;) {
        sum = 0u; cnt = 0u; mine = 0u;
#pragma unroll
        for (unsigned j = 0; j < 16; ++j) { const unsigned c = xb_ld(&bar[XB_XCNT(j)]); sum += c; cnt += (c > 0u) ? 1u : 0u; mine = (j == x) ? c : mine; }
        if (sum == G) break;
        __builtin_amdgcn_s_sleep(1);
        if ((++sp & 255u) == 0u) { if (xb_ld(&bar[XB_TMO])) break; if (sp > XB_SPIN_CAP) { atomicAdd(&bar[XB_TMO], 1u); break; } }
    }
    nloc = mine > 0u ? mine : 1u; nx = cnt > 0u ? cnt : 1u;
}

__device__ __forceinline__ void xcd_barrier(const XcdBarrier& b) {
    asm volatile("s_waitcnt vmcnt(0)" ::: "memory");
    __syncthreads();
    if (threadIdx.x == 0) {
        unsigned* bar = b.bar;
        __builtin_amdgcn_s_waitcnt(0);
        unsigned nloc = b.st[0], nx = b.st[1];
        if (nloc == 0u) { xcd_barrier_complete(bar, b.x, nloc, nx); b.st[0] = nloc; b.st[1] = nx; }
        const unsigned old = xb_add(&bar[XB_XSUB(b.x)], 1u);
        const unsigned gen = old / nloc;
        if (old + 1u == (gen + 1u) * nloc) {
            __builtin_amdgcn_fence(__ATOMIC_RELEASE, "agent");
            asm volatile("s_waitcnt vmcnt(0)" ::: "memory");
            const unsigned og = xb_add(&bar[XB_TOP], 1u);
            const unsigned tg = og / nx;
            if (og + 1u == (tg + 1u) * nx) xb_add(&bar[XB_TOPGEN], 1u);
            else XB_SPIN(xb_ld(&bar[XB_TOPGEN]) == tg, bar);
            __builtin_amdgcn_fence(__ATOMIC_ACQUIRE, "agent");
            xb_add(&bar[XB_XGEN(b.x)], 1u);
            asm volatile("s_waitcnt vmcnt(0)" ::: "memory");
        } else {
            XB_SPIN(xb_ld(&bar[XB_XGEN(b.x)]) == gen, bar);
            __builtin_amdgcn_fence(__ATOMIC_ACQUIRE, "agent");
            asm volatile("s_waitcnt vmcnt(0)" ::: "memory");
        }
    }
    __syncthreads();
}

DI float wave_sum(float v) {
#pragma unroll
    for (int o = 1; o < 64; o <<= 1) v += __shfl_xor(v, o);
    return v;
}
DI float rdlane(float v, int l) { return __uint_as_float((unsigned)__builtin_amdgcn_readlane((int)__float_as_uint(v), l)); }
DI unsigned pk2(float lo, float hi) { return cvt_pk_bf16(lo, hi); }

DI void ph_adaln(const float* cnd, const float* cctx, const float* ada_w, float* modp, int gw, int NGW, int lane) {
    for (int task = gw; task < 96 * KSPLIT; task += NGW) {
        const int ks = task & (KSPLIT - 1), cg = task / KSPLIT, l = cg / 48, cgl = cg % 48, col0 = cgl * 256 + lane * 4, k0 = ks * 128;
        float sv[9][2];
#pragma unroll
        for (int r = 0; r < 9; ++r)
#pragma unroll
            for (int hh = 0; hh < 2; ++hh) { const int k = k0 + hh * 64 + lane; const float v = r < 8 ? cnd[r * DM + k] : cctx[k]; sv[r][hh] = v / (1.0f + __expf(-v)); }
        f32x4 acc[9];
#pragma unroll
        for (int r = 0; r < 9; ++r) acc[r] = (f32x4){0.f, 0.f, 0.f, 0.f};
        const float* wp = ada_w + ((size_t)l * DM + k0) * NMOD + col0;
#pragma unroll
        for (int hh = 0; hh < 2; ++hh) {
#pragma unroll 8
            for (int kk = 0; kk < 64; ++kk) {
                const f32x4 w = *(const f32x4*)(wp + (size_t)(hh * 64 + kk) * NMOD);
#pragma unroll
                for (int r = 0; r < 9; ++r) { const float s = rdlane(sv[r][hh], kk); acc[r] += w * s; }
            }
        }
#pragma unroll
        for (int r = 0; r < 9; ++r) *(f32x4*)(modp + ((size_t)((ks * 2 + l) * 9 + r)) * NMOD + col0) = acc[r];
    }
}
struct CvtPtrs { const float *cin, *cout, *wqkv, *wo, *wg, *wu, *wd; bf16_t *W1A, *W1B, *W2, *WQKV, *WO, *WGU, *WDN; };
constexpr int CVT_E0 = 6656, CVT_L = 24576, CVT_TOTAL = CVT_E0 + 2 * CVT_L;
DI void cvt_resolve(const CvtPtrs& P, int it, const float*& src, int& ldw, bf16_t*& dst, int& ldd, bool& qperm, bool& f8) {
    int r = it; qperm = false; f8 = false;
    if (r < 3072) { const int kt = ((r >> 3) / 96) * 8 + (r & 7), nt = (r >> 3) % 96, n0 = nt * 64, part = n0 >> 11, j0 = n0 & 2047;
        src = P.cin + (size_t)(kt * 64) * 6144 + n0; ldw = 6144; ldd = DM;
        dst = (part == 0 ? P.W1B + (size_t)j0 * DM : P.W1A + (size_t)((j0 >> 7) * 256 + (part == 2 ? 128 : 0) + (j0 & 127)) * DM) + kt * 64; return; } r -= 3072;
    if (r < 1024) { const int kt = ((r >> 3) / 32) * 8 + (r & 7), nt = (r >> 3) % 32; src = P.cout + (size_t)(kt * 64) * DM + nt * 64; ldw = DM; dst = P.W2 + (size_t)(nt * 64) * DM + kt * 64; ldd = DM; return; } r -= 1024;
    if (r < 1536) { const int kt = ((r >> 3) / 48) * 8 + (r & 7), nt = (r >> 3) % 48; src = P.wqkv + (size_t)(kt * 64) * 3072 + nt * 64; ldw = 3072; qperm = nt < 40;     f8 = true; dst = (bf16_t*)((unsigned char*)P.WQKV + (size_t)(nt * 64) * DM + kt * 64); ldd = DM;     return; } r -= 1536;
    if (r < 1024) { const int kt = ((r >> 3) / 32) * 8 + (r & 7), nt = (r >> 3) % 32; src = P.wo + (size_t)(kt * 64) * DM + nt * 64; ldw = DM; f8 = true;
        dst = (bf16_t*)((unsigned char*)P.WO + (size_t)(nt * 64) * DM + kt * 64); ldd = DM; return; } r -= 1024;
    const int l = r / CVT_L, rr = r % CVT_L, kind = rr / 8192, q = rr % 8192, le = l * 16 + q / 512, rem = q % 512;
    f8 = true;
    if (kind < 2) { const int kt = ((rem >> 3) / 16) * 8 + (rem & 7), nt = (rem >> 3) % 16, n0 = nt * 64;
        src = (kind ? P.wu : P.wg) + (size_t)le * DM * DFF + (size_t)(kt * 64) * DFF + n0; ldw = DFF;
        dst = (bf16_t*)((unsigned char*)P.WGU + (size_t)(le * 2048 + (n0 >> 7) * 256 + kind * 128 + (n0 & 127)) * DM + kt * 64); ldd = DM; }
    else { const int kt = ((rem >> 3) / 32) * 8 + (rem & 7), nt = (rem >> 3) % 32;
        src = P.wd + (size_t)le * DFF * DM + (size_t)(kt * 64) * DM + nt * 64; ldw = DM; dst = (bf16_t*)((unsigned char*)P.WDN + (size_t)(le * 2048 + nt * 64) * DFF + kt * 64); ldd = DFF; }
}
constexpr int CVT_P = 36;
DI void cvt_range(const CvtPtrs& P, int lo, int hi, int w, int NW, LAS unsigned* scr, int lane) {
    int it = lo + w; if (it >= hi) return;
    const int c = lane & 15, q = lane >> 4;
    const float* src; int ldw; bf16_t* dst; int ldd; bool qperm, f8; cvt_resolve(P, it, src, ldw, dst, ldd, qperm, f8);
    f32x4 v[16];
#pragma unroll
    for (int rr = 0; rr < 16; ++rr) v[rr] = __builtin_nontemporal_load((const f32x4*)(src + (size_t)(16 * q + rr) * ldw + 4 * c));
    for (;;) {
        const bool cf8 = f8; const int wrow = qperm ? 32 * ((c >> 2) & 1) + 8 * (c & 3) + 4 * (c >> 3) : 4 * c;
        u32x4 pa[4], pb[4];
        if (cf8) {
#pragma unroll
            for (int i = 0; i < 4; ++i) { pa[i].x = pk4_fp8(v[0][i] * W8_SCALE, v[1][i] * W8_SCALE, v[2][i] * W8_SCALE, v[3][i] * W8_SCALE); pa[i].y = pk4_fp8(v[4][i] * W8_SCALE, v[5][i] * W8_SCALE, v[6][i] * W8_SCALE, v[7][i] * W8_SCALE);
                                          pa[i].z = pk4_fp8(v[8][i] * W8_SCALE, v[9][i] * W8_SCALE, v[10][i] * W8_SCALE, v[11][i] * W8_SCALE); pa[i].w = pk4_fp8(v[12][i] * W8_SCALE, v[13][i] * W8_SCALE, v[14][i] * W8_SCALE, v[15][i] * W8_SCALE); pb[i] = pa[i]; }
        } else {
#pragma unroll
            for (int i = 0; i < 4; ++i) { pa[i].x = pk2(v[0][i], v[1][i]); pa[i].y = pk2(v[2][i], v[3][i]); pa[i].z = pk2(v[4][i], v[5][i]); pa[i].w = pk2(v[6][i], v[7][i]);
                                          pb[i].x = pk2(v[8][i], v[9][i]); pb[i].y = pk2(v[10][i], v[11][i]); pb[i].z = pk2(v[12][i], v[13][i]); pb[i].w = pk2(v[14][i], v[15][i]); }
        }
        const int nit = it + NW; bf16_t* cdst = dst; const int cldd = ldd;
        if (nit < hi) { cvt_resolve(P, nit, src, ldw, dst, ldd, qperm, f8);
#pragma unroll
            for (int rr = 0; rr < 16; ++rr) v[rr] = __builtin_nontemporal_load((const f32x4*)(src + (size_t)(16 * q + rr) * ldw + 4 * c)); }
        if (cf8) {
#pragma unroll
            for (int i = 0; i < 4; ++i) *(LAS u32x4*)(scr + (wrow + i) * 20 + 4 * q) = pa[i];
            LDS_WAIT(); asm volatile("" ::: "memory");
#pragma unroll
            for (int j = 0; j < 4; ++j) { const int ch = lane + 64 * j, n = ch >> 2, part = ch & 3; const u32x4 o = *(const LAS u32x4*)(scr + n * 20 + 4 * part);
                *(u32x4*)((unsigned char*)cdst + (size_t)n * cldd + 16 * part) = o; }
        } else {
#pragma unroll
            for (int i = 0; i < 4; ++i) { *(LAS u32x4*)(scr + (wrow + i) * CVT_P + 8 * q) = pa[i]; *(LAS u32x4*)(scr + (wrow + i) * CVT_P + 8 * q + 4) = pb[i]; }
            LDS_WAIT(); asm volatile("" ::: "memory");
#pragma unroll
            for (int j = 0; j < 8; ++j) { const int n = (lane >> 3) + 8 * j; const u32x4 o = *(const LAS u32x4*)(scr + n * CVT_P + 4 * (lane & 7));
                *(u32x4*)(cdst + (size_t)n * cldd + 8 * (lane & 7)) = o; }
        }
        LDS_WAIT(); asm volatile("" ::: "memory");
        if (nit >= hi) break;
        it = nit;
    }
}
DI void ph_modred(const float* modp, const float* ada_b, float* mod, int gtid, int GT) {
    for (int i = gtid; i < 2 * 9 * NMOD; i += GT) { const int l = i / (9 * NMOD), j = i % NMOD; float s = ada_b[l * NMOD + j];
#pragma unroll
        for (int ks = 0; ks < KSPLIT; ++ks) s += modp[(size_t)ks * (2 * 9 * NMOD) + i];
        mod[i] = s; }
}
DI void row_load(const float* p, f32x4 (&v)[8], int lane) {
#pragma unroll
    for (int j = 0; j < 8; ++j) v[j] = *(const f32x4*)(p + 4 * lane + 256 * j);
}
DI void row_load_bf(const bf16_t* p, f32x4 (&v)[8], int lane) {
#pragma unroll
    for (int j = 0; j < 8; ++j) { const u32x2 w = *(const u32x2*)(p + 4 * lane + 256 * j); v[j] = (f32x4){bf_lo(w.x), bf_hi(w.x), bf_lo(w.y), bf_hi(w.y)}; }
}
DI void row_modulate(const f32x4 (&v)[8], f32x4 (&y)[8], const float* gain, const float* shift, const float* scale, int lane) {
    float ss = 0.f;
#pragma unroll
    for (int j = 0; j < 8; ++j) ss += (v[j][0] * v[j][0] + v[j][1] * v[j][1]) + (v[j][2] * v[j][2] + v[j][3] * v[j][3]);
    ss = wave_sum(ss);
    const float rstd = 1.0f / sqrtf(ss * (1.0f / DM) + NORM_EPS);
#pragma unroll
    for (int j = 0; j < 8; ++j) { const int c = 4 * lane + 256 * j; const f32x4 g = *(const f32x4*)(gain + c), sh = *(const f32x4*)(shift + c), sc = *(const f32x4*)(scale + c);
        y[j] = ((v[j] * rstd) * g) * (sc + 1.0f) + sh; }
}
DI void row_modulate2(const f32x4 (&v0)[8], const f32x4 (&v1)[8], f32x4 (&y0)[8], f32x4 (&y1)[8], const float* gain, const float* shift, const float* scale, int lane) {
    float s0 = 0.f, s1 = 0.f;
#pragma unroll
    for (int j = 0; j < 8; ++j) { s0 += (v0[j][0] * v0[j][0] + v0[j][1] * v0[j][1]) + (v0[j][2] * v0[j][2] + v0[j][3] * v0[j][3]); s1 += (v1[j][0] * v1[j][0] + v1[j][1] * v1[j][1]) + (v1[j][2] * v1[j][2] + v1[j][3] * v1[j][3]); }
    s0 = wave_sum(s0); s1 = wave_sum(s1);
    const float r0 = 1.0f / sqrtf(s0 * (1.0f / DM) + NORM_EPS), r1 = 1.0f / sqrtf(s1 * (1.0f / DM) + NORM_EPS);
#pragma unroll
    for (int j = 0; j < 8; ++j) { const int c = 4 * lane + 256 * j; const f32x4 g = *(const f32x4*)(gain + c), sh = *(const f32x4*)(shift + c), sc = *(const f32x4*)(scale + c);
        y0[j] = ((v0[j] * r0) * g) * (sc + 1.0f) + sh; y1[j] = ((v1[j] * r1) * g) * (sc + 1.0f) + sh; }
}
DI void row_store_bf16(bf16_t* p, const f32x4 (&y)[8], int lane) {
#pragma unroll
    for (int j = 0; j < 8; ++j) { u32x2 w; w.x = pk2(y[j][0], y[j][1]); w.y = pk2(y[j][2], y[j][3]); *(u32x2*)(p + 4 * lane + 256 * j) = w; }
}
DI void ph_mod0(const float* x, const float* ctx, const float* gain, const float* mod0, bf16_t* A, int gw, int NGW, int lane) {
    int row = gw; if (row >= MT) return;
    f32x4 v[8], vn[8];
    row_load(row < ML ? x + (size_t)row * DM : ctx + (size_t)(row - ML) * DM, v, lane);
    for (;;) {
        const int nrow = row + NGW; const bool more = nrow < MT;
        if (more) row_load(nrow < ML ? x + (size_t)nrow * DM : ctx + (size_t)(nrow - ML) * DM, vn, lane);
        const int cr = row < ML ? (row >> 11) : 8;
        f32x4 y[8]; row_modulate(v, y, gain, mod0 + (size_t)cr * NMOD + 0 * DM, mod0 + (size_t)cr * NMOD + 1 * DM, lane);
        row_store_bf16(A + (size_t)row * DM, y, lane);
        if (!more) break;
#pragma unroll
        for (int j = 0; j < 8; ++j) v[j] = vn[j];
        row = nrow;
    }
}
DI float reduce8(const float (&v)[8], int lane) {
    const bool u0 = lane & 1, u1 = lane & 2, u2 = lane & 4;
    float a[4], b2[2];
#pragma unroll
    for (int k = 0; k < 4; ++k) { const float lo = v[2 * k], hi = v[2 * k + 1]; a[k] = (u0 ? hi : lo) + __shfl_xor(u0 ? lo : hi, 1); }
#pragma unroll
    for (int k = 0; k < 2; ++k) { const float lo = a[2 * k], hi = a[2 * k + 1]; b2[k] = (u1 ? hi : lo) + __shfl_xor(u1 ? lo : hi, 2); }
    return (u2 ? b2[1] : b2[0]) + __shfl_xor(u2 ? b2[0] : b2[1], 4);
}
DI float reduce_halves(float lo8, float hi8, int lane) {
    const bool u3 = lane & 8;
    float t = (u3 ? hi8 : lo8) + __shfl_xor(u3 ? lo8 : hi8, 8);
    t += __shfl_xor(t, 16); t += __shfl_xor(t, 32); return t;
}
DI float softmax16(float lg) {
    float mx = lg;
#pragma unroll
    for (int o = 1; o < 16; o <<= 1) mx = fmaxf(mx, __shfl_xor(mx, o));
    const float ex = __expf(lg - mx); float den = ex;
#pragma unroll
    for (int o = 1; o < 16; o <<= 1) den += __shfl_xor(den, o);
    return ex / den;
}
DI void aff_store(float v, float* affL, float* affC, int row, int lane) {
    if (lane < 16) { if (row < ML) { const int b = row >> 11, n = row & 2047; affL[(size_t)(b * 16 + lane) * SEQ + n] = v; }
                     else { const int rc = row - ML, b = rc >> 8, n = rc & 255; affC[(size_t)(b * 16 + lane) * CTXL + n] = v; } }
}
DI void router_rows2(const f32x4 (&y0)[8], const f32x4 (&y1)[8], const LAS float* rwT, float* affL, float* affC, int row0, int lane) {
    f32x2 yp[8][4];
#pragma unroll
    for (int j = 0; j < 8; ++j)
#pragma unroll
        for (int q = 0; q < 4; ++q) yp[j][q] = (f32x2){y0[j][q], y1[j][q]};
    float r0[2], r1[2];
#pragma unroll
    for (int hf = 0; hf < 2; ++hf) {
        float l0[8], l1[8];
#pragma unroll
        for (int e = 0; e < 8; ++e) { f32x2 acc = (f32x2){0.f, 0.f};
#pragma unroll
            for (int j = 0; j < 8; ++j) { const f32x4 w = *(const LAS f32x4*)(rwT + (8 * hf + e) * DM + 4 * lane + 256 * j);
#pragma unroll
                for (int q = 0; q < 4; ++q) acc = __builtin_elementwise_fma(yp[j][q], (f32x2){w[q], w[q]}, acc); }
            l0[e] = acc.x; l1[e] = acc.y; __builtin_amdgcn_sched_barrier(0); }
        r0[hf] = reduce8(l0, lane); r1[hf] = reduce8(l1, lane);
    }
    const float a0 = softmax16(reduce_halves(r0[0], r0[1], lane)), a1 = softmax16(reduce_halves(r1[0], r1[1], lane));
    aff_store(a0, affL, affC, row0, lane); aff_store(a1, affL, affC, row0 + 1, lane);
}
DI void ph_rwt(const float* rw, float* rwT, int gtid, int GT) {
    for (int i = gtid; i < 2 * 16 * DM; i += GT) { const int l = i >> 15, e = (i >> 11) & 15, d = i & (DM - 1); rwT[i] = rw[(size_t)l * DM * 16 + d * 16 + e]; }
}
DI void load_router(const float* rwT_g, LAS float* rwT, int tid) {
    for (int i = tid; i < DM * 16 / 4; i += 512) ((LAS f32x4*)rwT)[i] = ((const f32x4*)rwT_g)[i];
    __syncthreads();
}
DI void ph_modffn(const bf16_t* H, const float* gain, const float* modl, bf16_t* A, const LAS float* rwT, float* affL, float* affC, int nrows, int gw, int NGW, int lane) {
    int rp = gw; if (rp >= nrows / 2) return;
    u32x2 p0[8], p1[8];
#define MODFFN_LOAD(rp_) do { const int row_ = 2 * (rp_); _Pragma("unroll") for (int j = 0; j < 8; ++j) { p0[j] = *(const u32x2*)(H + (size_t)row_ * DM + 4 * lane + 256 * j); p1[j] = *(const u32x2*)(H + (size_t)(row_ + 1) * DM + 4 * lane + 256 * j); } } while (0)
    MODFFN_LOAD(rp);
    for (;;) {
        const int row = 2 * rp; const int cr = row < ML ? (row >> 11) : 8;
        float s0 = 0.f, s1 = 0.f;
#pragma unroll
        for (int j = 0; j < 8; ++j) { const float a0 = bf_lo(p0[j].x), a1 = bf_hi(p0[j].x), a2 = bf_lo(p0[j].y), a3 = bf_hi(p0[j].y); s0 += (a0 * a0 + a1 * a1) + (a2 * a2 + a3 * a3);
                                      const float b0 = bf_lo(p1[j].x), b1 = bf_hi(p1[j].x), b2 = bf_lo(p1[j].y), b3 = bf_hi(p1[j].y); s1 += (b0 * b0 + b1 * b1) + (b2 * b2 + b3 * b3); }
        s0 = wave_sum(s0); s1 = wave_sum(s1);
        const float r0 = 1.0f / sqrtf(s0 * (1.0f / DM) + NORM_EPS), r1 = 1.0f / sqrtf(s1 * (1.0f / DM) + NORM_EPS);
        const float* shift = modl + (size_t)cr * NMOD + 3 * DM; const float* scale = modl + (size_t)cr * NMOD + 4 * DM;
        f32x4 y0[8], y1[8];
#pragma unroll
        for (int j = 0; j < 8; ++j) { const int c = 4 * lane + 256 * j; const f32x4 g = *(const f32x4*)(gain + c), sh = *(const f32x4*)(shift + c), sc = *(const f32x4*)(scale + c);
            const f32x4 v0 = (f32x4){bf_lo(p0[j].x), bf_hi(p0[j].x), bf_lo(p0[j].y), bf_hi(p0[j].y)}, v1 = (f32x4){bf_lo(p1[j].x), bf_hi(p1[j].x), bf_lo(p1[j].y), bf_hi(p1[j].y)};
            y0[j] = ((v0 * r0) * g) * (sc + 1.0f) + sh; y1[j] = ((v1 * r1) * g) * (sc + 1.0f) + sh;
            *(unsigned*)((unsigned char*)A + (size_t)row * DM + c) = pk4_fp8(y0[j][0], y0[j][1], y0[j][2], y0[j][3]);
            *(unsigned*)((unsigned char*)A + (size_t)(row + 1) * DM + c) = pk4_fp8(y1[j][0], y1[j][1], y1[j][2], y1[j][3]); }
        const int nrp = rp + NGW; const bool more = nrp < nrows / 2;
        if (more) MODFFN_LOAD(nrp);
        asm volatile("" ::: "memory");
        router_rows2(y0, y1, rwT, affL, affC, row, lane);
        if (!more) break;
        rp = nrp;
    }
#undef MODFFN_LOAD
}
DI void ph_topk(int nitems, const float* affL, const float* affC, int* rowsrc, float* gatev, int* inv, LAS unsigned* hist, int tid, int lane, int wave, int bid, int G) {
    LAS unsigned* sh = hist + 256;
    for (int it = bid; it < nitems; it += G) {
        const bool isc = it >= 128; const int be = it & 127, b = be >> 4, e = be & 15;
        const int N = isc ? CTXL : SEQ, C = isc ? CAPC : CAPL;
        const float* src = isc ? affC + (size_t)be * CTXL : affL + (size_t)be * SEQ;
        const int i0 = tid * 4; const bool valid = i0 < N;
        unsigned key[4];
        { f32x4 v = (f32x4){0.f, 0.f, 0.f, 0.f}; if (valid) v = *(const f32x4*)(src + i0);
#pragma unroll
          for (int q = 0; q < 4; ++q) key[q] = __float_as_uint(v[q]); }
        unsigned prefix = 0u, mask = 0u, krem = (unsigned)C;
        for (int pass = 3; pass >= 0; --pass) {
            const int shift = pass * 8;
            if (tid < 256) hist[tid] = 0u;
            __syncthreads();
            if (valid) {
#pragma unroll
                for (int q = 0; q < 4; ++q) if ((key[q] & mask) == prefix) __hip_atomic_fetch_add(&hist[(key[q] >> shift) & 255u], 1u, __ATOMIC_RELAXED, __HIP_MEMORY_SCOPE_WORKGROUP); }
            __syncthreads();
            if (wave == 0) {
                const unsigned h0 = hist[4 * lane], h1 = hist[4 * lane + 1], h2 = hist[4 * lane + 2], h3 = hist[4 * lane + 3];
                const unsigned tot = h0 + h1 + h2 + h3; unsigned incl = tot;
#pragma unroll
                for (int o = 1; o < 64; o <<= 1) { const unsigned t = __shfl_down(incl, o); if (lane + o < 64) incl += t; }
                const unsigned a3 = incl - tot, a2 = a3 + h3, a1 = a2 + h2, a0 = a1 + h1;
                if (a3 < krem && krem <= a3 + h3) { sh[0] = 4 * lane + 3; sh[1] = krem - a3; }
                if (a2 < krem && krem <= a2 + h2) { sh[0] = 4 * lane + 2; sh[1] = krem - a2; }
                if (a1 < krem && krem <= a1 + h1) { sh[0] = 4 * lane + 1; sh[1] = krem - a1; }
                if (a0 < krem && krem <= a0 + h0) { sh[0] = 4 * lane + 0; sh[1] = krem - a0; }
            }
            __syncthreads();
            const unsigned B = sh[0]; krem = sh[1]; prefix |= B << shift; mask |= 0xFFu << shift;
        }
        const unsigned T = prefix;
        unsigned cg = 0u, ce = 0u;
        if (valid) {
#pragma unroll
            for (int q = 0; q < 4; ++q) { cg += key[q] > T ? 1u : 0u; ce += key[q] == T ? 1u : 0u; } }
        const unsigned mine = cg | (ce << 16); unsigned incl = mine;
#pragma unroll
        for (int o = 1; o < 64; o <<= 1) { const unsigned t = __shfl_up(incl, o); if (lane >= o) incl += t; }
        if (lane == 63) sh[8 + wave] = incl;
        __syncthreads();
        unsigned woff = 0u;
#pragma unroll
        for (int w = 0; w < 8; ++w) woff += (w < wave) ? sh[8 + w] : 0u;
        const unsigned excl = woff + incl - mine; unsigned gtb = excl & 0xFFFFu, eqb = excl >> 16;
        if (valid) {
            const int ybase = e * YR + (isc ? NB * CAPL + b * CAPC : b * CAPL); const int rbase = isc ? ML + b * CTXL : b * SEQ;
#pragma unroll
            for (int q = 0; q < 4; ++q) {
                const bool isg = key[q] > T, ise = key[q] == T; const bool sel = isg || (ise && eqb < krem);
                const unsigned slot = gtb + (eqb < krem ? eqb : krem);
                const int trow = rbase + i0 + q; const int yrow = ybase + (int)slot;
                if (sel) { rowsrc[yrow] = trow; gatev[yrow] = __uint_as_float(key[q]); }
                inv[(size_t)trow * 16 + e] = sel ? yrow : -1;
                gtb += isg ? 1u : 0u; eqb += ise ? 1u : 0u;
            }
        }
        __syncthreads();
    }
}
template <bool LAST> DI void ph_combine(bf16_t* H, const bf16_t* Y, const int* inv, const float* modl  , const float* gain1, const float* mod1, bf16_t* A, float* out, int nrows, int gw, int NGW, int lane) {
    int row = gw; if (row >= nrows) return;
    u32x2 hp[8], hn[8]; int myinv, ninv = -1;
#define CMB_LOAD(HP, IV, row_) do { _Pragma("unroll") for (int j = 0; j < 8; ++j) HP[j] = *(const u32x2*)(H + (size_t)(row_) * DM + 4 * lane + 256 * j); IV = inv[(size_t)(row_) * 16 + (lane & 15)]; } while (0)
    CMB_LOAD(hp, myinv, row);
    for (;;) {
        const int nrow = row + NGW; const bool more = nrow < nrows;
        if (more) CMB_LOAD(hn, ninv, nrow);
        const int cr = row < ML ? (row >> 11) : 8;
        f32x4 acc[8];
#pragma unroll
        for (int j = 0; j < 8; ++j) acc[j] = (f32x4){0.f, 0.f, 0.f, 0.f};
        unsigned m = (unsigned)(__ballot(myinv >= 0) & 0xFFFFull);
        while (m) {
            const int e1 = __builtin_ctz(m); m &= m - 1; const bool two = m != 0u; const int e2 = two ? __builtin_ctz(m) : e1; if (two) m &= m - 1;
            const unsigned char* y1 = (const unsigned char*)Y + (size_t)__builtin_amdgcn_readlane(myinv, e1) * DM + 4 * lane; const unsigned char* y2 = (const unsigned char*)Y + (size_t)__builtin_amdgcn_readlane(myinv, e2) * DM + 4 * lane;
            unsigned q1[8], q2[8];
#pragma unroll
            for (int j = 0; j < 8; ++j) { q1[j] = *(const unsigned*)(y1 + 256 * j); q2[j] = *(const unsigned*)(y2 + 256 * j); }
            const float f2 = two ? 1.0f : 0.0f;
#pragma unroll
            for (int j = 0; j < 8; ++j) acc[j] += unpk4_fp8(q1[j]) + unpk4_fp8(q2[j]) * f2;
        }
        const float* g2 = modl + (size_t)cr * NMOD + 5 * DM;
        f32x4 v[8];
#pragma unroll
        for (int j = 0; j < 8; ++j) { const f32x4 g = *(const f32x4*)(g2 + 4 * lane + 256 * j); const f32x4 h = (f32x4){bf_lo(hp[j].x), bf_hi(hp[j].x), bf_lo(hp[j].y), bf_hi(hp[j].y)}; v[j] = h + g * (acc[j] * Y8_INV); }
        if (LAST) {
#pragma unroll
            for (int j = 0; j < 8; ++j) *(f32x4*)(out + (size_t)row * DM + 4 * lane + 256 * j) = v[j];
        } else {
            row_store_bf16(H + (size_t)row * DM, v, lane);
            f32x4 y[8]; row_modulate(v, y, gain1, mod1 + (size_t)cr * NMOD + 0 * DM, mod1 + (size_t)cr * NMOD + 1 * DM, lane);
#pragma unroll
            for (int j = 0; j < 8; ++j) *(unsigned*)((unsigned char*)A + (size_t)row * DM + 4 * lane + 256 * j) = pk4_fp8(y[j][0], y[j][1], y[j][2], y[j][3]);
        }
        if (!more) break;
#pragma unroll
        for (int j = 0; j < 8; ++j) hp[j] = hn[j];
        myinv = ninv; row = nrow;
    }
#undef CMB_LOAD
}
constexpr int KP = 272;
constexpr int VP = 288;
constexpr int ATT_VOFF = 64 * KP;
constexpr int ATT_TILE = 64 * KP + 64 * VP;
constexpr int ATT_OST = 2 * ATT_TILE;
DI float xhalf_max(float v) { auto rr = __builtin_amdgcn_permlane32_swap(__float_as_uint(v), __float_as_uint(v), false, false); return fmaxf(__uint_as_float(rr[0]), __uint_as_float(rr[1])); }
DI float xhalf_sum(float v) { auto rr = __builtin_amdgcn_permlane32_swap(__float_as_uint(v), __float_as_uint(v), false, false); return __uint_as_float(rr[0]) + __uint_as_float(rr[1]); }
DI int crow(int reg, int h) { return (reg & 3) + 8 * (reg >> 2) + 4 * h; }
DI long long vtr64(const LAS unsigned char* p) { typedef short v4i16_t __attribute__((ext_vector_type(4))); return __builtin_bit_cast(long long, __builtin_amdgcn_ds_read_tr16_b64_v4i16((LAS v4i16_t*)p)); }
DI s16x4 vtr(const LAS unsigned char* p) { typedef short v4i16_t __attribute__((ext_vector_type(4))); return __builtin_bit_cast(s16x4, __builtin_amdgcn_ds_read_tr16_b64_v4i16((LAS v4i16_t*)p)); }
DI bool att_tile_info(int item, int ti, int& base, int& mtype) {
    const int qhalf = item & 1, n = (item >> 3) & 15, b = item >> 7, tt = ti & 1; mtype = 0;
    if (ti < 4) { base = ML + b * CTXL + 64 * ti; return true; }
    const int blk = n - 1 + ((ti - 4) >> 1); if (blk < 0 || blk > 15) return false;
    if (ti < 6) { mtype = 1; if (tt == 0 && qhalf == 1) return false; } else if (ti >= 8) { mtype = 2; if (tt == 1 && qhalf == 0) return false; }
    base = b * SEQ + blk * 128 + 64 * tt; return true;
}
DI void att_next(int& item, int& ti, int G) { for (;;) { ++ti; if (ti >= 10) { ti = 0; item += G; return; } int b_, m_; if (att_tile_info(item, ti, b_, m_)) return; } }
DI void ph_attn(const bf16_t* Q, const bf16_t* Kb, const bf16_t* Vb, bf16_t* O, const float* sink, LAS unsigned char* lds, int tid, int lane, int wave, int bid, int G) {
    constexpr float LOG2E = 1.4426950408889634f;
    const int r = lane & 31, h = lane >> 5, g = wave >> 1, sub = wave & 1;
    const int ldrow = tid >> 3, ldc = tid & 7;
    int item = bid, ti = 0; if (item >= 1024) return;
    u32x4 kr[2], vr[2];
#define ATT_ISSUE(it_, ti_) do { int base_, mt_; att_tile_info(it_, ti_, base_, mt_); const int kvh_ = ((it_) >> 1) & 3; \
        _Pragma("unroll") for (int c2 = 0; c2 < 2; ++c2) { const size_t off_ = (size_t)(base_ + ldrow) * 512 + kvh_ * HD + (ldc + 8 * c2) * 8; kr[c2] = *(const u32x4*)(Kb + off_); vr[c2] = *(const u32x4*)(Vb + off_); } } while (0)
    bf16x8 qf[8]; float m2 = 0.f, lsum = 1.f; f32x16 o[4]; f32x16 negm;
#define ATT_QLOAD(it_) do { const int qrow_ = ((it_) >> 7) * SEQ + (((it_) >> 3) & 15) * 128 + ((it_) & 1) * 64 + sub * 32 + r; const int head_ = (((it_) >> 1) & 3) * 4 + g; \
        _Pragma("unroll") for (int s = 0; s < 8; ++s) qf[s] = *(const bf16x8*)(Q + (size_t)qrow_ * DM + head_ * HD + 16 * s + 8 * h); } while (0)
    ATT_QLOAD(item);
    ATT_ISSUE(item, ti);
    int buf = 0;
    while (item < 1024) {
        int nitem = item, nti = ti; att_next(nitem, nti, G);
        LAS unsigned char* tb = lds + buf * ATT_TILE;
#pragma unroll
        for (int c2 = 0; c2 < 2; ++c2) { *(LAS u32x4*)(tb + ldrow * KP + (ldc + 8 * c2) * 16) = kr[c2]; *(LAS u32x4*)(tb + ATT_VOFF + ldrow * VP + (ldc + 8 * c2) * 16) = vr[c2]; }
        if (nitem < 1024) ATT_ISSUE(nitem, nti);
        asm volatile("s_waitcnt lgkmcnt(0)" ::: "memory"); __builtin_amdgcn_s_barrier(); asm volatile("" ::: "memory");
        int base, mtype; att_tile_info(item, ti, base, mtype); const int tt = ti & 1;
        const int qhalf = item & 1, kvh = (item >> 1) & 3, n = (item >> 3) & 15, b = item >> 7;
        const int head = kvh * 4 + g, qq = qhalf * 64 + sub * 32 + r; const int qrow = b * SEQ + n * 128 + qq;
        if (ti == 0) {
            m2 = sink[head] * LOG2E; lsum = 1.0f;
#pragma unroll
            for (int i = 0; i < 16; ++i) negm[i] = -m2;
#pragma unroll
            for (int d = 0; d < 4; ++d)
#pragma unroll
                for (int i = 0; i < 16; ++i) o[d][i] = 0.f;
        }
        f32x16 x0, x1;
#pragma unroll
        for (int s = 0; s < 8; ++s) {
            const bf16x8 k0 = *(const LAS bf16x8*)(tb + r * KP + (16 * s + 8 * h) * 2), k1 = *(const LAS bf16x8*)(tb + (32 + r) * KP + (16 * s + 8 * h) * 2);
            if (s == 0) { x0 = __builtin_amdgcn_mfma_f32_32x32x16_bf16(k0, qf[s], negm, 0, 0, 0); x1 = __builtin_amdgcn_mfma_f32_32x32x16_bf16(k1, qf[s], negm, 0, 0, 0); }
            else { x0 = __builtin_amdgcn_mfma_f32_32x32x16_bf16(k0, qf[s], x0, 0, 0, 0); x1 = __builtin_amdgcn_mfma_f32_32x32x16_bf16(k1, qf[s], x1, 0, 0, 0); } }
        if (nitem != item && nitem < 1024) ATT_QLOAD(nitem);
        if (mtype == 1) {
#pragma unroll
            for (int i = 0; i < 16; ++i) { const int kk0 = tt * 64 + crow(i, h); if (kk0 < qq) x0[i] = -1.0e30f; if (kk0 + 32 < qq) x1[i] = -1.0e30f; } }
        if (mtype == 2) {
#pragma unroll
            for (int i = 0; i < 16; ++i) { const int kk0 = tt * 64 + crow(i, h); if (kk0 > qq) x0[i] = -1.0e30f; if (kk0 + 32 > qq) x1[i] = -1.0e30f; } }
        float tmax = fmaxf(x0[0], x1[0]);
#pragma unroll
        for (int i = 1; i < 16; ++i) tmax = fmaxf(fmaxf(tmax, x0[i]), x1[i]);
        tmax = xhalf_max(tmax);
        if (__any(tmax > 0.0f)) {
            const float dl = fmaxf(tmax, 0.0f), alpha = __builtin_amdgcn_exp2f(-dl); m2 += dl; lsum *= alpha;
#pragma unroll
            for (int i = 0; i < 16; ++i) { x0[i] -= dl; x1[i] -= dl; negm[i] = -m2; }
#pragma unroll
            for (int d = 0; d < 4; ++d)
#pragma unroll
                for (int i = 0; i < 16; ++i) o[d][i] *= alpha;
        }
        float ps = 0.f;
#pragma unroll
        for (int i = 0; i < 16; ++i) { x0[i] = __builtin_amdgcn_exp2f(x0[i]); x1[i] = __builtin_amdgcn_exp2f(x1[i]); ps += x0[i] + x1[i]; }
        lsum += xhalf_sum(ps);
        bf16x8 pf[2][2];
#pragma unroll
        for (int s = 0; s < 2; ++s) {
            u32x4 a, c; a.x = pk2(x0[8 * s + 0], x0[8 * s + 1]); a.y = pk2(x0[8 * s + 2], x0[8 * s + 3]); a.z = pk2(x0[8 * s + 4], x0[8 * s + 5]); a.w = pk2(x0[8 * s + 6], x0[8 * s + 7]);
            c.x = pk2(x1[8 * s + 0], x1[8 * s + 1]); c.y = pk2(x1[8 * s + 2], x1[8 * s + 3]); c.z = pk2(x1[8 * s + 4], x1[8 * s + 5]); c.w = pk2(x1[8 * s + 6], x1[8 * s + 7]);
            pf[0][s] = __builtin_bit_cast(bf16x8, a); pf[1][s] = __builtin_bit_cast(bf16x8, c); }
        const LAS unsigned char* vb = tb + ATT_VOFF + (4 * h + ((lane & 15) >> 2)) * VP + (16 * ((lane >> 4) & 1) + 4 * (lane & 3)) * 2;
#pragma unroll
        for (int d = 0; d < 4; ++d)
#pragma unroll
            for (int t = 0; t < 2; ++t)
#pragma unroll
                for (int s = 0; s < 2; ++s) {
                    typedef long long i64x2_t __attribute__((ext_vector_type(2)));
                    i64x2_t vv; vv.x = vtr64(vb + (t * 32 + 16 * s) * VP + d * 64); vv.y = vtr64(vb + (t * 32 + 16 * s + 8) * VP + d * 64);
                    const bf16x8 vf = __builtin_bit_cast(bf16x8, vv);
                    o[d] = __builtin_amdgcn_mfma_f32_32x32x16_bf16(vf, pf[t][s], o[d], 0, 0, 0); }
        if (nitem != item) {
            const float il = 1.0f / lsum;
            LAS unsigned char* st = lds + ATT_OST + wave * (32 * KP);
#pragma unroll
            for (int d = 0; d < 4; ++d)
#pragma unroll
                for (int g4 = 0; g4 < 4; ++g4) *(LAS unsigned*)(st + r * 144 + d * 32 + 8 * g4 + 4 * h) = pk4_fp8(o[d][4 * g4 + 0] * il, o[d][4 * g4 + 1] * il, o[d][4 * g4 + 2] * il, o[d][4 * g4 + 3] * il);
            asm volatile("s_waitcnt lgkmcnt(0)" ::: "memory");
            unsigned char* ob = (unsigned char*)O + (size_t)(qrow - r) * DM + head * HD;
#pragma unroll
            for (int j = 0; j < 4; ++j) { const int c = lane + 64 * j, row = c >> 3, c16 = c & 7;
                const u32x4 v = *(const LAS u32x4*)(st + row * 144 + c16 * 16); *(u32x4*)(ob + (size_t)row * DM + c16 * 16) = v; }
        }
        item = nitem; ti = nti; buf ^= 1;
    }
#undef ATT_ISSUE
#undef ATT_QLOAD
}
#ifndef MK_ONE_LAUNCH
#define MK_ONE_LAUNCH 1
#endif
constexpr int NPHASE = 19;
constexpr int CVT_X0_END = CVT_E0 + CVT_L;
#define CVT_MKCP() CvtPtrs CP; CP.cin = args.in[8]; CP.cout = args.in[10]; CP.wqkv = args.in[11]; CP.wo = args.in[15]; CP.wg = args.in[17]; CP.wu = args.in[18]; CP.wd = args.in[19]; \
    CP.W1A = W1A; CP.W1B = W1B; CP.W2 = W2; CP.WQKV = WQKV; CP.WO = WOt; CP.WGU = WGU; CP.WDN = WDN
#define CVT(LO, HI) do { CVT_MKCP(); cvt_range(CP, LO, HI, gw, NGW, cscr, lane); } while (0)
#define TAIL_CVT(NWG, LO, HI) do { const int R_ = ((NWG) + G - 1) / G, rem_ = (NWG) - (R_ - 1) * G; if (bid >= rem_) { CVT_MKCP(); cvt_range(CP, LO, HI, (bid - rem_) * 8 + wave, (G - rem_) * 8, cscr, lane); } } while (0)
#ifndef MK_T3
#define MK_T3 5120
#define MK_T4 12288
#define MK_T5 19456
#define MK_T9 2560
#define MK_T11 8192
#endif
constexpr int T3 = MK_T3, T4 = MK_T4, T5 = MK_T5, T9 = MK_T9, T11 = MK_T11;
#ifndef MK_DUP_MASK
#define MK_DUP_MASK 0u
#endif
constexpr unsigned DUP_MASK = MK_DUP_MASK;
struct Args { const float* in[20]; float* out; unsigned char* ws; int ph_lo, ph_hi; };
__global__ void __launch_bounds__(512, 2) dit_fwd(Args args) {
    extern __shared__ __attribute__((aligned(16))) unsigned char lds_raw[];
    LAS unsigned char* lds = (LAS unsigned char*)lds_raw;
    const int tid = threadIdx.x, lane = tid & 63, wave = __builtin_amdgcn_readfirstlane(tid >> 6);
    const int G = gridDim.x, bid = blockIdx.x;
    const int gw = bid * 8 + wave, NGW = G * 8;
    unsigned char* ws = args.ws;
    const float* x = args.in[0]; const float* cnd = args.in[1]; const float* ctx = args.in[2]; const float* cctx = args.in[3];
    const float* ada_w = args.in[4]; const float* ada_b = args.in[5]; const float* nmix = args.in[6]; const float* nffn = args.in[7];
    const float* conv_w = args.in[9]; const float* qgain = args.in[12]; const float* kgain = args.in[13]; const float* sink = args.in[14]; const float* router_w = args.in[16];
    float* mod = (float*)(ws + WS_MOD); float* modp = (float*)(ws + WS_MODP);
    float* affL = (float*)(ws + WS_AFFL); float* affC = (float*)(ws + WS_AFFC);
    float* rwt = (float*)(ws + WS_RWT);
    int* idmap = (int*)(ws + WS_IDMAP);
    int* rowsrc = (int*)(ws + WS_ROWSRC); float* gatev = (float*)(ws + WS_GATEV); int* inv = (int*)(ws + WS_INV);
    bf16_t* W1A = (bf16_t*)(ws + WS_W1A); bf16_t* W1B = (bf16_t*)(ws + WS_W1B); bf16_t* W2 = (bf16_t*)(ws + WS_W2); bf16_t* WQKV = (bf16_t*)(ws + WS_WQKV); bf16_t* WOt = (bf16_t*)(ws + WS_WO);
    bf16_t* WGU = (bf16_t*)(ws + WS_WGU); bf16_t* WDN = (bf16_t*)(ws + WS_WDN);
    bf16_t* H = (bf16_t*)(ws + WS_H); bf16_t* A = (bf16_t*)(ws + WS_A); bf16_t* U = (bf16_t*)(ws + WS_U); bf16_t* Z = (bf16_t*)(ws + WS_Z);
    bf16_t* Qb = (bf16_t*)(ws + WS_Q); bf16_t* Kb = (bf16_t*)(ws + WS_K); bf16_t* Vb = (bf16_t*)(ws + WS_V); bf16_t* Ob = (bf16_t*)(ws + WS_O);
    bf16_t* HM = (bf16_t*)(ws + WS_HM); bf16_t* Y = (bf16_t*)(ws + WS_Y);
    LAS unsigned* cscr = (LAS unsigned*)(lds + wave * 9216);

    for (int u = tid; u < (LDS_BYTES - MISC_OFF) / 4; u += 512) ((LAS unsigned*)(lds + MISC_OFF))[u] = 0u;
    __syncthreads();
#if MK_ONE_LAUNCH
    XcdBarrier bar = xcd_barrier_post((unsigned*)(ws + WS_CTL) + CW_BAR, (volatile LAS unsigned*)(lds + MISC_OFF) + 8);
#define GRID_BAR() xcd_barrier(bar)
#else
#define GRID_BAR() do {} while (0)
#endif
    const int lo = args.ph_lo, hi = args.ph_hi;
#define IN(k) (lo <= (k) && (k) < hi)
#define SEAM(k) do { if (IN(k) && IN((k) + 1)) GRID_BAR(); } while (0)
#define PHASE(k) if (IN(k)) _Pragma("unroll") for (int rep_ = 0; rep_ < 1 + (int)((DUP_MASK >> (k)) & 1u); ++rep_)
#define REP_BAR() do { if (rep_) GRID_BAR(); } while (0)

    PHASE(0) { REP_BAR(); ph_adaln(cnd, cctx, ada_w, modp, gw, NGW, lane); } SEAM(0);
    PHASE(1) { REP_BAR(); ph_modred(modp, ada_b, mod, bid * 512 + tid, G * 512); ph_rwt(router_w, rwt, bid * 512 + tid, G * 512); for (int i = bid * 512 + tid; i < YT; i += G * 512) idmap[i] = i; } SEAM(1);
    PHASE(2) { REP_BAR(); ph_mod0(x, ctx, nmix, mod, A, gw, NGW, lane); CVT(0, 4096); } SEAM(2);
    PHASE(3) { REP_BAR();
        pg8::Gemm g{A, W1A, MT, 4096, DM}; pg8::StaticOrder S; S.init(MT, 4096, G, bid);
        EpiPair<0> E{U, DM, 16};
        pg8::gemm_phase<EpiPair<0>, pg8::StaticOrder, true, true>(lds, g, S, E);
        TAIL_CVT((MT / 256) * 16, CVT_E0, CVT_E0 + T3);
    } SEAM(3);
    PHASE(4) { REP_BAR();
        pg8::Gemm g{A, W1B, MT, DM, DM}; pg8::StaticOrder S; S.init(MT, DM, G, bid);
        EpiConvGate E{U, Z, conv_w};
        pg8::gemm_phase<EpiConvGate, pg8::StaticOrder, true, true>(lds, g, S, E);
        TAIL_CVT((MT / 256) * 8, CVT_E0 + T3, CVT_E0 + T4);
    } SEAM(4);
    PHASE(5) { REP_BAR();
        pg8::Gemm g{Z, W2, MT, DM, DM}; pg8::StaticOrder S; S.init(MT, DM, G, bid);
        EpiResid<true> E{x, ctx, H, mod + 2 * DM, 1.0f};
        pg8::gemm_phase<EpiResid<true>, pg8::StaticOrder, true, true>(lds, g, S, E);
        TAIL_CVT((MT / 256) * 8, CVT_E0 + T4, CVT_E0 + T5);
    } SEAM(5);
    PHASE(6) { REP_BAR(); load_router(rwt, (LAS float*)lds, tid); ph_modffn(H, nffn, mod, A, (const LAS float*)lds, affL, affC, MT, gw, NGW, lane); } SEAM(6);
    PHASE(7) { REP_BAR(); ph_topk(256, affL, affC, rowsrc, gatev, inv, (LAS unsigned*)lds, tid, lane, wave, bid, G); if (T5 < 16384) CVT(CVT_E0 + T5, CVT_E0 + 16384); } SEAM(7);
    PHASE(8) { REP_BAR();
        pg8::Gemm g{A, WGU, YT, NE * 2048, DM / 2, rowsrc}; MoeOrder S{G, bid, 9};
        EpiPairF8 E{(unsigned char*)HM, DFF, 8};
        pg8::gemm_phase<EpiPairF8, MoeOrder, true, true, true, true>(lds, g, S, E);
        TAIL_CVT(NE * 9 * 8, CVT_E0 + (T5 > 16384 ? T5 : 16384), CVT_X0_END);
    } SEAM(8);
    PHASE(9) { REP_BAR();
        pg8::Gemm g{HM, WDN, YT, NE * 2048, DFF / 2, idmap}; MoeOrder S{G, bid, 9};
        EpiDown E{Y, gatev, W8_INV * Y8_SCALE};
        pg8::gemm_phase<EpiDown, MoeOrder, true, true, true, true>(lds, g, S, E);
        TAIL_CVT(NE * 9 * 8, CVT_X0_END, CVT_X0_END + T9);
    } SEAM(9);
    PHASE(10) { REP_BAR(); ph_combine<false>(H, Y, inv, mod, nmix + DM, mod + 9 * NMOD, A, nullptr, MT, gw, NGW, lane); CVT(4096, 4096 + 1536); } SEAM(10);
    PHASE(11) { REP_BAR();
        pg8::Gemm g{A, WQKV, MT, 3072, DM / 2, idmap}; QkvOrder S{G, bid};
        EpiQkvNorm E{Qb, Kb, Vb, qgain, kgain, (LAS float*)(lds + RING_BYTES), W8_INV};
        pg8::gemm_phase<EpiQkvNorm, QkvOrder, true, true, true, true>(lds, g, S, E);
        TAIL_CVT(800, CVT_X0_END + T9, CVT_X0_END + T11);
    } SEAM(11);
    PHASE(12) { REP_BAR(); ph_attn(Qb, Kb, Vb, Ob, sink, lds, tid, lane, wave, bid, G); __syncthreads(); CVT(4096 + 1536, CVT_E0); } SEAM(12);
    PHASE(13) { REP_BAR();
        pg8::Gemm g{Ob, WOt, ML, DM, DM / 2, idmap}; pg8::StaticOrder S; S.init(ML, DM, G, bid);
        EpiResid<false> E{nullptr, nullptr, H, mod + 9 * NMOD + 2 * DM, W8_INV};
        pg8::gemm_phase<EpiResid<false>, pg8::StaticOrder, true, true, true, true>(lds, g, S, E);
    } SEAM(13);
    PHASE(14) { REP_BAR(); load_router(rwt + DM * 16, (LAS float*)lds, tid); ph_modffn(H, nffn + DM, mod + 9 * NMOD, A, (const LAS float*)lds, affL, affC, ML, gw, NGW, lane); } SEAM(14);
    PHASE(15) { REP_BAR(); ph_topk(128, affL, affC, rowsrc, gatev, inv, (LAS unsigned*)lds, tid, lane, wave, bid, G); CVT(CVT_X0_END + T11, CVT_X0_END + 16384); } SEAM(15);
    PHASE(16) { REP_BAR();
        pg8::Gemm g{A, (const bf16_t*)((const unsigned char*)WGU + (size_t)NE * 2048 * DM), YT, NE * 2048, DM / 2, rowsrc}; MoeOrder S{G, bid, 8};
        EpiPairF8 E{(unsigned char*)HM, DFF, 8};
        pg8::gemm_phase<EpiPairF8, MoeOrder, true, true, true, true>(lds, g, S, E);
        CVT(CVT_X0_END + 16384, CVT_TOTAL);
    } SEAM(16);
    PHASE(17) { REP_BAR();
        pg8::Gemm g{HM, (const bf16_t*)((const unsigned char*)WDN + (size_t)NE * 2048 * DFF), YT, NE * 2048, DFF / 2, idmap}; MoeOrder S{G, bid, 8};
        EpiDown E{Y, gatev, W8_INV * Y8_SCALE};
        pg8::gemm_phase<EpiDown, MoeOrder, true, true, true, true>(lds, g, S, E);
    } SEAM(17);
    PHASE(18) { REP_BAR(); ph_combine<true>(H, Y, inv, mod + 9 * NMOD, nullptr, nullptr, nullptr, args.out, ML, gw, NGW, lane); }
#undef IN
#undef SEAM
#undef PHASE
#undef REP_BAR
}

extern "C" void kernel_launch(void* const* d_in, const int* in_sizes, int n_in, void* d_out, int out_size, void* d_ws, size_t ws_size, hipStream_t stream) {
    static int grid = 0;
    if (grid == 0) {
        if (n_in != 20 || out_size != ML * DM || ws_size < WS_END) { fprintf(stderr, "kernel_launch: unexpected problem (n_in %d, out %d, ws %zu); nothing launched\n", n_in, out_size, ws_size); grid = -1; return; }
        int dev = 0, cus = 0, per_cu = 0;
        if (hipGetDevice(&dev) != hipSuccess || hipDeviceGetAttribute(&cus, hipDeviceAttributeMultiprocessorCount, dev) != hipSuccess) { grid = -1; return; }
        if (hipFuncSetAttribute((const void*)dit_fwd, hipFuncAttributeMaxDynamicSharedMemorySize, LDS_BYTES) != hipSuccess) { fprintf(stderr, "kernel_launch: hipFuncSetAttribute failed\n"); grid = -1; return; }
        if (hipOccupancyMaxActiveBlocksPerMultiprocessor(&per_cu, (const void*)dit_fwd, 512, LDS_BYTES) != hipSuccess || per_cu < 1) fprintf(stderr, "kernel_launch: occupancy query reports %d workgroups per CU\n", per_cu);
        (void)hipGetLastError();
        grid = cus;
    }
    if (grid < 0) return;
    (void)hipMemsetAsync((char*)d_ws + WS_CTL, 0, CTL_ZERO_BYTES, stream);
    Args a{};
    for (int i = 0; i < 20; ++i) a.in[i] = (const float*)d_in[i];
    a.out = (float*)d_out; a.ws = (unsigned char*)d_ws;
#if MK_ONE_LAUNCH
    a.ph_lo = 0; a.ph_hi = NPHASE;
    hipLaunchKernelGGL(dit_fwd, dim3(grid), dim3(512), LDS_BYTES, stream, a);
#else
    for (int p = 0; p < NPHASE; ++p) { a.ph_lo = p; a.ph_hi = p + 1; hipLaunchKernelGGL(dit_fwd, dim3(grid), dim3(512), LDS_BYTES, stream, a); }
#endif
}
```

```cpp
#include <hip/hip_runtime.h>
#include <cstdio>
#include <cstdint>
namespace pg8 {
#define PG8_LAS __attribute__((address_space(3)))
typedef unsigned short bf16_t;
typedef short bf16x8 __attribute__((ext_vector_type(8)));
typedef float f32x4 __attribute__((ext_vector_type(4)));
typedef unsigned u32x4 __attribute__((ext_vector_type(4)));
constexpr int BM = 256, BK = 64, HALF = 128, HTB = HALF * BK * 2  , STAGE_BYTES = 8 * HTB, NXCD = 8, WGM = 8;

__host__ __device__ __forceinline__ int lds_byte(int r, int c) { const int st = (r >> 4) * 2 + (c >> 5), rr = r & 15, cc = c & 31, ob = rr * 64 + cc * 2; return st * 1024 + (ob ^ (((ob >> 9) & 1) << 5)); }
__host__ __device__ __forceinline__ void stage_rc(int b, int& R, int& C) { const int st = b / 1024, sb = b % 1024, swz = sb ^ (((sb >> 9) & 1) << 5); R = (st >> 1) * 16 + swz / 64; C = (st & 1) * 32 + (swz % 64) / 2; }
__host__ __device__ __forceinline__ int perm32(int rho) { const int n = rho >> 4, i = rho & 15; return 8 * (i >> 2) + 4 * n + (i & 3); }

struct Unit { int pm, pn; };
struct Gemm { const bf16_t* A; const bf16_t* Bt; int M, N, K; const int* rows = nullptr; };

struct StaticOrder {
    int nM, nN, nwg, G, c;
    __host__ __device__ void init(int M, int N, int G_, int c_) { nM = M / BM; nN = N / BM; nwg = nM * nN; G = G_; c = c_; }
    __host__ __device__ bool next(int i, Unit& u) const {
        const long L = (long)i * G + c; if (L >= nwg) return false;
        int wgid = (int)L; { const int q = nwg / NXCD, r = nwg % NXCD, xcd = wgid % NXCD, off = wgid / NXCD; wgid = (xcd < r ? xcd * (q + 1) : r * (q + 1) + (xcd - r) * q) + off; }
        const int nig = WGM * nN, gid = wgid / nig, fm = gid * WGM, gsz = (nM - fm) < WGM ? (nM - fm) : WGM;
        u.pm = fm + ((wgid % nig) % gsz); u.pn = (wgid % nig) / gsz; return true;
    }
    __device__ __forceinline__ void a_ready(const Unit&) const {}
    __device__ __forceinline__ void done(const Unit&) const {}
};
__device__ __forceinline__ unsigned cvt_pk_bf16(float lo, float hi) { unsigned r; asm volatile("v_cvt_pk_bf16_f32 %0, %1, %2" : "=v"(r) : "v"(lo), "v"(hi)); return r; }
typedef float f32x2 __attribute__((ext_vector_type(2)));
template <class Epi, class Sched, bool ALIGN_EPI = false, bool SP2 = false, bool GATHER = false, bool F8 = false>
__device__ __forceinline__ void gemm_phase(PG8_LAS unsigned char* lds, const Gemm g, const Sched& S, const Epi& E) {
    typedef int i32x4_t __attribute__((ext_vector_type(4)));
    const int tid = threadIdx.x, wid = __builtin_amdgcn_readfirstlane(tid >> 6), lane = tid & 63, wr = wid >> 2, wc = wid & 3, fr = lane & 15, fq = lane >> 4;
    const int K = g.K, nt = K / BK;
    unsigned voffA[2], voffB[2];
#pragma unroll
    for (int i = 0; i < 2; ++i) { int R, C; stage_rc(tid * 16 + i * 8192, R, C); const int Rb = Epi::PERM ? ((R & ~31) + perm32(R & 31)) : R;
        voffA[i] = (unsigned)(R * K + C) * 2u; voffB[i] = (unsigned)(Rb * K + C) * 2u; }
    const size_t kstep = (size_t)(BK * 2);
    const size_t hstep = (size_t)HALF * K * 2;
    const size_t tstep = 2 * hstep;
    const unsigned ldsw = (unsigned)wid * 1024u;
    const int aoff = lds_byte(wr * 64 + fr, fq * 8), boff = lds_byte(wc * 32 + fr, fq * 8);
#define PG8_SA(b, h) (((b) * 2 + (h)) * HTB)
#define PG8_SB(b, h) ((4 + (b) * 2 + (h)) * HTB)
#define PG8_UNI(p) ((const char*)(((unsigned long long)(unsigned)__builtin_amdgcn_readfirstlane((int)((unsigned long long)(p) >> 32)) << 32) | (unsigned long long)(unsigned)__builtin_amdgcn_readfirstlane((int)(unsigned long long)(p))))
#define PG8_STAGE(bufoff, gbase, voff) do { const char* gb_ = PG8_UNI(gbase);     \
        _Pragma("unroll") for (int _i = 0; _i < 2; ++_i) \
        __builtin_amdgcn_global_load_lds((const unsigned*)(gb_ + (voff)[_i]), (PG8_LAS unsigned*)(lds + (bufoff) + ldsw + _i * 8192), 16, 0, 0); } while (0)
#define PG8_STAGE_A(bufoff, kptr, h) do { if constexpr (GATHER) { PG8_STAGE(bufoff, kptr, vA[h]); } else { PG8_STAGE(bufoff, (kptr) + (h) * hstep, voffA); } } while (0)
#define PG8_GATHER_SWITCH() do { if constexpr (GATHER) { if (last && has_next) { asm volatile("" : "+v"(nv[0]), "+v"(nv[1]), "+v"(nv[2]), "+v"(nv[3])); \
        vA[0][0] = nv[0] * (unsigned)(K * 2) + gcoff[0]; vA[0][1] = nv[1] * (unsigned)(K * 2) + gcoff[1]; vA[1][0] = nv[2] * (unsigned)(K * 2) + gcoff[0]; vA[1][1] = nv[3] * (unsigned)(K * 2) + gcoff[1]; } } } while (0)
#define PG8_LDA(dst, b, h) do { _Pragma("unroll") for (int m = 0; m < 4; ++m) { if constexpr (F8) { dst##8[m] = PG8_CAT8(*(const PG8_LAS i32x4_t*)(lds + PG8_SA(b, h) + aoff + m * 2048), *(const PG8_LAS i32x4_t*)(lds + PG8_SA(b, h) + aoff + m * 2048 + 1024)); } \
        else { _Pragma("unroll") for (int k = 0; k < 2; ++k) dst[m][k] = *(const PG8_LAS bf16x8*)(lds + PG8_SA(b, h) + aoff + m * 2048 + k * 1024); } } } while (0)
#define PG8_LDB(dst, b, h) do { _Pragma("unroll") for (int n = 0; n < 2; ++n) { if constexpr (F8) { dst##8[n] = PG8_CAT8(*(const PG8_LAS i32x4_t*)(lds + PG8_SB(b, h) + boff + n * 2048), *(const PG8_LAS i32x4_t*)(lds + PG8_SB(b, h) + boff + n * 2048 + 1024)); } \
        else { _Pragma("unroll") for (int k = 0; k < 2; ++k) dst[n][k] = *(const PG8_LAS bf16x8*)(lds + PG8_SB(b, h) + boff + n * 2048 + k * 1024); } } } while (0)
#define PG8_CAT8(lo_, hi_) __builtin_shufflevector(lo_, hi_, 0, 1, 2, 3, 4, 5, 6, 7)
#define PG8_MMA(ai, bj, At, Bt) do { __builtin_amdgcn_s_setprio(1); _Pragma("unroll") for (int m = 0; m < 4; ++m) _Pragma("unroll") for (int n = 0; n < 2; ++n) { \
        if constexpr (F8) { acc[ai][bj][m][n] = __builtin_amdgcn_mfma_scale_f32_16x16x128_f8f6f4(Bt##8[n], At##8[m], acc[ai][bj][m][n], 0, 0, 0, 0x7f7f7f7f, 0, 0x7f7f7f7f); } \
        else { _Pragma("unroll") for (int k = 0; k < 2; ++k) acc[ai][bj][m][n] = __builtin_amdgcn_mfma_f32_16x16x32_bf16(Bt[n][k], At[m][k], acc[ai][bj][m][n], 0, 0, 0); } } \
        __builtin_amdgcn_s_setprio(0); } while (0)
#define PG8_WAIT_V(n) asm volatile("s_waitcnt vmcnt(" #n ")" ::: "memory")
#define PG8_WAIT_L(n) asm volatile("s_waitcnt lgkmcnt(" #n ")" ::: "memory")
#define PG8_BAR __builtin_amdgcn_s_barrier()
#define PG8_SCHED __builtin_amdgcn_sched_barrier(0)
    Unit cur, nxt; int ui = 0;
    if (!S.next(0, cur)) return;
    f32x4 acc[2][2][4][2];
#pragma unroll
    for (int a = 0; a < 2; ++a)
#pragma unroll
        for (int b = 0; b < 2; ++b)
#pragma unroll
            for (int m = 0; m < 4; ++m)
#pragma unroll
                for (int n = 0; n < 2; ++n) acc[a][b][m][n] = (f32x4){0.f, 0.f, 0.f, 0.f};
    bf16x8 At[4][2], B0[2][2], B1[2][2]; typedef int i32x8_t __attribute__((ext_vector_type(8))); i32x8_t At8[4], B08[2], B18[2];
    const char* cA = (const char*)g.A + (GATHER ? (size_t)0 : (size_t)cur.pm * tstep); const char* cB = (const char*)g.Bt + (size_t)cur.pn * tstep;
    unsigned vA[2][2], nv[4], gcoff[2]; int grow[2];
    if constexpr (GATHER) {
#pragma unroll
        for (int i = 0; i < 2; ++i) { int R, C; stage_rc(tid * 16 + i * 8192, R, C); grow[i] = R; gcoff[i] = (unsigned)(C * 2); }
#pragma unroll
        for (int h = 0; h < 2; ++h)
#pragma unroll
            for (int i = 0; i < 2; ++i) vA[h][i] = (unsigned)g.rows[cur.pm * BM + h * HALF + grow[i]] * (unsigned)(K * 2) + gcoff[i];
    }
    S.a_ready(cur);
    if constexpr (SP2) {
        PG8_STAGE(PG8_SB(0, 0), cB, voffB); PG8_STAGE(PG8_SB(0, 1), cB + hstep, voffB); PG8_STAGE_A(PG8_SA(0, 0), cA, 0); PG8_STAGE_A(PG8_SA(0, 1), cA, 1);
        if (wr == 1) PG8_BAR;
        PG8_WAIT_V(2); PG8_BAR;
        PG8_STAGE(PG8_SB(1, 0), cB + kstep, voffB); PG8_STAGE_A(PG8_SA(1, 0), cA + kstep, 0); PG8_STAGE(PG8_SB(1, 1), cB + hstep + kstep, voffB);
        PG8_WAIT_V(6); PG8_BAR;
    } else {
        PG8_STAGE(PG8_SB(0, 0), cB, voffB); PG8_STAGE_A(PG8_SA(0, 0), cA, 0); PG8_STAGE(PG8_SB(0, 1), cB + hstep, voffB); PG8_STAGE_A(PG8_SA(0, 1), cA, 1);
        if (wr == 1) PG8_BAR;
        PG8_WAIT_V(4); PG8_BAR;
        PG8_STAGE(PG8_SB(1, 0), cB + kstep, voffB); PG8_STAGE_A(PG8_SA(1, 0), cA + kstep, 0); PG8_STAGE(PG8_SB(1, 1), cB + hstep + kstep, voffB);
        PG8_WAIT_V(6); PG8_BAR;
    }
    for (;;) {
        const bool has_next = S.next(ui + 1, nxt);
        const char* nA = (has_next && !GATHER) ? (const char*)g.A + (size_t)nxt.pm * tstep : cA; const char* nB = has_next ? (const char*)g.Bt + (size_t)nxt.pn * tstep : cB;
        if constexpr (GATHER) { if (has_next) { const int* rp = g.rows + nxt.pm * BM;
            asm volatile("global_load_dword %0, %1, off" : "=&v"(nv[0]) : "v"(rp + grow[0]) : "memory"); asm volatile("global_load_dword %0, %1, off" : "=&v"(nv[1]) : "v"(rp + grow[1]) : "memory");
            asm volatile("global_load_dword %0, %1, off" : "=&v"(nv[2]) : "v"(rp + HALF + grow[0]) : "memory"); asm volatile("global_load_dword %0, %1, off" : "=&v"(nv[3]) : "v"(rp + HALF + grow[1]) : "memory"); } }
#pragma unroll 1
        for (int t = 0; t < nt; t += 2) {
            const bool last = (t == nt - 2);
            const char* a1 = cA + (size_t)(t + 1) * kstep;
            const char* a2 = last ? nA : cA + (size_t)(t + 2) * kstep; const char* b2 = last ? nB : cB + (size_t)(t + 2) * kstep;
            const char* a3 = a2 + kstep; const char* b3 = b2 + kstep;
            if (last && has_next) S.a_ready(nxt);
            if constexpr (SP2) {
            PG8_LDB(B0, 0, 0); PG8_LDB(B1, 0, 1); PG8_SCHED; PG8_LDA(At, 0, 0); PG8_STAGE_A(PG8_SA(1, 1), a1, 1); PG8_GATHER_SWITCH();
            PG8_WAIT_V(8); PG8_WAIT_L(0); PG8_BAR; PG8_MMA(0, 0, At, B0); PG8_MMA(0, 1, At, B1); PG8_BAR; PG8_SCHED;
            PG8_LDA(At, 0, 1); PG8_STAGE(PG8_SB(0, 0), b2, voffB); PG8_STAGE(PG8_SB(0, 1), b2 + hstep, voffB); PG8_STAGE_A(PG8_SA(0, 0), a2, 0);
            PG8_WAIT_V(8); PG8_WAIT_L(0); PG8_BAR; PG8_MMA(1, 0, At, B0); PG8_MMA(1, 1, At, B1); PG8_BAR; PG8_SCHED;
            PG8_LDB(B0, 1, 0); PG8_LDB(B1, 1, 1); PG8_SCHED; PG8_LDA(At, 1, 0); PG8_STAGE_A(PG8_SA(0, 1), a2, 1);
            PG8_WAIT_V(8); PG8_WAIT_L(0); PG8_BAR; PG8_MMA(0, 0, At, B0); PG8_MMA(0, 1, At, B1); PG8_BAR; PG8_SCHED;
            PG8_LDA(At, 1, 1); PG8_STAGE(PG8_SB(1, 0), b3, voffB); PG8_STAGE(PG8_SB(1, 1), b3 + hstep, voffB); PG8_STAGE_A(PG8_SA(1, 0), a3, 0);
            PG8_WAIT_V(8); PG8_WAIT_L(0); PG8_BAR; PG8_MMA(1, 0, At, B0); PG8_MMA(1, 1, At, B1); PG8_BAR; PG8_SCHED;
            } else {
            PG8_LDB(B0, 0, 0); PG8_SCHED; PG8_LDA(At, 0, 0); PG8_STAGE_A(PG8_SA(1, 1), a1, 1); PG8_GATHER_SWITCH();
            PG8_WAIT_L(8); PG8_BAR; PG8_WAIT_L(0); PG8_MMA(0, 0, At, B0); PG8_BAR; PG8_SCHED;
            PG8_LDB(B1, 0, 1); PG8_STAGE(PG8_SB(0, 0), b2, voffB);
            PG8_BAR; PG8_WAIT_L(0); PG8_MMA(0, 1, At, B1); PG8_BAR;
            PG8_LDA(At, 0, 1); PG8_STAGE_A(PG8_SA(0, 0), a2, 0);
            PG8_BAR; PG8_WAIT_L(0); PG8_MMA(1, 0, At, B0); PG8_BAR; PG8_SCHED;
            PG8_STAGE(PG8_SB(0, 1), b2 + hstep, voffB);
            PG8_WAIT_V(6); PG8_BAR; PG8_MMA(1, 1, At, B1); PG8_BAR;
            PG8_LDB(B0, 1, 0); PG8_SCHED; PG8_LDA(At, 1, 0); PG8_STAGE_A(PG8_SA(0, 1), a2, 1);
            PG8_WAIT_L(8); PG8_BAR; PG8_WAIT_L(0); PG8_MMA(0, 0, At, B0); PG8_BAR; PG8_SCHED;
            PG8_LDB(B1, 1, 1); PG8_STAGE(PG8_SB(1, 0), b3, voffB);
            PG8_BAR; PG8_WAIT_L(0); PG8_MMA(0, 1, At, B1); PG8_BAR;
            PG8_LDA(At, 1, 1); PG8_STAGE_A(PG8_SA(1, 0), a3, 0);
            PG8_BAR; PG8_WAIT_L(0); PG8_MMA(1, 0, At, B0); PG8_BAR; PG8_SCHED;
            PG8_STAGE(PG8_SB(1, 1), b3 + hstep, voffB);
            PG8_WAIT_V(6); PG8_BAR; PG8_MMA(1, 1, At, B1); PG8_BAR;
            }
        }
        if constexpr (ALIGN_EPI) { if (wr == 0) PG8_BAR; }
        if constexpr (!Epi::AFTER_DRAIN) { E(acc, cur, wr, wc, fr, fq); S.done(cur); }
        if (!has_next) break;
#pragma unroll
        for (int a = 0; a < 2; ++a)
#pragma unroll
            for (int b = 0; b < 2; ++b)
#pragma unroll
                for (int m = 0; m < 4; ++m)
#pragma unroll
                    for (int n = 0; n < 2; ++n) acc[a][b][m][n] = (f32x4){0.f, 0.f, 0.f, 0.f};
        cur = nxt; cA = nA; cB = nB; ++ui;
        if constexpr (ALIGN_EPI) { if (wr == 1) PG8_BAR; }
    }
    PG8_WAIT_V(0);
    if constexpr (!ALIGN_EPI) { if (wr == 0) PG8_BAR; }
    PG8_BAR;
    if constexpr (Epi::AFTER_DRAIN) { E.fused(acc, cur, wr, wc, fr, fq, lds, wid, lane); S.done(cur); }
#undef PG8_SA
#undef PG8_SB
#undef PG8_STAGE
#undef PG8_UNI
#undef PG8_STAGE_A
#undef PG8_GATHER_SWITCH
#undef PG8_LDA
#undef PG8_LDB
#undef PG8_MMA
#undef PG8_CAT8
#undef PG8_WAIT_V
#undef PG8_WAIT_L
#undef PG8_BAR
#undef PG8_SCHED
}
}

constexpr int DM = 2048, NB = 8, SEQ = 2048, CTXL = 256, NH = 16, NKV = 4, HD = 128;
constexpr int ML = NB * SEQ;
constexpr int MC = NB * CTXL;
constexpr int MT = ML + MC;
constexpr int NE = 16, CAPL = 256, CAPC = 32, DFF = 1024;
constexpr int YR = NB * CAPL + NB * CAPC;
constexpr int YT = NE * YR;
constexpr int NMOD = 6 * DM;
constexpr float NORM_EPS = 1e-6f;
constexpr int KSPLIT = 16;

using pg8::Unit; using pg8::f32x4; using pg8::u32x4; using pg8::bf16_t; using pg8::bf16x8; using pg8::cvt_pk_bf16;
typedef float f32x2 __attribute__((ext_vector_type(2)));
typedef unsigned u32x2 __attribute__((ext_vector_type(2)));
typedef float f32x16 __attribute__((ext_vector_type(16)));
typedef short s16x4 __attribute__((ext_vector_type(4)));
#define DI __device__ __forceinline__

DI float bf_lo(unsigned w) { return __uint_as_float(w << 16); }
DI float bf_hi(unsigned w) { return __uint_as_float(w & 0xffff0000u); }
DI unsigned pk4_fp8(float a, float b, float c, float d) {
    a = __builtin_amdgcn_fmed3f(a, -448.0f, 448.0f); b = __builtin_amdgcn_fmed3f(b, -448.0f, 448.0f); c = __builtin_amdgcn_fmed3f(c, -448.0f, 448.0f); d = __builtin_amdgcn_fmed3f(d, -448.0f, 448.0f);
    int w = __builtin_amdgcn_cvt_pk_fp8_f32(a, b, 0, false); w = __builtin_amdgcn_cvt_pk_fp8_f32(c, d, w, true); return (unsigned)w;
}
constexpr float Y8_SCALE = 64.0f, Y8_INV = 1.0f / 64.0f;
constexpr float W8_SCALE = 32.0f, W8_INV = 1.0f / 32.0f;
DI f32x4 unpk4_fp8(unsigned w) { const f32x2 lo = __builtin_amdgcn_cvt_pk_f32_fp8((int)w, false), hi = __builtin_amdgcn_cvt_pk_f32_fp8((int)w, true); return (f32x4){lo.x, lo.y, hi.x, hi.y}; }
DI float silu_f(float a) { return a * __builtin_amdgcn_rcpf(1.0f + __expf(-a)); }

DI int xcd_remap(int wgid, int nwg) { const int q = nwg / 8, r = nwg % 8, xcd = wgid % 8, off = wgid / 8; return (xcd < r ? xcd * (q + 1) : r * (q + 1) + (xcd - r) * q) + off; }
struct QkvOrder {
    int G, c;
    DI bool next(int i, Unit& u) const {
        const int L = i * G + c; if (L >= 800) return false;
        if (L < 768) { const int w = xcd_remap(L, 768); const int nig = 8 * 12, gid = w / nig; u.pm = gid * 8 + ((w % nig) % 8); u.pn = (w % nig) / 8; }
        else { const int j = L - 768; u.pm = 64 + (j >> 2); u.pn = 8 + (j & 3); }
        return true;
    }
    DI void a_ready(const Unit&) const {}
    DI void done(const Unit&) const {}
};
struct MoeOrder {
    int G, c, NP;
    DI bool next(int i, Unit& u) const {
        const int nwg = NE * NP * 8; const int L = i * G + c; if (L >= nwg) return false;
        const int w = xcd_remap(L, nwg); const int per = NP * 8, e = w / per, rem = w % per;
        u.pm = e * 9 + (rem % NP); u.pn = e * 8 + (rem / NP); return true;
    }
    DI void a_ready(const Unit&) const {}
    DI void done(const Unit&) const {}
};

template <int ACT  > struct EpiPair {
    static constexpr bool PERM = true, AFTER_DRAIN = false;
    bf16_t* O; int ldc; int pn_mod;
    DI void operator()(const f32x4 (&acc)[2][2][4][2], const Unit& u, int wr, int wc, int fr, int fq) const {
        const int row0 = u.pm * 256 + wr * 64 + fr, col0 = (u.pn % pn_mod) * 128 + wc * 32 + 8 * fq;
#pragma unroll
        for (int ai = 0; ai < 2; ++ai)
#pragma unroll
            for (int m = 0; m < 4; ++m) {
                bf16_t* rowp = O + (size_t)(row0 + ai * 128 + m * 16) * ldc + col0;
                f32x4 a0 = acc[ai][0][m][0], a1 = acc[ai][0][m][1]; const f32x4 b0 = acc[ai][1][m][0], b1 = acc[ai][1][m][1];
                if (ACT == 1) {
#pragma unroll
                    for (int j = 0; j < 4; ++j) { a0[j] = silu_f(a0[j]); a1[j] = silu_f(a1[j]); } }
                const f32x4 v0 = a0 * b0, v1 = a1 * b1;
                u32x4 w; w.x = cvt_pk_bf16(v0[0], v0[1]); w.y = cvt_pk_bf16(v0[2], v0[3]); w.z = cvt_pk_bf16(v1[0], v1[1]); w.w = cvt_pk_bf16(v1[2], v1[3]);
                *(u32x4*)rowp = w;
            }
    }
};
struct EpiPairF8 {
    static constexpr bool PERM = true, AFTER_DRAIN = false;
    unsigned char* O; int ldc; int pn_mod;
    DI void operator()(const f32x4 (&acc)[2][2][4][2], const Unit& u, int wr, int wc, int fr, int fq) const {
        const int row0 = u.pm * 256 + wr * 64 + fr, col0 = (u.pn % pn_mod) * 128 + wc * 32 + 8 * fq;
#pragma unroll
        for (int ai = 0; ai < 2; ++ai)
#pragma unroll
            for (int m = 0; m < 4; ++m) {
                unsigned char* rowp = O + (size_t)(row0 + ai * 128 + m * 16) * ldc + col0;
                f32x4 a0 = acc[ai][0][m][0] * W8_INV, a1 = acc[ai][0][m][1] * W8_INV; const f32x4 b0 = acc[ai][1][m][0] * W8_INV, b1 = acc[ai][1][m][1] * W8_INV;
#pragma unroll
                for (int j = 0; j < 4; ++j) { a0[j] = silu_f(a0[j]); a1[j] = silu_f(a1[j]); }
                const f32x4 v0 = a0 * b0, v1 = a1 * b1;
                u32x2 w; w.x = pk4_fp8(v0[0], v0[1], v0[2], v0[3]); w.y = pk4_fp8(v1[0], v1[1], v1[2], v1[3]);
                *(u32x2*)rowp = w;
            }
    }
};
struct EpiConvGate {
    static constexpr bool PERM = true, AFTER_DRAIN = false;
    const bf16_t* U; bf16_t* Z; const float* cw;
    DI void operator()(const f32x4 (&acc)[2][2][4][2], const Unit& u, int wr, int wc, int fr, int fq) const {
        const int row0 = u.pm * 256 + wr * 64 + fr, col0 = u.pn * 256 + wc * 32 + 8 * fq;
#pragma unroll
        for (int bj = 0; bj < 2; ++bj) {
            const int c = col0 + bj * 128;
            f32x4 w0a = *(const f32x4*)(cw + c), w0b = *(const f32x4*)(cw + c + 4), w1a = *(const f32x4*)(cw + 2048 + c), w1b = *(const f32x4*)(cw + 2048 + c + 4), w2a = *(const f32x4*)(cw + 4096 + c), w2b = *(const f32x4*)(cw + 4096 + c + 4);
#pragma unroll
            for (int ai = 0; ai < 2; ++ai)
#pragma unroll
                for (int m = 0; m < 4; ++m) {
                    const int row = row0 + ai * 128 + m * 16;
                    const int tpos = row < ML ? (row & (SEQ - 1)) : ((row - ML) & (CTXL - 1)); const int len = row < ML ? SEQ : CTXL;
                    const u32x4 z4 = (u32x4){0u, 0u, 0u, 0u};
                    const u32x4 uc = *(const u32x4*)(U + (size_t)row * DM + c);
                    const u32x4 up = tpos > 0 ? *(const u32x4*)(U + (size_t)(row - 1) * DM + c) : z4;
                    const u32x4 un = tpos < len - 1 ? *(const u32x4*)(U + (size_t)(row + 1) * DM + c) : z4;
                    f32x4 ya, yb;
                    ya[0] = w0a[0] * bf_lo(up.x) + w1a[0] * bf_lo(uc.x) + w2a[0] * bf_lo(un.x); ya[1] = w0a[1] * bf_hi(up.x) + w1a[1] * bf_hi(uc.x) + w2a[1] * bf_hi(un.x);
                    ya[2] = w0a[2] * bf_lo(up.y) + w1a[2] * bf_lo(uc.y) + w2a[2] * bf_lo(un.y); ya[3] = w0a[3] * bf_hi(up.y) + w1a[3] * bf_hi(uc.y) + w2a[3] * bf_hi(un.y);
                    yb[0] = w0b[0] * bf_lo(up.z) + w1b[0] * bf_lo(uc.z) + w2b[0] * bf_lo(un.z); yb[1] = w0b[1] * bf_hi(up.z) + w1b[1] * bf_hi(uc.z) + w2b[1] * bf_hi(un.z);
                    yb[2] = w0b[2] * bf_lo(up.w) + w1b[2] * bf_lo(uc.w) + w2b[2] * bf_lo(un.w); yb[3] = w0b[3] * bf_hi(up.w) + w1b[3] * bf_hi(uc.w) + w2b[3] * bf_hi(un.w);
                    const f32x4 v0 = acc[ai][bj][m][0] * ya, v1 = acc[ai][bj][m][1] * yb;
                    u32x4 w; w.x = cvt_pk_bf16(v0[0], v0[1]); w.y = cvt_pk_bf16(v0[2], v0[3]); w.z = cvt_pk_bf16(v1[0], v1[1]); w.w = cvt_pk_bf16(v1[2], v1[3]);
                    *(u32x4*)(Z + (size_t)row * DM + c) = w;
                }
        }
    }
};
template <bool BASE_F32> struct EpiResid {
    static constexpr bool PERM = true, AFTER_DRAIN = false;
    const float* base_lat; const float* base_ctx; bf16_t* out; const float* gate; float ws;
    DI void operator()(const f32x4 (&acc)[2][2][4][2], const Unit& u, int wr, int wc, int fr, int fq) const {
        const int rowt = u.pm * 256; const int cr = rowt < ML ? (rowt >> 11) : 8;
        const float* base = rowt < ML ? base_lat : base_ctx - (size_t)ML * DM;
        const int row0 = rowt + wr * 64 + fr, col0 = u.pn * 256 + wc * 32 + 8 * fq;
        f32x4 gv[2][2];
#pragma unroll
        for (int bj = 0; bj < 2; ++bj)
#pragma unroll
            for (int n = 0; n < 2; ++n) gv[bj][n] = *(const f32x4*)(gate + (size_t)cr * NMOD + col0 + bj * 128 + n * 4) * ws;
#pragma unroll
        for (int ai = 0; ai < 2; ++ai)
#pragma unroll
            for (int m = 0; m < 4; ++m) { const size_t off = (size_t)(row0 + ai * 128 + m * 16) * DM + col0;
#pragma unroll
                for (int bj = 0; bj < 2; ++bj) { f32x4 b0, b1;
                    if (BASE_F32) { b0 = *(const f32x4*)(base + off + bj * 128); b1 = *(const f32x4*)(base + off + bj * 128 + 4); }
                    else { const u32x4 hb = *(const u32x4*)(out + off + bj * 128); b0 = (f32x4){bf_lo(hb.x), bf_hi(hb.x), bf_lo(hb.y), bf_hi(hb.y)}; b1 = (f32x4){bf_lo(hb.z), bf_hi(hb.z), bf_lo(hb.w), bf_hi(hb.w)}; }
                    const f32x4 v0 = b0 + gv[bj][0] * acc[ai][bj][m][0], v1 = b1 + gv[bj][1] * acc[ai][bj][m][1];
                    u32x4 w; w.x = cvt_pk_bf16(v0[0], v0[1]); w.y = cvt_pk_bf16(v0[2], v0[3]); w.z = cvt_pk_bf16(v1[0], v1[1]); w.w = cvt_pk_bf16(v1[2], v1[3]);
                    *(u32x4*)(out + off + bj * 128) = w; }
                asm volatile("" ::: "memory"); }
    }
};
struct EpiDown {
    static constexpr bool PERM = true, AFTER_DRAIN = false;
    bf16_t* Y; const float* gatev; float ws;
    DI void operator()(const f32x4 (&acc)[2][2][4][2], const Unit& u, int wr, int wc, int fr, int fq) const {
        const int row0 = u.pm * 256 + wr * 64 + fr, col0 = (u.pn & 7) * 256 + wc * 32 + 8 * fq;
#pragma unroll
        for (int ai = 0; ai < 2; ++ai)
#pragma unroll
            for (int m = 0; m < 4; ++m) { const int row = row0 + ai * 128 + m * 16; const float gt = gatev[row] * ws;
#pragma unroll
                for (int bj = 0; bj < 2; ++bj) { const f32x4 v0 = acc[ai][bj][m][0] * gt, v1 = acc[ai][bj][m][1] * gt;
                    u32x2 w; w.x = pk4_fp8(v0[0], v0[1], v0[2], v0[3]); w.y = pk4_fp8(v1[0], v1[1], v1[2], v1[3]);
                    *(u32x2*)((unsigned char*)Y + (size_t)row * DM + col0 + bj * 128) = w; } }
    }
};
#define LAS3 __attribute__((address_space(3)))
struct EpiQkvNorm {
    static constexpr bool PERM = true, AFTER_DRAIN = false;
    bf16_t* Q; bf16_t* K; bf16_t* V; const float* qg; const float* kg; LAS3 float* P; float ws;
    DI void operator()(const f32x4 (&acc)[2][2][4][2], const Unit& u, int wr, int wc, int fr, int fq) const {
        const int row0 = u.pm * 256 + wr * 64 + fr; int colt = u.pn * 256;
        if (colt >= 2560) {
            const int col0 = colt - 2560 + wc * 32 + 8 * fq;
#pragma unroll
            for (int ai = 0; ai < 2; ++ai)
#pragma unroll
                for (int m = 0; m < 4; ++m) { bf16_t* rowp = V + (size_t)(row0 + ai * 128 + m * 16) * 512 + col0;
#pragma unroll
                    for (int bj = 0; bj < 2; ++bj) { const f32x4 v0 = acc[ai][bj][m][0] * ws, v1 = acc[ai][bj][m][1] * ws;
                        u32x4 w; w.x = cvt_pk_bf16(v0[0], v0[1]); w.y = cvt_pk_bf16(v0[2], v0[3]); w.z = cvt_pk_bf16(v1[0], v1[1]); w.w = cvt_pk_bf16(v1[2], v1[3]);
                        *(u32x4*)(rowp + bj * 128) = w; } }
            return;
        }
        const bool isq = colt < 2048; bf16_t* base = isq ? Q : K; const int ld = isq ? 2048 : 512; if (!isq) colt -= 2048;
        const int rl0 = wr * 64 + fr;
#pragma unroll
        for (int ai = 0; ai < 2; ++ai)
#pragma unroll
            for (int m = 0; m < 4; ++m)
#pragma unroll
                for (int bj = 0; bj < 2; ++bj) { const f32x4 a = acc[ai][bj][m][0], b = acc[ai][bj][m][1];
                    float s = (a[0] * a[0] + a[1] * a[1]) + (a[2] * a[2] + a[3] * a[3]) + (b[0] * b[0] + b[1] * b[1]) + (b[2] * b[2] + b[3] * b[3]);
                    s += __shfl_xor(s, 16); s += __shfl_xor(s, 32);
                    if (fq == 0) P[((ai * 128 + m * 16 + rl0) * 2 + bj) * 4 + wc] = s; }
        asm volatile("s_waitcnt lgkmcnt(0)" ::: "memory"); __builtin_amdgcn_s_barrier(); asm volatile("" ::: "memory");
        constexpr float QSCALE = 0.08838834764831845f * 1.4426950408889634f;
        const int i0 = 16 * (wc & 1) + 4 * fq, d0 = 64 * (wc >> 1) + i0;
        const float* gp = isq ? qg : kg; f32x4 g0 = *(const f32x4*)(gp + d0), g1 = *(const f32x4*)(gp + d0 + 32);
        if (isq) { g0 = g0 * QSCALE; g1 = g1 * QSCALE; }
        f32x4 ifr;
#pragma unroll
        for (int j = 0; j < 4; ++j) ifr[j] = exp2f(-(float)(i0 + j) * (13.287712379549449f / 32.0f));
        const bool lat = u.pm < 64;
#pragma unroll
        for (int ai = 0; ai < 2; ++ai)
#pragma unroll
            for (int m = 0; m < 4; ++m) { const int row = row0 + ai * 128 + m * 16; const int t = row & (SEQ - 1);
                const float pos = (float)((wc >> 1) == 0 ? (t >> 6) : (t & 63));
                f32x4 cs, sn;
#pragma unroll
                for (int j = 0; j < 4; ++j) { const float ang = pos * ifr[j]; cs[j] = lat ? __cosf(ang) : 1.0f; sn[j] = lat ? __sinf(ang) : 0.0f; }
#pragma unroll
                for (int bj = 0; bj < 2; ++bj) { const f32x4 pp = *(const LAS3 f32x4*)(P + ((ai * 128 + m * 16 + rl0) * 2 + bj) * 4);
                    const float rstd = ws / sqrtf(((pp[0] + pp[1]) + (pp[2] + pp[3])) * (ws * ws) * (1.0f / HD) + NORM_EPS);
                    const f32x4 a = acc[ai][bj][m][0] * rstd * g0, b = acc[ai][bj][m][1] * rstd * g1;
                    const f32x4 o1 = a * cs - b * sn, o2 = b * cs + a * sn;
                    u32x4 w; w.x = cvt_pk_bf16(o1[0], o1[1]); w.y = cvt_pk_bf16(o1[2], o1[3]); w.z = cvt_pk_bf16(o2[0], o2[1]); w.w = cvt_pk_bf16(o2[2], o2[3]);
                    *(u32x4*)(base + (size_t)row * ld + colt + bj * 128 + wc * 32 + 8 * fq) = w; } }
    }
};

constexpr size_t MiB = 1u << 20;
constexpr size_t WS_CTL = 0, CTL_ZERO_BYTES = 1 * MiB;
constexpr size_t WS_MOD = 1 * MiB;
constexpr size_t WS_MODP = 2 * MiB;
constexpr size_t WS_AFFL = 16 * MiB;
constexpr size_t WS_AFFC = 17 * MiB;
constexpr size_t WS_RWT = 17 * MiB + 128 * 1024;
constexpr size_t WS_IDMAP = 19 * MiB + 768 * 1024;
constexpr size_t WS_ROWSRC = 17 * MiB + 512 * 1024;
constexpr size_t WS_GATEV = 18 * MiB;
constexpr size_t WS_INV = 18 * MiB + 512 * 1024;
constexpr size_t WS_W1A = 20 * MiB;
constexpr size_t WS_W1B = 36 * MiB;
constexpr size_t WS_W2 = 44 * MiB;
constexpr size_t WS_WQKV = 52 * MiB;
constexpr size_t WS_WO = 64 * MiB;
constexpr size_t WS_WGU = 72 * MiB;
constexpr size_t WS_WDN = 328 * MiB;
constexpr size_t WS_H = 456 * MiB;
constexpr size_t WS_A = 600 * MiB;
constexpr size_t WS_U = 672 * MiB;
constexpr size_t WS_Z = 744 * MiB;
constexpr size_t WS_Q = WS_U, WS_K = WS_Z, WS_V = WS_Z + 18 * MiB;
constexpr size_t WS_HM = 816 * MiB;
constexpr size_t WS_O = WS_HM;
constexpr size_t WS_Y = 888 * MiB;
constexpr size_t WS_END = 1032 * MiB;
constexpr int CW_BAR = 4096;

constexpr int RING_BYTES = 131072;
constexpr int MISC_OFF = RING_BYTES + 14336;
constexpr int LDS_BYTES = 147456;

#define GAS __attribute__((address_space(1)))
#define LAS __attribute__((address_space(3)))
#define LDS_WAIT() asm volatile("s_waitcnt lgkmcnt(0)" ::: "memory")
#define VM_WAIT() asm volatile("s_waitcnt vmcnt(0)" ::: "memory")
#define XB_TMO      128
#define XB_XCNT(j)  (256  + 64 * (j))
#define XB_XSUB(j)  (1280 + 64 * (j))
#define XB_XGEN(j)  (2304 + 64 * (j))
#define XB_TOP      3328
#define XB_TOPGEN   3392
#define XCD_BAR_WORDS 3456
#define XB_SPIN_CAP (1u << 18)

__device__ __forceinline__ unsigned xb_ld(unsigned* p)              { return __hip_atomic_load(p, __ATOMIC_RELAXED, __HIP_MEMORY_SCOPE_AGENT); }
__device__ __forceinline__ unsigned xb_add(unsigned* p, unsigned v) { return __hip_atomic_fetch_add(p, v, __ATOMIC_RELAXED, __HIP_MEMORY_SCOPE_AGENT); }
__device__ __forceinline__ unsigned xb_xcc_id() { return (unsigned)__builtin_amdgcn_s_getreg((3 << 11) | 20) & 0xFu; }
#define XB_SPIN(cond, bar) do { unsigned _sp = 0; while (cond) { __builtin_amdgcn_s_sleep(1); \
    if ((++_sp & 255u) == 0u) { if (xb_ld(&(bar)[XB_TMO])) break; if (_sp > XB_SPIN_CAP) { atomicAdd(&(bar)[XB_TMO], 1u); break; } } } } while (0)

struct XcdBarrier {
    unsigned* bar; unsigned x;
    volatile LAS unsigned* st;
};

__device__ __forceinline__ XcdBarrier xcd_barrier_post(unsigned* bar, volatile LAS unsigned* st) {
    XcdBarrier b; b.bar = bar; b.x = xb_xcc_id(); b.st = st;
    if (threadIdx.x == 0) (void)xb_add(&bar[XB_XCNT(b.x)], 1u);
    return b;
}
__device__ __forceinline__ void xcd_barrier_complete(unsigned* bar, unsigned x, unsigned& nloc, unsigned& nx) {
    const unsigned G = gridDim.x * gridDim.y * gridDim.z;
    unsigned sum, cnt, mine, sp = 0u;
    for (;;) {
        sum = 0u; cnt = 0u; mine = 0u;
#pragma unroll
        for (unsigned j = 0; j < 16; ++j) { const unsigned c = xb_ld(&bar[XB_XCNT(j)]); sum += c; cnt += (c > 0u) ? 1u : 0u; mine = (j == x) ? c : mine; }
        if (sum == G) break;
        __builtin_amdgcn_s_sleep(1);
        if ((++sp & 255u) == 0u) { if (xb_ld(&bar[XB_TMO])) break; if (sp > XB_SPIN_CAP) { atomicAdd(&bar[XB_TMO], 1u); break; } }
    }
    nloc = mine > 0u ? mine : 1u; nx = cnt > 0u ? cnt : 1u;
}

__device__ __forceinline__ void xcd_barrier(const XcdBarrier& b) {
    asm volatile("s_waitcnt vmcnt(0)" ::: "memory");
    __syncthreads();
    if (threadIdx.x == 0) {
        unsigned* bar = b.bar;
        __builtin_amdgcn_s_waitcnt(0);
        unsigned nloc = b.st[0], nx = b.st[1];
        if (nloc == 0u) { xcd_barrier_complete(bar, b.x, nloc, nx); b.st[0] = nloc; b.st[1] = nx; }
        const unsigned old = xb_add(&bar[XB_XSUB(b.x)], 1u);
        const unsigned gen = old / nloc;
        if (old + 1u == (gen + 1u) * nloc) {
            __builtin_amdgcn_fence(__ATOMIC_RELEASE, "agent");
            asm volatile("s_waitcnt vmcnt(0)" ::: "memory");
            const unsigned og = xb_add(&bar[XB_TOP], 1u);
            const unsigned tg = og / nx;
            if (og + 1u == (tg + 1u) * nx) xb_add(&bar[XB_TOPGEN], 1u);
            else XB_SPIN(xb_ld(&bar[XB_TOPGEN]) == tg, bar);
            __builtin_amdgcn_fence(__ATOMIC_ACQUIRE, "agent");
            xb_add(&bar[XB_XGEN(b.x)], 1u);
            asm volatile("s_waitcnt vmcnt(0)" ::: "memory");
        } else {
            XB_SPIN(xb_ld(&bar[XB_XGEN(b.x)]) == gen, bar);
            __builtin_amdgcn_fence(__ATOMIC_ACQUIRE, "agent");
            asm volatile("s_waitcnt vmcnt(0)" ::: "memory");
        }
    }
    __syncthreads();
}

DI float wave_sum(float v) {
#pragma unroll
    for (int o = 1; o < 64; o <<= 1) v += __shfl_xor(v, o);
    return v;
}
DI float rdlane(float v, int l) { return __uint_as_float((unsigned)__builtin_amdgcn_readlane((int)__float_as_uint(v), l)); }
DI unsigned pk2(float lo, float hi) { return cvt_pk_bf16(lo, hi); }

DI void ph_adaln(const float* cnd, const float* cctx, const float* ada_w, float* modp, int gw, int NGW, int lane) {
    for (int task = gw; task < 96 * KSPLIT; task += NGW) {
        const int ks = task & (KSPLIT - 1), cg = task / KSPLIT, l = cg / 48, cgl = cg % 48, col0 = cgl * 256 + lane * 4, k0 = ks * 128;
        float sv[9][2];
#pragma unroll
        for (int r = 0; r < 9; ++r)
#pragma unroll
            for (int hh = 0; hh < 2; ++hh) { const int k = k0 + hh * 64 + lane; const float v = r < 8 ? cnd[r * DM + k] : cctx[k]; sv[r][hh] = v / (1.0f + __expf(-v)); }
        f32x4 acc[9];
#pragma unroll
        for (int r = 0; r < 9; ++r) acc[r] = (f32x4){0.f, 0.f, 0.f, 0.f};
        const float* wp = ada_w + ((size_t)l * DM + k0) * NMOD + col0;
#pragma unroll
        for (int hh = 0; hh < 2; ++hh) {
#pragma unroll 8
            for (int kk = 0; kk < 64; ++kk) {
                const f32x4 w = *(const f32x4*)(wp + (size_t)(hh * 64 + kk) * NMOD);
#pragma unroll
                for (int r = 0; r < 9; ++r) { const float s = rdlane(sv[r][hh], kk); acc[r] += w * s; }
            }
        }
#pragma unroll
        for (int r = 0; r < 9; ++r) *(f32x4*)(modp + ((size_t)((ks * 2 + l) * 9 + r)) * NMOD + col0) = acc[r];
    }
}
struct CvtPtrs { const float *cin, *cout, *wqkv, *wo, *wg, *wu, *wd; bf16_t *W1A, *W1B, *W2, *WQKV, *WO, *WGU, *WDN; };
constexpr int CVT_E0 = 6656, CVT_L = 24576, CVT_TOTAL = CVT_E0 + 2 * CVT_L;
DI void cvt_resolve(const CvtPtrs& P, int it, const float*& src, int& ldw, bf16_t*& dst, int& ldd, bool& qperm, bool& f8) {
    int r = it; qperm = false; f8 = false;
    if (r < 3072) { const int kt = ((r >> 3) / 96) * 8 + (r & 7), nt = (r >> 3) % 96, n0 = nt * 64, part = n0 >> 11, j0 = n0 & 2047;
        src = P.cin + (size_t)(kt * 64) * 6144 + n0; ldw = 6144; ldd = DM;
        dst = (part == 0 ? P.W1B + (size_t)j0 * DM : P.W1A + (size_t)((j0 >> 7) * 256 + (part == 2 ? 128 : 0) + (j0 & 127)) * DM) + kt * 64; return; } r -= 3072;
    if (r < 1024) { const int kt = ((r >> 3) / 32) * 8 + (r & 7), nt = (r >> 3) % 32; src = P.cout + (size_t)(kt * 64) * DM + nt * 64; ldw = DM; dst = P.W2 + (size_t)(nt * 64) * DM + kt * 64; ldd = DM; return; } r -= 1024;
    if (r < 1536) { const int kt = ((r >> 3) / 48) * 8 + (r & 7), nt = (r >> 3) % 48; src = P.wqkv + (size_t)(kt * 64) * 3072 + nt * 64; ldw = 3072; qperm = nt < 40;     f8 = true; dst = (bf16_t*)((unsigned char*)P.WQKV + (size_t)(nt * 64) * DM + kt * 64); ldd = DM;     return; } r -= 1536;
    if (r < 1024) { const int kt = ((r >> 3) / 32) * 8 + (r & 7), nt = (r >> 3) % 32; src = P.wo + (size_t)(kt * 64) * DM + nt * 64; ldw = DM; f8 = true;
        dst = (bf16_t*)((unsigned char*)P.WO + (size_t)(nt * 64) * DM + kt * 64); ldd = DM; return; } r -= 1024;
    const int l = r / CVT_L, rr = r % CVT_L, kind = rr / 8192, q = rr % 8192, le = l * 16 + q / 512, rem = q % 512;
    f8 = true;
    if (kind < 2) { const int kt = ((rem >> 3) / 16) * 8 + (rem & 7), nt = (rem >> 3) % 16, n0 = nt * 64;
        src = (kind ? P.wu : P.wg) + (size_t)le * DM * DFF + (size_t)(kt * 64) * DFF + n0; ldw = DFF;
        dst = (bf16_t*)((unsigned char*)P.WGU + (size_t)(le * 2048 + (n0 >> 7) * 256 + kind * 128 + (n0 & 127)) * DM + kt * 64); ldd = DM; }
    else { const int kt = ((rem >> 3) / 32) * 8 + (rem & 7), nt = (rem >> 3) % 32;
        src = P.wd + (size_t)le * DFF * DM + (size_t)(kt * 64) * DM + nt * 64; ldw = DM; dst = (bf16_t*)((unsigned char*)P.WDN + (size_t)(le * 2048 + nt * 64) * DFF + kt * 64); ldd = DFF; }
}
constexpr int CVT_P = 36;
DI void cvt_range(const CvtPtrs& P, int lo, int hi, int w, int NW, LAS unsigned* scr, int lane) {
    int it = lo + w; if (it >= hi) return;
    const int c = lane & 15, q = lane >> 4;
    const float* src; int ldw; bf16_t* dst; int ldd; bool qperm, f8; cvt_resolve(P, it, src, ldw, dst, ldd, qperm, f8);
    f32x4 v[16];
#pragma unroll
    for (int rr = 0; rr < 16; ++rr) v[rr] = __builtin_nontemporal_load((const f32x4*)(src + (size_t)(16 * q + rr) * ldw + 4 * c));
    for (;;) {
        const bool cf8 = f8; const int wrow = qperm ? 32 * ((c >> 2) & 1) + 8 * (c & 3) + 4 * (c >> 3) : 4 * c;
        u32x4 pa[4], pb[4];
        if (cf8) {
#pragma unroll
            for (int i = 0; i < 4; ++i) { pa[i].x = pk4_fp8(v[0][i] * W8_SCALE, v[1][i] * W8_SCALE, v[2][i] * W8_SCALE, v[3][i] * W8_SCALE); pa[i].y = pk4_fp8(v[4][i] * W8_SCALE, v[5][i] * W8_SCALE, v[6][i] * W8_SCALE, v[7][i] * W8_SCALE);
                                          pa[i].z = pk4_fp8(v[8][i] * W8_SCALE, v[9][i] * W8_SCALE, v[10][i] * W8_SCALE, v[11][i] * W8_SCALE); pa[i].w = pk4_fp8(v[12][i] * W8_SCALE, v[13][i] * W8_SCALE, v[14][i] * W8_SCALE, v[15][i] * W8_SCALE); pb[i] = pa[i]; }
        } else {
#pragma unroll
            for (int i = 0; i < 4; ++i) { pa[i].x = pk2(v[0][i], v[1][i]); pa[i].y = pk2(v[2][i], v[3][i]); pa[i].z = pk2(v[4][i], v[5][i]); pa[i].w = pk2(v[6][i], v[7][i]);
                                          pb[i].x = pk2(v[8][i], v[9][i]); pb[i].y = pk2(v[10][i], v[11][i]); pb[i].z = pk2(v[12][i], v[13][i]); pb[i].w = pk2(v[14][i], v[15][i]); }
        }
        const int nit = it + NW; bf16_t* cdst = dst; const int cldd = ldd;
        if (nit < hi) { cvt_resolve(P, nit, src, ldw, dst, ldd, qperm, f8);
#pragma unroll
            for (int rr = 0; rr < 16; ++rr) v[rr] = __builtin_nontemporal_load((const f32x4*)(src + (size_t)(16 * q + rr) * ldw + 4 * c)); }
        if (cf8) {
#pragma unroll
            for (int i = 0; i < 4; ++i) *(LAS u32x4*)(scr + (wrow + i) * 20 + 4 * q) = pa[i];
            LDS_WAIT(); asm volatile("" ::: "memory");
#pragma unroll
            for (int j = 0; j < 4; ++j) { const int ch = lane + 64 * j, n = ch >> 2, part = ch & 3; const u32x4 o = *(const LAS u32x4*)(scr + n * 20 + 4 * part);
                *(u32x4*)((unsigned char*)cdst + (size_t)n * cldd + 16 * part) = o; }
        } else {
#pragma unroll
            for (int i = 0; i < 4; ++i) { *(LAS u32x4*)(scr + (wrow + i) * CVT_P + 8 * q) = pa[i]; *(LAS u32x4*)(scr + (wrow + i) * CVT_P + 8 * q + 4) = pb[i]; }
            LDS_WAIT(); asm volatile("" ::: "memory");
#pragma unroll
            for (int j = 0; j < 8; ++j) { const int n = (lane >> 3) + 8 * j; const u32x4 o = *(const LAS u32x4*)(scr + n * CVT_P + 4 * (lane & 7));
                *(u32x4*)(cdst + (size_t)n * cldd + 8 * (lane & 7)) = o; }
        }
        LDS_WAIT(); asm volatile("" ::: "memory");
        if (nit >= hi) break;
        it = nit;
    }
}
DI void ph_modred(const float* modp, const float* ada_b, float* mod, int gtid, int GT) {
    for (int i = gtid; i < 2 * 9 * NMOD; i += GT) { const int l = i / (9 * NMOD), j = i % NMOD; float s = ada_b[l * NMOD + j];
#pragma unroll
        for (int ks = 0; ks < KSPLIT; ++ks) s += modp[(size_t)ks * (2 * 9 * NMOD) + i];
        mod[i] = s; }
}
DI void row_load(const float* p, f32x4 (&v)[8], int lane) {
#pragma unroll
    for (int j = 0; j < 8; ++j) v[j] = *(const f32x4*)(p + 4 * lane + 256 * j);
}
DI void row_load_bf(const bf16_t* p, f32x4 (&v)[8], int lane) {
#pragma unroll
    for (int j = 0; j < 8; ++j) { const u32x2 w = *(const u32x2*)(p + 4 * lane + 256 * j); v[j] = (f32x4){bf_lo(w.x), bf_hi(w.x), bf_lo(w.y), bf_hi(w.y)}; }
}
DI void row_modulate(const f32x4 (&v)[8], f32x4 (&y)[8], const float* gain, const float* shift, const float* scale, int lane) {
    float ss = 0.f;
#pragma unroll
    for (int j = 0; j < 8; ++j) ss += (v[j][0] * v[j][0] + v[j][1] * v[j][1]) + (v[j][2] * v[j][2] + v[j][3] * v[j][3]);
    ss = wave_sum(ss);
    const float rstd = 1.0f / sqrtf(ss * (1.0f / DM) + NORM_EPS);
#pragma unroll
    for (int j = 0; j < 8; ++j) { const int c = 4 * lane + 256 * j; const f32x4 g = *(const f32x4*)(gain + c), sh = *(const f32x4*)(shift + c), sc = *(const f32x4*)(scale + c);
        y[j] = ((v[j] * rstd) * g) * (sc + 1.0f) + sh; }
}
DI void row_modulate2(const f32x4 (&v0)[8], const f32x4 (&v1)[8], f32x4 (&y0)[8], f32x4 (&y1)[8], const float* gain, const float* shift, const float* scale, int lane) {
    float s0 = 0.f, s1 = 0.f;
#pragma unroll
    for (int j = 0; j < 8; ++j) { s0 += (v0[j][0] * v0[j][0] + v0[j][1] * v0[j][1]) + (v0[j][2] * v0[j][2] + v0[j][3] * v0[j][3]); s1 += (v1[j][0] * v1[j][0] + v1[j][1] * v1[j][1]) + (v1[j][2] * v1[j][2] + v1[j][3] * v1[j][3]); }
    s0 = wave_sum(s0); s1 = wave_sum(s1);
    const float r0 = 1.0f / sqrtf(s0 * (1.0f / DM) + NORM_EPS), r1 = 1.0f / sqrtf(s1 * (1.0f / DM) + NORM_EPS);
#pragma unroll
    for (int j = 0; j < 8; ++j) { const int c = 4 * lane + 256 * j; const f32x4 g = *(const f32x4*)(gain + c), sh = *(const f32x4*)(shift + c), sc = *(const f32x4*)(scale + c);
        y0[j] = ((v0[j] * r0) * g) * (sc + 1.0f) + sh; y1[j] = ((v1[j] * r1) * g) * (sc + 1.0f) + sh; }
}
DI void row_store_bf16(bf16_t* p, const f32x4 (&y)[8], int lane) {
#pragma unroll
    for (int j = 0; j < 8; ++j) { u32x2 w; w.x = pk2(y[j][0], y[j][1]); w.y = pk2(y[j][2], y[j][3]); *(u32x2*)(p + 4 * lane + 256 * j) = w; }
}
DI void ph_mod0(const float* x, const float* ctx, const float* gain, const float* mod0, bf16_t* A, int gw, int NGW, int lane) {
    int row = gw; if (row >= MT) return;
    f32x4 v[8], vn[8];
    row_load(row < ML ? x + (size_t)row * DM : ctx + (size_t)(row - ML) * DM, v, lane);
    for (;;) {
        const int nrow = row + NGW; const bool more = nrow < MT;
        if (more) row_load(nrow < ML ? x + (size_t)nrow * DM : ctx + (size_t)(nrow - ML) * DM, vn, lane);
        const int cr = row < ML ? (row >> 11) : 8;
        f32x4 y[8]; row_modulate(v, y, gain, mod0 + (size_t)cr * NMOD + 0 * DM, mod0 + (size_t)cr * NMOD + 1 * DM, lane);
        row_store_bf16(A + (size_t)row * DM, y, lane);
        if (!more) break;
#pragma unroll
        for (int j = 0; j < 8; ++j) v[j] = vn[j];
        row = nrow;
    }
}
DI float reduce8(const float (&v)[8], int lane) {
    const bool u0 = lane & 1, u1 = lane & 2, u2 = lane & 4;
    float a[4], b2[2];
#pragma unroll
    for (int k = 0; k < 4; ++k) { const float lo = v[2 * k], hi = v[2 * k + 1]; a[k] = (u0 ? hi : lo) + __shfl_xor(u0 ? lo : hi, 1); }
#pragma unroll
    for (int k = 0; k < 2; ++k) { const float lo = a[2 * k], hi = a[2 * k + 1]; b2[k] = (u1 ? hi : lo) + __shfl_xor(u1 ? lo : hi, 2); }
    return (u2 ? b2[1] : b2[0]) + __shfl_xor(u2 ? b2[0] : b2[1], 4);
}
DI float reduce_halves(float lo8, float hi8, int lane) {
    const bool u3 = lane & 8;
    float t = (u3 ? hi8 : lo8) + __shfl_xor(u3 ? lo8 : hi8, 8);
    t += __shfl_xor(t, 16); t += __shfl_xor(t, 32); return t;
}
DI float softmax16(float lg) {
    float mx = lg;
#pragma unroll
    for (int o = 1; o < 16; o <<= 1) mx = fmaxf(mx, __shfl_xor(mx, o));
    const float ex = __expf(lg - mx); float den = ex;
#pragma unroll
    for (int o = 1; o < 16; o <<= 1) den += __shfl_xor(den, o);
    return ex / den;
}
DI void aff_store(float v, float* affL, float* affC, int row, int lane) {
    if (lane < 16) { if (row < ML) { const int b = row >> 11, n = row & 2047; affL[(size_t)(b * 16 + lane) * SEQ + n] = v; }
                     else { const int rc = row - ML, b = rc >> 8, n = rc & 255; affC[(size_t)(b * 16 + lane) * CTXL + n] = v; } }
}
DI void router_rows2(const f32x4 (&y0)[8], const f32x4 (&y1)[8], const LAS float* rwT, float* affL, float* affC, int row0, int lane) {
    f32x2 yp[8][4];
#pragma unroll
    for (int j = 0; j < 8; ++j)
#pragma unroll
        for (int q = 0; q < 4; ++q) yp[j][q] = (f32x2){y0[j][q], y1[j][q]};
    float r0[2], r1[2];
#pragma unroll
    for (int hf = 0; hf < 2; ++hf) {
        float l0[8], l1[8];
#pragma unroll
        for (int e = 0; e < 8; ++e) { f32x2 acc = (f32x2){0.f, 0.f};
#pragma unroll
            for (int j = 0; j < 8; ++j) { const f32x4 w = *(const LAS f32x4*)(rwT + (8 * hf + e) * DM + 4 * lane + 256 * j);
#pragma unroll
                for (int q = 0; q < 4; ++q) acc = __builtin_elementwise_fma(yp[j][q], (f32x2){w[q], w[q]}, acc); }
            l0[e] = acc.x; l1[e] = acc.y; __builtin_amdgcn_sched_barrier(0); }
        r0[hf] = reduce8(l0, lane); r1[hf] = reduce8(l1, lane);
    }
    const float a0 = softmax16(reduce_halves(r0[0], r0[1], lane)), a1 = softmax16(reduce_halves(r1[0], r1[1], lane));
    aff_store(a0, affL, affC, row0, lane); aff_store(a1, affL, affC, row0 + 1, lane);
}
DI void ph_rwt(const float* rw, float* rwT, int gtid, int GT) {
    for (int i = gtid; i < 2 * 16 * DM; i += GT) { const int l = i >> 15, e = (i >> 11) & 15, d = i & (DM - 1); rwT[i] = rw[(size_t)l * DM * 16 + d * 16 + e]; }
}
DI void load_router(const float* rwT_g, LAS float* rwT, int tid) {
    for (int i = tid; i < DM * 16 / 4; i += 512) ((LAS f32x4*)rwT)[i] = ((const f32x4*)rwT_g)[i];
    __syncthreads();
}
DI void ph_modffn(const bf16_t* H, const float* gain, const float* modl, bf16_t* A, const LAS float* rwT, float* affL, float* affC, int nrows, int gw, int NGW, int lane) {
    int rp = gw; if (rp >= nrows / 2) return;
    u32x2 p0[8], p1[8];
#define MODFFN_LOAD(rp_) do { const int row_ = 2 * (rp_); _Pragma("unroll") for (int j = 0; j < 8; ++j) { p0[j] = *(const u32x2*)(H + (size_t)row_ * DM + 4 * lane + 256 * j); p1[j] = *(const u32x2*)(H + (size_t)(row_ + 1) * DM + 4 * lane + 256 * j); } } while (0)
    MODFFN_LOAD(rp);
    for (;;) {
        const int row = 2 * rp; const int cr = row < ML ? (row >> 11) : 8;
        float s0 = 0.f, s1 = 0.f;
#pragma unroll
        for (int j = 0; j < 8; ++j) { const float a0 = bf_lo(p0[j].x), a1 = bf_hi(p0[j].x), a2 = bf_lo(p0[j].y), a3 = bf_hi(p0[j].y); s0 += (a0 * a0 + a1 * a1) + (a2 * a2 + a3 * a3);
                                      const float b0 = bf_lo(p1[j].x), b1 = bf_hi(p1[j].x), b2 = bf_lo(p1[j].y), b3 = bf_hi(p1[j].y); s1 += (b0 * b0 + b1 * b1) + (b2 * b2 + b3 * b3); }
        s0 = wave_sum(s0); s1 = wave_sum(s1);
        const float r0 = 1.0f / sqrtf(s0 * (1.0f / DM) + NORM_EPS), r1 = 1.0f / sqrtf(s1 * (1.0f / DM) + NORM_EPS);
        const float* shift = modl + (size_t)cr * NMOD + 3 * DM; const float* scale = modl + (size_t)cr * NMOD + 4 * DM;
        f32x4 y0[8], y1[8];
#pragma unroll
        for (int j = 0; j < 8; ++j) { const int c = 4 * lane + 256 * j; const f32x4 g = *(const f32x4*)(gain + c), sh = *(const f32x4*)(shift + c), sc = *(const f32x4*)(scale + c);
            const f32x4 v0 = (f32x4){bf_lo(p0[j].x), bf_hi(p0[j].x), bf_lo(p0[j].y), bf_hi(p0[j].y)}, v1 = (f32x4){bf_lo(p1[j].x), bf_hi(p1[j].x), bf_lo(p1[j].y), bf_hi(p1[j].y)};
            y0[j] = ((v0 * r0) * g) * (sc + 1.0f) + sh; y1[j] = ((v1 * r1) * g) * (sc + 1.0f) + sh;
            *(unsigned*)((unsigned char*)A + (size_t)row * DM + c) = pk4_fp8(y0[j][0], y0[j][1], y0[j][2], y0[j][3]);
            *(unsigned*)((unsigned char*)A + (size_t)(row + 1) * DM + c) = pk4_fp8(y1[j][0], y1[j][1], y1[j][2], y1[j][3]); }
        const int nrp = rp + NGW; const bool more = nrp < nrows / 2;
        if (more) MODFFN_LOAD(nrp);
        asm volatile("" ::: "memory");
        router_rows2(y0, y1, rwT, affL, affC, row, lane);
        if (!more) break;
        rp = nrp;
    }
#undef MODFFN_LOAD
}
DI void ph_topk(int nitems, const float* affL, const float* affC, int* rowsrc, float* gatev, int* inv, LAS unsigned* hist, int tid, int lane, int wave, int bid, int G) {
    LAS unsigned* sh = hist + 256;
    for (int it = bid; it < nitems; it += G) {
        const bool isc = it >= 128; const int be = it & 127, b = be >> 4, e = be & 15;
        const int N = isc ? CTXL : SEQ, C = isc ? CAPC : CAPL;
        const float* src = isc ? affC + (size_t)be * CTXL : affL + (size_t)be * SEQ;
        const int i0 = tid * 4; const bool valid = i0 < N;
        unsigned key[4];
        { f32x4 v = (f32x4){0.f, 0.f, 0.f, 0.f}; if (valid) v = *(const f32x4*)(src + i0);
#pragma unroll
          for (int q = 0; q < 4; ++q) key[q] = __float_as_uint(v[q]); }
        unsigned prefix = 0u, mask = 0u, krem = (unsigned)C;
        for (int pass = 3; pass >= 0; --pass) {
            const int shift = pass * 8;
            if (tid < 256) hist[tid] = 0u;
            __syncthreads();
            if (valid) {
#pragma unroll
                for (int q = 0; q < 4; ++q) if ((key[q] & mask) == prefix) __hip_atomic_fetch_add(&hist[(key[q] >> shift) & 255u], 1u, __ATOMIC_RELAXED, __HIP_MEMORY_SCOPE_WORKGROUP); }
            __syncthreads();
            if (wave == 0) {
                const unsigned h0 = hist[4 * lane], h1 = hist[4 * lane + 1], h2 = hist[4 * lane + 2], h3 = hist[4 * lane + 3];
                const unsigned tot = h0 + h1 + h2 + h3; unsigned incl = tot;
#pragma unroll
                for (int o = 1; o < 64; o <<= 1) { const unsigned t = __shfl_down(incl, o); if (lane + o < 64) incl += t; }
                const unsigned a3 = incl - tot, a2 = a3 + h3, a1 = a2 + h2, a0 = a1 + h1;
                if (a3 < krem && krem <= a3 + h3) { sh[0] = 4 * lane + 3; sh[1] = krem - a3; }
                if (a2 < krem && krem <= a2 + h2) { sh[0] = 4 * lane + 2; sh[1] = krem - a2; }
                if (a1 < krem && krem <= a1 + h1) { sh[0] = 4 * lane + 1; sh[1] = krem - a1; }
                if (a0 < krem && krem <= a0 + h0) { sh[0] = 4 * lane + 0; sh[1] = krem - a0; }
            }
            __syncthreads();
            const unsigned B = sh[0]; krem = sh[1]; prefix |= B << shift; mask |= 0xFFu << shift;
        }
        const unsigned T = prefix;
        unsigned cg = 0u, ce = 0u;
        if (valid) {
#pragma unroll
            for (int q = 0; q < 4; ++q) { cg += key[q] > T ? 1u : 0u; ce += key[q] == T ? 1u : 0u; } }
        const unsigned mine = cg | (ce << 16); unsigned incl = mine;
#pragma unroll
        for (int o = 1; o < 64; o <<= 1) { const unsigned t = __shfl_up(incl, o); if (lane >= o) incl += t; }
        if (lane == 63) sh[8 + wave] = incl;
        __syncthreads();
        unsigned woff = 0u;
#pragma unroll
        for (int w = 0; w < 8; ++w) woff += (w < wave) ? sh[8 + w] : 0u;
        const unsigned excl = woff + incl - mine; unsigned gtb = excl & 0xFFFFu, eqb = excl >> 16;
        if (valid) {
            const int ybase = e * YR + (isc ? NB * CAPL + b * CAPC : b * CAPL); const int rbase = isc ? ML + b * CTXL : b * SEQ;
#pragma unroll
            for (int q = 0; q < 4; ++q) {
                const bool isg = key[q] > T, ise = key[q] == T; const bool sel = isg || (ise && eqb < krem);
                const unsigned slot = gtb + (eqb < krem ? eqb : krem);
                const int trow = rbase + i0 + q; const int yrow = ybase + (int)slot;
                if (sel) { rowsrc[yrow] = trow; gatev[yrow] = __uint_as_float(key[q]); }
                inv[(size_t)trow * 16 + e] = sel ? yrow : -1;
                gtb += isg ? 1u : 0u; eqb += ise ? 1u : 0u;
            }
        }
        __syncthreads();
    }
}
template <bool LAST> DI void ph_combine(bf16_t* H, const bf16_t* Y, const int* inv, const float* modl  , const float* gain1, const float* mod1, bf16_t* A, float* out, int nrows, int gw, int NGW, int lane) {
    int row = gw; if (row >= nrows) return;
    u32x2 hp[8], hn[8]; int myinv, ninv = -1;
#define CMB_LOAD(HP, IV, row_) do { _Pragma("unroll") for (int j = 0; j < 8; ++j) HP[j] = *(const u32x2*)(H + (size_t)(row_) * DM + 4 * lane + 256 * j); IV = inv[(size_t)(row_) * 16 + (lane & 15)]; } while (0)
    CMB_LOAD(hp, myinv, row);
    for (;;) {
        const int nrow = row + NGW; const bool more = nrow < nrows;
        if (more) CMB_LOAD(hn, ninv, nrow);
        const int cr = row < ML ? (row >> 11) : 8;
        f32x4 acc[8];
#pragma unroll
        for (int j = 0; j < 8; ++j) acc[j] = (f32x4){0.f, 0.f, 0.f, 0.f};
        unsigned m = (unsigned)(__ballot(myinv >= 0) & 0xFFFFull);
        while (m) {
            const int e1 = __builtin_ctz(m); m &= m - 1; const bool two = m != 0u; const int e2 = two ? __builtin_ctz(m) : e1; if (two) m &= m - 1;
            const unsigned char* y1 = (const unsigned char*)Y + (size_t)__builtin_amdgcn_readlane(myinv, e1) * DM + 4 * lane; const unsigned char* y2 = (const unsigned char*)Y + (size_t)__builtin_amdgcn_readlane(myinv, e2) * DM + 4 * lane;
            unsigned q1[8], q2[8];
#pragma unroll
            for (int j = 0; j < 8; ++j) { q1[j] = *(const unsigned*)(y1 + 256 * j); q2[j] = *(const unsigned*)(y2 + 256 * j); }
            const float f2 = two ? 1.0f : 0.0f;
#pragma unroll
            for (int j = 0; j < 8; ++j) acc[j] += unpk4_fp8(q1[j]) + unpk4_fp8(q2[j]) * f2;
        }
        const float* g2 = modl + (size_t)cr * NMOD + 5 * DM;
        f32x4 v[8];
#pragma unroll
        for (int j = 0; j < 8; ++j) { const f32x4 g = *(const f32x4*)(g2 + 4 * lane + 256 * j); const f32x4 h = (f32x4){bf_lo(hp[j].x), bf_hi(hp[j].x), bf_lo(hp[j].y), bf_hi(hp[j].y)}; v[j] = h + g * (acc[j] * Y8_INV); }
        if (LAST) {
#pragma unroll
            for (int j = 0; j < 8; ++j) *(f32x4*)(out + (size_t)row * DM + 4 * lane + 256 * j) = v[j];
        } else {
            row_store_bf16(H + (size_t)row * DM, v, lane);
            f32x4 y[8]; row_modulate(v, y, gain1, mod1 + (size_t)cr * NMOD + 0 * DM, mod1 + (size_t)cr * NMOD + 1 * DM, lane);
#pragma unroll
            for (int j = 0; j < 8; ++j) *(unsigned*)((unsigned char*)A + (size_t)row * DM + 4 * lane + 256 * j) = pk4_fp8(y[j][0], y[j][1], y[j][2], y[j][3]);
        }
        if (!more) break;
#pragma unroll
        for (int j = 0; j < 8; ++j) hp[j] = hn[j];
        myinv = ninv; row = nrow;
    }
#undef CMB_LOAD
}
constexpr int KP = 272;
constexpr int VP = 288;
constexpr int ATT_VOFF = 64 * KP;
constexpr int ATT_TILE = 64 * KP + 64 * VP;
constexpr int ATT_OST = 2 * ATT_TILE;
DI float xhalf_max(float v) { auto rr = __builtin_amdgcn_permlane32_swap(__float_as_uint(v), __float_as_uint(v), false, false); return fmaxf(__uint_as_float(rr[0]), __uint_as_float(rr[1])); }
DI float xhalf_sum(float v) { auto rr = __builtin_amdgcn_permlane32_swap(__float_as_uint(v), __float_as_uint(v), false, false); return __uint_as_float(rr[0]) + __uint_as_float(rr[1]); }
DI int crow(int reg, int h) { return (reg & 3) + 8 * (reg >> 2) + 4 * h; }
DI long long vtr64(const LAS unsigned char* p) { typedef short v4i16_t __attribute__((ext_vector_type(4))); return __builtin_bit_cast(long long, __builtin_amdgcn_ds_read_tr16_b64_v4i16((LAS v4i16_t*)p)); }
DI s16x4 vtr(const LAS unsigned char* p) { typedef short v4i16_t __attribute__((ext_vector_type(4))); return __builtin_bit_cast(s16x4, __builtin_amdgcn_ds_read_tr16_b64_v4i16((LAS v4i16_t*)p)); }
DI bool att_tile_info(int item, int ti, int& base, int& mtype) {
    const int qhalf = item & 1, n = (item >> 3) & 15, b = item >> 7, tt = ti & 1; mtype = 0;
    if (ti < 4) { base = ML + b * CTXL + 64 * ti; return true; }
    const int blk = n - 1 + ((ti - 4) >> 1); if (blk < 0 || blk > 15) return false;
    if (ti < 6) { mtype = 1; if (tt == 0 && qhalf == 1) return false; } else if (ti >= 8) { mtype = 2; if (tt == 1 && qhalf == 0) return false; }
    base = b * SEQ + blk * 128 + 64 * tt; return true;
}
DI void att_next(int& item, int& ti, int G) { for (;;) { ++ti; if (ti >= 10) { ti = 0; item += G; return; } int b_, m_; if (att_tile_info(item, ti, b_, m_)) return; } }
DI void ph_attn(const bf16_t* Q, const bf16_t* Kb, const bf16_t* Vb, bf16_t* O, const float* sink, LAS unsigned char* lds, int tid, int lane, int wave, int bid, int G) {
    constexpr float LOG2E = 1.4426950408889634f;
    const int r = lane & 31, h = lane >> 5, g = wave >> 1, sub = wave & 1;
    const int ldrow = tid >> 3, ldc = tid & 7;
    int item = bid, ti = 0; if (item >= 1024) return;
    u32x4 kr[2], vr[2];
#define ATT_ISSUE(it_, ti_) do { int base_, mt_; att_tile_info(it_, ti_, base_, mt_); const int kvh_ = ((it_) >> 1) & 3; \
        _Pragma("unroll") for (int c2 = 0; c2 < 2; ++c2) { const size_t off_ = (size_t)(base_ + ldrow) * 512 + kvh_ * HD + (ldc + 8 * c2) * 8; kr[c2] = *(const u32x4*)(Kb + off_); vr[c2] = *(const u32x4*)(Vb + off_); } } while (0)
    bf16x8 qf[8]; float m2 = 0.f, lsum = 1.f; f32x16 o[4]; f32x16 negm;
#define ATT_QLOAD(it_) do { const int qrow_ = ((it_) >> 7) * SEQ + (((it_) >> 3) & 15) * 128 + ((it_) & 1) * 64 + sub * 32 + r; const int head_ = (((it_) >> 1) & 3) * 4 + g; \
        _Pragma("unroll") for (int s = 0; s < 8; ++s) qf[s] = *(const bf16x8*)(Q + (size_t)qrow_ * DM + head_ * HD + 16 * s + 8 * h); } while (0)
    ATT_QLOAD(item);
    ATT_ISSUE(item, ti);
    int buf = 0;
    while (item < 1024) {
        int nitem = item, nti = ti; att_next(nitem, nti, G);
        LAS unsigned char* tb = lds + buf * ATT_TILE;
#pragma unroll
        for (int c2 = 0; c2 < 2; ++c2) { *(LAS u32x4*)(tb + ldrow * KP + (ldc + 8 * c2) * 16) = kr[c2]; *(LAS u32x4*)(tb + ATT_VOFF + ldrow * VP + (ldc + 8 * c2) * 16) = vr[c2]; }
        if (nitem < 1024) ATT_ISSUE(nitem, nti);
        asm volatile("s_waitcnt lgkmcnt(0)" ::: "memory"); __builtin_amdgcn_s_barrier(); asm volatile("" ::: "memory");
        int base, mtype; att_tile_info(item, ti, base, mtype); const int tt = ti & 1;
        const int qhalf = item & 1, kvh = (item >> 1) & 3, n = (item >> 3) & 15, b = item >> 7;
        const int head = kvh * 4 + g, qq = qhalf * 64 + sub * 32 + r; const int qrow = b * SEQ + n * 128 + qq;
        if (ti == 0) {
            m2 = sink[head] * LOG2E; lsum = 1.0f;
#pragma unroll
            for (int i = 0; i < 16; ++i) negm[i] = -m2;
#pragma unroll
            for (int d = 0; d < 4; ++d)
#pragma unroll
                for (int i = 0; i < 16; ++i) o[d][i] = 0.f;
        }
        f32x16 x0, x1;
#pragma unroll
        for (int s = 0; s < 8; ++s) {
            const bf16x8 k0 = *(const LAS bf16x8*)(tb + r * KP + (16 * s + 8 * h) * 2), k1 = *(const LAS bf16x8*)(tb + (32 + r) * KP + (16 * s + 8 * h) * 2);
            if (s == 0) { x0 = __builtin_amdgcn_mfma_f32_32x32x16_bf16(k0, qf[s], negm, 0, 0, 0); x1 = __builtin_amdgcn_mfma_f32_32x32x16_bf16(k1, qf[s], negm, 0, 0, 0); }
            else { x0 = __builtin_amdgcn_mfma_f32_32x32x16_bf16(k0, qf[s], x0, 0, 0, 0); x1 = __builtin_amdgcn_mfma_f32_32x32x16_bf16(k1, qf[s], x1, 0, 0, 0); } }
        if (nitem != item && nitem < 1024) ATT_QLOAD(nitem);
        if (mtype == 1) {
#pragma unroll
            for (int i = 0; i < 16; ++i) { const int kk0 = tt * 64 + crow(i, h); if (kk0 < qq) x0[i] = -1.0e30f; if (kk0 + 32 < qq) x1[i] = -1.0e30f; } }
        if (mtype == 2) {
#pragma unroll
            for (int i = 0; i < 16; ++i) { const int kk0 = tt * 64 + crow(i, h); if (kk0 > qq) x0[i] = -1.0e30f; if (kk0 + 32 > qq) x1[i] = -1.0e30f; } }
        float tmax = fmaxf(x0[0], x1[0]);
#pragma unroll
        for (int i = 1; i < 16; ++i) tmax = fmaxf(fmaxf(tmax, x0[i]), x1[i]);
        tmax = xhalf_max(tmax);
        if (__any(tmax > 0.0f)) {
            const float dl = fmaxf(tmax, 0.0f), alpha = __builtin_amdgcn_exp2f(-dl); m2 += dl; lsum *= alpha;
#pragma unroll
            for (int i = 0; i < 16; ++i) { x0[i] -= dl; x1[i] -= dl; negm[i] = -m2; }
#pragma unroll
            for (int d = 0; d < 4; ++d)
#pragma unroll
                for (int i = 0; i < 16; ++i) o[d][i] *= alpha;
        }
        float ps = 0.f;
#pragma unroll
        for (int i = 0; i < 16; ++i) { x0[i] = __builtin_amdgcn_exp2f(x0[i]); x1[i] = __builtin_amdgcn_exp2f(x1[i]); ps += x0[i] + x1[i]; }
        lsum += xhalf_sum(ps);
        bf16x8 pf[2][2];
#pragma unroll
        for (int s = 0; s < 2; ++s) {
            u32x4 a, c; a.x = pk2(x0[8 * s + 0], x0[8 * s + 1]); a.y = pk2(x0[8 * s + 2], x0[8 * s + 3]); a.z = pk2(x0[8 * s + 4], x0[8 * s + 5]); a.w = pk2(x0[8 * s + 6], x0[8 * s + 7]);
            c.x = pk2(x1[8 * s + 0], x1[8 * s + 1]); c.y = pk2(x1[8 * s + 2], x1[8 * s + 3]); c.z = pk2(x1[8 * s + 4], x1[8 * s + 5]); c.w = pk2(x1[8 * s + 6], x1[8 * s + 7]);
            pf[0][s] = __builtin_bit_cast(bf16x8, a); pf[1][s] = __builtin_bit_cast(bf16x8, c); }
        const LAS unsigned char* vb = tb + ATT_VOFF + (4 * h + ((lane & 15) >> 2)) * VP + (16 * ((lane >> 4) & 1) + 4 * (lane & 3)) * 2;
#pragma unroll
        for (int d = 0; d < 4; ++d)
#pragma unroll
            for (int t = 0; t < 2; ++t)
#pragma unroll
                for (int s = 0; s < 2; ++s) {
                    typedef long long i64x2_t __attribute__((ext_vector_type(2)));
                    i64x2_t vv; vv.x = vtr64(vb + (t * 32 + 16 * s) * VP + d * 64); vv.y = vtr64(vb + (t * 32 + 16 * s + 8) * VP + d * 64);
                    const bf16x8 vf = __builtin_bit_cast(bf16x8, vv);
                    o[d] = __builtin_amdgcn_mfma_f32_32x32x16_bf16(vf, pf[t][s], o[d], 0, 0, 0); }
        if (nitem != item) {
            const float il = 1.0f / lsum;
            LAS unsigned char* st = lds + ATT_OST + wave * (32 * KP);
#pragma unroll
            for (int d = 0; d < 4; ++d)
#pragma unroll
                for (int g4 = 0; g4 < 4; ++g4) *(LAS unsigned*)(st + r * 144 + d * 32 + 8 * g4 + 4 * h) = pk4_fp8(o[d][4 * g4 + 0] * il, o[d][4 * g4 + 1] * il, o[d][4 * g4 + 2] * il, o[d][4 * g4 + 3] * il);
            asm volatile("s_waitcnt lgkmcnt(0)" ::: "memory");
            unsigned char* ob = (unsigned char*)O + (size_t)(qrow - r) * DM + head * HD;
#pragma unroll
            for (int j = 0; j < 4; ++j) { const int c = lane + 64 * j, row = c >> 3, c16 = c & 7;
                const u32x4 v = *(const LAS u32x4*)(st + row * 144 + c16 * 16); *(u32x4*)(ob + (size_t)row * DM + c16 * 16) = v; }
        }
        item = nitem; ti = nti; buf ^= 1;
    }
#undef ATT_ISSUE
#undef ATT_QLOAD
}
#ifndef MK_ONE_LAUNCH
#define MK_ONE_LAUNCH 1
#endif
constexpr int NPHASE = 19;
constexpr int CVT_X0_END = CVT_E0 + CVT_L;
#define CVT_MKCP() CvtPtrs CP; CP.cin = args.in[8]; CP.cout = args.in[10]; CP.wqkv = args.in[11]; CP.wo = args.in[15]; CP.wg = args.in[17]; CP.wu = args.in[18]; CP.wd = args.in[19]; \
    CP.W1A = W1A; CP.W1B = W1B; CP.W2 = W2; CP.WQKV = WQKV; CP.WO = WOt; CP.WGU = WGU; CP.WDN = WDN
#define CVT(LO, HI) do { CVT_MKCP(); cvt_range(CP, LO, HI, gw, NGW, cscr, lane); } while (0)
#define TAIL_CVT(NWG, LO, HI) do { const int R_ = ((NWG) + G - 1) / G, rem_ = (NWG) - (R_ - 1) * G; if (bid >= rem_) { CVT_MKCP(); cvt_range(CP, LO, HI, (bid - rem_) * 8 + wave, (G - rem_) * 8, cscr, lane); } } while (0)
#define SIDE_CVT(GA, LO, HI) do { CVT_MKCP(); cvt_range(CP, LO, HI, (bid - (GA)) * 8 + wave, (G - (GA)) * 8, cscr, lane); } while (0)
#ifndef MK_C3
#define MK_C3 12288
#define MK_C4 23552
#define MK_C5 34816
#define MK_C8 40448
#define MK_C9 43008
#define MK_C11 47616
#endif
constexpr int C3 = MK_C3, C4 = MK_C4, C5 = MK_C5, C8 = MK_C8, C9 = MK_C9, C11 = MK_C11, GU0_END = CVT_E0 + 16384, GU1_END = CVT_X0_END + 16384;
static_assert(C5 >= GU0_END && C8 >= CVT_X0_END && C11 <= GU1_END && C3 >= CVT_E0, "tail budgets");
#ifndef MK_DUP_MASK
#define MK_DUP_MASK 0u
#endif
constexpr unsigned DUP_MASK = MK_DUP_MASK;
struct Args { const float* in[20]; float* out; unsigned char* ws; int ph_lo, ph_hi; };
__global__ void __launch_bounds__(512, 2) dit_fwd(Args args) {
    extern __shared__ __attribute__((aligned(16))) unsigned char lds_raw[];
    LAS unsigned char* lds = (LAS unsigned char*)lds_raw;
    const int tid = threadIdx.x, lane = tid & 63, wave = __builtin_amdgcn_readfirstlane(tid >> 6);
    const int G = gridDim.x, bid = blockIdx.x;
    const int gw = bid * 8 + wave, NGW = G * 8;
    unsigned char* ws = args.ws;
    const float* x = args.in[0]; const float* cnd = args.in[1]; const float* ctx = args.in[2]; const float* cctx = args.in[3];
    const float* ada_w = args.in[4]; const float* ada_b = args.in[5]; const float* nmix = args.in[6]; const float* nffn = args.in[7];
    const float* conv_w = args.in[9]; const float* qgain = args.in[12]; const float* kgain = args.in[13]; const float* sink = args.in[14]; const float* router_w = args.in[16];
    float* mod = (float*)(ws + WS_MOD); float* modp = (float*)(ws + WS_MODP);
    float* affL = (float*)(ws + WS_AFFL); float* affC = (float*)(ws + WS_AFFC);
    float* rwt = (float*)(ws + WS_RWT);
    int* idmap = (int*)(ws + WS_IDMAP);
    int* rowsrc = (int*)(ws + WS_ROWSRC); float* gatev = (float*)(ws + WS_GATEV); int* inv = (int*)(ws + WS_INV);
    bf16_t* W1A = (bf16_t*)(ws + WS_W1A); bf16_t* W1B = (bf16_t*)(ws + WS_W1B); bf16_t* W2 = (bf16_t*)(ws + WS_W2); bf16_t* WQKV = (bf16_t*)(ws + WS_WQKV); bf16_t* WOt = (bf16_t*)(ws + WS_WO);
    bf16_t* WGU = (bf16_t*)(ws + WS_WGU); bf16_t* WDN = (bf16_t*)(ws + WS_WDN);
    bf16_t* H = (bf16_t*)(ws + WS_H); bf16_t* A = (bf16_t*)(ws + WS_A); bf16_t* U = (bf16_t*)(ws + WS_U); bf16_t* Z = (bf16_t*)(ws + WS_Z);
    bf16_t* Qb = (bf16_t*)(ws + WS_Q); bf16_t* Kb = (bf16_t*)(ws + WS_K); bf16_t* Vb = (bf16_t*)(ws + WS_V); bf16_t* Ob = (bf16_t*)(ws + WS_O);
    bf16_t* HM = (bf16_t*)(ws + WS_HM); bf16_t* Y = (bf16_t*)(ws + WS_Y);
    LAS unsigned* cscr = (LAS unsigned*)(lds + wave * 9216);

    for (int u = tid; u < (LDS_BYTES - MISC_OFF) / 4; u += 512) ((LAS unsigned*)(lds + MISC_OFF))[u] = 0u;
    __syncthreads();
#if MK_ONE_LAUNCH
    XcdBarrier bar = xcd_barrier_post((unsigned*)(ws + WS_CTL) + CW_BAR, (volatile LAS unsigned*)(lds + MISC_OFF) + 8);
#define GRID_BAR() xcd_barrier(bar)
#else
#define GRID_BAR() do {} while (0)
#endif
    const int lo = args.ph_lo, hi = args.ph_hi;
    const int GA45 = (G * 3 / 4) & ~7;
#define IN(k) (lo <= (k) && (k) < hi)
#define SEAM(k) do { if (IN(k) && IN((k) + 1)) GRID_BAR(); } while (0)
#define PHASE(k) if (IN(k)) _Pragma("unroll") for (int rep_ = 0; rep_ < 1 + (int)((DUP_MASK >> (k)) & 1u); ++rep_)
#define REP_BAR() do { if (rep_) GRID_BAR(); } while (0)

    PHASE(0) { REP_BAR(); ph_adaln(cnd, cctx, ada_w, modp, gw, NGW, lane); } SEAM(0);
    PHASE(1) { REP_BAR(); ph_modred(modp, ada_b, mod, bid * 512 + tid, G * 512); ph_rwt(router_w, rwt, bid * 512 + tid, G * 512); for (int i = bid * 512 + tid; i < YT; i += G * 512) idmap[i] = i; } SEAM(1);
    PHASE(2) { REP_BAR(); ph_mod0(x, ctx, nmix, mod, A, gw, NGW, lane); CVT(0, 4096); } SEAM(2);
    PHASE(3) { REP_BAR();
        pg8::Gemm g{A, W1A, MT, 4096, DM}; pg8::StaticOrder S; S.init(MT, 4096, G, bid);
        EpiPair<0> E{U, DM, 16};
        pg8::gemm_phase<EpiPair<0>, pg8::StaticOrder, true, true>(lds, g, S, E);
        TAIL_CVT((MT / 256) * 16, 4096, C3);
    } SEAM(3);
    PHASE(4) { REP_BAR();
        if (bid < GA45) {
        pg8::Gemm g{A, W1B, MT, DM, DM}; pg8::StaticOrder S; S.init(MT, DM, GA45, bid);
        EpiConvGate E{U, Z, conv_w};
        pg8::gemm_phase<EpiConvGate, pg8::StaticOrder, true, true>(lds, g, S, E);
        } else SIDE_CVT(GA45, C3, C4);
    } SEAM(4);
    PHASE(5) { REP_BAR();
        if (bid < GA45) {
        pg8::Gemm g{Z, W2, MT, DM, DM}; pg8::StaticOrder S; S.init(MT, DM, GA45, bid);
        EpiResid<true> E{x, ctx, H, mod + 2 * DM, 1.0f};
        pg8::gemm_phase<EpiResid<true>, pg8::StaticOrder, true, true>(lds, g, S, E);
        } else SIDE_CVT(GA45, C4, C5);
    } SEAM(5);
    PHASE(6) { REP_BAR(); load_router(rwt, (LAS float*)lds, tid); ph_modffn(H, nffn, mod, A, (const LAS float*)lds, affL, affC, MT, gw, NGW, lane); } SEAM(6);
    PHASE(7) { REP_BAR(); ph_topk(256, affL, affC, rowsrc, gatev, inv, (LAS unsigned*)lds, tid, lane, wave, bid, G); } SEAM(7);
    PHASE(8) { REP_BAR();
        pg8::Gemm g{A, WGU, YT, NE * 2048, DM / 2, rowsrc}; MoeOrder S{G, bid, 9};
        EpiPairF8 E{(unsigned char*)HM, DFF, 8};
        pg8::gemm_phase<EpiPairF8, MoeOrder, true, true, true, true>(lds, g, S, E);
        TAIL_CVT(NE * 9 * 8, C5, C8);
    } SEAM(8);
    PHASE(9) { REP_BAR();
        pg8::Gemm g{HM, WDN, YT, NE * 2048, DFF / 2, idmap}; MoeOrder S{G, bid, 9};
        EpiDown E{Y, gatev, W8_INV * Y8_SCALE};
        pg8::gemm_phase<EpiDown, MoeOrder, true, true, true, true>(lds, g, S, E);
        TAIL_CVT(NE * 9 * 8, C8, C9);
    } SEAM(9);
    PHASE(10) { REP_BAR(); ph_combine<false>(H, Y, inv, mod, nmix + DM, mod + 9 * NMOD, A, nullptr, MT, gw, NGW, lane); } SEAM(10);
    PHASE(11) { REP_BAR();
        pg8::Gemm g{A, WQKV, MT, 3072, DM / 2, idmap}; QkvOrder S{G, bid};
        EpiQkvNorm E{Qb, Kb, Vb, qgain, kgain, (LAS float*)(lds + RING_BYTES), W8_INV};
        pg8::gemm_phase<EpiQkvNorm, QkvOrder, true, true, true, true>(lds, g, S, E);
        TAIL_CVT(800, C9, C11);
    } SEAM(11);
    PHASE(12) { REP_BAR(); ph_attn(Qb, Kb, Vb, Ob, sink, lds, tid, lane, wave, bid, G); } SEAM(12);
    PHASE(13) { REP_BAR();
        pg8::Gemm g{Ob, WOt, ML, DM, DM / 2, idmap}; pg8::StaticOrder S; S.init(ML, DM, G, bid);
        EpiResid<false> E{nullptr, nullptr, H, mod + 9 * NMOD + 2 * DM, W8_INV};
        pg8::gemm_phase<EpiResid<false>, pg8::StaticOrder, true, true, true, true>(lds, g, S, E);
    } SEAM(13);
    PHASE(14) { REP_BAR(); load_router(rwt + DM * 16, (LAS float*)lds, tid); ph_modffn(H, nffn + DM, mod + 9 * NMOD, A, (const LAS float*)lds, affL, affC, ML, gw, NGW, lane); } SEAM(14);
    PHASE(15) { REP_BAR(); ph_topk(128, affL, affC, rowsrc, gatev, inv, (LAS unsigned*)lds, tid, lane, wave, bid, G); CVT(C11, GU1_END); } SEAM(15);
    PHASE(16) { REP_BAR();
        pg8::Gemm g{A, (const bf16_t*)((const unsigned char*)WGU + (size_t)NE * 2048 * DM), YT, NE * 2048, DM / 2, rowsrc}; MoeOrder S{G, bid, 8};
        EpiPairF8 E{(unsigned char*)HM, DFF, 8};
        pg8::gemm_phase<EpiPairF8, MoeOrder, true, true, true, true>(lds, g, S, E);
        CVT(GU1_END, CVT_TOTAL);
    } SEAM(16);
    PHASE(17) { REP_BAR();
        pg8::Gemm g{HM, (const bf16_t*)((const unsigned char*)WDN + (size_t)NE * 2048 * DFF), YT, NE * 2048, DFF / 2, idmap}; MoeOrder S{G, bid, 8};
        EpiDown E{Y, gatev, W8_INV * Y8_SCALE};
        pg8::gemm_phase<EpiDown, MoeOrder, true, true, true, true>(lds, g, S, E);
    } SEAM(17);
    PHASE(18) { REP_BAR(); ph_combine<true>(H, Y, inv, mod + 9 * NMOD, nullptr, nullptr, nullptr, args.out, ML, gw, NGW, lane); }
#undef IN
#undef SEAM
#undef PHASE
#undef REP_BAR
}

extern "C" void kernel_launch(void* const* d_in, const int* in_sizes, int n_in, void* d_out, int out_size, void* d_ws, size_t ws_size, hipStream_t stream) {
    static int grid = 0;
    if (grid == 0) {
        if (n_in != 20 || out_size != ML * DM || ws_size < WS_END) { fprintf(stderr, "kernel_launch: unexpected problem (n_in %d, out %d, ws %zu); nothing launched\n", n_in, out_size, ws_size); grid = -1; return; }
        int dev = 0, cus = 0, per_cu = 0;
        if (hipGetDevice(&dev) != hipSuccess || hipDeviceGetAttribute(&cus, hipDeviceAttributeMultiprocessorCount, dev) != hipSuccess) { grid = -1; return; }
        if (hipFuncSetAttribute((const void*)dit_fwd, hipFuncAttributeMaxDynamicSharedMemorySize, LDS_BYTES) != hipSuccess) { fprintf(stderr, "kernel_launch: hipFuncSetAttribute failed\n"); grid = -1; return; }
        if (hipOccupancyMaxActiveBlocksPerMultiprocessor(&per_cu, (const void*)dit_fwd, 512, LDS_BYTES) != hipSuccess || per_cu < 1) fprintf(stderr, "kernel_launch: occupancy query reports %d workgroups per CU\n", per_cu);
        (void)hipGetLastError();
        grid = cus;
    }
    if (grid < 0) return;
    (void)hipMemsetAsync((char*)d_ws + WS_CTL, 0, CTL_ZERO_BYTES, stream);
    Args a{};
    for (int i = 0; i < 20; ++i) a.in[i] = (const float*)d_in[i];
    a.out = (float*)d_out; a.ws = (unsigned char*)d_ws;
#if MK_ONE_LAUNCH
    a.ph_lo = 0; a.ph_hi = NPHASE;
    hipLaunchKernelGGL(dit_fwd, dim3(grid), dim3(512), LDS_BYTES, stream, a);
#else
    for (int p = 0; p < NPHASE; ++p) { a.ph_lo = p; a.ph_hi = p + 1; hipLaunchKernelGGL(dit_fwd, dim3(grid), dim3(512), LDS_BYTES, stream, a); }
#endif
}
```

```cpp
#include <hip/hip_runtime.h>
#include <cstdio>
#include <cstdint>
namespace pg8 {
#define PG8_LAS __attribute__((address_space(3)))
typedef unsigned short bf16_t;
typedef short bf16x8 __attribute__((ext_vector_type(8)));
typedef float f32x4 __attribute__((ext_vector_type(4)));
typedef unsigned u32x4 __attribute__((ext_vector_type(4)));
constexpr int BM = 256, BK = 64, HALF = 128, HTB = HALF * BK * 2  , STAGE_BYTES = 8 * HTB, NXCD = 8, WGM = 8;

__host__ __device__ __forceinline__ int lds_byte(int r, int c) { const int st = (r >> 4) * 2 + (c >> 5), rr = r & 15, cc = c & 31, ob = rr * 64 + cc * 2; return st * 1024 + (ob ^ (((ob >> 9) & 1) << 5)); }
__host__ __device__ __forceinline__ void stage_rc(int b, int& R, int& C) { const int st = b / 1024, sb = b % 1024, swz = sb ^ (((sb >> 9) & 1) << 5); R = (st >> 1) * 16 + swz / 64; C = (st & 1) * 32 + (swz % 64) / 2; }
__host__ __device__ __forceinline__ int perm32(int rho) { const int n = rho >> 4, i = rho & 15; return 8 * (i >> 2) + 4 * n + (i & 3); }

struct Unit { int pm, pn; };
struct Gemm { const bf16_t* A; const bf16_t* Bt; int M, N, K; const int* rows = nullptr; };

struct StaticOrder {
    int nM, nN, nwg, G, c;
    __host__ __device__ void init(int M, int N, int G_, int c_) { nM = M / BM; nN = N / BM; nwg = nM * nN; G = G_; c = c_; }
    __host__ __device__ bool next(int i, Unit& u) const {
        const long L = (long)i * G + c; if (L >= nwg) return false;
        int wgid = (int)L; { const int q = nwg / NXCD, r = nwg % NXCD, xcd = wgid % NXCD, off = wgid / NXCD; wgid = (xcd < r ? xcd * (q + 1) : r * (q + 1) + (xcd - r) * q) + off; }
        const int nig = WGM * nN, gid = wgid / nig, fm = gid * WGM, gsz = (nM - fm) < WGM ? (nM - fm) : WGM;
        u.pm = fm + ((wgid % nig) % gsz); u.pn = (wgid % nig) / gsz; return true;
    }
    __device__ __forceinline__ void a_ready(const Unit&) const {}
    __device__ __forceinline__ void done(const Unit&) const {}
};
__device__ __forceinline__ unsigned cvt_pk_bf16(float lo, float hi) { unsigned r; asm volatile("v_cvt_pk_bf16_f32 %0, %1, %2" : "=v"(r) : "v"(lo), "v"(hi)); return r; }
typedef float f32x2 __attribute__((ext_vector_type(2)));
template <class Epi, class Sched, bool ALIGN_EPI = false, bool SP2 = false, bool GATHER = false, bool F8 = false>
__device__ __forceinline__ void gemm_phase(PG8_LAS unsigned char* lds, const Gemm g, const Sched& S, const Epi& E) {
    typedef int i32x4_t __attribute__((ext_vector_type(4)));
    const int tid = threadIdx.x, wid = __builtin_amdgcn_readfirstlane(tid >> 6), lane = tid & 63, wr = wid >> 2, wc = wid & 3, fr = lane & 15, fq = lane >> 4;
    const int K = g.K, nt = K / BK;
    unsigned voffA[2], voffB[2];
#pragma unroll
    for (int i = 0; i < 2; ++i) { int R, C; stage_rc(tid * 16 + i * 8192, R, C); const int Rb = Epi::PERM ? ((R & ~31) + perm32(R & 31)) : R;
        voffA[i] = (unsigned)(R * K + C) * 2u; voffB[i] = (unsigned)(Rb * K + C) * 2u; }
    const size_t kstep = (size_t)(BK * 2);
    const size_t hstep = (size_t)HALF * K * 2;
    const size_t tstep = 2 * hstep;
    const unsigned ldsw = (unsigned)wid * 1024u;
    const int aoff = lds_byte(wr * 64 + fr, fq * 8), boff = lds_byte(wc * 32 + fr, fq * 8);
#define PG8_SA(b, h) (((b) * 2 + (h)) * HTB)
#define PG8_SB(b, h) ((4 + (b) * 2 + (h)) * HTB)
#define PG8_UNI(p) ((const char*)(((unsigned long long)(unsigned)__builtin_amdgcn_readfirstlane((int)((unsigned long long)(p) >> 32)) << 32) | (unsigned long long)(unsigned)__builtin_amdgcn_readfirstlane((int)(unsigned long long)(p))))
#define PG8_STAGE(bufoff, gbase, voff) do { const char* gb_ = PG8_UNI(gbase);     \
        _Pragma("unroll") for (int _i = 0; _i < 2; ++_i) \
        __builtin_amdgcn_global_load_lds((const unsigned*)(gb_ + (voff)[_i]), (PG8_LAS unsigned*)(lds + (bufoff) + ldsw + _i * 8192), 16, 0, 0); } while (0)
#define PG8_STAGE_A(bufoff, kptr, h) do { if constexpr (GATHER) { PG8_STAGE(bufoff, kptr, vA[h]); } else { PG8_STAGE(bufoff, (kptr) + (h) * hstep, voffA); } } while (0)
#define PG8_GATHER_SWITCH() do { if constexpr (GATHER) { if (last && has_next) { asm volatile("" : "+v"(nv[0]), "+v"(nv[1]), "+v"(nv[2]), "+v"(nv[3])); \
        vA[0][0] = nv[0] * (unsigned)(K * 2) + gcoff[0]; vA[0][1] = nv[1] * (unsigned)(K * 2) + gcoff[1]; vA[1][0] = nv[2] * (unsigned)(K * 2) + gcoff[0]; vA[1][1] = nv[3] * (unsigned)(K * 2) + gcoff[1]; } } } while (0)
#define PG8_LDA(dst, b, h) do { _Pragma("unroll") for (int m = 0; m < 4; ++m) { if constexpr (F8) { dst##8[m] = PG8_CAT8(*(const PG8_LAS i32x4_t*)(lds + PG8_SA(b, h) + aoff + m * 2048), *(const PG8_LAS i32x4_t*)(lds + PG8_SA(b, h) + aoff + m * 2048 + 1024)); } \
        else { _Pragma("unroll") for (int k = 0; k < 2; ++k) dst[m][k] = *(const PG8_LAS bf16x8*)(lds + PG8_SA(b, h) + aoff + m * 2048 + k * 1024); } } } while (0)
#define PG8_LDB(dst, b, h) do { _Pragma("unroll") for (int n = 0; n < 2; ++n) { if constexpr (F8) { dst##8[n] = PG8_CAT8(*(const PG8_LAS i32x4_t*)(lds + PG8_SB(b, h) + boff + n * 2048), *(const PG8_LAS i32x4_t*)(lds + PG8_SB(b, h) + boff + n * 2048 + 1024)); } \
        else { _Pragma("unroll") for (int k = 0; k < 2; ++k) dst[n][k] = *(const PG8_LAS bf16x8*)(lds + PG8_SB(b, h) + boff + n * 2048 + k * 1024); } } } while (0)
#define PG8_CAT8(lo_, hi_) __builtin_shufflevector(lo_, hi_, 0, 1, 2, 3, 4, 5, 6, 7)
#define PG8_MMA(ai, bj, At, Bt) do { __builtin_amdgcn_s_setprio(1); _Pragma("unroll") for (int m = 0; m < 4; ++m) _Pragma("unroll") for (int n = 0; n < 2; ++n) { \
        if constexpr (F8) { acc[ai][bj][m][n] = __builtin_amdgcn_mfma_scale_f32_16x16x128_f8f6f4(Bt##8[n], At##8[m], acc[ai][bj][m][n], 0, 0, 0, 0x7f7f7f7f, 0, 0x7f7f7f7f); } \
        else { _Pragma("unroll") for (int k = 0; k < 2; ++k) acc[ai][bj][m][n] = __builtin_amdgcn_mfma_f32_16x16x32_bf16(Bt[n][k], At[m][k], acc[ai][bj][m][n], 0, 0, 0); } } \
        __builtin_amdgcn_s_setprio(0); } while (0)
#define PG8_WAIT_V(n) asm volatile("s_waitcnt vmcnt(" #n ")" ::: "memory")
#define PG8_WAIT_L(n) asm volatile("s_waitcnt lgkmcnt(" #n ")" ::: "memory")
#define PG8_BAR __builtin_amdgcn_s_barrier()
#define PG8_SCHED __builtin_amdgcn_sched_barrier(0)
    Unit cur, nxt; int ui = 0;
    if (!S.next(0, cur)) return;
    f32x4 acc[2][2][4][2];
#pragma unroll
    for (int a = 0; a < 2; ++a)
#pragma unroll
        for (int b = 0; b < 2; ++b)
#pragma unroll
            for (int m = 0; m < 4; ++m)
#pragma unroll
                for (int n = 0; n < 2; ++n) acc[a][b][m][n] = (f32x4){0.f, 0.f, 0.f, 0.f};
    bf16x8 At[4][2], B0[2][2], B1[2][2]; typedef int i32x8_t __attribute__((ext_vector_type(8))); i32x8_t At8[4], B08[2], B18[2];
    const char* cA = (const char*)g.A + (GATHER ? (size_t)0 : (size_t)cur.pm * tstep); const char* cB = (const char*)g.Bt + (size_t)cur.pn * tstep;
    unsigned vA[2][2], nv[4], gcoff[2]; int grow[2];
    if constexpr (GATHER) {
#pragma unroll
        for (int i = 0; i < 2; ++i) { int R, C; stage_rc(tid * 16 + i * 8192, R, C); grow[i] = R; gcoff[i] = (unsigned)(C * 2); }
#pragma unroll
        for (int h = 0; h < 2; ++h)
#pragma unroll
            for (int i = 0; i < 2; ++i) vA[h][i] = (unsigned)g.rows[cur.pm * BM + h * HALF + grow[i]] * (unsigned)(K * 2) + gcoff[i];
    }
    S.a_ready(cur);
    if constexpr (SP2) {
        PG8_STAGE(PG8_SB(0, 0), cB, voffB); PG8_STAGE(PG8_SB(0, 1), cB + hstep, voffB); PG8_STAGE_A(PG8_SA(0, 0), cA, 0); PG8_STAGE_A(PG8_SA(0, 1), cA, 1);
        if (wr == 1) PG8_BAR;
        PG8_WAIT_V(2); PG8_BAR;
        PG8_STAGE(PG8_SB(1, 0), cB + kstep, voffB); PG8_STAGE_A(PG8_SA(1, 0), cA + kstep, 0); PG8_STAGE(PG8_SB(1, 1), cB + hstep + kstep, voffB);
        PG8_WAIT_V(6); PG8_BAR;
    } else {
        PG8_STAGE(PG8_SB(0, 0), cB, voffB); PG8_STAGE_A(PG8_SA(0, 0), cA, 0); PG8_STAGE(PG8_SB(0, 1), cB + hstep, voffB); PG8_STAGE_A(PG8_SA(0, 1), cA, 1);
        if (wr == 1) PG8_BAR;
        PG8_WAIT_V(4); PG8_BAR;
        PG8_STAGE(PG8_SB(1, 0), cB + kstep, voffB); PG8_STAGE_A(PG8_SA(1, 0), cA + kstep, 0); PG8_STAGE(PG8_SB(1, 1), cB + hstep + kstep, voffB);
        PG8_WAIT_V(6); PG8_BAR;
    }
    for (;;) {
        const bool has_next = S.next(ui + 1, nxt);
        const char* nA = (has_next && !GATHER) ? (const char*)g.A + (size_t)nxt.pm * tstep : cA; const char* nB = has_next ? (const char*)g.Bt + (size_t)nxt.pn * tstep : cB;
        if constexpr (GATHER) { if (has_next) { const int* rp = g.rows + nxt.pm * BM;
            asm volatile("global_load_dword %0, %1, off" : "=&v"(nv[0]) : "v"(rp + grow[0]) : "memory"); asm volatile("global_load_dword %0, %1, off" : "=&v"(nv[1]) : "v"(rp + grow[1]) : "memory");
            asm volatile("global_load_dword %0, %1, off" : "=&v"(nv[2]) : "v"(rp + HALF + grow[0]) : "memory"); asm volatile("global_load_dword %0, %1, off" : "=&v"(nv[3]) : "v"(rp + HALF + grow[1]) : "memory"); } }
#pragma unroll 1
        for (int t = 0; t < nt; t += 2) {
            const bool last = (t == nt - 2);
            const char* a1 = cA + (size_t)(t + 1) * kstep;
            const char* a2 = last ? nA : cA + (size_t)(t + 2) * kstep; const char* b2 = last ? nB : cB + (size_t)(t + 2) * kstep;
            const char* a3 = a2 + kstep; const char* b3 = b2 + kstep;
            if (last && has_next) S.a_ready(nxt);
            if constexpr (SP2) {
            PG8_LDB(B0, 0, 0); PG8_LDB(B1, 0, 1); PG8_SCHED; PG8_LDA(At, 0, 0); PG8_STAGE_A(PG8_SA(1, 1), a1, 1); PG8_GATHER_SWITCH();
            PG8_WAIT_V(8); PG8_WAIT_L(0); PG8_BAR; PG8_MMA(0, 0, At, B0); PG8_MMA(0, 1, At, B1); PG8_BAR; PG8_SCHED;
            PG8_LDA(At, 0, 1); PG8_STAGE(PG8_SB(0, 0), b2, voffB); PG8_STAGE(PG8_SB(0, 1), b2 + hstep, voffB); PG8_STAGE_A(PG8_SA(0, 0), a2, 0);
            PG8_WAIT_V(8); PG8_WAIT_L(0); PG8_BAR; PG8_MMA(1, 0, At, B0); PG8_MMA(1, 1, At, B1); PG8_BAR; PG8_SCHED;
            PG8_LDB(B0, 1, 0); PG8_LDB(B1, 1, 1); PG8_SCHED; PG8_LDA(At, 1, 0); PG8_STAGE_A(PG8_SA(0, 1), a2, 1);
            PG8_WAIT_V(8); PG8_WAIT_L(0); PG8_BAR; PG8_MMA(0, 0, At, B0); PG8_MMA(0, 1, At, B1); PG8_BAR; PG8_SCHED;
            PG8_LDA(At, 1, 1); PG8_STAGE(PG8_SB(1, 0), b3, voffB); PG8_STAGE(PG8_SB(1, 1), b3 + hstep, voffB); PG8_STAGE_A(PG8_SA(1, 0), a3, 0);
            PG8_WAIT_V(8); PG8_WAIT_L(0); PG8_BAR; PG8_MMA(1, 0, At, B0); PG8_MMA(1, 1, At, B1); PG8_BAR; PG8_SCHED;
            } else {
            PG8_LDB(B0, 0, 0); PG8_SCHED; PG8_LDA(At, 0, 0); PG8_STAGE_A(PG8_SA(1, 1), a1, 1); PG8_GATHER_SWITCH();
            PG8_WAIT_L(8); PG8_BAR; PG8_WAIT_L(0); PG8_MMA(0, 0, At, B0); PG8_BAR; PG8_SCHED;
            PG8_LDB(B1, 0, 1); PG8_STAGE(PG8_SB(0, 0), b2, voffB);
            PG8_BAR; PG8_WAIT_L(0); PG8_MMA(0, 1, At, B1); PG8_BAR;
            PG8_LDA(At, 0, 1); PG8_STAGE_A(PG8_SA(0, 0), a2, 0);
            PG8_BAR; PG8_WAIT_L(0); PG8_MMA(1, 0, At, B0); PG8_BAR; PG8_SCHED;
            PG8_STAGE(PG8_SB(0, 1), b2 + hstep, voffB);
            PG8_WAIT_V(6); PG8_BAR; PG8_MMA(1, 1, At, B1); PG8_BAR;
            PG8_LDB(B0, 1, 0); PG8_SCHED; PG8_LDA(At, 1, 0); PG8_STAGE_A(PG8_SA(0, 1), a2, 1);
            PG8_WAIT_L(8); PG8_BAR; PG8_WAIT_L(0); PG8_MMA(0, 0, At, B0); PG8_BAR; PG8_SCHED;
            PG8_LDB(B1, 1, 1); PG8_STAGE(PG8_SB(1, 0), b3, voffB);
            PG8_BAR; PG8_WAIT_L(0); PG8_MMA(0, 1, At, B1); PG8_BAR;
            PG8_LDA(At, 1, 1); PG8_STAGE_A(PG8_SA(1, 0), a3, 0);
            PG8_BAR; PG8_WAIT_L(0); PG8_MMA(1, 0, At, B0); PG8_BAR; PG8_SCHED;
            PG8_STAGE(PG8_SB(1, 1), b3 + hstep, voffB);
            PG8_WAIT_V(6); PG8_BAR; PG8_MMA(1, 1, At, B1); PG8_BAR;
            }
        }
        if constexpr (ALIGN_EPI) { if (wr == 0) PG8_BAR; }
        if constexpr (!Epi::AFTER_DRAIN) { E(acc, cur, wr, wc, fr, fq); S.done(cur); }
        if (!has_next) break;
#pragma unroll
        for (int a = 0; a < 2; ++a)
#pragma unroll
            for (int b = 0; b < 2; ++b)
#pragma unroll
                for (int m = 0; m < 4; ++m)
#pragma unroll
                    for (int n = 0; n < 2; ++n) acc[a][b][m][n] = (f32x4){0.f, 0.f, 0.f, 0.f};
        cur = nxt; cA = nA; cB = nB; ++ui;
        if constexpr (ALIGN_EPI) { if (wr == 1) PG8_BAR; }
    }
    PG8_WAIT_V(0);
    if constexpr (!ALIGN_EPI) { if (wr == 0) PG8_BAR; }
    PG8_BAR;
    if constexpr (Epi::AFTER_DRAIN) { E.fused(acc, cur, wr, wc, fr, fq, lds, wid, lane); S.done(cur); }
#undef PG8_SA
#undef PG8_SB
#undef PG8_STAGE
#undef PG8_UNI
#undef PG8_STAGE_A
#undef PG8_GATHER_SWITCH
#undef PG8_LDA
#undef PG8_LDB
#undef PG8_MMA
#undef PG8_CAT8
#undef PG8_WAIT_V
#undef PG8_WAIT_L
#undef PG8_BAR
#undef PG8_SCHED
}
}

constexpr int DM = 2048, NB = 8, SEQ = 2048, CTXL = 256, NH = 16, NKV = 4, HD = 128;
constexpr int ML = NB * SEQ;
constexpr int MC = NB * CTXL;
constexpr int MT = ML + MC;
constexpr int NE = 16, CAPL = 256, CAPC = 32, DFF = 1024;
constexpr int YR = NB * CAPL + NB * CAPC;
constexpr int YT = NE * YR;
constexpr int NMOD = 6 * DM;
constexpr float NORM_EPS = 1e-6f;
constexpr int KSPLIT = 16;

using pg8::Unit; using pg8::f32x4; using pg8::u32x4; using pg8::bf16_t; using pg8::bf16x8; using pg8::cvt_pk_bf16;
typedef float f32x2 __attribute__((ext_vector_type(2)));
typedef unsigned u32x2 __attribute__((ext_vector_type(2)));
typedef float f32x16 __attribute__((ext_vector_type(16)));
typedef short s16x4 __attribute__((ext_vector_type(4)));
#define DI __device__ __forceinline__

DI float bf_lo(unsigned w) { return __uint_as_float(w << 16); }
DI float bf_hi(unsigned w) { return __uint_as_float(w & 0xffff0000u); }
DI unsigned pk4_fp8(float a, float b, float c, float d) {
    a = __builtin_amdgcn_fmed3f(a, -448.0f, 448.0f); b = __builtin_amdgcn_fmed3f(b, -448.0f, 448.0f); c = __builtin_amdgcn_fmed3f(c, -448.0f, 448.0f); d = __builtin_amdgcn_fmed3f(d, -448.0f, 448.0f);
    int w = __builtin_amdgcn_cvt_pk_fp8_f32(a, b, 0, false); w = __builtin_amdgcn_cvt_pk_fp8_f32(c, d, w, true); return (unsigned)w;
}
constexpr float Y8_SCALE = 64.0f, Y8_INV = 1.0f / 64.0f;
constexpr float W8_SCALE = 32.0f, W8_INV = 1.0f / 32.0f;
DI f32x4 unpk4_fp8(unsigned w) { const f32x2 lo = __builtin_amdgcn_cvt_pk_f32_fp8((int)w, false), hi = __builtin_amdgcn_cvt_pk_f32_fp8((int)w, true); return (f32x4){lo.x, lo.y, hi.x, hi.y}; }
DI float silu_f(float a) { return a * __builtin_amdgcn_rcpf(1.0f + __expf(-a)); }

DI int xcd_remap(int wgid, int nwg) { const int q = nwg / 8, r = nwg % 8, xcd = wgid % 8, off = wgid / 8; return (xcd < r ? xcd * (q + 1) : r * (q + 1) + (xcd - r) * q) + off; }
struct QkvOrder {
    int G, c;
    DI bool next(int i, Unit& u) const {
        const int L = i * G + c; if (L >= 800) return false;
        if (L < 768) { const int w = xcd_remap(L, 768); const int nig = 8 * 12, gid = w / nig; u.pm = gid * 8 + ((w % nig) % 8); u.pn = (w % nig) / 8; }
        else { const int j = L - 768; u.pm = 64 + (j >> 2); u.pn = 8 + (j & 3); }
        return true;
    }
    DI void a_ready(const Unit&) const {}
    DI void done(const Unit&) const {}
};
struct MoeOrder {
    int G, c, NP;
    DI bool next(int i, Unit& u) const {
        const int nwg = NE * NP * 8; const int L = i * G + c; if (L >= nwg) return false;
        const int w = xcd_remap(L, nwg); const int per = NP * 8, e = w / per, rem = w % per;
        u.pm = e * 9 + (rem % NP); u.pn = e * 8 + (rem / NP); return true;
    }
    DI void a_ready(const Unit&) const {}
    DI void done(const Unit&) const {}
};

template <int ACT  > struct EpiPair {
    static constexpr bool PERM = true, AFTER_DRAIN = false;
    bf16_t* O; int ldc; int pn_mod;
    DI void operator()(const f32x4 (&acc)[2][2][4][2], const Unit& u, int wr, int wc, int fr, int fq) const {
        const int row0 = u.pm * 256 + wr * 64 + fr, col0 = (u.pn % pn_mod) * 128 + wc * 32 + 8 * fq;
#pragma unroll
        for (int ai = 0; ai < 2; ++ai)
#pragma unroll
            for (int m = 0; m < 4; ++m) {
                bf16_t* rowp = O + (size_t)(row0 + ai * 128 + m * 16) * ldc + col0;
                f32x4 a0 = acc[ai][0][m][0], a1 = acc[ai][0][m][1]; const f32x4 b0 = acc[ai][1][m][0], b1 = acc[ai][1][m][1];
                if (ACT == 1) {
#pragma unroll
                    for (int j = 0; j < 4; ++j) { a0[j] = silu_f(a0[j]); a1[j] = silu_f(a1[j]); } }
                const f32x4 v0 = a0 * b0, v1 = a1 * b1;
                u32x4 w; w.x = cvt_pk_bf16(v0[0], v0[1]); w.y = cvt_pk_bf16(v0[2], v0[3]); w.z = cvt_pk_bf16(v1[0], v1[1]); w.w = cvt_pk_bf16(v1[2], v1[3]);
                *(u32x4*)rowp = w;
            }
    }
};
struct EpiPairF8 {
    static constexpr bool PERM = true, AFTER_DRAIN = false;
    unsigned char* O; int ldc; int pn_mod;
    DI void operator()(const f32x4 (&acc)[2][2][4][2], const Unit& u, int wr, int wc, int fr, int fq) const {
        const int row0 = u.pm * 256 + wr * 64 + fr, col0 = (u.pn % pn_mod) * 128 + wc * 32 + 8 * fq;
#pragma unroll
        for (int ai = 0; ai < 2; ++ai)
#pragma unroll
            for (int m = 0; m < 4; ++m) {
                unsigned char* rowp = O + (size_t)(row0 + ai * 128 + m * 16) * ldc + col0;
                f32x4 a0 = acc[ai][0][m][0] * W8_INV, a1 = acc[ai][0][m][1] * W8_INV; const f32x4 b0 = acc[ai][1][m][0] * W8_INV, b1 = acc[ai][1][m][1] * W8_INV;
#pragma unroll
                for (int j = 0; j < 4; ++j) { a0[j] = silu_f(a0[j]); a1[j] = silu_f(a1[j]); }
                const f32x4 v0 = a0 * b0, v1 = a1 * b1;
                u32x2 w; w.x = pk4_fp8(v0[0], v0[1], v0[2], v0[3]); w.y = pk4_fp8(v1[0], v1[1], v1[2], v1[3]);
                *(u32x2*)rowp = w;
            }
    }
};
struct EpiConvGate {
    static constexpr bool PERM = true, AFTER_DRAIN = false;
    const bf16_t* U; bf16_t* Z; const float* cw;
    DI void operator()(const f32x4 (&acc)[2][2][4][2], const Unit& u, int wr, int wc, int fr, int fq) const {
        const int row0 = u.pm * 256 + wr * 64 + fr, col0 = u.pn * 256 + wc * 32 + 8 * fq;
#pragma unroll
        for (int bj = 0; bj < 2; ++bj) {
            const int c = col0 + bj * 128;
            f32x4 w0a = *(const f32x4*)(cw + c), w0b = *(const f32x4*)(cw + c + 4), w1a = *(const f32x4*)(cw + 2048 + c), w1b = *(const f32x4*)(cw + 2048 + c + 4), w2a = *(const f32x4*)(cw + 4096 + c), w2b = *(const f32x4*)(cw + 4096 + c + 4);
#pragma unroll
            for (int ai = 0; ai < 2; ++ai)
#pragma unroll
                for (int m = 0; m < 4; ++m) {
                    const int row = row0 + ai * 128 + m * 16;
                    const int tpos = row < ML ? (row & (SEQ - 1)) : ((row - ML) & (CTXL - 1)); const int len = row < ML ? SEQ : CTXL;
                    const u32x4 z4 = (u32x4){0u, 0u, 0u, 0u};
                    const u32x4 uc = *(const u32x4*)(U + (size_t)row * DM + c);
                    const u32x4 up = tpos > 0 ? *(const u32x4*)(U + (size_t)(row - 1) * DM + c) : z4;
                    const u32x4 un = tpos < len - 1 ? *(const u32x4*)(U + (size_t)(row + 1) * DM + c) : z4;
                    f32x4 ya, yb;
                    ya[0] = w0a[0] * bf_lo(up.x) + w1a[0] * bf_lo(uc.x) + w2a[0] * bf_lo(un.x); ya[1] = w0a[1] * bf_hi(up.x) + w1a[1] * bf_hi(uc.x) + w2a[1] * bf_hi(un.x);
                    ya[2] = w0a[2] * bf_lo(up.y) + w1a[2] * bf_lo(uc.y) + w2a[2] * bf_lo(un.y); ya[3] = w0a[3] * bf_hi(up.y) + w1a[3] * bf_hi(uc.y) + w2a[3] * bf_hi(un.y);
                    yb[0] = w0b[0] * bf_lo(up.z) + w1b[0] * bf_lo(uc.z) + w2b[0] * bf_lo(un.z); yb[1] = w0b[1] * bf_hi(up.z) + w1b[1] * bf_hi(uc.z) + w2b[1] * bf_hi(un.z);
                    yb[2] = w0b[2] * bf_lo(up.w) + w1b[2] * bf_lo(uc.w) + w2b[2] * bf_lo(un.w); yb[3] = w0b[3] * bf_hi(up.w) + w1b[3] * bf_hi(uc.w) + w2b[3] * bf_hi(un.w);
                    const f32x4 v0 = acc[ai][bj][m][0] * ya, v1 = acc[ai][bj][m][1] * yb;
                    u32x4 w; w.x = cvt_pk_bf16(v0[0], v0[1]); w.y = cvt_pk_bf16(v0[2], v0[3]); w.z = cvt_pk_bf16(v1[0], v1[1]); w.w = cvt_pk_bf16(v1[2], v1[3]);
                    *(u32x4*)(Z + (size_t)row * DM + c) = w;
                }
        }
    }
};
template <bool BASE_F32> struct EpiResid {
    static constexpr bool PERM = true, AFTER_DRAIN = false;
    const float* base_lat; const float* base_ctx; bf16_t* out; const float* gate; float ws;
    DI void operator()(const f32x4 (&acc)[2][2][4][2], const Unit& u, int wr, int wc, int fr, int fq) const {
        const int rowt = u.pm * 256; const int cr = rowt < ML ? (rowt >> 11) : 8;
        const float* base = rowt < ML ? base_lat : base_ctx - (size_t)ML * DM;
        const int row0 = rowt + wr * 64 + fr, col0 = u.pn * 256 + wc * 32 + 8 * fq;
        f32x4 gv[2][2];
#pragma unroll
        for (int bj = 0; bj < 2; ++bj)
#pragma unroll
            for (int n = 0; n < 2; ++n) gv[bj][n] = *(const f32x4*)(gate + (size_t)cr * NMOD + col0 + bj * 128 + n * 4) * ws;
#pragma unroll
        for (int ai = 0; ai < 2; ++ai)
#pragma unroll
            for (int m = 0; m < 4; ++m) { const size_t off = (size_t)(row0 + ai * 128 + m * 16) * DM + col0;
#pragma unroll
                for (int bj = 0; bj < 2; ++bj) { f32x4 b0, b1;
                    if (BASE_F32) { b0 = *(const f32x4*)(base + off + bj * 128); b1 = *(const f32x4*)(base + off + bj * 128 + 4); }
                    else { const u32x4 hb = *(const u32x4*)(out + off + bj * 128); b0 = (f32x4){bf_lo(hb.x), bf_hi(hb.x), bf_lo(hb.y), bf_hi(hb.y)}; b1 = (f32x4){bf_lo(hb.z), bf_hi(hb.z), bf_lo(hb.w), bf_hi(hb.w)}; }
                    const f32x4 v0 = b0 + gv[bj][0] * acc[ai][bj][m][0], v1 = b1 + gv[bj][1] * acc[ai][bj][m][1];
                    u32x4 w; w.x = cvt_pk_bf16(v0[0], v0[1]); w.y = cvt_pk_bf16(v0[2], v0[3]); w.z = cvt_pk_bf16(v1[0], v1[1]); w.w = cvt_pk_bf16(v1[2], v1[3]);
                    *(u32x4*)(out + off + bj * 128) = w; }
                asm volatile("" ::: "memory"); }
    }
};
struct EpiDown {
    static constexpr bool PERM = true, AFTER_DRAIN = false;
    bf16_t* Y; const float* gatev; float ws;
    DI void operator()(const f32x4 (&acc)[2][2][4][2], const Unit& u, int wr, int wc, int fr, int fq) const {
        const int row0 = u.pm * 256 + wr * 64 + fr, col0 = (u.pn & 7) * 256 + wc * 32 + 8 * fq;
#pragma unroll
        for (int ai = 0; ai < 2; ++ai)
#pragma unroll
            for (int m = 0; m < 4; ++m) { const int row = row0 + ai * 128 + m * 16; const float gt = gatev[row] * ws;
#pragma unroll
                for (int bj = 0; bj < 2; ++bj) { const f32x4 v0 = acc[ai][bj][m][0] * gt, v1 = acc[ai][bj][m][1] * gt;
                    u32x2 w; w.x = pk4_fp8(v0[0], v0[1], v0[2], v0[3]); w.y = pk4_fp8(v1[0], v1[1], v1[2], v1[3]);
                    *(u32x2*)((unsigned char*)Y + (size_t)row * DM + col0 + bj * 128) = w; } }
    }
};
#define LAS3 __attribute__((address_space(3)))
struct EpiQkvNorm {
    static constexpr bool PERM = true, AFTER_DRAIN = false;
    bf16_t* Q; bf16_t* K; bf16_t* V; const float* qg; const float* kg; LAS3 float* P; float ws;
    DI void operator()(const f32x4 (&acc)[2][2][4][2], const Unit& u, int wr, int wc, int fr, int fq) const {
        const int row0 = u.pm * 256 + wr * 64 + fr; int colt = u.pn * 256;
        if (colt >= 2560) {
            const int col0 = colt - 2560 + wc * 32 + 8 * fq;
#pragma unroll
            for (int ai = 0; ai < 2; ++ai)
#pragma unroll
                for (int m = 0; m < 4; ++m) { bf16_t* rowp = V + (size_t)(row0 + ai * 128 + m * 16) * 512 + col0;
#pragma unroll
                    for (int bj = 0; bj < 2; ++bj) { const f32x4 v0 = acc[ai][bj][m][0] * ws, v1 = acc[ai][bj][m][1] * ws;
                        u32x4 w; w.x = cvt_pk_bf16(v0[0], v0[1]); w.y = cvt_pk_bf16(v0[2], v0[3]); w.z = cvt_pk_bf16(v1[0], v1[1]); w.w = cvt_pk_bf16(v1[2], v1[3]);
                        *(u32x4*)(rowp + bj * 128) = w; } }
            return;
        }
        const bool isq = colt < 2048; bf16_t* base = isq ? Q : K; const int ld = isq ? 2048 : 512; if (!isq) colt -= 2048;
        const int rl0 = wr * 64 + fr;
#pragma unroll
        for (int ai = 0; ai < 2; ++ai)
#pragma unroll
            for (int m = 0; m < 4; ++m)
#pragma unroll
                for (int bj = 0; bj < 2; ++bj) { const f32x4 a = acc[ai][bj][m][0], b = acc[ai][bj][m][1];
                    float s = (a[0] * a[0] + a[1] * a[1]) + (a[2] * a[2] + a[3] * a[3]) + (b[0] * b[0] + b[1] * b[1]) + (b[2] * b[2] + b[3] * b[3]);
                    s += __shfl_xor(s, 16); s += __shfl_xor(s, 32);
                    P[((ai * 128 + m * 16 + rl0) * 2 + bj) * 4 + wc] = s; }
        asm volatile("s_waitcnt lgkmcnt(0)" ::: "memory"); __builtin_amdgcn_s_barrier(); asm volatile("" ::: "memory");
        constexpr float QSCALE = 0.08838834764831845f * 1.4426950408889634f;
        int fqo = fq, fro = fr; asm volatile("" : "+v"(fqo), "+v"(fro));
        const int i0 = 16 * (wc & 1) + 4 * fqo, d0 = 64 * (wc >> 1) + i0;
        const float* gp = isq ? qg : kg; f32x4 g0 = *(const f32x4*)(gp + d0), g1 = *(const f32x4*)(gp + d0 + 32);
        if (isq) { g0 = g0 * QSCALE; g1 = g1 * QSCALE; }
        const float wsq = ws * ws * (1.0f / HD);
#define QKV_OUT(ai_, m_, cs_, sn_) do { const int row_ = row0 + (ai_) * 128 + (m_) * 16; \
            _Pragma("unroll") for (int bj = 0; bj < 2; ++bj) { const f32x4 pp = *(const LAS3 f32x4*)(P + (((ai_) * 128 + (m_) * 16 + rl0) * 2 + bj) * 4); \
                const float rstd = ws * __builtin_amdgcn_rsqf(((pp[0] + pp[1]) + (pp[2] + pp[3])) * wsq + NORM_EPS);     \
                const f32x4 a = acc[ai_][bj][m_][0] * (g0 * rstd), b = acc[ai_][bj][m_][1] * (g1 * rstd); \
                const f32x4 o1 = a * (cs_) - b * (sn_), o2 = b * (cs_) + a * (sn_); \
                u32x4 w; w.x = cvt_pk_bf16(o1[0], o1[1]); w.y = cvt_pk_bf16(o1[2], o1[3]); w.z = cvt_pk_bf16(o2[0], o2[1]); w.w = cvt_pk_bf16(o2[2], o2[3]); \
                *(u32x4*)(base + (size_t)row_ * ld + colt + bj * 128 + wc * 32 + 8 * fq) = w; } __builtin_amdgcn_sched_barrier(0); } while (0)
        if (u.pm >= 64) {
            const f32x4 one = (f32x4){1.f, 1.f, 1.f, 1.f}, zero = (f32x4){0.f, 0.f, 0.f, 0.f};
#pragma unroll
            for (int ai = 0; ai < 2; ++ai)
#pragma unroll
                for (int m = 0; m < 4; ++m) QKV_OUT(ai, m, one, zero);
            return;
        }
        f32x4 ifr;
#pragma unroll
        for (int j = 0; j < 4; ++j) ifr[j] = exp2f(-(float)(i0 + j) * (13.287712379549449f / 32.0f)) * 0.15915494309189535f;
        if ((wc >> 1) == 0) {
#pragma unroll
            for (int ai = 0; ai < 2; ++ai) { const float pos = (float)((4 * u.pm + wr + 2 * ai) & 31); f32x4 cs, sn;
#pragma unroll
                for (int j = 0; j < 4; ++j) { const float rev = pos * ifr[j]; cs[j] = __builtin_amdgcn_cosf(rev); sn[j] = __builtin_amdgcn_sinf(rev); }
#pragma unroll
                for (int m = 0; m < 4; ++m) QKV_OUT(ai, m, cs, sn); }
        } else {
#pragma unroll
            for (int m = 0; m < 4; ++m) { const float pos = (float)(16 * m + fro); f32x4 cs, sn;
#pragma unroll
                for (int j = 0; j < 4; ++j) { const float rev = pos * ifr[j]; cs[j] = __builtin_amdgcn_cosf(rev); sn[j] = __builtin_amdgcn_sinf(rev); }
#pragma unroll
                for (int ai = 0; ai < 2; ++ai) QKV_OUT(ai, m, cs, sn); }
        }
#undef QKV_OUT
    }
};

constexpr size_t MiB = 1u << 20;
constexpr size_t WS_CTL = 0, CTL_ZERO_BYTES = 1 * MiB;
constexpr size_t WS_MOD = 1 * MiB;
constexpr size_t WS_MODP = 2 * MiB;
constexpr size_t WS_AFFL = 16 * MiB;
constexpr size_t WS_AFFC = 17 * MiB;
constexpr size_t WS_RWT = 17 * MiB + 128 * 1024;
constexpr size_t WS_IDMAP = 19 * MiB + 768 * 1024;
constexpr size_t WS_ROWSRC = 17 * MiB + 512 * 1024;
constexpr size_t WS_GATEV = 18 * MiB;
constexpr size_t WS_INV = 18 * MiB + 512 * 1024;
constexpr size_t WS_W1A = 20 * MiB;
constexpr size_t WS_W1B = 36 * MiB;
constexpr size_t WS_W2 = 44 * MiB;
constexpr size_t WS_WQKV = 52 * MiB;
constexpr size_t WS_WO = 64 * MiB;
constexpr size_t WS_WGU = 72 * MiB;
constexpr size_t WS_WDN = 328 * MiB;
constexpr size_t WS_H = 456 * MiB;
constexpr size_t WS_A = 600 * MiB;
constexpr size_t WS_U = 672 * MiB;
constexpr size_t WS_Z = 744 * MiB;
constexpr size_t WS_Q = WS_U, WS_K = WS_Z, WS_V = WS_Z + 18 * MiB;
constexpr size_t WS_HM = 816 * MiB;
constexpr size_t WS_O = WS_HM;
constexpr size_t WS_Y = 888 * MiB;
constexpr size_t WS_END = 1032 * MiB;
constexpr int CW_BAR = 4096;

constexpr int RING_BYTES = 131072;
constexpr int MISC_OFF = RING_BYTES + 14336;
constexpr int LDS_BYTES = 147456;

#define GAS __attribute__((address_space(1)))
#define LAS __attribute__((address_space(3)))
#define LDS_WAIT() asm volatile("s_waitcnt lgkmcnt(0)" ::: "memory")
#define VM_WAIT() asm volatile("s_waitcnt vmcnt(0)" ::: "memory")
#define XB_TMO      128
#define XB_XCNT(j)  (256  + 64 * (j))
#define XB_XSUB(j)  (1280 + 64 * (j))
#define XB_XGEN(j)  (2304 + 64 * (j))
#define XB_TOP      3328
#define XB_TOPGEN   3392
#define XCD_BAR_WORDS 3456
#define XB_SPIN_CAP (1u << 18)

__device__ __forceinline__ unsigned xb_ld(unsigned* p)              { return __hip_atomic_load(p, __ATOMIC_RELAXED, __HIP_MEMORY_SCOPE_AGENT); }
__device__ __forceinline__ unsigned xb_add(unsigned* p, unsigned v) { return __hip_atomic_fetch_add(p, v, __ATOMIC_RELAXED, __HIP_MEMORY_SCOPE_AGENT); }
__device__ __forceinline__ unsigned xb_xcc_id() { return (unsigned)__builtin_amdgcn_s_getreg((3 << 11) | 20) & 0xFu; }
#define XB_SPIN(cond, bar) do { unsigned _sp = 0; while (cond) { __builtin_amdgcn_s_sleep(1); \
    if ((++_sp & 255u) == 0u) { if (xb_ld(&(bar)[XB_TMO])) break; if (_sp > XB_SPIN_CAP) { atomicAdd(&(bar)[XB_TMO], 1u); break; } } } } while (0)

struct XcdBarrier {
    unsigned* bar; unsigned x;
    volatile LAS unsigned* st;
};

__device__ __forceinline__ XcdBarrier xcd_barrier_post(unsigned* bar, volatile LAS unsigned* st) {
    XcdBarrier b; b.bar = bar; b.x = xb_xcc_id(); b.st = st;
    if (threadIdx.x == 0) (void)xb_add(&bar[XB_XCNT(b.x)], 1u);
    return b;
}
__device__ __forceinline__ void xcd_barrier_complete(unsigned* bar, unsigned x, unsigned& nloc, unsigned& nx) {
    const unsigned G = gridDim.x * gridDim.y * gridDim.z;
    unsigned sum, cnt, mine, sp = 0u;
    for (;;) {
        sum = 0u; cnt = 0u; mine = 0u;
#pragma unroll
        for (unsigned j = 0; j < 16; ++j) { const unsigned c = xb_ld(&bar[XB_XCNT(j)]); sum += c; cnt += (c > 0u) ? 1u : 0u; mine = (j == x) ? c : mine; }
        if (sum == G) break;
        __builtin_amdgcn_s_sleep(1);
        if ((++sp & 255u) == 0u) { if (xb_ld(&bar[XB_TMO])) break; if (sp > XB_SPIN_CAP) { atomicAdd(&bar[XB_TMO], 1u); break; } }
    }
    nloc = mine > 0u ? mine : 1u; nx = cnt > 0u ? cnt : 1u;
}

__device__ __forceinline__ void xcd_barrier(const XcdBarrier& b) {
    asm volatile("s_waitcnt vmcnt(0)" ::: "memory");
    __syncthreads();
    if (threadIdx.x == 0) {
        unsigned* bar = b.bar;
        __builtin_amdgcn_s_waitcnt(0);
        unsigned nloc = b.st[0], nx = b.st[1];
        if (nloc == 0u) { xcd_barrier_complete(bar, b.x, nloc, nx); b.st[0] = nloc; b.st[1] = nx; }
        const unsigned old = xb_add(&bar[XB_XSUB(b.x)], 1u);
        const unsigned gen = old / nloc;
        if (old + 1u == (gen + 1u) * nloc) {
            __builtin_amdgcn_fence(__ATOMIC_RELEASE, "agent");
            asm volatile("s_waitcnt vmcnt(0)" ::: "memory");
            const unsigned og = xb_add(&bar[XB_TOP], 1u);
            const unsigned tg = og / nx;
            if (og + 1u == (tg + 1u) * nx) xb_add(&bar[XB_TOPGEN], 1u);
            else XB_SPIN(xb_ld(&bar[XB_TOPGEN]) == tg, bar);
            __builtin_amdgcn_fence(__ATOMIC_ACQUIRE, "agent");
            xb_add(&bar[XB_XGEN(b.x)], 1u);
            asm volatile("s_waitcnt vmcnt(0)" ::: "memory");
        } else {
            XB_SPIN(xb_ld(&bar[XB_XGEN(b.x)]) == gen, bar);
            __builtin_amdgcn_fence(__ATOMIC_ACQUIRE, "agent");
            asm volatile("s_waitcnt vmcnt(0)" ::: "memory");
        }
    }
    __syncthreads();
}

DI float wave_sum(float v) {
#pragma unroll
    for (int o = 1; o < 64; o <<= 1) v += __shfl_xor(v, o);
    return v;
}
DI float rdlane(float v, int l) { return __uint_as_float((unsigned)__builtin_amdgcn_readlane((int)__float_as_uint(v), l)); }
DI unsigned pk2(float lo, float hi) { return cvt_pk_bf16(lo, hi); }

DI void ph_adaln(const float* cnd, const float* cctx, const float* ada_w, float* modp, int gw, int NGW, int lane) {
    const int G_ = NGW >> 3;
    for (int task = (gw & 7) * G_ + (gw >> 3); task < 96 * KSPLIT; task += NGW) {
        const int ks = task & (KSPLIT - 1), cg = task / KSPLIT, l = cg / 48, cgl = cg % 48, col0 = cgl * 256 + lane * 4, k0 = ks * 128;
        float sv[9][2];
#pragma unroll
        for (int r = 0; r < 9; ++r)
#pragma unroll
            for (int hh = 0; hh < 2; ++hh) { const int k = k0 + hh * 64 + lane; const float v = r < 8 ? cnd[r * DM + k] : cctx[k]; sv[r][hh] = v / (1.0f + __expf(-v)); }
        f32x4 acc[9];
#pragma unroll
        for (int r = 0; r < 9; ++r) acc[r] = (f32x4){0.f, 0.f, 0.f, 0.f};
        const float* wp = ada_w + ((size_t)l * DM + k0) * NMOD + col0;
#pragma unroll
        for (int hh = 0; hh < 2; ++hh) {
#pragma unroll 16
            for (int kk = 0; kk < 64; ++kk) {
                const f32x4 w = __builtin_nontemporal_load((const f32x4*)(wp + (size_t)(hh * 64 + kk) * NMOD));
#pragma unroll
                for (int r = 0; r < 9; ++r) { const float s = rdlane(sv[r][hh], kk); acc[r] += w * s; }
            }
        }
#pragma unroll
        for (int r = 0; r < 9; ++r) *(f32x4*)(modp + ((size_t)((ks * 2 + l) * 9 + r)) * NMOD + col0) = acc[r];
    }
}
struct CvtPtrs { const float *cin, *cout, *wqkv, *wo, *wg, *wu, *wd; bf16_t *W1A, *W1B, *W2, *WQKV, *WO, *WGU, *WDN; };
constexpr int CVT_E0 = 6656, CVT_L = 24576, CVT_TOTAL = CVT_E0 + 2 * CVT_L;
DI void cvt_resolve(const CvtPtrs& P, int it, const float*& src, int& ldw, bf16_t*& dst, int& ldd, bool& qperm, bool& f8) {
    int r = it; qperm = false; f8 = false;
    if (r < 3072) { const int kt = ((r >> 3) / 96) * 8 + (r & 7), nt = (r >> 3) % 96, n0 = nt * 64, part = n0 >> 11, j0 = n0 & 2047;
        src = P.cin + (size_t)(kt * 64) * 6144 + n0; ldw = 6144; ldd = DM;
        dst = (part == 0 ? P.W1B + (size_t)j0 * DM : P.W1A + (size_t)((j0 >> 7) * 256 + (part == 2 ? 128 : 0) + (j0 & 127)) * DM) + kt * 64; return; } r -= 3072;
    if (r < 1024) { const int kt = ((r >> 3) / 32) * 8 + (r & 7), nt = (r >> 3) % 32; src = P.cout + (size_t)(kt * 64) * DM + nt * 64; ldw = DM; dst = P.W2 + (size_t)(nt * 64) * DM + kt * 64; ldd = DM; return; } r -= 1024;
    if (r < 1536) { const int kt = ((r >> 3) / 48) * 8 + (r & 7), nt = (r >> 3) % 48; src = P.wqkv + (size_t)(kt * 64) * 3072 + nt * 64; ldw = 3072; qperm = nt < 40;     f8 = true; dst = (bf16_t*)((unsigned char*)P.WQKV + (size_t)(nt * 64) * DM + kt * 64); ldd = DM;     return; } r -= 1536;
    if (r < 1024) { const int kt = ((r >> 3) / 32) * 8 + (r & 7), nt = (r >> 3) % 32; src = P.wo + (size_t)(kt * 64) * DM + nt * 64; ldw = DM; f8 = true;
        dst = (bf16_t*)((unsigned char*)P.WO + (size_t)(nt * 64) * DM + kt * 64); ldd = DM; return; } r -= 1024;
    const int l = r / CVT_L, rr = r % CVT_L, kind = rr / 8192, q = rr % 8192, le = l * 16 + q / 512, rem = q % 512;
    f8 = true;
    if (kind < 2) { const int kt = ((rem >> 3) / 16) * 8 + (rem & 7), nt = (rem >> 3) % 16, n0 = nt * 64;
        src = (kind ? P.wu : P.wg) + (size_t)le * DM * DFF + (size_t)(kt * 64) * DFF + n0; ldw = DFF;
        dst = (bf16_t*)((unsigned char*)P.WGU + (size_t)(le * 2048 + (n0 >> 7) * 256 + kind * 128 + (n0 & 127)) * DM + kt * 64); ldd = DM; }
    else { const int kt = ((rem >> 3) / 32) * 8 + (rem & 7), nt = (rem >> 3) % 32;
        src = P.wd + (size_t)le * DFF * DM + (size_t)(kt * 64) * DM + nt * 64; ldw = DM; dst = (bf16_t*)((unsigned char*)P.WDN + (size_t)(le * 2048 + nt * 64) * DFF + kt * 64); ldd = DFF; }
}
constexpr int CVT_P = 36;
DI void cvt_range(const CvtPtrs& P, int lo, int hi, int w, int NW, LAS unsigned* scr, int lane) {
    int it = lo + w; if (it >= hi) return;
    const int c = lane & 15, q = lane >> 4;
    const float* src; int ldw; bf16_t* dst; int ldd; bool qperm, f8; cvt_resolve(P, it, src, ldw, dst, ldd, qperm, f8);
    f32x4 v[16];
#pragma unroll
    for (int rr = 0; rr < 16; ++rr) v[rr] = __builtin_nontemporal_load((const f32x4*)(src + (size_t)(16 * q + rr) * ldw + 4 * c));
    for (;;) {
        const bool cf8 = f8; const int wrow = qperm ? 32 * ((c >> 2) & 1) + 8 * (c & 3) + 4 * (c >> 3) : 4 * c;
        u32x4 pa[4], pb[4];
        if (cf8) {
#pragma unroll
            for (int i = 0; i < 4; ++i) { pa[i].x = pk4_fp8(v[0][i] * W8_SCALE, v[1][i] * W8_SCALE, v[2][i] * W8_SCALE, v[3][i] * W8_SCALE); pa[i].y = pk4_fp8(v[4][i] * W8_SCALE, v[5][i] * W8_SCALE, v[6][i] * W8_SCALE, v[7][i] * W8_SCALE);
                                          pa[i].z = pk4_fp8(v[8][i] * W8_SCALE, v[9][i] * W8_SCALE, v[10][i] * W8_SCALE, v[11][i] * W8_SCALE); pa[i].w = pk4_fp8(v[12][i] * W8_SCALE, v[13][i] * W8_SCALE, v[14][i] * W8_SCALE, v[15][i] * W8_SCALE); pb[i] = pa[i]; }
        } else {
#pragma unroll
            for (int i = 0; i < 4; ++i) { pa[i].x = pk2(v[0][i], v[1][i]); pa[i].y = pk2(v[2][i], v[3][i]); pa[i].z = pk2(v[4][i], v[5][i]); pa[i].w = pk2(v[6][i], v[7][i]);
                                          pb[i].x = pk2(v[8][i], v[9][i]); pb[i].y = pk2(v[10][i], v[11][i]); pb[i].z = pk2(v[12][i], v[13][i]); pb[i].w = pk2(v[14][i], v[15][i]); }
        }
        const int nit = it + NW; bf16_t* cdst = dst; const int cldd = ldd;
        if (nit < hi) { cvt_resolve(P, nit, src, ldw, dst, ldd, qperm, f8);
#pragma unroll
            for (int rr = 0; rr < 16; ++rr) v[rr] = __builtin_nontemporal_load((const f32x4*)(src + (size_t)(16 * q + rr) * ldw + 4 * c)); }
        if (cf8) {
#pragma unroll
            for (int i = 0; i < 4; ++i) *(LAS u32x4*)(scr + (wrow + i) * 20 + 4 * q) = pa[i];
            LDS_WAIT(); asm volatile("" ::: "memory");
#pragma unroll
            for (int j = 0; j < 4; ++j) { const int ch = lane + 64 * j, n = ch >> 2, part = ch & 3; const u32x4 o = *(const LAS u32x4*)(scr + n * 20 + 4 * part);
                *(u32x4*)((unsigned char*)cdst + (size_t)n * cldd + 16 * part) = o; }
        } else {
#pragma unroll
            for (int i = 0; i < 4; ++i) { *(LAS u32x4*)(scr + (wrow + i) * CVT_P + 8 * q) = pa[i]; *(LAS u32x4*)(scr + (wrow + i) * CVT_P + 8 * q + 4) = pb[i]; }
            LDS_WAIT(); asm volatile("" ::: "memory");
#pragma unroll
            for (int j = 0; j < 8; ++j) { const int n = (lane >> 3) + 8 * j; const u32x4 o = *(const LAS u32x4*)(scr + n * CVT_P + 4 * (lane & 7));
                *(u32x4*)(cdst + (size_t)n * cldd + 8 * (lane & 7)) = o; }
        }
        LDS_WAIT(); asm volatile("" ::: "memory");
        if (nit >= hi) break;
        it = nit;
    }
}
DI void ph_modred(const float* modp, const float* ada_b, float* mod, int gtid, int GT) {
    for (int i = gtid; i < 2 * 9 * NMOD; i += GT) { const int l = i / (9 * NMOD), j = i % NMOD; float s = ada_b[l * NMOD + j];
#pragma unroll
        for (int ks = 0; ks < KSPLIT; ++ks) s += modp[(size_t)ks * (2 * 9 * NMOD) + i];
        mod[i] = s; }
}
DI void row_load(const float* p, f32x4 (&v)[8], int lane) {
#pragma unroll
    for (int j = 0; j < 8; ++j) v[j] = *(const f32x4*)(p + 4 * lane + 256 * j);
}
DI void row_load_bf(const bf16_t* p, f32x4 (&v)[8], int lane) {
#pragma unroll
    for (int j = 0; j < 8; ++j) { const u32x2 w = *(const u32x2*)(p + 4 * lane + 256 * j); v[j] = (f32x4){bf_lo(w.x), bf_hi(w.x), bf_lo(w.y), bf_hi(w.y)}; }
}
DI void row_modulate(const f32x4 (&v)[8], f32x4 (&y)[8], const float* gain, const float* shift, const float* scale, int lane) {
    float ss = 0.f;
#pragma unroll
    for (int j = 0; j < 8; ++j) ss += (v[j][0] * v[j][0] + v[j][1] * v[j][1]) + (v[j][2] * v[j][2] + v[j][3] * v[j][3]);
    ss = wave_sum(ss);
    const float rstd = 1.0f / sqrtf(ss * (1.0f / DM) + NORM_EPS);
#pragma unroll
    for (int j = 0; j < 8; ++j) { const int c = 4 * lane + 256 * j; const f32x4 g = *(const f32x4*)(gain + c), sh = *(const f32x4*)(shift + c), sc = *(const f32x4*)(scale + c);
        y[j] = ((v[j] * rstd) * g) * (sc + 1.0f) + sh; }
}
DI void row_modulate2(const f32x4 (&v0)[8], const f32x4 (&v1)[8], f32x4 (&y0)[8], f32x4 (&y1)[8], const float* gain, const float* shift, const float* scale, int lane) {
    float s0 = 0.f, s1 = 0.f;
#pragma unroll
    for (int j = 0; j < 8; ++j) { s0 += (v0[j][0] * v0[j][0] + v0[j][1] * v0[j][1]) + (v0[j][2] * v0[j][2] + v0[j][3] * v0[j][3]); s1 += (v1[j][0] * v1[j][0] + v1[j][1] * v1[j][1]) + (v1[j][2] * v1[j][2] + v1[j][3] * v1[j][3]); }
    s0 = wave_sum(s0); s1 = wave_sum(s1);
    const float r0 = 1.0f / sqrtf(s0 * (1.0f / DM) + NORM_EPS), r1 = 1.0f / sqrtf(s1 * (1.0f / DM) + NORM_EPS);
#pragma unroll
    for (int j = 0; j < 8; ++j) { const int c = 4 * lane + 256 * j; const f32x4 g = *(const f32x4*)(gain + c), sh = *(const f32x4*)(shift + c), sc = *(const f32x4*)(scale + c);
        y0[j] = ((v0[j] * r0) * g) * (sc + 1.0f) + sh; y1[j] = ((v1[j] * r1) * g) * (sc + 1.0f) + sh; }
}
DI void row_store_bf16(bf16_t* p, const f32x4 (&y)[8], int lane) {
#pragma unroll
    for (int j = 0; j < 8; ++j) { u32x2 w; w.x = pk2(y[j][0], y[j][1]); w.y = pk2(y[j][2], y[j][3]); *(u32x2*)(p + 4 * lane + 256 * j) = w; }
}
DI void ph_mod0(const float* x, const float* ctx, const float* gain, const float* mod0, bf16_t* A, int gw, int NGW, int lane) {
    int row = gw; if (row >= MT) return;
    f32x4 v[8], vn[8];
    row_load(row < ML ? x + (size_t)row * DM : ctx + (size_t)(row - ML) * DM, v, lane);
    for (;;) {
        const int nrow = row + NGW; const bool more = nrow < MT;
        if (more) row_load(nrow < ML ? x + (size_t)nrow * DM : ctx + (size_t)(nrow - ML) * DM, vn, lane);
        const int cr = row < ML ? (row >> 11) : 8;
        f32x4 y[8]; row_modulate(v, y, gain, mod0 + (size_t)cr * NMOD + 0 * DM, mod0 + (size_t)cr * NMOD + 1 * DM, lane);
        row_store_bf16(A + (size_t)row * DM, y, lane);
        if (!more) break;
#pragma unroll
        for (int j = 0; j < 8; ++j) v[j] = vn[j];
        row = nrow;
    }
}
DI float reduce8(const float (&v)[8], int lane) {
    const bool u0 = lane & 1, u1 = lane & 2, u2 = lane & 4;
    float a[4], b2[2];
#pragma unroll
    for (int k = 0; k < 4; ++k) { const float lo = v[2 * k], hi = v[2 * k + 1]; a[k] = (u0 ? hi : lo) + __shfl_xor(u0 ? lo : hi, 1); }
#pragma unroll
    for (int k = 0; k < 2; ++k) { const float lo = a[2 * k], hi = a[2 * k + 1]; b2[k] = (u1 ? hi : lo) + __shfl_xor(u1 ? lo : hi, 2); }
    return (u2 ? b2[1] : b2[0]) + __shfl_xor(u2 ? b2[0] : b2[1], 4);
}
DI float reduce_halves(float lo8, float hi8, int lane) {
    const bool u3 = lane & 8;
    float t = (u3 ? hi8 : lo8) + __shfl_xor(u3 ? lo8 : hi8, 8);
    t += __shfl_xor(t, 16); t += __shfl_xor(t, 32); return t;
}
DI float softmax16(float lg) {
    float mx = lg;
#pragma unroll
    for (int o = 1; o < 16; o <<= 1) mx = fmaxf(mx, __shfl_xor(mx, o));
    const float ex = __expf(lg - mx); float den = ex;
#pragma unroll
    for (int o = 1; o < 16; o <<= 1) den += __shfl_xor(den, o);
    return ex / den;
}
DI void aff_store(float v, float* affL, float* affC, int row, int lane) {
    if (lane < 16) { if (row < ML) { const int b = row >> 11, n = row & 2047; affL[(size_t)(b * 16 + lane) * SEQ + n] = v; }
                     else { const int rc = row - ML, b = rc >> 8, n = rc & 255; affC[(size_t)(b * 16 + lane) * CTXL + n] = v; } }
}
DI void router_rows2(const f32x4 (&y0)[8], const f32x4 (&y1)[8], const LAS float* rwT, float* affL, float* affC, int row0, int lane) {
    f32x2 yp[8][4];
#pragma unroll
    for (int j = 0; j < 8; ++j)
#pragma unroll
        for (int q = 0; q < 4; ++q) yp[j][q] = (f32x2){y0[j][q], y1[j][q]};
    float r0[2], r1[2];
#pragma unroll
    for (int hf = 0; hf < 2; ++hf) {
        float l0[8], l1[8];
#pragma unroll
        for (int e = 0; e < 8; ++e) { f32x2 acc = (f32x2){0.f, 0.f};
#pragma unroll
            for (int j = 0; j < 8; ++j) { const f32x4 w = *(const LAS f32x4*)(rwT + (8 * hf + e) * DM + 4 * lane + 256 * j);
#pragma unroll
                for (int q = 0; q < 4; ++q) acc = __builtin_elementwise_fma(yp[j][q], (f32x2){w[q], w[q]}, acc); }
            l0[e] = acc.x; l1[e] = acc.y; __builtin_amdgcn_sched_barrier(0); }
        r0[hf] = reduce8(l0, lane); r1[hf] = reduce8(l1, lane);
    }
    const float a0 = softmax16(reduce_halves(r0[0], r0[1], lane)), a1 = softmax16(reduce_halves(r1[0], r1[1], lane));
    aff_store(a0, affL, affC, row0, lane); aff_store(a1, affL, affC, row0 + 1, lane);
}
DI void ph_rwt(const float* rw, float* rwT, int gtid, int GT) {
    for (int i = gtid; i < 2 * 16 * DM; i += GT) { const int l = i >> 15, e = (i >> 11) & 15, d = i & (DM - 1); rwT[i] = rw[(size_t)l * DM * 16 + d * 16 + e]; }
}
DI void load_router(const float* rwT_g, LAS float* rwT, int tid) {
    for (int i = tid; i < DM * 16 / 4; i += 512) ((LAS f32x4*)rwT)[i] = ((const f32x4*)rwT_g)[i];
    __syncthreads();
}
DI void modffn_table(const float* gain, const float* shift, const float* scale, LAS u32x4* tab, int tid) {
    const int c = 4 * (tid & 63) + 256 * (tid >> 6);
    const f32x4 g = *(const f32x4*)(gain + c), sc = *(const f32x4*)(scale + c), sh = *(const f32x4*)(shift + c); const f32x4 gm = g * (sc + 1.0f);
    u32x4 e; e.x = pk2(gm[0], gm[1]); e.y = pk2(gm[2], gm[3]); e.z = pk2(sh[0], sh[1]); e.w = pk2(sh[2], sh[3]);
    tab[tid] = e;
}
DI void modffn_block(const bf16_t* H, const LAS u32x4* tab, bf16_t* A, const LAS float* rwT, float* affL, float* affC, int rp0, int np, int lane) {
    u32x2 p0[8], p1[8];
#define MODFFN_LOAD(rp_) do { const int row_ = 2 * (rp_); _Pragma("unroll") for (int j = 0; j < 8; ++j) { p0[j] = *(const u32x2*)(H + (size_t)row_ * DM + 4 * lane + 256 * j); p1[j] = *(const u32x2*)(H + (size_t)(row_ + 1) * DM + 4 * lane + 256 * j); } } while (0)
    MODFFN_LOAD(rp0);
    for (int i = 0; i < np; ++i) {
        const int row = 2 * (rp0 + i);
        float s0 = 0.f, s1 = 0.f;
#pragma unroll
        for (int j = 0; j < 8; ++j) { const float a0 = bf_lo(p0[j].x), a1 = bf_hi(p0[j].x), a2 = bf_lo(p0[j].y), a3 = bf_hi(p0[j].y); s0 += (a0 * a0 + a1 * a1) + (a2 * a2 + a3 * a3);
                                      const float b0 = bf_lo(p1[j].x), b1 = bf_hi(p1[j].x), b2 = bf_lo(p1[j].y), b3 = bf_hi(p1[j].y); s1 += (b0 * b0 + b1 * b1) + (b2 * b2 + b3 * b3); }
        s0 = wave_sum(s0); s1 = wave_sum(s1);
        const float r0 = 1.0f / sqrtf(s0 * (1.0f / DM) + NORM_EPS), r1 = 1.0f / sqrtf(s1 * (1.0f / DM) + NORM_EPS);
        f32x4 y0[8], y1[8];
#pragma unroll
        for (int j = 0; j < 8; ++j) { const int c = 4 * lane + 256 * j; const u32x4 e = tab[lane + 64 * j];
            const f32x4 gm = (f32x4){bf_lo(e.x), bf_hi(e.x), bf_lo(e.y), bf_hi(e.y)}, sh = (f32x4){bf_lo(e.z), bf_hi(e.z), bf_lo(e.w), bf_hi(e.w)};
            const f32x4 v0 = (f32x4){bf_lo(p0[j].x), bf_hi(p0[j].x), bf_lo(p0[j].y), bf_hi(p0[j].y)}, v1 = (f32x4){bf_lo(p1[j].x), bf_hi(p1[j].x), bf_lo(p1[j].y), bf_hi(p1[j].y)};
            y0[j] = (v0 * r0) * gm + sh; y1[j] = (v1 * r1) * gm + sh;
            *(unsigned*)((unsigned char*)A + (size_t)row * DM + c) = pk4_fp8(y0[j][0], y0[j][1], y0[j][2], y0[j][3]);
            *(unsigned*)((unsigned char*)A + (size_t)(row + 1) * DM + c) = pk4_fp8(y1[j][0], y1[j][1], y1[j][2], y1[j][3]); }
        if (i + 1 < np) MODFFN_LOAD(rp0 + i + 1);
        asm volatile("" ::: "memory");
        router_rows2(y0, y1, rwT, affL, affC, row, lane);
    }
#undef MODFFN_LOAD
}
DI void ph_modffn(const bf16_t* H, const float* gain, const float* modl, bf16_t* A, const LAS float* rwT, LAS u32x4* tab, float* affL, float* affC, int nrows, int bid, int G, int tid) {
    const int lane = tid & 63, wave = tid >> 6, NGW = G * 8;
    for (int b0 = bid * 8; b0 < ML / 8; b0 += NGW) {
        const int cr = (8 * b0) >> 11;
        __syncthreads(); modffn_table(gain, modl + (size_t)cr * NMOD + 3 * DM, modl + (size_t)cr * NMOD + 4 * DM, tab, tid); __syncthreads();
        modffn_block(H, tab, A, rwT, affL, affC, 4 * (b0 + wave), 4, lane);
    }
    if (nrows > ML) {
        __syncthreads(); modffn_table(gain, modl + (size_t)8 * NMOD + 3 * DM, modl + (size_t)8 * NMOD + 4 * DM, tab, tid); __syncthreads();
        if (!(wave & 1))
            for (int pp = (bid * 8 + wave) >> 1; pp < (nrows - ML) / 2; pp += NGW >> 1) modffn_block(H, tab, A, rwT, affL, affC, ML / 2 + pp, 1, lane);
    }
}
constexpr int MF_TAB = RING_BYTES, MF_XSSQ = RING_BYTES + 8192;
static_assert(MF_XSSQ + 512 <= MISC_OFF, "modffn LDS map");
DI void ph_wprime(const float* nffn, const float* mod, const float* rwt, u32x4* wp, float* wb, int gtid, int GT, int gw, int lane) {
    for (int i = gtid; i < 2 * 9 * 4096; i += GT) {
        const int lc = i >> 12, l = lc / 9, cr = lc % 9, e = i & 4095, ks = e >> 6, ln = e & 63, n = ln & 15, q = ln >> 4, c0 = 64 * (ks >> 1) + 16 * q + 8 * (ks & 1);
        const float* gain = nffn + l * DM; const float* scale = mod + (size_t)(l * 9 + cr) * NMOD + 4 * DM; const float* rwT_g = rwt + l * 16 * DM;
        float w[8];
#pragma unroll
        for (int hh = 0; hh < 2; ++hh) { const f32x4 r = *(const f32x4*)(rwT_g + n * DM + c0 + 4 * hh), g = *(const f32x4*)(gain + c0 + 4 * hh), sc = *(const f32x4*)(scale + c0 + 4 * hh);
#pragma unroll
            for (int k = 0; k < 4; ++k) w[4 * hh + k] = r[k] * (g[k] * (sc[k] + 1.0f)); }
        u32x4 hi, lo;
#pragma unroll
        for (int d = 0; d < 4; ++d) { const unsigned ph = pk2(w[2 * d], w[2 * d + 1]); hi[d] = ph; lo[d] = pk2(w[2 * d] - bf_lo(ph), w[2 * d + 1] - bf_hi(ph)); }
        wp[(size_t)lc * 8192 + (ks * 2 + 0) * 64 + ln] = hi; wp[(size_t)lc * 8192 + (ks * 2 + 1) * 64 + ln] = lo;
    }
    if (gw < 2 * 9 * 16) { const int lc = gw >> 4, n = gw & 15, l = lc / 9; const float* shift = mod + (size_t)lc * NMOD + 3 * DM; const float* rw = rwt + (l * 16 + n) * DM; float s = 0.f;
#pragma unroll
        for (int j = 0; j < 8; ++j) { const f32x4 r = *(const f32x4*)(rw + 4 * lane + 256 * j), sh = *(const f32x4*)(shift + 4 * lane + 256 * j); s += (r[0] * sh[0] + r[1] * sh[1]) + (r[2] * sh[2] + r[3] * sh[3]); }
        s = wave_sum(s); if (lane == 0) wb[gw] = s; }
}
DI void modffn_prepare(const float* gain, const float* shift, const float* scale, const u32x4* wp_lc, LAS unsigned char* lds, int tid) {
    __syncthreads();
    { const int c = 4 * tid;
      const f32x4 g = *(const f32x4*)(gain + c), sc = *(const f32x4*)(scale + c), sh = *(const f32x4*)(shift + c); const f32x4 gm = g * (sc + 1.0f);
      u32x4 e; e.x = pk2(gm[0], gm[1]); e.y = pk2(gm[2], gm[3]); e.z = pk2(sh[0], sh[1]); e.w = pk2(sh[2], sh[3]);
      ((LAS u32x4*)(lds + MF_TAB))[tid] = e; }
    u32x4 t[16];
#pragma unroll
    for (int k = 0; k < 16; ++k) t[k] = wp_lc[tid + 512 * k];
#pragma unroll
    for (int k = 0; k < 16; ++k) ((LAS u32x4*)lds)[tid + 512 * k] = t[k];
    __syncthreads();
}
template <int NG, int KS> DI void modffn_pass(const bf16_t* H, bf16_t* A, LAS unsigned char* lds, const float* wb_lc, float* affL, float* affC, int row_base, int tid) {
    constexpr int NP = 32 / KS;
    const int lane = tid & 63, wave = __builtin_amdgcn_readfirstlane(tid >> 6), g = wave / KS, kh = wave % KS, r = lane & 15, q = lane >> 4;
    const int row = row_base + 16 * g + r, colb = (2048 / KS) * kh + 16 * q;
    u32x4 hv[NP][2];
#pragma unroll
    for (int p = 0; p < NP; ++p) { hv[p][0] = *(const u32x4*)(H + (size_t)row * DM + colb + 64 * p); hv[p][1] = *(const u32x4*)(H + (size_t)row * DM + colb + 64 * p + 8); }
    const float bias = wb_lc[r];
    f32x4 accA = (f32x4){0.f, 0.f, 0.f, 0.f}, accB = (f32x4){0.f, 0.f, 0.f, 0.f}; float ssq = 0.f;
    const LAS u32x4* frag = (const LAS u32x4*)lds + (size_t)(2 * NP * kh) * 128 + lane;
#pragma unroll
    for (int p = 0; p < NP; ++p)
#pragma unroll
        for (int h = 0; h < 2; ++h) {
            const u32x4 bh = frag[(2 * p + h) * 128], bl = frag[(2 * p + h) * 128 + 64]; const u32x4 a = hv[p][h];
            accA = __builtin_amdgcn_mfma_f32_16x16x32_bf16(__builtin_bit_cast(bf16x8, a), __builtin_bit_cast(bf16x8, bh), accA, 0, 0, 0);
            accB = __builtin_amdgcn_mfma_f32_16x16x32_bf16(__builtin_bit_cast(bf16x8, a), __builtin_bit_cast(bf16x8, bl), accB, 0, 0, 0);
#pragma unroll
            for (int d = 0; d < 4; ++d) { const float lo = bf_lo(a[d]), hi = bf_hi(a[d]); ssq += lo * lo + hi * hi; }
            if (h == 1) __builtin_amdgcn_sched_barrier(0);
        }
    ssq += __shfl_xor(ssq, 16); ssq += __shfl_xor(ssq, 32);
    f32x4 acc = accA + accB;
    __syncthreads();
    if (kh > 0) ((LAS f32x4*)lds)[(g * (KS - 1) + kh - 1) * 64 + lane] = acc;
    if (q == 0) ((LAS float*)(lds + MF_XSSQ))[(g * KS + kh) * 16 + r] = ssq;
    __syncthreads();
#pragma unroll
    for (int p = 0; p < NP; ++p) { asm volatile("" : "+v"(hv[p][0])); asm volatile("" : "+v"(hv[p][1])); }
    const LAS float* xs = (const LAS float*)(lds + MF_XSSQ) + g * KS * 16;
    { float st = 0.f;
#pragma unroll
      for (int k = 0; k < KS; ++k) st += xs[16 * k + r];
      const float rstd = 1.0f / sqrtf(st * (1.0f / DM) + NORM_EPS);
      const LAS u32x4* tab = (const LAS u32x4*)(lds + MF_TAB) + (colb >> 2);
#pragma unroll
      for (int p = 0; p < NP; ++p) { u32x4 o;
#pragma unroll
        for (int d = 0; d < 4; ++d) { const u32x4 e = tab[16 * p + d]; const unsigned w0 = hv[p][d >> 1][2 * (d & 1)], w1 = hv[p][d >> 1][2 * (d & 1) + 1];
            const float y0 = bf_lo(w0) * (rstd * bf_lo(e.x)) + bf_lo(e.z), y1 = bf_hi(w0) * (rstd * bf_hi(e.x)) + bf_hi(e.z), y2 = bf_lo(w1) * (rstd * bf_lo(e.y)) + bf_lo(e.w), y3 = bf_hi(w1) * (rstd * bf_hi(e.y)) + bf_hi(e.w);
            o[d] = pk4_fp8(y0, y1, y2, y3); }
        *(u32x4*)((unsigned char*)A + (size_t)row * DM + colb + 64 * p) = o; __builtin_amdgcn_sched_barrier(0); } }
    if (kh == 0) {
#pragma unroll
        for (int k = 1; k < KS; ++k) acc += ((const LAS f32x4*)lds)[(g * (KS - 1) + k - 1) * 64 + lane];
#pragma unroll
        for (int v = 0; v < 4; ++v) { const int rv = 4 * q + v; float st = 0.f;
#pragma unroll
            for (int k = 0; k < KS; ++k) st += xs[16 * k + rv];
            const float rstd = 1.0f / sqrtf(st * (1.0f / DM) + NORM_EPS);
            const float a = softmax16(acc[v] * rstd + bias); const int orow = row_base + 16 * g + rv;
            if (orow < ML) { const int b = orow >> 11, nn = orow & 2047; affL[(size_t)(b * 16 + r) * SEQ + nn] = a; }
            else { const int rc = orow - ML, b = rc >> 8, nn = rc & 255; affC[(size_t)(b * 16 + r) * CTXL + nn] = a; } }
    }
}
DI void ph_modffn_mfma(const bf16_t* H, const float* gain, const float* modl, const u32x4* wp_l, const float* wb_l, bf16_t* A, LAS unsigned char* lds, float* affL, float* affC, int nrows, int bid, int G, int tid) {
    for (int pb = bid; pb < ML / 64; pb += G) { const int cr = (64 * pb) >> 11;
        modffn_prepare(gain, modl + (size_t)cr * NMOD + 3 * DM, modl + (size_t)cr * NMOD + 4 * DM, wp_l + (size_t)cr * 8192, lds, tid);
        modffn_pass<4, 2>(H, A, lds, wb_l + cr * 16, affL, affC, 64 * pb, tid); }
    for (int pb = bid; pb < (nrows - ML) / 16; pb += G) {
        modffn_prepare(gain, modl + (size_t)8 * NMOD + 3 * DM, modl + (size_t)8 * NMOD + 4 * DM, wp_l + (size_t)8 * 8192, lds, tid);
        modffn_pass<1, 8>(H, A, lds, wb_l + 8 * 16, affL, affC, ML + 16 * pb, tid); }
}
DI void ph_topk(int nitems, const float* affL, const float* affC, int* rowsrc, float* gatev, int* inv, LAS unsigned* hist, int tid, int lane, int wave, int bid, int G) {
    LAS unsigned* sh = hist + 256;
    for (int it = bid; it < nitems; it += G) {
        const bool isc = it >= 128; const int be = it & 127, b = be >> 4, e = be & 15;
        const int N = isc ? CTXL : SEQ, C = isc ? CAPC : CAPL;
        const float* src = isc ? affC + (size_t)be * CTXL : affL + (size_t)be * SEQ;
        const int i0 = tid * 4; const bool valid = i0 < N;
        unsigned key[4];
        { f32x4 v = (f32x4){0.f, 0.f, 0.f, 0.f}; if (valid) v = *(const f32x4*)(src + i0);
#pragma unroll
          for (int q = 0; q < 4; ++q) key[q] = __float_as_uint(v[q]); }
        unsigned prefix = 0u, mask = 0u, krem = (unsigned)C;
        for (int pass = 3; pass >= 0; --pass) {
            const int shift = pass * 8;
            if (tid < 256) hist[tid] = 0u;
            __syncthreads();
            if (valid) {
#pragma unroll
                for (int q = 0; q < 4; ++q) if ((key[q] & mask) == prefix) __hip_atomic_fetch_add(&hist[(key[q] >> shift) & 255u], 1u, __ATOMIC_RELAXED, __HIP_MEMORY_SCOPE_WORKGROUP); }
            __syncthreads();
            if (wave == 0) {
                const unsigned h0 = hist[4 * lane], h1 = hist[4 * lane + 1], h2 = hist[4 * lane + 2], h3 = hist[4 * lane + 3];
                const unsigned tot = h0 + h1 + h2 + h3; unsigned incl = tot;
#pragma unroll
                for (int o = 1; o < 64; o <<= 1) { const unsigned t = __shfl_down(incl, o); if (lane + o < 64) incl += t; }
                const unsigned a3 = incl - tot, a2 = a3 + h3, a1 = a2 + h2, a0 = a1 + h1;
                if (a3 < krem && krem <= a3 + h3) { sh[0] = 4 * lane + 3; sh[1] = krem - a3; }
                if (a2 < krem && krem <= a2 + h2) { sh[0] = 4 * lane + 2; sh[1] = krem - a2; }
                if (a1 < krem && krem <= a1 + h1) { sh[0] = 4 * lane + 1; sh[1] = krem - a1; }
                if (a0 < krem && krem <= a0 + h0) { sh[0] = 4 * lane + 0; sh[1] = krem - a0; }
            }
            __syncthreads();
            const unsigned B = sh[0]; krem = sh[1]; prefix |= B << shift; mask |= 0xFFu << shift;
        }
        const unsigned T = prefix;
        unsigned cg = 0u, ce = 0u;
        if (valid) {
#pragma unroll
            for (int q = 0; q < 4; ++q) { cg += key[q] > T ? 1u : 0u; ce += key[q] == T ? 1u : 0u; } }
        const unsigned mine = cg | (ce << 16); unsigned incl = mine;
#pragma unroll
        for (int o = 1; o < 64; o <<= 1) { const unsigned t = __shfl_up(incl, o); if (lane >= o) incl += t; }
        if (lane == 63) sh[8 + wave] = incl;
        __syncthreads();
        unsigned woff = 0u;
#pragma unroll
        for (int w = 0; w < 8; ++w) woff += (w < wave) ? sh[8 + w] : 0u;
        const unsigned excl = woff + incl - mine; unsigned gtb = excl & 0xFFFFu, eqb = excl >> 16;
        if (valid) {
            const int ybase = e * YR + (isc ? NB * CAPL + b * CAPC : b * CAPL); const int rbase = isc ? ML + b * CTXL : b * SEQ;
#pragma unroll
            for (int q = 0; q < 4; ++q) {
                const bool isg = key[q] > T, ise = key[q] == T; const bool sel = isg || (ise && eqb < krem);
                const unsigned slot = gtb + (eqb < krem ? eqb : krem);
                const int trow = rbase + i0 + q; const int yrow = ybase + (int)slot;
                if (sel) { rowsrc[yrow] = trow; gatev[yrow] = __uint_as_float(key[q]); }
                inv[(size_t)trow * 16 + e] = sel ? yrow : -1;
                gtb += isg ? 1u : 0u; eqb += ise ? 1u : 0u;
            }
        }
        __syncthreads();
    }
}
#define CMB_FENCE() do { asm volatile("" ::: "memory"); __builtin_amdgcn_sched_barrier(0); } while (0)
template <bool LAST> DI void cmb_block(bf16_t* H, const bf16_t* Y, const int* inv, const float* g2, const float* gain1, const float* shift, const float* scale, bf16_t* A, float* out, int row0, int n, int lane) {
    u32x2 gvp[8], Gmp[8], shp[8];
    { f32x4 t0[8], t1[8], t2[8], t3[8];
#pragma unroll
      for (int j = 0; j < 8; ++j) { const int c = 4 * lane + 256 * j; t0[j] = *(const f32x4*)(g2 + c); if (!LAST) { t1[j] = *(const f32x4*)(gain1 + c); t2[j] = *(const f32x4*)(scale + c); t3[j] = *(const f32x4*)(shift + c); } }
      CMB_FENCE();
#pragma unroll
      for (int j = 0; j < 8; ++j) { const f32x4 t = t0[j] * Y8_INV; gvp[j].x = pk2(t[0], t[1]); gvp[j].y = pk2(t[2], t[3]);
        if (!LAST) { const f32x4 gm = t1[j] * (t2[j] + 1.0f); Gmp[j].x = pk2(gm[0], gm[1]); Gmp[j].y = pk2(gm[2], gm[3]); shp[j].x = pk2(t3[j][0], t3[j][1]); shp[j].y = pk2(t3[j][2], t3[j][3]); } }
      CMB_FENCE(); }
#define CMB_UNPK(P) ((f32x4){bf_lo((P).x), bf_hi((P).x), bf_lo((P).y), bf_hi((P).y)})
    u32x2 hp[8], hn[8]; int iv0, iv1 = -1, iv2 = -1;
    unsigned q1[8], q2[8]; unsigned m; float f1, f2;
#define CMB_LOADH(HP, row_) do { _Pragma("unroll") for (int j = 0; j < 8; ++j) HP[j] = *(const u32x2*)(H + (size_t)(row_) * DM + 4 * lane + 256 * j); } while (0)
#define CMB_INV(row_) inv[(size_t)(row_) * 16 + (lane & 15)]
#define CMB_GATHER(IV) do { const bool one_ = m != 0u; const int e1_ = one_ ? __builtin_ctz(m) : 0; m &= m - 1u; const bool two_ = one_ && m != 0u; const int e2_ = two_ ? __builtin_ctz(m) : e1_; if (two_) m &= m - 1u; \
        const int r1_ = __builtin_amdgcn_readlane(IV, e1_), r2_ = __builtin_amdgcn_readlane(IV, e2_); \
        const unsigned char* y1_ = (const unsigned char*)Y + (size_t)(one_ ? r1_ : 0) * DM + 4 * lane; const unsigned char* y2_ = (const unsigned char*)Y + (size_t)(two_ ? r2_ : 0) * DM + 4 * lane; \
        _Pragma("unroll") for (int j = 0; j < 8; ++j) { q1[j] = *(const unsigned*)(y1_ + 256 * j); q2[j] = *(const unsigned*)(y2_ + 256 * j); } \
        f1 = one_ ? 1.0f : 0.0f; f2 = two_ ? 1.0f : 0.0f; } while (0)
    CMB_LOADH(hp, row0); iv0 = CMB_INV(row0); if (n > 1) iv1 = CMB_INV(row0 + 1);
    m = (unsigned)(__ballot(iv0 >= 0) & 0xFFFFull);
    CMB_GATHER(iv0);
    for (int i = 0; i < n; ++i) {
        const int row = row0 + i; const bool more = i + 1 < n;
        if (more) CMB_LOADH(hn, row + 1);
        if (i + 2 < n) iv2 = CMB_INV(row + 2);
        CMB_FENCE();
        f32x4 acc[8];
#pragma unroll
        for (int j = 0; j < 8; ++j) acc[j] = unpk4_fp8(q1[j]) * f1 + unpk4_fp8(q2[j]) * f2;
        while (m) {
            CMB_GATHER(iv0);
#pragma unroll
            for (int j = 0; j < 8; ++j) acc[j] += unpk4_fp8(q1[j]) * f1 + unpk4_fp8(q2[j]) * f2;
        }
        CMB_FENCE();
        if (more) { m = (unsigned)(__ballot(iv1 >= 0) & 0xFFFFull); CMB_GATHER(iv1); }
        CMB_FENCE();
        f32x4 v[8];
#pragma unroll
        for (int j = 0; j < 8; ++j) { const f32x4 h = (f32x4){bf_lo(hp[j].x), bf_hi(hp[j].x), bf_lo(hp[j].y), bf_hi(hp[j].y)}; v[j] = h + CMB_UNPK(gvp[j]) * acc[j]; }
        if (LAST) {
#pragma unroll
            for (int j = 0; j < 8; ++j) *(f32x4*)(out + (size_t)row * DM + 4 * lane + 256 * j) = v[j];
        } else {
            float ss = 0.f;
#pragma unroll
            for (int j = 0; j < 8; ++j) ss += (v[j][0] * v[j][0] + v[j][1] * v[j][1]) + (v[j][2] * v[j][2] + v[j][3] * v[j][3]);
            ss = wave_sum(ss);
            const float rstd = 1.0f / sqrtf(ss * (1.0f / DM) + NORM_EPS);
            row_store_bf16(H + (size_t)row * DM, v, lane);
#pragma unroll
            for (int j = 0; j < 8; ++j) { const f32x4 y = (v[j] * rstd) * CMB_UNPK(Gmp[j]) + CMB_UNPK(shp[j]);
                *(unsigned*)((unsigned char*)A + (size_t)row * DM + 4 * lane + 256 * j) = pk4_fp8(y[0], y[1], y[2], y[3]); }
        }
        CMB_FENCE();
#pragma unroll
        for (int j = 0; j < 8; ++j) hp[j] = hn[j];
        iv0 = iv1; iv1 = iv2;
    }
#undef CMB_UNPK
#undef CMB_LOADH
#undef CMB_INV
#undef CMB_GATHER
}
template <bool LAST> DI void ph_combine(bf16_t* H, const bf16_t* Y, const int* inv, const float* modl  , const float* gain1, const float* mod1, bf16_t* A, float* out, int nrows, int gw, int NGW, int lane) {
    for (int blk = gw; blk < ML / 8; blk += NGW) { const int row0 = 8 * blk, cr = row0 >> 11;
        cmb_block<LAST>(H, Y, inv, modl + (size_t)cr * NMOD + 5 * DM, gain1, mod1 + (size_t)cr * NMOD + 0 * DM, mod1 + (size_t)cr * NMOD + 1 * DM, A, out, row0, 8, lane); }
    for (int row = ML + gw; row < nrows; row += NGW)
        cmb_block<LAST>(H, Y, inv, modl + (size_t)8 * NMOD + 5 * DM, gain1, mod1 + (size_t)8 * NMOD + 0 * DM, mod1 + (size_t)8 * NMOD + 1 * DM, A, out, row, 1, lane);
}
constexpr int KP = 272;
constexpr int VP = 288;
constexpr int ATT_VOFF = 64 * KP;
constexpr int ATT_TILE = 64 * KP + 64 * VP;
constexpr int ATT_OST = 2 * ATT_TILE;
DI float xhalf_max(float v) { auto rr = __builtin_amdgcn_permlane32_swap(__float_as_uint(v), __float_as_uint(v), false, false); return fmaxf(__uint_as_float(rr[0]), __uint_as_float(rr[1])); }
DI float xhalf_sum(float v) { auto rr = __builtin_amdgcn_permlane32_swap(__float_as_uint(v), __float_as_uint(v), false, false); return __uint_as_float(rr[0]) + __uint_as_float(rr[1]); }
DI int crow(int reg, int h) { return (reg & 3) + 8 * (reg >> 2) + 4 * h; }
DI long long vtr64(const LAS unsigned char* p) { typedef short v4i16_t __attribute__((ext_vector_type(4))); return __builtin_bit_cast(long long, __builtin_amdgcn_ds_read_tr16_b64_v4i16((LAS v4i16_t*)p)); }
DI s16x4 vtr(const LAS unsigned char* p) { typedef short v4i16_t __attribute__((ext_vector_type(4))); return __builtin_bit_cast(s16x4, __builtin_amdgcn_ds_read_tr16_b64_v4i16((LAS v4i16_t*)p)); }
DI bool att_tile_info(int item, int ti, int& base, int& mtype) {
    const int qhalf = item & 1, n = (item >> 3) & 15, b = item >> 7, tt = ti & 1; mtype = 0;
    if (ti < 4) { base = ML + b * CTXL + 64 * ti; return true; }
    const int blk = n - 1 + ((ti - 4) >> 1); if (blk < 0 || blk > 15) return false;
    if (ti < 6) { mtype = 1; if (tt == 0 && qhalf == 1) return false; } else if (ti >= 8) { mtype = 2; if (tt == 1 && qhalf == 0) return false; }
    base = b * SEQ + blk * 128 + 64 * tt; return true;
}
DI void att_next(int& item, int& ti, int G) { for (;;) { ++ti; if (ti >= 10) { ti = 0; item += G; return; } int b_, m_; if (att_tile_info(item, ti, b_, m_)) return; } }
DI void ph_attn(const bf16_t* Q, const bf16_t* Kb, const bf16_t* Vb, bf16_t* O, const float* sink, LAS unsigned char* lds, int tid, int lane, int wave, int bid, int G) {
    constexpr float LOG2E = 1.4426950408889634f;
    const int r = lane & 31, h = lane >> 5, g = wave >> 1, sub = wave & 1;
    const int ldrow = tid >> 3, ldc = tid & 7;
    int item = bid, ti = 0; if (item >= 1024) return;
    u32x4 kr[2], vr[2];
#define ATT_ISSUE(it_, ti_) do { int base_, mt_; att_tile_info(it_, ti_, base_, mt_); const int kvh_ = ((it_) >> 1) & 3; \
        _Pragma("unroll") for (int c2 = 0; c2 < 2; ++c2) { const size_t off_ = (size_t)(base_ + ldrow) * 512 + kvh_ * HD + (ldc + 8 * c2) * 8; kr[c2] = *(const u32x4*)(Kb + off_); vr[c2] = *(const u32x4*)(Vb + off_); } } while (0)
    bf16x8 qf[8]; float m2 = 0.f, lsum = 1.f; f32x16 o[4]; f32x16 negm;
#define ATT_QLOAD(it_) do { const int qrow_ = ((it_) >> 7) * SEQ + (((it_) >> 3) & 15) * 128 + ((it_) & 1) * 64 + sub * 32 + r; const int head_ = (((it_) >> 1) & 3) * 4 + g; \
        _Pragma("unroll") for (int s = 0; s < 8; ++s) qf[s] = *(const bf16x8*)(Q + (size_t)qrow_ * DM + head_ * HD + 16 * s + 8 * h); } while (0)
    ATT_QLOAD(item);
    ATT_ISSUE(item, ti);
    int buf = 0;
    while (item < 1024) {
        int nitem = item, nti = ti; att_next(nitem, nti, G);
        LAS unsigned char* tb = lds + buf * ATT_TILE;
#pragma unroll
        for (int c2 = 0; c2 < 2; ++c2) { *(LAS u32x4*)(tb + ldrow * KP + (ldc + 8 * c2) * 16) = kr[c2]; *(LAS u32x4*)(tb + ATT_VOFF + ldrow * VP + (ldc + 8 * c2) * 16) = vr[c2]; }
        if (nitem < 1024) ATT_ISSUE(nitem, nti);
        asm volatile("s_waitcnt lgkmcnt(0)" ::: "memory"); __builtin_amdgcn_s_barrier(); asm volatile("" ::: "memory");
        int base, mtype; att_tile_info(item, ti, base, mtype); const int tt = ti & 1;
        const int qhalf = item & 1, kvh = (item >> 1) & 3, n = (item >> 3) & 15, b = item >> 7;
        const int head = kvh * 4 + g, qq = qhalf * 64 + sub * 32 + r; const int qrow = b * SEQ + n * 128 + qq;
        if (ti == 0) {
            m2 = sink[head] * LOG2E; lsum = 1.0f;
#pragma unroll
            for (int i = 0; i < 16; ++i) negm[i] = -m2;
#pragma unroll
            for (int d = 0; d < 4; ++d)
#pragma unroll
                for (int i = 0; i < 16; ++i) o[d][i] = 0.f;
        }
        f32x16 x0, x1;
#pragma unroll
        for (int s = 0; s < 8; ++s) {
            const bf16x8 k0 = *(const LAS bf16x8*)(tb + r * KP + (16 * s + 8 * h) * 2), k1 = *(const LAS bf16x8*)(tb + (32 + r) * KP + (16 * s + 8 * h) * 2);
            if (s == 0) { x0 = __builtin_amdgcn_mfma_f32_32x32x16_bf16(k0, qf[s], negm, 0, 0, 0); x1 = __builtin_amdgcn_mfma_f32_32x32x16_bf16(k1, qf[s], negm, 0, 0, 0); }
            else { x0 = __builtin_amdgcn_mfma_f32_32x32x16_bf16(k0, qf[s], x0, 0, 0, 0); x1 = __builtin_amdgcn_mfma_f32_32x32x16_bf16(k1, qf[s], x1, 0, 0, 0); } }
        if (nitem != item && nitem < 1024) ATT_QLOAD(nitem);
        if (mtype == 1) {
#pragma unroll
            for (int i = 0; i < 16; ++i) { const int kk0 = tt * 64 + crow(i, h); if (kk0 < qq) x0[i] = -1.0e30f; if (kk0 + 32 < qq) x1[i] = -1.0e30f; } }
        if (mtype == 2) {
#pragma unroll
            for (int i = 0; i < 16; ++i) { const int kk0 = tt * 64 + crow(i, h); if (kk0 > qq) x0[i] = -1.0e30f; if (kk0 + 32 > qq) x1[i] = -1.0e30f; } }
        float tmax = fmaxf(x0[0], x1[0]);
#pragma unroll
        for (int i = 1; i < 16; ++i) tmax = fmaxf(fmaxf(tmax, x0[i]), x1[i]);
        tmax = xhalf_max(tmax);
        if (__any(tmax > 0.0f)) {
            const float dl = fmaxf(tmax, 0.0f), alpha = __builtin_amdgcn_exp2f(-dl); m2 += dl; lsum *= alpha;
#pragma unroll
            for (int i = 0; i < 16; ++i) { x0[i] -= dl; x1[i] -= dl; negm[i] = -m2; }
#pragma unroll
            for (int d = 0; d < 4; ++d)
#pragma unroll
                for (int i = 0; i < 16; ++i) o[d][i] *= alpha;
        }
        float ps = 0.f;
#pragma unroll
        for (int i = 0; i < 16; ++i) { x0[i] = __builtin_amdgcn_exp2f(x0[i]); x1[i] = __builtin_amdgcn_exp2f(x1[i]); ps += x0[i] + x1[i]; }
        lsum += xhalf_sum(ps);
        bf16x8 pf[2][2];
#pragma unroll
        for (int s = 0; s < 2; ++s) {
            u32x4 a, c; a.x = pk2(x0[8 * s + 0], x0[8 * s + 1]); a.y = pk2(x0[8 * s + 2], x0[8 * s + 3]); a.z = pk2(x0[8 * s + 4], x0[8 * s + 5]); a.w = pk2(x0[8 * s + 6], x0[8 * s + 7]);
            c.x = pk2(x1[8 * s + 0], x1[8 * s + 1]); c.y = pk2(x1[8 * s + 2], x1[8 * s + 3]); c.z = pk2(x1[8 * s + 4], x1[8 * s + 5]); c.w = pk2(x1[8 * s + 6], x1[8 * s + 7]);
            pf[0][s] = __builtin_bit_cast(bf16x8, a); pf[1][s] = __builtin_bit_cast(bf16x8, c); }
        const LAS unsigned char* vb = tb + ATT_VOFF + (4 * h + ((lane & 15) >> 2)) * VP + (16 * ((lane >> 4) & 1) + 4 * (lane & 3)) * 2;
#pragma unroll
        for (int d = 0; d < 4; ++d)
#pragma unroll
            for (int t = 0; t < 2; ++t)
#pragma unroll
                for (int s = 0; s < 2; ++s) {
                    typedef long long i64x2_t __attribute__((ext_vector_type(2)));
                    i64x2_t vv; vv.x = vtr64(vb + (t * 32 + 16 * s) * VP + d * 64); vv.y = vtr64(vb + (t * 32 + 16 * s + 8) * VP + d * 64);
                    const bf16x8 vf = __builtin_bit_cast(bf16x8, vv);
                    o[d] = __builtin_amdgcn_mfma_f32_32x32x16_bf16(vf, pf[t][s], o[d], 0, 0, 0); }
        if (nitem != item) {
            const float il = 1.0f / lsum;
            LAS unsigned char* st = lds + ATT_OST + wave * (32 * KP);
#pragma unroll
            for (int d = 0; d < 4; ++d)
#pragma unroll
                for (int g4 = 0; g4 < 4; ++g4) *(LAS unsigned*)(st + r * 144 + d * 32 + 8 * g4 + 4 * h) = pk4_fp8(o[d][4 * g4 + 0] * il, o[d][4 * g4 + 1] * il, o[d][4 * g4 + 2] * il, o[d][4 * g4 + 3] * il);
            asm volatile("s_waitcnt lgkmcnt(0)" ::: "memory");
            unsigned char* ob = (unsigned char*)O + (size_t)(qrow - r) * DM + head * HD;
#pragma unroll
            for (int j = 0; j < 4; ++j) { const int c = lane + 64 * j, row = c >> 3, c16 = c & 7;
                const u32x4 v = *(const LAS u32x4*)(st + row * 144 + c16 * 16); *(u32x4*)(ob + (size_t)row * DM + c16 * 16) = v; }
        }
        item = nitem; ti = nti; buf ^= 1;
    }
#undef ATT_ISSUE
#undef ATT_QLOAD
}
#ifndef MK_ONE_LAUNCH
#define MK_ONE_LAUNCH 1
#endif
constexpr int NPHASE = 19;
constexpr int CVT_X0_END = CVT_E0 + CVT_L;
#define CVT_MKCP() CvtPtrs CP; CP.cin = args.in[8]; CP.cout = args.in[10]; CP.wqkv = args.in[11]; CP.wo = args.in[15]; CP.wg = args.in[17]; CP.wu = args.in[18]; CP.wd = args.in[19]; \
    CP.W1A = W1A; CP.W1B = W1B; CP.W2 = W2; CP.WQKV = WQKV; CP.WO = WOt; CP.WGU = WGU; CP.WDN = WDN
#define CVT(LO, HI) do { CVT_MKCP(); cvt_range(CP, LO, HI, gw, NGW, cscr, lane); } while (0)
#define TAIL_CVT(NWG, LO, HI) do { const int R_ = ((NWG) + G - 1) / G, rem_ = (NWG) - (R_ - 1) * G; if (bid >= rem_) { CVT_MKCP(); cvt_range(CP, LO, HI, (bid - rem_) * 8 + wave, (G - rem_) * 8, cscr, lane); } } while (0)
#define SIDE_CVT(GA, LO, HI) do { CVT_MKCP(); cvt_range(CP, LO, HI, (bid - (GA)) * 8 + wave, (G - (GA)) * 8, cscr, lane); } while (0)
#ifndef MK_C3
#define MK_C3 12288
#define MK_C4 26624
#define MK_C5 40960
#define MK_C8 46592
#define MK_C9 49152
#define MK_C11 53760
#endif
constexpr int C3 = MK_C3, C4 = MK_C4, C5 = MK_C5, C8 = MK_C8, C9 = MK_C9, C11 = MK_C11, GU0_END = CVT_E0 + 16384, GU1_END = CVT_X0_END + 16384;
static_assert(C5 >= GU0_END && C8 >= CVT_X0_END && C3 >= CVT_E0 && C11 <= CVT_TOTAL, "tail budgets");
#ifndef MK_DUP_MASK
#define MK_DUP_MASK 0u
#endif
#define MK_PROBE_SEAM -1
#define MK_PROBE_BID 255
#define MK_PROBE_DUR 0
constexpr int PROBE_SEAM = MK_PROBE_SEAM, PROBE_BID = MK_PROBE_BID, PROBE_DUR = MK_PROBE_DUR;
constexpr unsigned DUP_MASK = MK_DUP_MASK;
struct Args { const float* in[20]; float* out; unsigned char* ws; int ph_lo, ph_hi; };
__global__ void __launch_bounds__(512, 2) dit_fwd(Args args) {
    extern __shared__ __attribute__((aligned(16))) unsigned char lds_raw[];
    LAS unsigned char* lds = (LAS unsigned char*)lds_raw;
    const int tid = threadIdx.x, lane = tid & 63, wave = __builtin_amdgcn_readfirstlane(tid >> 6);
    const int G = gridDim.x, bid = blockIdx.x;
    const int gw = bid * 8 + wave, NGW = G * 8;
    unsigned char* ws = args.ws;
    const float* x = args.in[0]; const float* cnd = args.in[1]; const float* ctx = args.in[2]; const float* cctx = args.in[3];
    const float* ada_w = args.in[4]; const float* ada_b = args.in[5]; const float* nmix = args.in[6]; const float* nffn = args.in[7];
    const float* conv_w = args.in[9]; const float* qgain = args.in[12]; const float* kgain = args.in[13]; const float* sink = args.in[14]; const float* router_w = args.in[16];
    float* mod = (float*)(ws + WS_MOD); float* modp = (float*)(ws + WS_MODP);
    float* affL = (float*)(ws + WS_AFFL); float* affC = (float*)(ws + WS_AFFC);
    float* rwt = (float*)(ws + WS_RWT);
    u32x4* wprime = (u32x4*)(ws + WS_MODP); float* wbias = (float*)(ws + WS_MODP + (size_t)2 * 9 * 8192 * 16);
    int* idmap = (int*)(ws + WS_IDMAP);
    int* rowsrc = (int*)(ws + WS_ROWSRC); float* gatev = (float*)(ws + WS_GATEV); int* inv = (int*)(ws + WS_INV);
    bf16_t* W1A = (bf16_t*)(ws + WS_W1A); bf16_t* W1B = (bf16_t*)(ws + WS_W1B); bf16_t* W2 = (bf16_t*)(ws + WS_W2); bf16_t* WQKV = (bf16_t*)(ws + WS_WQKV); bf16_t* WOt = (bf16_t*)(ws + WS_WO);
    bf16_t* WGU = (bf16_t*)(ws + WS_WGU); bf16_t* WDN = (bf16_t*)(ws + WS_WDN);
    bf16_t* H = (bf16_t*)(ws + WS_H); bf16_t* A = (bf16_t*)(ws + WS_A); bf16_t* U = (bf16_t*)(ws + WS_U); bf16_t* Z = (bf16_t*)(ws + WS_Z);
    bf16_t* Qb = (bf16_t*)(ws + WS_Q); bf16_t* Kb = (bf16_t*)(ws + WS_K); bf16_t* Vb = (bf16_t*)(ws + WS_V); bf16_t* Ob = (bf16_t*)(ws + WS_O);
    bf16_t* HM = (bf16_t*)(ws + WS_HM); bf16_t* Y = (bf16_t*)(ws + WS_Y);
    LAS unsigned* cscr = (LAS unsigned*)(lds + wave * 9216);

    for (int u = tid; u < (LDS_BYTES - MISC_OFF) / 4; u += 512) ((LAS unsigned*)(lds + MISC_OFF))[u] = 0u;
    __syncthreads();
#if MK_ONE_LAUNCH
    XcdBarrier bar = xcd_barrier_post((unsigned*)(ws + WS_CTL) + CW_BAR, (volatile LAS unsigned*)(lds + MISC_OFF) + 8);
#define GRID_BAR() xcd_barrier(bar)
#else
#define GRID_BAR() do {} while (0)
#endif
    const int lo = args.ph_lo, hi = args.ph_hi;
    const int GA45 = (G * 3 / 4) & ~7;
#define IN(k) (lo <= (k) && (k) < hi)
    unsigned long long pr_t1 = 0, pr_prev = PROBE_SEAM >= 0 ? __builtin_amdgcn_s_memrealtime() : 0ull; long long pr_D = 0;
#define SEAM(k) do { if (IN(k) && IN((k) + 1)) { \
        if (PROBE_SEAM >= 0) { pr_t1 = __builtin_amdgcn_s_memrealtime(); if ((k) == PROBE_SEAM && bid == 0 && tid == 0) __hip_atomic_store((unsigned long long*)(ws + WS_CTL + 65536), pr_t1, __ATOMIC_RELAXED, __HIP_MEMORY_SCOPE_AGENT); } \
        GRID_BAR(); \
        if ((k) == PROBE_SEAM && bid == PROBE_BID) pr_D = PROBE_DUR == 1 ? (long long)(pr_t1 - pr_prev) - 5000 : PROBE_DUR == 2 ? (long long)(__builtin_amdgcn_s_memrealtime() - pr_t1) - 5000 : (long long)(pr_t1 - __hip_atomic_load((unsigned long long*)(ws + WS_CTL + 65536), __ATOMIC_RELAXED, __HIP_MEMORY_SCOPE_AGENT)); \
        if (PROBE_SEAM >= 0) pr_prev = __builtin_amdgcn_s_memrealtime(); } } while (0)
#define PHASE(k) if (IN(k)) _Pragma("unroll") for (int rep_ = 0; rep_ < 1 + (int)((DUP_MASK >> (k)) & 1u); ++rep_)
#define REP_BAR() do { if (rep_) GRID_BAR(); } while (0)

    PHASE(0) { REP_BAR(); ph_adaln(cnd, cctx, ada_w, modp, gw, NGW, lane); } SEAM(0);
    PHASE(1) { REP_BAR(); ph_modred(modp, ada_b, mod, bid * 512 + tid, G * 512); ph_rwt(router_w, rwt, bid * 512 + tid, G * 512); for (int i = bid * 512 + tid; i < YT; i += G * 512) idmap[i] = i; } SEAM(1);
    PHASE(2) { REP_BAR(); ph_wprime(nffn, mod, rwt, wprime, wbias, bid * 512 + tid, G * 512, gw, lane); ph_mod0(x, ctx, nmix, mod, A, gw, NGW, lane); CVT(0, 4096); } SEAM(2);
    PHASE(3) { REP_BAR();
        pg8::Gemm g{A, W1A, MT, 4096, DM}; pg8::StaticOrder S; S.init(MT, 4096, G, bid);
        EpiPair<0> E{U, DM, 16};
        pg8::gemm_phase<EpiPair<0>, pg8::StaticOrder, true, true>(lds, g, S, E);
        TAIL_CVT((MT / 256) * 16, 4096, C3);
    } SEAM(3);
    PHASE(4) { REP_BAR();
        if (bid < GA45) {
        pg8::Gemm g{A, W1B, MT, DM, DM}; pg8::StaticOrder S; S.init(MT, DM, GA45, bid);
        EpiConvGate E{U, Z, conv_w};
        pg8::gemm_phase<EpiConvGate, pg8::StaticOrder, true, true>(lds, g, S, E);
        } else SIDE_CVT(GA45, C3, C4);
    } SEAM(4);
    PHASE(5) { REP_BAR();
        if (bid < GA45) {
        pg8::Gemm g{Z, W2, MT, DM, DM}; pg8::StaticOrder S; S.init(MT, DM, GA45, bid);
        EpiResid<true> E{x, ctx, H, mod + 2 * DM, 1.0f};
        pg8::gemm_phase<EpiResid<true>, pg8::StaticOrder, true, true>(lds, g, S, E);
        } else SIDE_CVT(GA45, C4, C5);
    } SEAM(5);
    PHASE(6) { REP_BAR(); ph_modffn_mfma(H, nffn, mod, wprime, wbias, A, lds, affL, affC, MT, bid, G, tid); } SEAM(6);
    PHASE(7) { REP_BAR(); ph_topk(256, affL, affC, rowsrc, gatev, inv, (LAS unsigned*)lds, tid, lane, wave, bid, G); } SEAM(7);
    PHASE(8) { REP_BAR();
        pg8::Gemm g{A, WGU, YT, NE * 2048, DM / 2, rowsrc}; MoeOrder S{G, bid, 9};
        EpiPairF8 E{(unsigned char*)HM, DFF, 8};
        pg8::gemm_phase<EpiPairF8, MoeOrder, true, true, true, true>(lds, g, S, E);
        TAIL_CVT(NE * 9 * 8, C5, C8);
    } SEAM(8);
    PHASE(9) { REP_BAR();
        pg8::Gemm g{HM, WDN, YT, NE * 2048, DFF / 2, idmap}; MoeOrder S{G, bid, 9};
        EpiDown E{Y, gatev, W8_INV * Y8_SCALE};
        pg8::gemm_phase<EpiDown, MoeOrder, true, true, true, true>(lds, g, S, E);
        TAIL_CVT(NE * 9 * 8, C8, C9);
    } SEAM(9);
    PHASE(10) { REP_BAR(); ph_combine<false>(H, Y, inv, mod, nmix + DM, mod + 9 * NMOD, A, nullptr, MT, gw, NGW, lane); } SEAM(10);
    PHASE(11) { REP_BAR();
        pg8::Gemm g{A, WQKV, MT, 3072, DM / 2, idmap}; QkvOrder S{G, bid};
        EpiQkvNorm E{Qb, Kb, Vb, qgain, kgain, (LAS float*)(lds + RING_BYTES), W8_INV};
        pg8::gemm_phase<EpiQkvNorm, QkvOrder, true, true, true, true>(lds, g, S, E);
        TAIL_CVT(800, C9, C11);
    } SEAM(11);
    PHASE(12) { REP_BAR(); ph_attn(Qb, Kb, Vb, Ob, sink, lds, tid, lane, wave, bid, G); } SEAM(12);
    PHASE(13) { REP_BAR();
        pg8::Gemm g{Ob, WOt, ML, DM, DM / 2, idmap}; pg8::StaticOrder S; S.init(ML, DM, G, bid);
        EpiResid<false> E{nullptr, nullptr, H, mod + 9 * NMOD + 2 * DM, W8_INV};
        pg8::gemm_phase<EpiResid<false>, pg8::StaticOrder, true, true, true, true>(lds, g, S, E);
    } SEAM(13);
    PHASE(14) { REP_BAR(); ph_modffn_mfma(H, nffn + DM, mod + 9 * NMOD, wprime + (size_t)9 * 8192, wbias + 9 * 16, A, lds, affL, affC, ML, bid, G, tid); } SEAM(14);
    PHASE(15) { REP_BAR(); ph_topk(128, affL, affC, rowsrc, gatev, inv, (LAS unsigned*)lds, tid, lane, wave, bid, G); CVT(C11, GU1_END); } SEAM(15);
    PHASE(16) { REP_BAR();
        pg8::Gemm g{A, (const bf16_t*)((const unsigned char*)WGU + (size_t)NE * 2048 * DM), YT, NE * 2048, DM / 2, rowsrc}; MoeOrder S{G, bid, 8};
        EpiPairF8 E{(unsigned char*)HM, DFF, 8};
        pg8::gemm_phase<EpiPairF8, MoeOrder, true, true, true, true>(lds, g, S, E);
        CVT((C11 > GU1_END ? C11 : GU1_END), CVT_TOTAL);
    } SEAM(16);
    PHASE(17) { REP_BAR();
        pg8::Gemm g{HM, (const bf16_t*)((const unsigned char*)WDN + (size_t)NE * 2048 * DFF), YT, NE * 2048, DFF / 2, idmap}; MoeOrder S{G, bid, 8};
        EpiDown E{Y, gatev, W8_INV * Y8_SCALE};
        pg8::gemm_phase<EpiDown, MoeOrder, true, true, true, true>(lds, g, S, E);
    } SEAM(17);
    PHASE(18) { REP_BAR(); ph_combine<true>(H, Y, inv, mod + 9 * NMOD, nullptr, nullptr, nullptr, args.out, ML, gw, NGW, lane); }
    if (PROBE_SEAM == 18 && PROBE_DUR == 1 && bid == PROBE_BID) pr_D = (long long)(__builtin_amdgcn_s_memrealtime() - pr_prev) - 5000;
    if (PROBE_SEAM >= 0 && bid == PROBE_BID) { const unsigned long long t_end = __builtin_amdgcn_s_memrealtime() + (unsigned long long)(8 * (pr_D + 5000)); while (__builtin_amdgcn_s_memrealtime() < t_end) __builtin_amdgcn_s_sleep(8); }
#undef IN
#undef SEAM
#undef PHASE
#undef REP_BAR
}

extern "C" void kernel_launch(void* const* d_in, const int* in_sizes, int n_in, void* d_out, int out_size, void* d_ws, size_t ws_size, hipStream_t stream) {
    static int grid = 0;
    if (grid == 0) {
        if (n_in != 20 || out_size != ML * DM || ws_size < WS_END) { fprintf(stderr, "kernel_launch: unexpected problem (n_in %d, out %d, ws %zu); nothing launched\n", n_in, out_size, ws_size); grid = -1; return; }
        int dev = 0, cus = 0, per_cu = 0;
        if (hipGetDevice(&dev) != hipSuccess || hipDeviceGetAttribute(&cus, hipDeviceAttributeMultiprocessorCount, dev) != hipSuccess) { grid = -1; return; }
        if (hipFuncSetAttribute((const void*)dit_fwd, hipFuncAttributeMaxDynamicSharedMemorySize, LDS_BYTES) != hipSuccess) { fprintf(stderr, "kernel_launch: hipFuncSetAttribute failed\n"); grid = -1; return; }
        if (hipOccupancyMaxActiveBlocksPerMultiprocessor(&per_cu, (const void*)dit_fwd, 512, LDS_BYTES) != hipSuccess || per_cu < 1) fprintf(stderr, "kernel_launch: occupancy query reports %d workgroups per CU\n", per_cu);
        (void)hipGetLastError();
        grid = cus;
    }
    if (grid < 0) return;
    (void)hipMemsetAsync((char*)d_ws + WS_CTL, 0, CTL_ZERO_BYTES, stream);
    Args a{};
    for (int i = 0; i < 20; ++i) a.in[i] = (const float*)d_in[i];
    a.out = (float*)d_out; a.ws = (unsigned char*)d_ws;
#if MK_ONE_LAUNCH
    a.ph_lo = 0; a.ph_hi = NPHASE;
    hipLaunchKernelGGL(dit_fwd, dim3(grid), dim3(512), LDS_BYTES, stream, a);
#else
    for (int p = 0; p < NPHASE; ++p) { a.ph_lo = p; a.ph_hi = p + 1; hipLaunchKernelGGL(dit_fwd, dim3(grid), dim3(512), LDS_BYTES, stream, a); }
#endif
}
```

```cpp
#include <hip/hip_runtime.h>
#include <cstdio>
#include <cstdint>
namespace pg8 {
#define PG8_LAS __attribute__((address_space(3)))
typedef unsigned short bf16_t;
typedef short bf16x8 __attribute__((ext_vector_type(8)));
typedef float f32x4 __attribute__((ext_vector_type(4)));
typedef unsigned u32x4 __attribute__((ext_vector_type(4)));
constexpr int BM = 256, BK = 64, HALF = 128, HTB = HALF * BK * 2  , STAGE_BYTES = 8 * HTB, NXCD = 8, WGM = 8;

__host__ __device__ __forceinline__ int lds_byte(int r, int c) { const int st = (r >> 4) * 2 + (c >> 5), rr = r & 15, cc = c & 31, ob = rr * 64 + cc * 2; return st * 1024 + (ob ^ (((ob >> 9) & 1) << 5)); }
__host__ __device__ __forceinline__ void stage_rc(int b, int& R, int& C) { const int st = b / 1024, sb = b % 1024, swz = sb ^ (((sb >> 9) & 1) << 5); R = (st >> 1) * 16 + swz / 64; C = (st & 1) * 32 + (swz % 64) / 2; }
__host__ __device__ __forceinline__ int perm32(int rho) { const int n = rho >> 4, i = rho & 15; return 8 * (i >> 2) + 4 * n + (i & 3); }

struct Unit { int pm, pn; };
struct Gemm { const bf16_t* A; const bf16_t* Bt; int M, N, K; const int* rows = nullptr; };

struct StaticOrder {
    int nM, nN, nwg, G, c;
    __host__ __device__ void init(int M, int N, int G_, int c_) { nM = M / BM; nN = N / BM; nwg = nM * nN; G = G_; c = c_; }
    __host__ __device__ bool next(int i, Unit& u) const {
        const long L = (long)i * G + c; if (L >= nwg) return false;
        int wgid = (int)L; { const int q = nwg / NXCD, r = nwg % NXCD, xcd = wgid % NXCD, off = wgid / NXCD; wgid = (xcd < r ? xcd * (q + 1) : r * (q + 1) + (xcd - r) * q) + off; }
        const int nig = WGM * nN, gid = wgid / nig, fm = gid * WGM, gsz = (nM - fm) < WGM ? (nM - fm) : WGM;
        u.pm = fm + ((wgid % nig) % gsz); u.pn = (wgid % nig) / gsz; return true;
    }
    __device__ __forceinline__ void a_ready(const Unit&) const {}
    __device__ __forceinline__ void done(const Unit&) const {}
};
__device__ __forceinline__ unsigned cvt_pk_bf16(float lo, float hi) { unsigned r; asm volatile("v_cvt_pk_bf16_f32 %0, %1, %2" : "=v"(r) : "v"(lo), "v"(hi)); return r; }
typedef float f32x2 __attribute__((ext_vector_type(2)));
template <class Epi, class Sched, bool ALIGN_EPI = false, bool SP2 = false, bool GATHER = false, bool F8 = false>
__device__ __forceinline__ void gemm_phase(PG8_LAS unsigned char* lds, const Gemm g, const Sched& S, const Epi& E) {
    typedef int i32x4_t __attribute__((ext_vector_type(4)));
    const int tid = threadIdx.x, wid = __builtin_amdgcn_readfirstlane(tid >> 6), lane = tid & 63, wr = wid >> 2, wc = wid & 3, fr = lane & 15, fq = lane >> 4;
    const int K = g.K, nt = K / BK;
    unsigned voffA[2], voffB[2];
#pragma unroll
    for (int i = 0; i < 2; ++i) { int R, C; stage_rc(tid * 16 + i * 8192, R, C); const int Rb = Epi::PERM ? ((R & ~31) + perm32(R & 31)) : R;
        voffA[i] = (unsigned)(R * K + C) * 2u; voffB[i] = (unsigned)(Rb * K + C) * 2u; }
    const size_t kstep = (size_t)(BK * 2);
    const size_t hstep = (size_t)HALF * K * 2;
    const size_t tstep = 2 * hstep;
    const unsigned ldsw = (unsigned)wid * 1024u;
    const int aoff = lds_byte(wr * 64 + fr, fq * 8), boff = lds_byte(wc * 32 + fr, fq * 8);
#define PG8_SA(b, h) (((b) * 2 + (h)) * HTB)
#define PG8_SB(b, h) ((4 + (b) * 2 + (h)) * HTB)
#define PG8_UNI(p) ((const char*)(((unsigned long long)(unsigned)__builtin_amdgcn_readfirstlane((int)((unsigned long long)(p) >> 32)) << 32) | (unsigned long long)(unsigned)__builtin_amdgcn_readfirstlane((int)(unsigned long long)(p))))
#define PG8_STAGE(bufoff, gbase, voff) do { const char* gb_ = PG8_UNI(gbase);     \
        _Pragma("unroll") for (int _i = 0; _i < 2; ++_i) \
        __builtin_amdgcn_global_load_lds((const unsigned*)(gb_ + (voff)[_i]), (PG8_LAS unsigned*)(lds + (bufoff) + ldsw + _i * 8192), 16, 0, 0); } while (0)
#define PG8_STAGE_A(bufoff, kptr, h) do { if constexpr (GATHER) { PG8_STAGE(bufoff, kptr, vA[h]); } else { PG8_STAGE(bufoff, (kptr) + (h) * hstep, voffA); } } while (0)
#define PG8_GATHER_SWITCH() do { if constexpr (GATHER) { if (last && has_next) { asm volatile("" : "+v"(nv[0]), "+v"(nv[1]), "+v"(nv[2]), "+v"(nv[3])); \
        vA[0][0] = nv[0] * (unsigned)(K * 2) + gcoff[0]; vA[0][1] = nv[1] * (unsigned)(K * 2) + gcoff[1]; vA[1][0] = nv[2] * (unsigned)(K * 2) + gcoff[0]; vA[1][1] = nv[3] * (unsigned)(K * 2) + gcoff[1]; } } } while (0)
#define PG8_LDA(dst, b, h) do { _Pragma("unroll") for (int m = 0; m < 4; ++m) { if constexpr (F8) { dst##8[m] = PG8_CAT8(*(const PG8_LAS i32x4_t*)(lds + PG8_SA(b, h) + aoff + m * 2048), *(const PG8_LAS i32x4_t*)(lds + PG8_SA(b, h) + aoff + m * 2048 + 1024)); } \
        else { _Pragma("unroll") for (int k = 0; k < 2; ++k) dst[m][k] = *(const PG8_LAS bf16x8*)(lds + PG8_SA(b, h) + aoff + m * 2048 + k * 1024); } } } while (0)
#define PG8_LDB(dst, b, h) do { _Pragma("unroll") for (int n = 0; n < 2; ++n) { if constexpr (F8) { dst##8[n] = PG8_CAT8(*(const PG8_LAS i32x4_t*)(lds + PG8_SB(b, h) + boff + n * 2048), *(const PG8_LAS i32x4_t*)(lds + PG8_SB(b, h) + boff + n * 2048 + 1024)); } \
        else { _Pragma("unroll") for (int k = 0; k < 2; ++k) dst[n][k] = *(const PG8_LAS bf16x8*)(lds + PG8_SB(b, h) + boff + n * 2048 + k * 1024); } } } while (0)
#define PG8_CAT8(lo_, hi_) __builtin_shufflevector(lo_, hi_, 0, 1, 2, 3, 4, 5, 6, 7)
#define PG8_MMA(ai, bj, At, Bt) do { __builtin_amdgcn_s_setprio(1); _Pragma("unroll") for (int m = 0; m < 4; ++m) _Pragma("unroll") for (int n = 0; n < 2; ++n) { \
        if constexpr (F8) { acc[ai][bj][m][n] = __builtin_amdgcn_mfma_scale_f32_16x16x128_f8f6f4(Bt##8[n], At##8[m], acc[ai][bj][m][n], 0, 0, 0, 0x7f7f7f7f, 0, 0x7f7f7f7f); } \
        else { _Pragma("unroll") for (int k = 0; k < 2; ++k) acc[ai][bj][m][n] = __builtin_amdgcn_mfma_f32_16x16x32_bf16(Bt[n][k], At[m][k], acc[ai][bj][m][n], 0, 0, 0); } } \
        __builtin_amdgcn_s_setprio(0); } while (0)
#define PG8_WAIT_V(n) asm volatile("s_waitcnt vmcnt(" #n ")" ::: "memory")
#define PG8_WAIT_L(n) asm volatile("s_waitcnt lgkmcnt(" #n ")" ::: "memory")
#define PG8_BAR __builtin_amdgcn_s_barrier()
#define PG8_SCHED __builtin_amdgcn_sched_barrier(0)
    Unit cur, nxt; int ui = 0;
    if (!S.next(0, cur)) return;
    f32x4 acc[2][2][4][2];
#pragma unroll
    for (int a = 0; a < 2; ++a)
#pragma unroll
        for (int b = 0; b < 2; ++b)
#pragma unroll
            for (int m = 0; m < 4; ++m)
#pragma unroll
                for (int n = 0; n < 2; ++n) acc[a][b][m][n] = (f32x4){0.f, 0.f, 0.f, 0.f};
    bf16x8 At[4][2], B0[2][2], B1[2][2]; typedef int i32x8_t __attribute__((ext_vector_type(8))); i32x8_t At8[4], B08[2], B18[2];
    const char* cA = (const char*)g.A + (GATHER ? (size_t)0 : (size_t)cur.pm * tstep); const char* cB = (const char*)g.Bt + (size_t)cur.pn * tstep;
    unsigned vA[2][2], nv[4], gcoff[2]; int grow[2];
    if constexpr (GATHER) {
#pragma unroll
        for (int i = 0; i < 2; ++i) { int R, C; stage_rc(tid * 16 + i * 8192, R, C); grow[i] = R; gcoff[i] = (unsigned)(C * 2); }
#pragma unroll
        for (int h = 0; h < 2; ++h)
#pragma unroll
            for (int i = 0; i < 2; ++i) vA[h][i] = (unsigned)g.rows[cur.pm * BM + h * HALF + grow[i]] * (unsigned)(K * 2) + gcoff[i];
    }
    S.a_ready(cur);
    if constexpr (SP2) {
        PG8_STAGE(PG8_SB(0, 0), cB, voffB); PG8_STAGE(PG8_SB(0, 1), cB + hstep, voffB); PG8_STAGE_A(PG8_SA(0, 0), cA, 0); PG8_STAGE_A(PG8_SA(0, 1), cA, 1);
        if (wr == 1) PG8_BAR;
        PG8_WAIT_V(2); PG8_BAR;
        PG8_STAGE(PG8_SB(1, 0), cB + kstep, voffB); PG8_STAGE_A(PG8_SA(1, 0), cA + kstep, 0); PG8_STAGE(PG8_SB(1, 1), cB + hstep + kstep, voffB);
        PG8_WAIT_V(6); PG8_BAR;
    } else {
        PG8_STAGE(PG8_SB(0, 0), cB, voffB); PG8_STAGE_A(PG8_SA(0, 0), cA, 0); PG8_STAGE(PG8_SB(0, 1), cB + hstep, voffB); PG8_STAGE_A(PG8_SA(0, 1), cA, 1);
        if (wr == 1) PG8_BAR;
        PG8_WAIT_V(4); PG8_BAR;
        PG8_STAGE(PG8_SB(1, 0), cB + kstep, voffB); PG8_STAGE_A(PG8_SA(1, 0), cA + kstep, 0); PG8_STAGE(PG8_SB(1, 1), cB + hstep + kstep, voffB);
        PG8_WAIT_V(6); PG8_BAR;
    }
    for (;;) {
        const bool has_next = S.next(ui + 1, nxt);
        const char* nA = (has_next && !GATHER) ? (const char*)g.A + (size_t)nxt.pm * tstep : cA; const char* nB = has_next ? (const char*)g.Bt + (size_t)nxt.pn * tstep : cB;
        if constexpr (GATHER) { if (has_next) { const int* rp = g.rows + nxt.pm * BM;
            asm volatile("global_load_dword %0, %1, off" : "=&v"(nv[0]) : "v"(rp + grow[0]) : "memory"); asm volatile("global_load_dword %0, %1, off" : "=&v"(nv[1]) : "v"(rp + grow[1]) : "memory");
            asm volatile("global_load_dword %0, %1, off" : "=&v"(nv[2]) : "v"(rp + HALF + grow[0]) : "memory"); asm volatile("global_load_dword %0, %1, off" : "=&v"(nv[3]) : "v"(rp + HALF + grow[1]) : "memory"); } }
#pragma unroll 1
        for (int t = 0; t < nt; t += 2) {
            const bool last = (t == nt - 2);
            const char* a1 = cA + (size_t)(t + 1) * kstep;
            const char* a2 = last ? nA : cA + (size_t)(t + 2) * kstep; const char* b2 = last ? nB : cB + (size_t)(t + 2) * kstep;
            const char* a3 = a2 + kstep; const char* b3 = b2 + kstep;
            if (last && has_next) S.a_ready(nxt);
            if constexpr (SP2) {
            PG8_LDB(B0, 0, 0); PG8_LDB(B1, 0, 1); PG8_SCHED; PG8_LDA(At, 0, 0); PG8_STAGE_A(PG8_SA(1, 1), a1, 1); PG8_GATHER_SWITCH();
            PG8_WAIT_V(8); PG8_WAIT_L(0); PG8_BAR; PG8_MMA(0, 0, At, B0); PG8_MMA(0, 1, At, B1); PG8_BAR; PG8_SCHED;
            PG8_LDA(At, 0, 1); PG8_STAGE(PG8_SB(0, 0), b2, voffB); PG8_STAGE(PG8_SB(0, 1), b2 + hstep, voffB); PG8_STAGE_A(PG8_SA(0, 0), a2, 0);
            PG8_WAIT_V(8); PG8_WAIT_L(0); PG8_BAR; PG8_MMA(1, 0, At, B0); PG8_MMA(1, 1, At, B1); PG8_BAR; PG8_SCHED;
            PG8_LDB(B0, 1, 0); PG8_LDB(B1, 1, 1); PG8_SCHED; PG8_LDA(At, 1, 0); PG8_STAGE_A(PG8_SA(0, 1), a2, 1);
            PG8_WAIT_V(8); PG8_WAIT_L(0); PG8_BAR; PG8_MMA(0, 0, At, B0); PG8_MMA(0, 1, At, B1); PG8_BAR; PG8_SCHED;
            PG8_LDA(At, 1, 1); PG8_STAGE(PG8_SB(1, 0), b3, voffB); PG8_STAGE(PG8_SB(1, 1), b3 + hstep, voffB); PG8_STAGE_A(PG8_SA(1, 0), a3, 0);
            PG8_WAIT_V(8); PG8_WAIT_L(0); PG8_BAR; PG8_MMA(1, 0, At, B0); PG8_MMA(1, 1, At, B1); PG8_BAR; PG8_SCHED;
            } else {
            PG8_LDB(B0, 0, 0); PG8_SCHED; PG8_LDA(At, 0, 0); PG8_STAGE_A(PG8_SA(1, 1), a1, 1); PG8_GATHER_SWITCH();
            PG8_WAIT_L(8); PG8_BAR; PG8_WAIT_L(0); PG8_MMA(0, 0, At, B0); PG8_BAR; PG8_SCHED;
            PG8_LDB(B1, 0, 1); PG8_STAGE(PG8_SB(0, 0), b2, voffB);
            PG8_BAR; PG8_WAIT_L(0); PG8_MMA(0, 1, At, B1); PG8_BAR;
            PG8_LDA(At, 0, 1); PG8_STAGE_A(PG8_SA(0, 0), a2, 0);
            PG8_BAR; PG8_WAIT_L(0); PG8_MMA(1, 0, At, B0); PG8_BAR; PG8_SCHED;
            PG8_STAGE(PG8_SB(0, 1), b2 + hstep, voffB);
            PG8_WAIT_V(6); PG8_BAR; PG8_MMA(1, 1, At, B1); PG8_BAR;
            PG8_LDB(B0, 1, 0); PG8_SCHED; PG8_LDA(At, 1, 0); PG8_STAGE_A(PG8_SA(0, 1), a2, 1);
            PG8_WAIT_L(8); PG8_BAR; PG8_WAIT_L(0); PG8_MMA(0, 0, At, B0); PG8_BAR; PG8_SCHED;
            PG8_LDB(B1, 1, 1); PG8_STAGE(PG8_SB(1, 0), b3, voffB);
            PG8_BAR; PG8_WAIT_L(0); PG8_MMA(0, 1, At, B1); PG8_BAR;
            PG8_LDA(At, 1, 1); PG8_STAGE_A(PG8_SA(1, 0), a3, 0);
            PG8_BAR; PG8_WAIT_L(0); PG8_MMA(1, 0, At, B0); PG8_BAR; PG8_SCHED;
            PG8_STAGE(PG8_SB(1, 1), b3 + hstep, voffB);
            PG8_WAIT_V(6); PG8_BAR; PG8_MMA(1, 1, At, B1); PG8_BAR;
            }
        }
        if constexpr (ALIGN_EPI) { if (wr == 0) PG8_BAR; }
        if constexpr (!Epi::AFTER_DRAIN) { E(acc, cur, wr, wc, fr, fq); S.done(cur); }
        if (!has_next) break;
#pragma unroll
        for (int a = 0; a < 2; ++a)
#pragma unroll
            for (int b = 0; b < 2; ++b)
#pragma unroll
                for (int m = 0; m < 4; ++m)
#pragma unroll
                    for (int n = 0; n < 2; ++n) acc[a][b][m][n] = (f32x4){0.f, 0.f, 0.f, 0.f};
        cur = nxt; cA = nA; cB = nB; ++ui;
        if constexpr (ALIGN_EPI) { if (wr == 1) PG8_BAR; }
    }
    PG8_WAIT_V(0);
    if constexpr (!ALIGN_EPI) { if (wr == 0) PG8_BAR; }
    PG8_BAR;
    if constexpr (Epi::AFTER_DRAIN) { E.fused(acc, cur, wr, wc, fr, fq, lds, wid, lane); S.done(cur); }
#undef PG8_SA
#undef PG8_SB
#undef PG8_STAGE
#undef PG8_UNI
#undef PG8_STAGE_A
#undef PG8_GATHER_SWITCH
#undef PG8_LDA
#undef PG8_LDB
#undef PG8_MMA
#undef PG8_CAT8
#undef PG8_WAIT_V
#undef PG8_WAIT_L
#undef PG8_BAR
#undef PG8_SCHED
}
}

constexpr int DM = 2048, NB = 8, SEQ = 2048, CTXL = 256, NH = 16, NKV = 4, HD = 128;
constexpr int ML = NB * SEQ;
constexpr int MC = NB * CTXL;
constexpr int MT = ML + MC;
constexpr int NE = 16, CAPL = 256, CAPC = 32, DFF = 1024;
constexpr int YR = NB * CAPL + NB * CAPC;
constexpr int YT = NE * YR;
constexpr int NMOD = 6 * DM;
constexpr float NORM_EPS = 1e-6f;
constexpr int KSPLIT = 16;

using pg8::Unit; using pg8::f32x4; using pg8::u32x4; using pg8::bf16_t; using pg8::bf16x8; using pg8::cvt_pk_bf16;
typedef float f32x2 __attribute__((ext_vector_type(2)));
typedef unsigned u32x2 __attribute__((ext_vector_type(2)));
typedef float f32x16 __attribute__((ext_vector_type(16)));
typedef short s16x4 __attribute__((ext_vector_type(4)));
#define DI __device__ __forceinline__

DI float bf_lo(unsigned w) { return __uint_as_float(w << 16); }
DI float bf_hi(unsigned w) { return __uint_as_float(w & 0xffff0000u); }
DI unsigned pk4_fp8(float a, float b, float c, float d) {
    a = __builtin_amdgcn_fmed3f(a, -448.0f, 448.0f); b = __builtin_amdgcn_fmed3f(b, -448.0f, 448.0f); c = __builtin_amdgcn_fmed3f(c, -448.0f, 448.0f); d = __builtin_amdgcn_fmed3f(d, -448.0f, 448.0f);
    int w = __builtin_amdgcn_cvt_pk_fp8_f32(a, b, 0, false); w = __builtin_amdgcn_cvt_pk_fp8_f32(c, d, w, true); return (unsigned)w;
}
constexpr float Y8_SCALE = 64.0f, Y8_INV = 1.0f / 64.0f;
constexpr float W8_SCALE = 32.0f, W8_INV = 1.0f / 32.0f;
DI f32x4 unpk4_fp8(unsigned w) { const f32x2 lo = __builtin_amdgcn_cvt_pk_f32_fp8((int)w, false), hi = __builtin_amdgcn_cvt_pk_f32_fp8((int)w, true); return (f32x4){lo.x, lo.y, hi.x, hi.y}; }
DI float silu_f(float a) { return a * __builtin_amdgcn_rcpf(1.0f + __expf(-a)); }

DI int xcd_remap(int wgid, int nwg) { const int q = nwg / 8, r = nwg % 8, xcd = wgid % 8, off = wgid / 8; return (xcd < r ? xcd * (q + 1) : r * (q + 1) + (xcd - r) * q) + off; }
struct QkvOrder {
    int G, c;
    DI bool next(int i, Unit& u) const {
        const int L = i * G + c; if (L >= 800) return false;
        if (L < 768) { const int w = xcd_remap(L, 768); const int nig = 8 * 12, gid = w / nig; u.pm = gid * 8 + ((w % nig) % 8); u.pn = (w % nig) / 8; }
        else { const int j = L - 768; u.pm = 64 + (j >> 2); u.pn = 8 + (j & 3); }
        return true;
    }
    DI void a_ready(const Unit&) const {}
    DI void done(const Unit&) const {}
};
struct MoeOrder {
    int G, c, NP;
    DI bool next(int i, Unit& u) const {
        const int nwg = NE * NP * 8; const int L = i * G + c; if (L >= nwg) return false;
        const int w = xcd_remap(L, nwg); const int per = NP * 8, e = w / per, rem = w % per;
        u.pm = e * 9 + (rem % NP); u.pn = e * 8 + (rem / NP); return true;
    }
    DI void a_ready(const Unit&) const {}
    DI void done(const Unit&) const {}
};

template <int ACT  > struct EpiPair {
    static constexpr bool PERM = true, AFTER_DRAIN = false;
    bf16_t* O; int ldc; int pn_mod;
    DI void operator()(const f32x4 (&acc)[2][2][4][2], const Unit& u, int wr, int wc, int fr, int fq) const {
        const int row0 = u.pm * 256 + wr * 64 + fr, col0 = (u.pn % pn_mod) * 128 + wc * 32 + 8 * fq;
#pragma unroll
        for (int ai = 0; ai < 2; ++ai)
#pragma unroll
            for (int m = 0; m < 4; ++m) {
                bf16_t* rowp = O + (size_t)(row0 + ai * 128 + m * 16) * ldc + col0;
                f32x4 a0 = acc[ai][0][m][0], a1 = acc[ai][0][m][1]; const f32x4 b0 = acc[ai][1][m][0], b1 = acc[ai][1][m][1];
                if (ACT == 1) {
#pragma unroll
                    for (int j = 0; j < 4; ++j) { a0[j] = silu_f(a0[j]); a1[j] = silu_f(a1[j]); } }
                const f32x4 v0 = a0 * b0, v1 = a1 * b1;
                u32x4 w; w.x = cvt_pk_bf16(v0[0], v0[1]); w.y = cvt_pk_bf16(v0[2], v0[3]); w.z = cvt_pk_bf16(v1[0], v1[1]); w.w = cvt_pk_bf16(v1[2], v1[3]);
                *(u32x4*)rowp = w;
            }
    }
};
struct EpiPairF8 {
    static constexpr bool PERM = true, AFTER_DRAIN = false;
    unsigned char* O; int ldc; int pn_mod;
    DI void operator()(const f32x4 (&acc)[2][2][4][2], const Unit& u, int wr, int wc, int fr, int fq) const {
        const int row0 = u.pm * 256 + wr * 64 + fr, col0 = (u.pn % pn_mod) * 128 + wc * 32 + 8 * fq;
#pragma unroll
        for (int ai = 0; ai < 2; ++ai)
#pragma unroll
            for (int m = 0; m < 4; ++m) {
                unsigned char* rowp = O + (size_t)(row0 + ai * 128 + m * 16) * ldc + col0;
                f32x4 a0 = acc[ai][0][m][0] * W8_INV, a1 = acc[ai][0][m][1] * W8_INV; const f32x4 b0 = acc[ai][1][m][0] * W8_INV, b1 = acc[ai][1][m][1] * W8_INV;
#pragma unroll
                for (int j = 0; j < 4; ++j) { a0[j] = silu_f(a0[j]); a1[j] = silu_f(a1[j]); }
                const f32x4 v0 = a0 * b0, v1 = a1 * b1;
                u32x2 w; w.x = pk4_fp8(v0[0], v0[1], v0[2], v0[3]); w.y = pk4_fp8(v1[0], v1[1], v1[2], v1[3]);
                *(u32x2*)rowp = w;
            }
    }
};
struct EpiConvGate {
    static constexpr bool PERM = true, AFTER_DRAIN = false;
    const bf16_t* U; bf16_t* Z; const float* cw; const bf16_t* zeros;
    DI void operator()(const f32x4 (&acc)[2][2][4][2], const Unit& u, int wr, int wc, int fr, int fq) const {
        const int row0 = u.pm * 256 + wr * 64 + fr, col0 = u.pn * 256 + wc * 32 + 8 * fq;
        const bool latu = u.pm * 256 < ML; const int tmask = latu ? SEQ - 1 : CTXL - 1, rbase = latu ? 0 : ML;
        u32x4 uc[3], up[3], un[3];
#define CG_ROW(it_) (row0 + (((it_) >> 2) & 1) * 128 + ((it_) & 3) * 16)
#define CG_LOAD(it_) do { const int row_ = CG_ROW(it_), tpos_ = (row_ - rbase) & tmask; const bf16_t* pc_ = U + (size_t)row_ * DM + col0 + ((it_) >> 3) * 128; \
            uc[(it_) % 3] = *(const u32x4*)pc_; up[(it_) % 3] = *(const u32x4*)(tpos_ > 0 ? pc_ - DM : zeros); un[(it_) % 3] = *(const u32x4*)(tpos_ < tmask ? pc_ + DM : zeros); } while (0)
        CG_LOAD(0); CG_LOAD(1); CG_LOAD(2);
        f32x4 w0a, w0b, w1a, w1b, w2a, w2b;
#pragma unroll
        for (int it = 0; it < 16; ++it) {
            const int bj = it >> 3, ai = (it >> 2) & 1, m = it & 3, c = col0 + bj * 128, row = CG_ROW(it);
            if ((it & 7) == 0) { w0a = *(const f32x4*)(cw + c); w0b = *(const f32x4*)(cw + c + 4); w1a = *(const f32x4*)(cw + 2048 + c); w1b = *(const f32x4*)(cw + 2048 + c + 4); w2a = *(const f32x4*)(cw + 4096 + c); w2b = *(const f32x4*)(cw + 4096 + c + 4); }
            const u32x4 cc = uc[it % 3], pp = up[it % 3], nn = un[it % 3];
            f32x4 ya, yb;
            ya[0] = w0a[0] * bf_lo(pp.x) + w1a[0] * bf_lo(cc.x) + w2a[0] * bf_lo(nn.x); ya[1] = w0a[1] * bf_hi(pp.x) + w1a[1] * bf_hi(cc.x) + w2a[1] * bf_hi(nn.x);
            ya[2] = w0a[2] * bf_lo(pp.y) + w1a[2] * bf_lo(cc.y) + w2a[2] * bf_lo(nn.y); ya[3] = w0a[3] * bf_hi(pp.y) + w1a[3] * bf_hi(cc.y) + w2a[3] * bf_hi(nn.y);
            yb[0] = w0b[0] * bf_lo(pp.z) + w1b[0] * bf_lo(cc.z) + w2b[0] * bf_lo(nn.z); yb[1] = w0b[1] * bf_hi(pp.z) + w1b[1] * bf_hi(cc.z) + w2b[1] * bf_hi(nn.z);
            yb[2] = w0b[2] * bf_lo(pp.w) + w1b[2] * bf_lo(cc.w) + w2b[2] * bf_lo(nn.w); yb[3] = w0b[3] * bf_hi(pp.w) + w1b[3] * bf_hi(cc.w) + w2b[3] * bf_hi(nn.w);
            const f32x4 v0 = acc[ai][bj][m][0] * ya, v1 = acc[ai][bj][m][1] * yb;
            u32x4 w; w.x = cvt_pk_bf16(v0[0], v0[1]); w.y = cvt_pk_bf16(v0[2], v0[3]); w.z = cvt_pk_bf16(v1[0], v1[1]); w.w = cvt_pk_bf16(v1[2], v1[3]);
            *(u32x4*)(Z + (size_t)row * DM + c) = w;
            if (it + 3 < 16) CG_LOAD(it + 3);
            __builtin_amdgcn_sched_barrier(0);
        }
#undef CG_ROW
#undef CG_LOAD
    }
};
template <bool BASE_F32> struct EpiResid {
    static constexpr bool PERM = true, AFTER_DRAIN = false;
    const float* base_lat; const float* base_ctx; bf16_t* out; const float* gate; float ws;
    DI void operator()(const f32x4 (&acc)[2][2][4][2], const Unit& u, int wr, int wc, int fr, int fq) const {
        const int rowt = u.pm * 256; const int cr = rowt < ML ? (rowt >> 11) : 8;
        const float* base = rowt < ML ? base_lat : base_ctx - (size_t)ML * DM;
        const int row0 = rowt + wr * 64 + fr, col0 = u.pn * 256 + wc * 32 + 8 * fq;
        f32x4 gv[2][2];
#pragma unroll
        for (int bj = 0; bj < 2; ++bj)
#pragma unroll
            for (int n = 0; n < 2; ++n) gv[bj][n] = *(const f32x4*)(gate + (size_t)cr * NMOD + col0 + bj * 128 + n * 4) * ws;
        f32x4 fb[BASE_F32 ? 3 : 1][2][2]; u32x4 hb[BASE_F32 ? 1 : 3][2];
#define RES_OFF(g_) ((size_t)(row0 + ((g_) >> 2) * 128 + ((g_) & 3) * 16) * DM + col0)
#define RES_LOAD(g_) do { const size_t off_ = RES_OFF(g_); _Pragma("unroll") for (int bj = 0; bj < 2; ++bj) { \
            if (BASE_F32) { fb[(g_) % 3][bj][0] = *(const f32x4*)(base + off_ + bj * 128); fb[(g_) % 3][bj][1] = *(const f32x4*)(base + off_ + bj * 128 + 4); } \
            else hb[(g_) % 3][bj] = *(const u32x4*)(out + off_ + bj * 128); } } while (0)
        RES_LOAD(0); RES_LOAD(1); RES_LOAD(2);
#pragma unroll
        for (int g = 0; g < 8; ++g) { const int ai = g >> 2, m = g & 3; const size_t off = RES_OFF(g);
#pragma unroll
            for (int bj = 0; bj < 2; ++bj) { f32x4 b0, b1;
                if (BASE_F32) { b0 = fb[g % 3][bj][0]; b1 = fb[g % 3][bj][1]; }
                else { const u32x4 h4 = hb[g % 3][bj]; b0 = (f32x4){bf_lo(h4.x), bf_hi(h4.x), bf_lo(h4.y), bf_hi(h4.y)}; b1 = (f32x4){bf_lo(h4.z), bf_hi(h4.z), bf_lo(h4.w), bf_hi(h4.w)}; }
                const f32x4 v0 = b0 + gv[bj][0] * acc[ai][bj][m][0], v1 = b1 + gv[bj][1] * acc[ai][bj][m][1];
                u32x4 w; w.x = cvt_pk_bf16(v0[0], v0[1]); w.y = cvt_pk_bf16(v0[2], v0[3]); w.z = cvt_pk_bf16(v1[0], v1[1]); w.w = cvt_pk_bf16(v1[2], v1[3]);
                *(u32x4*)(out + off + bj * 128) = w; }
            if (g + 3 < 8) RES_LOAD(g + 3);
            __builtin_amdgcn_sched_barrier(0); }
#undef RES_OFF
#undef RES_LOAD
    }
};
struct EpiDown {
    static constexpr bool PERM = true, AFTER_DRAIN = false;
    bf16_t* Y; const float* gatev; float ws;
    DI void operator()(const f32x4 (&acc)[2][2][4][2], const Unit& u, int wr, int wc, int fr, int fq) const {
        const int row0 = u.pm * 256 + wr * 64 + fr, col0 = (u.pn & 7) * 256 + wc * 32 + 8 * fq;
        float gts[2][4];
#pragma unroll
        for (int ai = 0; ai < 2; ++ai)
#pragma unroll
            for (int m = 0; m < 4; ++m) gts[ai][m] = gatev[row0 + ai * 128 + m * 16];
        __builtin_amdgcn_sched_barrier(0);
#pragma unroll
        for (int ai = 0; ai < 2; ++ai)
#pragma unroll
            for (int m = 0; m < 4; ++m) { const int row = row0 + ai * 128 + m * 16; const float gt = gts[ai][m] * ws;
#pragma unroll
                for (int bj = 0; bj < 2; ++bj) { const f32x4 v0 = acc[ai][bj][m][0] * gt, v1 = acc[ai][bj][m][1] * gt;
                    u32x2 w; w.x = pk4_fp8(v0[0], v0[1], v0[2], v0[3]); w.y = pk4_fp8(v1[0], v1[1], v1[2], v1[3]);
                    *(u32x2*)((unsigned char*)Y + (size_t)row * DM + col0 + bj * 128) = w; } }
    }
};
#define LAS3 __attribute__((address_space(3)))
struct EpiQkvNorm {
    static constexpr bool PERM = true, AFTER_DRAIN = false;
    bf16_t* Q; bf16_t* K; bf16_t* V; const float* qg; const float* kg; LAS3 float* P; float ws;
    DI void operator()(const f32x4 (&acc)[2][2][4][2], const Unit& u, int wr, int wc, int fr, int fq) const {
        const int row0 = u.pm * 256 + wr * 64 + fr; int colt = u.pn * 256;
        if (colt >= 2560) {
            const int col0 = colt - 2560 + wc * 32 + 8 * fq;
#pragma unroll
            for (int ai = 0; ai < 2; ++ai)
#pragma unroll
                for (int m = 0; m < 4; ++m) { bf16_t* rowp = V + (size_t)(row0 + ai * 128 + m * 16) * 512 + col0;
#pragma unroll
                    for (int bj = 0; bj < 2; ++bj) { const f32x4 v0 = acc[ai][bj][m][0] * ws, v1 = acc[ai][bj][m][1] * ws;
                        u32x4 w; w.x = cvt_pk_bf16(v0[0], v0[1]); w.y = cvt_pk_bf16(v0[2], v0[3]); w.z = cvt_pk_bf16(v1[0], v1[1]); w.w = cvt_pk_bf16(v1[2], v1[3]);
                        *(u32x4*)(rowp + bj * 128) = w; } }
            return;
        }
        const bool isq = colt < 2048; bf16_t* base = isq ? Q : K; const int ld = isq ? 2048 : 512; if (!isq) colt -= 2048;
        const int rl0 = wr * 64 + fr;
#pragma unroll
        for (int ai = 0; ai < 2; ++ai)
#pragma unroll
            for (int m = 0; m < 4; ++m)
#pragma unroll
                for (int bj = 0; bj < 2; ++bj) { const f32x4 a = acc[ai][bj][m][0], b = acc[ai][bj][m][1];
                    float s = (a[0] * a[0] + a[1] * a[1]) + (a[2] * a[2] + a[3] * a[3]) + (b[0] * b[0] + b[1] * b[1]) + (b[2] * b[2] + b[3] * b[3]);
                    s += __shfl_xor(s, 16); s += __shfl_xor(s, 32);
                    P[((ai * 128 + m * 16 + rl0) * 2 + bj) * 4 + wc] = s; }
        asm volatile("s_waitcnt lgkmcnt(0)" ::: "memory"); __builtin_amdgcn_s_barrier(); asm volatile("" ::: "memory");
        constexpr float QSCALE = 0.08838834764831845f * 1.4426950408889634f;
        int fqo = fq, fro = fr; asm volatile("" : "+v"(fqo), "+v"(fro));
        const int i0 = 16 * (wc & 1) + 4 * fqo, d0 = 64 * (wc >> 1) + i0;
        const float* gp = isq ? qg : kg; f32x4 g0 = *(const f32x4*)(gp + d0), g1 = *(const f32x4*)(gp + d0 + 32);
        if (isq) { g0 = g0 * QSCALE; g1 = g1 * QSCALE; }
        const float wsq = ws * ws * (1.0f / HD);
#define QKV_OUT(ai_, m_, cs_, sn_) do { const int row_ = row0 + (ai_) * 128 + (m_) * 16; \
            _Pragma("unroll") for (int bj = 0; bj < 2; ++bj) { const f32x4 pp = *(const LAS3 f32x4*)(P + (((ai_) * 128 + (m_) * 16 + rl0) * 2 + bj) * 4); \
                const float rstd = ws * __builtin_amdgcn_rsqf(((pp[0] + pp[1]) + (pp[2] + pp[3])) * wsq + NORM_EPS);     \
                const f32x4 a = acc[ai_][bj][m_][0] * (g0 * rstd), b = acc[ai_][bj][m_][1] * (g1 * rstd); \
                const f32x4 o1 = a * (cs_) - b * (sn_), o2 = b * (cs_) + a * (sn_); \
                u32x4 w; w.x = cvt_pk_bf16(o1[0], o1[1]); w.y = cvt_pk_bf16(o1[2], o1[3]); w.z = cvt_pk_bf16(o2[0], o2[1]); w.w = cvt_pk_bf16(o2[2], o2[3]); \
                *(u32x4*)(base + (size_t)row_ * ld + colt + bj * 128 + wc * 32 + 8 * fq) = w; } __builtin_amdgcn_sched_barrier(0); } while (0)
        if (u.pm >= 64) {
            const f32x4 one = (f32x4){1.f, 1.f, 1.f, 1.f}, zero = (f32x4){0.f, 0.f, 0.f, 0.f};
#pragma unroll
            for (int ai = 0; ai < 2; ++ai)
#pragma unroll
                for (int m = 0; m < 4; ++m) QKV_OUT(ai, m, one, zero);
            return;
        }
        f32x4 ifr;
#pragma unroll
        for (int j = 0; j < 4; ++j) ifr[j] = exp2f(-(float)(i0 + j) * (13.287712379549449f / 32.0f)) * 0.15915494309189535f;
        if ((wc >> 1) == 0) {
#pragma unroll
            for (int ai = 0; ai < 2; ++ai) { const float pos = (float)((4 * u.pm + wr + 2 * ai) & 31); f32x4 cs, sn;
#pragma unroll
                for (int j = 0; j < 4; ++j) { const float rev = pos * ifr[j]; cs[j] = __builtin_amdgcn_cosf(rev); sn[j] = __builtin_amdgcn_sinf(rev); }
#pragma unroll
                for (int m = 0; m < 4; ++m) QKV_OUT(ai, m, cs, sn); }
        } else {
#pragma unroll
            for (int m = 0; m < 4; ++m) { const float pos = (float)(16 * m + fro); f32x4 cs, sn;
#pragma unroll
                for (int j = 0; j < 4; ++j) { const float rev = pos * ifr[j]; cs[j] = __builtin_amdgcn_cosf(rev); sn[j] = __builtin_amdgcn_sinf(rev); }
#pragma unroll
                for (int ai = 0; ai < 2; ++ai) QKV_OUT(ai, m, cs, sn); }
        }
#undef QKV_OUT
    }
};

constexpr size_t MiB = 1u << 20;
constexpr size_t WS_CTL = 0, CTL_ZERO_BYTES = 1 * MiB;
constexpr size_t WS_MOD = 1 * MiB;
constexpr size_t WS_MODP = 2 * MiB;
constexpr size_t WS_AFFL = 16 * MiB;
constexpr size_t WS_AFFC = 17 * MiB;
constexpr size_t WS_RWT = 17 * MiB + 128 * 1024;
constexpr size_t WS_IDMAP = 19 * MiB + 768 * 1024;
constexpr size_t WS_ROWSRC = 17 * MiB + 512 * 1024;
constexpr size_t WS_GATEV = 18 * MiB;
constexpr size_t WS_INV = 18 * MiB + 512 * 1024;
constexpr size_t WS_W1A = 20 * MiB;
constexpr size_t WS_W1B = 36 * MiB;
constexpr size_t WS_W2 = 44 * MiB;
constexpr size_t WS_WQKV = 52 * MiB;
constexpr size_t WS_WO = 64 * MiB;
constexpr size_t WS_WGU = 72 * MiB;
constexpr size_t WS_WDN = 328 * MiB;
constexpr size_t WS_H = 456 * MiB;
constexpr size_t WS_A = 600 * MiB;
constexpr size_t WS_U = 672 * MiB;
constexpr size_t WS_Z = 744 * MiB;
constexpr size_t WS_Q = WS_U, WS_K = WS_Z, WS_V = WS_Z + 18 * MiB;
constexpr size_t WS_HM = 816 * MiB;
constexpr size_t WS_O = WS_HM;
constexpr size_t WS_Y = 888 * MiB;
constexpr size_t WS_END = 1032 * MiB;
constexpr int CW_BAR = 4096;

constexpr int RING_BYTES = 131072;
constexpr int MISC_OFF = RING_BYTES + 14336;
constexpr int LDS_BYTES = 147456;

#define GAS __attribute__((address_space(1)))
#define LAS __attribute__((address_space(3)))
#define LDS_WAIT() asm volatile("s_waitcnt lgkmcnt(0)" ::: "memory")
#define VM_WAIT() asm volatile("s_waitcnt vmcnt(0)" ::: "memory")
#define XB_TMO      128
#define XB_XCNT(j)  (256  + 64 * (j))
#define XB_XSUB(j)  (1280 + 64 * (j))
#define XB_XGEN(j)  (2304 + 64 * (j))
#define XB_TOP      3328
#define XB_TOPGEN   3392
#define XCD_BAR_WORDS 3456
#define XB_SPIN_CAP (1u << 18)

__device__ __forceinline__ unsigned xb_ld(unsigned* p)              { return __hip_atomic_load(p, __ATOMIC_RELAXED, __HIP_MEMORY_SCOPE_AGENT); }
__device__ __forceinline__ unsigned xb_add(unsigned* p, unsigned v) { return __hip_atomic_fetch_add(p, v, __ATOMIC_RELAXED, __HIP_MEMORY_SCOPE_AGENT); }
__device__ __forceinline__ unsigned xb_xcc_id() { return (unsigned)__builtin_amdgcn_s_getreg((3 << 11) | 20) & 0xFu; }
#define XB_SPIN(cond, bar) do { unsigned _sp = 0; while (cond) { __builtin_amdgcn_s_sleep(1); \
    if ((++_sp & 255u) == 0u) { if (xb_ld(&(bar)[XB_TMO])) break; if (_sp > XB_SPIN_CAP) { atomicAdd(&(bar)[XB_TMO], 1u); break; } } } } while (0)

struct XcdBarrier {
    unsigned* bar; unsigned x;
    volatile LAS unsigned* st;
};

__device__ __forceinline__ XcdBarrier xcd_barrier_post(unsigned* bar, volatile LAS unsigned* st) {
    XcdBarrier b; b.bar = bar; b.x = xb_xcc_id(); b.st = st;
    if (threadIdx.x == 0) (void)xb_add(&bar[XB_XCNT(b.x)], 1u);
    return b;
}
__device__ __forceinline__ void xcd_barrier_complete(unsigned* bar, unsigned x, unsigned& nloc, unsigned& nx) {
    const unsigned G = gridDim.x * gridDim.y * gridDim.z;
    unsigned sum, cnt, mine, sp = 0u;
    for (;;) {
        sum = 0u; cnt = 0u; mine = 0u;
#pragma unroll
        for (unsigned j = 0; j < 16; ++j) { const unsigned c = xb_ld(&bar[XB_XCNT(j)]); sum += c; cnt += (c > 0u) ? 1u : 0u; mine = (j == x) ? c : mine; }
        if (sum == G) break;
        __builtin_amdgcn_s_sleep(1);
        if ((++sp & 255u) == 0u) { if (xb_ld(&bar[XB_TMO])) break; if (sp > XB_SPIN_CAP) { atomicAdd(&bar[XB_TMO], 1u); break; } }
    }
    nloc = mine > 0u ? mine : 1u; nx = cnt > 0u ? cnt : 1u;
}

__device__ __forceinline__ void xcd_barrier(const XcdBarrier& b) {
    asm volatile("s_waitcnt vmcnt(0)" ::: "memory");
    __syncthreads();
    if (threadIdx.x == 0) {
        unsigned* bar = b.bar;
        __builtin_amdgcn_s_waitcnt(0);
        unsigned nloc = b.st[0], nx = b.st[1];
        if (nloc == 0u) { xcd_barrier_complete(bar, b.x, nloc, nx); b.st[0] = nloc; b.st[1] = nx; }
        const unsigned old = xb_add(&bar[XB_XSUB(b.x)], 1u);
        const unsigned gen = old / nloc;
        if (old + 1u == (gen + 1u) * nloc) {
            asm volatile("buffer_inv sc1" ::: "memory");
            __builtin_amdgcn_fence(__ATOMIC_RELEASE, "agent");
            asm volatile("s_waitcnt vmcnt(0)" ::: "memory");
            const unsigned og = xb_add(&bar[XB_TOP], 1u);
            const unsigned tg = og / nx;
            if (og + 1u == (tg + 1u) * nx) xb_add(&bar[XB_TOPGEN], 1u);
            else XB_SPIN(xb_ld(&bar[XB_TOPGEN]) == tg, bar);
            asm volatile("" ::: "memory");
            xb_add(&bar[XB_XGEN(b.x)], 1u);
            asm volatile("" ::: "memory");
        } else {
            asm volatile("buffer_inv sc1" ::: "memory");
            XB_SPIN(xb_ld(&bar[XB_XGEN(b.x)]) == gen, bar);
            asm volatile("" ::: "memory");
            asm volatile("s_waitcnt vmcnt(0)" ::: "memory");
        }
    }
    __syncthreads();
}

DI float wave_sum(float v) {
#pragma unroll
    for (int o = 1; o < 64; o <<= 1) v += __shfl_xor(v, o);
    return v;
}
DI float rdlane(float v, int l) { return __uint_as_float((unsigned)__builtin_amdgcn_readlane((int)__float_as_uint(v), l)); }
DI unsigned pk2(float lo, float hi) { return cvt_pk_bf16(lo, hi); }

DI void ph_adaln(const float* cnd, const float* cctx, const float* ada_w, float* modp, int gw, int NGW, int lane) {
    const int G_ = NGW >> 3;
    for (int task = (gw & 7) * G_ + (gw >> 3); task < 96 * KSPLIT; task += NGW) {
        const int ks = task & (KSPLIT - 1), cg = task / KSPLIT, l = cg / 48, cgl = cg % 48, col0 = cgl * 256 + lane * 4, k0 = ks * 128;
        float sv[9][2];
#pragma unroll
        for (int r = 0; r < 9; ++r)
#pragma unroll
            for (int hh = 0; hh < 2; ++hh) { const int k = k0 + hh * 64 + lane; const float v = r < 8 ? cnd[r * DM + k] : cctx[k]; sv[r][hh] = v / (1.0f + __expf(-v)); }
        f32x4 acc[9];
#pragma unroll
        for (int r = 0; r < 9; ++r) acc[r] = (f32x4){0.f, 0.f, 0.f, 0.f};
        const float* wp = ada_w + ((size_t)l * DM + k0) * NMOD + col0;
#pragma unroll
        for (int hh = 0; hh < 2; ++hh) {
#pragma unroll 16
            for (int kk = 0; kk < 64; ++kk) {
                const f32x4 w = __builtin_nontemporal_load((const f32x4*)(wp + (size_t)(hh * 64 + kk) * NMOD));
#pragma unroll
                for (int r = 0; r < 9; ++r) { const float s = rdlane(sv[r][hh], kk); acc[r] += w * s; }
            }
        }
#pragma unroll
        for (int r = 0; r < 9; ++r) *(f32x4*)(modp + ((size_t)((ks * 2 + l) * 9 + r)) * NMOD + col0) = acc[r];
    }
}
struct CvtPtrs { const float *cin, *cout, *wqkv, *wo, *wg, *wu, *wd; bf16_t *W1A, *W1B, *W2, *WQKV, *WO, *WGU, *WDN; };
constexpr int CVT_E0 = 6656, CVT_L = 24576, CVT_TOTAL = CVT_E0 + 2 * CVT_L;
DI void cvt_resolve(const CvtPtrs& P, int it, const float*& src, int& ldw, bf16_t*& dst, int& ldd, bool& qperm, bool& f8) {
    int r = it; qperm = false; f8 = false;
    if (r < 3072) { const int kt = ((r >> 3) / 96) * 8 + (r & 7), nt = (r >> 3) % 96, n0 = nt * 64, part = n0 >> 11, j0 = n0 & 2047;
        src = P.cin + (size_t)(kt * 64) * 6144 + n0; ldw = 6144; ldd = DM;
        dst = (part == 0 ? P.W1B + (size_t)j0 * DM : P.W1A + (size_t)((j0 >> 7) * 256 + (part == 2 ? 128 : 0) + (j0 & 127)) * DM) + kt * 64; return; } r -= 3072;
    if (r < 1024) { const int kt = ((r >> 3) / 32) * 8 + (r & 7), nt = (r >> 3) % 32; src = P.cout + (size_t)(kt * 64) * DM + nt * 64; ldw = DM; dst = P.W2 + (size_t)(nt * 64) * DM + kt * 64; ldd = DM; return; } r -= 1024;
    if (r < 1536) { const int kt = ((r >> 3) / 48) * 8 + (r & 7), nt = (r >> 3) % 48; src = P.wqkv + (size_t)(kt * 64) * 3072 + nt * 64; ldw = 3072; qperm = nt < 40;     f8 = true; dst = (bf16_t*)((unsigned char*)P.WQKV + (size_t)(nt * 64) * DM + kt * 64); ldd = DM;     return; } r -= 1536;
    if (r < 1024) { const int kt = ((r >> 3) / 32) * 8 + (r & 7), nt = (r >> 3) % 32; src = P.wo + (size_t)(kt * 64) * DM + nt * 64; ldw = DM; f8 = true;
        dst = (bf16_t*)((unsigned char*)P.WO + (size_t)(nt * 64) * DM + kt * 64); ldd = DM; return; } r -= 1024;
    const int l = r / CVT_L, rr = r % CVT_L, kind = rr / 8192, q = rr % 8192, le = l * 16 + q / 512, rem = q % 512;
    f8 = true;
    if (kind < 2) { const int kt = ((rem >> 3) / 16) * 8 + (rem & 7), nt = (rem >> 3) % 16, n0 = nt * 64;
        src = (kind ? P.wu : P.wg) + (size_t)le * DM * DFF + (size_t)(kt * 64) * DFF + n0; ldw = DFF;
        dst = (bf16_t*)((unsigned char*)P.WGU + (size_t)(le * 2048 + (n0 >> 7) * 256 + kind * 128 + (n0 & 127)) * DM + kt * 64); ldd = DM; }
    else { const int kt = ((rem >> 3) / 32) * 8 + (rem & 7), nt = (rem >> 3) % 32;
        src = P.wd + (size_t)le * DFF * DM + (size_t)(kt * 64) * DM + nt * 64; ldw = DM; dst = (bf16_t*)((unsigned char*)P.WDN + (size_t)(le * 2048 + nt * 64) * DFF + kt * 64); ldd = DFF; }
}
constexpr int CVT_P = 36;
DI void cvt_range(const CvtPtrs& P, int lo, int hi, int w, int NW, LAS unsigned* scr, int lane) {
    int it = lo + w; if (it >= hi) return;
    const int c = lane & 15, q = lane >> 4;
    const float* src; int ldw; bf16_t* dst; int ldd; bool qperm, f8; cvt_resolve(P, it, src, ldw, dst, ldd, qperm, f8);
    f32x4 v[16];
#pragma unroll
    for (int rr = 0; rr < 16; ++rr) v[rr] = __builtin_nontemporal_load((const f32x4*)(src + (size_t)(16 * q + rr) * ldw + 4 * c));
    for (;;) {
        const bool cf8 = f8; const int wrow = qperm ? 32 * ((c >> 2) & 1) + 8 * (c & 3) + 4 * (c >> 3) : 4 * c;
        u32x4 pa[4], pb[4];
        if (cf8) {
#pragma unroll
            for (int i = 0; i < 4; ++i) { pa[i].x = pk4_fp8(v[0][i] * W8_SCALE, v[1][i] * W8_SCALE, v[2][i] * W8_SCALE, v[3][i] * W8_SCALE); pa[i].y = pk4_fp8(v[4][i] * W8_SCALE, v[5][i] * W8_SCALE, v[6][i] * W8_SCALE, v[7][i] * W8_SCALE);
                                          pa[i].z = pk4_fp8(v[8][i] * W8_SCALE, v[9][i] * W8_SCALE, v[10][i] * W8_SCALE, v[11][i] * W8_SCALE); pa[i].w = pk4_fp8(v[12][i] * W8_SCALE, v[13][i] * W8_SCALE, v[14][i] * W8_SCALE, v[15][i] * W8_SCALE); pb[i] = pa[i]; }
        } else {
#pragma unroll
            for (int i = 0; i < 4; ++i) { pa[i].x = pk2(v[0][i], v[1][i]); pa[i].y = pk2(v[2][i], v[3][i]); pa[i].z = pk2(v[4][i], v[5][i]); pa[i].w = pk2(v[6][i], v[7][i]);
                                          pb[i].x = pk2(v[8][i], v[9][i]); pb[i].y = pk2(v[10][i], v[11][i]); pb[i].z = pk2(v[12][i], v[13][i]); pb[i].w = pk2(v[14][i], v[15][i]); }
        }
        const int nit = it + NW; bf16_t* cdst = dst; const int cldd = ldd;
        if (nit < hi) { cvt_resolve(P, nit, src, ldw, dst, ldd, qperm, f8);
#pragma unroll
            for (int rr = 0; rr < 16; ++rr) v[rr] = __builtin_nontemporal_load((const f32x4*)(src + (size_t)(16 * q + rr) * ldw + 4 * c)); }
        if (cf8) {
#pragma unroll
            for (int i = 0; i < 4; ++i) *(LAS u32x4*)(scr + (wrow + i) * 20 + 4 * q) = pa[i];
            LDS_WAIT(); asm volatile("" ::: "memory");
#pragma unroll
            for (int j = 0; j < 4; ++j) { const int ch = lane + 64 * j, n = ch >> 2, part = ch & 3; const u32x4 o = *(const LAS u32x4*)(scr + n * 20 + 4 * part);
                *(u32x4*)((unsigned char*)cdst + (size_t)n * cldd + 16 * part) = o; }
        } else {
#pragma unroll
            for (int i = 0; i < 4; ++i) { *(LAS u32x4*)(scr + (wrow + i) * CVT_P + 8 * q) = pa[i]; *(LAS u32x4*)(scr + (wrow + i) * CVT_P + 8 * q + 4) = pb[i]; }
            LDS_WAIT(); asm volatile("" ::: "memory");
#pragma unroll
            for (int j = 0; j < 8; ++j) { const int n = (lane >> 3) + 8 * j; const u32x4 o = *(const LAS u32x4*)(scr + n * CVT_P + 4 * (lane & 7));
                *(u32x4*)(cdst + (size_t)n * cldd + 8 * (lane & 7)) = o; }
        }
        LDS_WAIT(); asm volatile("" ::: "memory");
        if (nit >= hi) break;
        it = nit;
    }
}
DI void ph_modred(const float* modp, const float* ada_b, float* mod, int gtid, int GT) {
    for (int i = gtid; i < 2 * 9 * NMOD; i += GT) { const int l = i / (9 * NMOD), j = i % NMOD; float s = ada_b[l * NMOD + j];
#pragma unroll
        for (int ks = 0; ks < KSPLIT; ++ks) s += modp[(size_t)ks * (2 * 9 * NMOD) + i];
        mod[i] = s; }
}
DI void row_load(const float* p, f32x4 (&v)[8], int lane) {
#pragma unroll
    for (int j = 0; j < 8; ++j) v[j] = *(const f32x4*)(p + 4 * lane + 256 * j);
}
DI void row_load_bf(const bf16_t* p, f32x4 (&v)[8], int lane) {
#pragma unroll
    for (int j = 0; j < 8; ++j) { const u32x2 w = *(const u32x2*)(p + 4 * lane + 256 * j); v[j] = (f32x4){bf_lo(w.x), bf_hi(w.x), bf_lo(w.y), bf_hi(w.y)}; }
}
DI void row_modulate(const f32x4 (&v)[8], f32x4 (&y)[8], const float* gain, const float* shift, const float* scale, int lane) {
    float ss = 0.f;
#pragma unroll
    for (int j = 0; j < 8; ++j) ss += (v[j][0] * v[j][0] + v[j][1] * v[j][1]) + (v[j][2] * v[j][2] + v[j][3] * v[j][3]);
    ss = wave_sum(ss);
    const float rstd = 1.0f / sqrtf(ss * (1.0f / DM) + NORM_EPS);
#pragma unroll
    for (int j = 0; j < 8; ++j) { const int c = 4 * lane + 256 * j; const f32x4 g = *(const f32x4*)(gain + c), sh = *(const f32x4*)(shift + c), sc = *(const f32x4*)(scale + c);
        y[j] = ((v[j] * rstd) * g) * (sc + 1.0f) + sh; }
}
DI void row_modulate2(const f32x4 (&v0)[8], const f32x4 (&v1)[8], f32x4 (&y0)[8], f32x4 (&y1)[8], const float* gain, const float* shift, const float* scale, int lane) {
    float s0 = 0.f, s1 = 0.f;
#pragma unroll
    for (int j = 0; j < 8; ++j) { s0 += (v0[j][0] * v0[j][0] + v0[j][1] * v0[j][1]) + (v0[j][2] * v0[j][2] + v0[j][3] * v0[j][3]); s1 += (v1[j][0] * v1[j][0] + v1[j][1] * v1[j][1]) + (v1[j][2] * v1[j][2] + v1[j][3] * v1[j][3]); }
    s0 = wave_sum(s0); s1 = wave_sum(s1);
    const float r0 = 1.0f / sqrtf(s0 * (1.0f / DM) + NORM_EPS), r1 = 1.0f / sqrtf(s1 * (1.0f / DM) + NORM_EPS);
#pragma unroll
    for (int j = 0; j < 8; ++j) { const int c = 4 * lane + 256 * j; const f32x4 g = *(const f32x4*)(gain + c), sh = *(const f32x4*)(shift + c), sc = *(const f32x4*)(scale + c);
        y0[j] = ((v0[j] * r0) * g) * (sc + 1.0f) + sh; y1[j] = ((v1[j] * r1) * g) * (sc + 1.0f) + sh; }
}
DI void row_store_bf16(bf16_t* p, const f32x4 (&y)[8], int lane) {
#pragma unroll
    for (int j = 0; j < 8; ++j) { u32x2 w; w.x = pk2(y[j][0], y[j][1]); w.y = pk2(y[j][2], y[j][3]); *(u32x2*)(p + 4 * lane + 256 * j) = w; }
}
DI void ph_mod0(const float* x, const float* ctx, const float* gain, const float* mod0, bf16_t* A, int gw, int NGW, int lane) {
    int row = gw; if (row >= MT) return;
    f32x4 v[8], vn[8];
    row_load(row < ML ? x + (size_t)row * DM : ctx + (size_t)(row - ML) * DM, v, lane);
    for (;;) {
        const int nrow = row + NGW; const bool more = nrow < MT;
        if (more) row_load(nrow < ML ? x + (size_t)nrow * DM : ctx + (size_t)(nrow - ML) * DM, vn, lane);
        const int cr = row < ML ? (row >> 11) : 8;
        f32x4 y[8]; row_modulate(v, y, gain, mod0 + (size_t)cr * NMOD + 0 * DM, mod0 + (size_t)cr * NMOD + 1 * DM, lane);
        row_store_bf16(A + (size_t)row * DM, y, lane);
        if (!more) break;
#pragma unroll
        for (int j = 0; j < 8; ++j) v[j] = vn[j];
        row = nrow;
    }
}
DI float reduce8(const float (&v)[8], int lane) {
    const bool u0 = lane & 1, u1 = lane & 2, u2 = lane & 4;
    float a[4], b2[2];
#pragma unroll
    for (int k = 0; k < 4; ++k) { const float lo = v[2 * k], hi = v[2 * k + 1]; a[k] = (u0 ? hi : lo) + __shfl_xor(u0 ? lo : hi, 1); }
#pragma unroll
    for (int k = 0; k < 2; ++k) { const float lo = a[2 * k], hi = a[2 * k + 1]; b2[k] = (u1 ? hi : lo) + __shfl_xor(u1 ? lo : hi, 2); }
    return (u2 ? b2[1] : b2[0]) + __shfl_xor(u2 ? b2[0] : b2[1], 4);
}
DI float reduce_halves(float lo8, float hi8, int lane) {
    const bool u3 = lane & 8;
    float t = (u3 ? hi8 : lo8) + __shfl_xor(u3 ? lo8 : hi8, 8);
    t += __shfl_xor(t, 16); t += __shfl_xor(t, 32); return t;
}
DI float softmax16(float lg) {
    float mx = lg;
#pragma unroll
    for (int o = 1; o < 16; o <<= 1) mx = fmaxf(mx, __shfl_xor(mx, o));
    const float ex = __expf(lg - mx); float den = ex;
#pragma unroll
    for (int o = 1; o < 16; o <<= 1) den += __shfl_xor(den, o);
    return ex / den;
}
DI void aff_store(float v, float* affL, float* affC, int row, int lane) {
    if (lane < 16) { if (row < ML) { const int b = row >> 11, n = row & 2047; affL[(size_t)(b * 16 + lane) * SEQ + n] = v; }
                     else { const int rc = row - ML, b = rc >> 8, n = rc & 255; affC[(size_t)(b * 16 + lane) * CTXL + n] = v; } }
}
DI void router_rows2(const f32x4 (&y0)[8], const f32x4 (&y1)[8], const LAS float* rwT, float* affL, float* affC, int row0, int lane) {
    f32x2 yp[8][4];
#pragma unroll
    for (int j = 0; j < 8; ++j)
#pragma unroll
        for (int q = 0; q < 4; ++q) yp[j][q] = (f32x2){y0[j][q], y1[j][q]};
    float r0[2], r1[2];
#pragma unroll
    for (int hf = 0; hf < 2; ++hf) {
        float l0[8], l1[8];
#pragma unroll
        for (int e = 0; e < 8; ++e) { f32x2 acc = (f32x2){0.f, 0.f};
#pragma unroll
            for (int j = 0; j < 8; ++j) { const f32x4 w = *(const LAS f32x4*)(rwT + (8 * hf + e) * DM + 4 * lane + 256 * j);
#pragma unroll
                for (int q = 0; q < 4; ++q) acc = __builtin_elementwise_fma(yp[j][q], (f32x2){w[q], w[q]}, acc); }
            l0[e] = acc.x; l1[e] = acc.y; __builtin_amdgcn_sched_barrier(0); }
        r0[hf] = reduce8(l0, lane); r1[hf] = reduce8(l1, lane);
    }
    const float a0 = softmax16(reduce_halves(r0[0], r0[1], lane)), a1 = softmax16(reduce_halves(r1[0], r1[1], lane));
    aff_store(a0, affL, affC, row0, lane); aff_store(a1, affL, affC, row0 + 1, lane);
}
DI void ph_rwt(const float* rw, float* rwT, int gtid, int GT) {
    for (int i = gtid; i < 2 * 16 * DM; i += GT) { const int l = i >> 15, e = (i >> 11) & 15, d = i & (DM - 1); rwT[i] = rw[(size_t)l * DM * 16 + d * 16 + e]; }
}
DI void load_router(const float* rwT_g, LAS float* rwT, int tid) {
    for (int i = tid; i < DM * 16 / 4; i += 512) ((LAS f32x4*)rwT)[i] = ((const f32x4*)rwT_g)[i];
    __syncthreads();
}
DI void modffn_table(const float* gain, const float* shift, const float* scale, LAS u32x4* tab, int tid) {
    const int c = 4 * (tid & 63) + 256 * (tid >> 6);
    const f32x4 g = *(const f32x4*)(gain + c), sc = *(const f32x4*)(scale + c), sh = *(const f32x4*)(shift + c); const f32x4 gm = g * (sc + 1.0f);
    u32x4 e; e.x = pk2(gm[0], gm[1]); e.y = pk2(gm[2], gm[3]); e.z = pk2(sh[0], sh[1]); e.w = pk2(sh[2], sh[3]);
    tab[tid] = e;
}
DI void modffn_block(const bf16_t* H, const LAS u32x4* tab, bf16_t* A, const LAS float* rwT, float* affL, float* affC, int rp0, int np, int lane) {
    u32x2 p0[8], p1[8];
#define MODFFN_LOAD(rp_) do { const int row_ = 2 * (rp_); _Pragma("unroll") for (int j = 0; j < 8; ++j) { p0[j] = *(const u32x2*)(H + (size_t)row_ * DM + 4 * lane + 256 * j); p1[j] = *(const u32x2*)(H + (size_t)(row_ + 1) * DM + 4 * lane + 256 * j); } } while (0)
    MODFFN_LOAD(rp0);
    for (int i = 0; i < np; ++i) {
        const int row = 2 * (rp0 + i);
        float s0 = 0.f, s1 = 0.f;
#pragma unroll
        for (int j = 0; j < 8; ++j) { const float a0 = bf_lo(p0[j].x), a1 = bf_hi(p0[j].x), a2 = bf_lo(p0[j].y), a3 = bf_hi(p0[j].y); s0 += (a0 * a0 + a1 * a1) + (a2 * a2 + a3 * a3);
                                      const float b0 = bf_lo(p1[j].x), b1 = bf_hi(p1[j].x), b2 = bf_lo(p1[j].y), b3 = bf_hi(p1[j].y); s1 += (b0 * b0 + b1 * b1) + (b2 * b2 + b3 * b3); }
        s0 = wave_sum(s0); s1 = wave_sum(s1);
        const float r0 = 1.0f / sqrtf(s0 * (1.0f / DM) + NORM_EPS), r1 = 1.0f / sqrtf(s1 * (1.0f / DM) + NORM_EPS);
        f32x4 y0[8], y1[8];
#pragma unroll
        for (int j = 0; j < 8; ++j) { const int c = 4 * lane + 256 * j; const u32x4 e = tab[lane + 64 * j];
            const f32x4 gm = (f32x4){bf_lo(e.x), bf_hi(e.x), bf_lo(e.y), bf_hi(e.y)}, sh = (f32x4){bf_lo(e.z), bf_hi(e.z), bf_lo(e.w), bf_hi(e.w)};
            const f32x4 v0 = (f32x4){bf_lo(p0[j].x), bf_hi(p0[j].x), bf_lo(p0[j].y), bf_hi(p0[j].y)}, v1 = (f32x4){bf_lo(p1[j].x), bf_hi(p1[j].x), bf_lo(p1[j].y), bf_hi(p1[j].y)};
            y0[j] = (v0 * r0) * gm + sh; y1[j] = (v1 * r1) * gm + sh;
            *(unsigned*)((unsigned char*)A + (size_t)row * DM + c) = pk4_fp8(y0[j][0], y0[j][1], y0[j][2], y0[j][3]);
            *(unsigned*)((unsigned char*)A + (size_t)(row + 1) * DM + c) = pk4_fp8(y1[j][0], y1[j][1], y1[j][2], y1[j][3]); }
        if (i + 1 < np) MODFFN_LOAD(rp0 + i + 1);
        asm volatile("" ::: "memory");
        router_rows2(y0, y1, rwT, affL, affC, row, lane);
    }
#undef MODFFN_LOAD
}
DI void ph_modffn(const bf16_t* H, const float* gain, const float* modl, bf16_t* A, const LAS float* rwT, LAS u32x4* tab, float* affL, float* affC, int nrows, int bid, int G, int tid) {
    const int lane = tid & 63, wave = tid >> 6, NGW = G * 8;
    for (int b0 = bid * 8; b0 < ML / 8; b0 += NGW) {
        const int cr = (8 * b0) >> 11;
        __syncthreads(); modffn_table(gain, modl + (size_t)cr * NMOD + 3 * DM, modl + (size_t)cr * NMOD + 4 * DM, tab, tid); __syncthreads();
        modffn_block(H, tab, A, rwT, affL, affC, 4 * (b0 + wave), 4, lane);
    }
    if (nrows > ML) {
        __syncthreads(); modffn_table(gain, modl + (size_t)8 * NMOD + 3 * DM, modl + (size_t)8 * NMOD + 4 * DM, tab, tid); __syncthreads();
        if (!(wave & 1))
            for (int pp = (bid * 8 + wave) >> 1; pp < (nrows - ML) / 2; pp += NGW >> 1) modffn_block(H, tab, A, rwT, affL, affC, ML / 2 + pp, 1, lane);
    }
}
constexpr int MF_TAB = RING_BYTES, MF_XSSQ = RING_BYTES + 8192;
static_assert(MF_XSSQ + 512 <= MISC_OFF, "modffn LDS map");
DI void ph_wprime(const float* nffn, const float* mod, const float* rwt, u32x4* wp, float* wb, int gtid, int GT, int gw, int lane) {
    for (int i = gtid; i < 2 * 9 * 4096; i += GT) {
        const int lc = i >> 12, l = lc / 9, cr = lc % 9, e = i & 4095, ks = e >> 6, ln = e & 63, n = ln & 15, q = ln >> 4, c0 = 64 * (ks >> 1) + 16 * q + 8 * (ks & 1);
        const float* gain = nffn + l * DM; const float* scale = mod + (size_t)(l * 9 + cr) * NMOD + 4 * DM; const float* rwT_g = rwt + l * 16 * DM;
        float w[8];
#pragma unroll
        for (int hh = 0; hh < 2; ++hh) { const f32x4 r = *(const f32x4*)(rwT_g + n * DM + c0 + 4 * hh), g = *(const f32x4*)(gain + c0 + 4 * hh), sc = *(const f32x4*)(scale + c0 + 4 * hh);
#pragma unroll
            for (int k = 0; k < 4; ++k) w[4 * hh + k] = r[k] * (g[k] * (sc[k] + 1.0f)); }
        u32x4 hi, lo;
#pragma unroll
        for (int d = 0; d < 4; ++d) { const unsigned ph = pk2(w[2 * d], w[2 * d + 1]); hi[d] = ph; lo[d] = pk2(w[2 * d] - bf_lo(ph), w[2 * d + 1] - bf_hi(ph)); }
        wp[(size_t)lc * 8192 + (ks * 2 + 0) * 64 + ln] = hi; wp[(size_t)lc * 8192 + (ks * 2 + 1) * 64 + ln] = lo;
    }
    if (gw < 2 * 9 * 16) { const int lc = gw >> 4, n = gw & 15, l = lc / 9; const float* shift = mod + (size_t)lc * NMOD + 3 * DM; const float* rw = rwt + (l * 16 + n) * DM; float s = 0.f;
#pragma unroll
        for (int j = 0; j < 8; ++j) { const f32x4 r = *(const f32x4*)(rw + 4 * lane + 256 * j), sh = *(const f32x4*)(shift + 4 * lane + 256 * j); s += (r[0] * sh[0] + r[1] * sh[1]) + (r[2] * sh[2] + r[3] * sh[3]); }
        s = wave_sum(s); if (lane == 0) wb[gw] = s; }
}
DI void modffn_prepare(const float* gain, const float* shift, const float* scale, const u32x4* wp_lc, LAS unsigned char* lds, int tid) {
    __syncthreads();
    { const int c = 4 * tid;
      const f32x4 g = *(const f32x4*)(gain + c), sc = *(const f32x4*)(scale + c), sh = *(const f32x4*)(shift + c); const f32x4 gm = g * (sc + 1.0f);
      u32x4 e; e.x = pk2(gm[0], gm[1]); e.y = pk2(gm[2], gm[3]); e.z = pk2(sh[0], sh[1]); e.w = pk2(sh[2], sh[3]);
      ((LAS u32x4*)(lds + MF_TAB))[tid] = e; }
    u32x4 t[16];
#pragma unroll
    for (int k = 0; k < 16; ++k) t[k] = wp_lc[tid + 512 * k];
#pragma unroll
    for (int k = 0; k < 16; ++k) ((LAS u32x4*)lds)[tid + 512 * k] = t[k];
    __syncthreads();
}
template <int NG, int KS> DI void modffn_pass(const bf16_t* H, bf16_t* A, LAS unsigned char* lds, const float* wb_lc, float* affL, float* affC, int row_base, int tid) {
    constexpr int NP = 32 / KS;
    const int lane = tid & 63, wave = __builtin_amdgcn_readfirstlane(tid >> 6), g = wave / KS, kh = wave % KS, r = lane & 15, q = lane >> 4;
    const int row = row_base + 16 * g + r, colb = (2048 / KS) * kh + 16 * q;
    u32x4 hv[NP][2];
#pragma unroll
    for (int p = 0; p < NP; ++p) { hv[p][0] = *(const u32x4*)(H + (size_t)row * DM + colb + 64 * p); hv[p][1] = *(const u32x4*)(H + (size_t)row * DM + colb + 64 * p + 8); }
    const float bias = wb_lc[r];
    f32x4 accA = (f32x4){0.f, 0.f, 0.f, 0.f}, accB = (f32x4){0.f, 0.f, 0.f, 0.f}; float ssq = 0.f;
    const LAS u32x4* frag = (const LAS u32x4*)lds + (size_t)(2 * NP * kh) * 128 + lane;
#pragma unroll
    for (int p = 0; p < NP; ++p)
#pragma unroll
        for (int h = 0; h < 2; ++h) {
            const u32x4 bh = frag[(2 * p + h) * 128], bl = frag[(2 * p + h) * 128 + 64]; const u32x4 a = hv[p][h];
            __builtin_amdgcn_s_setprio(1);
            accA = __builtin_amdgcn_mfma_f32_16x16x32_bf16(__builtin_bit_cast(bf16x8, a), __builtin_bit_cast(bf16x8, bh), accA, 0, 0, 0);
            accB = __builtin_amdgcn_mfma_f32_16x16x32_bf16(__builtin_bit_cast(bf16x8, a), __builtin_bit_cast(bf16x8, bl), accB, 0, 0, 0);
            __builtin_amdgcn_s_setprio(0);
#pragma unroll
            for (int d = 0; d < 4; ++d) { const float lo = bf_lo(a[d]), hi = bf_hi(a[d]); ssq += lo * lo + hi * hi; }
            if (h == 1) __builtin_amdgcn_sched_barrier(0);
        }
    ssq += __shfl_xor(ssq, 16); ssq += __shfl_xor(ssq, 32);
    f32x4 acc = accA + accB;
    __syncthreads();
    if (kh > 0) ((LAS f32x4*)lds)[(g * (KS - 1) + kh - 1) * 64 + lane] = acc;
    if (q == 0) ((LAS float*)(lds + MF_XSSQ))[(g * KS + kh) * 16 + r] = ssq;
    __syncthreads();
#pragma unroll
    for (int p = 0; p < NP; ++p) { asm volatile("" : "+v"(hv[p][0])); asm volatile("" : "+v"(hv[p][1])); }
    const LAS float* xs = (const LAS float*)(lds + MF_XSSQ) + g * KS * 16;
    { float st = 0.f;
#pragma unroll
      for (int k = 0; k < KS; ++k) st += xs[16 * k + r];
      const float rstd = 1.0f / sqrtf(st * (1.0f / DM) + NORM_EPS);
      const LAS u32x4* tab = (const LAS u32x4*)(lds + MF_TAB) + (colb >> 2);
#pragma unroll
      for (int p = 0; p < NP; ++p) { u32x4 o;
#pragma unroll
        for (int d = 0; d < 4; ++d) { const u32x4 e = tab[16 * p + d]; const unsigned w0 = hv[p][d >> 1][2 * (d & 1)], w1 = hv[p][d >> 1][2 * (d & 1) + 1];
            const float y0 = bf_lo(w0) * (rstd * bf_lo(e.x)) + bf_lo(e.z), y1 = bf_hi(w0) * (rstd * bf_hi(e.x)) + bf_hi(e.z), y2 = bf_lo(w1) * (rstd * bf_lo(e.y)) + bf_lo(e.w), y3 = bf_hi(w1) * (rstd * bf_hi(e.y)) + bf_hi(e.w);
            o[d] = pk4_fp8(y0, y1, y2, y3); }
        *(u32x4*)((unsigned char*)A + (size_t)row * DM + colb + 64 * p) = o; __builtin_amdgcn_sched_barrier(0); } }
    if (kh == 0) {
#pragma unroll
        for (int k = 1; k < KS; ++k) acc += ((const LAS f32x4*)lds)[(g * (KS - 1) + k - 1) * 64 + lane];
#pragma unroll
        for (int v = 0; v < 4; ++v) { const int rv = 4 * q + v; float st = 0.f;
#pragma unroll
            for (int k = 0; k < KS; ++k) st += xs[16 * k + rv];
            const float rstd = 1.0f / sqrtf(st * (1.0f / DM) + NORM_EPS);
            const float a = softmax16(acc[v] * rstd + bias); const int orow = row_base + 16 * g + rv;
            if (orow < ML) { const int b = orow >> 11, nn = orow & 2047; affL[(size_t)(b * 16 + r) * SEQ + nn] = a; }
            else { const int rc = orow - ML, b = rc >> 8, nn = rc & 255; affC[(size_t)(b * 16 + r) * CTXL + nn] = a; } }
    }
}
DI void ph_modffn_mfma(const bf16_t* H, const float* gain, const float* modl, const u32x4* wp_l, const float* wb_l, bf16_t* A, LAS unsigned char* lds, float* affL, float* affC, int nrows, int bid, int G, int tid) {
    for (int pb = bid; pb < ML / 64; pb += G) { const int cr = (64 * pb) >> 11;
        modffn_prepare(gain, modl + (size_t)cr * NMOD + 3 * DM, modl + (size_t)cr * NMOD + 4 * DM, wp_l + (size_t)cr * 8192, lds, tid);
        modffn_pass<4, 2>(H, A, lds, wb_l + cr * 16, affL, affC, 64 * pb, tid); }
    for (int pb = bid; pb < (nrows - ML) / 16; pb += G) {
        modffn_prepare(gain, modl + (size_t)8 * NMOD + 3 * DM, modl + (size_t)8 * NMOD + 4 * DM, wp_l + (size_t)8 * 8192, lds, tid);
        modffn_pass<1, 8>(H, A, lds, wb_l + 8 * 16, affL, affC, ML + 16 * pb, tid); }
}
DI void ph_topk(int nitems, const float* affL, const float* affC, int* rowsrc, float* gatev, int* inv, LAS unsigned* hist, int tid, int lane, int wave, int bid, int G) {
    LAS unsigned* sh = hist + 256;
    for (int it = bid; it < nitems; it += G) {
        const bool isc = it >= 128; const int be = it & 127, b = be >> 4, e = be & 15;
        const int N = isc ? CTXL : SEQ, C = isc ? CAPC : CAPL;
        const float* src = isc ? affC + (size_t)be * CTXL : affL + (size_t)be * SEQ;
        const int i0 = tid * 4; const bool valid = i0 < N;
        unsigned key[4];
        { f32x4 v = (f32x4){0.f, 0.f, 0.f, 0.f}; if (valid) v = *(const f32x4*)(src + i0);
#pragma unroll
          for (int q = 0; q < 4; ++q) key[q] = __float_as_uint(v[q]); }
        unsigned prefix = 0u, mask = 0u, krem = (unsigned)C;
        for (int pass = 3; pass >= 0; --pass) {
            const int shift = pass * 8;
            if (tid < 256) hist[tid] = 0u;
            __syncthreads();
            if (valid) {
#pragma unroll
                for (int q = 0; q < 4; ++q) if ((key[q] & mask) == prefix) __hip_atomic_fetch_add(&hist[(key[q] >> shift) & 255u], 1u, __ATOMIC_RELAXED, __HIP_MEMORY_SCOPE_WORKGROUP); }
            __syncthreads();
            if (wave == 0) {
                const unsigned h0 = hist[4 * lane], h1 = hist[4 * lane + 1], h2 = hist[4 * lane + 2], h3 = hist[4 * lane + 3];
                const unsigned tot = h0 + h1 + h2 + h3; unsigned incl = tot;
#pragma unroll
                for (int o = 1; o < 64; o <<= 1) { const unsigned t = __shfl_down(incl, o); if (lane + o < 64) incl += t; }
                const unsigned a3 = incl - tot, a2 = a3 + h3, a1 = a2 + h2, a0 = a1 + h1;
                if (a3 < krem && krem <= a3 + h3) { sh[0] = 4 * lane + 3; sh[1] = krem - a3; }
                if (a2 < krem && krem <= a2 + h2) { sh[0] = 4 * lane + 2; sh[1] = krem - a2; }
                if (a1 < krem && krem <= a1 + h1) { sh[0] = 4 * lane + 1; sh[1] = krem - a1; }
                if (a0 < krem && krem <= a0 + h0) { sh[0] = 4 * lane + 0; sh[1] = krem - a0; }
            }
            __syncthreads();
            const unsigned B = sh[0]; krem = sh[1]; prefix |= B << shift; mask |= 0xFFu << shift;
        }
        const unsigned T = prefix;
        unsigned cg = 0u, ce = 0u;
        if (valid) {
#pragma unroll
            for (int q = 0; q < 4; ++q) { cg += key[q] > T ? 1u : 0u; ce += key[q] == T ? 1u : 0u; } }
        const unsigned mine = cg | (ce << 16); unsigned incl = mine;
#pragma unroll
        for (int o = 1; o < 64; o <<= 1) { const unsigned t = __shfl_up(incl, o); if (lane >= o) incl += t; }
        if (lane == 63) sh[8 + wave] = incl;
        __syncthreads();
        unsigned woff = 0u;
#pragma unroll
        for (int w = 0; w < 8; ++w) woff += (w < wave) ? sh[8 + w] : 0u;
        const unsigned excl = woff + incl - mine; unsigned gtb = excl & 0xFFFFu, eqb = excl >> 16;
        if (valid) {
            const int ybase = e * YR + (isc ? NB * CAPL + b * CAPC : b * CAPL); const int rbase = isc ? ML + b * CTXL : b * SEQ;
#pragma unroll
            for (int q = 0; q < 4; ++q) {
                const bool isg = key[q] > T, ise = key[q] == T; const bool sel = isg || (ise && eqb < krem);
                const unsigned slot = gtb + (eqb < krem ? eqb : krem);
                const int trow = rbase + i0 + q; const int yrow = ybase + (int)slot;
                if (sel) { rowsrc[yrow] = trow; gatev[yrow] = __uint_as_float(key[q]); }
                inv[(size_t)trow * 16 + e] = sel ? yrow : -1;
                gtb += isg ? 1u : 0u; eqb += ise ? 1u : 0u;
            }
        }
        __syncthreads();
    }
}
#define CMB_FENCE() do { asm volatile("" ::: "memory"); __builtin_amdgcn_sched_barrier(0); } while (0)
template <bool LAST> DI void cmb_block(bf16_t* H, const bf16_t* Y, const int* inv, const float* g2, const float* gain1, const float* shift, const float* scale, bf16_t* A, float* out, int row0, int n, int lane) {
    u32x2 gvp[8], Gmp[8], shp[8];
    { f32x4 t0[8], t1[8], t2[8], t3[8];
#pragma unroll
      for (int j = 0; j < 8; ++j) { const int c = 4 * lane + 256 * j; t0[j] = *(const f32x4*)(g2 + c); if (!LAST) { t1[j] = *(const f32x4*)(gain1 + c); t2[j] = *(const f32x4*)(scale + c); t3[j] = *(const f32x4*)(shift + c); } }
      CMB_FENCE();
#pragma unroll
      for (int j = 0; j < 8; ++j) { const f32x4 t = t0[j] * Y8_INV; gvp[j].x = pk2(t[0], t[1]); gvp[j].y = pk2(t[2], t[3]);
        if (!LAST) { const f32x4 gm = t1[j] * (t2[j] + 1.0f); Gmp[j].x = pk2(gm[0], gm[1]); Gmp[j].y = pk2(gm[2], gm[3]); shp[j].x = pk2(t3[j][0], t3[j][1]); shp[j].y = pk2(t3[j][2], t3[j][3]); } }
      CMB_FENCE(); }
#define CMB_UNPK(P) ((f32x4){bf_lo((P).x), bf_hi((P).x), bf_lo((P).y), bf_hi((P).y)})
    u32x2 hp[8], hn[8]; int iv0, iv1 = -1, iv2 = -1;
    unsigned q1[8], q2[8]; unsigned m; float f1, f2;
#define CMB_LOADH(HP, row_) do { _Pragma("unroll") for (int j = 0; j < 8; ++j) HP[j] = *(const u32x2*)(H + (size_t)(row_) * DM + 4 * lane + 256 * j); } while (0)
#define CMB_INV(row_) inv[(size_t)(row_) * 16 + (lane & 15)]
#define CMB_GATHER(IV) do { const bool one_ = m != 0u; const int e1_ = one_ ? __builtin_ctz(m) : 0; m &= m - 1u; const bool two_ = one_ && m != 0u; const int e2_ = two_ ? __builtin_ctz(m) : e1_; if (two_) m &= m - 1u; \
        const int r1_ = __builtin_amdgcn_readlane(IV, e1_), r2_ = __builtin_amdgcn_readlane(IV, e2_); \
        const unsigned char* y1_ = (const unsigned char*)Y + (size_t)(one_ ? r1_ : 0) * DM + 4 * lane; const unsigned char* y2_ = (const unsigned char*)Y + (size_t)(two_ ? r2_ : 0) * DM + 4 * lane; \
        _Pragma("unroll") for (int j = 0; j < 8; ++j) { q1[j] = *(const unsigned*)(y1_ + 256 * j); q2[j] = *(const unsigned*)(y2_ + 256 * j); } \
        f1 = one_ ? 1.0f : 0.0f; f2 = two_ ? 1.0f : 0.0f; } while (0)
    CMB_LOADH(hp, row0); iv0 = CMB_INV(row0); if (n > 1) iv1 = CMB_INV(row0 + 1);
    m = (unsigned)(__ballot(iv0 >= 0) & 0xFFFFull);
    CMB_GATHER(iv0);
    for (int i = 0; i < n; ++i) {
        const int row = row0 + i; const bool more = i + 1 < n;
        if (more) CMB_LOADH(hn, row + 1);
        if (i + 2 < n) iv2 = CMB_INV(row + 2);
        CMB_FENCE();
        f32x4 acc[8];
#pragma unroll
        for (int j = 0; j < 8; ++j) acc[j] = unpk4_fp8(q1[j]) * f1 + unpk4_fp8(q2[j]) * f2;
        while (m) {
            CMB_GATHER(iv0);
#pragma unroll
            for (int j = 0; j < 8; ++j) acc[j] += unpk4_fp8(q1[j]) * f1 + unpk4_fp8(q2[j]) * f2;
        }
        CMB_FENCE();
        if (more) { m = (unsigned)(__ballot(iv1 >= 0) & 0xFFFFull); CMB_GATHER(iv1); }
        CMB_FENCE();
        f32x4 v[8];
#pragma unroll
        for (int j = 0; j < 8; ++j) { const f32x4 h = (f32x4){bf_lo(hp[j].x), bf_hi(hp[j].x), bf_lo(hp[j].y), bf_hi(hp[j].y)}; v[j] = h + CMB_UNPK(gvp[j]) * acc[j]; }
        if (LAST) {
#pragma unroll
            for (int j = 0; j < 8; ++j) *(f32x4*)(out + (size_t)row * DM + 4 * lane + 256 * j) = v[j];
        } else {
            float ss = 0.f;
#pragma unroll
            for (int j = 0; j < 8; ++j) ss += (v[j][0] * v[j][0] + v[j][1] * v[j][1]) + (v[j][2] * v[j][2] + v[j][3] * v[j][3]);
            ss = wave_sum(ss);
            const float rstd = 1.0f / sqrtf(ss * (1.0f / DM) + NORM_EPS);
            row_store_bf16(H + (size_t)row * DM, v, lane);
#pragma unroll
            for (int j = 0; j < 8; ++j) { const f32x4 y = (v[j] * rstd) * CMB_UNPK(Gmp[j]) + CMB_UNPK(shp[j]);
                *(unsigned*)((unsigned char*)A + (size_t)row * DM + 4 * lane + 256 * j) = pk4_fp8(y[0], y[1], y[2], y[3]); }
        }
        CMB_FENCE();
#pragma unroll
        for (int j = 0; j < 8; ++j) hp[j] = hn[j];
        iv0 = iv1; iv1 = iv2;
    }
#undef CMB_UNPK
#undef CMB_LOADH
#undef CMB_INV
#undef CMB_GATHER
}
template <bool LAST> DI void ph_combine(bf16_t* H, const bf16_t* Y, const int* inv, const float* modl  , const float* gain1, const float* mod1, bf16_t* A, float* out, int nrows, int gw, int NGW, int lane) {
    for (int blk = gw; blk < ML / 8; blk += NGW) { const int row0 = 8 * blk, cr = row0 >> 11;
        cmb_block<LAST>(H, Y, inv, modl + (size_t)cr * NMOD + 5 * DM, gain1, mod1 + (size_t)cr * NMOD + 0 * DM, mod1 + (size_t)cr * NMOD + 1 * DM, A, out, row0, 8, lane); }
    for (int row = ML + gw; row < nrows; row += NGW)
        cmb_block<LAST>(H, Y, inv, modl + (size_t)8 * NMOD + 5 * DM, gain1, mod1 + (size_t)8 * NMOD + 0 * DM, mod1 + (size_t)8 * NMOD + 1 * DM, A, out, row, 1, lane);
}
constexpr int KP = 272;
constexpr int VP = 288;
constexpr int ATT_VOFF = 64 * KP;
constexpr int ATT_TILE = 64 * KP + 64 * VP;
constexpr int ATT_OST = 2 * ATT_TILE;
DI float xhalf_max(float v) { auto rr = __builtin_amdgcn_permlane32_swap(__float_as_uint(v), __float_as_uint(v), false, false); return fmaxf(__uint_as_float(rr[0]), __uint_as_float(rr[1])); }
DI float xhalf_sum(float v) { auto rr = __builtin_amdgcn_permlane32_swap(__float_as_uint(v), __float_as_uint(v), false, false); return __uint_as_float(rr[0]) + __uint_as_float(rr[1]); }
DI int crow(int reg, int h) { return (reg & 3) + 8 * (reg >> 2) + 4 * h; }
DI long long vtr64(const LAS unsigned char* p) { typedef short v4i16_t __attribute__((ext_vector_type(4))); return __builtin_bit_cast(long long, __builtin_amdgcn_ds_read_tr16_b64_v4i16((LAS v4i16_t*)p)); }
DI s16x4 vtr(const LAS unsigned char* p) { typedef short v4i16_t __attribute__((ext_vector_type(4))); return __builtin_bit_cast(s16x4, __builtin_amdgcn_ds_read_tr16_b64_v4i16((LAS v4i16_t*)p)); }
DI bool att_tile_info(int item, int ti, int& base, int& mtype) {
    const int qhalf = item & 1, n = (item >> 3) & 15, b = item >> 7, tt = ti & 1; mtype = 0;
    if (ti < 4) { base = ML + b * CTXL + 64 * ti; return true; }
    const int blk = n - 1 + ((ti - 4) >> 1); if (blk < 0 || blk > 15) return false;
    if (ti < 6) { mtype = 1; if (tt == 0 && qhalf == 1) return false; } else if (ti >= 8) { mtype = 2; if (tt == 1 && qhalf == 0) return false; }
    base = b * SEQ + blk * 128 + 64 * tt; return true;
}
DI void att_next(int& item, int& ti, int G) { for (;;) { ++ti; if (ti >= 10) { ti = 0; item += G; return; } int b_, m_; if (att_tile_info(item, ti, b_, m_)) return; } }
DI void ph_attn(const bf16_t* Q, const bf16_t* Kb, const bf16_t* Vb, bf16_t* O, const float* sink, LAS unsigned char* lds, int tid, int lane, int wave, int bid, int G) {
    constexpr float LOG2E = 1.4426950408889634f;
    const int r = lane & 31, h = lane >> 5, g = wave >> 1, sub = wave & 1;
    const int ldrow = tid >> 3, ldc = tid & 7;
    int item = bid, ti = 0; if (item >= 1024) return;
    u32x4 kr[2], vr[2];
#define ATT_ISSUE(it_, ti_) do { int base_, mt_; att_tile_info(it_, ti_, base_, mt_); const int kvh_ = ((it_) >> 1) & 3; \
        _Pragma("unroll") for (int c2 = 0; c2 < 2; ++c2) { const size_t off_ = (size_t)(base_ + ldrow) * 512 + kvh_ * HD + (ldc + 8 * c2) * 8; kr[c2] = *(const u32x4*)(Kb + off_); vr[c2] = *(const u32x4*)(Vb + off_); } } while (0)
    bf16x8 qf[8]; float m2 = 0.f, lsum = 1.f; f32x16 o[4]; f32x16 negm;
#define ATT_QLOAD(it_) do { const int qrow_ = ((it_) >> 7) * SEQ + (((it_) >> 3) & 15) * 128 + ((it_) & 1) * 64 + sub * 32 + r; const int head_ = (((it_) >> 1) & 3) * 4 + g; \
        _Pragma("unroll") for (int s = 0; s < 8; ++s) qf[s] = *(const bf16x8*)(Q + (size_t)qrow_ * DM + head_ * HD + 16 * s + 8 * h); } while (0)
    ATT_QLOAD(item);
#define ATT_QSETTLE() do { _Pragma("unroll") for (int s_ = 0; s_ < 8; ++s_) asm volatile("" : "+v"(qf[s_])); } while (0)
    ATT_QSETTLE();
    float sk = sink[((item >> 1) & 3) * 4 + g], skn = 0.f; asm volatile("" : "+v"(sk));
    ATT_ISSUE(item, ti);
    int buf = 0;
    while (item < 1024) {
        int nitem = item, nti = ti; att_next(nitem, nti, G);

        LAS unsigned char* tb = lds + buf * ATT_TILE;
#pragma unroll
        for (int c2 = 0; c2 < 2; ++c2) { *(LAS u32x4*)(tb + ldrow * KP + (ldc + 8 * c2) * 16) = kr[c2]; *(LAS u32x4*)(tb + ATT_VOFF + ldrow * VP + (ldc + 8 * c2) * 16) = vr[c2]; }
        if (nitem != item && nitem < 1024) skn = sink[((nitem >> 1) & 3) * 4 + g];
        if (nitem < 1024) ATT_ISSUE(nitem, nti);
        asm volatile("s_waitcnt lgkmcnt(0)" ::: "memory"); __builtin_amdgcn_s_barrier(); asm volatile("" ::: "memory");
        int base, mtype; att_tile_info(item, ti, base, mtype); const int tt = ti & 1;
        const int qhalf = item & 1, kvh = (item >> 1) & 3, n = (item >> 3) & 15, b = item >> 7;
        const int head = kvh * 4 + g, qq = qhalf * 64 + sub * 32 + r; const int qrow = b * SEQ + n * 128 + qq;
        if (ti == 0) {
            m2 = sk * LOG2E; lsum = 1.0f;
#pragma unroll
            for (int i = 0; i < 16; ++i) negm[i] = -m2;
#pragma unroll
            for (int d = 0; d < 4; ++d)
#pragma unroll
                for (int i = 0; i < 16; ++i) o[d][i] = 0.f;
        }
        f32x16 x0, x1;
        __builtin_amdgcn_s_setprio(1);
#pragma unroll
        for (int s = 0; s < 8; ++s) {
            const bf16x8 k0 = *(const LAS bf16x8*)(tb + r * KP + (16 * s + 8 * h) * 2), k1 = *(const LAS bf16x8*)(tb + (32 + r) * KP + (16 * s + 8 * h) * 2);
            if (s == 0) { x0 = __builtin_amdgcn_mfma_f32_32x32x16_bf16(k0, qf[s], negm, 0, 0, 0); x1 = __builtin_amdgcn_mfma_f32_32x32x16_bf16(k1, qf[s], negm, 0, 0, 0); }
            else { x0 = __builtin_amdgcn_mfma_f32_32x32x16_bf16(k0, qf[s], x0, 0, 0, 0); x1 = __builtin_amdgcn_mfma_f32_32x32x16_bf16(k1, qf[s], x1, 0, 0, 0); } }
        __builtin_amdgcn_s_setprio(0);
        if (nitem != item && nitem < 1024) ATT_QLOAD(nitem);
        if (mtype == 1) {
#pragma unroll
            for (int i = 0; i < 16; ++i) { const int kk0 = tt * 64 + crow(i, h); if (kk0 < qq) x0[i] = -1.0e30f; if (kk0 + 32 < qq) x1[i] = -1.0e30f; } }
        if (mtype == 2) {
#pragma unroll
            for (int i = 0; i < 16; ++i) { const int kk0 = tt * 64 + crow(i, h); if (kk0 > qq) x0[i] = -1.0e30f; if (kk0 + 32 > qq) x1[i] = -1.0e30f; } }
        float tmax = fmaxf(x0[0], x1[0]);
#pragma unroll
        for (int i = 1; i < 16; ++i) tmax = fmaxf(fmaxf(tmax, x0[i]), x1[i]);
        tmax = xhalf_max(tmax);
        if (__any(tmax > 0.0f)) {
            const float dl = fmaxf(tmax, 0.0f), alpha = __builtin_amdgcn_exp2f(-dl); m2 += dl; lsum *= alpha;
#pragma unroll
            for (int i = 0; i < 16; ++i) { x0[i] -= dl; x1[i] -= dl; negm[i] = -m2; }
#pragma unroll
            for (int d = 0; d < 4; ++d)
#pragma unroll
                for (int i = 0; i < 16; ++i) o[d][i] *= alpha;
        }
        float ps = 0.f;
#pragma unroll
        for (int i = 0; i < 16; ++i) { x0[i] = __builtin_amdgcn_exp2f(x0[i]); x1[i] = __builtin_amdgcn_exp2f(x1[i]); ps += x0[i] + x1[i]; }
        lsum += xhalf_sum(ps);
        bf16x8 pf[2][2];
#pragma unroll
        for (int s = 0; s < 2; ++s) {
            u32x4 a, c; a.x = pk2(x0[8 * s + 0], x0[8 * s + 1]); a.y = pk2(x0[8 * s + 2], x0[8 * s + 3]); a.z = pk2(x0[8 * s + 4], x0[8 * s + 5]); a.w = pk2(x0[8 * s + 6], x0[8 * s + 7]);
            c.x = pk2(x1[8 * s + 0], x1[8 * s + 1]); c.y = pk2(x1[8 * s + 2], x1[8 * s + 3]); c.z = pk2(x1[8 * s + 4], x1[8 * s + 5]); c.w = pk2(x1[8 * s + 6], x1[8 * s + 7]);
            pf[0][s] = __builtin_bit_cast(bf16x8, a); pf[1][s] = __builtin_bit_cast(bf16x8, c); }
        const LAS unsigned char* vb = tb + ATT_VOFF + (4 * h + ((lane & 15) >> 2)) * VP + (16 * ((lane >> 4) & 1) + 4 * (lane & 3)) * 2;
        __builtin_amdgcn_s_setprio(1);
#pragma unroll
        for (int d = 0; d < 4; ++d)
#pragma unroll
            for (int t = 0; t < 2; ++t)
#pragma unroll
                for (int s = 0; s < 2; ++s) {
                    typedef long long i64x2_t __attribute__((ext_vector_type(2)));
                    i64x2_t vv; vv.x = vtr64(vb + (t * 32 + 16 * s) * VP + d * 64); vv.y = vtr64(vb + (t * 32 + 16 * s + 8) * VP + d * 64);
                    const bf16x8 vf = __builtin_bit_cast(bf16x8, vv);
                    o[d] = __builtin_amdgcn_mfma_f32_32x32x16_bf16(vf, pf[t][s], o[d], 0, 0, 0); }
        __builtin_amdgcn_s_setprio(0);
        if (nitem != item) { ATT_QSETTLE(); asm volatile("" : "+v"(skn)); }
        if (nitem != item) {
            const float il = 1.0f / lsum;
            LAS unsigned char* st = lds + ATT_OST + wave * (32 * KP);
#pragma unroll
            for (int d = 0; d < 4; ++d)
#pragma unroll
                for (int g4 = 0; g4 < 4; ++g4) *(LAS unsigned*)(st + r * 144 + d * 32 + 8 * g4 + 4 * h) = pk4_fp8(o[d][4 * g4 + 0] * il, o[d][4 * g4 + 1] * il, o[d][4 * g4 + 2] * il, o[d][4 * g4 + 3] * il);
            asm volatile("s_waitcnt lgkmcnt(0)" ::: "memory");
            unsigned char* ob = (unsigned char*)O + (size_t)(qrow - r) * DM + head * HD;
#pragma unroll
            for (int j = 0; j < 4; ++j) { const int c = lane + 64 * j, row = c >> 3, c16 = c & 7;
                const u32x4 v = *(const LAS u32x4*)(st + row * 144 + c16 * 16); *(u32x4*)(ob + (size_t)row * DM + c16 * 16) = v; }
        }
        if (nitem != item) sk = skn;
        item = nitem; ti = nti; buf ^= 1;
    }
#undef ATT_ISSUE
#undef ATT_QLOAD
#undef ATT_QSETTLE
}
#ifndef MK_ONE_LAUNCH
#define MK_ONE_LAUNCH 1
#endif
constexpr int NPHASE = 19;
constexpr int CVT_X0_END = CVT_E0 + CVT_L;
#define CVT_MKCP() CvtPtrs CP; CP.cin = args.in[8]; CP.cout = args.in[10]; CP.wqkv = args.in[11]; CP.wo = args.in[15]; CP.wg = args.in[17]; CP.wu = args.in[18]; CP.wd = args.in[19]; \
    CP.W1A = W1A; CP.W1B = W1B; CP.W2 = W2; CP.WQKV = WQKV; CP.WO = WOt; CP.WGU = WGU; CP.WDN = WDN
#define CVT(LO, HI) do { CVT_MKCP(); cvt_range(CP, LO, HI, gw, NGW, cscr, lane); } while (0)
#define TAIL_CVT(NWG, LO, HI) do { const int R_ = ((NWG) + G - 1) / G, rem_ = (NWG) - (R_ - 1) * G; if (bid >= rem_) { CVT_MKCP(); cvt_range(CP, LO, HI, (bid - rem_) * 8 + wave, (G - rem_) * 8, cscr, lane); } } while (0)
#define SIDE_CVT(GA, LO, HI) do { CVT_MKCP(); cvt_range(CP, LO, HI, (bid - (GA)) * 8 + wave, (G - (GA)) * 8, cscr, lane); } while (0)
#ifndef MK_C3
#define MK_C3 11904
#define MK_C4 27648
#define MK_C5 41856
#define MK_C8 45888
#define MK_C9 46784
#define MK_C11 54272
#endif
constexpr int C3 = MK_C3, C4 = MK_C4, C5 = MK_C5, C8 = MK_C8, C9 = MK_C9, C11 = MK_C11, GU0_END = CVT_E0 + 16384, GU1_END = CVT_X0_END + 16384;
static_assert(C5 >= GU0_END && C8 >= CVT_X0_END && C3 >= CVT_E0 && C11 <= CVT_TOTAL, "tail budgets");
#ifndef MK_DUP_MASK
#define MK_DUP_MASK 0u
#endif
#define MK_PROBE_SEAM -1
#define MK_PROBE_BID 255
#define MK_PROBE_DUR 0
constexpr int PROBE_SEAM = MK_PROBE_SEAM, PROBE_BID = MK_PROBE_BID, PROBE_DUR = MK_PROBE_DUR;
constexpr unsigned DUP_MASK = MK_DUP_MASK;
struct Args { const float* in[20]; float* out; unsigned char* ws; int ph_lo, ph_hi; };
__global__ void __launch_bounds__(512, 2) dit_fwd(Args args) {
    extern __shared__ __attribute__((aligned(16))) unsigned char lds_raw[];
    LAS unsigned char* lds = (LAS unsigned char*)lds_raw;
    const int tid = threadIdx.x, lane = tid & 63, wave = __builtin_amdgcn_readfirstlane(tid >> 6);
    const int G = gridDim.x, bid = blockIdx.x;
    const int gw = bid * 8 + wave, NGW = G * 8;
    unsigned char* ws = args.ws;
    const float* x = args.in[0]; const float* cnd = args.in[1]; const float* ctx = args.in[2]; const float* cctx = args.in[3];
    const float* ada_w = args.in[4]; const float* ada_b = args.in[5]; const float* nmix = args.in[6]; const float* nffn = args.in[7];
    const float* conv_w = args.in[9]; const float* qgain = args.in[12]; const float* kgain = args.in[13]; const float* sink = args.in[14]; const float* router_w = args.in[16];
    float* mod = (float*)(ws + WS_MOD); float* modp = (float*)(ws + WS_MODP);
    float* affL = (float*)(ws + WS_AFFL); float* affC = (float*)(ws + WS_AFFC);
    float* rwt = (float*)(ws + WS_RWT);
    u32x4* wprime = (u32x4*)(ws + WS_MODP); float* wbias = (float*)(ws + WS_MODP + (size_t)2 * 9 * 8192 * 16);
    int* idmap = (int*)(ws + WS_IDMAP);
    int* rowsrc = (int*)(ws + WS_ROWSRC); float* gatev = (float*)(ws + WS_GATEV); int* inv = (int*)(ws + WS_INV);
    bf16_t* W1A = (bf16_t*)(ws + WS_W1A); bf16_t* W1B = (bf16_t*)(ws + WS_W1B); bf16_t* W2 = (bf16_t*)(ws + WS_W2); bf16_t* WQKV = (bf16_t*)(ws + WS_WQKV); bf16_t* WOt = (bf16_t*)(ws + WS_WO);
    bf16_t* WGU = (bf16_t*)(ws + WS_WGU); bf16_t* WDN = (bf16_t*)(ws + WS_WDN);
    bf16_t* H = (bf16_t*)(ws + WS_H); bf16_t* A = (bf16_t*)(ws + WS_A); bf16_t* U = (bf16_t*)(ws + WS_U); bf16_t* Z = (bf16_t*)(ws + WS_Z);
    bf16_t* Qb = (bf16_t*)(ws + WS_Q); bf16_t* Kb = (bf16_t*)(ws + WS_K); bf16_t* Vb = (bf16_t*)(ws + WS_V); bf16_t* Ob = (bf16_t*)(ws + WS_O);
    bf16_t* HM = (bf16_t*)(ws + WS_HM); bf16_t* Y = (bf16_t*)(ws + WS_Y);
    LAS unsigned* cscr = (LAS unsigned*)(lds + wave * 9216);

    for (int u = tid; u < (LDS_BYTES - MISC_OFF) / 4; u += 512) ((LAS unsigned*)(lds + MISC_OFF))[u] = 0u;
    __syncthreads();
#if MK_ONE_LAUNCH
    XcdBarrier bar = xcd_barrier_post((unsigned*)(ws + WS_CTL) + CW_BAR, (volatile LAS unsigned*)(lds + MISC_OFF) + 8);
#define GRID_BAR() xcd_barrier(bar)
#else
#define GRID_BAR() do {} while (0)
#endif
    const int lo = args.ph_lo, hi = args.ph_hi;
    const int GA45 = (G * 3 / 4) & ~7;
#define IN(k) (lo <= (k) && (k) < hi)
    unsigned long long pr_t1 = 0, pr_prev = PROBE_SEAM >= 0 ? __builtin_amdgcn_s_memrealtime() : 0ull; long long pr_D = 0;
#define SEAM(k) do { if (IN(k) && IN((k) + 1)) { \
        if (PROBE_SEAM >= 0) { pr_t1 = __builtin_amdgcn_s_memrealtime(); if ((k) == PROBE_SEAM && bid == 0 && tid == 0) __hip_atomic_store((unsigned long long*)(ws + WS_CTL + 65536), pr_t1, __ATOMIC_RELAXED, __HIP_MEMORY_SCOPE_AGENT); } \
        GRID_BAR(); \
        if ((k) == PROBE_SEAM && bid == PROBE_BID) pr_D = PROBE_DUR == 1 ? (long long)(pr_t1 - pr_prev) - 5000 : PROBE_DUR == 2 ? (long long)(__builtin_amdgcn_s_memrealtime() - pr_t1) - 5000 : (long long)(pr_t1 - __hip_atomic_load((unsigned long long*)(ws + WS_CTL + 65536), __ATOMIC_RELAXED, __HIP_MEMORY_SCOPE_AGENT)); \
        if (PROBE_SEAM >= 0) pr_prev = __builtin_amdgcn_s_memrealtime(); } } while (0)
#define PHASE(k) if (IN(k)) _Pragma("unroll") for (int rep_ = 0; rep_ < 1 + (int)((DUP_MASK >> (k)) & 1u); ++rep_)
#define REP_BAR() do { if (rep_) GRID_BAR(); } while (0)

    PHASE(0) { REP_BAR(); ph_adaln(cnd, cctx, ada_w, modp, gw, NGW, lane); } SEAM(0);
    PHASE(1) { REP_BAR(); ph_modred(modp, ada_b, mod, bid * 512 + tid, G * 512); ph_rwt(router_w, rwt, bid * 512 + tid, G * 512); for (int i = bid * 512 + tid; i < YT; i += G * 512) idmap[i] = i; } SEAM(1);
    PHASE(2) { REP_BAR(); ph_wprime(nffn, mod, rwt, wprime, wbias, bid * 512 + tid, G * 512, gw, lane); ph_mod0(x, ctx, nmix, mod, A, gw, NGW, lane); CVT(0, 4096); } SEAM(2);
    PHASE(3) { REP_BAR();
        pg8::Gemm g{A, W1A, MT, 4096, DM}; pg8::StaticOrder S; S.init(MT, 4096, G, bid);
        EpiPair<0> E{U, DM, 16};
        pg8::gemm_phase<EpiPair<0>, pg8::StaticOrder, true, true>(lds, g, S, E);
        TAIL_CVT((MT / 256) * 16, 4096, C3);
    } SEAM(3);
    PHASE(4) { REP_BAR();
        if (bid < GA45) {
        pg8::Gemm g{A, W1B, MT, DM, DM}; pg8::StaticOrder S; S.init(MT, DM, GA45, bid);
        EpiConvGate E{U, Z, conv_w, (const bf16_t*)(ws + WS_CTL + 131072)};
        pg8::gemm_phase<EpiConvGate, pg8::StaticOrder, true, true>(lds, g, S, E);
        } else SIDE_CVT(GA45, C3, C4);
    } SEAM(4);
    PHASE(5) { REP_BAR();
        if (bid < GA45) {
        pg8::Gemm g{Z, W2, MT, DM, DM}; pg8::StaticOrder S; S.init(MT, DM, GA45, bid);
        EpiResid<true> E{x, ctx, H, mod + 2 * DM, 1.0f};
        pg8::gemm_phase<EpiResid<true>, pg8::StaticOrder, true, true>(lds, g, S, E);
        } else SIDE_CVT(GA45, C4, C5);
    } SEAM(5);
    PHASE(6) { REP_BAR(); ph_modffn_mfma(H, nffn, mod, wprime, wbias, A, lds, affL, affC, MT, bid, G, tid); } SEAM(6);
    PHASE(7) { REP_BAR(); ph_topk(256, affL, affC, rowsrc, gatev, inv, (LAS unsigned*)lds, tid, lane, wave, bid, G); } SEAM(7);
    PHASE(8) { REP_BAR();
        pg8::Gemm g{A, WGU, YT, NE * 2048, DM / 2, rowsrc}; MoeOrder S{G, bid, 9};
        EpiPairF8 E{(unsigned char*)HM, DFF, 8};
        pg8::gemm_phase<EpiPairF8, MoeOrder, true, true, true, true>(lds, g, S, E);
        TAIL_CVT(NE * 9 * 8, C5, C8);
    } SEAM(8);
    PHASE(9) { REP_BAR();
        pg8::Gemm g{HM, WDN, YT, NE * 2048, DFF / 2, idmap}; MoeOrder S{G, bid, 9};
        EpiDown E{Y, gatev, W8_INV * Y8_SCALE};
        pg8::gemm_phase<EpiDown, MoeOrder, true, true, true, true>(lds, g, S, E);
        TAIL_CVT(NE * 9 * 8, C8, C9);
    } SEAM(9);
    PHASE(10) { REP_BAR(); ph_combine<false>(H, Y, inv, mod, nmix + DM, mod + 9 * NMOD, A, nullptr, MT, gw, NGW, lane); } SEAM(10);
    PHASE(11) { REP_BAR();
        pg8::Gemm g{A, WQKV, MT, 3072, DM / 2, idmap}; QkvOrder S{G, bid};
        EpiQkvNorm E{Qb, Kb, Vb, qgain, kgain, (LAS float*)(lds + RING_BYTES), W8_INV};
        pg8::gemm_phase<EpiQkvNorm, QkvOrder, true, true, true, true>(lds, g, S, E);
        TAIL_CVT(800, C9, C11);
    } SEAM(11);
    PHASE(12) { REP_BAR(); ph_attn(Qb, Kb, Vb, Ob, sink, lds, tid, lane, wave, bid, G); } SEAM(12);
    PHASE(13) { REP_BAR();
        pg8::Gemm g{Ob, WOt, ML, DM, DM / 2, idmap}; pg8::StaticOrder S; S.init(ML, DM, G, bid);
        EpiResid<false> E{nullptr, nullptr, H, mod + 9 * NMOD + 2 * DM, W8_INV};
        pg8::gemm_phase<EpiResid<false>, pg8::StaticOrder, true, true, true, true>(lds, g, S, E);
    } SEAM(13);
    PHASE(14) { REP_BAR(); ph_modffn_mfma(H, nffn + DM, mod + 9 * NMOD, wprime + (size_t)9 * 8192, wbias + 9 * 16, A, lds, affL, affC, ML, bid, G, tid); } SEAM(14);
    PHASE(15) { REP_BAR(); ph_topk(128, affL, affC, rowsrc, gatev, inv, (LAS unsigned*)lds, tid, lane, wave, bid, G); CVT(C11, GU1_END);
        if (C11 >= GU1_END) { if (G <= 128) CVT(C11, CVT_TOTAL); else if (bid >= 128) { CVT_MKCP(); cvt_range(CP, C11, CVT_TOTAL, (bid - 128) * 8 + wave, (G - 128) * 8, cscr, lane); } }
    } SEAM(15);
    PHASE(16) { REP_BAR();
        pg8::Gemm g{A, (const bf16_t*)((const unsigned char*)WGU + (size_t)NE * 2048 * DM), YT, NE * 2048, DM / 2, rowsrc}; MoeOrder S{G, bid, 8};
        EpiPairF8 E{(unsigned char*)HM, DFF, 8};
        pg8::gemm_phase<EpiPairF8, MoeOrder, true, true, true, true>(lds, g, S, E);
        if (C11 < GU1_END) CVT(GU1_END, CVT_TOTAL);
    } SEAM(16);
    PHASE(17) { REP_BAR();
        pg8::Gemm g{HM, (const bf16_t*)((const unsigned char*)WDN + (size_t)NE * 2048 * DFF), YT, NE * 2048, DFF / 2, idmap}; MoeOrder S{G, bid, 8};
        EpiDown E{Y, gatev, W8_INV * Y8_SCALE};
        pg8::gemm_phase<EpiDown, MoeOrder, true, true, true, true>(lds, g, S, E);
    } SEAM(17);
    PHASE(18) { REP_BAR(); ph_combine<true>(H, Y, inv, mod + 9 * NMOD, nullptr, nullptr, nullptr, args.out, ML, gw, NGW, lane); }
    if (PROBE_SEAM == 18 && PROBE_DUR == 1 && bid == PROBE_BID) pr_D = (long long)(__builtin_amdgcn_s_memrealtime() - pr_prev) - 5000;
    if (PROBE_SEAM >= 0 && bid == PROBE_BID) { const unsigned long long t_end = __builtin_amdgcn_s_memrealtime() + (unsigned long long)(8 * (pr_D + 5000)); while (__builtin_amdgcn_s_memrealtime() < t_end) __builtin_amdgcn_s_sleep(8); }
#undef IN
#undef SEAM
#undef PHASE
#undef REP_BAR
}

extern "C" void kernel_launch(void* const* d_in, const int* in_sizes, int n_in, void* d_out, int out_size, void* d_ws, size_t ws_size, hipStream_t stream) {
    static int grid = 0;
    if (grid == 0) {
        if (n_in != 20 || out_size != ML * DM || ws_size < WS_END) { fprintf(stderr, "kernel_launch: unexpected problem (n_in %d, out %d, ws %zu); nothing launched\n", n_in, out_size, ws_size); grid = -1; return; }
        int dev = 0, cus = 0, per_cu = 0;
        if (hipGetDevice(&dev) != hipSuccess || hipDeviceGetAttribute(&cus, hipDeviceAttributeMultiprocessorCount, dev) != hipSuccess) { grid = -1; return; }
        if (hipFuncSetAttribute((const void*)dit_fwd, hipFuncAttributeMaxDynamicSharedMemorySize, LDS_BYTES) != hipSuccess) { fprintf(stderr, "kernel_launch: hipFuncSetAttribute failed\n"); grid = -1; return; }
        if (hipOccupancyMaxActiveBlocksPerMultiprocessor(&per_cu, (const void*)dit_fwd, 512, LDS_BYTES) != hipSuccess || per_cu < 1) fprintf(stderr, "kernel_launch: occupancy query reports %d workgroups per CU\n", per_cu);
        (void)hipGetLastError();
        grid = cus;
    }
    if (grid < 0) return;
    (void)hipMemsetAsync((char*)d_ws + WS_CTL, 0, CTL_ZERO_BYTES, stream);
    Args a{};
    for (int i = 0; i < 20; ++i) a.in[i] = (const float*)d_in[i];
    a.out = (float*)d_out; a.ws = (unsigned char*)d_ws;
#if MK_ONE_LAUNCH
    a.ph_lo = 0; a.ph_hi = NPHASE;
    hipLaunchKernelGGL(dit_fwd, dim3(grid), dim3(512), LDS_BYTES, stream, a);
#else
    for (int p = 0; p < NPHASE; ++p) { a.ph_lo = p; a.ph_hi = p + 1; hipLaunchKernelGGL(dit_fwd, dim3(grid), dim3(512), LDS_BYTES, stream, a); }
#endif
}
```
